# Optimizing an MI355X kernel written in HIP

```python
import math
import numpy as np
import jax
import jax.numpy as jnp
from jax import lax

D_MODEL = 1024
BATCH = 16
SEQ = 4096
DEPTH = 4

CHUNK = 64
N_BRANCH = 4
BRANCH_WIDTH = D_MODEL // 2
HEAD_DIM = 64
RMS_EPS = 1e-6

SSD_INNER = BRANCH_WIDTH
SSD_HEAD_DIM = HEAD_DIM
SSD_HEADS = SSD_INNER // SSD_HEAD_DIM
SSD_GROUPS = 2
SSD_STATE = 64
SSD_CONV = 4
SSD_XBC = SSD_INNER + 2 * SSD_GROUPS * SSD_STATE

DSA_WIDTH = BRANCH_WIDTH
DSA_HEAD_DIM = HEAD_DIM
DSA_HEADS = DSA_WIDTH // DSA_HEAD_DIM
IDX_HEADS = 4
IDX_DIM = 32
DSA_MAX_TOPK = 256
DSA_Q_BLOCK = 32

REL_BUCKETS = 32
REL_MAX_DIST = 256

RWKV_WIDTH = BRANCH_WIDTH
RWKV_HEAD_DIM = HEAD_DIM
RWKV_HEADS = RWKV_WIDTH // RWKV_HEAD_DIM
RWKV_DECAY_LORA = 64
RWKV_ICLR_LORA = 64
RWKV_GATE_LORA = 128
RWKV_GN_EPS = 64e-5
RWKV_COLS = 3 * RWKV_WIDTH + RWKV_DECAY_LORA + RWKV_ICLR_LORA + RWKV_GATE_LORA

S5_WIDTH = BRANCH_WIDTH
S5_GROUP = 16
S5_GROUPS = S5_WIDTH // S5_GROUP
S5_STATE = 64

FFN_HIDDEN = -(-8 * D_MODEL // (3 * 256)) * 256

IN_SPLITS = (
    SSD_INNER, SSD_XBC, SSD_HEADS,
    DSA_WIDTH, DSA_WIDTH, DSA_WIDTH, IDX_HEADS * IDX_DIM, IDX_DIM, IDX_HEADS,
    RWKV_COLS,
    S5_WIDTH,
    N_BRANCH * D_MODEL,
)
IN_COLS = sum(IN_SPLITS)

kernel_name = "chunk_causal_hybrid_ssd_dsa_rwkv7_s5"


def _split_last(a, sizes):
    idx = np.cumsum(sizes)[:-1].tolist()
    return jnp.split(a, idx, axis=-1)


def _rmsnorm(x, g):
    xf = x.astype(jnp.float32)
    y = xf * lax.rsqrt(jnp.mean(xf * xf, axis=-1, keepdims=True) + RMS_EPS)
    return (y * g.astype(jnp.float32)).astype(x.dtype)


def _causal_depthwise_conv(x, w, bias):
    width, ch = w.shape
    y = lax.conv_general_dilated(x, w[:, None, :].astype(x.dtype), window_strides=(1,),
                                 padding=((width - 1, 0),), dimension_numbers=("NWC", "WIO", "NWC"),
                                 feature_group_count=ch)
    return y + bias.astype(y.dtype)


def _segsum(a):
    n = a.shape[-1]
    cs = jnp.cumsum(a, axis=-1)
    diff = cs[..., :, None] - cs[..., None, :]
    return jnp.where(jnp.tril(jnp.ones((n, n), dtype=bool)), diff, -jnp.inf)


def _ssd_scan(xs, a, bm, cm):
    b, t, h, p = xs.shape
    n = bm.shape[-1]
    c = t // CHUNK
    xs = xs.reshape(b, c, CHUNK, h, p)
    bm = bm.reshape(b, c, CHUNK, h, n)
    cm = cm.reshape(b, c, CHUNK, h, n)
    a = a.reshape(b, c, CHUNK, h).transpose(0, 3, 1, 2)
    a_cs = jnp.cumsum(a, axis=-1)
    decay_in = jnp.exp(_segsum(a))
    y_diag = jnp.einsum("bclhn,bcshn,bhcls,bcshp->bclhp", cm, bm, decay_in, xs)
    decay_to_end = jnp.exp(a_cs[..., -1:] - a_cs)
    chunk_states = jnp.einsum("bclhn,bhcl,bclhp->bchpn", bm, decay_to_end, xs)
    chunk_decay = jnp.exp(a_cs[..., -1])

    def step(state, inp):
        st, dec = inp
        return state * dec[..., None, None] + st, state

    _, prev = lax.scan(step, jnp.zeros((b, h, p, n), xs.dtype),
                       (jnp.moveaxis(chunk_states, 1, 0), jnp.moveaxis(chunk_decay, 2, 0)))
    prev = jnp.moveaxis(prev, 0, 1)
    y_off = jnp.einsum("bclhn,bchpn,bhcl->bclhp", cm, prev, jnp.exp(a_cs))
    return (y_diag + y_off).reshape(b, t, h, p)


def _ssd_mixer(z, xbc, dt_raw, conv_w, conv_b, dt_bias, a_log, d_skip, norm_g):
    b, t, _ = z.shape
    f32 = jnp.float32
    xbc = jax.nn.silu(_causal_depthwise_conv(xbc, conv_w, conv_b)).astype(f32)
    xs, bm, cm = _split_last(xbc, (SSD_INNER, SSD_GROUPS * SSD_STATE, SSD_GROUPS * SSD_STATE))
    xs = xs.reshape(b, t, SSD_HEADS, SSD_HEAD_DIM)
    rep = SSD_HEADS // SSD_GROUPS
    bm = jnp.repeat(bm.reshape(b, t, SSD_GROUPS, SSD_STATE), rep, axis=2)
    cm = jnp.repeat(cm.reshape(b, t, SSD_GROUPS, SSD_STATE), rep, axis=2)
    dt = jax.nn.softplus(dt_raw.astype(f32) + dt_bias.astype(f32))
    a = -jnp.exp(a_log.astype(f32))
    y = _ssd_scan(xs * dt[..., None], dt * a, bm, cm)
    y = y + d_skip.astype(f32)[:, None] * xs
    y = y.reshape(b, t, SSD_INNER) * jax.nn.silu(z.astype(f32))
    yg = y.reshape(b, t, SSD_GROUPS, SSD_INNER // SSD_GROUPS)
    yg = yg * lax.rsqrt(jnp.mean(yg * yg, axis=-1, keepdims=True) + RMS_EPS)
    return (yg.reshape(b, t, SSD_INNER) * norm_g.astype(f32)).astype(z.dtype)


def _t5_bucket(rel):
    half = REL_BUCKETS // 2
    exact = half // 2
    ret = jnp.where(rel > 0, half, 0)
    n = jnp.abs(rel)
    n_f = jnp.maximum(n, 1).astype(jnp.float32)
    large = exact + (jnp.log(n_f / exact) / math.log(REL_MAX_DIST / exact) * (half - exact)).astype(jnp.int32)
    large = jnp.minimum(large, half - 1)
    return ret + jnp.where(n < exact, n, large)


def _dsa_mixer(q, k, v, qi, ki, wi, rel_bias):
    b, t, h, dh = q.shape
    f32 = jnp.float32
    top_k = min(DSA_MAX_TOPK, t // 4)
    n_blk = t // DSA_Q_BLOCK
    key_chunk = jnp.arange(t) // CHUNK
    ki_f = ki.astype(f32)

    def one_block(start):
        qb = lax.dynamic_slice_in_dim(q, start, DSA_Q_BLOCK, axis=1)
        qib = lax.dynamic_slice_in_dim(qi, start, DSA_Q_BLOCK, axis=1).astype(f32)
        wib = lax.dynamic_slice_in_dim(wi, start, DSA_Q_BLOCK, axis=1).astype(f32)
        q_pos = start + jnp.arange(DSA_Q_BLOCK)
        s_h = jax.nn.relu(jnp.einsum("bqhe,bse->bqhs", qib, ki_f) * IDX_DIM ** -0.5)
        score = jnp.einsum("bqhs,bqh->bqs", s_h, wib) * IDX_HEADS ** -0.5
        admissible = key_chunk[None, :] <= (q_pos // CHUNK)[:, None]
        score = jnp.where(admissible[None], score, -jnp.inf)
        sel_score, sel_idx = lax.top_k(score, top_k)
        valid = jnp.isfinite(sel_score)
        k_sel = jax.vmap(lambda kb, ib: kb[ib])(k, sel_idx)
        v_sel = jax.vmap(lambda vb, ib: vb[ib])(v, sel_idx)
        logits = jnp.einsum("bqhd,bqkhd->bqhk", qb, k_sel).astype(f32) * dh ** -0.5
        bucket = _t5_bucket(sel_idx - q_pos[None, :, None])
        logits = logits + jnp.transpose(rel_bias[bucket], (0, 1, 3, 2)).astype(f32)
        logits = jnp.where(valid[:, :, None, :], logits, -jnp.inf)
        probs = jax.nn.softmax(logits, axis=-1)
        return jnp.einsum("bqhk,bqkhd->bqhd", probs.astype(v.dtype), v_sel)

    out = lax.map(one_block, jnp.arange(n_blk, dtype=jnp.int32) * DSA_Q_BLOCK)
    return out.transpose(1, 0, 2, 3, 4).reshape(b, t, h * dh)


def _wkv7_scan(r, decay, k, v, a, bb):
    bsz, t, h, n = r.shape

    def step(s, inp):
        r_t, w_t, k_t, v_t, a_t, b_t = inp
        sa = jnp.einsum("bhvk,bhk->bhv", s, a_t)
        s = s * w_t[:, :, None, :] + sa[..., None] * b_t[:, :, None, :] + v_t[..., None] * k_t[:, :, None, :]
        return s, jnp.einsum("bhvk,bhk->bhv", s, r_t)

    seq = tuple(jnp.moveaxis(z, 1, 0) for z in (r, decay, k, v, a, bb))
    _, y = lax.scan(step, jnp.zeros((bsz, h, n, n), jnp.float32), seq)
    return jnp.moveaxis(y, 0, 1)


def _rwkv7_mixer(cols, mu, w0, w2, a0, a2, g2, k_k, k_a, r_k, ln_g, ln_b):
    b, t, _ = cols.shape
    f32 = jnp.float32
    hd = (b, t, RWKV_HEADS, RWKV_HEAD_DIM)
    p = cols.astype(f32)
    p_prev = jnp.pad(p, ((0, 0), (1, 0), (0, 0)))[:, :-1]
    p = p + (p_prev - p) * mu.astype(f32)
    r, k, v, dw, da, dg = _split_last(p, (RWKV_WIDTH, RWKV_WIDTH, RWKV_WIDTH,
                                          RWKV_DECAY_LORA, RWKV_ICLR_LORA, RWKV_GATE_LORA))
    w = -jax.nn.softplus(-(w0.astype(f32) + jnp.tanh(dw) @ w2.astype(f32))) - 0.5
    decay = jnp.exp(-jnp.exp(w))
    a = jax.nn.sigmoid(a0.astype(f32) + da @ a2.astype(f32))
    g = jax.nn.sigmoid(dg) @ g2.astype(f32)
    kk = (k * k_k.astype(f32)).reshape(hd)
    kk = kk / jnp.maximum(jnp.linalg.norm(kk, axis=-1, keepdims=True), 1e-12)
    k = k * (1.0 + (a - 1.0) * k_a.astype(f32))
    rh, kh, vh, ah = r.reshape(hd), k.reshape(hd), v.reshape(hd), a.reshape(hd)
    y = _wkv7_scan(rh, decay.reshape(hd), kh, vh, -kk, kk * ah)
    mean = jnp.mean(y, axis=-1, keepdims=True)
    var = jnp.mean(jnp.square(y - mean), axis=-1, keepdims=True)
    y = ((y - mean) * lax.rsqrt(var + RWKV_GN_EPS)).reshape(b, t, RWKV_WIDTH)
    y = y * ln_g.astype(f32) + ln_b.astype(f32)
    bonus = jnp.sum(rh * kh * r_k.astype(f32), axis=-1, keepdims=True) * vh
    y = y + bonus.reshape(b, t, RWKV_WIDTH)
    return (y * g).astype(cols.dtype)


def _s5_mixer(u, a_re, a_im, b_re, b_im, c_re, c_im, d_skip, log_dt, glu_w, glu_b):
    bsz, t, _ = u.shape
    f32 = jnp.float32
    uf = u.astype(f32)
    ug = uf.reshape(bsz, t, S5_GROUPS, S5_GROUP)
    a = lax.complex(a_re.astype(f32), a_im.astype(f32))
    dt = jnp.exp(log_dt.astype(f32))[:, None]
    a_bar = jnp.exp(a * dt)
    b_bar = ((a_bar - 1.0) / a)[..., None] * lax.complex(b_re.astype(f32), b_im.astype(f32))
    bu = lax.complex(jnp.einsum("btgj,gpj->btgp", ug, jnp.real(b_bar)),
                     jnp.einsum("btgj,gpj->btgp", ug, jnp.imag(b_bar)))

    def combine(e1, e2):
        a1, b1 = e1
        a2, b2 = e2
        return a1 * a2, a2 * b1 + b2

    a_seq = jnp.broadcast_to(a_bar, (1, t, S5_GROUPS, S5_STATE))
    _, states = lax.associative_scan(combine, (a_seq, bu), axis=1)
    y = (jnp.einsum("btgp,gjp->btgj", jnp.real(states), c_re.astype(f32))
         - jnp.einsum("btgp,gjp->btgj", jnp.imag(states), c_im.astype(f32)))
    y = y.reshape(bsz, t, S5_WIDTH) + d_skip.astype(f32) * uf
    y = jax.nn.gelu(y)
    y = y * jax.nn.sigmoid(y @ glu_w.astype(f32) + glu_b.astype(f32))
    return y.astype(u.dtype)


def _swiglu(h, w1, w3, w2):
    return (jax.nn.silu(h @ w1) * (h @ w3)) @ w2


def setup_inputs(seed: int = 0) -> dict:
    key = jax.random.key(seed)
    ks = iter(jax.random.split(key, 40))
    f32 = jnp.float32
    L = DEPTH

    def nrm(shape, scale):
        return jax.random.normal(next(ks), shape, f32) * scale

    def uni(shape, lo, hi):
        return jax.random.uniform(next(ks), shape, f32, lo, hi)

    x = nrm((BATCH, SEQ, D_MODEL), 1.0)
    rel_bias = nrm((REL_BUCKETS, DSA_HEADS), 0.5)
    norm_mix_g = 1.0 + nrm((L, D_MODEL), 0.02)
    w_in = nrm((L, D_MODEL, IN_COLS), D_MODEL ** -0.5)
    ssd_conv_w = nrm((L, SSD_CONV, SSD_XBC), SSD_CONV ** -0.5)
    ssd_conv_b = nrm((L, SSD_XBC), 0.02)
    dt0 = jnp.exp(uni((L, SSD_HEADS), math.log(1e-3), math.log(1e-1)))
    ssd_dt_bias = dt0 + jnp.log(-jnp.expm1(-dt0))
    ssd_a_log = jnp.log(uni((L, SSD_HEADS), 1.0, 16.0))
    ssd_d = 1.0 + nrm((L, SSD_HEADS), 0.1)
    ssd_norm_g = 1.0 + nrm((L, SSD_INNER), 0.02)
    rwkv_mu = uni((L, RWKV_COLS), 0.0, 1.0)
    rwkv_w0 = uni((L, RWKV_WIDTH), -6.0, -1.0)
    rwkv_w2 = nrm((L, RWKV_DECAY_LORA, RWKV_WIDTH), 0.1)
    rwkv_a0 = nrm((L, RWKV_WIDTH), 0.1)
    rwkv_a2 = nrm((L, RWKV_ICLR_LORA, RWKV_WIDTH), 0.1)
    rwkv_g2 = nrm((L, RWKV_GATE_LORA, RWKV_WIDTH), RWKV_GATE_LORA ** -0.5)
    rwkv_k_k = 0.85 + nrm((L, RWKV_WIDTH), 0.05)
    rwkv_k_a = 1.0 + nrm((L, RWKV_WIDTH), 0.05)
    rwkv_r_k = nrm((L, RWKV_HEADS, RWKV_HEAD_DIM), 0.1)
    rwkv_ln_g = 1.0 + nrm((L, RWKV_WIDTH), 0.02)
    rwkv_ln_b = nrm((L, RWKV_WIDTH), 0.02)
    s5_a_re = -0.5 + nrm((L, S5_GROUPS, S5_STATE), 0.01)
    s5_a_im = jnp.pi * jnp.arange(S5_STATE, dtype=f32) + nrm((L, S5_GROUPS, S5_STATE), 0.01)
    s5_b_re = nrm((L, S5_GROUPS, S5_STATE, S5_GROUP), (2 * S5_GROUP) ** -0.5)
    s5_b_im = nrm((L, S5_GROUPS, S5_STATE, S5_GROUP), (2 * S5_GROUP) ** -0.5)
    s5_c_re = nrm((L, S5_GROUPS, S5_GROUP, S5_STATE), 0.25)
    s5_c_im = nrm((L, S5_GROUPS, S5_GROUP, S5_STATE), 0.25)
    s5_d = nrm((L, S5_WIDTH), 1.0)
    s5_log_dt = uni((L, S5_GROUPS), math.log(1e-3), math.log(1e-1))
    s5_glu_w = nrm((L, S5_WIDTH, S5_WIDTH), S5_WIDTH ** -0.5)
    s5_glu_b = nrm((L, S5_WIDTH), 0.02)
    w_branch = nrm((L, N_BRANCH, BRANCH_WIDTH, D_MODEL), BRANCH_WIDTH ** -0.5)
    w_out = nrm((L, D_MODEL, D_MODEL), D_MODEL ** -0.5)
    norm_ffn_g = 1.0 + nrm((L, D_MODEL), 0.02)
    ffn_w1 = nrm((L, D_MODEL, FFN_HIDDEN), D_MODEL ** -0.5)
    ffn_w3 = nrm((L, D_MODEL, FFN_HIDDEN), D_MODEL ** -0.5)
    ffn_w2 = nrm((L, FFN_HIDDEN, D_MODEL), FFN_HIDDEN ** -0.5)
    norm_final_g = 1.0 + nrm((D_MODEL,), 0.02)
    return {
        "x": x, "rel_bias": rel_bias, "norm_mix_g": norm_mix_g, "w_in": w_in,
        "ssd_conv_w": ssd_conv_w, "ssd_conv_b": ssd_conv_b, "ssd_dt_bias": ssd_dt_bias,
        "ssd_a_log": ssd_a_log, "ssd_d": ssd_d, "ssd_norm_g": ssd_norm_g,
        "rwkv_mu": rwkv_mu, "rwkv_w0": rwkv_w0, "rwkv_w2": rwkv_w2, "rwkv_a0": rwkv_a0,
        "rwkv_a2": rwkv_a2, "rwkv_g2": rwkv_g2, "rwkv_k_k": rwkv_k_k, "rwkv_k_a": rwkv_k_a,
        "rwkv_r_k": rwkv_r_k, "rwkv_ln_g": rwkv_ln_g, "rwkv_ln_b": rwkv_ln_b,
        "s5_a_re": s5_a_re, "s5_a_im": s5_a_im, "s5_b_re": s5_b_re, "s5_b_im": s5_b_im,
        "s5_c_re": s5_c_re, "s5_c_im": s5_c_im, "s5_d": s5_d, "s5_log_dt": s5_log_dt,
        "s5_glu_w": s5_glu_w, "s5_glu_b": s5_glu_b, "w_branch": w_branch, "w_out": w_out,
        "norm_ffn_g": norm_ffn_g, "ffn_w1": ffn_w1, "ffn_w3": ffn_w3, "ffn_w2": ffn_w2,
        "norm_final_g": norm_final_g,
    }


def reference(x, rel_bias, norm_mix_g, w_in, ssd_conv_w, ssd_conv_b, ssd_dt_bias, ssd_a_log, ssd_d,
              ssd_norm_g, rwkv_mu, rwkv_w0, rwkv_w2, rwkv_a0, rwkv_a2, rwkv_g2, rwkv_k_k, rwkv_k_a,
              rwkv_r_k, rwkv_ln_g, rwkv_ln_b, s5_a_re, s5_a_im, s5_b_re, s5_b_im, s5_c_re, s5_c_im,
              s5_d, s5_log_dt, s5_glu_w, s5_glu_b, w_branch, w_out, norm_ffn_g, ffn_w1, ffn_w3,
              ffn_w2, norm_final_g):
    b, t, _ = x.shape
    f32 = jnp.float32
    for i in range(DEPTH):
        h = _rmsnorm(x, norm_mix_g[i])
        proj = h @ w_in[i]
        (z, xbc, dt_raw, q, k, v, qi, ki, wi, rwkv_cols, s5_u, gate_cols) = _split_last(proj, IN_SPLITS)
        y_a = _ssd_mixer(z, xbc, dt_raw, ssd_conv_w[i], ssd_conv_b[i], ssd_dt_bias[i],
                         ssd_a_log[i], ssd_d[i], ssd_norm_g[i])
        y_b = _dsa_mixer(q.reshape(b, t, DSA_HEADS, DSA_HEAD_DIM), k.reshape(b, t, DSA_HEADS, DSA_HEAD_DIM),
                         v.reshape(b, t, DSA_HEADS, DSA_HEAD_DIM), qi.reshape(b, t, IDX_HEADS, IDX_DIM),
                         ki, wi, rel_bias).astype(x.dtype)
        y_c = _rwkv7_mixer(rwkv_cols, rwkv_mu[i], rwkv_w0[i], rwkv_w2[i], rwkv_a0[i], rwkv_a2[i],
                           rwkv_g2[i], rwkv_k_k[i], rwkv_k_a[i], rwkv_r_k[i], rwkv_ln_g[i], rwkv_ln_b[i])
        y_d = _s5_mixer(s5_u, s5_a_re[i], s5_a_im[i], s5_b_re[i], s5_b_im[i], s5_c_re[i], s5_c_im[i],
                        s5_d[i], s5_log_dt[i], s5_glu_w[i], s5_glu_b[i])
        merged = jnp.zeros((b, t, D_MODEL), f32)
        for n, y_n in enumerate((y_a, y_b, y_c, y_d)):
            gate = jax.nn.sigmoid(gate_cols[..., n * D_MODEL:(n + 1) * D_MODEL].astype(f32))
            merged = merged + gate * (y_n @ w_branch[i, n]).astype(f32)
        x = x + (merged.astype(x.dtype) @ w_out[i]).astype(x.dtype)
        h = _rmsnorm(x, norm_ffn_g[i])
        x = x + _swiglu(h, ffn_w1[i], ffn_w3[i], ffn_w2[i]).astype(x.dtype)
    return _rmsnorm(x, norm_final_g)
```

```cpp
#ifdef HOST_EMU
#error "HOST_EMU is a host-only debug build"
#else
#include <hip/hip_runtime.h>
#endif
#include <cstdio>
#include <cstdint>
#include <cmath>

#ifndef CFG_BATCH
#define CFG_BATCH 16
#endif
#ifndef CFG_SEQ
#define CFG_SEQ 4096
#endif
#ifndef CFG_DEPTH
#define CFG_DEPTH 4
#endif
#ifndef CFG_NB
#define CFG_NB 4
#endif
#ifndef CFG_LAUNCHES
#define CFG_LAUNCHES 0
#endif

typedef unsigned short bf16;
typedef float f32x4 __attribute__((ext_vector_type(4)));
typedef float f32x2 __attribute__((ext_vector_type(2)));
typedef unsigned u32x4 __attribute__((ext_vector_type(4)));
typedef unsigned u32x2 __attribute__((ext_vector_type(2)));

constexpr int BATCH = CFG_BATCH, SEQ = CFG_SEQ, DEPTH = CFG_DEPTH, NB = CFG_NB;
constexpr int D = 1024, M = BATCH * SEQ, MG = NB * SEQ, NGRP = BATCH / NB;
constexpr int IN_COLS = 9388, NPROJ = 9472, FFN = 2816;
constexpr int TOPK = (SEQ / 4) < 256 ? (SEQ / 4) : 256;
constexpr int NK64 = SEQ / 64, MW = SEQ / 32;
constexpr float RMS_EPS = 1e-6f, GN_EPS = 64e-5f;
static_assert(BATCH % NB == 0 && MG % 256 == 0 && SEQ % 64 == 0, "shape");

enum { I_X = 0, I_RELB, I_NMIX, I_WIN, I_CONVW, I_CONVB, I_DTB, I_ALOG, I_SSDD, I_SSDNG, I_MU, I_W0, I_W2, I_A0, I_A2, I_G2, I_KK, I_KA, I_RK, I_LNG, I_LNB,
       I_S5ARE, I_S5AIM, I_S5BRE, I_S5BIM, I_S5CRE, I_S5CIM, I_S5D, I_S5LDT, I_GLUW, I_GLUB, I_WBR, I_WOUT, I_NFFN, I_W1, I_W3, I_W2F, I_NFIN, N_IN };

constexpr size_t MiB = 1u << 20;
constexpr size_t al256(size_t x) { return (x + 255) & ~(size_t)255; }
constexpr size_t WS_CTL = 0, CTL_BYTES = 64 * 1024;
constexpr size_t WS_TAB = WS_CTL + CTL_BYTES;
constexpr size_t WS_ABAR = al256(WS_TAB + (SEQ + 64) * 4);
constexpr size_t WS_BBAR = WS_ABAR + 32 * 64 * 2 * 4;
constexpr size_t WS_WIN = al256(WS_BBAR + 32 * 64 * 16 * 2 * 4);
constexpr size_t WS_WB = WS_WIN + (size_t)NPROJ * 1024 * 2;
constexpr size_t WS_WOUT = WS_WB + (size_t)4 * 1024 * 512 * 2;
constexpr size_t WS_W13 = WS_WOUT + (size_t)1024 * 1024 * 2;
constexpr size_t WS_W2 = WS_W13 + (size_t)5632 * 1024 * 2;
constexpr size_t WS_GLU = WS_W2 + (size_t)1024 * 2816 * 2;
constexpr size_t WS_H = al256(WS_GLU + (size_t)512 * 512 * 2);
constexpr size_t WS_Z = WS_H + (size_t)MG * 1024 * 2;
constexpr size_t WS_XBC = WS_Z + (size_t)MG * 512 * 2;
constexpr size_t WS_Q = WS_XBC + (size_t)MG * 768 * 2;
constexpr size_t WS_K = WS_Q + (size_t)MG * 512 * 2;
constexpr size_t WS_V = WS_K + (size_t)MG * 512 * 2;
constexpr size_t WS_RW = WS_V + (size_t)MG * 512 * 2;
constexpr size_t WS_U = WS_RW + (size_t)MG * 1792 * 2;
constexpr size_t WS_SM = WS_U + (size_t)MG * 512 * 2;
constexpr size_t WS_G = WS_SM + (size_t)MG * 256 * 2;
constexpr size_t WS_Y = WS_G + (size_t)MG * 4096 * 2;
constexpr size_t WS_YD0 = WS_Y + (size_t)4 * MG * 512 * 2;
constexpr size_t WS_MRG = WS_YD0 + (size_t)MG * 512 * 2;
constexpr size_t WS_MASK = WS_MRG + (size_t)MG * 1024 * 2;
constexpr size_t WS_HID = WS_G;
constexpr size_t WS_END = WS_MASK + (size_t)MG * MW * 4;
static_assert((size_t)MG * 2816 * 2 <= (size_t)MG * 4096 * 2, "HID fits in G");

constexpr int LDS_SCRATCH = 131072;
constexpr int LDS_CTL_OFF = LDS_SCRATCH;
constexpr int LDS_BYTES = 147456;
constexpr int NTHREADS = 512, NWAVES = 8;

__device__ __forceinline__ float bf2f(bf16 v) { return __uint_as_float(((unsigned)v) << 16); }
__device__ __forceinline__ bf16 f2bf(float f) { unsigned u = __float_as_uint(f); u += 0x7fffu + ((u >> 16) & 1u); return (bf16)(u >> 16); }
__device__ __forceinline__ unsigned pk2(float lo, float hi) { return (unsigned)f2bf(lo) | ((unsigned)f2bf(hi) << 16); }
__device__ __forceinline__ float lo_bf(unsigned w) { return __uint_as_float(w << 16); }
__device__ __forceinline__ float hi_bf(unsigned w) { return __uint_as_float(w & 0xffff0000u); }
__device__ __forceinline__ float sigm(float x) { return 1.0f / (1.0f + __expf(-x)); }
__device__ __forceinline__ float softplusf(float x) { return x > 20.f ? x : log1pf(__expf(x)); }
__device__ __forceinline__ float gelu_tanh(float x) { const float u = 0.7978845608f * (x + 0.044715f * x * x * x); return 0.5f * x * (1.0f + tanhf(u)); }
__device__ __forceinline__ float wave_sum(float v) {
#pragma unroll
    for (int o = 1; o < 64; o <<= 1) v += __shfl_xor(v, o);
    return v;
}
__device__ __forceinline__ float wave_max(float v) {
#pragma unroll
    for (int o = 1; o < 64; o <<= 1) v = fmaxf(v, __shfl_xor(v, o));
    return v;
}
__device__ __forceinline__ int wave_sum_i(int v) {
#pragma unroll
    for (int o = 1; o < 64; o <<= 1) v += __shfl_xor(v, o);
    return v;
}
#ifdef HOST_EMU
#define WAVE_SYNC() (void)emu_wave_exchange(0)
#else
#define WAVE_SYNC() __builtin_amdgcn_wave_barrier()
#endif
#ifndef HOST_EMU
namespace pg8 {
__device__ __forceinline__ int pg8_fresh_tid() { int t = (int)threadIdx.x; asm volatile("" : "+v"(t)); return t; }
#define PG8_LAS __attribute__((address_space(3)))
typedef unsigned short bf16_t;
typedef short bf16x8 __attribute__((ext_vector_type(8)));
typedef float f32x4 __attribute__((ext_vector_type(4)));
typedef unsigned u32x4 __attribute__((ext_vector_type(4)));
constexpr int BM = 256, BK = 64, HALF = 128, HTB = HALF * BK * 2  , STAGE_BYTES = 8 * HTB, NXCD = 8, WGM = 8;

__host__ __device__ __forceinline__ int lds_byte(int r, int c) { const int st = (r >> 4) * 2 + (c >> 5), rr = r & 15, cc = c & 31, ob = rr * 64 + cc * 2; return st * 1024 + (ob ^ (((ob >> 9) & 1) << 5)); }
__host__ __device__ __forceinline__ void stage_rc(int b, int& R, int& C) { const int st = b / 1024, sb = b % 1024, swz = sb ^ (((sb >> 9) & 1) << 5); R = (st >> 1) * 16 + swz / 64; C = (st & 1) * 32 + (swz % 64) / 2; }
__host__ __device__ __forceinline__ int perm32(int rho) { const int n = rho >> 4, i = rho & 15; return 8 * (i >> 2) + 4 * n + (i & 3); }

struct Unit { int pm, pn; };
struct Gemm { const bf16_t* A; const bf16_t* Bt; int M, N, K; };

struct StaticOrder {
    int nM, nN, nwg, G, c;
    __host__ __device__ void init(int M, int N, int G_, int c_) { nM = M / BM; nN = N / BM; nwg = nM * nN; G = G_; c = c_; }
    __host__ __device__ bool next(int i, Unit& u) const {
        const long L = (long)i * G + c; if (L >= nwg) return false;
        int wgid = (int)L; { const int q = nwg / NXCD, r = nwg % NXCD, xcd = wgid % NXCD, off = wgid / NXCD; wgid = (xcd < r ? xcd * (q + 1) : r * (q + 1) + (xcd - r) * q) + off; }
        const int nig = WGM * nN, gid = wgid / nig, fm = gid * WGM, gsz = (nM - fm) < WGM ? (nM - fm) : WGM;
        u.pm = fm + ((wgid % nig) % gsz); u.pn = (wgid % nig) / gsz; return true;
    }
    __device__ __forceinline__ void a_ready(const Unit&) const {}
    __device__ __forceinline__ void done(const Unit&) const {}
};

__device__ __forceinline__ unsigned cvt_pk_bf16(float lo, float hi) { unsigned r; asm volatile("v_cvt_pk_bf16_f32 %0, %1, %2" : "=v"(r) : "v"(lo), "v"(hi)); return r; }

template <class Epi, class Sched, bool STAMP = false>
__device__ __forceinline__ void gemm_phase(PG8_LAS unsigned char* lds, const Gemm g, const Sched& S, const Epi& E, unsigned long long* stamps) {
    const int tid = pg8_fresh_tid(), wid = __builtin_amdgcn_readfirstlane(tid >> 6), lane = tid & 63, wr = wid >> 2, wc = wid & 3, fr = lane & 15, fq = lane >> 4;
    const int K = g.K, nt = K / BK;
    int ts_lo = 0, ts_hi = 0, nts = 0; const unsigned long long rt_entry = STAMP ? (unsigned long long)wall_clock64() : 0ull;
#define PG8_STAMP() do { if (STAMP && wid == 0 && nts < 64) { const unsigned long long _c = (unsigned long long)clock64(); \
        ts_lo = (lane == nts) ? (int)(unsigned)_c : ts_lo; ts_hi = (lane == nts) ? (int)(unsigned)(_c >> 32) : ts_hi; ++nts; } } while (0)
    PG8_STAMP();
    unsigned voffA[2], voffB[2];
#pragma unroll
    for (int i = 0; i < 2; ++i) { int R, C; stage_rc(tid * 16 + i * 8192, R, C); const int Rb = Epi::PERM ? ((R & ~31) + perm32(R & 31)) : R;
        voffA[i] = (unsigned)(R * K + C) * 2u; voffB[i] = (unsigned)(Rb * K + C) * 2u; }
    const size_t kstep = (size_t)(BK * 2);
    const size_t hstep = (size_t)HALF * K * 2;
    const size_t tstep = 2 * hstep;
    const unsigned ldsw = (unsigned)wid * 1024u;
    const int aoff = lds_byte(wr * 64 + fr, fq * 8), boff = lds_byte(wc * 32 + fr, fq * 8);
#define PG8_SA(b, h) (((b) * 2 + (h)) * HTB)
#define PG8_SB(b, h) ((4 + (b) * 2 + (h)) * HTB)
#define PG8_STAGE(bufoff, gbase, voff) do { _Pragma("unroll") for (int _i = 0; _i < 2; ++_i) \
        __builtin_amdgcn_global_load_lds((const unsigned*)((const char*)(gbase) + (voff)[_i]), (PG8_LAS unsigned*)(lds + (bufoff) + ldsw + _i * 8192), 16, 0, 0); } while (0)
#define PG8_LDA(dst, b, h) do { _Pragma("unroll") for (int m = 0; m < 4; ++m) _Pragma("unroll") for (int k = 0; k < 2; ++k) dst[m][k] = *(const PG8_LAS bf16x8*)(lds + PG8_SA(b, h) + aoff + m * 2048 + k * 1024); } while (0)
#define PG8_LDB(dst, b, h) do { _Pragma("unroll") for (int n = 0; n < 2; ++n) _Pragma("unroll") for (int k = 0; k < 2; ++k) dst[n][k] = *(const PG8_LAS bf16x8*)(lds + PG8_SB(b, h) + boff + n * 2048 + k * 1024); } while (0)
#define PG8_MMA(ai, bj, At, Bt) do { __builtin_amdgcn_s_setprio(1); _Pragma("unroll") for (int m = 0; m < 4; ++m) _Pragma("unroll") for (int n = 0; n < 2; ++n) _Pragma("unroll") for (int k = 0; k < 2; ++k) \
        acc[ai][bj][m][n] = __builtin_amdgcn_mfma_f32_16x16x32_bf16(Bt[n][k], At[m][k], acc[ai][bj][m][n], 0, 0, 0); __builtin_amdgcn_s_setprio(0); } while (0)
#define PG8_WAIT_V(n) asm volatile("s_waitcnt vmcnt(" #n ")" ::: "memory")
#define PG8_WAIT_L(n) asm volatile("s_waitcnt lgkmcnt(" #n ")" ::: "memory")
#define PG8_BAR __builtin_amdgcn_s_barrier()
#define PG8_SCHED __builtin_amdgcn_sched_barrier(0)
    Unit cur, nxt; int ui = 0;
    if (!S.next(0, cur)) return;
    f32x4 acc[2][2][4][2];
#pragma unroll
    for (int a = 0; a < 2; ++a)
#pragma unroll
        for (int b = 0; b < 2; ++b)
#pragma unroll
            for (int m = 0; m < 4; ++m)
#pragma unroll
                for (int n = 0; n < 2; ++n) acc[a][b][m][n] = (f32x4){0.f, 0.f, 0.f, 0.f};
    bf16x8 At[4][2], B0[2][2], B1[2][2];
    const char* cA = (const char*)g.A + (size_t)cur.pm * tstep; const char* cB = (const char*)g.Bt + (size_t)cur.pn * tstep;
    S.a_ready(cur);
    PG8_STAGE(PG8_SB(0, 0), cB, voffB); PG8_STAGE(PG8_SA(0, 0), cA, voffA); PG8_STAGE(PG8_SB(0, 1), cB + hstep, voffB); PG8_STAGE(PG8_SA(0, 1), cA + hstep, voffA);
    if (wr == 1) PG8_BAR;
    PG8_WAIT_V(4); PG8_BAR;
    PG8_STAGE(PG8_SB(1, 0), cB + kstep, voffB); PG8_STAGE(PG8_SA(1, 0), cA + kstep, voffA); PG8_STAGE(PG8_SB(1, 1), cB + hstep + kstep, voffB);
    PG8_WAIT_V(6); PG8_BAR;
    PG8_STAMP();
    for (;;) {
        const bool has_next = S.next(ui + 1, nxt);
        const char* nA = has_next ? (const char*)g.A + (size_t)nxt.pm * tstep : cA; const char* nB = has_next ? (const char*)g.Bt + (size_t)nxt.pn * tstep : cB;
        for (int t = 0; t < nt; t += 2) {
            const bool last = (t == nt - 2);
            const char* a1 = cA + (size_t)(t + 1) * kstep;
            const char* a2 = last ? nA : cA + (size_t)(t + 2) * kstep; const char* b2 = last ? nB : cB + (size_t)(t + 2) * kstep;
            const char* a3 = a2 + kstep; const char* b3 = b2 + kstep;
            if (last && has_next) S.a_ready(nxt);
            PG8_LDB(B0, 0, 0); PG8_SCHED; PG8_LDA(At, 0, 0); PG8_STAGE(PG8_SA(1, 1), a1 + hstep, voffA);
            PG8_WAIT_L(8); PG8_BAR; PG8_WAIT_L(0); PG8_MMA(0, 0, At, B0); PG8_BAR; PG8_SCHED;
            PG8_LDB(B1, 0, 1); PG8_STAGE(PG8_SB(0, 0), b2, voffB);
            PG8_BAR; PG8_WAIT_L(0); PG8_MMA(0, 1, At, B1); PG8_BAR;
            PG8_LDA(At, 0, 1); PG8_STAGE(PG8_SA(0, 0), a2, voffA);
            PG8_BAR; PG8_WAIT_L(0); PG8_MMA(1, 0, At, B0); PG8_BAR; PG8_SCHED;
            PG8_STAGE(PG8_SB(0, 1), b2 + hstep, voffB);
            PG8_WAIT_V(6); PG8_BAR; PG8_MMA(1, 1, At, B1); PG8_BAR;
            PG8_LDB(B0, 1, 0); PG8_SCHED; PG8_LDA(At, 1, 0); PG8_STAGE(PG8_SA(0, 1), a2 + hstep, voffA);
            PG8_WAIT_L(8); PG8_BAR; PG8_WAIT_L(0); PG8_MMA(0, 0, At, B0); PG8_BAR; PG8_SCHED;
            PG8_LDB(B1, 1, 1); PG8_STAGE(PG8_SB(1, 0), b3, voffB);
            PG8_BAR; PG8_WAIT_L(0); PG8_MMA(0, 1, At, B1); PG8_BAR;
            PG8_LDA(At, 1, 1); PG8_STAGE(PG8_SA(1, 0), a3, voffA);
            PG8_BAR; PG8_WAIT_L(0); PG8_MMA(1, 0, At, B0); PG8_BAR; PG8_SCHED;
            PG8_STAGE(PG8_SB(1, 1), b3 + hstep, voffB);
            PG8_WAIT_V(6); PG8_BAR; PG8_MMA(1, 1, At, B1); PG8_BAR;
        }
        PG8_STAMP();
        if constexpr (!Epi::AFTER_DRAIN) { E(acc, cur, wr, wc, fr, fq); S.done(cur); }
        PG8_STAMP();
        if (!has_next) break;
#pragma unroll
        for (int a = 0; a < 2; ++a)
#pragma unroll
            for (int b = 0; b < 2; ++b)
#pragma unroll
                for (int m = 0; m < 4; ++m)
#pragma unroll
                    for (int n = 0; n < 2; ++n) acc[a][b][m][n] = (f32x4){0.f, 0.f, 0.f, 0.f};
        cur = nxt; cA = nA; cB = nB; ++ui;
    }
    PG8_WAIT_V(0);
    if (wr == 0) PG8_BAR;
    PG8_BAR;
    if constexpr (Epi::AFTER_DRAIN) { E.fused(acc, cur, wr, wc, fr, fq, lds, wid, lane); S.done(cur); }
    PG8_STAMP();
    if (STAMP && wid == 0) { stamps[lane] = lane < nts ? (((unsigned long long)(unsigned)ts_hi << 32) | (unsigned)ts_lo) : 0ull;
        if (lane == 62) stamps[62] = rt_entry; if (lane == 63) stamps[63] = (unsigned long long)wall_clock64(); }
#undef PG8_STAMP
#undef PG8_SA
#undef PG8_SB
#undef PG8_STAGE
#undef PG8_LDA
#undef PG8_LDB
#undef PG8_MMA
#undef PG8_WAIT_V
#undef PG8_WAIT_L
#undef PG8_BAR
#undef PG8_SCHED
}
}

#define XB_TMO      128
#define XB_XCNT(j)  (256  + 64 * (j))
#define XB_XSUB(j)  (1280 + 64 * (j))
#define XB_XGEN(j)  (2304 + 64 * (j))
#define XB_TOP      3328
#define XB_TOPGEN   3392
#define XCD_BAR_WORDS 3456
#define XB_SPIN_CAP (1u << 18)
#define LAS __attribute__((address_space(3)))

__device__ __forceinline__ unsigned xb_ld(unsigned* p)              { return __hip_atomic_load(p, __ATOMIC_RELAXED, __HIP_MEMORY_SCOPE_AGENT); }
__device__ __forceinline__ unsigned xb_add(unsigned* p, unsigned v) { return __hip_atomic_fetch_add(p, v, __ATOMIC_RELAXED, __HIP_MEMORY_SCOPE_AGENT); }
__device__ __forceinline__ unsigned xb_xcc_id() { return (unsigned)__builtin_amdgcn_s_getreg((3 << 11) | 20) & 0xFu; }
#define XB_SPIN(cond, bar) do { unsigned _sp = 0; while (cond) { __builtin_amdgcn_s_sleep(1); \
    if ((++_sp & 255u) == 0u) { if (xb_ld(&(bar)[XB_TMO])) break; if (_sp > XB_SPIN_CAP) { atomicAdd(&(bar)[XB_TMO], 1u); break; } } } } while (0)

struct XcdBarrier {
    unsigned* bar; unsigned x;
    volatile LAS unsigned* st;
};

__device__ __forceinline__ XcdBarrier xcd_barrier_post(unsigned* bar, volatile LAS unsigned* st) {
    XcdBarrier b; b.bar = bar; b.x = xb_xcc_id(); b.st = st;
    if (threadIdx.x == 0) (void)xb_add(&bar[XB_XCNT(b.x)], 1u);
    return b;
}
__device__ __forceinline__ void xcd_barrier_complete(unsigned* bar, unsigned x, unsigned& nloc, unsigned& nx) {
    const unsigned G = gridDim.x * gridDim.y * gridDim.z;
    unsigned sum, cnt, mine, sp = 0u;
    for (;;) {
        sum = 0u; cnt = 0u; mine = 0u;
#pragma unroll
        for (unsigned j = 0; j < 16; ++j) { const unsigned c = xb_ld(&bar[XB_XCNT(j)]); sum += c; cnt += (c > 0u) ? 1u : 0u; mine = (j == x) ? c : mine; }
        if (sum == G) break;
        __builtin_amdgcn_s_sleep(1);
        if ((++sp & 255u) == 0u) { if (xb_ld(&bar[XB_TMO])) break; if (sp > XB_SPIN_CAP) { atomicAdd(&bar[XB_TMO], 1u); break; } }
    }
    nloc = mine > 0u ? mine : 1u; nx = cnt > 0u ? cnt : 1u;
}

__device__ __forceinline__ void xcd_barrier(const XcdBarrier& b) {
    asm volatile("s_waitcnt vmcnt(0)" ::: "memory");
    __syncthreads();
    if (threadIdx.x == 0) {
        unsigned* bar = b.bar;
        __builtin_amdgcn_s_waitcnt(0);
        unsigned nloc = b.st[0], nx = b.st[1];
        if (nloc == 0u) { xcd_barrier_complete(bar, b.x, nloc, nx); b.st[0] = nloc; b.st[1] = nx; }
        const unsigned old = xb_add(&bar[XB_XSUB(b.x)], 1u);
        const unsigned gen = old / nloc;
        if (old + 1u == (gen + 1u) * nloc) {
            __builtin_amdgcn_fence(__ATOMIC_RELEASE, "agent");
            asm volatile("s_waitcnt vmcnt(0)" ::: "memory");
            const unsigned og = xb_add(&bar[XB_TOP], 1u);
            const unsigned tg = og / nx;
            if (og + 1u == (tg + 1u) * nx) xb_add(&bar[XB_TOPGEN], 1u);
            else XB_SPIN(xb_ld(&bar[XB_TOPGEN]) == tg, bar);
            __builtin_amdgcn_fence(__ATOMIC_ACQUIRE, "agent");
            xb_add(&bar[XB_XGEN(b.x)], 1u);
            asm volatile("s_waitcnt vmcnt(0)" ::: "memory");
        } else {
            XB_SPIN(xb_ld(&bar[XB_XGEN(b.x)]) == gen, bar);
            __builtin_amdgcn_fence(__ATOMIC_ACQUIRE, "agent");
            asm volatile("s_waitcnt vmcnt(0)" ::: "memory");
        }
    }
    __syncthreads();
}

#else
namespace pg8 {
typedef unsigned short bf16_t;
typedef float f32x4 __attribute__((ext_vector_type(4)));
typedef unsigned u32x4 __attribute__((ext_vector_type(4)));
constexpr int BM = 256, BK = 64, HALF = 128, NXCD = 8, WGM = 8;
struct Unit { int pm, pn; };
struct Gemm { const bf16_t* A; const bf16_t* Bt; int M, N, K; };
struct StaticOrder {
    int nM, nN, nwg, G, c;
    void init(int M, int N, int G_, int c_) { nM = M / BM; nN = N / BM; nwg = nM * nN; G = G_; c = c_; }
    bool next(int i, Unit& u) const {
        const long L = (long)i * G + c; if (L >= nwg) return false;
        int wgid = (int)L; { const int q = nwg / NXCD, r = nwg % NXCD, xcd = wgid % NXCD, off = wgid / NXCD; wgid = (xcd < r ? xcd * (q + 1) : r * (q + 1) + (xcd - r) * q) + off; }
        const int nig = WGM * nN, gid = wgid / nig, fm = gid * WGM, gsz = (nM - fm) < WGM ? (nM - fm) : WGM;
        u.pm = fm + ((wgid % nig) % gsz); u.pn = (wgid % nig) / gsz; return true;
    }
    void a_ready(const Unit&) const {}
    void done(const Unit&) const {}
};
static inline unsigned cvt_pk_bf16(float lo, float hi) { return pk2(lo, hi); }
static float* emu_tile_buf(int b) { static std::vector<std::vector<float>> t; if ((int)t.size() <= b) t.resize(b + 1); if (t[b].empty()) t[b].resize(256 * 256); return t[b].data(); }
template <class Epi, class Sched, bool STAMP = false>
void gemm_phase(unsigned char* lds, const Gemm g, const Sched& S, const Epi& E, unsigned long long* stamps) {
    const int tid = threadIdx.x, wid = tid >> 6, lane = tid & 63, wr = wid >> 2, wc = wid & 3, fr = lane & 15, fq = lane >> 4;
    float* tile = emu_tile_buf(blockIdx.x);
    Unit u;
    for (int ui = 0; S.next(ui, u); ++ui) {
        __syncthreads();
        if (tid == 0) {
            std::vector<float> a((size_t)256 * g.K), b((size_t)256 * g.K);
            for (int r = 0; r < 256; ++r) for (int k = 0; k < g.K; ++k) { a[(size_t)r * g.K + k] = bf2f(g.A[((size_t)u.pm * 256 + r) * g.K + k]); b[(size_t)r * g.K + k] = bf2f(g.Bt[((size_t)u.pn * 256 + r) * g.K + k]); }
            for (int r = 0; r < 256; ++r) for (int c = 0; c < 256; ++c) { const float* ar = &a[(size_t)r * g.K]; const float* br = &b[(size_t)c * g.K]; float s = 0.f; for (int k = 0; k < g.K; ++k) s += ar[k] * br[k]; tile[r * 256 + c] = s; }
        }
        __syncthreads();
        f32x4 acc[2][2][4][2];
        for (int ai = 0; ai < 2; ++ai) for (int bj = 0; bj < 2; ++bj) for (int m = 0; m < 4; ++m) for (int n = 0; n < 2; ++n) for (int j = 0; j < 4; ++j) {
            const int r = 128 * ai + 64 * wr + 16 * m + fr;
            const int c = Epi::PERM ? (128 * bj + 32 * wc + 8 * fq + 4 * n + j) : (128 * bj + 32 * wc + 16 * n + 4 * fq + j);
            acc[ai][bj][m][n][j] = tile[r * 256 + c];
        }
        E(acc, u, wr, wc, fr, fq); S.done(u);
        __syncthreads();
    }
}
}
#endif
namespace pg8 {
__device__ __forceinline__ u32x4 pack8(const f32x4 v0, const f32x4 v1) { u32x4 w; w.x = cvt_pk_bf16(v0[0], v0[1]); w.y = cvt_pk_bf16(v0[2], v0[3]); w.z = cvt_pk_bf16(v1[0], v1[1]); w.w = cvt_pk_bf16(v1[2], v1[3]); return w; }
__device__ __forceinline__ void unpack8(const u32x4 w, f32x4& v0, f32x4& v1) { v0 = (f32x4){lo_bf(w.x), hi_bf(w.x), lo_bf(w.y), hi_bf(w.y)}; v1 = (f32x4){lo_bf(w.z), hi_bf(w.z), lo_bf(w.w), hi_bf(w.w)}; }
__device__ __forceinline__ f32x4 sig4(const f32x4 v) { return (f32x4){sigm(v[0]), sigm(v[1]), sigm(v[2]), sigm(v[3])}; }

struct EpiProj {
    static constexpr bool PERM = true, AFTER_DRAIN = false;
    unsigned char* ws;
    __device__ __forceinline__ void operator()(const f32x4 (&acc)[2][2][4][2], const Unit& u, int wr, int wc, int fr, int fq) const {
        const int pn = u.pn; size_t off; int ld, c0; bool sg = false;
        if (pn < 2) { off = WS_Z; ld = 512; c0 = pn * 256; }
        else if (pn < 5) { off = WS_XBC; ld = 768; c0 = (pn - 2) * 256; }
        else if (pn < 7) { off = WS_Q; ld = 512; c0 = (pn - 5) * 256; }
        else if (pn < 9) { off = WS_K; ld = 512; c0 = (pn - 7) * 256; }
        else if (pn < 11) { off = WS_V; ld = 512; c0 = (pn - 9) * 256; }
        else if (pn < 18) { off = WS_RW; ld = 1792; c0 = (pn - 11) * 256; }
        else if (pn < 20) { off = WS_U; ld = 512; c0 = (pn - 18) * 256; }
        else if (pn < 21) { off = WS_SM; ld = 256; c0 = 0; }
        else { off = WS_G; ld = 4096; c0 = (pn - 21) * 256; sg = true; }
        bf16_t* dst = (bf16_t*)(ws + off);
        const int row0 = u.pm * BM + wr * 64 + fr, col0 = c0 + wc * 32 + 8 * fq;
#pragma unroll
        for (int ai = 0; ai < 2; ++ai)
#pragma unroll
            for (int m = 0; m < 4; ++m) { bf16_t* rowp = dst + (size_t)(row0 + ai * HALF + m * 16) * ld + col0;
#pragma unroll
                for (int bj = 0; bj < 2; ++bj) { f32x4 v0 = acc[ai][bj][m][0], v1 = acc[ai][bj][m][1]; if (sg) { v0 = sig4(v0); v1 = sig4(v1); } *(u32x4*)(rowp + bj * HALF) = pack8(v0, v1); } }
    }
};
struct EpiMerge {
    static constexpr bool PERM = true, AFTER_DRAIN = false;
    const bf16_t* G; bf16_t* MRG;
    __device__ __forceinline__ void operator()(const f32x4 (&acc)[2][2][4][2], const Unit& u, int wr, int wc, int fr, int fq) const {
        const int n = u.pn >> 2, pn = u.pn & 3, pm = u.pm - n * (MG / 256);
        const int row0 = pm * BM + wr * 64 + fr, col0 = pn * BM + wc * 32 + 8 * fq;
#pragma unroll
        for (int ai = 0; ai < 2; ++ai)
#pragma unroll
            for (int m = 0; m < 4; ++m) { const size_t row = (size_t)(row0 + ai * HALF + m * 16);
#pragma unroll
                for (int bj = 0; bj < 2; ++bj) { const int col = col0 + bj * HALF;
                    f32x4 g0, g1; unpack8(*(const u32x4*)(G + row * 4096 + n * 1024 + col), g0, g1);
                    f32x4 v0 = acc[ai][bj][m][0] * g0, v1 = acc[ai][bj][m][1] * g1;
                    bf16_t* o = MRG + row * 1024 + col;
                    if (n > 0) { f32x4 p0, p1; unpack8(*(const u32x4*)o, p0, p1); v0 += p0; v1 += p1; }
                    *(u32x4*)o = pack8(v0, v1); } }
    }
};
struct MergeOrder {
    int G, c;
    __device__ __forceinline__ bool next(int i, Unit& u) const {
        const int tile = (i >> 2) * G + c, n = i & 3; if (tile >= (MG / 256) * 4) return false;
        u.pm = n * (MG / 256) + (tile >> 2); u.pn = n * 4 + (tile & 3); return true;
    }
    __device__ __forceinline__ void a_ready(const Unit&) const {}
    __device__ __forceinline__ void done(const Unit&) const {}
};
struct EpiResid {
    static constexpr bool PERM = false, AFTER_DRAIN = false;
    const float* base; float* out;
    __device__ __forceinline__ void operator()(const f32x4 (&acc)[2][2][4][2], const Unit& u, int wr, int wc, int fr, int fq) const {
        const int row0 = u.pm * BM + wr * 64 + fr, col0 = u.pn * BM + wc * 32 + 4 * fq;
#pragma unroll
        for (int ai = 0; ai < 2; ++ai)
#pragma unroll
            for (int m = 0; m < 4; ++m) { const size_t off = (size_t)(row0 + ai * HALF + m * 16) * 1024 + col0;
#pragma unroll
                for (int bj = 0; bj < 2; ++bj)
#pragma unroll
                    for (int n = 0; n < 2; ++n) *(f32x4*)(out + off + bj * HALF + n * 16) = *(const f32x4*)(base + off + bj * HALF + n * 16) + acc[ai][bj][m][n]; }
    }
};
struct EpiSwiglu {
    static constexpr bool PERM = true, AFTER_DRAIN = false;
    bf16_t* HID;
    __device__ __forceinline__ void operator()(const f32x4 (&acc)[2][2][4][2], const Unit& u, int wr, int wc, int fr, int fq) const {
        const int row0 = u.pm * BM + wr * 64 + fr, col0 = u.pn * HALF + wc * 32 + 8 * fq;
#pragma unroll
        for (int ai = 0; ai < 2; ++ai)
#pragma unroll
            for (int m = 0; m < 4; ++m) { f32x4 v[2];
#pragma unroll
                for (int n = 0; n < 2; ++n) { const f32x4 a = acc[ai][0][m][n], b = acc[ai][1][m][n]; v[n] = a * sig4(a) * b; }
                *(u32x4*)(HID + (size_t)(row0 + ai * HALF + m * 16) * FFN + col0) = pack8(v[0], v[1]); }
    }
};
struct EpiGlu {
    static constexpr bool PERM = true, AFTER_DRAIN = false;
    const bf16_t* Y0; bf16_t* OUT; const float* bias;
    __device__ __forceinline__ void operator()(const f32x4 (&acc)[2][2][4][2], const Unit& u, int wr, int wc, int fr, int fq) const {
        const int row0 = u.pm * BM + wr * 64 + fr, col0 = u.pn * BM + wc * 32 + 8 * fq;
#pragma unroll
        for (int ai = 0; ai < 2; ++ai)
#pragma unroll
            for (int m = 0; m < 4; ++m) { const size_t row = (size_t)(row0 + ai * HALF + m * 16);
#pragma unroll
                for (int bj = 0; bj < 2; ++bj) { const int col = col0 + bj * HALF;
                    f32x4 y0, y1; unpack8(*(const u32x4*)(Y0 + row * 512 + col), y0, y1);
                    const f32x4 b0 = *(const f32x4*)(bias + col), b1 = *(const f32x4*)(bias + col + 4);
                    *(u32x4*)(OUT + row * 512 + col) = pack8(y0 * sig4(acc[ai][bj][m][0] + b0), y1 * sig4(acc[ai][bj][m][1] + b1)); } }
    }
};
}
struct Args { const float* in[N_IN]; float* out; unsigned char* ws; int seg_lo, seg_hi; };
#ifdef HOST_EMU
typedef const Args* KArgs;
#define KLAUNDER(p) (p)
__device__ __forceinline__ int fresh_tid() { return (int)threadIdx.x; }
#else
typedef const __attribute__((address_space(4))) Args* KArgs;
__device__ __forceinline__ KArgs klaunder(KArgs p) { asm volatile("" : "+s"(p)); return p; }
#define KLAUNDER(p) klaunder(p)
__device__ __forceinline__ int fresh_tid() { int t = (int)threadIdx.x; asm volatile("" : "+v"(t)); return t; }
#endif
#define WSP(T, off) ((T*)(C->ws + (off)))

template <class Src>
__device__ __forceinline__ void transpose_item(const Src& S, int K, bf16* WT, float* scr, int item, int lane) {
    const int nblk = S.ndst / 32, kb = item / nblk, nb = item % nblk, k0 = 64 * kb, n0 = 32 * nb;
    const float* cp = S.col(n0 + (lane & 31)); const int ld = S.ld;
#pragma unroll 8
    for (int i = 0; i < 32; ++i) { const int kk = 2 * i + (lane >> 5); scr[kk * 33 + (lane & 31)] = cp ? cp[(size_t)(k0 + kk) * ld] : 0.f; }
    WAVE_SYNC();
    const int c = lane & 7;
#pragma unroll
    for (int j = 0; j < 4; ++j) { const int n = (lane >> 3) + 8 * j; const float* s = scr + (8 * c) * 33 + n;
        u32x4 o; o.x = pk2(s[0 * 33], s[1 * 33]); o.y = pk2(s[2 * 33], s[3 * 33]); o.z = pk2(s[4 * 33], s[5 * 33]); o.w = pk2(s[6 * 33], s[7 * 33]);
        *(u32x4*)(WT + (size_t)(n0 + n) * K + k0 + 8 * c) = o; }
    WAVE_SYNC();
}
struct SrcWin { const float* w; int ndst, ld;
    __device__ __forceinline__ const float* col(int n) const {
        int s;
        if (n < 1280) s = n;
        else if (n < 2816) s = n + 8;
        else if (n < 4608) s = n - 2816 + 2988;
        else if (n < 5120) s = n - 4608 + 4780;
        else if (n < 5128) s = n - 5120 + 1280;
        else if (n < 5256) s = n - 5128 + 2824;
        else if (n < 5288) s = n - 5256 + 2952;
        else if (n < 5292) s = n - 5288 + 2984;
        else if (n < 5376) return nullptr;
        else s = n - 5376 + 5292;
        return w + s; } };
struct SrcPlain { const float* w; int ndst, ld; __device__ __forceinline__ const float* col(int n) const { return w + n; } };
struct SrcW13 { const float* w1; const float* w3; int ndst, ld;
    __device__ __forceinline__ const float* col(int n) const { const int pn = n >> 8, r = n & 255; return w1 + (r < 128 ? (ptrdiff_t)0 : (w3 - w1)) + pn * 128 + (r & 127); } };

__device__ __forceinline__ void phase_weights(KArgs C, int layer, unsigned char* lds, int gw, int ngw, int lane, int wave) {
    float* scr = (float*)(lds + wave * 16384);
    constexpr int N_IN_ = 16 * (NPROJ / 32), N_BR = 8 * 32, N_OUT = 16 * 32, N_13 = 16 * (5632 / 32), N_2 = 44 * 32, N_GLU = 8 * 16;
    { const SrcWin s_in{C->in[I_WIN] + (size_t)layer * 1024 * IN_COLS, NPROJ, IN_COLS};
      for (int it = gw; it < N_IN_; it += ngw) transpose_item(s_in, 1024, WSP(bf16, WS_WIN), scr, it, lane); }
    for (int it = gw; it < 4 * N_BR; it += ngw) { const int n = it / N_BR; const SrcPlain s_b{C->in[I_WBR] + ((size_t)layer * 4 + n) * 512 * 1024, 1024, 1024};
        transpose_item(s_b, 512, WSP(bf16, WS_WB) + (size_t)n * 1024 * 512, scr, it % N_BR, lane); }
    { const SrcPlain s_out{C->in[I_WOUT] + (size_t)layer * 1024 * 1024, 1024, 1024};
      for (int it = gw; it < N_OUT; it += ngw) transpose_item(s_out, 1024, WSP(bf16, WS_WOUT), scr, it, lane); }
    { const SrcW13 s_13{C->in[I_W1] + (size_t)layer * 1024 * FFN, C->in[I_W3] + (size_t)layer * 1024 * FFN, 5632, FFN};
      for (int it = gw; it < N_13; it += ngw) transpose_item(s_13, 1024, WSP(bf16, WS_W13), scr, it, lane); }
    { const SrcPlain s_2{C->in[I_W2F] + (size_t)layer * FFN * 1024, 1024, 1024};
      for (int it = gw; it < N_2; it += ngw) transpose_item(s_2, FFN, WSP(bf16, WS_W2), scr, it, lane); }
    { const SrcPlain s_glu{C->in[I_GLUW] + (size_t)layer * 512 * 512, 512, 512};
      for (int it = gw; it < N_GLU; it += ngw) transpose_item(s_glu, 512, WSP(bf16, WS_GLU), scr, it, lane); }
    const int gt = gw * 64 + lane, ngt = ngw * 64;
    for (int e = gt; e < 32 * 64; e += ngt) {
        const int g = e >> 6;
        const float ar = C->in[I_S5ARE][layer * 2048 + e], ai = C->in[I_S5AIM][layer * 2048 + e], dt = expf(C->in[I_S5LDT][layer * 32 + g]);
        const float mag = expf(ar * dt), abr = mag * cosf(ai * dt), abi = mag * sinf(ai * dt);
        const float den = ar * ar + ai * ai, nr = abr - 1.0f, ni = abi;
        const float qr = (nr * ar + ni * ai) / den, qi = (ni * ar - nr * ai) / den;
        float* ab = WSP(float, WS_ABAR) + e * 2; ab[0] = abr; ab[1] = abi;
        float* bb = WSP(float, WS_BBAR) + (size_t)e * 32;
        for (int j = 0; j < 16; ++j) { const float br = C->in[I_S5BRE][((size_t)layer * 2048 + e) * 16 + j], bi = C->in[I_S5BIM][((size_t)layer * 2048 + e) * 16 + j];
            bb[2 * j] = qr * br - qi * bi; bb[2 * j + 1] = qr * bi + qi * br; }
    }
    if (layer == 0) for (int e = gt; e < SEQ + 63; e += ngt) {
        const int rel = e - (SEQ - 1); const int n = rel < 0 ? -rel : rel; int b = rel > 0 ? 16 : 0;
        if (n < 8) b += n; else { int lg = 8 + (int)(logf((float)n / 8.0f) / 3.4657359028f * 8.0f); if (lg > 15) lg = 15; b += lg; }
        WSP(int, WS_TAB)[e] = b;
    }
}

__device__ __forceinline__ void rms_row_bf16(const float* xrow, const float* g, bf16* orow, int lane) {
    const f32x4* xr = (const f32x4*)xrow + lane; const f32x4* gr = (const f32x4*)g + lane;
    f32x4 v[4]; float s = 0.f;
#pragma unroll
    for (int j = 0; j < 4; ++j) { v[j] = xr[64 * j]; s += (v[j].x * v[j].x + v[j].y * v[j].y) + (v[j].z * v[j].z + v[j].w * v[j].w); }
    const float rstd = 1.0f / sqrtf(wave_sum(s) * (1.f / D) + RMS_EPS);
    u32x2* o8 = (u32x2*)orow + lane;
#pragma unroll
    for (int j = 0; j < 4; ++j) { const f32x4 gg = gr[64 * j]; u32x2 w; w.x = pk2(v[j].x * rstd * gg.x, v[j].y * rstd * gg.y); w.y = pk2(v[j].z * rstd * gg.z, v[j].w * rstd * gg.w); o8[64 * j] = w; }
}
__device__ __forceinline__ void rms_row_f32(float* xrow, const float* g, int lane) {
    f32x4* xr = (f32x4*)xrow + lane; const f32x4* gr = (const f32x4*)g + lane;
    f32x4 v[4]; float s = 0.f;
#pragma unroll
    for (int j = 0; j < 4; ++j) { v[j] = xr[64 * j]; s += (v[j].x * v[j].x + v[j].y * v[j].y) + (v[j].z * v[j].z + v[j].w * v[j].w); }
    const float rstd = 1.0f / sqrtf(wave_sum(s) * (1.f / D) + RMS_EPS);
#pragma unroll
    for (int j = 0; j < 4; ++j) xr[64 * j] = v[j] * rstd * gr[64 * j];
}

__device__ __forceinline__ void ssd_unit(KArgs C, int layer, int unit, unsigned char* lds) {
    const int tid = fresh_tid(), bl = unit >> 3, h = unit & 7, gi = h >> 2, pp = tid >> 3, ns = tid & 7;
    float* xs = (float*)lds; float* Bs = xs + 4096; float* Cs = Bs + 4096; float* ys = Cs + 4096; float* dts = ys + 4096; float* decs = dts + 64;
    const bf16* XBC = WSP(const bf16, WS_XBC) + (size_t)bl * SEQ * 768;
    const bf16* SMp = WSP(const bf16, WS_SM) + (size_t)bl * SEQ * 256;
    const bf16* Zp = WSP(const bf16, WS_Z) + (size_t)bl * SEQ * 512;
    bf16* YA = WSP(bf16, WS_Y) + (size_t)bl * SEQ * 512;
    const float* cw = C->in[I_CONVW] + layer * 4 * 768; const float* cb = C->in[I_CONVB] + layer * 768;
    const float dtb = C->in[I_DTB][layer * 8 + h], A = -__expf(C->in[I_ALOG][layer * 8 + h]), Dh = C->in[I_SSDD][layer * 8 + h];
    float st[8];
#pragma unroll
    for (int i = 0; i < 8; ++i) st[i] = 0.f;
    for (int c0 = 0; c0 < SEQ; c0 += 64) {
        __syncthreads();
        for (int e = tid; e < 3 * 4096; e += NTHREADS) {
            const int which = e >> 12, r = e & 4095, t = r >> 6, j = r & 63;
            const int ch = which == 0 ? h * 64 + j : (which == 1 ? 512 + gi * 64 + j : 640 + gi * 64 + j);
            const int tt = c0 + t; float a = cb[ch];
#pragma unroll
            for (int q = 0; q < 4; ++q) { const int ts = tt - 3 + q; if (ts >= 0) a += cw[q * 768 + ch] * bf2f(XBC[(size_t)ts * 768 + ch]); }
            const float v = a * sigm(a);
            (which == 0 ? xs : (which == 1 ? Bs : Cs))[r] = v;
        }
        if (tid < 64) { const float dt = softplusf(bf2f(SMp[(size_t)(c0 + tid) * 256 + h]) + dtb); dts[tid] = dt; decs[tid] = __expf(A * dt); }
        __syncthreads();
        for (int t = 0; t < 64; ++t) {
            const float dec = decs[t], xdt = xs[t * 64 + pp] * dts[t]; float part = 0.f;
#pragma unroll
            for (int i = 0; i < 8; ++i) { st[i] = st[i] * dec + xdt * Bs[t * 64 + ns * 8 + i]; part += st[i] * Cs[t * 64 + ns * 8 + i]; }
            part += __shfl_xor(part, 1); part += __shfl_xor(part, 2); part += __shfl_xor(part, 4);
            if (ns == 0) ys[t * 64 + pp] = part;
        }
        __syncthreads();
        for (int e = tid; e < 4096; e += NTHREADS) { const int t = e >> 6, j = e & 63; const size_t row = (size_t)(c0 + t);
            float y = ys[e] + Dh * xs[e]; const float z = bf2f(Zp[row * 512 + h * 64 + j]); y *= z * sigm(z); YA[row * 512 + h * 64 + j] = f2bf(y); }
    }
}
__device__ __forceinline__ void ssd_norm_item(KArgs C, int layer, int item, int lane) {
    bf16* p = WSP(bf16, WS_Y) + (size_t)(item >> 1) * 512 + (item & 1) * 256 + lane * 4;
    const u32x2 w = *(const u32x2*)p; float v[4] = {lo_bf(w.x), hi_bf(w.x), lo_bf(w.y), hi_bf(w.y)};
    const float rstd = 1.0f / sqrtf(wave_sum(v[0] * v[0] + v[1] * v[1] + v[2] * v[2] + v[3] * v[3]) * (1.f / 256) + RMS_EPS);
    const float* g = C->in[I_SSDNG] + layer * 512 + (item & 1) * 256 + lane * 4;
    u32x2 o; o.x = pk2(v[0] * rstd * g[0], v[1] * rstd * g[1]); o.y = pk2(v[2] * rstd * g[2], v[3] * rstd * g[3]); *(u32x2*)p = o;
}

__device__ __forceinline__ void rwkv_unit(KArgs C, int layer, int unit, unsigned char* lds) {
    constexpr int TC = 32;
    const int tid = fresh_tid(), bl = unit >> 3, h = unit & 7, vr = tid >> 3, ks = tid & 7;
    float* r_ = (float*)lds; float* k_ = r_ + 2048; float* v_ = k_ + 2048; float* w_ = v_ + 2048; float* a_ = w_ + 2048; float* dg_ = a_ + 2048;
    float* kk_ = dg_ + 4096; float* bb_ = kk_ + 2048; float* g_ = bb_ + 2048; float* ys = g_ + 2048; float* st_ = ys + 2048;
    const bf16* RW = WSP(const bf16, WS_RW) + (size_t)bl * SEQ * 1792;
    bf16* YC = WSP(bf16, WS_Y) + (size_t)2 * MG * 512 + (size_t)bl * SEQ * 512;
    const float* mu = C->in[I_MU] + layer * 1792;
    const float* w0 = C->in[I_W0] + layer * 512; const float* w2 = C->in[I_W2] + (size_t)layer * 64 * 512;
    const float* a0 = C->in[I_A0] + layer * 512; const float* a2 = C->in[I_A2] + (size_t)layer * 64 * 512;
    const float* g2 = C->in[I_G2] + (size_t)layer * 128 * 512;
    const float* k_k = C->in[I_KK] + layer * 512; const float* k_a = C->in[I_KA] + layer * 512; const float* r_k = C->in[I_RK] + layer * 512;
    const float* ln_g = C->in[I_LNG] + layer * 512; const float* ln_b = C->in[I_LNB] + layer * 512;
    float st[8];
#pragma unroll
    for (int i = 0; i < 8; ++i) st[i] = 0.f;
    for (int c0 = 0; c0 < SEQ; c0 += TC) {
        __syncthreads();
        for (int e = tid; e < TC * 448; e += NTHREADS) {
            const int t = e / 448, c = e % 448; int col; float* dst;
            if (c < 64) { col = h * 64 + c; dst = r_ + t * 64 + c; }
            else if (c < 128) { col = 512 + h * 64 + (c - 64); dst = k_ + t * 64 + (c - 64); }
            else if (c < 192) { col = 1024 + h * 64 + (c - 128); dst = v_ + t * 64 + (c - 128); }
            else if (c < 256) { col = 1536 + (c - 192); dst = w_ + t * 64 + (c - 192); }
            else if (c < 320) { col = 1600 + (c - 256); dst = a_ + t * 64 + (c - 256); }
            else { col = 1664 + (c - 320); dst = dg_ + t * 128 + (c - 320); }
            const int tt = c0 + t; const float cur = bf2f(RW[(size_t)tt * 1792 + col]); const float prev = tt > 0 ? bf2f(RW[(size_t)(tt - 1) * 1792 + col]) : 0.f;
            float val = cur + (prev - cur) * mu[col];
            if (c >= 192 && c < 256) val = tanhf(val); else if (c >= 320) val = sigm(val);
            *dst = val;
        }
        __syncthreads();
        float rw[4], ra[4], rg[4];
        { const int j = tid & 63, hj = h * 64 + j, t0 = tid >> 6;
#pragma unroll
          for (int i = 0; i < 4; ++i) { rw[i] = w0[hj]; ra[i] = a0[hj]; rg[i] = 0.f; }
#pragma unroll 4
          for (int l = 0; l < 64; ++l) { const float wv = w2[l * 512 + hj], av = a2[l * 512 + hj];
#pragma unroll
              for (int i = 0; i < 4; ++i) { rw[i] += w_[(t0 + 8 * i) * 64 + l] * wv; ra[i] += a_[(t0 + 8 * i) * 64 + l] * av; } }
#pragma unroll 4
          for (int l = 0; l < 128; ++l) { const float gv = g2[l * 512 + hj];
#pragma unroll
              for (int i = 0; i < 4; ++i) rg[i] += dg_[(t0 + 8 * i) * 128 + l] * gv; } }
        __syncthreads();
#pragma unroll
        for (int i = 0; i < 4; ++i) { const int e = tid + NTHREADS * i, j = e & 63, hj = h * 64 + j;
            w_[e] = __expf(-__expf(-softplusf(-rw[i]) - 0.5f)); const float as = sigm(ra[i]); a_[e] = as; g_[e] = rg[i];
            kk_[e] = k_[e] * k_k[hj]; }
        __syncthreads();
        if (tid < TC) { float s = 0.f;
#pragma unroll 4
            for (int j = 0; j < 64; ++j) { const float q = kk_[tid * 64 + j]; s += q * q; } st_[tid] = 1.0f / fmaxf(sqrtf(s), 1e-12f); }
        __syncthreads();
#pragma unroll
        for (int i = 0; i < 4; ++i) { const int e = tid + NTHREADS * i, t = e >> 6, j = e & 63, hj = h * 64 + j;
            const float kn = kk_[e] * st_[t], as = a_[e]; kk_[e] = kn; bb_[e] = kn * as; k_[e] = k_[e] * (1.0f + (as - 1.0f) * k_a[hj]); }
        __syncthreads();
        for (int t = 0; t < TC; ++t) {
            const int o = t * 64 + ks * 8; float sa = 0.f;
#pragma unroll
            for (int i = 0; i < 8; ++i) sa -= st[i] * kk_[o + i];
            sa += __shfl_xor(sa, 1); sa += __shfl_xor(sa, 2); sa += __shfl_xor(sa, 4);
            const float vv = v_[t * 64 + vr]; float y = 0.f;
#pragma unroll
            for (int i = 0; i < 8; ++i) { st[i] = st[i] * w_[o + i] + sa * bb_[o + i] + vv * k_[o + i]; y += st[i] * r_[o + i]; }
            y += __shfl_xor(y, 1); y += __shfl_xor(y, 2); y += __shfl_xor(y, 4);
            if (ks == 0) ys[t * 64 + vr] = y;
        }
        __syncthreads();
        if (tid < TC) { float s = 0.f, bo = 0.f;
#pragma unroll 4
            for (int j = 0; j < 64; ++j) { s += ys[tid * 64 + j]; bo += r_[tid * 64 + j] * k_[tid * 64 + j] * r_k[h * 64 + j]; }
            const float mean = s * (1.f / 64); float q = 0.f;
#pragma unroll 4
            for (int j = 0; j < 64; ++j) { const float d = ys[tid * 64 + j] - mean; q += d * d; }
            st_[tid] = mean; st_[32 + tid] = 1.0f / sqrtf(q * (1.f / 64) + GN_EPS); st_[64 + tid] = bo; }
        __syncthreads();
#pragma unroll
        for (int i = 0; i < 4; ++i) { const int e = tid + NTHREADS * i, t = e >> 6, j = e & 63, hj = h * 64 + j;
            const float yn = (ys[e] - st_[t]) * st_[32 + t] * ln_g[hj] + ln_b[hj];
            YC[(size_t)(c0 + t) * 512 + hj] = f2bf((yn + st_[64 + t] * v_[e]) * g_[e]); }
    }
}

__device__ __forceinline__ void s5_unit(KArgs C, int layer, int unit, unsigned char* lds) {
    const int tid = fresh_tid(), bl = unit >> 5, g = unit & 31, p = tid & 63, to = tid >> 6;
    float* us = (float*)lds; float* bre = us + 1024; float* bim = bre + 4096; float* cre = bim + 4096; float* cim = cre + 1024;
    const bf16* U = WSP(const bf16, WS_U) + (size_t)bl * SEQ * 512 + g * 16;
    bf16* YD0 = WSP(bf16, WS_YD0) + (size_t)bl * SEQ * 512 + g * 16;
    float Bre[16], Bim[16];
    { const float* bb = WSP(const float, WS_BBAR) + ((size_t)g * 64 + p) * 32;
#pragma unroll
      for (int j = 0; j < 16; ++j) { Bre[j] = bb[2 * j]; Bim[j] = bb[2 * j + 1]; } }
    const float ar = WSP(const float, WS_ABAR)[(g * 64 + p) * 2], ai = WSP(const float, WS_ABAR)[(g * 64 + p) * 2 + 1];
    const float* dsk = C->in[I_S5D] + layer * 512 + g * 16;
    __syncthreads();
    for (int e = tid; e < 1024; e += NTHREADS) { cre[e] = C->in[I_S5CRE][((size_t)layer * 32 + g) * 1024 + e]; cim[e] = C->in[I_S5CIM][((size_t)layer * 32 + g) * 1024 + e]; }
    float sr = 0.f, si = 0.f;
    for (int c0 = 0; c0 < SEQ; c0 += 64) {
        __syncthreads();
        for (int e = tid; e < 1024; e += NTHREADS) us[e] = bf2f(U[(size_t)(c0 + (e >> 4)) * 512 + (e & 15)]);
        __syncthreads();
#pragma unroll
        for (int i = 0; i < 8; ++i) { const int t = to * 8 + i; float br = 0.f, bi = 0.f;
#pragma unroll
            for (int j = 0; j < 16; ++j) { const float u = us[t * 16 + j]; br += u * Bre[j]; bi += u * Bim[j]; }
            bre[t * 64 + p] = br; bim[t * 64 + p] = bi; }
        __syncthreads();
        if (tid < 64) for (int t = 0; t < 64; ++t) { const float nr = ar * sr - ai * si + bre[t * 64 + p], ni = ar * si + ai * sr + bim[t * 64 + p]; sr = nr; si = ni; bre[t * 64 + p] = nr; bim[t * 64 + p] = ni; }
        __syncthreads();
#pragma unroll
        for (int i = 0; i < 2; ++i) { const int e = tid + NTHREADS * i, t = e >> 4, j = e & 15; float y = 0.f;

#pragma unroll 8
            for (int q = 0; q < 64; ++q) y += bre[t * 64 + q] * cre[j * 64 + q] - bim[t * 64 + q] * cim[j * 64 + q];
            y += dsk[j] * us[e]; YD0[(size_t)(c0 + t) * 512 + j] = f2bf(gelu_tanh(y)); }
    }
}

__device__ __forceinline__ unsigned ord_key(float f) { const unsigned u = __float_as_uint(f); return (u & 0x80000000u) ? ~u : (u | 0x80000000u); }
__device__ __forceinline__ void dsa_index_row(KArgs C, int m, int lane, unsigned* ks) {
    const int bl = m / SEQ, t = m % SEQ, nkeys = ((t >> 6) + 1) * 64, nk64 = nkeys >> 6;
    unsigned* mrow = WSP(unsigned, WS_MASK) + (size_t)m * MW;
    if (nkeys <= TOPK) { for (int w = lane; w < MW; w += 64) mrow[w] = (w * 32 < nkeys) ? 0xffffffffu : 0u; return; }
    const bf16* smq = WSP(const bf16, WS_SM) + (size_t)m * 256;
    const bf16* smk = WSP(const bf16, WS_SM) + (size_t)bl * SEQ * 256 + 136;
    float* scf = (float*)ks;
    for (int h = 0; h < 4; ++h) {
        float qv[32];
#pragma unroll
        for (int e = 0; e < 32; ++e) qv[e] = bf2f(smq[8 + h * 32 + e]);
        const float wh = bf2f(smq[168 + h]) * 0.5f;
#pragma unroll 2
        for (int i = 0; i < nk64; ++i) {
            const u32x4* kr = (const u32x4*)(smk + (size_t)(i * 64 + lane) * 256); float dot = 0.f;
#pragma unroll
            for (int q = 0; q < 4; ++q) { const u32x4 w = kr[q];
                dot += qv[8 * q + 0] * lo_bf(w.x) + qv[8 * q + 1] * hi_bf(w.x) + qv[8 * q + 2] * lo_bf(w.y) + qv[8 * q + 3] * hi_bf(w.y)
                     + qv[8 * q + 4] * lo_bf(w.z) + qv[8 * q + 5] * hi_bf(w.z) + qv[8 * q + 6] * lo_bf(w.w) + qv[8 * q + 7] * hi_bf(w.w); }
            const float v = wh * fmaxf(dot * 0.17677669529f, 0.f);
            scf[i * 64 + lane] = (h == 0) ? v : scf[i * 64 + lane] + v;
        }
    }
    for (int i = 0; i < nk64; ++i) ks[i * 64 + lane] = ord_key(scf[i * 64 + lane]);
    unsigned T = 0u;
    for (int bit = 31; bit >= 0; --bit) { const unsigned cand = T | (1u << bit); int c = 0;
#pragma unroll 4
        for (int i = 0; i < nk64; ++i) c += (ks[i * 64 + lane] >= cand) ? 1 : 0;
        if (wave_sum_i(c) >= TOPK) T = cand; }
    int cgt = 0;
    for (int i = 0; i < nk64; ++i) cgt += (ks[i * 64 + lane] > T) ? 1 : 0;
    const int need = TOPK - wave_sum_i(cgt); int taken = 0;
    for (int i = 0; i < NK64; ++i) {
        const unsigned kv = (i < nk64) ? ks[i * 64 + lane] : 0u;
        const bool eq = kv == T && i < nk64; const unsigned long long be = __ballot(eq);
        const int pre = __popcll(be & ((1ull << lane) - 1ull));
        const bool sel = (i < nk64) && ((kv > T) || (eq && (taken + pre) < need)); taken += __popcll(be);
        const unsigned long long bs = __ballot(sel);
        if (lane == 0) { mrow[2 * i] = (unsigned)bs; mrow[2 * i + 1] = (unsigned)(bs >> 32); }
    }
}
__device__ __forceinline__ void dsa_attn_row(KArgs C, int m, int lane, int* idx, float* pl) {
    const int bl = m / SEQ, t = m % SEQ;
    const unsigned* mrow = WSP(const unsigned, WS_MASK) + (size_t)m * MW;
    int cnt = 0;
    WAVE_SYNC();
    for (int i = 0; i < NK64; ++i) { const unsigned long long w = (unsigned long long)mrow[2 * i] | ((unsigned long long)mrow[2 * i + 1] << 32);
        if ((w >> lane) & 1ull) idx[cnt + __popcll(w & ((1ull << lane) - 1ull))] = i * 64 + lane; cnt += __popcll(w); }
    WAVE_SYNC();
    const bf16* Qr = WSP(const bf16, WS_Q) + (size_t)m * 512;
    const bf16* Kb = WSP(const bf16, WS_K) + (size_t)bl * SEQ * 512;
    const bf16* Vb = WSP(const bf16, WS_V) + (size_t)bl * SEQ * 512;
    bf16* YB = WSP(bf16, WS_Y) + (size_t)MG * 512 + (size_t)m * 512;
    const int* tab = WSP(const int, WS_TAB); const float* relb = C->in[I_RELB];
    for (int h = 0; h < 8; ++h) {
        float qv[64];
#pragma unroll
        for (int d = 0; d < 64; ++d) qv[d] = bf2f(Qr[h * 64 + d]);
        float mx = -INFINITY;
        WAVE_SYNC();
#pragma unroll 1
        for (int c = 0; c < TOPK / 64; ++c) { const int j = c * 64 + lane; float lgv = -INFINITY;
            if (j < cnt) { const int key = idx[j]; const u32x4* kr = (const u32x4*)(Kb + (size_t)key * 512 + h * 64); float dot = 0.f;
#pragma unroll
                for (int q = 0; q < 8; ++q) { const u32x4 w = kr[q];
                    dot += qv[8 * q + 0] * lo_bf(w.x) + qv[8 * q + 1] * hi_bf(w.x) + qv[8 * q + 2] * lo_bf(w.y) + qv[8 * q + 3] * hi_bf(w.y)
                         + qv[8 * q + 4] * lo_bf(w.z) + qv[8 * q + 5] * hi_bf(w.z) + qv[8 * q + 6] * lo_bf(w.w) + qv[8 * q + 7] * hi_bf(w.w); }
                lgv = dot * 0.125f + relb[tab[key - t + SEQ - 1] * 8 + h]; }
            pl[j] = lgv; mx = fmaxf(mx, lgv); }
        mx = wave_max(mx); float sum = 0.f;
#pragma unroll 1
        for (int c = 0; c < TOPK / 64; ++c) { const int j = c * 64 + lane; const float e = (j < cnt) ? __expf(pl[j] - mx) : 0.f; pl[j] = e; sum += e; }
        const float inv = 1.0f / wave_sum(sum);
        WAVE_SYNC();
        float acc = 0.f;
#pragma unroll 4
        for (int j = 0; j < cnt; ++j) acc += pl[j] * bf2f(Vb[(size_t)idx[j] * 512 + h * 64 + lane]);
        YB[h * 64 + lane] = f2bf(acc * inv);
    }
}
constexpr int SEGS_PER_GROUP = 9, NSEG = DEPTH * (1 + NGRP * SEGS_PER_GROUP) + 1;

#ifdef HOST_EMU
#define GRID_BARRIER() emu_grid_sync()
#define LDS_PTR(p) ((unsigned char*)(p))
#else
#define GRID_BARRIER() xcd_barrier(bar)
#define LDS_PTR(p) ((PG8_LAS unsigned char*)(p))
#endif

__global__ void __launch_bounds__(NTHREADS, 2) fwd_kernel(Args a) {
#ifdef HOST_EMU
    unsigned char* lds = emu_lds;
#else
    extern __shared__ __attribute__((aligned(16))) unsigned char lds[];
#endif
#ifdef HOST_EMU
    KArgs Ck = &a;
#else
    KArgs Ck = (KArgs)__builtin_amdgcn_kernarg_segment_ptr();
    (void)a;
#endif
    const int G = gridDim.x, bx = blockIdx.x, ngw = G * NWAVES;
#ifndef HOST_EMU
    if (threadIdx.x < 4) ((LAS unsigned*)(lds + LDS_CTL_OFF))[threadIdx.x] = 0u;
    __syncthreads();
    XcdBarrier bar; bar.bar = (unsigned*)(Ck->ws + WS_CTL); bar.x = 0; bar.st = nullptr;
    if (Ck->seg_hi - Ck->seg_lo > 1) bar = xcd_barrier_post((unsigned*)(Ck->ws + WS_CTL), (volatile LAS unsigned*)(lds + LDS_CTL_OFF));
#endif
    int seg = 0;
#define RUN (seg >= Ck->seg_lo && seg < Ck->seg_hi)
#define SEAM do { if (seg >= Ck->seg_lo && seg + 1 < Ck->seg_hi) { GRID_BARRIER(); } ++seg; } while (0)
#define PHASE_VARS KArgs C = KLAUNDER(Ck); const int tid = fresh_tid(), lane = tid & 63, wave = __builtin_amdgcn_readfirstlane(tid >> 6), gw = bx * NWAVES + wave; (void)lane; (void)gw; (void)C
    for (int layer = 0; layer < DEPTH; ++layer) {
        if (RUN) { PHASE_VARS; phase_weights(C, layer, lds, gw, ngw, lane, wave); }
        SEAM;
        for (int grp = 0; grp < NGRP; ++grp) {
#define XIN ((layer == 0 ? C->in[I_X] : (const float*)C->out) + (size_t)grp * MG * D)
#define XOUT (C->out + (size_t)grp * MG * D)
            if (RUN) { PHASE_VARS; for (int m = gw; m < MG; m += ngw) rms_row_bf16(XIN + (size_t)m * D, C->in[I_NMIX] + layer * D, WSP(bf16, WS_H) + (size_t)m * D, lane); }
            SEAM;
            if (RUN) { PHASE_VARS; pg8::Gemm g{WSP(const bf16, WS_H), WSP(const bf16, WS_WIN), MG, NPROJ, D}; pg8::StaticOrder S; S.init(MG, NPROJ, G, bx);
                pg8::EpiProj E{C->ws}; pg8::gemm_phase<pg8::EpiProj, pg8::StaticOrder>(LDS_PTR(lds), g, S, E, nullptr); }
            SEAM;
            if (RUN) { PHASE_VARS;
                for (int u = bx; u < NB * 8; u += G) rwkv_unit(C, layer, u, lds);
                for (int u = (bx + G - (NB * 8) % G) % G; u < NB * 8; u += G) ssd_unit(C, layer, u, lds);
                for (int u = (bx + G - (NB * 16) % G) % G; u < NB * 32; u += G) s5_unit(C, layer, u, lds);
                __syncthreads();
                for (int m = ngw - 1 - gw; m < MG; m += ngw) dsa_index_row(C, m, lane, (unsigned*)lds + wave * SEQ);
            }
            SEAM;
            if (RUN) { PHASE_VARS;
                { pg8::Gemm g{WSP(const bf16, WS_YD0), WSP(const bf16, WS_GLU), MG, 512, 512}; pg8::StaticOrder S; S.init(MG, 512, G, bx);
                  pg8::EpiGlu E{WSP(const bf16, WS_YD0), WSP(bf16, WS_Y) + (size_t)3 * MG * 512, C->in[I_GLUB] + layer * 512};
                  pg8::gemm_phase<pg8::EpiGlu, pg8::StaticOrder>(LDS_PTR(lds), g, S, E, nullptr); }
                __syncthreads();
                for (int m = gw; m < MG; m += ngw) dsa_attn_row(C, m, lane, (int*)lds + wave * TOPK, (float*)(lds + 8 * TOPK * 4) + wave * TOPK);
                for (int it = gw; it < MG * 2; it += ngw) ssd_norm_item(C, layer, it, lane);
            }
            SEAM;
            if (RUN) { PHASE_VARS; pg8::Gemm g{WSP(const bf16, WS_Y), WSP(const bf16, WS_WB), 4 * MG, 4096, 512}; pg8::MergeOrder S{G, bx};
                pg8::EpiMerge E{WSP(const bf16, WS_G), WSP(bf16, WS_MRG)}; pg8::gemm_phase<pg8::EpiMerge, pg8::MergeOrder>(LDS_PTR(lds), g, S, E, nullptr); }
            SEAM;
            if (RUN) { PHASE_VARS; pg8::Gemm g{WSP(const bf16, WS_MRG), WSP(const bf16, WS_WOUT), MG, D, D}; pg8::StaticOrder S; S.init(MG, D, G, bx);
                pg8::EpiResid E{XIN, XOUT}; pg8::gemm_phase<pg8::EpiResid, pg8::StaticOrder>(LDS_PTR(lds), g, S, E, nullptr); }
            SEAM;
            if (RUN) { PHASE_VARS; for (int m = gw; m < MG; m += ngw) rms_row_bf16(XOUT + (size_t)m * D, C->in[I_NFFN] + layer * D, WSP(bf16, WS_H) + (size_t)m * D, lane); }
            SEAM;
            if (RUN) { PHASE_VARS; pg8::Gemm g{WSP(const bf16, WS_H), WSP(const bf16, WS_W13), MG, 5632, D}; pg8::StaticOrder S; S.init(MG, 5632, G, bx);
                pg8::EpiSwiglu E{WSP(bf16, WS_HID)}; pg8::gemm_phase<pg8::EpiSwiglu, pg8::StaticOrder>(LDS_PTR(lds), g, S, E, nullptr); }
            SEAM;
            if (RUN) { PHASE_VARS; pg8::Gemm g{WSP(const bf16, WS_HID), WSP(const bf16, WS_W2), MG, D, FFN}; pg8::StaticOrder S; S.init(MG, D, G, bx);
                pg8::EpiResid E{XOUT, XOUT}; pg8::gemm_phase<pg8::EpiResid, pg8::StaticOrder>(LDS_PTR(lds), g, S, E, nullptr); }
            SEAM;
        }
    }
    if (RUN) { PHASE_VARS; for (int m = gw; m < M; m += ngw) rms_row_f32(C->out + (size_t)m * D, C->in[I_NFIN], lane); }
#undef RUN
#undef SEAM
}

extern "C" void kernel_launch(void* const* d_in, const int* in_sizes, int n_in, void* d_out, int out_size, void* d_ws, size_t ws_size, hipStream_t stream) {
    static int grid = 0;
    if (grid == 0) {
        if (n_in != N_IN || out_size != M * D || ws_size < WS_END) { fprintf(stderr, "kernel_launch: unexpected shapes (n_in %d, out %d, ws %zu < %zu)\n", n_in, out_size, ws_size, (size_t)WS_END); grid = -1; return; }
        int dev = 0, cus = 0;
        if (hipGetDevice(&dev) != hipSuccess || hipDeviceGetAttribute(&cus, hipDeviceAttributeMultiprocessorCount, dev) != hipSuccess || cus < 1) { grid = -1; return; }
        if (hipFuncSetAttribute((const void*)fwd_kernel, hipFuncAttributeMaxDynamicSharedMemorySize, LDS_BYTES) != hipSuccess) { fprintf(stderr, "kernel_launch: hipFuncSetAttribute failed\n"); grid = -1; return; }
        (void)hipGetLastError();
        grid = cus;
    }
    if (grid < 0) return;
    (void)hipMemsetAsync((char*)d_ws + WS_CTL, 0, CTL_BYTES, stream);
    Args a{};
    for (int i = 0; i < N_IN; ++i) a.in[i] = (const float*)d_in[i];
    a.out = (float*)d_out; a.ws = (unsigned char*)d_ws;
#if CFG_LAUNCHES == 1
    a.seg_lo = 0; a.seg_hi = NSEG;
    hipLaunchKernelGGL(fwd_kernel, dim3(grid), dim3(NTHREADS), LDS_BYTES, stream, a);
#else
    for (int s = 0; s < NSEG; ++s) { a.seg_lo = s; a.seg_hi = s + 1; hipLaunchKernelGGL(fwd_kernel, dim3(grid), dim3(NTHREADS), LDS_BYTES, stream, a); }
#endif
}
```

```cpp
#ifdef HOST_EMU
#error "HOST_EMU is a host-only debug build"
#else
#include <hip/hip_runtime.h>
#endif
#include <cstdio>
#include <cstdint>
#include <cmath>

#ifndef CFG_BATCH
#define CFG_BATCH 16
#endif
#ifndef CFG_SEQ
#define CFG_SEQ 4096
#endif
#ifndef CFG_DEPTH
#define CFG_DEPTH 4
#endif
#ifndef CFG_NB
#define CFG_NB 8
#endif
#ifndef CFG_LAUNCHES
#define CFG_LAUNCHES 1
#endif

typedef unsigned short bf16;
typedef float f32x4 __attribute__((ext_vector_type(4)));
typedef float f32x2 __attribute__((ext_vector_type(2)));
typedef unsigned u32x4 __attribute__((ext_vector_type(4)));
typedef unsigned u32x2 __attribute__((ext_vector_type(2)));

constexpr int BATCH = CFG_BATCH, SEQ = CFG_SEQ, DEPTH = CFG_DEPTH, NB = CFG_NB;
constexpr int D = 1024, M = BATCH * SEQ, MG = NB * SEQ, NGRP = BATCH / NB;
constexpr int IN_COLS = 9388, NPROJ = 9472, NMIXC = 5376, FFN = 2816;
constexpr int TOPK = (SEQ / 4) < 256 ? (SEQ / 4) : 256;
constexpr int NK64 = SEQ / 64, MW = SEQ / 32;
constexpr float RMS_EPS = 1e-6f, GN_EPS = 64e-5f;
static_assert(BATCH % NB == 0 && MG % 256 == 0 && SEQ % 64 == 0, "shape");

enum { I_X = 0, I_RELB, I_NMIX, I_WIN, I_CONVW, I_CONVB, I_DTB, I_ALOG, I_SSDD, I_SSDNG, I_MU, I_W0, I_W2, I_A0, I_A2, I_G2, I_KK, I_KA, I_RK, I_LNG, I_LNB,
       I_S5ARE, I_S5AIM, I_S5BRE, I_S5BIM, I_S5CRE, I_S5CIM, I_S5D, I_S5LDT, I_GLUW, I_GLUB, I_WBR, I_WOUT, I_NFFN, I_W1, I_W3, I_W2F, I_NFIN, N_IN };

constexpr size_t MiB = 1u << 20;
constexpr size_t al256(size_t x) { return (x + 255) & ~(size_t)255; }
constexpr size_t WS_CTL = 0, CTL_BYTES = 64 * 1024;
constexpr size_t WS_TAB = WS_CTL + CTL_BYTES;
constexpr size_t WS_ABAR = al256(WS_TAB + (SEQ + 64) * 4);
constexpr size_t WS_BBAR = WS_ABAR + 32 * 64 * 2 * 4;
constexpr size_t WS_WIN = al256(WS_BBAR + 32 * 64 * 16 * 2 * 4);
constexpr size_t WS_WB = WS_WIN + (size_t)NPROJ * 1024 * 2;
constexpr size_t WS_WOUT = WS_WB + (size_t)4 * 1024 * 512 * 2;
constexpr size_t WS_W13 = WS_WOUT + (size_t)1024 * 1024 * 2;
constexpr size_t WS_W2 = WS_W13 + (size_t)5632 * 1024 * 2;
constexpr size_t WS_GLU = WS_W2 + (size_t)1024 * 2816 * 2;
constexpr size_t WS_WLORA = WS_GLU + (size_t)512 * 512 * 2;
constexpr size_t WS_H = al256(WS_WLORA + (size_t)1536 * 256 * 2);
constexpr size_t WS_Z = WS_H + (size_t)MG * 1024 * 2;
constexpr size_t WS_XBC = WS_Z + (size_t)MG * 512 * 2;
constexpr size_t WS_Q = WS_XBC + (size_t)MG * 768 * 2;
constexpr size_t WS_K = WS_Q + (size_t)MG * 512 * 2;
constexpr size_t WS_V = WS_K + (size_t)MG * 512 * 2;
constexpr size_t WS_RW = WS_V + (size_t)MG * 512 * 2;
constexpr size_t WS_U = WS_RW + (size_t)MG * 1792 * 2;
constexpr size_t WS_SM = WS_U + (size_t)MG * 512 * 2;
constexpr size_t WS_G = WS_Q;
constexpr size_t WS_Y = WS_SM + (size_t)MG * 256 * 2;
constexpr size_t WS_YD0 = WS_Y + (size_t)4 * MG * 512 * 2;
constexpr size_t WS_MRG = WS_YD0 + (size_t)MG * 512 * 2;
constexpr size_t WS_MASK = WS_MRG + (size_t)MG * 1024 * 2;
constexpr size_t WS_RA = WS_MASK + (size_t)MG * MW * 4;
constexpr size_t WS_WLOG = WS_RA + (size_t)MG * 256 * 2;
constexpr size_t WS_ASIG = WS_WLOG + (size_t)MG * 512 * 4;
constexpr size_t WS_GG = WS_ASIG + (size_t)MG * 512 * 2;
constexpr size_t WS_XBA = WS_GG + (size_t)MG * 512 * 2;
constexpr size_t WS_VT = WS_XBA + (size_t)MG * 768 * 2;
constexpr size_t WS_KI = WS_VT + (size_t)MG * 512 * 2;
constexpr size_t WS_QCTR = 16384;
constexpr size_t WS_HID = WS_G;
constexpr size_t WS_WALT = al256(WS_KI + (size_t)MG * 32 * 2);
constexpr size_t WDELTA = WS_WALT - WS_ABAR;
constexpr size_t WS_END = WS_WALT + (WS_H - WS_ABAR);
static_assert(WS_SM + (size_t)MG * 256 * 2 - WS_Q == (size_t)MG * 4096 * 2, "G overlays exactly Q..SM");
static_assert((size_t)MG * 2816 * 2 <= (size_t)MG * 4096 * 2, "HID fits in G");

constexpr int LDS_SCRATCH = 131072;
constexpr int LDS_CTL_OFF = LDS_SCRATCH;
constexpr int LDS_X = LDS_SCRATCH + 64;
constexpr int LDS_BYTES = 161792;
constexpr int NTHREADS = 512, NWAVES = 8;

__device__ __forceinline__ float bf2f(bf16 v) { return __uint_as_float(((unsigned)v) << 16); }
#ifdef HOST_EMU
__device__ __forceinline__ bf16 f2bf(float f) { unsigned u = __float_as_uint(f); u += 0x7fffu + ((u >> 16) & 1u); return (bf16)(u >> 16); }
#else
__device__ __forceinline__ bf16 f2bf(float f) { return __builtin_bit_cast(bf16, (__bf16)f); }
#endif
#ifdef HOST_EMU
__device__ __forceinline__ unsigned pk2(float lo, float hi) { return (unsigned)f2bf(lo) | ((unsigned)f2bf(hi) << 16); }
#else
typedef __bf16 bf16x2_hw __attribute__((ext_vector_type(2)));
__device__ __forceinline__ unsigned pk2(float lo, float hi) { const f32x2 v = {lo, hi}; return __builtin_bit_cast(unsigned, __builtin_convertvector(v, bf16x2_hw)); }
#endif
__device__ __forceinline__ float lo_bf(unsigned w) { return __uint_as_float(w << 16); }
__device__ __forceinline__ float hi_bf(unsigned w) { return __uint_as_float(w & 0xffff0000u); }
__device__ __forceinline__ float sigm(float x) { return 1.0f / (1.0f + __expf(-x)); }
__device__ __forceinline__ float softplusf(float x) { return x > 20.f ? x : log1pf(__expf(x)); }
__device__ __forceinline__ float gelu_tanh(float x) { const float u = 0.7978845608f * (x + 0.044715f * x * x * x); return 0.5f * x * (1.0f + tanhf(u)); }
__device__ __forceinline__ float wave_sum(float v) {
#pragma unroll
    for (int o = 1; o < 64; o <<= 1) v += __shfl_xor(v, o);
    return v;
}
__device__ __forceinline__ float wave_max(float v) {
#pragma unroll
    for (int o = 1; o < 64; o <<= 1) v = fmaxf(v, __shfl_xor(v, o));
    return v;
}
__device__ __forceinline__ int wave_sum_i(int v) {
#pragma unroll
    for (int o = 1; o < 64; o <<= 1) v += __shfl_xor(v, o);
    return v;
}
#ifdef HOST_EMU
#define WAVE_SYNC() (void)emu_wave_exchange(0)
#define SCHED_FENCE() do {} while (0)
#define LDS_SYNC() __syncthreads()
#else
#define WAVE_SYNC() __builtin_amdgcn_wave_barrier()
#define SCHED_FENCE() __builtin_amdgcn_sched_barrier(0)
#define LDS_SYNC() do { asm volatile("s_waitcnt lgkmcnt(0)" ::: "memory"); __builtin_amdgcn_s_barrier(); asm volatile("" ::: "memory"); } while (0)
#endif
#ifndef HOST_EMU
namespace pg8 {
__device__ __forceinline__ int pg8_fresh_tid() { int t = (int)threadIdx.x; asm volatile("" : "+v"(t)); return t; }
#define PG8_LAS __attribute__((address_space(3)))
typedef unsigned short bf16_t;
typedef short bf16x8 __attribute__((ext_vector_type(8)));
typedef float f32x4 __attribute__((ext_vector_type(4)));
typedef unsigned u32x4 __attribute__((ext_vector_type(4)));
constexpr int BM = 256, BK = 64, HALF = 128, HTB = HALF * BK * 2  , STAGE_BYTES = 8 * HTB, NXCD = 8, WGM = 8;

__host__ __device__ __forceinline__ int lds_byte(int r, int c) { const int st = (r >> 4) * 2 + (c >> 5), rr = r & 15, cc = c & 31, ob = rr * 64 + cc * 2; return st * 1024 + (ob ^ (((ob >> 9) & 1) << 5)); }
__host__ __device__ __forceinline__ void stage_rc(int b, int& R, int& C) { const int st = b / 1024, sb = b % 1024, swz = sb ^ (((sb >> 9) & 1) << 5); R = (st >> 1) * 16 + swz / 64; C = (st & 1) * 32 + (swz % 64) / 2; }
__host__ __device__ __forceinline__ int perm32(int rho) { const int n = rho >> 4, i = rho & 15; return 8 * (i >> 2) + 4 * n + (i & 3); }

struct Unit { int pm, pn; };
struct Gemm { const bf16_t* A; const bf16_t* Bt; int M, N, K; };

struct StaticOrder {
    int nM, nN, nwg, G, c;
    __host__ __device__ void init(int M, int N, int G_, int c_) { nM = M / BM; nN = N / BM; nwg = nM * nN; G = G_; c = c_; }
    __host__ __device__ bool next(int i, Unit& u) const {
        const long L = (long)i * G + c; if (L >= nwg) return false;
        int wgid = (int)L; { const int q = nwg / NXCD, r = nwg % NXCD, xcd = wgid % NXCD, off = wgid / NXCD; wgid = (xcd < r ? xcd * (q + 1) : r * (q + 1) + (xcd - r) * q) + off; }
        const int nig = WGM * nN, gid = wgid / nig, fm = gid * WGM, gsz = (nM - fm) < WGM ? (nM - fm) : WGM;
        u.pm = fm + ((wgid % nig) % gsz); u.pn = (wgid % nig) / gsz; return true;
    }
    __device__ __forceinline__ void a_ready(const Unit&) const {}
    __device__ __forceinline__ void done(const Unit&) const {}
};

__device__ __forceinline__ unsigned cvt_pk_bf16(float lo, float hi) { return pk2(lo, hi); }

template <class E, class = void> struct epi_keep { static constexpr bool value = false; };
template <class E> struct epi_keep<E, decltype((void)E::KEEP_ACC)> { static constexpr bool value = true; };
template <class Epi, class Sched, bool STAMP = false>
__device__ __forceinline__ void gemm_phase(PG8_LAS unsigned char* lds, const Gemm g, const Sched& S, const Epi& E, unsigned long long* stamps) {
    const int tid = pg8_fresh_tid(), wid = __builtin_amdgcn_readfirstlane(tid >> 6), lane = tid & 63, wr = wid >> 2, wc = wid & 3, fr = lane & 15, fq = lane >> 4;
    int K_ = g.K; asm volatile("" : "+s"(K_));
    const int K = K_, nt = K / BK;
    int ts_lo = 0, ts_hi = 0, nts = 0; const unsigned long long rt_entry = STAMP ? (unsigned long long)wall_clock64() : 0ull;
#define PG8_STAMP() do { if (STAMP && wid == 0 && nts < 64) { const unsigned long long _c = (unsigned long long)clock64(); \
        ts_lo = (lane == nts) ? (int)(unsigned)_c : ts_lo; ts_hi = (lane == nts) ? (int)(unsigned)(_c >> 32) : ts_hi; ++nts; } } while (0)
    PG8_STAMP();
    unsigned voffA[2], voffB[2];
#pragma unroll
    for (int i = 0; i < 2; ++i) { int R, C; stage_rc(tid * 16 + i * 8192, R, C); const int Rb = Epi::PERM ? ((R & ~31) + perm32(R & 31)) : R;
        voffA[i] = (unsigned)(R * K + C) * 2u; voffB[i] = (unsigned)(Rb * K + C) * 2u; }
    const size_t kstep = (size_t)(BK * 2);
    const size_t hstep = (size_t)HALF * K * 2;
    const size_t tstep = 2 * hstep;
    const unsigned ldsw = (unsigned)wid * 1024u;
    const int aoff = lds_byte(wr * 64 + fr, fq * 8), boff = lds_byte(wc * 32 + fr, fq * 8);
#define PG8_SA(b, h) (((b) * 2 + (h)) * HTB)
#define PG8_SB(b, h) ((4 + (b) * 2 + (h)) * HTB)
#define PG8_STAGE(bufoff, gbase, voff) do { _Pragma("unroll") for (int _i = 0; _i < 2; ++_i) \
        __builtin_amdgcn_global_load_lds((const unsigned*)((const char*)(gbase) + (voff)[_i]), (PG8_LAS unsigned*)(lds + (bufoff) + ldsw + _i * 8192), 16, 0, 0); } while (0)
#define PG8_LDA(dst, b, h) do { _Pragma("unroll") for (int m = 0; m < 4; ++m) _Pragma("unroll") for (int k = 0; k < 2; ++k) dst[m][k] = *(const PG8_LAS bf16x8*)(lds + PG8_SA(b, h) + aoff + m * 2048 + k * 1024); } while (0)
#define PG8_LDB(dst, b, h) do { _Pragma("unroll") for (int n = 0; n < 2; ++n) _Pragma("unroll") for (int k = 0; k < 2; ++k) dst[n][k] = *(const PG8_LAS bf16x8*)(lds + PG8_SB(b, h) + boff + n * 2048 + k * 1024); } while (0)
#define PG8_MMA(ai, bj, At, Bt) do { __builtin_amdgcn_s_setprio(1); _Pragma("unroll") for (int m = 0; m < 4; ++m) _Pragma("unroll") for (int n = 0; n < 2; ++n) _Pragma("unroll") for (int k = 0; k < 2; ++k) \
        acc[ai][bj][m][n] = __builtin_amdgcn_mfma_f32_16x16x32_bf16(Bt[n][k], At[m][k], acc[ai][bj][m][n], 0, 0, 0); __builtin_amdgcn_s_setprio(0); } while (0)
#define PG8_WAIT_V(n) asm volatile("s_waitcnt vmcnt(" #n ")" ::: "memory")
#define PG8_WAIT_L(n) asm volatile("s_waitcnt lgkmcnt(" #n ")" ::: "memory")
#define PG8_BAR __builtin_amdgcn_s_barrier()
#define PG8_SCHED __builtin_amdgcn_sched_barrier(0)
    Unit cur, nxt; int ui = 0;
    if (!S.next(0, cur)) return;
    f32x4 acc[2][2][4][2];
#pragma unroll
    for (int a = 0; a < 2; ++a)
#pragma unroll
        for (int b = 0; b < 2; ++b)
#pragma unroll
            for (int m = 0; m < 4; ++m)
#pragma unroll
                for (int n = 0; n < 2; ++n) acc[a][b][m][n] = (f32x4){0.f, 0.f, 0.f, 0.f};
    bf16x8 At[4][2], B0[2][2], B1[2][2];
    const char* cA = (const char*)g.A + (size_t)cur.pm * tstep; const char* cB = (const char*)g.Bt + (size_t)cur.pn * tstep;
    S.a_ready(cur);
    PG8_STAGE(PG8_SB(0, 0), cB, voffB); PG8_STAGE(PG8_SA(0, 0), cA, voffA); PG8_STAGE(PG8_SB(0, 1), cB + hstep, voffB); PG8_STAGE(PG8_SA(0, 1), cA + hstep, voffA);
    if (wr == 1) PG8_BAR;
    PG8_WAIT_V(4); PG8_BAR;
    PG8_STAGE(PG8_SB(1, 0), cB + kstep, voffB); PG8_STAGE(PG8_SA(1, 0), cA + kstep, voffA); PG8_STAGE(PG8_SB(1, 1), cB + hstep + kstep, voffB);
    PG8_WAIT_V(6); PG8_BAR;
    PG8_STAMP();
    for (;;) {
        const bool has_next = S.next(ui + 1, nxt);
        const char* nA = has_next ? (const char*)g.A + (size_t)nxt.pm * tstep : cA; const char* nB = has_next ? (const char*)g.Bt + (size_t)nxt.pn * tstep : cB;
        for (int t = 0; t < nt; t += 2) {
            const bool last = (t == nt - 2);
            const char* a1 = cA + (size_t)(t + 1) * kstep;
            const char* a2 = last ? nA : cA + (size_t)(t + 2) * kstep; const char* b2 = last ? nB : cB + (size_t)(t + 2) * kstep;
            const char* a3 = a2 + kstep; const char* b3 = b2 + kstep;
            if (last && has_next) S.a_ready(nxt);
            PG8_LDB(B0, 0, 0); PG8_SCHED; PG8_LDA(At, 0, 0); PG8_STAGE(PG8_SA(1, 1), a1 + hstep, voffA);
            PG8_WAIT_L(8); PG8_BAR; PG8_WAIT_L(0); PG8_MMA(0, 0, At, B0); PG8_BAR; PG8_SCHED;
            PG8_LDB(B1, 0, 1); PG8_STAGE(PG8_SB(0, 0), b2, voffB);
            PG8_BAR; PG8_WAIT_L(0); PG8_MMA(0, 1, At, B1); PG8_BAR;
            PG8_LDA(At, 0, 1); PG8_STAGE(PG8_SA(0, 0), a2, voffA);
            PG8_BAR; PG8_WAIT_L(0); PG8_MMA(1, 0, At, B0); PG8_BAR; PG8_SCHED;
            PG8_STAGE(PG8_SB(0, 1), b2 + hstep, voffB);
            PG8_WAIT_V(6); PG8_BAR; PG8_MMA(1, 1, At, B1); PG8_BAR;
            PG8_LDB(B0, 1, 0); PG8_SCHED; PG8_LDA(At, 1, 0); PG8_STAGE(PG8_SA(0, 1), a2 + hstep, voffA);
            PG8_WAIT_L(8); PG8_BAR; PG8_WAIT_L(0); PG8_MMA(0, 0, At, B0); PG8_BAR; PG8_SCHED;
            PG8_LDB(B1, 1, 1); PG8_STAGE(PG8_SB(1, 0), b3, voffB);
            PG8_BAR; PG8_WAIT_L(0); PG8_MMA(0, 1, At, B1); PG8_BAR;
            PG8_LDA(At, 1, 1); PG8_STAGE(PG8_SA(1, 0), a3, voffA);
            PG8_BAR; PG8_WAIT_L(0); PG8_MMA(1, 0, At, B0); PG8_BAR; PG8_SCHED;
            PG8_STAGE(PG8_SB(1, 1), b3 + hstep, voffB);
            PG8_WAIT_V(6); PG8_BAR; PG8_MMA(1, 1, At, B1); PG8_BAR;
        }
        PG8_STAMP();
        if constexpr (!Epi::AFTER_DRAIN) { E(acc, cur, wr, wc, fr, fq); S.done(cur); }
        PG8_STAMP();
        if (!has_next) break;
        bool zero_acc = true; if constexpr (epi_keep<Epi>::value) zero_acc = !E.keep(cur);
        if (zero_acc) {
#pragma unroll
        for (int a = 0; a < 2; ++a)
#pragma unroll
            for (int b = 0; b < 2; ++b)
#pragma unroll
                for (int m = 0; m < 4; ++m)
#pragma unroll
                    for (int n = 0; n < 2; ++n) acc[a][b][m][n] = (f32x4){0.f, 0.f, 0.f, 0.f}; }
        cur = nxt; cA = nA; cB = nB; ++ui;
    }
    PG8_WAIT_V(0);
    if (wr == 0) PG8_BAR;
    PG8_BAR;
    if constexpr (Epi::AFTER_DRAIN) { E.fused(acc, cur, wr, wc, fr, fq, lds, wid, lane); S.done(cur); }
    PG8_STAMP();
    if (STAMP && wid == 0) { stamps[lane] = lane < nts ? (((unsigned long long)(unsigned)ts_hi << 32) | (unsigned)ts_lo) : 0ull;
        if (lane == 62) stamps[62] = rt_entry; if (lane == 63) stamps[63] = (unsigned long long)wall_clock64(); }
#undef PG8_STAMP
#undef PG8_SA
#undef PG8_SB
#undef PG8_STAGE
#undef PG8_LDA
#undef PG8_LDB
#undef PG8_MMA
#undef PG8_WAIT_V
#undef PG8_WAIT_L
#undef PG8_BAR
#undef PG8_SCHED
}
}

#define XB_TMO      128
#define XB_XCNT(j)  (256  + 64 * (j))
#define XB_XSUB(j)  (1280 + 64 * (j))
#define XB_XGEN(j)  (2304 + 64 * (j))
#define XB_TOP      3328
#define XB_TOPGEN   3392
#define XCD_BAR_WORDS 3456
#define XB_SPIN_CAP (1u << 18)
#define LAS __attribute__((address_space(3)))

__device__ __forceinline__ unsigned xb_ld(unsigned* p)              { return __hip_atomic_load(p, __ATOMIC_RELAXED, __HIP_MEMORY_SCOPE_AGENT); }
__device__ __forceinline__ unsigned xb_add(unsigned* p, unsigned v) { return __hip_atomic_fetch_add(p, v, __ATOMIC_RELAXED, __HIP_MEMORY_SCOPE_AGENT); }
__device__ __forceinline__ unsigned xb_xcc_id() { return (unsigned)__builtin_amdgcn_s_getreg((3 << 11) | 20) & 0xFu; }
#define XB_SPIN(cond, bar) do { unsigned _sp = 0; while (cond) { __builtin_amdgcn_s_sleep(1); \
    if ((++_sp & 255u) == 0u) { if (xb_ld(&(bar)[XB_TMO])) break; if (_sp > XB_SPIN_CAP) { atomicAdd(&(bar)[XB_TMO], 1u); break; } } } } while (0)

struct XcdBarrier {
    unsigned* bar; unsigned x;
    volatile LAS unsigned* st;
};

__device__ __forceinline__ XcdBarrier xcd_barrier_post(unsigned* bar, volatile LAS unsigned* st) {
    XcdBarrier b; b.bar = bar; b.x = xb_xcc_id(); b.st = st;
    if (threadIdx.x == 0) (void)xb_add(&bar[XB_XCNT(b.x)], 1u);
    return b;
}
__device__ __forceinline__ void xcd_barrier_complete(unsigned* bar, unsigned x, unsigned& nloc, unsigned& nx) {
    const unsigned G = gridDim.x * gridDim.y * gridDim.z;
    unsigned sum, cnt, mine, sp = 0u;
    for (;;) {
        sum = 0u; cnt = 0u; mine = 0u;
#pragma unroll
        for (unsigned j = 0; j < 16; ++j) { const unsigned c = xb_ld(&bar[XB_XCNT(j)]); sum += c; cnt += (c > 0u) ? 1u : 0u; mine = (j == x) ? c : mine; }
        if (sum == G) break;
        __builtin_amdgcn_s_sleep(1);
        if ((++sp & 255u) == 0u) { if (xb_ld(&bar[XB_TMO])) break; if (sp > XB_SPIN_CAP) { atomicAdd(&bar[XB_TMO], 1u); break; } }
    }
    nloc = mine > 0u ? mine : 1u; nx = cnt > 0u ? cnt : 1u;
}

__device__ __forceinline__ void xcd_barrier(const XcdBarrier& b) {
    asm volatile("s_waitcnt vmcnt(0)" ::: "memory");
    __syncthreads();
    if (threadIdx.x == 0) {
        unsigned* bar = b.bar;
        __builtin_amdgcn_s_waitcnt(0);
        unsigned nloc = b.st[0], nx = b.st[1];
        if (nloc == 0u) { xcd_barrier_complete(bar, b.x, nloc, nx); b.st[0] = nloc; b.st[1] = nx; }
        const unsigned old = xb_add(&bar[XB_XSUB(b.x)], 1u);
        const unsigned gen = old / nloc;
        if (old + 1u == (gen + 1u) * nloc) {
            __builtin_amdgcn_fence(__ATOMIC_RELEASE, "agent");
            asm volatile("s_waitcnt vmcnt(0)" ::: "memory");
            const unsigned og = xb_add(&bar[XB_TOP], 1u);
            const unsigned tg = og / nx;
            if (og + 1u == (tg + 1u) * nx) xb_add(&bar[XB_TOPGEN], 1u);
            else XB_SPIN(xb_ld(&bar[XB_TOPGEN]) == tg, bar);
            __builtin_amdgcn_fence(__ATOMIC_ACQUIRE, "agent");
            xb_add(&bar[XB_XGEN(b.x)], 1u);
            asm volatile("s_waitcnt vmcnt(0)" ::: "memory");
        } else {
            XB_SPIN(xb_ld(&bar[XB_XGEN(b.x)]) == gen, bar);
            __builtin_amdgcn_fence(__ATOMIC_ACQUIRE, "agent");
            asm volatile("s_waitcnt vmcnt(0)" ::: "memory");
        }
    }
    __syncthreads();
}

#else
namespace pg8 {
typedef unsigned short bf16_t;
typedef float f32x4 __attribute__((ext_vector_type(4)));
typedef unsigned u32x4 __attribute__((ext_vector_type(4)));
constexpr int BM = 256, BK = 64, HALF = 128, NXCD = 8, WGM = 8;
struct Unit { int pm, pn; };
struct Gemm { const bf16_t* A; const bf16_t* Bt; int M, N, K; };
template <class E, class = void> struct epi_keep { static constexpr bool value = false; };
template <class E> struct epi_keep<E, decltype((void)E::KEEP_ACC)> { static constexpr bool value = true; };
struct StaticOrder {
    int nM, nN, nwg, G, c;
    void init(int M, int N, int G_, int c_) { nM = M / BM; nN = N / BM; nwg = nM * nN; G = G_; c = c_; }
    bool next(int i, Unit& u) const {
        const long L = (long)i * G + c; if (L >= nwg) return false;
        int wgid = (int)L; { const int q = nwg / NXCD, r = nwg % NXCD, xcd = wgid % NXCD, off = wgid / NXCD; wgid = (xcd < r ? xcd * (q + 1) : r * (q + 1) + (xcd - r) * q) + off; }
        const int nig = WGM * nN, gid = wgid / nig, fm = gid * WGM, gsz = (nM - fm) < WGM ? (nM - fm) : WGM;
        u.pm = fm + ((wgid % nig) % gsz); u.pn = (wgid % nig) / gsz; return true;
    }
    void a_ready(const Unit&) const {}
    void done(const Unit&) const {}
};
static inline unsigned cvt_pk_bf16(float lo, float hi) { return pk2(lo, hi); }
static float* emu_tile_buf(int b) { static std::vector<std::vector<float>> t; if ((int)t.size() <= b) t.resize(b + 1); if (t[b].empty()) t[b].resize(256 * 256); return t[b].data(); }
template <class Epi, class Sched, bool STAMP = false>
void gemm_phase(unsigned char* lds, const Gemm g, const Sched& S, const Epi& E, unsigned long long* stamps) {
    const int tid = threadIdx.x, wid = tid >> 6, lane = tid & 63, wr = wid >> 2, wc = wid & 3, fr = lane & 15, fq = lane >> 4;
    float* tile = emu_tile_buf(blockIdx.x);
    Unit u; f32x4 acc[2][2][4][2]; bool keep_next = false;
    for (int ui = 0; S.next(ui, u); ++ui) {
        __syncthreads();
        if (tid == 0) {
            std::vector<float> a((size_t)256 * g.K), b((size_t)256 * g.K);
            for (int r = 0; r < 256; ++r) for (int k = 0; k < g.K; ++k) { a[(size_t)r * g.K + k] = bf2f(g.A[((size_t)u.pm * 256 + r) * g.K + k]); b[(size_t)r * g.K + k] = bf2f(g.Bt[((size_t)u.pn * 256 + r) * g.K + k]); }
            for (int r = 0; r < 256; ++r) for (int c = 0; c < 256; ++c) { const float* ar = &a[(size_t)r * g.K]; const float* br = &b[(size_t)c * g.K]; float s = 0.f; for (int k = 0; k < g.K; ++k) s += ar[k] * br[k]; tile[r * 256 + c] = s; }
        }
        __syncthreads();
        if (!keep_next) for (int ai = 0; ai < 2; ++ai) for (int bj = 0; bj < 2; ++bj) for (int m = 0; m < 4; ++m) for (int n = 0; n < 2; ++n) acc[ai][bj][m][n] = (f32x4){0.f, 0.f, 0.f, 0.f};
        for (int ai = 0; ai < 2; ++ai) for (int bj = 0; bj < 2; ++bj) for (int m = 0; m < 4; ++m) for (int n = 0; n < 2; ++n) for (int j = 0; j < 4; ++j) {
            const int r = 128 * ai + 64 * wr + 16 * m + fr;
            const int c = Epi::PERM ? (128 * bj + 32 * wc + 8 * fq + 4 * n + j) : (128 * bj + 32 * wc + 16 * n + 4 * fq + j);
            acc[ai][bj][m][n][j] += tile[r * 256 + c];
        }
        E(acc, u, wr, wc, fr, fq); S.done(u);
        if constexpr (epi_keep<Epi>::value) keep_next = E.keep(u); else keep_next = false;
        __syncthreads();
    }
}
}
#endif
namespace pg8 {
#ifdef HOST_EMU
#define EPI_FENCE() do {} while (0)
#else
#define EPI_FENCE() asm volatile("" ::: "memory")
#endif
__device__ __forceinline__ u32x4 pack8(const f32x4 v0, const f32x4 v1) { u32x4 w; w.x = cvt_pk_bf16(v0[0], v0[1]); w.y = cvt_pk_bf16(v0[2], v0[3]); w.z = cvt_pk_bf16(v1[0], v1[1]); w.w = cvt_pk_bf16(v1[2], v1[3]); return w; }
__device__ __forceinline__ void unpack8(const u32x4 w, f32x4& v0, f32x4& v1) { v0 = (f32x4){lo_bf(w.x), hi_bf(w.x), lo_bf(w.y), hi_bf(w.y)}; v1 = (f32x4){lo_bf(w.z), hi_bf(w.z), lo_bf(w.w), hi_bf(w.w)}; }
__device__ __forceinline__ f32x4 sig4(const f32x4 v) { return (f32x4){sigm(v[0]), sigm(v[1]), sigm(v[2]), sigm(v[3])}; }

struct EpiProj {
    static constexpr bool PERM = true, AFTER_DRAIN = false;
    unsigned char* ws;
    __device__ __forceinline__ void operator()(const f32x4 (&acc)[2][2][4][2], const Unit& u, int wr, int wc, int fr, int fq) const {
        const int pn = u.pn; size_t off; int ld, c0;
        if (pn < 2) { off = WS_Z; ld = 512; c0 = pn * 256; }
        else if (pn < 5) { off = WS_XBC; ld = 768; c0 = (pn - 2) * 256; }
        else if (pn < 7) { off = WS_Q; ld = 512; c0 = (pn - 5) * 256; }
        else if (pn < 9) { off = WS_K; ld = 512; c0 = (pn - 7) * 256; }
        else if (pn < 11) { off = WS_V; ld = 512; c0 = (pn - 9) * 256; }
        else if (pn < 18) { off = WS_RW; ld = 1792; c0 = (pn - 11) * 256; }
        else if (pn < 20) { off = WS_U; ld = 512; c0 = (pn - 18) * 256; }
        else { off = WS_SM; ld = 256; c0 = 0; }
        bf16_t* dst = (bf16_t*)(ws + off);
        const int row0 = u.pm * BM + wr * 64 + fr, col0 = c0 + wc * 32 + 8 * fq;
        const int kic = HALF + wc * 32 + 8 * fq - 136;
        const bool ki = (pn == 20) && kic >= 0 && kic < 32;
#pragma unroll
        for (int ai = 0; ai < 2; ++ai)
#pragma unroll
            for (int m = 0; m < 4; ++m) { const size_t row = (size_t)(row0 + ai * HALF + m * 16); bf16_t* rowp = dst + row * ld + col0;
#pragma unroll
                for (int bj = 0; bj < 2; ++bj) { const u32x4 w = pack8(acc[ai][bj][m][0], acc[ai][bj][m][1]); *(u32x4*)(rowp + bj * HALF) = w;
                    if (bj == 1 && ki) *(u32x4*)((bf16_t*)(ws + WS_KI) + row * 32 + kic) = w; } }
    }
};
struct EpiGate {
    static constexpr bool PERM = true, AFTER_DRAIN = false;
    bf16_t* G;
    __device__ __forceinline__ void operator()(const f32x4 (&acc)[2][2][4][2], const Unit& u, int wr, int wc, int fr, int fq) const {
        const int row0 = u.pm * BM + wr * 64 + fr, col0 = u.pn * BM + wc * 32 + 8 * fq;
#pragma unroll
        for (int ai = 0; ai < 2; ++ai)
#pragma unroll
            for (int m = 0; m < 4; ++m) { bf16_t* rowp = G + (size_t)(row0 + ai * HALF + m * 16) * 4096 + col0;
#pragma unroll
                for (int bj = 0; bj < 2; ++bj) *(u32x4*)(rowp + bj * HALF) = pack8(sig4(acc[ai][bj][m][0]), sig4(acc[ai][bj][m][1])); }
    }
};
struct EpiMerge {
    static constexpr bool PERM = true, AFTER_DRAIN = false, KEEP_ACC = true;
    const bf16_t* G; bf16_t* MRG;
    __device__ __forceinline__ bool keep(const Unit& u) const { return (u.pn >> 2) < 3; }
    __device__ __forceinline__ void operator()(f32x4 (&acc)[2][2][4][2], const Unit& u, int wr, int wc, int fr, int fq) const {
        const int n = u.pn >> 2, pn = u.pn & 3, pm = u.pm - n * (MG / 256);
        const int row0 = pm * BM + wr * 64 + fr, col0 = pn * BM + wc * 32 + 8 * fq;
#pragma unroll
        for (int ai = 0; ai < 2; ++ai)
#pragma unroll
            for (int mp = 0; mp < 2; ++mp) { u32x4 ga[2][2], gb[2][2];
#pragma unroll
                for (int mm = 0; mm < 2; ++mm)
#pragma unroll
                    for (int bj = 0; bj < 2; ++bj) { const bf16_t* gp = G + (size_t)(row0 + ai * HALF + (2 * mp + mm) * 16) * 4096 + n * 1024 + col0 + bj * HALF; ga[mm][bj] = *(const u32x4*)gp; if (n < 3) gb[mm][bj] = *(const u32x4*)(gp + 1024); }
#pragma unroll
                for (int mm = 0; mm < 2; ++mm)
#pragma unroll
                    for (int bj = 0; bj < 2; ++bj) { const int m = 2 * mp + mm; f32x4 a0, a1; unpack8(ga[mm][bj], a0, a1);
                        if (n < 3) { f32x4 b0, b1; unpack8(gb[mm][bj], b0, b1);
#pragma unroll
                            for (int j = 0; j < 4; ++j) { acc[ai][bj][m][0][j] *= fmaxf(a0[j], 1e-6f) * __builtin_amdgcn_rcpf(fmaxf(b0[j], 1e-6f)); acc[ai][bj][m][1][j] *= fmaxf(a1[j], 1e-6f) * __builtin_amdgcn_rcpf(fmaxf(b1[j], 1e-6f)); } }
                        else {
#pragma unroll
                            for (int j = 0; j < 4; ++j) { a0[j] = fmaxf(a0[j], 1e-6f); a1[j] = fmaxf(a1[j], 1e-6f); }
                            *(u32x4*)(MRG + (size_t)(row0 + ai * HALF + m * 16) * 1024 + col0 + bj * HALF) = pack8(acc[ai][bj][m][0] * a0, acc[ai][bj][m][1] * a1); } }
                EPI_FENCE(); }
    }
};
struct MergeOrder {
    int G, c;
    __device__ __forceinline__ bool next(int i, Unit& u) const {
        const int tile = (i >> 2) * G + c, n = i & 3; if (tile >= (MG / 256) * 4) return false;
        u.pm = n * (MG / 256) + (tile >> 2); u.pn = n * 4 + (tile & 3); return true;
    }
    __device__ __forceinline__ void a_ready(const Unit&) const {}
    __device__ __forceinline__ void done(const Unit&) const {}
};
struct EpiResid {
    static constexpr bool PERM = false, AFTER_DRAIN = false;
    const float* base; float* out;
    __device__ __forceinline__ void operator()(const f32x4 (&acc)[2][2][4][2], const Unit& u, int wr, int wc, int fr, int fq) const {
        const int row0 = u.pm * BM + wr * 64 + fr, col0 = u.pn * BM + wc * 32 + 4 * fq;
#pragma unroll
        for (int ai = 0; ai < 2; ++ai) {
            f32x4 bv[4][2][2];
#pragma unroll
            for (int m = 0; m < 4; ++m)
#pragma unroll
                for (int bj = 0; bj < 2; ++bj)
#pragma unroll
                    for (int n = 0; n < 2; ++n) bv[m][bj][n] = *(const f32x4*)(base + (size_t)(row0 + ai * HALF + m * 16) * 1024 + col0 + bj * HALF + n * 16);
#pragma unroll
            for (int m = 0; m < 4; ++m)
#pragma unroll
                for (int bj = 0; bj < 2; ++bj)
#pragma unroll
                    for (int n = 0; n < 2; ++n) *(f32x4*)(out + (size_t)(row0 + ai * HALF + m * 16) * 1024 + col0 + bj * HALF + n * 16) = bv[m][bj][n] + acc[ai][bj][m][n];
            EPI_FENCE(); }
    }
};
struct EpiSwiglu {
    static constexpr bool PERM = true, AFTER_DRAIN = false;
    bf16_t* HID;
    __device__ __forceinline__ void operator()(const f32x4 (&acc)[2][2][4][2], const Unit& u, int wr, int wc, int fr, int fq) const {
        const int row0 = u.pm * BM + wr * 64 + fr, col0 = u.pn * HALF + wc * 32 + 8 * fq;
#pragma unroll
        for (int ai = 0; ai < 2; ++ai)
#pragma unroll
            for (int m = 0; m < 4; ++m) { f32x4 v[2];
#pragma unroll
                for (int n = 0; n < 2; ++n) { const f32x4 a = acc[ai][0][m][n], b = acc[ai][1][m][n]; v[n] = a * sig4(a) * b; }
                *(u32x4*)(HID + (size_t)(row0 + ai * HALF + m * 16) * FFN + col0) = pack8(v[0], v[1]); }
    }
};
struct EpiGlu {
    static constexpr bool PERM = true, AFTER_DRAIN = false;
    const bf16_t* Y0; bf16_t* OUT; const float* bias;
    __device__ __forceinline__ void operator()(const f32x4 (&acc)[2][2][4][2], const Unit& u, int wr, int wc, int fr, int fq) const {
        const int row0 = u.pm * BM + wr * 64 + fr, col0 = u.pn * BM + wc * 32 + 8 * fq;
#pragma unroll
        for (int ai = 0; ai < 2; ++ai)
#pragma unroll
            for (int m = 0; m < 4; ++m) { const size_t row = (size_t)(row0 + ai * HALF + m * 16);
#pragma unroll
                for (int bj = 0; bj < 2; ++bj) { const int col = col0 + bj * HALF;
                    f32x4 y0, y1; unpack8(*(const u32x4*)(Y0 + row * 512 + col), y0, y1);
                    const f32x4 b0 = *(const f32x4*)(bias + col), b1 = *(const f32x4*)(bias + col + 4);
                    *(u32x4*)(OUT + row * 512 + col) = pack8(y0 * sig4(acc[ai][bj][m][0] + b0), y1 * sig4(acc[ai][bj][m][1] + b1)); }
                EPI_FENCE(); }
    }
};
__device__ __forceinline__ float logdecay(float x) { return -0.6065306597f * sigm(x); }
struct EpiLora {
    static constexpr bool PERM = true, AFTER_DRAIN = false;
    float* WLOG; bf16_t* ASIG; bf16_t* GG; const float* w0; const float* a0;
    __device__ __forceinline__ void operator()(const f32x4 (&acc)[2][2][4][2], const Unit& u, int wr, int wc, int fr, int fq) const {
        const int kind = u.pn >> 1, row0 = u.pm * BM + wr * 64 + fr, col0 = (u.pn & 1) * BM + wc * 32 + 8 * fq;
        if (kind == 0) {
            f32x4 b[2][2];
#pragma unroll
            for (int bj = 0; bj < 2; ++bj) { b[bj][0] = *(const f32x4*)(w0 + col0 + bj * HALF); b[bj][1] = *(const f32x4*)(w0 + col0 + bj * HALF + 4); }
#pragma unroll
            for (int ai = 0; ai < 2; ++ai)
#pragma unroll
                for (int m = 0; m < 4; ++m)
#pragma unroll
                    for (int bj = 0; bj < 2; ++bj)
#pragma unroll
                        for (int n = 0; n < 2; ++n) { const f32x4 x = acc[ai][bj][m][n] + b[bj][n];
                            *(f32x4*)(WLOG + (size_t)(row0 + ai * HALF + m * 16) * 512 + col0 + bj * HALF + 4 * n) = (f32x4){logdecay(x[0]), logdecay(x[1]), logdecay(x[2]), logdecay(x[3])}; }
        } else if (kind == 1) {
            f32x4 b[2][2];
#pragma unroll
            for (int bj = 0; bj < 2; ++bj) { b[bj][0] = *(const f32x4*)(a0 + col0 + bj * HALF); b[bj][1] = *(const f32x4*)(a0 + col0 + bj * HALF + 4); }
#pragma unroll
            for (int ai = 0; ai < 2; ++ai)
#pragma unroll
                for (int m = 0; m < 4; ++m)
#pragma unroll
                    for (int bj = 0; bj < 2; ++bj)
                        *(u32x4*)(ASIG + (size_t)(row0 + ai * HALF + m * 16) * 512 + col0 + bj * HALF) = pack8(sig4(acc[ai][bj][m][0] + b[bj][0]), sig4(acc[ai][bj][m][1] + b[bj][1]));
        } else {
#pragma unroll
            for (int ai = 0; ai < 2; ++ai)
#pragma unroll
                for (int m = 0; m < 4; ++m)
#pragma unroll
                    for (int bj = 0; bj < 2; ++bj)
                        *(u32x4*)(GG + (size_t)(row0 + ai * HALF + m * 16) * 512 + col0 + bj * HALF) = pack8(acc[ai][bj][m][0], acc[ai][bj][m][1]);
        }
    }
};
}
typedef short bf16x8_t __attribute__((ext_vector_type(8)));
typedef float f32x16 __attribute__((ext_vector_type(16)));
typedef float f32x4_t __attribute__((ext_vector_type(4)));
__device__ __forceinline__ bf16x8_t frag2(const u32x2 lo, const u32x2 hi) { u32x4 w; w.x = lo.x; w.y = lo.y; w.z = hi.x; w.w = hi.y; return __builtin_bit_cast(bf16x8_t, w); }
struct Args { const float* in[N_IN]; float* out; unsigned char* ws; int seg_lo, seg_hi; };
#ifdef HOST_EMU
typedef const Args* KArgs;
#define KLAUNDER(p) (p)
__device__ __forceinline__ int fresh_tid() { return (int)threadIdx.x; }
#else
typedef const __attribute__((address_space(4))) Args* KArgs;
__device__ __forceinline__ KArgs klaunder(KArgs p) { asm volatile("" : "+s"(p)); return p; }
#define KLAUNDER(p) klaunder(p)
__device__ __forceinline__ int fresh_tid() { int t = (int)threadIdx.x; asm volatile("" : "+v"(t)); return t; }
#endif
#define WSP(T, off) ((T*)(C->ws + (off)))

template <class Src>
__device__ __forceinline__ void transpose_item(const Src& S, int K, bf16* WT, float* scr, int item, int lane) {
    const int nblk = S.ndst / 32, kb = item / nblk, nb = item % nblk, k0 = 64 * kb, n0 = 32 * nb;
    const float* cp = S.col(n0 + (lane & 31)); const int ld = S.ld;
#pragma unroll 8
    for (int i = 0; i < 32; ++i) { const int kk = 2 * i + (lane >> 5); scr[kk * 33 + (lane & 31)] = cp ? cp[(size_t)(k0 + kk) * ld] : 0.f; }
    WAVE_SYNC();
    const int c = lane & 7;
#pragma unroll
    for (int j = 0; j < 4; ++j) { const int n = (lane >> 3) + 8 * j; const float* s = scr + (8 * c) * 33 + n;
        u32x4 o; o.x = pk2(s[0 * 33], s[1 * 33]); o.y = pk2(s[2 * 33], s[3 * 33]); o.z = pk2(s[4 * 33], s[5 * 33]); o.w = pk2(s[6 * 33], s[7 * 33]);
        *(u32x4*)(WT + (size_t)(n0 + n) * K + k0 + 8 * c) = o; }
    WAVE_SYNC();
}
struct SrcWin { const float* w; int ndst, ld;
    __device__ __forceinline__ const float* col(int n) const {
        int s;
        if (n < 1280) s = n;
        else if (n < 2816) s = n + 8;
        else if (n < 4608) s = n - 2816 + 2988;
        else if (n < 5120) s = n - 4608 + 4780;
        else if (n < 5128) s = n - 5120 + 1280;
        else if (n < 5256) s = n - 5128 + 2824;
        else if (n < 5288) s = n - 5256 + 2952;
        else if (n < 5292) s = n - 5288 + 2984;
        else if (n < 5376) return nullptr;
        else s = n - 5376 + 5292;
        return w + s; } };
struct SrcPlain { const float* w; int ndst, ld; __device__ __forceinline__ const float* col(int n) const { return w + n; } };
struct SrcW13 { const float* w1; const float* w3; int ndst, ld;
    __device__ __forceinline__ const float* col(int n) const { const int pn = n >> 8, r = n & 255; return w1 + (r < 128 ? (ptrdiff_t)0 : (w3 - w1)) + pn * 128 + (r & 127); } };

__device__ __forceinline__ void phase_weights(KArgs C, int layer, unsigned char* lds, int gw, int ngw, int lane, int wave) {
    float* scr = (float*)(lds + wave * 16384); const size_t wo = (layer & 1) ? WDELTA : 0;
    constexpr int N_IN_ = 16 * (NPROJ / 32), N_BR = 8 * 32, N_OUT = 16 * 32, N_13 = 16 * (5632 / 32), N_2 = 44 * 32, N_GLU = 8 * 16;
    { const SrcWin s_in{C->in[I_WIN] + (size_t)layer * 1024 * IN_COLS, NPROJ, IN_COLS};
      for (int it = gw; it < N_IN_; it += ngw) transpose_item(s_in, 1024, WSP(bf16, WS_WIN + wo), scr, it, lane); }
    for (int it = gw; it < 4 * N_BR; it += ngw) { const int n = it / N_BR; const SrcPlain s_b{C->in[I_WBR] + ((size_t)layer * 4 + n) * 512 * 1024, 1024, 1024};
        transpose_item(s_b, 512, WSP(bf16, WS_WB + wo) + (size_t)n * 1024 * 512, scr, it % N_BR, lane); }
    { const SrcPlain s_out{C->in[I_WOUT] + (size_t)layer * 1024 * 1024, 1024, 1024};
      for (int it = gw; it < N_OUT; it += ngw) transpose_item(s_out, 1024, WSP(bf16, WS_WOUT + wo), scr, it, lane); }
    { const SrcW13 s_13{C->in[I_W1] + (size_t)layer * 1024 * FFN, C->in[I_W3] + (size_t)layer * 1024 * FFN, 5632, FFN};
      for (int it = gw; it < N_13; it += ngw) transpose_item(s_13, 1024, WSP(bf16, WS_W13 + wo), scr, it, lane); }
    { const SrcPlain s_2{C->in[I_W2F] + (size_t)layer * FFN * 1024, 1024, 1024};
      for (int it = gw; it < N_2; it += ngw) transpose_item(s_2, FFN, WSP(bf16, WS_W2 + wo), scr, it, lane); }
    { const SrcPlain s_glu{C->in[I_GLUW] + (size_t)layer * 512 * 512, 512, 512};
      for (int it = gw; it < N_GLU; it += ngw) transpose_item(s_glu, 512, WSP(bf16, WS_GLU + wo), scr, it, lane); }
    { const float* w2 = C->in[I_W2] + (size_t)layer * 64 * 512; const float* a2 = C->in[I_A2] + (size_t)layer * 64 * 512; const float* g2 = C->in[I_G2] + (size_t)layer * 128 * 512;
      bf16* WL = WSP(bf16, WS_WLORA + wo);
      for (int e = gw * 64 + lane; e < 1536 * 256; e += ngw * 64) { const int n = e >> 8, kc = e & 255; float v = 0.f;
          if (n < 512) { if (kc < 64) v = w2[kc * 512 + n]; } else if (n < 1024) { if (kc >= 64 && kc < 128) v = a2[(kc - 64) * 512 + (n - 512)]; } else { if (kc >= 128) v = g2[(kc - 128) * 512 + (n - 1024)]; }
          WL[e] = f2bf(v); } }
    const int gt = gw * 64 + lane, ngt = ngw * 64;
    for (int e = gt; e < 32 * 64; e += ngt) {
        const int g = e >> 6;
        const float ar = C->in[I_S5ARE][layer * 2048 + e], ai = C->in[I_S5AIM][layer * 2048 + e], dt = expf(C->in[I_S5LDT][layer * 32 + g]);
        const float mag = expf(ar * dt), abr = mag * cosf(ai * dt), abi = mag * sinf(ai * dt);
        const float den = ar * ar + ai * ai, nr = abr - 1.0f, ni = abi;
        const float qr = (nr * ar + ni * ai) / den, qi = (ni * ar - nr * ai) / den;
        float* ab = WSP(float, WS_ABAR + wo) + e * 2; ab[0] = abr; ab[1] = abi;
        float* bb = WSP(float, WS_BBAR + wo) + (size_t)e * 32;
        for (int j = 0; j < 16; ++j) { const float br = C->in[I_S5BRE][((size_t)layer * 2048 + e) * 16 + j], bi = C->in[I_S5BIM][((size_t)layer * 2048 + e) * 16 + j];
            bb[2 * j] = qr * br - qi * bi; bb[2 * j + 1] = qr * bi + qi * br; }
    }
    if (layer == 0) for (int e = gt; e < SEQ + 63; e += ngt) {
        const int rel = e - (SEQ - 1); const int n = rel < 0 ? -rel : rel; int b = rel > 0 ? 16 : 0;
        if (n < 8) b += n; else { int lg = 8 + (int)(logf((float)n / 8.0f) / 3.4657359028f * 8.0f); if (lg > 15) lg = 15; b += lg; }
        WSP(int, WS_TAB)[e] = b;
    }
}

__device__ __forceinline__ void rms_row_bf16(const float* xrow, const float* g, bf16* orow, int lane) {
    const f32x4* xr = (const f32x4*)xrow + lane; const f32x4* gr = (const f32x4*)g + lane;
    f32x4 v[4]; float s = 0.f;
#pragma unroll
    for (int j = 0; j < 4; ++j) { v[j] = xr[64 * j]; s += (v[j].x * v[j].x + v[j].y * v[j].y) + (v[j].z * v[j].z + v[j].w * v[j].w); }
    const float rstd = 1.0f / sqrtf(wave_sum(s) * (1.f / D) + RMS_EPS);
    u32x2* o8 = (u32x2*)orow + lane;
#pragma unroll
    for (int j = 0; j < 4; ++j) { const f32x4 gg = gr[64 * j]; u32x2 w; w.x = pk2(v[j].x * rstd * gg.x, v[j].y * rstd * gg.y); w.y = pk2(v[j].z * rstd * gg.z, v[j].w * rstd * gg.w); o8[64 * j] = w; }
}
template <int NR>
__device__ __forceinline__ void rms_rowN_bf16(const float* xrow, const float* g, bf16* orow, size_t step, int lane) {
    const f32x4* gr = (const f32x4*)g + lane; f32x4 v[NR][4]; float ss[NR];
#pragma unroll
    for (int q = 0; q < NR; ++q)
#pragma unroll
        for (int j = 0; j < 4; ++j) v[q][j] = ((const f32x4*)(xrow + q * step) + lane)[64 * j];
#pragma unroll
    for (int q = 0; q < NR; ++q) { float s = 0.f;
#pragma unroll
        for (int j = 0; j < 4; ++j) s += (v[q][j].x * v[q][j].x + v[q][j].y * v[q][j].y) + (v[q][j].z * v[q][j].z + v[q][j].w * v[q][j].w);
        ss[q] = s; }
#pragma unroll
    for (int o = 1; o < 64; o <<= 1)
#pragma unroll
        for (int q = 0; q < NR; ++q) ss[q] += __shfl_xor(ss[q], o);
#pragma unroll
    for (int q = 0; q < NR; ++q) { const float r = 1.0f / sqrtf(ss[q] * (1.f / D) + RMS_EPS); u32x2* o8 = (u32x2*)(orow + q * step) + lane;
#pragma unroll
        for (int j = 0; j < 4; ++j) { const f32x4 gg = gr[64 * j]; u32x2 w; w.x = pk2(v[q][j].x * r * gg.x, v[q][j].y * r * gg.y); w.y = pk2(v[q][j].z * r * gg.z, v[q][j].w * r * gg.w); o8[64 * j] = w; } }
}
__device__ __forceinline__ void rms_row_f32(float* xrow, const float* g, int lane) {
    f32x4* xr = (f32x4*)xrow + lane; const f32x4* gr = (const f32x4*)g + lane;
    f32x4 v[4]; float s = 0.f;
#pragma unroll
    for (int j = 0; j < 4; ++j) { v[j] = xr[64 * j]; s += (v[j].x * v[j].x + v[j].y * v[j].y) + (v[j].z * v[j].z + v[j].w * v[j].w); }
    const float rstd = 1.0f / sqrtf(wave_sum(s) * (1.f / D) + RMS_EPS);
#pragma unroll
    for (int j = 0; j < 4; ++j) xr[64 * j] = v[j] * rstd * gr[64 * j];
}

#ifdef HOST_EMU
__device__ __forceinline__ float red8(float v) { v += __shfl_xor(v, 1); v += __shfl_xor(v, 2); v += __shfl_xor(v, 4); return v; }
__device__ __forceinline__ float red16(float v) { v = red8(v); v += __shfl_xor(v, 8); return v; }
#else
template <int CTRL> __device__ __forceinline__ float dpp_f(float v) { return __builtin_bit_cast(float, __builtin_amdgcn_update_dpp(0, __builtin_bit_cast(int, v), CTRL, 0xf, 0xf, true)); }
__device__ __forceinline__ float red8(float v) { v += dpp_f<0xB1>(v); v += dpp_f<0x4E>(v); v += dpp_f<0x141>(v); return v; }
__device__ __forceinline__ float red16(float v) { v = red8(v); v += dpp_f<0x140>(v); return v; }
#endif
__device__ __forceinline__ f32x4 sig4g(const f32x4 v) { return (f32x4){sigm(v[0]), sigm(v[1]), sigm(v[2]), sigm(v[3])}; }
__device__ __forceinline__ void rms_row2_f32(float* xrow, size_t step, const float* g, int lane) {
    f32x4* xa = (f32x4*)xrow + lane; f32x4* xb = (f32x4*)(xrow + step) + lane; const f32x4* gr = (const f32x4*)g + lane;
    f32x4 va[4], vb[4]; float sa = 0.f, sb = 0.f;
#pragma unroll
    for (int j = 0; j < 4; ++j) { va[j] = xa[64 * j]; vb[j] = xb[64 * j]; }
#pragma unroll
    for (int j = 0; j < 4; ++j) { sa += (va[j].x * va[j].x + va[j].y * va[j].y) + (va[j].z * va[j].z + va[j].w * va[j].w); sb += (vb[j].x * vb[j].x + vb[j].y * vb[j].y) + (vb[j].z * vb[j].z + vb[j].w * vb[j].w); }
#pragma unroll
    for (int o = 1; o < 64; o <<= 1) { sa += __shfl_xor(sa, o); sb += __shfl_xor(sb, o); }
    const float ra = 1.0f / sqrtf(sa * (1.f / D) + RMS_EPS), rb = 1.0f / sqrtf(sb * (1.f / D) + RMS_EPS);
#pragma unroll
    for (int j = 0; j < 4; ++j) { const f32x4 gg = gr[64 * j]; xa[64 * j] = va[j] * ra * gg; xb[64 * j] = vb[j] * rb * gg; }
}
__device__ __forceinline__ void ssd_conv_row(KArgs C, int layer, int m, int lane) {
    const int t = m % SEQ; const float* cw = C->in[I_CONVW] + layer * 4 * 768; const float* cb = C->in[I_CONVB] + layer * 768;
#pragma unroll
    for (int i = 0; i < 3; ++i) { const int ch = i * 256 + lane * 4; const bf16* p = WSP(const bf16, WS_XBC) + (size_t)m * 768 + ch;
        f32x4 a = *(const f32x4*)(cb + ch);
#pragma unroll
        for (int q = 0; q < 4; ++q) if (t - 3 + q >= 0) { const u32x2 w = *(const u32x2*)(p - (3 - q) * 768); const f32x4 cq = *(const f32x4*)(cw + q * 768 + ch);
            a += cq * (f32x4){lo_bf(w.x), hi_bf(w.x), lo_bf(w.y), hi_bf(w.y)}; }
        a = a * sig4g(a);
        u32x2 o; o.x = pk2(a.x, a.y); o.y = pk2(a.z, a.w); *(u32x2*)(WSP(bf16, WS_XBA) + (size_t)m * 768 + ch) = o; }
}
__device__ __forceinline__ void ssd_conv_row2(KArgs C, int layer, int m, int step, int lane) {
    const float* cw = C->in[I_CONVW] + layer * 4 * 768; const float* cb = C->in[I_CONVB] + layer * 768;
    u32x2 w[2][3][4]; f32x4 cq[3][4], bb[3];
#pragma unroll
    for (int i = 0; i < 3; ++i) { const int ch = i * 256 + lane * 4; bb[i] = *(const f32x4*)(cb + ch);
#pragma unroll
        for (int q = 0; q < 4; ++q) { cq[i][q] = *(const f32x4*)(cw + q * 768 + ch);
#pragma unroll
            for (int r = 0; r < 2; ++r) { const int mm = m + r * step, t = mm % SEQ; const bf16* p = WSP(const bf16, WS_XBC) + (size_t)mm * 768 + ch;
                if (t - 3 + q >= 0) w[r][i][q] = *(const u32x2*)(p - (3 - q) * 768); else { w[r][i][q].x = 0u; w[r][i][q].y = 0u; } } } }
#pragma unroll
    for (int r = 0; r < 2; ++r)
#pragma unroll
        for (int i = 0; i < 3; ++i) { const int ch = i * 256 + lane * 4; f32x4 a = bb[i];
#pragma unroll
            for (int q = 0; q < 4; ++q) a += cq[i][q] * (f32x4){lo_bf(w[r][i][q].x), hi_bf(w[r][i][q].x), lo_bf(w[r][i][q].y), hi_bf(w[r][i][q].y)};
            a = a * sig4g(a);
            u32x2 o; o.x = pk2(a.x, a.y); o.y = pk2(a.z, a.w); *(u32x2*)(WSP(bf16, WS_XBA) + (size_t)(m + r * step) * 768 + ch) = o; }
}
__device__ __forceinline__ void ssd_unit(KArgs C, int layer, int unit, unsigned char* lds) {
    const int tid = fresh_tid(), lane = tid & 63, wave = tid >> 6, bl = unit >> 3, h = unit & 7, gi = h >> 2, pp = tid >> 3, c8 = (tid & 7) * 8, c16 = lane & 15, q = lane >> 4;
    bf16* Cb = (bf16*)lds; bf16* Bb = Cb + 4096; bf16* XT = Bb + 4096; bf16* BwT = XT + 4096; bf16* Pm = BwT + 4096; float* Yo = (float*)(Pm + 4096); float* dts = Yo + 8192; float* acs = dts + 128;
    const bf16* XA = WSP(const bf16, WS_XBA) + (size_t)bl * SEQ * 768 + (size_t)pp * 768 + c8;
    const bf16* SMp = WSP(const bf16, WS_SM) + (size_t)bl * SEQ * 256;
    const bf16* Zp = WSP(const bf16, WS_Z) + (size_t)bl * SEQ * 512 + (size_t)pp * 512 + h * 64 + c8;
    bf16* YA = WSP(bf16, WS_Y) + (size_t)bl * SEQ * 512 + (size_t)pp * 512 + h * 64 + c8;
    const float dtb = C->in[I_DTB][layer * 8 + h], A = -__expf(C->in[I_ALOG][layer * 8 + h]), Dh = C->in[I_SSDD][layer * 8 + h];
    f32x4_t Sd[2]; bf16x8_t Sf; Sd[0] = (f32x4_t){0.f, 0.f, 0.f, 0.f}; Sd[1] = Sd[0]; { u32x2 z; z.x = 0u; z.y = 0u; Sf = frag2(z, z); }
    const int pt = wave & 3, nh = wave >> 2;
    u32x4 fx, fb, fc, fz;
#define SSD_FETCH(c0_) do { const bf16* q_ = XA + (size_t)(c0_) * 768; fx = *(const u32x4*)(q_ + h * 64); fb = *(const u32x4*)(q_ + 512 + gi * 64); fc = *(const u32x4*)(q_ + 640 + gi * 64); fz = *(const u32x4*)(Zp + (size_t)(c0_) * 512); } while (0)
#define SSD_DT(c0_, par) do { if (wave == 0) { const float dt_ = softplusf(bf2f(SMp[(size_t)((c0_) + lane) * 256 + h]) + dtb); float a_ = A * dt_; \
        _Pragma("unroll") for (int o_ = 1; o_ < 64; o_ <<= 1) { const float t_ = __shfl_up(a_, o_); if (lane >= o_) a_ += t_; } dts[(par) * 64 + lane] = dt_; acs[(par) * 64 + lane] = a_; } } while (0)
    LDS_SYNC();
    SSD_FETCH(0); SSD_DT(0, 0);
    for (int c0 = 0, par = 0; c0 < SEQ; c0 += 64, par ^= 1) {
        LDS_SYNC();
        const u32x4 xk = fx, zk = fz;
        {
          const float dt = dts[par * 64 + pp], ea = __expf(acs[par * 64 + 63] - acs[par * 64 + pp]);
          *(u32x4*)(Cb + pp * 64 + c8) = fc; *(u32x4*)(Bb + pp * 64 + c8) = fb;
          f32x4 x0, x1, b0, b1; pg8::unpack8(fx, x0, x1); pg8::unpack8(fb, b0, b1); x0 = x0 * dt; x1 = x1 * dt; b0 = b0 * ea; b1 = b1 * ea;
#pragma unroll
          for (int i = 0; i < 4; ++i) { XT[(c8 + i) * 64 + pp] = f2bf(x0[i]); XT[(c8 + 4 + i) * 64 + pp] = f2bf(x1[i]); BwT[(c8 + i) * 64 + pp] = f2bf(b0[i]); BwT[(c8 + 4 + i) * 64 + pp] = f2bf(b1[i]); } }
        if (c0 + 64 < SEQ) { SSD_FETCH(c0 + 64); SSD_DT(c0 + 64, par ^ 1); }
        LDS_SYNC();
        {
          const f32x4_t z4 = {0.f, 0.f, 0.f, 0.f};
#pragma unroll
          for (int i = 0; i < 2; ++i) { const int id = wave + 8 * i, lt = id >> 2, st = id & 3; f32x4_t g = z4;
              if (st <= lt) {
#pragma unroll
                  for (int ks = 0; ks < 2; ++ks) g = __builtin_amdgcn_mfma_f32_16x16x32_bf16(*(const bf16x8_t*)(Cb + (16 * lt + c16) * 64 + 32 * ks + 8 * q), *(const bf16x8_t*)(Bb + (16 * st + c16) * 64 + 32 * ks + 8 * q), g, 0, 0, 0);
                  const float as_ = acs[par * 64 + 16 * st + c16];
#pragma unroll
                  for (int r = 0; r < 4; ++r) { const int l = 16 * lt + 4 * q + r; g[r] = (16 * st + c16 <= l) ? g[r] * __expf(acs[par * 64 + l] - as_) : 0.f; } }
#pragma unroll
              for (int r = 0; r < 4; ++r) Pm[(16 * lt + 4 * q + r) * 64 + 16 * st + c16] = f2bf(g[r]); }
#pragma unroll
          for (int lt = 0; lt < 4; ++lt) { const bf16* cr = Cb + (16 * lt + c16) * 64 + 32 * nh + 4 * q;
              const f32x4_t yo = __builtin_amdgcn_mfma_f32_16x16x32_bf16(frag2(*(const u32x2*)cr, *(const u32x2*)(cr + 16)), Sf, z4, 0, 0, 0);
#pragma unroll
              for (int r = 0; r < 4; ++r) Yo[nh * 4096 + (16 * lt + 4 * q + r) * 64 + 16 * pt + c16] = yo[r]; }
          const float eL = __expf(acs[par * 64 + 63]);
          const bf16x8_t xb0 = *(const bf16x8_t*)(XT + (16 * pt + c16) * 64 + 8 * q), xb1 = *(const bf16x8_t*)(XT + (16 * pt + c16) * 64 + 32 + 8 * q);
#pragma unroll
          for (int i = 0; i < 2; ++i) { const bf16* br = BwT + (16 * (2 * nh + i) + c16) * 64 + 8 * q; f32x4_t cin = Sd[i] * eL;
              cin = __builtin_amdgcn_mfma_f32_16x16x32_bf16(*(const bf16x8_t*)br, xb0, cin, 0, 0, 0); Sd[i] = __builtin_amdgcn_mfma_f32_16x16x32_bf16(*(const bf16x8_t*)(br + 32), xb1, cin, 0, 0, 0); }
          u32x2 lo, hi; lo.x = pk2(Sd[0][0], Sd[0][1]); lo.y = pk2(Sd[0][2], Sd[0][3]); hi.x = pk2(Sd[1][0], Sd[1][1]); hi.y = pk2(Sd[1][2], Sd[1][3]); Sf = frag2(lo, hi); }
        LDS_SYNC();
        {
          const f32x4_t z4 = {0.f, 0.f, 0.f, 0.f};
#pragma unroll
          for (int i = 0; i < 2; ++i) { const int id = wave + 8 * i, lt = id >> 2, p2 = id & 3;
              f32x4_t y = __builtin_amdgcn_mfma_f32_16x16x32_bf16(*(const bf16x8_t*)(Pm + (16 * lt + c16) * 64 + 8 * q), *(const bf16x8_t*)(XT + (16 * p2 + c16) * 64 + 8 * q), z4, 0, 0, 0);
              if (lt >= 2) y = __builtin_amdgcn_mfma_f32_16x16x32_bf16(*(const bf16x8_t*)(Pm + (16 * lt + c16) * 64 + 32 + 8 * q), *(const bf16x8_t*)(XT + (16 * p2 + c16) * 64 + 32 + 8 * q), y, 0, 0, 0);
#pragma unroll
              for (int r = 0; r < 4; ++r) { const int l = 16 * lt + 4 * q + r, o = l * 64 + 16 * p2 + c16; Yo[o] = y[r] + __expf(acs[par * 64 + l]) * (Yo[o] + Yo[4096 + o]); } } }
        LDS_SYNC();
        {
          f32x4 x0, x1, z0, z1; pg8::unpack8(xk, x0, x1); pg8::unpack8(zk, z0, z1);
          const f32x4 y0 = (*(const f32x4*)(Yo + pp * 64 + c8) + Dh * x0) * z0 * sig4g(z0), y1 = (*(const f32x4*)(Yo + pp * 64 + c8 + 4) + Dh * x1) * z1 * sig4g(z1);
          *(u32x4*)(YA + (size_t)c0 * 512) = pg8::pack8(y0, y1); }
    }
#undef SSD_FETCH
#undef SSD_DT
}
__device__ __forceinline__ void ssd_norm_item4(KArgs C, int layer, int item0, int stride, int nitems, int lane) {
    u32x2 w[4]; bf16* p[4];
#pragma unroll
    for (int q = 0; q < 4; ++q) { const int item = item0 + q * stride; p[q] = WSP(bf16, WS_Y) + (size_t)((item < nitems ? item : item0) >> 1) * 512 + ((item < nitems ? item : item0) & 1) * 256 + lane * 4; w[q] = *(const u32x2*)p[q]; }
#pragma unroll
    for (int q = 0; q < 4; ++q) { const int item = item0 + q * stride; if (item < nitems) {
        float v[4] = {lo_bf(w[q].x), hi_bf(w[q].x), lo_bf(w[q].y), hi_bf(w[q].y)};
        const float rstd = 1.0f / sqrtf(wave_sum(v[0] * v[0] + v[1] * v[1] + v[2] * v[2] + v[3] * v[3]) * (1.f / 256) + RMS_EPS);
        const float* g = C->in[I_SSDNG] + layer * 512 + (item & 1) * 256 + lane * 4;
        u32x2 o; o.x = pk2(v[0] * rstd * g[0], v[1] * rstd * g[1]); o.y = pk2(v[2] * rstd * g[2], v[3] * rstd * g[3]); *(u32x2*)p[q] = o; } }
}
__device__ __forceinline__ void rwkv_prep_row(KArgs C, int layer, int m, int lane) {
    const int t = m % SEQ, col = 1536 + lane * 4;
    const bf16* cur = WSP(const bf16, WS_RW) + (size_t)m * 1792 + col;
    const u32x2 wc = *(const u32x2*)cur; u32x2 wp; wp.x = 0u; wp.y = 0u; if (t > 0) wp = *(const u32x2*)(cur - 1792);
    const f32x4 mu = *(const f32x4*)(C->in[I_MU] + layer * 1792 + col);
    float v[4] = {lo_bf(wc.x), hi_bf(wc.x), lo_bf(wc.y), hi_bf(wc.y)}; const float p[4] = {lo_bf(wp.x), hi_bf(wp.x), lo_bf(wp.y), hi_bf(wp.y)};
#pragma unroll
    for (int i = 0; i < 4; ++i) { v[i] = v[i] + (p[i] - v[i]) * mu[i]; v[i] = lane < 16 ? tanhf(v[i]) : (lane < 32 ? v[i] : sigm(v[i])); }
    u32x2 o; o.x = pk2(v[0], v[1]); o.y = pk2(v[2], v[3]); *(u32x2*)(WSP(bf16, WS_RA) + (size_t)m * 256 + lane * 4) = o;
}
__device__ __forceinline__ void rwkv_prep_row2(KArgs C, int layer, int m, int step, int lane) {
    const int col = 1536 + lane * 4; const f32x4 mu = *(const f32x4*)(C->in[I_MU] + layer * 1792 + col);
    u32x2 wc[2], wp[2];
#pragma unroll
    for (int r = 0; r < 2; ++r) { const int mm = m + r * step; const bf16* cur = WSP(const bf16, WS_RW) + (size_t)mm * 1792 + col; wc[r] = *(const u32x2*)cur;
        if (mm % SEQ > 0) wp[r] = *(const u32x2*)(cur - 1792); else { wp[r].x = 0u; wp[r].y = 0u; } }
#pragma unroll
    for (int r = 0; r < 2; ++r) { float v[4] = {lo_bf(wc[r].x), hi_bf(wc[r].x), lo_bf(wc[r].y), hi_bf(wc[r].y)}; const float p[4] = {lo_bf(wp[r].x), hi_bf(wp[r].x), lo_bf(wp[r].y), hi_bf(wp[r].y)};
#pragma unroll
        for (int i = 0; i < 4; ++i) { v[i] = v[i] + (p[i] - v[i]) * mu[i]; v[i] = lane < 16 ? tanhf(v[i]) : (lane < 32 ? v[i] : sigm(v[i])); }
        u32x2 o; o.x = pk2(v[0], v[1]); o.y = pk2(v[2], v[3]); *(u32x2*)(WSP(bf16, WS_RA) + (size_t)(m + r * step) * 256 + lane * 4) = o; }
}
__device__ __forceinline__ void rwkv_unit(KArgs C, int layer, int unit, unsigned char* lds) {
    constexpr int SLOT = 16704, O_RT = 2048, O_BTL = 4096, O_KTL = 6144, O_BHT = 8192, O_KHT = 10240, O_VT = 12288, O_TM = 14336, O_AAK = 14848, O_RB = 15360, O_RK = 15872, O_DL = 16384, O_BON = 16640;
    const int tid = fresh_tid(), lane = tid & 63, wave = tid >> 6, bl = unit >> 3, h = unit & 7, pt = tid >> 3, k8 = (tid & 7) * 8, cc = pt >> 4, tl = pt & 15, hc = h * 64 + k8;
    float* WL = (float*)(lds + 4 * SLOT); float* Nf = WL + 4096; float* Yb = Nf + 1024; float* ct_ = Yb + 4096;
    const bf16* RW = WSP(const bf16, WS_RW) + (size_t)bl * SEQ * 1792 + hc;
    const float* WLG = WSP(const float, WS_WLOG) + (size_t)bl * SEQ * 512 + hc;
    const bf16* AS = WSP(const bf16, WS_ASIG) + (size_t)bl * SEQ * 512 + hc;
    const bf16* GG = WSP(const bf16, WS_GG) + (size_t)bl * SEQ * 512 + hc;
    bf16* YC = WSP(bf16, WS_Y) + (size_t)2 * MG * 512 + (size_t)bl * SEQ * 512 + hc;
    LDS_SYNC();
    { const int row = tid >> 6, j = tid & 63; const float* src = row == 0 ? C->in[I_MU] + layer * 1792 : row == 1 ? C->in[I_MU] + layer * 1792 + 512 : row == 2 ? C->in[I_MU] + layer * 1792 + 1024
          : row == 3 ? C->in[I_KK] + layer * 512 : row == 4 ? C->in[I_KA] + layer * 512 : row == 5 ? C->in[I_RK] + layer * 512 : row == 6 ? C->in[I_LNG] + layer * 512 : C->in[I_LNB] + layer * 512;
      ct_[tid] = src[h * 64 + j]; }
    f32x4_t Sd[4]; bf16x8_t Sf[2];
#pragma unroll
    for (int i = 0; i < 4; ++i) Sd[i] = (f32x4_t){0.f, 0.f, 0.f, 0.f};
    { u32x2 z; z.x = 0u; z.y = 0u; Sf[0] = frag2(z, z); Sf[1] = Sf[0]; }
    u32x4 rc, rp, kc, kp, vc, vp, ac, gc; f32x4 wl0, wl1;
#define RWKV_FETCH(c0_) do { const int tt_ = (c0_) + pt; const bf16* q_ = RW + (size_t)tt_ * 1792; \
        rc = *(const u32x4*)q_; kc = *(const u32x4*)(q_ + 512); vc = *(const u32x4*)(q_ + 1024); \
        if (tt_ > 0) { rp = *(const u32x4*)(q_ - 1792); kp = *(const u32x4*)(q_ - 1792 + 512); vp = *(const u32x4*)(q_ - 1792 + 1024); } else { rp = (u32x4){0u, 0u, 0u, 0u}; kp = rp; vp = rp; } \
        wl0 = *(const f32x4*)(WLG + (size_t)tt_ * 512); wl1 = *(const f32x4*)(WLG + (size_t)tt_ * 512 + 4); ac = *(const u32x4*)(AS + (size_t)tt_ * 512); gc = *(const u32x4*)(GG + (size_t)tt_ * 512); } while (0)
    RWKV_FETCH(0);
    for (int c0 = 0; c0 < SEQ; c0 += 64) {
        unsigned char* slot = lds + cc * SLOT;
        LDS_SYNC();
        f32x4 r0, r1, kq0, kq1, v0, v1, kk0, kk1, b0, b1; const u32x4 gkeep = gc; const f32x4 wk0 = wl0, wk1 = wl1;
        { f32x4 c0_, c1_, p0_, p1_, a0, a1;
          pg8::unpack8(rc, c0_, c1_); pg8::unpack8(rp, p0_, p1_); r0 = c0_ + (p0_ - c0_) * *(const f32x4*)(ct_ + k8); r1 = c1_ + (p1_ - c1_) * *(const f32x4*)(ct_ + k8 + 4);
          pg8::unpack8(kc, c0_, c1_); pg8::unpack8(kp, p0_, p1_); const f32x4 k00 = c0_ + (p0_ - c0_) * *(const f32x4*)(ct_ + 64 + k8), k01 = c1_ + (p1_ - c1_) * *(const f32x4*)(ct_ + 64 + k8 + 4);
          pg8::unpack8(vc, c0_, c1_); pg8::unpack8(vp, p0_, p1_); v0 = c0_ + (p0_ - c0_) * *(const f32x4*)(ct_ + 128 + k8); v1 = c1_ + (p1_ - c1_) * *(const f32x4*)(ct_ + 128 + k8 + 4);
          pg8::unpack8(ac, a0, a1);
          kk0 = k00 * *(const f32x4*)(ct_ + 192 + k8); kk1 = k01 * *(const f32x4*)(ct_ + 192 + k8 + 4);
          const float inv = 1.0f / fmaxf(sqrtf(red8((kk0.x * kk0.x + kk0.y * kk0.y + kk0.z * kk0.z + kk0.w * kk0.w) + (kk1.x * kk1.x + kk1.y * kk1.y + kk1.z * kk1.z + kk1.w * kk1.w))), 1e-12f);
          kk0 = kk0 * inv; kk1 = kk1 * inv; b0 = kk0 * a0; b1 = kk1 * a1;
          kq0 = k00 * (1.0f + (a0 - 1.0f) * *(const f32x4*)(ct_ + 256 + k8)); kq1 = k01 * (1.0f + (a1 - 1.0f) * *(const f32x4*)(ct_ + 256 + k8 + 4));
          const f32x4 q0 = r0 * kq0 * *(const f32x4*)(ct_ + 320 + k8), q1 = r1 * kq1 * *(const f32x4*)(ct_ + 320 + k8 + 4);
          const float bo = red8((q0.x + q0.y + q0.z + q0.w) + (q1.x + q1.y + q1.z + q1.w));
          if ((tid & 7) == 0) ((float*)(slot + O_BON))[tl] = bo;
          *(f32x4*)(WL + pt * 64 + k8) = wk0; *(f32x4*)(WL + pt * 64 + k8 + 4) = wk1; }
        if (c0 + 64 < SEQ) RWKV_FETCH(c0 + 64);
        LDS_SYNC();
        if (tid < 256) { const int c_ = tid >> 6, k_ = tid & 63; float w16[16], run = 0.f;
#pragma unroll
            for (int t = 0; t < 16; ++t) w16[t] = WL[(c_ * 16 + t) * 64 + k_];
#pragma unroll
            for (int t = 0; t < 16; ++t) { run += w16[t]; WL[(c_ * 16 + t) * 64 + k_] = run; }
            ((float*)(lds + c_ * SLOT + O_DL))[k_] = __expf(run); }
        LDS_SYNC();
        { const f32x4 cs0 = *(const f32x4*)(WL + pt * 64 + k8), cs1 = *(const f32x4*)(WL + pt * 64 + k8 + 4), d0 = *(const f32x4*)((const float*)(slot + O_DL) + k8), d1 = *(const f32x4*)((const float*)(slot + O_DL) + k8 + 4);
          f32x4 e0, e1, f0, f1, w0, w1;
#pragma unroll
          for (int i = 0; i < 4; ++i) { e0[i] = __expf(cs0[i]); e1[i] = __expf(cs1[i]); f0[i] = __builtin_amdgcn_rcpf(e0[i]); f1[i] = __builtin_amdgcn_rcpf(e1[i]); w0[i] = __expf(-wk0[i]); w1[i] = __expf(-wk1[i]); }
          const f32x4 bt0 = b0 * f0, bt1 = b1 * f1, kt0 = kq0 * f0, kt1 = kq1 * f1;
          *(u32x4*)((bf16*)slot + tl * 64 + k8) = pg8::pack8(-(kk0 * e0 * w0), -(kk1 * e1 * w1));
          *(u32x4*)((bf16*)(slot + O_RT) + tl * 64 + k8) = pg8::pack8(r0 * e0, r1 * e1);
          *(u32x4*)((bf16*)(slot + O_BTL) + tl * 64 + k8) = pg8::pack8(bt0, bt1);
          *(u32x4*)((bf16*)(slot + O_KTL) + tl * 64 + k8) = pg8::pack8(kt0, kt1);
          const f32x4 bh0 = bt0 * d0, bh1 = bt1 * d1, kh0 = kt0 * d0, kh1 = kt1 * d1;
          bf16* bht = (bf16*)(slot + O_BHT) + k8 * 16 + tl; bf16* kht = (bf16*)(slot + O_KHT) + k8 * 16 + tl; bf16* vt = (bf16*)(slot + O_VT) + k8 * 16 + tl;
#pragma unroll
          for (int i = 0; i < 4; ++i) { bht[i * 16] = f2bf(bh0[i]); bht[(i + 4) * 16] = f2bf(bh1[i]); kht[i * 16] = f2bf(kh0[i]); kht[(i + 4) * 16] = f2bf(kh1[i]); vt[i * 16] = f2bf(v0[i]); vt[(i + 4) * 16] = f2bf(v1[i]); } }
        LDS_SYNC();
        { unsigned char* sl = lds + (wave & 3) * SLOT; const int c16 = lane & 15, q = lane >> 4;
          const bf16x8_t a0 = *(const bf16x8_t*)((const bf16*)sl + c16 * 64 + 8 * q), a1 = *(const bf16x8_t*)((const bf16*)sl + c16 * 64 + 32 + 8 * q);
          const bf16x8_t bb0 = *(const bf16x8_t*)((const bf16*)(sl + O_BTL) + c16 * 64 + 8 * q), bb1 = *(const bf16x8_t*)((const bf16*)(sl + O_BTL) + c16 * 64 + 32 + 8 * q);
          const f32x4_t z4 = {0.f, 0.f, 0.f, 0.f};
          if (wave < 4) {
              f32x4_t n = __builtin_amdgcn_mfma_f32_16x16x32_bf16(a0, bb0, z4, 0, 0, 0); n = __builtin_amdgcn_mfma_f32_16x16x32_bf16(a1, bb1, n, 0, 0, 0);
              float* nf = Nf + (wave & 3) * 256;
#pragma unroll
              for (int r = 0; r < 4; ++r) nf[c16 * 16 + 4 * q + r] = (c16 < 4 * q + r) ? n[r] : 0.f;
              WAVE_SYNC();
              float tc[16];
#pragma unroll
              for (int t = 0; t < 16; ++t) tc[t] = (t == c16) ? 1.f : 0.f;
#pragma unroll
              for (int s2 = 0; s2 < 15; ++s2) { const f32x4 n0 = *(const f32x4*)(nf + s2 * 16), n1 = *(const f32x4*)(nf + s2 * 16 + 4), n2 = *(const f32x4*)(nf + s2 * 16 + 8), n3 = *(const f32x4*)(nf + s2 * 16 + 12);
                  const float ts = tc[s2]; const float nn[16] = {n0.x, n0.y, n0.z, n0.w, n1.x, n1.y, n1.z, n1.w, n2.x, n2.y, n2.z, n2.w, n3.x, n3.y, n3.z, n3.w};
#pragma unroll
                  for (int t = 0; t < 16; ++t) if (t > s2) tc[t] += nn[t] * ts; }
              if (q == 0) { bf16* tm = (bf16*)(sl + O_TM) + c16;
#pragma unroll
                  for (int t = 0; t < 16; ++t) tm[t * 16] = f2bf(tc[t]); }
          } else {
              const bf16x8_t r0f = *(const bf16x8_t*)((const bf16*)(sl + O_RT) + c16 * 64 + 8 * q), r1f = *(const bf16x8_t*)((const bf16*)(sl + O_RT) + c16 * 64 + 32 + 8 * q);
              const bf16x8_t kb0 = *(const bf16x8_t*)((const bf16*)(sl + O_KTL) + c16 * 64 + 8 * q), kb1 = *(const bf16x8_t*)((const bf16*)(sl + O_KTL) + c16 * 64 + 32 + 8 * q);
              f32x4_t ak = __builtin_amdgcn_mfma_f32_16x16x32_bf16(a0, kb0, z4, 0, 0, 0); ak = __builtin_amdgcn_mfma_f32_16x16x32_bf16(a1, kb1, ak, 0, 0, 0);
              f32x4_t rb = __builtin_amdgcn_mfma_f32_16x16x32_bf16(r0f, bb0, z4, 0, 0, 0); rb = __builtin_amdgcn_mfma_f32_16x16x32_bf16(r1f, bb1, rb, 0, 0, 0);
              f32x4_t rk = __builtin_amdgcn_mfma_f32_16x16x32_bf16(r0f, kb0, z4, 0, 0, 0); rk = __builtin_amdgcn_mfma_f32_16x16x32_bf16(r1f, kb1, rk, 0, 0, 0);
#pragma unroll
              for (int r = 0; r < 4; ++r) { const int t = 4 * q + r;
                  ((bf16*)(sl + O_AAK))[t * 16 + c16] = f2bf(c16 < t ? ak[r] : 0.f); ((bf16*)(sl + O_RB))[t * 16 + c16] = f2bf(c16 <= t ? rb[r] : 0.f); ((bf16*)(sl + O_RK))[t * 16 + c16] = f2bf(c16 <= t ? rk[r] : 0.f); }
          } }
        LDS_SYNC();
        if (wave < 4) { const int c16 = lane & 15, q = lane >> 4, vcol = 16 * wave + c16; u32x2 zz; zz.x = 0u; zz.y = 0u; const f32x4_t z4 = {0.f, 0.f, 0.f, 0.f};
#pragma unroll
            for (int ch = 0; ch < 4; ++ch) { const unsigned char* sl = lds + ch * SLOT;
                const bf16* at = (const bf16*)sl + c16 * 64 + 4 * q; const bf16* rt = (const bf16*)(sl + O_RT) + c16 * 64 + 4 * q;
                const bf16x8_t af0 = frag2(*(const u32x2*)at, *(const u32x2*)(at + 16)), af1 = frag2(*(const u32x2*)(at + 32), *(const u32x2*)(at + 48));
                const bf16x8_t rf0 = frag2(*(const u32x2*)rt, *(const u32x2*)(rt + 16)), rf1 = frag2(*(const u32x2*)(rt + 32), *(const u32x2*)(rt + 48));
                const u32x2 vq = *(const u32x2*)((const bf16*)(sl + O_VT) + vcol * 16 + 4 * q);
                const u32x2 aq = *(const u32x2*)((const bf16*)(sl + O_AAK) + c16 * 16 + 4 * q), tq = *(const u32x2*)((const bf16*)(sl + O_TM) + c16 * 16 + 4 * q);
                const u32x2 rbq = *(const u32x2*)((const bf16*)(sl + O_RB) + c16 * 16 + 4 * q), rkq = *(const u32x2*)((const bf16*)(sl + O_RK) + c16 * 16 + 4 * q);
                f32x4_t rhs = __builtin_amdgcn_mfma_f32_16x16x32_bf16(frag2(zz, aq), frag2(zz, vq), z4, 0, 0, 0); rhs = __builtin_amdgcn_mfma_f32_16x16x32_bf16(af0, Sf[0], rhs, 0, 0, 0);
                { const f32x4_t r2 = __builtin_amdgcn_mfma_f32_16x16x32_bf16(af1, Sf[1], z4, 0, 0, 0); rhs = rhs + r2; }
                u32x2 rl; rl.x = pk2(rhs[0], rhs[1]); rl.y = pk2(rhs[2], rhs[3]);
                const f32x4_t U = __builtin_amdgcn_mfma_f32_16x16x32_bf16(frag2(tq, zz), frag2(rl, zz), z4, 0, 0, 0);
                u32x2 ul; ul.x = pk2(U[0], U[1]); ul.y = pk2(U[2], U[3]); const bf16x8_t uv = frag2(ul, vq);
                f32x4_t y = __builtin_amdgcn_mfma_f32_16x16x32_bf16(rf0, Sf[0], z4, 0, 0, 0); y = __builtin_amdgcn_mfma_f32_16x16x32_bf16(rf1, Sf[1], y, 0, 0, 0);
                y = __builtin_amdgcn_mfma_f32_16x16x32_bf16(frag2(rbq, rkq), uv, y, 0, 0, 0);
#pragma unroll
                for (int r = 0; r < 4; ++r) Yb[(ch * 16 + 4 * q + r) * 64 + vcol] = y[r];
#pragma unroll
                for (int kt = 0; kt < 4; ++kt) { const f32x4 dl = *(const f32x4*)((const float*)(sl + O_DL) + 16 * kt + 4 * q);
                    const u32x2 bq = *(const u32x2*)((const bf16*)(sl + O_BHT) + (16 * kt + c16) * 16 + 4 * q), kq = *(const u32x2*)((const bf16*)(sl + O_KHT) + (16 * kt + c16) * 16 + 4 * q);
                    const f32x4_t cin = {Sd[kt][0] * dl.x, Sd[kt][1] * dl.y, Sd[kt][2] * dl.z, Sd[kt][3] * dl.w};
                    Sd[kt] = __builtin_amdgcn_mfma_f32_16x16x32_bf16(frag2(bq, kq), uv, cin, 0, 0, 0); }
#pragma unroll
                for (int s2 = 0; s2 < 2; ++s2) { u32x2 lo, hi; lo.x = pk2(Sd[2 * s2][0], Sd[2 * s2][1]); lo.y = pk2(Sd[2 * s2][2], Sd[2 * s2][3]); hi.x = pk2(Sd[2 * s2 + 1][0], Sd[2 * s2 + 1][1]); hi.y = pk2(Sd[2 * s2 + 1][2], Sd[2 * s2 + 1][3]); Sf[s2] = frag2(lo, hi); }
            } }
        LDS_SYNC();
        { const f32x4 y0 = *(const f32x4*)(Yb + pt * 64 + k8), y1 = *(const f32x4*)(Yb + pt * 64 + k8 + 4);
          const float mean = red8((y0.x + y0.y + y0.z + y0.w) + (y1.x + y1.y + y1.z + y1.w)) * (1.f / 64); const f32x4 d0 = y0 - mean, d1 = y1 - mean;
          const float rstd = 1.0f / sqrtf(red8((d0.x * d0.x + d0.y * d0.y + d0.z * d0.z + d0.w * d0.w) + (d1.x * d1.x + d1.y * d1.y + d1.z * d1.z + d1.w * d1.w)) * (1.f / 64) + GN_EPS);
          const float bo = ((const float*)(slot + O_BON))[tl]; f32x4 g0, g1; pg8::unpack8(gkeep, g0, g1);
          const f32x4 o0 = (d0 * rstd * *(const f32x4*)(ct_ + 384 + k8) + *(const f32x4*)(ct_ + 448 + k8) + bo * v0) * g0, o1 = (d1 * rstd * *(const f32x4*)(ct_ + 384 + k8 + 4) + *(const f32x4*)(ct_ + 448 + k8 + 4) + bo * v1) * g1;
          *(u32x4*)(YC + (size_t)(c0 + pt) * 512) = pg8::pack8(o0, o1); }
    }
#undef RWKV_FETCH
}

__device__ __forceinline__ void s5_unit(KArgs C, int layer, int unit, unsigned char* lds) {
    const int tid = fresh_tid(), lane = tid & 63, wave = tid >> 6, bl = unit >> 5, g = unit & 31, c16 = lane & 15, q = lane >> 4, sg = wave & 3, th = wave >> 2, p = 16 * sg + c16;
    constexpr int SP = 136;
    float* us = (float*)lds; float* ends = us + 1024; bf16* St = (bf16*)(ends + 16 * 128);
    const bf16* U = WSP(const bf16, WS_U) + (size_t)bl * SEQ * 512 + g * 16;
    bf16* YD0 = WSP(bf16, WS_YD0) + (size_t)bl * SEQ * 512 + g * 16;
    const size_t wo = (layer & 1) ? WDELTA : 0;
    bf16x8_t bre, bim;
    { const float* bb = WSP(const float, WS_BBAR + wo) + ((size_t)g * 64 + p) * 32; u32x4 wr_, wi_;
      if (q < 2) { const float* b8 = bb + 16 * q; wr_.x = pk2(b8[0], b8[2]); wr_.y = pk2(b8[4], b8[6]); wr_.z = pk2(b8[8], b8[10]); wr_.w = pk2(b8[12], b8[14]);
                   wi_.x = pk2(b8[1], b8[3]); wi_.y = pk2(b8[5], b8[7]); wi_.z = pk2(b8[9], b8[11]); wi_.w = pk2(b8[13], b8[15]); }
      else { wr_ = (u32x4){0u, 0u, 0u, 0u}; wi_ = wr_; }
      bre = __builtin_bit_cast(bf16x8_t, wr_); bim = __builtin_bit_cast(bf16x8_t, wi_); }
    float apr[4], api[4];
    { const float ar = WSP(const float, WS_ABAR + wo)[(g * 64 + p) * 2], ai = WSP(const float, WS_ABAR + wo)[(g * 64 + p) * 2 + 1]; apr[0] = ar; api[0] = ai;
#pragma unroll
      for (int i = 1; i < 4; ++i) { apr[i] = apr[i - 1] * ar - api[i - 1] * ai; api[i] = apr[i - 1] * ai + api[i - 1] * ar; } }
    bf16x8_t cf[4];
    { const float* cre = C->in[I_S5CRE] + ((size_t)layer * 32 + g) * 1024 + c16 * 64; const float* cim = C->in[I_S5CIM] + ((size_t)layer * 32 + g) * 1024 + c16 * 64;
#pragma unroll
      for (int ks = 0; ks < 4; ++ks) { const int c0_ = 32 * ks + 8 * q; const float* src = c0_ < 64 ? cre + c0_ : cim + (c0_ - 64); const float sgn = c0_ < 64 ? 1.f : -1.f;
          u32x4 w; w.x = pk2(sgn * src[0], sgn * src[1]); w.y = pk2(sgn * src[2], sgn * src[3]); w.z = pk2(sgn * src[4], sgn * src[5]); w.w = pk2(sgn * src[6], sgn * src[7]); cf[ks] = __builtin_bit_cast(bf16x8_t, w); } }
    const float dj = C->in[I_S5D][layer * 512 + g * 16 + c16];
    float cr = 0.f, ci = 0.f;
    u32x2 fu; fu.x = 0u; fu.y = 0u;
#define S5_FETCH(c0_) do { if (tid < 256) fu = *(const u32x2*)(U + (size_t)((c0_) + (tid >> 2)) * 512 + (tid & 3) * 4); } while (0)
    S5_FETCH(0);
    for (int c0 = 0; c0 < SEQ; c0 += 64) {
        LDS_SYNC();
        if (tid < 256) *(f32x4*)(us + (tid >> 2) * 16 + (tid & 3) * 4) = (f32x4){lo_bf(fu.x), hi_bf(fu.x), lo_bf(fu.y), hi_bf(fu.y)};
        if (c0 + 64 < SEQ) S5_FETCH(c0 + 64);
        LDS_SYNC();
        float lr[2][4], li[2][4];
#pragma unroll
        for (int tt = 0; tt < 2; ++tt) { bf16x8_t af;
            if (q < 2) { const float* ur = us + (32 * th + 16 * tt + c16) * 16 + 8 * q; const f32x4 u0 = *(const f32x4*)ur, u1 = *(const f32x4*)(ur + 4);
                u32x4 w; w.x = pk2(u0.x, u0.y); w.y = pk2(u0.z, u0.w); w.z = pk2(u1.x, u1.y); w.w = pk2(u1.z, u1.w); af = __builtin_bit_cast(bf16x8_t, w); }
            else { const u32x4 z = {0u, 0u, 0u, 0u}; af = __builtin_bit_cast(bf16x8_t, z); }
            const f32x4_t z4 = {0.f, 0.f, 0.f, 0.f};
            const f32x4_t dre = __builtin_amdgcn_mfma_f32_16x16x32_bf16(af, bre, z4, 0, 0, 0), dim = __builtin_amdgcn_mfma_f32_16x16x32_bf16(af, bim, z4, 0, 0, 0);
            lr[tt][0] = dre[0]; li[tt][0] = dim[0];
#pragma unroll
            for (int r = 1; r < 4; ++r) { lr[tt][r] = apr[0] * lr[tt][r - 1] - api[0] * li[tt][r - 1] + dre[r]; li[tt][r] = apr[0] * li[tt][r - 1] + api[0] * lr[tt][r - 1] + dim[r]; }
            const int rho = (2 * th + tt) * 4 + q; ends[(rho * 64 + p) * 2] = lr[tt][3]; ends[(rho * 64 + p) * 2 + 1] = li[tt][3]; }
        LDS_SYNC();
        { float xr = cr, xi = ci; const int rho0 = (2 * th) * 4 + q;
          for (int rr = 0; rr < 16; ++rr) {
              if (rr == rho0 || rr == rho0 + 4) { const int tt = (rr == rho0) ? 0 : 1;
#pragma unroll
                  for (int r = 0; r < 4; ++r) { const float sr = lr[tt][r] + apr[r] * xr - api[r] * xi, si = li[tt][r] + apr[r] * xi + api[r] * xr; const int t = 32 * th + 16 * tt + 4 * q + r;
                      St[t * SP + p] = f2bf(sr); St[t * SP + 64 + p] = f2bf(si); } }
              const float er = ends[(rr * 64 + p) * 2], ei = ends[(rr * 64 + p) * 2 + 1]; const float nr = apr[3] * xr - api[3] * xi + er, ni = apr[3] * xi + api[3] * xr + ei; xr = nr; xi = ni; }
          cr = xr; ci = xi; }
        LDS_SYNC();
        if (wave < 4) { f32x4_t y = {0.f, 0.f, 0.f, 0.f};
#pragma unroll
            for (int ks = 0; ks < 4; ++ks) y = __builtin_amdgcn_mfma_f32_16x16x32_bf16(*(const bf16x8_t*)(St + (16 * wave + c16) * SP + 32 * ks + 8 * q), cf[ks], y, 0, 0, 0);
#pragma unroll
            for (int r = 0; r < 4; ++r) { const int t = 16 * wave + 4 * q + r; YD0[(size_t)(c0 + t) * 512 + c16] = f2bf(gelu_tanh(y[r] + dj * us[t * 16 + c16])); } }
    }
#undef S5_FETCH
}

__device__ __forceinline__ unsigned ord_key(float f) { const unsigned u = __float_as_uint(f); return (u & 0x80000000u) ? ~u : (u | 0x80000000u); }
__device__ __forceinline__ void dsa_index_row(KArgs C, int m, int lane, unsigned* ks) {
    const int bl = m / SEQ, t = m % SEQ, nkeys = ((t >> 6) + 1) * 64, nk64 = nkeys >> 6;
    unsigned* mrow = WSP(unsigned, WS_MASK) + (size_t)m * MW;
    if (nkeys <= TOPK) { for (int w = lane; w < MW; w += 64) mrow[w] = (w * 32 < nkeys) ? 0xffffffffu : 0u; return; }
    const bf16* smq = WSP(const bf16, WS_SM) + (size_t)m * 256;
    const bf16* smk = WSP(const bf16, WS_SM) + (size_t)bl * SEQ * 256 + 136;
    float* scf = (float*)ks;
    for (int h = 0; h < 4; ++h) {
        float qv[32];
#pragma unroll
        for (int e = 0; e < 32; ++e) qv[e] = bf2f(smq[8 + h * 32 + e]);
        const float wh = bf2f(smq[168 + h]) * 0.5f;
#pragma unroll 2
        for (int i = 0; i < nk64; ++i) {
            const u32x4* kr = (const u32x4*)(smk + (size_t)(i * 64 + lane) * 256); float dot = 0.f;
#pragma unroll
            for (int q = 0; q < 4; ++q) { const u32x4 w = kr[q];
                dot += qv[8 * q + 0] * lo_bf(w.x) + qv[8 * q + 1] * hi_bf(w.x) + qv[8 * q + 2] * lo_bf(w.y) + qv[8 * q + 3] * hi_bf(w.y)
                     + qv[8 * q + 4] * lo_bf(w.z) + qv[8 * q + 5] * hi_bf(w.z) + qv[8 * q + 6] * lo_bf(w.w) + qv[8 * q + 7] * hi_bf(w.w); }
            const float v = wh * fmaxf(dot * 0.17677669529f, 0.f);
            scf[i * 64 + lane] = (h == 0) ? v : scf[i * 64 + lane] + v;
        }
    }
    for (int i = 0; i < nk64; ++i) ks[i * 64 + lane] = ord_key(scf[i * 64 + lane]);
    unsigned T = 0u;
    for (int bit = 31; bit >= 0; --bit) { const unsigned cand = T | (1u << bit); int c = 0;
#pragma unroll 4
        for (int i = 0; i < nk64; ++i) c += (ks[i * 64 + lane] >= cand) ? 1 : 0;
        if (wave_sum_i(c) >= TOPK) T = cand; }
    int cgt = 0;
    for (int i = 0; i < nk64; ++i) cgt += (ks[i * 64 + lane] > T) ? 1 : 0;
    const int need = TOPK - wave_sum_i(cgt); int taken = 0;
    for (int i = 0; i < NK64; ++i) {
        const unsigned kv = (i < nk64) ? ks[i * 64 + lane] : 0u;
        const bool eq = kv == T && i < nk64; const unsigned long long be = __ballot(eq);
        const int pre = __popcll(be & ((1ull << lane) - 1ull));
        const bool sel = (i < nk64) && ((kv > T) || (eq && (taken + pre) < need)); taken += __popcll(be);
        const unsigned long long bs = __ballot(sel);
        if (lane == 0) { mrow[2 * i] = (unsigned)bs; mrow[2 * i + 1] = (unsigned)(bs >> 32); }
    }
}
__device__ __forceinline__ void dsa_attn_row(KArgs C, int m, int lane, int* idx, float* pl) {
    const int bl = m / SEQ, t = m % SEQ;
    const unsigned* mrow = WSP(const unsigned, WS_MASK) + (size_t)m * MW;
    int cnt = 0;
    WAVE_SYNC();
    for (int i = 0; i < NK64; ++i) { const unsigned long long w = (unsigned long long)mrow[2 * i] | ((unsigned long long)mrow[2 * i + 1] << 32);
        if ((w >> lane) & 1ull) idx[cnt + __popcll(w & ((1ull << lane) - 1ull))] = i * 64 + lane; cnt += __popcll(w); }
    WAVE_SYNC();
    const bf16* Qr = WSP(const bf16, WS_Q) + (size_t)m * 512;
    const bf16* Kb = WSP(const bf16, WS_K) + (size_t)bl * SEQ * 512;
    const bf16* Vb = WSP(const bf16, WS_V) + (size_t)bl * SEQ * 512;
    bf16* YB = WSP(bf16, WS_Y) + (size_t)MG * 512 + (size_t)m * 512;
    const int* tab = WSP(const int, WS_TAB); const float* relb = C->in[I_RELB];
    for (int h = 0; h < 8; ++h) {
        float qv[64];
#pragma unroll
        for (int d = 0; d < 64; ++d) qv[d] = bf2f(Qr[h * 64 + d]);
        float mx = -INFINITY;
        WAVE_SYNC();
#pragma unroll 1
        for (int c = 0; c < TOPK / 64; ++c) { const int j = c * 64 + lane; float lgv = -INFINITY;
            if (j < cnt) { const int key = idx[j]; const u32x4* kr = (const u32x4*)(Kb + (size_t)key * 512 + h * 64); float dot = 0.f;
#pragma unroll
                for (int q = 0; q < 8; ++q) { const u32x4 w = kr[q];
                    dot += qv[8 * q + 0] * lo_bf(w.x) + qv[8 * q + 1] * hi_bf(w.x) + qv[8 * q + 2] * lo_bf(w.y) + qv[8 * q + 3] * hi_bf(w.y)
                         + qv[8 * q + 4] * lo_bf(w.z) + qv[8 * q + 5] * hi_bf(w.z) + qv[8 * q + 6] * lo_bf(w.w) + qv[8 * q + 7] * hi_bf(w.w); }
                lgv = dot * 0.125f + relb[tab[key - t + SEQ - 1] * 8 + h]; }
            pl[j] = lgv; mx = fmaxf(mx, lgv); }
        mx = wave_max(mx); float sum = 0.f;
#pragma unroll 1
        for (int c = 0; c < TOPK / 64; ++c) { const int j = c * 64 + lane; const float e = (j < cnt) ? __expf(pl[j] - mx) : 0.f; pl[j] = e; sum += e; }
        const float inv = 1.0f / wave_sum(sum);
        WAVE_SYNC();
        float acc = 0.f;
#pragma unroll 4
        for (int j = 0; j < cnt; ++j) acc += pl[j] * bf2f(Vb[(size_t)idx[j] * 512 + h * 64 + lane]);
        YB[h * 64 + lane] = f2bf(acc * inv);
    }
}

__device__ __forceinline__ void dsa_vt_item(KArgs C, int item, int lane, bf16* scr) {
    const int tb = item % NK64, bh = item / NK64, h = bh & 7, bl = bh >> 3;
    const bf16* V = WSP(const bf16, WS_V) + ((size_t)bl * SEQ + tb * 64) * 512 + h * 64;
    WAVE_SYNC();
#pragma unroll
    for (int i = 0; i < 8; ++i) { const int tk = (lane >> 3) + 8 * i, c8 = (lane & 7) * 8; const u32x4 w = *(const u32x4*)(V + (size_t)tk * 512 + c8);
        unsigned* d = (unsigned*)(scr + tk * 66 + c8); d[0] = w.x; d[1] = w.y; d[2] = w.z; d[3] = w.w; }
    WAVE_SYNC();
    bf16* Vt = WSP(bf16, WS_VT) + ((size_t)bh * 64) * SEQ + tb * 64 + lane;
#pragma unroll 8
    for (int d = 0; d < 64; ++d) Vt[(size_t)d * SEQ] = scr[lane * 66 + d];
}
__device__ __forceinline__ void dsa_attn_wave(KArgs C, int bl, int c, int qb, int h, int lane, float* btab) {
    const int l31 = lane & 31, hh = lane >> 5, q0 = c * 64 + qb * 32, qpos = q0 + l31; const size_t qrow = (size_t)bl * SEQ + qpos;
    const bf16* Qp = WSP(const bf16, WS_Q) + qrow * 512 + h * 64 + 8 * hh;
    const bf16* Kp = WSP(const bf16, WS_K) + ((size_t)bl * SEQ + l31) * 512 + h * 64 + 8 * hh;
    const bf16* Vp = WSP(const bf16, WS_VT) + ((size_t)(bl * 8 + h) * 64 + l31) * SEQ + 4 * hh;
    const unsigned* Mp = WSP(const unsigned, WS_MASK) + qrow * MW;
    constexpr float SC = 0.125f * 1.44269504089f;
    bf16x8_t qf[4];
#pragma unroll
    for (int s = 0; s < 4; ++s) qf[s] = *(const bf16x8_t*)(Qp + 16 * s);
    f32x16 O0, O1;
#pragma unroll
    for (int r = 0; r < 16; ++r) { O0[r] = 0.f; O1[r] = 0.f; }
    float m = -1e30f, lsum = 0.f;
    const float bfar = btab[0];
    const int nt = (c + 1) * 2;
    bf16x8_t kf[2][4]; u32x2 vf[2][2][2][2]; unsigned mw[2];
#define DSA_LOAD(kt_) do { _Pragma("unroll") for (int t2 = 0; t2 < 2; ++t2) { const int k0_ = ((kt_) + t2) * 32; \
        _Pragma("unroll") for (int s = 0; s < 4; ++s) kf[t2][s] = *(const bf16x8_t*)(Kp + (size_t)k0_ * 512 + 16 * s); \
        _Pragma("unroll") for (int dt = 0; dt < 2; ++dt) _Pragma("unroll") for (int s = 0; s < 2; ++s) _Pragma("unroll") for (int pc = 0; pc < 2; ++pc) \
            vf[t2][dt][s][pc] = *(const u32x2*)(Vp + (size_t)dt * 32 * SEQ + k0_ + 16 * s + 8 * pc); \
        mw[t2] = Mp[(kt_) + t2]; } } while (0)
    DSA_LOAD(0);
    for (int kt = 0; kt < nt; kt += 2) {
        bf16x8_t kc[2][4]; u32x2 vc[2][2][2][2]; unsigned mwc2[2];
#pragma unroll
        for (int t2 = 0; t2 < 2; ++t2) { mwc2[t2] = mw[t2] >> (4 * hh);
#pragma unroll
            for (int s = 0; s < 4; ++s) kc[t2][s] = kf[t2][s];
#pragma unroll
            for (int dt = 0; dt < 2; ++dt)
#pragma unroll
                for (int s = 0; s < 2; ++s) { vc[t2][dt][s][0] = vf[t2][dt][s][0]; vc[t2][dt][s][1] = vf[t2][dt][s][1]; } }
        if (kt + 2 < nt) DSA_LOAD(kt + 2);
#pragma unroll
        for (int t2 = 0; t2 < 2; ++t2) {
        const unsigned mwc = mwc2[t2];
        f32x16 S;
#pragma unroll
        for (int r = 0; r < 16; ++r) S[r] = 0.f;
#pragma unroll
        for (int s = 0; s < 4; ++s) S = __builtin_amdgcn_mfma_f32_32x32x16_bf16(kc[t2][s], qf[s], S, 0, 0, 0);
        const int k0 = (kt + t2) * 32; const bool far = (k0 + 31 - q0) <= -166;
        float tmax = -INFINITY;
        if (far) {
#pragma unroll
            for (int r = 0; r < 16; ++r) { const int row = (r & 3) + 8 * (r >> 2); const float v = ((mwc >> row) & 1u) ? S[r] * SC + bfar : -INFINITY; S[r] = v; tmax = fmaxf(tmax, v); }
        } else {
            const int rb = k0 + 4 * hh - qpos + 256;
#pragma unroll
            for (int r = 0; r < 16; ++r) { const int row = (r & 3) + 8 * (r >> 2); int ti = rb + row; ti = ti < 0 ? 0 : ti;
                const float v = ((mwc >> row) & 1u) ? S[r] * SC + btab[ti] : -INFINITY; S[r] = v; tmax = fmaxf(tmax, v); }
        }
        tmax = fmaxf(tmax, __shfl_xor(tmax, 32));
        const float mn = fmaxf(m, tmax), alpha = __builtin_amdgcn_exp2f(m - mn); m = mn;
        float ps = 0.f;
#pragma unroll
        for (int r = 0; r < 16; ++r) { const float p = __builtin_amdgcn_exp2f(S[r] - mn); S[r] = p; ps += p; }
        lsum = lsum * alpha + ps;
#pragma unroll
        for (int r = 0; r < 16; ++r) { O0[r] *= alpha; O1[r] *= alpha; }
        bf16x8_t pf[2];
#pragma unroll
        for (int s = 0; s < 2; ++s) { u32x4 w; w.x = pk2(S[8 * s + 0], S[8 * s + 1]); w.y = pk2(S[8 * s + 2], S[8 * s + 3]); w.z = pk2(S[8 * s + 4], S[8 * s + 5]); w.w = pk2(S[8 * s + 6], S[8 * s + 7]);
            pf[s] = __builtin_bit_cast(bf16x8_t, w); }
#pragma unroll
        for (int s = 0; s < 2; ++s) {
            O0 = __builtin_amdgcn_mfma_f32_32x32x16_bf16(frag2(vc[t2][0][s][0], vc[t2][0][s][1]), pf[s], O0, 0, 0, 0);
            O1 = __builtin_amdgcn_mfma_f32_32x32x16_bf16(frag2(vc[t2][1][s][0], vc[t2][1][s][1]), pf[s], O1, 0, 0, 0); }
        }
    }
#undef DSA_LOAD
    lsum += __shfl_xor(lsum, 32);
    const float inv = 1.0f / lsum;
    bf16* Y = WSP(bf16, WS_Y) + (size_t)MG * 512 + qrow * 512 + h * 64 + 4 * hh;
#pragma unroll
    for (int g = 0; g < 4; ++g) { u32x2 w; w.x = pk2(O0[4 * g] * inv, O0[4 * g + 1] * inv); w.y = pk2(O0[4 * g + 2] * inv, O0[4 * g + 3] * inv); *(u32x2*)(Y + 8 * g) = w;
        u32x2 w2; w2.x = pk2(O1[4 * g] * inv, O1[4 * g + 1] * inv); w2.y = pk2(O1[4 * g + 2] * inv, O1[4 * g + 3] * inv); *(u32x2*)(Y + 32 + 8 * g) = w2; }
}
__device__ __forceinline__ void dsa_attn_unit(KArgs C, int unit, int lane, int wave, unsigned char* lds) {
    const int hhalf = unit & 1, p = (unit >> 1) % (NK64 / 2), bl = (unit >> 1) / (NK64 / 2), h = 4 * hhalf + (wave >> 1), qb = wave & 1;
    float* btab = (float*)lds + wave * 320;
    WAVE_SYNC();
    { const int* tab = WSP(const int, WS_TAB); const float* relb = C->in[I_RELB];
      for (int i = lane; i < 320; i += 64) btab[i] = relb[tab[i - 256 + SEQ - 1] * 8 + h] * 1.44269504089f; }
    WAVE_SYNC();
    dsa_attn_wave(C, bl, p, qb, h, lane, btab);
    dsa_attn_wave(C, bl, NK64 - 1 - p, qb, h, lane, btab);
}

constexpr int IDX_CAP = 128, IDX_NBIN = 1024;
__device__ __forceinline__ void dsa_index_unit(KArgs C, int unit, int lane, int wave, unsigned char* lds) {
    const int oct = unit & 7, pairid = (unit >> 3) % (NK64 / 2), kx = (unit >> 3) / (NK64 / 2), bl = kx >> 1, c = (kx & 1) ? NK64 - 1 - pairid : pairid;
    const int t0 = c * 64 + oct * 8, nkeys = (c + 1) * 64, nk64 = c + 1; const size_t row0 = (size_t)bl * SEQ + t0;
    unsigned* mrow = WSP(unsigned, WS_MASK) + (row0 + wave) * MW;
    if (nkeys <= TOPK) { for (int w = lane; w < MW; w += 64) mrow[w] = (w * 32 < nkeys) ? 0xffffffffu : 0u; return; }
    float* scf = (float*)lds;
    unsigned* hist = (unsigned*)(lds + LDS_X) + wave * (IDX_NBIN / 2); unsigned* candv = (unsigned*)(lds + LDS_X + 8 * IDX_NBIN * 2) + wave * IDX_CAP; unsigned* candi = candv + 8 * IDX_CAP; unsigned* mword = (unsigned*)(lds + LDS_X + 8 * IDX_NBIN * 2 + 16 * IDX_CAP * 4) + wave * MW;
    const bf16* SMb = WSP(const bf16, WS_SM) + (size_t)bl * SEQ * 256;
    LDS_SYNC();
#ifndef PROBE_REP
#define PROBE_REP 0
#endif
    {
      const int l31 = lane & 31, half = lane >> 5;
      const bf16* qa = SMb + (size_t)(t0 + (l31 >> 2)) * 256 + 8 + (l31 & 3) * 32 + 8 * half;
      const bf16x8_t a0 = *(const bf16x8_t*)qa, a1 = *(const bf16x8_t*)(qa + 16);
      float wv[4][4];
#pragma unroll
      for (int g = 0; g < 4; ++g) { const u32x2 w = *(const u32x2*)(SMb + (size_t)(t0 + 2 * g + half) * 256 + 168); wv[g][0] = lo_bf(w.x) * 0.5f; wv[g][1] = hi_bf(w.x) * 0.5f; wv[g][2] = lo_bf(w.y) * 0.5f; wv[g][3] = hi_bf(w.y) * 0.5f; }
      for (int kt0 = wave; kt0 < nk64 * 2; kt0 += 8 * NWAVES) {
          bf16x8_t b0[8], b1[8];
#pragma unroll
          for (int u4 = 0; u4 < 8; ++u4) { const int kt = kt0 + 8 * u4; const bf16* kb = WSP(const bf16, WS_KI) + ((size_t)bl * SEQ + (size_t)((kt < nk64 * 2 ? kt : wave) * 32 + l31)) * 32 + 8 * half;
              b0[u4] = *(const bf16x8_t*)kb; b1[u4] = *(const bf16x8_t*)(kb + 16); }
#pragma unroll
          for (int u4 = 0; u4 < 8; ++u4) { const int kt = kt0 + 8 * u4; if (kt < nk64 * 2) {
              f32x16 d;
#pragma unroll
              for (int r = 0; r < 16; ++r) d[r] = 0.f;
              d = __builtin_amdgcn_mfma_f32_32x32x16_bf16(a0, b0[u4], d, 0, 0, 0); d = __builtin_amdgcn_mfma_f32_32x32x16_bf16(a1, b1[u4], d, 0, 0, 0);
#pragma unroll
              for (int g = 0; g < 4; ++g) { float sc = 0.f;
#pragma unroll
                  for (int j = 0; j < 4; ++j) sc += wv[g][j] * fmaxf(d[4 * g + j] * 0.17677669529f, 0.f);
                  scf[(2 * g + half) * SEQ + kt * 32 + l31] = sc; } } }
      } }
    { const int tail0 = nkeys, tail1 = ((nk64 + 7) >> 3) * 512;
      for (int e = tail0 + (int)(threadIdx.x); e < tail1; e += NTHREADS) {
#pragma unroll
          for (int qq = 0; qq < 8; ++qq) scf[qq * SEQ + e] = -3.0e38f; } }
    LDS_SYNC();
    const float* sc = scf + wave * SEQ; constexpr float NEG = -3.0e38f; const int nb8 = (nk64 + 7) >> 3;
    float v[NK64];
#pragma unroll
    for (int ib = 0; ib < NK64 / 8; ++ib) if (ib < nb8) {
#pragma unroll
        for (int j = 0; j < 8; ++j) v[ib * 8 + j] = sc[(ib * 8 + j) * 64 + lane];
        SCHED_FENCE(); }
    float mn = INFINITY, mx = -INFINITY;
#pragma unroll
    for (int ib = 0; ib < NK64 / 8; ++ib) if (ib < nb8) {
#pragma unroll
        for (int j = 0; j < 8; ++j) { const float x = v[ib * 8 + j]; mx = fmaxf(mx, x); mn = fminf(mn, x == NEG ? INFINITY : x); } }
    mn = -wave_max(-mn); mx = wave_max(mx);
    const float scale = (mx > mn) ? ((float)IDX_NBIN - 0.01f) / (mx - mn) : 0.f;
#pragma unroll
    for (int i = 0; i < IDX_NBIN / 128; ++i) hist[lane * (IDX_NBIN / 128) + i] = 0u;
    for (int w = lane; w < MW; w += 64) mword[w] = 0u;
    WAVE_SYNC();
#define IDX_BIN(x) ({ int b_ = (int)(fmaxf((x) - mn, 0.f) * scale); b_ > IDX_NBIN - 1 ? IDX_NBIN - 1 : b_; })
#pragma unroll
    for (int ib = 0; ib < NK64 / 8; ++ib) if (ib < nb8) {
#pragma unroll
        for (int j = 0; j < 8; ++j) { const int b = IDX_BIN(v[ib * 8 + j]); atomicAdd(&hist[b >> 1], (b & 1) ? 0x10000u : 1u); }
        SCHED_FENCE(); }
    WAVE_SYNC();
    int bstar, cgt;
    {
      unsigned hw[8]; int tot = 0;
#pragma unroll
      for (int i = 0; i < 8; ++i) { hw[i] = hist[lane * 8 + i]; tot += (int)(hw[i] & 0xffffu) + (int)(hw[i] >> 16); }
      int suf = tot;
#pragma unroll
      for (int o = 1; o < 64; o <<= 1) { const int t = __shfl_down(suf, o); if (lane + o < 64) suf += t; }
      const unsigned long long ge = __ballot(suf >= TOPK); const int L = 63 - __builtin_clzll(ge);
      int cum = __shfl(suf, L) - __shfl(tot, L); bstar = 16 * L; cgt = cum; bool found = false;
#pragma unroll
      for (int i = 7; i >= 0; --i) { const unsigned w = (unsigned)__shfl((int)hw[i], L); const int chi = (int)(w >> 16), clo = (int)(w & 0xffffu);
          if (!found && cum + chi >= TOPK) { bstar = 16 * L + 2 * i + 1; cgt = cum; found = true; } cum += found ? 0 : chi;
          if (!found && cum + clo >= TOPK) { bstar = 16 * L + 2 * i; cgt = cum; found = true; } cum += found ? 0 : clo; } }
    const int need = TOPK - cgt; int ncand = 0;
    unsigned mylo = 0u, myhi = 0u;
#pragma unroll
    for (int ib = 0; ib < NK64 / 8; ++ib) if (ib < nb8) {
#pragma unroll
        for (int j = 0; j < 8; ++j) { const int i = ib * 8 + j; const int b = IDX_BIN(v[i]);
            const unsigned long long bs = __ballot(b > bstar), bc = __ballot(b == bstar);
            if (lane == i) { mylo = (unsigned)bs; myhi = (unsigned)(bs >> 32); }
            if (bc != 0ull) {
                const int pos = ncand + (int)__builtin_amdgcn_mbcnt_hi((unsigned)(bc >> 32), __builtin_amdgcn_mbcnt_lo((unsigned)bc, 0u));
                if (b == bstar && pos < IDX_CAP) { candv[pos] = ord_key(v[i]); candi[pos] = (unsigned)(i * 64 + lane); }
                ncand += __popcll(bc); } }
        SCHED_FENCE(); }
    if (lane < nb8 * 8) { mword[2 * lane] = mylo; mword[2 * lane + 1] = myhi; }
#undef IDX_BIN
    WAVE_SYNC();
    if (ncand <= IDX_CAP) {
        for (int m = lane; m < ncand; m += 64) { const unsigned vm = candv[m]; int rank = 0;
#pragma unroll 4
            for (int j = 0; j < ncand; ++j) { const unsigned vj = candv[j]; rank += (vj > vm || (vj == vm && j < m)) ? 1 : 0; }
            if (rank < need) { const unsigned idx = candi[m]; atomicOr(&mword[idx >> 5], 1u << (idx & 31)); } }
    } else {
        unsigned T = 0u;
        for (int bit = 31; bit >= 0; --bit) { const unsigned cand = T | (1u << bit); int cn = 0;
#pragma unroll
            for (int ib = 0; ib < NK64 / 8; ++ib) if (ib < nb8) {
#pragma unroll
                for (int j = 0; j < 8; ++j) cn += (ord_key(v[ib * 8 + j]) >= cand) ? 1 : 0; }
            if (wave_sum_i(cn) >= TOPK) T = cand; }
        int cg = 0;
#pragma unroll
        for (int ib = 0; ib < NK64 / 8; ++ib) if (ib < nb8) {
#pragma unroll
            for (int j = 0; j < 8; ++j) cg += (ord_key(v[ib * 8 + j]) > T) ? 1 : 0; }
        const int need2 = TOPK - wave_sum_i(cg); int taken = 0;
#pragma unroll
        for (int ib = 0; ib < NK64 / 8; ++ib) if (ib < nb8) {
#pragma unroll
            for (int j = 0; j < 8; ++j) { const int i = ib * 8 + j; const unsigned kv = ord_key(v[i]); const bool eq = kv == T; const unsigned long long be = __ballot(eq);
                const int pre = __popcll(be & ((1ull << lane) - 1ull)); const bool sel = (kv > T) || (eq && (taken + pre) < need2); taken += __popcll(be);
                const unsigned long long bs = __ballot(sel); if (lane == 0) { mword[2 * i] = (unsigned)bs; mword[2 * i + 1] = (unsigned)(bs >> 32); } } }
    }
    WAVE_SYNC();
    for (int w = lane; w < MW; w += 64) mrow[w] = mword[w];
}

constexpr int AT_KP = 72, AT_VP = 72, AT_BUF = 64 * AT_KP + 64 * AT_VP;
__device__ __forceinline__ void dsa_attn_half(KArgs C, int bl, int h, int cb, int tid, bf16* tiles, const float* btab) {
    const int lane = tid & 63, wave = tid >> 6, l31 = lane & 31, hh = lane >> 5, c = 4 * cb + (wave >> 1), qb = wave & 1, q0 = c * 64 + qb * 32, qpos = q0 + l31;
    const size_t qrow = (size_t)bl * SEQ + qpos;
    const bf16* Qp = WSP(const bf16, WS_Q) + qrow * 512 + h * 64 + 8 * hh;
    const unsigned* Mp = WSP(const unsigned, WS_MASK) + qrow * MW;
    const bf16* gk = WSP(const bf16, WS_K) + ((size_t)bl * SEQ + (tid >> 3)) * 512 + h * 64 + (tid & 7) * 8;
    const bf16* gv = WSP(const bf16, WS_VT) + ((size_t)(bl * 8 + h) * 64 + (tid >> 3)) * SEQ + (tid & 7) * 8;
    const int lk = (tid >> 3) * AT_KP + (tid & 7) * 8, lv = 64 * AT_KP + (tid >> 3) * AT_VP + (tid & 7) * 8;
    constexpr float SC = 0.125f * 1.44269504089f;
    bf16x8_t qf[4];
#pragma unroll
    for (int s = 0; s < 4; ++s) qf[s] = *(const bf16x8_t*)(Qp + 16 * s);
    f32x16 O0, O1;
#pragma unroll
    for (int r = 0; r < 16; ++r) { O0[r] = 0.f; O1[r] = 0.f; }
    float m = -1e30f, lsum = 0.f;
    const int ntw = c + 1, nt = 4 * cb + 4;
    u32x4 prek = *(const u32x4*)gk, prev = *(const u32x4*)gv; u32x2 mwn = *(const u32x2*)Mp;
    LDS_SYNC();
    const float bfar = btab[0];
    *(u32x4*)(tiles + lk) = prek; *(u32x4*)(tiles + lv) = prev;
    if (nt > 1) { prek = *(const u32x4*)(gk + (size_t)64 * 512); prev = *(const u32x4*)(gv + 64); }
    for (int kt = 0; kt < nt; ++kt) {
        LDS_SYNC();
        const bf16* tb = tiles + (kt & 1) * AT_BUF; const u32x2 mw2 = mwn;
        if (kt + 1 < ntw) mwn = *(const u32x2*)(Mp + 2 * (kt + 1));
        if (kt < ntw) {
            f32x16 S[2];
#pragma unroll
            for (int t2 = 0; t2 < 2; ++t2) {
#pragma unroll
                for (int r = 0; r < 16; ++r) S[t2][r] = 0.f;
#pragma unroll
                for (int s = 0; s < 4; ++s) S[t2] = __builtin_amdgcn_mfma_f32_32x32x16_bf16(*(const bf16x8_t*)(tb + (t2 * 32 + l31) * AT_KP + 16 * s + 8 * hh), qf[s], S[t2], 0, 0, 0); }
            float tmax = -1e30f;
#pragma unroll
            for (int t2 = 0; t2 < 2; ++t2) { const int k0 = kt * 64 + t2 * 32;
                if ((k0 + 31 - q0) <= -166) {
#pragma unroll
                    for (int r = 0; r < 16; ++r) { const float v = S[t2][r] * SC + bfar; S[t2][r] = v; tmax = fmaxf(tmax, v); }
                } else { const int rb = k0 + 4 * hh - qpos + 256;
#pragma unroll
                    for (int r = 0; r < 16; ++r) { const int row = (r & 3) + 8 * (r >> 2); int ti = rb + row; ti = ti < 0 ? 0 : ti; const float v = S[t2][r] * SC + btab[ti]; S[t2][r] = v; tmax = fmaxf(tmax, v); } } }
            tmax = fmaxf(tmax, __shfl_xor(tmax, 32));
            if (__ballot(tmax > m) != 0ull) { const float mn = fmaxf(m, tmax), alpha = __builtin_amdgcn_exp2f(m - mn); m = mn; lsum *= alpha;
#pragma unroll
                for (int r = 0; r < 16; ++r) { O0[r] *= alpha; O1[r] *= alpha; } }
            float ps = 0.f;
#pragma unroll
            for (int t2 = 0; t2 < 2; ++t2) { const unsigned mwc = (t2 == 0 ? mw2.x : mw2.y) << (4 * (1 - hh));
#pragma unroll
                for (int r = 0; r < 16; ++r) { const int row = (r & 3) + 8 * (r >> 2) + 4;
                    const unsigned keep = (unsigned)((int)(mwc << (31 - row)) >> 31);
                    const float p = __uint_as_float(__float_as_uint(__builtin_amdgcn_exp2f(S[t2][r] - m)) & keep); S[t2][r] = p; ps += p; } }
            lsum += ps;
#pragma unroll
            for (int t2 = 0; t2 < 2; ++t2) { const bf16* vb = tb + 64 * AT_KP + l31 * AT_VP + t2 * 32 + 4 * hh;
#pragma unroll
                for (int s = 0; s < 2; ++s) { u32x4 w; w.x = pk2(S[t2][8 * s + 0], S[t2][8 * s + 1]); w.y = pk2(S[t2][8 * s + 2], S[t2][8 * s + 3]); w.z = pk2(S[t2][8 * s + 4], S[t2][8 * s + 5]); w.w = pk2(S[t2][8 * s + 6], S[t2][8 * s + 7]);
                    const bf16x8_t pf = __builtin_bit_cast(bf16x8_t, w);
                    O0 = __builtin_amdgcn_mfma_f32_32x32x16_bf16(frag2(*(const u32x2*)(vb + 16 * s), *(const u32x2*)(vb + 16 * s + 8)), pf, O0, 0, 0, 0);
                    O1 = __builtin_amdgcn_mfma_f32_32x32x16_bf16(frag2(*(const u32x2*)(vb + 32 * AT_VP + 16 * s), *(const u32x2*)(vb + 32 * AT_VP + 16 * s + 8)), pf, O1, 0, 0, 0); } }
        }
        if (kt + 1 < nt) { bf16* nb = tiles + ((kt + 1) & 1) * AT_BUF; *(u32x4*)(nb + lk) = prek; *(u32x4*)(nb + lv) = prev;
            if (kt + 2 < nt) { prek = *(const u32x4*)(gk + (size_t)(kt + 2) * 64 * 512); prev = *(const u32x4*)(gv + (size_t)(kt + 2) * 64); } }
    }
    lsum += __shfl_xor(lsum, 32);
    const float inv = 1.0f / lsum;
    bf16* Y = WSP(bf16, WS_Y) + (size_t)MG * 512 + qrow * 512 + h * 64 + 4 * hh;
#pragma unroll
    for (int g = 0; g < 4; ++g) { u32x2 w; w.x = pk2(O0[4 * g] * inv, O0[4 * g + 1] * inv); w.y = pk2(O0[4 * g + 2] * inv, O0[4 * g + 3] * inv); *(u32x2*)(Y + 8 * g) = w;
        u32x2 w2; w2.x = pk2(O1[4 * g] * inv, O1[4 * g + 1] * inv); w2.y = pk2(O1[4 * g + 2] * inv, O1[4 * g + 3] * inv); *(u32x2*)(Y + 32 + 8 * g) = w2; }
}
__device__ __forceinline__ void dsa_attn_unit3(KArgs C, int unit, int tid, unsigned char* lds) {
    constexpr int NPAIR = NK64 / 8;
    const int pr = unit % NPAIR, h = (unit / NPAIR) & 7, bl = unit / (NPAIR * 8);
    float* btab = (float*)lds; bf16* tiles = (bf16*)(lds + 2048);
    __syncthreads();
    { const int* tab = WSP(const int, WS_TAB); const float* relb = C->in[I_RELB];
      if (tid < 320) btab[tid] = relb[tab[tid - 256 + SEQ - 1] * 8 + h] * 1.44269504089f; }
    dsa_attn_half(C, bl, h, pr, tid, tiles, btab);
    dsa_attn_half(C, bl, h, NK64 / 4 - 1 - pr, tid, tiles, btab);
}
constexpr int SEGS_PER_GROUP = 11, NSEG = DEPTH * (1 + NGRP * SEGS_PER_GROUP) + 1;

#ifdef HOST_EMU
#define GRID_BARRIER() emu_grid_sync()
#define LDS_PTR(p) ((unsigned char*)(p))
#else
#define GRID_BARRIER() do { XcdBarrier b_; b_.bar = (unsigned*)(Ck->ws + WS_CTL); b_.x = xb_xcc_id(); b_.st = (volatile LAS unsigned*)(lds + LDS_CTL_OFF); xcd_barrier(b_); } while (0)
#define LDS_PTR(p) ((PG8_LAS unsigned char*)(p))
#endif

__global__ void __launch_bounds__(NTHREADS, 2) fwd_kernel(Args a) {
#ifdef HOST_EMU
    unsigned char* lds = emu_lds;
#else
    extern __shared__ __attribute__((aligned(16))) unsigned char lds[];
#endif
#ifdef HOST_EMU
    KArgs Ck = &a;
#else
    KArgs Ck = (KArgs)__builtin_amdgcn_kernarg_segment_ptr();
    (void)a;
#endif
#ifndef HOST_EMU
    if (threadIdx.x < 4) ((LAS unsigned*)(lds + LDS_CTL_OFF))[threadIdx.x] = 0u;
    __syncthreads();
    if (Ck->seg_hi - Ck->seg_lo > 1) (void)xcd_barrier_post((unsigned*)(Ck->ws + WS_CTL), (volatile LAS unsigned*)(lds + LDS_CTL_OFF));
#endif
#ifndef PROBE_REP
#define PROBE_REP 0
#endif
#define SEGID 0
#define RUN (SEGID >= Ck->seg_lo && SEGID < Ck->seg_hi)
#define SEAM do { if (SEGID >= Ck->seg_lo && SEGID + 1 < Ck->seg_hi) { GRID_BARRIER(); } } while (0)
#define WO ((layer & 1) ? WDELTA : (size_t)0)
#define PHASE_VARS KArgs C = KLAUNDER(Ck); const int G = gridDim.x, bx = blockIdx.x, ngw = G * NWAVES; (void)ngw; const int tid = fresh_tid(), lane = tid & 63, wave = __builtin_amdgcn_readfirstlane(tid >> 6), gw = bx * NWAVES + wave; (void)lane; (void)gw; (void)C
    for (int layer = 0; layer < DEPTH; ++layer) {
#undef SEGID
#define SEGID (layer * (1 + NGRP * SEGS_PER_GROUP))
        if (RUN) { PHASE_VARS; phase_weights(C, layer, lds, gw, ngw, lane, wave); }
        SEAM;
        for (int grp = 0; grp < NGRP; ++grp) {
#define XIN ((layer == 0 ? C->in[I_X] : (const float*)C->out) + (size_t)grp * MG * D)
#define XOUT (C->out + (size_t)grp * MG * D)
#undef SEGID
#define SEGID (layer * (1 + NGRP * SEGS_PER_GROUP) + 1 + grp * SEGS_PER_GROUP + 0)
            if (RUN) { PHASE_VARS; for (int m = gw; m < MG; m += 2 * ngw) { if (m + ngw < MG) rms_rowN_bf16<2>(XIN + (size_t)m * D, C->in[I_NMIX] + layer * D, WSP(bf16, WS_H) + (size_t)m * D, (size_t)ngw * D, lane); else rms_row_bf16(XIN + (size_t)m * D, C->in[I_NMIX] + layer * D, WSP(bf16, WS_H) + (size_t)m * D, lane); } }
            SEAM;
#undef SEGID
#define SEGID (layer * (1 + NGRP * SEGS_PER_GROUP) + 1 + grp * SEGS_PER_GROUP + 1)
            if (RUN) { PHASE_VARS; pg8::Gemm g{WSP(const bf16, WS_H), WSP(const bf16, WS_WIN + WO), MG, NMIXC, D}; pg8::StaticOrder S; S.init(MG, NMIXC, G, bx);
                pg8::EpiProj E{C->ws};
                pg8::gemm_phase<pg8::EpiProj, pg8::StaticOrder>(LDS_PTR(lds), g, S, E, nullptr); }
            SEAM;
#undef SEGID
#define SEGID (layer * (1 + NGRP * SEGS_PER_GROUP) + 1 + grp * SEGS_PER_GROUP + 2)
            if (RUN) { PHASE_VARS;
                for (int m = gw; m < MG; m += 2 * ngw) { if (m + ngw < MG) { rwkv_prep_row2(C, layer, m, ngw, lane); ssd_conv_row2(C, layer, m, ngw, lane); } else { rwkv_prep_row(C, layer, m, lane); ssd_conv_row(C, layer, m, lane); } }
                for (int it = gw; it < NB * 8 * NK64; it += ngw) dsa_vt_item(C, it, lane, (bf16*)(lds + wave * 16384));
                __syncthreads();
                for (int u = bx; u < NB * NK64 * 8; u += G) dsa_index_unit(C, u, lane, wave, lds);
            }
            SEAM;
#undef SEGID
#define SEGID (layer * (1 + NGRP * SEGS_PER_GROUP) + 1 + grp * SEGS_PER_GROUP + 3)
            if (RUN) { PHASE_VARS; pg8::Gemm g{WSP(const bf16, WS_RA), WSP(const bf16, WS_WLORA + WO), MG, 1536, 256}; pg8::StaticOrder S; S.init(MG, 1536, G, bx);
                pg8::EpiLora E{WSP(float, WS_WLOG), WSP(bf16, WS_ASIG), WSP(bf16, WS_GG), C->in[I_W0] + layer * 512, C->in[I_A0] + layer * 512};
                pg8::gemm_phase<pg8::EpiLora, pg8::StaticOrder>(LDS_PTR(lds), g, S, E, nullptr); }
            SEAM;
#undef SEGID
#define SEGID (layer * (1 + NGRP * SEGS_PER_GROUP) + 1 + grp * SEGS_PER_GROUP + 4)
            if (RUN) { PHASE_VARS;
                constexpr int U_R = NB * 8, U_S = U_R + NB * 8;
                for (int u = bx; u < U_R; u += G) rwkv_unit(C, layer, u, lds);
                for (int u = (bx + G - U_R % G) % G; u < NB * 8; u += G) ssd_unit(C, layer, u, lds);
                { const int first = U_S % G, span = G - first;
                  if (bx >= first) for (int u = bx - first; u < NB * 32; u += span) s5_unit(C, layer, u, lds); }
                for (;;) {
                    const int t2 = fresh_tid();
                    volatile unsigned* qs2 = (volatile unsigned*)(lds + LDS_CTL_OFF + 32);
                    __syncthreads();
                    if (t2 == 0) *qs2 = atomicAdd((unsigned*)(Ck->ws + WS_QCTR) + ((layer * NGRP + grp) * 2) * 64, 1u);
                    __syncthreads();
                    const int u = (int)*qs2;
                    if (u >= NB * NK64) break;
                    dsa_attn_unit3(KLAUNDER(Ck), u, t2, lds);
                }
            }
            SEAM;
#undef SEGID
#define SEGID (layer * (1 + NGRP * SEGS_PER_GROUP) + 1 + grp * SEGS_PER_GROUP + 5)
            if (RUN) { PHASE_VARS;
                { pg8::Gemm g{WSP(const bf16, WS_H), WSP(const bf16, WS_WIN + WO) + (size_t)NMIXC * D, MG, 4096, D}; pg8::StaticOrder S; S.init(MG, 4096, G, bx);
                  pg8::EpiGate E{WSP(bf16, WS_G)}; pg8::gemm_phase<pg8::EpiGate, pg8::StaticOrder>(LDS_PTR(lds), g, S, E, nullptr); }
                { pg8::Gemm g{WSP(const bf16, WS_YD0), WSP(const bf16, WS_GLU + WO), MG, 512, 512}; pg8::StaticOrder S; S.init(MG, 512, G, bx);
                  pg8::EpiGlu E{WSP(const bf16, WS_YD0), WSP(bf16, WS_Y) + (size_t)3 * MG * 512, C->in[I_GLUB] + layer * 512};
                  pg8::gemm_phase<pg8::EpiGlu, pg8::StaticOrder>(LDS_PTR(lds), g, S, E, nullptr); }
                for (int it = gw; it < MG * 2; it += 4 * ngw) ssd_norm_item4(C, layer, it, ngw, MG * 2, lane);
            }
            SEAM;
#undef SEGID
#define SEGID (layer * (1 + NGRP * SEGS_PER_GROUP) + 1 + grp * SEGS_PER_GROUP + 6)
            if (RUN) { PHASE_VARS; pg8::Gemm g{WSP(const bf16, WS_Y), WSP(const bf16, WS_WB + WO), 4 * MG, 4096, 512}; pg8::MergeOrder S{G, bx};
                pg8::EpiMerge E{WSP(const bf16, WS_G), WSP(bf16, WS_MRG)};
                pg8::gemm_phase<pg8::EpiMerge, pg8::MergeOrder>(LDS_PTR(lds), g, S, E, nullptr); }
            SEAM;
#undef SEGID
#define SEGID (layer * (1 + NGRP * SEGS_PER_GROUP) + 1 + grp * SEGS_PER_GROUP + 7)
            if (RUN) { PHASE_VARS; pg8::Gemm g{WSP(const bf16, WS_MRG), WSP(const bf16, WS_WOUT + WO), MG, D, D}; pg8::StaticOrder S; S.init(MG, D, G, bx);
                pg8::EpiResid E{XIN, XOUT}; pg8::gemm_phase<pg8::EpiResid, pg8::StaticOrder>(LDS_PTR(lds), g, S, E, nullptr); }
            SEAM;
#undef SEGID
#define SEGID (layer * (1 + NGRP * SEGS_PER_GROUP) + 1 + grp * SEGS_PER_GROUP + 8)
            if (RUN) { PHASE_VARS; for (int m = gw; m < MG; m += 2 * ngw) { if (m + ngw < MG) rms_rowN_bf16<2>(XOUT + (size_t)m * D, C->in[I_NFFN] + layer * D, WSP(bf16, WS_H) + (size_t)m * D, (size_t)ngw * D, lane); else rms_row_bf16(XOUT + (size_t)m * D, C->in[I_NFFN] + layer * D, WSP(bf16, WS_H) + (size_t)m * D, lane); } }
            SEAM;
#undef SEGID
#define SEGID (layer * (1 + NGRP * SEGS_PER_GROUP) + 1 + grp * SEGS_PER_GROUP + 9)
            if (RUN) { PHASE_VARS; pg8::Gemm g{WSP(const bf16, WS_H), WSP(const bf16, WS_W13 + WO), MG, 5632, D}; pg8::StaticOrder S; S.init(MG, 5632, G, bx);
                pg8::EpiSwiglu E{WSP(bf16, WS_HID)};
                pg8::gemm_phase<pg8::EpiSwiglu, pg8::StaticOrder>(LDS_PTR(lds), g, S, E, nullptr); }
            SEAM;
#undef SEGID
#define SEGID (layer * (1 + NGRP * SEGS_PER_GROUP) + 1 + grp * SEGS_PER_GROUP + 10)
            if (RUN) { PHASE_VARS; pg8::Gemm g{WSP(const bf16, WS_HID), WSP(const bf16, WS_W2 + WO), MG, D, FFN}; pg8::StaticOrder S; S.init(MG, D, G, bx);
                pg8::EpiResid E{XOUT, XOUT}; pg8::gemm_phase<pg8::EpiResid, pg8::StaticOrder>(LDS_PTR(lds), g, S, E, nullptr); }
            SEAM;
        }
    }
#undef SEGID
#define SEGID (NSEG - 1)
    { const int layer = 0; (void)layer;
    if (RUN) { PHASE_VARS; for (int m = gw; m < M; m += 2 * ngw) { if (m + ngw < M) rms_row2_f32(C->out + (size_t)m * D, (size_t)ngw * D, C->in[I_NFIN], lane); else rms_row_f32(C->out + (size_t)m * D, C->in[I_NFIN], lane); } } }
#undef RUN
#undef SEAM
}

extern "C" void kernel_launch(void* const* d_in, const int* in_sizes, int n_in, void* d_out, int out_size, void* d_ws, size_t ws_size, hipStream_t stream) {
    static int grid = 0;
    if (grid == 0) {
        if (n_in != N_IN || out_size != M * D || ws_size < WS_END) { fprintf(stderr, "kernel_launch: unexpected shapes (n_in %d, out %d, ws %zu < %zu)\n", n_in, out_size, ws_size, (size_t)WS_END); grid = -1; return; }
        int dev = 0, cus = 0;
        if (hipGetDevice(&dev) != hipSuccess || hipDeviceGetAttribute(&cus, hipDeviceAttributeMultiprocessorCount, dev) != hipSuccess || cus < 1) { grid = -1; return; }
        if (hipFuncSetAttribute((const void*)fwd_kernel, hipFuncAttributeMaxDynamicSharedMemorySize, LDS_BYTES) != hipSuccess) { fprintf(stderr, "kernel_launch: hipFuncSetAttribute failed\n"); grid = -1; return; }
        (void)hipGetLastError();
        grid = cus;
    }
    if (grid < 0) return;
    (void)hipMemsetAsync((char*)d_ws + WS_CTL, 0, CTL_BYTES, stream);
    Args a{};
    for (int i = 0; i < N_IN; ++i) a.in[i] = (const float*)d_in[i];
    a.out = (float*)d_out; a.ws = (unsigned char*)d_ws;
#if CFG_LAUNCHES == 1
    a.seg_lo = 0; a.seg_hi = NSEG;
    hipLaunchKernelGGL(fwd_kernel, dim3(grid), dim3(NTHREADS), LDS_BYTES, stream, a);
#else
    for (int s = 0; s < NSEG; ++s) { a.seg_lo = s; a.seg_hi = s + 1; hipLaunchKernelGGL(fwd_kernel, dim3(grid), dim3(NTHREADS), LDS_BYTES, stream, a); }
#endif
}
```

```cpp
#ifdef HOST_EMU
#error "HOST_EMU is a host-only debug build"
#else
#include <hip/hip_runtime.h>
#endif
#include <cstdio>
#include <cstdint>
#include <cmath>

#ifndef CFG_BATCH
#define CFG_BATCH 16
#endif
#ifndef CFG_SEQ
#define CFG_SEQ 4096
#endif
#ifndef CFG_DEPTH
#define CFG_DEPTH 4
#endif
#ifndef CFG_NB
#define CFG_NB 8
#endif
#ifndef CFG_LAUNCHES
#define CFG_LAUNCHES 1
#endif

typedef unsigned short bf16;
typedef float f32x4 __attribute__((ext_vector_type(4)));
typedef float f32x2 __attribute__((ext_vector_type(2)));
typedef unsigned u32x4 __attribute__((ext_vector_type(4)));
typedef unsigned u32x2 __attribute__((ext_vector_type(2)));

constexpr int BATCH = CFG_BATCH, SEQ = CFG_SEQ, DEPTH = CFG_DEPTH, NB = CFG_NB;
constexpr int D = 1024, M = BATCH * SEQ, MG = NB * SEQ, NGRP = BATCH / NB;
constexpr int IN_COLS = 9388, NPROJ = 9472, NMIXC = 5376, FFN = 2816;
constexpr int TOPK = (SEQ / 4) < 256 ? (SEQ / 4) : 256;
constexpr int NK64 = SEQ / 64, MW = SEQ / 32;
constexpr float RMS_EPS = 1e-6f, GN_EPS = 64e-5f;
static_assert(BATCH % NB == 0 && MG % 256 == 0 && SEQ % 64 == 0, "shape");

enum { I_X = 0, I_RELB, I_NMIX, I_WIN, I_CONVW, I_CONVB, I_DTB, I_ALOG, I_SSDD, I_SSDNG, I_MU, I_W0, I_W2, I_A0, I_A2, I_G2, I_KK, I_KA, I_RK, I_LNG, I_LNB,
       I_S5ARE, I_S5AIM, I_S5BRE, I_S5BIM, I_S5CRE, I_S5CIM, I_S5D, I_S5LDT, I_GLUW, I_GLUB, I_WBR, I_WOUT, I_NFFN, I_W1, I_W3, I_W2F, I_NFIN, N_IN };

constexpr size_t MiB = 1u << 20;
constexpr size_t al256(size_t x) { return (x + 255) & ~(size_t)255; }
constexpr size_t WS_CTL = 0, CTL_BYTES = 64 * 1024;
constexpr size_t WS_TAB = WS_CTL + CTL_BYTES;
constexpr size_t WS_ABAR = al256(WS_TAB + (SEQ + 64) * 4);
constexpr size_t WS_BBAR = WS_ABAR + 32 * 64 * 2 * 4;
constexpr size_t WS_WIN = al256(WS_BBAR + 32 * 64 * 16 * 2 * 4);
constexpr size_t WS_WB = WS_WIN + (size_t)NPROJ * 1024 * 2;
constexpr size_t WS_WOUT = WS_WB + (size_t)4 * 1024 * 512 * 2;
constexpr size_t WS_W13 = WS_WOUT + (size_t)1024 * 1024 * 2;
constexpr size_t WS_W2 = WS_W13 + (size_t)5632 * 1024 * 2;
constexpr size_t WS_GLU = WS_W2 + (size_t)1024 * 2816 * 2;
constexpr size_t WS_WLORA = WS_GLU + (size_t)512 * 512 * 2;
constexpr size_t WS_H = al256(WS_WLORA + (size_t)1536 * 256 * 2);
constexpr size_t WS_Z = WS_H + (size_t)MG * 1024 * 2;
constexpr size_t WS_XBC = WS_Z + (size_t)MG * 512 * 2;
constexpr size_t WS_Q = WS_XBC + (size_t)MG * 768 * 2;
constexpr size_t WS_K = WS_Q + (size_t)MG * 512 * 2;
constexpr size_t WS_V = WS_K + (size_t)MG * 512 * 2;
constexpr size_t WS_RW = WS_V + (size_t)MG * 512 * 2;
constexpr size_t WS_U = WS_RW + (size_t)MG * 1792 * 2;
constexpr size_t WS_SM = WS_U + (size_t)MG * 512 * 2;
constexpr size_t WS_G = WS_Q;
constexpr size_t WS_Y = WS_SM + (size_t)MG * 256 * 2;
constexpr size_t WS_YD0 = WS_Y + (size_t)4 * MG * 512 * 2;
constexpr size_t WS_MRG = WS_YD0 + (size_t)MG * 512 * 2;
constexpr size_t WS_MASK = WS_MRG + (size_t)MG * 1024 * 2;
constexpr size_t WS_RA = WS_MASK + (size_t)MG * MW * 4;
constexpr size_t WS_WLOG = WS_RA + (size_t)MG * 256 * 2;
constexpr size_t WS_ASIG = WS_WLOG + (size_t)MG * 512 * 4;
constexpr size_t WS_GG = WS_ASIG + (size_t)MG * 512 * 2;
constexpr size_t WS_XBA = WS_GG + (size_t)MG * 512 * 2;
constexpr size_t WS_VT = WS_XBA + (size_t)MG * 768 * 2;
constexpr size_t WS_KI = WS_VT + (size_t)MG * 512 * 2;
constexpr size_t WS_QCTR = 16384;
constexpr size_t WS_HID = WS_G;
constexpr size_t WS_WALT = al256(WS_KI + (size_t)MG * 32 * 2);
constexpr size_t WDELTA = WS_WALT - WS_ABAR;
constexpr size_t WS_END = WS_WALT + (WS_H - WS_ABAR);
static_assert(WS_SM + (size_t)MG * 256 * 2 - WS_Q == (size_t)MG * 4096 * 2, "G overlays exactly Q..SM");
static_assert((size_t)MG * 2816 * 2 <= (size_t)MG * 4096 * 2, "HID fits in G");

constexpr int LDS_SCRATCH = 131072;
constexpr int LDS_CTL_OFF = LDS_SCRATCH;
constexpr int LDS_X = LDS_SCRATCH + 64;
constexpr int LDS_BYTES = 161792;
constexpr int NTHREADS = 512, NWAVES = 8;

__device__ __forceinline__ float bf2f(bf16 v) { return __uint_as_float(((unsigned)v) << 16); }
#ifdef HOST_EMU
__device__ __forceinline__ bf16 f2bf(float f) { unsigned u = __float_as_uint(f); u += 0x7fffu + ((u >> 16) & 1u); return (bf16)(u >> 16); }
#else
__device__ __forceinline__ bf16 f2bf(float f) { return __builtin_bit_cast(bf16, (__bf16)f); }
#endif
#ifdef HOST_EMU
__device__ __forceinline__ unsigned pk2(float lo, float hi) { return (unsigned)f2bf(lo) | ((unsigned)f2bf(hi) << 16); }
#else
typedef __bf16 bf16x2_hw __attribute__((ext_vector_type(2)));
__device__ __forceinline__ unsigned pk2(float lo, float hi) { const f32x2 v = {lo, hi}; return __builtin_bit_cast(unsigned, __builtin_convertvector(v, bf16x2_hw)); }
#endif
__device__ __forceinline__ float lo_bf(unsigned w) { return __uint_as_float(w << 16); }
__device__ __forceinline__ float hi_bf(unsigned w) { return __uint_as_float(w & 0xffff0000u); }
__device__ __forceinline__ float sigm(float x) { return 1.0f / (1.0f + __expf(-x)); }
__device__ __forceinline__ float softplusf(float x) { return x > 20.f ? x : log1pf(__expf(x)); }
__device__ __forceinline__ float gelu_tanh(float x) { const float u = 0.7978845608f * (x + 0.044715f * x * x * x); return 0.5f * x * (1.0f + tanhf(u)); }
__device__ __forceinline__ float wave_sum(float v) {
#pragma unroll
    for (int o = 1; o < 64; o <<= 1) v += __shfl_xor(v, o);
    return v;
}
__device__ __forceinline__ float wave_max(float v) {
#pragma unroll
    for (int o = 1; o < 64; o <<= 1) v = fmaxf(v, __shfl_xor(v, o));
    return v;
}
__device__ __forceinline__ int wave_sum_i(int v) {
#pragma unroll
    for (int o = 1; o < 64; o <<= 1) v += __shfl_xor(v, o);
    return v;
}
#ifdef HOST_EMU
#define WAVE_SYNC() (void)emu_wave_exchange(0)
#define SCHED_FENCE() do {} while (0)
#define LDS_SYNC() __syncthreads()
#else
#define WAVE_SYNC() __builtin_amdgcn_wave_barrier()
#define SCHED_FENCE() __builtin_amdgcn_sched_barrier(0)
#define LDS_SYNC() do { asm volatile("s_waitcnt lgkmcnt(0)" ::: "memory"); __builtin_amdgcn_s_barrier(); asm volatile("" ::: "memory"); } while (0)
#endif
#ifndef HOST_EMU
namespace pg8 {
__device__ __forceinline__ int pg8_fresh_tid() { int t = (int)threadIdx.x; asm volatile("" : "+v"(t)); return t; }
#define PG8_LAS __attribute__((address_space(3)))
typedef unsigned short bf16_t;
typedef short bf16x8 __attribute__((ext_vector_type(8)));
typedef float f32x4 __attribute__((ext_vector_type(4)));
typedef unsigned u32x4 __attribute__((ext_vector_type(4)));
constexpr int BM = 256, BK = 64, HALF = 128, HTB = HALF * BK * 2  , STAGE_BYTES = 8 * HTB, NXCD = 8, WGM = 8;

__host__ __device__ __forceinline__ int lds_byte(int r, int c) { const int st = (r >> 4) * 2 + (c >> 5), rr = r & 15, cc = c & 31, ob = rr * 64 + cc * 2; return st * 1024 + (ob ^ (((ob >> 9) & 1) << 5)); }
__host__ __device__ __forceinline__ void stage_rc(int b, int& R, int& C) { const int st = b / 1024, sb = b % 1024, swz = sb ^ (((sb >> 9) & 1) << 5); R = (st >> 1) * 16 + swz / 64; C = (st & 1) * 32 + (swz % 64) / 2; }
__host__ __device__ __forceinline__ int perm32(int rho) { const int n = rho >> 4, i = rho & 15; return 8 * (i >> 2) + 4 * n + (i & 3); }

struct Unit { int pm, pn; };
struct Gemm { const bf16_t* A; const bf16_t* Bt; int M, N, K; };

struct StaticOrder {
    int nM, nN, nwg, G, c;
    __host__ __device__ void init(int M, int N, int G_, int c_) { nM = M / BM; nN = N / BM; nwg = nM * nN; G = G_; c = c_; }
    __host__ __device__ bool next(int i, Unit& u) const {
        const long L = (long)i * G + c; if (L >= nwg) return false;
        int wgid = (int)L; { const int q = nwg / NXCD, r = nwg % NXCD, xcd = wgid % NXCD, off = wgid / NXCD; wgid = (xcd < r ? xcd * (q + 1) : r * (q + 1) + (xcd - r) * q) + off; }
        const int nig = WGM * nN, gid = wgid / nig, fm = gid * WGM, gsz = (nM - fm) < WGM ? (nM - fm) : WGM;
        u.pm = fm + ((wgid % nig) % gsz); u.pn = (wgid % nig) / gsz; return true;
    }
    __device__ __forceinline__ void a_ready(const Unit&) const {}
    __device__ __forceinline__ void done(const Unit&) const {}
};

__device__ __forceinline__ unsigned cvt_pk_bf16(float lo, float hi) { return pk2(lo, hi); }

template <class E, class = void> struct epi_keep { static constexpr bool value = false; };
template <class E> struct epi_keep<E, decltype((void)E::KEEP_ACC)> { static constexpr bool value = true; };
template <class Epi, class Sched, bool STAMP = false>
__device__ __forceinline__ void gemm_phase(PG8_LAS unsigned char* lds, const Gemm g, const Sched& S, const Epi& E, unsigned long long* stamps) {
    const int tid = pg8_fresh_tid(), wid = __builtin_amdgcn_readfirstlane(tid >> 6), lane = tid & 63, wr = wid >> 2, wc = wid & 3, fr = lane & 15, fq = lane >> 4;
    int K_ = g.K; asm volatile("" : "+s"(K_));
    const int K = K_, nt = K / BK;
    int ts_lo = 0, ts_hi = 0, nts = 0; const unsigned long long rt_entry = STAMP ? (unsigned long long)wall_clock64() : 0ull;
#define PG8_STAMP() do { if (STAMP && wid == 0 && nts < 64) { const unsigned long long _c = (unsigned long long)clock64(); \
        ts_lo = (lane == nts) ? (int)(unsigned)_c : ts_lo; ts_hi = (lane == nts) ? (int)(unsigned)(_c >> 32) : ts_hi; ++nts; } } while (0)
    PG8_STAMP();
    unsigned voffA[2], voffB[2];
#pragma unroll
    for (int i = 0; i < 2; ++i) { int R, C; stage_rc(tid * 16 + i * 8192, R, C); const int Rb = Epi::PERM ? ((R & ~31) + perm32(R & 31)) : R;
        voffA[i] = (unsigned)(R * K + C) * 2u; voffB[i] = (unsigned)(Rb * K + C) * 2u; }
    const size_t kstep = (size_t)(BK * 2);
    const size_t hstep = (size_t)HALF * K * 2;
    const size_t tstep = 2 * hstep;
    const unsigned ldsw = (unsigned)wid * 1024u;
    const int aoff = lds_byte(wr * 64 + fr, fq * 8), boff = lds_byte(wc * 32 + fr, fq * 8);
#define PG8_SA(b, h) (((b) * 2 + (h)) * HTB)
#define PG8_SB(b, h) ((4 + (b) * 2 + (h)) * HTB)
#define PG8_STAGE(bufoff, gbase, voff) do { _Pragma("unroll") for (int _i = 0; _i < 2; ++_i) \
        __builtin_amdgcn_global_load_lds((const unsigned*)((const char*)(gbase) + (voff)[_i]), (PG8_LAS unsigned*)(lds + (bufoff) + ldsw + _i * 8192), 16, 0, 0); } while (0)
#define PG8_LDA(dst, b, h) do { _Pragma("unroll") for (int m = 0; m < 4; ++m) _Pragma("unroll") for (int k = 0; k < 2; ++k) dst[m][k] = *(const PG8_LAS bf16x8*)(lds + PG8_SA(b, h) + aoff + m * 2048 + k * 1024); } while (0)
#define PG8_LDB(dst, b, h) do { _Pragma("unroll") for (int n = 0; n < 2; ++n) _Pragma("unroll") for (int k = 0; k < 2; ++k) dst[n][k] = *(const PG8_LAS bf16x8*)(lds + PG8_SB(b, h) + boff + n * 2048 + k * 1024); } while (0)
#define PG8_MMA(ai, bj, At, Bt) do { __builtin_amdgcn_s_setprio(1); _Pragma("unroll") for (int m = 0; m < 4; ++m) _Pragma("unroll") for (int n = 0; n < 2; ++n) _Pragma("unroll") for (int k = 0; k < 2; ++k) \
        acc[ai][bj][m][n] = __builtin_amdgcn_mfma_f32_16x16x32_bf16(Bt[n][k], At[m][k], acc[ai][bj][m][n], 0, 0, 0); __builtin_amdgcn_s_setprio(0); } while (0)
#define PG8_WAIT_V(n) asm volatile("s_waitcnt vmcnt(" #n ")" ::: "memory")
#define PG8_WAIT_L(n) asm volatile("s_waitcnt lgkmcnt(" #n ")" ::: "memory")
#define PG8_BAR __builtin_amdgcn_s_barrier()
#define PG8_SCHED __builtin_amdgcn_sched_barrier(0)
    Unit cur, nxt; int ui = 0;
    if (!S.next(0, cur)) return;
    f32x4 acc[2][2][4][2];
#pragma unroll
    for (int a = 0; a < 2; ++a)
#pragma unroll
        for (int b = 0; b < 2; ++b)
#pragma unroll
            for (int m = 0; m < 4; ++m)
#pragma unroll
                for (int n = 0; n < 2; ++n) acc[a][b][m][n] = (f32x4){0.f, 0.f, 0.f, 0.f};
    bf16x8 At[4][2], B0[2][2], B1[2][2];
    const char* cA = (const char*)g.A + (size_t)cur.pm * tstep; const char* cB = (const char*)g.Bt + (size_t)cur.pn * tstep;
    S.a_ready(cur);
    PG8_STAGE(PG8_SB(0, 0), cB, voffB); PG8_STAGE(PG8_SA(0, 0), cA, voffA); PG8_STAGE(PG8_SB(0, 1), cB + hstep, voffB); PG8_STAGE(PG8_SA(0, 1), cA + hstep, voffA);
    if (wr == 1) PG8_BAR;
    PG8_WAIT_V(4); PG8_BAR;
    PG8_STAGE(PG8_SB(1, 0), cB + kstep, voffB); PG8_STAGE(PG8_SA(1, 0), cA + kstep, voffA); PG8_STAGE(PG8_SB(1, 1), cB + hstep + kstep, voffB);
    PG8_WAIT_V(6); PG8_BAR;
    PG8_STAMP();
    for (;;) {
        const bool has_next = S.next(ui + 1, nxt);
        const char* nA = has_next ? (const char*)g.A + (size_t)nxt.pm * tstep : cA; const char* nB = has_next ? (const char*)g.Bt + (size_t)nxt.pn * tstep : cB;
        for (int t = 0; t < nt; t += 2) {
            const bool last = (t == nt - 2);
            const char* a1 = cA + (size_t)(t + 1) * kstep;
            const char* a2 = last ? nA : cA + (size_t)(t + 2) * kstep; const char* b2 = last ? nB : cB + (size_t)(t + 2) * kstep;
            const char* a3 = a2 + kstep; const char* b3 = b2 + kstep;
            if (last && has_next) S.a_ready(nxt);
            PG8_LDB(B0, 0, 0); PG8_SCHED; PG8_LDA(At, 0, 0); PG8_STAGE(PG8_SA(1, 1), a1 + hstep, voffA);
            PG8_WAIT_L(8); PG8_BAR; PG8_WAIT_L(0); PG8_MMA(0, 0, At, B0); PG8_BAR; PG8_SCHED;
            PG8_LDB(B1, 0, 1); PG8_STAGE(PG8_SB(0, 0), b2, voffB);
            PG8_BAR; PG8_WAIT_L(0); PG8_MMA(0, 1, At, B1); PG8_BAR;
            PG8_LDA(At, 0, 1); PG8_STAGE(PG8_SA(0, 0), a2, voffA);
            PG8_BAR; PG8_WAIT_L(0); PG8_MMA(1, 0, At, B0); PG8_BAR; PG8_SCHED;
            PG8_STAGE(PG8_SB(0, 1), b2 + hstep, voffB);
            PG8_WAIT_V(6); PG8_BAR; PG8_MMA(1, 1, At, B1); PG8_BAR;
            PG8_LDB(B0, 1, 0); PG8_SCHED; PG8_LDA(At, 1, 0); PG8_STAGE(PG8_SA(0, 1), a2 + hstep, voffA);
            PG8_WAIT_L(8); PG8_BAR; PG8_WAIT_L(0); PG8_MMA(0, 0, At, B0); PG8_BAR; PG8_SCHED;
            PG8_LDB(B1, 1, 1); PG8_STAGE(PG8_SB(1, 0), b3, voffB);
            PG8_BAR; PG8_WAIT_L(0); PG8_MMA(0, 1, At, B1); PG8_BAR;
            PG8_LDA(At, 1, 1); PG8_STAGE(PG8_SA(1, 0), a3, voffA);
            PG8_BAR; PG8_WAIT_L(0); PG8_MMA(1, 0, At, B0); PG8_BAR; PG8_SCHED;
            PG8_STAGE(PG8_SB(1, 1), b3 + hstep, voffB);
            PG8_WAIT_V(6); PG8_BAR; PG8_MMA(1, 1, At, B1); PG8_BAR;
        }
        PG8_STAMP();
        if constexpr (!Epi::AFTER_DRAIN) { E(acc, cur, wr, wc, fr, fq); S.done(cur); }
        PG8_STAMP();
        if (!has_next) break;
        bool zero_acc = true; if constexpr (epi_keep<Epi>::value) zero_acc = !E.keep(cur);
        if (zero_acc) {
#pragma unroll
        for (int a = 0; a < 2; ++a)
#pragma unroll
            for (int b = 0; b < 2; ++b)
#pragma unroll
                for (int m = 0; m < 4; ++m)
#pragma unroll
                    for (int n = 0; n < 2; ++n) acc[a][b][m][n] = (f32x4){0.f, 0.f, 0.f, 0.f}; }
        cur = nxt; cA = nA; cB = nB; ++ui;
    }
    PG8_WAIT_V(0);
    if (wr == 0) PG8_BAR;
    PG8_BAR;
    if constexpr (Epi::AFTER_DRAIN) { E.fused(acc, cur, wr, wc, fr, fq, lds, wid, lane); S.done(cur); }
    PG8_STAMP();
    if (STAMP && wid == 0) { stamps[lane] = lane < nts ? (((unsigned long long)(unsigned)ts_hi << 32) | (unsigned)ts_lo) : 0ull;
        if (lane == 62) stamps[62] = rt_entry; if (lane == 63) stamps[63] = (unsigned long long)wall_clock64(); }
#undef PG8_STAMP
#undef PG8_SA
#undef PG8_SB
#undef PG8_STAGE
#undef PG8_LDA
#undef PG8_LDB
#undef PG8_MMA
#undef PG8_WAIT_V
#undef PG8_WAIT_L
#undef PG8_BAR
#undef PG8_SCHED
}
}

#define XB_TMO      128
#define XB_XCNT(j)  (256  + 64 * (j))
#define XB_XSUB(j)  (1280 + 64 * (j))
#define XB_XGEN(j)  (2304 + 64 * (j))
#define XB_TOP      3328
#define XB_TOPGEN   3392
#define XCD_BAR_WORDS 3456
#define XB_SPIN_CAP (1u << 18)
#define LAS __attribute__((address_space(3)))

__device__ __forceinline__ unsigned xb_ld(unsigned* p)              { return __hip_atomic_load(p, __ATOMIC_RELAXED, __HIP_MEMORY_SCOPE_AGENT); }
__device__ __forceinline__ unsigned xb_add(unsigned* p, unsigned v) { return __hip_atomic_fetch_add(p, v, __ATOMIC_RELAXED, __HIP_MEMORY_SCOPE_AGENT); }
__device__ __forceinline__ unsigned xb_xcc_id() { return (unsigned)__builtin_amdgcn_s_getreg((3 << 11) | 20) & 0xFu; }
#define XB_SPIN(cond, bar) do { unsigned _sp = 0; while (cond) { __builtin_amdgcn_s_sleep(1); \
    if ((++_sp & 255u) == 0u) { if (xb_ld(&(bar)[XB_TMO])) break; if (_sp > XB_SPIN_CAP) { atomicAdd(&(bar)[XB_TMO], 1u); break; } } } } while (0)

struct XcdBarrier {
    unsigned* bar; unsigned x;
    volatile LAS unsigned* st;
};

__device__ __forceinline__ XcdBarrier xcd_barrier_post(unsigned* bar, volatile LAS unsigned* st) {
    XcdBarrier b; b.bar = bar; b.x = xb_xcc_id(); b.st = st;
    if (threadIdx.x == 0) (void)xb_add(&bar[XB_XCNT(b.x)], 1u);
    return b;
}
__device__ __forceinline__ void xcd_barrier_complete(unsigned* bar, unsigned x, unsigned& nloc, unsigned& nx) {
    const unsigned G = gridDim.x * gridDim.y * gridDim.z;
    unsigned sum, cnt, mine, sp = 0u;
    for (;;) {
        sum = 0u; cnt = 0u; mine = 0u;
#pragma unroll
        for (unsigned j = 0; j < 16; ++j) { const unsigned c = xb_ld(&bar[XB_XCNT(j)]); sum += c; cnt += (c > 0u) ? 1u : 0u; mine = (j == x) ? c : mine; }
        if (sum == G) break;
        __builtin_amdgcn_s_sleep(1);
        if ((++sp & 255u) == 0u) { if (xb_ld(&bar[XB_TMO])) break; if (sp > XB_SPIN_CAP) { atomicAdd(&bar[XB_TMO], 1u); break; } }
    }
    nloc = mine > 0u ? mine : 1u; nx = cnt > 0u ? cnt : 1u;
}

__device__ __forceinline__ void xcd_barrier(const XcdBarrier& b) {
    asm volatile("s_waitcnt vmcnt(0)" ::: "memory");
    __syncthreads();
    if (threadIdx.x == 0) {
        unsigned* bar = b.bar;
        __builtin_amdgcn_s_waitcnt(0);
        unsigned nloc = b.st[0], nx = b.st[1];
        if (nloc == 0u) { xcd_barrier_complete(bar, b.x, nloc, nx); b.st[0] = nloc; b.st[1] = nx; }
        const unsigned old = xb_add(&bar[XB_XSUB(b.x)], 1u);
        const unsigned gen = old / nloc;
        if (old + 1u == (gen + 1u) * nloc) {
            __builtin_amdgcn_fence(__ATOMIC_RELEASE, "agent");
            asm volatile("s_waitcnt vmcnt(0)" ::: "memory");
            const unsigned og = xb_add(&bar[XB_TOP], 1u);
            const unsigned tg = og / nx;
            if (og + 1u == (tg + 1u) * nx) xb_add(&bar[XB_TOPGEN], 1u);
            else XB_SPIN(xb_ld(&bar[XB_TOPGEN]) == tg, bar);
            __builtin_amdgcn_fence(__ATOMIC_ACQUIRE, "agent");
            xb_add(&bar[XB_XGEN(b.x)], 1u);
            asm volatile("s_waitcnt vmcnt(0)" ::: "memory");
        } else {
            XB_SPIN(xb_ld(&bar[XB_XGEN(b.x)]) == gen, bar);
            __builtin_amdgcn_fence(__ATOMIC_ACQUIRE, "agent");
            asm volatile("s_waitcnt vmcnt(0)" ::: "memory");
        }
    }
    __syncthreads();
}

#else
namespace pg8 {
typedef unsigned short bf16_t;
typedef float f32x4 __attribute__((ext_vector_type(4)));
typedef unsigned u32x4 __attribute__((ext_vector_type(4)));
constexpr int BM = 256, BK = 64, HALF = 128, NXCD = 8, WGM = 8;
struct Unit { int pm, pn; };
struct Gemm { const bf16_t* A; const bf16_t* Bt; int M, N, K; };
template <class E, class = void> struct epi_keep { static constexpr bool value = false; };
template <class E> struct epi_keep<E, decltype((void)E::KEEP_ACC)> { static constexpr bool value = true; };
struct StaticOrder {
    int nM, nN, nwg, G, c;
    void init(int M, int N, int G_, int c_) { nM = M / BM; nN = N / BM; nwg = nM * nN; G = G_; c = c_; }
    bool next(int i, Unit& u) const {
        const long L = (long)i * G + c; if (L >= nwg) return false;
        int wgid = (int)L; { const int q = nwg / NXCD, r = nwg % NXCD, xcd = wgid % NXCD, off = wgid / NXCD; wgid = (xcd < r ? xcd * (q + 1) : r * (q + 1) + (xcd - r) * q) + off; }
        const int nig = WGM * nN, gid = wgid / nig, fm = gid * WGM, gsz = (nM - fm) < WGM ? (nM - fm) : WGM;
        u.pm = fm + ((wgid % nig) % gsz); u.pn = (wgid % nig) / gsz; return true;
    }
    void a_ready(const Unit&) const {}
    void done(const Unit&) const {}
};
static inline unsigned cvt_pk_bf16(float lo, float hi) { return pk2(lo, hi); }
static float* emu_tile_buf(int b) { static std::vector<std::vector<float>> t; if ((int)t.size() <= b) t.resize(b + 1); if (t[b].empty()) t[b].resize(256 * 256); return t[b].data(); }
template <class Epi, class Sched, bool STAMP = false>
void gemm_phase(unsigned char* lds, const Gemm g, const Sched& S, const Epi& E, unsigned long long* stamps) {
    const int tid = threadIdx.x, wid = tid >> 6, lane = tid & 63, wr = wid >> 2, wc = wid & 3, fr = lane & 15, fq = lane >> 4;
    float* tile = emu_tile_buf(blockIdx.x);
    Unit u; f32x4 acc[2][2][4][2]; bool keep_next = false;
    for (int ui = 0; S.next(ui, u); ++ui) {
        __syncthreads();
        if (tid == 0) {
            std::vector<float> a((size_t)256 * g.K), b((size_t)256 * g.K);
            for (int r = 0; r < 256; ++r) for (int k = 0; k < g.K; ++k) { a[(size_t)r * g.K + k] = bf2f(g.A[((size_t)u.pm * 256 + r) * g.K + k]); b[(size_t)r * g.K + k] = bf2f(g.Bt[((size_t)u.pn * 256 + r) * g.K + k]); }
            for (int r = 0; r < 256; ++r) for (int c = 0; c < 256; ++c) { const float* ar = &a[(size_t)r * g.K]; const float* br = &b[(size_t)c * g.K]; float s = 0.f; for (int k = 0; k < g.K; ++k) s += ar[k] * br[k]; tile[r * 256 + c] = s; }
        }
        __syncthreads();
        if (!keep_next) for (int ai = 0; ai < 2; ++ai) for (int bj = 0; bj < 2; ++bj) for (int m = 0; m < 4; ++m) for (int n = 0; n < 2; ++n) acc[ai][bj][m][n] = (f32x4){0.f, 0.f, 0.f, 0.f};
        for (int ai = 0; ai < 2; ++ai) for (int bj = 0; bj < 2; ++bj) for (int m = 0; m < 4; ++m) for (int n = 0; n < 2; ++n) for (int j = 0; j < 4; ++j) {
            const int r = 128 * ai + 64 * wr + 16 * m + fr;
            const int c = Epi::PERM ? (128 * bj + 32 * wc + 8 * fq + 4 * n + j) : (128 * bj + 32 * wc + 16 * n + 4 * fq + j);
            acc[ai][bj][m][n][j] += tile[r * 256 + c];
        }
        E(acc, u, wr, wc, fr, fq); S.done(u);
        if constexpr (epi_keep<Epi>::value) keep_next = E.keep(u); else keep_next = false;
        __syncthreads();
    }
}
}
#endif
namespace pg8 {
#ifdef HOST_EMU
#define EPI_FENCE() do {} while (0)
#else
#define EPI_FENCE() asm volatile("" ::: "memory")
#endif
__device__ __forceinline__ u32x4 pack8(const f32x4 v0, const f32x4 v1) { u32x4 w; w.x = cvt_pk_bf16(v0[0], v0[1]); w.y = cvt_pk_bf16(v0[2], v0[3]); w.z = cvt_pk_bf16(v1[0], v1[1]); w.w = cvt_pk_bf16(v1[2], v1[3]); return w; }
__device__ __forceinline__ void unpack8(const u32x4 w, f32x4& v0, f32x4& v1) { v0 = (f32x4){lo_bf(w.x), hi_bf(w.x), lo_bf(w.y), hi_bf(w.y)}; v1 = (f32x4){lo_bf(w.z), hi_bf(w.z), lo_bf(w.w), hi_bf(w.w)}; }
__device__ __forceinline__ f32x4 sig4(const f32x4 v) { return (f32x4){sigm(v[0]), sigm(v[1]), sigm(v[2]), sigm(v[3])}; }

struct EpiProj {
    static constexpr bool PERM = true, AFTER_DRAIN = false;
    unsigned char* ws;
    __device__ __forceinline__ void operator()(const f32x4 (&acc)[2][2][4][2], const Unit& u, int wr, int wc, int fr, int fq) const {
        const int pn = u.pn; size_t off; int ld, c0;
        if (pn < 2) { off = WS_Z; ld = 512; c0 = pn * 256; }
        else if (pn < 5) { off = WS_XBC; ld = 768; c0 = (pn - 2) * 256; }
        else if (pn < 7) { off = WS_Q; ld = 512; c0 = (pn - 5) * 256; }
        else if (pn < 9) { off = WS_K; ld = 512; c0 = (pn - 7) * 256; }
        else if (pn < 11) { off = WS_V; ld = 512; c0 = (pn - 9) * 256; }
        else if (pn < 18) { off = WS_RW; ld = 1792; c0 = (pn - 11) * 256; }
        else if (pn < 20) { off = WS_U; ld = 512; c0 = (pn - 18) * 256; }
        else { off = WS_SM; ld = 256; c0 = 0; }
        bf16_t* dst = (bf16_t*)(ws + off);
        const int row0 = u.pm * BM + wr * 64 + fr, col0 = c0 + wc * 32 + 8 * fq;
        const int kic = HALF + wc * 32 + 8 * fq - 136;
        const bool ki = (pn == 20) && kic >= 0 && kic < 32;
#pragma unroll
        for (int ai = 0; ai < 2; ++ai)
#pragma unroll
            for (int m = 0; m < 4; ++m) { const size_t row = (size_t)(row0 + ai * HALF + m * 16); bf16_t* rowp = dst + row * ld + col0;
#pragma unroll
                for (int bj = 0; bj < 2; ++bj) { const u32x4 w = pack8(acc[ai][bj][m][0], acc[ai][bj][m][1]); *(u32x4*)(rowp + bj * HALF) = w;
                    if (bj == 1 && ki) *(u32x4*)((bf16_t*)(ws + WS_KI) + row * 32 + kic) = w; } }
    }
};
struct EpiGate {
    static constexpr bool PERM = true, AFTER_DRAIN = false;
    bf16_t* G;
    __device__ __forceinline__ void operator()(const f32x4 (&acc)[2][2][4][2], const Unit& u, int wr, int wc, int fr, int fq) const {
        const int row0 = u.pm * BM + wr * 64 + fr, col0 = u.pn * BM + wc * 32 + 8 * fq;
#pragma unroll
        for (int ai = 0; ai < 2; ++ai)
#pragma unroll
            for (int m = 0; m < 4; ++m) { bf16_t* rowp = G + (size_t)(row0 + ai * HALF + m * 16) * 4096 + col0;
#pragma unroll
                for (int bj = 0; bj < 2; ++bj) *(u32x4*)(rowp + bj * HALF) = pack8(sig4(acc[ai][bj][m][0]), sig4(acc[ai][bj][m][1])); }
    }
};
struct EpiMerge {
    static constexpr bool PERM = true, AFTER_DRAIN = false, KEEP_ACC = true;
    const bf16_t* G; bf16_t* MRG;
    __device__ __forceinline__ bool keep(const Unit& u) const { return (u.pn >> 2) < 3; }
    __device__ __forceinline__ void operator()(f32x4 (&acc)[2][2][4][2], const Unit& u, int wr, int wc, int fr, int fq) const {
        const int n = u.pn >> 2, pn = u.pn & 3, pm = u.pm - n * (MG / 256);
        const int row0 = pm * BM + wr * 64 + fr, col0 = pn * BM + wc * 32 + 8 * fq;
#pragma unroll
        for (int ai = 0; ai < 2; ++ai)
#pragma unroll
            for (int mp = 0; mp < 2; ++mp) { u32x4 ga[2][2], gb[2][2];
#pragma unroll
                for (int mm = 0; mm < 2; ++mm)
#pragma unroll
                    for (int bj = 0; bj < 2; ++bj) { const bf16_t* gp = G + (size_t)(row0 + ai * HALF + (2 * mp + mm) * 16) * 4096 + n * 1024 + col0 + bj * HALF; ga[mm][bj] = *(const u32x4*)gp; if (n < 3) gb[mm][bj] = *(const u32x4*)(gp + 1024); }
#pragma unroll
                for (int mm = 0; mm < 2; ++mm)
#pragma unroll
                    for (int bj = 0; bj < 2; ++bj) { const int m = 2 * mp + mm; f32x4 a0, a1; unpack8(ga[mm][bj], a0, a1);
                        if (n < 3) { f32x4 b0, b1; unpack8(gb[mm][bj], b0, b1);
#pragma unroll
                            for (int j = 0; j < 4; ++j) { acc[ai][bj][m][0][j] *= fmaxf(a0[j], 1e-6f) * __builtin_amdgcn_rcpf(fmaxf(b0[j], 1e-6f)); acc[ai][bj][m][1][j] *= fmaxf(a1[j], 1e-6f) * __builtin_amdgcn_rcpf(fmaxf(b1[j], 1e-6f)); } }
                        else {
#pragma unroll
                            for (int j = 0; j < 4; ++j) { a0[j] = fmaxf(a0[j], 1e-6f); a1[j] = fmaxf(a1[j], 1e-6f); }
                            *(u32x4*)(MRG + (size_t)(row0 + ai * HALF + m * 16) * 1024 + col0 + bj * HALF) = pack8(acc[ai][bj][m][0] * a0, acc[ai][bj][m][1] * a1); } }
                EPI_FENCE(); }
    }
};
struct MergeOrder {
    int G, c;
    __device__ __forceinline__ bool next(int i, Unit& u) const {
        const int tile = (i >> 2) * G + c, n = i & 3; if (tile >= (MG / 256) * 4) return false;
        u.pm = n * (MG / 256) + (tile >> 2); u.pn = n * 4 + (tile & 3); return true;
    }
    __device__ __forceinline__ void a_ready(const Unit&) const {}
    __device__ __forceinline__ void done(const Unit&) const {}
};
struct EpiResid {
    static constexpr bool PERM = false, AFTER_DRAIN = false;
    const float* base; float* out;
    __device__ __forceinline__ void operator()(const f32x4 (&acc)[2][2][4][2], const Unit& u, int wr, int wc, int fr, int fq) const {
        const int row0 = u.pm * BM + wr * 64 + fr, col0 = u.pn * BM + wc * 32 + 4 * fq;
#pragma unroll
        for (int ai = 0; ai < 2; ++ai) {
            f32x4 bv[4][2][2];
#pragma unroll
            for (int m = 0; m < 4; ++m)
#pragma unroll
                for (int bj = 0; bj < 2; ++bj)
#pragma unroll
                    for (int n = 0; n < 2; ++n) bv[m][bj][n] = *(const f32x4*)(base + (size_t)(row0 + ai * HALF + m * 16) * 1024 + col0 + bj * HALF + n * 16);
#pragma unroll
            for (int m = 0; m < 4; ++m)
#pragma unroll
                for (int bj = 0; bj < 2; ++bj)
#pragma unroll
                    for (int n = 0; n < 2; ++n) *(f32x4*)(out + (size_t)(row0 + ai * HALF + m * 16) * 1024 + col0 + bj * HALF + n * 16) = bv[m][bj][n] + acc[ai][bj][m][n];
            EPI_FENCE(); }
    }
};
struct EpiSwiglu {
    static constexpr bool PERM = true, AFTER_DRAIN = false;
    bf16_t* HID;
    __device__ __forceinline__ void operator()(const f32x4 (&acc)[2][2][4][2], const Unit& u, int wr, int wc, int fr, int fq) const {
        const int row0 = u.pm * BM + wr * 64 + fr, col0 = u.pn * HALF + wc * 32 + 8 * fq;
#pragma unroll
        for (int ai = 0; ai < 2; ++ai)
#pragma unroll
            for (int m = 0; m < 4; ++m) { f32x4 v[2];
#pragma unroll
                for (int n = 0; n < 2; ++n) { const f32x4 a = acc[ai][0][m][n], b = acc[ai][1][m][n]; v[n] = a * sig4(a) * b; }
                *(u32x4*)(HID + (size_t)(row0 + ai * HALF + m * 16) * FFN + col0) = pack8(v[0], v[1]); }
    }
};
struct EpiGlu {
    static constexpr bool PERM = true, AFTER_DRAIN = false;
    const bf16_t* Y0; bf16_t* OUT; const float* bias;
    __device__ __forceinline__ void operator()(const f32x4 (&acc)[2][2][4][2], const Unit& u, int wr, int wc, int fr, int fq) const {
        const int row0 = u.pm * BM + wr * 64 + fr, col0 = u.pn * BM + wc * 32 + 8 * fq;
#pragma unroll
        for (int ai = 0; ai < 2; ++ai)
#pragma unroll
            for (int m = 0; m < 4; ++m) { const size_t row = (size_t)(row0 + ai * HALF + m * 16);
#pragma unroll
                for (int bj = 0; bj < 2; ++bj) { const int col = col0 + bj * HALF;
                    f32x4 y0, y1; unpack8(*(const u32x4*)(Y0 + row * 512 + col), y0, y1);
                    const f32x4 b0 = *(const f32x4*)(bias + col), b1 = *(const f32x4*)(bias + col + 4);
                    *(u32x4*)(OUT + row * 512 + col) = pack8(y0 * sig4(acc[ai][bj][m][0] + b0), y1 * sig4(acc[ai][bj][m][1] + b1)); }
                EPI_FENCE(); }
    }
};
__device__ __forceinline__ float logdecay(float x) { return -0.6065306597f * sigm(x); }
struct EpiLora {
    static constexpr bool PERM = true, AFTER_DRAIN = false;
    float* WLOG; bf16_t* ASIG; bf16_t* GG; const float* w0; const float* a0;
    __device__ __forceinline__ void operator()(const f32x4 (&acc)[2][2][4][2], const Unit& u, int wr, int wc, int fr, int fq) const {
        const int kind = u.pn >> 1, row0 = u.pm * BM + wr * 64 + fr, col0 = (u.pn & 1) * BM + wc * 32 + 8 * fq;
        if (kind == 0) {
            f32x4 b[2][2];
#pragma unroll
            for (int bj = 0; bj < 2; ++bj) { b[bj][0] = *(const f32x4*)(w0 + col0 + bj * HALF); b[bj][1] = *(const f32x4*)(w0 + col0 + bj * HALF + 4); }
#pragma unroll
            for (int ai = 0; ai < 2; ++ai)
#pragma unroll
                for (int m = 0; m < 4; ++m)
#pragma unroll
                    for (int bj = 0; bj < 2; ++bj)
#pragma unroll
                        for (int n = 0; n < 2; ++n) { const f32x4 x = acc[ai][bj][m][n] + b[bj][n];
                            *(f32x4*)(WLOG + (size_t)(row0 + ai * HALF + m * 16) * 512 + col0 + bj * HALF + 4 * n) = (f32x4){logdecay(x[0]), logdecay(x[1]), logdecay(x[2]), logdecay(x[3])}; }
        } else if (kind == 1) {
            f32x4 b[2][2];
#pragma unroll
            for (int bj = 0; bj < 2; ++bj) { b[bj][0] = *(const f32x4*)(a0 + col0 + bj * HALF); b[bj][1] = *(const f32x4*)(a0 + col0 + bj * HALF + 4); }
#pragma unroll
            for (int ai = 0; ai < 2; ++ai)
#pragma unroll
                for (int m = 0; m < 4; ++m)
#pragma unroll
                    for (int bj = 0; bj < 2; ++bj)
                        *(u32x4*)(ASIG + (size_t)(row0 + ai * HALF + m * 16) * 512 + col0 + bj * HALF) = pack8(sig4(acc[ai][bj][m][0] + b[bj][0]), sig4(acc[ai][bj][m][1] + b[bj][1]));
        } else {
#pragma unroll
            for (int ai = 0; ai < 2; ++ai)
#pragma unroll
                for (int m = 0; m < 4; ++m)
#pragma unroll
                    for (int bj = 0; bj < 2; ++bj)
                        *(u32x4*)(GG + (size_t)(row0 + ai * HALF + m * 16) * 512 + col0 + bj * HALF) = pack8(acc[ai][bj][m][0], acc[ai][bj][m][1]);
        }
    }
};
}
typedef short bf16x8_t __attribute__((ext_vector_type(8)));
typedef float f32x16 __attribute__((ext_vector_type(16)));
typedef float f32x4_t __attribute__((ext_vector_type(4)));
__device__ __forceinline__ bf16x8_t frag2(const u32x2 lo, const u32x2 hi) { u32x4 w; w.x = lo.x; w.y = lo.y; w.z = hi.x; w.w = hi.y; return __builtin_bit_cast(bf16x8_t, w); }
struct Args { const float* in[N_IN]; float* out; unsigned char* ws; int seg_lo, seg_hi; };
#ifdef HOST_EMU
typedef const Args* KArgs;
#define KLAUNDER(p) (p)
__device__ __forceinline__ int fresh_tid() { return (int)threadIdx.x; }
#else
typedef const __attribute__((address_space(4))) Args* KArgs;
__device__ __forceinline__ KArgs klaunder(KArgs p) { asm volatile("" : "+s"(p)); return p; }
#define KLAUNDER(p) klaunder(p)
__device__ __forceinline__ int fresh_tid() { int t = (int)threadIdx.x; asm volatile("" : "+v"(t)); return t; }
#endif
#define WSP(T, off) ((T*)(C->ws + (off)))

template <class Src>
__device__ __forceinline__ void transpose_item(const Src& S, int K, bf16* WT, float* scr, int item, int lane) {
    const int nblk = S.ndst / 32, kb = item / nblk, nb = item % nblk, k0 = 64 * kb, n0 = 32 * nb;
    const float* cp = S.col(n0 + (lane & 31)); const int ld = S.ld;
#pragma unroll 8
    for (int i = 0; i < 32; ++i) { const int kk = 2 * i + (lane >> 5); scr[kk * 33 + (lane & 31)] = cp ? cp[(size_t)(k0 + kk) * ld] : 0.f; }
    WAVE_SYNC();
    const int c = lane & 7;
#pragma unroll
    for (int j = 0; j < 4; ++j) { const int n = (lane >> 3) + 8 * j; const float* s = scr + (8 * c) * 33 + n;
        u32x4 o; o.x = pk2(s[0 * 33], s[1 * 33]); o.y = pk2(s[2 * 33], s[3 * 33]); o.z = pk2(s[4 * 33], s[5 * 33]); o.w = pk2(s[6 * 33], s[7 * 33]);
        *(u32x4*)(WT + (size_t)(n0 + n) * K + k0 + 8 * c) = o; }
    WAVE_SYNC();
}
struct SrcWin { const float* w; int ndst, ld;
    __device__ __forceinline__ const float* col(int n) const {
        int s;
        if (n < 1280) s = n;
        else if (n < 2816) s = n + 8;
        else if (n < 4608) s = n - 2816 + 2988;
        else if (n < 5120) s = n - 4608 + 4780;
        else if (n < 5128) s = n - 5120 + 1280;
        else if (n < 5256) s = n - 5128 + 2824;
        else if (n < 5288) s = n - 5256 + 2952;
        else if (n < 5292) s = n - 5288 + 2984;
        else if (n < 5376) return nullptr;
        else s = n - 5376 + 5292;
        return w + s; } };
struct SrcPlain { const float* w; int ndst, ld; __device__ __forceinline__ const float* col(int n) const { return w + n; } };
struct SrcW13 { const float* w1; const float* w3; int ndst, ld;
    __device__ __forceinline__ const float* col(int n) const { const int pn = n >> 8, r = n & 255; return w1 + (r < 128 ? (ptrdiff_t)0 : (w3 - w1)) + pn * 128 + (r & 127); } };

__device__ __forceinline__ void phase_weights(KArgs C, int layer, unsigned char* lds, int gw, int ngw, int lane, int wave) {
    float* scr = (float*)(lds + wave * 16384); const size_t wo = (layer & 1) ? WDELTA : 0;
    constexpr int N_IN_ = 16 * (NPROJ / 32), N_BR = 8 * 32, N_OUT = 16 * 32, N_13 = 16 * (5632 / 32), N_2 = 44 * 32, N_GLU = 8 * 16;
    { const SrcWin s_in{C->in[I_WIN] + (size_t)layer * 1024 * IN_COLS, NPROJ, IN_COLS};
      for (int it = gw; it < N_IN_; it += ngw) transpose_item(s_in, 1024, WSP(bf16, WS_WIN + wo), scr, it, lane); }
    for (int it = gw; it < 4 * N_BR; it += ngw) { const int n = it / N_BR; const SrcPlain s_b{C->in[I_WBR] + ((size_t)layer * 4 + n) * 512 * 1024, 1024, 1024};
        transpose_item(s_b, 512, WSP(bf16, WS_WB + wo) + (size_t)n * 1024 * 512, scr, it % N_BR, lane); }
    { const SrcPlain s_out{C->in[I_WOUT] + (size_t)layer * 1024 * 1024, 1024, 1024};
      for (int it = gw; it < N_OUT; it += ngw) transpose_item(s_out, 1024, WSP(bf16, WS_WOUT + wo), scr, it, lane); }
    { const SrcW13 s_13{C->in[I_W1] + (size_t)layer * 1024 * FFN, C->in[I_W3] + (size_t)layer * 1024 * FFN, 5632, FFN};
      for (int it = gw; it < N_13; it += ngw) transpose_item(s_13, 1024, WSP(bf16, WS_W13 + wo), scr, it, lane); }
    { const SrcPlain s_2{C->in[I_W2F] + (size_t)layer * FFN * 1024, 1024, 1024};
      for (int it = gw; it < N_2; it += ngw) transpose_item(s_2, FFN, WSP(bf16, WS_W2 + wo), scr, it, lane); }
    { const SrcPlain s_glu{C->in[I_GLUW] + (size_t)layer * 512 * 512, 512, 512};
      for (int it = gw; it < N_GLU; it += ngw) transpose_item(s_glu, 512, WSP(bf16, WS_GLU + wo), scr, it, lane); }
    { const float* w2 = C->in[I_W2] + (size_t)layer * 64 * 512; const float* a2 = C->in[I_A2] + (size_t)layer * 64 * 512; const float* g2 = C->in[I_G2] + (size_t)layer * 128 * 512;
      bf16* WL = WSP(bf16, WS_WLORA + wo);
      for (int e = gw * 64 + lane; e < 1536 * 256; e += ngw * 64) { const int n = e >> 8, kc = e & 255; float v = 0.f;
          if (n < 512) { if (kc < 64) v = w2[kc * 512 + n]; } else if (n < 1024) { if (kc >= 64 && kc < 128) v = a2[(kc - 64) * 512 + (n - 512)]; } else { if (kc >= 128) v = g2[(kc - 128) * 512 + (n - 1024)]; }
          WL[e] = f2bf(v); } }
    const int gt = gw * 64 + lane, ngt = ngw * 64;
    for (int e = gt; e < 32 * 64; e += ngt) {
        const int g = e >> 6;
        const float ar = C->in[I_S5ARE][layer * 2048 + e], ai = C->in[I_S5AIM][layer * 2048 + e], dt = expf(C->in[I_S5LDT][layer * 32 + g]);
        const float mag = expf(ar * dt), abr = mag * cosf(ai * dt), abi = mag * sinf(ai * dt);
        const float den = ar * ar + ai * ai, nr = abr - 1.0f, ni = abi;
        const float qr = (nr * ar + ni * ai) / den, qi = (ni * ar - nr * ai) / den;
        float* ab = WSP(float, WS_ABAR + wo) + e * 2; ab[0] = abr; ab[1] = abi;
        float* bb = WSP(float, WS_BBAR + wo) + (size_t)e * 32;
        for (int j = 0; j < 16; ++j) { const float br = C->in[I_S5BRE][((size_t)layer * 2048 + e) * 16 + j], bi = C->in[I_S5BIM][((size_t)layer * 2048 + e) * 16 + j];
            bb[2 * j] = qr * br - qi * bi; bb[2 * j + 1] = qr * bi + qi * br; }
    }
    if (layer == 0) for (int e = gt; e < SEQ + 63; e += ngt) {
        const int rel = e - (SEQ - 1); const int n = rel < 0 ? -rel : rel; int b = rel > 0 ? 16 : 0;
        if (n < 8) b += n; else { int lg = 8 + (int)(logf((float)n / 8.0f) / 3.4657359028f * 8.0f); if (lg > 15) lg = 15; b += lg; }
        WSP(int, WS_TAB)[e] = b;
    }
}

__device__ __forceinline__ void rms_row_bf16(const float* xrow, const float* g, bf16* orow, int lane) {
    const f32x4* xr = (const f32x4*)xrow + lane; const f32x4* gr = (const f32x4*)g + lane;
    f32x4 v[4]; float s = 0.f;
#pragma unroll
    for (int j = 0; j < 4; ++j) { v[j] = xr[64 * j]; s += (v[j].x * v[j].x + v[j].y * v[j].y) + (v[j].z * v[j].z + v[j].w * v[j].w); }
    const float rstd = 1.0f / sqrtf(wave_sum(s) * (1.f / D) + RMS_EPS);
    u32x2* o8 = (u32x2*)orow + lane;
#pragma unroll
    for (int j = 0; j < 4; ++j) { const f32x4 gg = gr[64 * j]; u32x2 w; w.x = pk2(v[j].x * rstd * gg.x, v[j].y * rstd * gg.y); w.y = pk2(v[j].z * rstd * gg.z, v[j].w * rstd * gg.w); o8[64 * j] = w; }
}
template <int NR>
__device__ __forceinline__ void rms_rowN_bf16(const float* xrow, const float* g, bf16* orow, size_t step, int lane) {
    const f32x4* gr = (const f32x4*)g + lane; f32x4 v[NR][4]; float ss[NR];
#pragma unroll
    for (int q = 0; q < NR; ++q)
#pragma unroll
        for (int j = 0; j < 4; ++j) v[q][j] = ((const f32x4*)(xrow + q * step) + lane)[64 * j];
#pragma unroll
    for (int q = 0; q < NR; ++q) { float s = 0.f;
#pragma unroll
        for (int j = 0; j < 4; ++j) s += (v[q][j].x * v[q][j].x + v[q][j].y * v[q][j].y) + (v[q][j].z * v[q][j].z + v[q][j].w * v[q][j].w);
        ss[q] = s; }
#pragma unroll
    for (int o = 1; o < 64; o <<= 1)
#pragma unroll
        for (int q = 0; q < NR; ++q) ss[q] += __shfl_xor(ss[q], o);
#pragma unroll
    for (int q = 0; q < NR; ++q) { const float r = 1.0f / sqrtf(ss[q] * (1.f / D) + RMS_EPS); u32x2* o8 = (u32x2*)(orow + q * step) + lane;
#pragma unroll
        for (int j = 0; j < 4; ++j) { const f32x4 gg = gr[64 * j]; u32x2 w; w.x = pk2(v[q][j].x * r * gg.x, v[q][j].y * r * gg.y); w.y = pk2(v[q][j].z * r * gg.z, v[q][j].w * r * gg.w); o8[64 * j] = w; } }
}
__device__ __forceinline__ void rms_row_f32(float* xrow, const float* g, int lane) {
    f32x4* xr = (f32x4*)xrow + lane; const f32x4* gr = (const f32x4*)g + lane;
    f32x4 v[4]; float s = 0.f;
#pragma unroll
    for (int j = 0; j < 4; ++j) { v[j] = xr[64 * j]; s += (v[j].x * v[j].x + v[j].y * v[j].y) + (v[j].z * v[j].z + v[j].w * v[j].w); }
    const float rstd = 1.0f / sqrtf(wave_sum(s) * (1.f / D) + RMS_EPS);
#pragma unroll
    for (int j = 0; j < 4; ++j) xr[64 * j] = v[j] * rstd * gr[64 * j];
}

#ifdef HOST_EMU
__device__ __forceinline__ float red8(float v) { v += __shfl_xor(v, 1); v += __shfl_xor(v, 2); v += __shfl_xor(v, 4); return v; }
__device__ __forceinline__ float red16(float v) { v = red8(v); v += __shfl_xor(v, 8); return v; }
#else
template <int CTRL> __device__ __forceinline__ float dpp_f(float v) { return __builtin_bit_cast(float, __builtin_amdgcn_update_dpp(0, __builtin_bit_cast(int, v), CTRL, 0xf, 0xf, true)); }
__device__ __forceinline__ float red8(float v) { v += dpp_f<0xB1>(v); v += dpp_f<0x4E>(v); v += dpp_f<0x141>(v); return v; }
__device__ __forceinline__ float red16(float v) { v = red8(v); v += dpp_f<0x140>(v); return v; }
#endif
__device__ __forceinline__ f32x4 sig4g(const f32x4 v) { return (f32x4){sigm(v[0]), sigm(v[1]), sigm(v[2]), sigm(v[3])}; }
__device__ __forceinline__ void rms_row2_f32(float* xrow, size_t step, const float* g, int lane) {
    f32x4* xa = (f32x4*)xrow + lane; f32x4* xb = (f32x4*)(xrow + step) + lane; const f32x4* gr = (const f32x4*)g + lane;
    f32x4 va[4], vb[4]; float sa = 0.f, sb = 0.f;
#pragma unroll
    for (int j = 0; j < 4; ++j) { va[j] = xa[64 * j]; vb[j] = xb[64 * j]; }
#pragma unroll
    for (int j = 0; j < 4; ++j) { sa += (va[j].x * va[j].x + va[j].y * va[j].y) + (va[j].z * va[j].z + va[j].w * va[j].w); sb += (vb[j].x * vb[j].x + vb[j].y * vb[j].y) + (vb[j].z * vb[j].z + vb[j].w * vb[j].w); }
#pragma unroll
    for (int o = 1; o < 64; o <<= 1) { sa += __shfl_xor(sa, o); sb += __shfl_xor(sb, o); }
    const float ra = 1.0f / sqrtf(sa * (1.f / D) + RMS_EPS), rb = 1.0f / sqrtf(sb * (1.f / D) + RMS_EPS);
#pragma unroll
    for (int j = 0; j < 4; ++j) { const f32x4 gg = gr[64 * j]; xa[64 * j] = va[j] * ra * gg; xb[64 * j] = vb[j] * rb * gg; }
}
__device__ __forceinline__ void ssd_conv_row(KArgs C, int layer, int m, int lane) {
    const int t = m % SEQ; const float* cw = C->in[I_CONVW] + layer * 4 * 768; const float* cb = C->in[I_CONVB] + layer * 768;
#pragma unroll
    for (int i = 0; i < 3; ++i) { const int ch = i * 256 + lane * 4; const bf16* p = WSP(const bf16, WS_XBC) + (size_t)m * 768 + ch;
        f32x4 a = *(const f32x4*)(cb + ch);
#pragma unroll
        for (int q = 0; q < 4; ++q) if (t - 3 + q >= 0) { const u32x2 w = *(const u32x2*)(p - (3 - q) * 768); const f32x4 cq = *(const f32x4*)(cw + q * 768 + ch);
            a += cq * (f32x4){lo_bf(w.x), hi_bf(w.x), lo_bf(w.y), hi_bf(w.y)}; }
        a = a * sig4g(a);
        u32x2 o; o.x = pk2(a.x, a.y); o.y = pk2(a.z, a.w); *(u32x2*)(WSP(bf16, WS_XBA) + (size_t)m * 768 + ch) = o; }
}
__device__ __forceinline__ void ssd_conv_row2(KArgs C, int layer, int m, int step, int lane) {
    const float* cw = C->in[I_CONVW] + layer * 4 * 768; const float* cb = C->in[I_CONVB] + layer * 768;
    u32x2 w[2][3][4]; f32x4 cq[3][4], bb[3];
#pragma unroll
    for (int i = 0; i < 3; ++i) { const int ch = i * 256 + lane * 4; bb[i] = *(const f32x4*)(cb + ch);
#pragma unroll
        for (int q = 0; q < 4; ++q) { cq[i][q] = *(const f32x4*)(cw + q * 768 + ch);
#pragma unroll
            for (int r = 0; r < 2; ++r) { const int mm = m + r * step, t = mm % SEQ; const bf16* p = WSP(const bf16, WS_XBC) + (size_t)mm * 768 + ch;
                if (t - 3 + q >= 0) w[r][i][q] = *(const u32x2*)(p - (3 - q) * 768); else { w[r][i][q].x = 0u; w[r][i][q].y = 0u; } } } }
#pragma unroll
    for (int r = 0; r < 2; ++r)
#pragma unroll
        for (int i = 0; i < 3; ++i) { const int ch = i * 256 + lane * 4; f32x4 a = bb[i];
#pragma unroll
            for (int q = 0; q < 4; ++q) a += cq[i][q] * (f32x4){lo_bf(w[r][i][q].x), hi_bf(w[r][i][q].x), lo_bf(w[r][i][q].y), hi_bf(w[r][i][q].y)};
            a = a * sig4g(a);
            u32x2 o; o.x = pk2(a.x, a.y); o.y = pk2(a.z, a.w); *(u32x2*)(WSP(bf16, WS_XBA) + (size_t)(m + r * step) * 768 + ch) = o; }
}
__device__ __forceinline__ void ssd_unit(KArgs C, int layer, int unit, unsigned char* lds) {
    const int tid = fresh_tid(), lane = tid & 63, wave = tid >> 6, bl = unit >> 3, h = unit & 7, gi = h >> 2, pp = tid >> 3, c8 = (tid & 7) * 8, c16 = lane & 15, q = lane >> 4;
    bf16* Cb = (bf16*)lds; bf16* Bb = Cb + 4096; bf16* XT = Bb + 4096; bf16* BwT = XT + 4096; bf16* Pm = BwT + 4096; float* Yo = (float*)(Pm + 4096); float* dts = Yo + 8192; float* acs = dts + 128;
    const bf16* XA = WSP(const bf16, WS_XBA) + (size_t)bl * SEQ * 768 + (size_t)pp * 768 + c8;
    const bf16* SMp = WSP(const bf16, WS_SM) + (size_t)bl * SEQ * 256;
    const bf16* Zp = WSP(const bf16, WS_Z) + (size_t)bl * SEQ * 512 + (size_t)pp * 512 + h * 64 + c8;
    bf16* YA = WSP(bf16, WS_Y) + (size_t)bl * SEQ * 512 + (size_t)pp * 512 + h * 64 + c8;
    const float dtb = C->in[I_DTB][layer * 8 + h], A = -__expf(C->in[I_ALOG][layer * 8 + h]), Dh = C->in[I_SSDD][layer * 8 + h];
    f32x4_t Sd[2]; bf16x8_t Sf; Sd[0] = (f32x4_t){0.f, 0.f, 0.f, 0.f}; Sd[1] = Sd[0]; { u32x2 z; z.x = 0u; z.y = 0u; Sf = frag2(z, z); }
    const int pt = wave & 3, nh = wave >> 2;
    u32x4 fx, fb, fc, fz;
#define SSD_FETCH(c0_) do { const bf16* q_ = XA + (size_t)(c0_) * 768; fx = *(const u32x4*)(q_ + h * 64); fb = *(const u32x4*)(q_ + 512 + gi * 64); fc = *(const u32x4*)(q_ + 640 + gi * 64); fz = *(const u32x4*)(Zp + (size_t)(c0_) * 512); } while (0)
#define SSD_DT(c0_, par) do { if (wave == 0) { const float dt_ = softplusf(bf2f(SMp[(size_t)((c0_) + lane) * 256 + h]) + dtb); float a_ = A * dt_; \
        _Pragma("unroll") for (int o_ = 1; o_ < 64; o_ <<= 1) { const float t_ = __shfl_up(a_, o_); if (lane >= o_) a_ += t_; } dts[(par) * 64 + lane] = dt_; acs[(par) * 64 + lane] = a_; } } while (0)
    LDS_SYNC();
    SSD_FETCH(0); SSD_DT(0, 0);
    for (int c0 = 0, par = 0; c0 < SEQ; c0 += 64, par ^= 1) {
        LDS_SYNC();
        const u32x4 xk = fx, zk = fz;
        {
          const float dt = dts[par * 64 + pp], ea = __expf(acs[par * 64 + 63] - acs[par * 64 + pp]);
          *(u32x4*)(Cb + pp * 64 + c8) = fc; *(u32x4*)(Bb + pp * 64 + c8) = fb;
          f32x4 x0, x1, b0, b1; pg8::unpack8(fx, x0, x1); pg8::unpack8(fb, b0, b1); x0 = x0 * dt; x1 = x1 * dt; b0 = b0 * ea; b1 = b1 * ea;
#pragma unroll
          for (int i = 0; i < 4; ++i) { XT[(c8 + i) * 64 + pp] = f2bf(x0[i]); XT[(c8 + 4 + i) * 64 + pp] = f2bf(x1[i]); BwT[(c8 + i) * 64 + pp] = f2bf(b0[i]); BwT[(c8 + 4 + i) * 64 + pp] = f2bf(b1[i]); } }
        if (c0 + 64 < SEQ) { SSD_FETCH(c0 + 64); SSD_DT(c0 + 64, par ^ 1); }
        LDS_SYNC();
        {
          const f32x4_t z4 = {0.f, 0.f, 0.f, 0.f};
#pragma unroll
          for (int i = 0; i < 2; ++i) { const int id = wave + 8 * i, lt = id >> 2, st = id & 3; f32x4_t g = z4;
              if (st <= lt) {
#pragma unroll
                  for (int ks = 0; ks < 2; ++ks) g = __builtin_amdgcn_mfma_f32_16x16x32_bf16(*(const bf16x8_t*)(Cb + (16 * lt + c16) * 64 + 32 * ks + 8 * q), *(const bf16x8_t*)(Bb + (16 * st + c16) * 64 + 32 * ks + 8 * q), g, 0, 0, 0);
                  const float as_ = acs[par * 64 + 16 * st + c16];
#pragma unroll
                  for (int r = 0; r < 4; ++r) { const int l = 16 * lt + 4 * q + r; g[r] = (16 * st + c16 <= l) ? g[r] * __expf(acs[par * 64 + l] - as_) : 0.f; } }
#pragma unroll
              for (int r = 0; r < 4; ++r) Pm[(16 * lt + 4 * q + r) * 64 + 16 * st + c16] = f2bf(g[r]); }
#pragma unroll
          for (int lt = 0; lt < 4; ++lt) { const bf16* cr = Cb + (16 * lt + c16) * 64 + 32 * nh + 4 * q;
              const f32x4_t yo = __builtin_amdgcn_mfma_f32_16x16x32_bf16(frag2(*(const u32x2*)cr, *(const u32x2*)(cr + 16)), Sf, z4, 0, 0, 0);
#pragma unroll
              for (int r = 0; r < 4; ++r) Yo[nh * 4096 + (16 * lt + 4 * q + r) * 64 + 16 * pt + c16] = yo[r]; }
          const float eL = __expf(acs[par * 64 + 63]);
          const bf16x8_t xb0 = *(const bf16x8_t*)(XT + (16 * pt + c16) * 64 + 8 * q), xb1 = *(const bf16x8_t*)(XT + (16 * pt + c16) * 64 + 32 + 8 * q);
#pragma unroll
          for (int i = 0; i < 2; ++i) { const bf16* br = BwT + (16 * (2 * nh + i) + c16) * 64 + 8 * q; f32x4_t cin = Sd[i] * eL;
              cin = __builtin_amdgcn_mfma_f32_16x16x32_bf16(*(const bf16x8_t*)br, xb0, cin, 0, 0, 0); Sd[i] = __builtin_amdgcn_mfma_f32_16x16x32_bf16(*(const bf16x8_t*)(br + 32), xb1, cin, 0, 0, 0); }
          u32x2 lo, hi; lo.x = pk2(Sd[0][0], Sd[0][1]); lo.y = pk2(Sd[0][2], Sd[0][3]); hi.x = pk2(Sd[1][0], Sd[1][1]); hi.y = pk2(Sd[1][2], Sd[1][3]); Sf = frag2(lo, hi); }
        LDS_SYNC();
        {
          const f32x4_t z4 = {0.f, 0.f, 0.f, 0.f};
#pragma unroll
          for (int i = 0; i < 2; ++i) { const int id = wave + 8 * i, lt = id >> 2, p2 = id & 3;
              f32x4_t y = __builtin_amdgcn_mfma_f32_16x16x32_bf16(*(const bf16x8_t*)(Pm + (16 * lt + c16) * 64 + 8 * q), *(const bf16x8_t*)(XT + (16 * p2 + c16) * 64 + 8 * q), z4, 0, 0, 0);
              if (lt >= 2) y = __builtin_amdgcn_mfma_f32_16x16x32_bf16(*(const bf16x8_t*)(Pm + (16 * lt + c16) * 64 + 32 + 8 * q), *(const bf16x8_t*)(XT + (16 * p2 + c16) * 64 + 32 + 8 * q), y, 0, 0, 0);
#pragma unroll
              for (int r = 0; r < 4; ++r) { const int l = 16 * lt + 4 * q + r, o = l * 64 + 16 * p2 + c16; Yo[o] = y[r] + __expf(acs[par * 64 + l]) * (Yo[o] + Yo[4096 + o]); } } }
        LDS_SYNC();
        {
          f32x4 x0, x1, z0, z1; pg8::unpack8(xk, x0, x1); pg8::unpack8(zk, z0, z1);
          const f32x4 y0 = (*(const f32x4*)(Yo + pp * 64 + c8) + Dh * x0) * z0 * sig4g(z0), y1 = (*(const f32x4*)(Yo + pp * 64 + c8 + 4) + Dh * x1) * z1 * sig4g(z1);
          *(u32x4*)(YA + (size_t)c0 * 512) = pg8::pack8(y0, y1); }
    }
#undef SSD_FETCH
#undef SSD_DT
}
__device__ __forceinline__ void ssd_norm_item4(KArgs C, int layer, int item0, int stride, int nitems, int lane) {
    u32x2 w[4]; bf16* p[4];
#pragma unroll
    for (int q = 0; q < 4; ++q) { const int item = item0 + q * stride; p[q] = WSP(bf16, WS_Y) + (size_t)((item < nitems ? item : item0) >> 1) * 512 + ((item < nitems ? item : item0) & 1) * 256 + lane * 4; w[q] = *(const u32x2*)p[q]; }
#pragma unroll
    for (int q = 0; q < 4; ++q) { const int item = item0 + q * stride; if (item < nitems) {
        float v[4] = {lo_bf(w[q].x), hi_bf(w[q].x), lo_bf(w[q].y), hi_bf(w[q].y)};
        const float rstd = 1.0f / sqrtf(wave_sum(v[0] * v[0] + v[1] * v[1] + v[2] * v[2] + v[3] * v[3]) * (1.f / 256) + RMS_EPS);
        const float* g = C->in[I_SSDNG] + layer * 512 + (item & 1) * 256 + lane * 4;
        u32x2 o; o.x = pk2(v[0] * rstd * g[0], v[1] * rstd * g[1]); o.y = pk2(v[2] * rstd * g[2], v[3] * rstd * g[3]); *(u32x2*)p[q] = o; } }
}
__device__ __forceinline__ void rwkv_prep_row(KArgs C, int layer, int m, int lane) {
    const int t = m % SEQ, col = 1536 + lane * 4;
    const bf16* cur = WSP(const bf16, WS_RW) + (size_t)m * 1792 + col;
    const u32x2 wc = *(const u32x2*)cur; u32x2 wp; wp.x = 0u; wp.y = 0u; if (t > 0) wp = *(const u32x2*)(cur - 1792);
    const f32x4 mu = *(const f32x4*)(C->in[I_MU] + layer * 1792 + col);
    float v[4] = {lo_bf(wc.x), hi_bf(wc.x), lo_bf(wc.y), hi_bf(wc.y)}; const float p[4] = {lo_bf(wp.x), hi_bf(wp.x), lo_bf(wp.y), hi_bf(wp.y)};
#pragma unroll
    for (int i = 0; i < 4; ++i) { v[i] = v[i] + (p[i] - v[i]) * mu[i]; v[i] = lane < 16 ? tanhf(v[i]) : (lane < 32 ? v[i] : sigm(v[i])); }
    u32x2 o; o.x = pk2(v[0], v[1]); o.y = pk2(v[2], v[3]); *(u32x2*)(WSP(bf16, WS_RA) + (size_t)m * 256 + lane * 4) = o;
}
__device__ __forceinline__ void rwkv_prep_row2(KArgs C, int layer, int m, int step, int lane) {
    const int col = 1536 + lane * 4; const f32x4 mu = *(const f32x4*)(C->in[I_MU] + layer * 1792 + col);
    u32x2 wc[2], wp[2];
#pragma unroll
    for (int r = 0; r < 2; ++r) { const int mm = m + r * step; const bf16* cur = WSP(const bf16, WS_RW) + (size_t)mm * 1792 + col; wc[r] = *(const u32x2*)cur;
        if (mm % SEQ > 0) wp[r] = *(const u32x2*)(cur - 1792); else { wp[r].x = 0u; wp[r].y = 0u; } }
#pragma unroll
    for (int r = 0; r < 2; ++r) { float v[4] = {lo_bf(wc[r].x), hi_bf(wc[r].x), lo_bf(wc[r].y), hi_bf(wc[r].y)}; const float p[4] = {lo_bf(wp[r].x), hi_bf(wp[r].x), lo_bf(wp[r].y), hi_bf(wp[r].y)};
#pragma unroll
        for (int i = 0; i < 4; ++i) { v[i] = v[i] + (p[i] - v[i]) * mu[i]; v[i] = lane < 16 ? tanhf(v[i]) : (lane < 32 ? v[i] : sigm(v[i])); }
        u32x2 o; o.x = pk2(v[0], v[1]); o.y = pk2(v[2], v[3]); *(u32x2*)(WSP(bf16, WS_RA) + (size_t)(m + r * step) * 256 + lane * 4) = o; }
}
__device__ __forceinline__ void rwkv_unit(KArgs C, int layer, int unit, unsigned char* lds) {
    constexpr int SLOT = 16704, O_RT = 2048, O_BTL = 4096, O_KTL = 6144, O_BHT = 8192, O_KHT = 10240, O_VT = 12288, O_TM = 14336, O_AAK = 14848, O_RB = 15360, O_RK = 15872, O_DL = 16384, O_BON = 16640;
    const int tid = fresh_tid(), lane = tid & 63, wave = tid >> 6, bl = unit >> 3, h = unit & 7, pt = tid >> 3, k8 = (tid & 7) * 8, cc = pt >> 4, tl = pt & 15, hc = h * 64 + k8;
    float* WL = (float*)(lds + 4 * SLOT); float* Nf = WL + 4096; float* Yb = Nf + 1024; float* ct_ = Yb + 4096;
    const bf16* RW = WSP(const bf16, WS_RW) + (size_t)bl * SEQ * 1792 + hc;
    const float* WLG = WSP(const float, WS_WLOG) + (size_t)bl * SEQ * 512 + hc;
    const bf16* AS = WSP(const bf16, WS_ASIG) + (size_t)bl * SEQ * 512 + hc;
    const bf16* GG = WSP(const bf16, WS_GG) + (size_t)bl * SEQ * 512 + hc;
    bf16* YC = WSP(bf16, WS_Y) + (size_t)2 * MG * 512 + (size_t)bl * SEQ * 512 + hc;
    LDS_SYNC();
    { const int row = tid >> 6, j = tid & 63; const float* src = row == 0 ? C->in[I_MU] + layer * 1792 : row == 1 ? C->in[I_MU] + layer * 1792 + 512 : row == 2 ? C->in[I_MU] + layer * 1792 + 1024
          : row == 3 ? C->in[I_KK] + layer * 512 : row == 4 ? C->in[I_KA] + layer * 512 : row == 5 ? C->in[I_RK] + layer * 512 : row == 6 ? C->in[I_LNG] + layer * 512 : C->in[I_LNB] + layer * 512;
      ct_[tid] = src[h * 64 + j]; }
    f32x4_t Sd[4]; bf16x8_t Sf[2];
#pragma unroll
    for (int i = 0; i < 4; ++i) Sd[i] = (f32x4_t){0.f, 0.f, 0.f, 0.f};
    { u32x2 z; z.x = 0u; z.y = 0u; Sf[0] = frag2(z, z); Sf[1] = Sf[0]; }
    u32x4 rc, rp, kc, kp, vc, vp, ac, gc; f32x4 wl0, wl1;
#define RWKV_FETCH(c0_) do { const int tt_ = (c0_) + pt; const bf16* q_ = RW + (size_t)tt_ * 1792; \
        rc = *(const u32x4*)q_; kc = *(const u32x4*)(q_ + 512); vc = *(const u32x4*)(q_ + 1024); \
        if (tt_ > 0) { rp = *(const u32x4*)(q_ - 1792); kp = *(const u32x4*)(q_ - 1792 + 512); vp = *(const u32x4*)(q_ - 1792 + 1024); } else { rp = (u32x4){0u, 0u, 0u, 0u}; kp = rp; vp = rp; } \
        wl0 = *(const f32x4*)(WLG + (size_t)tt_ * 512); wl1 = *(const f32x4*)(WLG + (size_t)tt_ * 512 + 4); ac = *(const u32x4*)(AS + (size_t)tt_ * 512); gc = *(const u32x4*)(GG + (size_t)tt_ * 512); } while (0)
    RWKV_FETCH(0);
    for (int c0 = 0; c0 < SEQ; c0 += 64) {
        unsigned char* slot = lds + cc * SLOT;
        LDS_SYNC();
        f32x4 r0, r1, kq0, kq1, v0, v1, kk0, kk1, b0, b1; const u32x4 gkeep = gc; const f32x4 wk0 = wl0, wk1 = wl1;
        { f32x4 c0_, c1_, p0_, p1_, a0, a1;
          pg8::unpack8(rc, c0_, c1_); pg8::unpack8(rp, p0_, p1_); r0 = c0_ + (p0_ - c0_) * *(const f32x4*)(ct_ + k8); r1 = c1_ + (p1_ - c1_) * *(const f32x4*)(ct_ + k8 + 4);
          pg8::unpack8(kc, c0_, c1_); pg8::unpack8(kp, p0_, p1_); const f32x4 k00 = c0_ + (p0_ - c0_) * *(const f32x4*)(ct_ + 64 + k8), k01 = c1_ + (p1_ - c1_) * *(const f32x4*)(ct_ + 64 + k8 + 4);
          pg8::unpack8(vc, c0_, c1_); pg8::unpack8(vp, p0_, p1_); v0 = c0_ + (p0_ - c0_) * *(const f32x4*)(ct_ + 128 + k8); v1 = c1_ + (p1_ - c1_) * *(const f32x4*)(ct_ + 128 + k8 + 4);
          pg8::unpack8(ac, a0, a1);
          kk0 = k00 * *(const f32x4*)(ct_ + 192 + k8); kk1 = k01 * *(const f32x4*)(ct_ + 192 + k8 + 4);
          const float inv = 1.0f / fmaxf(sqrtf(red8((kk0.x * kk0.x + kk0.y * kk0.y + kk0.z * kk0.z + kk0.w * kk0.w) + (kk1.x * kk1.x + kk1.y * kk1.y + kk1.z * kk1.z + kk1.w * kk1.w))), 1e-12f);
          kk0 = kk0 * inv; kk1 = kk1 * inv; b0 = kk0 * a0; b1 = kk1 * a1;
          kq0 = k00 * (1.0f + (a0 - 1.0f) * *(const f32x4*)(ct_ + 256 + k8)); kq1 = k01 * (1.0f + (a1 - 1.0f) * *(const f32x4*)(ct_ + 256 + k8 + 4));
          const f32x4 q0 = r0 * kq0 * *(const f32x4*)(ct_ + 320 + k8), q1 = r1 * kq1 * *(const f32x4*)(ct_ + 320 + k8 + 4);
          const float bo = red8((q0.x + q0.y + q0.z + q0.w) + (q1.x + q1.y + q1.z + q1.w));
          if ((tid & 7) == 0) ((float*)(slot + O_BON))[tl] = bo;
          *(f32x4*)(WL + pt * 64 + k8) = wk0; *(f32x4*)(WL + pt * 64 + k8 + 4) = wk1; }
        if (c0 + 64 < SEQ) RWKV_FETCH(c0 + 64);
        LDS_SYNC();
        if (tid < 256) { const int c_ = tid >> 6, k_ = tid & 63; float w16[16], run = 0.f;
#pragma unroll
            for (int t = 0; t < 16; ++t) w16[t] = WL[(c_ * 16 + t) * 64 + k_];
#pragma unroll
            for (int t = 0; t < 16; ++t) { run += w16[t]; WL[(c_ * 16 + t) * 64 + k_] = run; }
            ((float*)(lds + c_ * SLOT + O_DL))[k_] = __expf(run); }
        LDS_SYNC();
        { const f32x4 cs0 = *(const f32x4*)(WL + pt * 64 + k8), cs1 = *(const f32x4*)(WL + pt * 64 + k8 + 4), d0 = *(const f32x4*)((const float*)(slot + O_DL) + k8), d1 = *(const f32x4*)((const float*)(slot + O_DL) + k8 + 4);
          f32x4 e0, e1, f0, f1, w0, w1;
#pragma unroll
          for (int i = 0; i < 4; ++i) { e0[i] = __expf(cs0[i]); e1[i] = __expf(cs1[i]); f0[i] = __builtin_amdgcn_rcpf(e0[i]); f1[i] = __builtin_amdgcn_rcpf(e1[i]); w0[i] = __expf(-wk0[i]); w1[i] = __expf(-wk1[i]); }
          const f32x4 bt0 = b0 * f0, bt1 = b1 * f1, kt0 = kq0 * f0, kt1 = kq1 * f1;
          *(u32x4*)((bf16*)slot + tl * 64 + k8) = pg8::pack8(-(kk0 * e0 * w0), -(kk1 * e1 * w1));
          *(u32x4*)((bf16*)(slot + O_RT) + tl * 64 + k8) = pg8::pack8(r0 * e0, r1 * e1);
          *(u32x4*)((bf16*)(slot + O_BTL) + tl * 64 + k8) = pg8::pack8(bt0, bt1);
          *(u32x4*)((bf16*)(slot + O_KTL) + tl * 64 + k8) = pg8::pack8(kt0, kt1);
          const f32x4 bh0 = bt0 * d0, bh1 = bt1 * d1, kh0 = kt0 * d0, kh1 = kt1 * d1;
          bf16* bht = (bf16*)(slot + O_BHT) + k8 * 16 + tl; bf16* kht = (bf16*)(slot + O_KHT) + k8 * 16 + tl; bf16* vt = (bf16*)(slot + O_VT) + k8 * 16 + tl;
#pragma unroll
          for (int i = 0; i < 4; ++i) { bht[i * 16] = f2bf(bh0[i]); bht[(i + 4) * 16] = f2bf(bh1[i]); kht[i * 16] = f2bf(kh0[i]); kht[(i + 4) * 16] = f2bf(kh1[i]); vt[i * 16] = f2bf(v0[i]); vt[(i + 4) * 16] = f2bf(v1[i]); } }
        LDS_SYNC();
        { unsigned char* sl = lds + (wave & 3) * SLOT; const int c16 = lane & 15, q = lane >> 4;
          const bf16x8_t a0 = *(const bf16x8_t*)((const bf16*)sl + c16 * 64 + 8 * q), a1 = *(const bf16x8_t*)((const bf16*)sl + c16 * 64 + 32 + 8 * q);
          const bf16x8_t bb0 = *(const bf16x8_t*)((const bf16*)(sl + O_BTL) + c16 * 64 + 8 * q), bb1 = *(const bf16x8_t*)((const bf16*)(sl + O_BTL) + c16 * 64 + 32 + 8 * q);
          const f32x4_t z4 = {0.f, 0.f, 0.f, 0.f};
          if (wave < 4) {
              f32x4_t n = __builtin_amdgcn_mfma_f32_16x16x32_bf16(a0, bb0, z4, 0, 0, 0); n = __builtin_amdgcn_mfma_f32_16x16x32_bf16(a1, bb1, n, 0, 0, 0);
              float* nf = Nf + (wave & 3) * 256;
#pragma unroll
              for (int r = 0; r < 4; ++r) nf[c16 * 16 + 4 * q + r] = (c16 < 4 * q + r) ? n[r] : 0.f;
              WAVE_SYNC();
              float tc[16];
#pragma unroll
              for (int t = 0; t < 16; ++t) tc[t] = (t == c16) ? 1.f : 0.f;
#pragma unroll
              for (int s2 = 0; s2 < 15; ++s2) { const f32x4 n0 = *(const f32x4*)(nf + s2 * 16), n1 = *(const f32x4*)(nf + s2 * 16 + 4), n2 = *(const f32x4*)(nf + s2 * 16 + 8), n3 = *(const f32x4*)(nf + s2 * 16 + 12);
                  const float ts = tc[s2]; const float nn[16] = {n0.x, n0.y, n0.z, n0.w, n1.x, n1.y, n1.z, n1.w, n2.x, n2.y, n2.z, n2.w, n3.x, n3.y, n3.z, n3.w};
#pragma unroll
                  for (int t = 0; t < 16; ++t) if (t > s2) tc[t] += nn[t] * ts; }
              if (q == 0) { bf16* tm = (bf16*)(sl + O_TM) + c16;
#pragma unroll
                  for (int t = 0; t < 16; ++t) tm[t * 16] = f2bf(tc[t]); }
          } else {
              const bf16x8_t r0f = *(const bf16x8_t*)((const bf16*)(sl + O_RT) + c16 * 64 + 8 * q), r1f = *(const bf16x8_t*)((const bf16*)(sl + O_RT) + c16 * 64 + 32 + 8 * q);
              const bf16x8_t kb0 = *(const bf16x8_t*)((const bf16*)(sl + O_KTL) + c16 * 64 + 8 * q), kb1 = *(const bf16x8_t*)((const bf16*)(sl + O_KTL) + c16 * 64 + 32 + 8 * q);
              f32x4_t ak = __builtin_amdgcn_mfma_f32_16x16x32_bf16(a0, kb0, z4, 0, 0, 0); ak = __builtin_amdgcn_mfma_f32_16x16x32_bf16(a1, kb1, ak, 0, 0, 0);
              f32x4_t rb = __builtin_amdgcn_mfma_f32_16x16x32_bf16(r0f, bb0, z4, 0, 0, 0); rb = __builtin_amdgcn_mfma_f32_16x16x32_bf16(r1f, bb1, rb, 0, 0, 0);
              f32x4_t rk = __builtin_amdgcn_mfma_f32_16x16x32_bf16(r0f, kb0, z4, 0, 0, 0); rk = __builtin_amdgcn_mfma_f32_16x16x32_bf16(r1f, kb1, rk, 0, 0, 0);
#pragma unroll
              for (int r = 0; r < 4; ++r) { const int t = 4 * q + r;
                  ((bf16*)(sl + O_AAK))[t * 16 + c16] = f2bf(c16 < t ? ak[r] : 0.f); ((bf16*)(sl + O_RB))[t * 16 + c16] = f2bf(c16 <= t ? rb[r] : 0.f); ((bf16*)(sl + O_RK))[t * 16 + c16] = f2bf(c16 <= t ? rk[r] : 0.f); }
          } }
        LDS_SYNC();
        if (wave < 4) { const int c16 = lane & 15, q = lane >> 4, vcol = 16 * wave + c16; u32x2 zz; zz.x = 0u; zz.y = 0u; const f32x4_t z4 = {0.f, 0.f, 0.f, 0.f};
#pragma unroll
            for (int ch = 0; ch < 4; ++ch) { const unsigned char* sl = lds + ch * SLOT;
                const bf16* at = (const bf16*)sl + c16 * 64 + 4 * q; const bf16* rt = (const bf16*)(sl + O_RT) + c16 * 64 + 4 * q;
                const bf16x8_t af0 = frag2(*(const u32x2*)at, *(const u32x2*)(at + 16)), af1 = frag2(*(const u32x2*)(at + 32), *(const u32x2*)(at + 48));
                const bf16x8_t rf0 = frag2(*(const u32x2*)rt, *(const u32x2*)(rt + 16)), rf1 = frag2(*(const u32x2*)(rt + 32), *(const u32x2*)(rt + 48));
                const u32x2 vq = *(const u32x2*)((const bf16*)(sl + O_VT) + vcol * 16 + 4 * q);
                const u32x2 aq = *(const u32x2*)((const bf16*)(sl + O_AAK) + c16 * 16 + 4 * q), tq = *(const u32x2*)((const bf16*)(sl + O_TM) + c16 * 16 + 4 * q);
                const u32x2 rbq = *(const u32x2*)((const bf16*)(sl + O_RB) + c16 * 16 + 4 * q), rkq = *(const u32x2*)((const bf16*)(sl + O_RK) + c16 * 16 + 4 * q);
                f32x4_t rhs = __builtin_amdgcn_mfma_f32_16x16x32_bf16(frag2(zz, aq), frag2(zz, vq), z4, 0, 0, 0); rhs = __builtin_amdgcn_mfma_f32_16x16x32_bf16(af0, Sf[0], rhs, 0, 0, 0);
                { const f32x4_t r2 = __builtin_amdgcn_mfma_f32_16x16x32_bf16(af1, Sf[1], z4, 0, 0, 0); rhs = rhs + r2; }
                u32x2 rl; rl.x = pk2(rhs[0], rhs[1]); rl.y = pk2(rhs[2], rhs[3]);
                const f32x4_t U = __builtin_amdgcn_mfma_f32_16x16x32_bf16(frag2(tq, zz), frag2(rl, zz), z4, 0, 0, 0);
                u32x2 ul; ul.x = pk2(U[0], U[1]); ul.y = pk2(U[2], U[3]); const bf16x8_t uv = frag2(ul, vq);
                f32x4_t y = __builtin_amdgcn_mfma_f32_16x16x32_bf16(rf0, Sf[0], z4, 0, 0, 0); y = __builtin_amdgcn_mfma_f32_16x16x32_bf16(rf1, Sf[1], y, 0, 0, 0);
                y = __builtin_amdgcn_mfma_f32_16x16x32_bf16(frag2(rbq, rkq), uv, y, 0, 0, 0);
#pragma unroll
                for (int r = 0; r < 4; ++r) Yb[(ch * 16 + 4 * q + r) * 64 + vcol] = y[r];
#pragma unroll
                for (int kt = 0; kt < 4; ++kt) { const f32x4 dl = *(const f32x4*)((const float*)(sl + O_DL) + 16 * kt + 4 * q);
                    const u32x2 bq = *(const u32x2*)((const bf16*)(sl + O_BHT) + (16 * kt + c16) * 16 + 4 * q), kq = *(const u32x2*)((const bf16*)(sl + O_KHT) + (16 * kt + c16) * 16 + 4 * q);
                    const f32x4_t cin = {Sd[kt][0] * dl.x, Sd[kt][1] * dl.y, Sd[kt][2] * dl.z, Sd[kt][3] * dl.w};
                    Sd[kt] = __builtin_amdgcn_mfma_f32_16x16x32_bf16(frag2(bq, kq), uv, cin, 0, 0, 0); }
#pragma unroll
                for (int s2 = 0; s2 < 2; ++s2) { u32x2 lo, hi; lo.x = pk2(Sd[2 * s2][0], Sd[2 * s2][1]); lo.y = pk2(Sd[2 * s2][2], Sd[2 * s2][3]); hi.x = pk2(Sd[2 * s2 + 1][0], Sd[2 * s2 + 1][1]); hi.y = pk2(Sd[2 * s2 + 1][2], Sd[2 * s2 + 1][3]); Sf[s2] = frag2(lo, hi); }
            } }
        LDS_SYNC();
        { const f32x4 y0 = *(const f32x4*)(Yb + pt * 64 + k8), y1 = *(const f32x4*)(Yb + pt * 64 + k8 + 4);
          const float mean = red8((y0.x + y0.y + y0.z + y0.w) + (y1.x + y1.y + y1.z + y1.w)) * (1.f / 64); const f32x4 d0 = y0 - mean, d1 = y1 - mean;
          const float rstd = 1.0f / sqrtf(red8((d0.x * d0.x + d0.y * d0.y + d0.z * d0.z + d0.w * d0.w) + (d1.x * d1.x + d1.y * d1.y + d1.z * d1.z + d1.w * d1.w)) * (1.f / 64) + GN_EPS);
          const float bo = ((const float*)(slot + O_BON))[tl]; f32x4 g0, g1; pg8::unpack8(gkeep, g0, g1);
          const f32x4 o0 = (d0 * rstd * *(const f32x4*)(ct_ + 384 + k8) + *(const f32x4*)(ct_ + 448 + k8) + bo * v0) * g0, o1 = (d1 * rstd * *(const f32x4*)(ct_ + 384 + k8 + 4) + *(const f32x4*)(ct_ + 448 + k8 + 4) + bo * v1) * g1;
          *(u32x4*)(YC + (size_t)(c0 + pt) * 512) = pg8::pack8(o0, o1); }
    }
#undef RWKV_FETCH
}

__device__ __forceinline__ void s5_unit(KArgs C, int layer, int unit, unsigned char* lds) {
    const int tid = fresh_tid(), lane = tid & 63, wave = tid >> 6, bl = unit >> 5, g = unit & 31, c16 = lane & 15, q = lane >> 4, sg = wave & 3, th = wave >> 2, p = 16 * sg + c16;
    constexpr int SP = 136;
    float* us = (float*)lds; float* ends = us + 1024; bf16* St = (bf16*)(ends + 16 * 128);
    const bf16* U = WSP(const bf16, WS_U) + (size_t)bl * SEQ * 512 + g * 16;
    bf16* YD0 = WSP(bf16, WS_YD0) + (size_t)bl * SEQ * 512 + g * 16;
    const size_t wo = (layer & 1) ? WDELTA : 0;
    bf16x8_t bre, bim;
    { const float* bb = WSP(const float, WS_BBAR + wo) + ((size_t)g * 64 + p) * 32; u32x4 wr_, wi_;
      if (q < 2) { const float* b8 = bb + 16 * q; wr_.x = pk2(b8[0], b8[2]); wr_.y = pk2(b8[4], b8[6]); wr_.z = pk2(b8[8], b8[10]); wr_.w = pk2(b8[12], b8[14]);
                   wi_.x = pk2(b8[1], b8[3]); wi_.y = pk2(b8[5], b8[7]); wi_.z = pk2(b8[9], b8[11]); wi_.w = pk2(b8[13], b8[15]); }
      else { wr_ = (u32x4){0u, 0u, 0u, 0u}; wi_ = wr_; }
      bre = __builtin_bit_cast(bf16x8_t, wr_); bim = __builtin_bit_cast(bf16x8_t, wi_); }
    float apr[4], api[4];
    { const float ar = WSP(const float, WS_ABAR + wo)[(g * 64 + p) * 2], ai = WSP(const float, WS_ABAR + wo)[(g * 64 + p) * 2 + 1]; apr[0] = ar; api[0] = ai;
#pragma unroll
      for (int i = 1; i < 4; ++i) { apr[i] = apr[i - 1] * ar - api[i - 1] * ai; api[i] = apr[i - 1] * ai + api[i - 1] * ar; } }
    bf16x8_t cf[4];
    { const float* cre = C->in[I_S5CRE] + ((size_t)layer * 32 + g) * 1024 + c16 * 64; const float* cim = C->in[I_S5CIM] + ((size_t)layer * 32 + g) * 1024 + c16 * 64;
#pragma unroll
      for (int ks = 0; ks < 4; ++ks) { const int c0_ = 32 * ks + 8 * q; const float* src = c0_ < 64 ? cre + c0_ : cim + (c0_ - 64); const float sgn = c0_ < 64 ? 1.f : -1.f;
          u32x4 w; w.x = pk2(sgn * src[0], sgn * src[1]); w.y = pk2(sgn * src[2], sgn * src[3]); w.z = pk2(sgn * src[4], sgn * src[5]); w.w = pk2(sgn * src[6], sgn * src[7]); cf[ks] = __builtin_bit_cast(bf16x8_t, w); } }
    const float dj = C->in[I_S5D][layer * 512 + g * 16 + c16];
    float cr = 0.f, ci = 0.f;
    u32x2 fu; fu.x = 0u; fu.y = 0u;
#define S5_FETCH(c0_) do { if (tid < 256) fu = *(const u32x2*)(U + (size_t)((c0_) + (tid >> 2)) * 512 + (tid & 3) * 4); } while (0)
    S5_FETCH(0);
    for (int c0 = 0; c0 < SEQ; c0 += 64) {
        LDS_SYNC();
        if (tid < 256) *(f32x4*)(us + (tid >> 2) * 16 + (tid & 3) * 4) = (f32x4){lo_bf(fu.x), hi_bf(fu.x), lo_bf(fu.y), hi_bf(fu.y)};
        if (c0 + 64 < SEQ) S5_FETCH(c0 + 64);
        LDS_SYNC();
        float lr[2][4], li[2][4];
#pragma unroll
        for (int tt = 0; tt < 2; ++tt) { bf16x8_t af;
            if (q < 2) { const float* ur = us + (32 * th + 16 * tt + c16) * 16 + 8 * q; const f32x4 u0 = *(const f32x4*)ur, u1 = *(const f32x4*)(ur + 4);
                u32x4 w; w.x = pk2(u0.x, u0.y); w.y = pk2(u0.z, u0.w); w.z = pk2(u1.x, u1.y); w.w = pk2(u1.z, u1.w); af = __builtin_bit_cast(bf16x8_t, w); }
            else { const u32x4 z = {0u, 0u, 0u, 0u}; af = __builtin_bit_cast(bf16x8_t, z); }
            const f32x4_t z4 = {0.f, 0.f, 0.f, 0.f};
            const f32x4_t dre = __builtin_amdgcn_mfma_f32_16x16x32_bf16(af, bre, z4, 0, 0, 0), dim = __builtin_amdgcn_mfma_f32_16x16x32_bf16(af, bim, z4, 0, 0, 0);
            lr[tt][0] = dre[0]; li[tt][0] = dim[0];
#pragma unroll
            for (int r = 1; r < 4; ++r) { lr[tt][r] = apr[0] * lr[tt][r - 1] - api[0] * li[tt][r - 1] + dre[r]; li[tt][r] = apr[0] * li[tt][r - 1] + api[0] * lr[tt][r - 1] + dim[r]; }
            const int rho = (2 * th + tt) * 4 + q; ends[(rho * 64 + p) * 2] = lr[tt][3]; ends[(rho * 64 + p) * 2 + 1] = li[tt][3]; }
        LDS_SYNC();
        { float xr = cr, xi = ci; const int rho0 = (2 * th) * 4 + q;
          for (int rr = 0; rr < 16; ++rr) {
              if (rr == rho0 || rr == rho0 + 4) { const int tt = (rr == rho0) ? 0 : 1;
#pragma unroll
                  for (int r = 0; r < 4; ++r) { const float sr = lr[tt][r] + apr[r] * xr - api[r] * xi, si = li[tt][r] + apr[r] * xi + api[r] * xr; const int t = 32 * th + 16 * tt + 4 * q + r;
                      St[t * SP + p] = f2bf(sr); St[t * SP + 64 + p] = f2bf(si); } }
              const float er = ends[(rr * 64 + p) * 2], ei = ends[(rr * 64 + p) * 2 + 1]; const float nr = apr[3] * xr - api[3] * xi + er, ni = apr[3] * xi + api[3] * xr + ei; xr = nr; xi = ni; }
          cr = xr; ci = xi; }
        LDS_SYNC();
        if (wave < 4) { f32x4_t y = {0.f, 0.f, 0.f, 0.f};
#pragma unroll
            for (int ks = 0; ks < 4; ++ks) y = __builtin_amdgcn_mfma_f32_16x16x32_bf16(*(const bf16x8_t*)(St + (16 * wave + c16) * SP + 32 * ks + 8 * q), cf[ks], y, 0, 0, 0);
#pragma unroll
            for (int r = 0; r < 4; ++r) { const int t = 16 * wave + 4 * q + r; YD0[(size_t)(c0 + t) * 512 + c16] = f2bf(gelu_tanh(y[r] + dj * us[t * 16 + c16])); } }
    }
#undef S5_FETCH
}

__device__ __forceinline__ unsigned ord_key(float f) { const unsigned u = __float_as_uint(f); return (u & 0x80000000u) ? ~u : (u | 0x80000000u); }
__device__ __forceinline__ void dsa_vt_item(KArgs C, int item, int lane, bf16* scr) {
    const int tb = item % NK64, bh = item / NK64, h = bh & 7, bl = bh >> 3;
    const bf16* V = WSP(const bf16, WS_V) + ((size_t)bl * SEQ + tb * 64) * 512 + h * 64;
    WAVE_SYNC();
#pragma unroll
    for (int i = 0; i < 8; ++i) { const int tk = (lane >> 3) + 8 * i, c8 = (lane & 7) * 8; const u32x4 w = *(const u32x4*)(V + (size_t)tk * 512 + c8);
        unsigned* d = (unsigned*)(scr + tk * 66 + c8); d[0] = w.x; d[1] = w.y; d[2] = w.z; d[3] = w.w; }
    WAVE_SYNC();
    bf16* Vt = WSP(bf16, WS_VT) + ((size_t)bh * 64) * SEQ + tb * 64 + lane;
#pragma unroll 8
    for (int d = 0; d < 64; ++d) Vt[(size_t)d * SEQ] = scr[lane * 66 + d];
}
constexpr int IDX_CAP = 128, IDX_NBIN = 1024;
__device__ __forceinline__ void dsa_index_unit(KArgs C, int unit, int lane, int wave, unsigned char* lds) {
    const int oct = unit & 7, pairid = (unit >> 3) % (NK64 / 2), kx = (unit >> 3) / (NK64 / 2), bl = kx >> 1, c = (kx & 1) ? NK64 - 1 - pairid : pairid;
    const int t0 = c * 64 + oct * 8, nkeys = (c + 1) * 64, nk64 = c + 1; const size_t row0 = (size_t)bl * SEQ + t0;
    unsigned* mrow = WSP(unsigned, WS_MASK) + (row0 + wave) * MW;
    if (nkeys <= TOPK) { for (int w = lane; w < MW; w += 64) mrow[w] = (w * 32 < nkeys) ? 0xffffffffu : 0u; return; }
    float* scf = (float*)lds;
    unsigned* hist = (unsigned*)(lds + LDS_X) + wave * (IDX_NBIN / 2); unsigned* candv = (unsigned*)(lds + LDS_X + 8 * IDX_NBIN * 2) + wave * IDX_CAP; unsigned* candi = candv + 8 * IDX_CAP; unsigned* mword = (unsigned*)(lds + LDS_X + 8 * IDX_NBIN * 2 + 16 * IDX_CAP * 4) + wave * MW;
    const bf16* SMb = WSP(const bf16, WS_SM) + (size_t)bl * SEQ * 256;
    const int l31 = lane & 31, half = lane >> 5;
    const bf16* qa = SMb + (size_t)(t0 + (l31 >> 2)) * 256 + 8 + (l31 & 3) * 32 + 8 * half;
    const bf16x8_t a0 = *(const bf16x8_t*)qa, a1 = *(const bf16x8_t*)(qa + 16);
    u32x2 wraw[4];
#pragma unroll
    for (int g = 0; g < 4; ++g) wraw[g] = *(const u32x2*)(SMb + (size_t)(t0 + 2 * g + half) * 256 + 168);
    LDS_SYNC();
    {
      float wv[4][4];
#pragma unroll
      for (int g = 0; g < 4; ++g) { const u32x2 w = wraw[g]; wv[g][0] = lo_bf(w.x) * 0.5f; wv[g][1] = hi_bf(w.x) * 0.5f; wv[g][2] = lo_bf(w.y) * 0.5f; wv[g][3] = hi_bf(w.y) * 0.5f; }
      for (int kt0 = wave; kt0 < nk64 * 2; kt0 += 8 * NWAVES) {
          bf16x8_t b0[8], b1[8];
#pragma unroll
          for (int u4 = 0; u4 < 8; ++u4) { const int kt = kt0 + 8 * u4; const bf16* kb = WSP(const bf16, WS_KI) + ((size_t)bl * SEQ + (size_t)((kt < nk64 * 2 ? kt : wave) * 32 + l31)) * 32 + 8 * half;
              b0[u4] = *(const bf16x8_t*)kb; b1[u4] = *(const bf16x8_t*)(kb + 16); }
#pragma unroll
          for (int u4 = 0; u4 < 8; ++u4) { const int kt = kt0 + 8 * u4; if (kt < nk64 * 2) {
              f32x16 d;
#pragma unroll
              for (int r = 0; r < 16; ++r) d[r] = 0.f;
              d = __builtin_amdgcn_mfma_f32_32x32x16_bf16(a0, b0[u4], d, 0, 0, 0); d = __builtin_amdgcn_mfma_f32_32x32x16_bf16(a1, b1[u4], d, 0, 0, 0);
#pragma unroll
              for (int g = 0; g < 4; ++g) { float sc = 0.f;
#pragma unroll
                  for (int j = 0; j < 4; ++j) sc += wv[g][j] * fmaxf(d[4 * g + j] * 0.17677669529f, 0.f);
                  scf[(2 * g + half) * SEQ + kt * 32 + l31] = sc; } } }
      } }
    { const int tail0 = nkeys, tail1 = ((nk64 + 7) >> 3) * 512;
      for (int e = tail0 + (int)(threadIdx.x); e < tail1; e += NTHREADS) {
#pragma unroll
          for (int qq = 0; qq < 8; ++qq) scf[qq * SEQ + e] = -3.0e38f; } }
    LDS_SYNC();
    const float* sc = scf + wave * SEQ; constexpr float NEG = -3.0e38f; const int nb8 = (nk64 + 7) >> 3;
    float v[NK64];
#pragma unroll
    for (int ib = 0; ib < NK64 / 8; ++ib) if (ib < nb8) {
#pragma unroll
        for (int j = 0; j < 8; ++j) v[ib * 8 + j] = sc[(ib * 8 + j) * 64 + lane];
        SCHED_FENCE(); }
    float mn = INFINITY, mx = -INFINITY;
#pragma unroll
    for (int ib = 0; ib < NK64 / 8; ++ib) if (ib < nb8) {
#pragma unroll
        for (int j = 0; j < 8; ++j) { const float x = v[ib * 8 + j]; mx = fmaxf(mx, x); mn = fminf(mn, x == NEG ? INFINITY : x); } }
    mn = -wave_max(-mn); mx = wave_max(mx);
    const float scale = (mx > mn) ? ((float)IDX_NBIN - 0.01f) / (mx - mn) : 0.f;
#pragma unroll
    for (int i = 0; i < IDX_NBIN / 128; ++i) hist[lane * (IDX_NBIN / 128) + i] = 0u;
    for (int w = lane; w < MW; w += 64) mword[w] = 0u;
    WAVE_SYNC();
#define IDX_BIN(x) ({ int b_ = (int)(fmaxf((x) - mn, 0.f) * scale); b_ > IDX_NBIN - 1 ? IDX_NBIN - 1 : b_; })
#pragma unroll
    for (int ib = 0; ib < NK64 / 8; ++ib) if (ib < nb8) {
#pragma unroll
        for (int j = 0; j < 8; ++j) { const int b = IDX_BIN(v[ib * 8 + j]); atomicAdd(&hist[b >> 1], (b & 1) ? 0x10000u : 1u); }
        SCHED_FENCE(); }
    WAVE_SYNC();
    int bstar, cgt;
    {
      unsigned hw[8]; int tot = 0;
#pragma unroll
      for (int i = 0; i < 8; ++i) { hw[i] = hist[lane * 8 + i]; tot += (int)(hw[i] & 0xffffu) + (int)(hw[i] >> 16); }
      int suf = tot;
#pragma unroll
      for (int o = 1; o < 64; o <<= 1) { const int t = __shfl_down(suf, o); if (lane + o < 64) suf += t; }
      const unsigned long long ge = __ballot(suf >= TOPK); const int L = 63 - __builtin_clzll(ge);
      int cum = __shfl(suf, L) - __shfl(tot, L); bstar = 16 * L; cgt = cum; bool found = false;
#pragma unroll
      for (int i = 7; i >= 0; --i) { const unsigned w = (unsigned)__shfl((int)hw[i], L); const int chi = (int)(w >> 16), clo = (int)(w & 0xffffu);
          if (!found && cum + chi >= TOPK) { bstar = 16 * L + 2 * i + 1; cgt = cum; found = true; } cum += found ? 0 : chi;
          if (!found && cum + clo >= TOPK) { bstar = 16 * L + 2 * i; cgt = cum; found = true; } cum += found ? 0 : clo; } }
    const int need = TOPK - cgt; int ncand = 0;
    unsigned mylo = 0u, myhi = 0u;
#pragma unroll
    for (int ib = 0; ib < NK64 / 8; ++ib) if (ib < nb8) {
#pragma unroll
        for (int j = 0; j < 8; ++j) { const int i = ib * 8 + j; const int b = IDX_BIN(v[i]);
            const unsigned long long bs = __ballot(b > bstar), bc = __ballot(b == bstar);
            if (lane == i) { mylo = (unsigned)bs; myhi = (unsigned)(bs >> 32); }
            if (bc != 0ull) {
                const int pos = ncand + (int)__builtin_amdgcn_mbcnt_hi((unsigned)(bc >> 32), __builtin_amdgcn_mbcnt_lo((unsigned)bc, 0u));
                if (b == bstar && pos < IDX_CAP) { candv[pos] = ord_key(v[i]); candi[pos] = (unsigned)(i * 64 + lane); }
                ncand += __popcll(bc); } }
        SCHED_FENCE(); }
    if (lane < nb8 * 8) { mword[2 * lane] = mylo; mword[2 * lane + 1] = myhi; }
#undef IDX_BIN
    WAVE_SYNC();
    if (ncand <= IDX_CAP) {
        for (int m = lane; m < ncand; m += 64) { const unsigned vm = candv[m]; int rank = 0;
#pragma unroll 4
            for (int j = 0; j < ncand; ++j) { const unsigned vj = candv[j]; rank += (vj > vm || (vj == vm && j < m)) ? 1 : 0; }
            if (rank < need) { const unsigned idx = candi[m]; atomicOr(&mword[idx >> 5], 1u << (idx & 31)); } }
    } else {
        unsigned T = 0u;
        for (int bit = 31; bit >= 0; --bit) { const unsigned cand = T | (1u << bit); int cn = 0;
#pragma unroll
            for (int ib = 0; ib < NK64 / 8; ++ib) if (ib < nb8) {
#pragma unroll
                for (int j = 0; j < 8; ++j) cn += (ord_key(v[ib * 8 + j]) >= cand) ? 1 : 0; }
            if (wave_sum_i(cn) >= TOPK) T = cand; }
        int cg = 0;
#pragma unroll
        for (int ib = 0; ib < NK64 / 8; ++ib) if (ib < nb8) {
#pragma unroll
            for (int j = 0; j < 8; ++j) cg += (ord_key(v[ib * 8 + j]) > T) ? 1 : 0; }
        const int need2 = TOPK - wave_sum_i(cg); int taken = 0;
#pragma unroll
        for (int ib = 0; ib < NK64 / 8; ++ib) if (ib < nb8) {
#pragma unroll
            for (int j = 0; j < 8; ++j) { const int i = ib * 8 + j; const unsigned kv = ord_key(v[i]); const bool eq = kv == T; const unsigned long long be = __ballot(eq);
                const int pre = __popcll(be & ((1ull << lane) - 1ull)); const bool sel = (kv > T) || (eq && (taken + pre) < need2); taken += __popcll(be);
                const unsigned long long bs = __ballot(sel); if (lane == 0) { mword[2 * i] = (unsigned)bs; mword[2 * i + 1] = (unsigned)(bs >> 32); } } }
    }
    WAVE_SYNC();
    for (int w = lane; w < MW; w += 64) mrow[w] = mword[w];
}

constexpr int AT_KP = 72, AT_VP = 72, AT_BUF = 64 * AT_KP + 64 * AT_VP;
__device__ __forceinline__ void dsa_attn_half(KArgs C, int bl, int h, int cb, int tid, bf16* tiles, const float* btab) {
    const int lane = tid & 63, wave = tid >> 6, l31 = lane & 31, hh = lane >> 5, c = 4 * cb + (wave >> 1), qb = wave & 1, q0 = c * 64 + qb * 32, qpos = q0 + l31;
    const size_t qrow = (size_t)bl * SEQ + qpos;
    const bf16* Qp = WSP(const bf16, WS_Q) + qrow * 512 + h * 64 + 8 * hh;
    const unsigned* Mp = WSP(const unsigned, WS_MASK) + qrow * MW;
    const bf16* gk = WSP(const bf16, WS_K) + ((size_t)bl * SEQ + (tid >> 3)) * 512 + h * 64 + (tid & 7) * 8;
    const bf16* gv = WSP(const bf16, WS_VT) + ((size_t)(bl * 8 + h) * 64 + (tid >> 3)) * SEQ + (tid & 7) * 8;
    const int lk = (tid >> 3) * AT_KP + (tid & 7) * 8, lv = 64 * AT_KP + (tid >> 3) * AT_VP + (tid & 7) * 8;
    constexpr float SC = 0.125f * 1.44269504089f;
    bf16x8_t qf[4];
#pragma unroll
    for (int s = 0; s < 4; ++s) qf[s] = *(const bf16x8_t*)(Qp + 16 * s);
    f32x16 O0, O1;
#pragma unroll
    for (int r = 0; r < 16; ++r) { O0[r] = 0.f; O1[r] = 0.f; }
    float m = -1e30f, lsum = 0.f;
    const int ntw = c + 1, nt = 4 * cb + 4;
    u32x4 prek = *(const u32x4*)gk, prev = *(const u32x4*)gv; u32x2 mwn = *(const u32x2*)Mp;
    LDS_SYNC();
    const float bfar = btab[0];
    *(u32x4*)(tiles + lk) = prek; *(u32x4*)(tiles + lv) = prev;
    if (nt > 1) { prek = *(const u32x4*)(gk + (size_t)64 * 512); prev = *(const u32x4*)(gv + 64); }
    for (int kt = 0; kt < nt; ++kt) {
        LDS_SYNC();
        const bf16* tb = tiles + (kt & 1) * AT_BUF; const u32x2 mw2 = mwn;
        if (kt + 1 < ntw) mwn = *(const u32x2*)(Mp + 2 * (kt + 1));
        if (kt < ntw) {
            f32x16 S[2];
#pragma unroll
            for (int t2 = 0; t2 < 2; ++t2) {
#pragma unroll
                for (int r = 0; r < 16; ++r) S[t2][r] = 0.f;
#pragma unroll
                for (int s = 0; s < 4; ++s) S[t2] = __builtin_amdgcn_mfma_f32_32x32x16_bf16(*(const bf16x8_t*)(tb + (t2 * 32 + l31) * AT_KP + 16 * s + 8 * hh), qf[s], S[t2], 0, 0, 0); }
            float tmax = -1e30f;
#pragma unroll
            for (int t2 = 0; t2 < 2; ++t2) { const int k0 = kt * 64 + t2 * 32;
                if ((k0 + 31 - q0) <= -166) {
#pragma unroll
                    for (int r = 0; r < 16; ++r) { const float v = S[t2][r] * SC + bfar; S[t2][r] = v; tmax = fmaxf(tmax, v); }
                } else { const int rb = k0 + 4 * hh - qpos + 256;
#pragma unroll
                    for (int r = 0; r < 16; ++r) { const int row = (r & 3) + 8 * (r >> 2); int ti = rb + row; ti = ti < 0 ? 0 : ti; const float v = S[t2][r] * SC + btab[ti]; S[t2][r] = v; tmax = fmaxf(tmax, v); } } }
            tmax = fmaxf(tmax, __shfl_xor(tmax, 32));
            if (__ballot(tmax > m) != 0ull) { const float mn = fmaxf(m, tmax), alpha = __builtin_amdgcn_exp2f(m - mn); m = mn; lsum *= alpha;
#pragma unroll
                for (int r = 0; r < 16; ++r) { O0[r] *= alpha; O1[r] *= alpha; } }
            float ps = 0.f;
#pragma unroll
            for (int t2 = 0; t2 < 2; ++t2) { const unsigned mwc = (t2 == 0 ? mw2.x : mw2.y) << (4 * (1 - hh));
#pragma unroll
                for (int r = 0; r < 16; ++r) { const int row = (r & 3) + 8 * (r >> 2) + 4;
                    const unsigned keep = (unsigned)((int)(mwc << (31 - row)) >> 31);
                    const float p = __uint_as_float(__float_as_uint(__builtin_amdgcn_exp2f(S[t2][r] - m)) & keep); S[t2][r] = p; ps += p; } }
            lsum += ps;
#pragma unroll
            for (int t2 = 0; t2 < 2; ++t2) { const bf16* vb = tb + 64 * AT_KP + l31 * AT_VP + t2 * 32 + 4 * hh;
#pragma unroll
                for (int s = 0; s < 2; ++s) { u32x4 w; w.x = pk2(S[t2][8 * s + 0], S[t2][8 * s + 1]); w.y = pk2(S[t2][8 * s + 2], S[t2][8 * s + 3]); w.z = pk2(S[t2][8 * s + 4], S[t2][8 * s + 5]); w.w = pk2(S[t2][8 * s + 6], S[t2][8 * s + 7]);
                    const bf16x8_t pf = __builtin_bit_cast(bf16x8_t, w);
                    O0 = __builtin_amdgcn_mfma_f32_32x32x16_bf16(frag2(*(const u32x2*)(vb + 16 * s), *(const u32x2*)(vb + 16 * s + 8)), pf, O0, 0, 0, 0);
                    O1 = __builtin_amdgcn_mfma_f32_32x32x16_bf16(frag2(*(const u32x2*)(vb + 32 * AT_VP + 16 * s), *(const u32x2*)(vb + 32 * AT_VP + 16 * s + 8)), pf, O1, 0, 0, 0); } }
        }
        if (kt + 1 < nt) { bf16* nb = tiles + ((kt + 1) & 1) * AT_BUF; *(u32x4*)(nb + lk) = prek; *(u32x4*)(nb + lv) = prev;
            if (kt + 2 < nt) { prek = *(const u32x4*)(gk + (size_t)(kt + 2) * 64 * 512); prev = *(const u32x4*)(gv + (size_t)(kt + 2) * 64); } }
    }
    lsum += __shfl_xor(lsum, 32);
    const float inv = 1.0f / lsum;
    bf16* Y = WSP(bf16, WS_Y) + (size_t)MG * 512 + qrow * 512 + h * 64 + 4 * hh;
#pragma unroll
    for (int g = 0; g < 4; ++g) { u32x2 w; w.x = pk2(O0[4 * g] * inv, O0[4 * g + 1] * inv); w.y = pk2(O0[4 * g + 2] * inv, O0[4 * g + 3] * inv); *(u32x2*)(Y + 8 * g) = w;
        u32x2 w2; w2.x = pk2(O1[4 * g] * inv, O1[4 * g + 1] * inv); w2.y = pk2(O1[4 * g + 2] * inv, O1[4 * g + 3] * inv); *(u32x2*)(Y + 32 + 8 * g) = w2; }
}
__device__ __forceinline__ void dsa_attn_unit3(KArgs C, int unit, int tid, unsigned char* lds) {
    constexpr int NPAIR = NK64 / 8;
    const int pr = unit % NPAIR, h = (unit / NPAIR) & 7, bl = unit / (NPAIR * 8);
    float* btab = (float*)lds; bf16* tiles = (bf16*)(lds + 2048);
    __syncthreads();
    { const int* tab = WSP(const int, WS_TAB); const float* relb = C->in[I_RELB];
      if (tid < 320) btab[tid] = relb[tab[tid - 256 + SEQ - 1] * 8 + h] * 1.44269504089f; }
    dsa_attn_half(C, bl, h, pr, tid, tiles, btab);
    dsa_attn_half(C, bl, h, NK64 / 4 - 1 - pr, tid, tiles, btab);
}
constexpr int SEGS_PER_GROUP = 11, NSEG = DEPTH * (1 + NGRP * SEGS_PER_GROUP) + 1;

#ifdef HOST_EMU
#define GRID_BARRIER() emu_grid_sync()
#define LDS_PTR(p) ((unsigned char*)(p))
#else
#define GRID_BARRIER() do { XcdBarrier b_; b_.bar = (unsigned*)(Ck->ws + WS_CTL); b_.x = xb_xcc_id(); b_.st = (volatile LAS unsigned*)(lds + LDS_CTL_OFF); xcd_barrier(b_); } while (0)
#define LDS_PTR(p) ((PG8_LAS unsigned char*)(p))
#endif

__global__ void __launch_bounds__(NTHREADS, 2) fwd_kernel(Args a) {
#ifdef HOST_EMU
    unsigned char* lds = emu_lds;
#else
    extern __shared__ __attribute__((aligned(16))) unsigned char lds[];
#endif
#ifdef HOST_EMU
    KArgs Ck = &a;
#else
    KArgs Ck = (KArgs)__builtin_amdgcn_kernarg_segment_ptr();
    (void)a;
#endif
#ifndef HOST_EMU
    if (threadIdx.x < 4) ((LAS unsigned*)(lds + LDS_CTL_OFF))[threadIdx.x] = 0u;
    __syncthreads();
    if (Ck->seg_hi - Ck->seg_lo > 1) (void)xcd_barrier_post((unsigned*)(Ck->ws + WS_CTL), (volatile LAS unsigned*)(lds + LDS_CTL_OFF));
#endif
#define SEGID 0
#define RUN (SEGID >= Ck->seg_lo && SEGID < Ck->seg_hi)
#define SEAM do { if (SEGID >= Ck->seg_lo && SEGID + 1 < Ck->seg_hi) { GRID_BARRIER(); } } while (0)
#define WO ((layer & 1) ? WDELTA : (size_t)0)
#define PHASE_VARS KArgs C = KLAUNDER(Ck); const int G = gridDim.x, bx = blockIdx.x, ngw = G * NWAVES; (void)ngw; const int tid = fresh_tid(), lane = tid & 63, wave = __builtin_amdgcn_readfirstlane(tid >> 6), gw = bx * NWAVES + wave; (void)lane; (void)gw; (void)C
    for (int layer = 0; layer < DEPTH; ++layer) {
#undef SEGID
#define SEGID (layer * (1 + NGRP * SEGS_PER_GROUP))
        if (RUN) { PHASE_VARS; phase_weights(C, layer, lds, gw, ngw, lane, wave); }
        SEAM;
        for (int grp = 0; grp < NGRP; ++grp) {
#define XIN ((layer == 0 ? C->in[I_X] : (const float*)C->out) + (size_t)grp * MG * D)
#define XOUT (C->out + (size_t)grp * MG * D)
#undef SEGID
#define SEGID (layer * (1 + NGRP * SEGS_PER_GROUP) + 1 + grp * SEGS_PER_GROUP + 0)
            if (RUN) { PHASE_VARS; for (int m = gw; m < MG; m += 2 * ngw) { if (m + ngw < MG) rms_rowN_bf16<2>(XIN + (size_t)m * D, C->in[I_NMIX] + layer * D, WSP(bf16, WS_H) + (size_t)m * D, (size_t)ngw * D, lane); else rms_row_bf16(XIN + (size_t)m * D, C->in[I_NMIX] + layer * D, WSP(bf16, WS_H) + (size_t)m * D, lane); } }
            SEAM;
#undef SEGID
#define SEGID (layer * (1 + NGRP * SEGS_PER_GROUP) + 1 + grp * SEGS_PER_GROUP + 1)
            if (RUN) { PHASE_VARS; pg8::Gemm g{WSP(const bf16, WS_H), WSP(const bf16, WS_WIN + WO), MG, NMIXC, D}; pg8::StaticOrder S; S.init(MG, NMIXC, G, bx);
                pg8::EpiProj E{C->ws};
                pg8::gemm_phase<pg8::EpiProj, pg8::StaticOrder>(LDS_PTR(lds), g, S, E, nullptr); }
            SEAM;
#undef SEGID
#define SEGID (layer * (1 + NGRP * SEGS_PER_GROUP) + 1 + grp * SEGS_PER_GROUP + 2)
            if (RUN) { PHASE_VARS;
                for (int m = gw; m < MG; m += 2 * ngw) { if (m + ngw < MG) { rwkv_prep_row2(C, layer, m, ngw, lane); ssd_conv_row2(C, layer, m, ngw, lane); } else { rwkv_prep_row(C, layer, m, lane); ssd_conv_row(C, layer, m, lane); } }
                for (int it = gw; it < NB * 8 * NK64; it += ngw) dsa_vt_item(C, it, lane, (bf16*)(lds + wave * 16384));
                __syncthreads();
                for (int u = bx; u < NB * NK64 * 8; u += G) dsa_index_unit(C, u, lane, wave, lds);
            }
            SEAM;
#undef SEGID
#define SEGID (layer * (1 + NGRP * SEGS_PER_GROUP) + 1 + grp * SEGS_PER_GROUP + 3)
            if (RUN) { PHASE_VARS; pg8::Gemm g{WSP(const bf16, WS_RA), WSP(const bf16, WS_WLORA + WO), MG, 1536, 256}; pg8::StaticOrder S; S.init(MG, 1536, G, bx);
                pg8::EpiLora E{WSP(float, WS_WLOG), WSP(bf16, WS_ASIG), WSP(bf16, WS_GG), C->in[I_W0] + layer * 512, C->in[I_A0] + layer * 512};
                pg8::gemm_phase<pg8::EpiLora, pg8::StaticOrder>(LDS_PTR(lds), g, S, E, nullptr); }
            SEAM;
#undef SEGID
#define SEGID (layer * (1 + NGRP * SEGS_PER_GROUP) + 1 + grp * SEGS_PER_GROUP + 4)
            if (RUN) { PHASE_VARS;
                constexpr int U_R = NB * 8, U_S = U_R + NB * 8;
                for (int u = bx; u < U_R; u += G) rwkv_unit(C, layer, u, lds);
                for (int u = (bx + G - U_R % G) % G; u < NB * 8; u += G) ssd_unit(C, layer, u, lds);
                { const int first = U_S % G, span = G - first;
                  if (bx >= first) for (int u = bx - first; u < NB * 32; u += span) s5_unit(C, layer, u, lds); }
                for (;;) {
                    const int t2 = fresh_tid();
                    volatile unsigned* qs2 = (volatile unsigned*)(lds + LDS_CTL_OFF + 32);
                    __syncthreads();
                    if (t2 == 0) *qs2 = atomicAdd((unsigned*)(Ck->ws + WS_QCTR) + ((layer * NGRP + grp) * 2) * 64, 1u);
                    __syncthreads();
                    const int u = (int)*qs2;
                    if (u >= NB * NK64) break;
                    dsa_attn_unit3(KLAUNDER(Ck), u, t2, lds);
                }
            }
            SEAM;
#undef SEGID
#define SEGID (layer * (1 + NGRP * SEGS_PER_GROUP) + 1 + grp * SEGS_PER_GROUP + 5)
            if (RUN) { PHASE_VARS;
                { pg8::Gemm g{WSP(const bf16, WS_H), WSP(const bf16, WS_WIN + WO) + (size_t)NMIXC * D, MG, 4096, D}; pg8::StaticOrder S; S.init(MG, 4096, G, bx);
                  pg8::EpiGate E{WSP(bf16, WS_G)}; pg8::gemm_phase<pg8::EpiGate, pg8::StaticOrder>(LDS_PTR(lds), g, S, E, nullptr); }
                { pg8::Gemm g{WSP(const bf16, WS_YD0), WSP(const bf16, WS_GLU + WO), MG, 512, 512}; pg8::StaticOrder S; S.init(MG, 512, G, bx);
                  pg8::EpiGlu E{WSP(const bf16, WS_YD0), WSP(bf16, WS_Y) + (size_t)3 * MG * 512, C->in[I_GLUB] + layer * 512};
                  pg8::gemm_phase<pg8::EpiGlu, pg8::StaticOrder>(LDS_PTR(lds), g, S, E, nullptr); }
                for (int it = gw; it < MG * 2; it += 4 * ngw) ssd_norm_item4(C, layer, it, ngw, MG * 2, lane);
            }
            SEAM;
#undef SEGID
#define SEGID (layer * (1 + NGRP * SEGS_PER_GROUP) + 1 + grp * SEGS_PER_GROUP + 6)
            if (RUN) { PHASE_VARS; pg8::Gemm g{WSP(const bf16, WS_Y), WSP(const bf16, WS_WB + WO), 4 * MG, 4096, 512}; pg8::MergeOrder S{G, bx};
                pg8::EpiMerge E{WSP(const bf16, WS_G), WSP(bf16, WS_MRG)};
                pg8::gemm_phase<pg8::EpiMerge, pg8::MergeOrder>(LDS_PTR(lds), g, S, E, nullptr); }
            SEAM;
#undef SEGID
#define SEGID (layer * (1 + NGRP * SEGS_PER_GROUP) + 1 + grp * SEGS_PER_GROUP + 7)
            if (RUN) { PHASE_VARS; pg8::Gemm g{WSP(const bf16, WS_MRG), WSP(const bf16, WS_WOUT + WO), MG, D, D}; pg8::StaticOrder S; S.init(MG, D, G, bx);
                pg8::EpiResid E{XIN, XOUT}; pg8::gemm_phase<pg8::EpiResid, pg8::StaticOrder>(LDS_PTR(lds), g, S, E, nullptr); }
            SEAM;
#undef SEGID
#define SEGID (layer * (1 + NGRP * SEGS_PER_GROUP) + 1 + grp * SEGS_PER_GROUP + 8)
            if (RUN) { PHASE_VARS; for (int m = gw; m < MG; m += 2 * ngw) { if (m + ngw < MG) rms_rowN_bf16<2>(XOUT + (size_t)m * D, C->in[I_NFFN] + layer * D, WSP(bf16, WS_H) + (size_t)m * D, (size_t)ngw * D, lane); else rms_row_bf16(XOUT + (size_t)m * D, C->in[I_NFFN] + layer * D, WSP(bf16, WS_H) + (size_t)m * D, lane); } }
            SEAM;
#undef SEGID
#define SEGID (layer * (1 + NGRP * SEGS_PER_GROUP) + 1 + grp * SEGS_PER_GROUP + 9)
            if (RUN) { PHASE_VARS; pg8::Gemm g{WSP(const bf16, WS_H), WSP(const bf16, WS_W13 + WO), MG, 5632, D}; pg8::StaticOrder S; S.init(MG, 5632, G, bx);
                pg8::EpiSwiglu E{WSP(bf16, WS_HID)};
                pg8::gemm_phase<pg8::EpiSwiglu, pg8::StaticOrder>(LDS_PTR(lds), g, S, E, nullptr); }
            SEAM;
#undef SEGID
#define SEGID (layer * (1 + NGRP * SEGS_PER_GROUP) + 1 + grp * SEGS_PER_GROUP + 10)
            if (RUN) { PHASE_VARS; pg8::Gemm g{WSP(const bf16, WS_HID), WSP(const bf16, WS_W2 + WO), MG, D, FFN}; pg8::StaticOrder S; S.init(MG, D, G, bx);
                pg8::EpiResid E{XOUT, XOUT}; pg8::gemm_phase<pg8::EpiResid, pg8::StaticOrder>(LDS_PTR(lds), g, S, E, nullptr); }
            SEAM;
        }
    }
#undef SEGID
#define SEGID (NSEG - 1)
    { const int layer = 0; (void)layer;
    if (RUN) { PHASE_VARS; for (int m = gw; m < M; m += 2 * ngw) { if (m + ngw < M) rms_row2_f32(C->out + (size_t)m * D, (size_t)ngw * D, C->in[I_NFIN], lane); else rms_row_f32(C->out + (size_t)m * D, C->in[I_NFIN], lane); } } }
#undef RUN
#undef SEAM
}

extern "C" void kernel_launch(void* const* d_in, const int* in_sizes, int n_in, void* d_out, int out_size, void* d_ws, size_t ws_size, hipStream_t stream) {
    static int grid = 0;
    if (grid == 0) {
        if (n_in != N_IN || out_size != M * D || ws_size < WS_END) { fprintf(stderr, "kernel_launch: unexpected shapes (n_in %d, out %d, ws %zu < %zu)\n", n_in, out_size, ws_size, (size_t)WS_END); grid = -1; return; }
        int dev = 0, cus = 0;
        if (hipGetDevice(&dev) != hipSuccess || hipDeviceGetAttribute(&cus, hipDeviceAttributeMultiprocessorCount, dev) != hipSuccess || cus < 1) { grid = -1; return; }
        if (hipFuncSetAttribute((const void*)fwd_kernel, hipFuncAttributeMaxDynamicSharedMemorySize, LDS_BYTES) != hipSuccess) { fprintf(stderr, "kernel_launch: hipFuncSetAttribute failed\n"); grid = -1; return; }
        (void)hipGetLastError();
        grid = cus;
    }
    if (grid < 0) return;
    (void)hipMemsetAsync((char*)d_ws + WS_CTL, 0, CTL_BYTES, stream);
    Args a{};
    for (int i = 0; i < N_IN; ++i) a.in[i] = (const float*)d_in[i];
    a.out = (float*)d_out; a.ws = (unsigned char*)d_ws;
#if CFG_LAUNCHES == 1
    a.seg_lo = 0; a.seg_hi = NSEG;
    hipLaunchKernelGGL(fwd_kernel, dim3(grid), dim3(NTHREADS), LDS_BYTES, stream, a);
#else
    for (int s = 0; s < NSEG; ++s) { a.seg_lo = s; a.seg_hi = s + 1; hipLaunchKernelGGL(fwd_kernel, dim3(grid), dim3(NTHREADS), LDS_BYTES, stream, a); }
#endif
}
```

```cpp
#ifdef HOST_EMU
#error "HOST_EMU is a host-only debug build"
#else
#include <hip/hip_runtime.h>
#endif
#include <cstdio>
#include <cstdint>
#include <cmath>

#ifndef CFG_BATCH
#define CFG_BATCH 16
#endif
#ifndef CFG_SEQ
#define CFG_SEQ 4096
#endif
#ifndef CFG_DEPTH
#define CFG_DEPTH 4
#endif
#ifndef CFG_NB
#define CFG_NB 8
#endif
#ifndef CFG_LAUNCHES
#define CFG_LAUNCHES 1
#endif

typedef unsigned short bf16;
typedef float f32x4 __attribute__((ext_vector_type(4)));
typedef float f32x2 __attribute__((ext_vector_type(2)));
typedef unsigned u32x4 __attribute__((ext_vector_type(4)));
typedef unsigned u32x2 __attribute__((ext_vector_type(2)));

constexpr int BATCH = CFG_BATCH, SEQ = CFG_SEQ, DEPTH = CFG_DEPTH, NB = CFG_NB;
constexpr int D = 1024, M = BATCH * SEQ, MG = NB * SEQ, NGRP = BATCH / NB;
constexpr int IN_COLS = 9388, NPROJ = 9472, NMIXC = 5376, FFN = 2816;
constexpr int TOPK = (SEQ / 4) < 256 ? (SEQ / 4) : 256;
constexpr int NK64 = SEQ / 64, MW = SEQ / 32;
constexpr float RMS_EPS = 1e-6f, GN_EPS = 64e-5f;
static_assert(BATCH % NB == 0 && MG % 256 == 0 && SEQ % 64 == 0, "shape");

enum { I_X = 0, I_RELB, I_NMIX, I_WIN, I_CONVW, I_CONVB, I_DTB, I_ALOG, I_SSDD, I_SSDNG, I_MU, I_W0, I_W2, I_A0, I_A2, I_G2, I_KK, I_KA, I_RK, I_LNG, I_LNB,
       I_S5ARE, I_S5AIM, I_S5BRE, I_S5BIM, I_S5CRE, I_S5CIM, I_S5D, I_S5LDT, I_GLUW, I_GLUB, I_WBR, I_WOUT, I_NFFN, I_W1, I_W3, I_W2F, I_NFIN, N_IN };

constexpr size_t MiB = 1u << 20;
constexpr size_t al256(size_t x) { return (x + 255) & ~(size_t)255; }
constexpr size_t WS_CTL = 0, CTL_BYTES = 64 * 1024;
constexpr size_t WS_TAB = WS_CTL + CTL_BYTES;
constexpr size_t WS_ABAR = al256(WS_TAB + (SEQ + 64) * 4);
constexpr size_t WS_BBAR = WS_ABAR + 32 * 64 * 2 * 4;
constexpr size_t WS_WIN = al256(WS_BBAR + 32 * 64 * 16 * 2 * 4);
constexpr size_t WS_WB = WS_WIN + (size_t)NPROJ * 1024 * 2;
constexpr size_t WS_WOUT = WS_WB + (size_t)4 * 1024 * 512 * 2;
constexpr size_t WS_W13 = WS_WOUT + (size_t)1024 * 1024 * 2;
constexpr size_t WS_W2 = WS_W13 + (size_t)5632 * 1024 * 2;
constexpr size_t WS_GLU = WS_W2 + (size_t)1024 * 2816 * 2;
constexpr size_t WS_WLORA = WS_GLU + (size_t)512 * 512 * 2;
constexpr size_t WS_H = al256(WS_WLORA + (size_t)1536 * 256 * 2);
constexpr size_t WS_Z = WS_H + (size_t)MG * 1024 * 2;
constexpr size_t WS_XBC = WS_Z + (size_t)MG * 512 * 2;
constexpr size_t WS_Q = WS_XBC + (size_t)MG * 768 * 2;
constexpr size_t WS_K = WS_Q + (size_t)MG * 512 * 2;
constexpr size_t WS_V = WS_K + (size_t)MG * 512 * 2;
constexpr size_t WS_RW = WS_V + (size_t)MG * 512 * 2;
constexpr size_t WS_U = WS_RW + (size_t)MG * 1792 * 2;
constexpr size_t WS_SM = WS_U + (size_t)MG * 512 * 2;
constexpr size_t WS_G = WS_Q;
constexpr size_t WS_Y = WS_SM + (size_t)MG * 256 * 2;
constexpr size_t WS_YD0 = WS_Y + (size_t)4 * MG * 512 * 2;
constexpr size_t WS_MRG = WS_YD0 + (size_t)MG * 512 * 2;
constexpr size_t WS_MASK = WS_MRG + (size_t)MG * 1024 * 2;
constexpr size_t WS_RA = WS_MASK + (size_t)MG * MW * 4;
constexpr size_t WS_WLOG = WS_RA + (size_t)MG * 256 * 2;
constexpr size_t WS_ASIG = WS_WLOG + (size_t)MG * 512 * 4;
constexpr size_t WS_GG = WS_ASIG + (size_t)MG * 512 * 2;
constexpr size_t WS_XBA = WS_GG + (size_t)MG * 512 * 2;
constexpr size_t WS_VT = WS_XBA + (size_t)MG * 768 * 2;
constexpr size_t WS_KI = WS_VT + (size_t)MG * 512 * 2;
constexpr size_t WS_QCTR = 16384;
constexpr size_t WS_HID = WS_G;
constexpr size_t WS_WALT = al256(WS_KI + (size_t)MG * 32 * 2);
constexpr size_t WDELTA = WS_WALT - WS_ABAR;
constexpr size_t WS_END = WS_WALT + (WS_H - WS_ABAR);
static_assert(WS_SM + (size_t)MG * 256 * 2 - WS_Q == (size_t)MG * 4096 * 2, "G overlays exactly Q..SM");
static_assert((size_t)MG * 2816 * 2 <= (size_t)MG * 4096 * 2, "HID fits in G");

constexpr int LDS_SCRATCH = 131072;
constexpr int LDS_CTL_OFF = LDS_SCRATCH;
constexpr int LDS_X = LDS_SCRATCH + 64;
constexpr int LDS_BYTES = 161792;
constexpr int NTHREADS = 512, NWAVES = 8;

__device__ __forceinline__ float bf2f(bf16 v) { return __uint_as_float(((unsigned)v) << 16); }
#ifdef HOST_EMU
__device__ __forceinline__ bf16 f2bf(float f) { unsigned u = __float_as_uint(f); u += 0x7fffu + ((u >> 16) & 1u); return (bf16)(u >> 16); }
#else
__device__ __forceinline__ bf16 f2bf(float f) { return __builtin_bit_cast(bf16, (__bf16)f); }
#endif
#ifdef HOST_EMU
__device__ __forceinline__ unsigned pk2(float lo, float hi) { return (unsigned)f2bf(lo) | ((unsigned)f2bf(hi) << 16); }
#else
typedef __bf16 bf16x2_hw __attribute__((ext_vector_type(2)));
__device__ __forceinline__ unsigned pk2(float lo, float hi) { const f32x2 v = {lo, hi}; return __builtin_bit_cast(unsigned, __builtin_convertvector(v, bf16x2_hw)); }
#endif
__device__ __forceinline__ float lo_bf(unsigned w) { return __uint_as_float(w << 16); }
__device__ __forceinline__ float hi_bf(unsigned w) { return __uint_as_float(w & 0xffff0000u); }
__device__ __forceinline__ float sigm(float x) { return 1.0f / (1.0f + __expf(-x)); }
__device__ __forceinline__ float softplusf(float x) { return x > 20.f ? x : log1pf(__expf(x)); }
__device__ __forceinline__ float gelu_tanh(float x) { const float u = 0.7978845608f * (x + 0.044715f * x * x * x); return 0.5f * x * (1.0f + tanhf(u)); }
__device__ __forceinline__ float wave_sum(float v) {
#pragma unroll
    for (int o = 1; o < 64; o <<= 1) v += __shfl_xor(v, o);
    return v;
}
__device__ __forceinline__ float wave_max(float v) {
#pragma unroll
    for (int o = 1; o < 64; o <<= 1) v = fmaxf(v, __shfl_xor(v, o));
    return v;
}
__device__ __forceinline__ int wave_sum_i(int v) {
#pragma unroll
    for (int o = 1; o < 64; o <<= 1) v += __shfl_xor(v, o);
    return v;
}
#ifdef HOST_EMU
#define WAVE_SYNC() (void)emu_wave_exchange(0)
#define SCHED_FENCE() do {} while (0)
#define LDS_SYNC() __syncthreads()
#else
#define WAVE_SYNC() __builtin_amdgcn_wave_barrier()
#define SCHED_FENCE() __builtin_amdgcn_sched_barrier(0)
#define LDS_SYNC() do { asm volatile("s_waitcnt lgkmcnt(0)" ::: "memory"); __builtin_amdgcn_s_barrier(); asm volatile("" ::: "memory"); } while (0)
#endif
#ifndef HOST_EMU
namespace pg8 {
__device__ __forceinline__ int pg8_fresh_tid() { int t = (int)threadIdx.x; asm volatile("" : "+v"(t)); return t; }
#define PG8_LAS __attribute__((address_space(3)))
typedef unsigned short bf16_t;
typedef short bf16x8 __attribute__((ext_vector_type(8)));
typedef float f32x4 __attribute__((ext_vector_type(4)));
typedef unsigned u32x4 __attribute__((ext_vector_type(4)));
constexpr int BM = 256, BK = 64, HALF = 128, HTB = HALF * BK * 2  , STAGE_BYTES = 8 * HTB, NXCD = 8, WGM = 8;

__host__ __device__ __forceinline__ int lds_byte(int r, int c) { const int st = (r >> 4) * 2 + (c >> 5), rr = r & 15, cc = c & 31, ob = rr * 64 + cc * 2; return st * 1024 + (ob ^ (((ob >> 9) & 1) << 5)); }
__host__ __device__ __forceinline__ void stage_rc(int b, int& R, int& C) { const int st = b / 1024, sb = b % 1024, swz = sb ^ (((sb >> 9) & 1) << 5); R = (st >> 1) * 16 + swz / 64; C = (st & 1) * 32 + (swz % 64) / 2; }
__host__ __device__ __forceinline__ int perm32(int rho) { const int n = rho >> 4, i = rho & 15; return 8 * (i >> 2) + 4 * n + (i & 3); }

struct Unit { int pm, pn; };
struct Gemm { const bf16_t* A; const bf16_t* Bt; int M, N, K; };

struct StaticOrder {
    int nM, nN, nwg, G, c;
    __host__ __device__ void init(int M, int N, int G_, int c_) { nM = M / BM; nN = N / BM; nwg = nM * nN; G = G_; c = c_; }
    __host__ __device__ bool next(int i, Unit& u) const {
        const long L = (long)i * G + c; if (L >= nwg) return false;
        int wgid = (int)L; { const int q = nwg / NXCD, r = nwg % NXCD, xcd = wgid % NXCD, off = wgid / NXCD; wgid = (xcd < r ? xcd * (q + 1) : r * (q + 1) + (xcd - r) * q) + off; }
        const int nig = WGM * nN, gid = wgid / nig, fm = gid * WGM, gsz = (nM - fm) < WGM ? (nM - fm) : WGM;
        u.pm = fm + ((wgid % nig) % gsz); u.pn = (wgid % nig) / gsz; return true;
    }
    __device__ __forceinline__ void a_ready(const Unit&) const {}
    __device__ __forceinline__ void done(const Unit&) const {}
};

__device__ __forceinline__ unsigned cvt_pk_bf16(float lo, float hi) { return pk2(lo, hi); }

template <class E, class = void> struct epi_keep { static constexpr bool value = false; };
template <class E> struct epi_keep<E, decltype((void)E::KEEP_ACC)> { static constexpr bool value = true; };
template <class Epi, class Sched, bool STAMP = false, bool ALIGN_EPI = false, bool SP2 = false>
__device__ __forceinline__ void gemm_phase(PG8_LAS unsigned char* lds, const Gemm g, const Sched& S, const Epi& E, unsigned long long* stamps) {
    const int tid = pg8_fresh_tid(), wid = __builtin_amdgcn_readfirstlane(tid >> 6), lane = tid & 63, wr = wid >> 2, wc = wid & 3, fr = lane & 15, fq = lane >> 4;
    int K_ = g.K; asm volatile("" : "+s"(K_));
    const int K = K_, nt = K / BK;
    int ts_lo = 0, ts_hi = 0, nts = 0; const unsigned long long rt_entry = STAMP ? (unsigned long long)wall_clock64() : 0ull;
#define PG8_STAMP() do { if (STAMP && wid == 0 && nts < 64) { const unsigned long long _c = (unsigned long long)clock64(); \
        ts_lo = (lane == nts) ? (int)(unsigned)_c : ts_lo; ts_hi = (lane == nts) ? (int)(unsigned)(_c >> 32) : ts_hi; ++nts; } } while (0)
    PG8_STAMP();
    unsigned voffA[2], voffB[2];
#pragma unroll
    for (int i = 0; i < 2; ++i) { int R, C; stage_rc(tid * 16 + i * 8192, R, C); const int Rb = Epi::PERM ? ((R & ~31) + perm32(R & 31)) : R;
        voffA[i] = (unsigned)(R * K + C) * 2u; voffB[i] = (unsigned)(Rb * K + C) * 2u; }
    const size_t kstep = (size_t)(BK * 2);
    const size_t hstep = (size_t)HALF * K * 2;
    const size_t tstep = 2 * hstep;
    const unsigned ldsw = (unsigned)wid * 1024u;
    const int aoff = lds_byte(wr * 64 + fr, fq * 8), boff = lds_byte(wc * 32 + fr, fq * 8);
#define PG8_SA(b, h) (((b) * 2 + (h)) * HTB)
#define PG8_SB(b, h) ((4 + (b) * 2 + (h)) * HTB)
#define PG8_STAGE(bufoff, gbase, voff) do { _Pragma("unroll") for (int _i = 0; _i < 2; ++_i) \
        __builtin_amdgcn_global_load_lds((const unsigned*)((const char*)(gbase) + (voff)[_i]), (PG8_LAS unsigned*)(lds + (bufoff) + ldsw + _i * 8192), 16, 0, 0); } while (0)
#define PG8_LDA(dst, b, h) do { _Pragma("unroll") for (int m = 0; m < 4; ++m) _Pragma("unroll") for (int k = 0; k < 2; ++k) dst[m][k] = *(const PG8_LAS bf16x8*)(lds + PG8_SA(b, h) + aoff + m * 2048 + k * 1024); } while (0)
#define PG8_LDB(dst, b, h) do { _Pragma("unroll") for (int n = 0; n < 2; ++n) _Pragma("unroll") for (int k = 0; k < 2; ++k) dst[n][k] = *(const PG8_LAS bf16x8*)(lds + PG8_SB(b, h) + boff + n * 2048 + k * 1024); } while (0)
#define PG8_MMA(ai, bj, At, Bt) do { __builtin_amdgcn_s_setprio(1); _Pragma("unroll") for (int m = 0; m < 4; ++m) _Pragma("unroll") for (int n = 0; n < 2; ++n) _Pragma("unroll") for (int k = 0; k < 2; ++k) \
        acc[ai][bj][m][n] = __builtin_amdgcn_mfma_f32_16x16x32_bf16(Bt[n][k], At[m][k], acc[ai][bj][m][n], 0, 0, 0); __builtin_amdgcn_s_setprio(0); } while (0)
#define PG8_WAIT_V(n) asm volatile("s_waitcnt vmcnt(" #n ")" ::: "memory")
#define PG8_WAIT_L(n) asm volatile("s_waitcnt lgkmcnt(" #n ")" ::: "memory")
#define PG8_BAR __builtin_amdgcn_s_barrier()
#define PG8_SCHED __builtin_amdgcn_sched_barrier(0)
    Unit cur, nxt; int ui = 0;
    if (!S.next(0, cur)) return;
    f32x4 acc[2][2][4][2];
#pragma unroll
    for (int a = 0; a < 2; ++a)
#pragma unroll
        for (int b = 0; b < 2; ++b)
#pragma unroll
            for (int m = 0; m < 4; ++m)
#pragma unroll
                for (int n = 0; n < 2; ++n) acc[a][b][m][n] = (f32x4){0.f, 0.f, 0.f, 0.f};
    bf16x8 At[4][2], B0[2][2], B1[2][2];
    const char* cA = (const char*)g.A + (size_t)cur.pm * tstep; const char* cB = (const char*)g.Bt + (size_t)cur.pn * tstep;
    S.a_ready(cur);
    if constexpr (SP2) {
        PG8_STAGE(PG8_SB(0, 0), cB, voffB); PG8_STAGE(PG8_SB(0, 1), cB + hstep, voffB); PG8_STAGE(PG8_SA(0, 0), cA, voffA); PG8_STAGE(PG8_SA(0, 1), cA + hstep, voffA);
        if (wr == 1) PG8_BAR;
        PG8_WAIT_V(2); PG8_BAR;
        PG8_STAGE(PG8_SB(1, 0), cB + kstep, voffB); PG8_STAGE(PG8_SA(1, 0), cA + kstep, voffA); PG8_STAGE(PG8_SB(1, 1), cB + hstep + kstep, voffB);
        PG8_WAIT_V(6); PG8_BAR;
    } else {
    PG8_STAGE(PG8_SB(0, 0), cB, voffB); PG8_STAGE(PG8_SA(0, 0), cA, voffA); PG8_STAGE(PG8_SB(0, 1), cB + hstep, voffB); PG8_STAGE(PG8_SA(0, 1), cA + hstep, voffA);
    if (wr == 1) PG8_BAR;
    PG8_WAIT_V(4); PG8_BAR;
    PG8_STAGE(PG8_SB(1, 0), cB + kstep, voffB); PG8_STAGE(PG8_SA(1, 0), cA + kstep, voffA); PG8_STAGE(PG8_SB(1, 1), cB + hstep + kstep, voffB);
    PG8_WAIT_V(6); PG8_BAR;
    }
    PG8_STAMP();
    for (;;) {
        const bool has_next = S.next(ui + 1, nxt);
        const char* nA = has_next ? (const char*)g.A + (size_t)nxt.pm * tstep : cA; const char* nB = has_next ? (const char*)g.Bt + (size_t)nxt.pn * tstep : cB;
        for (int t = 0; t < nt; t += 2) {
            const bool last = (t == nt - 2);
            const char* a1 = cA + (size_t)(t + 1) * kstep;
            const char* a2 = last ? nA : cA + (size_t)(t + 2) * kstep; const char* b2 = last ? nB : cB + (size_t)(t + 2) * kstep;
            const char* a3 = a2 + kstep; const char* b3 = b2 + kstep;
            if (last && has_next) S.a_ready(nxt);
            if constexpr (SP2) {
            PG8_LDB(B0, 0, 0); PG8_LDB(B1, 0, 1); PG8_SCHED; PG8_LDA(At, 0, 0); PG8_STAGE(PG8_SA(1, 1), a1 + hstep, voffA);
            PG8_WAIT_V(8); PG8_WAIT_L(0); PG8_BAR; PG8_MMA(0, 0, At, B0); PG8_MMA(0, 1, At, B1); PG8_BAR; PG8_SCHED;
            PG8_LDA(At, 0, 1); PG8_STAGE(PG8_SB(0, 0), b2, voffB); PG8_STAGE(PG8_SB(0, 1), b2 + hstep, voffB); PG8_STAGE(PG8_SA(0, 0), a2, voffA);
            PG8_WAIT_V(8); PG8_WAIT_L(0); PG8_BAR; PG8_MMA(1, 0, At, B0); PG8_MMA(1, 1, At, B1); PG8_BAR; PG8_SCHED;
            PG8_LDB(B0, 1, 0); PG8_LDB(B1, 1, 1); PG8_SCHED; PG8_LDA(At, 1, 0); PG8_STAGE(PG8_SA(0, 1), a2 + hstep, voffA);
            PG8_WAIT_V(8); PG8_WAIT_L(0); PG8_BAR; PG8_MMA(0, 0, At, B0); PG8_MMA(0, 1, At, B1); PG8_BAR; PG8_SCHED;
            PG8_LDA(At, 1, 1); PG8_STAGE(PG8_SB(1, 0), b3, voffB); PG8_STAGE(PG8_SB(1, 1), b3 + hstep, voffB); PG8_STAGE(PG8_SA(1, 0), a3, voffA);
            PG8_WAIT_V(8); PG8_WAIT_L(0); PG8_BAR; PG8_MMA(1, 0, At, B0); PG8_MMA(1, 1, At, B1); PG8_BAR; PG8_SCHED;
            } else {
            PG8_LDB(B0, 0, 0); PG8_SCHED; PG8_LDA(At, 0, 0); PG8_STAGE(PG8_SA(1, 1), a1 + hstep, voffA);
            PG8_WAIT_L(8); PG8_BAR; PG8_WAIT_L(0); PG8_MMA(0, 0, At, B0); PG8_BAR; PG8_SCHED;
            PG8_LDB(B1, 0, 1); PG8_STAGE(PG8_SB(0, 0), b2, voffB);
            PG8_BAR; PG8_WAIT_L(0); PG8_MMA(0, 1, At, B1); PG8_BAR;
            PG8_LDA(At, 0, 1); PG8_STAGE(PG8_SA(0, 0), a2, voffA);
            PG8_BAR; PG8_WAIT_L(0); PG8_MMA(1, 0, At, B0); PG8_BAR; PG8_SCHED;
            PG8_STAGE(PG8_SB(0, 1), b2 + hstep, voffB);
            PG8_WAIT_V(6); PG8_BAR; PG8_MMA(1, 1, At, B1); PG8_BAR;
            PG8_LDB(B0, 1, 0); PG8_SCHED; PG8_LDA(At, 1, 0); PG8_STAGE(PG8_SA(0, 1), a2 + hstep, voffA);
            PG8_WAIT_L(8); PG8_BAR; PG8_WAIT_L(0); PG8_MMA(0, 0, At, B0); PG8_BAR; PG8_SCHED;
            PG8_LDB(B1, 1, 1); PG8_STAGE(PG8_SB(1, 0), b3, voffB);
            PG8_BAR; PG8_WAIT_L(0); PG8_MMA(0, 1, At, B1); PG8_BAR;
            PG8_LDA(At, 1, 1); PG8_STAGE(PG8_SA(1, 0), a3, voffA);
            PG8_BAR; PG8_WAIT_L(0); PG8_MMA(1, 0, At, B0); PG8_BAR; PG8_SCHED;
            PG8_STAGE(PG8_SB(1, 1), b3 + hstep, voffB);
            PG8_WAIT_V(6); PG8_BAR; PG8_MMA(1, 1, At, B1); PG8_BAR;
            }
        }
        PG8_STAMP();
        if constexpr (ALIGN_EPI) { if (wr == 0) PG8_BAR; }
        if constexpr (!Epi::AFTER_DRAIN) { E(acc, cur, wr, wc, fr, fq); S.done(cur); }
        PG8_STAMP();
        if (!has_next) break;
        bool zero_acc = true; if constexpr (epi_keep<Epi>::value) zero_acc = !E.keep(cur);
        if (zero_acc) {
#pragma unroll
        for (int a = 0; a < 2; ++a)
#pragma unroll
            for (int b = 0; b < 2; ++b)
#pragma unroll
                for (int m = 0; m < 4; ++m)
#pragma unroll
                    for (int n = 0; n < 2; ++n) acc[a][b][m][n] = (f32x4){0.f, 0.f, 0.f, 0.f}; }
        cur = nxt; cA = nA; cB = nB; ++ui;
        if constexpr (ALIGN_EPI) { if (wr == 1) PG8_BAR; }
    }
    PG8_WAIT_V(0);
    if constexpr (!ALIGN_EPI) { if (wr == 0) PG8_BAR; }
    PG8_BAR;
    if constexpr (Epi::AFTER_DRAIN) { E.fused(acc, cur, wr, wc, fr, fq, lds, wid, lane); S.done(cur); }
    PG8_STAMP();
    if (STAMP && wid == 0) { stamps[lane] = lane < nts ? (((unsigned long long)(unsigned)ts_hi << 32) | (unsigned)ts_lo) : 0ull;
        if (lane == 62) stamps[62] = rt_entry; if (lane == 63) stamps[63] = (unsigned long long)wall_clock64(); }
#undef PG8_STAMP
#undef PG8_SA
#undef PG8_SB
#undef PG8_STAGE
#undef PG8_LDA
#undef PG8_LDB
#undef PG8_MMA
#undef PG8_WAIT_V
#undef PG8_WAIT_L
#undef PG8_BAR
#undef PG8_SCHED
}
}

#define XB_TMO      128
#define XB_XCNT(j)  (256  + 64 * (j))
#define XB_XSUB(j)  (1280 + 64 * (j))
#define XB_XGEN(j)  (2304 + 64 * (j))
#define XB_TOP      3328
#define XB_TOPGEN   3392
#define XCD_BAR_WORDS 3456
#define XB_SPIN_CAP (1u << 18)
#define LAS __attribute__((address_space(3)))

__device__ __forceinline__ unsigned xb_ld(unsigned* p)              { return __hip_atomic_load(p, __ATOMIC_RELAXED, __HIP_MEMORY_SCOPE_AGENT); }
__device__ __forceinline__ unsigned xb_add(unsigned* p, unsigned v) { return __hip_atomic_fetch_add(p, v, __ATOMIC_RELAXED, __HIP_MEMORY_SCOPE_AGENT); }
__device__ __forceinline__ unsigned xb_xcc_id() { return (unsigned)__builtin_amdgcn_s_getreg((3 << 11) | 20) & 0xFu; }
#define XB_SPIN(cond, bar) do { unsigned _sp = 0; while (cond) { __builtin_amdgcn_s_sleep(1); \
    if ((++_sp & 255u) == 0u) { if (xb_ld(&(bar)[XB_TMO])) break; if (_sp > XB_SPIN_CAP) { atomicAdd(&(bar)[XB_TMO], 1u); break; } } } } while (0)

struct XcdBarrier {
    unsigned* bar; unsigned x;
    volatile LAS unsigned* st;
};

__device__ __forceinline__ XcdBarrier xcd_barrier_post(unsigned* bar, volatile LAS unsigned* st) {
    XcdBarrier b; b.bar = bar; b.x = xb_xcc_id(); b.st = st;
    if (threadIdx.x == 0) (void)xb_add(&bar[XB_XCNT(b.x)], 1u);
    return b;
}
__device__ __forceinline__ void xcd_barrier_complete(unsigned* bar, unsigned x, unsigned& nloc, unsigned& nx) {
    const unsigned G = gridDim.x * gridDim.y * gridDim.z;
    unsigned sum, cnt, mine, sp = 0u;
    for (;;) {
        sum = 0u; cnt = 0u; mine = 0u;
#pragma unroll
        for (unsigned j = 0; j < 16; ++j) { const unsigned c = xb_ld(&bar[XB_XCNT(j)]); sum += c; cnt += (c > 0u) ? 1u : 0u; mine = (j == x) ? c : mine; }
        if (sum == G) break;
        __builtin_amdgcn_s_sleep(1);
        if ((++sp & 255u) == 0u) { if (xb_ld(&bar[XB_TMO])) break; if (sp > XB_SPIN_CAP) { atomicAdd(&bar[XB_TMO], 1u); break; } }
    }
    nloc = mine > 0u ? mine : 1u; nx = cnt > 0u ? cnt : 1u;
}

__device__ __forceinline__ void xcd_barrier(const XcdBarrier& b) {
    asm volatile("s_waitcnt vmcnt(0)" ::: "memory");
    __syncthreads();
    if (threadIdx.x == 0) {
        unsigned* bar = b.bar;
        __builtin_amdgcn_s_waitcnt(0);
        unsigned nloc = b.st[0], nx = b.st[1];
        if (nloc == 0u) { xcd_barrier_complete(bar, b.x, nloc, nx); b.st[0] = nloc; b.st[1] = nx; }
        const unsigned old = xb_add(&bar[XB_XSUB(b.x)], 1u);
        const unsigned gen = old / nloc;
        if (old + 1u == (gen + 1u) * nloc) {
            __builtin_amdgcn_fence(__ATOMIC_RELEASE, "agent");
            asm volatile("s_waitcnt vmcnt(0)" ::: "memory");
            const unsigned og = xb_add(&bar[XB_TOP], 1u);
            const unsigned tg = og / nx;
            if (og + 1u == (tg + 1u) * nx) xb_add(&bar[XB_TOPGEN], 1u);
            else XB_SPIN(xb_ld(&bar[XB_TOPGEN]) == tg, bar);
            __builtin_amdgcn_fence(__ATOMIC_ACQUIRE, "agent");
            xb_add(&bar[XB_XGEN(b.x)], 1u);
            asm volatile("s_waitcnt vmcnt(0)" ::: "memory");
        } else {
            XB_SPIN(xb_ld(&bar[XB_XGEN(b.x)]) == gen, bar);
            __builtin_amdgcn_fence(__ATOMIC_ACQUIRE, "agent");
            asm volatile("s_waitcnt vmcnt(0)" ::: "memory");
        }
    }
    __syncthreads();
}

#else
namespace pg8 {
typedef unsigned short bf16_t;
typedef float f32x4 __attribute__((ext_vector_type(4)));
typedef unsigned u32x4 __attribute__((ext_vector_type(4)));
constexpr int BM = 256, BK = 64, HALF = 128, NXCD = 8, WGM = 8;
struct Unit { int pm, pn; };
struct Gemm { const bf16_t* A; const bf16_t* Bt; int M, N, K; };
template <class E, class = void> struct epi_keep { static constexpr bool value = false; };
template <class E> struct epi_keep<E, decltype((void)E::KEEP_ACC)> { static constexpr bool value = true; };
struct StaticOrder {
    int nM, nN, nwg, G, c;
    void init(int M, int N, int G_, int c_) { nM = M / BM; nN = N / BM; nwg = nM * nN; G = G_; c = c_; }
    bool next(int i, Unit& u) const {
        const long L = (long)i * G + c; if (L >= nwg) return false;
        int wgid = (int)L; { const int q = nwg / NXCD, r = nwg % NXCD, xcd = wgid % NXCD, off = wgid / NXCD; wgid = (xcd < r ? xcd * (q + 1) : r * (q + 1) + (xcd - r) * q) + off; }
        const int nig = WGM * nN, gid = wgid / nig, fm = gid * WGM, gsz = (nM - fm) < WGM ? (nM - fm) : WGM;
        u.pm = fm + ((wgid % nig) % gsz); u.pn = (wgid % nig) / gsz; return true;
    }
    void a_ready(const Unit&) const {}
    void done(const Unit&) const {}
};
static inline unsigned cvt_pk_bf16(float lo, float hi) { return pk2(lo, hi); }
static float* emu_tile_buf(int b) { static std::vector<std::vector<float>> t; if ((int)t.size() <= b) t.resize(b + 1); if (t[b].empty()) t[b].resize(256 * 256); return t[b].data(); }
template <class Epi, class Sched, bool STAMP = false>
void gemm_phase(unsigned char* lds, const Gemm g, const Sched& S, const Epi& E, unsigned long long* stamps) {
    const int tid = threadIdx.x, wid = tid >> 6, lane = tid & 63, wr = wid >> 2, wc = wid & 3, fr = lane & 15, fq = lane >> 4;
    float* tile = emu_tile_buf(blockIdx.x);
    Unit u; f32x4 acc[2][2][4][2]; bool keep_next = false;
    for (int ui = 0; S.next(ui, u); ++ui) {
        __syncthreads();
        if (tid == 0) {
            std::vector<float> a((size_t)256 * g.K), b((size_t)256 * g.K);
            for (int r = 0; r < 256; ++r) for (int k = 0; k < g.K; ++k) { a[(size_t)r * g.K + k] = bf2f(g.A[((size_t)u.pm * 256 + r) * g.K + k]); b[(size_t)r * g.K + k] = bf2f(g.Bt[((size_t)u.pn * 256 + r) * g.K + k]); }
            for (int r = 0; r < 256; ++r) for (int c = 0; c < 256; ++c) { const float* ar = &a[(size_t)r * g.K]; const float* br = &b[(size_t)c * g.K]; float s = 0.f; for (int k = 0; k < g.K; ++k) s += ar[k] * br[k]; tile[r * 256 + c] = s; }
        }
        __syncthreads();
        if (!keep_next) for (int ai = 0; ai < 2; ++ai) for (int bj = 0; bj < 2; ++bj) for (int m = 0; m < 4; ++m) for (int n = 0; n < 2; ++n) acc[ai][bj][m][n] = (f32x4){0.f, 0.f, 0.f, 0.f};
        for (int ai = 0; ai < 2; ++ai) for (int bj = 0; bj < 2; ++bj) for (int m = 0; m < 4; ++m) for (int n = 0; n < 2; ++n) for (int j = 0; j < 4; ++j) {
            const int r = 128 * ai + 64 * wr + 16 * m + fr;
            const int c = Epi::PERM ? (128 * bj + 32 * wc + 8 * fq + 4 * n + j) : (128 * bj + 32 * wc + 16 * n + 4 * fq + j);
            acc[ai][bj][m][n][j] += tile[r * 256 + c];
        }
        E(acc, u, wr, wc, fr, fq); S.done(u);
        if constexpr (epi_keep<Epi>::value) keep_next = E.keep(u); else keep_next = false;
        __syncthreads();
    }
}
}
#endif
namespace pg8 {
#ifdef HOST_EMU
#define EPI_FENCE() do {} while (0)
#else
#define EPI_FENCE() asm volatile("" ::: "memory")
#endif
__device__ __forceinline__ u32x4 pack8(const f32x4 v0, const f32x4 v1) { u32x4 w; w.x = cvt_pk_bf16(v0[0], v0[1]); w.y = cvt_pk_bf16(v0[2], v0[3]); w.z = cvt_pk_bf16(v1[0], v1[1]); w.w = cvt_pk_bf16(v1[2], v1[3]); return w; }
__device__ __forceinline__ void unpack8(const u32x4 w, f32x4& v0, f32x4& v1) { v0 = (f32x4){lo_bf(w.x), hi_bf(w.x), lo_bf(w.y), hi_bf(w.y)}; v1 = (f32x4){lo_bf(w.z), hi_bf(w.z), lo_bf(w.w), hi_bf(w.w)}; }
__device__ __forceinline__ f32x4 sig4(const f32x4 v) { return (f32x4){sigm(v[0]), sigm(v[1]), sigm(v[2]), sigm(v[3])}; }

struct EpiProj {
    static constexpr bool PERM = true, AFTER_DRAIN = false;
    unsigned char* ws;
    __device__ __forceinline__ void operator()(const f32x4 (&acc)[2][2][4][2], const Unit& u, int wr, int wc, int fr, int fq) const {
        const int pn = u.pn; size_t off; int ld, c0;
        if (pn < 2) { off = WS_Z; ld = 512; c0 = pn * 256; }
        else if (pn < 5) { off = WS_XBC; ld = 768; c0 = (pn - 2) * 256; }
        else if (pn < 7) { off = WS_Q; ld = 512; c0 = (pn - 5) * 256; }
        else if (pn < 9) { off = WS_K; ld = 512; c0 = (pn - 7) * 256; }
        else if (pn < 11) { off = WS_V; ld = 512; c0 = (pn - 9) * 256; }
        else if (pn < 18) { off = WS_RW; ld = 1792; c0 = (pn - 11) * 256; }
        else if (pn < 20) { off = WS_U; ld = 512; c0 = (pn - 18) * 256; }
        else { off = WS_SM; ld = 256; c0 = 0; }
        bf16_t* dst = (bf16_t*)(ws + off);
        const int row0 = u.pm * BM + wr * 64 + fr, col0 = c0 + wc * 32 + 8 * fq;
        const int kic = HALF + wc * 32 + 8 * fq - 136;
        const bool ki = (pn == 20) && kic >= 0 && kic < 32;
#pragma unroll
        for (int ai = 0; ai < 2; ++ai)
#pragma unroll
            for (int m = 0; m < 4; ++m) { const size_t row = (size_t)(row0 + ai * HALF + m * 16); bf16_t* rowp = dst + row * ld + col0;
#pragma unroll
                for (int bj = 0; bj < 2; ++bj) { const u32x4 w = pack8(acc[ai][bj][m][0], acc[ai][bj][m][1]); *(u32x4*)(rowp + bj * HALF) = w;
                    if (bj == 1 && ki) *(u32x4*)((bf16_t*)(ws + WS_KI) + row * 32 + kic) = w; } }
    }
};
struct EpiGate {
    static constexpr bool PERM = true, AFTER_DRAIN = false;
    bf16_t* G;
    __device__ __forceinline__ void operator()(const f32x4 (&acc)[2][2][4][2], const Unit& u, int wr, int wc, int fr, int fq) const {
        const int row0 = u.pm * BM + wr * 64 + fr, col0 = u.pn * BM + wc * 32 + 8 * fq;
#pragma unroll
        for (int ai = 0; ai < 2; ++ai)
#pragma unroll
            for (int m = 0; m < 4; ++m) { bf16_t* rowp = G + (size_t)(row0 + ai * HALF + m * 16) * 4096 + col0;
#pragma unroll
                for (int bj = 0; bj < 2; ++bj) *(u32x4*)(rowp + bj * HALF) = pack8(sig4(acc[ai][bj][m][0]), sig4(acc[ai][bj][m][1])); }
    }
};
struct EpiMerge {
    static constexpr bool PERM = true, AFTER_DRAIN = false, KEEP_ACC = true;
    const bf16_t* G; bf16_t* MRG;
    __device__ __forceinline__ bool keep(const Unit& u) const { return (u.pn >> 2) < 3; }
    __device__ __forceinline__ void operator()(f32x4 (&acc)[2][2][4][2], const Unit& u, int wr, int wc, int fr, int fq) const {
        const int n = u.pn >> 2, pn = u.pn & 3, pm = u.pm - n * (MG / 256);
        const int row0 = pm * BM + wr * 64 + fr, col0 = pn * BM + wc * 32 + 8 * fq;
#pragma unroll
        for (int ai = 0; ai < 2; ++ai)
#pragma unroll
            for (int mp = 0; mp < 2; ++mp) { u32x4 ga[2][2], gb[2][2];
#pragma unroll
                for (int mm = 0; mm < 2; ++mm)
#pragma unroll
                    for (int bj = 0; bj < 2; ++bj) { const bf16_t* gp = G + (size_t)(row0 + ai * HALF + (2 * mp + mm) * 16) * 4096 + n * 1024 + col0 + bj * HALF; ga[mm][bj] = *(const u32x4*)gp; if (n < 3) gb[mm][bj] = *(const u32x4*)(gp + 1024); }
#pragma unroll
                for (int mm = 0; mm < 2; ++mm)
#pragma unroll
                    for (int bj = 0; bj < 2; ++bj) { const int m = 2 * mp + mm; f32x4 a0, a1; unpack8(ga[mm][bj], a0, a1);
                        if (n < 3) { f32x4 b0, b1; unpack8(gb[mm][bj], b0, b1);
#pragma unroll
                            for (int j = 0; j < 4; ++j) { acc[ai][bj][m][0][j] *= fmaxf(a0[j], 1e-6f) * __builtin_amdgcn_rcpf(fmaxf(b0[j], 1e-6f)); acc[ai][bj][m][1][j] *= fmaxf(a1[j], 1e-6f) * __builtin_amdgcn_rcpf(fmaxf(b1[j], 1e-6f)); } }
                        else {
#pragma unroll
                            for (int j = 0; j < 4; ++j) { a0[j] = fmaxf(a0[j], 1e-6f); a1[j] = fmaxf(a1[j], 1e-6f); }
                            *(u32x4*)(MRG + (size_t)(row0 + ai * HALF + m * 16) * 1024 + col0 + bj * HALF) = pack8(acc[ai][bj][m][0] * a0, acc[ai][bj][m][1] * a1); } }
                EPI_FENCE(); }
    }
};
struct MergeOrder {
    int G, c;
    __device__ __forceinline__ bool next(int i, Unit& u) const {
        const int tile = (i >> 2) * G + c, n = i & 3; if (tile >= (MG / 256) * 4) return false;
        u.pm = n * (MG / 256) + (tile >> 2); u.pn = n * 4 + (tile & 3); return true;
    }
    __device__ __forceinline__ void a_ready(const Unit&) const {}
    __device__ __forceinline__ void done(const Unit&) const {}
};
struct EpiResid {
    static constexpr bool PERM = false, AFTER_DRAIN = false;
    const float* base; float* out;
    __device__ __forceinline__ void operator()(const f32x4 (&acc)[2][2][4][2], const Unit& u, int wr, int wc, int fr, int fq) const {
        const int row0 = u.pm * BM + wr * 64 + fr, col0 = u.pn * BM + wc * 32 + 4 * fq;
#pragma unroll
        for (int ai = 0; ai < 2; ++ai) {
            f32x4 bv[4][2][2];
#pragma unroll
            for (int m = 0; m < 4; ++m)
#pragma unroll
                for (int bj = 0; bj < 2; ++bj)
#pragma unroll
                    for (int n = 0; n < 2; ++n) bv[m][bj][n] = *(const f32x4*)(base + (size_t)(row0 + ai * HALF + m * 16) * 1024 + col0 + bj * HALF + n * 16);
#pragma unroll
            for (int m = 0; m < 4; ++m)
#pragma unroll
                for (int bj = 0; bj < 2; ++bj)
#pragma unroll
                    for (int n = 0; n < 2; ++n) *(f32x4*)(out + (size_t)(row0 + ai * HALF + m * 16) * 1024 + col0 + bj * HALF + n * 16) = bv[m][bj][n] + acc[ai][bj][m][n];
            EPI_FENCE(); }
    }
};
struct EpiSwiglu {
    static constexpr bool PERM = true, AFTER_DRAIN = false;
    bf16_t* HID;
    __device__ __forceinline__ void operator()(const f32x4 (&acc)[2][2][4][2], const Unit& u, int wr, int wc, int fr, int fq) const {
        const int row0 = u.pm * BM + wr * 64 + fr, col0 = u.pn * HALF + wc * 32 + 8 * fq;
#pragma unroll
        for (int ai = 0; ai < 2; ++ai)
#pragma unroll
            for (int m = 0; m < 4; ++m) { f32x4 v[2];
#pragma unroll
                for (int n = 0; n < 2; ++n) { const f32x4 a = acc[ai][0][m][n], b = acc[ai][1][m][n]; v[n] = a * sig4(a) * b; }
                *(u32x4*)(HID + (size_t)(row0 + ai * HALF + m * 16) * FFN + col0) = pack8(v[0], v[1]); }
    }
};
struct EpiGlu {
    static constexpr bool PERM = true, AFTER_DRAIN = false;
    const bf16_t* Y0; bf16_t* OUT; const float* bias;
    __device__ __forceinline__ void operator()(const f32x4 (&acc)[2][2][4][2], const Unit& u, int wr, int wc, int fr, int fq) const {
        const int row0 = u.pm * BM + wr * 64 + fr, col0 = u.pn * BM + wc * 32 + 8 * fq;
#pragma unroll
        for (int ai = 0; ai < 2; ++ai)
#pragma unroll
            for (int m = 0; m < 4; ++m) { const size_t row = (size_t)(row0 + ai * HALF + m * 16);
#pragma unroll
                for (int bj = 0; bj < 2; ++bj) { const int col = col0 + bj * HALF;
                    f32x4 y0, y1; unpack8(*(const u32x4*)(Y0 + row * 512 + col), y0, y1);
                    const f32x4 b0 = *(const f32x4*)(bias + col), b1 = *(const f32x4*)(bias + col + 4);
                    *(u32x4*)(OUT + row * 512 + col) = pack8(y0 * sig4(acc[ai][bj][m][0] + b0), y1 * sig4(acc[ai][bj][m][1] + b1)); }
                EPI_FENCE(); }
    }
};
__device__ __forceinline__ float logdecay(float x) { return -0.6065306597f * sigm(x); }
struct EpiLora {
    static constexpr bool PERM = true, AFTER_DRAIN = false;
    float* WLOG; bf16_t* ASIG; bf16_t* GG; const float* w0; const float* a0;
    __device__ __forceinline__ void operator()(const f32x4 (&acc)[2][2][4][2], const Unit& u, int wr, int wc, int fr, int fq) const {
        const int kind = u.pn >> 1, row0 = u.pm * BM + wr * 64 + fr, col0 = (u.pn & 1) * BM + wc * 32 + 8 * fq;
        if (kind == 0) {
            f32x4 b[2][2];
#pragma unroll
            for (int bj = 0; bj < 2; ++bj) { b[bj][0] = *(const f32x4*)(w0 + col0 + bj * HALF); b[bj][1] = *(const f32x4*)(w0 + col0 + bj * HALF + 4); }
#pragma unroll
            for (int ai = 0; ai < 2; ++ai)
#pragma unroll
                for (int m = 0; m < 4; ++m)
#pragma unroll
                    for (int bj = 0; bj < 2; ++bj)
#pragma unroll
                        for (int n = 0; n < 2; ++n) { const f32x4 x = acc[ai][bj][m][n] + b[bj][n];
                            *(f32x4*)(WLOG + (size_t)(row0 + ai * HALF + m * 16) * 512 + col0 + bj * HALF + 4 * n) = (f32x4){logdecay(x[0]), logdecay(x[1]), logdecay(x[2]), logdecay(x[3])}; }
        } else if (kind == 1) {
            f32x4 b[2][2];
#pragma unroll
            for (int bj = 0; bj < 2; ++bj) { b[bj][0] = *(const f32x4*)(a0 + col0 + bj * HALF); b[bj][1] = *(const f32x4*)(a0 + col0 + bj * HALF + 4); }
#pragma unroll
            for (int ai = 0; ai < 2; ++ai)
#pragma unroll
                for (int m = 0; m < 4; ++m)
#pragma unroll
                    for (int bj = 0; bj < 2; ++bj)
                        *(u32x4*)(ASIG + (size_t)(row0 + ai * HALF + m * 16) * 512 + col0 + bj * HALF) = pack8(sig4(acc[ai][bj][m][0] + b[bj][0]), sig4(acc[ai][bj][m][1] + b[bj][1]));
        } else {
#pragma unroll
            for (int ai = 0; ai < 2; ++ai)
#pragma unroll
                for (int m = 0; m < 4; ++m)
#pragma unroll
                    for (int bj = 0; bj < 2; ++bj)
                        *(u32x4*)(GG + (size_t)(row0 + ai * HALF + m * 16) * 512 + col0 + bj * HALF) = pack8(acc[ai][bj][m][0], acc[ai][bj][m][1]);
        }
    }
};
}
typedef short bf16x8_t __attribute__((ext_vector_type(8)));
typedef float f32x16 __attribute__((ext_vector_type(16)));
typedef float f32x4_t __attribute__((ext_vector_type(4)));
__device__ __forceinline__ bf16x8_t frag2(const u32x2 lo, const u32x2 hi) { u32x4 w; w.x = lo.x; w.y = lo.y; w.z = hi.x; w.w = hi.y; return __builtin_bit_cast(bf16x8_t, w); }
struct Args { const float* in[N_IN]; float* out; unsigned char* ws; int seg_lo, seg_hi; };
#ifdef HOST_EMU
typedef const Args* KArgs;
#define KLAUNDER(p) (p)
__device__ __forceinline__ int fresh_tid() { return (int)threadIdx.x; }
#else
typedef const __attribute__((address_space(4))) Args* KArgs;
__device__ __forceinline__ KArgs klaunder(KArgs p) { asm volatile("" : "+s"(p)); return p; }
#define KLAUNDER(p) klaunder(p)
__device__ __forceinline__ int fresh_tid() { int t = (int)threadIdx.x; asm volatile("" : "+v"(t)); return t; }
#endif
#define WSP(T, off) ((T*)(C->ws + (off)))

template <class Src>
__device__ __forceinline__ void transpose_item(const Src& S, int K, bf16* WT, float* scr, int item, int lane) {
    const int nblk = S.ndst / 32, kb = item / nblk, nb = item % nblk, k0 = 64 * kb, n0 = 32 * nb;
    const float* cp = S.col(n0 + (lane & 31)); const int ld = S.ld;
#pragma unroll 8
    for (int i = 0; i < 32; ++i) { const int kk = 2 * i + (lane >> 5); scr[kk * 33 + (lane & 31)] = cp ? cp[(size_t)(k0 + kk) * ld] : 0.f; }
    WAVE_SYNC();
    const int c = lane & 7;
#pragma unroll
    for (int j = 0; j < 4; ++j) { const int n = (lane >> 3) + 8 * j; const float* s = scr + (8 * c) * 33 + n;
        u32x4 o; o.x = pk2(s[0 * 33], s[1 * 33]); o.y = pk2(s[2 * 33], s[3 * 33]); o.z = pk2(s[4 * 33], s[5 * 33]); o.w = pk2(s[6 * 33], s[7 * 33]);
        *(u32x4*)(WT + (size_t)(n0 + n) * K + k0 + 8 * c) = o; }
    WAVE_SYNC();
}
struct SrcWin { const float* w; int ndst, ld;
    __device__ __forceinline__ const float* col(int n) const {
        int s;
        if (n < 1280) s = n;
        else if (n < 2816) s = n + 8;
        else if (n < 4608) s = n - 2816 + 2988;
        else if (n < 5120) s = n - 4608 + 4780;
        else if (n < 5128) s = n - 5120 + 1280;
        else if (n < 5256) s = n - 5128 + 2824;
        else if (n < 5288) s = n - 5256 + 2952;
        else if (n < 5292) s = n - 5288 + 2984;
        else if (n < 5376) return nullptr;
        else s = n - 5376 + 5292;
        return w + s; } };
struct SrcPlain { const float* w; int ndst, ld; __device__ __forceinline__ const float* col(int n) const { return w + n; } };
struct SrcW13 { const float* w1; const float* w3; int ndst, ld;
    __device__ __forceinline__ const float* col(int n) const { const int pn = n >> 8, r = n & 255; return w1 + (r < 128 ? (ptrdiff_t)0 : (w3 - w1)) + pn * 128 + (r & 127); } };

__device__ __forceinline__ void phase_weights(KArgs C, int layer, unsigned char* lds, int gw, int ngw, int lane, int wave) {
    float* scr = (float*)(lds + wave * 16384); const size_t wo = (layer & 1) ? WDELTA : 0;
    constexpr int N_IN_ = 16 * (NPROJ / 32), N_BR = 8 * 32, N_OUT = 16 * 32, N_13 = 16 * (5632 / 32), N_2 = 44 * 32, N_GLU = 8 * 16;
    { const SrcWin s_in{C->in[I_WIN] + (size_t)layer * 1024 * IN_COLS, NPROJ, IN_COLS};
      for (int it = gw; it < N_IN_; it += ngw) transpose_item(s_in, 1024, WSP(bf16, WS_WIN + wo), scr, it, lane); }
    for (int it = gw; it < 4 * N_BR; it += ngw) { const int n = it / N_BR; const SrcPlain s_b{C->in[I_WBR] + ((size_t)layer * 4 + n) * 512 * 1024, 1024, 1024};
        transpose_item(s_b, 512, WSP(bf16, WS_WB + wo) + (size_t)n * 1024 * 512, scr, it % N_BR, lane); }
    { const SrcPlain s_out{C->in[I_WOUT] + (size_t)layer * 1024 * 1024, 1024, 1024};
      for (int it = gw; it < N_OUT; it += ngw) transpose_item(s_out, 1024, WSP(bf16, WS_WOUT + wo), scr, it, lane); }
    { const SrcW13 s_13{C->in[I_W1] + (size_t)layer * 1024 * FFN, C->in[I_W3] + (size_t)layer * 1024 * FFN, 5632, FFN};
      for (int it = gw; it < N_13; it += ngw) transpose_item(s_13, 1024, WSP(bf16, WS_W13 + wo), scr, it, lane); }
    { const SrcPlain s_2{C->in[I_W2F] + (size_t)layer * FFN * 1024, 1024, 1024};
      for (int it = gw; it < N_2; it += ngw) transpose_item(s_2, FFN, WSP(bf16, WS_W2 + wo), scr, it, lane); }
    { const SrcPlain s_glu{C->in[I_GLUW] + (size_t)layer * 512 * 512, 512, 512};
      for (int it = gw; it < N_GLU; it += ngw) transpose_item(s_glu, 512, WSP(bf16, WS_GLU + wo), scr, it, lane); }
    { const float* w2 = C->in[I_W2] + (size_t)layer * 64 * 512; const float* a2 = C->in[I_A2] + (size_t)layer * 64 * 512; const float* g2 = C->in[I_G2] + (size_t)layer * 128 * 512;
      bf16* WL = WSP(bf16, WS_WLORA + wo);
      for (int e = gw * 64 + lane; e < 1536 * 256; e += ngw * 64) { const int n = e >> 8, kc = e & 255; float v = 0.f;
          if (n < 512) { if (kc < 64) v = w2[kc * 512 + n]; } else if (n < 1024) { if (kc >= 64 && kc < 128) v = a2[(kc - 64) * 512 + (n - 512)]; } else { if (kc >= 128) v = g2[(kc - 128) * 512 + (n - 1024)]; }
          WL[e] = f2bf(v); } }
    const int gt = gw * 64 + lane, ngt = ngw * 64;
    for (int e = gt; e < 32 * 64; e += ngt) {
        const int g = e >> 6;
        const float ar = C->in[I_S5ARE][layer * 2048 + e], ai = C->in[I_S5AIM][layer * 2048 + e], dt = expf(C->in[I_S5LDT][layer * 32 + g]);
        const float mag = expf(ar * dt), abr = mag * cosf(ai * dt), abi = mag * sinf(ai * dt);
        const float den = ar * ar + ai * ai, nr = abr - 1.0f, ni = abi;
        const float qr = (nr * ar + ni * ai) / den, qi = (ni * ar - nr * ai) / den;
        float* ab = WSP(float, WS_ABAR + wo) + e * 2; ab[0] = abr; ab[1] = abi;
        float* bb = WSP(float, WS_BBAR + wo) + (size_t)e * 32;
        for (int j = 0; j < 16; ++j) { const float br = C->in[I_S5BRE][((size_t)layer * 2048 + e) * 16 + j], bi = C->in[I_S5BIM][((size_t)layer * 2048 + e) * 16 + j];
            bb[2 * j] = qr * br - qi * bi; bb[2 * j + 1] = qr * bi + qi * br; }
    }
    if (layer == 0) for (int e = gt; e < SEQ + 63; e += ngt) {
        const int rel = e - (SEQ - 1); const int n = rel < 0 ? -rel : rel; int b = rel > 0 ? 16 : 0;
        if (n < 8) b += n; else { int lg = 8 + (int)(logf((float)n / 8.0f) / 3.4657359028f * 8.0f); if (lg > 15) lg = 15; b += lg; }
        WSP(int, WS_TAB)[e] = b;
    }
}

__device__ __forceinline__ void rms_row_bf16(const float* xrow, const float* g, bf16* orow, int lane) {
    const f32x4* xr = (const f32x4*)xrow + lane; const f32x4* gr = (const f32x4*)g + lane;
    f32x4 v[4]; float s = 0.f;
#pragma unroll
    for (int j = 0; j < 4; ++j) { v[j] = xr[64 * j]; s += (v[j].x * v[j].x + v[j].y * v[j].y) + (v[j].z * v[j].z + v[j].w * v[j].w); }
    const float rstd = 1.0f / sqrtf(wave_sum(s) * (1.f / D) + RMS_EPS);
    u32x2* o8 = (u32x2*)orow + lane;
#pragma unroll
    for (int j = 0; j < 4; ++j) { const f32x4 gg = gr[64 * j]; u32x2 w; w.x = pk2(v[j].x * rstd * gg.x, v[j].y * rstd * gg.y); w.y = pk2(v[j].z * rstd * gg.z, v[j].w * rstd * gg.w); o8[64 * j] = w; }
}
template <int NR>
__device__ __forceinline__ void rms_rowN_bf16(const float* xrow, const float* g, bf16* orow, size_t step, int lane) {
    const f32x4* gr = (const f32x4*)g + lane; f32x4 v[NR][4]; float ss[NR];
#pragma unroll
    for (int q = 0; q < NR; ++q)
#pragma unroll
        for (int j = 0; j < 4; ++j) v[q][j] = ((const f32x4*)(xrow + q * step) + lane)[64 * j];
#pragma unroll
    for (int q = 0; q < NR; ++q) { float s = 0.f;
#pragma unroll
        for (int j = 0; j < 4; ++j) s += (v[q][j].x * v[q][j].x + v[q][j].y * v[q][j].y) + (v[q][j].z * v[q][j].z + v[q][j].w * v[q][j].w);
        ss[q] = s; }
#pragma unroll
    for (int o = 1; o < 64; o <<= 1)
#pragma unroll
        for (int q = 0; q < NR; ++q) ss[q] += __shfl_xor(ss[q], o);
#pragma unroll
    for (int q = 0; q < NR; ++q) { const float r = 1.0f / sqrtf(ss[q] * (1.f / D) + RMS_EPS); u32x2* o8 = (u32x2*)(orow + q * step) + lane;
#pragma unroll
        for (int j = 0; j < 4; ++j) { const f32x4 gg = gr[64 * j]; u32x2 w; w.x = pk2(v[q][j].x * r * gg.x, v[q][j].y * r * gg.y); w.y = pk2(v[q][j].z * r * gg.z, v[q][j].w * r * gg.w); o8[64 * j] = w; } }
}
__device__ __forceinline__ void rms_row_f32(float* xrow, const float* g, int lane) {
    f32x4* xr = (f32x4*)xrow + lane; const f32x4* gr = (const f32x4*)g + lane;
    f32x4 v[4]; float s = 0.f;
#pragma unroll
    for (int j = 0; j < 4; ++j) { v[j] = xr[64 * j]; s += (v[j].x * v[j].x + v[j].y * v[j].y) + (v[j].z * v[j].z + v[j].w * v[j].w); }
    const float rstd = 1.0f / sqrtf(wave_sum(s) * (1.f / D) + RMS_EPS);
#pragma unroll
    for (int j = 0; j < 4; ++j) xr[64 * j] = v[j] * rstd * gr[64 * j];
}

#ifdef HOST_EMU
__device__ __forceinline__ float red8(float v) { v += __shfl_xor(v, 1); v += __shfl_xor(v, 2); v += __shfl_xor(v, 4); return v; }
__device__ __forceinline__ float red16(float v) { v = red8(v); v += __shfl_xor(v, 8); return v; }
#else
template <int CTRL> __device__ __forceinline__ float dpp_f(float v) { return __builtin_bit_cast(float, __builtin_amdgcn_update_dpp(0, __builtin_bit_cast(int, v), CTRL, 0xf, 0xf, true)); }
__device__ __forceinline__ float red8(float v) { v += dpp_f<0xB1>(v); v += dpp_f<0x4E>(v); v += dpp_f<0x141>(v); return v; }
__device__ __forceinline__ float red16(float v) { v = red8(v); v += dpp_f<0x140>(v); return v; }
#endif
__device__ __forceinline__ f32x4 sig4g(const f32x4 v) { return (f32x4){sigm(v[0]), sigm(v[1]), sigm(v[2]), sigm(v[3])}; }
__device__ __forceinline__ void rms_row2_f32(float* xrow, size_t step, const float* g, int lane) {
    f32x4* xa = (f32x4*)xrow + lane; f32x4* xb = (f32x4*)(xrow + step) + lane; const f32x4* gr = (const f32x4*)g + lane;
    f32x4 va[4], vb[4]; float sa = 0.f, sb = 0.f;
#pragma unroll
    for (int j = 0; j < 4; ++j) { va[j] = xa[64 * j]; vb[j] = xb[64 * j]; }
#pragma unroll
    for (int j = 0; j < 4; ++j) { sa += (va[j].x * va[j].x + va[j].y * va[j].y) + (va[j].z * va[j].z + va[j].w * va[j].w); sb += (vb[j].x * vb[j].x + vb[j].y * vb[j].y) + (vb[j].z * vb[j].z + vb[j].w * vb[j].w); }
#pragma unroll
    for (int o = 1; o < 64; o <<= 1) { sa += __shfl_xor(sa, o); sb += __shfl_xor(sb, o); }
    const float ra = 1.0f / sqrtf(sa * (1.f / D) + RMS_EPS), rb = 1.0f / sqrtf(sb * (1.f / D) + RMS_EPS);
#pragma unroll
    for (int j = 0; j < 4; ++j) { const f32x4 gg = gr[64 * j]; xa[64 * j] = va[j] * ra * gg; xb[64 * j] = vb[j] * rb * gg; }
}
__device__ __forceinline__ void ssd_conv_row(KArgs C, int layer, int m, int lane) {
    const int t = m % SEQ; const float* cw = C->in[I_CONVW] + layer * 4 * 768; const float* cb = C->in[I_CONVB] + layer * 768;
#pragma unroll
    for (int i = 0; i < 3; ++i) { const int ch = i * 256 + lane * 4; const bf16* p = WSP(const bf16, WS_XBC) + (size_t)m * 768 + ch;
        f32x4 a = *(const f32x4*)(cb + ch);
#pragma unroll
        for (int q = 0; q < 4; ++q) if (t - 3 + q >= 0) { const u32x2 w = *(const u32x2*)(p - (3 - q) * 768); const f32x4 cq = *(const f32x4*)(cw + q * 768 + ch);
            a += cq * (f32x4){lo_bf(w.x), hi_bf(w.x), lo_bf(w.y), hi_bf(w.y)}; }
        a = a * sig4g(a);
        u32x2 o; o.x = pk2(a.x, a.y); o.y = pk2(a.z, a.w); *(u32x2*)(WSP(bf16, WS_XBA) + (size_t)m * 768 + ch) = o; }
}
__device__ __forceinline__ void ssd_conv_row2(KArgs C, int layer, int m, int step, int lane) {
    const float* cw = C->in[I_CONVW] + layer * 4 * 768; const float* cb = C->in[I_CONVB] + layer * 768;
    u32x2 w[2][3][4]; f32x4 cq[3][4], bb[3];
#pragma unroll
    for (int i = 0; i < 3; ++i) { const int ch = i * 256 + lane * 4; bb[i] = *(const f32x4*)(cb + ch);
#pragma unroll
        for (int q = 0; q < 4; ++q) { cq[i][q] = *(const f32x4*)(cw + q * 768 + ch);
#pragma unroll
            for (int r = 0; r < 2; ++r) { const int mm = m + r * step, t = mm % SEQ; const bf16* p = WSP(const bf16, WS_XBC) + (size_t)mm * 768 + ch;
                if (t - 3 + q >= 0) w[r][i][q] = *(const u32x2*)(p - (3 - q) * 768); else { w[r][i][q].x = 0u; w[r][i][q].y = 0u; } } } }
#pragma unroll
    for (int r = 0; r < 2; ++r)
#pragma unroll
        for (int i = 0; i < 3; ++i) { const int ch = i * 256 + lane * 4; f32x4 a = bb[i];
#pragma unroll
            for (int q = 0; q < 4; ++q) a += cq[i][q] * (f32x4){lo_bf(w[r][i][q].x), hi_bf(w[r][i][q].x), lo_bf(w[r][i][q].y), hi_bf(w[r][i][q].y)};
            a = a * sig4g(a);
            u32x2 o; o.x = pk2(a.x, a.y); o.y = pk2(a.z, a.w); *(u32x2*)(WSP(bf16, WS_XBA) + (size_t)(m + r * step) * 768 + ch) = o; }
}
__device__ __forceinline__ void ssd_unit(KArgs C, int layer, int unit, unsigned char* lds) {
    const int tid = fresh_tid(), lane = tid & 63, wave = tid >> 6, bl = unit >> 3, h = unit & 7, gi = h >> 2, pp = tid >> 3, c8 = (tid & 7) * 8, c16 = lane & 15, q = lane >> 4;
    bf16* Cb = (bf16*)lds; bf16* Bb = Cb + 4096; bf16* XT = Bb + 4096; bf16* BwT = XT + 4096; bf16* Pm = BwT + 4096; float* Yo = (float*)(Pm + 4096); float* dts = Yo + 8192; float* acs = dts + 128;
    const bf16* XA = WSP(const bf16, WS_XBA) + (size_t)bl * SEQ * 768 + (size_t)pp * 768 + c8;
    const bf16* SMp = WSP(const bf16, WS_SM) + (size_t)bl * SEQ * 256;
    const bf16* Zp = WSP(const bf16, WS_Z) + (size_t)bl * SEQ * 512 + (size_t)pp * 512 + h * 64 + c8;
    bf16* YA = WSP(bf16, WS_Y) + (size_t)bl * SEQ * 512 + (size_t)pp * 512 + h * 64 + c8;
    const float dtb = C->in[I_DTB][layer * 8 + h], A = -__expf(C->in[I_ALOG][layer * 8 + h]), Dh = C->in[I_SSDD][layer * 8 + h];
    f32x4_t Sd[2]; bf16x8_t Sf; Sd[0] = (f32x4_t){0.f, 0.f, 0.f, 0.f}; Sd[1] = Sd[0]; { u32x2 z; z.x = 0u; z.y = 0u; Sf = frag2(z, z); }
    const int pt = wave & 3, nh = wave >> 2;
    u32x4 fx, fb, fc, fz;
#define SSD_FETCH(c0_) do { const bf16* q_ = XA + (size_t)(c0_) * 768; fx = *(const u32x4*)(q_ + h * 64); fb = *(const u32x4*)(q_ + 512 + gi * 64); fc = *(const u32x4*)(q_ + 640 + gi * 64); fz = *(const u32x4*)(Zp + (size_t)(c0_) * 512); } while (0)
#define SSD_DT(c0_, par) do { if (wave == 0) { const float dt_ = softplusf(bf2f(SMp[(size_t)((c0_) + lane) * 256 + h]) + dtb); float a_ = A * dt_; \
        _Pragma("unroll") for (int o_ = 1; o_ < 64; o_ <<= 1) { const float t_ = __shfl_up(a_, o_); if (lane >= o_) a_ += t_; } dts[(par) * 64 + lane] = dt_; acs[(par) * 64 + lane] = a_; } } while (0)
    LDS_SYNC();
    SSD_FETCH(0); SSD_DT(0, 0);
    for (int c0 = 0, par = 0; c0 < SEQ; c0 += 64, par ^= 1) {
        LDS_SYNC();
        const u32x4 xk = fx, zk = fz;
        {
          const float dt = dts[par * 64 + pp], ea = __expf(acs[par * 64 + 63] - acs[par * 64 + pp]);
          *(u32x4*)(Cb + pp * 64 + c8) = fc; *(u32x4*)(Bb + pp * 64 + c8) = fb;
          f32x4 x0, x1, b0, b1; pg8::unpack8(fx, x0, x1); pg8::unpack8(fb, b0, b1); x0 = x0 * dt; x1 = x1 * dt; b0 = b0 * ea; b1 = b1 * ea;
#pragma unroll
          for (int i = 0; i < 4; ++i) { XT[(c8 + i) * 64 + pp] = f2bf(x0[i]); XT[(c8 + 4 + i) * 64 + pp] = f2bf(x1[i]); BwT[(c8 + i) * 64 + pp] = f2bf(b0[i]); BwT[(c8 + 4 + i) * 64 + pp] = f2bf(b1[i]); } }
        if (c0 + 64 < SEQ) { SSD_FETCH(c0 + 64); SSD_DT(c0 + 64, par ^ 1); }
        LDS_SYNC();
        {
          const f32x4_t z4 = {0.f, 0.f, 0.f, 0.f};
#pragma unroll
          for (int i = 0; i < 2; ++i) { const int id = wave + 8 * i, lt = id >> 2, st = id & 3; f32x4_t g = z4;
              if (st <= lt) {
#pragma unroll
                  for (int ks = 0; ks < 2; ++ks) g = __builtin_amdgcn_mfma_f32_16x16x32_bf16(*(const bf16x8_t*)(Cb + (16 * lt + c16) * 64 + 32 * ks + 8 * q), *(const bf16x8_t*)(Bb + (16 * st + c16) * 64 + 32 * ks + 8 * q), g, 0, 0, 0);
                  const float as_ = acs[par * 64 + 16 * st + c16];
#pragma unroll
                  for (int r = 0; r < 4; ++r) { const int l = 16 * lt + 4 * q + r; g[r] = (16 * st + c16 <= l) ? g[r] * __expf(acs[par * 64 + l] - as_) : 0.f; } }
#pragma unroll
              for (int r = 0; r < 4; ++r) Pm[(16 * lt + 4 * q + r) * 64 + 16 * st + c16] = f2bf(g[r]); }
#pragma unroll
          for (int lt = 0; lt < 4; ++lt) { const bf16* cr = Cb + (16 * lt + c16) * 64 + 32 * nh + 4 * q;
              const f32x4_t yo = __builtin_amdgcn_mfma_f32_16x16x32_bf16(frag2(*(const u32x2*)cr, *(const u32x2*)(cr + 16)), Sf, z4, 0, 0, 0);
#pragma unroll
              for (int r = 0; r < 4; ++r) Yo[nh * 4096 + (16 * lt + 4 * q + r) * 64 + 16 * pt + c16] = yo[r]; }
          const float eL = __expf(acs[par * 64 + 63]);
          const bf16x8_t xb0 = *(const bf16x8_t*)(XT + (16 * pt + c16) * 64 + 8 * q), xb1 = *(const bf16x8_t*)(XT + (16 * pt + c16) * 64 + 32 + 8 * q);
#pragma unroll
          for (int i = 0; i < 2; ++i) { const bf16* br = BwT + (16 * (2 * nh + i) + c16) * 64 + 8 * q; f32x4_t cin = Sd[i] * eL;
              cin = __builtin_amdgcn_mfma_f32_16x16x32_bf16(*(const bf16x8_t*)br, xb0, cin, 0, 0, 0); Sd[i] = __builtin_amdgcn_mfma_f32_16x16x32_bf16(*(const bf16x8_t*)(br + 32), xb1, cin, 0, 0, 0); }
          u32x2 lo, hi; lo.x = pk2(Sd[0][0], Sd[0][1]); lo.y = pk2(Sd[0][2], Sd[0][3]); hi.x = pk2(Sd[1][0], Sd[1][1]); hi.y = pk2(Sd[1][2], Sd[1][3]); Sf = frag2(lo, hi); }
        LDS_SYNC();
        {
          const f32x4_t z4 = {0.f, 0.f, 0.f, 0.f};
#pragma unroll
          for (int i = 0; i < 2; ++i) { const int id = wave + 8 * i, lt = id >> 2, p2 = id & 3;
              f32x4_t y = __builtin_amdgcn_mfma_f32_16x16x32_bf16(*(const bf16x8_t*)(Pm + (16 * lt + c16) * 64 + 8 * q), *(const bf16x8_t*)(XT + (16 * p2 + c16) * 64 + 8 * q), z4, 0, 0, 0);
              if (lt >= 2) y = __builtin_amdgcn_mfma_f32_16x16x32_bf16(*(const bf16x8_t*)(Pm + (16 * lt + c16) * 64 + 32 + 8 * q), *(const bf16x8_t*)(XT + (16 * p2 + c16) * 64 + 32 + 8 * q), y, 0, 0, 0);
#pragma unroll
              for (int r = 0; r < 4; ++r) { const int l = 16 * lt + 4 * q + r, o = l * 64 + 16 * p2 + c16; Yo[o] = y[r] + __expf(acs[par * 64 + l]) * (Yo[o] + Yo[4096 + o]); } } }
        LDS_SYNC();
        {
          f32x4 x0, x1, z0, z1; pg8::unpack8(xk, x0, x1); pg8::unpack8(zk, z0, z1);
          const f32x4 y0 = (*(const f32x4*)(Yo + pp * 64 + c8) + Dh * x0) * z0 * sig4g(z0), y1 = (*(const f32x4*)(Yo + pp * 64 + c8 + 4) + Dh * x1) * z1 * sig4g(z1);
          *(u32x4*)(YA + (size_t)c0 * 512) = pg8::pack8(y0, y1); }
    }
#undef SSD_FETCH
#undef SSD_DT
}
__device__ __forceinline__ void ssd_norm_item4(KArgs C, int layer, int item0, int stride, int nitems, int lane) {
    u32x2 w[4]; bf16* p[4];
#pragma unroll
    for (int q = 0; q < 4; ++q) { const int item = item0 + q * stride; p[q] = WSP(bf16, WS_Y) + (size_t)((item < nitems ? item : item0) >> 1) * 512 + ((item < nitems ? item : item0) & 1) * 256 + lane * 4; w[q] = *(const u32x2*)p[q]; }
#pragma unroll
    for (int q = 0; q < 4; ++q) { const int item = item0 + q * stride; if (item < nitems) {
        float v[4] = {lo_bf(w[q].x), hi_bf(w[q].x), lo_bf(w[q].y), hi_bf(w[q].y)};
        const float rstd = 1.0f / sqrtf(wave_sum(v[0] * v[0] + v[1] * v[1] + v[2] * v[2] + v[3] * v[3]) * (1.f / 256) + RMS_EPS);
        const float* g = C->in[I_SSDNG] + layer * 512 + (item & 1) * 256 + lane * 4;
        u32x2 o; o.x = pk2(v[0] * rstd * g[0], v[1] * rstd * g[1]); o.y = pk2(v[2] * rstd * g[2], v[3] * rstd * g[3]); *(u32x2*)p[q] = o; } }
}
__device__ __forceinline__ void rwkv_prep_row(KArgs C, int layer, int m, int lane) {
    const int t = m % SEQ, col = 1536 + lane * 4;
    const bf16* cur = WSP(const bf16, WS_RW) + (size_t)m * 1792 + col;
    const u32x2 wc = *(const u32x2*)cur; u32x2 wp; wp.x = 0u; wp.y = 0u; if (t > 0) wp = *(const u32x2*)(cur - 1792);
    const f32x4 mu = *(const f32x4*)(C->in[I_MU] + layer * 1792 + col);
    float v[4] = {lo_bf(wc.x), hi_bf(wc.x), lo_bf(wc.y), hi_bf(wc.y)}; const float p[4] = {lo_bf(wp.x), hi_bf(wp.x), lo_bf(wp.y), hi_bf(wp.y)};
#pragma unroll
    for (int i = 0; i < 4; ++i) { v[i] = v[i] + (p[i] - v[i]) * mu[i]; v[i] = lane < 16 ? tanhf(v[i]) : (lane < 32 ? v[i] : sigm(v[i])); }
    u32x2 o; o.x = pk2(v[0], v[1]); o.y = pk2(v[2], v[3]); *(u32x2*)(WSP(bf16, WS_RA) + (size_t)m * 256 + lane * 4) = o;
}
__device__ __forceinline__ void rwkv_prep_row2(KArgs C, int layer, int m, int step, int lane) {
    const int col = 1536 + lane * 4; const f32x4 mu = *(const f32x4*)(C->in[I_MU] + layer * 1792 + col);
    u32x2 wc[2], wp[2];
#pragma unroll
    for (int r = 0; r < 2; ++r) { const int mm = m + r * step; const bf16* cur = WSP(const bf16, WS_RW) + (size_t)mm * 1792 + col; wc[r] = *(const u32x2*)cur;
        if (mm % SEQ > 0) wp[r] = *(const u32x2*)(cur - 1792); else { wp[r].x = 0u; wp[r].y = 0u; } }
#pragma unroll
    for (int r = 0; r < 2; ++r) { float v[4] = {lo_bf(wc[r].x), hi_bf(wc[r].x), lo_bf(wc[r].y), hi_bf(wc[r].y)}; const float p[4] = {lo_bf(wp[r].x), hi_bf(wp[r].x), lo_bf(wp[r].y), hi_bf(wp[r].y)};
#pragma unroll
        for (int i = 0; i < 4; ++i) { v[i] = v[i] + (p[i] - v[i]) * mu[i]; v[i] = lane < 16 ? tanhf(v[i]) : (lane < 32 ? v[i] : sigm(v[i])); }
        u32x2 o; o.x = pk2(v[0], v[1]); o.y = pk2(v[2], v[3]); *(u32x2*)(WSP(bf16, WS_RA) + (size_t)(m + r * step) * 256 + lane * 4) = o; }
}
__device__ __forceinline__ void rwkv_unit(KArgs C, int layer, int unit, unsigned char* lds) {
    constexpr int SLOT = 16704, O_RT = 2048, O_BTL = 4096, O_KTL = 6144, O_BHT = 8192, O_KHT = 10240, O_VT = 12288, O_TM = 14336, O_AAK = 14848, O_RB = 15360, O_RK = 15872, O_DL = 16384, O_BON = 16640;
    const int tid = fresh_tid(), lane = tid & 63, wave = tid >> 6, bl = unit >> 3, h = unit & 7, pt = tid >> 3, k8 = (tid & 7) * 8, cc = pt >> 4, tl = pt & 15, hc = h * 64 + k8;
    float* WL = (float*)(lds + 4 * SLOT); float* Nf = WL + 4096; float* Yb = Nf + 1024; float* ct_ = Yb + 4096;
    const bf16* RW = WSP(const bf16, WS_RW) + (size_t)bl * SEQ * 1792 + hc;
    const float* WLG = WSP(const float, WS_WLOG) + (size_t)bl * SEQ * 512 + hc;
    const bf16* AS = WSP(const bf16, WS_ASIG) + (size_t)bl * SEQ * 512 + hc;
    const bf16* GG = WSP(const bf16, WS_GG) + (size_t)bl * SEQ * 512 + hc;
    bf16* YC = WSP(bf16, WS_Y) + (size_t)2 * MG * 512 + (size_t)bl * SEQ * 512 + hc;
    LDS_SYNC();
    { const int row = tid >> 6, j = tid & 63; const float* src = row == 0 ? C->in[I_MU] + layer * 1792 : row == 1 ? C->in[I_MU] + layer * 1792 + 512 : row == 2 ? C->in[I_MU] + layer * 1792 + 1024
          : row == 3 ? C->in[I_KK] + layer * 512 : row == 4 ? C->in[I_KA] + layer * 512 : row == 5 ? C->in[I_RK] + layer * 512 : row == 6 ? C->in[I_LNG] + layer * 512 : C->in[I_LNB] + layer * 512;
      ct_[tid] = src[h * 64 + j]; }
    f32x4_t Sd[4]; bf16x8_t Sf[2];
#pragma unroll
    for (int i = 0; i < 4; ++i) Sd[i] = (f32x4_t){0.f, 0.f, 0.f, 0.f};
    { u32x2 z; z.x = 0u; z.y = 0u; Sf[0] = frag2(z, z); Sf[1] = Sf[0]; }
    u32x4 rc, rp, kc, kp, vc, vp, ac, gc; f32x4 wl0, wl1;
#define RWKV_FETCH(c0_) do { const int tt_ = (c0_) + pt; const bf16* q_ = RW + (size_t)tt_ * 1792; \
        rc = *(const u32x4*)q_; kc = *(const u32x4*)(q_ + 512); vc = *(const u32x4*)(q_ + 1024); \
        if (tt_ > 0) { rp = *(const u32x4*)(q_ - 1792); kp = *(const u32x4*)(q_ - 1792 + 512); vp = *(const u32x4*)(q_ - 1792 + 1024); } else { rp = (u32x4){0u, 0u, 0u, 0u}; kp = rp; vp = rp; } \
        wl0 = *(const f32x4*)(WLG + (size_t)tt_ * 512); wl1 = *(const f32x4*)(WLG + (size_t)tt_ * 512 + 4); ac = *(const u32x4*)(AS + (size_t)tt_ * 512); gc = *(const u32x4*)(GG + (size_t)tt_ * 512); } while (0)
    RWKV_FETCH(0);
    for (int c0 = 0; c0 < SEQ; c0 += 64) {
        unsigned char* slot = lds + cc * SLOT;
        LDS_SYNC();
        f32x4 r0, r1, kq0, kq1, v0, v1, kk0, kk1, b0, b1; const u32x4 gkeep = gc; const f32x4 wk0 = wl0, wk1 = wl1;
        { f32x4 c0_, c1_, p0_, p1_, a0, a1;
          pg8::unpack8(rc, c0_, c1_); pg8::unpack8(rp, p0_, p1_); r0 = c0_ + (p0_ - c0_) * *(const f32x4*)(ct_ + k8); r1 = c1_ + (p1_ - c1_) * *(const f32x4*)(ct_ + k8 + 4);
          pg8::unpack8(kc, c0_, c1_); pg8::unpack8(kp, p0_, p1_); const f32x4 k00 = c0_ + (p0_ - c0_) * *(const f32x4*)(ct_ + 64 + k8), k01 = c1_ + (p1_ - c1_) * *(const f32x4*)(ct_ + 64 + k8 + 4);
          pg8::unpack8(vc, c0_, c1_); pg8::unpack8(vp, p0_, p1_); v0 = c0_ + (p0_ - c0_) * *(const f32x4*)(ct_ + 128 + k8); v1 = c1_ + (p1_ - c1_) * *(const f32x4*)(ct_ + 128 + k8 + 4);
          pg8::unpack8(ac, a0, a1);
          kk0 = k00 * *(const f32x4*)(ct_ + 192 + k8); kk1 = k01 * *(const f32x4*)(ct_ + 192 + k8 + 4);
          const float inv = 1.0f / fmaxf(sqrtf(red8((kk0.x * kk0.x + kk0.y * kk0.y + kk0.z * kk0.z + kk0.w * kk0.w) + (kk1.x * kk1.x + kk1.y * kk1.y + kk1.z * kk1.z + kk1.w * kk1.w))), 1e-12f);
          kk0 = kk0 * inv; kk1 = kk1 * inv; b0 = kk0 * a0; b1 = kk1 * a1;
          kq0 = k00 * (1.0f + (a0 - 1.0f) * *(const f32x4*)(ct_ + 256 + k8)); kq1 = k01 * (1.0f + (a1 - 1.0f) * *(const f32x4*)(ct_ + 256 + k8 + 4));
          const f32x4 q0 = r0 * kq0 * *(const f32x4*)(ct_ + 320 + k8), q1 = r1 * kq1 * *(const f32x4*)(ct_ + 320 + k8 + 4);
          const float bo = red8((q0.x + q0.y + q0.z + q0.w) + (q1.x + q1.y + q1.z + q1.w));
          if ((tid & 7) == 0) ((float*)(slot + O_BON))[tl] = bo;
          *(f32x4*)(WL + pt * 64 + k8) = wk0; *(f32x4*)(WL + pt * 64 + k8 + 4) = wk1; }
        if (c0 + 64 < SEQ) RWKV_FETCH(c0 + 64);
        LDS_SYNC();
        if (tid < 256) { const int c_ = tid >> 6, k_ = tid & 63; float w16[16], run = 0.f;
#pragma unroll
            for (int t = 0; t < 16; ++t) w16[t] = WL[(c_ * 16 + t) * 64 + k_];
#pragma unroll
            for (int t = 0; t < 16; ++t) { run += w16[t]; WL[(c_ * 16 + t) * 64 + k_] = run; }
            ((float*)(lds + c_ * SLOT + O_DL))[k_] = __expf(run); }
        LDS_SYNC();
        { const f32x4 cs0 = *(const f32x4*)(WL + pt * 64 + k8), cs1 = *(const f32x4*)(WL + pt * 64 + k8 + 4), d0 = *(const f32x4*)((const float*)(slot + O_DL) + k8), d1 = *(const f32x4*)((const float*)(slot + O_DL) + k8 + 4);
          f32x4 e0, e1, f0, f1, w0, w1;
#pragma unroll
          for (int i = 0; i < 4; ++i) { e0[i] = __expf(cs0[i]); e1[i] = __expf(cs1[i]); f0[i] = __builtin_amdgcn_rcpf(e0[i]); f1[i] = __builtin_amdgcn_rcpf(e1[i]); w0[i] = __expf(-wk0[i]); w1[i] = __expf(-wk1[i]); }
          const f32x4 bt0 = b0 * f0, bt1 = b1 * f1, kt0 = kq0 * f0, kt1 = kq1 * f1;
          *(u32x4*)((bf16*)slot + tl * 64 + k8) = pg8::pack8(-(kk0 * e0 * w0), -(kk1 * e1 * w1));
          *(u32x4*)((bf16*)(slot + O_RT) + tl * 64 + k8) = pg8::pack8(r0 * e0, r1 * e1);
          *(u32x4*)((bf16*)(slot + O_BTL) + tl * 64 + k8) = pg8::pack8(bt0, bt1);
          *(u32x4*)((bf16*)(slot + O_KTL) + tl * 64 + k8) = pg8::pack8(kt0, kt1);
          const f32x4 bh0 = bt0 * d0, bh1 = bt1 * d1, kh0 = kt0 * d0, kh1 = kt1 * d1;
          bf16* bht = (bf16*)(slot + O_BHT) + k8 * 16 + tl; bf16* kht = (bf16*)(slot + O_KHT) + k8 * 16 + tl; bf16* vt = (bf16*)(slot + O_VT) + k8 * 16 + tl;
#pragma unroll
          for (int i = 0; i < 4; ++i) { bht[i * 16] = f2bf(bh0[i]); bht[(i + 4) * 16] = f2bf(bh1[i]); kht[i * 16] = f2bf(kh0[i]); kht[(i + 4) * 16] = f2bf(kh1[i]); vt[i * 16] = f2bf(v0[i]); vt[(i + 4) * 16] = f2bf(v1[i]); } }
        LDS_SYNC();
        { unsigned char* sl = lds + (wave & 3) * SLOT; const int c16 = lane & 15, q = lane >> 4;
          const bf16x8_t a0 = *(const bf16x8_t*)((const bf16*)sl + c16 * 64 + 8 * q), a1 = *(const bf16x8_t*)((const bf16*)sl + c16 * 64 + 32 + 8 * q);
          const bf16x8_t bb0 = *(const bf16x8_t*)((const bf16*)(sl + O_BTL) + c16 * 64 + 8 * q), bb1 = *(const bf16x8_t*)((const bf16*)(sl + O_BTL) + c16 * 64 + 32 + 8 * q);
          const f32x4_t z4 = {0.f, 0.f, 0.f, 0.f};
          if (wave < 4) {
              f32x4_t n = __builtin_amdgcn_mfma_f32_16x16x32_bf16(a0, bb0, z4, 0, 0, 0); n = __builtin_amdgcn_mfma_f32_16x16x32_bf16(a1, bb1, n, 0, 0, 0);
              float* nf = Nf + (wave & 3) * 256;
#pragma unroll
              for (int r = 0; r < 4; ++r) nf[c16 * 16 + 4 * q + r] = (c16 < 4 * q + r) ? n[r] : 0.f;
              WAVE_SYNC();
              float tc[16];
#pragma unroll
              for (int t = 0; t < 16; ++t) tc[t] = (t == c16) ? 1.f : 0.f;
#pragma unroll
              for (int s2 = 0; s2 < 15; ++s2) { const f32x4 n0 = *(const f32x4*)(nf + s2 * 16), n1 = *(const f32x4*)(nf + s2 * 16 + 4), n2 = *(const f32x4*)(nf + s2 * 16 + 8), n3 = *(const f32x4*)(nf + s2 * 16 + 12);
                  const float ts = tc[s2]; const float nn[16] = {n0.x, n0.y, n0.z, n0.w, n1.x, n1.y, n1.z, n1.w, n2.x, n2.y, n2.z, n2.w, n3.x, n3.y, n3.z, n3.w};
#pragma unroll
                  for (int t = 0; t < 16; ++t) if (t > s2) tc[t] += nn[t] * ts; }
              if (q == 0) { bf16* tm = (bf16*)(sl + O_TM) + c16;
#pragma unroll
                  for (int t = 0; t < 16; ++t) tm[t * 16] = f2bf(tc[t]); }
          } else {
              const bf16x8_t r0f = *(const bf16x8_t*)((const bf16*)(sl + O_RT) + c16 * 64 + 8 * q), r1f = *(const bf16x8_t*)((const bf16*)(sl + O_RT) + c16 * 64 + 32 + 8 * q);
              const bf16x8_t kb0 = *(const bf16x8_t*)((const bf16*)(sl + O_KTL) + c16 * 64 + 8 * q), kb1 = *(const bf16x8_t*)((const bf16*)(sl + O_KTL) + c16 * 64 + 32 + 8 * q);
              f32x4_t ak = __builtin_amdgcn_mfma_f32_16x16x32_bf16(a0, kb0, z4, 0, 0, 0); ak = __builtin_amdgcn_mfma_f32_16x16x32_bf16(a1, kb1, ak, 0, 0, 0);
              f32x4_t rb = __builtin_amdgcn_mfma_f32_16x16x32_bf16(r0f, bb0, z4, 0, 0, 0); rb = __builtin_amdgcn_mfma_f32_16x16x32_bf16(r1f, bb1, rb, 0, 0, 0);
              f32x4_t rk = __builtin_amdgcn_mfma_f32_16x16x32_bf16(r0f, kb0, z4, 0, 0, 0); rk = __builtin_amdgcn_mfma_f32_16x16x32_bf16(r1f, kb1, rk, 0, 0, 0);
#pragma unroll
              for (int r = 0; r < 4; ++r) { const int t = 4 * q + r;
                  ((bf16*)(sl + O_AAK))[t * 16 + c16] = f2bf(c16 < t ? ak[r] : 0.f); ((bf16*)(sl + O_RB))[t * 16 + c16] = f2bf(c16 <= t ? rb[r] : 0.f); ((bf16*)(sl + O_RK))[t * 16 + c16] = f2bf(c16 <= t ? rk[r] : 0.f); }
          } }
        LDS_SYNC();
        if (wave < 4) { const int c16 = lane & 15, q = lane >> 4, vcol = 16 * wave + c16; u32x2 zz; zz.x = 0u; zz.y = 0u; const f32x4_t z4 = {0.f, 0.f, 0.f, 0.f};
#pragma unroll
            for (int ch = 0; ch < 4; ++ch) { const unsigned char* sl = lds + ch * SLOT;
                const bf16* at = (const bf16*)sl + c16 * 64 + 4 * q; const bf16* rt = (const bf16*)(sl + O_RT) + c16 * 64 + 4 * q;
                const bf16x8_t af0 = frag2(*(const u32x2*)at, *(const u32x2*)(at + 16)), af1 = frag2(*(const u32x2*)(at + 32), *(const u32x2*)(at + 48));
                const bf16x8_t rf0 = frag2(*(const u32x2*)rt, *(const u32x2*)(rt + 16)), rf1 = frag2(*(const u32x2*)(rt + 32), *(const u32x2*)(rt + 48));
                const u32x2 vq = *(const u32x2*)((const bf16*)(sl + O_VT) + vcol * 16 + 4 * q);
                const u32x2 aq = *(const u32x2*)((const bf16*)(sl + O_AAK) + c16 * 16 + 4 * q), tq = *(const u32x2*)((const bf16*)(sl + O_TM) + c16 * 16 + 4 * q);
                const u32x2 rbq = *(const u32x2*)((const bf16*)(sl + O_RB) + c16 * 16 + 4 * q), rkq = *(const u32x2*)((const bf16*)(sl + O_RK) + c16 * 16 + 4 * q);
                f32x4_t rhs = __builtin_amdgcn_mfma_f32_16x16x32_bf16(frag2(zz, aq), frag2(zz, vq), z4, 0, 0, 0); rhs = __builtin_amdgcn_mfma_f32_16x16x32_bf16(af0, Sf[0], rhs, 0, 0, 0);
                { const f32x4_t r2 = __builtin_amdgcn_mfma_f32_16x16x32_bf16(af1, Sf[1], z4, 0, 0, 0); rhs = rhs + r2; }
                u32x2 rl; rl.x = pk2(rhs[0], rhs[1]); rl.y = pk2(rhs[2], rhs[3]);
                const f32x4_t U = __builtin_amdgcn_mfma_f32_16x16x32_bf16(frag2(tq, zz), frag2(rl, zz), z4, 0, 0, 0);
                u32x2 ul; ul.x = pk2(U[0], U[1]); ul.y = pk2(U[2], U[3]); const bf16x8_t uv = frag2(ul, vq);
                f32x4_t y = __builtin_amdgcn_mfma_f32_16x16x32_bf16(rf0, Sf[0], z4, 0, 0, 0); y = __builtin_amdgcn_mfma_f32_16x16x32_bf16(rf1, Sf[1], y, 0, 0, 0);
                y = __builtin_amdgcn_mfma_f32_16x16x32_bf16(frag2(rbq, rkq), uv, y, 0, 0, 0);
#pragma unroll
                for (int r = 0; r < 4; ++r) Yb[(ch * 16 + 4 * q + r) * 64 + vcol] = y[r];
#pragma unroll
                for (int kt = 0; kt < 4; ++kt) { const f32x4 dl = *(const f32x4*)((const float*)(sl + O_DL) + 16 * kt + 4 * q);
                    const u32x2 bq = *(const u32x2*)((const bf16*)(sl + O_BHT) + (16 * kt + c16) * 16 + 4 * q), kq = *(const u32x2*)((const bf16*)(sl + O_KHT) + (16 * kt + c16) * 16 + 4 * q);
                    const f32x4_t cin = {Sd[kt][0] * dl.x, Sd[kt][1] * dl.y, Sd[kt][2] * dl.z, Sd[kt][3] * dl.w};
                    Sd[kt] = __builtin_amdgcn_mfma_f32_16x16x32_bf16(frag2(bq, kq), uv, cin, 0, 0, 0); }
#pragma unroll
                for (int s2 = 0; s2 < 2; ++s2) { u32x2 lo, hi; lo.x = pk2(Sd[2 * s2][0], Sd[2 * s2][1]); lo.y = pk2(Sd[2 * s2][2], Sd[2 * s2][3]); hi.x = pk2(Sd[2 * s2 + 1][0], Sd[2 * s2 + 1][1]); hi.y = pk2(Sd[2 * s2 + 1][2], Sd[2 * s2 + 1][3]); Sf[s2] = frag2(lo, hi); }
            } }
        LDS_SYNC();
        { const f32x4 y0 = *(const f32x4*)(Yb + pt * 64 + k8), y1 = *(const f32x4*)(Yb + pt * 64 + k8 + 4);
          const float mean = red8((y0.x + y0.y + y0.z + y0.w) + (y1.x + y1.y + y1.z + y1.w)) * (1.f / 64); const f32x4 d0 = y0 - mean, d1 = y1 - mean;
          const float rstd = 1.0f / sqrtf(red8((d0.x * d0.x + d0.y * d0.y + d0.z * d0.z + d0.w * d0.w) + (d1.x * d1.x + d1.y * d1.y + d1.z * d1.z + d1.w * d1.w)) * (1.f / 64) + GN_EPS);
          const float bo = ((const float*)(slot + O_BON))[tl]; f32x4 g0, g1; pg8::unpack8(gkeep, g0, g1);
          const f32x4 o0 = (d0 * rstd * *(const f32x4*)(ct_ + 384 + k8) + *(const f32x4*)(ct_ + 448 + k8) + bo * v0) * g0, o1 = (d1 * rstd * *(const f32x4*)(ct_ + 384 + k8 + 4) + *(const f32x4*)(ct_ + 448 + k8 + 4) + bo * v1) * g1;
          *(u32x4*)(YC + (size_t)(c0 + pt) * 512) = pg8::pack8(o0, o1); }
    }
#undef RWKV_FETCH
}

__device__ __forceinline__ void s5_unit(KArgs C, int layer, int unit, unsigned char* lds) {
    const int tid = fresh_tid(), lane = tid & 63, wave = tid >> 6, bl = unit >> 5, g = unit & 31, c16 = lane & 15, q = lane >> 4, sg = wave & 3, th = wave >> 2, p = 16 * sg + c16;
    constexpr int SP = 136;
    float* us = (float*)lds; float* ends = us + 1024; bf16* St = (bf16*)(ends + 16 * 128);
    const bf16* U = WSP(const bf16, WS_U) + (size_t)bl * SEQ * 512 + g * 16;
    bf16* YD0 = WSP(bf16, WS_YD0) + (size_t)bl * SEQ * 512 + g * 16;
    const size_t wo = (layer & 1) ? WDELTA : 0;
    bf16x8_t bre, bim;
    { const float* bb = WSP(const float, WS_BBAR + wo) + ((size_t)g * 64 + p) * 32; u32x4 wr_, wi_;
      if (q < 2) { const float* b8 = bb + 16 * q; wr_.x = pk2(b8[0], b8[2]); wr_.y = pk2(b8[4], b8[6]); wr_.z = pk2(b8[8], b8[10]); wr_.w = pk2(b8[12], b8[14]);
                   wi_.x = pk2(b8[1], b8[3]); wi_.y = pk2(b8[5], b8[7]); wi_.z = pk2(b8[9], b8[11]); wi_.w = pk2(b8[13], b8[15]); }
      else { wr_ = (u32x4){0u, 0u, 0u, 0u}; wi_ = wr_; }
      bre = __builtin_bit_cast(bf16x8_t, wr_); bim = __builtin_bit_cast(bf16x8_t, wi_); }
    float apr[4], api[4];
    { const float ar = WSP(const float, WS_ABAR + wo)[(g * 64 + p) * 2], ai = WSP(const float, WS_ABAR + wo)[(g * 64 + p) * 2 + 1]; apr[0] = ar; api[0] = ai;
#pragma unroll
      for (int i = 1; i < 4; ++i) { apr[i] = apr[i - 1] * ar - api[i - 1] * ai; api[i] = apr[i - 1] * ai + api[i - 1] * ar; } }
    bf16x8_t cf[4];
    { const float* cre = C->in[I_S5CRE] + ((size_t)layer * 32 + g) * 1024 + c16 * 64; const float* cim = C->in[I_S5CIM] + ((size_t)layer * 32 + g) * 1024 + c16 * 64;
#pragma unroll
      for (int ks = 0; ks < 4; ++ks) { const int c0_ = 32 * ks + 8 * q; const float* src = c0_ < 64 ? cre + c0_ : cim + (c0_ - 64); const float sgn = c0_ < 64 ? 1.f : -1.f;
          u32x4 w; w.x = pk2(sgn * src[0], sgn * src[1]); w.y = pk2(sgn * src[2], sgn * src[3]); w.z = pk2(sgn * src[4], sgn * src[5]); w.w = pk2(sgn * src[6], sgn * src[7]); cf[ks] = __builtin_bit_cast(bf16x8_t, w); } }
    const float dj = C->in[I_S5D][layer * 512 + g * 16 + c16];
    float cr = 0.f, ci = 0.f;
    u32x2 fu; fu.x = 0u; fu.y = 0u;
#define S5_FETCH(c0_) do { if (tid < 256) fu = *(const u32x2*)(U + (size_t)((c0_) + (tid >> 2)) * 512 + (tid & 3) * 4); } while (0)
    S5_FETCH(0);
    for (int c0 = 0; c0 < SEQ; c0 += 64) {
        LDS_SYNC();
        if (tid < 256) *(f32x4*)(us + (tid >> 2) * 16 + (tid & 3) * 4) = (f32x4){lo_bf(fu.x), hi_bf(fu.x), lo_bf(fu.y), hi_bf(fu.y)};
        if (c0 + 64 < SEQ) S5_FETCH(c0 + 64);
        LDS_SYNC();
        float lr[2][4], li[2][4];
#pragma unroll
        for (int tt = 0; tt < 2; ++tt) { bf16x8_t af;
            if (q < 2) { const float* ur = us + (32 * th + 16 * tt + c16) * 16 + 8 * q; const f32x4 u0 = *(const f32x4*)ur, u1 = *(const f32x4*)(ur + 4);
                u32x4 w; w.x = pk2(u0.x, u0.y); w.y = pk2(u0.z, u0.w); w.z = pk2(u1.x, u1.y); w.w = pk2(u1.z, u1.w); af = __builtin_bit_cast(bf16x8_t, w); }
            else { const u32x4 z = {0u, 0u, 0u, 0u}; af = __builtin_bit_cast(bf16x8_t, z); }
            const f32x4_t z4 = {0.f, 0.f, 0.f, 0.f};
            const f32x4_t dre = __builtin_amdgcn_mfma_f32_16x16x32_bf16(af, bre, z4, 0, 0, 0), dim = __builtin_amdgcn_mfma_f32_16x16x32_bf16(af, bim, z4, 0, 0, 0);
            lr[tt][0] = dre[0]; li[tt][0] = dim[0];
#pragma unroll
            for (int r = 1; r < 4; ++r) { lr[tt][r] = apr[0] * lr[tt][r - 1] - api[0] * li[tt][r - 1] + dre[r]; li[tt][r] = apr[0] * li[tt][r - 1] + api[0] * lr[tt][r - 1] + dim[r]; }
            const int rho = (2 * th + tt) * 4 + q; ends[(rho * 64 + p) * 2] = lr[tt][3]; ends[(rho * 64 + p) * 2 + 1] = li[tt][3]; }
        LDS_SYNC();
        { float xr = cr, xi = ci; const int rho0 = (2 * th) * 4 + q;
          for (int rr = 0; rr < 16; ++rr) {
              if (rr == rho0 || rr == rho0 + 4) { const int tt = (rr == rho0) ? 0 : 1;
#pragma unroll
                  for (int r = 0; r < 4; ++r) { const float sr = lr[tt][r] + apr[r] * xr - api[r] * xi, si = li[tt][r] + apr[r] * xi + api[r] * xr; const int t = 32 * th + 16 * tt + 4 * q + r;
                      St[t * SP + p] = f2bf(sr); St[t * SP + 64 + p] = f2bf(si); } }
              const float er = ends[(rr * 64 + p) * 2], ei = ends[(rr * 64 + p) * 2 + 1]; const float nr = apr[3] * xr - api[3] * xi + er, ni = apr[3] * xi + api[3] * xr + ei; xr = nr; xi = ni; }
          cr = xr; ci = xi; }
        LDS_SYNC();
        if (wave < 4) { f32x4_t y = {0.f, 0.f, 0.f, 0.f};
#pragma unroll
            for (int ks = 0; ks < 4; ++ks) y = __builtin_amdgcn_mfma_f32_16x16x32_bf16(*(const bf16x8_t*)(St + (16 * wave + c16) * SP + 32 * ks + 8 * q), cf[ks], y, 0, 0, 0);
#pragma unroll
            for (int r = 0; r < 4; ++r) { const int t = 16 * wave + 4 * q + r; YD0[(size_t)(c0 + t) * 512 + c16] = f2bf(gelu_tanh(y[r] + dj * us[t * 16 + c16])); } }
    }
#undef S5_FETCH
}

__device__ __forceinline__ unsigned ord_key(float f) { const unsigned u = __float_as_uint(f); return (u & 0x80000000u) ? ~u : (u | 0x80000000u); }
__device__ __forceinline__ void dsa_vt_item(KArgs C, int item, int lane, bf16* scr) {
    const int tb = item % NK64, bh = item / NK64, h = bh & 7, bl = bh >> 3;
    const bf16* V = WSP(const bf16, WS_V) + ((size_t)bl * SEQ + tb * 64) * 512 + h * 64;
    WAVE_SYNC();
#pragma unroll
    for (int i = 0; i < 8; ++i) { const int tk = (lane >> 3) + 8 * i, c8 = (lane & 7) * 8; const u32x4 w = *(const u32x4*)(V + (size_t)tk * 512 + c8);
        unsigned* d = (unsigned*)(scr + tk * 66 + c8); d[0] = w.x; d[1] = w.y; d[2] = w.z; d[3] = w.w; }
    WAVE_SYNC();
    bf16* Vt = WSP(bf16, WS_VT) + ((size_t)bh * 64) * SEQ + tb * 64 + lane;
#pragma unroll 8
    for (int d = 0; d < 64; ++d) Vt[(size_t)d * SEQ] = scr[lane * 66 + d];
}
constexpr int IDX_CAP = 128, IDX_NBIN = 1024;
__device__ __forceinline__ void dsa_index_unit(KArgs C, int unit, int lane, int wave, unsigned char* lds) {
    const int oct = unit & 7, pairid = (unit >> 3) % (NK64 / 2), kx = (unit >> 3) / (NK64 / 2), bl = kx >> 1, c = (kx & 1) ? NK64 - 1 - pairid : pairid;
    const int t0 = c * 64 + oct * 8, nkeys = (c + 1) * 64, nk64 = c + 1; const size_t row0 = (size_t)bl * SEQ + t0;
    unsigned* mrow = WSP(unsigned, WS_MASK) + (row0 + wave) * MW;
    if (nkeys <= TOPK) { for (int w = lane; w < MW; w += 64) mrow[w] = (w * 32 < nkeys) ? 0xffffffffu : 0u; return; }
    float* scf = (float*)lds;
    unsigned* hist = (unsigned*)(lds + LDS_X) + wave * (IDX_NBIN / 2); unsigned* candv = (unsigned*)(lds + LDS_X + 8 * IDX_NBIN * 2) + wave * IDX_CAP; unsigned* candi = candv + 8 * IDX_CAP; unsigned* mword = (unsigned*)(lds + LDS_X + 8 * IDX_NBIN * 2 + 16 * IDX_CAP * 4) + wave * MW;
    const bf16* SMb = WSP(const bf16, WS_SM) + (size_t)bl * SEQ * 256;
    const int l31 = lane & 31, half = lane >> 5;
    const bf16* qa = SMb + (size_t)(t0 + (l31 >> 2)) * 256 + 8 + (l31 & 3) * 32 + 8 * half;
    const bf16x8_t a0 = *(const bf16x8_t*)qa, a1 = *(const bf16x8_t*)(qa + 16);
    u32x2 wraw[4];
#pragma unroll
    for (int g = 0; g < 4; ++g) wraw[g] = *(const u32x2*)(SMb + (size_t)(t0 + 2 * g + half) * 256 + 168);
    LDS_SYNC();
    {
      float wv[4][4];
#pragma unroll
      for (int g = 0; g < 4; ++g) { const u32x2 w = wraw[g]; wv[g][0] = lo_bf(w.x) * 0.5f; wv[g][1] = hi_bf(w.x) * 0.5f; wv[g][2] = lo_bf(w.y) * 0.5f; wv[g][3] = hi_bf(w.y) * 0.5f; }
      for (int kt0 = wave; kt0 < nk64 * 2; kt0 += 8 * NWAVES) {
          bf16x8_t b0[8], b1[8];
#pragma unroll
          for (int u4 = 0; u4 < 8; ++u4) { const int kt = kt0 + 8 * u4; const bf16* kb = WSP(const bf16, WS_KI) + ((size_t)bl * SEQ + (size_t)((kt < nk64 * 2 ? kt : wave) * 32 + l31)) * 32 + 8 * half;
              b0[u4] = *(const bf16x8_t*)kb; b1[u4] = *(const bf16x8_t*)(kb + 16); }
#pragma unroll
          for (int u4 = 0; u4 < 8; ++u4) { const int kt = kt0 + 8 * u4; if (kt < nk64 * 2) {
              f32x16 d;
#pragma unroll
              for (int r = 0; r < 16; ++r) d[r] = 0.f;
              d = __builtin_amdgcn_mfma_f32_32x32x16_bf16(a0, b0[u4], d, 0, 0, 0); d = __builtin_amdgcn_mfma_f32_32x32x16_bf16(a1, b1[u4], d, 0, 0, 0);
#pragma unroll
              for (int g = 0; g < 4; ++g) { float sc = 0.f;
#pragma unroll
                  for (int j = 0; j < 4; ++j) sc += wv[g][j] * fmaxf(d[4 * g + j] * 0.17677669529f, 0.f);
                  scf[(2 * g + half) * SEQ + kt * 32 + l31] = sc; } } }
      } }
    { const int tail0 = nkeys, tail1 = ((nk64 + 7) >> 3) * 512;
      for (int e = tail0 + (int)(threadIdx.x); e < tail1; e += NTHREADS) {
#pragma unroll
          for (int qq = 0; qq < 8; ++qq) scf[qq * SEQ + e] = -3.0e38f; } }
    LDS_SYNC();
    const float* sc = scf + wave * SEQ; constexpr float NEG = -3.0e38f; const int nb8 = (nk64 + 7) >> 3;
    float v[NK64];
#pragma unroll
    for (int ib = 0; ib < NK64 / 8; ++ib) if (ib < nb8) {
#pragma unroll
        for (int j = 0; j < 8; ++j) v[ib * 8 + j] = sc[(ib * 8 + j) * 64 + lane];
        SCHED_FENCE(); }
    float mn = INFINITY, mx = -INFINITY;
#pragma unroll
    for (int ib = 0; ib < NK64 / 8; ++ib) if (ib < nb8) {
#pragma unroll
        for (int j = 0; j < 8; ++j) { const float x = v[ib * 8 + j]; mx = fmaxf(mx, x); mn = fminf(mn, x == NEG ? INFINITY : x); } }
    mn = -wave_max(-mn); mx = wave_max(mx);
    const float scale = (mx > mn) ? ((float)IDX_NBIN - 0.01f) / (mx - mn) : 0.f;
#pragma unroll
    for (int i = 0; i < IDX_NBIN / 128; ++i) hist[lane * (IDX_NBIN / 128) + i] = 0u;
    for (int w = lane; w < MW; w += 64) mword[w] = 0u;
    WAVE_SYNC();
#define IDX_BIN(x) ({ int b_ = (int)(fmaxf((x) - mn, 0.f) * scale); b_ > IDX_NBIN - 1 ? IDX_NBIN - 1 : b_; })
#pragma unroll
    for (int ib = 0; ib < NK64 / 8; ++ib) if (ib < nb8) {
#pragma unroll
        for (int j = 0; j < 8; ++j) { const int b = IDX_BIN(v[ib * 8 + j]); atomicAdd(&hist[b >> 1], (b & 1) ? 0x10000u : 1u); }
        SCHED_FENCE(); }
    WAVE_SYNC();
    int bstar, cgt;
    {
      unsigned hw[8]; int tot = 0;
#pragma unroll
      for (int i = 0; i < 8; ++i) { hw[i] = hist[lane * 8 + i]; tot += (int)(hw[i] & 0xffffu) + (int)(hw[i] >> 16); }
      int suf = tot;
#pragma unroll
      for (int o = 1; o < 64; o <<= 1) { const int t = __shfl_down(suf, o); if (lane + o < 64) suf += t; }
      const unsigned long long ge = __ballot(suf >= TOPK); const int L = 63 - __builtin_clzll(ge);
      int cum = __shfl(suf, L) - __shfl(tot, L); bstar = 16 * L; cgt = cum; bool found = false;
#pragma unroll
      for (int i = 7; i >= 0; --i) { const unsigned w = (unsigned)__shfl((int)hw[i], L); const int chi = (int)(w >> 16), clo = (int)(w & 0xffffu);
          if (!found && cum + chi >= TOPK) { bstar = 16 * L + 2 * i + 1; cgt = cum; found = true; } cum += found ? 0 : chi;
          if (!found && cum + clo >= TOPK) { bstar = 16 * L + 2 * i; cgt = cum; found = true; } cum += found ? 0 : clo; } }
    const int need = TOPK - cgt; int ncand = 0;
    unsigned mylo = 0u, myhi = 0u;
#pragma unroll
    for (int ib = 0; ib < NK64 / 8; ++ib) if (ib < nb8) {
#pragma unroll
        for (int j = 0; j < 8; ++j) { const int i = ib * 8 + j; const int b = IDX_BIN(v[i]);
            const unsigned long long bs = __ballot(b > bstar), bc = __ballot(b == bstar);
            if (lane == i) { mylo = (unsigned)bs; myhi = (unsigned)(bs >> 32); }
            if (bc != 0ull) {
                const int pos = ncand + (int)__builtin_amdgcn_mbcnt_hi((unsigned)(bc >> 32), __builtin_amdgcn_mbcnt_lo((unsigned)bc, 0u));
                if (b == bstar && pos < IDX_CAP) { candv[pos] = ord_key(v[i]); candi[pos] = (unsigned)(i * 64 + lane); }
                ncand += __popcll(bc); } }
        SCHED_FENCE(); }
    if (lane < nb8 * 8) { mword[2 * lane] = mylo; mword[2 * lane + 1] = myhi; }
#undef IDX_BIN
    WAVE_SYNC();
    if (ncand <= IDX_CAP) {
        for (int m = lane; m < ncand; m += 64) { const unsigned vm = candv[m]; int rank = 0;
#pragma unroll 4
            for (int j = 0; j < ncand; ++j) { const unsigned vj = candv[j]; rank += (vj > vm || (vj == vm && j < m)) ? 1 : 0; }
            if (rank < need) { const unsigned idx = candi[m]; atomicOr(&mword[idx >> 5], 1u << (idx & 31)); } }
    } else {
        unsigned T = 0u;
        for (int bit = 31; bit >= 0; --bit) { const unsigned cand = T | (1u << bit); int cn = 0;
#pragma unroll
            for (int ib = 0; ib < NK64 / 8; ++ib) if (ib < nb8) {
#pragma unroll
                for (int j = 0; j < 8; ++j) cn += (ord_key(v[ib * 8 + j]) >= cand) ? 1 : 0; }
            if (wave_sum_i(cn) >= TOPK) T = cand; }
        int cg = 0;
#pragma unroll
        for (int ib = 0; ib < NK64 / 8; ++ib) if (ib < nb8) {
#pragma unroll
            for (int j = 0; j < 8; ++j) cg += (ord_key(v[ib * 8 + j]) > T) ? 1 : 0; }
        const int need2 = TOPK - wave_sum_i(cg); int taken = 0;
#pragma unroll
        for (int ib = 0; ib < NK64 / 8; ++ib) if (ib < nb8) {
#pragma unroll
            for (int j = 0; j < 8; ++j) { const int i = ib * 8 + j; const unsigned kv = ord_key(v[i]); const bool eq = kv == T; const unsigned long long be = __ballot(eq);
                const int pre = __popcll(be & ((1ull << lane) - 1ull)); const bool sel = (kv > T) || (eq && (taken + pre) < need2); taken += __popcll(be);
                const unsigned long long bs = __ballot(sel); if (lane == 0) { mword[2 * i] = (unsigned)bs; mword[2 * i + 1] = (unsigned)(bs >> 32); } } }
    }
    WAVE_SYNC();
    for (int w = lane; w < MW; w += 64) mrow[w] = mword[w];
}

constexpr int AT_KP = 72, AT_VP = 72, AT_BUF = 64 * AT_KP + 64 * AT_VP;
__device__ __forceinline__ void dsa_attn_half(KArgs C, int bl, int h, int cb, int tid, bf16* tiles, const float* btab) {
    const int lane = tid & 63, wave = tid >> 6, l31 = lane & 31, hh = lane >> 5, c = 4 * cb + (wave >> 1), qb = wave & 1, q0 = c * 64 + qb * 32, qpos = q0 + l31;
    const size_t qrow = (size_t)bl * SEQ + qpos;
    const bf16* Qp = WSP(const bf16, WS_Q) + qrow * 512 + h * 64 + 8 * hh;
    const unsigned* Mp = WSP(const unsigned, WS_MASK) + qrow * MW;
    const bf16* gk = WSP(const bf16, WS_K) + ((size_t)bl * SEQ + (tid >> 3)) * 512 + h * 64 + (tid & 7) * 8;
    const bf16* gv = WSP(const bf16, WS_VT) + ((size_t)(bl * 8 + h) * 64 + (tid >> 3)) * SEQ + (tid & 7) * 8;
    const int lk = (tid >> 3) * AT_KP + (tid & 7) * 8, lv = 64 * AT_KP + (tid >> 3) * AT_VP + (tid & 7) * 8;
    constexpr float SC = 0.125f * 1.44269504089f;
    bf16x8_t qf[4];
#pragma unroll
    for (int s = 0; s < 4; ++s) qf[s] = *(const bf16x8_t*)(Qp + 16 * s);
    f32x16 O0, O1;
#pragma unroll
    for (int r = 0; r < 16; ++r) { O0[r] = 0.f; O1[r] = 0.f; }
    float m = -1e30f, lsum = 0.f;
    const int ntw = c + 1, nt = 4 * cb + 4;
    u32x4 prek = *(const u32x4*)gk, prev = *(const u32x4*)gv; u32x2 mwn = *(const u32x2*)Mp;
    LDS_SYNC();
    const float bfar = btab[0];
    *(u32x4*)(tiles + lk) = prek; *(u32x4*)(tiles + lv) = prev;
    if (nt > 1) { prek = *(const u32x4*)(gk + (size_t)64 * 512); prev = *(const u32x4*)(gv + 64); }
    for (int kt = 0; kt < nt; ++kt) {
        LDS_SYNC();
        const bf16* tb = tiles + (kt & 1) * AT_BUF; const u32x2 mw2 = mwn;
        if (kt + 1 < ntw) mwn = *(const u32x2*)(Mp + 2 * (kt + 1));
        if (kt < ntw) {
            f32x16 S[2];
#pragma unroll
            for (int t2 = 0; t2 < 2; ++t2) {
#pragma unroll
                for (int r = 0; r < 16; ++r) S[t2][r] = 0.f;
#pragma unroll
                for (int s = 0; s < 4; ++s) S[t2] = __builtin_amdgcn_mfma_f32_32x32x16_bf16(*(const bf16x8_t*)(tb + (t2 * 32 + l31) * AT_KP + 16 * s + 8 * hh), qf[s], S[t2], 0, 0, 0); }
            float tmax = -1e30f;
#pragma unroll
            for (int t2 = 0; t2 < 2; ++t2) { const int k0 = kt * 64 + t2 * 32;
                if ((k0 + 31 - q0) <= -166) {
#pragma unroll
                    for (int r = 0; r < 16; ++r) { const float v = S[t2][r] * SC + bfar; S[t2][r] = v; tmax = fmaxf(tmax, v); }
                } else { const int rb = k0 + 4 * hh - qpos + 256;
#pragma unroll
                    for (int r = 0; r < 16; ++r) { const int row = (r & 3) + 8 * (r >> 2); int ti = rb + row; ti = ti < 0 ? 0 : ti; const float v = S[t2][r] * SC + btab[ti]; S[t2][r] = v; tmax = fmaxf(tmax, v); } } }
            tmax = fmaxf(tmax, __shfl_xor(tmax, 32));
            if (__ballot(tmax > m) != 0ull) { const float mn = fmaxf(m, tmax), alpha = __builtin_amdgcn_exp2f(m - mn); m = mn; lsum *= alpha;
#pragma unroll
                for (int r = 0; r < 16; ++r) { O0[r] *= alpha; O1[r] *= alpha; } }
            float ps = 0.f;
#pragma unroll
            for (int t2 = 0; t2 < 2; ++t2) { const unsigned mwc = (t2 == 0 ? mw2.x : mw2.y) << (4 * (1 - hh));
#pragma unroll
                for (int r = 0; r < 16; ++r) { const int row = (r & 3) + 8 * (r >> 2) + 4;
                    const unsigned keep = (unsigned)((int)(mwc << (31 - row)) >> 31);
                    const float p = __uint_as_float(__float_as_uint(__builtin_amdgcn_exp2f(S[t2][r] - m)) & keep); S[t2][r] = p; ps += p; } }
            lsum += ps;
#pragma unroll
            for (int t2 = 0; t2 < 2; ++t2) { const bf16* vb = tb + 64 * AT_KP + l31 * AT_VP + t2 * 32 + 4 * hh;
#pragma unroll
                for (int s = 0; s < 2; ++s) { u32x4 w; w.x = pk2(S[t2][8 * s + 0], S[t2][8 * s + 1]); w.y = pk2(S[t2][8 * s + 2], S[t2][8 * s + 3]); w.z = pk2(S[t2][8 * s + 4], S[t2][8 * s + 5]); w.w = pk2(S[t2][8 * s + 6], S[t2][8 * s + 7]);
                    const bf16x8_t pf = __builtin_bit_cast(bf16x8_t, w);
                    O0 = __builtin_amdgcn_mfma_f32_32x32x16_bf16(frag2(*(const u32x2*)(vb + 16 * s), *(const u32x2*)(vb + 16 * s + 8)), pf, O0, 0, 0, 0);
                    O1 = __builtin_amdgcn_mfma_f32_32x32x16_bf16(frag2(*(const u32x2*)(vb + 32 * AT_VP + 16 * s), *(const u32x2*)(vb + 32 * AT_VP + 16 * s + 8)), pf, O1, 0, 0, 0); } }
        }
        if (kt + 1 < nt) { bf16* nb = tiles + ((kt + 1) & 1) * AT_BUF; *(u32x4*)(nb + lk) = prek; *(u32x4*)(nb + lv) = prev;
            if (kt + 2 < nt) { prek = *(const u32x4*)(gk + (size_t)(kt + 2) * 64 * 512); prev = *(const u32x4*)(gv + (size_t)(kt + 2) * 64); } }
    }
    lsum += __shfl_xor(lsum, 32);
    const float inv = 1.0f / lsum;
    bf16* Y = WSP(bf16, WS_Y) + (size_t)MG * 512 + qrow * 512 + h * 64 + 4 * hh;
#pragma unroll
    for (int g = 0; g < 4; ++g) { u32x2 w; w.x = pk2(O0[4 * g] * inv, O0[4 * g + 1] * inv); w.y = pk2(O0[4 * g + 2] * inv, O0[4 * g + 3] * inv); *(u32x2*)(Y + 8 * g) = w;
        u32x2 w2; w2.x = pk2(O1[4 * g] * inv, O1[4 * g + 1] * inv); w2.y = pk2(O1[4 * g + 2] * inv, O1[4 * g + 3] * inv); *(u32x2*)(Y + 32 + 8 * g) = w2; }
}
__device__ __forceinline__ void dsa_attn_unit3(KArgs C, int unit, int tid, unsigned char* lds) {
    constexpr int NPAIR = NK64 / 8;
    const int pr = unit % NPAIR, h = (unit / NPAIR) & 7, bl = unit / (NPAIR * 8);
    float* btab = (float*)lds; bf16* tiles = (bf16*)(lds + 2048);
    __syncthreads();
    { const int* tab = WSP(const int, WS_TAB); const float* relb = C->in[I_RELB];
      if (tid < 320) btab[tid] = relb[tab[tid - 256 + SEQ - 1] * 8 + h] * 1.44269504089f; }
    dsa_attn_half(C, bl, h, pr, tid, tiles, btab);
    dsa_attn_half(C, bl, h, NK64 / 4 - 1 - pr, tid, tiles, btab);
}
#ifndef GP_ALIGN
#define GP_ALIGN true
#endif
#ifndef GP_SP2
#define GP_SP2 true
#endif
constexpr int SEGS_PER_GROUP = 11, NSEG = DEPTH * (1 + NGRP * SEGS_PER_GROUP) + 1;

#ifdef HOST_EMU
#define GRID_BARRIER() emu_grid_sync()
#define LDS_PTR(p) ((unsigned char*)(p))
#else
#define GRID_BARRIER() do { XcdBarrier b_; b_.bar = (unsigned*)(Ck->ws + WS_CTL); b_.x = xb_xcc_id(); b_.st = (volatile LAS unsigned*)(lds + LDS_CTL_OFF); xcd_barrier(b_); } while (0)
#define LDS_PTR(p) ((PG8_LAS unsigned char*)(p))
#endif

__global__ void __launch_bounds__(NTHREADS, 2) fwd_kernel(Args a) {
#ifdef HOST_EMU
    unsigned char* lds = emu_lds;
#else
    extern __shared__ __attribute__((aligned(16))) unsigned char lds[];
#endif
#ifdef HOST_EMU
    KArgs Ck = &a;
#else
    KArgs Ck = (KArgs)__builtin_amdgcn_kernarg_segment_ptr();
    (void)a;
#endif
#ifndef HOST_EMU
    if (threadIdx.x < 4) ((LAS unsigned*)(lds + LDS_CTL_OFF))[threadIdx.x] = 0u;
    __syncthreads();
    if (Ck->seg_hi - Ck->seg_lo > 1) (void)xcd_barrier_post((unsigned*)(Ck->ws + WS_CTL), (volatile LAS unsigned*)(lds + LDS_CTL_OFF));
#endif
#define SEGID 0
#define RUN (SEGID >= Ck->seg_lo && SEGID < Ck->seg_hi)
#define SEAM do { if (SEGID >= Ck->seg_lo && SEGID + 1 < Ck->seg_hi) { GRID_BARRIER(); } } while (0)
#define WO ((layer & 1) ? WDELTA : (size_t)0)
#define PHASE_VARS KArgs C = KLAUNDER(Ck); const int G = gridDim.x, bx = blockIdx.x, ngw = G * NWAVES; (void)ngw; const int tid = fresh_tid(), lane = tid & 63, wave = __builtin_amdgcn_readfirstlane(tid >> 6), gw = bx * NWAVES + wave; (void)lane; (void)gw; (void)C
    for (int layer = 0; layer < DEPTH; ++layer) {
#undef SEGID
#define SEGID (layer * (1 + NGRP * SEGS_PER_GROUP))
        if (RUN) { PHASE_VARS; phase_weights(C, layer, lds, gw, ngw, lane, wave); }
        SEAM;
        for (int grp = 0; grp < NGRP; ++grp) {
#define XIN ((layer == 0 ? C->in[I_X] : (const float*)C->out) + (size_t)grp * MG * D)
#define XOUT (C->out + (size_t)grp * MG * D)
#undef SEGID
#define SEGID (layer * (1 + NGRP * SEGS_PER_GROUP) + 1 + grp * SEGS_PER_GROUP + 0)
            if (RUN) { PHASE_VARS; for (int m = gw; m < MG; m += 2 * ngw) { if (m + ngw < MG) rms_rowN_bf16<2>(XIN + (size_t)m * D, C->in[I_NMIX] + layer * D, WSP(bf16, WS_H) + (size_t)m * D, (size_t)ngw * D, lane); else rms_row_bf16(XIN + (size_t)m * D, C->in[I_NMIX] + layer * D, WSP(bf16, WS_H) + (size_t)m * D, lane); } }
            SEAM;
#undef SEGID
#define SEGID (layer * (1 + NGRP * SEGS_PER_GROUP) + 1 + grp * SEGS_PER_GROUP + 1)
            if (RUN) { PHASE_VARS; pg8::Gemm g{WSP(const bf16, WS_H), WSP(const bf16, WS_WIN + WO), MG, NMIXC, D}; pg8::StaticOrder S; S.init(MG, NMIXC, G, bx);
                pg8::EpiProj E{C->ws};
                pg8::gemm_phase<pg8::EpiProj, pg8::StaticOrder, false, GP_ALIGN, GP_SP2>(LDS_PTR(lds), g, S, E, nullptr); }
            SEAM;
#undef SEGID
#define SEGID (layer * (1 + NGRP * SEGS_PER_GROUP) + 1 + grp * SEGS_PER_GROUP + 2)
            if (RUN) { PHASE_VARS;
                for (int m = gw; m < MG; m += 2 * ngw) { if (m + ngw < MG) { rwkv_prep_row2(C, layer, m, ngw, lane); ssd_conv_row2(C, layer, m, ngw, lane); } else { rwkv_prep_row(C, layer, m, lane); ssd_conv_row(C, layer, m, lane); } }
                for (int it = gw; it < NB * 8 * NK64; it += ngw) dsa_vt_item(C, it, lane, (bf16*)(lds + wave * 16384));
                __syncthreads();
                for (int u = bx; u < NB * NK64 * 8; u += G) dsa_index_unit(C, u, lane, wave, lds);
            }
            SEAM;
#undef SEGID
#define SEGID (layer * (1 + NGRP * SEGS_PER_GROUP) + 1 + grp * SEGS_PER_GROUP + 3)
            if (RUN) { PHASE_VARS; pg8::Gemm g{WSP(const bf16, WS_RA), WSP(const bf16, WS_WLORA + WO), MG, 1536, 256}; pg8::StaticOrder S; S.init(MG, 1536, G, bx);
                pg8::EpiLora E{WSP(float, WS_WLOG), WSP(bf16, WS_ASIG), WSP(bf16, WS_GG), C->in[I_W0] + layer * 512, C->in[I_A0] + layer * 512};
                pg8::gemm_phase<pg8::EpiLora, pg8::StaticOrder, false, GP_ALIGN, GP_SP2>(LDS_PTR(lds), g, S, E, nullptr); }
            SEAM;
#undef SEGID
#define SEGID (layer * (1 + NGRP * SEGS_PER_GROUP) + 1 + grp * SEGS_PER_GROUP + 4)
            if (RUN) { PHASE_VARS;
                constexpr int U_R = NB * 8, U_S = U_R + NB * 8;
                for (int u = bx; u < U_R; u += G) rwkv_unit(C, layer, u, lds);
                for (int u = (bx + G - U_R % G) % G; u < NB * 8; u += G) ssd_unit(C, layer, u, lds);
                { const int first = U_S % G, span = G - first;
                  if (bx >= first) for (int u = bx - first; u < NB * 32; u += span) s5_unit(C, layer, u, lds); }
                for (;;) {
                    const int t2 = fresh_tid();
                    volatile unsigned* qs2 = (volatile unsigned*)(lds + LDS_CTL_OFF + 32);
                    __syncthreads();
                    if (t2 == 0) *qs2 = atomicAdd((unsigned*)(Ck->ws + WS_QCTR) + ((layer * NGRP + grp) * 2) * 64, 1u);
                    __syncthreads();
                    const int u = (int)*qs2;
                    if (u >= NB * NK64) break;
                    dsa_attn_unit3(KLAUNDER(Ck), u, t2, lds);
                }
            }
            SEAM;
#undef SEGID
#define SEGID (layer * (1 + NGRP * SEGS_PER_GROUP) + 1 + grp * SEGS_PER_GROUP + 5)
            if (RUN) { PHASE_VARS;
                { pg8::Gemm g{WSP(const bf16, WS_H), WSP(const bf16, WS_WIN + WO) + (size_t)NMIXC * D, MG, 4096, D}; pg8::StaticOrder S; S.init(MG, 4096, G, bx);
                  pg8::EpiGate E{WSP(bf16, WS_G)}; pg8::gemm_phase<pg8::EpiGate, pg8::StaticOrder, false, GP_ALIGN, GP_SP2>(LDS_PTR(lds), g, S, E, nullptr); }
                { pg8::Gemm g{WSP(const bf16, WS_YD0), WSP(const bf16, WS_GLU + WO), MG, 512, 512}; pg8::StaticOrder S; S.init(MG, 512, G, bx);
                  pg8::EpiGlu E{WSP(const bf16, WS_YD0), WSP(bf16, WS_Y) + (size_t)3 * MG * 512, C->in[I_GLUB] + layer * 512};
                  pg8::gemm_phase<pg8::EpiGlu, pg8::StaticOrder, false, GP_ALIGN, GP_SP2>(LDS_PTR(lds), g, S, E, nullptr); }
                for (int it = gw; it < MG * 2; it += 4 * ngw) ssd_norm_item4(C, layer, it, ngw, MG * 2, lane);
            }
            SEAM;
#undef SEGID
#define SEGID (layer * (1 + NGRP * SEGS_PER_GROUP) + 1 + grp * SEGS_PER_GROUP + 6)
            if (RUN) { PHASE_VARS; pg8::Gemm g{WSP(const bf16, WS_Y), WSP(const bf16, WS_WB + WO), 4 * MG, 4096, 512}; pg8::MergeOrder S{G, bx};
                pg8::EpiMerge E{WSP(const bf16, WS_G), WSP(bf16, WS_MRG)};
                pg8::gemm_phase<pg8::EpiMerge, pg8::MergeOrder, false, GP_ALIGN, GP_SP2>(LDS_PTR(lds), g, S, E, nullptr); }
            SEAM;
#undef SEGID
#define SEGID (layer * (1 + NGRP * SEGS_PER_GROUP) + 1 + grp * SEGS_PER_GROUP + 7)
            if (RUN) { PHASE_VARS; pg8::Gemm g{WSP(const bf16, WS_MRG), WSP(const bf16, WS_WOUT + WO), MG, D, D}; pg8::StaticOrder S; S.init(MG, D, G, bx);
                pg8::EpiResid E{XIN, XOUT}; pg8::gemm_phase<pg8::EpiResid, pg8::StaticOrder, false, GP_ALIGN, GP_SP2>(LDS_PTR(lds), g, S, E, nullptr); }
            SEAM;
#undef SEGID
#define SEGID (layer * (1 + NGRP * SEGS_PER_GROUP) + 1 + grp * SEGS_PER_GROUP + 8)
            if (RUN) { PHASE_VARS; for (int m = gw; m < MG; m += 2 * ngw) { if (m + ngw < MG) rms_rowN_bf16<2>(XOUT + (size_t)m * D, C->in[I_NFFN] + layer * D, WSP(bf16, WS_H) + (size_t)m * D, (size_t)ngw * D, lane); else rms_row_bf16(XOUT + (size_t)m * D, C->in[I_NFFN] + layer * D, WSP(bf16, WS_H) + (size_t)m * D, lane); } }
            SEAM;
#undef SEGID
#define SEGID (layer * (1 + NGRP * SEGS_PER_GROUP) + 1 + grp * SEGS_PER_GROUP + 9)
            if (RUN) { PHASE_VARS; pg8::Gemm g{WSP(const bf16, WS_H), WSP(const bf16, WS_W13 + WO), MG, 5632, D}; pg8::StaticOrder S; S.init(MG, 5632, G, bx);
                pg8::EpiSwiglu E{WSP(bf16, WS_HID)};
                pg8::gemm_phase<pg8::EpiSwiglu, pg8::StaticOrder, false, GP_ALIGN, GP_SP2>(LDS_PTR(lds), g, S, E, nullptr); }
            SEAM;
#undef SEGID
#define SEGID (layer * (1 + NGRP * SEGS_PER_GROUP) + 1 + grp * SEGS_PER_GROUP + 10)
            if (RUN) { PHASE_VARS; pg8::Gemm g{WSP(const bf16, WS_HID), WSP(const bf16, WS_W2 + WO), MG, D, FFN}; pg8::StaticOrder S; S.init(MG, D, G, bx);
                pg8::EpiResid E{XOUT, XOUT}; pg8::gemm_phase<pg8::EpiResid, pg8::StaticOrder, false, GP_ALIGN, GP_SP2>(LDS_PTR(lds), g, S, E, nullptr); }
            SEAM;
        }
    }
#undef SEGID
#define SEGID (NSEG - 1)
    { const int layer = 0; (void)layer;
    if (RUN) { PHASE_VARS; for (int m = gw; m < M; m += 2 * ngw) { if (m + ngw < M) rms_row2_f32(C->out + (size_t)m * D, (size_t)ngw * D, C->in[I_NFIN], lane); else rms_row_f32(C->out + (size_t)m * D, C->in[I_NFIN], lane); } } }
#undef RUN
#undef SEAM
}

extern "C" void kernel_launch(void* const* d_in, const int* in_sizes, int n_in, void* d_out, int out_size, void* d_ws, size_t ws_size, hipStream_t stream) {
    static int grid = 0;
    if (grid == 0) {
        if (n_in != N_IN || out_size != M * D || ws_size < WS_END) { fprintf(stderr, "kernel_launch: unexpected shapes (n_in %d, out %d, ws %zu < %zu)\n", n_in, out_size, ws_size, (size_t)WS_END); grid = -1; return; }
        int dev = 0, cus = 0;
        if (hipGetDevice(&dev) != hipSuccess || hipDeviceGetAttribute(&cus, hipDeviceAttributeMultiprocessorCount, dev) != hipSuccess || cus < 1) { grid = -1; return; }
        if (hipFuncSetAttribute((const void*)fwd_kernel, hipFuncAttributeMaxDynamicSharedMemorySize, LDS_BYTES) != hipSuccess) { fprintf(stderr, "kernel_launch: hipFuncSetAttribute failed\n"); grid = -1; return; }
        (void)hipGetLastError();
        grid = cus;
    }
    if (grid < 0) return;
    (void)hipMemsetAsync((char*)d_ws + WS_CTL, 0, CTL_BYTES, stream);
    Args a{};
    for (int i = 0; i < N_IN; ++i) a.in[i] = (const float*)d_in[i];
    a.out = (float*)d_out; a.ws = (unsigned char*)d_ws;
#if CFG_LAUNCHES == 1
    a.seg_lo = 0; a.seg_hi = NSEG;
    hipLaunchKernelGGL(fwd_kernel, dim3(grid), dim3(NTHREADS), LDS_BYTES, stream, a);
#else
    for (int s = 0; s < NSEG; ++s) { a.seg_lo = s; a.seg_hi = s + 1; hipLaunchKernelGGL(fwd_kernel, dim3(grid), dim3(NTHREADS), LDS_BYTES, stream, a); }
#endif
}
```

```cpp
#ifdef HOST_EMU
#error "HOST_EMU is a host-only debug build"
#else
#include <hip/hip_runtime.h>
#endif
#include <cstdio>
#include <cstdint>
#include <cmath>

#ifndef CFG_BATCH
#define CFG_BATCH 16
#endif
#ifndef CFG_SEQ
#define CFG_SEQ 4096
#endif
#ifndef CFG_DEPTH
#define CFG_DEPTH 4
#endif
#ifndef CFG_NB
#define CFG_NB 8
#endif
#ifndef CFG_LAUNCHES
#define CFG_LAUNCHES 1
#endif

typedef unsigned short bf16;
typedef float f32x4 __attribute__((ext_vector_type(4)));
typedef float f32x2 __attribute__((ext_vector_type(2)));
typedef unsigned u32x4 __attribute__((ext_vector_type(4)));
typedef unsigned u32x2 __attribute__((ext_vector_type(2)));

constexpr int BATCH = CFG_BATCH, SEQ = CFG_SEQ, DEPTH = CFG_DEPTH, NB = CFG_NB;
constexpr int D = 1024, M = BATCH * SEQ, MG = NB * SEQ, NGRP = BATCH / NB;
constexpr int IN_COLS = 9388, NPROJ = 9472, NMIXC = 5376, FFN = 2816;
constexpr int TOPK = (SEQ / 4) < 256 ? (SEQ / 4) : 256;
constexpr int NK64 = SEQ / 64, MW = SEQ / 32;
constexpr float RMS_EPS = 1e-6f, GN_EPS = 64e-5f;
static_assert(BATCH % NB == 0 && MG % 256 == 0 && SEQ % 64 == 0, "shape");

enum { I_X = 0, I_RELB, I_NMIX, I_WIN, I_CONVW, I_CONVB, I_DTB, I_ALOG, I_SSDD, I_SSDNG, I_MU, I_W0, I_W2, I_A0, I_A2, I_G2, I_KK, I_KA, I_RK, I_LNG, I_LNB,
       I_S5ARE, I_S5AIM, I_S5BRE, I_S5BIM, I_S5CRE, I_S5CIM, I_S5D, I_S5LDT, I_GLUW, I_GLUB, I_WBR, I_WOUT, I_NFFN, I_W1, I_W3, I_W2F, I_NFIN, N_IN };

constexpr size_t MiB = 1u << 20;
constexpr size_t al256(size_t x) { return (x + 255) & ~(size_t)255; }
constexpr size_t WS_CTL = 0, CTL_BYTES = 64 * 1024;
constexpr size_t WS_TAB = WS_CTL + CTL_BYTES;
constexpr size_t WS_ABAR = al256(WS_TAB + (SEQ + 64) * 4);
constexpr size_t WS_BBAR = WS_ABAR + 32 * 64 * 2 * 4;
constexpr size_t WS_WIN = al256(WS_BBAR + 32 * 64 * 16 * 2 * 4);
constexpr size_t WS_WB = WS_WIN + (size_t)NPROJ * 1024 * 2;
constexpr size_t WS_WOUT = WS_WB + (size_t)4 * 1024 * 512 * 2;
constexpr size_t WS_W13 = WS_WOUT + (size_t)1024 * 1024 * 2;
constexpr size_t WS_W2 = WS_W13 + (size_t)5632 * 1024 * 2;
constexpr size_t WS_GLU = WS_W2 + (size_t)1024 * 2816 * 2;
constexpr size_t WS_WLORA = WS_GLU + (size_t)512 * 512 * 2;
constexpr size_t WS_H = al256(WS_WLORA + (size_t)1536 * 256 * 2);
constexpr size_t WS_Z = WS_H + (size_t)MG * 1024 * 2;
constexpr size_t WS_XBC = WS_Z + (size_t)MG * 512 * 2;
constexpr size_t WS_Q = WS_XBC + (size_t)MG * 768 * 2;
constexpr size_t WS_K = WS_Q + (size_t)MG * 512 * 2;
constexpr size_t WS_V = WS_K + (size_t)MG * 512 * 2;
constexpr size_t WS_RW = WS_V + (size_t)MG * 512 * 2;
constexpr size_t WS_U = WS_RW + (size_t)MG * 1792 * 2;
constexpr size_t WS_SM = WS_U + (size_t)MG * 512 * 2;
constexpr size_t WS_G = WS_Q;
constexpr size_t WS_Y = WS_SM + (size_t)MG * 256 * 2;
constexpr size_t WS_YD0 = WS_Y + (size_t)4 * MG * 512 * 2;
constexpr size_t WS_MRG = WS_YD0 + (size_t)MG * 512 * 2;
constexpr size_t WS_MASK = WS_MRG + (size_t)MG * 1024 * 2;
constexpr size_t WS_RA = WS_MASK + (size_t)MG * MW * 4;
constexpr size_t WS_WLOG = WS_RA + (size_t)MG * 256 * 2;
constexpr size_t WS_ASIG = WS_WLOG + (size_t)MG * 512 * 4;
constexpr size_t WS_GG = WS_ASIG + (size_t)MG * 512 * 2;
constexpr size_t WS_XBA = WS_GG + (size_t)MG * 512 * 2;
constexpr size_t WS_VT = WS_XBA + (size_t)MG * 768 * 2;
constexpr size_t WS_KI = WS_VT + (size_t)MG * 512 * 2;
constexpr size_t WS_QCTR = 16384;
constexpr size_t WS_HID = WS_G;
constexpr size_t WS_WALT = al256(WS_KI + (size_t)MG * 32 * 2);
constexpr size_t WDELTA = WS_WALT - WS_ABAR;
constexpr size_t WS_END = WS_WALT + (WS_H - WS_ABAR);
static_assert(WS_SM + (size_t)MG * 256 * 2 - WS_Q == (size_t)MG * 4096 * 2, "G overlays exactly Q..SM");
static_assert((size_t)MG * 2816 * 2 <= (size_t)MG * 4096 * 2, "HID fits in G");

constexpr int LDS_SCRATCH = 131072;
constexpr int LDS_CTL_OFF = LDS_SCRATCH;
constexpr int LDS_X = LDS_SCRATCH + 64;
constexpr int LDS_BYTES = 161792;
constexpr int NTHREADS = 512, NWAVES = 8;

__device__ __forceinline__ float bf2f(bf16 v) { return __uint_as_float(((unsigned)v) << 16); }
#ifdef HOST_EMU
__device__ __forceinline__ bf16 f2bf(float f) { unsigned u = __float_as_uint(f); u += 0x7fffu + ((u >> 16) & 1u); return (bf16)(u >> 16); }
#else
__device__ __forceinline__ bf16 f2bf(float f) { return __builtin_bit_cast(bf16, (__bf16)f); }
#endif
#ifdef HOST_EMU
__device__ __forceinline__ unsigned pk2(float lo, float hi) { return (unsigned)f2bf(lo) | ((unsigned)f2bf(hi) << 16); }
#else
typedef __bf16 bf16x2_hw __attribute__((ext_vector_type(2)));
__device__ __forceinline__ unsigned pk2(float lo, float hi) { const f32x2 v = {lo, hi}; return __builtin_bit_cast(unsigned, __builtin_convertvector(v, bf16x2_hw)); }
#endif
__device__ __forceinline__ float lo_bf(unsigned w) { return __uint_as_float(w << 16); }
__device__ __forceinline__ float hi_bf(unsigned w) { return __uint_as_float(w & 0xffff0000u); }
#ifndef HOST_EMU
__device__ __forceinline__ float sigm(float x) { return __builtin_amdgcn_rcpf(1.0f + __expf(-x)); }
#else
__device__ __forceinline__ float sigm(float x) { return 1.0f / (1.0f + __expf(-x)); }
#endif
__device__ __forceinline__ float tanh_fast(float x) { return 2.0f * sigm(2.0f * x) - 1.0f; }
__device__ __forceinline__ float softplusf(float x) { return x > 20.f ? x : log1pf(__expf(x)); }
__device__ __forceinline__ float gelu_tanh(float x) { const float u = 0.7978845608f * (x + 0.044715f * x * x * x); return x * sigm(2.0f * u); }
__device__ __forceinline__ float wave_sum(float v) {
#pragma unroll
    for (int o = 1; o < 64; o <<= 1) v += __shfl_xor(v, o);
    return v;
}
__device__ __forceinline__ float wave_max(float v) {
#pragma unroll
    for (int o = 1; o < 64; o <<= 1) v = fmaxf(v, __shfl_xor(v, o));
    return v;
}
__device__ __forceinline__ int wave_sum_i(int v) {
#pragma unroll
    for (int o = 1; o < 64; o <<= 1) v += __shfl_xor(v, o);
    return v;
}
#ifdef HOST_EMU
#define WAVE_SYNC() (void)emu_wave_exchange(0)
#define SCHED_FENCE() do {} while (0)
#define LDS_SYNC() __syncthreads()
#else
#define WAVE_SYNC() __builtin_amdgcn_wave_barrier()
#define SCHED_FENCE() __builtin_amdgcn_sched_barrier(0)
#define LDS_SYNC() do { asm volatile("s_waitcnt lgkmcnt(0)" ::: "memory"); __builtin_amdgcn_s_barrier(); asm volatile("" ::: "memory"); } while (0)
#endif
#ifndef HOST_EMU
namespace pg8 {
__device__ __forceinline__ int pg8_fresh_tid() { int t = (int)threadIdx.x; asm volatile("" : "+v"(t)); return t; }
#define PG8_LAS __attribute__((address_space(3)))
typedef unsigned short bf16_t;
typedef short bf16x8 __attribute__((ext_vector_type(8)));
typedef float f32x4 __attribute__((ext_vector_type(4)));
typedef unsigned u32x4 __attribute__((ext_vector_type(4)));
constexpr int BM = 256, BK = 64, HALF = 128, HTB = HALF * BK * 2  , STAGE_BYTES = 8 * HTB, NXCD = 8, WGM = 8;

__host__ __device__ __forceinline__ int lds_byte(int r, int c) { const int st = (r >> 4) * 2 + (c >> 5), rr = r & 15, cc = c & 31, ob = rr * 64 + cc * 2; return st * 1024 + (ob ^ (((ob >> 9) & 1) << 5)); }
__host__ __device__ __forceinline__ void stage_rc(int b, int& R, int& C) { const int st = b / 1024, sb = b % 1024, swz = sb ^ (((sb >> 9) & 1) << 5); R = (st >> 1) * 16 + swz / 64; C = (st & 1) * 32 + (swz % 64) / 2; }
__host__ __device__ __forceinline__ int perm32(int rho) { const int n = rho >> 4, i = rho & 15; return 8 * (i >> 2) + 4 * n + (i & 3); }

struct Unit { int pm, pn; };
struct Gemm { const bf16_t* A; const bf16_t* Bt; int M, N, K; };

struct StaticOrder {
    int nM, nN, nwg, G, c;
    __host__ __device__ void init(int M, int N, int G_, int c_) { nM = M / BM; nN = N / BM; nwg = nM * nN; G = G_; c = c_; }
    __host__ __device__ bool next(int i, Unit& u) const {
        const long L = (long)i * G + c; if (L >= nwg) return false;
        int wgid = (int)L; { const int q = nwg / NXCD, r = nwg % NXCD, xcd = wgid % NXCD, off = wgid / NXCD; wgid = (xcd < r ? xcd * (q + 1) : r * (q + 1) + (xcd - r) * q) + off; }
        const int nig = WGM * nN, gid = wgid / nig, fm = gid * WGM, gsz = (nM - fm) < WGM ? (nM - fm) : WGM;
        u.pm = fm + ((wgid % nig) % gsz); u.pn = (wgid % nig) / gsz; return true;
    }
    __device__ __forceinline__ void a_ready(const Unit&) const {}
    __device__ __forceinline__ void done(const Unit&) const {}
};

__device__ __forceinline__ unsigned cvt_pk_bf16(float lo, float hi) { return pk2(lo, hi); }

template <class E, class = void> struct epi_keep { static constexpr bool value = false; };
template <class E> struct epi_keep<E, decltype((void)E::KEEP_ACC)> { static constexpr bool value = true; };
template <class Epi, class Sched, bool STAMP = false, bool ALIGN_EPI = false, bool SP2 = false>
__device__ __forceinline__ void gemm_phase(PG8_LAS unsigned char* lds, const Gemm g, const Sched& S, const Epi& E, unsigned long long* stamps) {
    const int tid = pg8_fresh_tid(), wid = __builtin_amdgcn_readfirstlane(tid >> 6), lane = tid & 63, wr = wid >> 2, wc = wid & 3, fr = lane & 15, fq = lane >> 4;
    int K_ = g.K; asm volatile("" : "+s"(K_));
    const int K = K_, nt = K / BK;
    int ts_lo = 0, ts_hi = 0, nts = 0; const unsigned long long rt_entry = STAMP ? (unsigned long long)wall_clock64() : 0ull;
#define PG8_STAMP() do { if (STAMP && wid == 0 && nts < 64) { const unsigned long long _c = (unsigned long long)clock64(); \
        ts_lo = (lane == nts) ? (int)(unsigned)_c : ts_lo; ts_hi = (lane == nts) ? (int)(unsigned)(_c >> 32) : ts_hi; ++nts; } } while (0)
    PG8_STAMP();
    unsigned voffA[2], voffB[2];
#pragma unroll
    for (int i = 0; i < 2; ++i) { int R, C; stage_rc(tid * 16 + i * 8192, R, C); const int Rb = Epi::PERM ? ((R & ~31) + perm32(R & 31)) : R;
        voffA[i] = (unsigned)(R * K + C) * 2u; voffB[i] = (unsigned)(Rb * K + C) * 2u; }
    const size_t kstep = (size_t)(BK * 2);
    const size_t hstep = (size_t)HALF * K * 2;
    const size_t tstep = 2 * hstep;
    const unsigned ldsw = (unsigned)wid * 1024u;
    const int aoff = lds_byte(wr * 64 + fr, fq * 8), boff = lds_byte(wc * 32 + fr, fq * 8);
#define PG8_SA(b, h) (((b) * 2 + (h)) * HTB)
#define PG8_SB(b, h) ((4 + (b) * 2 + (h)) * HTB)
#define PG8_STAGE(bufoff, gbase, voff) do { _Pragma("unroll") for (int _i = 0; _i < 2; ++_i) \
        __builtin_amdgcn_global_load_lds((const unsigned*)((const char*)(gbase) + (voff)[_i]), (PG8_LAS unsigned*)(lds + (bufoff) + ldsw + _i * 8192), 16, 0, 0); } while (0)
#define PG8_LDA(dst, b, h) do { _Pragma("unroll") for (int m = 0; m < 4; ++m) _Pragma("unroll") for (int k = 0; k < 2; ++k) dst[m][k] = *(const PG8_LAS bf16x8*)(lds + PG8_SA(b, h) + aoff + m * 2048 + k * 1024); } while (0)
#define PG8_LDB(dst, b, h) do { _Pragma("unroll") for (int n = 0; n < 2; ++n) _Pragma("unroll") for (int k = 0; k < 2; ++k) dst[n][k] = *(const PG8_LAS bf16x8*)(lds + PG8_SB(b, h) + boff + n * 2048 + k * 1024); } while (0)
#define PG8_MMA(ai, bj, At, Bt) do { __builtin_amdgcn_s_setprio(1); _Pragma("unroll") for (int m = 0; m < 4; ++m) _Pragma("unroll") for (int n = 0; n < 2; ++n) _Pragma("unroll") for (int k = 0; k < 2; ++k) \
        acc[ai][bj][m][n] = __builtin_amdgcn_mfma_f32_16x16x32_bf16(Bt[n][k], At[m][k], acc[ai][bj][m][n], 0, 0, 0); __builtin_amdgcn_s_setprio(0); } while (0)
#define PG8_WAIT_V(n) asm volatile("s_waitcnt vmcnt(" #n ")" ::: "memory")
#define PG8_WAIT_L(n) asm volatile("s_waitcnt lgkmcnt(" #n ")" ::: "memory")
#define PG8_BAR __builtin_amdgcn_s_barrier()
#define PG8_SCHED __builtin_amdgcn_sched_barrier(0)
    Unit cur, nxt; int ui = 0;
    if (!S.next(0, cur)) return;
    f32x4 acc[2][2][4][2];
#pragma unroll
    for (int a = 0; a < 2; ++a)
#pragma unroll
        for (int b = 0; b < 2; ++b)
#pragma unroll
            for (int m = 0; m < 4; ++m)
#pragma unroll
                for (int n = 0; n < 2; ++n) acc[a][b][m][n] = (f32x4){0.f, 0.f, 0.f, 0.f};
    bf16x8 At[4][2], B0[2][2], B1[2][2];
    const char* cA = (const char*)g.A + (size_t)cur.pm * tstep; const char* cB = (const char*)g.Bt + (size_t)cur.pn * tstep;
    S.a_ready(cur);
    if constexpr (SP2) {
        PG8_STAGE(PG8_SB(0, 0), cB, voffB); PG8_STAGE(PG8_SB(0, 1), cB + hstep, voffB); PG8_STAGE(PG8_SA(0, 0), cA, voffA); PG8_STAGE(PG8_SA(0, 1), cA + hstep, voffA);
        if (wr == 1) PG8_BAR;
        PG8_WAIT_V(2); PG8_BAR;
        PG8_STAGE(PG8_SB(1, 0), cB + kstep, voffB); PG8_STAGE(PG8_SA(1, 0), cA + kstep, voffA); PG8_STAGE(PG8_SB(1, 1), cB + hstep + kstep, voffB);
        PG8_WAIT_V(6); PG8_BAR;
    } else {
    PG8_STAGE(PG8_SB(0, 0), cB, voffB); PG8_STAGE(PG8_SA(0, 0), cA, voffA); PG8_STAGE(PG8_SB(0, 1), cB + hstep, voffB); PG8_STAGE(PG8_SA(0, 1), cA + hstep, voffA);
    if (wr == 1) PG8_BAR;
    PG8_WAIT_V(4); PG8_BAR;
    PG8_STAGE(PG8_SB(1, 0), cB + kstep, voffB); PG8_STAGE(PG8_SA(1, 0), cA + kstep, voffA); PG8_STAGE(PG8_SB(1, 1), cB + hstep + kstep, voffB);
    PG8_WAIT_V(6); PG8_BAR;
    }
    PG8_STAMP();
    for (;;) {
        const bool has_next = S.next(ui + 1, nxt);
        const char* nA = has_next ? (const char*)g.A + (size_t)nxt.pm * tstep : cA; const char* nB = has_next ? (const char*)g.Bt + (size_t)nxt.pn * tstep : cB;
        for (int t = 0; t < nt; t += 2) {
            const bool last = (t == nt - 2);
            const char* a1 = cA + (size_t)(t + 1) * kstep;
            const char* a2 = last ? nA : cA + (size_t)(t + 2) * kstep; const char* b2 = last ? nB : cB + (size_t)(t + 2) * kstep;
            const char* a3 = a2 + kstep; const char* b3 = b2 + kstep;
            if (last && has_next) S.a_ready(nxt);
            if constexpr (SP2) {
            PG8_LDB(B0, 0, 0); PG8_LDB(B1, 0, 1); PG8_SCHED; PG8_LDA(At, 0, 0); PG8_STAGE(PG8_SA(1, 1), a1 + hstep, voffA);
            PG8_WAIT_V(8); PG8_WAIT_L(0); PG8_BAR; PG8_MMA(0, 0, At, B0); PG8_MMA(0, 1, At, B1); PG8_BAR; PG8_SCHED;
            PG8_LDA(At, 0, 1); PG8_STAGE(PG8_SB(0, 0), b2, voffB); PG8_STAGE(PG8_SB(0, 1), b2 + hstep, voffB); PG8_STAGE(PG8_SA(0, 0), a2, voffA);
            PG8_WAIT_V(8); PG8_WAIT_L(0); PG8_BAR; PG8_MMA(1, 0, At, B0); PG8_MMA(1, 1, At, B1); PG8_BAR; PG8_SCHED;
            PG8_LDB(B0, 1, 0); PG8_LDB(B1, 1, 1); PG8_SCHED; PG8_LDA(At, 1, 0); PG8_STAGE(PG8_SA(0, 1), a2 + hstep, voffA);
            PG8_WAIT_V(8); PG8_WAIT_L(0); PG8_BAR; PG8_MMA(0, 0, At, B0); PG8_MMA(0, 1, At, B1); PG8_BAR; PG8_SCHED;
            PG8_LDA(At, 1, 1); PG8_STAGE(PG8_SB(1, 0), b3, voffB); PG8_STAGE(PG8_SB(1, 1), b3 + hstep, voffB); PG8_STAGE(PG8_SA(1, 0), a3, voffA);
            PG8_WAIT_V(8); PG8_WAIT_L(0); PG8_BAR; PG8_MMA(1, 0, At, B0); PG8_MMA(1, 1, At, B1); PG8_BAR; PG8_SCHED;
            } else {
            PG8_LDB(B0, 0, 0); PG8_SCHED; PG8_LDA(At, 0, 0); PG8_STAGE(PG8_SA(1, 1), a1 + hstep, voffA);
            PG8_WAIT_L(8); PG8_BAR; PG8_WAIT_L(0); PG8_MMA(0, 0, At, B0); PG8_BAR; PG8_SCHED;
            PG8_LDB(B1, 0, 1); PG8_STAGE(PG8_SB(0, 0), b2, voffB);
            PG8_BAR; PG8_WAIT_L(0); PG8_MMA(0, 1, At, B1); PG8_BAR;
            PG8_LDA(At, 0, 1); PG8_STAGE(PG8_SA(0, 0), a2, voffA);
            PG8_BAR; PG8_WAIT_L(0); PG8_MMA(1, 0, At, B0); PG8_BAR; PG8_SCHED;
            PG8_STAGE(PG8_SB(0, 1), b2 + hstep, voffB);
            PG8_WAIT_V(6); PG8_BAR; PG8_MMA(1, 1, At, B1); PG8_BAR;
            PG8_LDB(B0, 1, 0); PG8_SCHED; PG8_LDA(At, 1, 0); PG8_STAGE(PG8_SA(0, 1), a2 + hstep, voffA);
            PG8_WAIT_L(8); PG8_BAR; PG8_WAIT_L(0); PG8_MMA(0, 0, At, B0); PG8_BAR; PG8_SCHED;
            PG8_LDB(B1, 1, 1); PG8_STAGE(PG8_SB(1, 0), b3, voffB);
            PG8_BAR; PG8_WAIT_L(0); PG8_MMA(0, 1, At, B1); PG8_BAR;
            PG8_LDA(At, 1, 1); PG8_STAGE(PG8_SA(1, 0), a3, voffA);
            PG8_BAR; PG8_WAIT_L(0); PG8_MMA(1, 0, At, B0); PG8_BAR; PG8_SCHED;
            PG8_STAGE(PG8_SB(1, 1), b3 + hstep, voffB);
            PG8_WAIT_V(6); PG8_BAR; PG8_MMA(1, 1, At, B1); PG8_BAR;
            }
        }
        PG8_STAMP();
        if constexpr (ALIGN_EPI) { if (wr == 0) PG8_BAR; }
        if constexpr (!Epi::AFTER_DRAIN) { E(acc, cur, wr, wc, fr, fq); S.done(cur); }
        PG8_STAMP();
        if (!has_next) break;
        bool zero_acc = true; if constexpr (epi_keep<Epi>::value) zero_acc = !E.keep(cur);
        if (zero_acc) {
#pragma unroll
        for (int a = 0; a < 2; ++a)
#pragma unroll
            for (int b = 0; b < 2; ++b)
#pragma unroll
                for (int m = 0; m < 4; ++m)
#pragma unroll
                    for (int n = 0; n < 2; ++n) acc[a][b][m][n] = (f32x4){0.f, 0.f, 0.f, 0.f}; }
        cur = nxt; cA = nA; cB = nB; ++ui;
        if constexpr (ALIGN_EPI) { if (wr == 1) PG8_BAR; }
    }
    PG8_WAIT_V(0);
    if constexpr (!ALIGN_EPI) { if (wr == 0) PG8_BAR; }
    PG8_BAR;
    if constexpr (Epi::AFTER_DRAIN) { E.fused(acc, cur, wr, wc, fr, fq, lds, wid, lane); S.done(cur); }
    PG8_STAMP();
    if (STAMP && wid == 0) { stamps[lane] = lane < nts ? (((unsigned long long)(unsigned)ts_hi << 32) | (unsigned)ts_lo) : 0ull;
        if (lane == 62) stamps[62] = rt_entry; if (lane == 63) stamps[63] = (unsigned long long)wall_clock64(); }
#undef PG8_STAMP
#undef PG8_SA
#undef PG8_SB
#undef PG8_STAGE
#undef PG8_LDA
#undef PG8_LDB
#undef PG8_MMA
#undef PG8_WAIT_V
#undef PG8_WAIT_L
#undef PG8_BAR
#undef PG8_SCHED
}
}

#define XB_TMO      128
#define XB_XCNT(j)  (256  + 64 * (j))
#define XB_XSUB(j)  (1280 + 64 * (j))
#define XB_XGEN(j)  (2304 + 64 * (j))
#define XB_TOP      3328
#define XB_TOPGEN   3392
#define XCD_BAR_WORDS 3456
#define XB_SPIN_CAP (1u << 18)
#define LAS __attribute__((address_space(3)))

__device__ __forceinline__ unsigned xb_ld(unsigned* p)              { return __hip_atomic_load(p, __ATOMIC_RELAXED, __HIP_MEMORY_SCOPE_AGENT); }
__device__ __forceinline__ unsigned xb_add(unsigned* p, unsigned v) { return __hip_atomic_fetch_add(p, v, __ATOMIC_RELAXED, __HIP_MEMORY_SCOPE_AGENT); }
__device__ __forceinline__ unsigned xb_xcc_id() { return (unsigned)__builtin_amdgcn_s_getreg((3 << 11) | 20) & 0xFu; }
#define XB_SPIN(cond, bar) do { unsigned _sp = 0; while (cond) { __builtin_amdgcn_s_sleep(1); \
    if ((++_sp & 255u) == 0u) { if (xb_ld(&(bar)[XB_TMO])) break; if (_sp > XB_SPIN_CAP) { atomicAdd(&(bar)[XB_TMO], 1u); break; } } } } while (0)

struct XcdBarrier {
    unsigned* bar; unsigned x;
    volatile LAS unsigned* st;
};

__device__ __forceinline__ XcdBarrier xcd_barrier_post(unsigned* bar, volatile LAS unsigned* st) {
    XcdBarrier b; b.bar = bar; b.x = xb_xcc_id(); b.st = st;
    if (threadIdx.x == 0) (void)xb_add(&bar[XB_XCNT(b.x)], 1u);
    return b;
}
__device__ __forceinline__ void xcd_barrier_complete(unsigned* bar, unsigned x, unsigned& nloc, unsigned& nx) {
    const unsigned G = gridDim.x * gridDim.y * gridDim.z;
    unsigned sum, cnt, mine, sp = 0u;
    for (;;) {
        sum = 0u; cnt = 0u; mine = 0u;
#pragma unroll
        for (unsigned j = 0; j < 16; ++j) { const unsigned c = xb_ld(&bar[XB_XCNT(j)]); sum += c; cnt += (c > 0u) ? 1u : 0u; mine = (j == x) ? c : mine; }
        if (sum == G) break;
        __builtin_amdgcn_s_sleep(1);
        if ((++sp & 255u) == 0u) { if (xb_ld(&bar[XB_TMO])) break; if (sp > XB_SPIN_CAP) { atomicAdd(&bar[XB_TMO], 1u); break; } }
    }
    nloc = mine > 0u ? mine : 1u; nx = cnt > 0u ? cnt : 1u;
}

__device__ __forceinline__ void xcd_barrier(const XcdBarrier& b) {
    asm volatile("s_waitcnt vmcnt(0)" ::: "memory");
    __syncthreads();
    if (threadIdx.x == 0) {
        unsigned* bar = b.bar;
        __builtin_amdgcn_s_waitcnt(0);
        unsigned nloc = b.st[0], nx = b.st[1];
        if (nloc == 0u) { xcd_barrier_complete(bar, b.x, nloc, nx); b.st[0] = nloc; b.st[1] = nx; }
        const unsigned old = xb_add(&bar[XB_XSUB(b.x)], 1u);
        const unsigned gen = old / nloc;
        if (old + 1u == (gen + 1u) * nloc) {
            __builtin_amdgcn_fence(__ATOMIC_RELEASE, "agent");
            asm volatile("s_waitcnt vmcnt(0)" ::: "memory");
            const unsigned og = xb_add(&bar[XB_TOP], 1u);
            const unsigned tg = og / nx;
            if (og + 1u == (tg + 1u) * nx) xb_add(&bar[XB_TOPGEN], 1u);
            else XB_SPIN(xb_ld(&bar[XB_TOPGEN]) == tg, bar);
            __builtin_amdgcn_fence(__ATOMIC_ACQUIRE, "agent");
            xb_add(&bar[XB_XGEN(b.x)], 1u);
            asm volatile("s_waitcnt vmcnt(0)" ::: "memory");
        } else {
            XB_SPIN(xb_ld(&bar[XB_XGEN(b.x)]) == gen, bar);
            __builtin_amdgcn_fence(__ATOMIC_ACQUIRE, "agent");
            asm volatile("s_waitcnt vmcnt(0)" ::: "memory");
        }
    }
    __syncthreads();
}

#else
namespace pg8 {
typedef unsigned short bf16_t;
typedef float f32x4 __attribute__((ext_vector_type(4)));
typedef unsigned u32x4 __attribute__((ext_vector_type(4)));
constexpr int BM = 256, BK = 64, HALF = 128, NXCD = 8, WGM = 8;
struct Unit { int pm, pn; };
struct Gemm { const bf16_t* A; const bf16_t* Bt; int M, N, K; };
template <class E, class = void> struct epi_keep { static constexpr bool value = false; };
template <class E> struct epi_keep<E, decltype((void)E::KEEP_ACC)> { static constexpr bool value = true; };
struct StaticOrder {
    int nM, nN, nwg, G, c;
    void init(int M, int N, int G_, int c_) { nM = M / BM; nN = N / BM; nwg = nM * nN; G = G_; c = c_; }
    bool next(int i, Unit& u) const {
        const long L = (long)i * G + c; if (L >= nwg) return false;
        int wgid = (int)L; { const int q = nwg / NXCD, r = nwg % NXCD, xcd = wgid % NXCD, off = wgid / NXCD; wgid = (xcd < r ? xcd * (q + 1) : r * (q + 1) + (xcd - r) * q) + off; }
        const int nig = WGM * nN, gid = wgid / nig, fm = gid * WGM, gsz = (nM - fm) < WGM ? (nM - fm) : WGM;
        u.pm = fm + ((wgid % nig) % gsz); u.pn = (wgid % nig) / gsz; return true;
    }
    void a_ready(const Unit&) const {}
    void done(const Unit&) const {}
};
static inline unsigned cvt_pk_bf16(float lo, float hi) { return pk2(lo, hi); }
static float* emu_tile_buf(int b) { static std::vector<std::vector<float>> t; if ((int)t.size() <= b) t.resize(b + 1); if (t[b].empty()) t[b].resize(256 * 256); return t[b].data(); }
template <class Epi, class Sched, bool STAMP = false, bool ALIGN_EPI = false, bool SP2 = false>
void gemm_phase(unsigned char* lds, const Gemm g, const Sched& S, const Epi& E, unsigned long long* stamps) {
    const int tid = threadIdx.x, wid = tid >> 6, lane = tid & 63, wr = wid >> 2, wc = wid & 3, fr = lane & 15, fq = lane >> 4;
    float* tile = emu_tile_buf(blockIdx.x);
    Unit u; f32x4 acc[2][2][4][2]; bool keep_next = false;
    for (int ui = 0; S.next(ui, u); ++ui) {
        __syncthreads();
        if (tid == 0) {
            std::vector<float> a((size_t)256 * g.K), b((size_t)256 * g.K);
            for (int r = 0; r < 256; ++r) for (int k = 0; k < g.K; ++k) { a[(size_t)r * g.K + k] = bf2f(g.A[((size_t)u.pm * 256 + r) * g.K + k]); b[(size_t)r * g.K + k] = bf2f(g.Bt[((size_t)u.pn * 256 + r) * g.K + k]); }
            for (int r = 0; r < 256; ++r) for (int c = 0; c < 256; ++c) { const float* ar = &a[(size_t)r * g.K]; const float* br = &b[(size_t)c * g.K]; float s = 0.f; for (int k = 0; k < g.K; ++k) s += ar[k] * br[k]; tile[r * 256 + c] = s; }
        }
        __syncthreads();
        if (!keep_next) for (int ai = 0; ai < 2; ++ai) for (int bj = 0; bj < 2; ++bj) for (int m = 0; m < 4; ++m) for (int n = 0; n < 2; ++n) acc[ai][bj][m][n] = (f32x4){0.f, 0.f, 0.f, 0.f};
        for (int ai = 0; ai < 2; ++ai) for (int bj = 0; bj < 2; ++bj) for (int m = 0; m < 4; ++m) for (int n = 0; n < 2; ++n) for (int j = 0; j < 4; ++j) {
            const int r = 128 * ai + 64 * wr + 16 * m + fr;
            const int c = Epi::PERM ? (128 * bj + 32 * wc + 8 * fq + 4 * n + j) : (128 * bj + 32 * wc + 16 * n + 4 * fq + j);
            acc[ai][bj][m][n][j] += tile[r * 256 + c];
        }
        E(acc, u, wr, wc, fr, fq); S.done(u);
        if constexpr (epi_keep<Epi>::value) keep_next = E.keep(u); else keep_next = false;
        __syncthreads();
    }
}
}
#endif
namespace pg8 {
#ifdef HOST_EMU
#define EPI_FENCE() do {} while (0)
#else
#define EPI_FENCE() asm volatile("" ::: "memory")
#endif
__device__ __forceinline__ u32x4 pack8(const f32x4 v0, const f32x4 v1) { u32x4 w; w.x = cvt_pk_bf16(v0[0], v0[1]); w.y = cvt_pk_bf16(v0[2], v0[3]); w.z = cvt_pk_bf16(v1[0], v1[1]); w.w = cvt_pk_bf16(v1[2], v1[3]); return w; }
__device__ __forceinline__ void unpack8(const u32x4 w, f32x4& v0, f32x4& v1) { v0 = (f32x4){lo_bf(w.x), hi_bf(w.x), lo_bf(w.y), hi_bf(w.y)}; v1 = (f32x4){lo_bf(w.z), hi_bf(w.z), lo_bf(w.w), hi_bf(w.w)}; }
__device__ __forceinline__ f32x4 sig4(const f32x4 v) { return (f32x4){sigm(v[0]), sigm(v[1]), sigm(v[2]), sigm(v[3])}; }
#ifndef HOST_EMU
__device__ __forceinline__ float gate_sig(float x) { return __builtin_amdgcn_rcpf(fminf(1.0f + __expf(-x), 1.0e6f)); }
#else
__device__ __forceinline__ float gate_sig(float x) { return fmaxf(sigm(x), 1.0e-6f); }
#endif
__device__ __forceinline__ f32x4 gsig4(const f32x4 v) { return (f32x4){gate_sig(v[0]), gate_sig(v[1]), gate_sig(v[2]), gate_sig(v[3])}; }

struct EpiProj {
    static constexpr bool PERM = true, AFTER_DRAIN = false;
    unsigned char* ws;
    __device__ __forceinline__ void operator()(const f32x4 (&acc)[2][2][4][2], const Unit& u, int wr, int wc, int fr, int fq) const {
        const int pn = u.pn; size_t off; int ld, c0;
        if (pn < 2) { off = WS_Z; ld = 512; c0 = pn * 256; }
        else if (pn < 5) { off = WS_XBC; ld = 768; c0 = (pn - 2) * 256; }
        else if (pn < 7) { off = WS_Q; ld = 512; c0 = (pn - 5) * 256; }
        else if (pn < 9) { off = WS_K; ld = 512; c0 = (pn - 7) * 256; }
        else if (pn < 11) { off = WS_V; ld = 512; c0 = (pn - 9) * 256; }
        else if (pn < 18) { off = WS_RW; ld = 1792; c0 = (pn - 11) * 256; }
        else if (pn < 20) { off = WS_U; ld = 512; c0 = (pn - 18) * 256; }
        else { off = WS_SM; ld = 256; c0 = 0; }
        bf16_t* dst = (bf16_t*)(ws + off);
        const int row0 = u.pm * BM + wr * 64 + fr, col0 = c0 + wc * 32 + 8 * fq;
        const int kic = HALF + wc * 32 + 8 * fq - 136;
        const bool ki = (pn == 20) && kic >= 0 && kic < 32;
#pragma unroll
        for (int ai = 0; ai < 2; ++ai)
#pragma unroll
            for (int m = 0; m < 4; ++m) { const size_t row = (size_t)(row0 + ai * HALF + m * 16); bf16_t* rowp = dst + row * ld + col0;
#pragma unroll
                for (int bj = 0; bj < 2; ++bj) { const u32x4 w = pack8(acc[ai][bj][m][0], acc[ai][bj][m][1]); *(u32x4*)(rowp + bj * HALF) = w;
                    if (bj == 1 && ki) *(u32x4*)((bf16_t*)(ws + WS_KI) + row * 32 + kic) = w; } }
    }
};
struct EpiGate {
    static constexpr bool PERM = true, AFTER_DRAIN = false;
    bf16_t* G;
    __device__ __forceinline__ void operator()(const f32x4 (&acc)[2][2][4][2], const Unit& u, int wr, int wc, int fr, int fq) const {
        const int row0 = u.pm * BM + wr * 64 + fr, col0 = u.pn * BM + wc * 32 + 8 * fq;
#pragma unroll
        for (int ai = 0; ai < 2; ++ai)
#pragma unroll
            for (int m = 0; m < 4; ++m) { bf16_t* rowp = G + (size_t)(row0 + ai * HALF + m * 16) * 4096 + col0;
#pragma unroll
                for (int bj = 0; bj < 2; ++bj) *(u32x4*)(rowp + bj * HALF) = pack8(gsig4(acc[ai][bj][m][0]), gsig4(acc[ai][bj][m][1])); }
    }
};
struct EpiMerge {
    static constexpr bool PERM = true, AFTER_DRAIN = false, KEEP_ACC = true;
    const bf16_t* G; bf16_t* MRG;
    __device__ __forceinline__ bool keep(const Unit& u) const { return (u.pn >> 2) < 3; }
    __device__ __forceinline__ void operator()(f32x4 (&acc)[2][2][4][2], const Unit& u, int wr, int wc, int fr, int fq) const {
        const int n = u.pn >> 2, pn = u.pn & 3, pm = u.pm - n * (MG / 256);
        const int row0 = pm * BM + wr * 64 + fr, col0 = pn * BM + wc * 32 + 8 * fq;
#pragma unroll
        for (int ai = 0; ai < 2; ++ai)
#pragma unroll
            for (int mp = 0; mp < 2; ++mp) { u32x4 ga[2][2], gb[2][2];
#pragma unroll
                for (int mm = 0; mm < 2; ++mm)
#pragma unroll
                    for (int bj = 0; bj < 2; ++bj) { const bf16_t* gp = G + (size_t)(row0 + ai * HALF + (2 * mp + mm) * 16) * 4096 + n * 1024 + col0 + bj * HALF; ga[mm][bj] = *(const u32x4*)gp; if (n < 3) gb[mm][bj] = *(const u32x4*)(gp + 1024); }
#pragma unroll
                for (int mm = 0; mm < 2; ++mm)
#pragma unroll
                    for (int bj = 0; bj < 2; ++bj) { const int m = 2 * mp + mm; f32x4 a0, a1; unpack8(ga[mm][bj], a0, a1);
                        if (n < 3) { f32x4 b0, b1; unpack8(gb[mm][bj], b0, b1);
#pragma unroll
                            for (int j = 0; j < 4; ++j) { acc[ai][bj][m][0][j] *= a0[j] * __builtin_amdgcn_rcpf(b0[j]); acc[ai][bj][m][1][j] *= a1[j] * __builtin_amdgcn_rcpf(b1[j]); } }
                        else
                            *(u32x4*)(MRG + (size_t)(row0 + ai * HALF + m * 16) * 1024 + col0 + bj * HALF) = pack8(acc[ai][bj][m][0] * a0, acc[ai][bj][m][1] * a1); }
                EPI_FENCE(); }
    }
};
struct MergeOrder {
    int G, c;
    __device__ __forceinline__ bool next(int i, Unit& u) const {
        const int tile = (i >> 2) * G + c, n = i & 3; if (tile >= (MG / 256) * 4) return false;
        u.pm = n * (MG / 256) + (tile >> 2); u.pn = n * 4 + (tile & 3); return true;
    }
    __device__ __forceinline__ void a_ready(const Unit&) const {}
    __device__ __forceinline__ void done(const Unit&) const {}
};
struct EpiResid {
    static constexpr bool PERM = false, AFTER_DRAIN = false;
    const float* base; float* out;
    __device__ __forceinline__ void operator()(const f32x4 (&acc)[2][2][4][2], const Unit& u, int wr, int wc, int fr, int fq) const {
        const int row0 = u.pm * BM + wr * 64 + fr, col0 = u.pn * BM + wc * 32 + 4 * fq;
#pragma unroll
        for (int ai = 0; ai < 2; ++ai) {
            f32x4 bv[4][2][2];
#pragma unroll
            for (int m = 0; m < 4; ++m)
#pragma unroll
                for (int bj = 0; bj < 2; ++bj)
#pragma unroll
                    for (int n = 0; n < 2; ++n) bv[m][bj][n] = *(const f32x4*)(base + (size_t)(row0 + ai * HALF + m * 16) * 1024 + col0 + bj * HALF + n * 16);
#pragma unroll
            for (int m = 0; m < 4; ++m)
#pragma unroll
                for (int bj = 0; bj < 2; ++bj)
#pragma unroll
                    for (int n = 0; n < 2; ++n) *(f32x4*)(out + (size_t)(row0 + ai * HALF + m * 16) * 1024 + col0 + bj * HALF + n * 16) = bv[m][bj][n] + acc[ai][bj][m][n];
            EPI_FENCE(); }
    }
};
struct EpiSwiglu {
    static constexpr bool PERM = true, AFTER_DRAIN = false;
    bf16_t* HID;
    __device__ __forceinline__ void operator()(const f32x4 (&acc)[2][2][4][2], const Unit& u, int wr, int wc, int fr, int fq) const {
        const int row0 = u.pm * BM + wr * 64 + fr, col0 = u.pn * HALF + wc * 32 + 8 * fq;
#pragma unroll
        for (int ai = 0; ai < 2; ++ai)
#pragma unroll
            for (int m = 0; m < 4; ++m) { f32x4 v[2];
#pragma unroll
                for (int n = 0; n < 2; ++n) { const f32x4 a = acc[ai][0][m][n], b = acc[ai][1][m][n]; v[n] = a * sig4(a) * b; }
                *(u32x4*)(HID + (size_t)(row0 + ai * HALF + m * 16) * FFN + col0) = pack8(v[0], v[1]); }
    }
};
struct EpiGlu {
    static constexpr bool PERM = true, AFTER_DRAIN = false;
    const bf16_t* Y0; bf16_t* OUT; const float* bias;
    __device__ __forceinline__ void operator()(const f32x4 (&acc)[2][2][4][2], const Unit& u, int wr, int wc, int fr, int fq) const {
        const int row0 = u.pm * BM + wr * 64 + fr, col0 = u.pn * BM + wc * 32 + 8 * fq;
#pragma unroll
        for (int ai = 0; ai < 2; ++ai)
#pragma unroll
            for (int m = 0; m < 4; ++m) { const size_t row = (size_t)(row0 + ai * HALF + m * 16);
#pragma unroll
                for (int bj = 0; bj < 2; ++bj) { const int col = col0 + bj * HALF;
                    f32x4 y0, y1; unpack8(*(const u32x4*)(Y0 + row * 512 + col), y0, y1);
                    const f32x4 b0 = *(const f32x4*)(bias + col), b1 = *(const f32x4*)(bias + col + 4);
                    *(u32x4*)(OUT + row * 512 + col) = pack8(y0 * sig4(acc[ai][bj][m][0] + b0), y1 * sig4(acc[ai][bj][m][1] + b1)); }
                EPI_FENCE(); }
    }
};
__device__ __forceinline__ float logdecay(float x) { return -0.6065306597f * sigm(x); }
struct EpiLora {
    static constexpr bool PERM = true, AFTER_DRAIN = false;
    float* WLOG; bf16_t* ASIG; bf16_t* GG; const float* w0; const float* a0;
    __device__ __forceinline__ void operator()(const f32x4 (&acc)[2][2][4][2], const Unit& u, int wr, int wc, int fr, int fq) const {
        const int kind = u.pn >> 1, row0 = u.pm * BM + wr * 64 + fr, col0 = (u.pn & 1) * BM + wc * 32 + 8 * fq;
        if (kind == 0) {
            f32x4 b[2][2];
#pragma unroll
            for (int bj = 0; bj < 2; ++bj) { b[bj][0] = *(const f32x4*)(w0 + col0 + bj * HALF); b[bj][1] = *(const f32x4*)(w0 + col0 + bj * HALF + 4); }
#pragma unroll
            for (int ai = 0; ai < 2; ++ai)
#pragma unroll
                for (int m = 0; m < 4; ++m)
#pragma unroll
                    for (int bj = 0; bj < 2; ++bj)
#pragma unroll
                        for (int n = 0; n < 2; ++n) { const f32x4 x = acc[ai][bj][m][n] + b[bj][n];
                            *(f32x4*)(WLOG + (size_t)(row0 + ai * HALF + m * 16) * 512 + col0 + bj * HALF + 4 * n) = (f32x4){logdecay(x[0]), logdecay(x[1]), logdecay(x[2]), logdecay(x[3])}; }
        } else if (kind == 1) {
            f32x4 b[2][2];
#pragma unroll
            for (int bj = 0; bj < 2; ++bj) { b[bj][0] = *(const f32x4*)(a0 + col0 + bj * HALF); b[bj][1] = *(const f32x4*)(a0 + col0 + bj * HALF + 4); }
#pragma unroll
            for (int ai = 0; ai < 2; ++ai)
#pragma unroll
                for (int m = 0; m < 4; ++m)
#pragma unroll
                    for (int bj = 0; bj < 2; ++bj)
                        *(u32x4*)(ASIG + (size_t)(row0 + ai * HALF + m * 16) * 512 + col0 + bj * HALF) = pack8(sig4(acc[ai][bj][m][0] + b[bj][0]), sig4(acc[ai][bj][m][1] + b[bj][1]));
        } else {
#pragma unroll
            for (int ai = 0; ai < 2; ++ai)
#pragma unroll
                for (int m = 0; m < 4; ++m)
#pragma unroll
                    for (int bj = 0; bj < 2; ++bj)
                        *(u32x4*)(GG + (size_t)(row0 + ai * HALF + m * 16) * 512 + col0 + bj * HALF) = pack8(acc[ai][bj][m][0], acc[ai][bj][m][1]);
        }
    }
};
}
typedef short bf16x8_t __attribute__((ext_vector_type(8)));
typedef float f32x16 __attribute__((ext_vector_type(16)));
typedef float f32x4_t __attribute__((ext_vector_type(4)));
__device__ __forceinline__ bf16x8_t frag2(const u32x2 lo, const u32x2 hi) { u32x4 w; w.x = lo.x; w.y = lo.y; w.z = hi.x; w.w = hi.y; return __builtin_bit_cast(bf16x8_t, w); }
struct Args { const float* in[N_IN]; float* out; unsigned char* ws; int seg_lo, seg_hi; };
#ifdef HOST_EMU
typedef const Args* KArgs;
#define KLAUNDER(p) (p)
__device__ __forceinline__ int fresh_tid() { return (int)threadIdx.x; }
#else
typedef const __attribute__((address_space(4))) Args* KArgs;
__device__ __forceinline__ KArgs klaunder(KArgs p) { asm volatile("" : "+s"(p)); return p; }
#define KLAUNDER(p) klaunder(p)
__device__ __forceinline__ int fresh_tid() { int t = (int)threadIdx.x; asm volatile("" : "+v"(t)); return t; }
#endif
#define WSP(T, off) ((T*)(C->ws + (off)))

template <class Src>
__device__ __forceinline__ void transpose_item(const Src& S, int K, bf16* WT, float* scr, int item, int lane) {
    const int nblk = S.ndst / 32, kb = item / nblk, nb = item % nblk, k0 = 64 * kb, n0 = 32 * nb;
    const float* cp = S.col(n0 + (lane & 31)); const int ld = S.ld;
#pragma unroll 8
    for (int i = 0; i < 32; ++i) { const int kk = 2 * i + (lane >> 5); scr[kk * 33 + (lane & 31)] = cp ? cp[(size_t)(k0 + kk) * ld] : 0.f; }
    WAVE_SYNC();
    const int c = lane & 7;
#pragma unroll
    for (int j = 0; j < 4; ++j) { const int n = (lane >> 3) + 8 * j; const float* s = scr + (8 * c) * 33 + n;
        u32x4 o; o.x = pk2(s[0 * 33], s[1 * 33]); o.y = pk2(s[2 * 33], s[3 * 33]); o.z = pk2(s[4 * 33], s[5 * 33]); o.w = pk2(s[6 * 33], s[7 * 33]);
        *(u32x4*)(WT + (size_t)(n0 + n) * K + k0 + 8 * c) = o; }
    WAVE_SYNC();
}
struct SrcWin { const float* w; int ndst, ld;
    __device__ __forceinline__ const float* col(int n) const {
        int s;
        if (n < 1280) s = n;
        else if (n < 2816) s = n + 8;
        else if (n < 4608) s = n - 2816 + 2988;
        else if (n < 5120) s = n - 4608 + 4780;
        else if (n < 5128) s = n - 5120 + 1280;
        else if (n < 5256) s = n - 5128 + 2824;
        else if (n < 5288) s = n - 5256 + 2952;
        else if (n < 5292) s = n - 5288 + 2984;
        else if (n < 5376) return nullptr;
        else s = n - 5376 + 5292;
        return w + s; } };
struct SrcPlain { const float* w; int ndst, ld; __device__ __forceinline__ const float* col(int n) const { return w + n; } };
struct SrcW13 { const float* w1; const float* w3; int ndst, ld;
    __device__ __forceinline__ const float* col(int n) const { const int pn = n >> 8, r = n & 255; return w1 + (r < 128 ? (ptrdiff_t)0 : (w3 - w1)) + pn * 128 + (r & 127); } };

__device__ __forceinline__ void phase_weights(KArgs C, int layer, unsigned char* lds, int gw, int ngw, int lane, int wave) {
    float* scr = (float*)(lds + wave * 16384); const size_t wo = (layer & 1) ? WDELTA : 0;
    constexpr int N_IN_ = 16 * (NPROJ / 32), N_BR = 8 * 32, N_OUT = 16 * 32, N_13 = 16 * (5632 / 32), N_2 = 44 * 32, N_GLU = 8 * 16;
    { const SrcWin s_in{C->in[I_WIN] + (size_t)layer * 1024 * IN_COLS, NPROJ, IN_COLS};
      for (int it = gw; it < N_IN_; it += ngw) transpose_item(s_in, 1024, WSP(bf16, WS_WIN + wo), scr, it, lane); }
    for (int it = gw; it < 4 * N_BR; it += ngw) { const int n = it / N_BR; const SrcPlain s_b{C->in[I_WBR] + ((size_t)layer * 4 + n) * 512 * 1024, 1024, 1024};
        transpose_item(s_b, 512, WSP(bf16, WS_WB + wo) + (size_t)n * 1024 * 512, scr, it % N_BR, lane); }
    { const SrcPlain s_out{C->in[I_WOUT] + (size_t)layer * 1024 * 1024, 1024, 1024};
      for (int it = gw; it < N_OUT; it += ngw) transpose_item(s_out, 1024, WSP(bf16, WS_WOUT + wo), scr, it, lane); }
    { const SrcW13 s_13{C->in[I_W1] + (size_t)layer * 1024 * FFN, C->in[I_W3] + (size_t)layer * 1024 * FFN, 5632, FFN};
      for (int it = gw; it < N_13; it += ngw) transpose_item(s_13, 1024, WSP(bf16, WS_W13 + wo), scr, it, lane); }
    { const SrcPlain s_2{C->in[I_W2F] + (size_t)layer * FFN * 1024, 1024, 1024};
      for (int it = gw; it < N_2; it += ngw) transpose_item(s_2, FFN, WSP(bf16, WS_W2 + wo), scr, it, lane); }
    { const SrcPlain s_glu{C->in[I_GLUW] + (size_t)layer * 512 * 512, 512, 512};
      for (int it = gw; it < N_GLU; it += ngw) transpose_item(s_glu, 512, WSP(bf16, WS_GLU + wo), scr, it, lane); }
    { const float* w2 = C->in[I_W2] + (size_t)layer * 64 * 512; const float* a2 = C->in[I_A2] + (size_t)layer * 64 * 512; const float* g2 = C->in[I_G2] + (size_t)layer * 128 * 512;
      bf16* WL = WSP(bf16, WS_WLORA + wo);
      for (int e = gw * 64 + lane; e < 1536 * 256; e += ngw * 64) { const int n = e >> 8, kc = e & 255; float v = 0.f;
          if (n < 512) { if (kc < 64) v = w2[kc * 512 + n]; } else if (n < 1024) { if (kc >= 64 && kc < 128) v = a2[(kc - 64) * 512 + (n - 512)]; } else { if (kc >= 128) v = g2[(kc - 128) * 512 + (n - 1024)]; }
          WL[e] = f2bf(v); } }
    const int gt = gw * 64 + lane, ngt = ngw * 64;
    for (int e = gt; e < 32 * 64; e += ngt) {
        const int g = e >> 6;
        const float ar = C->in[I_S5ARE][layer * 2048 + e], ai = C->in[I_S5AIM][layer * 2048 + e], dt = expf(C->in[I_S5LDT][layer * 32 + g]);
        const float mag = expf(ar * dt), abr = mag * cosf(ai * dt), abi = mag * sinf(ai * dt);
        const float den = ar * ar + ai * ai, nr = abr - 1.0f, ni = abi;
        const float qr = (nr * ar + ni * ai) / den, qi = (ni * ar - nr * ai) / den;
        float* ab = WSP(float, WS_ABAR + wo) + e * 2; ab[0] = abr; ab[1] = abi;
        float* bb = WSP(float, WS_BBAR + wo) + (size_t)e * 32;
        for (int j = 0; j < 16; ++j) { const float br = C->in[I_S5BRE][((size_t)layer * 2048 + e) * 16 + j], bi = C->in[I_S5BIM][((size_t)layer * 2048 + e) * 16 + j];
            bb[2 * j] = qr * br - qi * bi; bb[2 * j + 1] = qr * bi + qi * br; }
    }
    if (layer == 0) for (int e = gt; e < SEQ + 63; e += ngt) {
        const int rel = e - (SEQ - 1); const int n = rel < 0 ? -rel : rel; int b = rel > 0 ? 16 : 0;
        if (n < 8) b += n; else { int lg = 8 + (int)(logf((float)n / 8.0f) / 3.4657359028f * 8.0f); if (lg > 15) lg = 15; b += lg; }
        WSP(int, WS_TAB)[e] = b;
    }
}

__device__ __forceinline__ void rms_row_bf16(const float* xrow, const float* g, bf16* orow, int lane) {
    const f32x4* xr = (const f32x4*)xrow + lane; const f32x4* gr = (const f32x4*)g + lane;
    f32x4 v[4]; float s = 0.f;
#pragma unroll
    for (int j = 0; j < 4; ++j) { v[j] = xr[64 * j]; s += (v[j].x * v[j].x + v[j].y * v[j].y) + (v[j].z * v[j].z + v[j].w * v[j].w); }
    const float rstd = 1.0f / sqrtf(wave_sum(s) * (1.f / D) + RMS_EPS);
    u32x2* o8 = (u32x2*)orow + lane;
#pragma unroll
    for (int j = 0; j < 4; ++j) { const f32x4 gg = gr[64 * j]; u32x2 w; w.x = pk2(v[j].x * rstd * gg.x, v[j].y * rstd * gg.y); w.y = pk2(v[j].z * rstd * gg.z, v[j].w * rstd * gg.w); o8[64 * j] = w; }
}
template <int NR>
__device__ __forceinline__ void rms_rowN_bf16(const float* xrow, const float* g, bf16* orow, size_t step, int lane) {
    const f32x4* gr = (const f32x4*)g + lane; f32x4 v[NR][4]; float ss[NR];
#pragma unroll
    for (int q = 0; q < NR; ++q)
#pragma unroll
        for (int j = 0; j < 4; ++j) v[q][j] = ((const f32x4*)(xrow + q * step) + lane)[64 * j];
#pragma unroll
    for (int q = 0; q < NR; ++q) { float s = 0.f;
#pragma unroll
        for (int j = 0; j < 4; ++j) s += (v[q][j].x * v[q][j].x + v[q][j].y * v[q][j].y) + (v[q][j].z * v[q][j].z + v[q][j].w * v[q][j].w);
        ss[q] = s; }
#pragma unroll
    for (int o = 1; o < 64; o <<= 1)
#pragma unroll
        for (int q = 0; q < NR; ++q) ss[q] += __shfl_xor(ss[q], o);
#pragma unroll
    for (int q = 0; q < NR; ++q) { const float r = 1.0f / sqrtf(ss[q] * (1.f / D) + RMS_EPS); u32x2* o8 = (u32x2*)(orow + q * step) + lane;
#pragma unroll
        for (int j = 0; j < 4; ++j) { const f32x4 gg = gr[64 * j]; u32x2 w; w.x = pk2(v[q][j].x * r * gg.x, v[q][j].y * r * gg.y); w.y = pk2(v[q][j].z * r * gg.z, v[q][j].w * r * gg.w); o8[64 * j] = w; } }
}
__device__ __forceinline__ void rms_row_f32(float* xrow, const float* g, int lane) {
    f32x4* xr = (f32x4*)xrow + lane; const f32x4* gr = (const f32x4*)g + lane;
    f32x4 v[4]; float s = 0.f;
#pragma unroll
    for (int j = 0; j < 4; ++j) { v[j] = xr[64 * j]; s += (v[j].x * v[j].x + v[j].y * v[j].y) + (v[j].z * v[j].z + v[j].w * v[j].w); }
    const float rstd = 1.0f / sqrtf(wave_sum(s) * (1.f / D) + RMS_EPS);
#pragma unroll
    for (int j = 0; j < 4; ++j) xr[64 * j] = v[j] * rstd * gr[64 * j];
}

#ifdef HOST_EMU
__device__ __forceinline__ float red8(float v) { v += __shfl_xor(v, 1); v += __shfl_xor(v, 2); v += __shfl_xor(v, 4); return v; }
__device__ __forceinline__ float red16(float v) { v = red8(v); v += __shfl_xor(v, 8); return v; }
#else
template <int CTRL> __device__ __forceinline__ float dpp_f(float v) { return __builtin_bit_cast(float, __builtin_amdgcn_update_dpp(0, __builtin_bit_cast(int, v), CTRL, 0xf, 0xf, true)); }
__device__ __forceinline__ float red8(float v) { v += dpp_f<0xB1>(v); v += dpp_f<0x4E>(v); v += dpp_f<0x141>(v); return v; }
__device__ __forceinline__ float red16(float v) { v = red8(v); v += dpp_f<0x140>(v); return v; }
#endif
__device__ __forceinline__ f32x4 sig4g(const f32x4 v) { return (f32x4){sigm(v[0]), sigm(v[1]), sigm(v[2]), sigm(v[3])}; }
__device__ __forceinline__ void rms_row2_f32(float* xrow, size_t step, const float* g, int lane) {
    f32x4* xa = (f32x4*)xrow + lane; f32x4* xb = (f32x4*)(xrow + step) + lane; const f32x4* gr = (const f32x4*)g + lane;
    f32x4 va[4], vb[4]; float sa = 0.f, sb = 0.f;
#pragma unroll
    for (int j = 0; j < 4; ++j) { va[j] = xa[64 * j]; vb[j] = xb[64 * j]; }
#pragma unroll
    for (int j = 0; j < 4; ++j) { sa += (va[j].x * va[j].x + va[j].y * va[j].y) + (va[j].z * va[j].z + va[j].w * va[j].w); sb += (vb[j].x * vb[j].x + vb[j].y * vb[j].y) + (vb[j].z * vb[j].z + vb[j].w * vb[j].w); }
#pragma unroll
    for (int o = 1; o < 64; o <<= 1) { sa += __shfl_xor(sa, o); sb += __shfl_xor(sb, o); }
    const float ra = 1.0f / sqrtf(sa * (1.f / D) + RMS_EPS), rb = 1.0f / sqrtf(sb * (1.f / D) + RMS_EPS);
#pragma unroll
    for (int j = 0; j < 4; ++j) { const f32x4 gg = gr[64 * j]; xa[64 * j] = va[j] * ra * gg; xb[64 * j] = vb[j] * rb * gg; }
}
__device__ __forceinline__ void ssd_conv_row(KArgs C, int layer, int m, int lane) {
    const int t = m % SEQ; const float* cw = C->in[I_CONVW] + layer * 4 * 768; const float* cb = C->in[I_CONVB] + layer * 768;
#pragma unroll
    for (int i = 0; i < 3; ++i) { const int ch = i * 256 + lane * 4; const bf16* p = WSP(const bf16, WS_XBC) + (size_t)m * 768 + ch;
        f32x4 a = *(const f32x4*)(cb + ch);
#pragma unroll
        for (int q = 0; q < 4; ++q) if (t - 3 + q >= 0) { const u32x2 w = *(const u32x2*)(p - (3 - q) * 768); const f32x4 cq = *(const f32x4*)(cw + q * 768 + ch);
            a += cq * (f32x4){lo_bf(w.x), hi_bf(w.x), lo_bf(w.y), hi_bf(w.y)}; }
        a = a * sig4g(a);
        u32x2 o; o.x = pk2(a.x, a.y); o.y = pk2(a.z, a.w); *(u32x2*)(WSP(bf16, WS_XBA) + (size_t)m * 768 + ch) = o; }
}
__device__ __forceinline__ void ssd_conv_row2(KArgs C, int layer, int m, int step, int lane) {
    const float* cw = C->in[I_CONVW] + layer * 4 * 768; const float* cb = C->in[I_CONVB] + layer * 768;
    u32x2 w[2][3][4]; f32x4 cq[3][4], bb[3];
#pragma unroll
    for (int i = 0; i < 3; ++i) { const int ch = i * 256 + lane * 4; bb[i] = *(const f32x4*)(cb + ch);
#pragma unroll
        for (int q = 0; q < 4; ++q) { cq[i][q] = *(const f32x4*)(cw + q * 768 + ch);
#pragma unroll
            for (int r = 0; r < 2; ++r) { const int mm = m + r * step, t = mm % SEQ; const bf16* p = WSP(const bf16, WS_XBC) + (size_t)mm * 768 + ch;
                if (t - 3 + q >= 0) w[r][i][q] = *(const u32x2*)(p - (3 - q) * 768); else { w[r][i][q].x = 0u; w[r][i][q].y = 0u; } } } }
#pragma unroll
    for (int r = 0; r < 2; ++r)
#pragma unroll
        for (int i = 0; i < 3; ++i) { const int ch = i * 256 + lane * 4; f32x4 a = bb[i];
#pragma unroll
            for (int q = 0; q < 4; ++q) a += cq[i][q] * (f32x4){lo_bf(w[r][i][q].x), hi_bf(w[r][i][q].x), lo_bf(w[r][i][q].y), hi_bf(w[r][i][q].y)};
            a = a * sig4g(a);
            u32x2 o; o.x = pk2(a.x, a.y); o.y = pk2(a.z, a.w); *(u32x2*)(WSP(bf16, WS_XBA) + (size_t)(m + r * step) * 768 + ch) = o; }
}
__device__ __forceinline__ void ssd_unit(KArgs C, int layer, int unit, unsigned char* lds) {
    const int tid = fresh_tid(), lane = tid & 63, wave = tid >> 6, bl = unit >> 3, h = unit & 7, gi = h >> 2, pp = tid >> 3, c8 = (tid & 7) * 8, c16 = lane & 15, q = lane >> 4;
    bf16* Cb = (bf16*)lds; bf16* Bb = Cb + 4096; bf16* XT = Bb + 4096; bf16* BwT = XT + 4096; bf16* Pm = BwT + 4096; float* Yo = (float*)(Pm + 4096); float* dts = Yo + 8192; float* acs = dts + 128;
    const bf16* XA = WSP(const bf16, WS_XBA) + (size_t)bl * SEQ * 768 + (size_t)pp * 768 + c8;
    const bf16* SMp = WSP(const bf16, WS_SM) + (size_t)bl * SEQ * 256;
    const bf16* Zp = WSP(const bf16, WS_Z) + (size_t)bl * SEQ * 512 + (size_t)pp * 512 + h * 64 + c8;
    bf16* YA = WSP(bf16, WS_Y) + (size_t)bl * SEQ * 512 + (size_t)pp * 512 + h * 64 + c8;
    const float dtb = C->in[I_DTB][layer * 8 + h], A = -__expf(C->in[I_ALOG][layer * 8 + h]), Dh = C->in[I_SSDD][layer * 8 + h];
    f32x4_t Sd[2]; bf16x8_t Sf; Sd[0] = (f32x4_t){0.f, 0.f, 0.f, 0.f}; Sd[1] = Sd[0]; { u32x2 z; z.x = 0u; z.y = 0u; Sf = frag2(z, z); }
    const int pt = wave & 3, nh = wave >> 2;
    u32x4 fx, fb, fc, fz;
#define SSD_FETCH(c0_) do { const bf16* q_ = XA + (size_t)(c0_) * 768; fx = *(const u32x4*)(q_ + h * 64); fb = *(const u32x4*)(q_ + 512 + gi * 64); fc = *(const u32x4*)(q_ + 640 + gi * 64); fz = *(const u32x4*)(Zp + (size_t)(c0_) * 512); } while (0)
#define SSD_DT(c0_, par) do { if (wave == 0) { const float dt_ = softplusf(bf2f(SMp[(size_t)((c0_) + lane) * 256 + h]) + dtb); float a_ = A * dt_; \
        _Pragma("unroll") for (int o_ = 1; o_ < 64; o_ <<= 1) { const float t_ = __shfl_up(a_, o_); if (lane >= o_) a_ += t_; } dts[(par) * 64 + lane] = dt_; acs[(par) * 64 + lane] = a_; } } while (0)
    LDS_SYNC();
    SSD_FETCH(0); SSD_DT(0, 0);
    for (int c0 = 0, par = 0; c0 < SEQ; c0 += 64, par ^= 1) {
        LDS_SYNC();
        const u32x4 xk = fx, zk = fz;
        {
          const float dt = dts[par * 64 + pp], ea = __expf(acs[par * 64 + 63] - acs[par * 64 + pp]);
          *(u32x4*)(Cb + pp * 64 + c8) = fc; *(u32x4*)(Bb + pp * 64 + c8) = fb;
          f32x4 x0, x1, b0, b1; pg8::unpack8(fx, x0, x1); pg8::unpack8(fb, b0, b1); x0 = x0 * dt; x1 = x1 * dt; b0 = b0 * ea; b1 = b1 * ea;
#pragma unroll
          for (int i = 0; i < 4; ++i) { XT[(c8 + i) * 64 + pp] = f2bf(x0[i]); XT[(c8 + 4 + i) * 64 + pp] = f2bf(x1[i]); BwT[(c8 + i) * 64 + pp] = f2bf(b0[i]); BwT[(c8 + 4 + i) * 64 + pp] = f2bf(b1[i]); } }
        if (c0 + 64 < SEQ) { SSD_FETCH(c0 + 64); SSD_DT(c0 + 64, par ^ 1); }
        LDS_SYNC();
        {
          const f32x4_t z4 = {0.f, 0.f, 0.f, 0.f};
#pragma unroll
          for (int i = 0; i < 2; ++i) { const int id = wave + 8 * i, lt = id >> 2, st = id & 3; f32x4_t g = z4;
              if (st <= lt) {
#pragma unroll
                  for (int ks = 0; ks < 2; ++ks) g = __builtin_amdgcn_mfma_f32_16x16x32_bf16(*(const bf16x8_t*)(Cb + (16 * lt + c16) * 64 + 32 * ks + 8 * q), *(const bf16x8_t*)(Bb + (16 * st + c16) * 64 + 32 * ks + 8 * q), g, 0, 0, 0);
                  const float as_ = acs[par * 64 + 16 * st + c16];
#pragma unroll
                  for (int r = 0; r < 4; ++r) { const int l = 16 * lt + 4 * q + r; g[r] = (16 * st + c16 <= l) ? g[r] * __expf(acs[par * 64 + l] - as_) : 0.f; } }
#pragma unroll
              for (int r = 0; r < 4; ++r) Pm[(16 * lt + 4 * q + r) * 64 + 16 * st + c16] = f2bf(g[r]); }
#pragma unroll
          for (int lt = 0; lt < 4; ++lt) { const bf16* cr = Cb + (16 * lt + c16) * 64 + 32 * nh + 4 * q;
              const f32x4_t yo = __builtin_amdgcn_mfma_f32_16x16x32_bf16(frag2(*(const u32x2*)cr, *(const u32x2*)(cr + 16)), Sf, z4, 0, 0, 0);
#pragma unroll
              for (int r = 0; r < 4; ++r) Yo[nh * 4096 + (16 * lt + 4 * q + r) * 64 + 16 * pt + c16] = yo[r]; }
          const float eL = __expf(acs[par * 64 + 63]);
          const bf16x8_t xb0 = *(const bf16x8_t*)(XT + (16 * pt + c16) * 64 + 8 * q), xb1 = *(const bf16x8_t*)(XT + (16 * pt + c16) * 64 + 32 + 8 * q);
#pragma unroll
          for (int i = 0; i < 2; ++i) { const bf16* br = BwT + (16 * (2 * nh + i) + c16) * 64 + 8 * q; f32x4_t cin = Sd[i] * eL;
              cin = __builtin_amdgcn_mfma_f32_16x16x32_bf16(*(const bf16x8_t*)br, xb0, cin, 0, 0, 0); Sd[i] = __builtin_amdgcn_mfma_f32_16x16x32_bf16(*(const bf16x8_t*)(br + 32), xb1, cin, 0, 0, 0); }
          u32x2 lo, hi; lo.x = pk2(Sd[0][0], Sd[0][1]); lo.y = pk2(Sd[0][2], Sd[0][3]); hi.x = pk2(Sd[1][0], Sd[1][1]); hi.y = pk2(Sd[1][2], Sd[1][3]); Sf = frag2(lo, hi); }
        LDS_SYNC();
        {
          const f32x4_t z4 = {0.f, 0.f, 0.f, 0.f};
#pragma unroll
          for (int i = 0; i < 2; ++i) { const int id = wave + 8 * i, lt = id >> 2, p2 = id & 3;
              f32x4_t y = __builtin_amdgcn_mfma_f32_16x16x32_bf16(*(const bf16x8_t*)(Pm + (16 * lt + c16) * 64 + 8 * q), *(const bf16x8_t*)(XT + (16 * p2 + c16) * 64 + 8 * q), z4, 0, 0, 0);
              if (lt >= 2) y = __builtin_amdgcn_mfma_f32_16x16x32_bf16(*(const bf16x8_t*)(Pm + (16 * lt + c16) * 64 + 32 + 8 * q), *(const bf16x8_t*)(XT + (16 * p2 + c16) * 64 + 32 + 8 * q), y, 0, 0, 0);
#pragma unroll
              for (int r = 0; r < 4; ++r) { const int l = 16 * lt + 4 * q + r, o = l * 64 + 16 * p2 + c16; Yo[o] = y[r] + __expf(acs[par * 64 + l]) * (Yo[o] + Yo[4096 + o]); } } }
        LDS_SYNC();
        {
          f32x4 x0, x1, z0, z1; pg8::unpack8(xk, x0, x1); pg8::unpack8(zk, z0, z1);
          const f32x4 y0 = (*(const f32x4*)(Yo + pp * 64 + c8) + Dh * x0) * z0 * sig4g(z0), y1 = (*(const f32x4*)(Yo + pp * 64 + c8 + 4) + Dh * x1) * z1 * sig4g(z1);
          *(u32x4*)(YA + (size_t)c0 * 512) = pg8::pack8(y0, y1); }
    }
#undef SSD_FETCH
#undef SSD_DT
}
__device__ __forceinline__ void ssd_norm_item4(KArgs C, int layer, int item0, int stride, int nitems, int lane) {
    u32x2 w[4]; bf16* p[4];
#pragma unroll
    for (int q = 0; q < 4; ++q) { const int item = item0 + q * stride; p[q] = WSP(bf16, WS_Y) + (size_t)((item < nitems ? item : item0) >> 1) * 512 + ((item < nitems ? item : item0) & 1) * 256 + lane * 4; w[q] = *(const u32x2*)p[q]; }
#pragma unroll
    for (int q = 0; q < 4; ++q) { const int item = item0 + q * stride; if (item < nitems) {
        float v[4] = {lo_bf(w[q].x), hi_bf(w[q].x), lo_bf(w[q].y), hi_bf(w[q].y)};
        const float rstd = 1.0f / sqrtf(wave_sum(v[0] * v[0] + v[1] * v[1] + v[2] * v[2] + v[3] * v[3]) * (1.f / 256) + RMS_EPS);
        const float* g = C->in[I_SSDNG] + layer * 512 + (item & 1) * 256 + lane * 4;
        u32x2 o; o.x = pk2(v[0] * rstd * g[0], v[1] * rstd * g[1]); o.y = pk2(v[2] * rstd * g[2], v[3] * rstd * g[3]); *(u32x2*)p[q] = o; } }
}
__device__ __forceinline__ void rwkv_prep_row(KArgs C, int layer, int m, int lane) {
    const int t = m % SEQ, col = 1536 + lane * 4;
    const bf16* cur = WSP(const bf16, WS_RW) + (size_t)m * 1792 + col;
    const u32x2 wc = *(const u32x2*)cur; u32x2 wp; wp.x = 0u; wp.y = 0u; if (t > 0) wp = *(const u32x2*)(cur - 1792);
    const f32x4 mu = *(const f32x4*)(C->in[I_MU] + layer * 1792 + col);
    float v[4] = {lo_bf(wc.x), hi_bf(wc.x), lo_bf(wc.y), hi_bf(wc.y)}; const float p[4] = {lo_bf(wp.x), hi_bf(wp.x), lo_bf(wp.y), hi_bf(wp.y)};
#pragma unroll
    for (int i = 0; i < 4; ++i) { v[i] = v[i] + (p[i] - v[i]) * mu[i]; v[i] = lane < 16 ? tanh_fast(v[i]) : (lane < 32 ? v[i] : sigm(v[i])); }
    u32x2 o; o.x = pk2(v[0], v[1]); o.y = pk2(v[2], v[3]); *(u32x2*)(WSP(bf16, WS_RA) + (size_t)m * 256 + lane * 4) = o;
}
__device__ __forceinline__ void rwkv_prep_row2(KArgs C, int layer, int m, int step, int lane) {
    const int col = 1536 + lane * 4; const f32x4 mu = *(const f32x4*)(C->in[I_MU] + layer * 1792 + col);
    u32x2 wc[2], wp[2];
#pragma unroll
    for (int r = 0; r < 2; ++r) { const int mm = m + r * step; const bf16* cur = WSP(const bf16, WS_RW) + (size_t)mm * 1792 + col; wc[r] = *(const u32x2*)cur;
        if (mm % SEQ > 0) wp[r] = *(const u32x2*)(cur - 1792); else { wp[r].x = 0u; wp[r].y = 0u; } }
#pragma unroll
    for (int r = 0; r < 2; ++r) { float v[4] = {lo_bf(wc[r].x), hi_bf(wc[r].x), lo_bf(wc[r].y), hi_bf(wc[r].y)}; const float p[4] = {lo_bf(wp[r].x), hi_bf(wp[r].x), lo_bf(wp[r].y), hi_bf(wp[r].y)};
#pragma unroll
        for (int i = 0; i < 4; ++i) { v[i] = v[i] + (p[i] - v[i]) * mu[i]; v[i] = lane < 16 ? tanh_fast(v[i]) : (lane < 32 ? v[i] : sigm(v[i])); }
        u32x2 o; o.x = pk2(v[0], v[1]); o.y = pk2(v[2], v[3]); *(u32x2*)(WSP(bf16, WS_RA) + (size_t)(m + r * step) * 256 + lane * 4) = o; }
}
__device__ __forceinline__ void rwkv_unit(KArgs C, int layer, int unit, unsigned char* lds) {
    constexpr int SLOT = 16704, O_RT = 2048, O_BTL = 4096, O_KTL = 6144, O_BHT = 8192, O_KHT = 10240, O_VT = 12288, O_TM = 14336, O_AAK = 14848, O_RB = 15360, O_RK = 15872, O_DL = 16384, O_BON = 16640;
    const int tid = fresh_tid(), lane = tid & 63, wave = tid >> 6, bl = unit >> 3, h = unit & 7, pt = tid >> 3, k8 = (tid & 7) * 8, cc = pt >> 4, tl = pt & 15, hc = h * 64 + k8;
    float* WL = (float*)(lds + 4 * SLOT); float* Nf = WL + 4096; float* Yb = Nf + 1024; float* ct_ = Yb + 4096;
    const bf16* RW = WSP(const bf16, WS_RW) + (size_t)bl * SEQ * 1792 + hc;
    const float* WLG = WSP(const float, WS_WLOG) + (size_t)bl * SEQ * 512 + hc;
    const bf16* AS = WSP(const bf16, WS_ASIG) + (size_t)bl * SEQ * 512 + hc;
    const bf16* GG = WSP(const bf16, WS_GG) + (size_t)bl * SEQ * 512 + hc;
    bf16* YC = WSP(bf16, WS_Y) + (size_t)2 * MG * 512 + (size_t)bl * SEQ * 512 + hc;
    LDS_SYNC();
    { const int row = tid >> 6, j = tid & 63; const float* src = row == 0 ? C->in[I_MU] + layer * 1792 : row == 1 ? C->in[I_MU] + layer * 1792 + 512 : row == 2 ? C->in[I_MU] + layer * 1792 + 1024
          : row == 3 ? C->in[I_KK] + layer * 512 : row == 4 ? C->in[I_KA] + layer * 512 : row == 5 ? C->in[I_RK] + layer * 512 : row == 6 ? C->in[I_LNG] + layer * 512 : C->in[I_LNB] + layer * 512;
      ct_[tid] = src[h * 64 + j]; }
    f32x4_t Sd[4]; bf16x8_t Sf[2];
#pragma unroll
    for (int i = 0; i < 4; ++i) Sd[i] = (f32x4_t){0.f, 0.f, 0.f, 0.f};
    { u32x2 z; z.x = 0u; z.y = 0u; Sf[0] = frag2(z, z); Sf[1] = Sf[0]; }
    u32x4 rc, rp, kc, kp, vc, vp, ac, gc; f32x4 wl0, wl1;
#define RWKV_FETCH(c0_) do { const int tt_ = (c0_) + pt; const bf16* q_ = RW + (size_t)tt_ * 1792; \
        rc = *(const u32x4*)q_; kc = *(const u32x4*)(q_ + 512); vc = *(const u32x4*)(q_ + 1024); \
        if (tt_ > 0) { rp = *(const u32x4*)(q_ - 1792); kp = *(const u32x4*)(q_ - 1792 + 512); vp = *(const u32x4*)(q_ - 1792 + 1024); } else { rp = (u32x4){0u, 0u, 0u, 0u}; kp = rp; vp = rp; } \
        wl0 = *(const f32x4*)(WLG + (size_t)tt_ * 512); wl1 = *(const f32x4*)(WLG + (size_t)tt_ * 512 + 4); ac = *(const u32x4*)(AS + (size_t)tt_ * 512); gc = *(const u32x4*)(GG + (size_t)tt_ * 512); } while (0)
    RWKV_FETCH(0);
    for (int c0 = 0; c0 < SEQ; c0 += 64) {
        unsigned char* slot = lds + cc * SLOT;
        LDS_SYNC();
        f32x4 r0, r1, kq0, kq1, v0, v1, kk0, kk1, b0, b1; const u32x4 gkeep = gc; const f32x4 wk0 = wl0, wk1 = wl1;
        { f32x4 c0_, c1_, p0_, p1_, a0, a1;
          pg8::unpack8(rc, c0_, c1_); pg8::unpack8(rp, p0_, p1_); r0 = c0_ + (p0_ - c0_) * *(const f32x4*)(ct_ + k8); r1 = c1_ + (p1_ - c1_) * *(const f32x4*)(ct_ + k8 + 4);
          pg8::unpack8(kc, c0_, c1_); pg8::unpack8(kp, p0_, p1_); const f32x4 k00 = c0_ + (p0_ - c0_) * *(const f32x4*)(ct_ + 64 + k8), k01 = c1_ + (p1_ - c1_) * *(const f32x4*)(ct_ + 64 + k8 + 4);
          pg8::unpack8(vc, c0_, c1_); pg8::unpack8(vp, p0_, p1_); v0 = c0_ + (p0_ - c0_) * *(const f32x4*)(ct_ + 128 + k8); v1 = c1_ + (p1_ - c1_) * *(const f32x4*)(ct_ + 128 + k8 + 4);
          pg8::unpack8(ac, a0, a1);
          kk0 = k00 * *(const f32x4*)(ct_ + 192 + k8); kk1 = k01 * *(const f32x4*)(ct_ + 192 + k8 + 4);
          const float inv = 1.0f / fmaxf(sqrtf(red8((kk0.x * kk0.x + kk0.y * kk0.y + kk0.z * kk0.z + kk0.w * kk0.w) + (kk1.x * kk1.x + kk1.y * kk1.y + kk1.z * kk1.z + kk1.w * kk1.w))), 1e-12f);
          kk0 = kk0 * inv; kk1 = kk1 * inv; b0 = kk0 * a0; b1 = kk1 * a1;
          kq0 = k00 * (1.0f + (a0 - 1.0f) * *(const f32x4*)(ct_ + 256 + k8)); kq1 = k01 * (1.0f + (a1 - 1.0f) * *(const f32x4*)(ct_ + 256 + k8 + 4));
          const f32x4 q0 = r0 * kq0 * *(const f32x4*)(ct_ + 320 + k8), q1 = r1 * kq1 * *(const f32x4*)(ct_ + 320 + k8 + 4);
          const float bo = red8((q0.x + q0.y + q0.z + q0.w) + (q1.x + q1.y + q1.z + q1.w));
          if ((tid & 7) == 0) ((float*)(slot + O_BON))[tl] = bo;
          *(f32x4*)(WL + pt * 64 + k8) = wk0; *(f32x4*)(WL + pt * 64 + k8 + 4) = wk1; }
        if (c0 + 64 < SEQ) RWKV_FETCH(c0 + 64);
        LDS_SYNC();
        if (tid < 256) { const int c_ = tid >> 6, k_ = tid & 63; float w16[16], run = 0.f;
#pragma unroll
            for (int t = 0; t < 16; ++t) w16[t] = WL[(c_ * 16 + t) * 64 + k_];
#pragma unroll
            for (int t = 0; t < 16; ++t) { run += w16[t]; WL[(c_ * 16 + t) * 64 + k_] = run; }
            ((float*)(lds + c_ * SLOT + O_DL))[k_] = __expf(run); }
        LDS_SYNC();
        { const f32x4 cs0 = *(const f32x4*)(WL + pt * 64 + k8), cs1 = *(const f32x4*)(WL + pt * 64 + k8 + 4), d0 = *(const f32x4*)((const float*)(slot + O_DL) + k8), d1 = *(const f32x4*)((const float*)(slot + O_DL) + k8 + 4);
          f32x4 e0, e1, f0, f1, w0, w1;
#pragma unroll
          for (int i = 0; i < 4; ++i) { e0[i] = __expf(cs0[i]); e1[i] = __expf(cs1[i]); f0[i] = __builtin_amdgcn_rcpf(e0[i]); f1[i] = __builtin_amdgcn_rcpf(e1[i]); w0[i] = __expf(-wk0[i]); w1[i] = __expf(-wk1[i]); }
          const f32x4 bt0 = b0 * f0, bt1 = b1 * f1, kt0 = kq0 * f0, kt1 = kq1 * f1;
          *(u32x4*)((bf16*)slot + tl * 64 + k8) = pg8::pack8(-(kk0 * e0 * w0), -(kk1 * e1 * w1));
          *(u32x4*)((bf16*)(slot + O_RT) + tl * 64 + k8) = pg8::pack8(r0 * e0, r1 * e1);
          *(u32x4*)((bf16*)(slot + O_BTL) + tl * 64 + k8) = pg8::pack8(bt0, bt1);
          *(u32x4*)((bf16*)(slot + O_KTL) + tl * 64 + k8) = pg8::pack8(kt0, kt1);
          const f32x4 bh0 = bt0 * d0, bh1 = bt1 * d1, kh0 = kt0 * d0, kh1 = kt1 * d1;
          bf16* bht = (bf16*)(slot + O_BHT) + k8 * 16 + tl; bf16* kht = (bf16*)(slot + O_KHT) + k8 * 16 + tl; bf16* vt = (bf16*)(slot + O_VT) + k8 * 16 + tl;
#pragma unroll
          for (int i = 0; i < 4; ++i) { bht[i * 16] = f2bf(bh0[i]); bht[(i + 4) * 16] = f2bf(bh1[i]); kht[i * 16] = f2bf(kh0[i]); kht[(i + 4) * 16] = f2bf(kh1[i]); vt[i * 16] = f2bf(v0[i]); vt[(i + 4) * 16] = f2bf(v1[i]); } }
        LDS_SYNC();
        { unsigned char* sl = lds + (wave & 3) * SLOT; const int c16 = lane & 15, q = lane >> 4;
          const bf16x8_t a0 = *(const bf16x8_t*)((const bf16*)sl + c16 * 64 + 8 * q), a1 = *(const bf16x8_t*)((const bf16*)sl + c16 * 64 + 32 + 8 * q);
          const bf16x8_t bb0 = *(const bf16x8_t*)((const bf16*)(sl + O_BTL) + c16 * 64 + 8 * q), bb1 = *(const bf16x8_t*)((const bf16*)(sl + O_BTL) + c16 * 64 + 32 + 8 * q);
          const f32x4_t z4 = {0.f, 0.f, 0.f, 0.f};
          if (wave < 4) {
              f32x4_t n = __builtin_amdgcn_mfma_f32_16x16x32_bf16(a0, bb0, z4, 0, 0, 0); n = __builtin_amdgcn_mfma_f32_16x16x32_bf16(a1, bb1, n, 0, 0, 0);
              float* nf = Nf + (wave & 3) * 256;
#pragma unroll
              for (int r = 0; r < 4; ++r) nf[c16 * 16 + 4 * q + r] = (c16 < 4 * q + r) ? n[r] : 0.f;
              WAVE_SYNC();
              float tc[16];
#pragma unroll
              for (int t = 0; t < 16; ++t) tc[t] = (t == c16) ? 1.f : 0.f;
#pragma unroll
              for (int s2 = 0; s2 < 15; ++s2) { const f32x4 n0 = *(const f32x4*)(nf + s2 * 16), n1 = *(const f32x4*)(nf + s2 * 16 + 4), n2 = *(const f32x4*)(nf + s2 * 16 + 8), n3 = *(const f32x4*)(nf + s2 * 16 + 12);
                  const float ts = tc[s2]; const float nn[16] = {n0.x, n0.y, n0.z, n0.w, n1.x, n1.y, n1.z, n1.w, n2.x, n2.y, n2.z, n2.w, n3.x, n3.y, n3.z, n3.w};
#pragma unroll
                  for (int t = 0; t < 16; ++t) if (t > s2) tc[t] += nn[t] * ts; }
              if (q == 0) { bf16* tm = (bf16*)(sl + O_TM) + c16;
#pragma unroll
                  for (int t = 0; t < 16; ++t) tm[t * 16] = f2bf(tc[t]); }
          } else {
              const bf16x8_t r0f = *(const bf16x8_t*)((const bf16*)(sl + O_RT) + c16 * 64 + 8 * q), r1f = *(const bf16x8_t*)((const bf16*)(sl + O_RT) + c16 * 64 + 32 + 8 * q);
              const bf16x8_t kb0 = *(const bf16x8_t*)((const bf16*)(sl + O_KTL) + c16 * 64 + 8 * q), kb1 = *(const bf16x8_t*)((const bf16*)(sl + O_KTL) + c16 * 64 + 32 + 8 * q);
              f32x4_t ak = __builtin_amdgcn_mfma_f32_16x16x32_bf16(a0, kb0, z4, 0, 0, 0); ak = __builtin_amdgcn_mfma_f32_16x16x32_bf16(a1, kb1, ak, 0, 0, 0);
              f32x4_t rb = __builtin_amdgcn_mfma_f32_16x16x32_bf16(r0f, bb0, z4, 0, 0, 0); rb = __builtin_amdgcn_mfma_f32_16x16x32_bf16(r1f, bb1, rb, 0, 0, 0);
              f32x4_t rk = __builtin_amdgcn_mfma_f32_16x16x32_bf16(r0f, kb0, z4, 0, 0, 0); rk = __builtin_amdgcn_mfma_f32_16x16x32_bf16(r1f, kb1, rk, 0, 0, 0);
#pragma unroll
              for (int r = 0; r < 4; ++r) { const int t = 4 * q + r;
                  ((bf16*)(sl + O_AAK))[t * 16 + c16] = f2bf(c16 < t ? ak[r] : 0.f); ((bf16*)(sl + O_RB))[t * 16 + c16] = f2bf(c16 <= t ? rb[r] : 0.f); ((bf16*)(sl + O_RK))[t * 16 + c16] = f2bf(c16 <= t ? rk[r] : 0.f); }
          } }
        LDS_SYNC();
        if (wave < 4) { const int c16 = lane & 15, q = lane >> 4, vcol = 16 * wave + c16; u32x2 zz; zz.x = 0u; zz.y = 0u; const f32x4_t z4 = {0.f, 0.f, 0.f, 0.f};
#pragma unroll
            for (int ch = 0; ch < 4; ++ch) { const unsigned char* sl = lds + ch * SLOT;
                const bf16* at = (const bf16*)sl + c16 * 64 + 4 * q; const bf16* rt = (const bf16*)(sl + O_RT) + c16 * 64 + 4 * q;
                const bf16x8_t af0 = frag2(*(const u32x2*)at, *(const u32x2*)(at + 16)), af1 = frag2(*(const u32x2*)(at + 32), *(const u32x2*)(at + 48));
                const bf16x8_t rf0 = frag2(*(const u32x2*)rt, *(const u32x2*)(rt + 16)), rf1 = frag2(*(const u32x2*)(rt + 32), *(const u32x2*)(rt + 48));
                const u32x2 vq = *(const u32x2*)((const bf16*)(sl + O_VT) + vcol * 16 + 4 * q);
                const u32x2 aq = *(const u32x2*)((const bf16*)(sl + O_AAK) + c16 * 16 + 4 * q), tq = *(const u32x2*)((const bf16*)(sl + O_TM) + c16 * 16 + 4 * q);
                const u32x2 rbq = *(const u32x2*)((const bf16*)(sl + O_RB) + c16 * 16 + 4 * q), rkq = *(const u32x2*)((const bf16*)(sl + O_RK) + c16 * 16 + 4 * q);
                f32x4_t rhs = __builtin_amdgcn_mfma_f32_16x16x32_bf16(frag2(zz, aq), frag2(zz, vq), z4, 0, 0, 0); rhs = __builtin_amdgcn_mfma_f32_16x16x32_bf16(af0, Sf[0], rhs, 0, 0, 0);
                { const f32x4_t r2 = __builtin_amdgcn_mfma_f32_16x16x32_bf16(af1, Sf[1], z4, 0, 0, 0); rhs = rhs + r2; }
                u32x2 rl; rl.x = pk2(rhs[0], rhs[1]); rl.y = pk2(rhs[2], rhs[3]);
                const f32x4_t U = __builtin_amdgcn_mfma_f32_16x16x32_bf16(frag2(tq, zz), frag2(rl, zz), z4, 0, 0, 0);
                u32x2 ul; ul.x = pk2(U[0], U[1]); ul.y = pk2(U[2], U[3]); const bf16x8_t uv = frag2(ul, vq);
                f32x4_t y = __builtin_amdgcn_mfma_f32_16x16x32_bf16(rf0, Sf[0], z4, 0, 0, 0); y = __builtin_amdgcn_mfma_f32_16x16x32_bf16(rf1, Sf[1], y, 0, 0, 0);
                y = __builtin_amdgcn_mfma_f32_16x16x32_bf16(frag2(rbq, rkq), uv, y, 0, 0, 0);
#pragma unroll
                for (int r = 0; r < 4; ++r) Yb[(ch * 16 + 4 * q + r) * 64 + vcol] = y[r];
#pragma unroll
                for (int kt = 0; kt < 4; ++kt) { const f32x4 dl = *(const f32x4*)((const float*)(sl + O_DL) + 16 * kt + 4 * q);
                    const u32x2 bq = *(const u32x2*)((const bf16*)(sl + O_BHT) + (16 * kt + c16) * 16 + 4 * q), kq = *(const u32x2*)((const bf16*)(sl + O_KHT) + (16 * kt + c16) * 16 + 4 * q);
                    const f32x4_t cin = {Sd[kt][0] * dl.x, Sd[kt][1] * dl.y, Sd[kt][2] * dl.z, Sd[kt][3] * dl.w};
                    Sd[kt] = __builtin_amdgcn_mfma_f32_16x16x32_bf16(frag2(bq, kq), uv, cin, 0, 0, 0); }
#pragma unroll
                for (int s2 = 0; s2 < 2; ++s2) { u32x2 lo, hi; lo.x = pk2(Sd[2 * s2][0], Sd[2 * s2][1]); lo.y = pk2(Sd[2 * s2][2], Sd[2 * s2][3]); hi.x = pk2(Sd[2 * s2 + 1][0], Sd[2 * s2 + 1][1]); hi.y = pk2(Sd[2 * s2 + 1][2], Sd[2 * s2 + 1][3]); Sf[s2] = frag2(lo, hi); }
            } }
        LDS_SYNC();
        { const f32x4 y0 = *(const f32x4*)(Yb + pt * 64 + k8), y1 = *(const f32x4*)(Yb + pt * 64 + k8 + 4);
          const float mean = red8((y0.x + y0.y + y0.z + y0.w) + (y1.x + y1.y + y1.z + y1.w)) * (1.f / 64); const f32x4 d0 = y0 - mean, d1 = y1 - mean;
          const float rstd = 1.0f / sqrtf(red8((d0.x * d0.x + d0.y * d0.y + d0.z * d0.z + d0.w * d0.w) + (d1.x * d1.x + d1.y * d1.y + d1.z * d1.z + d1.w * d1.w)) * (1.f / 64) + GN_EPS);
          const float bo = ((const float*)(slot + O_BON))[tl]; f32x4 g0, g1; pg8::unpack8(gkeep, g0, g1);
          const f32x4 o0 = (d0 * rstd * *(const f32x4*)(ct_ + 384 + k8) + *(const f32x4*)(ct_ + 448 + k8) + bo * v0) * g0, o1 = (d1 * rstd * *(const f32x4*)(ct_ + 384 + k8 + 4) + *(const f32x4*)(ct_ + 448 + k8 + 4) + bo * v1) * g1;
          *(u32x4*)(YC + (size_t)(c0 + pt) * 512) = pg8::pack8(o0, o1); }
    }
#undef RWKV_FETCH
}

__device__ __forceinline__ void s5_unit(KArgs C, int layer, int unit, unsigned char* lds) {
    const int tid = fresh_tid(), lane = tid & 63, wave = tid >> 6, bl = unit >> 5, g = unit & 31, c16 = lane & 15, q = lane >> 4, sg = wave & 3, th = wave >> 2, p = 16 * sg + c16;
    constexpr int SP = 136;
    float* us = (float*)lds; float* ends = us + 1024; bf16* St = (bf16*)(ends + 16 * 128);
    const bf16* U = WSP(const bf16, WS_U) + (size_t)bl * SEQ * 512 + g * 16;
    bf16* YD0 = WSP(bf16, WS_YD0) + (size_t)bl * SEQ * 512 + g * 16;
    const size_t wo = (layer & 1) ? WDELTA : 0;
    bf16x8_t bre, bim;
    { const float* bb = WSP(const float, WS_BBAR + wo) + ((size_t)g * 64 + p) * 32; u32x4 wr_, wi_;
      if (q < 2) { const float* b8 = bb + 16 * q; wr_.x = pk2(b8[0], b8[2]); wr_.y = pk2(b8[4], b8[6]); wr_.z = pk2(b8[8], b8[10]); wr_.w = pk2(b8[12], b8[14]);
                   wi_.x = pk2(b8[1], b8[3]); wi_.y = pk2(b8[5], b8[7]); wi_.z = pk2(b8[9], b8[11]); wi_.w = pk2(b8[13], b8[15]); }
      else { wr_ = (u32x4){0u, 0u, 0u, 0u}; wi_ = wr_; }
      bre = __builtin_bit_cast(bf16x8_t, wr_); bim = __builtin_bit_cast(bf16x8_t, wi_); }
    float apr[4], api[4];
    { const float ar = WSP(const float, WS_ABAR + wo)[(g * 64 + p) * 2], ai = WSP(const float, WS_ABAR + wo)[(g * 64 + p) * 2 + 1]; apr[0] = ar; api[0] = ai;
#pragma unroll
      for (int i = 1; i < 4; ++i) { apr[i] = apr[i - 1] * ar - api[i - 1] * ai; api[i] = apr[i - 1] * ai + api[i - 1] * ar; } }
    bf16x8_t cf[4];
    { const float* cre = C->in[I_S5CRE] + ((size_t)layer * 32 + g) * 1024 + c16 * 64; const float* cim = C->in[I_S5CIM] + ((size_t)layer * 32 + g) * 1024 + c16 * 64;
#pragma unroll
      for (int ks = 0; ks < 4; ++ks) { const int c0_ = 32 * ks + 8 * q; const float* src = c0_ < 64 ? cre + c0_ : cim + (c0_ - 64); const float sgn = c0_ < 64 ? 1.f : -1.f;
          u32x4 w; w.x = pk2(sgn * src[0], sgn * src[1]); w.y = pk2(sgn * src[2], sgn * src[3]); w.z = pk2(sgn * src[4], sgn * src[5]); w.w = pk2(sgn * src[6], sgn * src[7]); cf[ks] = __builtin_bit_cast(bf16x8_t, w); } }
    const float dj = C->in[I_S5D][layer * 512 + g * 16 + c16];
    float cr = 0.f, ci = 0.f;
    u32x2 fu; fu.x = 0u; fu.y = 0u;
#define S5_FETCH(c0_) do { if (tid < 256) fu = *(const u32x2*)(U + (size_t)((c0_) + (tid >> 2)) * 512 + (tid & 3) * 4); } while (0)
    S5_FETCH(0);
    for (int c0 = 0; c0 < SEQ; c0 += 64) {
        LDS_SYNC();
        if (tid < 256) *(f32x4*)(us + (tid >> 2) * 16 + (tid & 3) * 4) = (f32x4){lo_bf(fu.x), hi_bf(fu.x), lo_bf(fu.y), hi_bf(fu.y)};
        if (c0 + 64 < SEQ) S5_FETCH(c0 + 64);
        LDS_SYNC();
        float lr[2][4], li[2][4];
#pragma unroll
        for (int tt = 0; tt < 2; ++tt) { bf16x8_t af;
            if (q < 2) { const float* ur = us + (32 * th + 16 * tt + c16) * 16 + 8 * q; const f32x4 u0 = *(const f32x4*)ur, u1 = *(const f32x4*)(ur + 4);
                u32x4 w; w.x = pk2(u0.x, u0.y); w.y = pk2(u0.z, u0.w); w.z = pk2(u1.x, u1.y); w.w = pk2(u1.z, u1.w); af = __builtin_bit_cast(bf16x8_t, w); }
            else { const u32x4 z = {0u, 0u, 0u, 0u}; af = __builtin_bit_cast(bf16x8_t, z); }
            const f32x4_t z4 = {0.f, 0.f, 0.f, 0.f};
            const f32x4_t dre = __builtin_amdgcn_mfma_f32_16x16x32_bf16(af, bre, z4, 0, 0, 0), dim = __builtin_amdgcn_mfma_f32_16x16x32_bf16(af, bim, z4, 0, 0, 0);
            lr[tt][0] = dre[0]; li[tt][0] = dim[0];
#pragma unroll
            for (int r = 1; r < 4; ++r) { lr[tt][r] = apr[0] * lr[tt][r - 1] - api[0] * li[tt][r - 1] + dre[r]; li[tt][r] = apr[0] * li[tt][r - 1] + api[0] * lr[tt][r - 1] + dim[r]; }
            const int rho = (2 * th + tt) * 4 + q; ends[(rho * 64 + p) * 2] = lr[tt][3]; ends[(rho * 64 + p) * 2 + 1] = li[tt][3]; }
        LDS_SYNC();
        { float xr = cr, xi = ci; const int rho0 = (2 * th) * 4 + q;
          for (int rr = 0; rr < 16; ++rr) {
              if (rr == rho0 || rr == rho0 + 4) { const int tt = (rr == rho0) ? 0 : 1;
#pragma unroll
                  for (int r = 0; r < 4; ++r) { const float sr = lr[tt][r] + apr[r] * xr - api[r] * xi, si = li[tt][r] + apr[r] * xi + api[r] * xr; const int t = 32 * th + 16 * tt + 4 * q + r;
                      St[t * SP + p] = f2bf(sr); St[t * SP + 64 + p] = f2bf(si); } }
              const float er = ends[(rr * 64 + p) * 2], ei = ends[(rr * 64 + p) * 2 + 1]; const float nr = apr[3] * xr - api[3] * xi + er, ni = apr[3] * xi + api[3] * xr + ei; xr = nr; xi = ni; }
          cr = xr; ci = xi; }
        LDS_SYNC();
        if (wave < 4) { f32x4_t y = {0.f, 0.f, 0.f, 0.f};
#pragma unroll
            for (int ks = 0; ks < 4; ++ks) y = __builtin_amdgcn_mfma_f32_16x16x32_bf16(*(const bf16x8_t*)(St + (16 * wave + c16) * SP + 32 * ks + 8 * q), cf[ks], y, 0, 0, 0);
#pragma unroll
            for (int r = 0; r < 4; ++r) { const int t = 16 * wave + 4 * q + r; YD0[(size_t)(c0 + t) * 512 + c16] = f2bf(gelu_tanh(y[r] + dj * us[t * 16 + c16])); } }
    }
#undef S5_FETCH
}

__device__ __forceinline__ unsigned ord_key(float f) { const unsigned u = __float_as_uint(f); return (u & 0x80000000u) ? ~u : (u | 0x80000000u); }
__device__ __forceinline__ void dsa_vt_item(KArgs C, int item, int lane, bf16* scr) {
    const int tb = item % NK64, bh = item / NK64, h = bh & 7, bl = bh >> 3;
    const bf16* V = WSP(const bf16, WS_V) + ((size_t)bl * SEQ + tb * 64) * 512 + h * 64;
    WAVE_SYNC();
#pragma unroll
    for (int i = 0; i < 8; ++i) { const int tk = (lane >> 3) + 8 * i, c8 = (lane & 7) * 8; const u32x4 w = *(const u32x4*)(V + (size_t)tk * 512 + c8);
        unsigned* d = (unsigned*)(scr + tk * 66 + c8); d[0] = w.x; d[1] = w.y; d[2] = w.z; d[3] = w.w; }
    WAVE_SYNC();
    bf16* Vt = WSP(bf16, WS_VT) + ((size_t)bh * 64) * SEQ + tb * 64 + lane;
#pragma unroll 8
    for (int d = 0; d < 64; ++d) Vt[(size_t)d * SEQ] = scr[lane * 66 + d];
}
constexpr int IDX_CAP = 128, IDX_NBIN = 1024;
__device__ __forceinline__ void dsa_index_unit(KArgs C, int unit, int lane, int wave, unsigned char* lds) {
    const int oct = unit & 7, pairid = (unit >> 3) % (NK64 / 2), kx = (unit >> 3) / (NK64 / 2), bl = kx >> 1, c = (kx & 1) ? NK64 - 1 - pairid : pairid;
    const int t0 = c * 64 + oct * 8, nkeys = (c + 1) * 64, nk64 = c + 1; const size_t row0 = (size_t)bl * SEQ + t0;
    unsigned* mrow = WSP(unsigned, WS_MASK) + (row0 + wave) * MW;
    if (nkeys <= TOPK) { for (int w = lane; w < MW; w += 64) mrow[w] = (w * 32 < nkeys) ? 0xffffffffu : 0u; return; }
    float* scf = (float*)lds;
    unsigned* hist = (unsigned*)(lds + LDS_X) + wave * (IDX_NBIN / 2); unsigned* candv = (unsigned*)(lds + LDS_X + 8 * IDX_NBIN * 2) + wave * IDX_CAP; unsigned* candi = candv + 8 * IDX_CAP; unsigned* mword = (unsigned*)(lds + LDS_X + 8 * IDX_NBIN * 2 + 16 * IDX_CAP * 4) + wave * MW;
    const bf16* SMb = WSP(const bf16, WS_SM) + (size_t)bl * SEQ * 256;
    const int l31 = lane & 31, half = lane >> 5;
    const bf16* qa = SMb + (size_t)(t0 + (l31 >> 2)) * 256 + 8 + (l31 & 3) * 32 + 8 * half;
    const bf16x8_t a0 = *(const bf16x8_t*)qa, a1 = *(const bf16x8_t*)(qa + 16);
    u32x2 wraw[4];
#pragma unroll
    for (int g = 0; g < 4; ++g) wraw[g] = *(const u32x2*)(SMb + (size_t)(t0 + 2 * g + half) * 256 + 168);
    LDS_SYNC();
    {
      float wv[4][4];
#pragma unroll
      for (int g = 0; g < 4; ++g) { const u32x2 w = wraw[g]; wv[g][0] = lo_bf(w.x) * 0.5f; wv[g][1] = hi_bf(w.x) * 0.5f; wv[g][2] = lo_bf(w.y) * 0.5f; wv[g][3] = hi_bf(w.y) * 0.5f; }
      for (int kt0 = wave; kt0 < nk64 * 2; kt0 += 8 * NWAVES) {
          bf16x8_t b0[8], b1[8];
#pragma unroll
          for (int u4 = 0; u4 < 8; ++u4) { const int kt = kt0 + 8 * u4; const bf16* kb = WSP(const bf16, WS_KI) + ((size_t)bl * SEQ + (size_t)((kt < nk64 * 2 ? kt : wave) * 32 + l31)) * 32 + 8 * half;
              b0[u4] = *(const bf16x8_t*)kb; b1[u4] = *(const bf16x8_t*)(kb + 16); }
#pragma unroll
          for (int u4 = 0; u4 < 8; ++u4) { const int kt = kt0 + 8 * u4; if (kt < nk64 * 2) {
              f32x16 d;
#pragma unroll
              for (int r = 0; r < 16; ++r) d[r] = 0.f;
              d = __builtin_amdgcn_mfma_f32_32x32x16_bf16(a0, b0[u4], d, 0, 0, 0); d = __builtin_amdgcn_mfma_f32_32x32x16_bf16(a1, b1[u4], d, 0, 0, 0);
#pragma unroll
              for (int g = 0; g < 4; ++g) { float sc = 0.f;
#pragma unroll
                  for (int j = 0; j < 4; ++j) sc += wv[g][j] * fmaxf(d[4 * g + j] * 0.17677669529f, 0.f);
                  scf[(2 * g + half) * SEQ + kt * 32 + l31] = sc; } } }
      } }
    { const int tail0 = nkeys, tail1 = ((nk64 + 7) >> 3) * 512;
      for (int e = tail0 + (int)(threadIdx.x); e < tail1; e += NTHREADS) {
#pragma unroll
          for (int qq = 0; qq < 8; ++qq) scf[qq * SEQ + e] = -3.0e38f; } }
    LDS_SYNC();
    const float* sc = scf + wave * SEQ; constexpr float NEG = -3.0e38f; const int nb8 = (nk64 + 7) >> 3;
    float v[NK64];
#pragma unroll
    for (int ib = 0; ib < NK64 / 8; ++ib) if (ib < nb8) {
#pragma unroll
        for (int j = 0; j < 8; ++j) v[ib * 8 + j] = sc[(ib * 8 + j) * 64 + lane];
        SCHED_FENCE(); }
    float mn = INFINITY, mx = -INFINITY;
#pragma unroll
    for (int ib = 0; ib < NK64 / 8; ++ib) if (ib < nb8) {
#pragma unroll
        for (int j = 0; j < 8; ++j) { const float x = v[ib * 8 + j]; mx = fmaxf(mx, x); mn = fminf(mn, x == NEG ? INFINITY : x); } }
    mn = -wave_max(-mn); mx = wave_max(mx);
    const float scale = (mx > mn) ? ((float)IDX_NBIN - 0.01f) / (mx - mn) : 0.f;
#pragma unroll
    for (int i = 0; i < IDX_NBIN / 128; ++i) hist[lane * (IDX_NBIN / 128) + i] = 0u;
    for (int w = lane; w < MW; w += 64) mword[w] = 0u;
    WAVE_SYNC();
#define IDX_BIN(x) ({ int b_ = (int)(fmaxf((x) - mn, 0.f) * scale); b_ > IDX_NBIN - 1 ? IDX_NBIN - 1 : b_; })
#pragma unroll
    for (int ib = 0; ib < NK64 / 8; ++ib) if (ib < nb8) {
#pragma unroll
        for (int j = 0; j < 8; ++j) { const int b = IDX_BIN(v[ib * 8 + j]); atomicAdd(&hist[b >> 1], (b & 1) ? 0x10000u : 1u); }
        SCHED_FENCE(); }
    WAVE_SYNC();
    int bstar, cgt;
    {
      unsigned hw[8]; int tot = 0;
#pragma unroll
      for (int i = 0; i < 8; ++i) { hw[i] = hist[lane * 8 + i]; tot += (int)(hw[i] & 0xffffu) + (int)(hw[i] >> 16); }
      int suf = tot;
#pragma unroll
      for (int o = 1; o < 64; o <<= 1) { const int t = __shfl_down(suf, o); if (lane + o < 64) suf += t; }
      const unsigned long long ge = __ballot(suf >= TOPK); const int L = 63 - __builtin_clzll(ge);
      int cum = __shfl(suf, L) - __shfl(tot, L); bstar = 16 * L; cgt = cum; bool found = false;
#pragma unroll
      for (int i = 7; i >= 0; --i) { const unsigned w = (unsigned)__shfl((int)hw[i], L); const int chi = (int)(w >> 16), clo = (int)(w & 0xffffu);
          if (!found && cum + chi >= TOPK) { bstar = 16 * L + 2 * i + 1; cgt = cum; found = true; } cum += found ? 0 : chi;
          if (!found && cum + clo >= TOPK) { bstar = 16 * L + 2 * i; cgt = cum; found = true; } cum += found ? 0 : clo; } }
    const int need = TOPK - cgt; int ncand = 0;
    unsigned mylo = 0u, myhi = 0u;
#pragma unroll
    for (int ib = 0; ib < NK64 / 8; ++ib) if (ib < nb8) {
#pragma unroll
        for (int j = 0; j < 8; ++j) { const int i = ib * 8 + j; const int b = IDX_BIN(v[i]);
            const unsigned long long bs = __ballot(b > bstar), bc = __ballot(b == bstar);
            if (lane == i) { mylo = (unsigned)bs; myhi = (unsigned)(bs >> 32); }
            if (bc != 0ull) {
                const int pos = ncand + (int)__builtin_amdgcn_mbcnt_hi((unsigned)(bc >> 32), __builtin_amdgcn_mbcnt_lo((unsigned)bc, 0u));
                if (b == bstar && pos < IDX_CAP) { candv[pos] = ord_key(v[i]); candi[pos] = (unsigned)(i * 64 + lane); }
                ncand += __popcll(bc); } }
        SCHED_FENCE(); }
    if (lane < nb8 * 8) { mword[2 * lane] = mylo; mword[2 * lane + 1] = myhi; }
#undef IDX_BIN
    WAVE_SYNC();
    if (ncand <= IDX_CAP) {
        for (int m = lane; m < ncand; m += 64) { const unsigned vm = candv[m]; int rank = 0;
#pragma unroll 4
            for (int j = 0; j < ncand; ++j) { const unsigned vj = candv[j]; rank += (vj > vm || (vj == vm && j < m)) ? 1 : 0; }
            if (rank < need) { const unsigned idx = candi[m]; atomicOr(&mword[idx >> 5], 1u << (idx & 31)); } }
    } else {
        unsigned T = 0u;
        for (int bit = 31; bit >= 0; --bit) { const unsigned cand = T | (1u << bit); int cn = 0;
#pragma unroll
            for (int ib = 0; ib < NK64 / 8; ++ib) if (ib < nb8) {
#pragma unroll
                for (int j = 0; j < 8; ++j) cn += (ord_key(v[ib * 8 + j]) >= cand) ? 1 : 0; }
            if (wave_sum_i(cn) >= TOPK) T = cand; }
        int cg = 0;
#pragma unroll
        for (int ib = 0; ib < NK64 / 8; ++ib) if (ib < nb8) {
#pragma unroll
            for (int j = 0; j < 8; ++j) cg += (ord_key(v[ib * 8 + j]) > T) ? 1 : 0; }
        const int need2 = TOPK - wave_sum_i(cg); int taken = 0;
#pragma unroll
        for (int ib = 0; ib < NK64 / 8; ++ib) if (ib < nb8) {
#pragma unroll
            for (int j = 0; j < 8; ++j) { const int i = ib * 8 + j; const unsigned kv = ord_key(v[i]); const bool eq = kv == T; const unsigned long long be = __ballot(eq);
                const int pre = __popcll(be & ((1ull << lane) - 1ull)); const bool sel = (kv > T) || (eq && (taken + pre) < need2); taken += __popcll(be);
                const unsigned long long bs = __ballot(sel); if (lane == 0) { mword[2 * i] = (unsigned)bs; mword[2 * i + 1] = (unsigned)(bs >> 32); } } }
    }
    WAVE_SYNC();
    for (int w = lane; w < MW; w += 64) mrow[w] = mword[w];
}

constexpr int AT_KP = 72, AT_VP = 72, AT_BUF = 64 * AT_KP + 64 * AT_VP;
__device__ __forceinline__ void dsa_attn_half(KArgs C, int bl, int h, int cb, int tid, bf16* tiles, const float* btab) {
    const int lane = tid & 63, wave = tid >> 6, l31 = lane & 31, hh = lane >> 5, c = 4 * cb + (wave >> 1), qb = wave & 1, q0 = c * 64 + qb * 32, qpos = q0 + l31;
    const size_t qrow = (size_t)bl * SEQ + qpos;
    const bf16* Qp = WSP(const bf16, WS_Q) + qrow * 512 + h * 64 + 8 * hh;
    const unsigned* Mp = WSP(const unsigned, WS_MASK) + qrow * MW;
    const bf16* gk = WSP(const bf16, WS_K) + ((size_t)bl * SEQ + (tid >> 3)) * 512 + h * 64 + (tid & 7) * 8;
    const bf16* gv = WSP(const bf16, WS_VT) + ((size_t)(bl * 8 + h) * 64 + (tid >> 3)) * SEQ + (tid & 7) * 8;
    const int lk = (tid >> 3) * AT_KP + (tid & 7) * 8, lv = 64 * AT_KP + (tid >> 3) * AT_VP + (tid & 7) * 8;
    constexpr float SC = 0.125f * 1.44269504089f;
    bf16x8_t qf[4];
#pragma unroll
    for (int s = 0; s < 4; ++s) qf[s] = *(const bf16x8_t*)(Qp + 16 * s);
    f32x16 O0, O1;
#pragma unroll
    for (int r = 0; r < 16; ++r) { O0[r] = 0.f; O1[r] = 0.f; }
    float m = -1e30f, lsum = 0.f;
    const int ntw = c + 1, nt = 4 * cb + 4;
    u32x4 prek = *(const u32x4*)gk, prev = *(const u32x4*)gv; u32x2 mwn = *(const u32x2*)Mp;
    LDS_SYNC();
    const float bfar = btab[0];
    *(u32x4*)(tiles + lk) = prek; *(u32x4*)(tiles + lv) = prev;
    if (nt > 1) { prek = *(const u32x4*)(gk + (size_t)64 * 512); prev = *(const u32x4*)(gv + 64); }
    for (int kt = 0; kt < nt; ++kt) {
        LDS_SYNC();
        const bf16* tb = tiles + (kt & 1) * AT_BUF; const u32x2 mw2 = mwn;
        if (kt + 1 < ntw) mwn = *(const u32x2*)(Mp + 2 * (kt + 1));
        if (kt < ntw) {
            f32x16 S[2];
#pragma unroll
            for (int t2 = 0; t2 < 2; ++t2) {
#pragma unroll
                for (int r = 0; r < 16; ++r) S[t2][r] = 0.f;
#pragma unroll
                for (int s = 0; s < 4; ++s) S[t2] = __builtin_amdgcn_mfma_f32_32x32x16_bf16(*(const bf16x8_t*)(tb + (t2 * 32 + l31) * AT_KP + 16 * s + 8 * hh), qf[s], S[t2], 0, 0, 0); }
            float tmax = -1e30f;
#pragma unroll
            for (int t2 = 0; t2 < 2; ++t2) { const int k0 = kt * 64 + t2 * 32;
                if ((k0 + 31 - q0) <= -166) {
#pragma unroll
                    for (int r = 0; r < 16; ++r) { const float v = S[t2][r] * SC + bfar; S[t2][r] = v; tmax = fmaxf(tmax, v); }
                } else { const int rb = k0 + 4 * hh - qpos + 256;
#pragma unroll
                    for (int r = 0; r < 16; ++r) { const int row = (r & 3) + 8 * (r >> 2); int ti = rb + row; ti = ti < 0 ? 0 : ti; const float v = S[t2][r] * SC + btab[ti]; S[t2][r] = v; tmax = fmaxf(tmax, v); } } }
            tmax = fmaxf(tmax, __shfl_xor(tmax, 32));
            if (__ballot(tmax > m) != 0ull) { const float mn = fmaxf(m, tmax), alpha = __builtin_amdgcn_exp2f(m - mn); m = mn; lsum *= alpha;
#pragma unroll
                for (int r = 0; r < 16; ++r) { O0[r] *= alpha; O1[r] *= alpha; } }
            float ps = 0.f;
#pragma unroll
            for (int t2 = 0; t2 < 2; ++t2) { const unsigned mwc = (t2 == 0 ? mw2.x : mw2.y) << (4 * (1 - hh));
#pragma unroll
                for (int r = 0; r < 16; ++r) { const int row = (r & 3) + 8 * (r >> 2) + 4;
                    const unsigned keep = (unsigned)((int)(mwc << (31 - row)) >> 31);
                    const float p = __uint_as_float(__float_as_uint(__builtin_amdgcn_exp2f(S[t2][r] - m)) & keep); S[t2][r] = p; ps += p; } }
            lsum += ps;
#pragma unroll
            for (int t2 = 0; t2 < 2; ++t2) { const bf16* vb = tb + 64 * AT_KP + l31 * AT_VP + t2 * 32 + 4 * hh;
#pragma unroll
                for (int s = 0; s < 2; ++s) { u32x4 w; w.x = pk2(S[t2][8 * s + 0], S[t2][8 * s + 1]); w.y = pk2(S[t2][8 * s + 2], S[t2][8 * s + 3]); w.z = pk2(S[t2][8 * s + 4], S[t2][8 * s + 5]); w.w = pk2(S[t2][8 * s + 6], S[t2][8 * s + 7]);
                    const bf16x8_t pf = __builtin_bit_cast(bf16x8_t, w);
                    O0 = __builtin_amdgcn_mfma_f32_32x32x16_bf16(frag2(*(const u32x2*)(vb + 16 * s), *(const u32x2*)(vb + 16 * s + 8)), pf, O0, 0, 0, 0);
                    O1 = __builtin_amdgcn_mfma_f32_32x32x16_bf16(frag2(*(const u32x2*)(vb + 32 * AT_VP + 16 * s), *(const u32x2*)(vb + 32 * AT_VP + 16 * s + 8)), pf, O1, 0, 0, 0); } }
        }
        if (kt + 1 < nt) { bf16* nb = tiles + ((kt + 1) & 1) * AT_BUF; *(u32x4*)(nb + lk) = prek; *(u32x4*)(nb + lv) = prev;
            if (kt + 2 < nt) { prek = *(const u32x4*)(gk + (size_t)(kt + 2) * 64 * 512); prev = *(const u32x4*)(gv + (size_t)(kt + 2) * 64); } }
    }
    lsum += __shfl_xor(lsum, 32);
    const float inv = 1.0f / lsum;
    bf16* Y = WSP(bf16, WS_Y) + (size_t)MG * 512 + qrow * 512 + h * 64 + 4 * hh;
#pragma unroll
    for (int g = 0; g < 4; ++g) { u32x2 w; w.x = pk2(O0[4 * g] * inv, O0[4 * g + 1] * inv); w.y = pk2(O0[4 * g + 2] * inv, O0[4 * g + 3] * inv); *(u32x2*)(Y + 8 * g) = w;
        u32x2 w2; w2.x = pk2(O1[4 * g] * inv, O1[4 * g + 1] * inv); w2.y = pk2(O1[4 * g + 2] * inv, O1[4 * g + 3] * inv); *(u32x2*)(Y + 32 + 8 * g) = w2; }
}
__device__ __forceinline__ void dsa_attn_unit3(KArgs C, int unit, int tid, unsigned char* lds) {
    constexpr int NPAIR = NK64 / 8;
    const int pr = unit % NPAIR, h = (unit / NPAIR) & 7, bl = unit / (NPAIR * 8);
    float* btab = (float*)lds; bf16* tiles = (bf16*)(lds + 2048);
    __syncthreads();
    { const int* tab = WSP(const int, WS_TAB); const float* relb = C->in[I_RELB];
      if (tid < 320) btab[tid] = relb[tab[tid - 256 + SEQ - 1] * 8 + h] * 1.44269504089f; }
    dsa_attn_half(C, bl, h, pr, tid, tiles, btab);
    dsa_attn_half(C, bl, h, NK64 / 4 - 1 - pr, tid, tiles, btab);
}
#ifndef GP_ALIGN
#define GP_ALIGN true
#endif
#ifndef GP_SP2
#define GP_SP2 true
#endif
constexpr int SEGS_PER_GROUP = 11, NSEG = DEPTH * (1 + NGRP * SEGS_PER_GROUP) + 1;

#ifdef HOST_EMU
#define GRID_BARRIER() emu_grid_sync()
#define LDS_PTR(p) ((unsigned char*)(p))
#else
#define GRID_BARRIER() do { XcdBarrier b_; b_.bar = (unsigned*)(Ck->ws + WS_CTL); b_.x = xb_xcc_id(); b_.st = (volatile LAS unsigned*)(lds + LDS_CTL_OFF); xcd_barrier(b_); } while (0)
#define LDS_PTR(p) ((PG8_LAS unsigned char*)(p))
#endif

__global__ void __launch_bounds__(NTHREADS, 2) fwd_kernel(Args a) {
#ifdef HOST_EMU
    unsigned char* lds = emu_lds;
#else
    extern __shared__ __attribute__((aligned(16))) unsigned char lds[];
#endif
#ifdef HOST_EMU
    KArgs Ck = &a;
#else
    KArgs Ck = (KArgs)__builtin_amdgcn_kernarg_segment_ptr();
    (void)a;
#endif
#ifndef HOST_EMU
    if (threadIdx.x < 4) ((LAS unsigned*)(lds + LDS_CTL_OFF))[threadIdx.x] = 0u;
    __syncthreads();
    if (Ck->seg_hi - Ck->seg_lo > 1) (void)xcd_barrier_post((unsigned*)(Ck->ws + WS_CTL), (volatile LAS unsigned*)(lds + LDS_CTL_OFF));
#endif
#define SEGID 0
#define RUN (SEGID >= Ck->seg_lo && SEGID < Ck->seg_hi)
#define SEAM do { if (SEGID >= Ck->seg_lo && SEGID + 1 < Ck->seg_hi) { GRID_BARRIER(); } } while (0)
#define WO ((layer & 1) ? WDELTA : (size_t)0)
#define PHASE_VARS KArgs C = KLAUNDER(Ck); const int G = gridDim.x, bx = blockIdx.x, ngw = G * NWAVES; (void)ngw; const int tid = fresh_tid(), lane = tid & 63, wave = __builtin_amdgcn_readfirstlane(tid >> 6), gw = bx * NWAVES + wave; (void)lane; (void)gw; (void)C
    for (int layer = 0; layer < DEPTH; ++layer) {
#undef SEGID
#define SEGID (layer * (1 + NGRP * SEGS_PER_GROUP))
        if (RUN) { PHASE_VARS; phase_weights(C, layer, lds, gw, ngw, lane, wave); }
        SEAM;
        for (int grp = 0; grp < NGRP; ++grp) {
#define XIN ((layer == 0 ? C->in[I_X] : (const float*)C->out) + (size_t)grp * MG * D)
#define XOUT (C->out + (size_t)grp * MG * D)
#undef SEGID
#define SEGID (layer * (1 + NGRP * SEGS_PER_GROUP) + 1 + grp * SEGS_PER_GROUP + 0)
            if (RUN) { PHASE_VARS; for (int m = gw; m < MG; m += 2 * ngw) { if (m + ngw < MG) rms_rowN_bf16<2>(XIN + (size_t)m * D, C->in[I_NMIX] + layer * D, WSP(bf16, WS_H) + (size_t)m * D, (size_t)ngw * D, lane); else rms_row_bf16(XIN + (size_t)m * D, C->in[I_NMIX] + layer * D, WSP(bf16, WS_H) + (size_t)m * D, lane); } }
            SEAM;
#undef SEGID
#define SEGID (layer * (1 + NGRP * SEGS_PER_GROUP) + 1 + grp * SEGS_PER_GROUP + 1)
            if (RUN) { PHASE_VARS; pg8::Gemm g{WSP(const bf16, WS_H), WSP(const bf16, WS_WIN + WO), MG, NMIXC, D}; pg8::StaticOrder S; S.init(MG, NMIXC, G, bx);
                pg8::EpiProj E{C->ws};
                pg8::gemm_phase<pg8::EpiProj, pg8::StaticOrder, false, GP_ALIGN, GP_SP2>(LDS_PTR(lds), g, S, E, nullptr); }
            SEAM;
#undef SEGID
#define SEGID (layer * (1 + NGRP * SEGS_PER_GROUP) + 1 + grp * SEGS_PER_GROUP + 2)
            if (RUN) { PHASE_VARS;
                for (int m = gw; m < MG; m += 2 * ngw) { if (m + ngw < MG) { rwkv_prep_row2(C, layer, m, ngw, lane); ssd_conv_row2(C, layer, m, ngw, lane); } else { rwkv_prep_row(C, layer, m, lane); ssd_conv_row(C, layer, m, lane); } }
                for (int it = gw; it < NB * 8 * NK64; it += ngw) dsa_vt_item(C, it, lane, (bf16*)(lds + wave * 16384));
                __syncthreads();
                for (int u = bx; u < NB * NK64 * 8; u += G) dsa_index_unit(C, u, lane, wave, lds);
            }
            SEAM;
#undef SEGID
#define SEGID (layer * (1 + NGRP * SEGS_PER_GROUP) + 1 + grp * SEGS_PER_GROUP + 3)
            if (RUN) { PHASE_VARS; pg8::Gemm g{WSP(const bf16, WS_RA), WSP(const bf16, WS_WLORA + WO), MG, 1536, 256}; pg8::StaticOrder S; S.init(MG, 1536, G, bx);
                pg8::EpiLora E{WSP(float, WS_WLOG), WSP(bf16, WS_ASIG), WSP(bf16, WS_GG), C->in[I_W0] + layer * 512, C->in[I_A0] + layer * 512};
                pg8::gemm_phase<pg8::EpiLora, pg8::StaticOrder, false, GP_ALIGN, GP_SP2>(LDS_PTR(lds), g, S, E, nullptr); }
            SEAM;
#undef SEGID
#define SEGID (layer * (1 + NGRP * SEGS_PER_GROUP) + 1 + grp * SEGS_PER_GROUP + 4)
            if (RUN) { PHASE_VARS;
                constexpr int U_R = NB * 8, U_S = U_R + NB * 8;
                for (int u = bx; u < U_R; u += G) rwkv_unit(C, layer, u, lds);
                for (int u = (bx + G - U_R % G) % G; u < NB * 8; u += G) ssd_unit(C, layer, u, lds);
                { const int first = U_S % G, span = G - first;
                  if (bx >= first) for (int u = bx - first; u < NB * 32; u += span) s5_unit(C, layer, u, lds); }
                for (;;) {
                    const int t2 = fresh_tid();
                    volatile unsigned* qs2 = (volatile unsigned*)(lds + LDS_CTL_OFF + 32);
                    __syncthreads();
                    if (t2 == 0) *qs2 = atomicAdd((unsigned*)(Ck->ws + WS_QCTR) + ((layer * NGRP + grp) * 2) * 64, 1u);
                    __syncthreads();
                    const int u = (int)*qs2;
                    if (u >= NB * NK64) break;
                    dsa_attn_unit3(KLAUNDER(Ck), u, t2, lds);
                }
            }
            SEAM;
#undef SEGID
#define SEGID (layer * (1 + NGRP * SEGS_PER_GROUP) + 1 + grp * SEGS_PER_GROUP + 5)
            if (RUN) { PHASE_VARS;
                { pg8::Gemm g{WSP(const bf16, WS_H), WSP(const bf16, WS_WIN + WO) + (size_t)NMIXC * D, MG, 4096, D}; pg8::StaticOrder S; S.init(MG, 4096, G, bx);
                  pg8::EpiGate E{WSP(bf16, WS_G)}; pg8::gemm_phase<pg8::EpiGate, pg8::StaticOrder, false, GP_ALIGN, GP_SP2>(LDS_PTR(lds), g, S, E, nullptr); }
                { pg8::Gemm g{WSP(const bf16, WS_YD0), WSP(const bf16, WS_GLU + WO), MG, 512, 512}; pg8::StaticOrder S; S.init(MG, 512, G, bx);
                  pg8::EpiGlu E{WSP(const bf16, WS_YD0), WSP(bf16, WS_Y) + (size_t)3 * MG * 512, C->in[I_GLUB] + layer * 512};
                  pg8::gemm_phase<pg8::EpiGlu, pg8::StaticOrder, false, GP_ALIGN, GP_SP2>(LDS_PTR(lds), g, S, E, nullptr); }
                for (int it = gw; it < MG * 2; it += 4 * ngw) ssd_norm_item4(C, layer, it, ngw, MG * 2, lane);
            }
            SEAM;
#undef SEGID
#define SEGID (layer * (1 + NGRP * SEGS_PER_GROUP) + 1 + grp * SEGS_PER_GROUP + 6)
            if (RUN) { PHASE_VARS; pg8::Gemm g{WSP(const bf16, WS_Y), WSP(const bf16, WS_WB + WO), 4 * MG, 4096, 512}; pg8::MergeOrder S{G, bx};
                pg8::EpiMerge E{WSP(const bf16, WS_G), WSP(bf16, WS_MRG)};
                pg8::gemm_phase<pg8::EpiMerge, pg8::MergeOrder, false, GP_ALIGN, GP_SP2>(LDS_PTR(lds), g, S, E, nullptr); }
            SEAM;
#undef SEGID
#define SEGID (layer * (1 + NGRP * SEGS_PER_GROUP) + 1 + grp * SEGS_PER_GROUP + 7)
            if (RUN) { PHASE_VARS; pg8::Gemm g{WSP(const bf16, WS_MRG), WSP(const bf16, WS_WOUT + WO), MG, D, D}; pg8::StaticOrder S; S.init(MG, D, G, bx);
                pg8::EpiResid E{XIN, XOUT}; pg8::gemm_phase<pg8::EpiResid, pg8::StaticOrder, false, GP_ALIGN, GP_SP2>(LDS_PTR(lds), g, S, E, nullptr); }
            SEAM;
#undef SEGID
#define SEGID (layer * (1 + NGRP * SEGS_PER_GROUP) + 1 + grp * SEGS_PER_GROUP + 8)
            if (RUN) { PHASE_VARS; for (int m = gw; m < MG; m += 2 * ngw) { if (m + ngw < MG) rms_rowN_bf16<2>(XOUT + (size_t)m * D, C->in[I_NFFN] + layer * D, WSP(bf16, WS_H) + (size_t)m * D, (size_t)ngw * D, lane); else rms_row_bf16(XOUT + (size_t)m * D, C->in[I_NFFN] + layer * D, WSP(bf16, WS_H) + (size_t)m * D, lane); } }
            SEAM;
#undef SEGID
#define SEGID (layer * (1 + NGRP * SEGS_PER_GROUP) + 1 + grp * SEGS_PER_GROUP + 9)
            if (RUN) { PHASE_VARS; pg8::Gemm g{WSP(const bf16, WS_H), WSP(const bf16, WS_W13 + WO), MG, 5632, D}; pg8::StaticOrder S; S.init(MG, 5632, G, bx);
                pg8::EpiSwiglu E{WSP(bf16, WS_HID)};
                pg8::gemm_phase<pg8::EpiSwiglu, pg8::StaticOrder, false, GP_ALIGN, GP_SP2>(LDS_PTR(lds), g, S, E, nullptr); }
            SEAM;
#undef SEGID
#define SEGID (layer * (1 + NGRP * SEGS_PER_GROUP) + 1 + grp * SEGS_PER_GROUP + 10)
            if (RUN) { PHASE_VARS; pg8::Gemm g{WSP(const bf16, WS_HID), WSP(const bf16, WS_W2 + WO), MG, D, FFN}; pg8::StaticOrder S; S.init(MG, D, G, bx);
                pg8::EpiResid E{XOUT, XOUT}; pg8::gemm_phase<pg8::EpiResid, pg8::StaticOrder, false, GP_ALIGN, GP_SP2>(LDS_PTR(lds), g, S, E, nullptr); }
            SEAM;
        }
    }
#undef SEGID
#define SEGID (NSEG - 1)
    { const int layer = 0; (void)layer;
    if (RUN) { PHASE_VARS; for (int m = gw; m < M; m += 2 * ngw) { if (m + ngw < M) rms_row2_f32(C->out + (size_t)m * D, (size_t)ngw * D, C->in[I_NFIN], lane); else rms_row_f32(C->out + (size_t)m * D, C->in[I_NFIN], lane); } } }
#undef RUN
#undef SEAM
}

extern "C" void kernel_launch(void* const* d_in, const int* in_sizes, int n_in, void* d_out, int out_size, void* d_ws, size_t ws_size, hipStream_t stream) {
    static int grid = 0;
    if (grid == 0) {
        if (n_in != N_IN || out_size != M * D || ws_size < WS_END) { fprintf(stderr, "kernel_launch: unexpected shapes (n_in %d, out %d, ws %zu < %zu)\n", n_in, out_size, ws_size, (size_t)WS_END); grid = -1; return; }
        int dev = 0, cus = 0;
        if (hipGetDevice(&dev) != hipSuccess || hipDeviceGetAttribute(&cus, hipDeviceAttributeMultiprocessorCount, dev) != hipSuccess || cus < 1) { grid = -1; return; }
        if (hipFuncSetAttribute((const void*)fwd_kernel, hipFuncAttributeMaxDynamicSharedMemorySize, LDS_BYTES) != hipSuccess) { fprintf(stderr, "kernel_launch: hipFuncSetAttribute failed\n"); grid = -1; return; }
        (void)hipGetLastError();
        grid = cus;
    }
    if (grid < 0) return;
    (void)hipMemsetAsync((char*)d_ws + WS_CTL, 0, CTL_BYTES, stream);
    Args a{};
    for (int i = 0; i < N_IN; ++i) a.in[i] = (const float*)d_in[i];
    a.out = (float*)d_out; a.ws = (unsigned char*)d_ws;
#if CFG_LAUNCHES == 1
    a.seg_lo = 0; a.seg_hi = NSEG;
    hipLaunchKernelGGL(fwd_kernel, dim3(grid), dim3(NTHREADS), LDS_BYTES, stream, a);
#else
    for (int s = 0; s < NSEG; ++s) { a.seg_lo = s; a.seg_hi = s + 1; hipLaunchKernelGGL(fwd_kernel, dim3(grid), dim3(NTHREADS), LDS_BYTES, stream, a); }
#endif
}
```

```cpp
#ifdef HOST_EMU
#error "HOST_EMU is a host-only debug build"
#else
#include <hip/hip_runtime.h>
#endif
#include <cstdio>
#include <cstdint>
#include <cmath>

#ifndef CFG_BATCH
#define CFG_BATCH 16
#endif
#ifndef CFG_SEQ
#define CFG_SEQ 4096
#endif
#ifndef CFG_DEPTH
#define CFG_DEPTH 4
#endif
#ifndef CFG_NB
#define CFG_NB 8
#endif
#ifndef CFG_LAUNCHES
#define CFG_LAUNCHES 1
#endif

typedef unsigned short bf16;
typedef float f32x4 __attribute__((ext_vector_type(4)));
typedef float f32x2 __attribute__((ext_vector_type(2)));
typedef unsigned u32x4 __attribute__((ext_vector_type(4)));
typedef unsigned u32x2 __attribute__((ext_vector_type(2)));

constexpr int BATCH = CFG_BATCH, SEQ = CFG_SEQ, DEPTH = CFG_DEPTH, NB = CFG_NB;
constexpr int D = 1024, M = BATCH * SEQ, MG = NB * SEQ, NGRP = BATCH / NB;
constexpr int IN_COLS = 9388, NPROJ = 9472, NMIXC = 5376, FFN = 2816;
constexpr int TOPK = (SEQ / 4) < 256 ? (SEQ / 4) : 256;
constexpr int NK64 = SEQ / 64, MW = SEQ / 32;
constexpr float RMS_EPS = 1e-6f, GN_EPS = 64e-5f;
static_assert(BATCH % NB == 0 && MG % 256 == 0 && SEQ % 64 == 0, "shape");

enum { I_X = 0, I_RELB, I_NMIX, I_WIN, I_CONVW, I_CONVB, I_DTB, I_ALOG, I_SSDD, I_SSDNG, I_MU, I_W0, I_W2, I_A0, I_A2, I_G2, I_KK, I_KA, I_RK, I_LNG, I_LNB,
       I_S5ARE, I_S5AIM, I_S5BRE, I_S5BIM, I_S5CRE, I_S5CIM, I_S5D, I_S5LDT, I_GLUW, I_GLUB, I_WBR, I_WOUT, I_NFFN, I_W1, I_W3, I_W2F, I_NFIN, N_IN };

constexpr size_t MiB = 1u << 20;
constexpr size_t al256(size_t x) { return (x + 255) & ~(size_t)255; }
constexpr size_t WS_CTL = 0, CTL_BYTES = 64 * 1024;
constexpr size_t WS_TAB = WS_CTL + CTL_BYTES;
constexpr size_t WS_ABAR = al256(WS_TAB + (SEQ + 64) * 4);
constexpr size_t WS_BBAR = WS_ABAR + 32 * 64 * 2 * 4;
constexpr size_t WS_WIN = al256(WS_BBAR + 32 * 64 * 16 * 2 * 4);
constexpr size_t WS_WB = WS_WIN + (size_t)NPROJ * 1024 * 2;
constexpr size_t WS_WOUT = WS_WB + (size_t)4 * 1024 * 512 * 2;
constexpr size_t WS_W13 = WS_WOUT + (size_t)1024 * 1024 * 2;
constexpr size_t WS_W2 = WS_W13 + (size_t)5632 * 1024 * 2;
constexpr size_t WS_GLU = WS_W2 + (size_t)1024 * 2816 * 2;
constexpr size_t WS_WLORA = WS_GLU + (size_t)512 * 512 * 2;
constexpr size_t WS_H = al256(WS_WLORA + (size_t)1536 * 256 * 2);
constexpr size_t WS_Z = WS_H + (size_t)MG * 1024 * 2;
constexpr size_t WS_XBC = WS_Z + (size_t)MG * 512 * 2;
constexpr size_t WS_Q = WS_XBC + (size_t)MG * 768 * 2;
constexpr size_t WS_K = WS_Q + (size_t)MG * 512 * 2;
constexpr size_t WS_V = WS_K + (size_t)MG * 512 * 2;
constexpr size_t WS_RW = WS_V + (size_t)MG * 512 * 2;
constexpr size_t WS_U = WS_RW + (size_t)MG * 1792 * 2;
constexpr size_t WS_SM = WS_U + (size_t)MG * 512 * 2;
constexpr size_t WS_G = WS_Q;
constexpr size_t WS_Y = WS_SM + (size_t)MG * 256 * 2;
constexpr size_t WS_YD0 = WS_Y + (size_t)4 * MG * 512 * 2;
constexpr size_t WS_MRG = WS_YD0 + (size_t)MG * 512 * 2;
constexpr size_t WS_MASK = WS_MRG + (size_t)MG * 1024 * 2;
constexpr size_t WS_RA = WS_MASK + (size_t)MG * MW * 4;
constexpr size_t WS_WLOG = WS_RA + (size_t)MG * 256 * 2;
constexpr size_t WS_ASIG = WS_WLOG + (size_t)MG * 512 * 4;
constexpr size_t WS_GG = WS_ASIG + (size_t)MG * 512 * 2;
constexpr size_t WS_XBA = WS_GG + (size_t)MG * 512 * 2;
constexpr size_t WS_VT = WS_XBA + (size_t)MG * 768 * 2;
constexpr size_t WS_KI = WS_VT + (size_t)MG * 512 * 2;
constexpr size_t WS_QCTR = 16384;
constexpr size_t WS_HID = WS_G;
constexpr size_t WS_WALT = al256(WS_KI + (size_t)MG * 32 * 2);
constexpr size_t WDELTA = WS_WALT - WS_ABAR;
constexpr size_t WS_END = WS_WALT + (WS_H - WS_ABAR);
static_assert(WS_SM + (size_t)MG * 256 * 2 - WS_Q == (size_t)MG * 4096 * 2, "G overlays exactly Q..SM");
static_assert((size_t)MG * 2816 * 2 <= (size_t)MG * 4096 * 2, "HID fits in G");

constexpr int LDS_SCRATCH = 131072;
constexpr int LDS_CTL_OFF = LDS_SCRATCH;
constexpr int LDS_X = LDS_SCRATCH + 64;
constexpr int LDS_BYTES = 161792;
constexpr int NTHREADS = 512, NWAVES = 8;

__device__ __forceinline__ float bf2f(bf16 v) { return __uint_as_float(((unsigned)v) << 16); }
#ifdef HOST_EMU
__device__ __forceinline__ bf16 f2bf(float f) { unsigned u = __float_as_uint(f); u += 0x7fffu + ((u >> 16) & 1u); return (bf16)(u >> 16); }
#else
__device__ __forceinline__ bf16 f2bf(float f) { return __builtin_bit_cast(bf16, (__bf16)f); }
#endif
#ifdef HOST_EMU
__device__ __forceinline__ unsigned pk2(float lo, float hi) { return (unsigned)f2bf(lo) | ((unsigned)f2bf(hi) << 16); }
#else
typedef __bf16 bf16x2_hw __attribute__((ext_vector_type(2)));
__device__ __forceinline__ unsigned pk2(float lo, float hi) { const f32x2 v = {lo, hi}; return __builtin_bit_cast(unsigned, __builtin_convertvector(v, bf16x2_hw)); }
#endif
__device__ __forceinline__ float lo_bf(unsigned w) { return __uint_as_float(w << 16); }
__device__ __forceinline__ float hi_bf(unsigned w) { return __uint_as_float(w & 0xffff0000u); }
#ifndef HOST_EMU
__device__ __forceinline__ float sigm(float x) { return __builtin_amdgcn_rcpf(1.0f + __expf(-x)); }
#else
__device__ __forceinline__ float sigm(float x) { return 1.0f / (1.0f + __expf(-x)); }
#endif
#ifndef HOST_EMU
template <int BIT> __device__ __forceinline__ unsigned bit_fill(unsigned w) { unsigned r; asm("v_bfe_i32 %0, %1, %2, 1" : "=v"(r) : "v"(w), "n"(BIT)); return r; }
#else
template <int BIT> __device__ __forceinline__ unsigned bit_fill(unsigned w) { return ((w >> BIT) & 1u) ? 0xffffffffu : 0u; }
#endif
__device__ __forceinline__ int imax0(int v) { return v < 0 ? 0 : v; }
__device__ __forceinline__ float tanh_fast(float x) { return 2.0f * sigm(2.0f * x) - 1.0f; }
__device__ __forceinline__ float softplusf(float x) { return x > 20.f ? x : log1pf(__expf(x)); }
__device__ __forceinline__ float gelu_tanh(float x) { const float u = 0.7978845608f * (x + 0.044715f * x * x * x); return x * sigm(2.0f * u); }
__device__ __forceinline__ float wave_sum(float v) {
#pragma unroll
    for (int o = 1; o < 64; o <<= 1) v += __shfl_xor(v, o);
    return v;
}
__device__ __forceinline__ float wave_max(float v) {
#pragma unroll
    for (int o = 1; o < 64; o <<= 1) v = fmaxf(v, __shfl_xor(v, o));
    return v;
}
__device__ __forceinline__ int wave_sum_i(int v) {
#pragma unroll
    for (int o = 1; o < 64; o <<= 1) v += __shfl_xor(v, o);
    return v;
}
#ifdef HOST_EMU
#define WAVE_SYNC() (void)emu_wave_exchange(0)
#define SCHED_FENCE() do {} while (0)
#define LDS_SYNC() __syncthreads()
#else
#define WAVE_SYNC() __builtin_amdgcn_wave_barrier()
#define SCHED_FENCE() __builtin_amdgcn_sched_barrier(0)
#define LDS_SYNC() do { asm volatile("s_waitcnt lgkmcnt(0)" ::: "memory"); __builtin_amdgcn_s_barrier(); asm volatile("" ::: "memory"); } while (0)
#endif
#ifndef HOST_EMU
namespace pg8 {
__device__ __forceinline__ int pg8_fresh_tid() { int t = (int)threadIdx.x; asm volatile("" : "+v"(t)); return t; }
#define PG8_LAS __attribute__((address_space(3)))
typedef unsigned short bf16_t;
typedef short bf16x8 __attribute__((ext_vector_type(8)));
typedef float f32x4 __attribute__((ext_vector_type(4)));
typedef unsigned u32x4 __attribute__((ext_vector_type(4)));
constexpr int BM = 256, BK = 64, HALF = 128, HTB = HALF * BK * 2  , STAGE_BYTES = 8 * HTB, NXCD = 8, WGM = 8;

__host__ __device__ __forceinline__ int lds_byte(int r, int c) { const int st = (r >> 4) * 2 + (c >> 5), rr = r & 15, cc = c & 31, ob = rr * 64 + cc * 2; return st * 1024 + (ob ^ (((ob >> 9) & 1) << 5)); }
__host__ __device__ __forceinline__ void stage_rc(int b, int& R, int& C) { const int st = b / 1024, sb = b % 1024, swz = sb ^ (((sb >> 9) & 1) << 5); R = (st >> 1) * 16 + swz / 64; C = (st & 1) * 32 + (swz % 64) / 2; }
__host__ __device__ __forceinline__ int perm32(int rho) { const int n = rho >> 4, i = rho & 15; return 8 * (i >> 2) + 4 * n + (i & 3); }

struct Unit { int pm, pn; };
struct Gemm { const bf16_t* A; const bf16_t* Bt; int M, N, K; };

struct StaticOrder {
    int nM, nN, nwg, G, c;
    __host__ __device__ void init(int M, int N, int G_, int c_) { nM = M / BM; nN = N / BM; nwg = nM * nN; G = G_; c = c_; }
    __host__ __device__ bool next(int i, Unit& u) const {
        const long L = (long)i * G + c; if (L >= nwg) return false;
        int wgid = (int)L; { const int q = nwg / NXCD, r = nwg % NXCD, xcd = wgid % NXCD, off = wgid / NXCD; wgid = (xcd < r ? xcd * (q + 1) : r * (q + 1) + (xcd - r) * q) + off; }
        const int nig = WGM * nN, gid = wgid / nig, fm = gid * WGM, gsz = (nM - fm) < WGM ? (nM - fm) : WGM;
        u.pm = fm + ((wgid % nig) % gsz); u.pn = (wgid % nig) / gsz; return true;
    }
    __device__ __forceinline__ void a_ready(const Unit&) const {}
    __device__ __forceinline__ void done(const Unit&) const {}
};

__device__ __forceinline__ unsigned cvt_pk_bf16(float lo, float hi) { return pk2(lo, hi); }

template <class E, class = void> struct epi_keep { static constexpr bool value = false; };
template <class E> struct epi_keep<E, decltype((void)E::KEEP_ACC)> { static constexpr bool value = true; };
template <class Epi, class Sched, bool STAMP = false, bool ALIGN_EPI = false, bool SP2 = false>
__device__ __forceinline__ void gemm_phase(PG8_LAS unsigned char* lds, const Gemm g, const Sched& S, const Epi& E, unsigned long long* stamps) {
    const int tid = pg8_fresh_tid(), wid = __builtin_amdgcn_readfirstlane(tid >> 6), lane = tid & 63, wr = wid >> 2, wc = wid & 3, fr = lane & 15, fq = lane >> 4;
    int K_ = g.K; asm volatile("" : "+s"(K_));
    const int K = K_, nt = K / BK;
    int ts_lo = 0, ts_hi = 0, nts = 0; const unsigned long long rt_entry = STAMP ? (unsigned long long)wall_clock64() : 0ull;
#define PG8_STAMP() do { if (STAMP && wid == 0 && nts < 64) { const unsigned long long _c = (unsigned long long)clock64(); \
        ts_lo = (lane == nts) ? (int)(unsigned)_c : ts_lo; ts_hi = (lane == nts) ? (int)(unsigned)(_c >> 32) : ts_hi; ++nts; } } while (0)
    PG8_STAMP();
    unsigned voffA[2], voffB[2];
#pragma unroll
    for (int i = 0; i < 2; ++i) { int R, C; stage_rc(tid * 16 + i * 8192, R, C); const int Rb = Epi::PERM ? ((R & ~31) + perm32(R & 31)) : R;
        voffA[i] = (unsigned)(R * K + C) * 2u; voffB[i] = (unsigned)(Rb * K + C) * 2u; }
    const size_t kstep = (size_t)(BK * 2);
    const size_t hstep = (size_t)HALF * K * 2;
    const size_t tstep = 2 * hstep;
    const unsigned ldsw = (unsigned)wid * 1024u;
    const int aoff = lds_byte(wr * 64 + fr, fq * 8), boff = lds_byte(wc * 32 + fr, fq * 8);
#define PG8_SA(b, h) (((b) * 2 + (h)) * HTB)
#define PG8_SB(b, h) ((4 + (b) * 2 + (h)) * HTB)
#define PG8_STAGE(bufoff, gbase, voff) do { _Pragma("unroll") for (int _i = 0; _i < 2; ++_i) \
        __builtin_amdgcn_global_load_lds((const unsigned*)((const char*)(gbase) + (voff)[_i]), (PG8_LAS unsigned*)(lds + (bufoff) + ldsw + _i * 8192), 16, 0, 0); } while (0)
#define PG8_LDA(dst, b, h) do { _Pragma("unroll") for (int m = 0; m < 4; ++m) _Pragma("unroll") for (int k = 0; k < 2; ++k) dst[m][k] = *(const PG8_LAS bf16x8*)(lds + PG8_SA(b, h) + aoff + m * 2048 + k * 1024); } while (0)
#define PG8_LDB(dst, b, h) do { _Pragma("unroll") for (int n = 0; n < 2; ++n) _Pragma("unroll") for (int k = 0; k < 2; ++k) dst[n][k] = *(const PG8_LAS bf16x8*)(lds + PG8_SB(b, h) + boff + n * 2048 + k * 1024); } while (0)
#define PG8_MMA(ai, bj, At, Bt) do { __builtin_amdgcn_s_setprio(1); _Pragma("unroll") for (int m = 0; m < 4; ++m) _Pragma("unroll") for (int n = 0; n < 2; ++n) _Pragma("unroll") for (int k = 0; k < 2; ++k) \
        acc[ai][bj][m][n] = __builtin_amdgcn_mfma_f32_16x16x32_bf16(Bt[n][k], At[m][k], acc[ai][bj][m][n], 0, 0, 0); __builtin_amdgcn_s_setprio(0); } while (0)
#define PG8_WAIT_V(n) asm volatile("s_waitcnt vmcnt(" #n ")" ::: "memory")
#define PG8_WAIT_L(n) asm volatile("s_waitcnt lgkmcnt(" #n ")" ::: "memory")
#define PG8_BAR __builtin_amdgcn_s_barrier()
#define PG8_SCHED __builtin_amdgcn_sched_barrier(0)
    Unit cur, nxt; int ui = 0;
    if (!S.next(0, cur)) return;
    f32x4 acc[2][2][4][2];
#pragma unroll
    for (int a = 0; a < 2; ++a)
#pragma unroll
        for (int b = 0; b < 2; ++b)
#pragma unroll
            for (int m = 0; m < 4; ++m)
#pragma unroll
                for (int n = 0; n < 2; ++n) acc[a][b][m][n] = (f32x4){0.f, 0.f, 0.f, 0.f};
    bf16x8 At[4][2], B0[2][2], B1[2][2];
    const char* cA = (const char*)g.A + (size_t)cur.pm * tstep; const char* cB = (const char*)g.Bt + (size_t)cur.pn * tstep;
    S.a_ready(cur);
    if constexpr (SP2) {
        PG8_STAGE(PG8_SB(0, 0), cB, voffB); PG8_STAGE(PG8_SB(0, 1), cB + hstep, voffB); PG8_STAGE(PG8_SA(0, 0), cA, voffA); PG8_STAGE(PG8_SA(0, 1), cA + hstep, voffA);
        if (wr == 1) PG8_BAR;
        PG8_WAIT_V(2); PG8_BAR;
        PG8_STAGE(PG8_SB(1, 0), cB + kstep, voffB); PG8_STAGE(PG8_SA(1, 0), cA + kstep, voffA); PG8_STAGE(PG8_SB(1, 1), cB + hstep + kstep, voffB);
        PG8_WAIT_V(6); PG8_BAR;
    } else {
    PG8_STAGE(PG8_SB(0, 0), cB, voffB); PG8_STAGE(PG8_SA(0, 0), cA, voffA); PG8_STAGE(PG8_SB(0, 1), cB + hstep, voffB); PG8_STAGE(PG8_SA(0, 1), cA + hstep, voffA);
    if (wr == 1) PG8_BAR;
    PG8_WAIT_V(4); PG8_BAR;
    PG8_STAGE(PG8_SB(1, 0), cB + kstep, voffB); PG8_STAGE(PG8_SA(1, 0), cA + kstep, voffA); PG8_STAGE(PG8_SB(1, 1), cB + hstep + kstep, voffB);
    PG8_WAIT_V(6); PG8_BAR;
    }
    PG8_STAMP();
    for (;;) {
        const bool has_next = S.next(ui + 1, nxt);
        const char* nA = has_next ? (const char*)g.A + (size_t)nxt.pm * tstep : cA; const char* nB = has_next ? (const char*)g.Bt + (size_t)nxt.pn * tstep : cB;
        for (int t = 0; t < nt; t += 2) {
            const bool last = (t == nt - 2);
            const char* a1 = cA + (size_t)(t + 1) * kstep;
            const char* a2 = last ? nA : cA + (size_t)(t + 2) * kstep; const char* b2 = last ? nB : cB + (size_t)(t + 2) * kstep;
            const char* a3 = a2 + kstep; const char* b3 = b2 + kstep;
            if (last && has_next) S.a_ready(nxt);
            if constexpr (SP2) {
            PG8_LDB(B0, 0, 0); PG8_LDB(B1, 0, 1); PG8_SCHED; PG8_LDA(At, 0, 0); PG8_STAGE(PG8_SA(1, 1), a1 + hstep, voffA);
            PG8_WAIT_V(8); PG8_WAIT_L(0); PG8_BAR; PG8_MMA(0, 0, At, B0); PG8_MMA(0, 1, At, B1); PG8_BAR; PG8_SCHED;
            PG8_LDA(At, 0, 1); PG8_STAGE(PG8_SB(0, 0), b2, voffB); PG8_STAGE(PG8_SB(0, 1), b2 + hstep, voffB); PG8_STAGE(PG8_SA(0, 0), a2, voffA);
            PG8_WAIT_V(8); PG8_WAIT_L(0); PG8_BAR; PG8_MMA(1, 0, At, B0); PG8_MMA(1, 1, At, B1); PG8_BAR; PG8_SCHED;
            PG8_LDB(B0, 1, 0); PG8_LDB(B1, 1, 1); PG8_SCHED; PG8_LDA(At, 1, 0); PG8_STAGE(PG8_SA(0, 1), a2 + hstep, voffA);
            PG8_WAIT_V(8); PG8_WAIT_L(0); PG8_BAR; PG8_MMA(0, 0, At, B0); PG8_MMA(0, 1, At, B1); PG8_BAR; PG8_SCHED;
            PG8_LDA(At, 1, 1); PG8_STAGE(PG8_SB(1, 0), b3, voffB); PG8_STAGE(PG8_SB(1, 1), b3 + hstep, voffB); PG8_STAGE(PG8_SA(1, 0), a3, voffA);
            PG8_WAIT_V(8); PG8_WAIT_L(0); PG8_BAR; PG8_MMA(1, 0, At, B0); PG8_MMA(1, 1, At, B1); PG8_BAR; PG8_SCHED;
            } else {
            PG8_LDB(B0, 0, 0); PG8_SCHED; PG8_LDA(At, 0, 0); PG8_STAGE(PG8_SA(1, 1), a1 + hstep, voffA);
            PG8_WAIT_L(8); PG8_BAR; PG8_WAIT_L(0); PG8_MMA(0, 0, At, B0); PG8_BAR; PG8_SCHED;
            PG8_LDB(B1, 0, 1); PG8_STAGE(PG8_SB(0, 0), b2, voffB);
            PG8_BAR; PG8_WAIT_L(0); PG8_MMA(0, 1, At, B1); PG8_BAR;
            PG8_LDA(At, 0, 1); PG8_STAGE(PG8_SA(0, 0), a2, voffA);
            PG8_BAR; PG8_WAIT_L(0); PG8_MMA(1, 0, At, B0); PG8_BAR; PG8_SCHED;
            PG8_STAGE(PG8_SB(0, 1), b2 + hstep, voffB);
            PG8_WAIT_V(6); PG8_BAR; PG8_MMA(1, 1, At, B1); PG8_BAR;
            PG8_LDB(B0, 1, 0); PG8_SCHED; PG8_LDA(At, 1, 0); PG8_STAGE(PG8_SA(0, 1), a2 + hstep, voffA);
            PG8_WAIT_L(8); PG8_BAR; PG8_WAIT_L(0); PG8_MMA(0, 0, At, B0); PG8_BAR; PG8_SCHED;
            PG8_LDB(B1, 1, 1); PG8_STAGE(PG8_SB(1, 0), b3, voffB);
            PG8_BAR; PG8_WAIT_L(0); PG8_MMA(0, 1, At, B1); PG8_BAR;
            PG8_LDA(At, 1, 1); PG8_STAGE(PG8_SA(1, 0), a3, voffA);
            PG8_BAR; PG8_WAIT_L(0); PG8_MMA(1, 0, At, B0); PG8_BAR; PG8_SCHED;
            PG8_STAGE(PG8_SB(1, 1), b3 + hstep, voffB);
            PG8_WAIT_V(6); PG8_BAR; PG8_MMA(1, 1, At, B1); PG8_BAR;
            }
        }
        PG8_STAMP();
        if constexpr (ALIGN_EPI) { if (wr == 0) PG8_BAR; }
        if constexpr (!Epi::AFTER_DRAIN) { E(acc, cur, wr, wc, fr, fq); S.done(cur); }
        PG8_STAMP();
        if (!has_next) break;
        bool zero_acc = true; if constexpr (epi_keep<Epi>::value) zero_acc = !E.keep(cur);
        if (zero_acc) {
#pragma unroll
        for (int a = 0; a < 2; ++a)
#pragma unroll
            for (int b = 0; b < 2; ++b)
#pragma unroll
                for (int m = 0; m < 4; ++m)
#pragma unroll
                    for (int n = 0; n < 2; ++n) acc[a][b][m][n] = (f32x4){0.f, 0.f, 0.f, 0.f}; }
        cur = nxt; cA = nA; cB = nB; ++ui;
        if constexpr (ALIGN_EPI) { if (wr == 1) PG8_BAR; }
    }
    PG8_WAIT_V(0);
    if constexpr (!ALIGN_EPI) { if (wr == 0) PG8_BAR; }
    PG8_BAR;
    if constexpr (Epi::AFTER_DRAIN) { E.fused(acc, cur, wr, wc, fr, fq, lds, wid, lane); S.done(cur); }
    PG8_STAMP();
    if (STAMP && wid == 0) { stamps[lane] = lane < nts ? (((unsigned long long)(unsigned)ts_hi << 32) | (unsigned)ts_lo) : 0ull;
        if (lane == 62) stamps[62] = rt_entry; if (lane == 63) stamps[63] = (unsigned long long)wall_clock64(); }
#undef PG8_STAMP
#undef PG8_SA
#undef PG8_SB
#undef PG8_STAGE
#undef PG8_LDA
#undef PG8_LDB
#undef PG8_MMA
#undef PG8_WAIT_V
#undef PG8_WAIT_L
#undef PG8_BAR
#undef PG8_SCHED
}
}

#define XB_TMO      128
#define XB_XCNT(j)  (256  + 64 * (j))
#define XB_XSUB(j)  (1280 + 64 * (j))
#define XB_XGEN(j)  (2304 + 64 * (j))
#define XB_TOP      3328
#define XB_TOPGEN   3392
#define XCD_BAR_WORDS 3456
#define XB_SPIN_CAP (1u << 18)
#define LAS __attribute__((address_space(3)))

__device__ __forceinline__ unsigned xb_ld(unsigned* p)              { return __hip_atomic_load(p, __ATOMIC_RELAXED, __HIP_MEMORY_SCOPE_AGENT); }
__device__ __forceinline__ unsigned xb_add(unsigned* p, unsigned v) { return __hip_atomic_fetch_add(p, v, __ATOMIC_RELAXED, __HIP_MEMORY_SCOPE_AGENT); }
__device__ __forceinline__ unsigned xb_xcc_id() { return (unsigned)__builtin_amdgcn_s_getreg((3 << 11) | 20) & 0xFu; }
#define XB_SPIN(cond, bar) do { unsigned _sp = 0; while (cond) { __builtin_amdgcn_s_sleep(1); \
    if ((++_sp & 255u) == 0u) { if (xb_ld(&(bar)[XB_TMO])) break; if (_sp > XB_SPIN_CAP) { atomicAdd(&(bar)[XB_TMO], 1u); break; } } } } while (0)

struct XcdBarrier {
    unsigned* bar; unsigned x;
    volatile LAS unsigned* st;
};

__device__ __forceinline__ XcdBarrier xcd_barrier_post(unsigned* bar, volatile LAS unsigned* st) {
    XcdBarrier b; b.bar = bar; b.x = xb_xcc_id(); b.st = st;
    if (threadIdx.x == 0) (void)xb_add(&bar[XB_XCNT(b.x)], 1u);
    return b;
}
__device__ __forceinline__ void xcd_barrier_complete(unsigned* bar, unsigned x, unsigned& nloc, unsigned& nx) {
    const unsigned G = gridDim.x * gridDim.y * gridDim.z;
    unsigned sum, cnt, mine, sp = 0u;
    for (;;) {
        sum = 0u; cnt = 0u; mine = 0u;
#pragma unroll
        for (unsigned j = 0; j < 16; ++j) { const unsigned c = xb_ld(&bar[XB_XCNT(j)]); sum += c; cnt += (c > 0u) ? 1u : 0u; mine = (j == x) ? c : mine; }
        if (sum == G) break;
        __builtin_amdgcn_s_sleep(1);
        if ((++sp & 255u) == 0u) { if (xb_ld(&bar[XB_TMO])) break; if (sp > XB_SPIN_CAP) { atomicAdd(&bar[XB_TMO], 1u); break; } }
    }
    nloc = mine > 0u ? mine : 1u; nx = cnt > 0u ? cnt : 1u;
}

__device__ __forceinline__ void xcd_barrier(const XcdBarrier& b) {
    asm volatile("s_waitcnt vmcnt(0)" ::: "memory");
    __syncthreads();
    if (threadIdx.x == 0) {
        unsigned* bar = b.bar;
        __builtin_amdgcn_s_waitcnt(0);
        unsigned nloc = b.st[0], nx = b.st[1];
        if (nloc == 0u) { xcd_barrier_complete(bar, b.x, nloc, nx); b.st[0] = nloc; b.st[1] = nx; }
        const unsigned old = xb_add(&bar[XB_XSUB(b.x)], 1u);
        const unsigned gen = old / nloc;
        if (old + 1u == (gen + 1u) * nloc) {
            __builtin_amdgcn_fence(__ATOMIC_RELEASE, "agent");
            asm volatile("s_waitcnt vmcnt(0)" ::: "memory");
            const unsigned og = xb_add(&bar[XB_TOP], 1u);
            const unsigned tg = og / nx;
            if (og + 1u == (tg + 1u) * nx) xb_add(&bar[XB_TOPGEN], 1u);
            else XB_SPIN(xb_ld(&bar[XB_TOPGEN]) == tg, bar);
            __builtin_amdgcn_fence(__ATOMIC_ACQUIRE, "agent");
            xb_add(&bar[XB_XGEN(b.x)], 1u);
            asm volatile("s_waitcnt vmcnt(0)" ::: "memory");
        } else {
            XB_SPIN(xb_ld(&bar[XB_XGEN(b.x)]) == gen, bar);
            __builtin_amdgcn_fence(__ATOMIC_ACQUIRE, "agent");
            asm volatile("s_waitcnt vmcnt(0)" ::: "memory");
        }
    }
    __syncthreads();
}

#else
namespace pg8 {
typedef unsigned short bf16_t;
typedef float f32x4 __attribute__((ext_vector_type(4)));
typedef unsigned u32x4 __attribute__((ext_vector_type(4)));
constexpr int BM = 256, BK = 64, HALF = 128, NXCD = 8, WGM = 8;
struct Unit { int pm, pn; };
struct Gemm { const bf16_t* A; const bf16_t* Bt; int M, N, K; };
template <class E, class = void> struct epi_keep { static constexpr bool value = false; };
template <class E> struct epi_keep<E, decltype((void)E::KEEP_ACC)> { static constexpr bool value = true; };
struct StaticOrder {
    int nM, nN, nwg, G, c;
    void init(int M, int N, int G_, int c_) { nM = M / BM; nN = N / BM; nwg = nM * nN; G = G_; c = c_; }
    bool next(int i, Unit& u) const {
        const long L = (long)i * G + c; if (L >= nwg) return false;
        int wgid = (int)L; { const int q = nwg / NXCD, r = nwg % NXCD, xcd = wgid % NXCD, off = wgid / NXCD; wgid = (xcd < r ? xcd * (q + 1) : r * (q + 1) + (xcd - r) * q) + off; }
        const int nig = WGM * nN, gid = wgid / nig, fm = gid * WGM, gsz = (nM - fm) < WGM ? (nM - fm) : WGM;
        u.pm = fm + ((wgid % nig) % gsz); u.pn = (wgid % nig) / gsz; return true;
    }
    void a_ready(const Unit&) const {}
    void done(const Unit&) const {}
};
static inline unsigned cvt_pk_bf16(float lo, float hi) { return pk2(lo, hi); }
static float* emu_tile_buf(int b) { static std::vector<std::vector<float>> t; if ((int)t.size() <= b) t.resize(b + 1); if (t[b].empty()) t[b].resize(256 * 256); return t[b].data(); }
template <class Epi, class Sched, bool STAMP = false, bool ALIGN_EPI = false, bool SP2 = false>
void gemm_phase(unsigned char* lds, const Gemm g, const Sched& S, const Epi& E, unsigned long long* stamps) {
    const int tid = threadIdx.x, wid = tid >> 6, lane = tid & 63, wr = wid >> 2, wc = wid & 3, fr = lane & 15, fq = lane >> 4;
    float* tile = emu_tile_buf(blockIdx.x);
    Unit u; f32x4 acc[2][2][4][2]; bool keep_next = false;
    for (int ui = 0; S.next(ui, u); ++ui) {
        __syncthreads();
        if (tid == 0) {
            std::vector<float> a((size_t)256 * g.K), b((size_t)256 * g.K);
            for (int r = 0; r < 256; ++r) for (int k = 0; k < g.K; ++k) { a[(size_t)r * g.K + k] = bf2f(g.A[((size_t)u.pm * 256 + r) * g.K + k]); b[(size_t)r * g.K + k] = bf2f(g.Bt[((size_t)u.pn * 256 + r) * g.K + k]); }
            for (int r = 0; r < 256; ++r) for (int c = 0; c < 256; ++c) { const float* ar = &a[(size_t)r * g.K]; const float* br = &b[(size_t)c * g.K]; float s = 0.f; for (int k = 0; k < g.K; ++k) s += ar[k] * br[k]; tile[r * 256 + c] = s; }
        }
        __syncthreads();
        if (!keep_next) for (int ai = 0; ai < 2; ++ai) for (int bj = 0; bj < 2; ++bj) for (int m = 0; m < 4; ++m) for (int n = 0; n < 2; ++n) acc[ai][bj][m][n] = (f32x4){0.f, 0.f, 0.f, 0.f};
        for (int ai = 0; ai < 2; ++ai) for (int bj = 0; bj < 2; ++bj) for (int m = 0; m < 4; ++m) for (int n = 0; n < 2; ++n) for (int j = 0; j < 4; ++j) {
            const int r = 128 * ai + 64 * wr + 16 * m + fr;
            const int c = Epi::PERM ? (128 * bj + 32 * wc + 8 * fq + 4 * n + j) : (128 * bj + 32 * wc + 16 * n + 4 * fq + j);
            acc[ai][bj][m][n][j] += tile[r * 256 + c];
        }
        E(acc, u, wr, wc, fr, fq); S.done(u);
        if constexpr (epi_keep<Epi>::value) keep_next = E.keep(u); else keep_next = false;
        __syncthreads();
    }
}
}
#endif
namespace pg8 {
#ifdef HOST_EMU
#define EPI_FENCE() do {} while (0)
#else
#define EPI_FENCE() asm volatile("" ::: "memory")
#endif
__device__ __forceinline__ u32x4 pack8(const f32x4 v0, const f32x4 v1) { u32x4 w; w.x = cvt_pk_bf16(v0[0], v0[1]); w.y = cvt_pk_bf16(v0[2], v0[3]); w.z = cvt_pk_bf16(v1[0], v1[1]); w.w = cvt_pk_bf16(v1[2], v1[3]); return w; }
__device__ __forceinline__ void unpack8(const u32x4 w, f32x4& v0, f32x4& v1) { v0 = (f32x4){lo_bf(w.x), hi_bf(w.x), lo_bf(w.y), hi_bf(w.y)}; v1 = (f32x4){lo_bf(w.z), hi_bf(w.z), lo_bf(w.w), hi_bf(w.w)}; }
__device__ __forceinline__ f32x4 sig4(const f32x4 v) { return (f32x4){sigm(v[0]), sigm(v[1]), sigm(v[2]), sigm(v[3])}; }
#ifndef HOST_EMU
__device__ __forceinline__ float gate_sig(float x) { return __builtin_amdgcn_rcpf(fminf(1.0f + __expf(-x), 1.0e6f)); }
#else
__device__ __forceinline__ float gate_sig(float x) { return fmaxf(sigm(x), 1.0e-6f); }
#endif
__device__ __forceinline__ f32x4 gsig4(const f32x4 v) { return (f32x4){gate_sig(v[0]), gate_sig(v[1]), gate_sig(v[2]), gate_sig(v[3])}; }

struct EpiProj {
    static constexpr bool PERM = true, AFTER_DRAIN = false;
    unsigned char* ws;
    __device__ __forceinline__ void operator()(const f32x4 (&acc)[2][2][4][2], const Unit& u, int wr, int wc, int fr, int fq) const {
        const int pn = u.pn; size_t off; int ld, c0;
        if (pn < 2) { off = WS_Z; ld = 512; c0 = pn * 256; }
        else if (pn < 5) { off = WS_XBC; ld = 768; c0 = (pn - 2) * 256; }
        else if (pn < 7) { off = WS_Q; ld = 512; c0 = (pn - 5) * 256; }
        else if (pn < 9) { off = WS_K; ld = 512; c0 = (pn - 7) * 256; }
        else if (pn < 11) { off = WS_V; ld = 512; c0 = (pn - 9) * 256; }
        else if (pn < 18) { off = WS_RW; ld = 1792; c0 = (pn - 11) * 256; }
        else if (pn < 20) { off = WS_U; ld = 512; c0 = (pn - 18) * 256; }
        else { off = WS_SM; ld = 256; c0 = 0; }
        bf16_t* dst = (bf16_t*)(ws + off);
        const int row0 = u.pm * BM + wr * 64 + fr, col0 = c0 + wc * 32 + 8 * fq;
        const int kic = HALF + wc * 32 + 8 * fq - 136;
        const bool ki = (pn == 20) && kic >= 0 && kic < 32;
#pragma unroll
        for (int ai = 0; ai < 2; ++ai)
#pragma unroll
            for (int m = 0; m < 4; ++m) { const size_t row = (size_t)(row0 + ai * HALF + m * 16); bf16_t* rowp = dst + row * ld + col0;
#pragma unroll
                for (int bj = 0; bj < 2; ++bj) { const u32x4 w = pack8(acc[ai][bj][m][0], acc[ai][bj][m][1]); *(u32x4*)(rowp + bj * HALF) = w;
                    if (bj == 1 && ki) *(u32x4*)((bf16_t*)(ws + WS_KI) + row * 32 + kic) = w; } }
    }
};
struct EpiGate {
    static constexpr bool PERM = true, AFTER_DRAIN = false;
    bf16_t* G;
    __device__ __forceinline__ void operator()(const f32x4 (&acc)[2][2][4][2], const Unit& u, int wr, int wc, int fr, int fq) const {
        const int row0 = u.pm * BM + wr * 64 + fr, col0 = u.pn * BM + wc * 32 + 8 * fq;
#pragma unroll
        for (int ai = 0; ai < 2; ++ai)
#pragma unroll
            for (int m = 0; m < 4; ++m) { bf16_t* rowp = G + (size_t)(row0 + ai * HALF + m * 16) * 4096 + col0;
#pragma unroll
                for (int bj = 0; bj < 2; ++bj) *(u32x4*)(rowp + bj * HALF) = pack8(gsig4(acc[ai][bj][m][0]), gsig4(acc[ai][bj][m][1])); }
    }
};
struct EpiMerge {
    static constexpr bool PERM = true, AFTER_DRAIN = false, KEEP_ACC = true;
    const bf16_t* G; bf16_t* MRG;
    __device__ __forceinline__ bool keep(const Unit& u) const { return (u.pn >> 2) < 3; }
    __device__ __forceinline__ void operator()(f32x4 (&acc)[2][2][4][2], const Unit& u, int wr, int wc, int fr, int fq) const {
        const int n = u.pn >> 2, pn = u.pn & 3, pm = u.pm - n * (MG / 256);
        const int row0 = pm * BM + wr * 64 + fr, col0 = pn * BM + wc * 32 + 8 * fq;
#pragma unroll
        for (int ai = 0; ai < 2; ++ai)
#pragma unroll
            for (int mp = 0; mp < 2; ++mp) { u32x4 ga[2][2], gb[2][2];
#pragma unroll
                for (int mm = 0; mm < 2; ++mm)
#pragma unroll
                    for (int bj = 0; bj < 2; ++bj) { const bf16_t* gp = G + (size_t)(row0 + ai * HALF + (2 * mp + mm) * 16) * 4096 + n * 1024 + col0 + bj * HALF; ga[mm][bj] = *(const u32x4*)gp; if (n < 3) gb[mm][bj] = *(const u32x4*)(gp + 1024); }
#pragma unroll
                for (int mm = 0; mm < 2; ++mm)
#pragma unroll
                    for (int bj = 0; bj < 2; ++bj) { const int m = 2 * mp + mm; f32x4 a0, a1; unpack8(ga[mm][bj], a0, a1);
                        if (n < 3) { f32x4 b0, b1; unpack8(gb[mm][bj], b0, b1);
#pragma unroll
                            for (int j = 0; j < 4; ++j) { acc[ai][bj][m][0][j] *= a0[j] * __builtin_amdgcn_rcpf(b0[j]); acc[ai][bj][m][1][j] *= a1[j] * __builtin_amdgcn_rcpf(b1[j]); } }
                        else
                            *(u32x4*)(MRG + (size_t)(row0 + ai * HALF + m * 16) * 1024 + col0 + bj * HALF) = pack8(acc[ai][bj][m][0] * a0, acc[ai][bj][m][1] * a1); }
                EPI_FENCE(); }
    }
};
struct MergeOrder {
    int G, c;
    __device__ __forceinline__ bool next(int i, Unit& u) const {
        const int tile = (i >> 2) * G + c, n = i & 3; if (tile >= (MG / 256) * 4) return false;
        u.pm = n * (MG / 256) + (tile >> 2); u.pn = n * 4 + (tile & 3); return true;
    }
    __device__ __forceinline__ void a_ready(const Unit&) const {}
    __device__ __forceinline__ void done(const Unit&) const {}
};
struct EpiResid {
    static constexpr bool PERM = false, AFTER_DRAIN = false;
    const float* base; float* out;
    __device__ __forceinline__ void operator()(const f32x4 (&acc)[2][2][4][2], const Unit& u, int wr, int wc, int fr, int fq) const {
        const int row0 = u.pm * BM + wr * 64 + fr, col0 = u.pn * BM + wc * 32 + 4 * fq;
#pragma unroll
        for (int ai = 0; ai < 2; ++ai) {
            f32x4 bv[4][2][2];
#pragma unroll
            for (int m = 0; m < 4; ++m)
#pragma unroll
                for (int bj = 0; bj < 2; ++bj)
#pragma unroll
                    for (int n = 0; n < 2; ++n) bv[m][bj][n] = *(const f32x4*)(base + (size_t)(row0 + ai * HALF + m * 16) * 1024 + col0 + bj * HALF + n * 16);
#pragma unroll
            for (int m = 0; m < 4; ++m)
#pragma unroll
                for (int bj = 0; bj < 2; ++bj)
#pragma unroll
                    for (int n = 0; n < 2; ++n) *(f32x4*)(out + (size_t)(row0 + ai * HALF + m * 16) * 1024 + col0 + bj * HALF + n * 16) = bv[m][bj][n] + acc[ai][bj][m][n];
            EPI_FENCE(); }
    }
};
struct EpiSwiglu {
    static constexpr bool PERM = true, AFTER_DRAIN = false;
    bf16_t* HID;
    __device__ __forceinline__ void operator()(const f32x4 (&acc)[2][2][4][2], const Unit& u, int wr, int wc, int fr, int fq) const {
        const int row0 = u.pm * BM + wr * 64 + fr, col0 = u.pn * HALF + wc * 32 + 8 * fq;
#pragma unroll
        for (int ai = 0; ai < 2; ++ai)
#pragma unroll
            for (int m = 0; m < 4; ++m) { f32x4 v[2];
#pragma unroll
                for (int n = 0; n < 2; ++n) { const f32x4 a = acc[ai][0][m][n], b = acc[ai][1][m][n]; v[n] = a * sig4(a) * b; }
                *(u32x4*)(HID + (size_t)(row0 + ai * HALF + m * 16) * FFN + col0) = pack8(v[0], v[1]); }
    }
};
struct EpiGlu {
    static constexpr bool PERM = true, AFTER_DRAIN = false;
    const bf16_t* Y0; bf16_t* OUT; const float* bias;
    __device__ __forceinline__ void operator()(const f32x4 (&acc)[2][2][4][2], const Unit& u, int wr, int wc, int fr, int fq) const {
        const int row0 = u.pm * BM + wr * 64 + fr, col0 = u.pn * BM + wc * 32 + 8 * fq;
#pragma unroll
        for (int ai = 0; ai < 2; ++ai)
#pragma unroll
            for (int m = 0; m < 4; ++m) { const size_t row = (size_t)(row0 + ai * HALF + m * 16);
#pragma unroll
                for (int bj = 0; bj < 2; ++bj) { const int col = col0 + bj * HALF;
                    f32x4 y0, y1; unpack8(*(const u32x4*)(Y0 + row * 512 + col), y0, y1);
                    const f32x4 b0 = *(const f32x4*)(bias + col), b1 = *(const f32x4*)(bias + col + 4);
                    *(u32x4*)(OUT + row * 512 + col) = pack8(y0 * sig4(acc[ai][bj][m][0] + b0), y1 * sig4(acc[ai][bj][m][1] + b1)); }
                EPI_FENCE(); }
    }
};
__device__ __forceinline__ float logdecay(float x) { return -0.6065306597f * sigm(x); }
struct EpiLora {
    static constexpr bool PERM = true, AFTER_DRAIN = false;
    float* WLOG; bf16_t* ASIG; bf16_t* GG; const float* w0; const float* a0;
    __device__ __forceinline__ void operator()(const f32x4 (&acc)[2][2][4][2], const Unit& u, int wr, int wc, int fr, int fq) const {
        const int kind = u.pn >> 1, row0 = u.pm * BM + wr * 64 + fr, col0 = (u.pn & 1) * BM + wc * 32 + 8 * fq;
        if (kind == 0) {
            f32x4 b[2][2];
#pragma unroll
            for (int bj = 0; bj < 2; ++bj) { b[bj][0] = *(const f32x4*)(w0 + col0 + bj * HALF); b[bj][1] = *(const f32x4*)(w0 + col0 + bj * HALF + 4); }
#pragma unroll
            for (int ai = 0; ai < 2; ++ai)
#pragma unroll
                for (int m = 0; m < 4; ++m)
#pragma unroll
                    for (int bj = 0; bj < 2; ++bj)
#pragma unroll
                        for (int n = 0; n < 2; ++n) { const f32x4 x = acc[ai][bj][m][n] + b[bj][n];
                            *(f32x4*)(WLOG + (size_t)(row0 + ai * HALF + m * 16) * 512 + col0 + bj * HALF + 4 * n) = (f32x4){logdecay(x[0]), logdecay(x[1]), logdecay(x[2]), logdecay(x[3])}; }
        } else if (kind == 1) {
            f32x4 b[2][2];
#pragma unroll
            for (int bj = 0; bj < 2; ++bj) { b[bj][0] = *(const f32x4*)(a0 + col0 + bj * HALF); b[bj][1] = *(const f32x4*)(a0 + col0 + bj * HALF + 4); }
#pragma unroll
            for (int ai = 0; ai < 2; ++ai)
#pragma unroll
                for (int m = 0; m < 4; ++m)
#pragma unroll
                    for (int bj = 0; bj < 2; ++bj)
                        *(u32x4*)(ASIG + (size_t)(row0 + ai * HALF + m * 16) * 512 + col0 + bj * HALF) = pack8(sig4(acc[ai][bj][m][0] + b[bj][0]), sig4(acc[ai][bj][m][1] + b[bj][1]));
        } else {
#pragma unroll
            for (int ai = 0; ai < 2; ++ai)
#pragma unroll
                for (int m = 0; m < 4; ++m)
#pragma unroll
                    for (int bj = 0; bj < 2; ++bj)
                        *(u32x4*)(GG + (size_t)(row0 + ai * HALF + m * 16) * 512 + col0 + bj * HALF) = pack8(acc[ai][bj][m][0], acc[ai][bj][m][1]);
        }
    }
};
}
typedef short bf16x8_t __attribute__((ext_vector_type(8)));
typedef float f32x16 __attribute__((ext_vector_type(16)));
typedef float f32x4_t __attribute__((ext_vector_type(4)));
__device__ __forceinline__ bf16x8_t frag2(const u32x2 lo, const u32x2 hi) { u32x4 w; w.x = lo.x; w.y = lo.y; w.z = hi.x; w.w = hi.y; return __builtin_bit_cast(bf16x8_t, w); }
struct Args { const float* in[N_IN]; float* out; unsigned char* ws; int seg_lo, seg_hi; };
#ifdef HOST_EMU
typedef const Args* KArgs;
#define KLAUNDER(p) (p)
__device__ __forceinline__ int fresh_tid() { return (int)threadIdx.x; }
#else
typedef const __attribute__((address_space(4))) Args* KArgs;
__device__ __forceinline__ KArgs klaunder(KArgs p) { asm volatile("" : "+s"(p)); return p; }
#define KLAUNDER(p) klaunder(p)
__device__ __forceinline__ int fresh_tid() { int t = (int)threadIdx.x; asm volatile("" : "+v"(t)); return t; }
#endif
#define WSP(T, off) ((T*)(C->ws + (off)))

template <class Src>
__device__ __forceinline__ void transpose_item(const Src& S, int K, bf16* WT, float* scr, int item, int lane) {
    const int nblk = S.ndst / 32, kb = item / nblk, nb = item % nblk, k0 = 64 * kb, n0 = 32 * nb;
    const float* cp = S.col(n0 + (lane & 31)); const int ld = S.ld;
#pragma unroll 8
    for (int i = 0; i < 32; ++i) { const int kk = 2 * i + (lane >> 5); scr[kk * 33 + (lane & 31)] = cp ? cp[(size_t)(k0 + kk) * ld] : 0.f; }
    WAVE_SYNC();
    const int c = lane & 7;
#pragma unroll
    for (int j = 0; j < 4; ++j) { const int n = (lane >> 3) + 8 * j; const float* s = scr + (8 * c) * 33 + n;
        u32x4 o; o.x = pk2(s[0 * 33], s[1 * 33]); o.y = pk2(s[2 * 33], s[3 * 33]); o.z = pk2(s[4 * 33], s[5 * 33]); o.w = pk2(s[6 * 33], s[7 * 33]);
        *(u32x4*)(WT + (size_t)(n0 + n) * K + k0 + 8 * c) = o; }
    WAVE_SYNC();
}
struct SrcWin { const float* w; int ndst, ld;
    __device__ __forceinline__ const float* col(int n) const {
        int s;
        if (n < 1280) s = n;
        else if (n < 2816) s = n + 8;
        else if (n < 4608) s = n - 2816 + 2988;
        else if (n < 5120) s = n - 4608 + 4780;
        else if (n < 5128) s = n - 5120 + 1280;
        else if (n < 5256) s = n - 5128 + 2824;
        else if (n < 5288) s = n - 5256 + 2952;
        else if (n < 5292) s = n - 5288 + 2984;
        else if (n < 5376) return nullptr;
        else s = n - 5376 + 5292;
        return w + s; } };
struct SrcPlain { const float* w; int ndst, ld; __device__ __forceinline__ const float* col(int n) const { return w + n; } };
struct SrcW13 { const float* w1; const float* w3; int ndst, ld;
    __device__ __forceinline__ const float* col(int n) const { const int pn = n >> 8, r = n & 255; return w1 + (r < 128 ? (ptrdiff_t)0 : (w3 - w1)) + pn * 128 + (r & 127); } };

__device__ __forceinline__ void phase_weights(KArgs C, int layer, unsigned char* lds, int gw, int ngw, int lane, int wave) {
    float* scr = (float*)(lds + wave * 16384); const size_t wo = (layer & 1) ? WDELTA : 0;
    constexpr int N_IN_ = 16 * (NPROJ / 32), N_BR = 8 * 32, N_OUT = 16 * 32, N_13 = 16 * (5632 / 32), N_2 = 44 * 32, N_GLU = 8 * 16;
    { const SrcWin s_in{C->in[I_WIN] + (size_t)layer * 1024 * IN_COLS, NPROJ, IN_COLS};
      for (int it = gw; it < N_IN_; it += ngw) transpose_item(s_in, 1024, WSP(bf16, WS_WIN + wo), scr, it, lane); }
    for (int it = gw; it < 4 * N_BR; it += ngw) { const int n = it / N_BR; const SrcPlain s_b{C->in[I_WBR] + ((size_t)layer * 4 + n) * 512 * 1024, 1024, 1024};
        transpose_item(s_b, 512, WSP(bf16, WS_WB + wo) + (size_t)n * 1024 * 512, scr, it % N_BR, lane); }
    { const SrcPlain s_out{C->in[I_WOUT] + (size_t)layer * 1024 * 1024, 1024, 1024};
      for (int it = gw; it < N_OUT; it += ngw) transpose_item(s_out, 1024, WSP(bf16, WS_WOUT + wo), scr, it, lane); }
    { const SrcW13 s_13{C->in[I_W1] + (size_t)layer * 1024 * FFN, C->in[I_W3] + (size_t)layer * 1024 * FFN, 5632, FFN};
      for (int it = gw; it < N_13; it += ngw) transpose_item(s_13, 1024, WSP(bf16, WS_W13 + wo), scr, it, lane); }
    { const SrcPlain s_2{C->in[I_W2F] + (size_t)layer * FFN * 1024, 1024, 1024};
      for (int it = gw; it < N_2; it += ngw) transpose_item(s_2, FFN, WSP(bf16, WS_W2 + wo), scr, it, lane); }
    { const SrcPlain s_glu{C->in[I_GLUW] + (size_t)layer * 512 * 512, 512, 512};
      for (int it = gw; it < N_GLU; it += ngw) transpose_item(s_glu, 512, WSP(bf16, WS_GLU + wo), scr, it, lane); }
    { const float* w2 = C->in[I_W2] + (size_t)layer * 64 * 512; const float* a2 = C->in[I_A2] + (size_t)layer * 64 * 512; const float* g2 = C->in[I_G2] + (size_t)layer * 128 * 512;
      bf16* WL = WSP(bf16, WS_WLORA + wo);
      for (int e = gw * 64 + lane; e < 1536 * 256; e += ngw * 64) { const int n = e >> 8, kc = e & 255; float v = 0.f;
          if (n < 512) { if (kc < 64) v = w2[kc * 512 + n]; } else if (n < 1024) { if (kc >= 64 && kc < 128) v = a2[(kc - 64) * 512 + (n - 512)]; } else { if (kc >= 128) v = g2[(kc - 128) * 512 + (n - 1024)]; }
          WL[e] = f2bf(v); } }
    const int gt = gw * 64 + lane, ngt = ngw * 64;
    for (int e = gt; e < 32 * 64; e += ngt) {
        const int g = e >> 6;
        const float ar = C->in[I_S5ARE][layer * 2048 + e], ai = C->in[I_S5AIM][layer * 2048 + e], dt = expf(C->in[I_S5LDT][layer * 32 + g]);
        const float mag = expf(ar * dt), abr = mag * cosf(ai * dt), abi = mag * sinf(ai * dt);
        const float den = ar * ar + ai * ai, nr = abr - 1.0f, ni = abi;
        const float qr = (nr * ar + ni * ai) / den, qi = (ni * ar - nr * ai) / den;
        float* ab = WSP(float, WS_ABAR + wo) + e * 2; ab[0] = abr; ab[1] = abi;
        float* bb = WSP(float, WS_BBAR + wo) + (size_t)e * 32;
        for (int j = 0; j < 16; ++j) { const float br = C->in[I_S5BRE][((size_t)layer * 2048 + e) * 16 + j], bi = C->in[I_S5BIM][((size_t)layer * 2048 + e) * 16 + j];
            bb[2 * j] = qr * br - qi * bi; bb[2 * j + 1] = qr * bi + qi * br; }
    }
    if (layer == 0) for (int e = gt; e < SEQ + 63; e += ngt) {
        const int rel = e - (SEQ - 1); const int n = rel < 0 ? -rel : rel; int b = rel > 0 ? 16 : 0;
        if (n < 8) b += n; else { int lg = 8 + (int)(logf((float)n / 8.0f) / 3.4657359028f * 8.0f); if (lg > 15) lg = 15; b += lg; }
        WSP(int, WS_TAB)[e] = b;
    }
}

__device__ __forceinline__ void rms_row_bf16(const float* xrow, const float* g, bf16* orow, int lane) {
    const f32x4* xr = (const f32x4*)xrow + lane; const f32x4* gr = (const f32x4*)g + lane;
    f32x4 v[4]; float s = 0.f;
#pragma unroll
    for (int j = 0; j < 4; ++j) { v[j] = xr[64 * j]; s += (v[j].x * v[j].x + v[j].y * v[j].y) + (v[j].z * v[j].z + v[j].w * v[j].w); }
    const float rstd = 1.0f / sqrtf(wave_sum(s) * (1.f / D) + RMS_EPS);
    u32x2* o8 = (u32x2*)orow + lane;
#pragma unroll
    for (int j = 0; j < 4; ++j) { const f32x4 gg = gr[64 * j]; u32x2 w; w.x = pk2(v[j].x * rstd * gg.x, v[j].y * rstd * gg.y); w.y = pk2(v[j].z * rstd * gg.z, v[j].w * rstd * gg.w); o8[64 * j] = w; }
}
template <int NR>
__device__ __forceinline__ void rms_rowN_bf16(const float* xrow, const float* g, bf16* orow, size_t step, int lane) {
    const f32x4* gr = (const f32x4*)g + lane; f32x4 v[NR][4]; float ss[NR];
#pragma unroll
    for (int q = 0; q < NR; ++q)
#pragma unroll
        for (int j = 0; j < 4; ++j) v[q][j] = ((const f32x4*)(xrow + q * step) + lane)[64 * j];
#pragma unroll
    for (int q = 0; q < NR; ++q) { float s = 0.f;
#pragma unroll
        for (int j = 0; j < 4; ++j) s += (v[q][j].x * v[q][j].x + v[q][j].y * v[q][j].y) + (v[q][j].z * v[q][j].z + v[q][j].w * v[q][j].w);
        ss[q] = s; }
#pragma unroll
    for (int o = 1; o < 64; o <<= 1)
#pragma unroll
        for (int q = 0; q < NR; ++q) ss[q] += __shfl_xor(ss[q], o);
#pragma unroll
    for (int q = 0; q < NR; ++q) { const float r = 1.0f / sqrtf(ss[q] * (1.f / D) + RMS_EPS); u32x2* o8 = (u32x2*)(orow + q * step) + lane;
#pragma unroll
        for (int j = 0; j < 4; ++j) { const f32x4 gg = gr[64 * j]; u32x2 w; w.x = pk2(v[q][j].x * r * gg.x, v[q][j].y * r * gg.y); w.y = pk2(v[q][j].z * r * gg.z, v[q][j].w * r * gg.w); o8[64 * j] = w; } }
}
__device__ __forceinline__ void rms_row_f32(float* xrow, const float* g, int lane) {
    f32x4* xr = (f32x4*)xrow + lane; const f32x4* gr = (const f32x4*)g + lane;
    f32x4 v[4]; float s = 0.f;
#pragma unroll
    for (int j = 0; j < 4; ++j) { v[j] = xr[64 * j]; s += (v[j].x * v[j].x + v[j].y * v[j].y) + (v[j].z * v[j].z + v[j].w * v[j].w); }
    const float rstd = 1.0f / sqrtf(wave_sum(s) * (1.f / D) + RMS_EPS);
#pragma unroll
    for (int j = 0; j < 4; ++j) xr[64 * j] = v[j] * rstd * gr[64 * j];
}

#ifdef HOST_EMU
__device__ __forceinline__ float red8(float v) { v += __shfl_xor(v, 1); v += __shfl_xor(v, 2); v += __shfl_xor(v, 4); return v; }
__device__ __forceinline__ float red16(float v) { v = red8(v); v += __shfl_xor(v, 8); return v; }
#else
template <int CTRL> __device__ __forceinline__ float dpp_f(float v) { return __builtin_bit_cast(float, __builtin_amdgcn_update_dpp(0, __builtin_bit_cast(int, v), CTRL, 0xf, 0xf, true)); }
__device__ __forceinline__ float red8(float v) { v += dpp_f<0xB1>(v); v += dpp_f<0x4E>(v); v += dpp_f<0x141>(v); return v; }
__device__ __forceinline__ float red16(float v) { v = red8(v); v += dpp_f<0x140>(v); return v; }
#endif
__device__ __forceinline__ f32x4 sig4g(const f32x4 v) { return (f32x4){sigm(v[0]), sigm(v[1]), sigm(v[2]), sigm(v[3])}; }
__device__ __forceinline__ void rms_row2_f32(float* xrow, size_t step, const float* g, int lane) {
    f32x4* xa = (f32x4*)xrow + lane; f32x4* xb = (f32x4*)(xrow + step) + lane; const f32x4* gr = (const f32x4*)g + lane;
    f32x4 va[4], vb[4]; float sa = 0.f, sb = 0.f;
#pragma unroll
    for (int j = 0; j < 4; ++j) { va[j] = xa[64 * j]; vb[j] = xb[64 * j]; }
#pragma unroll
    for (int j = 0; j < 4; ++j) { sa += (va[j].x * va[j].x + va[j].y * va[j].y) + (va[j].z * va[j].z + va[j].w * va[j].w); sb += (vb[j].x * vb[j].x + vb[j].y * vb[j].y) + (vb[j].z * vb[j].z + vb[j].w * vb[j].w); }
#pragma unroll
    for (int o = 1; o < 64; o <<= 1) { sa += __shfl_xor(sa, o); sb += __shfl_xor(sb, o); }
    const float ra = 1.0f / sqrtf(sa * (1.f / D) + RMS_EPS), rb = 1.0f / sqrtf(sb * (1.f / D) + RMS_EPS);
#pragma unroll
    for (int j = 0; j < 4; ++j) { const f32x4 gg = gr[64 * j]; xa[64 * j] = va[j] * ra * gg; xb[64 * j] = vb[j] * rb * gg; }
}
__device__ __forceinline__ void ssd_conv_row(KArgs C, int layer, int m, int lane) {
    const int t = m % SEQ; const float* cw = C->in[I_CONVW] + layer * 4 * 768; const float* cb = C->in[I_CONVB] + layer * 768;
#pragma unroll
    for (int i = 0; i < 3; ++i) { const int ch = i * 256 + lane * 4; const bf16* p = WSP(const bf16, WS_XBC) + (size_t)m * 768 + ch;
        f32x4 a = *(const f32x4*)(cb + ch);
#pragma unroll
        for (int q = 0; q < 4; ++q) if (t - 3 + q >= 0) { const u32x2 w = *(const u32x2*)(p - (3 - q) * 768); const f32x4 cq = *(const f32x4*)(cw + q * 768 + ch);
            a += cq * (f32x4){lo_bf(w.x), hi_bf(w.x), lo_bf(w.y), hi_bf(w.y)}; }
        a = a * sig4g(a);
        u32x2 o; o.x = pk2(a.x, a.y); o.y = pk2(a.z, a.w); *(u32x2*)(WSP(bf16, WS_XBA) + (size_t)m * 768 + ch) = o; }
}
__device__ __forceinline__ void ssd_conv_row2(KArgs C, int layer, int m, int step, int lane) {
    const float* cw = C->in[I_CONVW] + layer * 4 * 768; const float* cb = C->in[I_CONVB] + layer * 768;
    u32x2 w[2][3][4]; f32x4 cq[3][4], bb[3];
#pragma unroll
    for (int i = 0; i < 3; ++i) { const int ch = i * 256 + lane * 4; bb[i] = *(const f32x4*)(cb + ch);
#pragma unroll
        for (int q = 0; q < 4; ++q) { cq[i][q] = *(const f32x4*)(cw + q * 768 + ch);
#pragma unroll
            for (int r = 0; r < 2; ++r) { const int mm = m + r * step, t = mm % SEQ; const bf16* p = WSP(const bf16, WS_XBC) + (size_t)mm * 768 + ch;
                if (t - 3 + q >= 0) w[r][i][q] = *(const u32x2*)(p - (3 - q) * 768); else { w[r][i][q].x = 0u; w[r][i][q].y = 0u; } } } }
#pragma unroll
    for (int r = 0; r < 2; ++r)
#pragma unroll
        for (int i = 0; i < 3; ++i) { const int ch = i * 256 + lane * 4; f32x4 a = bb[i];
#pragma unroll
            for (int q = 0; q < 4; ++q) a += cq[i][q] * (f32x4){lo_bf(w[r][i][q].x), hi_bf(w[r][i][q].x), lo_bf(w[r][i][q].y), hi_bf(w[r][i][q].y)};
            a = a * sig4g(a);
            u32x2 o; o.x = pk2(a.x, a.y); o.y = pk2(a.z, a.w); *(u32x2*)(WSP(bf16, WS_XBA) + (size_t)(m + r * step) * 768 + ch) = o; }
}
__device__ __forceinline__ void ssd_unit(KArgs C, int layer, int unit, unsigned char* lds) {
    const int tid = fresh_tid(), lane = tid & 63, wave = tid >> 6, bl = unit >> 3, h = unit & 7, gi = h >> 2, pp = tid >> 3, c8 = (tid & 7) * 8, c16 = lane & 15, q = lane >> 4;
    bf16* Cb = (bf16*)lds; bf16* Bb = Cb + 4096; bf16* XT = Bb + 4096; bf16* BwT = XT + 4096; bf16* Pm = BwT + 4096; float* Yo = (float*)(Pm + 4096); float* dts = Yo + 8192; float* acs = dts + 128;
    const bf16* XA = WSP(const bf16, WS_XBA) + (size_t)bl * SEQ * 768 + (size_t)pp * 768 + c8;
    const bf16* SMp = WSP(const bf16, WS_SM) + (size_t)bl * SEQ * 256;
    const bf16* Zp = WSP(const bf16, WS_Z) + (size_t)bl * SEQ * 512 + (size_t)pp * 512 + h * 64 + c8;
    bf16* YA = WSP(bf16, WS_Y) + (size_t)bl * SEQ * 512 + (size_t)pp * 512 + h * 64 + c8;
    const float dtb = C->in[I_DTB][layer * 8 + h], A = -__expf(C->in[I_ALOG][layer * 8 + h]), Dh = C->in[I_SSDD][layer * 8 + h];
    f32x4_t Sd[2]; bf16x8_t Sf; Sd[0] = (f32x4_t){0.f, 0.f, 0.f, 0.f}; Sd[1] = Sd[0]; { u32x2 z; z.x = 0u; z.y = 0u; Sf = frag2(z, z); }
    const int pt = wave & 3, nh = wave >> 2;
    u32x4 fx, fb, fc, fz;
#define SSD_FETCH(c0_) do { const bf16* q_ = XA + (size_t)(c0_) * 768; fx = *(const u32x4*)(q_ + h * 64); fb = *(const u32x4*)(q_ + 512 + gi * 64); fc = *(const u32x4*)(q_ + 640 + gi * 64); fz = *(const u32x4*)(Zp + (size_t)(c0_) * 512); } while (0)
#define SSD_DT(c0_, par) do { if (wave == 0) { const float dt_ = softplusf(bf2f(SMp[(size_t)((c0_) + lane) * 256 + h]) + dtb); float a_ = A * dt_; \
        _Pragma("unroll") for (int o_ = 1; o_ < 64; o_ <<= 1) { const float t_ = __shfl_up(a_, o_); if (lane >= o_) a_ += t_; } dts[(par) * 64 + lane] = dt_; acs[(par) * 64 + lane] = a_; } } while (0)
    LDS_SYNC();
    SSD_FETCH(0); SSD_DT(0, 0);
    for (int c0 = 0, par = 0; c0 < SEQ; c0 += 64, par ^= 1) {
        LDS_SYNC();
        const u32x4 xk = fx, zk = fz;
        {
          const float dt = dts[par * 64 + pp], ea = __expf(acs[par * 64 + 63] - acs[par * 64 + pp]);
          *(u32x4*)(Cb + pp * 64 + c8) = fc; *(u32x4*)(Bb + pp * 64 + c8) = fb;
          f32x4 x0, x1, b0, b1; pg8::unpack8(fx, x0, x1); pg8::unpack8(fb, b0, b1); x0 = x0 * dt; x1 = x1 * dt; b0 = b0 * ea; b1 = b1 * ea;
#pragma unroll
          for (int i = 0; i < 4; ++i) { XT[(c8 + i) * 64 + pp] = f2bf(x0[i]); XT[(c8 + 4 + i) * 64 + pp] = f2bf(x1[i]); BwT[(c8 + i) * 64 + pp] = f2bf(b0[i]); BwT[(c8 + 4 + i) * 64 + pp] = f2bf(b1[i]); } }
        if (c0 + 64 < SEQ) { SSD_FETCH(c0 + 64); SSD_DT(c0 + 64, par ^ 1); }
        LDS_SYNC();
        {
          const f32x4_t z4 = {0.f, 0.f, 0.f, 0.f};
#pragma unroll
          for (int i = 0; i < 2; ++i) { const int id = wave + 8 * i, lt = id >> 2, st = id & 3; f32x4_t g = z4;
              if (st <= lt) {
#pragma unroll
                  for (int ks = 0; ks < 2; ++ks) g = __builtin_amdgcn_mfma_f32_16x16x32_bf16(*(const bf16x8_t*)(Cb + (16 * lt + c16) * 64 + 32 * ks + 8 * q), *(const bf16x8_t*)(Bb + (16 * st + c16) * 64 + 32 * ks + 8 * q), g, 0, 0, 0);
                  const float as_ = acs[par * 64 + 16 * st + c16];
#pragma unroll
                  for (int r = 0; r < 4; ++r) { const int l = 16 * lt + 4 * q + r; g[r] = (16 * st + c16 <= l) ? g[r] * __expf(acs[par * 64 + l] - as_) : 0.f; } }
#pragma unroll
              for (int r = 0; r < 4; ++r) Pm[(16 * lt + 4 * q + r) * 64 + 16 * st + c16] = f2bf(g[r]); }
#pragma unroll
          for (int lt = 0; lt < 4; ++lt) { const bf16* cr = Cb + (16 * lt + c16) * 64 + 32 * nh + 4 * q;
              const f32x4_t yo = __builtin_amdgcn_mfma_f32_16x16x32_bf16(frag2(*(const u32x2*)cr, *(const u32x2*)(cr + 16)), Sf, z4, 0, 0, 0);
#pragma unroll
              for (int r = 0; r < 4; ++r) Yo[nh * 4096 + (16 * lt + 4 * q + r) * 64 + 16 * pt + c16] = yo[r]; }
          const float eL = __expf(acs[par * 64 + 63]);
          const bf16x8_t xb0 = *(const bf16x8_t*)(XT + (16 * pt + c16) * 64 + 8 * q), xb1 = *(const bf16x8_t*)(XT + (16 * pt + c16) * 64 + 32 + 8 * q);
#pragma unroll
          for (int i = 0; i < 2; ++i) { const bf16* br = BwT + (16 * (2 * nh + i) + c16) * 64 + 8 * q; f32x4_t cin = Sd[i] * eL;
              cin = __builtin_amdgcn_mfma_f32_16x16x32_bf16(*(const bf16x8_t*)br, xb0, cin, 0, 0, 0); Sd[i] = __builtin_amdgcn_mfma_f32_16x16x32_bf16(*(const bf16x8_t*)(br + 32), xb1, cin, 0, 0, 0); }
          u32x2 lo, hi; lo.x = pk2(Sd[0][0], Sd[0][1]); lo.y = pk2(Sd[0][2], Sd[0][3]); hi.x = pk2(Sd[1][0], Sd[1][1]); hi.y = pk2(Sd[1][2], Sd[1][3]); Sf = frag2(lo, hi); }
        LDS_SYNC();
        {
          const f32x4_t z4 = {0.f, 0.f, 0.f, 0.f};
#pragma unroll
          for (int i = 0; i < 2; ++i) { const int id = wave + 8 * i, lt = id >> 2, p2 = id & 3;
              f32x4_t y = __builtin_amdgcn_mfma_f32_16x16x32_bf16(*(const bf16x8_t*)(Pm + (16 * lt + c16) * 64 + 8 * q), *(const bf16x8_t*)(XT + (16 * p2 + c16) * 64 + 8 * q), z4, 0, 0, 0);
              if (lt >= 2) y = __builtin_amdgcn_mfma_f32_16x16x32_bf16(*(const bf16x8_t*)(Pm + (16 * lt + c16) * 64 + 32 + 8 * q), *(const bf16x8_t*)(XT + (16 * p2 + c16) * 64 + 32 + 8 * q), y, 0, 0, 0);
#pragma unroll
              for (int r = 0; r < 4; ++r) { const int l = 16 * lt + 4 * q + r, o = l * 64 + 16 * p2 + c16; Yo[o] = y[r] + __expf(acs[par * 64 + l]) * (Yo[o] + Yo[4096 + o]); } } }
        LDS_SYNC();
        {
          f32x4 x0, x1, z0, z1; pg8::unpack8(xk, x0, x1); pg8::unpack8(zk, z0, z1);
          const f32x4 y0 = (*(const f32x4*)(Yo + pp * 64 + c8) + Dh * x0) * z0 * sig4g(z0), y1 = (*(const f32x4*)(Yo + pp * 64 + c8 + 4) + Dh * x1) * z1 * sig4g(z1);
          *(u32x4*)(YA + (size_t)c0 * 512) = pg8::pack8(y0, y1); }
    }
#undef SSD_FETCH
#undef SSD_DT
}
__device__ __forceinline__ void ssd_norm_item4(KArgs C, int layer, int item0, int stride, int nitems, int lane) {
    u32x2 w[4]; bf16* p[4];
#pragma unroll
    for (int q = 0; q < 4; ++q) { const int item = item0 + q * stride; p[q] = WSP(bf16, WS_Y) + (size_t)((item < nitems ? item : item0) >> 1) * 512 + ((item < nitems ? item : item0) & 1) * 256 + lane * 4; w[q] = *(const u32x2*)p[q]; }
#pragma unroll
    for (int q = 0; q < 4; ++q) { const int item = item0 + q * stride; if (item < nitems) {
        float v[4] = {lo_bf(w[q].x), hi_bf(w[q].x), lo_bf(w[q].y), hi_bf(w[q].y)};
        const float rstd = 1.0f / sqrtf(wave_sum(v[0] * v[0] + v[1] * v[1] + v[2] * v[2] + v[3] * v[3]) * (1.f / 256) + RMS_EPS);
        const float* g = C->in[I_SSDNG] + layer * 512 + (item & 1) * 256 + lane * 4;
        u32x2 o; o.x = pk2(v[0] * rstd * g[0], v[1] * rstd * g[1]); o.y = pk2(v[2] * rstd * g[2], v[3] * rstd * g[3]); *(u32x2*)p[q] = o; } }
}
__device__ __forceinline__ void rwkv_prep_row(KArgs C, int layer, int m, int lane) {
    const int t = m % SEQ, col = 1536 + lane * 4;
    const bf16* cur = WSP(const bf16, WS_RW) + (size_t)m * 1792 + col;
    const u32x2 wc = *(const u32x2*)cur; u32x2 wp; wp.x = 0u; wp.y = 0u; if (t > 0) wp = *(const u32x2*)(cur - 1792);
    const f32x4 mu = *(const f32x4*)(C->in[I_MU] + layer * 1792 + col);
    float v[4] = {lo_bf(wc.x), hi_bf(wc.x), lo_bf(wc.y), hi_bf(wc.y)}; const float p[4] = {lo_bf(wp.x), hi_bf(wp.x), lo_bf(wp.y), hi_bf(wp.y)};
#pragma unroll
    for (int i = 0; i < 4; ++i) { v[i] = v[i] + (p[i] - v[i]) * mu[i]; v[i] = lane < 16 ? tanh_fast(v[i]) : (lane < 32 ? v[i] : sigm(v[i])); }
    u32x2 o; o.x = pk2(v[0], v[1]); o.y = pk2(v[2], v[3]); *(u32x2*)(WSP(bf16, WS_RA) + (size_t)m * 256 + lane * 4) = o;
}
__device__ __forceinline__ void rwkv_prep_row2(KArgs C, int layer, int m, int step, int lane) {
    const int col = 1536 + lane * 4; const f32x4 mu = *(const f32x4*)(C->in[I_MU] + layer * 1792 + col);
    u32x2 wc[2], wp[2];
#pragma unroll
    for (int r = 0; r < 2; ++r) { const int mm = m + r * step; const bf16* cur = WSP(const bf16, WS_RW) + (size_t)mm * 1792 + col; wc[r] = *(const u32x2*)cur;
        if (mm % SEQ > 0) wp[r] = *(const u32x2*)(cur - 1792); else { wp[r].x = 0u; wp[r].y = 0u; } }
#pragma unroll
    for (int r = 0; r < 2; ++r) { float v[4] = {lo_bf(wc[r].x), hi_bf(wc[r].x), lo_bf(wc[r].y), hi_bf(wc[r].y)}; const float p[4] = {lo_bf(wp[r].x), hi_bf(wp[r].x), lo_bf(wp[r].y), hi_bf(wp[r].y)};
#pragma unroll
        for (int i = 0; i < 4; ++i) { v[i] = v[i] + (p[i] - v[i]) * mu[i]; v[i] = lane < 16 ? tanh_fast(v[i]) : (lane < 32 ? v[i] : sigm(v[i])); }
        u32x2 o; o.x = pk2(v[0], v[1]); o.y = pk2(v[2], v[3]); *(u32x2*)(WSP(bf16, WS_RA) + (size_t)(m + r * step) * 256 + lane * 4) = o; }
}
__device__ __forceinline__ void rwkv_unit(KArgs C, int layer, int unit, unsigned char* lds) {
    constexpr int SLOT = 16704, O_RT = 2048, O_BTL = 4096, O_KTL = 6144, O_BHT = 8192, O_KHT = 10240, O_VT = 12288, O_TM = 14336, O_AAK = 14848, O_RB = 15360, O_RK = 15872, O_DL = 16384, O_BON = 16640;
    const int tid = fresh_tid(), lane = tid & 63, wave = tid >> 6, bl = unit >> 3, h = unit & 7, pt = tid >> 3, k8 = (tid & 7) * 8, cc = pt >> 4, tl = pt & 15, hc = h * 64 + k8;
    float* WL = (float*)(lds + 4 * SLOT); float* Nf = WL + 4096; float* Yb = Nf + 1024; float* ct_ = Yb + 4096;
    const bf16* RW = WSP(const bf16, WS_RW) + (size_t)bl * SEQ * 1792 + hc;
    const float* WLG = WSP(const float, WS_WLOG) + (size_t)bl * SEQ * 512 + hc;
    const bf16* AS = WSP(const bf16, WS_ASIG) + (size_t)bl * SEQ * 512 + hc;
    const bf16* GG = WSP(const bf16, WS_GG) + (size_t)bl * SEQ * 512 + hc;
    bf16* YC = WSP(bf16, WS_Y) + (size_t)2 * MG * 512 + (size_t)bl * SEQ * 512 + hc;
    LDS_SYNC();
    { const int row = tid >> 6, j = tid & 63; const float* src = row == 0 ? C->in[I_MU] + layer * 1792 : row == 1 ? C->in[I_MU] + layer * 1792 + 512 : row == 2 ? C->in[I_MU] + layer * 1792 + 1024
          : row == 3 ? C->in[I_KK] + layer * 512 : row == 4 ? C->in[I_KA] + layer * 512 : row == 5 ? C->in[I_RK] + layer * 512 : row == 6 ? C->in[I_LNG] + layer * 512 : C->in[I_LNB] + layer * 512;
      ct_[tid] = src[h * 64 + j]; }
    f32x4_t Sd[4]; bf16x8_t Sf[2];
#pragma unroll
    for (int i = 0; i < 4; ++i) Sd[i] = (f32x4_t){0.f, 0.f, 0.f, 0.f};
    { u32x2 z; z.x = 0u; z.y = 0u; Sf[0] = frag2(z, z); Sf[1] = Sf[0]; }
    u32x4 rc, rp, kc, kp, vc, vp, ac, gc; f32x4 wl0, wl1;
#define RWKV_FETCH(c0_) do { const int tt_ = (c0_) + pt; const bf16* q_ = RW + (size_t)tt_ * 1792; \
        rc = *(const u32x4*)q_; kc = *(const u32x4*)(q_ + 512); vc = *(const u32x4*)(q_ + 1024); \
        if (tt_ > 0) { rp = *(const u32x4*)(q_ - 1792); kp = *(const u32x4*)(q_ - 1792 + 512); vp = *(const u32x4*)(q_ - 1792 + 1024); } else { rp = (u32x4){0u, 0u, 0u, 0u}; kp = rp; vp = rp; } \
        wl0 = *(const f32x4*)(WLG + (size_t)tt_ * 512); wl1 = *(const f32x4*)(WLG + (size_t)tt_ * 512 + 4); ac = *(const u32x4*)(AS + (size_t)tt_ * 512); gc = *(const u32x4*)(GG + (size_t)tt_ * 512); } while (0)
    RWKV_FETCH(0);
    for (int c0 = 0; c0 < SEQ; c0 += 64) {
        unsigned char* slot = lds + cc * SLOT;
        LDS_SYNC();
        f32x4 r0, r1, kq0, kq1, v0, v1, kk0, kk1, b0, b1; const u32x4 gkeep = gc; const f32x4 wk0 = wl0, wk1 = wl1;
        { f32x4 c0_, c1_, p0_, p1_, a0, a1;
          pg8::unpack8(rc, c0_, c1_); pg8::unpack8(rp, p0_, p1_); r0 = c0_ + (p0_ - c0_) * *(const f32x4*)(ct_ + k8); r1 = c1_ + (p1_ - c1_) * *(const f32x4*)(ct_ + k8 + 4);
          pg8::unpack8(kc, c0_, c1_); pg8::unpack8(kp, p0_, p1_); const f32x4 k00 = c0_ + (p0_ - c0_) * *(const f32x4*)(ct_ + 64 + k8), k01 = c1_ + (p1_ - c1_) * *(const f32x4*)(ct_ + 64 + k8 + 4);
          pg8::unpack8(vc, c0_, c1_); pg8::unpack8(vp, p0_, p1_); v0 = c0_ + (p0_ - c0_) * *(const f32x4*)(ct_ + 128 + k8); v1 = c1_ + (p1_ - c1_) * *(const f32x4*)(ct_ + 128 + k8 + 4);
          pg8::unpack8(ac, a0, a1);
          kk0 = k00 * *(const f32x4*)(ct_ + 192 + k8); kk1 = k01 * *(const f32x4*)(ct_ + 192 + k8 + 4);
          const float inv = 1.0f / fmaxf(sqrtf(red8((kk0.x * kk0.x + kk0.y * kk0.y + kk0.z * kk0.z + kk0.w * kk0.w) + (kk1.x * kk1.x + kk1.y * kk1.y + kk1.z * kk1.z + kk1.w * kk1.w))), 1e-12f);
          kk0 = kk0 * inv; kk1 = kk1 * inv; b0 = kk0 * a0; b1 = kk1 * a1;
          kq0 = k00 * (1.0f + (a0 - 1.0f) * *(const f32x4*)(ct_ + 256 + k8)); kq1 = k01 * (1.0f + (a1 - 1.0f) * *(const f32x4*)(ct_ + 256 + k8 + 4));
          const f32x4 q0 = r0 * kq0 * *(const f32x4*)(ct_ + 320 + k8), q1 = r1 * kq1 * *(const f32x4*)(ct_ + 320 + k8 + 4);
          const float bo = red8((q0.x + q0.y + q0.z + q0.w) + (q1.x + q1.y + q1.z + q1.w));
          if ((tid & 7) == 0) ((float*)(slot + O_BON))[tl] = bo;
          *(f32x4*)(WL + pt * 64 + k8) = wk0; *(f32x4*)(WL + pt * 64 + k8 + 4) = wk1; }
        if (c0 + 64 < SEQ) RWKV_FETCH(c0 + 64);
        LDS_SYNC();
        if (tid < 256) { const int c_ = tid >> 6, k_ = tid & 63; float w16[16], run = 0.f;
#pragma unroll
            for (int t = 0; t < 16; ++t) w16[t] = WL[(c_ * 16 + t) * 64 + k_];
#pragma unroll
            for (int t = 0; t < 16; ++t) { run += w16[t]; WL[(c_ * 16 + t) * 64 + k_] = run; }
            ((float*)(lds + c_ * SLOT + O_DL))[k_] = __expf(run); }
        LDS_SYNC();
        { const f32x4 cs0 = *(const f32x4*)(WL + pt * 64 + k8), cs1 = *(const f32x4*)(WL + pt * 64 + k8 + 4), d0 = *(const f32x4*)((const float*)(slot + O_DL) + k8), d1 = *(const f32x4*)((const float*)(slot + O_DL) + k8 + 4);
          f32x4 e0, e1, f0, f1, w0, w1;
#pragma unroll
          for (int i = 0; i < 4; ++i) { e0[i] = __expf(cs0[i]); e1[i] = __expf(cs1[i]); f0[i] = __builtin_amdgcn_rcpf(e0[i]); f1[i] = __builtin_amdgcn_rcpf(e1[i]); w0[i] = __expf(-wk0[i]); w1[i] = __expf(-wk1[i]); }
          const f32x4 bt0 = b0 * f0, bt1 = b1 * f1, kt0 = kq0 * f0, kt1 = kq1 * f1;
          *(u32x4*)((bf16*)slot + tl * 64 + k8) = pg8::pack8(-(kk0 * e0 * w0), -(kk1 * e1 * w1));
          *(u32x4*)((bf16*)(slot + O_RT) + tl * 64 + k8) = pg8::pack8(r0 * e0, r1 * e1);
          *(u32x4*)((bf16*)(slot + O_BTL) + tl * 64 + k8) = pg8::pack8(bt0, bt1);
          *(u32x4*)((bf16*)(slot + O_KTL) + tl * 64 + k8) = pg8::pack8(kt0, kt1);
          const f32x4 bh0 = bt0 * d0, bh1 = bt1 * d1, kh0 = kt0 * d0, kh1 = kt1 * d1;
          bf16* bht = (bf16*)(slot + O_BHT) + k8 * 16 + tl; bf16* kht = (bf16*)(slot + O_KHT) + k8 * 16 + tl; bf16* vt = (bf16*)(slot + O_VT) + k8 * 16 + tl;
#pragma unroll
          for (int i = 0; i < 4; ++i) { bht[i * 16] = f2bf(bh0[i]); bht[(i + 4) * 16] = f2bf(bh1[i]); kht[i * 16] = f2bf(kh0[i]); kht[(i + 4) * 16] = f2bf(kh1[i]); vt[i * 16] = f2bf(v0[i]); vt[(i + 4) * 16] = f2bf(v1[i]); } }
        LDS_SYNC();
        { unsigned char* sl = lds + (wave & 3) * SLOT; const int c16 = lane & 15, q = lane >> 4;
          const bf16x8_t a0 = *(const bf16x8_t*)((const bf16*)sl + c16 * 64 + 8 * q), a1 = *(const bf16x8_t*)((const bf16*)sl + c16 * 64 + 32 + 8 * q);
          const bf16x8_t bb0 = *(const bf16x8_t*)((const bf16*)(sl + O_BTL) + c16 * 64 + 8 * q), bb1 = *(const bf16x8_t*)((const bf16*)(sl + O_BTL) + c16 * 64 + 32 + 8 * q);
          const f32x4_t z4 = {0.f, 0.f, 0.f, 0.f};
          if (wave < 4) {
              f32x4_t n = __builtin_amdgcn_mfma_f32_16x16x32_bf16(a0, bb0, z4, 0, 0, 0); n = __builtin_amdgcn_mfma_f32_16x16x32_bf16(a1, bb1, n, 0, 0, 0);
              float* nf = Nf + (wave & 3) * 256;
#pragma unroll
              for (int r = 0; r < 4; ++r) nf[c16 * 16 + 4 * q + r] = (c16 < 4 * q + r) ? n[r] : 0.f;
              WAVE_SYNC();
              float tc[16];
#pragma unroll
              for (int t = 0; t < 16; ++t) tc[t] = (t == c16) ? 1.f : 0.f;
#pragma unroll
              for (int s2 = 0; s2 < 15; ++s2) { const f32x4 n0 = *(const f32x4*)(nf + s2 * 16), n1 = *(const f32x4*)(nf + s2 * 16 + 4), n2 = *(const f32x4*)(nf + s2 * 16 + 8), n3 = *(const f32x4*)(nf + s2 * 16 + 12);
                  const float ts = tc[s2]; const float nn[16] = {n0.x, n0.y, n0.z, n0.w, n1.x, n1.y, n1.z, n1.w, n2.x, n2.y, n2.z, n2.w, n3.x, n3.y, n3.z, n3.w};
#pragma unroll
                  for (int t = 0; t < 16; ++t) if (t > s2) tc[t] += nn[t] * ts; }
              if (q == 0) { bf16* tm = (bf16*)(sl + O_TM) + c16;
#pragma unroll
                  for (int t = 0; t < 16; ++t) tm[t * 16] = f2bf(tc[t]); }
          } else {
              const bf16x8_t r0f = *(const bf16x8_t*)((const bf16*)(sl + O_RT) + c16 * 64 + 8 * q), r1f = *(const bf16x8_t*)((const bf16*)(sl + O_RT) + c16 * 64 + 32 + 8 * q);
              const bf16x8_t kb0 = *(const bf16x8_t*)((const bf16*)(sl + O_KTL) + c16 * 64 + 8 * q), kb1 = *(const bf16x8_t*)((const bf16*)(sl + O_KTL) + c16 * 64 + 32 + 8 * q);
              f32x4_t ak = __builtin_amdgcn_mfma_f32_16x16x32_bf16(a0, kb0, z4, 0, 0, 0); ak = __builtin_amdgcn_mfma_f32_16x16x32_bf16(a1, kb1, ak, 0, 0, 0);
              f32x4_t rb = __builtin_amdgcn_mfma_f32_16x16x32_bf16(r0f, bb0, z4, 0, 0, 0); rb = __builtin_amdgcn_mfma_f32_16x16x32_bf16(r1f, bb1, rb, 0, 0, 0);
              f32x4_t rk = __builtin_amdgcn_mfma_f32_16x16x32_bf16(r0f, kb0, z4, 0, 0, 0); rk = __builtin_amdgcn_mfma_f32_16x16x32_bf16(r1f, kb1, rk, 0, 0, 0);
#pragma unroll
              for (int r = 0; r < 4; ++r) { const int t = 4 * q + r;
                  ((bf16*)(sl + O_AAK))[t * 16 + c16] = f2bf(c16 < t ? ak[r] : 0.f); ((bf16*)(sl + O_RB))[t * 16 + c16] = f2bf(c16 <= t ? rb[r] : 0.f); ((bf16*)(sl + O_RK))[t * 16 + c16] = f2bf(c16 <= t ? rk[r] : 0.f); }
          } }
        LDS_SYNC();
        if (wave < 4) { const int c16 = lane & 15, q = lane >> 4, vcol = 16 * wave + c16; u32x2 zz; zz.x = 0u; zz.y = 0u; const f32x4_t z4 = {0.f, 0.f, 0.f, 0.f};
#pragma unroll
            for (int ch = 0; ch < 4; ++ch) { const unsigned char* sl = lds + ch * SLOT;
                const bf16* at = (const bf16*)sl + c16 * 64 + 4 * q; const bf16* rt = (const bf16*)(sl + O_RT) + c16 * 64 + 4 * q;
                const bf16x8_t af0 = frag2(*(const u32x2*)at, *(const u32x2*)(at + 16)), af1 = frag2(*(const u32x2*)(at + 32), *(const u32x2*)(at + 48));
                const bf16x8_t rf0 = frag2(*(const u32x2*)rt, *(const u32x2*)(rt + 16)), rf1 = frag2(*(const u32x2*)(rt + 32), *(const u32x2*)(rt + 48));
                const u32x2 vq = *(const u32x2*)((const bf16*)(sl + O_VT) + vcol * 16 + 4 * q);
                const u32x2 aq = *(const u32x2*)((const bf16*)(sl + O_AAK) + c16 * 16 + 4 * q), tq = *(const u32x2*)((const bf16*)(sl + O_TM) + c16 * 16 + 4 * q);
                const u32x2 rbq = *(const u32x2*)((const bf16*)(sl + O_RB) + c16 * 16 + 4 * q), rkq = *(const u32x2*)((const bf16*)(sl + O_RK) + c16 * 16 + 4 * q);
                f32x4_t rhs = __builtin_amdgcn_mfma_f32_16x16x32_bf16(frag2(zz, aq), frag2(zz, vq), z4, 0, 0, 0); rhs = __builtin_amdgcn_mfma_f32_16x16x32_bf16(af0, Sf[0], rhs, 0, 0, 0);
                { const f32x4_t r2 = __builtin_amdgcn_mfma_f32_16x16x32_bf16(af1, Sf[1], z4, 0, 0, 0); rhs = rhs + r2; }
                u32x2 rl; rl.x = pk2(rhs[0], rhs[1]); rl.y = pk2(rhs[2], rhs[3]);
                const f32x4_t U = __builtin_amdgcn_mfma_f32_16x16x32_bf16(frag2(tq, zz), frag2(rl, zz), z4, 0, 0, 0);
                u32x2 ul; ul.x = pk2(U[0], U[1]); ul.y = pk2(U[2], U[3]); const bf16x8_t uv = frag2(ul, vq);
                f32x4_t y = __builtin_amdgcn_mfma_f32_16x16x32_bf16(rf0, Sf[0], z4, 0, 0, 0); y = __builtin_amdgcn_mfma_f32_16x16x32_bf16(rf1, Sf[1], y, 0, 0, 0);
                y = __builtin_amdgcn_mfma_f32_16x16x32_bf16(frag2(rbq, rkq), uv, y, 0, 0, 0);
#pragma unroll
                for (int r = 0; r < 4; ++r) Yb[(ch * 16 + 4 * q + r) * 64 + vcol] = y[r];
#pragma unroll
                for (int kt = 0; kt < 4; ++kt) { const f32x4 dl = *(const f32x4*)((const float*)(sl + O_DL) + 16 * kt + 4 * q);
                    const u32x2 bq = *(const u32x2*)((const bf16*)(sl + O_BHT) + (16 * kt + c16) * 16 + 4 * q), kq = *(const u32x2*)((const bf16*)(sl + O_KHT) + (16 * kt + c16) * 16 + 4 * q);
                    const f32x4_t cin = {Sd[kt][0] * dl.x, Sd[kt][1] * dl.y, Sd[kt][2] * dl.z, Sd[kt][3] * dl.w};
                    Sd[kt] = __builtin_amdgcn_mfma_f32_16x16x32_bf16(frag2(bq, kq), uv, cin, 0, 0, 0); }
#pragma unroll
                for (int s2 = 0; s2 < 2; ++s2) { u32x2 lo, hi; lo.x = pk2(Sd[2 * s2][0], Sd[2 * s2][1]); lo.y = pk2(Sd[2 * s2][2], Sd[2 * s2][3]); hi.x = pk2(Sd[2 * s2 + 1][0], Sd[2 * s2 + 1][1]); hi.y = pk2(Sd[2 * s2 + 1][2], Sd[2 * s2 + 1][3]); Sf[s2] = frag2(lo, hi); }
            } }
        LDS_SYNC();
        { const f32x4 y0 = *(const f32x4*)(Yb + pt * 64 + k8), y1 = *(const f32x4*)(Yb + pt * 64 + k8 + 4);
          const float mean = red8((y0.x + y0.y + y0.z + y0.w) + (y1.x + y1.y + y1.z + y1.w)) * (1.f / 64); const f32x4 d0 = y0 - mean, d1 = y1 - mean;
          const float rstd = 1.0f / sqrtf(red8((d0.x * d0.x + d0.y * d0.y + d0.z * d0.z + d0.w * d0.w) + (d1.x * d1.x + d1.y * d1.y + d1.z * d1.z + d1.w * d1.w)) * (1.f / 64) + GN_EPS);
          const float bo = ((const float*)(slot + O_BON))[tl]; f32x4 g0, g1; pg8::unpack8(gkeep, g0, g1);
          const f32x4 o0 = (d0 * rstd * *(const f32x4*)(ct_ + 384 + k8) + *(const f32x4*)(ct_ + 448 + k8) + bo * v0) * g0, o1 = (d1 * rstd * *(const f32x4*)(ct_ + 384 + k8 + 4) + *(const f32x4*)(ct_ + 448 + k8 + 4) + bo * v1) * g1;
          *(u32x4*)(YC + (size_t)(c0 + pt) * 512) = pg8::pack8(o0, o1); }
    }
#undef RWKV_FETCH
}

__device__ __forceinline__ void s5_unit(KArgs C, int layer, int unit, unsigned char* lds) {
    const int tid = fresh_tid(), lane = tid & 63, wave = tid >> 6, bl = unit >> 5, g = unit & 31, c16 = lane & 15, q = lane >> 4, sg = wave & 3, th = wave >> 2, p = 16 * sg + c16;
    constexpr int SP = 136;
    float* us = (float*)lds; float* ends = us + 1024; bf16* St = (bf16*)(ends + 16 * 128);
    const bf16* U = WSP(const bf16, WS_U) + (size_t)bl * SEQ * 512 + g * 16;
    bf16* YD0 = WSP(bf16, WS_YD0) + (size_t)bl * SEQ * 512 + g * 16;
    const size_t wo = (layer & 1) ? WDELTA : 0;
    bf16x8_t bre, bim;
    { const float* bb = WSP(const float, WS_BBAR + wo) + ((size_t)g * 64 + p) * 32; u32x4 wr_, wi_;
      if (q < 2) { const float* b8 = bb + 16 * q; wr_.x = pk2(b8[0], b8[2]); wr_.y = pk2(b8[4], b8[6]); wr_.z = pk2(b8[8], b8[10]); wr_.w = pk2(b8[12], b8[14]);
                   wi_.x = pk2(b8[1], b8[3]); wi_.y = pk2(b8[5], b8[7]); wi_.z = pk2(b8[9], b8[11]); wi_.w = pk2(b8[13], b8[15]); }
      else { wr_ = (u32x4){0u, 0u, 0u, 0u}; wi_ = wr_; }
      bre = __builtin_bit_cast(bf16x8_t, wr_); bim = __builtin_bit_cast(bf16x8_t, wi_); }
    float apr[4], api[4];
    { const float ar = WSP(const float, WS_ABAR + wo)[(g * 64 + p) * 2], ai = WSP(const float, WS_ABAR + wo)[(g * 64 + p) * 2 + 1]; apr[0] = ar; api[0] = ai;
#pragma unroll
      for (int i = 1; i < 4; ++i) { apr[i] = apr[i - 1] * ar - api[i - 1] * ai; api[i] = apr[i - 1] * ai + api[i - 1] * ar; } }
    bf16x8_t cf[4];
    { const float* cre = C->in[I_S5CRE] + ((size_t)layer * 32 + g) * 1024 + c16 * 64; const float* cim = C->in[I_S5CIM] + ((size_t)layer * 32 + g) * 1024 + c16 * 64;
#pragma unroll
      for (int ks = 0; ks < 4; ++ks) { const int c0_ = 32 * ks + 8 * q; const float* src = c0_ < 64 ? cre + c0_ : cim + (c0_ - 64); const float sgn = c0_ < 64 ? 1.f : -1.f;
          u32x4 w; w.x = pk2(sgn * src[0], sgn * src[1]); w.y = pk2(sgn * src[2], sgn * src[3]); w.z = pk2(sgn * src[4], sgn * src[5]); w.w = pk2(sgn * src[6], sgn * src[7]); cf[ks] = __builtin_bit_cast(bf16x8_t, w); } }
    const float dj = C->in[I_S5D][layer * 512 + g * 16 + c16];
    float cr = 0.f, ci = 0.f;
    u32x2 fu; fu.x = 0u; fu.y = 0u;
#define S5_FETCH(c0_) do { if (tid < 256) fu = *(const u32x2*)(U + (size_t)((c0_) + (tid >> 2)) * 512 + (tid & 3) * 4); } while (0)
    S5_FETCH(0);
    for (int c0 = 0; c0 < SEQ; c0 += 64) {
        LDS_SYNC();
        if (tid < 256) *(f32x4*)(us + (tid >> 2) * 16 + (tid & 3) * 4) = (f32x4){lo_bf(fu.x), hi_bf(fu.x), lo_bf(fu.y), hi_bf(fu.y)};
        if (c0 + 64 < SEQ) S5_FETCH(c0 + 64);
        LDS_SYNC();
        float lr[2][4], li[2][4];
#pragma unroll
        for (int tt = 0; tt < 2; ++tt) { bf16x8_t af;
            if (q < 2) { const float* ur = us + (32 * th + 16 * tt + c16) * 16 + 8 * q; const f32x4 u0 = *(const f32x4*)ur, u1 = *(const f32x4*)(ur + 4);
                u32x4 w; w.x = pk2(u0.x, u0.y); w.y = pk2(u0.z, u0.w); w.z = pk2(u1.x, u1.y); w.w = pk2(u1.z, u1.w); af = __builtin_bit_cast(bf16x8_t, w); }
            else { const u32x4 z = {0u, 0u, 0u, 0u}; af = __builtin_bit_cast(bf16x8_t, z); }
            const f32x4_t z4 = {0.f, 0.f, 0.f, 0.f};
            const f32x4_t dre = __builtin_amdgcn_mfma_f32_16x16x32_bf16(af, bre, z4, 0, 0, 0), dim = __builtin_amdgcn_mfma_f32_16x16x32_bf16(af, bim, z4, 0, 0, 0);
            lr[tt][0] = dre[0]; li[tt][0] = dim[0];
#pragma unroll
            for (int r = 1; r < 4; ++r) { lr[tt][r] = apr[0] * lr[tt][r - 1] - api[0] * li[tt][r - 1] + dre[r]; li[tt][r] = apr[0] * li[tt][r - 1] + api[0] * lr[tt][r - 1] + dim[r]; }
            const int rho = (2 * th + tt) * 4 + q; ends[(rho * 64 + p) * 2] = lr[tt][3]; ends[(rho * 64 + p) * 2 + 1] = li[tt][3]; }
        LDS_SYNC();
        { float xr = cr, xi = ci; const int rho0 = (2 * th) * 4 + q;
          for (int rr = 0; rr < 16; ++rr) {
              if (rr == rho0 || rr == rho0 + 4) { const int tt = (rr == rho0) ? 0 : 1;
#pragma unroll
                  for (int r = 0; r < 4; ++r) { const float sr = lr[tt][r] + apr[r] * xr - api[r] * xi, si = li[tt][r] + apr[r] * xi + api[r] * xr; const int t = 32 * th + 16 * tt + 4 * q + r;
                      St[t * SP + p] = f2bf(sr); St[t * SP + 64 + p] = f2bf(si); } }
              const float er = ends[(rr * 64 + p) * 2], ei = ends[(rr * 64 + p) * 2 + 1]; const float nr = apr[3] * xr - api[3] * xi + er, ni = apr[3] * xi + api[3] * xr + ei; xr = nr; xi = ni; }
          cr = xr; ci = xi; }
        LDS_SYNC();
        if (wave < 4) { f32x4_t y = {0.f, 0.f, 0.f, 0.f};
#pragma unroll
            for (int ks = 0; ks < 4; ++ks) y = __builtin_amdgcn_mfma_f32_16x16x32_bf16(*(const bf16x8_t*)(St + (16 * wave + c16) * SP + 32 * ks + 8 * q), cf[ks], y, 0, 0, 0);
#pragma unroll
            for (int r = 0; r < 4; ++r) { const int t = 16 * wave + 4 * q + r; YD0[(size_t)(c0 + t) * 512 + c16] = f2bf(gelu_tanh(y[r] + dj * us[t * 16 + c16])); } }
    }
#undef S5_FETCH
}

__device__ __forceinline__ unsigned ord_key(float f) { const unsigned u = __float_as_uint(f); return (u & 0x80000000u) ? ~u : (u | 0x80000000u); }
__device__ __forceinline__ void dsa_vt_item(KArgs C, int item, int lane, bf16* scr) {
    const int tb = item % NK64, bh = item / NK64, h = bh & 7, bl = bh >> 3;
    const bf16* V = WSP(const bf16, WS_V) + ((size_t)bl * SEQ + tb * 64) * 512 + h * 64;
    WAVE_SYNC();
#pragma unroll
    for (int i = 0; i < 8; ++i) { const int tk = (lane >> 3) + 8 * i, c8 = (lane & 7) * 8; const u32x4 w = *(const u32x4*)(V + (size_t)tk * 512 + c8);
        unsigned* d = (unsigned*)(scr + tk * 66 + c8); d[0] = w.x; d[1] = w.y; d[2] = w.z; d[3] = w.w; }
    WAVE_SYNC();
    bf16* Vt = WSP(bf16, WS_VT) + ((size_t)bh * 64) * SEQ + tb * 64 + lane;
#pragma unroll 8
    for (int d = 0; d < 64; ++d) Vt[(size_t)d * SEQ] = scr[lane * 66 + d];
}
constexpr int IDX_CAP = 128, IDX_NBIN = 1024;
__device__ __forceinline__ void dsa_index_unit(KArgs C, int unit, int lane, int wave, unsigned char* lds) {
    const int oct = unit & 7, pairid = (unit >> 3) % (NK64 / 2), kx = (unit >> 3) / (NK64 / 2), bl = kx >> 1, c = (kx & 1) ? NK64 - 1 - pairid : pairid;
    const int t0 = c * 64 + oct * 8, nkeys = (c + 1) * 64, nk64 = c + 1; const size_t row0 = (size_t)bl * SEQ + t0;
    unsigned* mrow = WSP(unsigned, WS_MASK) + (row0 + wave) * MW;
    if (nkeys <= TOPK) { for (int w = lane; w < MW; w += 64) mrow[w] = (w * 32 < nkeys) ? 0xffffffffu : 0u; return; }
    float* scf = (float*)lds;
    unsigned* hist = (unsigned*)(lds + LDS_X) + wave * (IDX_NBIN / 2); unsigned* candv = (unsigned*)(lds + LDS_X + 8 * IDX_NBIN * 2) + wave * IDX_CAP; unsigned* candi = candv + 8 * IDX_CAP; unsigned* mword = (unsigned*)(lds + LDS_X + 8 * IDX_NBIN * 2 + 16 * IDX_CAP * 4) + wave * MW;
    const bf16* SMb = WSP(const bf16, WS_SM) + (size_t)bl * SEQ * 256;
    const int l31 = lane & 31, half = lane >> 5;
    const bf16* qa = SMb + (size_t)(t0 + (l31 >> 2)) * 256 + 8 + (l31 & 3) * 32 + 8 * half;
    const bf16x8_t a0 = *(const bf16x8_t*)qa, a1 = *(const bf16x8_t*)(qa + 16);
    u32x2 wraw[4];
#pragma unroll
    for (int g = 0; g < 4; ++g) wraw[g] = *(const u32x2*)(SMb + (size_t)(t0 + 2 * g + half) * 256 + 168);
    LDS_SYNC();
    {
      float wv[4][4];
#pragma unroll
      for (int g = 0; g < 4; ++g) { const u32x2 w = wraw[g]; wv[g][0] = lo_bf(w.x) * 0.5f; wv[g][1] = hi_bf(w.x) * 0.5f; wv[g][2] = lo_bf(w.y) * 0.5f; wv[g][3] = hi_bf(w.y) * 0.5f; }
      for (int kt0 = wave; kt0 < nk64 * 2; kt0 += 8 * NWAVES) {
          bf16x8_t b0[8], b1[8];
#pragma unroll
          for (int u4 = 0; u4 < 8; ++u4) { const int kt = kt0 + 8 * u4; const bf16* kb = WSP(const bf16, WS_KI) + ((size_t)bl * SEQ + (size_t)((kt < nk64 * 2 ? kt : wave) * 32 + l31)) * 32 + 8 * half;
              b0[u4] = *(const bf16x8_t*)kb; b1[u4] = *(const bf16x8_t*)(kb + 16); }
#pragma unroll
          for (int u4 = 0; u4 < 8; ++u4) { const int kt = kt0 + 8 * u4; if (kt < nk64 * 2) {
              f32x16 d;
#pragma unroll
              for (int r = 0; r < 16; ++r) d[r] = 0.f;
              d = __builtin_amdgcn_mfma_f32_32x32x16_bf16(a0, b0[u4], d, 0, 0, 0); d = __builtin_amdgcn_mfma_f32_32x32x16_bf16(a1, b1[u4], d, 0, 0, 0);
#pragma unroll
              for (int g = 0; g < 4; ++g) { float sc = 0.f;
#pragma unroll
                  for (int j = 0; j < 4; ++j) sc += wv[g][j] * fmaxf(d[4 * g + j] * 0.17677669529f, 0.f);
                  scf[(2 * g + half) * SEQ + kt * 32 + l31] = sc; } } }
      } }
    { const int tail0 = nkeys, tail1 = ((nk64 + 7) >> 3) * 512;
      for (int e = tail0 + (int)(threadIdx.x); e < tail1; e += NTHREADS) {
#pragma unroll
          for (int qq = 0; qq < 8; ++qq) scf[qq * SEQ + e] = -3.0e38f; } }
    LDS_SYNC();
    const float* sc = scf + wave * SEQ; constexpr float NEG = -3.0e38f; const int nb8 = (nk64 + 7) >> 3;
    float v[NK64];
#pragma unroll
    for (int ib = 0; ib < NK64 / 8; ++ib) if (ib < nb8) {
#pragma unroll
        for (int j = 0; j < 8; ++j) v[ib * 8 + j] = sc[(ib * 8 + j) * 64 + lane];
        SCHED_FENCE(); }
    float mn = INFINITY, mx = -INFINITY;
#pragma unroll
    for (int ib = 0; ib < NK64 / 8; ++ib) if (ib < nb8) {
#pragma unroll
        for (int j = 0; j < 8; ++j) { const float x = v[ib * 8 + j]; mx = fmaxf(mx, x); mn = fminf(mn, x == NEG ? INFINITY : x); } }
    mn = -wave_max(-mn); mx = wave_max(mx);
    const float scale = (mx > mn) ? ((float)IDX_NBIN - 0.01f) / (mx - mn) : 0.f;
#pragma unroll
    for (int i = 0; i < IDX_NBIN / 128; ++i) hist[lane * (IDX_NBIN / 128) + i] = 0u;
    for (int w = lane; w < MW; w += 64) mword[w] = 0u;
    WAVE_SYNC();
#define IDX_BIN(x) ({ int b_ = (int)(fmaxf((x) - mn, 0.f) * scale); b_ > IDX_NBIN - 1 ? IDX_NBIN - 1 : b_; })
#pragma unroll
    for (int ib = 0; ib < NK64 / 8; ++ib) if (ib < nb8) {
#pragma unroll
        for (int j = 0; j < 8; ++j) { const int b = IDX_BIN(v[ib * 8 + j]); atomicAdd(&hist[b >> 1], (b & 1) ? 0x10000u : 1u); }
        SCHED_FENCE(); }
    WAVE_SYNC();
    int bstar, cgt;
    {
      unsigned hw[8]; int tot = 0;
#pragma unroll
      for (int i = 0; i < 8; ++i) { hw[i] = hist[lane * 8 + i]; tot += (int)(hw[i] & 0xffffu) + (int)(hw[i] >> 16); }
      int suf = tot;
#pragma unroll
      for (int o = 1; o < 64; o <<= 1) { const int t = __shfl_down(suf, o); if (lane + o < 64) suf += t; }
      const unsigned long long ge = __ballot(suf >= TOPK); const int L = 63 - __builtin_clzll(ge);
      int cum = __shfl(suf, L) - __shfl(tot, L); bstar = 16 * L; cgt = cum; bool found = false;
#pragma unroll
      for (int i = 7; i >= 0; --i) { const unsigned w = (unsigned)__shfl((int)hw[i], L); const int chi = (int)(w >> 16), clo = (int)(w & 0xffffu);
          if (!found && cum + chi >= TOPK) { bstar = 16 * L + 2 * i + 1; cgt = cum; found = true; } cum += found ? 0 : chi;
          if (!found && cum + clo >= TOPK) { bstar = 16 * L + 2 * i; cgt = cum; found = true; } cum += found ? 0 : clo; } }
    const int need = TOPK - cgt; int ncand = 0;
    unsigned mylo = 0u, myhi = 0u;
#pragma unroll
    for (int ib = 0; ib < NK64 / 8; ++ib) if (ib < nb8) {
#pragma unroll
        for (int j = 0; j < 8; ++j) { const int i = ib * 8 + j; const int b = IDX_BIN(v[i]);
            const unsigned long long bs = __ballot(b > bstar), bc = __ballot(b == bstar);
            if (lane == i) { mylo = (unsigned)bs; myhi = (unsigned)(bs >> 32); }
            if (bc != 0ull) {
                const int pos = ncand + (int)__builtin_amdgcn_mbcnt_hi((unsigned)(bc >> 32), __builtin_amdgcn_mbcnt_lo((unsigned)bc, 0u));
                if (b == bstar && pos < IDX_CAP) { candv[pos] = ord_key(v[i]); candi[pos] = (unsigned)(i * 64 + lane); }
                ncand += __popcll(bc); } }
        SCHED_FENCE(); }
    if (lane < nb8 * 8) { mword[2 * lane] = mylo; mword[2 * lane + 1] = myhi; }
#undef IDX_BIN
    WAVE_SYNC();
    if (ncand <= IDX_CAP) {
        for (int m = lane; m < ncand; m += 64) { const unsigned vm = candv[m]; int rank = 0;
#pragma unroll 4
            for (int j = 0; j < ncand; ++j) { const unsigned vj = candv[j]; rank += (vj > vm || (vj == vm && j < m)) ? 1 : 0; }
            if (rank < need) { const unsigned idx = candi[m]; atomicOr(&mword[idx >> 5], 1u << (idx & 31)); } }
    } else {
        unsigned T = 0u;
        for (int bit = 31; bit >= 0; --bit) { const unsigned cand = T | (1u << bit); int cn = 0;
#pragma unroll
            for (int ib = 0; ib < NK64 / 8; ++ib) if (ib < nb8) {
#pragma unroll
                for (int j = 0; j < 8; ++j) cn += (ord_key(v[ib * 8 + j]) >= cand) ? 1 : 0; }
            if (wave_sum_i(cn) >= TOPK) T = cand; }
        int cg = 0;
#pragma unroll
        for (int ib = 0; ib < NK64 / 8; ++ib) if (ib < nb8) {
#pragma unroll
            for (int j = 0; j < 8; ++j) cg += (ord_key(v[ib * 8 + j]) > T) ? 1 : 0; }
        const int need2 = TOPK - wave_sum_i(cg); int taken = 0;
#pragma unroll
        for (int ib = 0; ib < NK64 / 8; ++ib) if (ib < nb8) {
#pragma unroll
            for (int j = 0; j < 8; ++j) { const int i = ib * 8 + j; const unsigned kv = ord_key(v[i]); const bool eq = kv == T; const unsigned long long be = __ballot(eq);
                const int pre = __popcll(be & ((1ull << lane) - 1ull)); const bool sel = (kv > T) || (eq && (taken + pre) < need2); taken += __popcll(be);
                const unsigned long long bs = __ballot(sel); if (lane == 0) { mword[2 * i] = (unsigned)bs; mword[2 * i + 1] = (unsigned)(bs >> 32); } } }
    }
    WAVE_SYNC();
    for (int w = lane; w < MW; w += 64) mrow[w] = mword[w];
}

constexpr int AT_KP = 72, AT_VP = 72, AT_BUF = 64 * AT_KP + 64 * AT_VP;
__device__ __forceinline__ void dsa_attn_half(KArgs C, int bl, int h, int cb, int tid, bf16* tiles, const float* btab) {
    const int lane = tid & 63, wave = tid >> 6, l31 = lane & 31, hh = lane >> 5, c = 4 * cb + (wave >> 1), qb = wave & 1, q0 = c * 64 + qb * 32, qpos = q0 + l31, q0s = __builtin_amdgcn_readfirstlane(q0);
    const size_t qrow = (size_t)bl * SEQ + qpos;
    const bf16* Qp = WSP(const bf16, WS_Q) + qrow * 512 + h * 64 + 8 * hh;
    const unsigned* Mp = WSP(const unsigned, WS_MASK) + qrow * MW;
    const bf16* gk = WSP(const bf16, WS_K) + ((size_t)bl * SEQ + (tid >> 3)) * 512 + h * 64 + (tid & 7) * 8;
    const bf16* gv = WSP(const bf16, WS_VT) + ((size_t)(bl * 8 + h) * 64 + (tid >> 3)) * SEQ + (tid & 7) * 8;
    const int lk = (tid >> 3) * AT_KP + (tid & 7) * 8, lv = 64 * AT_KP + (tid >> 3) * AT_VP + (tid & 7) * 8;
    constexpr float SC = 0.125f * 1.44269504089f;
    bf16x8_t qf[4];
#pragma unroll
    for (int s = 0; s < 4; ++s) qf[s] = *(const bf16x8_t*)(Qp + 16 * s);
    f32x16 O0, O1;
#pragma unroll
    for (int r = 0; r < 16; ++r) { O0[r] = 0.f; O1[r] = 0.f; }
    float m = -1e30f, lsum = 0.f;
    const int ntw = c + 1, nt = 4 * cb + 4;
    u32x4 prek = *(const u32x4*)gk, prev = *(const u32x4*)gv; u32x2 mwn = *(const u32x2*)Mp;
    LDS_SYNC();
    const float bfar = btab[0];
    *(u32x4*)(tiles + lk) = prek; *(u32x4*)(tiles + lv) = prev;
    if (nt > 1) { prek = *(const u32x4*)(gk + (size_t)64 * 512); prev = *(const u32x4*)(gv + 64); }
    for (int kt = 0; kt < nt; ++kt) {
        LDS_SYNC();
        const bf16* tb = tiles + (kt & 1) * AT_BUF; const u32x2 mw2 = mwn;
        if (kt + 1 < ntw) mwn = *(const u32x2*)(Mp + 2 * (kt + 1));
        if (kt < ntw) {
            f32x16 S[2];
#pragma unroll
            for (int t2 = 0; t2 < 2; ++t2) {
#pragma unroll
                for (int r = 0; r < 16; ++r) S[t2][r] = 0.f;
#pragma unroll
                for (int s = 0; s < 4; ++s) S[t2] = __builtin_amdgcn_mfma_f32_32x32x16_bf16(*(const bf16x8_t*)(tb + (t2 * 32 + l31) * AT_KP + 16 * s + 8 * hh), qf[s], S[t2], 0, 0, 0); }
#define AT_P2(P_, X0_, X1_, MW_, R_, ROW_) do { f32x2 pp_; pp_.x = __uint_as_float(__float_as_uint(__builtin_amdgcn_exp2f(X0_)) & bit_fill<ROW_>(MW_)); \
                pp_.y = __uint_as_float(__float_as_uint(__builtin_amdgcn_exp2f(X1_)) & bit_fill<ROW_ + 1>(MW_)); P_[R_] = pp_.x; P_[R_ + 1] = pp_.y; ps2 += pp_; } while (0)
#define AT_RESCALE(TM_) do { float tm_ = (TM_); tm_ = fmaxf(tm_, __shfl_xor(tm_, 32)); \
                if (__ballot(tm_ > m) != 0ull) { const float mn = fmaxf(m, tm_), alpha = __builtin_amdgcn_exp2f(m - mn); m = mn; lsum *= alpha; \
                    _Pragma("unroll") for (int r = 0; r < 16; ++r) { O0[r] *= alpha; O1[r] *= alpha; } } } while (0)
            f32x16 P[2]; f32x2 ps2 = (f32x2){0.f, 0.f}; float tm;
            const unsigned mwc0 = mw2.x >> (4 * hh), mwc1 = mw2.y >> (4 * hh);
            const bool far = (kt * 64 + 63 - q0s) <= -166;
            if (far) { float rm = fmaxf(S[0][0], S[1][0]);
#pragma unroll
                for (int r = 1; r < 16; ++r) rm = fmaxf(fmaxf(rm, S[0][r]), S[1][r]);
                tm = rm * SC + bfar;
            } else { tm = -1e30f;
#pragma unroll
                for (int t2 = 0; t2 < 2; ++t2) { const int rb = kt * 64 + t2 * 32 + 4 * hh - qpos + 256;
#pragma unroll
                    for (int r = 0; r < 16; ++r) { const int row = (r & 3) + 8 * (r >> 2); int ti = rb + row; ti = ti < 0 ? 0 : ti; tm = fmaxf(tm, S[t2][r] * SC + btab[ti]); } } }
            AT_RESCALE(tm);
            if (far) { const float ad = bfar - m;
#define AT_FAR(R_, ROW_) do { const f32x2 x0_ = (f32x2){S[0][R_], S[0][R_ + 1]} * SC + ad, x1_ = (f32x2){S[1][R_], S[1][R_ + 1]} * SC + ad; \
                    AT_P2(P[0], x0_.x, x0_.y, mwc0, R_, ROW_); AT_P2(P[1], x1_.x, x1_.y, mwc1, R_, ROW_); } while (0)
                AT_FAR(0, 0); AT_FAR(2, 2); AT_FAR(4, 8); AT_FAR(6, 10); AT_FAR(8, 16); AT_FAR(10, 18); AT_FAR(12, 24); AT_FAR(14, 26);
#undef AT_FAR
            } else {
#define AT_BIAS(T2_, R_, ROW_) (S[T2_][R_] * SC + (btab[imax0(kt * 64 + (T2_) * 32 + 4 * hh - qpos + 256 + (ROW_))] - m))
#define AT_NEAR(R_, ROW_) do { AT_P2(P[0], AT_BIAS(0, R_, ROW_), AT_BIAS(0, R_ + 1, ROW_ + 1), mwc0, R_, ROW_); AT_P2(P[1], AT_BIAS(1, R_, ROW_), AT_BIAS(1, R_ + 1, ROW_ + 1), mwc1, R_, ROW_); } while (0)
                AT_NEAR(0, 0); AT_NEAR(2, 2); AT_NEAR(4, 8); AT_NEAR(6, 10); AT_NEAR(8, 16); AT_NEAR(10, 18); AT_NEAR(12, 24); AT_NEAR(14, 26);
#undef AT_BIAS
#undef AT_NEAR
            }
#undef AT_P2
#undef AT_RESCALE
            const float ps = ps2.x + ps2.y;
            lsum += ps;
#pragma unroll
            for (int t2 = 0; t2 < 2; ++t2) { const bf16* vb = tb + 64 * AT_KP + l31 * AT_VP + t2 * 32 + 4 * hh;
#pragma unroll
                for (int s = 0; s < 2; ++s) { u32x4 w; w.x = pk2(P[t2][8 * s + 0], P[t2][8 * s + 1]); w.y = pk2(P[t2][8 * s + 2], P[t2][8 * s + 3]); w.z = pk2(P[t2][8 * s + 4], P[t2][8 * s + 5]); w.w = pk2(P[t2][8 * s + 6], P[t2][8 * s + 7]);
                    const bf16x8_t pf = __builtin_bit_cast(bf16x8_t, w);
                    O0 = __builtin_amdgcn_mfma_f32_32x32x16_bf16(frag2(*(const u32x2*)(vb + 16 * s), *(const u32x2*)(vb + 16 * s + 8)), pf, O0, 0, 0, 0);
                    O1 = __builtin_amdgcn_mfma_f32_32x32x16_bf16(frag2(*(const u32x2*)(vb + 32 * AT_VP + 16 * s), *(const u32x2*)(vb + 32 * AT_VP + 16 * s + 8)), pf, O1, 0, 0, 0); } }
        }
        if (kt + 1 < nt) { bf16* nb = tiles + ((kt + 1) & 1) * AT_BUF; *(u32x4*)(nb + lk) = prek; *(u32x4*)(nb + lv) = prev;
            if (kt + 2 < nt) { prek = *(const u32x4*)(gk + (size_t)(kt + 2) * 64 * 512); prev = *(const u32x4*)(gv + (size_t)(kt + 2) * 64); } }
    }
    lsum += __shfl_xor(lsum, 32);
    const float inv = 1.0f / lsum;
    bf16* Y = WSP(bf16, WS_Y) + (size_t)MG * 512 + qrow * 512 + h * 64 + 4 * hh;
#pragma unroll
    for (int g = 0; g < 4; ++g) { u32x2 w; w.x = pk2(O0[4 * g] * inv, O0[4 * g + 1] * inv); w.y = pk2(O0[4 * g + 2] * inv, O0[4 * g + 3] * inv); *(u32x2*)(Y + 8 * g) = w;
        u32x2 w2; w2.x = pk2(O1[4 * g] * inv, O1[4 * g + 1] * inv); w2.y = pk2(O1[4 * g + 2] * inv, O1[4 * g + 3] * inv); *(u32x2*)(Y + 32 + 8 * g) = w2; }
}
__device__ __forceinline__ void dsa_attn_unit3(KArgs C, int unit, int tid, unsigned char* lds) {
    constexpr int NPAIR = NK64 / 8;
    const int pr = unit % NPAIR, h = (unit / NPAIR) & 7, bl = unit / (NPAIR * 8);
    float* btab = (float*)lds; bf16* tiles = (bf16*)(lds + 2048);
    __syncthreads();
    { const int* tab = WSP(const int, WS_TAB); const float* relb = C->in[I_RELB];
      if (tid < 320) btab[tid] = relb[tab[tid - 256 + SEQ - 1] * 8 + h] * 1.44269504089f; }
    dsa_attn_half(C, bl, h, pr, tid, tiles, btab);
    dsa_attn_half(C, bl, h, NK64 / 4 - 1 - pr, tid, tiles, btab);
}
#ifndef GP_ALIGN
#define GP_ALIGN true
#endif
#ifndef GP_SP2
#define GP_SP2 true
#endif
constexpr int SEGS_PER_GROUP = 11, NSEG = DEPTH * (1 + NGRP * SEGS_PER_GROUP) + 1;

#ifdef HOST_EMU
#define GRID_BARRIER() emu_grid_sync()
#define LDS_PTR(p) ((unsigned char*)(p))
#else
#define GRID_BARRIER() do { XcdBarrier b_; b_.bar = (unsigned*)(Ck->ws + WS_CTL); b_.x = xb_xcc_id(); b_.st = (volatile LAS unsigned*)(lds + LDS_CTL_OFF); xcd_barrier(b_); } while (0)
#define LDS_PTR(p) ((PG8_LAS unsigned char*)(p))
#endif

__global__ void __launch_bounds__(NTHREADS, 2) fwd_kernel(Args a) {
#ifdef HOST_EMU
    unsigned char* lds = emu_lds;
#else
    extern __shared__ __attribute__((aligned(16))) unsigned char lds[];
#endif
#ifdef HOST_EMU
    KArgs Ck = &a;
#else
    KArgs Ck = (KArgs)__builtin_amdgcn_kernarg_segment_ptr();
    (void)a;
#endif
#ifndef HOST_EMU
    if (threadIdx.x < 4) ((LAS unsigned*)(lds + LDS_CTL_OFF))[threadIdx.x] = 0u;
    __syncthreads();
    if (Ck->seg_hi - Ck->seg_lo > 1) (void)xcd_barrier_post((unsigned*)(Ck->ws + WS_CTL), (volatile LAS unsigned*)(lds + LDS_CTL_OFF));
#endif
#define SEGID 0
#define RUN (SEGID >= Ck->seg_lo && SEGID < Ck->seg_hi)
#define SEAM do { if (SEGID >= Ck->seg_lo && SEGID + 1 < Ck->seg_hi) { GRID_BARRIER(); } } while (0)
#define WO ((layer & 1) ? WDELTA : (size_t)0)
#define PHASE_VARS KArgs C = KLAUNDER(Ck); const int G = gridDim.x, bx = blockIdx.x, ngw = G * NWAVES; (void)ngw; const int tid = fresh_tid(), lane = tid & 63, wave = __builtin_amdgcn_readfirstlane(tid >> 6), gw = bx * NWAVES + wave; (void)lane; (void)gw; (void)C
    for (int layer = 0; layer < DEPTH; ++layer) {
#undef SEGID
#define SEGID (layer * (1 + NGRP * SEGS_PER_GROUP))
        if (RUN) { PHASE_VARS; phase_weights(C, layer, lds, gw, ngw, lane, wave); }
        SEAM;
        for (int grp = 0; grp < NGRP; ++grp) {
#define XIN ((layer == 0 ? C->in[I_X] : (const float*)C->out) + (size_t)grp * MG * D)
#define XOUT (C->out + (size_t)grp * MG * D)
#undef SEGID
#define SEGID (layer * (1 + NGRP * SEGS_PER_GROUP) + 1 + grp * SEGS_PER_GROUP + 0)
            if (RUN) { PHASE_VARS; for (int m = gw; m < MG; m += 2 * ngw) { if (m + ngw < MG) rms_rowN_bf16<2>(XIN + (size_t)m * D, C->in[I_NMIX] + layer * D, WSP(bf16, WS_H) + (size_t)m * D, (size_t)ngw * D, lane); else rms_row_bf16(XIN + (size_t)m * D, C->in[I_NMIX] + layer * D, WSP(bf16, WS_H) + (size_t)m * D, lane); } }
            SEAM;
#undef SEGID
#define SEGID (layer * (1 + NGRP * SEGS_PER_GROUP) + 1 + grp * SEGS_PER_GROUP + 1)
            if (RUN) { PHASE_VARS; pg8::Gemm g{WSP(const bf16, WS_H), WSP(const bf16, WS_WIN + WO), MG, NMIXC, D}; pg8::StaticOrder S; S.init(MG, NMIXC, G, bx);
                pg8::EpiProj E{C->ws};
                pg8::gemm_phase<pg8::EpiProj, pg8::StaticOrder, false, GP_ALIGN, GP_SP2>(LDS_PTR(lds), g, S, E, nullptr); }
            SEAM;
#undef SEGID
#define SEGID (layer * (1 + NGRP * SEGS_PER_GROUP) + 1 + grp * SEGS_PER_GROUP + 2)
            if (RUN) { PHASE_VARS;
                for (int m = gw; m < MG; m += 2 * ngw) { if (m + ngw < MG) { rwkv_prep_row2(C, layer, m, ngw, lane); ssd_conv_row2(C, layer, m, ngw, lane); } else { rwkv_prep_row(C, layer, m, lane); ssd_conv_row(C, layer, m, lane); } }
                for (int it = gw; it < NB * 8 * NK64; it += ngw) dsa_vt_item(C, it, lane, (bf16*)(lds + wave * 16384));
                __syncthreads();
                for (int u = bx; u < NB * NK64 * 8; u += G) dsa_index_unit(C, u, lane, wave, lds);
            }
            SEAM;
#undef SEGID
#define SEGID (layer * (1 + NGRP * SEGS_PER_GROUP) + 1 + grp * SEGS_PER_GROUP + 3)
            if (RUN) { PHASE_VARS; pg8::Gemm g{WSP(const bf16, WS_RA), WSP(const bf16, WS_WLORA + WO), MG, 1536, 256}; pg8::StaticOrder S; S.init(MG, 1536, G, bx);
                pg8::EpiLora E{WSP(float, WS_WLOG), WSP(bf16, WS_ASIG), WSP(bf16, WS_GG), C->in[I_W0] + layer * 512, C->in[I_A0] + layer * 512};
                pg8::gemm_phase<pg8::EpiLora, pg8::StaticOrder, false, GP_ALIGN, GP_SP2>(LDS_PTR(lds), g, S, E, nullptr); }
            SEAM;
#undef SEGID
#define SEGID (layer * (1 + NGRP * SEGS_PER_GROUP) + 1 + grp * SEGS_PER_GROUP + 4)
            if (RUN) { PHASE_VARS;
                constexpr int U_R = NB * 8, U_S = U_R + NB * 8;
                for (int u = bx; u < U_R; u += G) rwkv_unit(C, layer, u, lds);
                for (int u = (bx + G - U_R % G) % G; u < NB * 8; u += G) ssd_unit(C, layer, u, lds);
                { const int first = U_S % G, span = G - first;
                  if (bx >= first) for (int u = bx - first; u < NB * 32; u += span) s5_unit(C, layer, u, lds); }
                for (;;) {
                    const int t2 = fresh_tid();
                    volatile unsigned* qs2 = (volatile unsigned*)(lds + LDS_CTL_OFF + 32);
                    __syncthreads();
                    if (t2 == 0) *qs2 = atomicAdd((unsigned*)(Ck->ws + WS_QCTR) + ((layer * NGRP + grp) * 2) * 64, 1u);
                    __syncthreads();
                    const int u = (int)*qs2;
                    if (u >= NB * NK64) break;
                    dsa_attn_unit3(KLAUNDER(Ck), u, t2, lds);
                }
            }
            SEAM;
#undef SEGID
#define SEGID (layer * (1 + NGRP * SEGS_PER_GROUP) + 1 + grp * SEGS_PER_GROUP + 5)
            if (RUN) { PHASE_VARS;
                { pg8::Gemm g{WSP(const bf16, WS_H), WSP(const bf16, WS_WIN + WO) + (size_t)NMIXC * D, MG, 4096, D}; pg8::StaticOrder S; S.init(MG, 4096, G, bx);
                  pg8::EpiGate E{WSP(bf16, WS_G)}; pg8::gemm_phase<pg8::EpiGate, pg8::StaticOrder, false, GP_ALIGN, GP_SP2>(LDS_PTR(lds), g, S, E, nullptr); }
                { pg8::Gemm g{WSP(const bf16, WS_YD0), WSP(const bf16, WS_GLU + WO), MG, 512, 512}; pg8::StaticOrder S; S.init(MG, 512, G, bx);
                  pg8::EpiGlu E{WSP(const bf16, WS_YD0), WSP(bf16, WS_Y) + (size_t)3 * MG * 512, C->in[I_GLUB] + layer * 512};
                  pg8::gemm_phase<pg8::EpiGlu, pg8::StaticOrder, false, GP_ALIGN, GP_SP2>(LDS_PTR(lds), g, S, E, nullptr); }
                for (int it = gw; it < MG * 2; it += 4 * ngw) ssd_norm_item4(C, layer, it, ngw, MG * 2, lane);
            }
            SEAM;
#undef SEGID
#define SEGID (layer * (1 + NGRP * SEGS_PER_GROUP) + 1 + grp * SEGS_PER_GROUP + 6)
            if (RUN) { PHASE_VARS; pg8::Gemm g{WSP(const bf16, WS_Y), WSP(const bf16, WS_WB + WO), 4 * MG, 4096, 512}; pg8::MergeOrder S{G, bx};
                pg8::EpiMerge E{WSP(const bf16, WS_G), WSP(bf16, WS_MRG)};
                pg8::gemm_phase<pg8::EpiMerge, pg8::MergeOrder, false, GP_ALIGN, GP_SP2>(LDS_PTR(lds), g, S, E, nullptr); }
            SEAM;
#undef SEGID
#define SEGID (layer * (1 + NGRP * SEGS_PER_GROUP) + 1 + grp * SEGS_PER_GROUP + 7)
            if (RUN) { PHASE_VARS; pg8::Gemm g{WSP(const bf16, WS_MRG), WSP(const bf16, WS_WOUT + WO), MG, D, D}; pg8::StaticOrder S; S.init(MG, D, G, bx);
                pg8::EpiResid E{XIN, XOUT}; pg8::gemm_phase<pg8::EpiResid, pg8::StaticOrder, false, GP_ALIGN, GP_SP2>(LDS_PTR(lds), g, S, E, nullptr); }
            SEAM;
#undef SEGID
#define SEGID (layer * (1 + NGRP * SEGS_PER_GROUP) + 1 + grp * SEGS_PER_GROUP + 8)
            if (RUN) { PHASE_VARS; for (int m = gw; m < MG; m += 2 * ngw) { if (m + ngw < MG) rms_rowN_bf16<2>(XOUT + (size_t)m * D, C->in[I_NFFN] + layer * D, WSP(bf16, WS_H) + (size_t)m * D, (size_t)ngw * D, lane); else rms_row_bf16(XOUT + (size_t)m * D, C->in[I_NFFN] + layer * D, WSP(bf16, WS_H) + (size_t)m * D, lane); } }
            SEAM;
#undef SEGID
#define SEGID (layer * (1 + NGRP * SEGS_PER_GROUP) + 1 + grp * SEGS_PER_GROUP + 9)
            if (RUN) { PHASE_VARS; pg8::Gemm g{WSP(const bf16, WS_H), WSP(const bf16, WS_W13 + WO), MG, 5632, D}; pg8::StaticOrder S; S.init(MG, 5632, G, bx);
                pg8::EpiSwiglu E{WSP(bf16, WS_HID)};
                pg8::gemm_phase<pg8::EpiSwiglu, pg8::StaticOrder, false, GP_ALIGN, GP_SP2>(LDS_PTR(lds), g, S, E, nullptr); }
            SEAM;
#undef SEGID
#define SEGID (layer * (1 + NGRP * SEGS_PER_GROUP) + 1 + grp * SEGS_PER_GROUP + 10)
            if (RUN) { PHASE_VARS; pg8::Gemm g{WSP(const bf16, WS_HID), WSP(const bf16, WS_W2 + WO), MG, D, FFN}; pg8::StaticOrder S; S.init(MG, D, G, bx);
                pg8::EpiResid E{XOUT, XOUT}; pg8::gemm_phase<pg8::EpiResid, pg8::StaticOrder, false, GP_ALIGN, GP_SP2>(LDS_PTR(lds), g, S, E, nullptr); }
            SEAM;
        }
    }
#undef SEGID
#define SEGID (NSEG - 1)
    { const int layer = 0; (void)layer;
    if (RUN) { PHASE_VARS; for (int m = gw; m < M; m += 2 * ngw) { if (m + ngw < M) rms_row2_f32(C->out + (size_t)m * D, (size_t)ngw * D, C->in[I_NFIN], lane); else rms_row_f32(C->out + (size_t)m * D, C->in[I_NFIN], lane); } } }
#undef RUN
#undef SEAM
}

extern "C" void kernel_launch(void* const* d_in, const int* in_sizes, int n_in, void* d_out, int out_size, void* d_ws, size_t ws_size, hipStream_t stream) {
    static int grid = 0;
    if (grid == 0) {
        if (n_in != N_IN || out_size != M * D || ws_size < WS_END) { fprintf(stderr, "kernel_launch: unexpected shapes (n_in %d, out %d, ws %zu < %zu)\n", n_in, out_size, ws_size, (size_t)WS_END); grid = -1; return; }
        int dev = 0, cus = 0;
        if (hipGetDevice(&dev) != hipSuccess || hipDeviceGetAttribute(&cus, hipDeviceAttributeMultiprocessorCount, dev) != hipSuccess || cus < 1) { grid = -1; return; }
        if (hipFuncSetAttribute((const void*)fwd_kernel, hipFuncAttributeMaxDynamicSharedMemorySize, LDS_BYTES) != hipSuccess) { fprintf(stderr, "kernel_launch: hipFuncSetAttribute failed\n"); grid = -1; return; }
        (void)hipGetLastError();
        grid = cus;
    }
    if (grid < 0) return;
    (void)hipMemsetAsync((char*)d_ws + WS_CTL, 0, CTL_BYTES, stream);
    Args a{};
    for (int i = 0; i < N_IN; ++i) a.in[i] = (const float*)d_in[i];
    a.out = (float*)d_out; a.ws = (unsigned char*)d_ws;
#if CFG_LAUNCHES == 1
    a.seg_lo = 0; a.seg_hi = NSEG;
    hipLaunchKernelGGL(fwd_kernel, dim3(grid), dim3(NTHREADS), LDS_BYTES, stream, a);
#else
    for (int s = 0; s < NSEG; ++s) { a.seg_lo = s; a.seg_hi = s + 1; hipLaunchKernelGGL(fwd_kernel, dim3(grid), dim3(NTHREADS), LDS_BYTES, stream, a); }
#endif
}
```

```cpp
#ifdef HOST_EMU
#error "HOST_EMU is a host-only debug build"
#else
#include <hip/hip_runtime.h>
#endif
#include <cstdio>
#include <cstdint>
#include <cmath>

#ifndef CFG_BATCH
#define CFG_BATCH 16
#endif
#ifndef CFG_SEQ
#define CFG_SEQ 4096
#endif
#ifndef CFG_DEPTH
#define CFG_DEPTH 4
#endif
#ifndef CFG_NB
#define CFG_NB 8
#endif
#ifndef CFG_LAUNCHES
#define CFG_LAUNCHES 1
#endif

typedef unsigned short bf16;
typedef float f32x4 __attribute__((ext_vector_type(4)));
typedef float f32x2 __attribute__((ext_vector_type(2)));
typedef unsigned u32x4 __attribute__((ext_vector_type(4)));
typedef unsigned u32x2 __attribute__((ext_vector_type(2)));

constexpr int BATCH = CFG_BATCH, SEQ = CFG_SEQ, DEPTH = CFG_DEPTH, NB = CFG_NB;
constexpr int D = 1024, M = BATCH * SEQ, MG = NB * SEQ, NGRP = BATCH / NB;
constexpr int IN_COLS = 9388, NPROJ = 9472, NMIXC = 5376, FFN = 2816;
constexpr int TOPK = (SEQ / 4) < 256 ? (SEQ / 4) : 256;
constexpr int NK64 = SEQ / 64, MW = SEQ / 32;
constexpr float RMS_EPS = 1e-6f, GN_EPS = 64e-5f;
static_assert(BATCH % NB == 0 && MG % 256 == 0 && SEQ % 64 == 0, "shape");

enum { I_X = 0, I_RELB, I_NMIX, I_WIN, I_CONVW, I_CONVB, I_DTB, I_ALOG, I_SSDD, I_SSDNG, I_MU, I_W0, I_W2, I_A0, I_A2, I_G2, I_KK, I_KA, I_RK, I_LNG, I_LNB,
       I_S5ARE, I_S5AIM, I_S5BRE, I_S5BIM, I_S5CRE, I_S5CIM, I_S5D, I_S5LDT, I_GLUW, I_GLUB, I_WBR, I_WOUT, I_NFFN, I_W1, I_W3, I_W2F, I_NFIN, N_IN };

constexpr size_t MiB = 1u << 20;
constexpr size_t al256(size_t x) { return (x + 255) & ~(size_t)255; }
constexpr size_t WS_CTL = 0, CTL_BYTES = 64 * 1024;
constexpr size_t WS_TAB = WS_CTL + CTL_BYTES;
constexpr size_t WS_ABAR = al256(WS_TAB + (SEQ + 64) * 4);
constexpr size_t WS_BBAR = WS_ABAR + 32 * 64 * 2 * 4;
constexpr size_t WS_WIN = al256(WS_BBAR + 32 * 64 * 16 * 2 * 4);
constexpr size_t WS_WB = WS_WIN + (size_t)NPROJ * 1024 * 2;
constexpr size_t WS_WOUT = WS_WB + (size_t)4 * 1024 * 512 * 2;
constexpr size_t WS_W13 = WS_WOUT + (size_t)1024 * 1024 * 2;
constexpr size_t WS_W2 = WS_W13 + (size_t)5632 * 1024 * 2;
constexpr size_t WS_GLU = WS_W2 + (size_t)1024 * 2816 * 2;
constexpr size_t WS_WLORA = WS_GLU + (size_t)512 * 512 * 2;
constexpr size_t WS_H = al256(WS_WLORA + (size_t)1536 * 256 * 2);
constexpr size_t WS_Z = WS_H + (size_t)MG * 1024 * 2;
constexpr size_t WS_XBC = WS_Z + (size_t)MG * 512 * 2;
constexpr size_t WS_Q = WS_XBC + (size_t)MG * 768 * 2;
constexpr size_t WS_K = WS_Q + (size_t)MG * 512 * 2;
constexpr size_t WS_V = WS_K + (size_t)MG * 512 * 2;
constexpr size_t WS_RW = WS_V + (size_t)MG * 512 * 2;
constexpr size_t WS_U = WS_RW + (size_t)MG * 1792 * 2;
constexpr size_t WS_SM = WS_U + (size_t)MG * 512 * 2;
constexpr size_t WS_G = WS_Q;
constexpr size_t WS_Y = WS_SM + (size_t)MG * 256 * 2;
constexpr size_t WS_YD0 = WS_Y + (size_t)4 * MG * 512 * 2;
constexpr size_t WS_MRG = WS_YD0 + (size_t)MG * 512 * 2;
constexpr size_t WS_MASK = WS_MRG + (size_t)MG * 1024 * 2;
constexpr size_t WS_RA = WS_MASK + (size_t)MG * MW * 4;
constexpr size_t WS_WLOG = WS_RA + (size_t)MG * 256 * 2;
constexpr size_t WS_ASIG = WS_WLOG + (size_t)MG * 512 * 4;
constexpr size_t WS_GG = WS_ASIG + (size_t)MG * 512 * 2;
constexpr size_t WS_XBA = WS_GG + (size_t)MG * 512 * 2;
constexpr size_t WS_VT = WS_XBA + (size_t)MG * 768 * 2;
constexpr size_t WS_KI = WS_VT + (size_t)MG * 512 * 2;
constexpr size_t WS_QCTR = 16384;
constexpr size_t WS_HID = WS_G;
constexpr size_t WS_WALT = al256(WS_KI + (size_t)MG * 32 * 2);
constexpr size_t WDELTA = WS_WALT - WS_ABAR;
constexpr size_t WS_END = WS_WALT + (WS_H - WS_ABAR);
static_assert(WS_SM + (size_t)MG * 256 * 2 - WS_Q == (size_t)MG * 4096 * 2, "G overlays exactly Q..SM");
static_assert((size_t)MG * 2816 * 2 <= (size_t)MG * 4096 * 2, "HID fits in G");

constexpr int LDS_SCRATCH = 131072;
constexpr int LDS_CTL_OFF = LDS_SCRATCH;
constexpr int LDS_X = LDS_SCRATCH + 64;
constexpr int LDS_BYTES = 161792;
constexpr int NTHREADS = 512, NWAVES = 8;

__device__ __forceinline__ float bf2f(bf16 v) { return __uint_as_float(((unsigned)v) << 16); }
#ifdef HOST_EMU
__device__ __forceinline__ bf16 f2bf(float f) { unsigned u = __float_as_uint(f); u += 0x7fffu + ((u >> 16) & 1u); return (bf16)(u >> 16); }
#else
__device__ __forceinline__ bf16 f2bf(float f) { return __builtin_bit_cast(bf16, (__bf16)f); }
#endif
#ifdef HOST_EMU
__device__ __forceinline__ unsigned pk2(float lo, float hi) { return (unsigned)f2bf(lo) | ((unsigned)f2bf(hi) << 16); }
#else
typedef __bf16 bf16x2_hw __attribute__((ext_vector_type(2)));
__device__ __forceinline__ unsigned pk2(float lo, float hi) { const f32x2 v = {lo, hi}; return __builtin_bit_cast(unsigned, __builtin_convertvector(v, bf16x2_hw)); }
#endif
__device__ __forceinline__ float lo_bf(unsigned w) { return __uint_as_float(w << 16); }
__device__ __forceinline__ float hi_bf(unsigned w) { return __uint_as_float(w & 0xffff0000u); }
#ifndef HOST_EMU
__device__ __forceinline__ float sigm(float x) { return __builtin_amdgcn_rcpf(1.0f + __expf(-x)); }
#else
__device__ __forceinline__ float sigm(float x) { return 1.0f / (1.0f + __expf(-x)); }
#endif
#ifndef HOST_EMU
template <int BIT> __device__ __forceinline__ unsigned bit_fill(unsigned w) { unsigned r; asm("v_bfe_i32 %0, %1, %2, 1" : "=v"(r) : "v"(w), "n"(BIT)); return r; }
#else
template <int BIT> __device__ __forceinline__ unsigned bit_fill(unsigned w) { return ((w >> BIT) & 1u) ? 0xffffffffu : 0u; }
#endif
__device__ __forceinline__ int imax0(int v) { return v < 0 ? 0 : v; }
__device__ __forceinline__ float tanh_fast(float x) { return 2.0f * sigm(2.0f * x) - 1.0f; }
__device__ __forceinline__ float softplusf(float x) { return x > 20.f ? x : log1pf(__expf(x)); }
__device__ __forceinline__ float gelu_tanh(float x) { const float u = 0.7978845608f * (x + 0.044715f * x * x * x); return x * sigm(2.0f * u); }
__device__ __forceinline__ float wave_sum(float v) {
#pragma unroll
    for (int o = 1; o < 64; o <<= 1) v += __shfl_xor(v, o);
    return v;
}
__device__ __forceinline__ float wave_max(float v) {
#pragma unroll
    for (int o = 1; o < 64; o <<= 1) v = fmaxf(v, __shfl_xor(v, o));
    return v;
}
__device__ __forceinline__ int wave_sum_i(int v) {
#pragma unroll
    for (int o = 1; o < 64; o <<= 1) v += __shfl_xor(v, o);
    return v;
}
#ifdef HOST_EMU
#define WAVE_SYNC() (void)emu_wave_exchange(0)
#define SCHED_FENCE() do {} while (0)
#define LDS_SYNC() __syncthreads()
#else
#define WAVE_SYNC() __builtin_amdgcn_wave_barrier()
#define SCHED_FENCE() __builtin_amdgcn_sched_barrier(0)
#define LDS_SYNC() do { asm volatile("s_waitcnt lgkmcnt(0)" ::: "memory"); __builtin_amdgcn_s_barrier(); asm volatile("" ::: "memory"); } while (0)
#endif
#ifndef HOST_EMU
namespace pg8 {
__device__ __forceinline__ int pg8_fresh_tid() { int t = (int)threadIdx.x; asm volatile("" : "+v"(t)); return t; }
#define PG8_LAS __attribute__((address_space(3)))
typedef unsigned short bf16_t;
typedef short bf16x8 __attribute__((ext_vector_type(8)));
typedef float f32x4 __attribute__((ext_vector_type(4)));
typedef unsigned u32x4 __attribute__((ext_vector_type(4)));
constexpr int BM = 256, BK = 64, HALF = 128, HTB = HALF * BK * 2  , STAGE_BYTES = 8 * HTB, NXCD = 8, WGM = 8;

__host__ __device__ __forceinline__ int lds_byte(int r, int c) { const int st = (r >> 4) * 2 + (c >> 5), rr = r & 15, cc = c & 31, ob = rr * 64 + cc * 2; return st * 1024 + (ob ^ (((ob >> 9) & 1) << 5)); }
__host__ __device__ __forceinline__ void stage_rc(int b, int& R, int& C) { const int st = b / 1024, sb = b % 1024, swz = sb ^ (((sb >> 9) & 1) << 5); R = (st >> 1) * 16 + swz / 64; C = (st & 1) * 32 + (swz % 64) / 2; }
__host__ __device__ __forceinline__ int perm32(int rho) { const int n = rho >> 4, i = rho & 15; return 8 * (i >> 2) + 4 * n + (i & 3); }

struct Unit { int pm, pn; };
struct Gemm { const bf16_t* A; const bf16_t* Bt; int M, N, K; };

struct StaticOrder {
    int nM, nN, nwg, G, c;
    __host__ __device__ void init(int M, int N, int G_, int c_) { nM = M / BM; nN = N / BM; nwg = nM * nN; G = G_; c = c_; }
    __host__ __device__ bool next(int i, Unit& u) const {
        const long L = (long)i * G + c; if (L >= nwg) return false;
        int wgid = (int)L; { const int q = nwg / NXCD, r = nwg % NXCD, xcd = wgid % NXCD, off = wgid / NXCD; wgid = (xcd < r ? xcd * (q + 1) : r * (q + 1) + (xcd - r) * q) + off; }
        const int nig = WGM * nN, gid = wgid / nig, fm = gid * WGM, gsz = (nM - fm) < WGM ? (nM - fm) : WGM;
        u.pm = fm + ((wgid % nig) % gsz); u.pn = (wgid % nig) / gsz; return true;
    }
    __device__ __forceinline__ void a_ready(const Unit&) const {}
    __device__ __forceinline__ void done(const Unit&) const {}
};

__device__ __forceinline__ unsigned cvt_pk_bf16(float lo, float hi) { return pk2(lo, hi); }

template <class E, class = void> struct epi_keep { static constexpr bool value = false; };
template <class E> struct epi_keep<E, decltype((void)E::KEEP_ACC)> { static constexpr bool value = true; };
template <class Epi, class Sched, bool STAMP = false, bool ALIGN_EPI = false, bool SP2 = false>
__device__ __forceinline__ void gemm_phase(PG8_LAS unsigned char* lds, const Gemm g, const Sched& S, const Epi& E, unsigned long long* stamps) {
    const int tid = pg8_fresh_tid(), wid = __builtin_amdgcn_readfirstlane(tid >> 6), lane = tid & 63, wr = wid >> 2, wc = wid & 3, fr = lane & 15, fq = lane >> 4;
    int K_ = g.K; asm volatile("" : "+s"(K_));
    const int K = K_, nt = K / BK;
    int ts_lo = 0, ts_hi = 0, nts = 0; const unsigned long long rt_entry = STAMP ? (unsigned long long)wall_clock64() : 0ull;
#define PG8_STAMP() do { if (STAMP && wid == 0 && nts < 64) { const unsigned long long _c = (unsigned long long)clock64(); \
        ts_lo = (lane == nts) ? (int)(unsigned)_c : ts_lo; ts_hi = (lane == nts) ? (int)(unsigned)(_c >> 32) : ts_hi; ++nts; } } while (0)
    PG8_STAMP();
    unsigned voffA[2], voffB[2];
#pragma unroll
    for (int i = 0; i < 2; ++i) { int R, C; stage_rc(tid * 16 + i * 8192, R, C); const int Rb = Epi::PERM ? ((R & ~31) + perm32(R & 31)) : R;
        voffA[i] = (unsigned)(R * K + C) * 2u; voffB[i] = (unsigned)(Rb * K + C) * 2u; }
    const size_t kstep = (size_t)(BK * 2);
    const size_t hstep = (size_t)HALF * K * 2;
    const size_t tstep = 2 * hstep;
    const unsigned ldsw = (unsigned)wid * 1024u;
    const int aoff = lds_byte(wr * 64 + fr, fq * 8), boff = lds_byte(wc * 32 + fr, fq * 8);
#define PG8_SA(b, h) (((b) * 2 + (h)) * HTB)
#define PG8_SB(b, h) ((4 + (b) * 2 + (h)) * HTB)
#define PG8_STAGE(bufoff, gbase, voff) do { _Pragma("unroll") for (int _i = 0; _i < 2; ++_i) \
        __builtin_amdgcn_global_load_lds((const unsigned*)((const char*)(gbase) + (voff)[_i]), (PG8_LAS unsigned*)(lds + (bufoff) + ldsw + _i * 8192), 16, 0, 0); } while (0)
#define PG8_LDA(dst, b, h) do { _Pragma("unroll") for (int m = 0; m < 4; ++m) _Pragma("unroll") for (int k = 0; k < 2; ++k) dst[m][k] = *(const PG8_LAS bf16x8*)(lds + PG8_SA(b, h) + aoff + m * 2048 + k * 1024); } while (0)
#define PG8_LDB(dst, b, h) do { _Pragma("unroll") for (int n = 0; n < 2; ++n) _Pragma("unroll") for (int k = 0; k < 2; ++k) dst[n][k] = *(const PG8_LAS bf16x8*)(lds + PG8_SB(b, h) + boff + n * 2048 + k * 1024); } while (0)
#define PG8_MMA(ai, bj, At, Bt) do { __builtin_amdgcn_s_setprio(1); _Pragma("unroll") for (int m = 0; m < 4; ++m) _Pragma("unroll") for (int n = 0; n < 2; ++n) _Pragma("unroll") for (int k = 0; k < 2; ++k) \
        acc[ai][bj][m][n] = __builtin_amdgcn_mfma_f32_16x16x32_bf16(Bt[n][k], At[m][k], acc[ai][bj][m][n], 0, 0, 0); __builtin_amdgcn_s_setprio(0); } while (0)
#define PG8_WAIT_V(n) asm volatile("s_waitcnt vmcnt(" #n ")" ::: "memory")
#define PG8_WAIT_L(n) asm volatile("s_waitcnt lgkmcnt(" #n ")" ::: "memory")
#define PG8_BAR __builtin_amdgcn_s_barrier()
#define PG8_SCHED __builtin_amdgcn_sched_barrier(0)
    Unit cur, nxt; int ui = 0;
    if (!S.next(0, cur)) return;
    f32x4 acc[2][2][4][2];
#pragma unroll
    for (int a = 0; a < 2; ++a)
#pragma unroll
        for (int b = 0; b < 2; ++b)
#pragma unroll
            for (int m = 0; m < 4; ++m)
#pragma unroll
                for (int n = 0; n < 2; ++n) acc[a][b][m][n] = (f32x4){0.f, 0.f, 0.f, 0.f};
    bf16x8 At[4][2], B0[2][2], B1[2][2];
    const char* cA = (const char*)g.A + (size_t)cur.pm * tstep; const char* cB = (const char*)g.Bt + (size_t)cur.pn * tstep;
    S.a_ready(cur);
    if constexpr (SP2) {
        PG8_STAGE(PG8_SB(0, 0), cB, voffB); PG8_STAGE(PG8_SB(0, 1), cB + hstep, voffB); PG8_STAGE(PG8_SA(0, 0), cA, voffA); PG8_STAGE(PG8_SA(0, 1), cA + hstep, voffA);
        if (wr == 1) PG8_BAR;
        PG8_WAIT_V(2); PG8_BAR;
        PG8_STAGE(PG8_SB(1, 0), cB + kstep, voffB); PG8_STAGE(PG8_SA(1, 0), cA + kstep, voffA); PG8_STAGE(PG8_SB(1, 1), cB + hstep + kstep, voffB);
        PG8_WAIT_V(6); PG8_BAR;
    } else {
    PG8_STAGE(PG8_SB(0, 0), cB, voffB); PG8_STAGE(PG8_SA(0, 0), cA, voffA); PG8_STAGE(PG8_SB(0, 1), cB + hstep, voffB); PG8_STAGE(PG8_SA(0, 1), cA + hstep, voffA);
    if (wr == 1) PG8_BAR;
    PG8_WAIT_V(4); PG8_BAR;
    PG8_STAGE(PG8_SB(1, 0), cB + kstep, voffB); PG8_STAGE(PG8_SA(1, 0), cA + kstep, voffA); PG8_STAGE(PG8_SB(1, 1), cB + hstep + kstep, voffB);
    PG8_WAIT_V(6); PG8_BAR;
    }
    PG8_STAMP();
    for (;;) {
        const bool has_next = S.next(ui + 1, nxt);
        const char* nA = has_next ? (const char*)g.A + (size_t)nxt.pm * tstep : cA; const char* nB = has_next ? (const char*)g.Bt + (size_t)nxt.pn * tstep : cB;
        for (int t = 0; t < nt; t += 2) {
            const bool last = (t == nt - 2);
            const char* a1 = cA + (size_t)(t + 1) * kstep;
            const char* a2 = last ? nA : cA + (size_t)(t + 2) * kstep; const char* b2 = last ? nB : cB + (size_t)(t + 2) * kstep;
            const char* a3 = a2 + kstep; const char* b3 = b2 + kstep;
            if (last && has_next) S.a_ready(nxt);
            if constexpr (SP2) {
            PG8_LDB(B0, 0, 0); PG8_LDB(B1, 0, 1); PG8_SCHED; PG8_LDA(At, 0, 0); PG8_STAGE(PG8_SA(1, 1), a1 + hstep, voffA);
            PG8_WAIT_V(8); PG8_WAIT_L(0); PG8_BAR; PG8_MMA(0, 0, At, B0); PG8_MMA(0, 1, At, B1); PG8_BAR; PG8_SCHED;
            PG8_LDA(At, 0, 1); PG8_STAGE(PG8_SB(0, 0), b2, voffB); PG8_STAGE(PG8_SB(0, 1), b2 + hstep, voffB); PG8_STAGE(PG8_SA(0, 0), a2, voffA);
            PG8_WAIT_V(8); PG8_WAIT_L(0); PG8_BAR; PG8_MMA(1, 0, At, B0); PG8_MMA(1, 1, At, B1); PG8_BAR; PG8_SCHED;
            PG8_LDB(B0, 1, 0); PG8_LDB(B1, 1, 1); PG8_SCHED; PG8_LDA(At, 1, 0); PG8_STAGE(PG8_SA(0, 1), a2 + hstep, voffA);
            PG8_WAIT_V(8); PG8_WAIT_L(0); PG8_BAR; PG8_MMA(0, 0, At, B0); PG8_MMA(0, 1, At, B1); PG8_BAR; PG8_SCHED;
            PG8_LDA(At, 1, 1); PG8_STAGE(PG8_SB(1, 0), b3, voffB); PG8_STAGE(PG8_SB(1, 1), b3 + hstep, voffB); PG8_STAGE(PG8_SA(1, 0), a3, voffA);
            PG8_WAIT_V(8); PG8_WAIT_L(0); PG8_BAR; PG8_MMA(1, 0, At, B0); PG8_MMA(1, 1, At, B1); PG8_BAR; PG8_SCHED;
            } else {
            PG8_LDB(B0, 0, 0); PG8_SCHED; PG8_LDA(At, 0, 0); PG8_STAGE(PG8_SA(1, 1), a1 + hstep, voffA);
            PG8_WAIT_L(8); PG8_BAR; PG8_WAIT_L(0); PG8_MMA(0, 0, At, B0); PG8_BAR; PG8_SCHED;
            PG8_LDB(B1, 0, 1); PG8_STAGE(PG8_SB(0, 0), b2, voffB);
            PG8_BAR; PG8_WAIT_L(0); PG8_MMA(0, 1, At, B1); PG8_BAR;
            PG8_LDA(At, 0, 1); PG8_STAGE(PG8_SA(0, 0), a2, voffA);
            PG8_BAR; PG8_WAIT_L(0); PG8_MMA(1, 0, At, B0); PG8_BAR; PG8_SCHED;
            PG8_STAGE(PG8_SB(0, 1), b2 + hstep, voffB);
            PG8_WAIT_V(6); PG8_BAR; PG8_MMA(1, 1, At, B1); PG8_BAR;
            PG8_LDB(B0, 1, 0); PG8_SCHED; PG8_LDA(At, 1, 0); PG8_STAGE(PG8_SA(0, 1), a2 + hstep, voffA);
            PG8_WAIT_L(8); PG8_BAR; PG8_WAIT_L(0); PG8_MMA(0, 0, At, B0); PG8_BAR; PG8_SCHED;
            PG8_LDB(B1, 1, 1); PG8_STAGE(PG8_SB(1, 0), b3, voffB);
            PG8_BAR; PG8_WAIT_L(0); PG8_MMA(0, 1, At, B1); PG8_BAR;
            PG8_LDA(At, 1, 1); PG8_STAGE(PG8_SA(1, 0), a3, voffA);
            PG8_BAR; PG8_WAIT_L(0); PG8_MMA(1, 0, At, B0); PG8_BAR; PG8_SCHED;
            PG8_STAGE(PG8_SB(1, 1), b3 + hstep, voffB);
            PG8_WAIT_V(6); PG8_BAR; PG8_MMA(1, 1, At, B1); PG8_BAR;
            }
        }
        PG8_STAMP();
        if constexpr (ALIGN_EPI) { if (wr == 0) PG8_BAR; }
        if constexpr (!Epi::AFTER_DRAIN) { E(acc, cur, wr, wc, fr, fq); S.done(cur); }
        PG8_STAMP();
        if (!has_next) break;
        bool zero_acc = true; if constexpr (epi_keep<Epi>::value) zero_acc = !E.keep(cur);
        if (zero_acc) {
#pragma unroll
        for (int a = 0; a < 2; ++a)
#pragma unroll
            for (int b = 0; b < 2; ++b)
#pragma unroll
                for (int m = 0; m < 4; ++m)
#pragma unroll
                    for (int n = 0; n < 2; ++n) acc[a][b][m][n] = (f32x4){0.f, 0.f, 0.f, 0.f}; }
        cur = nxt; cA = nA; cB = nB; ++ui;
        if constexpr (ALIGN_EPI) { if (wr == 1) PG8_BAR; }
    }
    PG8_WAIT_V(0);
    if constexpr (!ALIGN_EPI) { if (wr == 0) PG8_BAR; }
    PG8_BAR;
    if constexpr (Epi::AFTER_DRAIN) { E.fused(acc, cur, wr, wc, fr, fq, lds, wid, lane); S.done(cur); }
    PG8_STAMP();
    if (STAMP && wid == 0) { stamps[lane] = lane < nts ? (((unsigned long long)(unsigned)ts_hi << 32) | (unsigned)ts_lo) : 0ull;
        if (lane == 62) stamps[62] = rt_entry; if (lane == 63) stamps[63] = (unsigned long long)wall_clock64(); }
#undef PG8_STAMP
#undef PG8_SA
#undef PG8_SB
#undef PG8_STAGE
#undef PG8_LDA
#undef PG8_LDB
#undef PG8_MMA
#undef PG8_WAIT_V
#undef PG8_WAIT_L
#undef PG8_BAR
#undef PG8_SCHED
}
}

#define XB_TMO      128
#define XB_XCNT(j)  (256  + 64 * (j))
#define XB_XSUB(j)  (1280 + 64 * (j))
#define XB_XGEN(j)  (2304 + 64 * (j))
#define XB_TOP      3328
#define XB_TOPGEN   3392
#define XCD_BAR_WORDS 3456
#define XB_SPIN_CAP (1u << 18)
#define LAS __attribute__((address_space(3)))

__device__ __forceinline__ unsigned xb_ld(unsigned* p)              { return __hip_atomic_load(p, __ATOMIC_RELAXED, __HIP_MEMORY_SCOPE_AGENT); }
__device__ __forceinline__ unsigned xb_add(unsigned* p, unsigned v) { return __hip_atomic_fetch_add(p, v, __ATOMIC_RELAXED, __HIP_MEMORY_SCOPE_AGENT); }
__device__ __forceinline__ unsigned xb_xcc_id() { return (unsigned)__builtin_amdgcn_s_getreg((3 << 11) | 20) & 0xFu; }
#define XB_SPIN(cond, bar) do { unsigned _sp = 0; while (cond) { __builtin_amdgcn_s_sleep(1); \
    if ((++_sp & 255u) == 0u) { if (xb_ld(&(bar)[XB_TMO])) break; if (_sp > XB_SPIN_CAP) { atomicAdd(&(bar)[XB_TMO], 1u); break; } } } } while (0)

struct XcdBarrier {
    unsigned* bar; unsigned x;
    volatile LAS unsigned* st;
};

__device__ __forceinline__ XcdBarrier xcd_barrier_post(unsigned* bar, volatile LAS unsigned* st) {
    XcdBarrier b; b.bar = bar; b.x = xb_xcc_id(); b.st = st;
    if (threadIdx.x == 0) (void)xb_add(&bar[XB_XCNT(b.x)], 1u);
    return b;
}
__device__ __forceinline__ void xcd_barrier_complete(unsigned* bar, unsigned x, unsigned& nloc, unsigned& nx) {
    const unsigned G = gridDim.x * gridDim.y * gridDim.z;
    unsigned sum, cnt, mine, sp = 0u;
    for (;;) {
        sum = 0u; cnt = 0u; mine = 0u;
#pragma unroll
        for (unsigned j = 0; j < 16; ++j) { const unsigned c = xb_ld(&bar[XB_XCNT(j)]); sum += c; cnt += (c > 0u) ? 1u : 0u; mine = (j == x) ? c : mine; }
        if (sum == G) break;
        __builtin_amdgcn_s_sleep(1);
        if ((++sp & 255u) == 0u) { if (xb_ld(&bar[XB_TMO])) break; if (sp > XB_SPIN_CAP) { atomicAdd(&bar[XB_TMO], 1u); break; } }
    }
    nloc = mine > 0u ? mine : 1u; nx = cnt > 0u ? cnt : 1u;
}

__device__ __forceinline__ void xcd_barrier(const XcdBarrier& b) {
    asm volatile("s_waitcnt vmcnt(0)" ::: "memory");
    __syncthreads();
    if (threadIdx.x == 0) {
        unsigned* bar = b.bar;
        __builtin_amdgcn_s_waitcnt(0);
        unsigned nloc = b.st[0], nx = b.st[1];
        if (nloc == 0u) { xcd_barrier_complete(bar, b.x, nloc, nx); b.st[0] = nloc; b.st[1] = nx; }
        const unsigned old = xb_add(&bar[XB_XSUB(b.x)], 1u);
        const unsigned gen = old / nloc;
        if (old + 1u == (gen + 1u) * nloc) {
            __builtin_amdgcn_fence(__ATOMIC_RELEASE, "agent");
            asm volatile("s_waitcnt vmcnt(0)" ::: "memory");
            const unsigned og = xb_add(&bar[XB_TOP], 1u);
            const unsigned tg = og / nx;
            if (og + 1u == (tg + 1u) * nx) xb_add(&bar[XB_TOPGEN], 1u);
            else XB_SPIN(xb_ld(&bar[XB_TOPGEN]) == tg, bar);
            __builtin_amdgcn_fence(__ATOMIC_ACQUIRE, "agent");
            xb_add(&bar[XB_XGEN(b.x)], 1u);
            asm volatile("s_waitcnt vmcnt(0)" ::: "memory");
        } else {
            XB_SPIN(xb_ld(&bar[XB_XGEN(b.x)]) == gen, bar);
            __builtin_amdgcn_fence(__ATOMIC_ACQUIRE, "agent");
            asm volatile("s_waitcnt vmcnt(0)" ::: "memory");
        }
    }
    __syncthreads();
}

#else
namespace pg8 {
typedef unsigned short bf16_t;
typedef float f32x4 __attribute__((ext_vector_type(4)));
typedef unsigned u32x4 __attribute__((ext_vector_type(4)));
constexpr int BM = 256, BK = 64, HALF = 128, NXCD = 8, WGM = 8;
struct Unit { int pm, pn; };
struct Gemm { const bf16_t* A; const bf16_t* Bt; int M, N, K; };
template <class E, class = void> struct epi_keep { static constexpr bool value = false; };
template <class E> struct epi_keep<E, decltype((void)E::KEEP_ACC)> { static constexpr bool value = true; };
struct StaticOrder {
    int nM, nN, nwg, G, c;
    void init(int M, int N, int G_, int c_) { nM = M / BM; nN = N / BM; nwg = nM * nN; G = G_; c = c_; }
    bool next(int i, Unit& u) const {
        const long L = (long)i * G + c; if (L >= nwg) return false;
        int wgid = (int)L; { const int q = nwg / NXCD, r = nwg % NXCD, xcd = wgid % NXCD, off = wgid / NXCD; wgid = (xcd < r ? xcd * (q + 1) : r * (q + 1) + (xcd - r) * q) + off; }
        const int nig = WGM * nN, gid = wgid / nig, fm = gid * WGM, gsz = (nM - fm) < WGM ? (nM - fm) : WGM;
        u.pm = fm + ((wgid % nig) % gsz); u.pn = (wgid % nig) / gsz; return true;
    }
    void a_ready(const Unit&) const {}
    void done(const Unit&) const {}
};
static inline unsigned cvt_pk_bf16(float lo, float hi) { return pk2(lo, hi); }
static float* emu_tile_buf(int b) { static std::vector<std::vector<float>> t; if ((int)t.size() <= b) t.resize(b + 1); if (t[b].empty()) t[b].resize(256 * 256); return t[b].data(); }
template <class Epi, class Sched, bool STAMP = false, bool ALIGN_EPI = false, bool SP2 = false>
void gemm_phase(unsigned char* lds, const Gemm g, const Sched& S, const Epi& E, unsigned long long* stamps) {
    const int tid = threadIdx.x, wid = tid >> 6, lane = tid & 63, wr = wid >> 2, wc = wid & 3, fr = lane & 15, fq = lane >> 4;
    float* tile = emu_tile_buf(blockIdx.x);
    Unit u; f32x4 acc[2][2][4][2]; bool keep_next = false;
    for (int ui = 0; S.next(ui, u); ++ui) {
        __syncthreads();
        if (tid == 0) {
            std::vector<float> a((size_t)256 * g.K), b((size_t)256 * g.K);
            for (int r = 0; r < 256; ++r) for (int k = 0; k < g.K; ++k) { a[(size_t)r * g.K + k] = bf2f(g.A[((size_t)u.pm * 256 + r) * g.K + k]); b[(size_t)r * g.K + k] = bf2f(g.Bt[((size_t)u.pn * 256 + r) * g.K + k]); }
            for (int r = 0; r < 256; ++r) for (int c = 0; c < 256; ++c) { const float* ar = &a[(size_t)r * g.K]; const float* br = &b[(size_t)c * g.K]; float s = 0.f; for (int k = 0; k < g.K; ++k) s += ar[k] * br[k]; tile[r * 256 + c] = s; }
        }
        __syncthreads();
        if (!keep_next) for (int ai = 0; ai < 2; ++ai) for (int bj = 0; bj < 2; ++bj) for (int m = 0; m < 4; ++m) for (int n = 0; n < 2; ++n) acc[ai][bj][m][n] = (f32x4){0.f, 0.f, 0.f, 0.f};
        for (int ai = 0; ai < 2; ++ai) for (int bj = 0; bj < 2; ++bj) for (int m = 0; m < 4; ++m) for (int n = 0; n < 2; ++n) for (int j = 0; j < 4; ++j) {
            const int r = 128 * ai + 64 * wr + 16 * m + fr;
            const int c = Epi::PERM ? (128 * bj + 32 * wc + 8 * fq + 4 * n + j) : (128 * bj + 32 * wc + 16 * n + 4 * fq + j);
            acc[ai][bj][m][n][j] += tile[r * 256 + c];
        }
        E(acc, u, wr, wc, fr, fq); S.done(u);
        if constexpr (epi_keep<Epi>::value) keep_next = E.keep(u); else keep_next = false;
        __syncthreads();
    }
}
}
#endif
namespace pg8 {
#ifdef HOST_EMU
#define EPI_FENCE() do {} while (0)
#else
#define EPI_FENCE() asm volatile("" ::: "memory")
#endif
__device__ __forceinline__ u32x4 pack8(const f32x4 v0, const f32x4 v1) { u32x4 w; w.x = cvt_pk_bf16(v0[0], v0[1]); w.y = cvt_pk_bf16(v0[2], v0[3]); w.z = cvt_pk_bf16(v1[0], v1[1]); w.w = cvt_pk_bf16(v1[2], v1[3]); return w; }
__device__ __forceinline__ void unpack8(const u32x4 w, f32x4& v0, f32x4& v1) { v0 = (f32x4){lo_bf(w.x), hi_bf(w.x), lo_bf(w.y), hi_bf(w.y)}; v1 = (f32x4){lo_bf(w.z), hi_bf(w.z), lo_bf(w.w), hi_bf(w.w)}; }
__device__ __forceinline__ f32x4 sig4(const f32x4 v) { return (f32x4){sigm(v[0]), sigm(v[1]), sigm(v[2]), sigm(v[3])}; }
#ifndef HOST_EMU
__device__ __forceinline__ float gate_sig(float x) { return __builtin_amdgcn_rcpf(fminf(1.0f + __expf(-x), 1.0e6f)); }
#else
__device__ __forceinline__ float gate_sig(float x) { return fmaxf(sigm(x), 1.0e-6f); }
#endif
__device__ __forceinline__ f32x4 gsig4(const f32x4 v) { return (f32x4){gate_sig(v[0]), gate_sig(v[1]), gate_sig(v[2]), gate_sig(v[3])}; }

struct EpiProj {
    static constexpr bool PERM = true, AFTER_DRAIN = false;
    unsigned char* ws;
    __device__ __forceinline__ void operator()(const f32x4 (&acc)[2][2][4][2], const Unit& u, int wr, int wc, int fr, int fq) const {
        const int pn = u.pn; size_t off; int ld, c0;
        if (pn < 2) { off = WS_Z; ld = 512; c0 = pn * 256; }
        else if (pn < 5) { off = WS_XBC; ld = 768; c0 = (pn - 2) * 256; }
        else if (pn < 7) { off = WS_Q; ld = 512; c0 = (pn - 5) * 256; }
        else if (pn < 9) { off = WS_K; ld = 512; c0 = (pn - 7) * 256; }
        else if (pn < 11) { off = WS_V; ld = 512; c0 = (pn - 9) * 256; }
        else if (pn < 18) { off = WS_RW; ld = 1792; c0 = (pn - 11) * 256; }
        else if (pn < 20) { off = WS_U; ld = 512; c0 = (pn - 18) * 256; }
        else { off = WS_SM; ld = 256; c0 = 0; }
        bf16_t* dst = (bf16_t*)(ws + off);
        const int row0 = u.pm * BM + wr * 64 + fr, col0 = c0 + wc * 32 + 8 * fq;
        const int kic = HALF + wc * 32 + 8 * fq - 136;
        const bool ki = (pn == 20) && kic >= 0 && kic < 32;
#pragma unroll
        for (int ai = 0; ai < 2; ++ai)
#pragma unroll
            for (int m = 0; m < 4; ++m) { const size_t row = (size_t)(row0 + ai * HALF + m * 16); bf16_t* rowp = dst + row * ld + col0;
#pragma unroll
                for (int bj = 0; bj < 2; ++bj) { const u32x4 w = pack8(acc[ai][bj][m][0], acc[ai][bj][m][1]); *(u32x4*)(rowp + bj * HALF) = w;
                    if (bj == 1 && ki) *(u32x4*)((bf16_t*)(ws + WS_KI) + row * 32 + kic) = w; } }
    }
};
struct EpiGate {
    static constexpr bool PERM = true, AFTER_DRAIN = false;
    bf16_t* G;
    __device__ __forceinline__ void operator()(const f32x4 (&acc)[2][2][4][2], const Unit& u, int wr, int wc, int fr, int fq) const {
        const int row0 = u.pm * BM + wr * 64 + fr, col0 = u.pn * BM + wc * 32 + 8 * fq;
#pragma unroll
        for (int ai = 0; ai < 2; ++ai)
#pragma unroll
            for (int m = 0; m < 4; ++m) { bf16_t* rowp = G + (size_t)(row0 + ai * HALF + m * 16) * 4096 + col0;
#pragma unroll
                for (int bj = 0; bj < 2; ++bj) *(u32x4*)(rowp + bj * HALF) = pack8(gsig4(acc[ai][bj][m][0]), gsig4(acc[ai][bj][m][1])); }
    }
};
struct EpiMerge {
    static constexpr bool PERM = true, AFTER_DRAIN = false, KEEP_ACC = true;
    const bf16_t* G; bf16_t* MRG;
    __device__ __forceinline__ bool keep(const Unit& u) const { return (u.pn >> 2) < 3; }
    __device__ __forceinline__ void operator()(f32x4 (&acc)[2][2][4][2], const Unit& u, int wr, int wc, int fr, int fq) const {
        const int n = u.pn >> 2, pn = u.pn & 3, pm = u.pm - n * (MG / 256);
        const int row0 = pm * BM + wr * 64 + fr, col0 = pn * BM + wc * 32 + 8 * fq;
#pragma unroll
        for (int ai = 0; ai < 2; ++ai)
#pragma unroll
            for (int mp = 0; mp < 2; ++mp) { u32x4 ga[2][2], gb[2][2];
#pragma unroll
                for (int mm = 0; mm < 2; ++mm)
#pragma unroll
                    for (int bj = 0; bj < 2; ++bj) { const bf16_t* gp = G + (size_t)(row0 + ai * HALF + (2 * mp + mm) * 16) * 4096 + n * 1024 + col0 + bj * HALF; ga[mm][bj] = *(const u32x4*)gp; if (n < 3) gb[mm][bj] = *(const u32x4*)(gp + 1024); }
#pragma unroll
                for (int mm = 0; mm < 2; ++mm)
#pragma unroll
                    for (int bj = 0; bj < 2; ++bj) { const int m = 2 * mp + mm; f32x4 a0, a1; unpack8(ga[mm][bj], a0, a1);
                        if (n < 3) { f32x4 b0, b1; unpack8(gb[mm][bj], b0, b1);
#pragma unroll
                            for (int j = 0; j < 4; ++j) { acc[ai][bj][m][0][j] *= a0[j] * __builtin_amdgcn_rcpf(b0[j]); acc[ai][bj][m][1][j] *= a1[j] * __builtin_amdgcn_rcpf(b1[j]); } }
                        else
                            *(u32x4*)(MRG + (size_t)(row0 + ai * HALF + m * 16) * 1024 + col0 + bj * HALF) = pack8(acc[ai][bj][m][0] * a0, acc[ai][bj][m][1] * a1); }
                EPI_FENCE(); }
    }
};
struct MergeOrder {
    int G, c;
    __device__ __forceinline__ bool next(int i, Unit& u) const {
        const int tile = (i >> 2) * G + c, n = i & 3; if (tile >= (MG / 256) * 4) return false;
        u.pm = n * (MG / 256) + (tile >> 2); u.pn = n * 4 + (tile & 3); return true;
    }
    __device__ __forceinline__ void a_ready(const Unit&) const {}
    __device__ __forceinline__ void done(const Unit&) const {}
};
struct EpiResid {
    static constexpr bool PERM = false, AFTER_DRAIN = false;
    const float* base; float* out;
    __device__ __forceinline__ void operator()(const f32x4 (&acc)[2][2][4][2], const Unit& u, int wr, int wc, int fr, int fq) const {
        const int row0 = u.pm * BM + wr * 64 + fr, col0 = u.pn * BM + wc * 32 + 4 * fq;
#pragma unroll
        for (int ai = 0; ai < 2; ++ai) {
            f32x4 bv[4][2][2];
#pragma unroll
            for (int m = 0; m < 4; ++m)
#pragma unroll
                for (int bj = 0; bj < 2; ++bj)
#pragma unroll
                    for (int n = 0; n < 2; ++n) bv[m][bj][n] = *(const f32x4*)(base + (size_t)(row0 + ai * HALF + m * 16) * 1024 + col0 + bj * HALF + n * 16);
#pragma unroll
            for (int m = 0; m < 4; ++m)
#pragma unroll
                for (int bj = 0; bj < 2; ++bj)
#pragma unroll
                    for (int n = 0; n < 2; ++n) *(f32x4*)(out + (size_t)(row0 + ai * HALF + m * 16) * 1024 + col0 + bj * HALF + n * 16) = bv[m][bj][n] + acc[ai][bj][m][n];
            EPI_FENCE(); }
    }
};
struct EpiSwiglu {
    static constexpr bool PERM = true, AFTER_DRAIN = false;
    bf16_t* HID;
    __device__ __forceinline__ void operator()(const f32x4 (&acc)[2][2][4][2], const Unit& u, int wr, int wc, int fr, int fq) const {
        const int row0 = u.pm * BM + wr * 64 + fr, col0 = u.pn * HALF + wc * 32 + 8 * fq;
#pragma unroll
        for (int ai = 0; ai < 2; ++ai)
#pragma unroll
            for (int m = 0; m < 4; ++m) { f32x4 v[2];
#pragma unroll
                for (int n = 0; n < 2; ++n) { const f32x4 a = acc[ai][0][m][n], b = acc[ai][1][m][n]; v[n] = a * sig4(a) * b; }
                *(u32x4*)(HID + (size_t)(row0 + ai * HALF + m * 16) * FFN + col0) = pack8(v[0], v[1]); }
    }
};
struct EpiGlu {
    static constexpr bool PERM = true, AFTER_DRAIN = false;
    const bf16_t* Y0; bf16_t* OUT; const float* bias;
    __device__ __forceinline__ void operator()(const f32x4 (&acc)[2][2][4][2], const Unit& u, int wr, int wc, int fr, int fq) const {
        const int row0 = u.pm * BM + wr * 64 + fr, col0 = u.pn * BM + wc * 32 + 8 * fq;
#pragma unroll
        for (int ai = 0; ai < 2; ++ai)
#pragma unroll
            for (int m = 0; m < 4; ++m) { const size_t row = (size_t)(row0 + ai * HALF + m * 16);
#pragma unroll
                for (int bj = 0; bj < 2; ++bj) { const int col = col0 + bj * HALF;
                    f32x4 y0, y1; unpack8(*(const u32x4*)(Y0 + row * 512 + col), y0, y1);
                    const f32x4 b0 = *(const f32x4*)(bias + col), b1 = *(const f32x4*)(bias + col + 4);
                    *(u32x4*)(OUT + row * 512 + col) = pack8(y0 * sig4(acc[ai][bj][m][0] + b0), y1 * sig4(acc[ai][bj][m][1] + b1)); }
                EPI_FENCE(); }
    }
};
__device__ __forceinline__ float logdecay(float x) { return -0.6065306597f * sigm(x); }
struct EpiLora {
    static constexpr bool PERM = true, AFTER_DRAIN = false;
    float* WLOG; bf16_t* ASIG; bf16_t* GG; const float* w0; const float* a0;
    __device__ __forceinline__ void operator()(const f32x4 (&acc)[2][2][4][2], const Unit& u, int wr, int wc, int fr, int fq) const {
        const int kind = u.pn >> 1, row0 = u.pm * BM + wr * 64 + fr, col0 = (u.pn & 1) * BM + wc * 32 + 8 * fq;
        if (kind == 0) {
            f32x4 b[2][2];
#pragma unroll
            for (int bj = 0; bj < 2; ++bj) { b[bj][0] = *(const f32x4*)(w0 + col0 + bj * HALF); b[bj][1] = *(const f32x4*)(w0 + col0 + bj * HALF + 4); }
#pragma unroll
            for (int ai = 0; ai < 2; ++ai)
#pragma unroll
                for (int m = 0; m < 4; ++m)
#pragma unroll
                    for (int bj = 0; bj < 2; ++bj)
#pragma unroll
                        for (int n = 0; n < 2; ++n) { const f32x4 x = acc[ai][bj][m][n] + b[bj][n];
                            *(f32x4*)(WLOG + (size_t)(row0 + ai * HALF + m * 16) * 512 + col0 + bj * HALF + 4 * n) = (f32x4){logdecay(x[0]), logdecay(x[1]), logdecay(x[2]), logdecay(x[3])}; }
        } else if (kind == 1) {
            f32x4 b[2][2];
#pragma unroll
            for (int bj = 0; bj < 2; ++bj) { b[bj][0] = *(const f32x4*)(a0 + col0 + bj * HALF); b[bj][1] = *(const f32x4*)(a0 + col0 + bj * HALF + 4); }
#pragma unroll
            for (int ai = 0; ai < 2; ++ai)
#pragma unroll
                for (int m = 0; m < 4; ++m)
#pragma unroll
                    for (int bj = 0; bj < 2; ++bj)
                        *(u32x4*)(ASIG + (size_t)(row0 + ai * HALF + m * 16) * 512 + col0 + bj * HALF) = pack8(sig4(acc[ai][bj][m][0] + b[bj][0]), sig4(acc[ai][bj][m][1] + b[bj][1]));
        } else {
#pragma unroll
            for (int ai = 0; ai < 2; ++ai)
#pragma unroll
                for (int m = 0; m < 4; ++m)
#pragma unroll
                    for (int bj = 0; bj < 2; ++bj)
                        *(u32x4*)(GG + (size_t)(row0 + ai * HALF + m * 16) * 512 + col0 + bj * HALF) = pack8(acc[ai][bj][m][0], acc[ai][bj][m][1]);
        }
    }
};
}
typedef short bf16x8_t __attribute__((ext_vector_type(8)));
typedef float f32x16 __attribute__((ext_vector_type(16)));
typedef float f32x4_t __attribute__((ext_vector_type(4)));
__device__ __forceinline__ bf16x8_t frag2(const u32x2 lo, const u32x2 hi) { u32x4 w; w.x = lo.x; w.y = lo.y; w.z = hi.x; w.w = hi.y; return __builtin_bit_cast(bf16x8_t, w); }
struct Args { const float* in[N_IN]; float* out; unsigned char* ws; int seg_lo, seg_hi; };
#ifdef HOST_EMU
typedef const Args* KArgs;
#define KLAUNDER(p) (p)
__device__ __forceinline__ int fresh_tid() { return (int)threadIdx.x; }
#else
typedef const __attribute__((address_space(4))) Args* KArgs;
__device__ __forceinline__ KArgs klaunder(KArgs p) { asm volatile("" : "+s"(p)); return p; }
#define KLAUNDER(p) klaunder(p)
__device__ __forceinline__ int fresh_tid() { int t = (int)threadIdx.x; asm volatile("" : "+v"(t)); return t; }
#endif
#define WSP(T, off) ((T*)(C->ws + (off)))

template <class Src>
__device__ __forceinline__ void transpose_item(const Src& S, int K, bf16* WT, float* scr, int item, int lane) {
    const int nblk = S.ndst / 32, kb = item / nblk, nb = item % nblk, k0 = 64 * kb, n0 = 32 * nb;
    const float* cp = S.col(n0 + (lane & 31)); const int ld = S.ld;
#pragma unroll 8
    for (int i = 0; i < 32; ++i) { const int kk = 2 * i + (lane >> 5); scr[kk * 33 + (lane & 31)] = cp ? cp[(size_t)(k0 + kk) * ld] : 0.f; }
    WAVE_SYNC();
    const int c = lane & 7;
#pragma unroll
    for (int j = 0; j < 4; ++j) { const int n = (lane >> 3) + 8 * j; const float* s = scr + (8 * c) * 33 + n;
        u32x4 o; o.x = pk2(s[0 * 33], s[1 * 33]); o.y = pk2(s[2 * 33], s[3 * 33]); o.z = pk2(s[4 * 33], s[5 * 33]); o.w = pk2(s[6 * 33], s[7 * 33]);
        *(u32x4*)(WT + (size_t)(n0 + n) * K + k0 + 8 * c) = o; }
    WAVE_SYNC();
}
struct SrcWin { const float* w; int ndst, ld;
    __device__ __forceinline__ const float* col(int n) const {
        int s;
        if (n < 1280) s = n;
        else if (n < 2816) s = n + 8;
        else if (n < 4608) s = n - 2816 + 2988;
        else if (n < 5120) s = n - 4608 + 4780;
        else if (n < 5128) s = n - 5120 + 1280;
        else if (n < 5256) s = n - 5128 + 2824;
        else if (n < 5288) s = n - 5256 + 2952;
        else if (n < 5292) s = n - 5288 + 2984;
        else if (n < 5376) return nullptr;
        else s = n - 5376 + 5292;
        return w + s; } };
struct SrcPlain { const float* w; int ndst, ld; __device__ __forceinline__ const float* col(int n) const { return w + n; } };
struct SrcW13 { const float* w1; const float* w3; int ndst, ld;
    __device__ __forceinline__ const float* col(int n) const { const int pn = n >> 8, r = n & 255; return w1 + (r < 128 ? (ptrdiff_t)0 : (w3 - w1)) + pn * 128 + (r & 127); } };

__device__ __forceinline__ void phase_weights(KArgs C, int layer, unsigned char* lds, int gw, int ngw, int lane, int wave) {
    float* scr = (float*)(lds + wave * 16384); const size_t wo = (layer & 1) ? WDELTA : 0;
    constexpr int N_IN_ = 16 * (NPROJ / 32), N_BR = 8 * 32, N_OUT = 16 * 32, N_13 = 16 * (5632 / 32), N_2 = 44 * 32, N_GLU = 8 * 16;
    { const SrcWin s_in{C->in[I_WIN] + (size_t)layer * 1024 * IN_COLS, NPROJ, IN_COLS};
      for (int it = gw; it < N_IN_; it += ngw) transpose_item(s_in, 1024, WSP(bf16, WS_WIN + wo), scr, it, lane); }
    for (int it = gw; it < 4 * N_BR; it += ngw) { const int n = it / N_BR; const SrcPlain s_b{C->in[I_WBR] + ((size_t)layer * 4 + n) * 512 * 1024, 1024, 1024};
        transpose_item(s_b, 512, WSP(bf16, WS_WB + wo) + (size_t)n * 1024 * 512, scr, it % N_BR, lane); }
    { const SrcPlain s_out{C->in[I_WOUT] + (size_t)layer * 1024 * 1024, 1024, 1024};
      for (int it = gw; it < N_OUT; it += ngw) transpose_item(s_out, 1024, WSP(bf16, WS_WOUT + wo), scr, it, lane); }
    { const SrcW13 s_13{C->in[I_W1] + (size_t)layer * 1024 * FFN, C->in[I_W3] + (size_t)layer * 1024 * FFN, 5632, FFN};
      for (int it = gw; it < N_13; it += ngw) transpose_item(s_13, 1024, WSP(bf16, WS_W13 + wo), scr, it, lane); }
    { const SrcPlain s_2{C->in[I_W2F] + (size_t)layer * FFN * 1024, 1024, 1024};
      for (int it = gw; it < N_2; it += ngw) transpose_item(s_2, FFN, WSP(bf16, WS_W2 + wo), scr, it, lane); }
    { const SrcPlain s_glu{C->in[I_GLUW] + (size_t)layer * 512 * 512, 512, 512};
      for (int it = gw; it < N_GLU; it += ngw) transpose_item(s_glu, 512, WSP(bf16, WS_GLU + wo), scr, it, lane); }
    { const float* w2 = C->in[I_W2] + (size_t)layer * 64 * 512; const float* a2 = C->in[I_A2] + (size_t)layer * 64 * 512; const float* g2 = C->in[I_G2] + (size_t)layer * 128 * 512;
      bf16* WL = WSP(bf16, WS_WLORA + wo);
      for (int e = gw * 64 + lane; e < 1536 * 256; e += ngw * 64) { const int n = e >> 8, kc = e & 255; float v = 0.f;
          if (n < 512) { if (kc < 64) v = w2[kc * 512 + n]; } else if (n < 1024) { if (kc >= 64 && kc < 128) v = a2[(kc - 64) * 512 + (n - 512)]; } else { if (kc >= 128) v = g2[(kc - 128) * 512 + (n - 1024)]; }
          WL[e] = f2bf(v); } }
    const int gt = gw * 64 + lane, ngt = ngw * 64;
    for (int e = gt; e < 32 * 64; e += ngt) {
        const int g = e >> 6;
        const float ar = C->in[I_S5ARE][layer * 2048 + e], ai = C->in[I_S5AIM][layer * 2048 + e], dt = expf(C->in[I_S5LDT][layer * 32 + g]);
        const float mag = expf(ar * dt), abr = mag * cosf(ai * dt), abi = mag * sinf(ai * dt);
        const float den = ar * ar + ai * ai, nr = abr - 1.0f, ni = abi;
        const float qr = (nr * ar + ni * ai) / den, qi = (ni * ar - nr * ai) / den;
        float* ab = WSP(float, WS_ABAR + wo) + e * 2; ab[0] = abr; ab[1] = abi;
        float* bb = WSP(float, WS_BBAR + wo) + (size_t)e * 32;
        for (int j = 0; j < 16; ++j) { const float br = C->in[I_S5BRE][((size_t)layer * 2048 + e) * 16 + j], bi = C->in[I_S5BIM][((size_t)layer * 2048 + e) * 16 + j];
            bb[2 * j] = qr * br - qi * bi; bb[2 * j + 1] = qr * bi + qi * br; }
    }
    if (layer == 0) for (int e = gt; e < SEQ + 63; e += ngt) {
        const int rel = e - (SEQ - 1); const int n = rel < 0 ? -rel : rel; int b = rel > 0 ? 16 : 0;
        if (n < 8) b += n; else { int lg = 8 + (int)(logf((float)n / 8.0f) / 3.4657359028f * 8.0f); if (lg > 15) lg = 15; b += lg; }
        WSP(int, WS_TAB)[e] = b;
    }
}

__device__ __forceinline__ void rms_row_bf16(const float* xrow, const float* g, bf16* orow, int lane) {
    const f32x4* xr = (const f32x4*)xrow + lane; const f32x4* gr = (const f32x4*)g + lane;
    f32x4 v[4]; float s = 0.f;
#pragma unroll
    for (int j = 0; j < 4; ++j) { v[j] = xr[64 * j]; s += (v[j].x * v[j].x + v[j].y * v[j].y) + (v[j].z * v[j].z + v[j].w * v[j].w); }
    const float rstd = 1.0f / sqrtf(wave_sum(s) * (1.f / D) + RMS_EPS);
    u32x2* o8 = (u32x2*)orow + lane;
#pragma unroll
    for (int j = 0; j < 4; ++j) { const f32x4 gg = gr[64 * j]; u32x2 w; w.x = pk2(v[j].x * rstd * gg.x, v[j].y * rstd * gg.y); w.y = pk2(v[j].z * rstd * gg.z, v[j].w * rstd * gg.w); o8[64 * j] = w; }
}
template <int NR>
__device__ __forceinline__ void rms_rowN_bf16(const float* xrow, const float* g, bf16* orow, size_t step, int lane) {
    const f32x4* gr = (const f32x4*)g + lane; f32x4 v[NR][4]; float ss[NR];
#pragma unroll
    for (int q = 0; q < NR; ++q)
#pragma unroll
        for (int j = 0; j < 4; ++j) v[q][j] = ((const f32x4*)(xrow + q * step) + lane)[64 * j];
#pragma unroll
    for (int q = 0; q < NR; ++q) { float s = 0.f;
#pragma unroll
        for (int j = 0; j < 4; ++j) s += (v[q][j].x * v[q][j].x + v[q][j].y * v[q][j].y) + (v[q][j].z * v[q][j].z + v[q][j].w * v[q][j].w);
        ss[q] = s; }
#pragma unroll
    for (int o = 1; o < 64; o <<= 1)
#pragma unroll
        for (int q = 0; q < NR; ++q) ss[q] += __shfl_xor(ss[q], o);
#pragma unroll
    for (int q = 0; q < NR; ++q) { const float r = 1.0f / sqrtf(ss[q] * (1.f / D) + RMS_EPS); u32x2* o8 = (u32x2*)(orow + q * step) + lane;
#pragma unroll
        for (int j = 0; j < 4; ++j) { const f32x4 gg = gr[64 * j]; u32x2 w; w.x = pk2(v[q][j].x * r * gg.x, v[q][j].y * r * gg.y); w.y = pk2(v[q][j].z * r * gg.z, v[q][j].w * r * gg.w); o8[64 * j] = w; } }
}
__device__ __forceinline__ void rms_row_f32(float* xrow, const float* g, int lane) {
    f32x4* xr = (f32x4*)xrow + lane; const f32x4* gr = (const f32x4*)g + lane;
    f32x4 v[4]; float s = 0.f;
#pragma unroll
    for (int j = 0; j < 4; ++j) { v[j] = xr[64 * j]; s += (v[j].x * v[j].x + v[j].y * v[j].y) + (v[j].z * v[j].z + v[j].w * v[j].w); }
    const float rstd = 1.0f / sqrtf(wave_sum(s) * (1.f / D) + RMS_EPS);
#pragma unroll
    for (int j = 0; j < 4; ++j) xr[64 * j] = v[j] * rstd * gr[64 * j];
}

#ifdef HOST_EMU
__device__ __forceinline__ float red8(float v) { v += __shfl_xor(v, 1); v += __shfl_xor(v, 2); v += __shfl_xor(v, 4); return v; }
__device__ __forceinline__ float red16(float v) { v = red8(v); v += __shfl_xor(v, 8); return v; }
#else
template <int CTRL> __device__ __forceinline__ float dpp_f(float v) { return __builtin_bit_cast(float, __builtin_amdgcn_update_dpp(0, __builtin_bit_cast(int, v), CTRL, 0xf, 0xf, true)); }
__device__ __forceinline__ float red8(float v) { v += dpp_f<0xB1>(v); v += dpp_f<0x4E>(v); v += dpp_f<0x141>(v); return v; }
__device__ __forceinline__ float red16(float v) { v = red8(v); v += dpp_f<0x140>(v); return v; }
#endif
__device__ __forceinline__ f32x4 sig4g(const f32x4 v) { return (f32x4){sigm(v[0]), sigm(v[1]), sigm(v[2]), sigm(v[3])}; }
__device__ __forceinline__ void rms_row2_f32(float* xrow, size_t step, const float* g, int lane) {
    f32x4* xa = (f32x4*)xrow + lane; f32x4* xb = (f32x4*)(xrow + step) + lane; const f32x4* gr = (const f32x4*)g + lane;
    f32x4 va[4], vb[4]; float sa = 0.f, sb = 0.f;
#pragma unroll
    for (int j = 0; j < 4; ++j) { va[j] = xa[64 * j]; vb[j] = xb[64 * j]; }
#pragma unroll
    for (int j = 0; j < 4; ++j) { sa += (va[j].x * va[j].x + va[j].y * va[j].y) + (va[j].z * va[j].z + va[j].w * va[j].w); sb += (vb[j].x * vb[j].x + vb[j].y * vb[j].y) + (vb[j].z * vb[j].z + vb[j].w * vb[j].w); }
#pragma unroll
    for (int o = 1; o < 64; o <<= 1) { sa += __shfl_xor(sa, o); sb += __shfl_xor(sb, o); }
    const float ra = 1.0f / sqrtf(sa * (1.f / D) + RMS_EPS), rb = 1.0f / sqrtf(sb * (1.f / D) + RMS_EPS);
#pragma unroll
    for (int j = 0; j < 4; ++j) { const f32x4 gg = gr[64 * j]; xa[64 * j] = va[j] * ra * gg; xb[64 * j] = vb[j] * rb * gg; }
}
__device__ __forceinline__ void ssd_conv_row(KArgs C, int layer, int m, int lane) {
    const int t = m % SEQ; const float* cw = C->in[I_CONVW] + layer * 4 * 768; const float* cb = C->in[I_CONVB] + layer * 768;
#pragma unroll
    for (int i = 0; i < 3; ++i) { const int ch = i * 256 + lane * 4; const bf16* p = WSP(const bf16, WS_XBC) + (size_t)m * 768 + ch;
        f32x4 a = *(const f32x4*)(cb + ch);
#pragma unroll
        for (int q = 0; q < 4; ++q) if (t - 3 + q >= 0) { const u32x2 w = *(const u32x2*)(p - (3 - q) * 768); const f32x4 cq = *(const f32x4*)(cw + q * 768 + ch);
            a += cq * (f32x4){lo_bf(w.x), hi_bf(w.x), lo_bf(w.y), hi_bf(w.y)}; }
        a = a * sig4g(a);
        u32x2 o; o.x = pk2(a.x, a.y); o.y = pk2(a.z, a.w); *(u32x2*)(WSP(bf16, WS_XBA) + (size_t)m * 768 + ch) = o; }
}
__device__ __forceinline__ void ssd_conv_row2(KArgs C, int layer, int m, int step, int lane) {
    const float* cw = C->in[I_CONVW] + layer * 4 * 768; const float* cb = C->in[I_CONVB] + layer * 768;
    u32x2 w[2][3][4]; f32x4 cq[3][4], bb[3];
#pragma unroll
    for (int i = 0; i < 3; ++i) { const int ch = i * 256 + lane * 4; bb[i] = *(const f32x4*)(cb + ch);
#pragma unroll
        for (int q = 0; q < 4; ++q) { cq[i][q] = *(const f32x4*)(cw + q * 768 + ch);
#pragma unroll
            for (int r = 0; r < 2; ++r) { const int mm = m + r * step, t = mm % SEQ; const bf16* p = WSP(const bf16, WS_XBC) + (size_t)mm * 768 + ch;
                if (t - 3 + q >= 0) w[r][i][q] = *(const u32x2*)(p - (3 - q) * 768); else { w[r][i][q].x = 0u; w[r][i][q].y = 0u; } } } }
#pragma unroll
    for (int r = 0; r < 2; ++r)
#pragma unroll
        for (int i = 0; i < 3; ++i) { const int ch = i * 256 + lane * 4; f32x4 a = bb[i];
#pragma unroll
            for (int q = 0; q < 4; ++q) a += cq[i][q] * (f32x4){lo_bf(w[r][i][q].x), hi_bf(w[r][i][q].x), lo_bf(w[r][i][q].y), hi_bf(w[r][i][q].y)};
            a = a * sig4g(a);
            u32x2 o; o.x = pk2(a.x, a.y); o.y = pk2(a.z, a.w); *(u32x2*)(WSP(bf16, WS_XBA) + (size_t)(m + r * step) * 768 + ch) = o; }
}
__device__ __forceinline__ void ssd_unit(KArgs C, int layer, int unit, unsigned char* lds) {
    const int tid = fresh_tid(), lane = tid & 63, wave = tid >> 6, bl = unit >> 3, h = unit & 7, gi = h >> 2, pp = tid >> 3, c8 = (tid & 7) * 8, c16 = lane & 15, q = lane >> 4;
    bf16* Cb = (bf16*)lds; bf16* Bb = Cb + 4096; bf16* XT = Bb + 4096; bf16* BwT = XT + 4096; bf16* Pm = BwT + 4096; float* Yo = (float*)(Pm + 4096); float* dts = Yo + 8192; float* acs = dts + 128;
    const bf16* XA = WSP(const bf16, WS_XBA) + (size_t)bl * SEQ * 768 + (size_t)pp * 768 + c8;
    const bf16* SMp = WSP(const bf16, WS_SM) + (size_t)bl * SEQ * 256;
    const bf16* Zp = WSP(const bf16, WS_Z) + (size_t)bl * SEQ * 512 + (size_t)pp * 512 + h * 64 + c8;
    bf16* YA = WSP(bf16, WS_Y) + (size_t)bl * SEQ * 512 + (size_t)pp * 512 + h * 64 + c8;
    const float dtb = C->in[I_DTB][layer * 8 + h], A = -__expf(C->in[I_ALOG][layer * 8 + h]), Dh = C->in[I_SSDD][layer * 8 + h];
    f32x4_t Sd[2]; bf16x8_t Sf; Sd[0] = (f32x4_t){0.f, 0.f, 0.f, 0.f}; Sd[1] = Sd[0]; { u32x2 z; z.x = 0u; z.y = 0u; Sf = frag2(z, z); }
    const int pt = wave & 3, nh = wave >> 2;
    u32x4 fx, fb, fc, fz;
#define SSD_FETCH(c0_) do { const bf16* q_ = XA + (size_t)(c0_) * 768; fx = *(const u32x4*)(q_ + h * 64); fb = *(const u32x4*)(q_ + 512 + gi * 64); fc = *(const u32x4*)(q_ + 640 + gi * 64); fz = *(const u32x4*)(Zp + (size_t)(c0_) * 512); } while (0)
#define SSD_DT(c0_, par) do { if (wave == 0) { const float dt_ = softplusf(bf2f(SMp[(size_t)((c0_) + lane) * 256 + h]) + dtb); float a_ = A * dt_; \
        _Pragma("unroll") for (int o_ = 1; o_ < 64; o_ <<= 1) { const float t_ = __shfl_up(a_, o_); if (lane >= o_) a_ += t_; } dts[(par) * 64 + lane] = dt_; acs[(par) * 64 + lane] = a_; } } while (0)
    LDS_SYNC();
    SSD_FETCH(0); SSD_DT(0, 0);
    for (int c0 = 0, par = 0; c0 < SEQ; c0 += 64, par ^= 1) {
        LDS_SYNC();
        const u32x4 xk = fx, zk = fz;
        {
          const float dt = dts[par * 64 + pp], ea = __expf(acs[par * 64 + 63] - acs[par * 64 + pp]);
          *(u32x4*)(Cb + pp * 64 + c8) = fc; *(u32x4*)(Bb + pp * 64 + c8) = fb;
          f32x4 x0, x1, b0, b1; pg8::unpack8(fx, x0, x1); pg8::unpack8(fb, b0, b1); x0 = x0 * dt; x1 = x1 * dt; b0 = b0 * ea; b1 = b1 * ea;
#pragma unroll
          for (int i = 0; i < 4; ++i) { XT[(c8 + i) * 64 + pp] = f2bf(x0[i]); XT[(c8 + 4 + i) * 64 + pp] = f2bf(x1[i]); BwT[(c8 + i) * 64 + pp] = f2bf(b0[i]); BwT[(c8 + 4 + i) * 64 + pp] = f2bf(b1[i]); } }
        if (c0 + 64 < SEQ) { SSD_FETCH(c0 + 64); SSD_DT(c0 + 64, par ^ 1); }
        LDS_SYNC();
        {
          const f32x4_t z4 = {0.f, 0.f, 0.f, 0.f};
#pragma unroll
          for (int i = 0; i < 2; ++i) { const int id = wave + 8 * i, lt = id >> 2, st = id & 3; f32x4_t g = z4;
              if (st <= lt) {
#pragma unroll
                  for (int ks = 0; ks < 2; ++ks) g = __builtin_amdgcn_mfma_f32_16x16x32_bf16(*(const bf16x8_t*)(Cb + (16 * lt + c16) * 64 + 32 * ks + 8 * q), *(const bf16x8_t*)(Bb + (16 * st + c16) * 64 + 32 * ks + 8 * q), g, 0, 0, 0);
                  const float as_ = acs[par * 64 + 16 * st + c16];
#pragma unroll
                  for (int r = 0; r < 4; ++r) { const int l = 16 * lt + 4 * q + r; g[r] = (16 * st + c16 <= l) ? g[r] * __expf(acs[par * 64 + l] - as_) : 0.f; } }
#pragma unroll
              for (int r = 0; r < 4; ++r) Pm[(16 * lt + 4 * q + r) * 64 + 16 * st + c16] = f2bf(g[r]); }
#pragma unroll
          for (int lt = 0; lt < 4; ++lt) { const bf16* cr = Cb + (16 * lt + c16) * 64 + 32 * nh + 4 * q;
              const f32x4_t yo = __builtin_amdgcn_mfma_f32_16x16x32_bf16(frag2(*(const u32x2*)cr, *(const u32x2*)(cr + 16)), Sf, z4, 0, 0, 0);
#pragma unroll
              for (int r = 0; r < 4; ++r) Yo[nh * 4096 + (16 * lt + 4 * q + r) * 64 + 16 * pt + c16] = yo[r]; }
          const float eL = __expf(acs[par * 64 + 63]);
          const bf16x8_t xb0 = *(const bf16x8_t*)(XT + (16 * pt + c16) * 64 + 8 * q), xb1 = *(const bf16x8_t*)(XT + (16 * pt + c16) * 64 + 32 + 8 * q);
#pragma unroll
          for (int i = 0; i < 2; ++i) { const bf16* br = BwT + (16 * (2 * nh + i) + c16) * 64 + 8 * q; f32x4_t cin = Sd[i] * eL;
              cin = __builtin_amdgcn_mfma_f32_16x16x32_bf16(*(const bf16x8_t*)br, xb0, cin, 0, 0, 0); Sd[i] = __builtin_amdgcn_mfma_f32_16x16x32_bf16(*(const bf16x8_t*)(br + 32), xb1, cin, 0, 0, 0); }
          u32x2 lo, hi; lo.x = pk2(Sd[0][0], Sd[0][1]); lo.y = pk2(Sd[0][2], Sd[0][3]); hi.x = pk2(Sd[1][0], Sd[1][1]); hi.y = pk2(Sd[1][2], Sd[1][3]); Sf = frag2(lo, hi); }
        LDS_SYNC();
        {
          const f32x4_t z4 = {0.f, 0.f, 0.f, 0.f};
#pragma unroll
          for (int i = 0; i < 2; ++i) { const int id = wave + 8 * i, lt = id >> 2, p2 = id & 3;
              f32x4_t y = __builtin_amdgcn_mfma_f32_16x16x32_bf16(*(const bf16x8_t*)(Pm + (16 * lt + c16) * 64 + 8 * q), *(const bf16x8_t*)(XT + (16 * p2 + c16) * 64 + 8 * q), z4, 0, 0, 0);
              if (lt >= 2) y = __builtin_amdgcn_mfma_f32_16x16x32_bf16(*(const bf16x8_t*)(Pm + (16 * lt + c16) * 64 + 32 + 8 * q), *(const bf16x8_t*)(XT + (16 * p2 + c16) * 64 + 32 + 8 * q), y, 0, 0, 0);
#pragma unroll
              for (int r = 0; r < 4; ++r) { const int l = 16 * lt + 4 * q + r, o = l * 64 + 16 * p2 + c16; Yo[o] = y[r] + __expf(acs[par * 64 + l]) * (Yo[o] + Yo[4096 + o]); } } }
        LDS_SYNC();
        {
          f32x4 x0, x1, z0, z1; pg8::unpack8(xk, x0, x1); pg8::unpack8(zk, z0, z1);
          const f32x4 y0 = (*(const f32x4*)(Yo + pp * 64 + c8) + Dh * x0) * z0 * sig4g(z0), y1 = (*(const f32x4*)(Yo + pp * 64 + c8 + 4) + Dh * x1) * z1 * sig4g(z1);
          *(u32x4*)(YA + (size_t)c0 * 512) = pg8::pack8(y0, y1); }
    }
#undef SSD_FETCH
#undef SSD_DT
}
__device__ __forceinline__ void ssd_norm_item4(KArgs C, int layer, int item0, int stride, int nitems, int lane) {
    u32x2 w[4]; bf16* p[4];
#pragma unroll
    for (int q = 0; q < 4; ++q) { const int item = item0 + q * stride; p[q] = WSP(bf16, WS_Y) + (size_t)((item < nitems ? item : item0) >> 1) * 512 + ((item < nitems ? item : item0) & 1) * 256 + lane * 4; w[q] = *(const u32x2*)p[q]; }
#pragma unroll
    for (int q = 0; q < 4; ++q) { const int item = item0 + q * stride; if (item < nitems) {
        float v[4] = {lo_bf(w[q].x), hi_bf(w[q].x), lo_bf(w[q].y), hi_bf(w[q].y)};
        const float rstd = 1.0f / sqrtf(wave_sum(v[0] * v[0] + v[1] * v[1] + v[2] * v[2] + v[3] * v[3]) * (1.f / 256) + RMS_EPS);
        const float* g = C->in[I_SSDNG] + layer * 512 + (item & 1) * 256 + lane * 4;
        u32x2 o; o.x = pk2(v[0] * rstd * g[0], v[1] * rstd * g[1]); o.y = pk2(v[2] * rstd * g[2], v[3] * rstd * g[3]); *(u32x2*)p[q] = o; } }
}
__device__ __forceinline__ void rwkv_prep_row(KArgs C, int layer, int m, int lane) {
    const int t = m % SEQ, col = 1536 + lane * 4;
    const bf16* cur = WSP(const bf16, WS_RW) + (size_t)m * 1792 + col;
    const u32x2 wc = *(const u32x2*)cur; u32x2 wp; wp.x = 0u; wp.y = 0u; if (t > 0) wp = *(const u32x2*)(cur - 1792);
    const f32x4 mu = *(const f32x4*)(C->in[I_MU] + layer * 1792 + col);
    float v[4] = {lo_bf(wc.x), hi_bf(wc.x), lo_bf(wc.y), hi_bf(wc.y)}; const float p[4] = {lo_bf(wp.x), hi_bf(wp.x), lo_bf(wp.y), hi_bf(wp.y)};
#pragma unroll
    for (int i = 0; i < 4; ++i) { v[i] = v[i] + (p[i] - v[i]) * mu[i]; v[i] = lane < 16 ? tanh_fast(v[i]) : (lane < 32 ? v[i] : sigm(v[i])); }
    u32x2 o; o.x = pk2(v[0], v[1]); o.y = pk2(v[2], v[3]); *(u32x2*)(WSP(bf16, WS_RA) + (size_t)m * 256 + lane * 4) = o;
}
__device__ __forceinline__ void rwkv_prep_row2(KArgs C, int layer, int m, int step, int lane) {
    const int col = 1536 + lane * 4; const f32x4 mu = *(const f32x4*)(C->in[I_MU] + layer * 1792 + col);
    u32x2 wc[2], wp[2];
#pragma unroll
    for (int r = 0; r < 2; ++r) { const int mm = m + r * step; const bf16* cur = WSP(const bf16, WS_RW) + (size_t)mm * 1792 + col; wc[r] = *(const u32x2*)cur;
        if (mm % SEQ > 0) wp[r] = *(const u32x2*)(cur - 1792); else { wp[r].x = 0u; wp[r].y = 0u; } }
#pragma unroll
    for (int r = 0; r < 2; ++r) { float v[4] = {lo_bf(wc[r].x), hi_bf(wc[r].x), lo_bf(wc[r].y), hi_bf(wc[r].y)}; const float p[4] = {lo_bf(wp[r].x), hi_bf(wp[r].x), lo_bf(wp[r].y), hi_bf(wp[r].y)};
#pragma unroll
        for (int i = 0; i < 4; ++i) { v[i] = v[i] + (p[i] - v[i]) * mu[i]; v[i] = lane < 16 ? tanh_fast(v[i]) : (lane < 32 ? v[i] : sigm(v[i])); }
        u32x2 o; o.x = pk2(v[0], v[1]); o.y = pk2(v[2], v[3]); *(u32x2*)(WSP(bf16, WS_RA) + (size_t)(m + r * step) * 256 + lane * 4) = o; }
}
__device__ __forceinline__ void rwkv_unit(KArgs C, int layer, int unit, unsigned char* lds) {
    constexpr int SLOT = 16704, O_RT = 2048, O_BTL = 4096, O_KTL = 6144, O_BHT = 8192, O_KHT = 10240, O_VT = 12288, O_TM = 14336, O_AAK = 14848, O_RB = 15360, O_RK = 15872, O_DL = 16384, O_BON = 16640;
    const int tid = fresh_tid(), lane = tid & 63, wave = tid >> 6, bl = unit >> 3, h = unit & 7, pt = tid >> 3, k8 = (tid & 7) * 8, cc = pt >> 4, tl = pt & 15, hc = h * 64 + k8;
    float* WL = (float*)(lds + 4 * SLOT); float* Nf = WL + 4096; float* Yb = Nf + 1024; float* ct_ = Yb + 4096;
    const bf16* RW = WSP(const bf16, WS_RW) + (size_t)bl * SEQ * 1792 + hc;
    const float* WLG = WSP(const float, WS_WLOG) + (size_t)bl * SEQ * 512 + hc;
    const bf16* AS = WSP(const bf16, WS_ASIG) + (size_t)bl * SEQ * 512 + hc;
    const bf16* GG = WSP(const bf16, WS_GG) + (size_t)bl * SEQ * 512 + hc;
    bf16* YC = WSP(bf16, WS_Y) + (size_t)2 * MG * 512 + (size_t)bl * SEQ * 512 + hc;
    LDS_SYNC();
    { const int row = tid >> 6, j = tid & 63; const float* src = row == 0 ? C->in[I_MU] + layer * 1792 : row == 1 ? C->in[I_MU] + layer * 1792 + 512 : row == 2 ? C->in[I_MU] + layer * 1792 + 1024
          : row == 3 ? C->in[I_KK] + layer * 512 : row == 4 ? C->in[I_KA] + layer * 512 : row == 5 ? C->in[I_RK] + layer * 512 : row == 6 ? C->in[I_LNG] + layer * 512 : C->in[I_LNB] + layer * 512;
      ct_[tid] = src[h * 64 + j]; }
    f32x4_t Sd[4]; bf16x8_t Sf[2];
#pragma unroll
    for (int i = 0; i < 4; ++i) Sd[i] = (f32x4_t){0.f, 0.f, 0.f, 0.f};
    { u32x2 z; z.x = 0u; z.y = 0u; Sf[0] = frag2(z, z); Sf[1] = Sf[0]; }
    u32x4 rc, rp, kc, kp, vc, vp, ac, gc; f32x4 wl0, wl1;
#define RWKV_FETCH(c0_) do { const int tt_ = (c0_) + pt; const bf16* q_ = RW + (size_t)tt_ * 1792; \
        rc = *(const u32x4*)q_; kc = *(const u32x4*)(q_ + 512); vc = *(const u32x4*)(q_ + 1024); \
        if (tt_ > 0) { rp = *(const u32x4*)(q_ - 1792); kp = *(const u32x4*)(q_ - 1792 + 512); vp = *(const u32x4*)(q_ - 1792 + 1024); } else { rp = (u32x4){0u, 0u, 0u, 0u}; kp = rp; vp = rp; } \
        wl0 = *(const f32x4*)(WLG + (size_t)tt_ * 512); wl1 = *(const f32x4*)(WLG + (size_t)tt_ * 512 + 4); ac = *(const u32x4*)(AS + (size_t)tt_ * 512); gc = *(const u32x4*)(GG + (size_t)tt_ * 512); } while (0)
    RWKV_FETCH(0);
    for (int c0 = 0; c0 < SEQ; c0 += 64) {
        unsigned char* slot = lds + cc * SLOT;
        LDS_SYNC();
        f32x4 r0, r1, kq0, kq1, v0, v1, kk0, kk1, b0, b1; const u32x4 gkeep = gc; const f32x4 wk0 = wl0, wk1 = wl1;
        { f32x4 c0_, c1_, p0_, p1_, a0, a1;
          pg8::unpack8(rc, c0_, c1_); pg8::unpack8(rp, p0_, p1_); r0 = c0_ + (p0_ - c0_) * *(const f32x4*)(ct_ + k8); r1 = c1_ + (p1_ - c1_) * *(const f32x4*)(ct_ + k8 + 4);
          pg8::unpack8(kc, c0_, c1_); pg8::unpack8(kp, p0_, p1_); const f32x4 k00 = c0_ + (p0_ - c0_) * *(const f32x4*)(ct_ + 64 + k8), k01 = c1_ + (p1_ - c1_) * *(const f32x4*)(ct_ + 64 + k8 + 4);
          pg8::unpack8(vc, c0_, c1_); pg8::unpack8(vp, p0_, p1_); v0 = c0_ + (p0_ - c0_) * *(const f32x4*)(ct_ + 128 + k8); v1 = c1_ + (p1_ - c1_) * *(const f32x4*)(ct_ + 128 + k8 + 4);
          pg8::unpack8(ac, a0, a1);
          kk0 = k00 * *(const f32x4*)(ct_ + 192 + k8); kk1 = k01 * *(const f32x4*)(ct_ + 192 + k8 + 4);
          const float inv = 1.0f / fmaxf(sqrtf(red8((kk0.x * kk0.x + kk0.y * kk0.y + kk0.z * kk0.z + kk0.w * kk0.w) + (kk1.x * kk1.x + kk1.y * kk1.y + kk1.z * kk1.z + kk1.w * kk1.w))), 1e-12f);
          kk0 = kk0 * inv; kk1 = kk1 * inv; b0 = kk0 * a0; b1 = kk1 * a1;
          kq0 = k00 * (1.0f + (a0 - 1.0f) * *(const f32x4*)(ct_ + 256 + k8)); kq1 = k01 * (1.0f + (a1 - 1.0f) * *(const f32x4*)(ct_ + 256 + k8 + 4));
          const f32x4 q0 = r0 * kq0 * *(const f32x4*)(ct_ + 320 + k8), q1 = r1 * kq1 * *(const f32x4*)(ct_ + 320 + k8 + 4);
          const float bo = red8((q0.x + q0.y + q0.z + q0.w) + (q1.x + q1.y + q1.z + q1.w));
          if ((tid & 7) == 0) ((float*)(slot + O_BON))[tl] = bo;
          *(f32x4*)(WL + pt * 64 + k8) = wk0; *(f32x4*)(WL + pt * 64 + k8 + 4) = wk1; }
        if (c0 + 64 < SEQ) RWKV_FETCH(c0 + 64);
        LDS_SYNC();
        if (tid < 256) { const int c_ = tid >> 6, k_ = tid & 63; float w16[16], run = 0.f;
#pragma unroll
            for (int t = 0; t < 16; ++t) w16[t] = WL[(c_ * 16 + t) * 64 + k_];
#pragma unroll
            for (int t = 0; t < 16; ++t) { run += w16[t]; WL[(c_ * 16 + t) * 64 + k_] = run; }
            ((float*)(lds + c_ * SLOT + O_DL))[k_] = __expf(run); }
        LDS_SYNC();
        { const f32x4 cs0 = *(const f32x4*)(WL + pt * 64 + k8), cs1 = *(const f32x4*)(WL + pt * 64 + k8 + 4), d0 = *(const f32x4*)((const float*)(slot + O_DL) + k8), d1 = *(const f32x4*)((const float*)(slot + O_DL) + k8 + 4);
          f32x4 e0, e1, f0, f1, w0, w1;
#pragma unroll
          for (int i = 0; i < 4; ++i) { e0[i] = __expf(cs0[i]); e1[i] = __expf(cs1[i]); f0[i] = __builtin_amdgcn_rcpf(e0[i]); f1[i] = __builtin_amdgcn_rcpf(e1[i]); w0[i] = __expf(-wk0[i]); w1[i] = __expf(-wk1[i]); }
          const f32x4 bt0 = b0 * f0, bt1 = b1 * f1, kt0 = kq0 * f0, kt1 = kq1 * f1;
          *(u32x4*)((bf16*)slot + tl * 64 + k8) = pg8::pack8(-(kk0 * e0 * w0), -(kk1 * e1 * w1));
          *(u32x4*)((bf16*)(slot + O_RT) + tl * 64 + k8) = pg8::pack8(r0 * e0, r1 * e1);
          *(u32x4*)((bf16*)(slot + O_BTL) + tl * 64 + k8) = pg8::pack8(bt0, bt1);
          *(u32x4*)((bf16*)(slot + O_KTL) + tl * 64 + k8) = pg8::pack8(kt0, kt1);
          const f32x4 bh0 = bt0 * d0, bh1 = bt1 * d1, kh0 = kt0 * d0, kh1 = kt1 * d1;
          bf16* bht = (bf16*)(slot + O_BHT) + k8 * 16 + tl; bf16* kht = (bf16*)(slot + O_KHT) + k8 * 16 + tl; bf16* vt = (bf16*)(slot + O_VT) + k8 * 16 + tl;
#pragma unroll
          for (int i = 0; i < 4; ++i) { bht[i * 16] = f2bf(bh0[i]); bht[(i + 4) * 16] = f2bf(bh1[i]); kht[i * 16] = f2bf(kh0[i]); kht[(i + 4) * 16] = f2bf(kh1[i]); vt[i * 16] = f2bf(v0[i]); vt[(i + 4) * 16] = f2bf(v1[i]); } }
        LDS_SYNC();
        { unsigned char* sl = lds + (wave & 3) * SLOT; const int c16 = lane & 15, q = lane >> 4;
          const bf16x8_t a0 = *(const bf16x8_t*)((const bf16*)sl + c16 * 64 + 8 * q), a1 = *(const bf16x8_t*)((const bf16*)sl + c16 * 64 + 32 + 8 * q);
          const bf16x8_t bb0 = *(const bf16x8_t*)((const bf16*)(sl + O_BTL) + c16 * 64 + 8 * q), bb1 = *(const bf16x8_t*)((const bf16*)(sl + O_BTL) + c16 * 64 + 32 + 8 * q);
          const f32x4_t z4 = {0.f, 0.f, 0.f, 0.f};
          if (wave < 4) {
              f32x4_t n = __builtin_amdgcn_mfma_f32_16x16x32_bf16(a0, bb0, z4, 0, 0, 0); n = __builtin_amdgcn_mfma_f32_16x16x32_bf16(a1, bb1, n, 0, 0, 0);
              float* nf = Nf + (wave & 3) * 256;
#pragma unroll
              for (int r = 0; r < 4; ++r) nf[c16 * 16 + 4 * q + r] = (c16 < 4 * q + r) ? n[r] : 0.f;
              WAVE_SYNC();
              float tc[16];
#pragma unroll
              for (int t = 0; t < 16; ++t) tc[t] = (t == c16) ? 1.f : 0.f;
#pragma unroll
              for (int s2 = 0; s2 < 15; ++s2) { const f32x4 n0 = *(const f32x4*)(nf + s2 * 16), n1 = *(const f32x4*)(nf + s2 * 16 + 4), n2 = *(const f32x4*)(nf + s2 * 16 + 8), n3 = *(const f32x4*)(nf + s2 * 16 + 12);
                  const float ts = tc[s2]; const float nn[16] = {n0.x, n0.y, n0.z, n0.w, n1.x, n1.y, n1.z, n1.w, n2.x, n2.y, n2.z, n2.w, n3.x, n3.y, n3.z, n3.w};
#pragma unroll
                  for (int t = 0; t < 16; ++t) if (t > s2) tc[t] += nn[t] * ts; }
              if (q == 0) { bf16* tm = (bf16*)(sl + O_TM) + c16;
#pragma unroll
                  for (int t = 0; t < 16; ++t) tm[t * 16] = f2bf(tc[t]); }
          } else {
              const bf16x8_t r0f = *(const bf16x8_t*)((const bf16*)(sl + O_RT) + c16 * 64 + 8 * q), r1f = *(const bf16x8_t*)((const bf16*)(sl + O_RT) + c16 * 64 + 32 + 8 * q);
              const bf16x8_t kb0 = *(const bf16x8_t*)((const bf16*)(sl + O_KTL) + c16 * 64 + 8 * q), kb1 = *(const bf16x8_t*)((const bf16*)(sl + O_KTL) + c16 * 64 + 32 + 8 * q);
              f32x4_t ak = __builtin_amdgcn_mfma_f32_16x16x32_bf16(a0, kb0, z4, 0, 0, 0); ak = __builtin_amdgcn_mfma_f32_16x16x32_bf16(a1, kb1, ak, 0, 0, 0);
              f32x4_t rb = __builtin_amdgcn_mfma_f32_16x16x32_bf16(r0f, bb0, z4, 0, 0, 0); rb = __builtin_amdgcn_mfma_f32_16x16x32_bf16(r1f, bb1, rb, 0, 0, 0);
              f32x4_t rk = __builtin_amdgcn_mfma_f32_16x16x32_bf16(r0f, kb0, z4, 0, 0, 0); rk = __builtin_amdgcn_mfma_f32_16x16x32_bf16(r1f, kb1, rk, 0, 0, 0);
#pragma unroll
              for (int r = 0; r < 4; ++r) { const int t = 4 * q + r;
                  ((bf16*)(sl + O_AAK))[t * 16 + c16] = f2bf(c16 < t ? ak[r] : 0.f); ((bf16*)(sl + O_RB))[t * 16 + c16] = f2bf(c16 <= t ? rb[r] : 0.f); ((bf16*)(sl + O_RK))[t * 16 + c16] = f2bf(c16 <= t ? rk[r] : 0.f); }
          } }
        LDS_SYNC();
        if (wave < 4) { const int c16 = lane & 15, q = lane >> 4, vcol = 16 * wave + c16; u32x2 zz; zz.x = 0u; zz.y = 0u; const f32x4_t z4 = {0.f, 0.f, 0.f, 0.f};
#pragma unroll
            for (int ch = 0; ch < 4; ++ch) { const unsigned char* sl = lds + ch * SLOT;
                const bf16* at = (const bf16*)sl + c16 * 64 + 4 * q; const bf16* rt = (const bf16*)(sl + O_RT) + c16 * 64 + 4 * q;
                const bf16x8_t af0 = frag2(*(const u32x2*)at, *(const u32x2*)(at + 16)), af1 = frag2(*(const u32x2*)(at + 32), *(const u32x2*)(at + 48));
                const bf16x8_t rf0 = frag2(*(const u32x2*)rt, *(const u32x2*)(rt + 16)), rf1 = frag2(*(const u32x2*)(rt + 32), *(const u32x2*)(rt + 48));
                const u32x2 vq = *(const u32x2*)((const bf16*)(sl + O_VT) + vcol * 16 + 4 * q);
                const u32x2 aq = *(const u32x2*)((const bf16*)(sl + O_AAK) + c16 * 16 + 4 * q), tq = *(const u32x2*)((const bf16*)(sl + O_TM) + c16 * 16 + 4 * q);
                const u32x2 rbq = *(const u32x2*)((const bf16*)(sl + O_RB) + c16 * 16 + 4 * q), rkq = *(const u32x2*)((const bf16*)(sl + O_RK) + c16 * 16 + 4 * q);
                f32x4_t rhs = __builtin_amdgcn_mfma_f32_16x16x32_bf16(frag2(zz, aq), frag2(zz, vq), z4, 0, 0, 0); rhs = __builtin_amdgcn_mfma_f32_16x16x32_bf16(af0, Sf[0], rhs, 0, 0, 0);
                { const f32x4_t r2 = __builtin_amdgcn_mfma_f32_16x16x32_bf16(af1, Sf[1], z4, 0, 0, 0); rhs = rhs + r2; }
                u32x2 rl; rl.x = pk2(rhs[0], rhs[1]); rl.y = pk2(rhs[2], rhs[3]);
                const f32x4_t U = __builtin_amdgcn_mfma_f32_16x16x32_bf16(frag2(tq, zz), frag2(rl, zz), z4, 0, 0, 0);
                u32x2 ul; ul.x = pk2(U[0], U[1]); ul.y = pk2(U[2], U[3]); const bf16x8_t uv = frag2(ul, vq);
                f32x4_t y = __builtin_amdgcn_mfma_f32_16x16x32_bf16(rf0, Sf[0], z4, 0, 0, 0); y = __builtin_amdgcn_mfma_f32_16x16x32_bf16(rf1, Sf[1], y, 0, 0, 0);
                y = __builtin_amdgcn_mfma_f32_16x16x32_bf16(frag2(rbq, rkq), uv, y, 0, 0, 0);
#pragma unroll
                for (int r = 0; r < 4; ++r) Yb[(ch * 16 + 4 * q + r) * 64 + vcol] = y[r];
#pragma unroll
                for (int kt = 0; kt < 4; ++kt) { const f32x4 dl = *(const f32x4*)((const float*)(sl + O_DL) + 16 * kt + 4 * q);
                    const u32x2 bq = *(const u32x2*)((const bf16*)(sl + O_BHT) + (16 * kt + c16) * 16 + 4 * q), kq = *(const u32x2*)((const bf16*)(sl + O_KHT) + (16 * kt + c16) * 16 + 4 * q);
                    const f32x4_t cin = {Sd[kt][0] * dl.x, Sd[kt][1] * dl.y, Sd[kt][2] * dl.z, Sd[kt][3] * dl.w};
                    Sd[kt] = __builtin_amdgcn_mfma_f32_16x16x32_bf16(frag2(bq, kq), uv, cin, 0, 0, 0); }
#pragma unroll
                for (int s2 = 0; s2 < 2; ++s2) { u32x2 lo, hi; lo.x = pk2(Sd[2 * s2][0], Sd[2 * s2][1]); lo.y = pk2(Sd[2 * s2][2], Sd[2 * s2][3]); hi.x = pk2(Sd[2 * s2 + 1][0], Sd[2 * s2 + 1][1]); hi.y = pk2(Sd[2 * s2 + 1][2], Sd[2 * s2 + 1][3]); Sf[s2] = frag2(lo, hi); }
            } }
        LDS_SYNC();
        { const f32x4 y0 = *(const f32x4*)(Yb + pt * 64 + k8), y1 = *(const f32x4*)(Yb + pt * 64 + k8 + 4);
          const float mean = red8((y0.x + y0.y + y0.z + y0.w) + (y1.x + y1.y + y1.z + y1.w)) * (1.f / 64); const f32x4 d0 = y0 - mean, d1 = y1 - mean;
          const float rstd = 1.0f / sqrtf(red8((d0.x * d0.x + d0.y * d0.y + d0.z * d0.z + d0.w * d0.w) + (d1.x * d1.x + d1.y * d1.y + d1.z * d1.z + d1.w * d1.w)) * (1.f / 64) + GN_EPS);
          const float bo = ((const float*)(slot + O_BON))[tl]; f32x4 g0, g1; pg8::unpack8(gkeep, g0, g1);
          const f32x4 o0 = (d0 * rstd * *(const f32x4*)(ct_ + 384 + k8) + *(const f32x4*)(ct_ + 448 + k8) + bo * v0) * g0, o1 = (d1 * rstd * *(const f32x4*)(ct_ + 384 + k8 + 4) + *(const f32x4*)(ct_ + 448 + k8 + 4) + bo * v1) * g1;
          *(u32x4*)(YC + (size_t)(c0 + pt) * 512) = pg8::pack8(o0, o1); }
    }
#undef RWKV_FETCH
}

__device__ __forceinline__ void s5_unit(KArgs C, int layer, int unit, unsigned char* lds) {
    const int tid = fresh_tid(), lane = tid & 63, wave = tid >> 6, bl = unit >> 5, g = unit & 31, c16 = lane & 15, q = lane >> 4, sg = wave & 3, th = wave >> 2, p = 16 * sg + c16;
    constexpr int SP = 136;
    float* us = (float*)lds; float* ends = us + 1024; bf16* St = (bf16*)(ends + 16 * 128);
    const bf16* U = WSP(const bf16, WS_U) + (size_t)bl * SEQ * 512 + g * 16;
    bf16* YD0 = WSP(bf16, WS_YD0) + (size_t)bl * SEQ * 512 + g * 16;
    const size_t wo = (layer & 1) ? WDELTA : 0;
    bf16x8_t bre, bim;
    { const float* bb = WSP(const float, WS_BBAR + wo) + ((size_t)g * 64 + p) * 32; u32x4 wr_, wi_;
      if (q < 2) { const float* b8 = bb + 16 * q; wr_.x = pk2(b8[0], b8[2]); wr_.y = pk2(b8[4], b8[6]); wr_.z = pk2(b8[8], b8[10]); wr_.w = pk2(b8[12], b8[14]);
                   wi_.x = pk2(b8[1], b8[3]); wi_.y = pk2(b8[5], b8[7]); wi_.z = pk2(b8[9], b8[11]); wi_.w = pk2(b8[13], b8[15]); }
      else { wr_ = (u32x4){0u, 0u, 0u, 0u}; wi_ = wr_; }
      bre = __builtin_bit_cast(bf16x8_t, wr_); bim = __builtin_bit_cast(bf16x8_t, wi_); }
    float apr[4], api[4];
    { const float ar = WSP(const float, WS_ABAR + wo)[(g * 64 + p) * 2], ai = WSP(const float, WS_ABAR + wo)[(g * 64 + p) * 2 + 1]; apr[0] = ar; api[0] = ai;
#pragma unroll
      for (int i = 1; i < 4; ++i) { apr[i] = apr[i - 1] * ar - api[i - 1] * ai; api[i] = apr[i - 1] * ai + api[i - 1] * ar; } }
    bf16x8_t cf[4];
    { const float* cre = C->in[I_S5CRE] + ((size_t)layer * 32 + g) * 1024 + c16 * 64; const float* cim = C->in[I_S5CIM] + ((size_t)layer * 32 + g) * 1024 + c16 * 64;
#pragma unroll
      for (int ks = 0; ks < 4; ++ks) { const int c0_ = 32 * ks + 8 * q; const float* src = c0_ < 64 ? cre + c0_ : cim + (c0_ - 64); const float sgn = c0_ < 64 ? 1.f : -1.f;
          u32x4 w; w.x = pk2(sgn * src[0], sgn * src[1]); w.y = pk2(sgn * src[2], sgn * src[3]); w.z = pk2(sgn * src[4], sgn * src[5]); w.w = pk2(sgn * src[6], sgn * src[7]); cf[ks] = __builtin_bit_cast(bf16x8_t, w); } }
    const float dj = C->in[I_S5D][layer * 512 + g * 16 + c16];
    float cr = 0.f, ci = 0.f;
    u32x2 fu; fu.x = 0u; fu.y = 0u;
#define S5_FETCH(c0_) do { if (tid < 256) fu = *(const u32x2*)(U + (size_t)((c0_) + (tid >> 2)) * 512 + (tid & 3) * 4); } while (0)
    S5_FETCH(0);
    for (int c0 = 0; c0 < SEQ; c0 += 64) {
        LDS_SYNC();
        if (tid < 256) *(f32x4*)(us + (tid >> 2) * 16 + (tid & 3) * 4) = (f32x4){lo_bf(fu.x), hi_bf(fu.x), lo_bf(fu.y), hi_bf(fu.y)};
        if (c0 + 64 < SEQ) S5_FETCH(c0 + 64);
        LDS_SYNC();
        float lr[2][4], li[2][4];
#pragma unroll
        for (int tt = 0; tt < 2; ++tt) { bf16x8_t af;
            if (q < 2) { const float* ur = us + (32 * th + 16 * tt + c16) * 16 + 8 * q; const f32x4 u0 = *(const f32x4*)ur, u1 = *(const f32x4*)(ur + 4);
                u32x4 w; w.x = pk2(u0.x, u0.y); w.y = pk2(u0.z, u0.w); w.z = pk2(u1.x, u1.y); w.w = pk2(u1.z, u1.w); af = __builtin_bit_cast(bf16x8_t, w); }
            else { const u32x4 z = {0u, 0u, 0u, 0u}; af = __builtin_bit_cast(bf16x8_t, z); }
            const f32x4_t z4 = {0.f, 0.f, 0.f, 0.f};
            const f32x4_t dre = __builtin_amdgcn_mfma_f32_16x16x32_bf16(af, bre, z4, 0, 0, 0), dim = __builtin_amdgcn_mfma_f32_16x16x32_bf16(af, bim, z4, 0, 0, 0);
            lr[tt][0] = dre[0]; li[tt][0] = dim[0];
#pragma unroll
            for (int r = 1; r < 4; ++r) { lr[tt][r] = apr[0] * lr[tt][r - 1] - api[0] * li[tt][r - 1] + dre[r]; li[tt][r] = apr[0] * li[tt][r - 1] + api[0] * lr[tt][r - 1] + dim[r]; }
            const int rho = (2 * th + tt) * 4 + q; ends[(rho * 64 + p) * 2] = lr[tt][3]; ends[(rho * 64 + p) * 2 + 1] = li[tt][3]; }
        LDS_SYNC();
        { float xr = cr, xi = ci; const int rho0 = (2 * th) * 4 + q;
          for (int rr = 0; rr < 16; ++rr) {
              if (rr == rho0 || rr == rho0 + 4) { const int tt = (rr == rho0) ? 0 : 1;
#pragma unroll
                  for (int r = 0; r < 4; ++r) { const float sr = lr[tt][r] + apr[r] * xr - api[r] * xi, si = li[tt][r] + apr[r] * xi + api[r] * xr; const int t = 32 * th + 16 * tt + 4 * q + r;
                      St[t * SP + p] = f2bf(sr); St[t * SP + 64 + p] = f2bf(si); } }
              const float er = ends[(rr * 64 + p) * 2], ei = ends[(rr * 64 + p) * 2 + 1]; const float nr = apr[3] * xr - api[3] * xi + er, ni = apr[3] * xi + api[3] * xr + ei; xr = nr; xi = ni; }
          cr = xr; ci = xi; }
        LDS_SYNC();
        if (wave < 4) { f32x4_t y = {0.f, 0.f, 0.f, 0.f};
#pragma unroll
            for (int ks = 0; ks < 4; ++ks) y = __builtin_amdgcn_mfma_f32_16x16x32_bf16(*(const bf16x8_t*)(St + (16 * wave + c16) * SP + 32 * ks + 8 * q), cf[ks], y, 0, 0, 0);
#pragma unroll
            for (int r = 0; r < 4; ++r) { const int t = 16 * wave + 4 * q + r; YD0[(size_t)(c0 + t) * 512 + c16] = f2bf(gelu_tanh(y[r] + dj * us[t * 16 + c16])); } }
    }
#undef S5_FETCH
}

__device__ __forceinline__ unsigned ord_key(float f) { const unsigned u = __float_as_uint(f); return (u & 0x80000000u) ? ~u : (u | 0x80000000u); }
__device__ __forceinline__ void dsa_vt_item(KArgs C, int item, int lane, bf16* scr) {
    const int tb = item % NK64, bh = item / NK64, h = bh & 7, bl = bh >> 3;
    const bf16* V = WSP(const bf16, WS_V) + ((size_t)bl * SEQ + tb * 64) * 512 + h * 64;
    WAVE_SYNC();
#pragma unroll
    for (int i = 0; i < 8; ++i) { const int tk = (lane >> 3) + 8 * i, c8 = (lane & 7) * 8; const u32x4 w = *(const u32x4*)(V + (size_t)tk * 512 + c8);
        unsigned* d = (unsigned*)(scr + tk * 66 + c8); d[0] = w.x; d[1] = w.y; d[2] = w.z; d[3] = w.w; }
    WAVE_SYNC();
    bf16* Vt = WSP(bf16, WS_VT) + ((size_t)bh * 64) * SEQ + tb * 64 + lane;
#pragma unroll 8
    for (int d = 0; d < 64; ++d) Vt[(size_t)d * SEQ] = scr[lane * 66 + d];
}
constexpr int IDX_CAP = 128, IDX_NBIN = 1024;
__device__ __forceinline__ void dsa_index_unit(KArgs C, int unit, int lane, int wave, unsigned char* lds) {
    const int oct = unit & 7, pairid = (unit >> 3) % (NK64 / 2), kx = (unit >> 3) / (NK64 / 2), bl = kx >> 1, c = (kx & 1) ? NK64 - 1 - pairid : pairid;
    const int t0 = c * 64 + oct * 8, nkeys = (c + 1) * 64, nk64 = c + 1; const size_t row0 = (size_t)bl * SEQ + t0;
    unsigned* mrow = WSP(unsigned, WS_MASK) + (row0 + wave) * MW;
    if (nkeys <= TOPK) { for (int w = lane; w < MW; w += 64) mrow[w] = (w * 32 < nkeys) ? 0xffffffffu : 0u; return; }
    float* scf = (float*)lds;
    unsigned* hist = (unsigned*)(lds + LDS_X) + wave * (IDX_NBIN / 2); unsigned* candv = (unsigned*)(lds + LDS_X + 8 * IDX_NBIN * 2) + wave * IDX_CAP; unsigned* candi = candv + 8 * IDX_CAP; unsigned* mword = (unsigned*)(lds + LDS_X + 8 * IDX_NBIN * 2 + 16 * IDX_CAP * 4) + wave * MW;
    const bf16* SMb = WSP(const bf16, WS_SM) + (size_t)bl * SEQ * 256;
    const int l31 = lane & 31, half = lane >> 5;
    const bf16* qa = SMb + (size_t)(t0 + (l31 >> 2)) * 256 + 8 + (l31 & 3) * 32 + 8 * half;
    const bf16x8_t a0 = *(const bf16x8_t*)qa, a1 = *(const bf16x8_t*)(qa + 16);
    u32x2 wraw[4];
#pragma unroll
    for (int g = 0; g < 4; ++g) wraw[g] = *(const u32x2*)(SMb + (size_t)(t0 + 2 * g + half) * 256 + 168);
    LDS_SYNC();
    {
      float wv[4][4];
#pragma unroll
      for (int g = 0; g < 4; ++g) { const u32x2 w = wraw[g]; wv[g][0] = lo_bf(w.x) * 0.5f; wv[g][1] = hi_bf(w.x) * 0.5f; wv[g][2] = lo_bf(w.y) * 0.5f; wv[g][3] = hi_bf(w.y) * 0.5f; }
      for (int kt0 = wave; kt0 < nk64 * 2; kt0 += 8 * NWAVES) {
          bf16x8_t b0[8], b1[8];
#pragma unroll
          for (int u4 = 0; u4 < 8; ++u4) { const int kt = kt0 + 8 * u4; const bf16* kb = WSP(const bf16, WS_KI) + ((size_t)bl * SEQ + (size_t)((kt < nk64 * 2 ? kt : wave) * 32 + l31)) * 32 + 8 * half;
              b0[u4] = *(const bf16x8_t*)kb; b1[u4] = *(const bf16x8_t*)(kb + 16); }
#pragma unroll
          for (int u4 = 0; u4 < 8; ++u4) { const int kt = kt0 + 8 * u4; if (kt < nk64 * 2) {
              f32x16 d;
#pragma unroll
              for (int r = 0; r < 16; ++r) d[r] = 0.f;
              d = __builtin_amdgcn_mfma_f32_32x32x16_bf16(a0, b0[u4], d, 0, 0, 0); d = __builtin_amdgcn_mfma_f32_32x32x16_bf16(a1, b1[u4], d, 0, 0, 0);
#pragma unroll
              for (int g = 0; g < 4; ++g) { float sc = 0.f;
#pragma unroll
                  for (int j = 0; j < 4; ++j) sc += wv[g][j] * fmaxf(d[4 * g + j] * 0.17677669529f, 0.f);
                  scf[(2 * g + half) * SEQ + kt * 32 + l31] = sc; } } }
      } }
    { const int tail0 = nkeys, tail1 = ((nk64 + 7) >> 3) * 512;
      for (int e = tail0 + (int)(threadIdx.x); e < tail1; e += NTHREADS) {
#pragma unroll
          for (int qq = 0; qq < 8; ++qq) scf[qq * SEQ + e] = -3.0e38f; } }
    LDS_SYNC();
    const float* sc = scf + wave * SEQ; constexpr float NEG = -3.0e38f; const int nb8 = (nk64 + 7) >> 3;
    float v[NK64];
#pragma unroll
    for (int ib = 0; ib < NK64 / 8; ++ib) if (ib < nb8) {
#pragma unroll
        for (int j = 0; j < 8; ++j) v[ib * 8 + j] = sc[(ib * 8 + j) * 64 + lane];
        SCHED_FENCE(); }
    float mn = INFINITY, mx = -INFINITY;
#pragma unroll
    for (int ib = 0; ib < NK64 / 8; ++ib) if (ib < nb8) {
#pragma unroll
        for (int j = 0; j < 8; ++j) { const float x = v[ib * 8 + j]; mx = fmaxf(mx, x); mn = fminf(mn, x == NEG ? INFINITY : x); } }
    mn = -wave_max(-mn); mx = wave_max(mx);
    const float scale = (mx > mn) ? ((float)(IDX_NBIN - 2) - 0.01f) / (mx - mn) : 0.f;
#pragma unroll
    for (int i = 0; i < IDX_NBIN / 128; ++i) hist[lane * (IDX_NBIN / 128) + i] = 0u;
    for (int w = lane; w < MW; w += 64) mword[w] = 0u;
    WAVE_SYNC();
#define IDX_BIN(x) ({ const float x_ = (x); int b_ = (int)(fmaxf(x_ - mn, 0.f) * scale + 1.0f); b_ = b_ > IDX_NBIN - 2 ? IDX_NBIN - 2 : b_; b_ + (__float_as_int(x_) >> 31) + (__float_as_int(x_) > 0 ? 1 : 0); })
#pragma unroll
    for (int ib = 0; ib < NK64 / 8; ++ib) if (ib < nb8) {
#pragma unroll
        for (int j = 0; j < 8; ++j) { const int b = IDX_BIN(v[ib * 8 + j]); atomicAdd(&hist[b >> 1], (b & 1) ? 0x10000u : 1u); }
        SCHED_FENCE(); }
    WAVE_SYNC();
    int bstar, cgt;
    {
      unsigned hw[8]; int tot = 0;
#pragma unroll
      for (int i = 0; i < 8; ++i) { hw[i] = hist[lane * 8 + i]; tot += (int)(hw[i] & 0xffffu) + (int)(hw[i] >> 16); }
      int suf = tot;
#pragma unroll
      for (int o = 1; o < 64; o <<= 1) { const int t = __shfl_down(suf, o); if (lane + o < 64) suf += t; }
      const unsigned long long ge = __ballot(suf >= TOPK); const int L = 63 - __builtin_clzll(ge);
      int cum = __shfl(suf, L) - __shfl(tot, L); bstar = 16 * L; cgt = cum; bool found = false;
#pragma unroll
      for (int i = 7; i >= 0; --i) { const unsigned w = (unsigned)__shfl((int)hw[i], L); const int chi = (int)(w >> 16), clo = (int)(w & 0xffffu);
          if (!found && cum + chi >= TOPK) { bstar = 16 * L + 2 * i + 1; cgt = cum; found = true; } cum += found ? 0 : chi;
          if (!found && cum + clo >= TOPK) { bstar = 16 * L + 2 * i; cgt = cum; found = true; } cum += found ? 0 : clo; } }
    const int need = TOPK - cgt; int ncand = 0;
    const bool tiebin = bstar == IDX_BIN(0.0f);
    unsigned mylo = 0u, myhi = 0u;
#pragma unroll
    for (int ib = 0; ib < NK64 / 8; ++ib) if (ib < nb8) {
#pragma unroll
        for (int j = 0; j < 8; ++j) { const int i = ib * 8 + j; const int b = IDX_BIN(v[i]);
            unsigned long long bs = __ballot(b > bstar); const unsigned long long bc = __ballot(b == bstar);
            if (bc != 0ull) {
                const int pos = ncand + (int)__builtin_amdgcn_mbcnt_hi((unsigned)(bc >> 32), __builtin_amdgcn_mbcnt_lo((unsigned)bc, 0u));
                if (tiebin) bs |= __ballot(b == bstar && pos < need);
                else if (b == bstar && pos < IDX_CAP) { candv[pos] = ord_key(v[i]); candi[pos] = (unsigned)(i * 64 + lane); }
                ncand += __popcll(bc); }
            if (lane == i) { mylo = (unsigned)bs; myhi = (unsigned)(bs >> 32); } }
        SCHED_FENCE(); }
    if (lane < nb8 * 8) { mword[2 * lane] = mylo; mword[2 * lane + 1] = myhi; }
#undef IDX_BIN
    WAVE_SYNC();
    if (tiebin) { }
    else if (ncand <= IDX_CAP) {
        for (int m = lane; m < ncand; m += 64) { const unsigned vm = candv[m]; int rank = 0;
#pragma unroll 4
            for (int j = 0; j < ncand; ++j) { const unsigned vj = candv[j]; rank += (vj > vm || (vj == vm && j < m)) ? 1 : 0; }
            if (rank < need) { const unsigned idx = candi[m]; atomicOr(&mword[idx >> 5], 1u << (idx & 31)); } }
    } else {
        unsigned T = 0u;
        for (int bit = 31; bit >= 0; --bit) { const unsigned cand = T | (1u << bit); int cn = 0;
#pragma unroll
            for (int ib = 0; ib < NK64 / 8; ++ib) if (ib < nb8) {
#pragma unroll
                for (int j = 0; j < 8; ++j) cn += (ord_key(v[ib * 8 + j]) >= cand) ? 1 : 0; }
            if (wave_sum_i(cn) >= TOPK) T = cand; }
        int cg = 0;
#pragma unroll
        for (int ib = 0; ib < NK64 / 8; ++ib) if (ib < nb8) {
#pragma unroll
            for (int j = 0; j < 8; ++j) cg += (ord_key(v[ib * 8 + j]) > T) ? 1 : 0; }
        const int need2 = TOPK - wave_sum_i(cg); int taken = 0;
#pragma unroll
        for (int ib = 0; ib < NK64 / 8; ++ib) if (ib < nb8) {
#pragma unroll
            for (int j = 0; j < 8; ++j) { const int i = ib * 8 + j; const unsigned kv = ord_key(v[i]); const bool eq = kv == T; const unsigned long long be = __ballot(eq);
                const int pre = __popcll(be & ((1ull << lane) - 1ull)); const bool sel = (kv > T) || (eq && (taken + pre) < need2); taken += __popcll(be);
                const unsigned long long bs = __ballot(sel); if (lane == 0) { mword[2 * i] = (unsigned)bs; mword[2 * i + 1] = (unsigned)(bs >> 32); } } }
    }
    WAVE_SYNC();
#ifdef HOST_EMU
    if (lane == 0) { static int rows = 0, bad = 0, ties = 0, falls = 0; std::vector<int> id(nkeys); for (int i = 0; i < nkeys; ++i) id[i] = i;
        std::stable_sort(id.begin(), id.end(), [&](int a, int b) { return sc[a] > sc[b]; }); std::vector<unsigned> ref(MW, 0u); for (int i = 0; i < TOPK; ++i) ref[id[i] >> 5] |= 1u << (id[i] & 31);
        bool ok = true; for (int w = 0; w < MW; ++w) ok = ok && ref[w] == mword[w]; ++rows; bad += ok ? 0 : 1; ties += tiebin ? 1 : 0; falls += (!tiebin && ncand > IDX_CAP) ? 1 : 0;
        if ((rows & 63) == 0 || !ok) printf("[idx-check] rows %d bad %d tiebin %d fallback %d\n", rows, bad, ties, falls); }
#endif
    for (int w = lane; w < MW; w += 64) mrow[w] = mword[w];
}

constexpr int AT_KP = 72, AT_VP = 72, AT_BUF = 64 * AT_KP + 64 * AT_VP;
__device__ __forceinline__ void dsa_attn_half(KArgs C, int bl, int h, int cb, int tid, bf16* tiles, const float* btab) {
    const int lane = tid & 63, wave = tid >> 6, l31 = lane & 31, hh = lane >> 5, c = 4 * cb + (wave >> 1), qb = wave & 1, q0 = c * 64 + qb * 32, qpos = q0 + l31, q0s = __builtin_amdgcn_readfirstlane(q0);
    const size_t qrow = (size_t)bl * SEQ + qpos;
    const bf16* Qp = WSP(const bf16, WS_Q) + qrow * 512 + h * 64 + 8 * hh;
    const unsigned* Mp = WSP(const unsigned, WS_MASK) + qrow * MW;
    const bf16* gk = WSP(const bf16, WS_K) + ((size_t)bl * SEQ + (tid >> 3)) * 512 + h * 64 + (tid & 7) * 8;
    const bf16* gv = WSP(const bf16, WS_VT) + ((size_t)(bl * 8 + h) * 64 + (tid >> 3)) * SEQ + (tid & 7) * 8;
    const int lk = (tid >> 3) * AT_KP + (tid & 7) * 8, lv = 64 * AT_KP + (tid >> 3) * AT_VP + (tid & 7) * 8;
    constexpr float SC = 0.125f * 1.44269504089f;
    bf16x8_t qf[4];
#pragma unroll
    for (int s = 0; s < 4; ++s) qf[s] = *(const bf16x8_t*)(Qp + 16 * s);
    f32x16 O0, O1;
#pragma unroll
    for (int r = 0; r < 16; ++r) { O0[r] = 0.f; O1[r] = 0.f; }
    float m = -1e30f, lsum = 0.f;
    const int ntw = c + 1, nt = 4 * cb + 4;
    u32x4 prek = *(const u32x4*)gk, prev = *(const u32x4*)gv; u32x2 mwn = *(const u32x2*)Mp;
    LDS_SYNC();
    const float bfar = btab[0];
    *(u32x4*)(tiles + lk) = prek; *(u32x4*)(tiles + lv) = prev;
    if (nt > 1) { prek = *(const u32x4*)(gk + (size_t)64 * 512); prev = *(const u32x4*)(gv + 64); }
    for (int kt = 0; kt < nt; ++kt) {
        LDS_SYNC();
        const bf16* tb = tiles + (kt & 1) * AT_BUF; const u32x2 mw2 = mwn;
        if (kt + 1 < ntw) mwn = *(const u32x2*)(Mp + 2 * (kt + 1));
        if (kt < ntw) {
            f32x16 S[2];
#pragma unroll
            for (int t2 = 0; t2 < 2; ++t2) {
#pragma unroll
                for (int r = 0; r < 16; ++r) S[t2][r] = 0.f;
#pragma unroll
                for (int s = 0; s < 4; ++s) S[t2] = __builtin_amdgcn_mfma_f32_32x32x16_bf16(*(const bf16x8_t*)(tb + (t2 * 32 + l31) * AT_KP + 16 * s + 8 * hh), qf[s], S[t2], 0, 0, 0); }
#define AT_P2(P_, X0_, X1_, MW_, R_, ROW_) do { f32x2 pp_; pp_.x = __uint_as_float(__float_as_uint(__builtin_amdgcn_exp2f(X0_)) & bit_fill<ROW_>(MW_)); \
                pp_.y = __uint_as_float(__float_as_uint(__builtin_amdgcn_exp2f(X1_)) & bit_fill<ROW_ + 1>(MW_)); P_[R_] = pp_.x; P_[R_ + 1] = pp_.y; ps2 += pp_; } while (0)
#define AT_RESCALE(TM_) do { float tm_ = (TM_); tm_ = fmaxf(tm_, __shfl_xor(tm_, 32)); \
                if (__ballot(tm_ > m) != 0ull) { const float mn = fmaxf(m, tm_), alpha = __builtin_amdgcn_exp2f(m - mn); m = mn; lsum *= alpha; \
                    _Pragma("unroll") for (int r = 0; r < 16; ++r) { O0[r] *= alpha; O1[r] *= alpha; } } } while (0)
            f32x16 P[2]; f32x2 ps2 = (f32x2){0.f, 0.f}; float tm;
            const unsigned mwc0 = mw2.x >> (4 * hh), mwc1 = mw2.y >> (4 * hh);
            const bool far = (kt * 64 + 63 - q0s) <= -166;
            if (far) { float rm = fmaxf(S[0][0], S[1][0]);
#pragma unroll
                for (int r = 1; r < 16; ++r) rm = fmaxf(fmaxf(rm, S[0][r]), S[1][r]);
                tm = rm * SC + bfar;
            } else { tm = -1e30f;
#pragma unroll
                for (int t2 = 0; t2 < 2; ++t2) { const int rb = kt * 64 + t2 * 32 + 4 * hh - qpos + 256;
#pragma unroll
                    for (int r = 0; r < 16; ++r) { const int row = (r & 3) + 8 * (r >> 2); int ti = rb + row; ti = ti < 0 ? 0 : ti; tm = fmaxf(tm, S[t2][r] * SC + btab[ti]); } } }
            AT_RESCALE(tm);
            if (far) { const float ad = bfar - m;
#define AT_FAR(R_, ROW_) do { const f32x2 x0_ = (f32x2){S[0][R_], S[0][R_ + 1]} * SC + ad, x1_ = (f32x2){S[1][R_], S[1][R_ + 1]} * SC + ad; \
                    AT_P2(P[0], x0_.x, x0_.y, mwc0, R_, ROW_); AT_P2(P[1], x1_.x, x1_.y, mwc1, R_, ROW_); } while (0)
                AT_FAR(0, 0); AT_FAR(2, 2); AT_FAR(4, 8); AT_FAR(6, 10); AT_FAR(8, 16); AT_FAR(10, 18); AT_FAR(12, 24); AT_FAR(14, 26);
#undef AT_FAR
            } else {
#define AT_BIAS(T2_, R_, ROW_) (S[T2_][R_] * SC + (btab[imax0(kt * 64 + (T2_) * 32 + 4 * hh - qpos + 256 + (ROW_))] - m))
#define AT_NEAR(R_, ROW_) do { AT_P2(P[0], AT_BIAS(0, R_, ROW_), AT_BIAS(0, R_ + 1, ROW_ + 1), mwc0, R_, ROW_); AT_P2(P[1], AT_BIAS(1, R_, ROW_), AT_BIAS(1, R_ + 1, ROW_ + 1), mwc1, R_, ROW_); } while (0)
                AT_NEAR(0, 0); AT_NEAR(2, 2); AT_NEAR(4, 8); AT_NEAR(6, 10); AT_NEAR(8, 16); AT_NEAR(10, 18); AT_NEAR(12, 24); AT_NEAR(14, 26);
#undef AT_BIAS
#undef AT_NEAR
            }
#undef AT_P2
#undef AT_RESCALE
            const float ps = ps2.x + ps2.y;
            lsum += ps;
#pragma unroll
            for (int t2 = 0; t2 < 2; ++t2) { const bf16* vb = tb + 64 * AT_KP + l31 * AT_VP + t2 * 32 + 4 * hh;
#pragma unroll
                for (int s = 0; s < 2; ++s) { u32x4 w; w.x = pk2(P[t2][8 * s + 0], P[t2][8 * s + 1]); w.y = pk2(P[t2][8 * s + 2], P[t2][8 * s + 3]); w.z = pk2(P[t2][8 * s + 4], P[t2][8 * s + 5]); w.w = pk2(P[t2][8 * s + 6], P[t2][8 * s + 7]);
                    const bf16x8_t pf = __builtin_bit_cast(bf16x8_t, w);
                    O0 = __builtin_amdgcn_mfma_f32_32x32x16_bf16(frag2(*(const u32x2*)(vb + 16 * s), *(const u32x2*)(vb + 16 * s + 8)), pf, O0, 0, 0, 0);
                    O1 = __builtin_amdgcn_mfma_f32_32x32x16_bf16(frag2(*(const u32x2*)(vb + 32 * AT_VP + 16 * s), *(const u32x2*)(vb + 32 * AT_VP + 16 * s + 8)), pf, O1, 0, 0, 0); } }
        }
        if (kt + 1 < nt) { bf16* nb = tiles + ((kt + 1) & 1) * AT_BUF; *(u32x4*)(nb + lk) = prek; *(u32x4*)(nb + lv) = prev;
            if (kt + 2 < nt) { prek = *(const u32x4*)(gk + (size_t)(kt + 2) * 64 * 512); prev = *(const u32x4*)(gv + (size_t)(kt + 2) * 64); } }
    }
    lsum += __shfl_xor(lsum, 32);
    const float inv = 1.0f / lsum;
    bf16* Y = WSP(bf16, WS_Y) + (size_t)MG * 512 + qrow * 512 + h * 64 + 4 * hh;
#pragma unroll
    for (int g = 0; g < 4; ++g) { u32x2 w; w.x = pk2(O0[4 * g] * inv, O0[4 * g + 1] * inv); w.y = pk2(O0[4 * g + 2] * inv, O0[4 * g + 3] * inv); *(u32x2*)(Y + 8 * g) = w;
        u32x2 w2; w2.x = pk2(O1[4 * g] * inv, O1[4 * g + 1] * inv); w2.y = pk2(O1[4 * g + 2] * inv, O1[4 * g + 3] * inv); *(u32x2*)(Y + 32 + 8 * g) = w2; }
}
__device__ __forceinline__ void dsa_attn_unit3(KArgs C, int unit, int tid, unsigned char* lds) {
    constexpr int NPAIR = NK64 / 8;
    const int pr = unit % NPAIR, h = (unit / NPAIR) & 7, bl = unit / (NPAIR * 8);
    float* btab = (float*)lds; bf16* tiles = (bf16*)(lds + 2048);
    __syncthreads();
    { const int* tab = WSP(const int, WS_TAB); const float* relb = C->in[I_RELB];
      if (tid < 320) btab[tid] = relb[tab[tid - 256 + SEQ - 1] * 8 + h] * 1.44269504089f; }
    dsa_attn_half(C, bl, h, pr, tid, tiles, btab);
    dsa_attn_half(C, bl, h, NK64 / 4 - 1 - pr, tid, tiles, btab);
}
#ifndef GP_ALIGN
#define GP_ALIGN true
#endif
#ifndef GP_SP2
#define GP_SP2 true
#endif
constexpr int SEGS_PER_GROUP = 11, NSEG = DEPTH * (1 + NGRP * SEGS_PER_GROUP) + 1;

#ifdef HOST_EMU
#define GRID_BARRIER() emu_grid_sync()
#define LDS_PTR(p) ((unsigned char*)(p))
#else
#define GRID_BARRIER() do { XcdBarrier b_; b_.bar = (unsigned*)(Ck->ws + WS_CTL); b_.x = xb_xcc_id(); b_.st = (volatile LAS unsigned*)(lds + LDS_CTL_OFF); xcd_barrier(b_); } while (0)
#define LDS_PTR(p) ((PG8_LAS unsigned char*)(p))
#endif

__global__ void __launch_bounds__(NTHREADS, 2) fwd_kernel(Args a) {
#ifdef HOST_EMU
    unsigned char* lds = emu_lds;
#else
    extern __shared__ __attribute__((aligned(16))) unsigned char lds[];
#endif
#ifdef HOST_EMU
    KArgs Ck = &a;
#else
    KArgs Ck = (KArgs)__builtin_amdgcn_kernarg_segment_ptr();
    (void)a;
#endif
#ifndef HOST_EMU
    if (threadIdx.x < 4) ((LAS unsigned*)(lds + LDS_CTL_OFF))[threadIdx.x] = 0u;
    __syncthreads();
    if (Ck->seg_hi - Ck->seg_lo > 1) (void)xcd_barrier_post((unsigned*)(Ck->ws + WS_CTL), (volatile LAS unsigned*)(lds + LDS_CTL_OFF));
#endif
#define SEGID 0
#define RUN (SEGID >= Ck->seg_lo && SEGID < Ck->seg_hi)
#define SEAM do { if (SEGID >= Ck->seg_lo && SEGID + 1 < Ck->seg_hi) { GRID_BARRIER(); } } while (0)
#define WO ((layer & 1) ? WDELTA : (size_t)0)
#define PHASE_VARS KArgs C = KLAUNDER(Ck); const int G = gridDim.x, bx = blockIdx.x, ngw = G * NWAVES; (void)ngw; const int tid = fresh_tid(), lane = tid & 63, wave = __builtin_amdgcn_readfirstlane(tid >> 6), gw = bx * NWAVES + wave; (void)lane; (void)gw; (void)C
    for (int layer = 0; layer < DEPTH; ++layer) {
#undef SEGID
#define SEGID (layer * (1 + NGRP * SEGS_PER_GROUP))
        if (RUN) { PHASE_VARS; phase_weights(C, layer, lds, gw, ngw, lane, wave); }
        SEAM;
        for (int grp = 0; grp < NGRP; ++grp) {
#define XIN ((layer == 0 ? C->in[I_X] : (const float*)C->out) + (size_t)grp * MG * D)
#define XOUT (C->out + (size_t)grp * MG * D)
#undef SEGID
#define SEGID (layer * (1 + NGRP * SEGS_PER_GROUP) + 1 + grp * SEGS_PER_GROUP + 0)
            if (RUN) { PHASE_VARS; for (int m = gw; m < MG; m += 2 * ngw) { if (m + ngw < MG) rms_rowN_bf16<2>(XIN + (size_t)m * D, C->in[I_NMIX] + layer * D, WSP(bf16, WS_H) + (size_t)m * D, (size_t)ngw * D, lane); else rms_row_bf16(XIN + (size_t)m * D, C->in[I_NMIX] + layer * D, WSP(bf16, WS_H) + (size_t)m * D, lane); } }
            SEAM;
#undef SEGID
#define SEGID (layer * (1 + NGRP * SEGS_PER_GROUP) + 1 + grp * SEGS_PER_GROUP + 1)
            if (RUN) { PHASE_VARS; pg8::Gemm g{WSP(const bf16, WS_H), WSP(const bf16, WS_WIN + WO), MG, NMIXC, D}; pg8::StaticOrder S; S.init(MG, NMIXC, G, bx);
                pg8::EpiProj E{C->ws};
                pg8::gemm_phase<pg8::EpiProj, pg8::StaticOrder, false, GP_ALIGN, GP_SP2>(LDS_PTR(lds), g, S, E, nullptr); }
            SEAM;
#undef SEGID
#define SEGID (layer * (1 + NGRP * SEGS_PER_GROUP) + 1 + grp * SEGS_PER_GROUP + 2)
            if (RUN) { PHASE_VARS;
                for (int m = gw; m < MG; m += 2 * ngw) { if (m + ngw < MG) { rwkv_prep_row2(C, layer, m, ngw, lane); ssd_conv_row2(C, layer, m, ngw, lane); } else { rwkv_prep_row(C, layer, m, lane); ssd_conv_row(C, layer, m, lane); } }
                for (int it = gw; it < NB * 8 * NK64; it += ngw) dsa_vt_item(C, it, lane, (bf16*)(lds + wave * 16384));
                __syncthreads();
                for (int u = bx; u < NB * NK64 * 8; u += G) dsa_index_unit(C, u, lane, wave, lds);
            }
            SEAM;
#undef SEGID
#define SEGID (layer * (1 + NGRP * SEGS_PER_GROUP) + 1 + grp * SEGS_PER_GROUP + 3)
            if (RUN) { PHASE_VARS; pg8::Gemm g{WSP(const bf16, WS_RA), WSP(const bf16, WS_WLORA + WO), MG, 1536, 256}; pg8::StaticOrder S; S.init(MG, 1536, G, bx);
                pg8::EpiLora E{WSP(float, WS_WLOG), WSP(bf16, WS_ASIG), WSP(bf16, WS_GG), C->in[I_W0] + layer * 512, C->in[I_A0] + layer * 512};
                pg8::gemm_phase<pg8::EpiLora, pg8::StaticOrder, false, GP_ALIGN, GP_SP2>(LDS_PTR(lds), g, S, E, nullptr); }
            SEAM;
#undef SEGID
#define SEGID (layer * (1 + NGRP * SEGS_PER_GROUP) + 1 + grp * SEGS_PER_GROUP + 4)
            if (RUN) { PHASE_VARS;
                constexpr int U_R = NB * 8, U_S = U_R + NB * 8;
                for (int u = bx; u < U_R; u += G) rwkv_unit(C, layer, u, lds);
                for (int u = (bx + G - U_R % G) % G; u < NB * 8; u += G) ssd_unit(C, layer, u, lds);
                { const int first = U_S % G, span = G - first;
                  if (bx >= first) for (int u = bx - first; u < NB * 32; u += span) s5_unit(C, layer, u, lds); }
                for (;;) {
                    const int t2 = fresh_tid();
                    volatile unsigned* qs2 = (volatile unsigned*)(lds + LDS_CTL_OFF + 32);
                    __syncthreads();
                    if (t2 == 0) *qs2 = atomicAdd((unsigned*)(Ck->ws + WS_QCTR) + ((layer * NGRP + grp) * 2) * 64, 1u);
                    __syncthreads();
                    const int u = (int)*qs2;
                    if (u >= NB * NK64) break;
                    dsa_attn_unit3(KLAUNDER(Ck), u, t2, lds);
                }
            }
            SEAM;
#undef SEGID
#define SEGID (layer * (1 + NGRP * SEGS_PER_GROUP) + 1 + grp * SEGS_PER_GROUP + 5)
            if (RUN) { PHASE_VARS;
                { pg8::Gemm g{WSP(const bf16, WS_H), WSP(const bf16, WS_WIN + WO) + (size_t)NMIXC * D, MG, 4096, D}; pg8::StaticOrder S; S.init(MG, 4096, G, bx);
                  pg8::EpiGate E{WSP(bf16, WS_G)}; pg8::gemm_phase<pg8::EpiGate, pg8::StaticOrder, false, GP_ALIGN, GP_SP2>(LDS_PTR(lds), g, S, E, nullptr); }
                { pg8::Gemm g{WSP(const bf16, WS_YD0), WSP(const bf16, WS_GLU + WO), MG, 512, 512}; pg8::StaticOrder S; S.init(MG, 512, G, bx);
                  pg8::EpiGlu E{WSP(const bf16, WS_YD0), WSP(bf16, WS_Y) + (size_t)3 * MG * 512, C->in[I_GLUB] + layer * 512};
                  pg8::gemm_phase<pg8::EpiGlu, pg8::StaticOrder, false, GP_ALIGN, GP_SP2>(LDS_PTR(lds), g, S, E, nullptr); }
                for (int it = gw; it < MG * 2; it += 4 * ngw) ssd_norm_item4(C, layer, it, ngw, MG * 2, lane);
            }
            SEAM;
#undef SEGID
#define SEGID (layer * (1 + NGRP * SEGS_PER_GROUP) + 1 + grp * SEGS_PER_GROUP + 6)
            if (RUN) { PHASE_VARS; pg8::Gemm g{WSP(const bf16, WS_Y), WSP(const bf16, WS_WB + WO), 4 * MG, 4096, 512}; pg8::MergeOrder S{G, bx};
                pg8::EpiMerge E{WSP(const bf16, WS_G), WSP(bf16, WS_MRG)};
                pg8::gemm_phase<pg8::EpiMerge, pg8::MergeOrder, false, GP_ALIGN, GP_SP2>(LDS_PTR(lds), g, S, E, nullptr); }
            SEAM;
#undef SEGID
#define SEGID (layer * (1 + NGRP * SEGS_PER_GROUP) + 1 + grp * SEGS_PER_GROUP + 7)
            if (RUN) { PHASE_VARS; pg8::Gemm g{WSP(const bf16, WS_MRG), WSP(const bf16, WS_WOUT + WO), MG, D, D}; pg8::StaticOrder S; S.init(MG, D, G, bx);
                pg8::EpiResid E{XIN, XOUT}; pg8::gemm_phase<pg8::EpiResid, pg8::StaticOrder, false, GP_ALIGN, GP_SP2>(LDS_PTR(lds), g, S, E, nullptr); }
            SEAM;
#undef SEGID
#define SEGID (layer * (1 + NGRP * SEGS_PER_GROUP) + 1 + grp * SEGS_PER_GROUP + 8)
            if (RUN) { PHASE_VARS; for (int m = gw; m < MG; m += 2 * ngw) { if (m + ngw < MG) rms_rowN_bf16<2>(XOUT + (size_t)m * D, C->in[I_NFFN] + layer * D, WSP(bf16, WS_H) + (size_t)m * D, (size_t)ngw * D, lane); else rms_row_bf16(XOUT + (size_t)m * D, C->in[I_NFFN] + layer * D, WSP(bf16, WS_H) + (size_t)m * D, lane); } }
            SEAM;
#undef SEGID
#define SEGID (layer * (1 + NGRP * SEGS_PER_GROUP) + 1 + grp * SEGS_PER_GROUP + 9)
            if (RUN) { PHASE_VARS; pg8::Gemm g{WSP(const bf16, WS_H), WSP(const bf16, WS_W13 + WO), MG, 5632, D}; pg8::StaticOrder S; S.init(MG, 5632, G, bx);
                pg8::EpiSwiglu E{WSP(bf16, WS_HID)};
                pg8::gemm_phase<pg8::EpiSwiglu, pg8::StaticOrder, false, GP_ALIGN, GP_SP2>(LDS_PTR(lds), g, S, E, nullptr); }
            SEAM;
#undef SEGID
#define SEGID (layer * (1 + NGRP * SEGS_PER_GROUP) + 1 + grp * SEGS_PER_GROUP + 10)
            if (RUN) { PHASE_VARS; pg8::Gemm g{WSP(const bf16, WS_HID), WSP(const bf16, WS_W2 + WO), MG, D, FFN}; pg8::StaticOrder S; S.init(MG, D, G, bx);
                pg8::EpiResid E{XOUT, XOUT}; pg8::gemm_phase<pg8::EpiResid, pg8::StaticOrder, false, GP_ALIGN, GP_SP2>(LDS_PTR(lds), g, S, E, nullptr); }
            SEAM;
        }
    }
#undef SEGID
#define SEGID (NSEG - 1)
    { const int layer = 0; (void)layer;
    if (RUN) { PHASE_VARS; for (int m = gw; m < M; m += 2 * ngw) { if (m + ngw < M) rms_row2_f32(C->out + (size_t)m * D, (size_t)ngw * D, C->in[I_NFIN], lane); else rms_row_f32(C->out + (size_t)m * D, C->in[I_NFIN], lane); } } }
#undef RUN
#undef SEAM
}

extern "C" void kernel_launch(void* const* d_in, const int* in_sizes, int n_in, void* d_out, int out_size, void* d_ws, size_t ws_size, hipStream_t stream) {
    static int grid = 0;
    if (grid == 0) {
        if (n_in != N_IN || out_size != M * D || ws_size < WS_END) { fprintf(stderr, "kernel_launch: unexpected shapes (n_in %d, out %d, ws %zu < %zu)\n", n_in, out_size, ws_size, (size_t)WS_END); grid = -1; return; }
        int dev = 0, cus = 0;
        if (hipGetDevice(&dev) != hipSuccess || hipDeviceGetAttribute(&cus, hipDeviceAttributeMultiprocessorCount, dev) != hipSuccess || cus < 1) { grid = -1; return; }
        if (hipFuncSetAttribute((const void*)fwd_kernel, hipFuncAttributeMaxDynamicSharedMemorySize, LDS_BYTES) != hipSuccess) { fprintf(stderr, "kernel_launch: hipFuncSetAttribute failed\n"); grid = -1; return; }
        (void)hipGetLastError();
        grid = cus;
    }
    if (grid < 0) return;
    (void)hipMemsetAsync((char*)d_ws + WS_CTL, 0, CTL_BYTES, stream);
    Args a{};
    for (int i = 0; i < N_IN; ++i) a.in[i] = (const float*)d_in[i];
    a.out = (float*)d_out; a.ws = (unsigned char*)d_ws;
#if CFG_LAUNCHES == 1
    a.seg_lo = 0; a.seg_hi = NSEG;
    hipLaunchKernelGGL(fwd_kernel, dim3(grid), dim3(NTHREADS), LDS_BYTES, stream, a);
#else
    for (int s = 0; s < NSEG; ++s) { a.seg_lo = s; a.seg_hi = s + 1; hipLaunchKernelGGL(fwd_kernel, dim3(grid), dim3(NTHREADS), LDS_BYTES, stream, a); }
#endif
}
```

```cpp
#ifdef HOST_EMU
#error "HOST_EMU is a host-only debug build"
#else
#include <hip/hip_runtime.h>
#endif
#include <cstdio>
#include <cstdint>
#include <cmath>

#ifndef CFG_BATCH
#define CFG_BATCH 16
#endif
#ifndef CFG_SEQ
#define CFG_SEQ 4096
#endif
#ifndef CFG_DEPTH
#define CFG_DEPTH 4
#endif
#ifndef CFG_NB
#define CFG_NB 8
#endif
#ifndef CFG_LAUNCHES
#define CFG_LAUNCHES 1
#endif

typedef unsigned short bf16;
typedef float f32x4 __attribute__((ext_vector_type(4)));
typedef float f32x2 __attribute__((ext_vector_type(2)));
typedef unsigned u32x4 __attribute__((ext_vector_type(4)));
typedef unsigned u32x2 __attribute__((ext_vector_type(2)));

constexpr int BATCH = CFG_BATCH, SEQ = CFG_SEQ, DEPTH = CFG_DEPTH, NB = CFG_NB;
constexpr int D = 1024, M = BATCH * SEQ, MG = NB * SEQ, NGRP = BATCH / NB;
constexpr int IN_COLS = 9388, NPROJ = 9472, NMIXC = 5376, FFN = 2816;
constexpr int TOPK = (SEQ / 4) < 256 ? (SEQ / 4) : 256;
constexpr int NK64 = SEQ / 64, MW = SEQ / 32;
constexpr float RMS_EPS = 1e-6f, GN_EPS = 64e-5f;
static_assert(BATCH % NB == 0 && MG % 256 == 0 && SEQ % 64 == 0, "shape");

enum { I_X = 0, I_RELB, I_NMIX, I_WIN, I_CONVW, I_CONVB, I_DTB, I_ALOG, I_SSDD, I_SSDNG, I_MU, I_W0, I_W2, I_A0, I_A2, I_G2, I_KK, I_KA, I_RK, I_LNG, I_LNB,
       I_S5ARE, I_S5AIM, I_S5BRE, I_S5BIM, I_S5CRE, I_S5CIM, I_S5D, I_S5LDT, I_GLUW, I_GLUB, I_WBR, I_WOUT, I_NFFN, I_W1, I_W3, I_W2F, I_NFIN, N_IN };

constexpr size_t MiB = 1u << 20;
constexpr size_t al256(size_t x) { return (x + 255) & ~(size_t)255; }
constexpr size_t WS_CTL = 0, CTL_BYTES = 64 * 1024;
constexpr size_t WS_TAB = WS_CTL + CTL_BYTES;
constexpr size_t WS_ABAR = al256(WS_TAB + (SEQ + 64) * 4);
constexpr size_t WS_BBAR = WS_ABAR + 32 * 64 * 2 * 4;
constexpr size_t WS_WIN = al256(WS_BBAR + 32 * 64 * 16 * 2 * 4);
constexpr size_t WS_WB = WS_WIN + (size_t)NPROJ * 1024 * 2;
constexpr size_t WS_WOUT = WS_WB + (size_t)4 * 1024 * 512 * 2;
constexpr size_t WS_W13 = WS_WOUT + (size_t)1024 * 1024 * 2;
constexpr size_t WS_W2 = WS_W13 + (size_t)5632 * 1024 * 2;
constexpr size_t WS_GLU = WS_W2 + (size_t)1024 * 2816 * 2;
constexpr size_t WS_WLORA = WS_GLU + (size_t)512 * 512 * 2;
constexpr size_t WS_H = al256(WS_WLORA + (size_t)1536 * 256 * 2);
constexpr size_t WS_Z = WS_H + (size_t)MG * 1024 * 2;
constexpr size_t WS_XBC = WS_Z + (size_t)MG * 512 * 2;
constexpr size_t WS_Q = WS_XBC + (size_t)MG * 768 * 2;
constexpr size_t WS_K = WS_Q + (size_t)MG * 512 * 2;
constexpr size_t WS_V = WS_K + (size_t)MG * 512 * 2;
constexpr size_t WS_RW = WS_V + (size_t)MG * 512 * 2;
constexpr size_t WS_U = WS_RW + (size_t)MG * 1792 * 2;
constexpr size_t WS_SM = WS_U + (size_t)MG * 512 * 2;
constexpr size_t WS_G = WS_Q;
constexpr size_t WS_Y = WS_SM + (size_t)MG * 256 * 2;
constexpr size_t WS_YD0 = WS_Y + (size_t)4 * MG * 512 * 2;
constexpr size_t WS_MRG = WS_YD0 + (size_t)MG * 512 * 2;
constexpr size_t WS_MASK = WS_MRG + (size_t)MG * 1024 * 2;
constexpr size_t WS_RA = WS_MASK + (size_t)MG * MW * 4;
constexpr size_t WS_WLOG = WS_RA + (size_t)MG * 256 * 2;
constexpr size_t WS_ASIG = WS_WLOG + (size_t)MG * 512 * 4;
constexpr size_t WS_GG = WS_ASIG + (size_t)MG * 512 * 2;
constexpr size_t WS_XBA = WS_GG + (size_t)MG * 512 * 2;
constexpr size_t WS_VT = WS_XBA + (size_t)MG * 768 * 2;
constexpr size_t WS_KI = WS_VT + (size_t)MG * 512 * 2;
constexpr size_t WS_QCTR = 16384;
constexpr size_t WS_HID = WS_G;
constexpr size_t WS_WALT = al256(WS_KI + (size_t)MG * 32 * 2);
constexpr size_t WDELTA = WS_WALT - WS_ABAR;
constexpr size_t WS_END = WS_WALT + (WS_H - WS_ABAR);
static_assert(WS_SM + (size_t)MG * 256 * 2 - WS_Q == (size_t)MG * 4096 * 2, "G overlays exactly Q..SM");
static_assert((size_t)MG * 2816 * 2 <= (size_t)MG * 4096 * 2, "HID fits in G");

constexpr int LDS_SCRATCH = 131072;
constexpr int LDS_CTL_OFF = LDS_SCRATCH;
constexpr int LDS_X = LDS_SCRATCH + 64;
constexpr int LDS_BYTES = 161792;
constexpr int NTHREADS = 512, NWAVES = 8;

__device__ __forceinline__ float bf2f(bf16 v) { return __uint_as_float(((unsigned)v) << 16); }
#ifdef HOST_EMU
__device__ __forceinline__ bf16 f2bf(float f) { unsigned u = __float_as_uint(f); u += 0x7fffu + ((u >> 16) & 1u); return (bf16)(u >> 16); }
#else
__device__ __forceinline__ bf16 f2bf(float f) { return __builtin_bit_cast(bf16, (__bf16)f); }
#endif
#ifdef HOST_EMU
__device__ __forceinline__ unsigned pk2(float lo, float hi) { return (unsigned)f2bf(lo) | ((unsigned)f2bf(hi) << 16); }
#else
typedef __bf16 bf16x2_hw __attribute__((ext_vector_type(2)));
__device__ __forceinline__ unsigned pk2(float lo, float hi) { const f32x2 v = {lo, hi}; return __builtin_bit_cast(unsigned, __builtin_convertvector(v, bf16x2_hw)); }
#endif
__device__ __forceinline__ float lo_bf(unsigned w) { return __uint_as_float(w << 16); }
__device__ __forceinline__ float hi_bf(unsigned w) { return __uint_as_float(w & 0xffff0000u); }
#ifndef HOST_EMU
__device__ __forceinline__ float sigm(float x) { return __builtin_amdgcn_rcpf(1.0f + __expf(-x)); }
#else
__device__ __forceinline__ float sigm(float x) { return 1.0f / (1.0f + __expf(-x)); }
#endif
#ifndef HOST_EMU
template <int BIT> __device__ __forceinline__ unsigned bit_fill(unsigned w) { unsigned r; asm("v_bfe_i32 %0, %1, %2, 1" : "=v"(r) : "v"(w), "n"(BIT)); return r; }
#else
template <int BIT> __device__ __forceinline__ unsigned bit_fill(unsigned w) { return ((w >> BIT) & 1u) ? 0xffffffffu : 0u; }
#endif
__device__ __forceinline__ int imax0(int v) { return v < 0 ? 0 : v; }
__device__ __forceinline__ float tanh_fast(float x) { return 2.0f * sigm(2.0f * x) - 1.0f; }
__device__ __forceinline__ float softplusf(float x) { return x > 20.f ? x : log1pf(__expf(x)); }
__device__ __forceinline__ float gelu_tanh(float x) { const float u = 0.7978845608f * (x + 0.044715f * x * x * x); return x * sigm(2.0f * u); }
__device__ __forceinline__ float wave_sum(float v) {
#pragma unroll
    for (int o = 1; o < 64; o <<= 1) v += __shfl_xor(v, o);
    return v;
}
__device__ __forceinline__ float wave_max(float v) {
#pragma unroll
    for (int o = 1; o < 64; o <<= 1) v = fmaxf(v, __shfl_xor(v, o));
    return v;
}
__device__ __forceinline__ int wave_sum_i(int v) {
#pragma unroll
    for (int o = 1; o < 64; o <<= 1) v += __shfl_xor(v, o);
    return v;
}
#ifdef HOST_EMU
#define WAVE_SYNC() (void)emu_wave_exchange(0)
#define SCHED_FENCE() do {} while (0)
#define LDS_SYNC() __syncthreads()
#else
#define WAVE_SYNC() __builtin_amdgcn_wave_barrier()
#define SCHED_FENCE() __builtin_amdgcn_sched_barrier(0)
#define LDS_SYNC() do { asm volatile("s_waitcnt lgkmcnt(0)" ::: "memory"); __builtin_amdgcn_s_barrier(); asm volatile("" ::: "memory"); } while (0)
#endif
#ifndef HOST_EMU
namespace pg8 {
__device__ __forceinline__ int pg8_fresh_tid() { int t = (int)threadIdx.x; asm volatile("" : "+v"(t)); return t; }
#define PG8_LAS __attribute__((address_space(3)))
typedef unsigned short bf16_t;
typedef short bf16x8 __attribute__((ext_vector_type(8)));
typedef float f32x4 __attribute__((ext_vector_type(4)));
typedef unsigned u32x4 __attribute__((ext_vector_type(4)));
constexpr int BM = 256, BK = 64, HALF = 128, HTB = HALF * BK * 2  , STAGE_BYTES = 8 * HTB, NXCD = 8, WGM = 8;

__host__ __device__ __forceinline__ int lds_byte(int r, int c) { const int st = (r >> 4) * 2 + (c >> 5), rr = r & 15, cc = c & 31, ob = rr * 64 + cc * 2; return st * 1024 + (ob ^ (((ob >> 9) & 1) << 5)); }
__host__ __device__ __forceinline__ void stage_rc(int b, int& R, int& C) { const int st = b / 1024, sb = b % 1024, swz = sb ^ (((sb >> 9) & 1) << 5); R = (st >> 1) * 16 + swz / 64; C = (st & 1) * 32 + (swz % 64) / 2; }
__host__ __device__ __forceinline__ int perm32(int rho) { const int n = rho >> 4, i = rho & 15; return 8 * (i >> 2) + 4 * n + (i & 3); }

struct Unit { int pm, pn; };
struct Gemm { const bf16_t* A; const bf16_t* Bt; int M, N, K; };

struct StaticOrder {
    int nM, nN, nwg, G, c;
    __host__ __device__ void init(int M, int N, int G_, int c_) { nM = M / BM; nN = N / BM; nwg = nM * nN; G = G_; c = c_; }
    __host__ __device__ bool next(int i, Unit& u) const {
        const long L = (long)i * G + c; if (L >= nwg) return false;
        int wgid = (int)L; { const int q = nwg / NXCD, r = nwg % NXCD, xcd = wgid % NXCD, off = wgid / NXCD; wgid = (xcd < r ? xcd * (q + 1) : r * (q + 1) + (xcd - r) * q) + off; }
        const int nig = WGM * nN, gid = wgid / nig, fm = gid * WGM, gsz = (nM - fm) < WGM ? (nM - fm) : WGM;
        u.pm = fm + ((wgid % nig) % gsz); u.pn = (wgid % nig) / gsz; return true;
    }
    __device__ __forceinline__ void a_ready(const Unit&) const {}
    __device__ __forceinline__ void done(const Unit&) const {}
};

__device__ __forceinline__ unsigned cvt_pk_bf16(float lo, float hi) { return pk2(lo, hi); }

template <class E, class = void> struct epi_keep { static constexpr bool value = false; };
template <class E> struct epi_keep<E, decltype((void)E::KEEP_ACC)> { static constexpr bool value = true; };
template <class Epi, class Sched, bool STAMP = false, bool ALIGN_EPI = false, bool SP2 = false>
__device__ __forceinline__ void gemm_phase(PG8_LAS unsigned char* lds, const Gemm g, const Sched& S, const Epi& E, unsigned long long* stamps) {
    const int tid = pg8_fresh_tid(), wid = __builtin_amdgcn_readfirstlane(tid >> 6), lane = tid & 63, wr = wid >> 2, wc = wid & 3, fr = lane & 15, fq = lane >> 4;
    int K_ = g.K; asm volatile("" : "+s"(K_));
    const int K = K_, nt = K / BK;
    int ts_lo = 0, ts_hi = 0, nts = 0; const unsigned long long rt_entry = STAMP ? (unsigned long long)wall_clock64() : 0ull;
#define PG8_STAMP() do { if (STAMP && wid == 0 && nts < 64) { const unsigned long long _c = (unsigned long long)clock64(); \
        ts_lo = (lane == nts) ? (int)(unsigned)_c : ts_lo; ts_hi = (lane == nts) ? (int)(unsigned)(_c >> 32) : ts_hi; ++nts; } } while (0)
    PG8_STAMP();
    unsigned voffA[2], voffB[2];
#pragma unroll
    for (int i = 0; i < 2; ++i) { int R, C; stage_rc(tid * 16 + i * 8192, R, C); const int Rb = Epi::PERM ? ((R & ~31) + perm32(R & 31)) : R;
        voffA[i] = (unsigned)(R * K + C) * 2u; voffB[i] = (unsigned)(Rb * K + C) * 2u; }
    const size_t kstep = (size_t)(BK * 2);
    const size_t hstep = (size_t)HALF * K * 2;
    const size_t tstep = 2 * hstep;
    const unsigned ldsw = (unsigned)wid * 1024u;
    const int aoff = lds_byte(wr * 64 + fr, fq * 8), boff = lds_byte(wc * 32 + fr, fq * 8);
#define PG8_SA(b, h) (((b) * 2 + (h)) * HTB)
#define PG8_SB(b, h) ((4 + (b) * 2 + (h)) * HTB)
#define PG8_STAGE(bufoff, gbase, voff) do { _Pragma("unroll") for (int _i = 0; _i < 2; ++_i) \
        __builtin_amdgcn_global_load_lds((const unsigned*)((const char*)(gbase) + (voff)[_i]), (PG8_LAS unsigned*)(lds + (bufoff) + ldsw + _i * 8192), 16, 0, 0); } while (0)
#define PG8_LDA(dst, b, h) do { _Pragma("unroll") for (int m = 0; m < 4; ++m) _Pragma("unroll") for (int k = 0; k < 2; ++k) dst[m][k] = *(const PG8_LAS bf16x8*)(lds + PG8_SA(b, h) + aoff + m * 2048 + k * 1024); } while (0)
#define PG8_LDB(dst, b, h) do { _Pragma("unroll") for (int n = 0; n < 2; ++n) _Pragma("unroll") for (int k = 0; k < 2; ++k) dst[n][k] = *(const PG8_LAS bf16x8*)(lds + PG8_SB(b, h) + boff + n * 2048 + k * 1024); } while (0)
#define PG8_MMA(ai, bj, At, Bt) do { __builtin_amdgcn_s_setprio(1); _Pragma("unroll") for (int m = 0; m < 4; ++m) _Pragma("unroll") for (int n = 0; n < 2; ++n) _Pragma("unroll") for (int k = 0; k < 2; ++k) \
        acc[ai][bj][m][n] = __builtin_amdgcn_mfma_f32_16x16x32_bf16(Bt[n][k], At[m][k], acc[ai][bj][m][n], 0, 0, 0); __builtin_amdgcn_s_setprio(0); } while (0)
#define PG8_WAIT_V(n) asm volatile("s_waitcnt vmcnt(" #n ")" ::: "memory")
#define PG8_WAIT_L(n) asm volatile("s_waitcnt lgkmcnt(" #n ")" ::: "memory")
#define PG8_BAR __builtin_amdgcn_s_barrier()
#define PG8_SCHED __builtin_amdgcn_sched_barrier(0)
    Unit cur, nxt; int ui = 0;
    if (!S.next(0, cur)) return;
    f32x4 acc[2][2][4][2];
#pragma unroll
    for (int a = 0; a < 2; ++a)
#pragma unroll
        for (int b = 0; b < 2; ++b)
#pragma unroll
            for (int m = 0; m < 4; ++m)
#pragma unroll
                for (int n = 0; n < 2; ++n) acc[a][b][m][n] = (f32x4){0.f, 0.f, 0.f, 0.f};
    bf16x8 At[4][2], B0[2][2], B1[2][2];
    const char* cA = (const char*)g.A + (size_t)cur.pm * tstep; const char* cB = (const char*)g.Bt + (size_t)cur.pn * tstep;
    S.a_ready(cur);
    if constexpr (SP2) {
        PG8_STAGE(PG8_SB(0, 0), cB, voffB); PG8_STAGE(PG8_SB(0, 1), cB + hstep, voffB); PG8_STAGE(PG8_SA(0, 0), cA, voffA); PG8_STAGE(PG8_SA(0, 1), cA + hstep, voffA);
        if (wr == 1) PG8_BAR;
        PG8_WAIT_V(2); PG8_BAR;
        PG8_STAGE(PG8_SB(1, 0), cB + kstep, voffB); PG8_STAGE(PG8_SA(1, 0), cA + kstep, voffA); PG8_STAGE(PG8_SB(1, 1), cB + hstep + kstep, voffB);
        PG8_WAIT_V(6); PG8_BAR;
    } else {
    PG8_STAGE(PG8_SB(0, 0), cB, voffB); PG8_STAGE(PG8_SA(0, 0), cA, voffA); PG8_STAGE(PG8_SB(0, 1), cB + hstep, voffB); PG8_STAGE(PG8_SA(0, 1), cA + hstep, voffA);
    if (wr == 1) PG8_BAR;
    PG8_WAIT_V(4); PG8_BAR;
    PG8_STAGE(PG8_SB(1, 0), cB + kstep, voffB); PG8_STAGE(PG8_SA(1, 0), cA + kstep, voffA); PG8_STAGE(PG8_SB(1, 1), cB + hstep + kstep, voffB);
    PG8_WAIT_V(6); PG8_BAR;
    }
    PG8_STAMP();
    for (;;) {
        const bool has_next = S.next(ui + 1, nxt);
        const char* nA = has_next ? (const char*)g.A + (size_t)nxt.pm * tstep : cA; const char* nB = has_next ? (const char*)g.Bt + (size_t)nxt.pn * tstep : cB;
        for (int t = 0; t < nt; t += 2) {
            const bool last = (t == nt - 2);
            const char* a1 = cA + (size_t)(t + 1) * kstep;
            const char* a2 = last ? nA : cA + (size_t)(t + 2) * kstep; const char* b2 = last ? nB : cB + (size_t)(t + 2) * kstep;
            const char* a3 = a2 + kstep; const char* b3 = b2 + kstep;
            if (last && has_next) S.a_ready(nxt);
            if constexpr (SP2) {
            PG8_LDB(B0, 0, 0); PG8_LDB(B1, 0, 1); PG8_SCHED; PG8_LDA(At, 0, 0); PG8_STAGE(PG8_SA(1, 1), a1 + hstep, voffA);
            PG8_WAIT_V(8); PG8_WAIT_L(0); PG8_BAR; PG8_MMA(0, 0, At, B0); PG8_MMA(0, 1, At, B1); PG8_BAR; PG8_SCHED;
            PG8_LDA(At, 0, 1); PG8_STAGE(PG8_SB(0, 0), b2, voffB); PG8_STAGE(PG8_SB(0, 1), b2 + hstep, voffB); PG8_STAGE(PG8_SA(0, 0), a2, voffA);
            PG8_WAIT_V(8); PG8_WAIT_L(0); PG8_BAR; PG8_MMA(1, 0, At, B0); PG8_MMA(1, 1, At, B1); PG8_BAR; PG8_SCHED;
            PG8_LDB(B0, 1, 0); PG8_LDB(B1, 1, 1); PG8_SCHED; PG8_LDA(At, 1, 0); PG8_STAGE(PG8_SA(0, 1), a2 + hstep, voffA);
            PG8_WAIT_V(8); PG8_WAIT_L(0); PG8_BAR; PG8_MMA(0, 0, At, B0); PG8_MMA(0, 1, At, B1); PG8_BAR; PG8_SCHED;
            PG8_LDA(At, 1, 1); PG8_STAGE(PG8_SB(1, 0), b3, voffB); PG8_STAGE(PG8_SB(1, 1), b3 + hstep, voffB); PG8_STAGE(PG8_SA(1, 0), a3, voffA);
            PG8_WAIT_V(8); PG8_WAIT_L(0); PG8_BAR; PG8_MMA(1, 0, At, B0); PG8_MMA(1, 1, At, B1); PG8_BAR; PG8_SCHED;
            } else {
            PG8_LDB(B0, 0, 0); PG8_SCHED; PG8_LDA(At, 0, 0); PG8_STAGE(PG8_SA(1, 1), a1 + hstep, voffA);
            PG8_WAIT_L(8); PG8_BAR; PG8_WAIT_L(0); PG8_MMA(0, 0, At, B0); PG8_BAR; PG8_SCHED;
            PG8_LDB(B1, 0, 1); PG8_STAGE(PG8_SB(0, 0), b2, voffB);
            PG8_BAR; PG8_WAIT_L(0); PG8_MMA(0, 1, At, B1); PG8_BAR;
            PG8_LDA(At, 0, 1); PG8_STAGE(PG8_SA(0, 0), a2, voffA);
            PG8_BAR; PG8_WAIT_L(0); PG8_MMA(1, 0, At, B0); PG8_BAR; PG8_SCHED;
            PG8_STAGE(PG8_SB(0, 1), b2 + hstep, voffB);
            PG8_WAIT_V(6); PG8_BAR; PG8_MMA(1, 1, At, B1); PG8_BAR;
            PG8_LDB(B0, 1, 0); PG8_SCHED; PG8_LDA(At, 1, 0); PG8_STAGE(PG8_SA(0, 1), a2 + hstep, voffA);
            PG8_WAIT_L(8); PG8_BAR; PG8_WAIT_L(0); PG8_MMA(0, 0, At, B0); PG8_BAR; PG8_SCHED;
            PG8_LDB(B1, 1, 1); PG8_STAGE(PG8_SB(1, 0), b3, voffB);
            PG8_BAR; PG8_WAIT_L(0); PG8_MMA(0, 1, At, B1); PG8_BAR;
            PG8_LDA(At, 1, 1); PG8_STAGE(PG8_SA(1, 0), a3, voffA);
            PG8_BAR; PG8_WAIT_L(0); PG8_MMA(1, 0, At, B0); PG8_BAR; PG8_SCHED;
            PG8_STAGE(PG8_SB(1, 1), b3 + hstep, voffB);
            PG8_WAIT_V(6); PG8_BAR; PG8_MMA(1, 1, At, B1); PG8_BAR;
            }
        }
        PG8_STAMP();
        if constexpr (ALIGN_EPI) { if (wr == 0) PG8_BAR; }
        if constexpr (!Epi::AFTER_DRAIN) { E(acc, cur, wr, wc, fr, fq); S.done(cur); }
        PG8_STAMP();
        if (!has_next) break;
        bool zero_acc = true; if constexpr (epi_keep<Epi>::value) zero_acc = !E.keep(cur);
        if (zero_acc) { const bf16x8 z8 = {0, 0, 0, 0, 0, 0, 0, 0};
#pragma unroll
        for (int a = 0; a < 2; ++a)
#pragma unroll
            for (int b = 0; b < 2; ++b)
#pragma unroll
                for (int m = 0; m < 4; ++m)
#pragma unroll
                    for (int n = 0; n < 2; ++n) acc[a][b][m][n] = __builtin_amdgcn_mfma_f32_16x16x32_bf16(z8, z8, (f32x4){0.f, 0.f, 0.f, 0.f}, 0, 0, 0); }
        cur = nxt; cA = nA; cB = nB; ++ui;
        if constexpr (ALIGN_EPI) { if (wr == 1) PG8_BAR; }
    }
    PG8_WAIT_V(0);
    if constexpr (!ALIGN_EPI) { if (wr == 0) PG8_BAR; }
    PG8_BAR;
    if constexpr (Epi::AFTER_DRAIN) { E.fused(acc, cur, wr, wc, fr, fq, lds, wid, lane); S.done(cur); }
    PG8_STAMP();
    if (STAMP && wid == 0) { stamps[lane] = lane < nts ? (((unsigned long long)(unsigned)ts_hi << 32) | (unsigned)ts_lo) : 0ull;
        if (lane == 62) stamps[62] = rt_entry; if (lane == 63) stamps[63] = (unsigned long long)wall_clock64(); }
#undef PG8_STAMP
#undef PG8_SA
#undef PG8_SB
#undef PG8_STAGE
#undef PG8_LDA
#undef PG8_LDB
#undef PG8_MMA
#undef PG8_WAIT_V
#undef PG8_WAIT_L
#undef PG8_BAR
#undef PG8_SCHED
}
}

#define XB_TMO      128
#define XB_XCNT(j)  (256  + 64 * (j))
#define XB_XSUB(j)  (1280 + 64 * (j))
#define XB_XGEN(j)  (2304 + 64 * (j))
#define XB_TOP      3328
#define XB_TOPGEN   3392
#define XCD_BAR_WORDS 3456
#define XB_SPIN_CAP (1u << 18)
#define LAS __attribute__((address_space(3)))

__device__ __forceinline__ unsigned xb_ld(unsigned* p)              { return __hip_atomic_load(p, __ATOMIC_RELAXED, __HIP_MEMORY_SCOPE_AGENT); }
__device__ __forceinline__ unsigned xb_add(unsigned* p, unsigned v) { return __hip_atomic_fetch_add(p, v, __ATOMIC_RELAXED, __HIP_MEMORY_SCOPE_AGENT); }
__device__ __forceinline__ unsigned xb_xcc_id() { return (unsigned)__builtin_amdgcn_s_getreg((3 << 11) | 20) & 0xFu; }
#define XB_SPIN(cond, bar) do { unsigned _sp = 0; while (cond) { __builtin_amdgcn_s_sleep(1); \
    if ((++_sp & 255u) == 0u) { if (xb_ld(&(bar)[XB_TMO])) break; if (_sp > XB_SPIN_CAP) { atomicAdd(&(bar)[XB_TMO], 1u); break; } } } } while (0)

struct XcdBarrier {
    unsigned* bar; unsigned x;
    volatile LAS unsigned* st;
};

__device__ __forceinline__ XcdBarrier xcd_barrier_post(unsigned* bar, volatile LAS unsigned* st) {
    XcdBarrier b; b.bar = bar; b.x = xb_xcc_id(); b.st = st;
    if (threadIdx.x == 0) (void)xb_add(&bar[XB_XCNT(b.x)], 1u);
    return b;
}
__device__ __forceinline__ void xcd_barrier_complete(unsigned* bar, unsigned x, unsigned& nloc, unsigned& nx) {
    const unsigned G = gridDim.x * gridDim.y * gridDim.z;
    unsigned sum, cnt, mine, sp = 0u;
    for (;;) {
        sum = 0u; cnt = 0u; mine = 0u;
#pragma unroll
        for (unsigned j = 0; j < 16; ++j) { const unsigned c = xb_ld(&bar[XB_XCNT(j)]); sum += c; cnt += (c > 0u) ? 1u : 0u; mine = (j == x) ? c : mine; }
        if (sum == G) break;
        __builtin_amdgcn_s_sleep(1);
        if ((++sp & 255u) == 0u) { if (xb_ld(&bar[XB_TMO])) break; if (sp > XB_SPIN_CAP) { atomicAdd(&bar[XB_TMO], 1u); break; } }
    }
    nloc = mine > 0u ? mine : 1u; nx = cnt > 0u ? cnt : 1u;
}

__device__ __forceinline__ void xcd_barrier(const XcdBarrier& b) {
    asm volatile("s_waitcnt vmcnt(0)" ::: "memory");
    __syncthreads();
    if (threadIdx.x == 0) {
        unsigned* bar = b.bar;
        __builtin_amdgcn_s_waitcnt(0);
        unsigned nloc = b.st[0], nx = b.st[1];
        if (nloc == 0u) { xcd_barrier_complete(bar, b.x, nloc, nx); b.st[0] = nloc; b.st[1] = nx; }
        const unsigned old = xb_add(&bar[XB_XSUB(b.x)], 1u);
        const unsigned gen = old / nloc;
        if (old + 1u == (gen + 1u) * nloc) {
            __builtin_amdgcn_fence(__ATOMIC_RELEASE, "agent");
            asm volatile("s_waitcnt vmcnt(0)" ::: "memory");
            const unsigned og = xb_add(&bar[XB_TOP], 1u);
            const unsigned tg = og / nx;
            if (og + 1u == (tg + 1u) * nx) xb_add(&bar[XB_TOPGEN], 1u);
            else XB_SPIN(xb_ld(&bar[XB_TOPGEN]) == tg, bar);
            __builtin_amdgcn_fence(__ATOMIC_ACQUIRE, "agent");
            xb_add(&bar[XB_XGEN(b.x)], 1u);
            asm volatile("s_waitcnt vmcnt(0)" ::: "memory");
        } else {
            XB_SPIN(xb_ld(&bar[XB_XGEN(b.x)]) == gen, bar);
            __builtin_amdgcn_fence(__ATOMIC_ACQUIRE, "agent");
            asm volatile("s_waitcnt vmcnt(0)" ::: "memory");
        }
    }
    __syncthreads();
}

#else
namespace pg8 {
typedef unsigned short bf16_t;
typedef float f32x4 __attribute__((ext_vector_type(4)));
typedef unsigned u32x4 __attribute__((ext_vector_type(4)));
constexpr int BM = 256, BK = 64, HALF = 128, NXCD = 8, WGM = 8;
struct Unit { int pm, pn; };
struct Gemm { const bf16_t* A; const bf16_t* Bt; int M, N, K; };
template <class E, class = void> struct epi_keep { static constexpr bool value = false; };
template <class E> struct epi_keep<E, decltype((void)E::KEEP_ACC)> { static constexpr bool value = true; };
struct StaticOrder {
    int nM, nN, nwg, G, c;
    void init(int M, int N, int G_, int c_) { nM = M / BM; nN = N / BM; nwg = nM * nN; G = G_; c = c_; }
    bool next(int i, Unit& u) const {
        const long L = (long)i * G + c; if (L >= nwg) return false;
        int wgid = (int)L; { const int q = nwg / NXCD, r = nwg % NXCD, xcd = wgid % NXCD, off = wgid / NXCD; wgid = (xcd < r ? xcd * (q + 1) : r * (q + 1) + (xcd - r) * q) + off; }
        const int nig = WGM * nN, gid = wgid / nig, fm = gid * WGM, gsz = (nM - fm) < WGM ? (nM - fm) : WGM;
        u.pm = fm + ((wgid % nig) % gsz); u.pn = (wgid % nig) / gsz; return true;
    }
    void a_ready(const Unit&) const {}
    void done(const Unit&) const {}
};
static inline unsigned cvt_pk_bf16(float lo, float hi) { return pk2(lo, hi); }
static float* emu_tile_buf(int b) { static std::vector<std::vector<float>> t; if ((int)t.size() <= b) t.resize(b + 1); if (t[b].empty()) t[b].resize(256 * 256); return t[b].data(); }
template <class Epi, class Sched, bool STAMP = false, bool ALIGN_EPI = false, bool SP2 = false, bool ZPEEL = false>
void gemm_phase(unsigned char* lds, const Gemm g, const Sched& S, const Epi& E, unsigned long long* stamps) {
    const int tid = threadIdx.x, wid = tid >> 6, lane = tid & 63, wr = wid >> 2, wc = wid & 3, fr = lane & 15, fq = lane >> 4;
    float* tile = emu_tile_buf(blockIdx.x);
    Unit u; f32x4 acc[2][2][4][2]; bool keep_next = false;
    for (int ui = 0; S.next(ui, u); ++ui) {
        __syncthreads();
        if (tid == 0) {
            std::vector<float> a((size_t)256 * g.K), b((size_t)256 * g.K);
            for (int r = 0; r < 256; ++r) for (int k = 0; k < g.K; ++k) { a[(size_t)r * g.K + k] = bf2f(g.A[((size_t)u.pm * 256 + r) * g.K + k]); b[(size_t)r * g.K + k] = bf2f(g.Bt[((size_t)u.pn * 256 + r) * g.K + k]); }
            for (int r = 0; r < 256; ++r) for (int c = 0; c < 256; ++c) { const float* ar = &a[(size_t)r * g.K]; const float* br = &b[(size_t)c * g.K]; float s = 0.f; for (int k = 0; k < g.K; ++k) s += ar[k] * br[k]; tile[r * 256 + c] = s; }
        }
        __syncthreads();
        if (!keep_next) for (int ai = 0; ai < 2; ++ai) for (int bj = 0; bj < 2; ++bj) for (int m = 0; m < 4; ++m) for (int n = 0; n < 2; ++n) acc[ai][bj][m][n] = (f32x4){0.f, 0.f, 0.f, 0.f};
        for (int ai = 0; ai < 2; ++ai) for (int bj = 0; bj < 2; ++bj) for (int m = 0; m < 4; ++m) for (int n = 0; n < 2; ++n) for (int j = 0; j < 4; ++j) {
            const int r = 128 * ai + 64 * wr + 16 * m + fr;
            const int c = Epi::PERM ? (128 * bj + 32 * wc + 8 * fq + 4 * n + j) : (128 * bj + 32 * wc + 16 * n + 4 * fq + j);
            acc[ai][bj][m][n][j] += tile[r * 256 + c];
        }
        E(acc, u, wr, wc, fr, fq); S.done(u);
        if constexpr (epi_keep<Epi>::value) keep_next = E.keep(u); else keep_next = false;
        __syncthreads();
    }
}
}
#endif
namespace pg8 {
#ifdef HOST_EMU
#define EPI_FENCE() do {} while (0)
#else
#define EPI_FENCE() asm volatile("" ::: "memory")
#endif
__device__ __forceinline__ u32x4 pack8(const f32x4 v0, const f32x4 v1) { u32x4 w; w.x = cvt_pk_bf16(v0[0], v0[1]); w.y = cvt_pk_bf16(v0[2], v0[3]); w.z = cvt_pk_bf16(v1[0], v1[1]); w.w = cvt_pk_bf16(v1[2], v1[3]); return w; }
__device__ __forceinline__ void unpack8(const u32x4 w, f32x4& v0, f32x4& v1) { v0 = (f32x4){lo_bf(w.x), hi_bf(w.x), lo_bf(w.y), hi_bf(w.y)}; v1 = (f32x4){lo_bf(w.z), hi_bf(w.z), lo_bf(w.w), hi_bf(w.w)}; }
__device__ __forceinline__ f32x4 sig4(const f32x4 v) { return (f32x4){sigm(v[0]), sigm(v[1]), sigm(v[2]), sigm(v[3])}; }
#ifndef HOST_EMU
__device__ __forceinline__ float gate_sig(float x) { return __builtin_amdgcn_rcpf(fminf(1.0f + __expf(-x), 1.0e6f)); }
#else
__device__ __forceinline__ float gate_sig(float x) { return fmaxf(sigm(x), 1.0e-6f); }
#endif
__device__ __forceinline__ f32x4 gsig4(const f32x4 v) { return (f32x4){gate_sig(v[0]), gate_sig(v[1]), gate_sig(v[2]), gate_sig(v[3])}; }

struct EpiProj {
    static constexpr bool PERM = true, AFTER_DRAIN = false;
    unsigned char* ws;
    __device__ __forceinline__ void operator()(const f32x4 (&acc)[2][2][4][2], const Unit& u, int wr, int wc, int fr, int fq) const {
        const int pn = u.pn; size_t off; int ld, c0;
        if (pn < 2) { off = WS_Z; ld = 512; c0 = pn * 256; }
        else if (pn < 5) { off = WS_XBC; ld = 768; c0 = (pn - 2) * 256; }
        else if (pn < 7) { off = WS_Q; ld = 512; c0 = (pn - 5) * 256; }
        else if (pn < 9) { off = WS_K; ld = 512; c0 = (pn - 7) * 256; }
        else if (pn < 11) { off = WS_V; ld = 512; c0 = (pn - 9) * 256; }
        else if (pn < 18) { off = WS_RW; ld = 1792; c0 = (pn - 11) * 256; }
        else if (pn < 20) { off = WS_U; ld = 512; c0 = (pn - 18) * 256; }
        else { off = WS_SM; ld = 256; c0 = 0; }
        bf16_t* dst = (bf16_t*)(ws + off);
        const int row0 = u.pm * BM + wr * 64 + fr, col0 = c0 + wc * 32 + 8 * fq;
        const int kic = HALF + wc * 32 + 8 * fq - 136;
        const bool ki = (pn == 20) && kic >= 0 && kic < 32;
#pragma unroll
        for (int ai = 0; ai < 2; ++ai)
#pragma unroll
            for (int m = 0; m < 4; ++m) { const size_t row = (size_t)(row0 + ai * HALF + m * 16); bf16_t* rowp = dst + row * ld + col0;
#pragma unroll
                for (int bj = 0; bj < 2; ++bj) { const u32x4 w = pack8(acc[ai][bj][m][0], acc[ai][bj][m][1]); *(u32x4*)(rowp + bj * HALF) = w;
                    if (bj == 1 && ki) *(u32x4*)((bf16_t*)(ws + WS_KI) + row * 32 + kic) = w; } }
    }
};
struct EpiGate {
    static constexpr bool PERM = true, AFTER_DRAIN = false;
    bf16_t* G;
    __device__ __forceinline__ void operator()(const f32x4 (&acc)[2][2][4][2], const Unit& u, int wr, int wc, int fr, int fq) const {
        const int row0 = u.pm * BM + wr * 64 + fr, col0 = u.pn * BM + wc * 32 + 8 * fq;
#pragma unroll
        for (int ai = 0; ai < 2; ++ai)
#pragma unroll
            for (int m = 0; m < 4; ++m) { bf16_t* rowp = G + (size_t)(row0 + ai * HALF + m * 16) * 4096 + col0;
#pragma unroll
                for (int bj = 0; bj < 2; ++bj) *(u32x4*)(rowp + bj * HALF) = pack8(gsig4(acc[ai][bj][m][0]), gsig4(acc[ai][bj][m][1])); }
    }
};
struct EpiMerge {
    static constexpr bool PERM = true, AFTER_DRAIN = false, KEEP_ACC = true;
    const bf16_t* G; bf16_t* MRG;
    __device__ __forceinline__ bool keep(const Unit& u) const { return (u.pn >> 2) < 3; }
    __device__ __forceinline__ void operator()(f32x4 (&acc)[2][2][4][2], const Unit& u, int wr, int wc, int fr, int fq) const {
        const int n = u.pn >> 2, pn = u.pn & 3, pm = u.pm - n * (MG / 256);
        const int row0 = pm * BM + wr * 64 + fr, col0 = pn * BM + wc * 32 + 8 * fq;
#pragma unroll
        for (int ai = 0; ai < 2; ++ai)
#pragma unroll
            for (int mp = 0; mp < 2; ++mp) { u32x4 ga[2][2], gb[2][2];
#pragma unroll
                for (int mm = 0; mm < 2; ++mm)
#pragma unroll
                    for (int bj = 0; bj < 2; ++bj) { const bf16_t* gp = G + (size_t)(row0 + ai * HALF + (2 * mp + mm) * 16) * 4096 + n * 1024 + col0 + bj * HALF; ga[mm][bj] = *(const u32x4*)gp; if (n < 3) gb[mm][bj] = *(const u32x4*)(gp + 1024); }
#pragma unroll
                for (int mm = 0; mm < 2; ++mm)
#pragma unroll
                    for (int bj = 0; bj < 2; ++bj) { const int m = 2 * mp + mm; f32x4 a0, a1; unpack8(ga[mm][bj], a0, a1);
                        if (n < 3) { f32x4 b0, b1; unpack8(gb[mm][bj], b0, b1);
#pragma unroll
                            for (int j = 0; j < 4; ++j) { acc[ai][bj][m][0][j] *= a0[j] * __builtin_amdgcn_rcpf(b0[j]); acc[ai][bj][m][1][j] *= a1[j] * __builtin_amdgcn_rcpf(b1[j]); } }
                        else
                            *(u32x4*)(MRG + (size_t)(row0 + ai * HALF + m * 16) * 1024 + col0 + bj * HALF) = pack8(acc[ai][bj][m][0] * a0, acc[ai][bj][m][1] * a1); }
                EPI_FENCE(); }
    }
};
struct MergeOrder {
    int G, c;
    __device__ __forceinline__ bool next(int i, Unit& u) const {
        const int tile = (i >> 2) * G + c, n = i & 3; if (tile >= (MG / 256) * 4) return false;
        u.pm = n * (MG / 256) + (tile >> 2); u.pn = n * 4 + (tile & 3); return true;
    }
    __device__ __forceinline__ void a_ready(const Unit&) const {}
    __device__ __forceinline__ void done(const Unit&) const {}
};
struct EpiResid {
    static constexpr bool PERM = false, AFTER_DRAIN = false;
    const float* base; float* out;
    __device__ __forceinline__ void operator()(const f32x4 (&acc)[2][2][4][2], const Unit& u, int wr, int wc, int fr, int fq) const {
        const int row0 = u.pm * BM + wr * 64 + fr, col0 = u.pn * BM + wc * 32 + 4 * fq;
#pragma unroll
        for (int ai = 0; ai < 2; ++ai) {
            f32x4 bv[4][2][2];
#pragma unroll
            for (int m = 0; m < 4; ++m)
#pragma unroll
                for (int bj = 0; bj < 2; ++bj)
#pragma unroll
                    for (int n = 0; n < 2; ++n) bv[m][bj][n] = *(const f32x4*)(base + (size_t)(row0 + ai * HALF + m * 16) * 1024 + col0 + bj * HALF + n * 16);
#pragma unroll
            for (int m = 0; m < 4; ++m)
#pragma unroll
                for (int bj = 0; bj < 2; ++bj)
#pragma unroll
                    for (int n = 0; n < 2; ++n) *(f32x4*)(out + (size_t)(row0 + ai * HALF + m * 16) * 1024 + col0 + bj * HALF + n * 16) = bv[m][bj][n] + acc[ai][bj][m][n];
            EPI_FENCE(); }
    }
};
struct EpiSwiglu {
    static constexpr bool PERM = true, AFTER_DRAIN = false;
    bf16_t* HID;
    __device__ __forceinline__ void operator()(const f32x4 (&acc)[2][2][4][2], const Unit& u, int wr, int wc, int fr, int fq) const {
        const int row0 = u.pm * BM + wr * 64 + fr, col0 = u.pn * HALF + wc * 32 + 8 * fq;
#pragma unroll
        for (int ai = 0; ai < 2; ++ai)
#pragma unroll
            for (int m = 0; m < 4; ++m) { f32x4 v[2];
#pragma unroll
                for (int n = 0; n < 2; ++n) { const f32x4 a = acc[ai][0][m][n], b = acc[ai][1][m][n]; v[n] = a * sig4(a) * b; }
                *(u32x4*)(HID + (size_t)(row0 + ai * HALF + m * 16) * FFN + col0) = pack8(v[0], v[1]); }
    }
};
struct EpiGlu {
    static constexpr bool PERM = true, AFTER_DRAIN = false;
    const bf16_t* Y0; bf16_t* OUT; const float* bias;
    __device__ __forceinline__ void operator()(const f32x4 (&acc)[2][2][4][2], const Unit& u, int wr, int wc, int fr, int fq) const {
        const int row0 = u.pm * BM + wr * 64 + fr, col0 = u.pn * BM + wc * 32 + 8 * fq;
#pragma unroll
        for (int ai = 0; ai < 2; ++ai)
#pragma unroll
            for (int m = 0; m < 4; ++m) { const size_t row = (size_t)(row0 + ai * HALF + m * 16);
#pragma unroll
                for (int bj = 0; bj < 2; ++bj) { const int col = col0 + bj * HALF;
                    f32x4 y0, y1; unpack8(*(const u32x4*)(Y0 + row * 512 + col), y0, y1);
                    const f32x4 b0 = *(const f32x4*)(bias + col), b1 = *(const f32x4*)(bias + col + 4);
                    *(u32x4*)(OUT + row * 512 + col) = pack8(y0 * sig4(acc[ai][bj][m][0] + b0), y1 * sig4(acc[ai][bj][m][1] + b1)); }
                EPI_FENCE(); }
    }
};
__device__ __forceinline__ float logdecay(float x) { return -0.6065306597f * sigm(x); }
struct EpiLora {
    static constexpr bool PERM = true, AFTER_DRAIN = false;
    float* WLOG; bf16_t* ASIG; bf16_t* GG; const float* w0; const float* a0;
    __device__ __forceinline__ void operator()(const f32x4 (&acc)[2][2][4][2], const Unit& u, int wr, int wc, int fr, int fq) const {
        const int kind = u.pn >> 1, row0 = u.pm * BM + wr * 64 + fr, col0 = (u.pn & 1) * BM + wc * 32 + 8 * fq;
        if (kind == 0) {
            f32x4 b[2][2];
#pragma unroll
            for (int bj = 0; bj < 2; ++bj) { b[bj][0] = *(const f32x4*)(w0 + col0 + bj * HALF); b[bj][1] = *(const f32x4*)(w0 + col0 + bj * HALF + 4); }
#pragma unroll
            for (int ai = 0; ai < 2; ++ai)
#pragma unroll
                for (int m = 0; m < 4; ++m)
#pragma unroll
                    for (int bj = 0; bj < 2; ++bj)
#pragma unroll
                        for (int n = 0; n < 2; ++n) { const f32x4 x = acc[ai][bj][m][n] + b[bj][n];
                            *(f32x4*)(WLOG + (size_t)(row0 + ai * HALF + m * 16) * 512 + col0 + bj * HALF + 4 * n) = (f32x4){logdecay(x[0]), logdecay(x[1]), logdecay(x[2]), logdecay(x[3])}; }
        } else if (kind == 1) {
            f32x4 b[2][2];
#pragma unroll
            for (int bj = 0; bj < 2; ++bj) { b[bj][0] = *(const f32x4*)(a0 + col0 + bj * HALF); b[bj][1] = *(const f32x4*)(a0 + col0 + bj * HALF + 4); }
#pragma unroll
            for (int ai = 0; ai < 2; ++ai)
#pragma unroll
                for (int m = 0; m < 4; ++m)
#pragma unroll
                    for (int bj = 0; bj < 2; ++bj)
                        *(u32x4*)(ASIG + (size_t)(row0 + ai * HALF + m * 16) * 512 + col0 + bj * HALF) = pack8(sig4(acc[ai][bj][m][0] + b[bj][0]), sig4(acc[ai][bj][m][1] + b[bj][1]));
        } else {
#pragma unroll
            for (int ai = 0; ai < 2; ++ai)
#pragma unroll
                for (int m = 0; m < 4; ++m)
#pragma unroll
                    for (int bj = 0; bj < 2; ++bj)
                        *(u32x4*)(GG + (size_t)(row0 + ai * HALF + m * 16) * 512 + col0 + bj * HALF) = pack8(acc[ai][bj][m][0], acc[ai][bj][m][1]);
        }
    }
};
}
typedef short bf16x8_t __attribute__((ext_vector_type(8)));
typedef float f32x16 __attribute__((ext_vector_type(16)));
typedef float f32x4_t __attribute__((ext_vector_type(4)));
__device__ __forceinline__ bf16x8_t frag2(const u32x2 lo, const u32x2 hi) { u32x4 w; w.x = lo.x; w.y = lo.y; w.z = hi.x; w.w = hi.y; return __builtin_bit_cast(bf16x8_t, w); }
struct Args { const float* in[N_IN]; float* out; unsigned char* ws; int seg_lo, seg_hi; };
#ifdef HOST_EMU
typedef const Args* KArgs;
#define KLAUNDER(p) (p)
__device__ __forceinline__ int fresh_tid() { return (int)threadIdx.x; }
#else
typedef const __attribute__((address_space(4))) Args* KArgs;
__device__ __forceinline__ KArgs klaunder(KArgs p) { asm volatile("" : "+s"(p)); return p; }
#define KLAUNDER(p) klaunder(p)
__device__ __forceinline__ int fresh_tid() { int t = (int)threadIdx.x; asm volatile("" : "+v"(t)); return t; }
#endif
#define WSP(T, off) ((T*)(C->ws + (off)))

template <class Src>
__device__ __forceinline__ void transpose_item(const Src& S, int K, bf16* WT, float* scr, int item, int lane) {
    const int nblk = S.ndst / 32, kb = item / nblk, nb = item % nblk, k0 = 64 * kb, n0 = 32 * nb;
    const float* cp = S.col(n0 + (lane & 31)); const int ld = S.ld;
#pragma unroll 8
    for (int i = 0; i < 32; ++i) { const int kk = 2 * i + (lane >> 5); scr[kk * 33 + (lane & 31)] = cp ? cp[(size_t)(k0 + kk) * ld] : 0.f; }
    WAVE_SYNC();
    const int c = lane & 7;
#pragma unroll
    for (int j = 0; j < 4; ++j) { const int n = (lane >> 3) + 8 * j; const float* s = scr + (8 * c) * 33 + n;
        u32x4 o; o.x = pk2(s[0 * 33], s[1 * 33]); o.y = pk2(s[2 * 33], s[3 * 33]); o.z = pk2(s[4 * 33], s[5 * 33]); o.w = pk2(s[6 * 33], s[7 * 33]);
        *(u32x4*)(WT + (size_t)(n0 + n) * K + k0 + 8 * c) = o; }
    WAVE_SYNC();
}
struct SrcWin { const float* w; int ndst, ld;
    __device__ __forceinline__ const float* col(int n) const {
        int s;
        if (n < 1280) s = n;
        else if (n < 2816) s = n + 8;
        else if (n < 4608) s = n - 2816 + 2988;
        else if (n < 5120) s = n - 4608 + 4780;
        else if (n < 5128) s = n - 5120 + 1280;
        else if (n < 5256) s = n - 5128 + 2824;
        else if (n < 5288) s = n - 5256 + 2952;
        else if (n < 5292) s = n - 5288 + 2984;
        else if (n < 5376) return nullptr;
        else s = n - 5376 + 5292;
        return w + s; } };
struct SrcPlain { const float* w; int ndst, ld; __device__ __forceinline__ const float* col(int n) const { return w + n; } };
struct SrcW13 { const float* w1; const float* w3; int ndst, ld;
    __device__ __forceinline__ const float* col(int n) const { const int pn = n >> 8, r = n & 255; return w1 + (r < 128 ? (ptrdiff_t)0 : (w3 - w1)) + pn * 128 + (r & 127); } };

__device__ __forceinline__ void phase_weights(KArgs C, int layer, unsigned char* lds, int gw, int ngw, int lane, int wave) {
    float* scr = (float*)(lds + wave * 16384); const size_t wo = (layer & 1) ? WDELTA : 0;
    constexpr int N_IN_ = 16 * (NPROJ / 32), N_BR = 8 * 32, N_OUT = 16 * 32, N_13 = 16 * (5632 / 32), N_2 = 44 * 32, N_GLU = 8 * 16;
    { const SrcWin s_in{C->in[I_WIN] + (size_t)layer * 1024 * IN_COLS, NPROJ, IN_COLS};
      for (int it = gw; it < N_IN_; it += ngw) transpose_item(s_in, 1024, WSP(bf16, WS_WIN + wo), scr, it, lane); }
    for (int it = gw; it < 4 * N_BR; it += ngw) { const int n = it / N_BR; const SrcPlain s_b{C->in[I_WBR] + ((size_t)layer * 4 + n) * 512 * 1024, 1024, 1024};
        transpose_item(s_b, 512, WSP(bf16, WS_WB + wo) + (size_t)n * 1024 * 512, scr, it % N_BR, lane); }
    { const SrcPlain s_out{C->in[I_WOUT] + (size_t)layer * 1024 * 1024, 1024, 1024};
      for (int it = gw; it < N_OUT; it += ngw) transpose_item(s_out, 1024, WSP(bf16, WS_WOUT + wo), scr, it, lane); }
    { const SrcW13 s_13{C->in[I_W1] + (size_t)layer * 1024 * FFN, C->in[I_W3] + (size_t)layer * 1024 * FFN, 5632, FFN};
      for (int it = gw; it < N_13; it += ngw) transpose_item(s_13, 1024, WSP(bf16, WS_W13 + wo), scr, it, lane); }
    { const SrcPlain s_2{C->in[I_W2F] + (size_t)layer * FFN * 1024, 1024, 1024};
      for (int it = gw; it < N_2; it += ngw) transpose_item(s_2, FFN, WSP(bf16, WS_W2 + wo), scr, it, lane); }
    { const SrcPlain s_glu{C->in[I_GLUW] + (size_t)layer * 512 * 512, 512, 512};
      for (int it = gw; it < N_GLU; it += ngw) transpose_item(s_glu, 512, WSP(bf16, WS_GLU + wo), scr, it, lane); }
    { const float* w2 = C->in[I_W2] + (size_t)layer * 64 * 512; const float* a2 = C->in[I_A2] + (size_t)layer * 64 * 512; const float* g2 = C->in[I_G2] + (size_t)layer * 128 * 512;
      bf16* WL = WSP(bf16, WS_WLORA + wo);
      for (int e = gw * 64 + lane; e < 1536 * 256; e += ngw * 64) { const int n = e >> 8, kc = e & 255; float v = 0.f;
          if (n < 512) { if (kc < 64) v = w2[kc * 512 + n]; } else if (n < 1024) { if (kc >= 64 && kc < 128) v = a2[(kc - 64) * 512 + (n - 512)]; } else { if (kc >= 128) v = g2[(kc - 128) * 512 + (n - 1024)]; }
          WL[e] = f2bf(v); } }
    const int gt = gw * 64 + lane, ngt = ngw * 64;
    for (int e = gt; e < 32 * 64; e += ngt) {
        const int g = e >> 6;
        const float ar = C->in[I_S5ARE][layer * 2048 + e], ai = C->in[I_S5AIM][layer * 2048 + e], dt = expf(C->in[I_S5LDT][layer * 32 + g]);
        const float mag = expf(ar * dt), abr = mag * cosf(ai * dt), abi = mag * sinf(ai * dt);
        const float den = ar * ar + ai * ai, nr = abr - 1.0f, ni = abi;
        const float qr = (nr * ar + ni * ai) / den, qi = (ni * ar - nr * ai) / den;
        float* ab = WSP(float, WS_ABAR + wo) + e * 2; ab[0] = abr; ab[1] = abi;
        float* bb = WSP(float, WS_BBAR + wo) + (size_t)e * 32;
        for (int j = 0; j < 16; ++j) { const float br = C->in[I_S5BRE][((size_t)layer * 2048 + e) * 16 + j], bi = C->in[I_S5BIM][((size_t)layer * 2048 + e) * 16 + j];
            bb[2 * j] = qr * br - qi * bi; bb[2 * j + 1] = qr * bi + qi * br; }
    }
    if (layer == 0) for (int e = gt; e < SEQ + 63; e += ngt) {
        const int rel = e - (SEQ - 1); const int n = rel < 0 ? -rel : rel; int b = rel > 0 ? 16 : 0;
        if (n < 8) b += n; else { int lg = 8 + (int)(logf((float)n / 8.0f) / 3.4657359028f * 8.0f); if (lg > 15) lg = 15; b += lg; }
        WSP(int, WS_TAB)[e] = b;
    }
}

__device__ __forceinline__ void rms_row_bf16(const float* xrow, const float* g, bf16* orow, int lane) {
    const f32x4* xr = (const f32x4*)xrow + lane; const f32x4* gr = (const f32x4*)g + lane;
    f32x4 v[4]; float s = 0.f;
#pragma unroll
    for (int j = 0; j < 4; ++j) { v[j] = xr[64 * j]; s += (v[j].x * v[j].x + v[j].y * v[j].y) + (v[j].z * v[j].z + v[j].w * v[j].w); }
    const float rstd = 1.0f / sqrtf(wave_sum(s) * (1.f / D) + RMS_EPS);
    u32x2* o8 = (u32x2*)orow + lane;
#pragma unroll
    for (int j = 0; j < 4; ++j) { const f32x4 gg = gr[64 * j]; u32x2 w; w.x = pk2(v[j].x * rstd * gg.x, v[j].y * rstd * gg.y); w.y = pk2(v[j].z * rstd * gg.z, v[j].w * rstd * gg.w); o8[64 * j] = w; }
}
template <int NR>
__device__ __forceinline__ void rms_rowN_bf16(const float* xrow, const float* g, bf16* orow, size_t step, int lane) {
    const f32x4* gr = (const f32x4*)g + lane; f32x4 v[NR][4]; float ss[NR];
#pragma unroll
    for (int q = 0; q < NR; ++q)
#pragma unroll
        for (int j = 0; j < 4; ++j) v[q][j] = ((const f32x4*)(xrow + q * step) + lane)[64 * j];
#pragma unroll
    for (int q = 0; q < NR; ++q) { float s = 0.f;
#pragma unroll
        for (int j = 0; j < 4; ++j) s += (v[q][j].x * v[q][j].x + v[q][j].y * v[q][j].y) + (v[q][j].z * v[q][j].z + v[q][j].w * v[q][j].w);
        ss[q] = s; }
#pragma unroll
    for (int o = 1; o < 64; o <<= 1)
#pragma unroll
        for (int q = 0; q < NR; ++q) ss[q] += __shfl_xor(ss[q], o);
#pragma unroll
    for (int q = 0; q < NR; ++q) { const float r = 1.0f / sqrtf(ss[q] * (1.f / D) + RMS_EPS); u32x2* o8 = (u32x2*)(orow + q * step) + lane;
#pragma unroll
        for (int j = 0; j < 4; ++j) { const f32x4 gg = gr[64 * j]; u32x2 w; w.x = pk2(v[q][j].x * r * gg.x, v[q][j].y * r * gg.y); w.y = pk2(v[q][j].z * r * gg.z, v[q][j].w * r * gg.w); o8[64 * j] = w; } }
}
__device__ __forceinline__ void rms_row_f32(float* xrow, const float* g, int lane) {
    f32x4* xr = (f32x4*)xrow + lane; const f32x4* gr = (const f32x4*)g + lane;
    f32x4 v[4]; float s = 0.f;
#pragma unroll
    for (int j = 0; j < 4; ++j) { v[j] = xr[64 * j]; s += (v[j].x * v[j].x + v[j].y * v[j].y) + (v[j].z * v[j].z + v[j].w * v[j].w); }
    const float rstd = 1.0f / sqrtf(wave_sum(s) * (1.f / D) + RMS_EPS);
#pragma unroll
    for (int j = 0; j < 4; ++j) xr[64 * j] = v[j] * rstd * gr[64 * j];
}

#ifdef HOST_EMU
__device__ __forceinline__ float red8(float v) { v += __shfl_xor(v, 1); v += __shfl_xor(v, 2); v += __shfl_xor(v, 4); return v; }
__device__ __forceinline__ float red16(float v) { v = red8(v); v += __shfl_xor(v, 8); return v; }
#else
template <int CTRL> __device__ __forceinline__ float dpp_f(float v) { return __builtin_bit_cast(float, __builtin_amdgcn_update_dpp(0, __builtin_bit_cast(int, v), CTRL, 0xf, 0xf, true)); }
__device__ __forceinline__ float red8(float v) { v += dpp_f<0xB1>(v); v += dpp_f<0x4E>(v); v += dpp_f<0x141>(v); return v; }
__device__ __forceinline__ float red16(float v) { v = red8(v); v += dpp_f<0x140>(v); return v; }
#endif
__device__ __forceinline__ f32x4 sig4g(const f32x4 v) { return (f32x4){sigm(v[0]), sigm(v[1]), sigm(v[2]), sigm(v[3])}; }
__device__ __forceinline__ void rms_row2_f32(float* xrow, size_t step, const float* g, int lane) {
    f32x4* xa = (f32x4*)xrow + lane; f32x4* xb = (f32x4*)(xrow + step) + lane; const f32x4* gr = (const f32x4*)g + lane;
    f32x4 va[4], vb[4]; float sa = 0.f, sb = 0.f;
#pragma unroll
    for (int j = 0; j < 4; ++j) { va[j] = xa[64 * j]; vb[j] = xb[64 * j]; }
#pragma unroll
    for (int j = 0; j < 4; ++j) { sa += (va[j].x * va[j].x + va[j].y * va[j].y) + (va[j].z * va[j].z + va[j].w * va[j].w); sb += (vb[j].x * vb[j].x + vb[j].y * vb[j].y) + (vb[j].z * vb[j].z + vb[j].w * vb[j].w); }
#pragma unroll
    for (int o = 1; o < 64; o <<= 1) { sa += __shfl_xor(sa, o); sb += __shfl_xor(sb, o); }
    const float ra = 1.0f / sqrtf(sa * (1.f / D) + RMS_EPS), rb = 1.0f / sqrtf(sb * (1.f / D) + RMS_EPS);
#pragma unroll
    for (int j = 0; j < 4; ++j) { const f32x4 gg = gr[64 * j]; xa[64 * j] = va[j] * ra * gg; xb[64 * j] = vb[j] * rb * gg; }
}
__device__ __forceinline__ void ssd_conv_row(KArgs C, int layer, int m, int lane) {
    const int t = m % SEQ; const float* cw = C->in[I_CONVW] + layer * 4 * 768; const float* cb = C->in[I_CONVB] + layer * 768;
#pragma unroll
    for (int i = 0; i < 3; ++i) { const int ch = i * 256 + lane * 4; const bf16* p = WSP(const bf16, WS_XBC) + (size_t)m * 768 + ch;
        f32x4 a = *(const f32x4*)(cb + ch);
#pragma unroll
        for (int q = 0; q < 4; ++q) if (t - 3 + q >= 0) { const u32x2 w = *(const u32x2*)(p - (3 - q) * 768); const f32x4 cq = *(const f32x4*)(cw + q * 768 + ch);
            a += cq * (f32x4){lo_bf(w.x), hi_bf(w.x), lo_bf(w.y), hi_bf(w.y)}; }
        a = a * sig4g(a);
        u32x2 o; o.x = pk2(a.x, a.y); o.y = pk2(a.z, a.w); *(u32x2*)(WSP(bf16, WS_XBA) + (size_t)m * 768 + ch) = o; }
}
__device__ __forceinline__ void ssd_conv_row2(KArgs C, int layer, int m, int step, int lane) {
    const float* cw = C->in[I_CONVW] + layer * 4 * 768; const float* cb = C->in[I_CONVB] + layer * 768;
    u32x2 w[2][3][4]; f32x4 cq[3][4], bb[3];
#pragma unroll
    for (int i = 0; i < 3; ++i) { const int ch = i * 256 + lane * 4; bb[i] = *(const f32x4*)(cb + ch);
#pragma unroll
        for (int q = 0; q < 4; ++q) { cq[i][q] = *(const f32x4*)(cw + q * 768 + ch);
#pragma unroll
            for (int r = 0; r < 2; ++r) { const int mm = m + r * step, t = mm % SEQ; const bf16* p = WSP(const bf16, WS_XBC) + (size_t)mm * 768 + ch;
                if (t - 3 + q >= 0) w[r][i][q] = *(const u32x2*)(p - (3 - q) * 768); else { w[r][i][q].x = 0u; w[r][i][q].y = 0u; } } } }
#pragma unroll
    for (int r = 0; r < 2; ++r)
#pragma unroll
        for (int i = 0; i < 3; ++i) { const int ch = i * 256 + lane * 4; f32x4 a = bb[i];
#pragma unroll
            for (int q = 0; q < 4; ++q) a += cq[i][q] * (f32x4){lo_bf(w[r][i][q].x), hi_bf(w[r][i][q].x), lo_bf(w[r][i][q].y), hi_bf(w[r][i][q].y)};
            a = a * sig4g(a);
            u32x2 o; o.x = pk2(a.x, a.y); o.y = pk2(a.z, a.w); *(u32x2*)(WSP(bf16, WS_XBA) + (size_t)(m + r * step) * 768 + ch) = o; }
}
__device__ __forceinline__ void ssd_unit(KArgs C, int layer, int unit, unsigned char* lds) {
    const int tid = fresh_tid(), lane = tid & 63, wave = tid >> 6, bl = unit >> 3, h = unit & 7, gi = h >> 2, pp = tid >> 3, c8 = (tid & 7) * 8, c16 = lane & 15, q = lane >> 4;
    bf16* Cb = (bf16*)lds; bf16* Bb = Cb + 4096; bf16* XT = Bb + 4096; bf16* BwT = XT + 4096; bf16* Pm = BwT + 4096; float* Yo = (float*)(Pm + 4096); float* dts = Yo + 8192; float* acs = dts + 128;
    const bf16* XA = WSP(const bf16, WS_XBA) + (size_t)bl * SEQ * 768 + (size_t)pp * 768 + c8;
    const bf16* SMp = WSP(const bf16, WS_SM) + (size_t)bl * SEQ * 256;
    const bf16* Zp = WSP(const bf16, WS_Z) + (size_t)bl * SEQ * 512 + (size_t)pp * 512 + h * 64 + c8;
    bf16* YA = WSP(bf16, WS_Y) + (size_t)bl * SEQ * 512 + (size_t)pp * 512 + h * 64 + c8;
    const float dtb = C->in[I_DTB][layer * 8 + h], A = -__expf(C->in[I_ALOG][layer * 8 + h]), Dh = C->in[I_SSDD][layer * 8 + h];
    f32x4_t Sd[2]; bf16x8_t Sf; Sd[0] = (f32x4_t){0.f, 0.f, 0.f, 0.f}; Sd[1] = Sd[0]; { u32x2 z; z.x = 0u; z.y = 0u; Sf = frag2(z, z); }
    const int pt = wave & 3, nh = wave >> 2;
    u32x4 fx, fb, fc, fz;
#define SSD_FETCH(c0_) do { const bf16* q_ = XA + (size_t)(c0_) * 768; fx = *(const u32x4*)(q_ + h * 64); fb = *(const u32x4*)(q_ + 512 + gi * 64); fc = *(const u32x4*)(q_ + 640 + gi * 64); fz = *(const u32x4*)(Zp + (size_t)(c0_) * 512); } while (0)
#define SSD_DT(c0_, par) do { if (wave == 0) { const float dt_ = softplusf(bf2f(SMp[(size_t)((c0_) + lane) * 256 + h]) + dtb); float a_ = A * dt_; \
        _Pragma("unroll") for (int o_ = 1; o_ < 64; o_ <<= 1) { const float t_ = __shfl_up(a_, o_); if (lane >= o_) a_ += t_; } dts[(par) * 64 + lane] = dt_; acs[(par) * 64 + lane] = a_; } } while (0)
    LDS_SYNC();
    SSD_FETCH(0); SSD_DT(0, 0);
    for (int c0 = 0, par = 0; c0 < SEQ; c0 += 64, par ^= 1) {
        LDS_SYNC();
        const u32x4 xk = fx, zk = fz;
        {
          const float dt = dts[par * 64 + pp], ea = __expf(acs[par * 64 + 63] - acs[par * 64 + pp]);
          *(u32x4*)(Cb + pp * 64 + c8) = fc; *(u32x4*)(Bb + pp * 64 + c8) = fb;
          f32x4 x0, x1, b0, b1; pg8::unpack8(fx, x0, x1); pg8::unpack8(fb, b0, b1); x0 = x0 * dt; x1 = x1 * dt; b0 = b0 * ea; b1 = b1 * ea;
#pragma unroll
          for (int i = 0; i < 4; ++i) { XT[(c8 + i) * 64 + pp] = f2bf(x0[i]); XT[(c8 + 4 + i) * 64 + pp] = f2bf(x1[i]); BwT[(c8 + i) * 64 + pp] = f2bf(b0[i]); BwT[(c8 + 4 + i) * 64 + pp] = f2bf(b1[i]); } }
        if (c0 + 64 < SEQ) { SSD_FETCH(c0 + 64); SSD_DT(c0 + 64, par ^ 1); }
        LDS_SYNC();
        {
          const f32x4_t z4 = {0.f, 0.f, 0.f, 0.f};
#pragma unroll
          for (int i = 0; i < 2; ++i) { const int id = wave + 8 * i, lt = id >> 2, st = id & 3; f32x4_t g = z4;
              if (st <= lt) {
#pragma unroll
                  for (int ks = 0; ks < 2; ++ks) g = __builtin_amdgcn_mfma_f32_16x16x32_bf16(*(const bf16x8_t*)(Cb + (16 * lt + c16) * 64 + 32 * ks + 8 * q), *(const bf16x8_t*)(Bb + (16 * st + c16) * 64 + 32 * ks + 8 * q), g, 0, 0, 0);
                  const float as_ = acs[par * 64 + 16 * st + c16];
#pragma unroll
                  for (int r = 0; r < 4; ++r) { const int l = 16 * lt + 4 * q + r; g[r] = (16 * st + c16 <= l) ? g[r] * __expf(acs[par * 64 + l] - as_) : 0.f; } }
#pragma unroll
              for (int r = 0; r < 4; ++r) Pm[(16 * lt + 4 * q + r) * 64 + 16 * st + c16] = f2bf(g[r]); }
#pragma unroll
          for (int lt = 0; lt < 4; ++lt) { const bf16* cr = Cb + (16 * lt + c16) * 64 + 32 * nh + 4 * q;
              const f32x4_t yo = __builtin_amdgcn_mfma_f32_16x16x32_bf16(frag2(*(const u32x2*)cr, *(const u32x2*)(cr + 16)), Sf, z4, 0, 0, 0);
#pragma unroll
              for (int r = 0; r < 4; ++r) Yo[nh * 4096 + (16 * lt + 4 * q + r) * 64 + 16 * pt + c16] = yo[r]; }
          const float eL = __expf(acs[par * 64 + 63]);
          const bf16x8_t xb0 = *(const bf16x8_t*)(XT + (16 * pt + c16) * 64 + 8 * q), xb1 = *(const bf16x8_t*)(XT + (16 * pt + c16) * 64 + 32 + 8 * q);
#pragma unroll
          for (int i = 0; i < 2; ++i) { const bf16* br = BwT + (16 * (2 * nh + i) + c16) * 64 + 8 * q; f32x4_t cin = Sd[i] * eL;
              cin = __builtin_amdgcn_mfma_f32_16x16x32_bf16(*(const bf16x8_t*)br, xb0, cin, 0, 0, 0); Sd[i] = __builtin_amdgcn_mfma_f32_16x16x32_bf16(*(const bf16x8_t*)(br + 32), xb1, cin, 0, 0, 0); }
          u32x2 lo, hi; lo.x = pk2(Sd[0][0], Sd[0][1]); lo.y = pk2(Sd[0][2], Sd[0][3]); hi.x = pk2(Sd[1][0], Sd[1][1]); hi.y = pk2(Sd[1][2], Sd[1][3]); Sf = frag2(lo, hi); }
        LDS_SYNC();
        {
          const f32x4_t z4 = {0.f, 0.f, 0.f, 0.f};
#pragma unroll
          for (int i = 0; i < 2; ++i) { const int id = wave + 8 * i, lt = id >> 2, p2 = id & 3;
              f32x4_t y = __builtin_amdgcn_mfma_f32_16x16x32_bf16(*(const bf16x8_t*)(Pm + (16 * lt + c16) * 64 + 8 * q), *(const bf16x8_t*)(XT + (16 * p2 + c16) * 64 + 8 * q), z4, 0, 0, 0);
              if (lt >= 2) y = __builtin_amdgcn_mfma_f32_16x16x32_bf16(*(const bf16x8_t*)(Pm + (16 * lt + c16) * 64 + 32 + 8 * q), *(const bf16x8_t*)(XT + (16 * p2 + c16) * 64 + 32 + 8 * q), y, 0, 0, 0);
#pragma unroll
              for (int r = 0; r < 4; ++r) { const int l = 16 * lt + 4 * q + r, o = l * 64 + 16 * p2 + c16; Yo[o] = y[r] + __expf(acs[par * 64 + l]) * (Yo[o] + Yo[4096 + o]); } } }
        LDS_SYNC();
        {
          f32x4 x0, x1, z0, z1; pg8::unpack8(xk, x0, x1); pg8::unpack8(zk, z0, z1);
          const f32x4 y0 = (*(const f32x4*)(Yo + pp * 64 + c8) + Dh * x0) * z0 * sig4g(z0), y1 = (*(const f32x4*)(Yo + pp * 64 + c8 + 4) + Dh * x1) * z1 * sig4g(z1);
          *(u32x4*)(YA + (size_t)c0 * 512) = pg8::pack8(y0, y1); }
    }
#undef SSD_FETCH
#undef SSD_DT
}
__device__ __forceinline__ void ssd_norm_item4(KArgs C, int layer, int item0, int stride, int nitems, int lane) {
    u32x2 w[4]; bf16* p[4];
#pragma unroll
    for (int q = 0; q < 4; ++q) { const int item = item0 + q * stride; p[q] = WSP(bf16, WS_Y) + (size_t)((item < nitems ? item : item0) >> 1) * 512 + ((item < nitems ? item : item0) & 1) * 256 + lane * 4; w[q] = *(const u32x2*)p[q]; }
#pragma unroll
    for (int q = 0; q < 4; ++q) { const int item = item0 + q * stride; if (item < nitems) {
        float v[4] = {lo_bf(w[q].x), hi_bf(w[q].x), lo_bf(w[q].y), hi_bf(w[q].y)};
        const float rstd = 1.0f / sqrtf(wave_sum(v[0] * v[0] + v[1] * v[1] + v[2] * v[2] + v[3] * v[3]) * (1.f / 256) + RMS_EPS);
        const float* g = C->in[I_SSDNG] + layer * 512 + (item & 1) * 256 + lane * 4;
        u32x2 o; o.x = pk2(v[0] * rstd * g[0], v[1] * rstd * g[1]); o.y = pk2(v[2] * rstd * g[2], v[3] * rstd * g[3]); *(u32x2*)p[q] = o; } }
}
__device__ __forceinline__ void rwkv_prep_row(KArgs C, int layer, int m, int lane) {
    const int t = m % SEQ, col = 1536 + lane * 4;
    const bf16* cur = WSP(const bf16, WS_RW) + (size_t)m * 1792 + col;
    const u32x2 wc = *(const u32x2*)cur; u32x2 wp; wp.x = 0u; wp.y = 0u; if (t > 0) wp = *(const u32x2*)(cur - 1792);
    const f32x4 mu = *(const f32x4*)(C->in[I_MU] + layer * 1792 + col);
    float v[4] = {lo_bf(wc.x), hi_bf(wc.x), lo_bf(wc.y), hi_bf(wc.y)}; const float p[4] = {lo_bf(wp.x), hi_bf(wp.x), lo_bf(wp.y), hi_bf(wp.y)};
#pragma unroll
    for (int i = 0; i < 4; ++i) { v[i] = v[i] + (p[i] - v[i]) * mu[i]; v[i] = lane < 16 ? tanh_fast(v[i]) : (lane < 32 ? v[i] : sigm(v[i])); }
    u32x2 o; o.x = pk2(v[0], v[1]); o.y = pk2(v[2], v[3]); *(u32x2*)(WSP(bf16, WS_RA) + (size_t)m * 256 + lane * 4) = o;
}
__device__ __forceinline__ void rwkv_prep_row2(KArgs C, int layer, int m, int step, int lane) {
    const int col = 1536 + lane * 4; const f32x4 mu = *(const f32x4*)(C->in[I_MU] + layer * 1792 + col);
    u32x2 wc[2], wp[2];
#pragma unroll
    for (int r = 0; r < 2; ++r) { const int mm = m + r * step; const bf16* cur = WSP(const bf16, WS_RW) + (size_t)mm * 1792 + col; wc[r] = *(const u32x2*)cur;
        if (mm % SEQ > 0) wp[r] = *(const u32x2*)(cur - 1792); else { wp[r].x = 0u; wp[r].y = 0u; } }
#pragma unroll
    for (int r = 0; r < 2; ++r) { float v[4] = {lo_bf(wc[r].x), hi_bf(wc[r].x), lo_bf(wc[r].y), hi_bf(wc[r].y)}; const float p[4] = {lo_bf(wp[r].x), hi_bf(wp[r].x), lo_bf(wp[r].y), hi_bf(wp[r].y)};
#pragma unroll
        for (int i = 0; i < 4; ++i) { v[i] = v[i] + (p[i] - v[i]) * mu[i]; v[i] = lane < 16 ? tanh_fast(v[i]) : (lane < 32 ? v[i] : sigm(v[i])); }
        u32x2 o; o.x = pk2(v[0], v[1]); o.y = pk2(v[2], v[3]); *(u32x2*)(WSP(bf16, WS_RA) + (size_t)(m + r * step) * 256 + lane * 4) = o; }
}
__device__ __forceinline__ void rwkv_unit(KArgs C, int layer, int unit, unsigned char* lds) {
    constexpr int SLOT = 16704, O_RT = 2048, O_BTL = 4096, O_KTL = 6144, O_BHT = 8192, O_KHT = 10240, O_VT = 12288, O_TM = 14336, O_AAK = 14848, O_RB = 15360, O_RK = 15872, O_DL = 16384, O_BON = 16640;
    const int tid = fresh_tid(), lane = tid & 63, wave = tid >> 6, bl = unit >> 3, h = unit & 7, pt = tid >> 3, k8 = (tid & 7) * 8, cc = pt >> 4, tl = pt & 15, hc = h * 64 + k8;
    float* WL = (float*)(lds + 4 * SLOT); float* Nf = WL + 4096; float* Yb = Nf + 1024; float* ct_ = Yb + 4096;
    const bf16* RW = WSP(const bf16, WS_RW) + (size_t)bl * SEQ * 1792 + hc;
    const float* WLG = WSP(const float, WS_WLOG) + (size_t)bl * SEQ * 512 + hc;
    const bf16* AS = WSP(const bf16, WS_ASIG) + (size_t)bl * SEQ * 512 + hc;
    const bf16* GG = WSP(const bf16, WS_GG) + (size_t)bl * SEQ * 512 + hc;
    bf16* YC = WSP(bf16, WS_Y) + (size_t)2 * MG * 512 + (size_t)bl * SEQ * 512 + hc;
    LDS_SYNC();
    { const int row = tid >> 6, j = tid & 63; const float* src = row == 0 ? C->in[I_MU] + layer * 1792 : row == 1 ? C->in[I_MU] + layer * 1792 + 512 : row == 2 ? C->in[I_MU] + layer * 1792 + 1024
          : row == 3 ? C->in[I_KK] + layer * 512 : row == 4 ? C->in[I_KA] + layer * 512 : row == 5 ? C->in[I_RK] + layer * 512 : row == 6 ? C->in[I_LNG] + layer * 512 : C->in[I_LNB] + layer * 512;
      ct_[tid] = src[h * 64 + j]; }
    f32x4_t Sd[4]; bf16x8_t Sf[2];
#pragma unroll
    for (int i = 0; i < 4; ++i) Sd[i] = (f32x4_t){0.f, 0.f, 0.f, 0.f};
    { u32x2 z; z.x = 0u; z.y = 0u; Sf[0] = frag2(z, z); Sf[1] = Sf[0]; }
    u32x4 rc, rp, kc, kp, vc, vp, ac, gc; f32x4 wl0, wl1;
#define RWKV_FETCH(c0_) do { const int tt_ = (c0_) + pt; const bf16* q_ = RW + (size_t)tt_ * 1792; \
        rc = *(const u32x4*)q_; kc = *(const u32x4*)(q_ + 512); vc = *(const u32x4*)(q_ + 1024); \
        if (tt_ > 0) { rp = *(const u32x4*)(q_ - 1792); kp = *(const u32x4*)(q_ - 1792 + 512); vp = *(const u32x4*)(q_ - 1792 + 1024); } else { rp = (u32x4){0u, 0u, 0u, 0u}; kp = rp; vp = rp; } \
        wl0 = *(const f32x4*)(WLG + (size_t)tt_ * 512); wl1 = *(const f32x4*)(WLG + (size_t)tt_ * 512 + 4); ac = *(const u32x4*)(AS + (size_t)tt_ * 512); gc = *(const u32x4*)(GG + (size_t)tt_ * 512); } while (0)
    RWKV_FETCH(0);
    LDS_SYNC();
    for (int c0 = 0; c0 < SEQ; c0 += 64) {
        unsigned char* slot = lds + cc * SLOT;
        f32x4 r0, r1, kq0, kq1, v0, v1, kk0, kk1, b0, b1; const u32x4 gkeep = gc; const f32x4 wk0 = wl0, wk1 = wl1; float bo;
        { f32x4 c0_, c1_, p0_, p1_, a0, a1;
          pg8::unpack8(rc, c0_, c1_); pg8::unpack8(rp, p0_, p1_); r0 = c0_ + (p0_ - c0_) * *(const f32x4*)(ct_ + k8); r1 = c1_ + (p1_ - c1_) * *(const f32x4*)(ct_ + k8 + 4);
          pg8::unpack8(kc, c0_, c1_); pg8::unpack8(kp, p0_, p1_); const f32x4 k00 = c0_ + (p0_ - c0_) * *(const f32x4*)(ct_ + 64 + k8), k01 = c1_ + (p1_ - c1_) * *(const f32x4*)(ct_ + 64 + k8 + 4);
          pg8::unpack8(vc, c0_, c1_); pg8::unpack8(vp, p0_, p1_); v0 = c0_ + (p0_ - c0_) * *(const f32x4*)(ct_ + 128 + k8); v1 = c1_ + (p1_ - c1_) * *(const f32x4*)(ct_ + 128 + k8 + 4);
          pg8::unpack8(ac, a0, a1);
          kk0 = k00 * *(const f32x4*)(ct_ + 192 + k8); kk1 = k01 * *(const f32x4*)(ct_ + 192 + k8 + 4);
          const float inv = 1.0f / fmaxf(sqrtf(red8((kk0.x * kk0.x + kk0.y * kk0.y + kk0.z * kk0.z + kk0.w * kk0.w) + (kk1.x * kk1.x + kk1.y * kk1.y + kk1.z * kk1.z + kk1.w * kk1.w))), 1e-12f);
          kk0 = kk0 * inv; kk1 = kk1 * inv; b0 = kk0 * a0; b1 = kk1 * a1;
          kq0 = k00 * (1.0f + (a0 - 1.0f) * *(const f32x4*)(ct_ + 256 + k8)); kq1 = k01 * (1.0f + (a1 - 1.0f) * *(const f32x4*)(ct_ + 256 + k8 + 4));
          const f32x4 q0 = r0 * kq0 * *(const f32x4*)(ct_ + 320 + k8), q1 = r1 * kq1 * *(const f32x4*)(ct_ + 320 + k8 + 4);
          bo = red8((q0.x + q0.y + q0.z + q0.w) + (q1.x + q1.y + q1.z + q1.w));
          *(f32x4*)(WL + pt * 64 + k8) = wk0; *(f32x4*)(WL + pt * 64 + k8 + 4) = wk1; }
        if (c0 + 64 < SEQ) RWKV_FETCH(c0 + 64);
        LDS_SYNC();
        if (tid < 256) { const int c_ = tid >> 6, k_ = tid & 63; float w16[16], run = 0.f;
#pragma unroll
            for (int t = 0; t < 16; ++t) w16[t] = WL[(c_ * 16 + t) * 64 + k_];
#pragma unroll
            for (int t = 0; t < 16; ++t) { run += w16[t]; WL[(c_ * 16 + t) * 64 + k_] = run; }
            ((float*)(lds + c_ * SLOT + O_DL))[k_] = __expf(run); }
        LDS_SYNC();
        { const f32x4 cs0 = *(const f32x4*)(WL + pt * 64 + k8), cs1 = *(const f32x4*)(WL + pt * 64 + k8 + 4), d0 = *(const f32x4*)((const float*)(slot + O_DL) + k8), d1 = *(const f32x4*)((const float*)(slot + O_DL) + k8 + 4);
          f32x4 e0, e1, f0, f1, w0, w1;
#pragma unroll
          for (int i = 0; i < 4; ++i) { e0[i] = __expf(cs0[i]); e1[i] = __expf(cs1[i]); f0[i] = __builtin_amdgcn_rcpf(e0[i]); f1[i] = __builtin_amdgcn_rcpf(e1[i]); w0[i] = __expf(-wk0[i]); w1[i] = __expf(-wk1[i]); }
          const f32x4 bt0 = b0 * f0, bt1 = b1 * f1, kt0 = kq0 * f0, kt1 = kq1 * f1;
          *(u32x4*)((bf16*)slot + tl * 64 + k8) = pg8::pack8(-(kk0 * e0 * w0), -(kk1 * e1 * w1));
          *(u32x4*)((bf16*)(slot + O_RT) + tl * 64 + k8) = pg8::pack8(r0 * e0, r1 * e1);
          *(u32x4*)((bf16*)(slot + O_BTL) + tl * 64 + k8) = pg8::pack8(bt0, bt1);
          *(u32x4*)((bf16*)(slot + O_KTL) + tl * 64 + k8) = pg8::pack8(kt0, kt1);
          const f32x4 bh0 = bt0 * d0, bh1 = bt1 * d1, kh0 = kt0 * d0, kh1 = kt1 * d1;
          bf16* bht = (bf16*)(slot + O_BHT) + k8 * 16 + tl; bf16* kht = (bf16*)(slot + O_KHT) + k8 * 16 + tl; bf16* vt = (bf16*)(slot + O_VT) + k8 * 16 + tl;
#pragma unroll
          for (int i = 0; i < 4; ++i) { bht[i * 16] = f2bf(bh0[i]); bht[(i + 4) * 16] = f2bf(bh1[i]); kht[i * 16] = f2bf(kh0[i]); kht[(i + 4) * 16] = f2bf(kh1[i]); vt[i * 16] = f2bf(v0[i]); vt[(i + 4) * 16] = f2bf(v1[i]); } }
        LDS_SYNC();
        { unsigned char* sl = lds + (wave & 3) * SLOT; const int c16 = lane & 15, q = lane >> 4;
          const bf16x8_t a0 = *(const bf16x8_t*)((const bf16*)sl + c16 * 64 + 8 * q), a1 = *(const bf16x8_t*)((const bf16*)sl + c16 * 64 + 32 + 8 * q);
          const bf16x8_t bb0 = *(const bf16x8_t*)((const bf16*)(sl + O_BTL) + c16 * 64 + 8 * q), bb1 = *(const bf16x8_t*)((const bf16*)(sl + O_BTL) + c16 * 64 + 32 + 8 * q);
          const f32x4_t z4 = {0.f, 0.f, 0.f, 0.f};
          if (wave < 4) {
              f32x4_t n = __builtin_amdgcn_mfma_f32_16x16x32_bf16(a0, bb0, z4, 0, 0, 0); n = __builtin_amdgcn_mfma_f32_16x16x32_bf16(a1, bb1, n, 0, 0, 0);
              float* nf = Nf + (wave & 3) * 256;
#pragma unroll
              for (int r = 0; r < 4; ++r) nf[c16 * 16 + 4 * q + r] = (c16 < 4 * q + r) ? n[r] : 0.f;
              WAVE_SYNC();
              float tc[16];
#pragma unroll
              for (int t = 0; t < 16; ++t) tc[t] = (t == c16) ? 1.f : 0.f;
#pragma unroll
              for (int s2 = 0; s2 < 15; ++s2) { const f32x4 n0 = *(const f32x4*)(nf + s2 * 16), n1 = *(const f32x4*)(nf + s2 * 16 + 4), n2 = *(const f32x4*)(nf + s2 * 16 + 8), n3 = *(const f32x4*)(nf + s2 * 16 + 12);
                  const float ts = tc[s2]; const float nn[16] = {n0.x, n0.y, n0.z, n0.w, n1.x, n1.y, n1.z, n1.w, n2.x, n2.y, n2.z, n2.w, n3.x, n3.y, n3.z, n3.w};
#pragma unroll
                  for (int t = 0; t < 16; ++t) if (t > s2) tc[t] += nn[t] * ts; }
              if (q == 0) { bf16* tm = (bf16*)(sl + O_TM) + c16;
#pragma unroll
                  for (int t = 0; t < 16; ++t) tm[t * 16] = f2bf(tc[t]); }
          } else {
              const bf16x8_t r0f = *(const bf16x8_t*)((const bf16*)(sl + O_RT) + c16 * 64 + 8 * q), r1f = *(const bf16x8_t*)((const bf16*)(sl + O_RT) + c16 * 64 + 32 + 8 * q);
              const bf16x8_t kb0 = *(const bf16x8_t*)((const bf16*)(sl + O_KTL) + c16 * 64 + 8 * q), kb1 = *(const bf16x8_t*)((const bf16*)(sl + O_KTL) + c16 * 64 + 32 + 8 * q);
              f32x4_t ak = __builtin_amdgcn_mfma_f32_16x16x32_bf16(a0, kb0, z4, 0, 0, 0); ak = __builtin_amdgcn_mfma_f32_16x16x32_bf16(a1, kb1, ak, 0, 0, 0);
              f32x4_t rb = __builtin_amdgcn_mfma_f32_16x16x32_bf16(r0f, bb0, z4, 0, 0, 0); rb = __builtin_amdgcn_mfma_f32_16x16x32_bf16(r1f, bb1, rb, 0, 0, 0);
              f32x4_t rk = __builtin_amdgcn_mfma_f32_16x16x32_bf16(r0f, kb0, z4, 0, 0, 0); rk = __builtin_amdgcn_mfma_f32_16x16x32_bf16(r1f, kb1, rk, 0, 0, 0);
#pragma unroll
              for (int r = 0; r < 4; ++r) { const int t = 4 * q + r;
                  ((bf16*)(sl + O_AAK))[t * 16 + c16] = f2bf(c16 < t ? ak[r] : 0.f); ((bf16*)(sl + O_RB))[t * 16 + c16] = f2bf(c16 <= t ? rb[r] : 0.f); ((bf16*)(sl + O_RK))[t * 16 + c16] = f2bf(c16 <= t ? rk[r] : 0.f); }
          } }
        LDS_SYNC();
        if (wave < 4) { const int c16 = lane & 15, q = lane >> 4, vcol = 16 * wave + c16; u32x2 zz; zz.x = 0u; zz.y = 0u; const f32x4_t z4 = {0.f, 0.f, 0.f, 0.f};
#pragma unroll
            for (int ch = 0; ch < 4; ++ch) { const unsigned char* sl = lds + ch * SLOT;
                const bf16* at = (const bf16*)sl + c16 * 64 + 4 * q; const bf16* rt = (const bf16*)(sl + O_RT) + c16 * 64 + 4 * q;
                const bf16x8_t af0 = frag2(*(const u32x2*)at, *(const u32x2*)(at + 16)), af1 = frag2(*(const u32x2*)(at + 32), *(const u32x2*)(at + 48));
                const bf16x8_t rf0 = frag2(*(const u32x2*)rt, *(const u32x2*)(rt + 16)), rf1 = frag2(*(const u32x2*)(rt + 32), *(const u32x2*)(rt + 48));
                const u32x2 vq = *(const u32x2*)((const bf16*)(sl + O_VT) + vcol * 16 + 4 * q);
                const u32x2 aq = *(const u32x2*)((const bf16*)(sl + O_AAK) + c16 * 16 + 4 * q), tq = *(const u32x2*)((const bf16*)(sl + O_TM) + c16 * 16 + 4 * q);
                const u32x2 rbq = *(const u32x2*)((const bf16*)(sl + O_RB) + c16 * 16 + 4 * q), rkq = *(const u32x2*)((const bf16*)(sl + O_RK) + c16 * 16 + 4 * q);
                f32x4_t rhs = __builtin_amdgcn_mfma_f32_16x16x32_bf16(frag2(zz, aq), frag2(zz, vq), z4, 0, 0, 0); rhs = __builtin_amdgcn_mfma_f32_16x16x32_bf16(af0, Sf[0], rhs, 0, 0, 0);
                { const f32x4_t r2 = __builtin_amdgcn_mfma_f32_16x16x32_bf16(af1, Sf[1], z4, 0, 0, 0); rhs = rhs + r2; }
                u32x2 rl; rl.x = pk2(rhs[0], rhs[1]); rl.y = pk2(rhs[2], rhs[3]);
                const f32x4_t U = __builtin_amdgcn_mfma_f32_16x16x32_bf16(frag2(tq, zz), frag2(rl, zz), z4, 0, 0, 0);
                u32x2 ul; ul.x = pk2(U[0], U[1]); ul.y = pk2(U[2], U[3]); const bf16x8_t uv = frag2(ul, vq);
                f32x4_t y = __builtin_amdgcn_mfma_f32_16x16x32_bf16(rf0, Sf[0], z4, 0, 0, 0); y = __builtin_amdgcn_mfma_f32_16x16x32_bf16(rf1, Sf[1], y, 0, 0, 0);
                y = __builtin_amdgcn_mfma_f32_16x16x32_bf16(frag2(rbq, rkq), uv, y, 0, 0, 0);
#pragma unroll
                for (int r = 0; r < 4; ++r) Yb[(ch * 16 + 4 * q + r) * 64 + vcol] = y[r];
#pragma unroll
                for (int kt = 0; kt < 4; ++kt) { const f32x4 dl = *(const f32x4*)((const float*)(sl + O_DL) + 16 * kt + 4 * q);
                    const u32x2 bq = *(const u32x2*)((const bf16*)(sl + O_BHT) + (16 * kt + c16) * 16 + 4 * q), kq = *(const u32x2*)((const bf16*)(sl + O_KHT) + (16 * kt + c16) * 16 + 4 * q);
                    const f32x4_t cin = {Sd[kt][0] * dl.x, Sd[kt][1] * dl.y, Sd[kt][2] * dl.z, Sd[kt][3] * dl.w};
                    Sd[kt] = __builtin_amdgcn_mfma_f32_16x16x32_bf16(frag2(bq, kq), uv, cin, 0, 0, 0); }
#pragma unroll
                for (int s2 = 0; s2 < 2; ++s2) { u32x2 lo, hi; lo.x = pk2(Sd[2 * s2][0], Sd[2 * s2][1]); lo.y = pk2(Sd[2 * s2][2], Sd[2 * s2][3]); hi.x = pk2(Sd[2 * s2 + 1][0], Sd[2 * s2 + 1][1]); hi.y = pk2(Sd[2 * s2 + 1][2], Sd[2 * s2 + 1][3]); Sf[s2] = frag2(lo, hi); }
            } }
        LDS_SYNC();
        { const f32x4 y0 = *(const f32x4*)(Yb + pt * 64 + k8), y1 = *(const f32x4*)(Yb + pt * 64 + k8 + 4);
          const float mean = red8((y0.x + y0.y + y0.z + y0.w) + (y1.x + y1.y + y1.z + y1.w)) * (1.f / 64); const f32x4 d0 = y0 - mean, d1 = y1 - mean;
          const float rstd = 1.0f / sqrtf(red8((d0.x * d0.x + d0.y * d0.y + d0.z * d0.z + d0.w * d0.w) + (d1.x * d1.x + d1.y * d1.y + d1.z * d1.z + d1.w * d1.w)) * (1.f / 64) + GN_EPS);
          f32x4 g0, g1; pg8::unpack8(gkeep, g0, g1);
          const f32x4 o0 = (d0 * rstd * *(const f32x4*)(ct_ + 384 + k8) + *(const f32x4*)(ct_ + 448 + k8) + bo * v0) * g0, o1 = (d1 * rstd * *(const f32x4*)(ct_ + 384 + k8 + 4) + *(const f32x4*)(ct_ + 448 + k8 + 4) + bo * v1) * g1;
          *(u32x4*)(YC + (size_t)(c0 + pt) * 512) = pg8::pack8(o0, o1); }
    }
#undef RWKV_FETCH
}

__device__ __forceinline__ void s5_unit(KArgs C, int layer, int unit, unsigned char* lds) {
    const int tid = fresh_tid(), lane = tid & 63, wave = tid >> 6, bl = unit >> 5, g = unit & 31, c16 = lane & 15, q = lane >> 4, sg = wave & 3, th = wave >> 2, p = 16 * sg + c16;
    constexpr int SP = 136;
    float* us = (float*)lds; float* ends = us + 1024; bf16* St = (bf16*)(ends + 16 * 128);
    const bf16* U = WSP(const bf16, WS_U) + (size_t)bl * SEQ * 512 + g * 16;
    bf16* YD0 = WSP(bf16, WS_YD0) + (size_t)bl * SEQ * 512 + g * 16;
    const size_t wo = (layer & 1) ? WDELTA : 0;
    bf16x8_t bre, bim;
    { const float* bb = WSP(const float, WS_BBAR + wo) + ((size_t)g * 64 + p) * 32; u32x4 wr_, wi_;
      if (q < 2) { const float* b8 = bb + 16 * q; wr_.x = pk2(b8[0], b8[2]); wr_.y = pk2(b8[4], b8[6]); wr_.z = pk2(b8[8], b8[10]); wr_.w = pk2(b8[12], b8[14]);
                   wi_.x = pk2(b8[1], b8[3]); wi_.y = pk2(b8[5], b8[7]); wi_.z = pk2(b8[9], b8[11]); wi_.w = pk2(b8[13], b8[15]); }
      else { wr_ = (u32x4){0u, 0u, 0u, 0u}; wi_ = wr_; }
      bre = __builtin_bit_cast(bf16x8_t, wr_); bim = __builtin_bit_cast(bf16x8_t, wi_); }
    float apr[4], api[4];
    { const float ar = WSP(const float, WS_ABAR + wo)[(g * 64 + p) * 2], ai = WSP(const float, WS_ABAR + wo)[(g * 64 + p) * 2 + 1]; apr[0] = ar; api[0] = ai;
#pragma unroll
      for (int i = 1; i < 4; ++i) { apr[i] = apr[i - 1] * ar - api[i - 1] * ai; api[i] = apr[i - 1] * ai + api[i - 1] * ar; } }
    bf16x8_t cf[4];
    { const float* cre = C->in[I_S5CRE] + ((size_t)layer * 32 + g) * 1024 + c16 * 64; const float* cim = C->in[I_S5CIM] + ((size_t)layer * 32 + g) * 1024 + c16 * 64;
#pragma unroll
      for (int ks = 0; ks < 4; ++ks) { const int c0_ = 32 * ks + 8 * q; const float* src = c0_ < 64 ? cre + c0_ : cim + (c0_ - 64); const float sgn = c0_ < 64 ? 1.f : -1.f;
          u32x4 w; w.x = pk2(sgn * src[0], sgn * src[1]); w.y = pk2(sgn * src[2], sgn * src[3]); w.z = pk2(sgn * src[4], sgn * src[5]); w.w = pk2(sgn * src[6], sgn * src[7]); cf[ks] = __builtin_bit_cast(bf16x8_t, w); } }
    const float dj = C->in[I_S5D][layer * 512 + g * 16 + c16];
    float cr = 0.f, ci = 0.f;
    u32x2 fu; fu.x = 0u; fu.y = 0u;
#define S5_FETCH(c0_) do { if (tid < 256) fu = *(const u32x2*)(U + (size_t)((c0_) + (tid >> 2)) * 512 + (tid & 3) * 4); } while (0)
    S5_FETCH(0);
    for (int c0 = 0; c0 < SEQ; c0 += 64) {
        LDS_SYNC();
        if (tid < 256) *(f32x4*)(us + (tid >> 2) * 16 + (tid & 3) * 4) = (f32x4){lo_bf(fu.x), hi_bf(fu.x), lo_bf(fu.y), hi_bf(fu.y)};
        if (c0 + 64 < SEQ) S5_FETCH(c0 + 64);
        LDS_SYNC();
        float lr[2][4], li[2][4];
#pragma unroll
        for (int tt = 0; tt < 2; ++tt) { bf16x8_t af;
            if (q < 2) { const float* ur = us + (32 * th + 16 * tt + c16) * 16 + 8 * q; const f32x4 u0 = *(const f32x4*)ur, u1 = *(const f32x4*)(ur + 4);
                u32x4 w; w.x = pk2(u0.x, u0.y); w.y = pk2(u0.z, u0.w); w.z = pk2(u1.x, u1.y); w.w = pk2(u1.z, u1.w); af = __builtin_bit_cast(bf16x8_t, w); }
            else { const u32x4 z = {0u, 0u, 0u, 0u}; af = __builtin_bit_cast(bf16x8_t, z); }
            const f32x4_t z4 = {0.f, 0.f, 0.f, 0.f};
            const f32x4_t dre = __builtin_amdgcn_mfma_f32_16x16x32_bf16(af, bre, z4, 0, 0, 0), dim = __builtin_amdgcn_mfma_f32_16x16x32_bf16(af, bim, z4, 0, 0, 0);
            lr[tt][0] = dre[0]; li[tt][0] = dim[0];
#pragma unroll
            for (int r = 1; r < 4; ++r) { lr[tt][r] = apr[0] * lr[tt][r - 1] - api[0] * li[tt][r - 1] + dre[r]; li[tt][r] = apr[0] * li[tt][r - 1] + api[0] * lr[tt][r - 1] + dim[r]; }
            const int rho = (2 * th + tt) * 4 + q; ends[(rho * 64 + p) * 2] = lr[tt][3]; ends[(rho * 64 + p) * 2 + 1] = li[tt][3]; }
        LDS_SYNC();
        { float xr = cr, xi = ci; const int rho0 = (2 * th) * 4 + q;
          for (int rr = 0; rr < 16; ++rr) {
              if (rr == rho0 || rr == rho0 + 4) { const int tt = (rr == rho0) ? 0 : 1;
#pragma unroll
                  for (int r = 0; r < 4; ++r) { const float sr = lr[tt][r] + apr[r] * xr - api[r] * xi, si = li[tt][r] + apr[r] * xi + api[r] * xr; const int t = 32 * th + 16 * tt + 4 * q + r;
                      St[t * SP + p] = f2bf(sr); St[t * SP + 64 + p] = f2bf(si); } }
              const float er = ends[(rr * 64 + p) * 2], ei = ends[(rr * 64 + p) * 2 + 1]; const float nr = apr[3] * xr - api[3] * xi + er, ni = apr[3] * xi + api[3] * xr + ei; xr = nr; xi = ni; }
          cr = xr; ci = xi; }
        LDS_SYNC();
        if (wave < 4) { f32x4_t y = {0.f, 0.f, 0.f, 0.f};
#pragma unroll
            for (int ks = 0; ks < 4; ++ks) y = __builtin_amdgcn_mfma_f32_16x16x32_bf16(*(const bf16x8_t*)(St + (16 * wave + c16) * SP + 32 * ks + 8 * q), cf[ks], y, 0, 0, 0);
#pragma unroll
            for (int r = 0; r < 4; ++r) { const int t = 16 * wave + 4 * q + r; YD0[(size_t)(c0 + t) * 512 + c16] = f2bf(gelu_tanh(y[r] + dj * us[t * 16 + c16])); } }
    }
#undef S5_FETCH
}

__device__ __forceinline__ unsigned ord_key(float f) { const unsigned u = __float_as_uint(f); return (u & 0x80000000u) ? ~u : (u | 0x80000000u); }
__device__ __forceinline__ void dsa_vt_item(KArgs C, int item, int lane, bf16* scr) {
    const int tb = item % NK64, bh = item / NK64, h = bh & 7, bl = bh >> 3;
    const bf16* V = WSP(const bf16, WS_V) + ((size_t)bl * SEQ + tb * 64) * 512 + h * 64;
    WAVE_SYNC();
#pragma unroll
    for (int i = 0; i < 8; ++i) { const int tk = (lane >> 3) + 8 * i, c8 = (lane & 7) * 8; const u32x4 w = *(const u32x4*)(V + (size_t)tk * 512 + c8);
        unsigned* d = (unsigned*)(scr + tk * 66 + c8); d[0] = w.x; d[1] = w.y; d[2] = w.z; d[3] = w.w; }
    WAVE_SYNC();
    bf16* Vt = WSP(bf16, WS_VT) + ((size_t)bh * 64) * SEQ + tb * 64 + lane;
#pragma unroll 8
    for (int d = 0; d < 64; ++d) Vt[(size_t)d * SEQ] = scr[lane * 66 + d];
}
constexpr int IDX_CAP = 128, IDX_NBIN = 1024;
__device__ __forceinline__ void dsa_index_unit(KArgs C, int unit, int lane, int wave, unsigned char* lds) {
    const int oct = unit & 7, pairid = (unit >> 3) % (NK64 / 2), kx = (unit >> 3) / (NK64 / 2), bl = kx >> 1, c = (kx & 1) ? NK64 - 1 - pairid : pairid;
    const int t0 = c * 64 + oct * 8, nkeys = (c + 1) * 64, nk64 = c + 1; const size_t row0 = (size_t)bl * SEQ + t0;
    unsigned* mrow = WSP(unsigned, WS_MASK) + (row0 + wave) * MW;
    if (nkeys <= TOPK) { for (int w = lane; w < MW; w += 64) mrow[w] = (w * 32 < nkeys) ? 0xffffffffu : 0u; return; }
    float* scf = (float*)lds;
    unsigned* hist = (unsigned*)(lds + LDS_X) + wave * (IDX_NBIN / 2); unsigned* candv = (unsigned*)(lds + LDS_X + 8 * IDX_NBIN * 2) + wave * IDX_CAP; unsigned* candi = candv + 8 * IDX_CAP; unsigned* mword = (unsigned*)(lds + LDS_X + 8 * IDX_NBIN * 2 + 16 * IDX_CAP * 4) + wave * MW;
    const bf16* SMb = WSP(const bf16, WS_SM) + (size_t)bl * SEQ * 256;
    const int l31 = lane & 31, half = lane >> 5;
    const bf16* qa = SMb + (size_t)(t0 + (l31 >> 2)) * 256 + 8 + (l31 & 3) * 32 + 8 * half;
    const bf16x8_t a0 = *(const bf16x8_t*)qa, a1 = *(const bf16x8_t*)(qa + 16);
    u32x2 wraw[4];
#pragma unroll
    for (int g = 0; g < 4; ++g) wraw[g] = *(const u32x2*)(SMb + (size_t)(t0 + 2 * g + half) * 256 + 168);
    LDS_SYNC();
    {
      float wv[4][4];
#pragma unroll
      for (int g = 0; g < 4; ++g) { const u32x2 w = wraw[g]; wv[g][0] = lo_bf(w.x) * 0.5f; wv[g][1] = hi_bf(w.x) * 0.5f; wv[g][2] = lo_bf(w.y) * 0.5f; wv[g][3] = hi_bf(w.y) * 0.5f; }
      for (int kt0 = wave; kt0 < nk64 * 2; kt0 += 8 * NWAVES) {
          bf16x8_t b0[8], b1[8];
#pragma unroll
          for (int u4 = 0; u4 < 8; ++u4) { const int kt = kt0 + 8 * u4; const bf16* kb = WSP(const bf16, WS_KI) + ((size_t)bl * SEQ + (size_t)((kt < nk64 * 2 ? kt : wave) * 32 + l31)) * 32 + 8 * half;
              b0[u4] = *(const bf16x8_t*)kb; b1[u4] = *(const bf16x8_t*)(kb + 16); }
#pragma unroll
          for (int u4 = 0; u4 < 8; ++u4) { const int kt = kt0 + 8 * u4; if (kt < nk64 * 2) {
              f32x16 d;
#pragma unroll
              for (int r = 0; r < 16; ++r) d[r] = 0.f;
              d = __builtin_amdgcn_mfma_f32_32x32x16_bf16(a0, b0[u4], d, 0, 0, 0); d = __builtin_amdgcn_mfma_f32_32x32x16_bf16(a1, b1[u4], d, 0, 0, 0);
#pragma unroll
              for (int g = 0; g < 4; ++g) { float sc = 0.f;
#pragma unroll
                  for (int j = 0; j < 4; ++j) sc += wv[g][j] * fmaxf(d[4 * g + j] * 0.17677669529f, 0.f);
                  scf[(2 * g + half) * SEQ + kt * 32 + l31] = sc; } } }
      } }
    { const int tail0 = nkeys, tail1 = ((nk64 + 7) >> 3) * 512;
      for (int e = tail0 + (int)(threadIdx.x); e < tail1; e += NTHREADS) {
#pragma unroll
          for (int qq = 0; qq < 8; ++qq) scf[qq * SEQ + e] = -3.0e38f; } }
    LDS_SYNC();
    const float* sc = scf + wave * SEQ; constexpr float NEG = -3.0e38f; const int nb8 = (nk64 + 7) >> 3;
    float v[NK64];
#pragma unroll
    for (int ib = 0; ib < NK64 / 8; ++ib) if (ib < nb8) {
#pragma unroll
        for (int j = 0; j < 8; ++j) v[ib * 8 + j] = sc[(ib * 8 + j) * 64 + lane];
        SCHED_FENCE(); }
    float mn = INFINITY, mx = -INFINITY;
#pragma unroll
    for (int ib = 0; ib < NK64 / 8; ++ib) if (ib < nb8) {
#pragma unroll
        for (int j = 0; j < 8; ++j) { const float x = v[ib * 8 + j]; mx = fmaxf(mx, x); mn = fminf(mn, x == NEG ? INFINITY : x); } }
    mn = -wave_max(-mn); mx = wave_max(mx);
    const float scale = (mx > mn) ? ((float)(IDX_NBIN - 2) - 0.01f) / (mx - mn) : 0.f;
#pragma unroll
    for (int i = 0; i < IDX_NBIN / 128; ++i) hist[lane * (IDX_NBIN / 128) + i] = 0u;
    for (int w = lane; w < MW; w += 64) mword[w] = 0u;
    WAVE_SYNC();
#define IDX_BIN(x) ({ const float x_ = (x); int b_ = (int)(fmaxf(x_ - mn, 0.f) * scale + 1.0f); b_ = b_ > IDX_NBIN - 2 ? IDX_NBIN - 2 : b_; b_ + (__float_as_int(x_) >> 31) + (__float_as_int(x_) > 0 ? 1 : 0); })
#pragma unroll
    for (int ib = 0; ib < NK64 / 8; ++ib) if (ib < nb8) {
#pragma unroll
        for (int j = 0; j < 8; ++j) { const int b = IDX_BIN(v[ib * 8 + j]); atomicAdd(&hist[b >> 1], (b & 1) ? 0x10000u : 1u); }
        SCHED_FENCE(); }
    WAVE_SYNC();
    int bstar, cgt;
    {
      unsigned hw[8]; int tot = 0;
#pragma unroll
      for (int i = 0; i < 8; ++i) { hw[i] = hist[lane * 8 + i]; tot += (int)(hw[i] & 0xffffu) + (int)(hw[i] >> 16); }
      int suf = tot;
#pragma unroll
      for (int o = 1; o < 64; o <<= 1) { const int t = __shfl_down(suf, o); if (lane + o < 64) suf += t; }
      const unsigned long long ge = __ballot(suf >= TOPK); const int L = 63 - __builtin_clzll(ge);
      int cum = __shfl(suf, L) - __shfl(tot, L); bstar = 16 * L; cgt = cum; bool found = false;
#pragma unroll
      for (int i = 7; i >= 0; --i) { const unsigned w = (unsigned)__shfl((int)hw[i], L); const int chi = (int)(w >> 16), clo = (int)(w & 0xffffu);
          if (!found && cum + chi >= TOPK) { bstar = 16 * L + 2 * i + 1; cgt = cum; found = true; } cum += found ? 0 : chi;
          if (!found && cum + clo >= TOPK) { bstar = 16 * L + 2 * i; cgt = cum; found = true; } cum += found ? 0 : clo; } }
    const int need = TOPK - cgt; int ncand = 0;
    const bool tiebin = bstar == IDX_BIN(0.0f);
    unsigned mylo = 0u, myhi = 0u;
#pragma unroll
    for (int ib = 0; ib < NK64 / 8; ++ib) if (ib < nb8) {
#pragma unroll
        for (int j = 0; j < 8; ++j) { const int i = ib * 8 + j; const int b = IDX_BIN(v[i]);
            unsigned long long bs = __ballot(b > bstar); const unsigned long long bc = __ballot(b == bstar);
            if (bc != 0ull) {
                const int pos = ncand + (int)__builtin_amdgcn_mbcnt_hi((unsigned)(bc >> 32), __builtin_amdgcn_mbcnt_lo((unsigned)bc, 0u));
                if (tiebin) bs |= __ballot(b == bstar && pos < need);
                else if (b == bstar && pos < IDX_CAP) { candv[pos] = ord_key(v[i]); candi[pos] = (unsigned)(i * 64 + lane); }
                ncand += __popcll(bc); }
            if (lane == i) { mylo = (unsigned)bs; myhi = (unsigned)(bs >> 32); } }
        SCHED_FENCE(); }
    if (lane < nb8 * 8) { mword[2 * lane] = mylo; mword[2 * lane + 1] = myhi; }
#undef IDX_BIN
    WAVE_SYNC();
    if (tiebin) { }
    else if (ncand <= IDX_CAP) {
        for (int m = lane; m < ncand; m += 64) { const unsigned vm = candv[m]; int rank = 0;
#pragma unroll 4
            for (int j = 0; j < ncand; ++j) { const unsigned vj = candv[j]; rank += (vj > vm || (vj == vm && j < m)) ? 1 : 0; }
            if (rank < need) { const unsigned idx = candi[m]; atomicOr(&mword[idx >> 5], 1u << (idx & 31)); } }
    } else {
        unsigned T = 0u;
        for (int bit = 31; bit >= 0; --bit) { const unsigned cand = T | (1u << bit); int cn = 0;
#pragma unroll
            for (int ib = 0; ib < NK64 / 8; ++ib) if (ib < nb8) {
#pragma unroll
                for (int j = 0; j < 8; ++j) cn += (ord_key(v[ib * 8 + j]) >= cand) ? 1 : 0; }
            if (wave_sum_i(cn) >= TOPK) T = cand; }
        int cg = 0;
#pragma unroll
        for (int ib = 0; ib < NK64 / 8; ++ib) if (ib < nb8) {
#pragma unroll
            for (int j = 0; j < 8; ++j) cg += (ord_key(v[ib * 8 + j]) > T) ? 1 : 0; }
        const int need2 = TOPK - wave_sum_i(cg); int taken = 0;
#pragma unroll
        for (int ib = 0; ib < NK64 / 8; ++ib) if (ib < nb8) {
#pragma unroll
            for (int j = 0; j < 8; ++j) { const int i = ib * 8 + j; const unsigned kv = ord_key(v[i]); const bool eq = kv == T; const unsigned long long be = __ballot(eq);
                const int pre = __popcll(be & ((1ull << lane) - 1ull)); const bool sel = (kv > T) || (eq && (taken + pre) < need2); taken += __popcll(be);
                const unsigned long long bs = __ballot(sel); if (lane == 0) { mword[2 * i] = (unsigned)bs; mword[2 * i + 1] = (unsigned)(bs >> 32); } } }
    }
    WAVE_SYNC();
#ifdef HOST_EMU
    if (lane == 0) { static int rows = 0, bad = 0, ties = 0, falls = 0; std::vector<int> id(nkeys); for (int i = 0; i < nkeys; ++i) id[i] = i;
        std::stable_sort(id.begin(), id.end(), [&](int a, int b) { return sc[a] > sc[b]; }); std::vector<unsigned> ref(MW, 0u); for (int i = 0; i < TOPK; ++i) ref[id[i] >> 5] |= 1u << (id[i] & 31);
        bool ok = true; for (int w = 0; w < MW; ++w) ok = ok && ref[w] == mword[w]; ++rows; bad += ok ? 0 : 1; ties += tiebin ? 1 : 0; falls += (!tiebin && ncand > IDX_CAP) ? 1 : 0;
        if ((rows & 63) == 0 || !ok) printf("[idx-check] rows %d bad %d tiebin %d fallback %d\n", rows, bad, ties, falls); }
#endif
    for (int w = lane; w < MW; w += 64) mrow[w] = mword[w];
}

constexpr int AT_KP = 72, AT_VP = 72, AT_BUF = 64 * AT_KP + 64 * AT_VP;
__device__ __forceinline__ void dsa_attn_half(KArgs C, int bl, int h, int cb, int tid, bf16* tiles, const float* btab) {
    const int lane = tid & 63, wave = tid >> 6, l31 = lane & 31, hh = lane >> 5, c = 4 * cb + (wave >> 1), qb = wave & 1, q0 = c * 64 + qb * 32, qpos = q0 + l31, q0s = __builtin_amdgcn_readfirstlane(q0);
    const size_t qrow = (size_t)bl * SEQ + qpos;
    const bf16* Qp = WSP(const bf16, WS_Q) + qrow * 512 + h * 64 + 8 * hh;
    const unsigned* Mp = WSP(const unsigned, WS_MASK) + qrow * MW;
    const bf16* gk = WSP(const bf16, WS_K) + ((size_t)bl * SEQ + (tid >> 3)) * 512 + h * 64 + (tid & 7) * 8;
    const bf16* gv = WSP(const bf16, WS_VT) + ((size_t)(bl * 8 + h) * 64 + (tid >> 3)) * SEQ + (tid & 7) * 8;
    const int lk = (tid >> 3) * AT_KP + (tid & 7) * 8, lv = 64 * AT_KP + (tid >> 3) * AT_VP + (tid & 7) * 8;
    constexpr float SC = 0.125f * 1.44269504089f;
    bf16x8_t qf[4];
#pragma unroll
    for (int s = 0; s < 4; ++s) qf[s] = *(const bf16x8_t*)(Qp + 16 * s);
    f32x16 O0, O1;
#pragma unroll
    for (int r = 0; r < 16; ++r) { O0[r] = 0.f; O1[r] = 0.f; }
    float m = -1e30f, lsum = 0.f;
    const int ntw = c + 1, nt = 4 * cb + 4;
    u32x4 prek = *(const u32x4*)gk, prev = *(const u32x4*)gv; u32x2 mwn = *(const u32x2*)Mp;
    LDS_SYNC();
    const float bfar = btab[0];
    *(u32x4*)(tiles + lk) = prek; *(u32x4*)(tiles + lv) = prev;
    if (nt > 1) { prek = *(const u32x4*)(gk + (size_t)64 * 512); prev = *(const u32x4*)(gv + 64); }
    for (int kt = 0; kt < nt; ++kt) {
        LDS_SYNC();
        const bf16* tb = tiles + (kt & 1) * AT_BUF; const u32x2 mw2 = mwn;
        if (kt + 1 < ntw) mwn = *(const u32x2*)(Mp + 2 * (kt + 1));
        if (kt < ntw) {
            f32x16 S[2];
#pragma unroll
            for (int t2 = 0; t2 < 2; ++t2) {
#pragma unroll
                for (int r = 0; r < 16; ++r) S[t2][r] = 0.f;
#pragma unroll
                for (int s = 0; s < 4; ++s) S[t2] = __builtin_amdgcn_mfma_f32_32x32x16_bf16(*(const bf16x8_t*)(tb + (t2 * 32 + l31) * AT_KP + 16 * s + 8 * hh), qf[s], S[t2], 0, 0, 0); }
#define AT_P2(P_, X0_, X1_, MW_, R_, ROW_) do { f32x2 pp_; pp_.x = __uint_as_float(__float_as_uint(__builtin_amdgcn_exp2f(X0_)) & bit_fill<ROW_>(MW_)); \
                pp_.y = __uint_as_float(__float_as_uint(__builtin_amdgcn_exp2f(X1_)) & bit_fill<ROW_ + 1>(MW_)); P_[R_] = pp_.x; P_[R_ + 1] = pp_.y; ps2 += pp_; } while (0)
#define AT_RESCALE(TM_) do { float tm_ = (TM_); tm_ = fmaxf(tm_, __shfl_xor(tm_, 32)); \
                if (__ballot(tm_ > m) != 0ull) { const float mn = fmaxf(m, tm_), alpha = __builtin_amdgcn_exp2f(m - mn); m = mn; lsum *= alpha; \
                    _Pragma("unroll") for (int r = 0; r < 16; ++r) { O0[r] *= alpha; O1[r] *= alpha; } } } while (0)
            f32x16 P[2]; f32x2 ps2 = (f32x2){0.f, 0.f}; float tm;
            const unsigned mwc0 = mw2.x >> (4 * hh), mwc1 = mw2.y >> (4 * hh);
            const bool far = (kt * 64 + 63 - q0s) <= -166;
            if (far) { float rm = fmaxf(S[0][0], S[1][0]);
#pragma unroll
                for (int r = 1; r < 16; ++r) rm = fmaxf(fmaxf(rm, S[0][r]), S[1][r]);
                tm = rm * SC + bfar;
            } else { tm = -1e30f;
#pragma unroll
                for (int t2 = 0; t2 < 2; ++t2) { const int rb = kt * 64 + t2 * 32 + 4 * hh - qpos + 256;
#pragma unroll
                    for (int r = 0; r < 16; ++r) { const int row = (r & 3) + 8 * (r >> 2); int ti = rb + row; ti = ti < 0 ? 0 : ti; tm = fmaxf(tm, S[t2][r] * SC + btab[ti]); } } }
            AT_RESCALE(tm);
            if (far) { const float ad = bfar - m;
#define AT_FAR(R_, ROW_) do { const f32x2 x0_ = (f32x2){S[0][R_], S[0][R_ + 1]} * SC + ad, x1_ = (f32x2){S[1][R_], S[1][R_ + 1]} * SC + ad; \
                    AT_P2(P[0], x0_.x, x0_.y, mwc0, R_, ROW_); AT_P2(P[1], x1_.x, x1_.y, mwc1, R_, ROW_); } while (0)
                AT_FAR(0, 0); AT_FAR(2, 2); AT_FAR(4, 8); AT_FAR(6, 10); AT_FAR(8, 16); AT_FAR(10, 18); AT_FAR(12, 24); AT_FAR(14, 26);
#undef AT_FAR
            } else {
#define AT_BIAS(T2_, R_, ROW_) (S[T2_][R_] * SC + (btab[imax0(kt * 64 + (T2_) * 32 + 4 * hh - qpos + 256 + (ROW_))] - m))
#define AT_NEAR(R_, ROW_) do { AT_P2(P[0], AT_BIAS(0, R_, ROW_), AT_BIAS(0, R_ + 1, ROW_ + 1), mwc0, R_, ROW_); AT_P2(P[1], AT_BIAS(1, R_, ROW_), AT_BIAS(1, R_ + 1, ROW_ + 1), mwc1, R_, ROW_); } while (0)
                AT_NEAR(0, 0); AT_NEAR(2, 2); AT_NEAR(4, 8); AT_NEAR(6, 10); AT_NEAR(8, 16); AT_NEAR(10, 18); AT_NEAR(12, 24); AT_NEAR(14, 26);
#undef AT_BIAS
#undef AT_NEAR
            }
#undef AT_P2
#undef AT_RESCALE
            const float ps = ps2.x + ps2.y;
            lsum += ps;
#pragma unroll
            for (int t2 = 0; t2 < 2; ++t2) { const bf16* vb = tb + 64 * AT_KP + l31 * AT_VP + t2 * 32 + 4 * hh;
#pragma unroll
                for (int s = 0; s < 2; ++s) { u32x4 w; w.x = pk2(P[t2][8 * s + 0], P[t2][8 * s + 1]); w.y = pk2(P[t2][8 * s + 2], P[t2][8 * s + 3]); w.z = pk2(P[t2][8 * s + 4], P[t2][8 * s + 5]); w.w = pk2(P[t2][8 * s + 6], P[t2][8 * s + 7]);
                    const bf16x8_t pf = __builtin_bit_cast(bf16x8_t, w);
                    O0 = __builtin_amdgcn_mfma_f32_32x32x16_bf16(frag2(*(const u32x2*)(vb + 16 * s), *(const u32x2*)(vb + 16 * s + 8)), pf, O0, 0, 0, 0);
                    O1 = __builtin_amdgcn_mfma_f32_32x32x16_bf16(frag2(*(const u32x2*)(vb + 32 * AT_VP + 16 * s), *(const u32x2*)(vb + 32 * AT_VP + 16 * s + 8)), pf, O1, 0, 0, 0); } }
        }
        if (kt + 1 < nt) { bf16* nb = tiles + ((kt + 1) & 1) * AT_BUF; *(u32x4*)(nb + lk) = prek; *(u32x4*)(nb + lv) = prev;
            if (kt + 2 < nt) { prek = *(const u32x4*)(gk + (size_t)(kt + 2) * 64 * 512); prev = *(const u32x4*)(gv + (size_t)(kt + 2) * 64); } }
    }
    lsum += __shfl_xor(lsum, 32);
    const float inv = 1.0f / lsum;
    bf16* Y = WSP(bf16, WS_Y) + (size_t)MG * 512 + qrow * 512 + h * 64 + 4 * hh;
#pragma unroll
    for (int g = 0; g < 4; ++g) { u32x2 w; w.x = pk2(O0[4 * g] * inv, O0[4 * g + 1] * inv); w.y = pk2(O0[4 * g + 2] * inv, O0[4 * g + 3] * inv); *(u32x2*)(Y + 8 * g) = w;
        u32x2 w2; w2.x = pk2(O1[4 * g] * inv, O1[4 * g + 1] * inv); w2.y = pk2(O1[4 * g + 2] * inv, O1[4 * g + 3] * inv); *(u32x2*)(Y + 32 + 8 * g) = w2; }
}
__device__ __forceinline__ void dsa_attn_unit3(KArgs C, int unit, int tid, unsigned char* lds) {
    constexpr int NPAIR = NK64 / 8;
    const int pr = unit % NPAIR, h = (unit / NPAIR) & 7, bl = unit / (NPAIR * 8);
    float* btab = (float*)lds; bf16* tiles = (bf16*)(lds + 2048);
    __syncthreads();
    { const int* tab = WSP(const int, WS_TAB); const float* relb = C->in[I_RELB];
      if (tid < 320) btab[tid] = relb[tab[tid - 256 + SEQ - 1] * 8 + h] * 1.44269504089f; }
    dsa_attn_half(C, bl, h, pr, tid, tiles, btab);
    dsa_attn_half(C, bl, h, NK64 / 4 - 1 - pr, tid, tiles, btab);
}
#ifndef GP_ALIGN
#define GP_ALIGN true
#endif
#ifndef GP_SP2
#define GP_SP2 true
#endif
constexpr int SEGS_PER_GROUP = 11, NSEG = DEPTH * (1 + NGRP * SEGS_PER_GROUP) + 1;

#ifdef HOST_EMU
#define GRID_BARRIER() emu_grid_sync()
#define LDS_PTR(p) ((unsigned char*)(p))
#else
#define GRID_BARRIER() do { XcdBarrier b_; b_.bar = (unsigned*)(Ck->ws + WS_CTL); b_.x = xb_xcc_id(); b_.st = (volatile LAS unsigned*)(lds + LDS_CTL_OFF); xcd_barrier(b_); } while (0)
#define LDS_PTR(p) ((PG8_LAS unsigned char*)(p))
#endif

__global__ void __launch_bounds__(NTHREADS, 2) fwd_kernel(Args a) {
#ifdef HOST_EMU
    unsigned char* lds = emu_lds;
#else
    extern __shared__ __attribute__((aligned(16))) unsigned char lds[];
#endif
#ifdef HOST_EMU
    KArgs Ck = &a;
#else
    KArgs Ck = (KArgs)__builtin_amdgcn_kernarg_segment_ptr();
    (void)a;
#endif
#ifndef HOST_EMU
    if (threadIdx.x < 4) ((LAS unsigned*)(lds + LDS_CTL_OFF))[threadIdx.x] = 0u;
    __syncthreads();
    if (Ck->seg_hi - Ck->seg_lo > 1) (void)xcd_barrier_post((unsigned*)(Ck->ws + WS_CTL), (volatile LAS unsigned*)(lds + LDS_CTL_OFF));
#endif
#define SEGID 0
#define RUN (SEGID >= Ck->seg_lo && SEGID < Ck->seg_hi)
#define SEAM do { if (SEGID >= Ck->seg_lo && SEGID + 1 < Ck->seg_hi) { GRID_BARRIER(); } } while (0)
#define WO ((layer & 1) ? WDELTA : (size_t)0)
#define PHASE_VARS KArgs C = KLAUNDER(Ck); const int G = gridDim.x, bx = blockIdx.x, ngw = G * NWAVES; (void)ngw; const int tid = fresh_tid(), lane = tid & 63, wave = __builtin_amdgcn_readfirstlane(tid >> 6), gw = bx * NWAVES + wave; (void)lane; (void)gw; (void)C
    for (int layer = 0; layer < DEPTH; ++layer) {
#undef SEGID
#define SEGID (layer * (1 + NGRP * SEGS_PER_GROUP))
        if (RUN) { PHASE_VARS; phase_weights(C, layer, lds, gw, ngw, lane, wave); }
        SEAM;
        for (int grp = 0; grp < NGRP; ++grp) {
#define XIN ((layer == 0 ? C->in[I_X] : (const float*)C->out) + (size_t)grp * MG * D)
#define XOUT (C->out + (size_t)grp * MG * D)
#undef SEGID
#define SEGID (layer * (1 + NGRP * SEGS_PER_GROUP) + 1 + grp * SEGS_PER_GROUP + 0)
            if (RUN) { PHASE_VARS; for (int m = gw; m < MG; m += 2 * ngw) { if (m + ngw < MG) rms_rowN_bf16<2>(XIN + (size_t)m * D, C->in[I_NMIX] + layer * D, WSP(bf16, WS_H) + (size_t)m * D, (size_t)ngw * D, lane); else rms_row_bf16(XIN + (size_t)m * D, C->in[I_NMIX] + layer * D, WSP(bf16, WS_H) + (size_t)m * D, lane); } }
            SEAM;
#undef SEGID
#define SEGID (layer * (1 + NGRP * SEGS_PER_GROUP) + 1 + grp * SEGS_PER_GROUP + 1)
            if (RUN) { PHASE_VARS; pg8::Gemm g{WSP(const bf16, WS_H), WSP(const bf16, WS_WIN + WO), MG, NMIXC, D}; pg8::StaticOrder S; S.init(MG, NMIXC, G, bx);
                pg8::EpiProj E{C->ws};
                pg8::gemm_phase<pg8::EpiProj, pg8::StaticOrder, false, GP_ALIGN, GP_SP2>(LDS_PTR(lds), g, S, E, nullptr); }
            SEAM;
#undef SEGID
#define SEGID (layer * (1 + NGRP * SEGS_PER_GROUP) + 1 + grp * SEGS_PER_GROUP + 2)
            if (RUN) { PHASE_VARS;
                for (int m = gw; m < MG; m += 2 * ngw) { if (m + ngw < MG) { rwkv_prep_row2(C, layer, m, ngw, lane); ssd_conv_row2(C, layer, m, ngw, lane); } else { rwkv_prep_row(C, layer, m, lane); ssd_conv_row(C, layer, m, lane); } }
                for (int it = gw; it < NB * 8 * NK64; it += ngw) dsa_vt_item(C, it, lane, (bf16*)(lds + wave * 16384));
                __syncthreads();
                for (int u = bx; u < NB * NK64 * 8; u += G) dsa_index_unit(C, u, lane, wave, lds);
            }
            SEAM;
#undef SEGID
#define SEGID (layer * (1 + NGRP * SEGS_PER_GROUP) + 1 + grp * SEGS_PER_GROUP + 3)
            if (RUN) { PHASE_VARS; pg8::Gemm g{WSP(const bf16, WS_RA), WSP(const bf16, WS_WLORA + WO), MG, 1536, 256}; pg8::StaticOrder S; S.init(MG, 1536, G, bx);
                pg8::EpiLora E{WSP(float, WS_WLOG), WSP(bf16, WS_ASIG), WSP(bf16, WS_GG), C->in[I_W0] + layer * 512, C->in[I_A0] + layer * 512};
                pg8::gemm_phase<pg8::EpiLora, pg8::StaticOrder, false, GP_ALIGN, GP_SP2>(LDS_PTR(lds), g, S, E, nullptr); }
            SEAM;
#undef SEGID
#define SEGID (layer * (1 + NGRP * SEGS_PER_GROUP) + 1 + grp * SEGS_PER_GROUP + 4)
            if (RUN) { PHASE_VARS;
                constexpr int U_R = NB * 8, U_S = U_R + NB * 8;
                for (int u = bx; u < U_R; u += G) rwkv_unit(C, layer, u, lds);
                for (int u = (bx + G - U_R % G) % G; u < NB * 8; u += G) ssd_unit(C, layer, u, lds);
                { const int first = U_S % G, span = G - first;
                  if (bx >= first) for (int u = bx - first; u < NB * 32; u += span) s5_unit(C, layer, u, lds); }
                for (;;) {
                    const int t2 = fresh_tid();
                    volatile unsigned* qs2 = (volatile unsigned*)(lds + LDS_CTL_OFF + 32);
                    __syncthreads();
                    if (t2 == 0) *qs2 = atomicAdd((unsigned*)(Ck->ws + WS_QCTR) + ((layer * NGRP + grp) * 2) * 64, 1u);
                    __syncthreads();
                    const int u = (int)*qs2;
                    if (u >= NB * NK64) break;
                    dsa_attn_unit3(KLAUNDER(Ck), u, t2, lds);
                }
            }
            SEAM;
#undef SEGID
#define SEGID (layer * (1 + NGRP * SEGS_PER_GROUP) + 1 + grp * SEGS_PER_GROUP + 5)
            if (RUN) { PHASE_VARS;
                { pg8::Gemm g{WSP(const bf16, WS_H), WSP(const bf16, WS_WIN + WO) + (size_t)NMIXC * D, MG, 4096, D}; pg8::StaticOrder S; S.init(MG, 4096, G, bx);
                  pg8::EpiGate E{WSP(bf16, WS_G)}; pg8::gemm_phase<pg8::EpiGate, pg8::StaticOrder, false, GP_ALIGN, GP_SP2>(LDS_PTR(lds), g, S, E, nullptr); }
                { pg8::Gemm g{WSP(const bf16, WS_YD0), WSP(const bf16, WS_GLU + WO), MG, 512, 512}; pg8::StaticOrder S; S.init(MG, 512, G, bx);
                  pg8::EpiGlu E{WSP(const bf16, WS_YD0), WSP(bf16, WS_Y) + (size_t)3 * MG * 512, C->in[I_GLUB] + layer * 512};
                  pg8::gemm_phase<pg8::EpiGlu, pg8::StaticOrder, false, GP_ALIGN, GP_SP2>(LDS_PTR(lds), g, S, E, nullptr); }
                for (int it = gw; it < MG * 2; it += 4 * ngw) ssd_norm_item4(C, layer, it, ngw, MG * 2, lane);
            }
            SEAM;
#undef SEGID
#define SEGID (layer * (1 + NGRP * SEGS_PER_GROUP) + 1 + grp * SEGS_PER_GROUP + 6)
            if (RUN) { PHASE_VARS; pg8::Gemm g{WSP(const bf16, WS_Y), WSP(const bf16, WS_WB + WO), 4 * MG, 4096, 512}; pg8::MergeOrder S{G, bx};
                pg8::EpiMerge E{WSP(const bf16, WS_G), WSP(bf16, WS_MRG)};
                pg8::gemm_phase<pg8::EpiMerge, pg8::MergeOrder, false, GP_ALIGN, GP_SP2>(LDS_PTR(lds), g, S, E, nullptr); }
            SEAM;
#undef SEGID
#define SEGID (layer * (1 + NGRP * SEGS_PER_GROUP) + 1 + grp * SEGS_PER_GROUP + 7)
            if (RUN) { PHASE_VARS; pg8::Gemm g{WSP(const bf16, WS_MRG), WSP(const bf16, WS_WOUT + WO), MG, D, D}; pg8::StaticOrder S; S.init(MG, D, G, bx);
                pg8::EpiResid E{XIN, XOUT}; pg8::gemm_phase<pg8::EpiResid, pg8::StaticOrder, false, GP_ALIGN, GP_SP2>(LDS_PTR(lds), g, S, E, nullptr); }
            SEAM;
#undef SEGID
#define SEGID (layer * (1 + NGRP * SEGS_PER_GROUP) + 1 + grp * SEGS_PER_GROUP + 8)
            if (RUN) { PHASE_VARS; for (int m = gw; m < MG; m += 2 * ngw) { if (m + ngw < MG) rms_rowN_bf16<2>(XOUT + (size_t)m * D, C->in[I_NFFN] + layer * D, WSP(bf16, WS_H) + (size_t)m * D, (size_t)ngw * D, lane); else rms_row_bf16(XOUT + (size_t)m * D, C->in[I_NFFN] + layer * D, WSP(bf16, WS_H) + (size_t)m * D, lane); } }
            SEAM;
#undef SEGID
#define SEGID (layer * (1 + NGRP * SEGS_PER_GROUP) + 1 + grp * SEGS_PER_GROUP + 9)
            if (RUN) { PHASE_VARS; pg8::Gemm g{WSP(const bf16, WS_H), WSP(const bf16, WS_W13 + WO), MG, 5632, D}; pg8::StaticOrder S; S.init(MG, 5632, G, bx);
                pg8::EpiSwiglu E{WSP(bf16, WS_HID)};
                pg8::gemm_phase<pg8::EpiSwiglu, pg8::StaticOrder, false, GP_ALIGN, GP_SP2>(LDS_PTR(lds), g, S, E, nullptr); }
            SEAM;
#undef SEGID
#define SEGID (layer * (1 + NGRP * SEGS_PER_GROUP) + 1 + grp * SEGS_PER_GROUP + 10)
            if (RUN) { PHASE_VARS; pg8::Gemm g{WSP(const bf16, WS_HID), WSP(const bf16, WS_W2 + WO), MG, D, FFN}; pg8::StaticOrder S; S.init(MG, D, G, bx);
                pg8::EpiResid E{XOUT, XOUT}; pg8::gemm_phase<pg8::EpiResid, pg8::StaticOrder, false, GP_ALIGN, GP_SP2>(LDS_PTR(lds), g, S, E, nullptr); }
            SEAM;
        }
    }
#undef SEGID
#define SEGID (NSEG - 1)
    { const int layer = 0; (void)layer;
    if (RUN) { PHASE_VARS; for (int m = gw; m < M; m += 2 * ngw) { if (m + ngw < M) rms_row2_f32(C->out + (size_t)m * D, (size_t)ngw * D, C->in[I_NFIN], lane); else rms_row_f32(C->out + (size_t)m * D, C->in[I_NFIN], lane); } } }
#undef RUN
#undef SEAM
}

extern "C" void kernel_launch(void* const* d_in, const int* in_sizes, int n_in, void* d_out, int out_size, void* d_ws, size_t ws_size, hipStream_t stream) {
    static int grid = 0;
    if (grid == 0) {
        if (n_in != N_IN || out_size != M * D || ws_size < WS_END) { fprintf(stderr, "kernel_launch: unexpected shapes (n_in %d, out %d, ws %zu < %zu)\n", n_in, out_size, ws_size, (size_t)WS_END); grid = -1; return; }
        int dev = 0, cus = 0;
        if (hipGetDevice(&dev) != hipSuccess || hipDeviceGetAttribute(&cus, hipDeviceAttributeMultiprocessorCount, dev) != hipSuccess || cus < 1) { grid = -1; return; }
        if (hipFuncSetAttribute((const void*)fwd_kernel, hipFuncAttributeMaxDynamicSharedMemorySize, LDS_BYTES) != hipSuccess) { fprintf(stderr, "kernel_launch: hipFuncSetAttribute failed\n"); grid = -1; return; }
        (void)hipGetLastError();
        grid = cus;
    }
    if (grid < 0) return;
    (void)hipMemsetAsync((char*)d_ws + WS_CTL, 0, CTL_BYTES, stream);
    Args a{};
    for (int i = 0; i < N_IN; ++i) a.in[i] = (const float*)d_in[i];
    a.out = (float*)d_out; a.ws = (unsigned char*)d_ws;
#if CFG_LAUNCHES == 1
    a.seg_lo = 0; a.seg_hi = NSEG;
    hipLaunchKernelGGL(fwd_kernel, dim3(grid), dim3(NTHREADS), LDS_BYTES, stream, a);
#else
    for (int s = 0; s < NSEG; ++s) { a.seg_lo = s; a.seg_hi = s + 1; hipLaunchKernelGGL(fwd_kernel, dim3(grid), dim3(NTHREADS), LDS_BYTES, stream, a); }
#endif
}
```

```cpp
#ifdef HOST_EMU
#error "HOST_EMU is a host-only debug build"
#else
#include <hip/hip_runtime.h>
#endif
#include <cstdio>
#include <cstdint>
#include <cmath>

#ifndef CFG_BATCH
#define CFG_BATCH 16
#endif
#ifndef CFG_SEQ
#define CFG_SEQ 4096
#endif
#ifndef CFG_DEPTH
#define CFG_DEPTH 4
#endif
#ifndef CFG_NB
#define CFG_NB 8
#endif
#ifndef CFG_LAUNCHES
#define CFG_LAUNCHES 1
#endif

typedef unsigned short bf16;
typedef float f32x4 __attribute__((ext_vector_type(4)));
typedef float f32x2 __attribute__((ext_vector_type(2)));
typedef unsigned u32x4 __attribute__((ext_vector_type(4)));
typedef unsigned u32x2 __attribute__((ext_vector_type(2)));

constexpr int BATCH = CFG_BATCH, SEQ = CFG_SEQ, DEPTH = CFG_DEPTH, NB = CFG_NB;
constexpr int D = 1024, M = BATCH * SEQ, MG = NB * SEQ, NGRP = BATCH / NB;
constexpr int IN_COLS = 9388, NPROJ = 9472, NMIXC = 5376, FFN = 2816;
constexpr int TOPK = (SEQ / 4) < 256 ? (SEQ / 4) : 256;
constexpr int NK64 = SEQ / 64, MW = SEQ / 32;
constexpr float RMS_EPS = 1e-6f, GN_EPS = 64e-5f;
static_assert(BATCH % NB == 0 && MG % 256 == 0 && SEQ % 64 == 0, "shape");

enum { I_X = 0, I_RELB, I_NMIX, I_WIN, I_CONVW, I_CONVB, I_DTB, I_ALOG, I_SSDD, I_SSDNG, I_MU, I_W0, I_W2, I_A0, I_A2, I_G2, I_KK, I_KA, I_RK, I_LNG, I_LNB,
       I_S5ARE, I_S5AIM, I_S5BRE, I_S5BIM, I_S5CRE, I_S5CIM, I_S5D, I_S5LDT, I_GLUW, I_GLUB, I_WBR, I_WOUT, I_NFFN, I_W1, I_W3, I_W2F, I_NFIN, N_IN };

constexpr size_t MiB = 1u << 20;
constexpr size_t al256(size_t x) { return (x + 255) & ~(size_t)255; }
constexpr size_t WS_CTL = 0, CTL_BYTES = 64 * 1024;
constexpr size_t WS_TAB = WS_CTL + CTL_BYTES;
constexpr size_t WS_ABAR = al256(WS_TAB + (SEQ + 64) * 4);
constexpr size_t WS_BBAR = WS_ABAR + 32 * 64 * 2 * 4;
constexpr size_t WS_WIN = al256(WS_BBAR + 32 * 64 * 16 * 2 * 4);
constexpr size_t WS_WB = WS_WIN + (size_t)NPROJ * 1024 * 2;
constexpr size_t WS_WOUT = WS_WB + (size_t)4 * 1024 * 512 * 2;
constexpr size_t WS_W13 = WS_WOUT + (size_t)1024 * 1024 * 2;
constexpr size_t WS_W2 = WS_W13 + (size_t)5632 * 1024 * 2;
constexpr size_t WS_GLU = WS_W2 + (size_t)1024 * 2816 * 2;
constexpr size_t WS_WLORA = WS_GLU + (size_t)512 * 512 * 2;
constexpr size_t WS_H = al256(WS_WLORA + (size_t)1536 * 256 * 2);
constexpr size_t WS_Z = WS_H + (size_t)MG * 1024 * 2;
constexpr size_t WS_XBC = WS_Z + (size_t)MG * 512 * 2;
constexpr size_t WS_Q = WS_XBC + (size_t)MG * 768 * 2;
constexpr size_t WS_K = WS_Q + (size_t)MG * 512 * 2;
constexpr size_t WS_V = WS_K + (size_t)MG * 512 * 2;
constexpr size_t WS_RW = WS_V + (size_t)MG * 512 * 2;
constexpr size_t WS_U = WS_RW + (size_t)MG * 1792 * 2;
constexpr size_t WS_SM = WS_U + (size_t)MG * 512 * 2;
constexpr size_t WS_G = WS_Q;
constexpr size_t WS_Y = WS_SM + (size_t)MG * 256 * 2;
constexpr size_t WS_YD0 = WS_Y + (size_t)4 * MG * 512 * 2;
constexpr size_t WS_MRG = WS_YD0 + (size_t)MG * 512 * 2;
constexpr size_t WS_MASK = WS_MRG + (size_t)MG * 1024 * 2;
constexpr size_t WS_RA = WS_MASK + (size_t)MG * MW * 4;
constexpr size_t WS_WLOG = WS_RA + (size_t)MG * 256 * 2;
constexpr size_t WS_ASIG = WS_WLOG + (size_t)MG * 512 * 4;
constexpr size_t WS_GG = WS_ASIG + (size_t)MG * 512 * 2;
constexpr size_t WS_XBA = WS_GG + (size_t)MG * 512 * 2;
constexpr size_t WS_VT = WS_XBA + (size_t)MG * 768 * 2;
constexpr size_t WS_KI = WS_VT + (size_t)MG * 512 * 2;
constexpr size_t WS_QCTR = 16384;
constexpr size_t WS_HID = WS_G;
constexpr size_t WS_WALT = al256(WS_KI + (size_t)MG * 32 * 2);
constexpr size_t WDELTA = WS_WALT - WS_ABAR;
constexpr size_t WS_END = WS_WALT + (WS_H - WS_ABAR);
static_assert(WS_SM + (size_t)MG * 256 * 2 - WS_Q == (size_t)MG * 4096 * 2, "G overlays exactly Q..SM");
static_assert((size_t)MG * 2816 * 2 <= (size_t)MG * 4096 * 2, "HID fits in G");

constexpr int LDS_SCRATCH = 131072;
constexpr int LDS_CTL_OFF = LDS_SCRATCH;
constexpr int LDS_X = LDS_SCRATCH + 64;
constexpr int LDS_BYTES = 161792;
constexpr int NTHREADS = 512, NWAVES = 8;

__device__ __forceinline__ float bf2f(bf16 v) { return __uint_as_float(((unsigned)v) << 16); }
#ifdef HOST_EMU
__device__ __forceinline__ bf16 f2bf(float f) { unsigned u = __float_as_uint(f); u += 0x7fffu + ((u >> 16) & 1u); return (bf16)(u >> 16); }
#else
__device__ __forceinline__ bf16 f2bf(float f) { return __builtin_bit_cast(bf16, (__bf16)f); }
#endif
#ifdef HOST_EMU
__device__ __forceinline__ unsigned pk2(float lo, float hi) { return (unsigned)f2bf(lo) | ((unsigned)f2bf(hi) << 16); }
#else
typedef __bf16 bf16x2_hw __attribute__((ext_vector_type(2)));
__device__ __forceinline__ unsigned pk2(float lo, float hi) { const f32x2 v = {lo, hi}; return __builtin_bit_cast(unsigned, __builtin_convertvector(v, bf16x2_hw)); }
#endif
__device__ __forceinline__ float lo_bf(unsigned w) { return __uint_as_float(w << 16); }
__device__ __forceinline__ float hi_bf(unsigned w) { return __uint_as_float(w & 0xffff0000u); }
#ifndef HOST_EMU
__device__ __forceinline__ float sigm(float x) { return __builtin_amdgcn_rcpf(1.0f + __expf(-x)); }
#else
__device__ __forceinline__ float sigm(float x) { return 1.0f / (1.0f + __expf(-x)); }
#endif
#ifndef HOST_EMU
template <int BIT> __device__ __forceinline__ unsigned bit_fill(unsigned w) { unsigned r; asm("v_bfe_i32 %0, %1, %2, 1" : "=v"(r) : "v"(w), "n"(BIT)); return r; }
#else
template <int BIT> __device__ __forceinline__ unsigned bit_fill(unsigned w) { return ((w >> BIT) & 1u) ? 0xffffffffu : 0u; }
#endif
__device__ __forceinline__ int imax0(int v) { return v < 0 ? 0 : v; }
__device__ __forceinline__ float tanh_fast(float x) { return 2.0f * sigm(2.0f * x) - 1.0f; }
__device__ __forceinline__ float softplusf(float x) { return x > 20.f ? x : log1pf(__expf(x)); }
__device__ __forceinline__ float gelu_tanh(float x) { const float u = 0.7978845608f * (x + 0.044715f * x * x * x); return x * sigm(2.0f * u); }
__device__ __forceinline__ float wave_sum(float v) {
#pragma unroll
    for (int o = 1; o < 64; o <<= 1) v += __shfl_xor(v, o);
    return v;
}
__device__ __forceinline__ float wave_max(float v) {
#pragma unroll
    for (int o = 1; o < 64; o <<= 1) v = fmaxf(v, __shfl_xor(v, o));
    return v;
}
__device__ __forceinline__ int wave_sum_i(int v) {
#pragma unroll
    for (int o = 1; o < 64; o <<= 1) v += __shfl_xor(v, o);
    return v;
}
#ifdef HOST_EMU
#define WAVE_SYNC() (void)emu_wave_exchange(0)
#define SCHED_FENCE() do {} while (0)
#define LDS_SYNC() __syncthreads()
#else
#define WAVE_SYNC() __builtin_amdgcn_wave_barrier()
#define SCHED_FENCE() __builtin_amdgcn_sched_barrier(0)
#define LDS_SYNC() do { asm volatile("s_waitcnt lgkmcnt(0)" ::: "memory"); __builtin_amdgcn_s_barrier(); asm volatile("" ::: "memory"); } while (0)
#endif
#ifndef HOST_EMU
namespace pg8 {
__device__ __forceinline__ int pg8_fresh_tid() { int t = (int)threadIdx.x; asm volatile("" : "+v"(t)); return t; }
#define PG8_LAS __attribute__((address_space(3)))
typedef unsigned short bf16_t;
typedef short bf16x8 __attribute__((ext_vector_type(8)));
typedef float f32x4 __attribute__((ext_vector_type(4)));
typedef unsigned u32x4 __attribute__((ext_vector_type(4)));
constexpr int BM = 256, BK = 64, HALF = 128, HTB = HALF * BK * 2  , STAGE_BYTES = 8 * HTB, NXCD = 8, WGM = 8;

__host__ __device__ __forceinline__ int lds_byte(int r, int c) { const int st = (r >> 4) * 2 + (c >> 5), rr = r & 15, cc = c & 31, ob = rr * 64 + cc * 2; return st * 1024 + (ob ^ (((ob >> 9) & 1) << 5)); }
__host__ __device__ __forceinline__ void stage_rc(int b, int& R, int& C) { const int st = b / 1024, sb = b % 1024, swz = sb ^ (((sb >> 9) & 1) << 5); R = (st >> 1) * 16 + swz / 64; C = (st & 1) * 32 + (swz % 64) / 2; }
__host__ __device__ __forceinline__ int perm32(int rho) { const int n = rho >> 4, i = rho & 15; return 8 * (i >> 2) + 4 * n + (i & 3); }

struct Unit { int pm, pn; };
struct Gemm { const bf16_t* A; const bf16_t* Bt; int M, N, K; };

struct StaticOrder {
    int nM, nN, nwg, G, c;
    __host__ __device__ void init(int M, int N, int G_, int c_) { nM = M / BM; nN = N / BM; nwg = nM * nN; G = G_; c = c_; }
    __host__ __device__ bool next(int i, Unit& u) const {
        const long L = (long)i * G + c; if (L >= nwg) return false;
        int wgid = (int)L; { const int q = nwg / NXCD, r = nwg % NXCD, xcd = wgid % NXCD, off = wgid / NXCD; wgid = (xcd < r ? xcd * (q + 1) : r * (q + 1) + (xcd - r) * q) + off; }
        const int nig = WGM * nN, gid = wgid / nig, fm = gid * WGM, gsz = (nM - fm) < WGM ? (nM - fm) : WGM;
        u.pm = fm + ((wgid % nig) % gsz); u.pn = (wgid % nig) / gsz; return true;
    }
    __device__ __forceinline__ void a_ready(const Unit&) const {}
    __device__ __forceinline__ void done(const Unit&) const {}
};

__device__ __forceinline__ unsigned cvt_pk_bf16(float lo, float hi) { return pk2(lo, hi); }

template <class E, class = void> struct epi_keep { static constexpr bool value = false; };
template <class E> struct epi_keep<E, decltype((void)E::KEEP_ACC)> { static constexpr bool value = true; };
template <class Epi, class Sched, bool STAMP = false, bool ALIGN_EPI = false, bool SP2 = false>
__device__ __forceinline__ void gemm_phase(PG8_LAS unsigned char* lds, const Gemm g, const Sched& S, const Epi& E, unsigned long long* stamps) {
    const int tid = pg8_fresh_tid(), wid = __builtin_amdgcn_readfirstlane(tid >> 6), lane = tid & 63, wr = wid >> 2, wc = wid & 3, fr = lane & 15, fq = lane >> 4;
    int K_ = g.K; asm volatile("" : "+s"(K_));
    const int K = K_, nt = K / BK;
    int ts_lo = 0, ts_hi = 0, nts = 0; const unsigned long long rt_entry = STAMP ? (unsigned long long)wall_clock64() : 0ull;
#define PG8_STAMP() do { if (STAMP && wid == 0 && nts < 64) { const unsigned long long _c = (unsigned long long)clock64(); \
        ts_lo = (lane == nts) ? (int)(unsigned)_c : ts_lo; ts_hi = (lane == nts) ? (int)(unsigned)(_c >> 32) : ts_hi; ++nts; } } while (0)
    PG8_STAMP();
    unsigned voffA[2], voffB[2];
#pragma unroll
    for (int i = 0; i < 2; ++i) { int R, C; stage_rc(tid * 16 + i * 8192, R, C); const int Rb = Epi::PERM ? ((R & ~31) + perm32(R & 31)) : R;
        voffA[i] = (unsigned)(R * K + C) * 2u; voffB[i] = (unsigned)(Rb * K + C) * 2u; }
    const size_t kstep = (size_t)(BK * 2);
    const size_t hstep = (size_t)HALF * K * 2;
    const size_t tstep = 2 * hstep;
    const unsigned ldsw = (unsigned)wid * 1024u;
    const int aoff = lds_byte(wr * 64 + fr, fq * 8), boff = lds_byte(wc * 32 + fr, fq * 8);
#define PG8_SA(b, h) (((b) * 2 + (h)) * HTB)
#define PG8_SB(b, h) ((4 + (b) * 2 + (h)) * HTB)
#define PG8_STAGE(bufoff, gbase, voff) do { _Pragma("unroll") for (int _i = 0; _i < 2; ++_i) \
        __builtin_amdgcn_global_load_lds((const unsigned*)((const char*)(gbase) + (voff)[_i]), (PG8_LAS unsigned*)(lds + (bufoff) + ldsw + _i * 8192), 16, 0, 0); } while (0)
#define PG8_LDA(dst, b, h) do { _Pragma("unroll") for (int m = 0; m < 4; ++m) _Pragma("unroll") for (int k = 0; k < 2; ++k) dst[m][k] = *(const PG8_LAS bf16x8*)(lds + PG8_SA(b, h) + aoff + m * 2048 + k * 1024); } while (0)
#define PG8_LDB(dst, b, h) do { _Pragma("unroll") for (int n = 0; n < 2; ++n) _Pragma("unroll") for (int k = 0; k < 2; ++k) dst[n][k] = *(const PG8_LAS bf16x8*)(lds + PG8_SB(b, h) + boff + n * 2048 + k * 1024); } while (0)
#define PG8_MMA(ai, bj, At, Bt) do { __builtin_amdgcn_s_setprio(1); _Pragma("unroll") for (int m = 0; m < 4; ++m) _Pragma("unroll") for (int n = 0; n < 2; ++n) _Pragma("unroll") for (int k = 0; k < 2; ++k) \
        acc[ai][bj][m][n] = __builtin_amdgcn_mfma_f32_16x16x32_bf16(Bt[n][k], At[m][k], acc[ai][bj][m][n], 0, 0, 0); __builtin_amdgcn_s_setprio(0); } while (0)
#define PG8_WAIT_V(n) asm volatile("s_waitcnt vmcnt(" #n ")" ::: "memory")
#define PG8_WAIT_L(n) asm volatile("s_waitcnt lgkmcnt(" #n ")" ::: "memory")
#define PG8_BAR __builtin_amdgcn_s_barrier()
#define PG8_SCHED __builtin_amdgcn_sched_barrier(0)
    Unit cur, nxt; int ui = 0;
    if (!S.next(0, cur)) return;
    f32x4 acc[2][2][4][2];
#pragma unroll
    for (int a = 0; a < 2; ++a)
#pragma unroll
        for (int b = 0; b < 2; ++b)
#pragma unroll
            for (int m = 0; m < 4; ++m)
#pragma unroll
                for (int n = 0; n < 2; ++n) acc[a][b][m][n] = (f32x4){0.f, 0.f, 0.f, 0.f};
    bf16x8 At[4][2], B0[2][2], B1[2][2];
    const char* cA = (const char*)g.A + (size_t)cur.pm * tstep; const char* cB = (const char*)g.Bt + (size_t)cur.pn * tstep;
    S.a_ready(cur);
    if constexpr (SP2) {
        PG8_STAGE(PG8_SB(0, 0), cB, voffB); PG8_STAGE(PG8_SB(0, 1), cB + hstep, voffB); PG8_STAGE(PG8_SA(0, 0), cA, voffA); PG8_STAGE(PG8_SA(0, 1), cA + hstep, voffA);
        if (wr == 1) PG8_BAR;
        PG8_WAIT_V(2); PG8_BAR;
        PG8_STAGE(PG8_SB(1, 0), cB + kstep, voffB); PG8_STAGE(PG8_SA(1, 0), cA + kstep, voffA); PG8_STAGE(PG8_SB(1, 1), cB + hstep + kstep, voffB);
        PG8_WAIT_V(6); PG8_BAR;
    } else {
    PG8_STAGE(PG8_SB(0, 0), cB, voffB); PG8_STAGE(PG8_SA(0, 0), cA, voffA); PG8_STAGE(PG8_SB(0, 1), cB + hstep, voffB); PG8_STAGE(PG8_SA(0, 1), cA + hstep, voffA);
    if (wr == 1) PG8_BAR;
    PG8_WAIT_V(4); PG8_BAR;
    PG8_STAGE(PG8_SB(1, 0), cB + kstep, voffB); PG8_STAGE(PG8_SA(1, 0), cA + kstep, voffA); PG8_STAGE(PG8_SB(1, 1), cB + hstep + kstep, voffB);
    PG8_WAIT_V(6); PG8_BAR;
    }
    PG8_STAMP();
    for (;;) {
        const bool has_next = S.next(ui + 1, nxt);
        const char* nA = has_next ? (const char*)g.A + (size_t)nxt.pm * tstep : cA; const char* nB = has_next ? (const char*)g.Bt + (size_t)nxt.pn * tstep : cB;
        for (int t = 0; t < nt; t += 2) {
            const bool last = (t == nt - 2);
            const char* a1 = cA + (size_t)(t + 1) * kstep;
            const char* a2 = last ? nA : cA + (size_t)(t + 2) * kstep; const char* b2 = last ? nB : cB + (size_t)(t + 2) * kstep;
            const char* a3 = a2 + kstep; const char* b3 = b2 + kstep;
            if (last && has_next) S.a_ready(nxt);
            if constexpr (SP2) {
            PG8_LDB(B0, 0, 0); PG8_LDB(B1, 0, 1); PG8_SCHED; PG8_LDA(At, 0, 0); PG8_STAGE(PG8_SA(1, 1), a1 + hstep, voffA);
            PG8_WAIT_V(8); PG8_WAIT_L(0); PG8_BAR; PG8_MMA(0, 0, At, B0); PG8_MMA(0, 1, At, B1); PG8_BAR; PG8_SCHED;
            PG8_LDA(At, 0, 1); PG8_STAGE(PG8_SB(0, 0), b2, voffB); PG8_STAGE(PG8_SB(0, 1), b2 + hstep, voffB); PG8_STAGE(PG8_SA(0, 0), a2, voffA);
            PG8_WAIT_V(8); PG8_WAIT_L(0); PG8_BAR; PG8_MMA(1, 0, At, B0); PG8_MMA(1, 1, At, B1); PG8_BAR; PG8_SCHED;
            PG8_LDB(B0, 1, 0); PG8_LDB(B1, 1, 1); PG8_SCHED; PG8_LDA(At, 1, 0); PG8_STAGE(PG8_SA(0, 1), a2 + hstep, voffA);
            PG8_WAIT_V(8); PG8_WAIT_L(0); PG8_BAR; PG8_MMA(0, 0, At, B0); PG8_MMA(0, 1, At, B1); PG8_BAR; PG8_SCHED;
            PG8_LDA(At, 1, 1); PG8_STAGE(PG8_SB(1, 0), b3, voffB); PG8_STAGE(PG8_SB(1, 1), b3 + hstep, voffB); PG8_STAGE(PG8_SA(1, 0), a3, voffA);
            PG8_WAIT_V(8); PG8_WAIT_L(0); PG8_BAR; PG8_MMA(1, 0, At, B0); PG8_MMA(1, 1, At, B1); PG8_BAR; PG8_SCHED;
            } else {
            PG8_LDB(B0, 0, 0); PG8_SCHED; PG8_LDA(At, 0, 0); PG8_STAGE(PG8_SA(1, 1), a1 + hstep, voffA);
            PG8_WAIT_L(8); PG8_BAR; PG8_WAIT_L(0); PG8_MMA(0, 0, At, B0); PG8_BAR; PG8_SCHED;
            PG8_LDB(B1, 0, 1); PG8_STAGE(PG8_SB(0, 0), b2, voffB);
            PG8_BAR; PG8_WAIT_L(0); PG8_MMA(0, 1, At, B1); PG8_BAR;
            PG8_LDA(At, 0, 1); PG8_STAGE(PG8_SA(0, 0), a2, voffA);
            PG8_BAR; PG8_WAIT_L(0); PG8_MMA(1, 0, At, B0); PG8_BAR; PG8_SCHED;
            PG8_STAGE(PG8_SB(0, 1), b2 + hstep, voffB);
            PG8_WAIT_V(6); PG8_BAR; PG8_MMA(1, 1, At, B1); PG8_BAR;
            PG8_LDB(B0, 1, 0); PG8_SCHED; PG8_LDA(At, 1, 0); PG8_STAGE(PG8_SA(0, 1), a2 + hstep, voffA);
            PG8_WAIT_L(8); PG8_BAR; PG8_WAIT_L(0); PG8_MMA(0, 0, At, B0); PG8_BAR; PG8_SCHED;
            PG8_LDB(B1, 1, 1); PG8_STAGE(PG8_SB(1, 0), b3, voffB);
            PG8_BAR; PG8_WAIT_L(0); PG8_MMA(0, 1, At, B1); PG8_BAR;
            PG8_LDA(At, 1, 1); PG8_STAGE(PG8_SA(1, 0), a3, voffA);
            PG8_BAR; PG8_WAIT_L(0); PG8_MMA(1, 0, At, B0); PG8_BAR; PG8_SCHED;
            PG8_STAGE(PG8_SB(1, 1), b3 + hstep, voffB);
            PG8_WAIT_V(6); PG8_BAR; PG8_MMA(1, 1, At, B1); PG8_BAR;
            }
        }
        PG8_STAMP();
        if constexpr (ALIGN_EPI) { if (wr == 0) PG8_BAR; }
        if constexpr (!Epi::AFTER_DRAIN) { E(acc, cur, wr, wc, fr, fq); S.done(cur); }
        PG8_STAMP();
        if (!has_next) break;
        bool zero_acc = true; if constexpr (epi_keep<Epi>::value) zero_acc = !E.keep(cur);
        if (zero_acc) { const bf16x8 z8 = {0, 0, 0, 0, 0, 0, 0, 0};
#pragma unroll
        for (int a = 0; a < 2; ++a)
#pragma unroll
            for (int b = 0; b < 2; ++b)
#pragma unroll
                for (int m = 0; m < 4; ++m)
#pragma unroll
                    for (int n = 0; n < 2; ++n) acc[a][b][m][n] = __builtin_amdgcn_mfma_f32_16x16x32_bf16(z8, z8, (f32x4){0.f, 0.f, 0.f, 0.f}, 0, 0, 0); }
        cur = nxt; cA = nA; cB = nB; ++ui;
        if constexpr (ALIGN_EPI) { if (wr == 1) PG8_BAR; }
    }
    PG8_WAIT_V(0);
    if constexpr (!ALIGN_EPI) { if (wr == 0) PG8_BAR; }
    PG8_BAR;
    if constexpr (Epi::AFTER_DRAIN) { E.fused(acc, cur, wr, wc, fr, fq, lds, wid, lane); S.done(cur); }
    PG8_STAMP();
    if (STAMP && wid == 0) { stamps[lane] = lane < nts ? (((unsigned long long)(unsigned)ts_hi << 32) | (unsigned)ts_lo) : 0ull;
        if (lane == 62) stamps[62] = rt_entry; if (lane == 63) stamps[63] = (unsigned long long)wall_clock64(); }
#undef PG8_STAMP
#undef PG8_SA
#undef PG8_SB
#undef PG8_STAGE
#undef PG8_LDA
#undef PG8_LDB
#undef PG8_MMA
#undef PG8_WAIT_V
#undef PG8_WAIT_L
#undef PG8_BAR
#undef PG8_SCHED
}
}

#define XB_TMO      128
#define XB_XCNT(j)  (256  + 64 * (j))
#define XB_XSUB(j)  (1280 + 64 * (j))
#define XB_XGEN(j)  (2304 + 64 * (j))
#define XB_TOP      3328
#define XB_TOPGEN   3392
#define XCD_BAR_WORDS 3456
#define XB_SPIN_CAP (1u << 18)
#define LAS __attribute__((address_space(3)))

__device__ __forceinline__ unsigned xb_ld(unsigned* p)              { return __hip_atomic_load(p, __ATOMIC_RELAXED, __HIP_MEMORY_SCOPE_AGENT); }
__device__ __forceinline__ unsigned xb_add(unsigned* p, unsigned v) { return __hip_atomic_fetch_add(p, v, __ATOMIC_RELAXED, __HIP_MEMORY_SCOPE_AGENT); }
__device__ __forceinline__ unsigned xb_xcc_id() { return (unsigned)__builtin_amdgcn_s_getreg((3 << 11) | 20) & 0xFu; }
#define XB_SPIN(cond, bar) do { unsigned _sp = 0; while (cond) { __builtin_amdgcn_s_sleep(1); \
    if ((++_sp & 255u) == 0u) { if (xb_ld(&(bar)[XB_TMO])) break; if (_sp > XB_SPIN_CAP) { atomicAdd(&(bar)[XB_TMO], 1u); break; } } } } while (0)

struct XcdBarrier {
    unsigned* bar; unsigned x;
    volatile LAS unsigned* st;
};

__device__ __forceinline__ XcdBarrier xcd_barrier_post(unsigned* bar, volatile LAS unsigned* st) {
    XcdBarrier b; b.bar = bar; b.x = xb_xcc_id(); b.st = st;
    if (threadIdx.x == 0) (void)xb_add(&bar[XB_XCNT(b.x)], 1u);
    return b;
}
__device__ __forceinline__ void xcd_barrier_complete(unsigned* bar, unsigned x, unsigned& nloc, unsigned& nx) {
    const unsigned G = gridDim.x * gridDim.y * gridDim.z;
    unsigned sum, cnt, mine, sp = 0u;
    for (;;) {
        sum = 0u; cnt = 0u; mine = 0u;
#pragma unroll
        for (unsigned j = 0; j < 16; ++j) { const unsigned c = xb_ld(&bar[XB_XCNT(j)]); sum += c; cnt += (c > 0u) ? 1u : 0u; mine = (j == x) ? c : mine; }
        if (sum == G) break;
        __builtin_amdgcn_s_sleep(1);
        if ((++sp & 255u) == 0u) { if (xb_ld(&bar[XB_TMO])) break; if (sp > XB_SPIN_CAP) { atomicAdd(&bar[XB_TMO], 1u); break; } }
    }
    nloc = mine > 0u ? mine : 1u; nx = cnt > 0u ? cnt : 1u;
}

__device__ __forceinline__ void xcd_barrier(const XcdBarrier& b) {
    asm volatile("s_waitcnt vmcnt(0)" ::: "memory");
    __syncthreads();
    if (threadIdx.x == 0) {
        unsigned* bar = b.bar;
        __builtin_amdgcn_s_waitcnt(0);
        unsigned nloc = b.st[0], nx = b.st[1];
        if (nloc == 0u) { xcd_barrier_complete(bar, b.x, nloc, nx); b.st[0] = nloc; b.st[1] = nx; }
        const unsigned old = xb_add(&bar[XB_XSUB(b.x)], 1u);
        const unsigned gen = old / nloc;
        if (old + 1u == (gen + 1u) * nloc) {
            __builtin_amdgcn_fence(__ATOMIC_RELEASE, "agent");
            asm volatile("s_waitcnt vmcnt(0)" ::: "memory");
            const unsigned og = xb_add(&bar[XB_TOP], 1u);
            const unsigned tg = og / nx;
            if (og + 1u == (tg + 1u) * nx) xb_add(&bar[XB_TOPGEN], 1u);
            else XB_SPIN(xb_ld(&bar[XB_TOPGEN]) == tg, bar);
            __builtin_amdgcn_fence(__ATOMIC_ACQUIRE, "agent");
            xb_add(&bar[XB_XGEN(b.x)], 1u);
            asm volatile("s_waitcnt vmcnt(0)" ::: "memory");
        } else {
            XB_SPIN(xb_ld(&bar[XB_XGEN(b.x)]) == gen, bar);
            __builtin_amdgcn_fence(__ATOMIC_ACQUIRE, "agent");
            asm volatile("s_waitcnt vmcnt(0)" ::: "memory");
        }
    }
    __syncthreads();
}

#else
namespace pg8 {
typedef unsigned short bf16_t;
typedef float f32x4 __attribute__((ext_vector_type(4)));
typedef unsigned u32x4 __attribute__((ext_vector_type(4)));
constexpr int BM = 256, BK = 64, HALF = 128, NXCD = 8, WGM = 8;
struct Unit { int pm, pn; };
struct Gemm { const bf16_t* A; const bf16_t* Bt; int M, N, K; };
template <class E, class = void> struct epi_keep { static constexpr bool value = false; };
template <class E> struct epi_keep<E, decltype((void)E::KEEP_ACC)> { static constexpr bool value = true; };
struct StaticOrder {
    int nM, nN, nwg, G, c;
    void init(int M, int N, int G_, int c_) { nM = M / BM; nN = N / BM; nwg = nM * nN; G = G_; c = c_; }
    bool next(int i, Unit& u) const {
        const long L = (long)i * G + c; if (L >= nwg) return false;
        int wgid = (int)L; { const int q = nwg / NXCD, r = nwg % NXCD, xcd = wgid % NXCD, off = wgid / NXCD; wgid = (xcd < r ? xcd * (q + 1) : r * (q + 1) + (xcd - r) * q) + off; }
        const int nig = WGM * nN, gid = wgid / nig, fm = gid * WGM, gsz = (nM - fm) < WGM ? (nM - fm) : WGM;
        u.pm = fm + ((wgid % nig) % gsz); u.pn = (wgid % nig) / gsz; return true;
    }
    void a_ready(const Unit&) const {}
    void done(const Unit&) const {}
};
static inline unsigned cvt_pk_bf16(float lo, float hi) { return pk2(lo, hi); }
static float* emu_tile_buf(int b) { static std::vector<std::vector<float>> t; if ((int)t.size() <= b) t.resize(b + 1); if (t[b].empty()) t[b].resize(256 * 256); return t[b].data(); }
template <class Epi, class Sched, bool STAMP = false, bool ALIGN_EPI = false, bool SP2 = false, bool ZPEEL = false>
void gemm_phase(unsigned char* lds, const Gemm g, const Sched& S, const Epi& E, unsigned long long* stamps) {
    const int tid = threadIdx.x, wid = tid >> 6, lane = tid & 63, wr = wid >> 2, wc = wid & 3, fr = lane & 15, fq = lane >> 4;
    float* tile = emu_tile_buf(blockIdx.x);
    Unit u; f32x4 acc[2][2][4][2]; bool keep_next = false;
    for (int ui = 0; S.next(ui, u); ++ui) {
        __syncthreads();
        if (tid == 0) {
            std::vector<float> a((size_t)256 * g.K), b((size_t)256 * g.K);
            for (int r = 0; r < 256; ++r) for (int k = 0; k < g.K; ++k) { a[(size_t)r * g.K + k] = bf2f(g.A[((size_t)u.pm * 256 + r) * g.K + k]); b[(size_t)r * g.K + k] = bf2f(g.Bt[((size_t)u.pn * 256 + r) * g.K + k]); }
            for (int r = 0; r < 256; ++r) for (int c = 0; c < 256; ++c) { const float* ar = &a[(size_t)r * g.K]; const float* br = &b[(size_t)c * g.K]; float s = 0.f; for (int k = 0; k < g.K; ++k) s += ar[k] * br[k]; tile[r * 256 + c] = s; }
        }
        __syncthreads();
        if (!keep_next) for (int ai = 0; ai < 2; ++ai) for (int bj = 0; bj < 2; ++bj) for (int m = 0; m < 4; ++m) for (int n = 0; n < 2; ++n) acc[ai][bj][m][n] = (f32x4){0.f, 0.f, 0.f, 0.f};
        for (int ai = 0; ai < 2; ++ai) for (int bj = 0; bj < 2; ++bj) for (int m = 0; m < 4; ++m) for (int n = 0; n < 2; ++n) for (int j = 0; j < 4; ++j) {
            const int r = 128 * ai + 64 * wr + 16 * m + fr;
            const int c = Epi::PERM ? (128 * bj + 32 * wc + 8 * fq + 4 * n + j) : (128 * bj + 32 * wc + 16 * n + 4 * fq + j);
            acc[ai][bj][m][n][j] += tile[r * 256 + c];
        }
        E(acc, u, wr, wc, fr, fq); S.done(u);
        if constexpr (epi_keep<Epi>::value) keep_next = E.keep(u); else keep_next = false;
        __syncthreads();
    }
}
}
#endif
namespace pg8 {
#ifdef HOST_EMU
#define EPI_FENCE() do {} while (0)
#else
#define EPI_FENCE() asm volatile("" ::: "memory")
#endif
__device__ __forceinline__ u32x4 pack8(const f32x4 v0, const f32x4 v1) { u32x4 w; w.x = cvt_pk_bf16(v0[0], v0[1]); w.y = cvt_pk_bf16(v0[2], v0[3]); w.z = cvt_pk_bf16(v1[0], v1[1]); w.w = cvt_pk_bf16(v1[2], v1[3]); return w; }
__device__ __forceinline__ void unpack8(const u32x4 w, f32x4& v0, f32x4& v1) { v0 = (f32x4){lo_bf(w.x), hi_bf(w.x), lo_bf(w.y), hi_bf(w.y)}; v1 = (f32x4){lo_bf(w.z), hi_bf(w.z), lo_bf(w.w), hi_bf(w.w)}; }
__device__ __forceinline__ f32x4 sig4(const f32x4 v) { return (f32x4){sigm(v[0]), sigm(v[1]), sigm(v[2]), sigm(v[3])}; }
#ifndef HOST_EMU
__device__ __forceinline__ float gate_sig(float x) { return __builtin_amdgcn_rcpf(fminf(1.0f + __expf(-x), 1.0e6f)); }
#else
__device__ __forceinline__ float gate_sig(float x) { return fmaxf(sigm(x), 1.0e-6f); }
#endif
__device__ __forceinline__ f32x4 gsig4(const f32x4 v) { return (f32x4){gate_sig(v[0]), gate_sig(v[1]), gate_sig(v[2]), gate_sig(v[3])}; }

struct EpiProj {
    static constexpr bool PERM = true, AFTER_DRAIN = false;
    unsigned char* ws;
    __device__ __forceinline__ void operator()(const f32x4 (&acc)[2][2][4][2], const Unit& u, int wr, int wc, int fr, int fq) const {
        const int pn = u.pn; size_t off; int ld, c0;
        if (pn < 2) { off = WS_Z; ld = 512; c0 = pn * 256; }
        else if (pn < 5) { off = WS_XBC; ld = 768; c0 = (pn - 2) * 256; }
        else if (pn < 7) { off = WS_Q; ld = 512; c0 = (pn - 5) * 256; }
        else if (pn < 9) { off = WS_K; ld = 512; c0 = (pn - 7) * 256; }
        else if (pn < 11) { off = WS_V; ld = 512; c0 = (pn - 9) * 256; }
        else if (pn < 18) { off = WS_RW; ld = 1792; c0 = (pn - 11) * 256; }
        else if (pn < 20) { off = WS_U; ld = 512; c0 = (pn - 18) * 256; }
        else { off = WS_SM; ld = 256; c0 = 0; }
        bf16_t* dst = (bf16_t*)(ws + off);
        const int row0 = u.pm * BM + wr * 64 + fr, col0 = c0 + wc * 32 + 8 * fq;
        const int kic = HALF + wc * 32 + 8 * fq - 136;
        const bool ki = (pn == 20) && kic >= 0 && kic < 32;
#pragma unroll
        for (int ai = 0; ai < 2; ++ai)
#pragma unroll
            for (int m = 0; m < 4; ++m) { const size_t row = (size_t)(row0 + ai * HALF + m * 16); bf16_t* rowp = dst + row * ld + col0;
#pragma unroll
                for (int bj = 0; bj < 2; ++bj) { const u32x4 w = pack8(acc[ai][bj][m][0], acc[ai][bj][m][1]); *(u32x4*)(rowp + bj * HALF) = w;
                    if (bj == 1 && ki) *(u32x4*)((bf16_t*)(ws + WS_KI) + row * 32 + kic) = w; } }
    }
};
struct EpiGate {
    static constexpr bool PERM = true, AFTER_DRAIN = false;
    bf16_t* G;
    __device__ __forceinline__ void operator()(const f32x4 (&acc)[2][2][4][2], const Unit& u, int wr, int wc, int fr, int fq) const {
        const int row0 = u.pm * BM + wr * 64 + fr, col0 = u.pn * BM + wc * 32 + 8 * fq;
#pragma unroll
        for (int ai = 0; ai < 2; ++ai)
#pragma unroll
            for (int m = 0; m < 4; ++m) { bf16_t* rowp = G + (size_t)(row0 + ai * HALF + m * 16) * 4096 + col0;
#pragma unroll
                for (int bj = 0; bj < 2; ++bj) *(u32x4*)(rowp + bj * HALF) = pack8(gsig4(acc[ai][bj][m][0]), gsig4(acc[ai][bj][m][1])); }
    }
};
struct EpiMerge {
    static constexpr bool PERM = true, AFTER_DRAIN = false, KEEP_ACC = true;
    const bf16_t* G; bf16_t* MRG;
    __device__ __forceinline__ bool keep(const Unit& u) const { return (u.pn >> 2) < 3; }
    __device__ __forceinline__ void operator()(f32x4 (&acc)[2][2][4][2], const Unit& u, int wr, int wc, int fr, int fq) const {
        const int n = u.pn >> 2, pn = u.pn & 3, pm = u.pm - n * (MG / 256);
        const int row0 = pm * BM + wr * 64 + fr, col0 = pn * BM + wc * 32 + 8 * fq;
#pragma unroll
        for (int ai = 0; ai < 2; ++ai)
#pragma unroll
            for (int mp = 0; mp < 2; ++mp) { u32x4 ga[2][2], gb[2][2];
#pragma unroll
                for (int mm = 0; mm < 2; ++mm)
#pragma unroll
                    for (int bj = 0; bj < 2; ++bj) { const bf16_t* gp = G + (size_t)(row0 + ai * HALF + (2 * mp + mm) * 16) * 4096 + n * 1024 + col0 + bj * HALF; ga[mm][bj] = *(const u32x4*)gp; if (n < 3) gb[mm][bj] = *(const u32x4*)(gp + 1024); }
#pragma unroll
                for (int mm = 0; mm < 2; ++mm)
#pragma unroll
                    for (int bj = 0; bj < 2; ++bj) { const int m = 2 * mp + mm; f32x4 a0, a1; unpack8(ga[mm][bj], a0, a1);
                        if (n < 3) { f32x4 b0, b1; unpack8(gb[mm][bj], b0, b1);
#pragma unroll
                            for (int j = 0; j < 4; ++j) { acc[ai][bj][m][0][j] *= a0[j] * __builtin_amdgcn_rcpf(b0[j]); acc[ai][bj][m][1][j] *= a1[j] * __builtin_amdgcn_rcpf(b1[j]); } }
                        else
                            *(u32x4*)(MRG + (size_t)(row0 + ai * HALF + m * 16) * 1024 + col0 + bj * HALF) = pack8(acc[ai][bj][m][0] * a0, acc[ai][bj][m][1] * a1); }
                EPI_FENCE(); }
    }
};
struct MergeOrder {
    int G, c;
    __device__ __forceinline__ bool next(int i, Unit& u) const {
        const int tile = (i >> 2) * G + c, n = i & 3; if (tile >= (MG / 256) * 4) return false;
        u.pm = n * (MG / 256) + (tile >> 2); u.pn = n * 4 + (tile & 3); return true;
    }
    __device__ __forceinline__ void a_ready(const Unit&) const {}
    __device__ __forceinline__ void done(const Unit&) const {}
};
struct EpiResid {
    static constexpr bool PERM = false, AFTER_DRAIN = false;
    const float* base; float* out;
    __device__ __forceinline__ void operator()(const f32x4 (&acc)[2][2][4][2], const Unit& u, int wr, int wc, int fr, int fq) const {
        const int row0 = u.pm * BM + wr * 64 + fr, col0 = u.pn * BM + wc * 32 + 4 * fq;
#pragma unroll
        for (int ai = 0; ai < 2; ++ai) {
            f32x4 bv[4][2][2];
#pragma unroll
            for (int m = 0; m < 4; ++m)
#pragma unroll
                for (int bj = 0; bj < 2; ++bj)
#pragma unroll
                    for (int n = 0; n < 2; ++n) bv[m][bj][n] = *(const f32x4*)(base + (size_t)(row0 + ai * HALF + m * 16) * 1024 + col0 + bj * HALF + n * 16);
#pragma unroll
            for (int m = 0; m < 4; ++m)
#pragma unroll
                for (int bj = 0; bj < 2; ++bj)
#pragma unroll
                    for (int n = 0; n < 2; ++n) *(f32x4*)(out + (size_t)(row0 + ai * HALF + m * 16) * 1024 + col0 + bj * HALF + n * 16) = bv[m][bj][n] + acc[ai][bj][m][n];
            EPI_FENCE(); }
    }
};
struct EpiSwiglu {
    static constexpr bool PERM = true, AFTER_DRAIN = false;
    bf16_t* HID;
    __device__ __forceinline__ void operator()(const f32x4 (&acc)[2][2][4][2], const Unit& u, int wr, int wc, int fr, int fq) const {
        const int row0 = u.pm * BM + wr * 64 + fr, col0 = u.pn * HALF + wc * 32 + 8 * fq;
#pragma unroll
        for (int ai = 0; ai < 2; ++ai)
#pragma unroll
            for (int m = 0; m < 4; ++m) { f32x4 v[2];
#pragma unroll
                for (int n = 0; n < 2; ++n) { const f32x4 a = acc[ai][0][m][n], b = acc[ai][1][m][n]; v[n] = a * sig4(a) * b; }
                *(u32x4*)(HID + (size_t)(row0 + ai * HALF + m * 16) * FFN + col0) = pack8(v[0], v[1]); }
    }
};
struct EpiGlu {
    static constexpr bool PERM = true, AFTER_DRAIN = false;
    const bf16_t* Y0; bf16_t* OUT; const float* bias;
    __device__ __forceinline__ void operator()(const f32x4 (&acc)[2][2][4][2], const Unit& u, int wr, int wc, int fr, int fq) const {
        const int row0 = u.pm * BM + wr * 64 + fr, col0 = u.pn * BM + wc * 32 + 8 * fq;
#pragma unroll
        for (int ai = 0; ai < 2; ++ai)
#pragma unroll
            for (int m = 0; m < 4; ++m) { const size_t row = (size_t)(row0 + ai * HALF + m * 16);
#pragma unroll
                for (int bj = 0; bj < 2; ++bj) { const int col = col0 + bj * HALF;
                    f32x4 y0, y1; unpack8(*(const u32x4*)(Y0 + row * 512 + col), y0, y1);
                    const f32x4 b0 = *(const f32x4*)(bias + col), b1 = *(const f32x4*)(bias + col + 4);
                    *(u32x4*)(OUT + row * 512 + col) = pack8(y0 * sig4(acc[ai][bj][m][0] + b0), y1 * sig4(acc[ai][bj][m][1] + b1)); }
                EPI_FENCE(); }
    }
};
__device__ __forceinline__ float logdecay(float x) { return -0.6065306597f * sigm(x); }
struct EpiLora {
    static constexpr bool PERM = true, AFTER_DRAIN = false;
    float* WLOG; bf16_t* ASIG; bf16_t* GG; const float* w0; const float* a0;
    __device__ __forceinline__ void operator()(const f32x4 (&acc)[2][2][4][2], const Unit& u, int wr, int wc, int fr, int fq) const {
        const int kind = u.pn >> 1, row0 = u.pm * BM + wr * 64 + fr, col0 = (u.pn & 1) * BM + wc * 32 + 8 * fq;
        if (kind == 0) {
            f32x4 b[2][2];
#pragma unroll
            for (int bj = 0; bj < 2; ++bj) { b[bj][0] = *(const f32x4*)(w0 + col0 + bj * HALF); b[bj][1] = *(const f32x4*)(w0 + col0 + bj * HALF + 4); }
#pragma unroll
            for (int ai = 0; ai < 2; ++ai)
#pragma unroll
                for (int m = 0; m < 4; ++m)
#pragma unroll
                    for (int bj = 0; bj < 2; ++bj)
#pragma unroll
                        for (int n = 0; n < 2; ++n) { const f32x4 x = acc[ai][bj][m][n] + b[bj][n];
                            *(f32x4*)(WLOG + (size_t)(row0 + ai * HALF + m * 16) * 512 + col0 + bj * HALF + 4 * n) = (f32x4){logdecay(x[0]), logdecay(x[1]), logdecay(x[2]), logdecay(x[3])}; }
        } else if (kind == 1) {
            f32x4 b[2][2];
#pragma unroll
            for (int bj = 0; bj < 2; ++bj) { b[bj][0] = *(const f32x4*)(a0 + col0 + bj * HALF); b[bj][1] = *(const f32x4*)(a0 + col0 + bj * HALF + 4); }
#pragma unroll
            for (int ai = 0; ai < 2; ++ai)
#pragma unroll
                for (int m = 0; m < 4; ++m)
#pragma unroll
                    for (int bj = 0; bj < 2; ++bj)
                        *(u32x4*)(ASIG + (size_t)(row0 + ai * HALF + m * 16) * 512 + col0 + bj * HALF) = pack8(sig4(acc[ai][bj][m][0] + b[bj][0]), sig4(acc[ai][bj][m][1] + b[bj][1]));
        } else {
#pragma unroll
            for (int ai = 0; ai < 2; ++ai)
#pragma unroll
                for (int m = 0; m < 4; ++m)
#pragma unroll
                    for (int bj = 0; bj < 2; ++bj)
                        *(u32x4*)(GG + (size_t)(row0 + ai * HALF + m * 16) * 512 + col0 + bj * HALF) = pack8(acc[ai][bj][m][0], acc[ai][bj][m][1]);
        }
    }
};
}
typedef short bf16x8_t __attribute__((ext_vector_type(8)));
typedef float f32x16 __attribute__((ext_vector_type(16)));
typedef float f32x4_t __attribute__((ext_vector_type(4)));
__device__ __forceinline__ bf16x8_t frag2(const u32x2 lo, const u32x2 hi) { u32x4 w; w.x = lo.x; w.y = lo.y; w.z = hi.x; w.w = hi.y; return __builtin_bit_cast(bf16x8_t, w); }
struct Args { const float* in[N_IN]; float* out; unsigned char* ws; int seg_lo, seg_hi; };
#ifdef HOST_EMU
typedef const Args* KArgs;
#define KLAUNDER(p) (p)
__device__ __forceinline__ int fresh_tid() { return (int)threadIdx.x; }
#else
typedef const __attribute__((address_space(4))) Args* KArgs;
__device__ __forceinline__ KArgs klaunder(KArgs p) { asm volatile("" : "+s"(p)); return p; }
#define KLAUNDER(p) klaunder(p)
__device__ __forceinline__ int fresh_tid() { int t = (int)threadIdx.x; asm volatile("" : "+v"(t)); return t; }
#endif
#define WSP(T, off) ((T*)(C->ws + (off)))

template <class Src>
__device__ __forceinline__ void transpose_item(const Src& S, int K, bf16* WT, float* scr, int item, int lane) {
    const int nblk = S.ndst / 32, kb = item / nblk, nb = item % nblk, k0 = 64 * kb, n0 = 32 * nb;
    const float* cp = S.col(n0 + (lane & 31)); const int ld = S.ld; const float* cq = cp ? cp : S.col(0);
    float ld32[32];
#pragma unroll
    for (int i = 0; i < 32; ++i) ld32[i] = cq[(size_t)(k0 + 2 * i + (lane >> 5)) * ld];
#pragma unroll
    for (int i = 0; i < 32; ++i) { const int kk = 2 * i + (lane >> 5); scr[kk * 33 + (lane & 31)] = cp ? ld32[i] : 0.f; }
    WAVE_SYNC();
    const int c = lane & 7;
#pragma unroll
    for (int j = 0; j < 4; ++j) { const int n = (lane >> 3) + 8 * j; const float* s = scr + (8 * c) * 33 + n;
        u32x4 o; o.x = pk2(s[0 * 33], s[1 * 33]); o.y = pk2(s[2 * 33], s[3 * 33]); o.z = pk2(s[4 * 33], s[5 * 33]); o.w = pk2(s[6 * 33], s[7 * 33]);
        *(u32x4*)(WT + (size_t)(n0 + n) * K + k0 + 8 * c) = o; }
    WAVE_SYNC();
}
struct SrcWin { const float* w; int ndst, ld;
    __device__ __forceinline__ const float* col(int n) const {
        int s;
        if (n < 1280) s = n;
        else if (n < 2816) s = n + 8;
        else if (n < 4608) s = n - 2816 + 2988;
        else if (n < 5120) s = n - 4608 + 4780;
        else if (n < 5128) s = n - 5120 + 1280;
        else if (n < 5256) s = n - 5128 + 2824;
        else if (n < 5288) s = n - 5256 + 2952;
        else if (n < 5292) s = n - 5288 + 2984;
        else if (n < 5376) return nullptr;
        else s = n - 5376 + 5292;
        return w + s; } };
struct SrcPlain { const float* w; int ndst, ld; __device__ __forceinline__ const float* col(int n) const { return w + n; } };
struct SrcW13 { const float* w1; const float* w3; int ndst, ld;
    __device__ __forceinline__ const float* col(int n) const { const int pn = n >> 8, r = n & 255; return w1 + (r < 128 ? (ptrdiff_t)0 : (w3 - w1)) + pn * 128 + (r & 127); } };

__device__ __forceinline__ void phase_weights(KArgs C, int layer, unsigned char* lds, int gw, int ngw, int lane, int wave) {
    float* scr = (float*)(lds + wave * 16384); const size_t wo = (layer & 1) ? WDELTA : 0;
    constexpr int N_IN_ = 16 * (NPROJ / 32), N_BR = 8 * 32, N_OUT = 16 * 32, N_13 = 16 * (5632 / 32), N_2 = 44 * 32, N_GLU = 8 * 16;
    { const SrcWin s_in{C->in[I_WIN] + (size_t)layer * 1024 * IN_COLS, NPROJ, IN_COLS};
      for (int it = gw; it < N_IN_; it += ngw) transpose_item(s_in, 1024, WSP(bf16, WS_WIN + wo), scr, it, lane); }
    for (int it = gw; it < 4 * N_BR; it += ngw) { const int n = it / N_BR; const SrcPlain s_b{C->in[I_WBR] + ((size_t)layer * 4 + n) * 512 * 1024, 1024, 1024};
        transpose_item(s_b, 512, WSP(bf16, WS_WB + wo) + (size_t)n * 1024 * 512, scr, it % N_BR, lane); }
    { const SrcPlain s_out{C->in[I_WOUT] + (size_t)layer * 1024 * 1024, 1024, 1024};
      for (int it = gw; it < N_OUT; it += ngw) transpose_item(s_out, 1024, WSP(bf16, WS_WOUT + wo), scr, it, lane); }
    { const SrcW13 s_13{C->in[I_W1] + (size_t)layer * 1024 * FFN, C->in[I_W3] + (size_t)layer * 1024 * FFN, 5632, FFN};
      for (int it = gw; it < N_13; it += ngw) transpose_item(s_13, 1024, WSP(bf16, WS_W13 + wo), scr, it, lane); }
    { const SrcPlain s_2{C->in[I_W2F] + (size_t)layer * FFN * 1024, 1024, 1024};
      for (int it = gw; it < N_2; it += ngw) transpose_item(s_2, FFN, WSP(bf16, WS_W2 + wo), scr, it, lane); }
    { const SrcPlain s_glu{C->in[I_GLUW] + (size_t)layer * 512 * 512, 512, 512};
      for (int it = gw; it < N_GLU; it += ngw) transpose_item(s_glu, 512, WSP(bf16, WS_GLU + wo), scr, it, lane); }
    { const float* w2 = C->in[I_W2] + (size_t)layer * 64 * 512; const float* a2 = C->in[I_A2] + (size_t)layer * 64 * 512; const float* g2 = C->in[I_G2] + (size_t)layer * 128 * 512;
      bf16* WL = WSP(bf16, WS_WLORA + wo);
      for (int e = gw * 64 + lane; e < 1536 * 256; e += ngw * 64) { const int n = e >> 8, kc = e & 255; float v = 0.f;
          if (n < 512) { if (kc < 64) v = w2[kc * 512 + n]; } else if (n < 1024) { if (kc >= 64 && kc < 128) v = a2[(kc - 64) * 512 + (n - 512)]; } else { if (kc >= 128) v = g2[(kc - 128) * 512 + (n - 1024)]; }
          WL[e] = f2bf(v); } }
    const int gt = gw * 64 + lane, ngt = ngw * 64;
    for (int e = gt; e < 32 * 64; e += ngt) {
        const int g = e >> 6;
        const float ar = C->in[I_S5ARE][layer * 2048 + e], ai = C->in[I_S5AIM][layer * 2048 + e], dt = expf(C->in[I_S5LDT][layer * 32 + g]);
        const float mag = expf(ar * dt), abr = mag * cosf(ai * dt), abi = mag * sinf(ai * dt);
        const float den = ar * ar + ai * ai, nr = abr - 1.0f, ni = abi;
        const float qr = (nr * ar + ni * ai) / den, qi = (ni * ar - nr * ai) / den;
        float* ab = WSP(float, WS_ABAR + wo) + e * 2; ab[0] = abr; ab[1] = abi;
        float* bb = WSP(float, WS_BBAR + wo) + (size_t)e * 32;
        for (int j = 0; j < 16; ++j) { const float br = C->in[I_S5BRE][((size_t)layer * 2048 + e) * 16 + j], bi = C->in[I_S5BIM][((size_t)layer * 2048 + e) * 16 + j];
            bb[2 * j] = qr * br - qi * bi; bb[2 * j + 1] = qr * bi + qi * br; }
    }
    if (layer == 0) for (int e = gt; e < SEQ + 63; e += ngt) {
        const int rel = e - (SEQ - 1); const int n = rel < 0 ? -rel : rel; int b = rel > 0 ? 16 : 0;
        if (n < 8) b += n; else { int lg = 8 + (int)(logf((float)n / 8.0f) / 3.4657359028f * 8.0f); if (lg > 15) lg = 15; b += lg; }
        WSP(int, WS_TAB)[e] = b;
    }
}

__device__ __forceinline__ void rms_row_bf16(const float* xrow, const float* g, bf16* orow, int lane) {
    const f32x4* xr = (const f32x4*)xrow + lane; const f32x4* gr = (const f32x4*)g + lane;
    f32x4 v[4]; float s = 0.f;
#pragma unroll
    for (int j = 0; j < 4; ++j) { v[j] = xr[64 * j]; s += (v[j].x * v[j].x + v[j].y * v[j].y) + (v[j].z * v[j].z + v[j].w * v[j].w); }
    const float rstd = 1.0f / sqrtf(wave_sum(s) * (1.f / D) + RMS_EPS);
    u32x2* o8 = (u32x2*)orow + lane;
#pragma unroll
    for (int j = 0; j < 4; ++j) { const f32x4 gg = gr[64 * j]; u32x2 w; w.x = pk2(v[j].x * rstd * gg.x, v[j].y * rstd * gg.y); w.y = pk2(v[j].z * rstd * gg.z, v[j].w * rstd * gg.w); o8[64 * j] = w; }
}
template <int NR>
__device__ __forceinline__ void rms_rowN_bf16(const float* xrow, const float* g, bf16* orow, size_t step, int lane) {
    const f32x4* gr = (const f32x4*)g + lane; f32x4 v[NR][4]; float ss[NR];
#pragma unroll
    for (int q = 0; q < NR; ++q)
#pragma unroll
        for (int j = 0; j < 4; ++j) v[q][j] = ((const f32x4*)(xrow + q * step) + lane)[64 * j];
#pragma unroll
    for (int q = 0; q < NR; ++q) { float s = 0.f;
#pragma unroll
        for (int j = 0; j < 4; ++j) s += (v[q][j].x * v[q][j].x + v[q][j].y * v[q][j].y) + (v[q][j].z * v[q][j].z + v[q][j].w * v[q][j].w);
        ss[q] = s; }
#pragma unroll
    for (int o = 1; o < 64; o <<= 1)
#pragma unroll
        for (int q = 0; q < NR; ++q) ss[q] += __shfl_xor(ss[q], o);
#pragma unroll
    for (int q = 0; q < NR; ++q) { const float r = 1.0f / sqrtf(ss[q] * (1.f / D) + RMS_EPS); u32x2* o8 = (u32x2*)(orow + q * step) + lane;
#pragma unroll
        for (int j = 0; j < 4; ++j) { const f32x4 gg = gr[64 * j]; u32x2 w; w.x = pk2(v[q][j].x * r * gg.x, v[q][j].y * r * gg.y); w.y = pk2(v[q][j].z * r * gg.z, v[q][j].w * r * gg.w); o8[64 * j] = w; } }
}
__device__ __forceinline__ void rms_row_f32(float* xrow, const float* g, int lane) {
    f32x4* xr = (f32x4*)xrow + lane; const f32x4* gr = (const f32x4*)g + lane;
    f32x4 v[4]; float s = 0.f;
#pragma unroll
    for (int j = 0; j < 4; ++j) { v[j] = xr[64 * j]; s += (v[j].x * v[j].x + v[j].y * v[j].y) + (v[j].z * v[j].z + v[j].w * v[j].w); }
    const float rstd = 1.0f / sqrtf(wave_sum(s) * (1.f / D) + RMS_EPS);
#pragma unroll
    for (int j = 0; j < 4; ++j) xr[64 * j] = v[j] * rstd * gr[64 * j];
}

#ifdef HOST_EMU
__device__ __forceinline__ float red8(float v) { v += __shfl_xor(v, 1); v += __shfl_xor(v, 2); v += __shfl_xor(v, 4); return v; }
__device__ __forceinline__ float red16(float v) { v = red8(v); v += __shfl_xor(v, 8); return v; }
#else
template <int CTRL> __device__ __forceinline__ float dpp_f(float v) { return __builtin_bit_cast(float, __builtin_amdgcn_update_dpp(0, __builtin_bit_cast(int, v), CTRL, 0xf, 0xf, true)); }
__device__ __forceinline__ float red8(float v) { v += dpp_f<0xB1>(v); v += dpp_f<0x4E>(v); v += dpp_f<0x141>(v); return v; }
__device__ __forceinline__ float red16(float v) { v = red8(v); v += dpp_f<0x140>(v); return v; }
#endif
__device__ __forceinline__ f32x4 sig4g(const f32x4 v) { return (f32x4){sigm(v[0]), sigm(v[1]), sigm(v[2]), sigm(v[3])}; }
__device__ __forceinline__ void rms_row2_f32(float* xrow, size_t step, const float* g, int lane) {
    f32x4* xa = (f32x4*)xrow + lane; f32x4* xb = (f32x4*)(xrow + step) + lane; const f32x4* gr = (const f32x4*)g + lane;
    f32x4 va[4], vb[4]; float sa = 0.f, sb = 0.f;
#pragma unroll
    for (int j = 0; j < 4; ++j) { va[j] = xa[64 * j]; vb[j] = xb[64 * j]; }
#pragma unroll
    for (int j = 0; j < 4; ++j) { sa += (va[j].x * va[j].x + va[j].y * va[j].y) + (va[j].z * va[j].z + va[j].w * va[j].w); sb += (vb[j].x * vb[j].x + vb[j].y * vb[j].y) + (vb[j].z * vb[j].z + vb[j].w * vb[j].w); }
#pragma unroll
    for (int o = 1; o < 64; o <<= 1) { sa += __shfl_xor(sa, o); sb += __shfl_xor(sb, o); }
    const float ra = 1.0f / sqrtf(sa * (1.f / D) + RMS_EPS), rb = 1.0f / sqrtf(sb * (1.f / D) + RMS_EPS);
#pragma unroll
    for (int j = 0; j < 4; ++j) { const f32x4 gg = gr[64 * j]; xa[64 * j] = va[j] * ra * gg; xb[64 * j] = vb[j] * rb * gg; }
}
__device__ __forceinline__ void ssd_conv_row(KArgs C, int layer, int m, int lane) {
    const int t = m % SEQ; const float* cw = C->in[I_CONVW] + layer * 4 * 768; const float* cb = C->in[I_CONVB] + layer * 768;
#pragma unroll
    for (int i = 0; i < 3; ++i) { const int ch = i * 256 + lane * 4; const bf16* p = WSP(const bf16, WS_XBC) + (size_t)m * 768 + ch;
        f32x4 a = *(const f32x4*)(cb + ch);
#pragma unroll
        for (int q = 0; q < 4; ++q) if (t - 3 + q >= 0) { const u32x2 w = *(const u32x2*)(p - (3 - q) * 768); const f32x4 cq = *(const f32x4*)(cw + q * 768 + ch);
            a += cq * (f32x4){lo_bf(w.x), hi_bf(w.x), lo_bf(w.y), hi_bf(w.y)}; }
        a = a * sig4g(a);
        u32x2 o; o.x = pk2(a.x, a.y); o.y = pk2(a.z, a.w); *(u32x2*)(WSP(bf16, WS_XBA) + (size_t)m * 768 + ch) = o; }
}
__device__ __forceinline__ void ssd_conv_row2(KArgs C, int layer, int m, int step, int lane) {
    const float* cw = C->in[I_CONVW] + layer * 4 * 768; const float* cb = C->in[I_CONVB] + layer * 768;
    u32x2 w[2][3][4]; f32x4 cq[3][4], bb[3];
#pragma unroll
    for (int i = 0; i < 3; ++i) { const int ch = i * 256 + lane * 4; bb[i] = *(const f32x4*)(cb + ch);
#pragma unroll
        for (int q = 0; q < 4; ++q) { cq[i][q] = *(const f32x4*)(cw + q * 768 + ch);
#pragma unroll
            for (int r = 0; r < 2; ++r) { const int mm = m + r * step, t = mm % SEQ; const bf16* p = WSP(const bf16, WS_XBC) + (size_t)mm * 768 + ch;
                if (t - 3 + q >= 0) w[r][i][q] = *(const u32x2*)(p - (3 - q) * 768); else { w[r][i][q].x = 0u; w[r][i][q].y = 0u; } } } }
#pragma unroll
    for (int r = 0; r < 2; ++r)
#pragma unroll
        for (int i = 0; i < 3; ++i) { const int ch = i * 256 + lane * 4; f32x4 a = bb[i];
#pragma unroll
            for (int q = 0; q < 4; ++q) a += cq[i][q] * (f32x4){lo_bf(w[r][i][q].x), hi_bf(w[r][i][q].x), lo_bf(w[r][i][q].y), hi_bf(w[r][i][q].y)};
            a = a * sig4g(a);
            u32x2 o; o.x = pk2(a.x, a.y); o.y = pk2(a.z, a.w); *(u32x2*)(WSP(bf16, WS_XBA) + (size_t)(m + r * step) * 768 + ch) = o; }
}
__device__ __forceinline__ void ssd_unit(KArgs C, int layer, int unit, unsigned char* lds) {
    const int tid = fresh_tid(), lane = tid & 63, wave = tid >> 6, bl = unit >> 3, h = unit & 7, gi = h >> 2, pp = tid >> 3, c8 = (tid & 7) * 8, c16 = lane & 15, q = lane >> 4;
    bf16* Cb = (bf16*)lds; bf16* Bb = Cb + 4096; bf16* XT = Bb + 4096; bf16* BwT = XT + 4096; bf16* Pm = BwT + 4096; float* Yo = (float*)(Pm + 4096); float* dts = Yo + 8192; float* acs = dts + 128;
    const bf16* XA = WSP(const bf16, WS_XBA) + (size_t)bl * SEQ * 768 + (size_t)pp * 768 + c8;
    const bf16* SMp = WSP(const bf16, WS_SM) + (size_t)bl * SEQ * 256;
    const bf16* Zp = WSP(const bf16, WS_Z) + (size_t)bl * SEQ * 512 + (size_t)pp * 512 + h * 64 + c8;
    bf16* YA = WSP(bf16, WS_Y) + (size_t)bl * SEQ * 512 + (size_t)pp * 512 + h * 64 + c8;
    const float dtb = C->in[I_DTB][layer * 8 + h], A = -__expf(C->in[I_ALOG][layer * 8 + h]), Dh = C->in[I_SSDD][layer * 8 + h];
    f32x4_t Sd[2]; bf16x8_t Sf; Sd[0] = (f32x4_t){0.f, 0.f, 0.f, 0.f}; Sd[1] = Sd[0]; { u32x2 z; z.x = 0u; z.y = 0u; Sf = frag2(z, z); }
    const int pt = wave & 3, nh = wave >> 2;
    u32x4 fx, fb, fc, fz;
#define SSD_FETCH(c0_) do { const bf16* q_ = XA + (size_t)(c0_) * 768; fx = *(const u32x4*)(q_ + h * 64); fb = *(const u32x4*)(q_ + 512 + gi * 64); fc = *(const u32x4*)(q_ + 640 + gi * 64); fz = *(const u32x4*)(Zp + (size_t)(c0_) * 512); } while (0)
#define SSD_DT(c0_, par) do { if (wave == 0) { const float dt_ = softplusf(bf2f(SMp[(size_t)((c0_) + lane) * 256 + h]) + dtb); float a_ = A * dt_; \
        _Pragma("unroll") for (int o_ = 1; o_ < 64; o_ <<= 1) { const float t_ = __shfl_up(a_, o_); if (lane >= o_) a_ += t_; } dts[(par) * 64 + lane] = dt_; acs[(par) * 64 + lane] = a_; } } while (0)
    LDS_SYNC();
    SSD_FETCH(0); SSD_DT(0, 0);
    for (int c0 = 0, par = 0; c0 < SEQ; c0 += 64, par ^= 1) {
        LDS_SYNC();
        const u32x4 xk = fx, zk = fz;
        {
          const float dt = dts[par * 64 + pp], ea = __expf(acs[par * 64 + 63] - acs[par * 64 + pp]);
          *(u32x4*)(Cb + pp * 64 + c8) = fc; *(u32x4*)(Bb + pp * 64 + c8) = fb;
          f32x4 x0, x1, b0, b1; pg8::unpack8(fx, x0, x1); pg8::unpack8(fb, b0, b1); x0 = x0 * dt; x1 = x1 * dt; b0 = b0 * ea; b1 = b1 * ea;
#pragma unroll
          for (int i = 0; i < 4; ++i) { XT[(c8 + i) * 64 + pp] = f2bf(x0[i]); XT[(c8 + 4 + i) * 64 + pp] = f2bf(x1[i]); BwT[(c8 + i) * 64 + pp] = f2bf(b0[i]); BwT[(c8 + 4 + i) * 64 + pp] = f2bf(b1[i]); } }
        if (c0 + 64 < SEQ) { SSD_FETCH(c0 + 64); SSD_DT(c0 + 64, par ^ 1); }
        LDS_SYNC();
        {
          const f32x4_t z4 = {0.f, 0.f, 0.f, 0.f};
#pragma unroll
          for (int i = 0; i < 2; ++i) { const int id = wave + 8 * i, lt = id >> 2, st = id & 3; f32x4_t g = z4;
              if (st <= lt) {
#pragma unroll
                  for (int ks = 0; ks < 2; ++ks) g = __builtin_amdgcn_mfma_f32_16x16x32_bf16(*(const bf16x8_t*)(Cb + (16 * lt + c16) * 64 + 32 * ks + 8 * q), *(const bf16x8_t*)(Bb + (16 * st + c16) * 64 + 32 * ks + 8 * q), g, 0, 0, 0);
                  const float as_ = acs[par * 64 + 16 * st + c16];
#pragma unroll
                  for (int r = 0; r < 4; ++r) { const int l = 16 * lt + 4 * q + r; g[r] = (16 * st + c16 <= l) ? g[r] * __expf(acs[par * 64 + l] - as_) : 0.f; } }
#pragma unroll
              for (int r = 0; r < 4; ++r) Pm[(16 * lt + 4 * q + r) * 64 + 16 * st + c16] = f2bf(g[r]); }
#pragma unroll
          for (int lt = 0; lt < 4; ++lt) { const bf16* cr = Cb + (16 * lt + c16) * 64 + 32 * nh + 4 * q;
              const f32x4_t yo = __builtin_amdgcn_mfma_f32_16x16x32_bf16(frag2(*(const u32x2*)cr, *(const u32x2*)(cr + 16)), Sf, z4, 0, 0, 0);
#pragma unroll
              for (int r = 0; r < 4; ++r) Yo[nh * 4096 + (16 * lt + 4 * q + r) * 64 + 16 * pt + c16] = yo[r]; }
          const float eL = __expf(acs[par * 64 + 63]);
          const bf16x8_t xb0 = *(const bf16x8_t*)(XT + (16 * pt + c16) * 64 + 8 * q), xb1 = *(const bf16x8_t*)(XT + (16 * pt + c16) * 64 + 32 + 8 * q);
#pragma unroll
          for (int i = 0; i < 2; ++i) { const bf16* br = BwT + (16 * (2 * nh + i) + c16) * 64 + 8 * q; f32x4_t cin = Sd[i] * eL;
              cin = __builtin_amdgcn_mfma_f32_16x16x32_bf16(*(const bf16x8_t*)br, xb0, cin, 0, 0, 0); Sd[i] = __builtin_amdgcn_mfma_f32_16x16x32_bf16(*(const bf16x8_t*)(br + 32), xb1, cin, 0, 0, 0); }
          u32x2 lo, hi; lo.x = pk2(Sd[0][0], Sd[0][1]); lo.y = pk2(Sd[0][2], Sd[0][3]); hi.x = pk2(Sd[1][0], Sd[1][1]); hi.y = pk2(Sd[1][2], Sd[1][3]); Sf = frag2(lo, hi); }
        LDS_SYNC();
        {
          const f32x4_t z4 = {0.f, 0.f, 0.f, 0.f};
#pragma unroll
          for (int i = 0; i < 2; ++i) { const int id = wave + 8 * i, lt = id >> 2, p2 = id & 3;
              f32x4_t y = __builtin_amdgcn_mfma_f32_16x16x32_bf16(*(const bf16x8_t*)(Pm + (16 * lt + c16) * 64 + 8 * q), *(const bf16x8_t*)(XT + (16 * p2 + c16) * 64 + 8 * q), z4, 0, 0, 0);
              if (lt >= 2) y = __builtin_amdgcn_mfma_f32_16x16x32_bf16(*(const bf16x8_t*)(Pm + (16 * lt + c16) * 64 + 32 + 8 * q), *(const bf16x8_t*)(XT + (16 * p2 + c16) * 64 + 32 + 8 * q), y, 0, 0, 0);
#pragma unroll
              for (int r = 0; r < 4; ++r) { const int l = 16 * lt + 4 * q + r, o = l * 64 + 16 * p2 + c16; Yo[o] = y[r] + __expf(acs[par * 64 + l]) * (Yo[o] + Yo[4096 + o]); } } }
        LDS_SYNC();
        {
          f32x4 x0, x1, z0, z1; pg8::unpack8(xk, x0, x1); pg8::unpack8(zk, z0, z1);
          const f32x4 y0 = (*(const f32x4*)(Yo + pp * 64 + c8) + Dh * x0) * z0 * sig4g(z0), y1 = (*(const f32x4*)(Yo + pp * 64 + c8 + 4) + Dh * x1) * z1 * sig4g(z1);
          *(u32x4*)(YA + (size_t)c0 * 512) = pg8::pack8(y0, y1); }
    }
#undef SSD_FETCH
#undef SSD_DT
}
__device__ __forceinline__ void ssd_norm_item4(KArgs C, int layer, int item0, int stride, int nitems, int lane) {
    u32x2 w[4]; bf16* p[4];
#pragma unroll
    for (int q = 0; q < 4; ++q) { const int item = item0 + q * stride; p[q] = WSP(bf16, WS_Y) + (size_t)((item < nitems ? item : item0) >> 1) * 512 + ((item < nitems ? item : item0) & 1) * 256 + lane * 4; w[q] = *(const u32x2*)p[q]; }
#pragma unroll
    for (int q = 0; q < 4; ++q) { const int item = item0 + q * stride; if (item < nitems) {
        float v[4] = {lo_bf(w[q].x), hi_bf(w[q].x), lo_bf(w[q].y), hi_bf(w[q].y)};
        const float rstd = 1.0f / sqrtf(wave_sum(v[0] * v[0] + v[1] * v[1] + v[2] * v[2] + v[3] * v[3]) * (1.f / 256) + RMS_EPS);
        const float* g = C->in[I_SSDNG] + layer * 512 + (item & 1) * 256 + lane * 4;
        u32x2 o; o.x = pk2(v[0] * rstd * g[0], v[1] * rstd * g[1]); o.y = pk2(v[2] * rstd * g[2], v[3] * rstd * g[3]); *(u32x2*)p[q] = o; } }
}
__device__ __forceinline__ void rwkv_prep_row(KArgs C, int layer, int m, int lane) {
    const int t = m % SEQ, col = 1536 + lane * 4;
    const bf16* cur = WSP(const bf16, WS_RW) + (size_t)m * 1792 + col;
    const u32x2 wc = *(const u32x2*)cur; u32x2 wp; wp.x = 0u; wp.y = 0u; if (t > 0) wp = *(const u32x2*)(cur - 1792);
    const f32x4 mu = *(const f32x4*)(C->in[I_MU] + layer * 1792 + col);
    float v[4] = {lo_bf(wc.x), hi_bf(wc.x), lo_bf(wc.y), hi_bf(wc.y)}; const float p[4] = {lo_bf(wp.x), hi_bf(wp.x), lo_bf(wp.y), hi_bf(wp.y)};
#pragma unroll
    for (int i = 0; i < 4; ++i) { v[i] = v[i] + (p[i] - v[i]) * mu[i]; v[i] = lane < 16 ? tanh_fast(v[i]) : (lane < 32 ? v[i] : sigm(v[i])); }
    u32x2 o; o.x = pk2(v[0], v[1]); o.y = pk2(v[2], v[3]); *(u32x2*)(WSP(bf16, WS_RA) + (size_t)m * 256 + lane * 4) = o;
}
__device__ __forceinline__ void rwkv_prep_row2(KArgs C, int layer, int m, int step, int lane) {
    const int col = 1536 + lane * 4; const f32x4 mu = *(const f32x4*)(C->in[I_MU] + layer * 1792 + col);
    u32x2 wc[2], wp[2];
#pragma unroll
    for (int r = 0; r < 2; ++r) { const int mm = m + r * step; const bf16* cur = WSP(const bf16, WS_RW) + (size_t)mm * 1792 + col; wc[r] = *(const u32x2*)cur;
        if (mm % SEQ > 0) wp[r] = *(const u32x2*)(cur - 1792); else { wp[r].x = 0u; wp[r].y = 0u; } }
#pragma unroll
    for (int r = 0; r < 2; ++r) { float v[4] = {lo_bf(wc[r].x), hi_bf(wc[r].x), lo_bf(wc[r].y), hi_bf(wc[r].y)}; const float p[4] = {lo_bf(wp[r].x), hi_bf(wp[r].x), lo_bf(wp[r].y), hi_bf(wp[r].y)};
#pragma unroll
        for (int i = 0; i < 4; ++i) { v[i] = v[i] + (p[i] - v[i]) * mu[i]; v[i] = lane < 16 ? tanh_fast(v[i]) : (lane < 32 ? v[i] : sigm(v[i])); }
        u32x2 o; o.x = pk2(v[0], v[1]); o.y = pk2(v[2], v[3]); *(u32x2*)(WSP(bf16, WS_RA) + (size_t)(m + r * step) * 256 + lane * 4) = o; }
}
__device__ __forceinline__ void rwkv_unit(KArgs C, int layer, int unit, unsigned char* lds) {
    constexpr int SLOT = 16704, O_RT = 2048, O_BTL = 4096, O_KTL = 6144, O_BHT = 8192, O_KHT = 10240, O_VT = 12288, O_TM = 14336, O_AAK = 14848, O_RB = 15360, O_RK = 15872, O_DL = 16384, O_BON = 16640;
    const int tid = fresh_tid(), lane = tid & 63, wave = tid >> 6, bl = unit >> 3, h = unit & 7, pt = tid >> 3, k8 = (tid & 7) * 8, cc = pt >> 4, tl = pt & 15, hc = h * 64 + k8;
    float* WL = (float*)(lds + 4 * SLOT); float* Nf = WL + 4096; float* Yb = Nf + 1024; float* ct_ = Yb + 4096;
    const bf16* RW = WSP(const bf16, WS_RW) + (size_t)bl * SEQ * 1792 + hc;
    const float* WLG = WSP(const float, WS_WLOG) + (size_t)bl * SEQ * 512 + hc;
    const bf16* AS = WSP(const bf16, WS_ASIG) + (size_t)bl * SEQ * 512 + hc;
    const bf16* GG = WSP(const bf16, WS_GG) + (size_t)bl * SEQ * 512 + hc;
    bf16* YC = WSP(bf16, WS_Y) + (size_t)2 * MG * 512 + (size_t)bl * SEQ * 512 + hc;
    LDS_SYNC();
    { const int row = tid >> 6, j = tid & 63; const float* src = row == 0 ? C->in[I_MU] + layer * 1792 : row == 1 ? C->in[I_MU] + layer * 1792 + 512 : row == 2 ? C->in[I_MU] + layer * 1792 + 1024
          : row == 3 ? C->in[I_KK] + layer * 512 : row == 4 ? C->in[I_KA] + layer * 512 : row == 5 ? C->in[I_RK] + layer * 512 : row == 6 ? C->in[I_LNG] + layer * 512 : C->in[I_LNB] + layer * 512;
      ct_[tid] = src[h * 64 + j]; }
    f32x4_t Sd[4]; bf16x8_t Sf[2];
#pragma unroll
    for (int i = 0; i < 4; ++i) Sd[i] = (f32x4_t){0.f, 0.f, 0.f, 0.f};
    { u32x2 z; z.x = 0u; z.y = 0u; Sf[0] = frag2(z, z); Sf[1] = Sf[0]; }
    u32x4 rc, rp, kc, kp, vc, vp, ac, gc; f32x4 wl0, wl1;
#define RWKV_FETCH(c0_) do { const int tt_ = (c0_) + pt; const bf16* q_ = RW + (size_t)tt_ * 1792; \
        rc = *(const u32x4*)q_; kc = *(const u32x4*)(q_ + 512); vc = *(const u32x4*)(q_ + 1024); \
        if (tt_ > 0) { rp = *(const u32x4*)(q_ - 1792); kp = *(const u32x4*)(q_ - 1792 + 512); vp = *(const u32x4*)(q_ - 1792 + 1024); } else { rp = (u32x4){0u, 0u, 0u, 0u}; kp = rp; vp = rp; } \
        wl0 = *(const f32x4*)(WLG + (size_t)tt_ * 512); wl1 = *(const f32x4*)(WLG + (size_t)tt_ * 512 + 4); ac = *(const u32x4*)(AS + (size_t)tt_ * 512); gc = *(const u32x4*)(GG + (size_t)tt_ * 512); } while (0)
    RWKV_FETCH(0);
    LDS_SYNC();
    for (int c0 = 0; c0 < SEQ; c0 += 64) {
        unsigned char* slot = lds + cc * SLOT;
        f32x4 r0, r1, kq0, kq1, v0, v1, kk0, kk1, b0, b1; const u32x4 gkeep = gc; const f32x4 wk0 = wl0, wk1 = wl1; float bo;
        { f32x4 c0_, c1_, p0_, p1_, a0, a1;
          pg8::unpack8(rc, c0_, c1_); pg8::unpack8(rp, p0_, p1_); r0 = c0_ + (p0_ - c0_) * *(const f32x4*)(ct_ + k8); r1 = c1_ + (p1_ - c1_) * *(const f32x4*)(ct_ + k8 + 4);
          pg8::unpack8(kc, c0_, c1_); pg8::unpack8(kp, p0_, p1_); const f32x4 k00 = c0_ + (p0_ - c0_) * *(const f32x4*)(ct_ + 64 + k8), k01 = c1_ + (p1_ - c1_) * *(const f32x4*)(ct_ + 64 + k8 + 4);
          pg8::unpack8(vc, c0_, c1_); pg8::unpack8(vp, p0_, p1_); v0 = c0_ + (p0_ - c0_) * *(const f32x4*)(ct_ + 128 + k8); v1 = c1_ + (p1_ - c1_) * *(const f32x4*)(ct_ + 128 + k8 + 4);
          pg8::unpack8(ac, a0, a1);
          kk0 = k00 * *(const f32x4*)(ct_ + 192 + k8); kk1 = k01 * *(const f32x4*)(ct_ + 192 + k8 + 4);
          const float inv = 1.0f / fmaxf(sqrtf(red8((kk0.x * kk0.x + kk0.y * kk0.y + kk0.z * kk0.z + kk0.w * kk0.w) + (kk1.x * kk1.x + kk1.y * kk1.y + kk1.z * kk1.z + kk1.w * kk1.w))), 1e-12f);
          kk0 = kk0 * inv; kk1 = kk1 * inv; b0 = kk0 * a0; b1 = kk1 * a1;
          kq0 = k00 * (1.0f + (a0 - 1.0f) * *(const f32x4*)(ct_ + 256 + k8)); kq1 = k01 * (1.0f + (a1 - 1.0f) * *(const f32x4*)(ct_ + 256 + k8 + 4));
          const f32x4 q0 = r0 * kq0 * *(const f32x4*)(ct_ + 320 + k8), q1 = r1 * kq1 * *(const f32x4*)(ct_ + 320 + k8 + 4);
          bo = red8((q0.x + q0.y + q0.z + q0.w) + (q1.x + q1.y + q1.z + q1.w));
          *(f32x4*)(WL + pt * 64 + k8) = wk0; *(f32x4*)(WL + pt * 64 + k8 + 4) = wk1; }
        if (c0 + 64 < SEQ) RWKV_FETCH(c0 + 64);
        LDS_SYNC();
        if (tid < 256) { const int c_ = tid >> 6, k_ = tid & 63; float w16[16], run = 0.f;
#pragma unroll
            for (int t = 0; t < 16; ++t) w16[t] = WL[(c_ * 16 + t) * 64 + k_];
#pragma unroll
            for (int t = 0; t < 16; ++t) { run += w16[t]; WL[(c_ * 16 + t) * 64 + k_] = run; }
            ((float*)(lds + c_ * SLOT + O_DL))[k_] = __expf(run); }
        LDS_SYNC();
        { const f32x4 cs0 = *(const f32x4*)(WL + pt * 64 + k8), cs1 = *(const f32x4*)(WL + pt * 64 + k8 + 4), d0 = *(const f32x4*)((const float*)(slot + O_DL) + k8), d1 = *(const f32x4*)((const float*)(slot + O_DL) + k8 + 4);
          f32x4 e0, e1, f0, f1, w0, w1;
#pragma unroll
          for (int i = 0; i < 4; ++i) { e0[i] = __expf(cs0[i]); e1[i] = __expf(cs1[i]); f0[i] = __builtin_amdgcn_rcpf(e0[i]); f1[i] = __builtin_amdgcn_rcpf(e1[i]); w0[i] = __expf(-wk0[i]); w1[i] = __expf(-wk1[i]); }
          const f32x4 bt0 = b0 * f0, bt1 = b1 * f1, kt0 = kq0 * f0, kt1 = kq1 * f1;
          *(u32x4*)((bf16*)slot + tl * 64 + k8) = pg8::pack8(-(kk0 * e0 * w0), -(kk1 * e1 * w1));
          *(u32x4*)((bf16*)(slot + O_RT) + tl * 64 + k8) = pg8::pack8(r0 * e0, r1 * e1);
          *(u32x4*)((bf16*)(slot + O_BTL) + tl * 64 + k8) = pg8::pack8(bt0, bt1);
          *(u32x4*)((bf16*)(slot + O_KTL) + tl * 64 + k8) = pg8::pack8(kt0, kt1);
          const f32x4 bh0 = bt0 * d0, bh1 = bt1 * d1, kh0 = kt0 * d0, kh1 = kt1 * d1;
          bf16* bht = (bf16*)(slot + O_BHT) + k8 * 16 + tl; bf16* kht = (bf16*)(slot + O_KHT) + k8 * 16 + tl; bf16* vt = (bf16*)(slot + O_VT) + k8 * 16 + tl;
#pragma unroll
          for (int i = 0; i < 4; ++i) { bht[i * 16] = f2bf(bh0[i]); bht[(i + 4) * 16] = f2bf(bh1[i]); kht[i * 16] = f2bf(kh0[i]); kht[(i + 4) * 16] = f2bf(kh1[i]); vt[i * 16] = f2bf(v0[i]); vt[(i + 4) * 16] = f2bf(v1[i]); } }
        LDS_SYNC();
        { unsigned char* sl = lds + (wave & 3) * SLOT; const int c16 = lane & 15, q = lane >> 4;
          const bf16x8_t a0 = *(const bf16x8_t*)((const bf16*)sl + c16 * 64 + 8 * q), a1 = *(const bf16x8_t*)((const bf16*)sl + c16 * 64 + 32 + 8 * q);
          const bf16x8_t bb0 = *(const bf16x8_t*)((const bf16*)(sl + O_BTL) + c16 * 64 + 8 * q), bb1 = *(const bf16x8_t*)((const bf16*)(sl + O_BTL) + c16 * 64 + 32 + 8 * q);
          const f32x4_t z4 = {0.f, 0.f, 0.f, 0.f};
          if (wave < 4) {
              f32x4_t n = __builtin_amdgcn_mfma_f32_16x16x32_bf16(a0, bb0, z4, 0, 0, 0); n = __builtin_amdgcn_mfma_f32_16x16x32_bf16(a1, bb1, n, 0, 0, 0);
              float* nf = Nf + (wave & 3) * 256;
#pragma unroll
              for (int r = 0; r < 4; ++r) nf[c16 * 16 + 4 * q + r] = (c16 < 4 * q + r) ? n[r] : 0.f;
              WAVE_SYNC();
              float tc[16];
#pragma unroll
              for (int t = 0; t < 16; ++t) tc[t] = (t == c16) ? 1.f : 0.f;
#pragma unroll
              for (int s2 = 0; s2 < 15; ++s2) { const f32x4 n0 = *(const f32x4*)(nf + s2 * 16), n1 = *(const f32x4*)(nf + s2 * 16 + 4), n2 = *(const f32x4*)(nf + s2 * 16 + 8), n3 = *(const f32x4*)(nf + s2 * 16 + 12);
                  const float ts = tc[s2]; const float nn[16] = {n0.x, n0.y, n0.z, n0.w, n1.x, n1.y, n1.z, n1.w, n2.x, n2.y, n2.z, n2.w, n3.x, n3.y, n3.z, n3.w};
#pragma unroll
                  for (int t = 0; t < 16; ++t) if (t > s2) tc[t] += nn[t] * ts; }
              if (q == 0) { bf16* tm = (bf16*)(sl + O_TM) + c16;
#pragma unroll
                  for (int t = 0; t < 16; ++t) tm[t * 16] = f2bf(tc[t]); }
          } else {
              const bf16x8_t r0f = *(const bf16x8_t*)((const bf16*)(sl + O_RT) + c16 * 64 + 8 * q), r1f = *(const bf16x8_t*)((const bf16*)(sl + O_RT) + c16 * 64 + 32 + 8 * q);
              const bf16x8_t kb0 = *(const bf16x8_t*)((const bf16*)(sl + O_KTL) + c16 * 64 + 8 * q), kb1 = *(const bf16x8_t*)((const bf16*)(sl + O_KTL) + c16 * 64 + 32 + 8 * q);
              f32x4_t ak = __builtin_amdgcn_mfma_f32_16x16x32_bf16(a0, kb0, z4, 0, 0, 0); ak = __builtin_amdgcn_mfma_f32_16x16x32_bf16(a1, kb1, ak, 0, 0, 0);
              f32x4_t rb = __builtin_amdgcn_mfma_f32_16x16x32_bf16(r0f, bb0, z4, 0, 0, 0); rb = __builtin_amdgcn_mfma_f32_16x16x32_bf16(r1f, bb1, rb, 0, 0, 0);
              f32x4_t rk = __builtin_amdgcn_mfma_f32_16x16x32_bf16(r0f, kb0, z4, 0, 0, 0); rk = __builtin_amdgcn_mfma_f32_16x16x32_bf16(r1f, kb1, rk, 0, 0, 0);
#pragma unroll
              for (int r = 0; r < 4; ++r) { const int t = 4 * q + r;
                  ((bf16*)(sl + O_AAK))[t * 16 + c16] = f2bf(c16 < t ? ak[r] : 0.f); ((bf16*)(sl + O_RB))[t * 16 + c16] = f2bf(c16 <= t ? rb[r] : 0.f); ((bf16*)(sl + O_RK))[t * 16 + c16] = f2bf(c16 <= t ? rk[r] : 0.f); }
          } }
        LDS_SYNC();
        if (wave < 4) { const int c16 = lane & 15, q = lane >> 4, vcol = 16 * wave + c16; u32x2 zz; zz.x = 0u; zz.y = 0u; const f32x4_t z4 = {0.f, 0.f, 0.f, 0.f};
#pragma unroll
            for (int ch = 0; ch < 4; ++ch) { const unsigned char* sl = lds + ch * SLOT;
                const bf16* at = (const bf16*)sl + c16 * 64 + 4 * q; const bf16* rt = (const bf16*)(sl + O_RT) + c16 * 64 + 4 * q;
                const bf16x8_t af0 = frag2(*(const u32x2*)at, *(const u32x2*)(at + 16)), af1 = frag2(*(const u32x2*)(at + 32), *(const u32x2*)(at + 48));
                const bf16x8_t rf0 = frag2(*(const u32x2*)rt, *(const u32x2*)(rt + 16)), rf1 = frag2(*(const u32x2*)(rt + 32), *(const u32x2*)(rt + 48));
                const u32x2 vq = *(const u32x2*)((const bf16*)(sl + O_VT) + vcol * 16 + 4 * q);
                const u32x2 aq = *(const u32x2*)((const bf16*)(sl + O_AAK) + c16 * 16 + 4 * q), tq = *(const u32x2*)((const bf16*)(sl + O_TM) + c16 * 16 + 4 * q);
                const u32x2 rbq = *(const u32x2*)((const bf16*)(sl + O_RB) + c16 * 16 + 4 * q), rkq = *(const u32x2*)((const bf16*)(sl + O_RK) + c16 * 16 + 4 * q);
                f32x4_t rhs = __builtin_amdgcn_mfma_f32_16x16x32_bf16(frag2(zz, aq), frag2(zz, vq), z4, 0, 0, 0); rhs = __builtin_amdgcn_mfma_f32_16x16x32_bf16(af0, Sf[0], rhs, 0, 0, 0);
                { const f32x4_t r2 = __builtin_amdgcn_mfma_f32_16x16x32_bf16(af1, Sf[1], z4, 0, 0, 0); rhs = rhs + r2; }
                u32x2 rl; rl.x = pk2(rhs[0], rhs[1]); rl.y = pk2(rhs[2], rhs[3]);
                const f32x4_t U = __builtin_amdgcn_mfma_f32_16x16x32_bf16(frag2(tq, zz), frag2(rl, zz), z4, 0, 0, 0);
                u32x2 ul; ul.x = pk2(U[0], U[1]); ul.y = pk2(U[2], U[3]); const bf16x8_t uv = frag2(ul, vq);
                f32x4_t y = __builtin_amdgcn_mfma_f32_16x16x32_bf16(rf0, Sf[0], z4, 0, 0, 0); y = __builtin_amdgcn_mfma_f32_16x16x32_bf16(rf1, Sf[1], y, 0, 0, 0);
                y = __builtin_amdgcn_mfma_f32_16x16x32_bf16(frag2(rbq, rkq), uv, y, 0, 0, 0);
#pragma unroll
                for (int r = 0; r < 4; ++r) Yb[(ch * 16 + 4 * q + r) * 64 + vcol] = y[r];
#pragma unroll
                for (int kt = 0; kt < 4; ++kt) { const f32x4 dl = *(const f32x4*)((const float*)(sl + O_DL) + 16 * kt + 4 * q);
                    const u32x2 bq = *(const u32x2*)((const bf16*)(sl + O_BHT) + (16 * kt + c16) * 16 + 4 * q), kq = *(const u32x2*)((const bf16*)(sl + O_KHT) + (16 * kt + c16) * 16 + 4 * q);
                    const f32x4_t cin = {Sd[kt][0] * dl.x, Sd[kt][1] * dl.y, Sd[kt][2] * dl.z, Sd[kt][3] * dl.w};
                    Sd[kt] = __builtin_amdgcn_mfma_f32_16x16x32_bf16(frag2(bq, kq), uv, cin, 0, 0, 0); }
#pragma unroll
                for (int s2 = 0; s2 < 2; ++s2) { u32x2 lo, hi; lo.x = pk2(Sd[2 * s2][0], Sd[2 * s2][1]); lo.y = pk2(Sd[2 * s2][2], Sd[2 * s2][3]); hi.x = pk2(Sd[2 * s2 + 1][0], Sd[2 * s2 + 1][1]); hi.y = pk2(Sd[2 * s2 + 1][2], Sd[2 * s2 + 1][3]); Sf[s2] = frag2(lo, hi); }
            } }
        LDS_SYNC();
        { const f32x4 y0 = *(const f32x4*)(Yb + pt * 64 + k8), y1 = *(const f32x4*)(Yb + pt * 64 + k8 + 4);
          const float mean = red8((y0.x + y0.y + y0.z + y0.w) + (y1.x + y1.y + y1.z + y1.w)) * (1.f / 64); const f32x4 d0 = y0 - mean, d1 = y1 - mean;
          const float rstd = 1.0f / sqrtf(red8((d0.x * d0.x + d0.y * d0.y + d0.z * d0.z + d0.w * d0.w) + (d1.x * d1.x + d1.y * d1.y + d1.z * d1.z + d1.w * d1.w)) * (1.f / 64) + GN_EPS);
          f32x4 g0, g1; pg8::unpack8(gkeep, g0, g1);
          const f32x4 o0 = (d0 * rstd * *(const f32x4*)(ct_ + 384 + k8) + *(const f32x4*)(ct_ + 448 + k8) + bo * v0) * g0, o1 = (d1 * rstd * *(const f32x4*)(ct_ + 384 + k8 + 4) + *(const f32x4*)(ct_ + 448 + k8 + 4) + bo * v1) * g1;
          *(u32x4*)(YC + (size_t)(c0 + pt) * 512) = pg8::pack8(o0, o1); }
    }
#undef RWKV_FETCH
}

__device__ __forceinline__ void s5_unit(KArgs C, int layer, int unit, unsigned char* lds) {
    const int tid = fresh_tid(), lane = tid & 63, wave = tid >> 6, bl = unit >> 5, g = unit & 31, c16 = lane & 15, q = lane >> 4, sg = wave & 3, th = wave >> 2, p = 16 * sg + c16;
    constexpr int SP = 136;
    float* us = (float*)lds; float* ends = us + 1024; bf16* St = (bf16*)(ends + 16 * 128);
    const bf16* U = WSP(const bf16, WS_U) + (size_t)bl * SEQ * 512 + g * 16;
    bf16* YD0 = WSP(bf16, WS_YD0) + (size_t)bl * SEQ * 512 + g * 16;
    const size_t wo = (layer & 1) ? WDELTA : 0;
    bf16x8_t bre, bim;
    { const float* bb = WSP(const float, WS_BBAR + wo) + ((size_t)g * 64 + p) * 32; u32x4 wr_, wi_;
      if (q < 2) { const float* b8 = bb + 16 * q; wr_.x = pk2(b8[0], b8[2]); wr_.y = pk2(b8[4], b8[6]); wr_.z = pk2(b8[8], b8[10]); wr_.w = pk2(b8[12], b8[14]);
                   wi_.x = pk2(b8[1], b8[3]); wi_.y = pk2(b8[5], b8[7]); wi_.z = pk2(b8[9], b8[11]); wi_.w = pk2(b8[13], b8[15]); }
      else { wr_ = (u32x4){0u, 0u, 0u, 0u}; wi_ = wr_; }
      bre = __builtin_bit_cast(bf16x8_t, wr_); bim = __builtin_bit_cast(bf16x8_t, wi_); }
    float apr[4], api[4];
    { const float ar = WSP(const float, WS_ABAR + wo)[(g * 64 + p) * 2], ai = WSP(const float, WS_ABAR + wo)[(g * 64 + p) * 2 + 1]; apr[0] = ar; api[0] = ai;
#pragma unroll
      for (int i = 1; i < 4; ++i) { apr[i] = apr[i - 1] * ar - api[i - 1] * ai; api[i] = apr[i - 1] * ai + api[i - 1] * ar; } }
    bf16x8_t cf[4];
    { const float* cre = C->in[I_S5CRE] + ((size_t)layer * 32 + g) * 1024 + c16 * 64; const float* cim = C->in[I_S5CIM] + ((size_t)layer * 32 + g) * 1024 + c16 * 64;
#pragma unroll
      for (int ks = 0; ks < 4; ++ks) { const int c0_ = 32 * ks + 8 * q; const float* src = c0_ < 64 ? cre + c0_ : cim + (c0_ - 64); const float sgn = c0_ < 64 ? 1.f : -1.f;
          u32x4 w; w.x = pk2(sgn * src[0], sgn * src[1]); w.y = pk2(sgn * src[2], sgn * src[3]); w.z = pk2(sgn * src[4], sgn * src[5]); w.w = pk2(sgn * src[6], sgn * src[7]); cf[ks] = __builtin_bit_cast(bf16x8_t, w); } }
    const float dj = C->in[I_S5D][layer * 512 + g * 16 + c16];
    float cr = 0.f, ci = 0.f;
    u32x2 fu; fu.x = 0u; fu.y = 0u;
#define S5_FETCH(c0_) do { if (tid < 256) fu = *(const u32x2*)(U + (size_t)((c0_) + (tid >> 2)) * 512 + (tid & 3) * 4); } while (0)
    S5_FETCH(0);
    for (int c0 = 0; c0 < SEQ; c0 += 64) {
        LDS_SYNC();
        if (tid < 256) *(f32x4*)(us + (tid >> 2) * 16 + (tid & 3) * 4) = (f32x4){lo_bf(fu.x), hi_bf(fu.x), lo_bf(fu.y), hi_bf(fu.y)};
        if (c0 + 64 < SEQ) S5_FETCH(c0 + 64);
        LDS_SYNC();
        float lr[2][4], li[2][4];
#pragma unroll
        for (int tt = 0; tt < 2; ++tt) { bf16x8_t af;
            if (q < 2) { const float* ur = us + (32 * th + 16 * tt + c16) * 16 + 8 * q; const f32x4 u0 = *(const f32x4*)ur, u1 = *(const f32x4*)(ur + 4);
                u32x4 w; w.x = pk2(u0.x, u0.y); w.y = pk2(u0.z, u0.w); w.z = pk2(u1.x, u1.y); w.w = pk2(u1.z, u1.w); af = __builtin_bit_cast(bf16x8_t, w); }
            else { const u32x4 z = {0u, 0u, 0u, 0u}; af = __builtin_bit_cast(bf16x8_t, z); }
            const f32x4_t z4 = {0.f, 0.f, 0.f, 0.f};
            const f32x4_t dre = __builtin_amdgcn_mfma_f32_16x16x32_bf16(af, bre, z4, 0, 0, 0), dim = __builtin_amdgcn_mfma_f32_16x16x32_bf16(af, bim, z4, 0, 0, 0);
            lr[tt][0] = dre[0]; li[tt][0] = dim[0];
#pragma unroll
            for (int r = 1; r < 4; ++r) { lr[tt][r] = apr[0] * lr[tt][r - 1] - api[0] * li[tt][r - 1] + dre[r]; li[tt][r] = apr[0] * li[tt][r - 1] + api[0] * lr[tt][r - 1] + dim[r]; }
            const int rho = (2 * th + tt) * 4 + q; ends[(rho * 64 + p) * 2] = lr[tt][3]; ends[(rho * 64 + p) * 2 + 1] = li[tt][3]; }
        LDS_SYNC();
        { float xr = cr, xi = ci; const int rho0 = (2 * th) * 4 + q;
          for (int rr = 0; rr < 16; ++rr) {
              if (rr == rho0 || rr == rho0 + 4) { const int tt = (rr == rho0) ? 0 : 1;
#pragma unroll
                  for (int r = 0; r < 4; ++r) { const float sr = lr[tt][r] + apr[r] * xr - api[r] * xi, si = li[tt][r] + apr[r] * xi + api[r] * xr; const int t = 32 * th + 16 * tt + 4 * q + r;
                      St[t * SP + p] = f2bf(sr); St[t * SP + 64 + p] = f2bf(si); } }
              const float er = ends[(rr * 64 + p) * 2], ei = ends[(rr * 64 + p) * 2 + 1]; const float nr = apr[3] * xr - api[3] * xi + er, ni = apr[3] * xi + api[3] * xr + ei; xr = nr; xi = ni; }
          cr = xr; ci = xi; }
        LDS_SYNC();
        if (wave < 4) { f32x4_t y = {0.f, 0.f, 0.f, 0.f};
#pragma unroll
            for (int ks = 0; ks < 4; ++ks) y = __builtin_amdgcn_mfma_f32_16x16x32_bf16(*(const bf16x8_t*)(St + (16 * wave + c16) * SP + 32 * ks + 8 * q), cf[ks], y, 0, 0, 0);
#pragma unroll
            for (int r = 0; r < 4; ++r) { const int t = 16 * wave + 4 * q + r; YD0[(size_t)(c0 + t) * 512 + c16] = f2bf(gelu_tanh(y[r] + dj * us[t * 16 + c16])); } }
    }
#undef S5_FETCH
}

__device__ __forceinline__ unsigned ord_key(float f) { const unsigned u = __float_as_uint(f); return (u & 0x80000000u) ? ~u : (u | 0x80000000u); }
__device__ __forceinline__ void dsa_vt_item(KArgs C, int item, int lane, bf16* scr) {
    const int tb = item % NK64, bh = item / NK64, h = bh & 7, bl = bh >> 3;
    const bf16* V = WSP(const bf16, WS_V) + ((size_t)bl * SEQ + tb * 64) * 512 + h * 64;
    WAVE_SYNC();
#pragma unroll
    for (int i = 0; i < 8; ++i) { const int tk = (lane >> 3) + 8 * i, c8 = (lane & 7) * 8; const u32x4 w = *(const u32x4*)(V + (size_t)tk * 512 + c8);
        unsigned* d = (unsigned*)(scr + tk * 66 + c8); d[0] = w.x; d[1] = w.y; d[2] = w.z; d[3] = w.w; }
    WAVE_SYNC();
    bf16* Vt = WSP(bf16, WS_VT) + ((size_t)bh * 64) * SEQ + tb * 64 + lane;
#pragma unroll 8
    for (int d = 0; d < 64; ++d) Vt[(size_t)d * SEQ] = scr[lane * 66 + d];
}
constexpr int IDX_CAP = 128, IDX_NBIN = 1024;
__device__ __forceinline__ void dsa_index_unit(KArgs C, int unit, int lane, int wave, unsigned char* lds) {
    const int oct = unit & 7, pairid = (unit >> 3) % (NK64 / 2), kx = (unit >> 3) / (NK64 / 2), bl = kx >> 1, c = (kx & 1) ? NK64 - 1 - pairid : pairid;
    const int t0 = c * 64 + oct * 8, nkeys = (c + 1) * 64, nk64 = c + 1; const size_t row0 = (size_t)bl * SEQ + t0;
    unsigned* mrow = WSP(unsigned, WS_MASK) + (row0 + wave) * MW;
    if (nkeys <= TOPK) { for (int w = lane; w < MW; w += 64) mrow[w] = (w * 32 < nkeys) ? 0xffffffffu : 0u; return; }
    float* scf = (float*)lds;
    unsigned* hist = (unsigned*)(lds + LDS_X) + wave * (IDX_NBIN / 2); unsigned* candv = (unsigned*)(lds + LDS_X + 8 * IDX_NBIN * 2) + wave * IDX_CAP; unsigned* candi = candv + 8 * IDX_CAP; unsigned* mword = (unsigned*)(lds + LDS_X + 8 * IDX_NBIN * 2 + 16 * IDX_CAP * 4) + wave * MW;
    const bf16* SMb = WSP(const bf16, WS_SM) + (size_t)bl * SEQ * 256;
    const int l31 = lane & 31, half = lane >> 5;
    const bf16* qa = SMb + (size_t)(t0 + (l31 >> 2)) * 256 + 8 + (l31 & 3) * 32 + 8 * half;
    const bf16x8_t a0 = *(const bf16x8_t*)qa, a1 = *(const bf16x8_t*)(qa + 16);
    u32x2 wraw[4];
#pragma unroll
    for (int g = 0; g < 4; ++g) wraw[g] = *(const u32x2*)(SMb + (size_t)(t0 + 2 * g + half) * 256 + 168);
    LDS_SYNC();
    {
      float wv[4][4];
#pragma unroll
      for (int g = 0; g < 4; ++g) { const u32x2 w = wraw[g]; wv[g][0] = lo_bf(w.x) * 0.5f; wv[g][1] = hi_bf(w.x) * 0.5f; wv[g][2] = lo_bf(w.y) * 0.5f; wv[g][3] = hi_bf(w.y) * 0.5f; }
      for (int kt0 = wave; kt0 < nk64 * 2; kt0 += 8 * NWAVES) {
          bf16x8_t b0[8], b1[8];
#pragma unroll
          for (int u4 = 0; u4 < 8; ++u4) { const int kt = kt0 + 8 * u4; const bf16* kb = WSP(const bf16, WS_KI) + ((size_t)bl * SEQ + (size_t)((kt < nk64 * 2 ? kt : wave) * 32 + l31)) * 32 + 8 * half;
              b0[u4] = *(const bf16x8_t*)kb; b1[u4] = *(const bf16x8_t*)(kb + 16); }
#pragma unroll
          for (int u4 = 0; u4 < 8; ++u4) { const int kt = kt0 + 8 * u4; if (kt < nk64 * 2) {
              f32x16 d;
#pragma unroll
              for (int r = 0; r < 16; ++r) d[r] = 0.f;
              d = __builtin_amdgcn_mfma_f32_32x32x16_bf16(a0, b0[u4], d, 0, 0, 0); d = __builtin_amdgcn_mfma_f32_32x32x16_bf16(a1, b1[u4], d, 0, 0, 0);
#pragma unroll
              for (int g = 0; g < 4; ++g) { float sc = 0.f;
#pragma unroll
                  for (int j = 0; j < 4; ++j) sc += wv[g][j] * fmaxf(d[4 * g + j] * 0.17677669529f, 0.f);
                  scf[(2 * g + half) * SEQ + kt * 32 + l31] = sc; } } }
      } }
    { const int tail0 = nkeys, tail1 = ((nk64 + 7) >> 3) * 512;
      for (int e = tail0 + (int)(threadIdx.x); e < tail1; e += NTHREADS) {
#pragma unroll
          for (int qq = 0; qq < 8; ++qq) scf[qq * SEQ + e] = -3.0e38f; } }
    LDS_SYNC();
    const float* sc = scf + wave * SEQ; constexpr float NEG = -3.0e38f; const int nb8 = (nk64 + 7) >> 3;
    float v[NK64];
#pragma unroll
    for (int ib = 0; ib < NK64 / 8; ++ib) if (ib < nb8) {
#pragma unroll
        for (int j = 0; j < 8; ++j) v[ib * 8 + j] = sc[(ib * 8 + j) * 64 + lane];
        SCHED_FENCE(); }
    float mn = INFINITY, mx = -INFINITY;
#pragma unroll
    for (int ib = 0; ib < NK64 / 8; ++ib) if (ib < nb8) {
#pragma unroll
        for (int j = 0; j < 8; ++j) { const float x = v[ib * 8 + j]; mx = fmaxf(mx, x); mn = fminf(mn, x == NEG ? INFINITY : x); } }
    mn = -wave_max(-mn); mx = wave_max(mx);
    const float scale = (mx > mn) ? ((float)(IDX_NBIN - 2) - 0.01f) / (mx - mn) : 0.f;
#pragma unroll
    for (int i = 0; i < IDX_NBIN / 128; ++i) hist[lane * (IDX_NBIN / 128) + i] = 0u;
    for (int w = lane; w < MW; w += 64) mword[w] = 0u;
    WAVE_SYNC();
#define IDX_BIN(x) ({ const float x_ = (x); int b_ = (int)(fmaxf(x_ - mn, 0.f) * scale + 1.0f); b_ = b_ > IDX_NBIN - 2 ? IDX_NBIN - 2 : b_; b_ + (__float_as_int(x_) >> 31) + (__float_as_int(x_) > 0 ? 1 : 0); })
#pragma unroll
    for (int ib = 0; ib < NK64 / 8; ++ib) if (ib < nb8) {
#pragma unroll
        for (int j = 0; j < 8; ++j) { const int b = IDX_BIN(v[ib * 8 + j]); atomicAdd(&hist[b >> 1], (b & 1) ? 0x10000u : 1u); }
        SCHED_FENCE(); }
    WAVE_SYNC();
    int bstar, cgt;
    {
      unsigned hw[8]; int tot = 0;
#pragma unroll
      for (int i = 0; i < 8; ++i) { hw[i] = hist[lane * 8 + i]; tot += (int)(hw[i] & 0xffffu) + (int)(hw[i] >> 16); }
      int suf = tot;
#pragma unroll
      for (int o = 1; o < 64; o <<= 1) { const int t = __shfl_down(suf, o); if (lane + o < 64) suf += t; }
      const unsigned long long ge = __ballot(suf >= TOPK); const int L = 63 - __builtin_clzll(ge);
      int cum = __shfl(suf, L) - __shfl(tot, L); bstar = 16 * L; cgt = cum; bool found = false;
#pragma unroll
      for (int i = 7; i >= 0; --i) { const unsigned w = (unsigned)__shfl((int)hw[i], L); const int chi = (int)(w >> 16), clo = (int)(w & 0xffffu);
          if (!found && cum + chi >= TOPK) { bstar = 16 * L + 2 * i + 1; cgt = cum; found = true; } cum += found ? 0 : chi;
          if (!found && cum + clo >= TOPK) { bstar = 16 * L + 2 * i; cgt = cum; found = true; } cum += found ? 0 : clo; } }
    const int need = TOPK - cgt; int ncand = 0;
    const bool tiebin = bstar == IDX_BIN(0.0f);
    unsigned mylo = 0u, myhi = 0u;
#pragma unroll
    for (int ib = 0; ib < NK64 / 8; ++ib) if (ib < nb8) {
#pragma unroll
        for (int j = 0; j < 8; ++j) { const int i = ib * 8 + j; const int b = IDX_BIN(v[i]);
            unsigned long long bs = __ballot(b > bstar); const unsigned long long bc = __ballot(b == bstar);
            if (bc != 0ull) {
                const int pos = ncand + (int)__builtin_amdgcn_mbcnt_hi((unsigned)(bc >> 32), __builtin_amdgcn_mbcnt_lo((unsigned)bc, 0u));
                if (tiebin) bs |= __ballot(b == bstar && pos < need);
                else if (b == bstar && pos < IDX_CAP) { candv[pos] = ord_key(v[i]); candi[pos] = (unsigned)(i * 64 + lane); }
                ncand += __popcll(bc); }
            if (lane == i) { mylo = (unsigned)bs; myhi = (unsigned)(bs >> 32); } }
        SCHED_FENCE(); }
    if (lane < nb8 * 8) { mword[2 * lane] = mylo; mword[2 * lane + 1] = myhi; }
#undef IDX_BIN
    WAVE_SYNC();
    if (tiebin) { }
    else if (ncand <= IDX_CAP) {
        for (int m = lane; m < ncand; m += 64) { const unsigned vm = candv[m]; int rank = 0;
#pragma unroll 4
            for (int j = 0; j < ncand; ++j) { const unsigned vj = candv[j]; rank += (vj > vm || (vj == vm && j < m)) ? 1 : 0; }
            if (rank < need) { const unsigned idx = candi[m]; atomicOr(&mword[idx >> 5], 1u << (idx & 31)); } }
    } else {
        unsigned T = 0u;
        for (int bit = 31; bit >= 0; --bit) { const unsigned cand = T | (1u << bit); int cn = 0;
#pragma unroll
            for (int ib = 0; ib < NK64 / 8; ++ib) if (ib < nb8) {
#pragma unroll
                for (int j = 0; j < 8; ++j) cn += (ord_key(v[ib * 8 + j]) >= cand) ? 1 : 0; }
            if (wave_sum_i(cn) >= TOPK) T = cand; }
        int cg = 0;
#pragma unroll
        for (int ib = 0; ib < NK64 / 8; ++ib) if (ib < nb8) {
#pragma unroll
            for (int j = 0; j < 8; ++j) cg += (ord_key(v[ib * 8 + j]) > T) ? 1 : 0; }
        const int need2 = TOPK - wave_sum_i(cg); int taken = 0;
#pragma unroll
        for (int ib = 0; ib < NK64 / 8; ++ib) if (ib < nb8) {
#pragma unroll
            for (int j = 0; j < 8; ++j) { const int i = ib * 8 + j; const unsigned kv = ord_key(v[i]); const bool eq = kv == T; const unsigned long long be = __ballot(eq);
                const int pre = __popcll(be & ((1ull << lane) - 1ull)); const bool sel = (kv > T) || (eq && (taken + pre) < need2); taken += __popcll(be);
                const unsigned long long bs = __ballot(sel); if (lane == 0) { mword[2 * i] = (unsigned)bs; mword[2 * i + 1] = (unsigned)(bs >> 32); } } }
    }
    WAVE_SYNC();
#ifdef HOST_EMU
    if (lane == 0) { static int rows = 0, bad = 0, ties = 0, falls = 0; std::vector<int> id(nkeys); for (int i = 0; i < nkeys; ++i) id[i] = i;
        std::stable_sort(id.begin(), id.end(), [&](int a, int b) { return sc[a] > sc[b]; }); std::vector<unsigned> ref(MW, 0u); for (int i = 0; i < TOPK; ++i) ref[id[i] >> 5] |= 1u << (id[i] & 31);
        bool ok = true; for (int w = 0; w < MW; ++w) ok = ok && ref[w] == mword[w]; ++rows; bad += ok ? 0 : 1; ties += tiebin ? 1 : 0; falls += (!tiebin && ncand > IDX_CAP) ? 1 : 0;
        if ((rows & 63) == 0 || !ok) printf("[idx-check] rows %d bad %d tiebin %d fallback %d\n", rows, bad, ties, falls); }
#endif
    for (int w = lane; w < MW; w += 64) mrow[w] = mword[w];
}

constexpr int AT_KP = 72, AT_VP = 72, AT_BUF = 64 * AT_KP + 64 * AT_VP;
__device__ __forceinline__ void dsa_attn_half(KArgs C, int bl, int h, int cb, int tid, bf16* tiles, const float* btab) {
    const int lane = tid & 63, wave = tid >> 6, l31 = lane & 31, hh = lane >> 5, c = 4 * cb + (wave >> 1), qb = wave & 1, q0 = c * 64 + qb * 32, qpos = q0 + l31, q0s = __builtin_amdgcn_readfirstlane(q0);
    const size_t qrow = (size_t)bl * SEQ + qpos;
    const bf16* Qp = WSP(const bf16, WS_Q) + qrow * 512 + h * 64 + 8 * hh;
    const unsigned* Mp = WSP(const unsigned, WS_MASK) + qrow * MW;
    const bf16* gk = WSP(const bf16, WS_K) + ((size_t)bl * SEQ + (tid >> 3)) * 512 + h * 64 + (tid & 7) * 8;
    const bf16* gv = WSP(const bf16, WS_VT) + ((size_t)(bl * 8 + h) * 64 + (tid >> 3)) * SEQ + (tid & 7) * 8;
    const int lk = (tid >> 3) * AT_KP + (tid & 7) * 8, lv = 64 * AT_KP + (tid >> 3) * AT_VP + (tid & 7) * 8;
    constexpr float SC = 0.125f * 1.44269504089f;
    bf16x8_t qf[4];
#pragma unroll
    for (int s = 0; s < 4; ++s) qf[s] = *(const bf16x8_t*)(Qp + 16 * s);
    f32x16 O0, O1;
#pragma unroll
    for (int r = 0; r < 16; ++r) { O0[r] = 0.f; O1[r] = 0.f; }
    float m = -1e30f, lsum = 0.f;
    const int ntw = c + 1, nt = 4 * cb + 4;
    u32x4 prek = *(const u32x4*)gk, prev = *(const u32x4*)gv; u32x2 mwn = *(const u32x2*)Mp;
    LDS_SYNC();
    const float bfar = btab[0];
    *(u32x4*)(tiles + lk) = prek; *(u32x4*)(tiles + lv) = prev;
    if (nt > 1) { prek = *(const u32x4*)(gk + (size_t)64 * 512); prev = *(const u32x4*)(gv + 64); }
    for (int kt = 0; kt < nt; ++kt) {
        LDS_SYNC();
        const bf16* tb = tiles + (kt & 1) * AT_BUF; const u32x2 mw2 = mwn;
        if (kt + 1 < ntw) mwn = *(const u32x2*)(Mp + 2 * (kt + 1));
        if (kt < ntw) {
            f32x16 S[2];
#pragma unroll
            for (int t2 = 0; t2 < 2; ++t2) {
#pragma unroll
                for (int r = 0; r < 16; ++r) S[t2][r] = 0.f;
#pragma unroll
                for (int s = 0; s < 4; ++s) S[t2] = __builtin_amdgcn_mfma_f32_32x32x16_bf16(*(const bf16x8_t*)(tb + (t2 * 32 + l31) * AT_KP + 16 * s + 8 * hh), qf[s], S[t2], 0, 0, 0); }
#define AT_P2(P_, X0_, X1_, MW_, R_, ROW_) do { f32x2 pp_; pp_.x = __uint_as_float(__float_as_uint(__builtin_amdgcn_exp2f(X0_)) & bit_fill<ROW_>(MW_)); \
                pp_.y = __uint_as_float(__float_as_uint(__builtin_amdgcn_exp2f(X1_)) & bit_fill<ROW_ + 1>(MW_)); P_[R_] = pp_.x; P_[R_ + 1] = pp_.y; ps2 += pp_; } while (0)
#define AT_RESCALE(TM_) do { float tm_ = (TM_); tm_ = fmaxf(tm_, __shfl_xor(tm_, 32)); \
                if (__ballot(tm_ > m) != 0ull) { const float mn = fmaxf(m, tm_), alpha = __builtin_amdgcn_exp2f(m - mn); m = mn; lsum *= alpha; \
                    _Pragma("unroll") for (int r = 0; r < 16; ++r) { O0[r] *= alpha; O1[r] *= alpha; } } } while (0)
            f32x16 P[2]; f32x2 ps2 = (f32x2){0.f, 0.f}; float tm;
            const unsigned mwc0 = mw2.x >> (4 * hh), mwc1 = mw2.y >> (4 * hh);
            const bool far = (kt * 64 + 63 - q0s) <= -166;
            if (far) { float rm = fmaxf(S[0][0], S[1][0]);
#pragma unroll
                for (int r = 1; r < 16; ++r) rm = fmaxf(fmaxf(rm, S[0][r]), S[1][r]);
                tm = rm * SC + bfar;
            } else { tm = -1e30f;
#pragma unroll
                for (int t2 = 0; t2 < 2; ++t2) { const int rb = kt * 64 + t2 * 32 + 4 * hh - qpos + 256;
#pragma unroll
                    for (int r = 0; r < 16; ++r) { const int row = (r & 3) + 8 * (r >> 2); int ti = rb + row; ti = ti < 0 ? 0 : ti; tm = fmaxf(tm, S[t2][r] * SC + btab[ti]); } } }
            AT_RESCALE(tm);
            if (far) { const float ad = bfar - m;
#define AT_FAR(R_, ROW_) do { const f32x2 x0_ = (f32x2){S[0][R_], S[0][R_ + 1]} * SC + ad, x1_ = (f32x2){S[1][R_], S[1][R_ + 1]} * SC + ad; \
                    AT_P2(P[0], x0_.x, x0_.y, mwc0, R_, ROW_); AT_P2(P[1], x1_.x, x1_.y, mwc1, R_, ROW_); } while (0)
                AT_FAR(0, 0); AT_FAR(2, 2); AT_FAR(4, 8); AT_FAR(6, 10); AT_FAR(8, 16); AT_FAR(10, 18); AT_FAR(12, 24); AT_FAR(14, 26);
#undef AT_FAR
            } else {
#define AT_BIAS(T2_, R_, ROW_) (S[T2_][R_] * SC + (btab[imax0(kt * 64 + (T2_) * 32 + 4 * hh - qpos + 256 + (ROW_))] - m))
#define AT_NEAR(R_, ROW_) do { AT_P2(P[0], AT_BIAS(0, R_, ROW_), AT_BIAS(0, R_ + 1, ROW_ + 1), mwc0, R_, ROW_); AT_P2(P[1], AT_BIAS(1, R_, ROW_), AT_BIAS(1, R_ + 1, ROW_ + 1), mwc1, R_, ROW_); } while (0)
                AT_NEAR(0, 0); AT_NEAR(2, 2); AT_NEAR(4, 8); AT_NEAR(6, 10); AT_NEAR(8, 16); AT_NEAR(10, 18); AT_NEAR(12, 24); AT_NEAR(14, 26);
#undef AT_BIAS
#undef AT_NEAR
            }
#undef AT_P2
#undef AT_RESCALE
            const float ps = ps2.x + ps2.y;
            lsum += ps;
#pragma unroll
            for (int t2 = 0; t2 < 2; ++t2) { const bf16* vb = tb + 64 * AT_KP + l31 * AT_VP + t2 * 32 + 4 * hh;
#pragma unroll
                for (int s = 0; s < 2; ++s) { u32x4 w; w.x = pk2(P[t2][8 * s + 0], P[t2][8 * s + 1]); w.y = pk2(P[t2][8 * s + 2], P[t2][8 * s + 3]); w.z = pk2(P[t2][8 * s + 4], P[t2][8 * s + 5]); w.w = pk2(P[t2][8 * s + 6], P[t2][8 * s + 7]);
                    const bf16x8_t pf = __builtin_bit_cast(bf16x8_t, w);
                    O0 = __builtin_amdgcn_mfma_f32_32x32x16_bf16(frag2(*(const u32x2*)(vb + 16 * s), *(const u32x2*)(vb + 16 * s + 8)), pf, O0, 0, 0, 0);
                    O1 = __builtin_amdgcn_mfma_f32_32x32x16_bf16(frag2(*(const u32x2*)(vb + 32 * AT_VP + 16 * s), *(const u32x2*)(vb + 32 * AT_VP + 16 * s + 8)), pf, O1, 0, 0, 0); } }
        }
        if (kt + 1 < nt) { bf16* nb = tiles + ((kt + 1) & 1) * AT_BUF; *(u32x4*)(nb + lk) = prek; *(u32x4*)(nb + lv) = prev;
            if (kt + 2 < nt) { prek = *(const u32x4*)(gk + (size_t)(kt + 2) * 64 * 512); prev = *(const u32x4*)(gv + (size_t)(kt + 2) * 64); } }
    }
    lsum += __shfl_xor(lsum, 32);
    const float inv = 1.0f / lsum;
    bf16* Y = WSP(bf16, WS_Y) + (size_t)MG * 512 + qrow * 512 + h * 64 + 4 * hh;
#pragma unroll
    for (int g = 0; g < 4; ++g) { u32x2 w; w.x = pk2(O0[4 * g] * inv, O0[4 * g + 1] * inv); w.y = pk2(O0[4 * g + 2] * inv, O0[4 * g + 3] * inv); *(u32x2*)(Y + 8 * g) = w;
        u32x2 w2; w2.x = pk2(O1[4 * g] * inv, O1[4 * g + 1] * inv); w2.y = pk2(O1[4 * g + 2] * inv, O1[4 * g + 3] * inv); *(u32x2*)(Y + 32 + 8 * g) = w2; }
}
__device__ __forceinline__ void dsa_attn_unit3(KArgs C, int unit, int tid, unsigned char* lds) {
    constexpr int NPAIR = NK64 / 8;
    const int pr = unit % NPAIR, h = (unit / NPAIR) & 7, bl = unit / (NPAIR * 8);
    float* btab = (float*)lds; bf16* tiles = (bf16*)(lds + 2048);
    __syncthreads();
    { const int* tab = WSP(const int, WS_TAB); const float* relb = C->in[I_RELB];
      if (tid < 320) btab[tid] = relb[tab[tid - 256 + SEQ - 1] * 8 + h] * 1.44269504089f; }
    dsa_attn_half(C, bl, h, pr, tid, tiles, btab);
    dsa_attn_half(C, bl, h, NK64 / 4 - 1 - pr, tid, tiles, btab);
}
#ifndef GP_ALIGN
#define GP_ALIGN true
#endif
#ifndef GP_SP2
#define GP_SP2 true
#endif
constexpr int SEGS_PER_GROUP = 11, NSEG = DEPTH * (1 + NGRP * SEGS_PER_GROUP) + 1;

#ifdef HOST_EMU
#define GRID_BARRIER() emu_grid_sync()
#define LDS_PTR(p) ((unsigned char*)(p))
#else
#define GRID_BARRIER() do { XcdBarrier b_; b_.bar = (unsigned*)(Ck->ws + WS_CTL); b_.x = xb_xcc_id(); b_.st = (volatile LAS unsigned*)(lds + LDS_CTL_OFF); xcd_barrier(b_); } while (0)
#define LDS_PTR(p) ((PG8_LAS unsigned char*)(p))
#endif

__global__ void __launch_bounds__(NTHREADS, 2) fwd_kernel(Args a) {
#ifdef HOST_EMU
    unsigned char* lds = emu_lds;
#else
    extern __shared__ __attribute__((aligned(16))) unsigned char lds[];
#endif
#ifdef HOST_EMU
    KArgs Ck = &a;
#else
    KArgs Ck = (KArgs)__builtin_amdgcn_kernarg_segment_ptr();
    (void)a;
#endif
#ifndef HOST_EMU
    if (threadIdx.x < 4) ((LAS unsigned*)(lds + LDS_CTL_OFF))[threadIdx.x] = 0u;
    __syncthreads();
    if (Ck->seg_hi - Ck->seg_lo > 1) (void)xcd_barrier_post((unsigned*)(Ck->ws + WS_CTL), (volatile LAS unsigned*)(lds + LDS_CTL_OFF));
#endif
#define SEGID 0
#define RUN (SEGID >= Ck->seg_lo && SEGID < Ck->seg_hi)
#define SEAM do { if (SEGID >= Ck->seg_lo && SEGID + 1 < Ck->seg_hi) { GRID_BARRIER(); } } while (0)
#define WO ((layer & 1) ? WDELTA : (size_t)0)
#define PHASE_VARS KArgs C = KLAUNDER(Ck); const int G = gridDim.x, bx = blockIdx.x, ngw = G * NWAVES; (void)ngw; const int tid = fresh_tid(), lane = tid & 63, wave = __builtin_amdgcn_readfirstlane(tid >> 6), gw = bx * NWAVES + wave; (void)lane; (void)gw; (void)C
    for (int layer = 0; layer < DEPTH; ++layer) {
#undef SEGID
#define SEGID (layer * (1 + NGRP * SEGS_PER_GROUP))
        if (RUN) { PHASE_VARS; phase_weights(C, layer, lds, gw, ngw, lane, wave); }
        SEAM;
        for (int grp = 0; grp < NGRP; ++grp) {
#define XIN ((layer == 0 ? C->in[I_X] : (const float*)C->out) + (size_t)grp * MG * D)
#define XOUT (C->out + (size_t)grp * MG * D)
#undef SEGID
#define SEGID (layer * (1 + NGRP * SEGS_PER_GROUP) + 1 + grp * SEGS_PER_GROUP + 0)
            if (RUN) { PHASE_VARS; for (int m = gw; m < MG; m += 2 * ngw) { if (m + ngw < MG) rms_rowN_bf16<2>(XIN + (size_t)m * D, C->in[I_NMIX] + layer * D, WSP(bf16, WS_H) + (size_t)m * D, (size_t)ngw * D, lane); else rms_row_bf16(XIN + (size_t)m * D, C->in[I_NMIX] + layer * D, WSP(bf16, WS_H) + (size_t)m * D, lane); } }
            SEAM;
#undef SEGID
#define SEGID (layer * (1 + NGRP * SEGS_PER_GROUP) + 1 + grp * SEGS_PER_GROUP + 1)
            if (RUN) { PHASE_VARS; pg8::Gemm g{WSP(const bf16, WS_H), WSP(const bf16, WS_WIN + WO), MG, NMIXC, D}; pg8::StaticOrder S; S.init(MG, NMIXC, G, bx);
                pg8::EpiProj E{C->ws};
                pg8::gemm_phase<pg8::EpiProj, pg8::StaticOrder, false, GP_ALIGN, GP_SP2>(LDS_PTR(lds), g, S, E, nullptr); }
            SEAM;
#undef SEGID
#define SEGID (layer * (1 + NGRP * SEGS_PER_GROUP) + 1 + grp * SEGS_PER_GROUP + 2)
            if (RUN) { PHASE_VARS;
                for (int m = gw; m < MG; m += 2 * ngw) { if (m + ngw < MG) { rwkv_prep_row2(C, layer, m, ngw, lane); ssd_conv_row2(C, layer, m, ngw, lane); } else { rwkv_prep_row(C, layer, m, lane); ssd_conv_row(C, layer, m, lane); } }
                for (int it = gw; it < NB * 8 * NK64; it += ngw) dsa_vt_item(C, it, lane, (bf16*)(lds + wave * 16384));
                __syncthreads();
                for (int u = bx; u < NB * NK64 * 8; u += G) dsa_index_unit(C, u, lane, wave, lds);
            }
            SEAM;
#undef SEGID
#define SEGID (layer * (1 + NGRP * SEGS_PER_GROUP) + 1 + grp * SEGS_PER_GROUP + 3)
            if (RUN) { PHASE_VARS; pg8::Gemm g{WSP(const bf16, WS_RA), WSP(const bf16, WS_WLORA + WO), MG, 1536, 256}; pg8::StaticOrder S; S.init(MG, 1536, G, bx);
                pg8::EpiLora E{WSP(float, WS_WLOG), WSP(bf16, WS_ASIG), WSP(bf16, WS_GG), C->in[I_W0] + layer * 512, C->in[I_A0] + layer * 512};
                pg8::gemm_phase<pg8::EpiLora, pg8::StaticOrder, false, GP_ALIGN, GP_SP2>(LDS_PTR(lds), g, S, E, nullptr); }
            SEAM;
#undef SEGID
#define SEGID (layer * (1 + NGRP * SEGS_PER_GROUP) + 1 + grp * SEGS_PER_GROUP + 4)
            if (RUN) { PHASE_VARS;
                constexpr int U_R = NB * 8, U_S = U_R + NB * 8;
                for (int u = bx; u < U_R; u += G) rwkv_unit(C, layer, u, lds);
                for (int u = (bx + G - U_R % G) % G; u < NB * 8; u += G) ssd_unit(C, layer, u, lds);
                { const int first = U_S % G, span = G - first;
                  if (bx >= first) for (int u = bx - first; u < NB * 32; u += span) s5_unit(C, layer, u, lds); }
                for (;;) {
                    const int t2 = fresh_tid();
                    volatile unsigned* qs2 = (volatile unsigned*)(lds + LDS_CTL_OFF + 32);
                    __syncthreads();
                    if (t2 == 0) *qs2 = atomicAdd((unsigned*)(Ck->ws + WS_QCTR) + ((layer * NGRP + grp) * 2) * 64, 1u);
                    __syncthreads();
                    const int u = (int)*qs2;
                    if (u >= NB * NK64) break;
                    dsa_attn_unit3(KLAUNDER(Ck), u, t2, lds);
                }
            }
            SEAM;
#undef SEGID
#define SEGID (layer * (1 + NGRP * SEGS_PER_GROUP) + 1 + grp * SEGS_PER_GROUP + 5)
            if (RUN) { PHASE_VARS;
                { pg8::Gemm g{WSP(const bf16, WS_H), WSP(const bf16, WS_WIN + WO) + (size_t)NMIXC * D, MG, 4096, D}; pg8::StaticOrder S; S.init(MG, 4096, G, bx);
                  pg8::EpiGate E{WSP(bf16, WS_G)}; pg8::gemm_phase<pg8::EpiGate, pg8::StaticOrder, false, GP_ALIGN, GP_SP2>(LDS_PTR(lds), g, S, E, nullptr); }
                { pg8::Gemm g{WSP(const bf16, WS_YD0), WSP(const bf16, WS_GLU + WO), MG, 512, 512}; pg8::StaticOrder S; S.init(MG, 512, G, bx);
                  pg8::EpiGlu E{WSP(const bf16, WS_YD0), WSP(bf16, WS_Y) + (size_t)3 * MG * 512, C->in[I_GLUB] + layer * 512};
                  pg8::gemm_phase<pg8::EpiGlu, pg8::StaticOrder, false, GP_ALIGN, GP_SP2>(LDS_PTR(lds), g, S, E, nullptr); }
                for (int it = gw; it < MG * 2; it += 4 * ngw) ssd_norm_item4(C, layer, it, ngw, MG * 2, lane);
            }
            SEAM;
#undef SEGID
#define SEGID (layer * (1 + NGRP * SEGS_PER_GROUP) + 1 + grp * SEGS_PER_GROUP + 6)
            if (RUN) { PHASE_VARS; pg8::Gemm g{WSP(const bf16, WS_Y), WSP(const bf16, WS_WB + WO), 4 * MG, 4096, 512}; pg8::MergeOrder S{G, bx};
                pg8::EpiMerge E{WSP(const bf16, WS_G), WSP(bf16, WS_MRG)};
                pg8::gemm_phase<pg8::EpiMerge, pg8::MergeOrder, false, GP_ALIGN, GP_SP2>(LDS_PTR(lds), g, S, E, nullptr); }
            SEAM;
#undef SEGID
#define SEGID (layer * (1 + NGRP * SEGS_PER_GROUP) + 1 + grp * SEGS_PER_GROUP + 7)
            if (RUN) { PHASE_VARS; pg8::Gemm g{WSP(const bf16, WS_MRG), WSP(const bf16, WS_WOUT + WO), MG, D, D}; pg8::StaticOrder S; S.init(MG, D, G, bx);
                pg8::EpiResid E{XIN, XOUT}; pg8::gemm_phase<pg8::EpiResid, pg8::StaticOrder, false, GP_ALIGN, GP_SP2>(LDS_PTR(lds), g, S, E, nullptr); }
            SEAM;
#undef SEGID
#define SEGID (layer * (1 + NGRP * SEGS_PER_GROUP) + 1 + grp * SEGS_PER_GROUP + 8)
            if (RUN) { PHASE_VARS; for (int m = gw; m < MG; m += 2 * ngw) { if (m + ngw < MG) rms_rowN_bf16<2>(XOUT + (size_t)m * D, C->in[I_NFFN] + layer * D, WSP(bf16, WS_H) + (size_t)m * D, (size_t)ngw * D, lane); else rms_row_bf16(XOUT + (size_t)m * D, C->in[I_NFFN] + layer * D, WSP(bf16, WS_H) + (size_t)m * D, lane); } }
            SEAM;
#undef SEGID
#define SEGID (layer * (1 + NGRP * SEGS_PER_GROUP) + 1 + grp * SEGS_PER_GROUP + 9)
            if (RUN) { PHASE_VARS; pg8::Gemm g{WSP(const bf16, WS_H), WSP(const bf16, WS_W13 + WO), MG, 5632, D}; pg8::StaticOrder S; S.init(MG, 5632, G, bx);
                pg8::EpiSwiglu E{WSP(bf16, WS_HID)};
                pg8::gemm_phase<pg8::EpiSwiglu, pg8::StaticOrder, false, GP_ALIGN, GP_SP2>(LDS_PTR(lds), g, S, E, nullptr); }
            SEAM;
#undef SEGID
#define SEGID (layer * (1 + NGRP * SEGS_PER_GROUP) + 1 + grp * SEGS_PER_GROUP + 10)
            if (RUN) { PHASE_VARS; pg8::Gemm g{WSP(const bf16, WS_HID), WSP(const bf16, WS_W2 + WO), MG, D, FFN}; pg8::StaticOrder S; S.init(MG, D, G, bx);
                pg8::EpiResid E{XOUT, XOUT}; pg8::gemm_phase<pg8::EpiResid, pg8::StaticOrder, false, GP_ALIGN, GP_SP2>(LDS_PTR(lds), g, S, E, nullptr); }
            SEAM;
        }
    }
#undef SEGID
#define SEGID (NSEG - 1)
    { const int layer = 0; (void)layer;
    if (RUN) { PHASE_VARS; for (int m = gw; m < M; m += 2 * ngw) { if (m + ngw < M) rms_row2_f32(C->out + (size_t)m * D, (size_t)ngw * D, C->in[I_NFIN], lane); else rms_row_f32(C->out + (size_t)m * D, C->in[I_NFIN], lane); } } }
#undef RUN
#undef SEAM
}

extern "C" void kernel_launch(void* const* d_in, const int* in_sizes, int n_in, void* d_out, int out_size, void* d_ws, size_t ws_size, hipStream_t stream) {
    static int grid = 0;
    if (grid == 0) {
        if (n_in != N_IN || out_size != M * D || ws_size < WS_END) { fprintf(stderr, "kernel_launch: unexpected shapes (n_in %d, out %d, ws %zu < %zu)\n", n_in, out_size, ws_size, (size_t)WS_END); grid = -1; return; }
        int dev = 0, cus = 0;
        if (hipGetDevice(&dev) != hipSuccess || hipDeviceGetAttribute(&cus, hipDeviceAttributeMultiprocessorCount, dev) != hipSuccess || cus < 1) { grid = -1; return; }
        if (hipFuncSetAttribute((const void*)fwd_kernel, hipFuncAttributeMaxDynamicSharedMemorySize, LDS_BYTES) != hipSuccess) { fprintf(stderr, "kernel_launch: hipFuncSetAttribute failed\n"); grid = -1; return; }
        (void)hipGetLastError();
        grid = cus;
    }
    if (grid < 0) return;
    (void)hipMemsetAsync((char*)d_ws + WS_CTL, 0, CTL_BYTES, stream);
    Args a{};
    for (int i = 0; i < N_IN; ++i) a.in[i] = (const float*)d_in[i];
    a.out = (float*)d_out; a.ws = (unsigned char*)d_ws;
#if CFG_LAUNCHES == 1
    a.seg_lo = 0; a.seg_hi = NSEG;
    hipLaunchKernelGGL(fwd_kernel, dim3(grid), dim3(NTHREADS), LDS_BYTES, stream, a);
#else
    for (int s = 0; s < NSEG; ++s) { a.seg_lo = s; a.seg_hi = s + 1; hipLaunchKernelGGL(fwd_kernel, dim3(grid), dim3(NTHREADS), LDS_BYTES, stream, a); }
#endif
}
```

```cpp
#ifdef HOST_EMU
#error "HOST_EMU is a host-only debug build"
#else
#include <hip/hip_runtime.h>
#endif
#include <cstdio>
#include <cstdint>
#include <cmath>

#ifndef CFG_BATCH
#define CFG_BATCH 16
#endif
#ifndef CFG_SEQ
#define CFG_SEQ 4096
#endif
#ifndef CFG_DEPTH
#define CFG_DEPTH 4
#endif
#ifndef CFG_NB
#define CFG_NB 8
#endif
#ifndef CFG_LAUNCHES
#define CFG_LAUNCHES 1
#endif

typedef unsigned short bf16;
typedef float f32x4 __attribute__((ext_vector_type(4)));
typedef float f32x2 __attribute__((ext_vector_type(2)));
typedef unsigned u32x4 __attribute__((ext_vector_type(4)));
typedef unsigned u32x2 __attribute__((ext_vector_type(2)));

constexpr int BATCH = CFG_BATCH, SEQ = CFG_SEQ, DEPTH = CFG_DEPTH, NB = CFG_NB;
constexpr int D = 1024, M = BATCH * SEQ, MG = NB * SEQ, NGRP = BATCH / NB;
constexpr int IN_COLS = 9388, NPROJ = 9472, NMIXC = 5376, FFN = 2816;
constexpr int TOPK = (SEQ / 4) < 256 ? (SEQ / 4) : 256;
constexpr int NK64 = SEQ / 64, MW = SEQ / 32;
constexpr float RMS_EPS = 1e-6f, GN_EPS = 64e-5f;
static_assert(BATCH % NB == 0 && MG % 256 == 0 && SEQ % 64 == 0, "shape");

enum { I_X = 0, I_RELB, I_NMIX, I_WIN, I_CONVW, I_CONVB, I_DTB, I_ALOG, I_SSDD, I_SSDNG, I_MU, I_W0, I_W2, I_A0, I_A2, I_G2, I_KK, I_KA, I_RK, I_LNG, I_LNB,
       I_S5ARE, I_S5AIM, I_S5BRE, I_S5BIM, I_S5CRE, I_S5CIM, I_S5D, I_S5LDT, I_GLUW, I_GLUB, I_WBR, I_WOUT, I_NFFN, I_W1, I_W3, I_W2F, I_NFIN, N_IN };

constexpr size_t MiB = 1u << 20;
constexpr size_t al256(size_t x) { return (x + 255) & ~(size_t)255; }
constexpr size_t WS_CTL = 0, CTL_BYTES = 64 * 1024;
constexpr size_t WS_TAB = WS_CTL + CTL_BYTES;
constexpr size_t WS_ABAR = al256(WS_TAB + (SEQ + 64) * 4);
constexpr size_t WS_BBAR = WS_ABAR + 32 * 64 * 2 * 4;
constexpr size_t WS_WIN = al256(WS_BBAR + 32 * 64 * 16 * 2 * 4);
constexpr size_t WS_WB = WS_WIN + (size_t)NPROJ * 1024 * 2;
constexpr size_t WS_WOUT = WS_WB + (size_t)4 * 1024 * 512 * 2;
constexpr size_t WS_W13 = WS_WOUT + (size_t)1024 * 1024 * 2;
constexpr size_t WS_W2 = WS_W13 + (size_t)5632 * 1024 * 2;
constexpr size_t WS_GLU = WS_W2 + (size_t)1024 * 2816 * 2;
constexpr size_t WS_WLORA = WS_GLU + (size_t)512 * 512 * 2;
constexpr size_t WS_H = al256(WS_WLORA + (size_t)1536 * 256 * 2);
constexpr size_t WS_Z = WS_H + (size_t)MG * 1024 * 2;
constexpr size_t WS_XBC = WS_Z + (size_t)MG * 512 * 2;
constexpr size_t WS_Q = WS_XBC + (size_t)MG * 768 * 2;
constexpr size_t WS_K = WS_Q + (size_t)MG * 512 * 2;
constexpr size_t WS_V = WS_K + (size_t)MG * 512 * 2;
constexpr size_t WS_RW = WS_V + (size_t)MG * 512 * 2;
constexpr size_t WS_U = WS_RW + (size_t)MG * 1792 * 2;
constexpr size_t WS_SM = WS_U + (size_t)MG * 512 * 2;
constexpr size_t WS_G = WS_Q;
constexpr size_t WS_Y = WS_SM + (size_t)MG * 256 * 2;
constexpr size_t WS_YD0 = WS_Y + (size_t)4 * MG * 512 * 2;
constexpr size_t WS_MRG = WS_YD0 + (size_t)MG * 512 * 2;
constexpr size_t WS_MASK = WS_MRG + (size_t)MG * 1024 * 2;
constexpr size_t WS_RA = WS_MASK + (size_t)MG * MW * 4;
constexpr size_t WS_WLOG = WS_RA + (size_t)MG * 256 * 2;
constexpr size_t WS_ASIG = WS_WLOG + (size_t)MG * 512 * 4;
constexpr size_t WS_GG = WS_ASIG + (size_t)MG * 512 * 2;
constexpr size_t WS_XBA = WS_GG + (size_t)MG * 512 * 2;
constexpr size_t WS_VT = WS_XBA + (size_t)MG * 768 * 2;
constexpr size_t WS_KI = WS_VT + (size_t)MG * 512 * 2;
constexpr size_t WS_QCTR = 16384;
constexpr size_t WS_HID = WS_G;
constexpr size_t WS_WALT = al256(WS_KI + (size_t)MG * 32 * 2);
constexpr size_t WDELTA = WS_WALT - WS_ABAR;
constexpr size_t WS_END = WS_WALT + (WS_H - WS_ABAR);
static_assert(WS_SM + (size_t)MG * 256 * 2 - WS_Q == (size_t)MG * 4096 * 2, "G overlays exactly Q..SM");
static_assert((size_t)MG * 2816 * 2 <= (size_t)MG * 4096 * 2, "HID fits in G");

constexpr int LDS_SCRATCH = 131072;
constexpr int LDS_CTL_OFF = LDS_SCRATCH;
constexpr int LDS_X = LDS_SCRATCH + 64;
constexpr int LDS_BYTES = 161792;
constexpr int NTHREADS = 512, NWAVES = 8;

__device__ __forceinline__ float bf2f(bf16 v) { return __uint_as_float(((unsigned)v) << 16); }
#ifdef HOST_EMU
__device__ __forceinline__ bf16 f2bf(float f) { unsigned u = __float_as_uint(f); u += 0x7fffu + ((u >> 16) & 1u); return (bf16)(u >> 16); }
#else
__device__ __forceinline__ bf16 f2bf(float f) { return __builtin_bit_cast(bf16, (__bf16)f); }
#endif
#ifdef HOST_EMU
__device__ __forceinline__ unsigned pk2(float lo, float hi) { return (unsigned)f2bf(lo) | ((unsigned)f2bf(hi) << 16); }
#else
typedef __bf16 bf16x2_hw __attribute__((ext_vector_type(2)));
__device__ __forceinline__ unsigned pk2(float lo, float hi) { const f32x2 v = {lo, hi}; return __builtin_bit_cast(unsigned, __builtin_convertvector(v, bf16x2_hw)); }
#endif
__device__ __forceinline__ float lo_bf(unsigned w) { return __uint_as_float(w << 16); }
__device__ __forceinline__ float hi_bf(unsigned w) { return __uint_as_float(w & 0xffff0000u); }
#ifndef HOST_EMU
__device__ __forceinline__ float sigm(float x) { return __builtin_amdgcn_rcpf(1.0f + __expf(-x)); }
#else
__device__ __forceinline__ float sigm(float x) { return 1.0f / (1.0f + __expf(-x)); }
#endif
#ifndef HOST_EMU
template <int BIT> __device__ __forceinline__ unsigned bit_fill(unsigned w) { unsigned r; asm("v_bfe_i32 %0, %1, %2, 1" : "=v"(r) : "v"(w), "n"(BIT)); return r; }
#else
template <int BIT> __device__ __forceinline__ unsigned bit_fill(unsigned w) { return ((w >> BIT) & 1u) ? 0xffffffffu : 0u; }
#endif
__device__ __forceinline__ int imax0(int v) { return v < 0 ? 0 : v; }
__device__ __forceinline__ float tanh_fast(float x) { return 2.0f * sigm(2.0f * x) - 1.0f; }
__device__ __forceinline__ float softplusf(float x) { return x > 20.f ? x : log1pf(__expf(x)); }
__device__ __forceinline__ float gelu_tanh(float x) { const float u = 0.7978845608f * (x + 0.044715f * x * x * x); return x * sigm(2.0f * u); }
__device__ __forceinline__ float wave_sum(float v) {
#pragma unroll
    for (int o = 1; o < 64; o <<= 1) v += __shfl_xor(v, o);
    return v;
}
__device__ __forceinline__ float wave_max(float v) {
#pragma unroll
    for (int o = 1; o < 64; o <<= 1) v = fmaxf(v, __shfl_xor(v, o));
    return v;
}
__device__ __forceinline__ int wave_sum_i(int v) {
#pragma unroll
    for (int o = 1; o < 64; o <<= 1) v += __shfl_xor(v, o);
    return v;
}
#ifdef HOST_EMU
#define WAVE_SYNC() (void)emu_wave_exchange(0)
#define SCHED_FENCE() do {} while (0)
#define LDS_SYNC() __syncthreads()
#else
#define WAVE_SYNC() __builtin_amdgcn_wave_barrier()
#define SCHED_FENCE() __builtin_amdgcn_sched_barrier(0)
#define LDS_SYNC() do { asm volatile("s_waitcnt lgkmcnt(0)" ::: "memory"); __builtin_amdgcn_s_barrier(); asm volatile("" ::: "memory"); } while (0)
#endif
#ifndef HOST_EMU
namespace pg8 {
__device__ __forceinline__ int pg8_fresh_tid() { int t = (int)threadIdx.x; asm volatile("" : "+v"(t)); return t; }
#define PG8_LAS __attribute__((address_space(3)))
typedef unsigned short bf16_t;
typedef short bf16x8 __attribute__((ext_vector_type(8)));
typedef float f32x4 __attribute__((ext_vector_type(4)));
typedef unsigned u32x4 __attribute__((ext_vector_type(4)));
constexpr int BM = 256, BK = 64, HALF = 128, HTB = HALF * BK * 2  , STAGE_BYTES = 8 * HTB, NXCD = 8, WGM = 8;

__host__ __device__ __forceinline__ int lds_byte(int r, int c) { const int st = (r >> 4) * 2 + (c >> 5), rr = r & 15, cc = c & 31, ob = rr * 64 + cc * 2; return st * 1024 + (ob ^ (((ob >> 9) & 1) << 5)); }
__host__ __device__ __forceinline__ void stage_rc(int b, int& R, int& C) { const int st = b / 1024, sb = b % 1024, swz = sb ^ (((sb >> 9) & 1) << 5); R = (st >> 1) * 16 + swz / 64; C = (st & 1) * 32 + (swz % 64) / 2; }
__host__ __device__ __forceinline__ int perm32(int rho) { const int n = rho >> 4, i = rho & 15; return 8 * (i >> 2) + 4 * n + (i & 3); }

struct Unit { int pm, pn; };
struct Gemm { const bf16_t* A; const bf16_t* Bt; int M, N, K; };

struct StaticOrder {
    int nM, nN, nwg, G, c;
    __host__ __device__ void init(int M, int N, int G_, int c_) { nM = M / BM; nN = N / BM; nwg = nM * nN; G = G_; c = c_; }
    __host__ __device__ bool next(int i, Unit& u) const {
        const long L = (long)i * G + c; if (L >= nwg) return false;
        int wgid = (int)L; { const int q = nwg / NXCD, r = nwg % NXCD, xcd = wgid % NXCD, off = wgid / NXCD; wgid = (xcd < r ? xcd * (q + 1) : r * (q + 1) + (xcd - r) * q) + off; }
        const int nig = WGM * nN, gid = wgid / nig, fm = gid * WGM, gsz = (nM - fm) < WGM ? (nM - fm) : WGM;
        u.pm = fm + ((wgid % nig) % gsz); u.pn = (wgid % nig) / gsz; return true;
    }
    __device__ __forceinline__ void a_ready(const Unit&) const {}
    __device__ __forceinline__ void done(const Unit&) const {}
};

__device__ __forceinline__ unsigned cvt_pk_bf16(float lo, float hi) { return pk2(lo, hi); }

template <class E, class = void> struct epi_keep { static constexpr bool value = false; };
template <class E> struct epi_keep<E, decltype((void)E::KEEP_ACC)> { static constexpr bool value = true; };
template <class Epi, class Sched, bool STAMP = false, bool ALIGN_EPI = false, bool SP2 = false>
__device__ __forceinline__ void gemm_phase(PG8_LAS unsigned char* lds, const Gemm g, const Sched& S, const Epi& E, unsigned long long* stamps) {
    const int tid = pg8_fresh_tid(), wid = __builtin_amdgcn_readfirstlane(tid >> 6), lane = tid & 63, wr = wid >> 2, wc = wid & 3, fr = lane & 15, fq = lane >> 4;
    int K_ = g.K; asm volatile("" : "+s"(K_));
    const int K = K_, nt = K / BK;
    int ts_lo = 0, ts_hi = 0, nts = 0; const unsigned long long rt_entry = STAMP ? (unsigned long long)wall_clock64() : 0ull;
#define PG8_STAMP() do { if (STAMP && wid == 0 && nts < 64) { const unsigned long long _c = (unsigned long long)clock64(); \
        ts_lo = (lane == nts) ? (int)(unsigned)_c : ts_lo; ts_hi = (lane == nts) ? (int)(unsigned)(_c >> 32) : ts_hi; ++nts; } } while (0)
    PG8_STAMP();
    unsigned voffA[2], voffB[2];
#pragma unroll
    for (int i = 0; i < 2; ++i) { int R, C; stage_rc(tid * 16 + i * 8192, R, C); const int Rb = Epi::PERM ? ((R & ~31) + perm32(R & 31)) : R;
        voffA[i] = (unsigned)(R * K + C) * 2u; voffB[i] = (unsigned)(Rb * K + C) * 2u; }
    const size_t kstep = (size_t)(BK * 2);
    const size_t hstep = (size_t)HALF * K * 2;
    const size_t tstep = 2 * hstep;
    const unsigned ldsw = (unsigned)wid * 1024u;
    const int aoff = lds_byte(wr * 64 + fr, fq * 8), boff = lds_byte(wc * 32 + fr, fq * 8);
#define PG8_SA(b, h) (((b) * 2 + (h)) * HTB)
#define PG8_SB(b, h) ((4 + (b) * 2 + (h)) * HTB)
#define PG8_STAGE(bufoff, gbase, voff) do { _Pragma("unroll") for (int _i = 0; _i < 2; ++_i) \
        __builtin_amdgcn_global_load_lds((const unsigned*)((const char*)(gbase) + (voff)[_i]), (PG8_LAS unsigned*)(lds + (bufoff) + ldsw + _i * 8192), 16, 0, 0); } while (0)
#define PG8_LDA(dst, b, h) do { _Pragma("unroll") for (int m = 0; m < 4; ++m) _Pragma("unroll") for (int k = 0; k < 2; ++k) dst[m][k] = *(const PG8_LAS bf16x8*)(lds + PG8_SA(b, h) + aoff + m * 2048 + k * 1024); } while (0)
#define PG8_LDB(dst, b, h) do { _Pragma("unroll") for (int n = 0; n < 2; ++n) _Pragma("unroll") for (int k = 0; k < 2; ++k) dst[n][k] = *(const PG8_LAS bf16x8*)(lds + PG8_SB(b, h) + boff + n * 2048 + k * 1024); } while (0)
#define PG8_MMA(ai, bj, At, Bt) do { __builtin_amdgcn_s_setprio(1); _Pragma("unroll") for (int m = 0; m < 4; ++m) _Pragma("unroll") for (int n = 0; n < 2; ++n) _Pragma("unroll") for (int k = 0; k < 2; ++k) \
        acc[ai][bj][m][n] = __builtin_amdgcn_mfma_f32_16x16x32_bf16(Bt[n][k], At[m][k], acc[ai][bj][m][n], 0, 0, 0); __builtin_amdgcn_s_setprio(0); } while (0)
#define PG8_WAIT_V(n) asm volatile("s_waitcnt vmcnt(" #n ")" ::: "memory")
#define PG8_WAIT_L(n) asm volatile("s_waitcnt lgkmcnt(" #n ")" ::: "memory")
#define PG8_BAR __builtin_amdgcn_s_barrier()
#define PG8_SCHED __builtin_amdgcn_sched_barrier(0)
    Unit cur, nxt; int ui = 0;
    if (!S.next(0, cur)) return;
    f32x4 acc[2][2][4][2];
#pragma unroll
    for (int a = 0; a < 2; ++a)
#pragma unroll
        for (int b = 0; b < 2; ++b)
#pragma unroll
            for (int m = 0; m < 4; ++m)
#pragma unroll
                for (int n = 0; n < 2; ++n) acc[a][b][m][n] = (f32x4){0.f, 0.f, 0.f, 0.f};
    bf16x8 At[4][2], B0[2][2], B1[2][2];
    const char* cA = (const char*)g.A + (size_t)cur.pm * tstep; const char* cB = (const char*)g.Bt + (size_t)cur.pn * tstep;
    S.a_ready(cur);
    if constexpr (SP2) {
        PG8_STAGE(PG8_SB(0, 0), cB, voffB); PG8_STAGE(PG8_SB(0, 1), cB + hstep, voffB); PG8_STAGE(PG8_SA(0, 0), cA, voffA); PG8_STAGE(PG8_SA(0, 1), cA + hstep, voffA);
        if (wr == 1) PG8_BAR;
        PG8_WAIT_V(2); PG8_BAR;
        PG8_STAGE(PG8_SB(1, 0), cB + kstep, voffB); PG8_STAGE(PG8_SA(1, 0), cA + kstep, voffA); PG8_STAGE(PG8_SB(1, 1), cB + hstep + kstep, voffB);
        PG8_WAIT_V(6); PG8_BAR;
    } else {
    PG8_STAGE(PG8_SB(0, 0), cB, voffB); PG8_STAGE(PG8_SA(0, 0), cA, voffA); PG8_STAGE(PG8_SB(0, 1), cB + hstep, voffB); PG8_STAGE(PG8_SA(0, 1), cA + hstep, voffA);
    if (wr == 1) PG8_BAR;
    PG8_WAIT_V(4); PG8_BAR;
    PG8_STAGE(PG8_SB(1, 0), cB + kstep, voffB); PG8_STAGE(PG8_SA(1, 0), cA + kstep, voffA); PG8_STAGE(PG8_SB(1, 1), cB + hstep + kstep, voffB);
    PG8_WAIT_V(6); PG8_BAR;
    }
    PG8_STAMP();
    for (;;) {
        const bool has_next = S.next(ui + 1, nxt);
        const char* nA = has_next ? (const char*)g.A + (size_t)nxt.pm * tstep : cA; const char* nB = has_next ? (const char*)g.Bt + (size_t)nxt.pn * tstep : cB;
        for (int t = 0; t < nt; t += 2) {
            const bool last = (t == nt - 2);
            const char* a1 = cA + (size_t)(t + 1) * kstep;
            const char* a2 = last ? nA : cA + (size_t)(t + 2) * kstep; const char* b2 = last ? nB : cB + (size_t)(t + 2) * kstep;
            const char* a3 = a2 + kstep; const char* b3 = b2 + kstep;
            if (last && has_next) S.a_ready(nxt);
            if constexpr (SP2) {
            PG8_LDB(B0, 0, 0); PG8_LDB(B1, 0, 1); PG8_SCHED; PG8_LDA(At, 0, 0); PG8_STAGE(PG8_SA(1, 1), a1 + hstep, voffA);
            PG8_WAIT_V(8); PG8_WAIT_L(0); PG8_BAR; PG8_MMA(0, 0, At, B0); PG8_MMA(0, 1, At, B1); PG8_BAR; PG8_SCHED;
            PG8_LDA(At, 0, 1); PG8_STAGE(PG8_SB(0, 0), b2, voffB); PG8_STAGE(PG8_SB(0, 1), b2 + hstep, voffB); PG8_STAGE(PG8_SA(0, 0), a2, voffA);
            PG8_WAIT_V(8); PG8_WAIT_L(0); PG8_BAR; PG8_MMA(1, 0, At, B0); PG8_MMA(1, 1, At, B1); PG8_BAR; PG8_SCHED;
            PG8_LDB(B0, 1, 0); PG8_LDB(B1, 1, 1); PG8_SCHED; PG8_LDA(At, 1, 0); PG8_STAGE(PG8_SA(0, 1), a2 + hstep, voffA);
            PG8_WAIT_V(8); PG8_WAIT_L(0); PG8_BAR; PG8_MMA(0, 0, At, B0); PG8_MMA(0, 1, At, B1); PG8_BAR; PG8_SCHED;
            PG8_LDA(At, 1, 1); PG8_STAGE(PG8_SB(1, 0), b3, voffB); PG8_STAGE(PG8_SB(1, 1), b3 + hstep, voffB); PG8_STAGE(PG8_SA(1, 0), a3, voffA);
            PG8_WAIT_V(8); PG8_WAIT_L(0); PG8_BAR; PG8_MMA(1, 0, At, B0); PG8_MMA(1, 1, At, B1); PG8_BAR; PG8_SCHED;
            } else {
            PG8_LDB(B0, 0, 0); PG8_SCHED; PG8_LDA(At, 0, 0); PG8_STAGE(PG8_SA(1, 1), a1 + hstep, voffA);
            PG8_WAIT_L(8); PG8_BAR; PG8_WAIT_L(0); PG8_MMA(0, 0, At, B0); PG8_BAR; PG8_SCHED;
            PG8_LDB(B1, 0, 1); PG8_STAGE(PG8_SB(0, 0), b2, voffB);
            PG8_BAR; PG8_WAIT_L(0); PG8_MMA(0, 1, At, B1); PG8_BAR;
            PG8_LDA(At, 0, 1); PG8_STAGE(PG8_SA(0, 0), a2, voffA);
            PG8_BAR; PG8_WAIT_L(0); PG8_MMA(1, 0, At, B0); PG8_BAR; PG8_SCHED;
            PG8_STAGE(PG8_SB(0, 1), b2 + hstep, voffB);
            PG8_WAIT_V(6); PG8_BAR; PG8_MMA(1, 1, At, B1); PG8_BAR;
            PG8_LDB(B0, 1, 0); PG8_SCHED; PG8_LDA(At, 1, 0); PG8_STAGE(PG8_SA(0, 1), a2 + hstep, voffA);
            PG8_WAIT_L(8); PG8_BAR; PG8_WAIT_L(0); PG8_MMA(0, 0, At, B0); PG8_BAR; PG8_SCHED;
            PG8_LDB(B1, 1, 1); PG8_STAGE(PG8_SB(1, 0), b3, voffB);
            PG8_BAR; PG8_WAIT_L(0); PG8_MMA(0, 1, At, B1); PG8_BAR;
            PG8_LDA(At, 1, 1); PG8_STAGE(PG8_SA(1, 0), a3, voffA);
            PG8_BAR; PG8_WAIT_L(0); PG8_MMA(1, 0, At, B0); PG8_BAR; PG8_SCHED;
            PG8_STAGE(PG8_SB(1, 1), b3 + hstep, voffB);
            PG8_WAIT_V(6); PG8_BAR; PG8_MMA(1, 1, At, B1); PG8_BAR;
            }
        }
        PG8_STAMP();
        if constexpr (ALIGN_EPI) { if (wr == 0) PG8_BAR; }
        if constexpr (!Epi::AFTER_DRAIN) { E(acc, cur, wr, wc, fr, fq); S.done(cur); }
        PG8_STAMP();
        if (!has_next) break;
        bool zero_acc = true; if constexpr (epi_keep<Epi>::value) zero_acc = !E.keep(cur);
        if (zero_acc) { const bf16x8 z8 = {0, 0, 0, 0, 0, 0, 0, 0};
#pragma unroll
        for (int a = 0; a < 2; ++a)
#pragma unroll
            for (int b = 0; b < 2; ++b)
#pragma unroll
                for (int m = 0; m < 4; ++m)
#pragma unroll
                    for (int n = 0; n < 2; ++n) acc[a][b][m][n] = __builtin_amdgcn_mfma_f32_16x16x32_bf16(z8, z8, (f32x4){0.f, 0.f, 0.f, 0.f}, 0, 0, 0); }
        cur = nxt; cA = nA; cB = nB; ++ui;
        if constexpr (ALIGN_EPI) { if (wr == 1) PG8_BAR; }
    }
    PG8_WAIT_V(0);
    if constexpr (!ALIGN_EPI) { if (wr == 0) PG8_BAR; }
    PG8_BAR;
    if constexpr (Epi::AFTER_DRAIN) { E.fused(acc, cur, wr, wc, fr, fq, lds, wid, lane); S.done(cur); }
    PG8_STAMP();
    if (STAMP && wid == 0) { stamps[lane] = lane < nts ? (((unsigned long long)(unsigned)ts_hi << 32) | (unsigned)ts_lo) : 0ull;
        if (lane == 62) stamps[62] = rt_entry; if (lane == 63) stamps[63] = (unsigned long long)wall_clock64(); }
#undef PG8_STAMP
#undef PG8_SA
#undef PG8_SB
#undef PG8_STAGE
#undef PG8_LDA
#undef PG8_LDB
#undef PG8_MMA
#undef PG8_WAIT_V
#undef PG8_WAIT_L
#undef PG8_BAR
#undef PG8_SCHED
}
}

#define XB_TMO      128
#define XB_XCNT(j)  (256  + 64 * (j))
#define XB_XSUB(j)  (1280 + 64 * (j))
#define XB_XGEN(j)  (2304 + 64 * (j))
#define XB_TOP      3328
#define XB_TOPGEN   3392
#define XCD_BAR_WORDS 3456
#define XB_SPIN_CAP (1u << 18)
#define LAS __attribute__((address_space(3)))

__device__ __forceinline__ unsigned xb_ld(unsigned* p)              { return __hip_atomic_load(p, __ATOMIC_RELAXED, __HIP_MEMORY_SCOPE_AGENT); }
__device__ __forceinline__ unsigned xb_add(unsigned* p, unsigned v) { return __hip_atomic_fetch_add(p, v, __ATOMIC_RELAXED, __HIP_MEMORY_SCOPE_AGENT); }
__device__ __forceinline__ unsigned xb_xcc_id() { return (unsigned)__builtin_amdgcn_s_getreg((3 << 11) | 20) & 0xFu; }
#define XB_SPIN(cond, bar) do { unsigned _sp = 0; while (cond) { __builtin_amdgcn_s_sleep(1); \
    if ((++_sp & 255u) == 0u) { if (xb_ld(&(bar)[XB_TMO])) break; if (_sp > XB_SPIN_CAP) { atomicAdd(&(bar)[XB_TMO], 1u); break; } } } } while (0)

struct XcdBarrier {
    unsigned* bar; unsigned x;
    volatile LAS unsigned* st;
};

__device__ __forceinline__ XcdBarrier xcd_barrier_post(unsigned* bar, volatile LAS unsigned* st) {
    XcdBarrier b; b.bar = bar; b.x = xb_xcc_id(); b.st = st;
    if (threadIdx.x == 0) (void)xb_add(&bar[XB_XCNT(b.x)], 1u);
    return b;
}
__device__ __forceinline__ void xcd_barrier_complete(unsigned* bar, unsigned x, unsigned& nloc, unsigned& nx) {
    const unsigned G = gridDim.x * gridDim.y * gridDim.z;
    unsigned sum, cnt, mine, sp = 0u;
    for (;;) {
        sum = 0u; cnt = 0u; mine = 0u;
#pragma unroll
        for (unsigned j = 0; j < 16; ++j) { const unsigned c = xb_ld(&bar[XB_XCNT(j)]); sum += c; cnt += (c > 0u) ? 1u : 0u; mine = (j == x) ? c : mine; }
        if (sum == G) break;
        __builtin_amdgcn_s_sleep(1);
        if ((++sp & 255u) == 0u) { if (xb_ld(&bar[XB_TMO])) break; if (sp > XB_SPIN_CAP) { atomicAdd(&bar[XB_TMO], 1u); break; } }
    }
    nloc = mine > 0u ? mine : 1u; nx = cnt > 0u ? cnt : 1u;
}

__device__ __forceinline__ void xcd_barrier(const XcdBarrier& b) {
    asm volatile("s_waitcnt vmcnt(0)" ::: "memory");
    __syncthreads();
    if (threadIdx.x == 0) {
        unsigned* bar = b.bar;
        __builtin_amdgcn_s_waitcnt(0);
        unsigned nloc = b.st[0], nx = b.st[1];
        if (nloc == 0u) { xcd_barrier_complete(bar, b.x, nloc, nx); b.st[0] = nloc; b.st[1] = nx; }
        const unsigned old = xb_add(&bar[XB_XSUB(b.x)], 1u);
        const unsigned gen = old / nloc;
        if (old + 1u == (gen + 1u) * nloc) {
            __builtin_amdgcn_fence(__ATOMIC_RELEASE, "agent");
            asm volatile("s_waitcnt vmcnt(0)" ::: "memory");
            const unsigned og = xb_add(&bar[XB_TOP], 1u);
            const unsigned tg = og / nx;
            if (og + 1u == (tg + 1u) * nx) xb_add(&bar[XB_TOPGEN], 1u);
            else XB_SPIN(xb_ld(&bar[XB_TOPGEN]) == tg, bar);
            __builtin_amdgcn_fence(__ATOMIC_ACQUIRE, "agent");
            xb_add(&bar[XB_XGEN(b.x)], 1u);
            asm volatile("s_waitcnt vmcnt(0)" ::: "memory");
        } else {
            XB_SPIN(xb_ld(&bar[XB_XGEN(b.x)]) == gen, bar);
            __builtin_amdgcn_fence(__ATOMIC_ACQUIRE, "agent");
            asm volatile("s_waitcnt vmcnt(0)" ::: "memory");
        }
    }
    __syncthreads();
}

#else
namespace pg8 {
typedef unsigned short bf16_t;
typedef float f32x4 __attribute__((ext_vector_type(4)));
typedef unsigned u32x4 __attribute__((ext_vector_type(4)));
constexpr int BM = 256, BK = 64, HALF = 128, NXCD = 8, WGM = 8;
struct Unit { int pm, pn; };
struct Gemm { const bf16_t* A; const bf16_t* Bt; int M, N, K; };
template <class E, class = void> struct epi_keep { static constexpr bool value = false; };
template <class E> struct epi_keep<E, decltype((void)E::KEEP_ACC)> { static constexpr bool value = true; };
struct StaticOrder {
    int nM, nN, nwg, G, c;
    void init(int M, int N, int G_, int c_) { nM = M / BM; nN = N / BM; nwg = nM * nN; G = G_; c = c_; }
    bool next(int i, Unit& u) const {
        const long L = (long)i * G + c; if (L >= nwg) return false;
        int wgid = (int)L; { const int q = nwg / NXCD, r = nwg % NXCD, xcd = wgid % NXCD, off = wgid / NXCD; wgid = (xcd < r ? xcd * (q + 1) : r * (q + 1) + (xcd - r) * q) + off; }
        const int nig = WGM * nN, gid = wgid / nig, fm = gid * WGM, gsz = (nM - fm) < WGM ? (nM - fm) : WGM;
        u.pm = fm + ((wgid % nig) % gsz); u.pn = (wgid % nig) / gsz; return true;
    }
    void a_ready(const Unit&) const {}
    void done(const Unit&) const {}
};
static inline unsigned cvt_pk_bf16(float lo, float hi) { return pk2(lo, hi); }
static float* emu_tile_buf(int b) { static std::vector<std::vector<float>> t; if ((int)t.size() <= b) t.resize(b + 1); if (t[b].empty()) t[b].resize(256 * 256); return t[b].data(); }
template <class Epi, class Sched, bool STAMP = false, bool ALIGN_EPI = false, bool SP2 = false, bool ZPEEL = false>
void gemm_phase(unsigned char* lds, const Gemm g, const Sched& S, const Epi& E, unsigned long long* stamps) {
    const int tid = threadIdx.x, wid = tid >> 6, lane = tid & 63, wr = wid >> 2, wc = wid & 3, fr = lane & 15, fq = lane >> 4;
    float* tile = emu_tile_buf(blockIdx.x);
    Unit u; f32x4 acc[2][2][4][2]; bool keep_next = false;
    for (int ui = 0; S.next(ui, u); ++ui) {
        __syncthreads();
        if (tid == 0) {
            std::vector<float> a((size_t)256 * g.K), b((size_t)256 * g.K);
            for (int r = 0; r < 256; ++r) for (int k = 0; k < g.K; ++k) { a[(size_t)r * g.K + k] = bf2f(g.A[((size_t)u.pm * 256 + r) * g.K + k]); b[(size_t)r * g.K + k] = bf2f(g.Bt[((size_t)u.pn * 256 + r) * g.K + k]); }
            for (int r = 0; r < 256; ++r) for (int c = 0; c < 256; ++c) { const float* ar = &a[(size_t)r * g.K]; const float* br = &b[(size_t)c * g.K]; float s = 0.f; for (int k = 0; k < g.K; ++k) s += ar[k] * br[k]; tile[r * 256 + c] = s; }
        }
        __syncthreads();
        if (!keep_next) for (int ai = 0; ai < 2; ++ai) for (int bj = 0; bj < 2; ++bj) for (int m = 0; m < 4; ++m) for (int n = 0; n < 2; ++n) acc[ai][bj][m][n] = (f32x4){0.f, 0.f, 0.f, 0.f};
        for (int ai = 0; ai < 2; ++ai) for (int bj = 0; bj < 2; ++bj) for (int m = 0; m < 4; ++m) for (int n = 0; n < 2; ++n) for (int j = 0; j < 4; ++j) {
            const int r = 128 * ai + 64 * wr + 16 * m + fr;
            const int c = Epi::PERM ? (128 * bj + 32 * wc + 8 * fq + 4 * n + j) : (128 * bj + 32 * wc + 16 * n + 4 * fq + j);
            acc[ai][bj][m][n][j] += tile[r * 256 + c];
        }
        E(acc, u, wr, wc, fr, fq); S.done(u);
        if constexpr (epi_keep<Epi>::value) keep_next = E.keep(u); else keep_next = false;
        __syncthreads();
    }
}
}
#endif
namespace pg8 {
#ifdef HOST_EMU
#define EPI_FENCE() do {} while (0)
#else
#define EPI_FENCE() asm volatile("" ::: "memory")
#endif
__device__ __forceinline__ u32x4 pack8(const f32x4 v0, const f32x4 v1) { u32x4 w; w.x = cvt_pk_bf16(v0[0], v0[1]); w.y = cvt_pk_bf16(v0[2], v0[3]); w.z = cvt_pk_bf16(v1[0], v1[1]); w.w = cvt_pk_bf16(v1[2], v1[3]); return w; }
__device__ __forceinline__ void unpack8(const u32x4 w, f32x4& v0, f32x4& v1) { v0 = (f32x4){lo_bf(w.x), hi_bf(w.x), lo_bf(w.y), hi_bf(w.y)}; v1 = (f32x4){lo_bf(w.z), hi_bf(w.z), lo_bf(w.w), hi_bf(w.w)}; }
__device__ __forceinline__ f32x4 sig4(const f32x4 v) { return (f32x4){sigm(v[0]), sigm(v[1]), sigm(v[2]), sigm(v[3])}; }
#ifndef HOST_EMU
__device__ __forceinline__ float gate_sig(float x) { return __builtin_amdgcn_rcpf(fminf(1.0f + __expf(-x), 1.0e6f)); }
#else
__device__ __forceinline__ float gate_sig(float x) { return fmaxf(sigm(x), 1.0e-6f); }
#endif
__device__ __forceinline__ f32x4 gsig4(const f32x4 v) { return (f32x4){gate_sig(v[0]), gate_sig(v[1]), gate_sig(v[2]), gate_sig(v[3])}; }

struct EpiProj {
    static constexpr bool PERM = true, AFTER_DRAIN = false;
    unsigned char* ws;
    __device__ __forceinline__ void operator()(const f32x4 (&acc)[2][2][4][2], const Unit& u, int wr, int wc, int fr, int fq) const {
        const int pn = u.pn; size_t off; int ld, c0;
        if (pn < 2) { off = WS_Z; ld = 512; c0 = pn * 256; }
        else if (pn < 5) { off = WS_XBC; ld = 768; c0 = (pn - 2) * 256; }
        else if (pn < 7) { off = WS_Q; ld = 512; c0 = (pn - 5) * 256; }
        else if (pn < 9) { off = WS_K; ld = 512; c0 = (pn - 7) * 256; }
        else if (pn < 11) { off = WS_V; ld = 512; c0 = (pn - 9) * 256; }
        else if (pn < 18) { off = WS_RW; ld = 1792; c0 = (pn - 11) * 256; }
        else if (pn < 20) { off = WS_U; ld = 512; c0 = (pn - 18) * 256; }
        else { off = WS_SM; ld = 256; c0 = 0; }
        bf16_t* dst = (bf16_t*)(ws + off);
        const int row0 = u.pm * BM + wr * 64 + fr, col0 = c0 + wc * 32 + 8 * fq;
        const int kic = HALF + wc * 32 + 8 * fq - 136;
        const bool ki = (pn == 20) && kic >= 0 && kic < 32;
#pragma unroll
        for (int ai = 0; ai < 2; ++ai)
#pragma unroll
            for (int m = 0; m < 4; ++m) { const size_t row = (size_t)(row0 + ai * HALF + m * 16); bf16_t* rowp = dst + row * ld + col0;
#pragma unroll
                for (int bj = 0; bj < 2; ++bj) { const u32x4 w = pack8(acc[ai][bj][m][0], acc[ai][bj][m][1]); *(u32x4*)(rowp + bj * HALF) = w;
                    if (bj == 1 && ki) *(u32x4*)((bf16_t*)(ws + WS_KI) + row * 32 + kic) = w; } }
    }
};
struct EpiGate {
    static constexpr bool PERM = true, AFTER_DRAIN = false;
    bf16_t* G;
    __device__ __forceinline__ void operator()(const f32x4 (&acc)[2][2][4][2], const Unit& u, int wr, int wc, int fr, int fq) const {
        const int row0 = u.pm * BM + wr * 64 + fr, col0 = u.pn * BM + wc * 32 + 8 * fq;
#pragma unroll
        for (int ai = 0; ai < 2; ++ai)
#pragma unroll
            for (int m = 0; m < 4; ++m) { bf16_t* rowp = G + (size_t)(row0 + ai * HALF + m * 16) * 4096 + col0;
#pragma unroll
                for (int bj = 0; bj < 2; ++bj) *(u32x4*)(rowp + bj * HALF) = pack8(gsig4(acc[ai][bj][m][0]), gsig4(acc[ai][bj][m][1])); }
    }
};
struct EpiMerge {
    static constexpr bool PERM = true, AFTER_DRAIN = false, KEEP_ACC = true;
    const bf16_t* G; bf16_t* MRG;
    __device__ __forceinline__ bool keep(const Unit& u) const { return (u.pn >> 2) < 3; }
    __device__ __forceinline__ void operator()(f32x4 (&acc)[2][2][4][2], const Unit& u, int wr, int wc, int fr, int fq) const {
        const int n = u.pn >> 2, pn = u.pn & 3, pm = u.pm - n * (MG / 256);
        const int row0 = pm * BM + wr * 64 + fr, col0 = pn * BM + wc * 32 + 8 * fq;
#pragma unroll
        for (int ai = 0; ai < 2; ++ai)
#pragma unroll
            for (int mp = 0; mp < 2; ++mp) { u32x4 ga[2][2], gb[2][2];
#pragma unroll
                for (int mm = 0; mm < 2; ++mm)
#pragma unroll
                    for (int bj = 0; bj < 2; ++bj) { const bf16_t* gp = G + (size_t)(row0 + ai * HALF + (2 * mp + mm) * 16) * 4096 + n * 1024 + col0 + bj * HALF; ga[mm][bj] = *(const u32x4*)gp; if (n < 3) gb[mm][bj] = *(const u32x4*)(gp + 1024); }
#pragma unroll
                for (int mm = 0; mm < 2; ++mm)
#pragma unroll
                    for (int bj = 0; bj < 2; ++bj) { const int m = 2 * mp + mm; f32x4 a0, a1; unpack8(ga[mm][bj], a0, a1);
                        if (n < 3) { f32x4 b0, b1; unpack8(gb[mm][bj], b0, b1);
#pragma unroll
                            for (int j = 0; j < 4; ++j) { acc[ai][bj][m][0][j] *= a0[j] * __builtin_amdgcn_rcpf(b0[j]); acc[ai][bj][m][1][j] *= a1[j] * __builtin_amdgcn_rcpf(b1[j]); } }
                        else
                            *(u32x4*)(MRG + (size_t)(row0 + ai * HALF + m * 16) * 1024 + col0 + bj * HALF) = pack8(acc[ai][bj][m][0] * a0, acc[ai][bj][m][1] * a1); }
                EPI_FENCE(); }
    }
};
struct MergeOrder {
    int G, c;
    __device__ __forceinline__ bool next(int i, Unit& u) const {
        const int tile = (i >> 2) * G + c, n = i & 3; if (tile >= (MG / 256) * 4) return false;
        u.pm = n * (MG / 256) + (tile >> 2); u.pn = n * 4 + (tile & 3); return true;
    }
    __device__ __forceinline__ void a_ready(const Unit&) const {}
    __device__ __forceinline__ void done(const Unit&) const {}
};
struct EpiResid {
    static constexpr bool PERM = false, AFTER_DRAIN = false;
    const float* base; float* out;
    __device__ __forceinline__ void operator()(const f32x4 (&acc)[2][2][4][2], const Unit& u, int wr, int wc, int fr, int fq) const {
        const int row0 = u.pm * BM + wr * 64 + fr, col0 = u.pn * BM + wc * 32 + 4 * fq;
#pragma unroll
        for (int ai = 0; ai < 2; ++ai) {
            f32x4 bv[4][2][2];
#pragma unroll
            for (int m = 0; m < 4; ++m)
#pragma unroll
                for (int bj = 0; bj < 2; ++bj)
#pragma unroll
                    for (int n = 0; n < 2; ++n) bv[m][bj][n] = *(const f32x4*)(base + (size_t)(row0 + ai * HALF + m * 16) * 1024 + col0 + bj * HALF + n * 16);
#pragma unroll
            for (int m = 0; m < 4; ++m)
#pragma unroll
                for (int bj = 0; bj < 2; ++bj)
#pragma unroll
                    for (int n = 0; n < 2; ++n) *(f32x4*)(out + (size_t)(row0 + ai * HALF + m * 16) * 1024 + col0 + bj * HALF + n * 16) = bv[m][bj][n] + acc[ai][bj][m][n];
            EPI_FENCE(); }
    }
};
struct EpiSwiglu {
    static constexpr bool PERM = true, AFTER_DRAIN = false;
    bf16_t* HID;
    __device__ __forceinline__ void operator()(const f32x4 (&acc)[2][2][4][2], const Unit& u, int wr, int wc, int fr, int fq) const {
        const int row0 = u.pm * BM + wr * 64 + fr, col0 = u.pn * HALF + wc * 32 + 8 * fq;
#pragma unroll
        for (int ai = 0; ai < 2; ++ai)
#pragma unroll
            for (int m = 0; m < 4; ++m) { f32x4 v[2];
#pragma unroll
                for (int n = 0; n < 2; ++n) { const f32x4 a = acc[ai][0][m][n], b = acc[ai][1][m][n]; v[n] = a * sig4(a) * b; }
                *(u32x4*)(HID + (size_t)(row0 + ai * HALF + m * 16) * FFN + col0) = pack8(v[0], v[1]); }
    }
};
struct EpiGlu {
    static constexpr bool PERM = true, AFTER_DRAIN = false;
    const bf16_t* Y0; bf16_t* OUT; const float* bias;
    __device__ __forceinline__ void operator()(const f32x4 (&acc)[2][2][4][2], const Unit& u, int wr, int wc, int fr, int fq) const {
        const int row0 = u.pm * BM + wr * 64 + fr, col0 = u.pn * BM + wc * 32 + 8 * fq;
#pragma unroll
        for (int ai = 0; ai < 2; ++ai)
#pragma unroll
            for (int m = 0; m < 4; ++m) { const size_t row = (size_t)(row0 + ai * HALF + m * 16);
#pragma unroll
                for (int bj = 0; bj < 2; ++bj) { const int col = col0 + bj * HALF;
                    f32x4 y0, y1; unpack8(*(const u32x4*)(Y0 + row * 512 + col), y0, y1);
                    const f32x4 b0 = *(const f32x4*)(bias + col), b1 = *(const f32x4*)(bias + col + 4);
                    *(u32x4*)(OUT + row * 512 + col) = pack8(y0 * sig4(acc[ai][bj][m][0] + b0), y1 * sig4(acc[ai][bj][m][1] + b1)); }
                EPI_FENCE(); }
    }
};
__device__ __forceinline__ float logdecay(float x) { return -0.6065306597f * sigm(x); }
struct EpiLora {
    static constexpr bool PERM = true, AFTER_DRAIN = false;
    float* WLOG; bf16_t* ASIG; bf16_t* GG; const float* w0; const float* a0;
    __device__ __forceinline__ void operator()(const f32x4 (&acc)[2][2][4][2], const Unit& u, int wr, int wc, int fr, int fq) const {
        const int kind = u.pn >> 1, row0 = u.pm * BM + wr * 64 + fr, col0 = (u.pn & 1) * BM + wc * 32 + 8 * fq;
        if (kind == 0) {
            f32x4 b[2][2];
#pragma unroll
            for (int bj = 0; bj < 2; ++bj) { b[bj][0] = *(const f32x4*)(w0 + col0 + bj * HALF); b[bj][1] = *(const f32x4*)(w0 + col0 + bj * HALF + 4); }
#pragma unroll
            for (int ai = 0; ai < 2; ++ai)
#pragma unroll
                for (int m = 0; m < 4; ++m)
#pragma unroll
                    for (int bj = 0; bj < 2; ++bj)
#pragma unroll
                        for (int n = 0; n < 2; ++n) { const f32x4 x = acc[ai][bj][m][n] + b[bj][n];
                            *(f32x4*)(WLOG + (size_t)(row0 + ai * HALF + m * 16) * 512 + col0 + bj * HALF + 4 * n) = (f32x4){logdecay(x[0]), logdecay(x[1]), logdecay(x[2]), logdecay(x[3])}; }
        } else if (kind == 1) {
            f32x4 b[2][2];
#pragma unroll
            for (int bj = 0; bj < 2; ++bj) { b[bj][0] = *(const f32x4*)(a0 + col0 + bj * HALF); b[bj][1] = *(const f32x4*)(a0 + col0 + bj * HALF + 4); }
#pragma unroll
            for (int ai = 0; ai < 2; ++ai)
#pragma unroll
                for (int m = 0; m < 4; ++m)
#pragma unroll
                    for (int bj = 0; bj < 2; ++bj)
                        *(u32x4*)(ASIG + (size_t)(row0 + ai * HALF + m * 16) * 512 + col0 + bj * HALF) = pack8(sig4(acc[ai][bj][m][0] + b[bj][0]), sig4(acc[ai][bj][m][1] + b[bj][1]));
        } else {
#pragma unroll
            for (int ai = 0; ai < 2; ++ai)
#pragma unroll
                for (int m = 0; m < 4; ++m)
#pragma unroll
                    for (int bj = 0; bj < 2; ++bj)
                        *(u32x4*)(GG + (size_t)(row0 + ai * HALF + m * 16) * 512 + col0 + bj * HALF) = pack8(acc[ai][bj][m][0], acc[ai][bj][m][1]);
        }
    }
};
}
typedef short bf16x8_t __attribute__((ext_vector_type(8)));
typedef float f32x16 __attribute__((ext_vector_type(16)));
typedef float f32x4_t __attribute__((ext_vector_type(4)));
__device__ __forceinline__ bf16x8_t frag2(const u32x2 lo, const u32x2 hi) { u32x4 w; w.x = lo.x; w.y = lo.y; w.z = hi.x; w.w = hi.y; return __builtin_bit_cast(bf16x8_t, w); }
struct Args { const float* in[N_IN]; float* out; unsigned char* ws; int seg_lo, seg_hi; };
#ifdef HOST_EMU
typedef const Args* KArgs;
#define KLAUNDER(p) (p)
__device__ __forceinline__ int fresh_tid() { return (int)threadIdx.x; }
#else
typedef const __attribute__((address_space(4))) Args* KArgs;
__device__ __forceinline__ KArgs klaunder(KArgs p) { asm volatile("" : "+s"(p)); return p; }
#define KLAUNDER(p) klaunder(p)
__device__ __forceinline__ int fresh_tid() { int t = (int)threadIdx.x; asm volatile("" : "+v"(t)); return t; }
#endif
#define WSP(T, off) ((T*)(C->ws + (off)))

template <class Src>
__device__ __forceinline__ void transpose_item(const Src& S, int K, bf16* WT, float* scr, int item, int lane) {
    const int nblk = S.ndst / 32, kb = item / nblk, nb = item % nblk, k0 = 64 * kb, n0 = 32 * nb;
    const float* cp = S.col(n0 + (lane & 31)); const int ld = S.ld; const float* cq = cp ? cp : S.col(0);
    float ld32[32];
#pragma unroll
    for (int i = 0; i < 32; ++i) ld32[i] = cq[(size_t)(k0 + 2 * i + (lane >> 5)) * ld];
#pragma unroll
    for (int i = 0; i < 32; ++i) { const int kk = 2 * i + (lane >> 5); scr[kk * 33 + (lane & 31)] = cp ? ld32[i] : 0.f; }
    WAVE_SYNC();
    const int c = lane & 7;
#pragma unroll
    for (int j = 0; j < 4; ++j) { const int n = (lane >> 3) + 8 * j; const float* s = scr + (8 * c) * 33 + n;
        u32x4 o; o.x = pk2(s[0 * 33], s[1 * 33]); o.y = pk2(s[2 * 33], s[3 * 33]); o.z = pk2(s[4 * 33], s[5 * 33]); o.w = pk2(s[6 * 33], s[7 * 33]);
        *(u32x4*)(WT + (size_t)(n0 + n) * K + k0 + 8 * c) = o; }
    WAVE_SYNC();
}
struct SrcWin { const float* w; int ndst, ld;
    __device__ __forceinline__ const float* col(int n) const {
        int s;
        if (n < 1280) s = n;
        else if (n < 2816) s = n + 8;
        else if (n < 4608) s = n - 2816 + 2988;
        else if (n < 5120) s = n - 4608 + 4780;
        else if (n < 5128) s = n - 5120 + 1280;
        else if (n < 5256) s = n - 5128 + 2824;
        else if (n < 5288) s = n - 5256 + 2952;
        else if (n < 5292) s = n - 5288 + 2984;
        else if (n < 5376) return nullptr;
        else s = n - 5376 + 5292;
        return w + s; } };
struct SrcPlain { const float* w; int ndst, ld; __device__ __forceinline__ const float* col(int n) const { return w + n; } };
struct SrcW13 { const float* w1; const float* w3; int ndst, ld;
    __device__ __forceinline__ const float* col(int n) const { const int pn = n >> 8, r = n & 255; return w1 + (r < 128 ? (ptrdiff_t)0 : (w3 - w1)) + pn * 128 + (r & 127); } };

__device__ __forceinline__ void phase_weights(KArgs C, int layer, unsigned char* lds, int gw, int ngw, int lane, int wave) {
    float* scr = (float*)(lds + wave * 16384); const size_t wo = (layer & 1) ? WDELTA : 0;
    constexpr int N_IN_ = 16 * (NPROJ / 32), N_BR = 8 * 32, N_OUT = 16 * 32, N_13 = 16 * (5632 / 32), N_2 = 44 * 32, N_GLU = 8 * 16;
    { constexpr int E0 = N_IN_, E1 = E0 + 4 * N_BR, E2 = E1 + N_OUT, E3 = E2 + N_13, E4 = E3 + N_2, E5 = E4 + N_GLU;
      for (int it = gw; it < E5; it += ngw) {
          if (it < E0) { const SrcWin s_in{C->in[I_WIN] + (size_t)layer * 1024 * IN_COLS, NPROJ, IN_COLS}; transpose_item(s_in, 1024, WSP(bf16, WS_WIN + wo), scr, it, lane); }
          else if (it < E1) { const int i2 = it - E0, n = i2 / N_BR; const SrcPlain s_b{C->in[I_WBR] + ((size_t)layer * 4 + n) * 512 * 1024, 1024, 1024};
              transpose_item(s_b, 512, WSP(bf16, WS_WB + wo) + (size_t)n * 1024 * 512, scr, i2 % N_BR, lane); }
          else if (it < E2) { const SrcPlain s_out{C->in[I_WOUT] + (size_t)layer * 1024 * 1024, 1024, 1024}; transpose_item(s_out, 1024, WSP(bf16, WS_WOUT + wo), scr, it - E1, lane); }
          else if (it < E3) { const SrcW13 s_13{C->in[I_W1] + (size_t)layer * 1024 * FFN, C->in[I_W3] + (size_t)layer * 1024 * FFN, 5632, FFN}; transpose_item(s_13, 1024, WSP(bf16, WS_W13 + wo), scr, it - E2, lane); }
          else if (it < E4) { const SrcPlain s_2{C->in[I_W2F] + (size_t)layer * FFN * 1024, 1024, 1024}; transpose_item(s_2, FFN, WSP(bf16, WS_W2 + wo), scr, it - E3, lane); }
          else { const SrcPlain s_glu{C->in[I_GLUW] + (size_t)layer * 512 * 512, 512, 512}; transpose_item(s_glu, 512, WSP(bf16, WS_GLU + wo), scr, it - E4, lane); } } }
    { const float* w2 = C->in[I_W2] + (size_t)layer * 64 * 512; const float* a2 = C->in[I_A2] + (size_t)layer * 64 * 512; const float* g2 = C->in[I_G2] + (size_t)layer * 128 * 512;
      bf16* WL = WSP(bf16, WS_WLORA + wo);
      for (int e = gw * 64 + lane; e < 1536 * 256; e += ngw * 64) { const int n = e >> 8, kc = e & 255; float v = 0.f;
          if (n < 512) { if (kc < 64) v = w2[kc * 512 + n]; } else if (n < 1024) { if (kc >= 64 && kc < 128) v = a2[(kc - 64) * 512 + (n - 512)]; } else { if (kc >= 128) v = g2[(kc - 128) * 512 + (n - 1024)]; }
          WL[e] = f2bf(v); } }
    const int gt = gw * 64 + lane, ngt = ngw * 64;
    for (int ej = ngt - 1 - gt; ej < 32 * 64 * 16; ej += ngt) {
        const int e = ej >> 4, j = ej & 15, g = e >> 6;
        const float ar = C->in[I_S5ARE][layer * 2048 + e], ai = C->in[I_S5AIM][layer * 2048 + e], dt = expf(C->in[I_S5LDT][layer * 32 + g]);
        const float br = C->in[I_S5BRE][((size_t)layer * 2048 + e) * 16 + j], bi = C->in[I_S5BIM][((size_t)layer * 2048 + e) * 16 + j];
        const float mag = expf(ar * dt), abr = mag * cosf(ai * dt), abi = mag * sinf(ai * dt);
        const float den = ar * ar + ai * ai, nr = abr - 1.0f, ni = abi;
        const float qr = (nr * ar + ni * ai) / den, qi = (ni * ar - nr * ai) / den;
        if (j == 0) { float* ab = WSP(float, WS_ABAR + wo) + e * 2; ab[0] = abr; ab[1] = abi; }
        float* bb = WSP(float, WS_BBAR + wo) + (size_t)e * 32;
        bb[2 * j] = qr * br - qi * bi; bb[2 * j + 1] = qr * bi + qi * br;
    }
    if (layer == 0) for (int e = gt; e < SEQ + 63; e += ngt) {
        const int rel = e - (SEQ - 1); const int n = rel < 0 ? -rel : rel; int b = rel > 0 ? 16 : 0;
        if (n < 8) b += n; else { int lg = 8 + (int)(logf((float)n / 8.0f) / 3.4657359028f * 8.0f); if (lg > 15) lg = 15; b += lg; }
        WSP(int, WS_TAB)[e] = b;
    }
}

__device__ __forceinline__ void rms_row_bf16(const float* xrow, const float* g, bf16* orow, int lane) {
    const f32x4* xr = (const f32x4*)xrow + lane; const f32x4* gr = (const f32x4*)g + lane;
    f32x4 v[4]; float s = 0.f;
#pragma unroll
    for (int j = 0; j < 4; ++j) { v[j] = xr[64 * j]; s += (v[j].x * v[j].x + v[j].y * v[j].y) + (v[j].z * v[j].z + v[j].w * v[j].w); }
    const float rstd = 1.0f / sqrtf(wave_sum(s) * (1.f / D) + RMS_EPS);
    u32x2* o8 = (u32x2*)orow + lane;
#pragma unroll
    for (int j = 0; j < 4; ++j) { const f32x4 gg = gr[64 * j]; u32x2 w; w.x = pk2(v[j].x * rstd * gg.x, v[j].y * rstd * gg.y); w.y = pk2(v[j].z * rstd * gg.z, v[j].w * rstd * gg.w); o8[64 * j] = w; }
}
template <int NR>
__device__ __forceinline__ void rms_rowN_bf16(const float* xrow, const float* g, bf16* orow, size_t step, int lane) {
    const f32x4* gr = (const f32x4*)g + lane; f32x4 v[NR][4]; float ss[NR];
#pragma unroll
    for (int q = 0; q < NR; ++q)
#pragma unroll
        for (int j = 0; j < 4; ++j) v[q][j] = ((const f32x4*)(xrow + q * step) + lane)[64 * j];
#pragma unroll
    for (int q = 0; q < NR; ++q) { float s = 0.f;
#pragma unroll
        for (int j = 0; j < 4; ++j) s += (v[q][j].x * v[q][j].x + v[q][j].y * v[q][j].y) + (v[q][j].z * v[q][j].z + v[q][j].w * v[q][j].w);
        ss[q] = s; }
#pragma unroll
    for (int o = 1; o < 64; o <<= 1)
#pragma unroll
        for (int q = 0; q < NR; ++q) ss[q] += __shfl_xor(ss[q], o);
#pragma unroll
    for (int q = 0; q < NR; ++q) { const float r = 1.0f / sqrtf(ss[q] * (1.f / D) + RMS_EPS); u32x2* o8 = (u32x2*)(orow + q * step) + lane;
#pragma unroll
        for (int j = 0; j < 4; ++j) { const f32x4 gg = gr[64 * j]; u32x2 w; w.x = pk2(v[q][j].x * r * gg.x, v[q][j].y * r * gg.y); w.y = pk2(v[q][j].z * r * gg.z, v[q][j].w * r * gg.w); o8[64 * j] = w; } }
}
__device__ __forceinline__ void rms_row_f32(float* xrow, const float* g, int lane) {
    f32x4* xr = (f32x4*)xrow + lane; const f32x4* gr = (const f32x4*)g + lane;
    f32x4 v[4]; float s = 0.f;
#pragma unroll
    for (int j = 0; j < 4; ++j) { v[j] = xr[64 * j]; s += (v[j].x * v[j].x + v[j].y * v[j].y) + (v[j].z * v[j].z + v[j].w * v[j].w); }
    const float rstd = 1.0f / sqrtf(wave_sum(s) * (1.f / D) + RMS_EPS);
#pragma unroll
    for (int j = 0; j < 4; ++j) xr[64 * j] = v[j] * rstd * gr[64 * j];
}

#ifdef HOST_EMU
__device__ __forceinline__ float red8(float v) { v += __shfl_xor(v, 1); v += __shfl_xor(v, 2); v += __shfl_xor(v, 4); return v; }
__device__ __forceinline__ float red16(float v) { v = red8(v); v += __shfl_xor(v, 8); return v; }
#else
template <int CTRL> __device__ __forceinline__ float dpp_f(float v) { return __builtin_bit_cast(float, __builtin_amdgcn_update_dpp(0, __builtin_bit_cast(int, v), CTRL, 0xf, 0xf, true)); }
__device__ __forceinline__ float red8(float v) { v += dpp_f<0xB1>(v); v += dpp_f<0x4E>(v); v += dpp_f<0x141>(v); return v; }
__device__ __forceinline__ float red16(float v) { v = red8(v); v += dpp_f<0x140>(v); return v; }
#endif
__device__ __forceinline__ f32x4 sig4g(const f32x4 v) { return (f32x4){sigm(v[0]), sigm(v[1]), sigm(v[2]), sigm(v[3])}; }
__device__ __forceinline__ void rms_row2_f32(float* xrow, size_t step, const float* g, int lane) {
    f32x4* xa = (f32x4*)xrow + lane; f32x4* xb = (f32x4*)(xrow + step) + lane; const f32x4* gr = (const f32x4*)g + lane;
    f32x4 va[4], vb[4]; float sa = 0.f, sb = 0.f;
#pragma unroll
    for (int j = 0; j < 4; ++j) { va[j] = xa[64 * j]; vb[j] = xb[64 * j]; }
#pragma unroll
    for (int j = 0; j < 4; ++j) { sa += (va[j].x * va[j].x + va[j].y * va[j].y) + (va[j].z * va[j].z + va[j].w * va[j].w); sb += (vb[j].x * vb[j].x + vb[j].y * vb[j].y) + (vb[j].z * vb[j].z + vb[j].w * vb[j].w); }
#pragma unroll
    for (int o = 1; o < 64; o <<= 1) { sa += __shfl_xor(sa, o); sb += __shfl_xor(sb, o); }
    const float ra = 1.0f / sqrtf(sa * (1.f / D) + RMS_EPS), rb = 1.0f / sqrtf(sb * (1.f / D) + RMS_EPS);
#pragma unroll
    for (int j = 0; j < 4; ++j) { const f32x4 gg = gr[64 * j]; xa[64 * j] = va[j] * ra * gg; xb[64 * j] = vb[j] * rb * gg; }
}
__device__ __forceinline__ void ssd_conv_row(KArgs C, int layer, int m, int lane) {
    const int t = m % SEQ; const float* cw = C->in[I_CONVW] + layer * 4 * 768; const float* cb = C->in[I_CONVB] + layer * 768;
#pragma unroll
    for (int i = 0; i < 3; ++i) { const int ch = i * 256 + lane * 4; const bf16* p = WSP(const bf16, WS_XBC) + (size_t)m * 768 + ch;
        f32x4 a = *(const f32x4*)(cb + ch);
#pragma unroll
        for (int q = 0; q < 4; ++q) if (t - 3 + q >= 0) { const u32x2 w = *(const u32x2*)(p - (3 - q) * 768); const f32x4 cq = *(const f32x4*)(cw + q * 768 + ch);
            a += cq * (f32x4){lo_bf(w.x), hi_bf(w.x), lo_bf(w.y), hi_bf(w.y)}; }
        a = a * sig4g(a);
        u32x2 o; o.x = pk2(a.x, a.y); o.y = pk2(a.z, a.w); *(u32x2*)(WSP(bf16, WS_XBA) + (size_t)m * 768 + ch) = o; }
}
__device__ __forceinline__ void ssd_conv_row2(KArgs C, int layer, int m, int step, int lane) {
    const float* cw = C->in[I_CONVW] + layer * 4 * 768; const float* cb = C->in[I_CONVB] + layer * 768;
    u32x2 w[2][3][4]; f32x4 cq[3][4], bb[3];
#pragma unroll
    for (int i = 0; i < 3; ++i) { const int ch = i * 256 + lane * 4; bb[i] = *(const f32x4*)(cb + ch);
#pragma unroll
        for (int q = 0; q < 4; ++q) { cq[i][q] = *(const f32x4*)(cw + q * 768 + ch);
#pragma unroll
            for (int r = 0; r < 2; ++r) { const int mm = m + r * step, t = mm % SEQ; const bf16* p = WSP(const bf16, WS_XBC) + (size_t)mm * 768 + ch;
                if (t - 3 + q >= 0) w[r][i][q] = *(const u32x2*)(p - (3 - q) * 768); else { w[r][i][q].x = 0u; w[r][i][q].y = 0u; } } } }
#pragma unroll
    for (int r = 0; r < 2; ++r)
#pragma unroll
        for (int i = 0; i < 3; ++i) { const int ch = i * 256 + lane * 4; f32x4 a = bb[i];
#pragma unroll
            for (int q = 0; q < 4; ++q) a += cq[i][q] * (f32x4){lo_bf(w[r][i][q].x), hi_bf(w[r][i][q].x), lo_bf(w[r][i][q].y), hi_bf(w[r][i][q].y)};
            a = a * sig4g(a);
            u32x2 o; o.x = pk2(a.x, a.y); o.y = pk2(a.z, a.w); *(u32x2*)(WSP(bf16, WS_XBA) + (size_t)(m + r * step) * 768 + ch) = o; }
}
__device__ __forceinline__ void ssd_unit(KArgs C, int layer, int unit, unsigned char* lds) {
    const int tid = fresh_tid(), lane = tid & 63, wave = tid >> 6, bl = unit >> 3, h = unit & 7, gi = h >> 2, pp = tid >> 3, c8 = (tid & 7) * 8, c16 = lane & 15, q = lane >> 4;
    bf16* Cb = (bf16*)lds; bf16* Bb = Cb + 4096; bf16* XT = Bb + 4096; bf16* BwT = XT + 4096; bf16* Pm = BwT + 4096; float* Yo = (float*)(Pm + 4096); float* dts = Yo + 8192; float* acs = dts + 128;
    const bf16* XA = WSP(const bf16, WS_XBA) + (size_t)bl * SEQ * 768 + (size_t)pp * 768 + c8;
    const bf16* SMp = WSP(const bf16, WS_SM) + (size_t)bl * SEQ * 256;
    const bf16* Zp = WSP(const bf16, WS_Z) + (size_t)bl * SEQ * 512 + (size_t)pp * 512 + h * 64 + c8;
    bf16* YA = WSP(bf16, WS_Y) + (size_t)bl * SEQ * 512 + (size_t)pp * 512 + h * 64 + c8;
    const float dtb = C->in[I_DTB][layer * 8 + h], A = -__expf(C->in[I_ALOG][layer * 8 + h]), Dh = C->in[I_SSDD][layer * 8 + h];
    f32x4_t Sd[2]; bf16x8_t Sf; Sd[0] = (f32x4_t){0.f, 0.f, 0.f, 0.f}; Sd[1] = Sd[0]; { u32x2 z; z.x = 0u; z.y = 0u; Sf = frag2(z, z); }
    const int pt = wave & 3, nh = wave >> 2;
    u32x4 fx, fb, fc, fz;
#define SSD_FETCH(c0_) do { const bf16* q_ = XA + (size_t)(c0_) * 768; fx = *(const u32x4*)(q_ + h * 64); fb = *(const u32x4*)(q_ + 512 + gi * 64); fc = *(const u32x4*)(q_ + 640 + gi * 64); fz = *(const u32x4*)(Zp + (size_t)(c0_) * 512); } while (0)
#define SSD_DT(c0_, par) do { if (wave == 0) { const float dt_ = softplusf(bf2f(SMp[(size_t)((c0_) + lane) * 256 + h]) + dtb); float a_ = A * dt_; \
        _Pragma("unroll") for (int o_ = 1; o_ < 64; o_ <<= 1) { const float t_ = __shfl_up(a_, o_); if (lane >= o_) a_ += t_; } dts[(par) * 64 + lane] = dt_; acs[(par) * 64 + lane] = a_; } } while (0)
    LDS_SYNC();
    SSD_FETCH(0); SSD_DT(0, 0);
    for (int c0 = 0, par = 0; c0 < SEQ; c0 += 64, par ^= 1) {
        LDS_SYNC();
        const u32x4 xk = fx, zk = fz;
        {
          const float dt = dts[par * 64 + pp], ea = __expf(acs[par * 64 + 63] - acs[par * 64 + pp]);
          *(u32x4*)(Cb + pp * 64 + c8) = fc; *(u32x4*)(Bb + pp * 64 + c8) = fb;
          f32x4 x0, x1, b0, b1; pg8::unpack8(fx, x0, x1); pg8::unpack8(fb, b0, b1); x0 = x0 * dt; x1 = x1 * dt; b0 = b0 * ea; b1 = b1 * ea;
#pragma unroll
          for (int i = 0; i < 4; ++i) { XT[(c8 + i) * 64 + pp] = f2bf(x0[i]); XT[(c8 + 4 + i) * 64 + pp] = f2bf(x1[i]); BwT[(c8 + i) * 64 + pp] = f2bf(b0[i]); BwT[(c8 + 4 + i) * 64 + pp] = f2bf(b1[i]); } }
        if (c0 + 64 < SEQ) { SSD_FETCH(c0 + 64); SSD_DT(c0 + 64, par ^ 1); }
        LDS_SYNC();
        {
          const f32x4_t z4 = {0.f, 0.f, 0.f, 0.f};
#pragma unroll
          for (int i = 0; i < 2; ++i) { const int id = wave + 8 * i, lt = id >> 2, st = id & 3; f32x4_t g = z4;
              if (st <= lt) {
#pragma unroll
                  for (int ks = 0; ks < 2; ++ks) g = __builtin_amdgcn_mfma_f32_16x16x32_bf16(*(const bf16x8_t*)(Cb + (16 * lt + c16) * 64 + 32 * ks + 8 * q), *(const bf16x8_t*)(Bb + (16 * st + c16) * 64 + 32 * ks + 8 * q), g, 0, 0, 0);
                  const float as_ = acs[par * 64 + 16 * st + c16];
#pragma unroll
                  for (int r = 0; r < 4; ++r) { const int l = 16 * lt + 4 * q + r; g[r] = (16 * st + c16 <= l) ? g[r] * __expf(acs[par * 64 + l] - as_) : 0.f; } }
#pragma unroll
              for (int r = 0; r < 4; ++r) Pm[(16 * lt + 4 * q + r) * 64 + 16 * st + c16] = f2bf(g[r]); }
#pragma unroll
          for (int lt = 0; lt < 4; ++lt) { const bf16* cr = Cb + (16 * lt + c16) * 64 + 32 * nh + 4 * q;
              const f32x4_t yo = __builtin_amdgcn_mfma_f32_16x16x32_bf16(frag2(*(const u32x2*)cr, *(const u32x2*)(cr + 16)), Sf, z4, 0, 0, 0);
#pragma unroll
              for (int r = 0; r < 4; ++r) Yo[nh * 4096 + (16 * lt + 4 * q + r) * 64 + 16 * pt + c16] = yo[r]; }
          const float eL = __expf(acs[par * 64 + 63]);
          const bf16x8_t xb0 = *(const bf16x8_t*)(XT + (16 * pt + c16) * 64 + 8 * q), xb1 = *(const bf16x8_t*)(XT + (16 * pt + c16) * 64 + 32 + 8 * q);
#pragma unroll
          for (int i = 0; i < 2; ++i) { const bf16* br = BwT + (16 * (2 * nh + i) + c16) * 64 + 8 * q; f32x4_t cin = Sd[i] * eL;
              cin = __builtin_amdgcn_mfma_f32_16x16x32_bf16(*(const bf16x8_t*)br, xb0, cin, 0, 0, 0); Sd[i] = __builtin_amdgcn_mfma_f32_16x16x32_bf16(*(const bf16x8_t*)(br + 32), xb1, cin, 0, 0, 0); }
          u32x2 lo, hi; lo.x = pk2(Sd[0][0], Sd[0][1]); lo.y = pk2(Sd[0][2], Sd[0][3]); hi.x = pk2(Sd[1][0], Sd[1][1]); hi.y = pk2(Sd[1][2], Sd[1][3]); Sf = frag2(lo, hi); }
        LDS_SYNC();
        {
          const f32x4_t z4 = {0.f, 0.f, 0.f, 0.f};
#pragma unroll
          for (int i = 0; i < 2; ++i) { const int id = wave + 8 * i, lt = id >> 2, p2 = id & 3;
              f32x4_t y = __builtin_amdgcn_mfma_f32_16x16x32_bf16(*(const bf16x8_t*)(Pm + (16 * lt + c16) * 64 + 8 * q), *(const bf16x8_t*)(XT + (16 * p2 + c16) * 64 + 8 * q), z4, 0, 0, 0);
              if (lt >= 2) y = __builtin_amdgcn_mfma_f32_16x16x32_bf16(*(const bf16x8_t*)(Pm + (16 * lt + c16) * 64 + 32 + 8 * q), *(const bf16x8_t*)(XT + (16 * p2 + c16) * 64 + 32 + 8 * q), y, 0, 0, 0);
#pragma unroll
              for (int r = 0; r < 4; ++r) { const int l = 16 * lt + 4 * q + r, o = l * 64 + 16 * p2 + c16; Yo[o] = y[r] + __expf(acs[par * 64 + l]) * (Yo[o] + Yo[4096 + o]); } } }
        LDS_SYNC();
        {
          f32x4 x0, x1, z0, z1; pg8::unpack8(xk, x0, x1); pg8::unpack8(zk, z0, z1);
          const f32x4 y0 = (*(const f32x4*)(Yo + pp * 64 + c8) + Dh * x0) * z0 * sig4g(z0), y1 = (*(const f32x4*)(Yo + pp * 64 + c8 + 4) + Dh * x1) * z1 * sig4g(z1);
          *(u32x4*)(YA + (size_t)c0 * 512) = pg8::pack8(y0, y1); }
    }
#undef SSD_FETCH
#undef SSD_DT
}
__device__ __forceinline__ void ssd_norm_item4(KArgs C, int layer, int item0, int stride, int nitems, int lane) {
    u32x2 w[4]; bf16* p[4];
#pragma unroll
    for (int q = 0; q < 4; ++q) { const int item = item0 + q * stride; p[q] = WSP(bf16, WS_Y) + (size_t)((item < nitems ? item : item0) >> 1) * 512 + ((item < nitems ? item : item0) & 1) * 256 + lane * 4; w[q] = *(const u32x2*)p[q]; }
#pragma unroll
    for (int q = 0; q < 4; ++q) { const int item = item0 + q * stride; if (item < nitems) {
        float v[4] = {lo_bf(w[q].x), hi_bf(w[q].x), lo_bf(w[q].y), hi_bf(w[q].y)};
        const float rstd = 1.0f / sqrtf(wave_sum(v[0] * v[0] + v[1] * v[1] + v[2] * v[2] + v[3] * v[3]) * (1.f / 256) + RMS_EPS);
        const float* g = C->in[I_SSDNG] + layer * 512 + (item & 1) * 256 + lane * 4;
        u32x2 o; o.x = pk2(v[0] * rstd * g[0], v[1] * rstd * g[1]); o.y = pk2(v[2] * rstd * g[2], v[3] * rstd * g[3]); *(u32x2*)p[q] = o; } }
}
__device__ __forceinline__ void rwkv_prep_row(KArgs C, int layer, int m, int lane) {
    const int t = m % SEQ, col = 1536 + lane * 4;
    const bf16* cur = WSP(const bf16, WS_RW) + (size_t)m * 1792 + col;
    const u32x2 wc = *(const u32x2*)cur; u32x2 wp; wp.x = 0u; wp.y = 0u; if (t > 0) wp = *(const u32x2*)(cur - 1792);
    const f32x4 mu = *(const f32x4*)(C->in[I_MU] + layer * 1792 + col);
    float v[4] = {lo_bf(wc.x), hi_bf(wc.x), lo_bf(wc.y), hi_bf(wc.y)}; const float p[4] = {lo_bf(wp.x), hi_bf(wp.x), lo_bf(wp.y), hi_bf(wp.y)};
#pragma unroll
    for (int i = 0; i < 4; ++i) { v[i] = v[i] + (p[i] - v[i]) * mu[i]; v[i] = lane < 16 ? tanh_fast(v[i]) : (lane < 32 ? v[i] : sigm(v[i])); }
    u32x2 o; o.x = pk2(v[0], v[1]); o.y = pk2(v[2], v[3]); *(u32x2*)(WSP(bf16, WS_RA) + (size_t)m * 256 + lane * 4) = o;
}
__device__ __forceinline__ void rwkv_prep_row2(KArgs C, int layer, int m, int step, int lane) {
    const int col = 1536 + lane * 4; const f32x4 mu = *(const f32x4*)(C->in[I_MU] + layer * 1792 + col);
    u32x2 wc[2], wp[2];
#pragma unroll
    for (int r = 0; r < 2; ++r) { const int mm = m + r * step; const bf16* cur = WSP(const bf16, WS_RW) + (size_t)mm * 1792 + col; wc[r] = *(const u32x2*)cur;
        if (mm % SEQ > 0) wp[r] = *(const u32x2*)(cur - 1792); else { wp[r].x = 0u; wp[r].y = 0u; } }
#pragma unroll
    for (int r = 0; r < 2; ++r) { float v[4] = {lo_bf(wc[r].x), hi_bf(wc[r].x), lo_bf(wc[r].y), hi_bf(wc[r].y)}; const float p[4] = {lo_bf(wp[r].x), hi_bf(wp[r].x), lo_bf(wp[r].y), hi_bf(wp[r].y)};
#pragma unroll
        for (int i = 0; i < 4; ++i) { v[i] = v[i] + (p[i] - v[i]) * mu[i]; v[i] = lane < 16 ? tanh_fast(v[i]) : (lane < 32 ? v[i] : sigm(v[i])); }
        u32x2 o; o.x = pk2(v[0], v[1]); o.y = pk2(v[2], v[3]); *(u32x2*)(WSP(bf16, WS_RA) + (size_t)(m + r * step) * 256 + lane * 4) = o; }
}
__device__ __forceinline__ void rwkv_unit(KArgs C, int layer, int unit, unsigned char* lds) {
    constexpr int SLOT = 16704, O_RT = 2048, O_BTL = 4096, O_KTL = 6144, O_BHT = 8192, O_KHT = 10240, O_VT = 12288, O_TM = 14336, O_AAK = 14848, O_RB = 15360, O_RK = 15872, O_DL = 16384, O_BON = 16640;
    const int tid = fresh_tid(), lane = tid & 63, wave = tid >> 6, bl = unit >> 3, h = unit & 7, pt = tid >> 3, k8 = (tid & 7) * 8, cc = pt >> 4, tl = pt & 15, hc = h * 64 + k8;
    float* WL = (float*)(lds + 4 * SLOT); float* Nf = WL + 4096; float* Yb = Nf + 1024; float* ct_ = Yb + 4096;
    const bf16* RW = WSP(const bf16, WS_RW) + (size_t)bl * SEQ * 1792 + hc;
    const float* WLG = WSP(const float, WS_WLOG) + (size_t)bl * SEQ * 512 + hc;
    const bf16* AS = WSP(const bf16, WS_ASIG) + (size_t)bl * SEQ * 512 + hc;
    const bf16* GG = WSP(const bf16, WS_GG) + (size_t)bl * SEQ * 512 + hc;
    bf16* YC = WSP(bf16, WS_Y) + (size_t)2 * MG * 512 + (size_t)bl * SEQ * 512 + hc;
    LDS_SYNC();
    { const int row = tid >> 6, j = tid & 63; const float* src = row == 0 ? C->in[I_MU] + layer * 1792 : row == 1 ? C->in[I_MU] + layer * 1792 + 512 : row == 2 ? C->in[I_MU] + layer * 1792 + 1024
          : row == 3 ? C->in[I_KK] + layer * 512 : row == 4 ? C->in[I_KA] + layer * 512 : row == 5 ? C->in[I_RK] + layer * 512 : row == 6 ? C->in[I_LNG] + layer * 512 : C->in[I_LNB] + layer * 512;
      ct_[tid] = src[h * 64 + j]; }
    f32x4_t Sd[4]; bf16x8_t Sf[2];
#pragma unroll
    for (int i = 0; i < 4; ++i) Sd[i] = (f32x4_t){0.f, 0.f, 0.f, 0.f};
    { u32x2 z; z.x = 0u; z.y = 0u; Sf[0] = frag2(z, z); Sf[1] = Sf[0]; }
    u32x4 rc, rp, kc, kp, vc, vp, ac, gc; f32x4 wl0, wl1;
#define RWKV_FETCH(c0_) do { const int tt_ = (c0_) + pt; const bf16* q_ = RW + (size_t)tt_ * 1792; \
        rc = *(const u32x4*)q_; kc = *(const u32x4*)(q_ + 512); vc = *(const u32x4*)(q_ + 1024); \
        if (tt_ > 0) { rp = *(const u32x4*)(q_ - 1792); kp = *(const u32x4*)(q_ - 1792 + 512); vp = *(const u32x4*)(q_ - 1792 + 1024); } else { rp = (u32x4){0u, 0u, 0u, 0u}; kp = rp; vp = rp; } \
        wl0 = *(const f32x4*)(WLG + (size_t)tt_ * 512); wl1 = *(const f32x4*)(WLG + (size_t)tt_ * 512 + 4); ac = *(const u32x4*)(AS + (size_t)tt_ * 512); gc = *(const u32x4*)(GG + (size_t)tt_ * 512); } while (0)
    RWKV_FETCH(0);
    LDS_SYNC();
    for (int c0 = 0; c0 < SEQ; c0 += 64) {
        unsigned char* slot = lds + cc * SLOT;
        f32x4 r0, r1, kq0, kq1, v0, v1, kk0, kk1, b0, b1; const u32x4 gkeep = gc; const f32x4 wk0 = wl0, wk1 = wl1; float bo;
        { f32x4 c0_, c1_, p0_, p1_, a0, a1;
          pg8::unpack8(rc, c0_, c1_); pg8::unpack8(rp, p0_, p1_); r0 = c0_ + (p0_ - c0_) * *(const f32x4*)(ct_ + k8); r1 = c1_ + (p1_ - c1_) * *(const f32x4*)(ct_ + k8 + 4);
          pg8::unpack8(kc, c0_, c1_); pg8::unpack8(kp, p0_, p1_); const f32x4 k00 = c0_ + (p0_ - c0_) * *(const f32x4*)(ct_ + 64 + k8), k01 = c1_ + (p1_ - c1_) * *(const f32x4*)(ct_ + 64 + k8 + 4);
          pg8::unpack8(vc, c0_, c1_); pg8::unpack8(vp, p0_, p1_); v0 = c0_ + (p0_ - c0_) * *(const f32x4*)(ct_ + 128 + k8); v1 = c1_ + (p1_ - c1_) * *(const f32x4*)(ct_ + 128 + k8 + 4);
          pg8::unpack8(ac, a0, a1);
          kk0 = k00 * *(const f32x4*)(ct_ + 192 + k8); kk1 = k01 * *(const f32x4*)(ct_ + 192 + k8 + 4);
          const float inv = 1.0f / fmaxf(sqrtf(red8((kk0.x * kk0.x + kk0.y * kk0.y + kk0.z * kk0.z + kk0.w * kk0.w) + (kk1.x * kk1.x + kk1.y * kk1.y + kk1.z * kk1.z + kk1.w * kk1.w))), 1e-12f);
          kk0 = kk0 * inv; kk1 = kk1 * inv; b0 = kk0 * a0; b1 = kk1 * a1;
          kq0 = k00 * (1.0f + (a0 - 1.0f) * *(const f32x4*)(ct_ + 256 + k8)); kq1 = k01 * (1.0f + (a1 - 1.0f) * *(const f32x4*)(ct_ + 256 + k8 + 4));
          const f32x4 q0 = r0 * kq0 * *(const f32x4*)(ct_ + 320 + k8), q1 = r1 * kq1 * *(const f32x4*)(ct_ + 320 + k8 + 4);
          bo = red8((q0.x + q0.y + q0.z + q0.w) + (q1.x + q1.y + q1.z + q1.w));
          *(f32x4*)(WL + pt * 64 + k8) = wk0; *(f32x4*)(WL + pt * 64 + k8 + 4) = wk1; }
        if (c0 + 64 < SEQ) RWKV_FETCH(c0 + 64);
        LDS_SYNC();
        if (tid < 256) { const int c_ = tid >> 6, k_ = tid & 63; float w16[16], run = 0.f;
#pragma unroll
            for (int t = 0; t < 16; ++t) w16[t] = WL[(c_ * 16 + t) * 64 + k_];
#pragma unroll
            for (int t = 0; t < 16; ++t) { run += w16[t]; WL[(c_ * 16 + t) * 64 + k_] = run; }
            ((float*)(lds + c_ * SLOT + O_DL))[k_] = __expf(run); }
        LDS_SYNC();
        { const f32x4 cs0 = *(const f32x4*)(WL + pt * 64 + k8), cs1 = *(const f32x4*)(WL + pt * 64 + k8 + 4), d0 = *(const f32x4*)((const float*)(slot + O_DL) + k8), d1 = *(const f32x4*)((const float*)(slot + O_DL) + k8 + 4);
          f32x4 e0, e1, f0, f1, w0, w1;
#pragma unroll
          for (int i = 0; i < 4; ++i) { e0[i] = __expf(cs0[i]); e1[i] = __expf(cs1[i]); f0[i] = __builtin_amdgcn_rcpf(e0[i]); f1[i] = __builtin_amdgcn_rcpf(e1[i]); w0[i] = __expf(-wk0[i]); w1[i] = __expf(-wk1[i]); }
          const f32x4 bt0 = b0 * f0, bt1 = b1 * f1, kt0 = kq0 * f0, kt1 = kq1 * f1;
          *(u32x4*)((bf16*)slot + tl * 64 + k8) = pg8::pack8(-(kk0 * e0 * w0), -(kk1 * e1 * w1));
          *(u32x4*)((bf16*)(slot + O_RT) + tl * 64 + k8) = pg8::pack8(r0 * e0, r1 * e1);
          *(u32x4*)((bf16*)(slot + O_BTL) + tl * 64 + k8) = pg8::pack8(bt0, bt1);
          *(u32x4*)((bf16*)(slot + O_KTL) + tl * 64 + k8) = pg8::pack8(kt0, kt1);
          const f32x4 bh0 = bt0 * d0, bh1 = bt1 * d1, kh0 = kt0 * d0, kh1 = kt1 * d1;
          bf16* bht = (bf16*)(slot + O_BHT) + k8 * 16 + tl; bf16* kht = (bf16*)(slot + O_KHT) + k8 * 16 + tl; bf16* vt = (bf16*)(slot + O_VT) + k8 * 16 + tl;
#pragma unroll
          for (int i = 0; i < 4; ++i) { bht[i * 16] = f2bf(bh0[i]); bht[(i + 4) * 16] = f2bf(bh1[i]); kht[i * 16] = f2bf(kh0[i]); kht[(i + 4) * 16] = f2bf(kh1[i]); vt[i * 16] = f2bf(v0[i]); vt[(i + 4) * 16] = f2bf(v1[i]); } }
        LDS_SYNC();
        { unsigned char* sl = lds + (wave & 3) * SLOT; const int c16 = lane & 15, q = lane >> 4;
          const bf16x8_t a0 = *(const bf16x8_t*)((const bf16*)sl + c16 * 64 + 8 * q), a1 = *(const bf16x8_t*)((const bf16*)sl + c16 * 64 + 32 + 8 * q);
          const bf16x8_t bb0 = *(const bf16x8_t*)((const bf16*)(sl + O_BTL) + c16 * 64 + 8 * q), bb1 = *(const bf16x8_t*)((const bf16*)(sl + O_BTL) + c16 * 64 + 32 + 8 * q);
          const f32x4_t z4 = {0.f, 0.f, 0.f, 0.f};
          if (wave < 4) {
              f32x4_t n = __builtin_amdgcn_mfma_f32_16x16x32_bf16(a0, bb0, z4, 0, 0, 0); n = __builtin_amdgcn_mfma_f32_16x16x32_bf16(a1, bb1, n, 0, 0, 0);
              float* nf = Nf + (wave & 3) * 256;
#pragma unroll
              for (int r = 0; r < 4; ++r) nf[c16 * 16 + 4 * q + r] = (c16 < 4 * q + r) ? n[r] : 0.f;
              WAVE_SYNC();
              float tc[16];
#pragma unroll
              for (int t = 0; t < 16; ++t) tc[t] = (t == c16) ? 1.f : 0.f;
#pragma unroll
              for (int s2 = 0; s2 < 15; ++s2) { const f32x4 n0 = *(const f32x4*)(nf + s2 * 16), n1 = *(const f32x4*)(nf + s2 * 16 + 4), n2 = *(const f32x4*)(nf + s2 * 16 + 8), n3 = *(const f32x4*)(nf + s2 * 16 + 12);
                  const float ts = tc[s2]; const float nn[16] = {n0.x, n0.y, n0.z, n0.w, n1.x, n1.y, n1.z, n1.w, n2.x, n2.y, n2.z, n2.w, n3.x, n3.y, n3.z, n3.w};
#pragma unroll
                  for (int t = 0; t < 16; ++t) if (t > s2) tc[t] += nn[t] * ts; }
              if (q == 0) { bf16* tm = (bf16*)(sl + O_TM) + c16;
#pragma unroll
                  for (int t = 0; t < 16; ++t) tm[t * 16] = f2bf(tc[t]); }
          } else {
              const bf16x8_t r0f = *(const bf16x8_t*)((const bf16*)(sl + O_RT) + c16 * 64 + 8 * q), r1f = *(const bf16x8_t*)((const bf16*)(sl + O_RT) + c16 * 64 + 32 + 8 * q);
              const bf16x8_t kb0 = *(const bf16x8_t*)((const bf16*)(sl + O_KTL) + c16 * 64 + 8 * q), kb1 = *(const bf16x8_t*)((const bf16*)(sl + O_KTL) + c16 * 64 + 32 + 8 * q);
              f32x4_t ak = __builtin_amdgcn_mfma_f32_16x16x32_bf16(a0, kb0, z4, 0, 0, 0); ak = __builtin_amdgcn_mfma_f32_16x16x32_bf16(a1, kb1, ak, 0, 0, 0);
              f32x4_t rb = __builtin_amdgcn_mfma_f32_16x16x32_bf16(r0f, bb0, z4, 0, 0, 0); rb = __builtin_amdgcn_mfma_f32_16x16x32_bf16(r1f, bb1, rb, 0, 0, 0);
              f32x4_t rk = __builtin_amdgcn_mfma_f32_16x16x32_bf16(r0f, kb0, z4, 0, 0, 0); rk = __builtin_amdgcn_mfma_f32_16x16x32_bf16(r1f, kb1, rk, 0, 0, 0);
#pragma unroll
              for (int r = 0; r < 4; ++r) { const int t = 4 * q + r;
                  ((bf16*)(sl + O_AAK))[t * 16 + c16] = f2bf(c16 < t ? ak[r] : 0.f); ((bf16*)(sl + O_RB))[t * 16 + c16] = f2bf(c16 <= t ? rb[r] : 0.f); ((bf16*)(sl + O_RK))[t * 16 + c16] = f2bf(c16 <= t ? rk[r] : 0.f); }
          } }
        LDS_SYNC();
        if (wave < 4) { const int c16 = lane & 15, q = lane >> 4, vcol = 16 * wave + c16; u32x2 zz; zz.x = 0u; zz.y = 0u; const f32x4_t z4 = {0.f, 0.f, 0.f, 0.f};
#pragma unroll
            for (int ch = 0; ch < 4; ++ch) { const unsigned char* sl = lds + ch * SLOT;
                const bf16* at = (const bf16*)sl + c16 * 64 + 4 * q; const bf16* rt = (const bf16*)(sl + O_RT) + c16 * 64 + 4 * q;
                const bf16x8_t af0 = frag2(*(const u32x2*)at, *(const u32x2*)(at + 16)), af1 = frag2(*(const u32x2*)(at + 32), *(const u32x2*)(at + 48));
                const bf16x8_t rf0 = frag2(*(const u32x2*)rt, *(const u32x2*)(rt + 16)), rf1 = frag2(*(const u32x2*)(rt + 32), *(const u32x2*)(rt + 48));
                const u32x2 vq = *(const u32x2*)((const bf16*)(sl + O_VT) + vcol * 16 + 4 * q);
                const u32x2 aq = *(const u32x2*)((const bf16*)(sl + O_AAK) + c16 * 16 + 4 * q), tq = *(const u32x2*)((const bf16*)(sl + O_TM) + c16 * 16 + 4 * q);
                const u32x2 rbq = *(const u32x2*)((const bf16*)(sl + O_RB) + c16 * 16 + 4 * q), rkq = *(const u32x2*)((const bf16*)(sl + O_RK) + c16 * 16 + 4 * q);
                f32x4_t rhs = __builtin_amdgcn_mfma_f32_16x16x32_bf16(frag2(zz, aq), frag2(zz, vq), z4, 0, 0, 0); rhs = __builtin_amdgcn_mfma_f32_16x16x32_bf16(af0, Sf[0], rhs, 0, 0, 0);
                { const f32x4_t r2 = __builtin_amdgcn_mfma_f32_16x16x32_bf16(af1, Sf[1], z4, 0, 0, 0); rhs = rhs + r2; }
                u32x2 rl; rl.x = pk2(rhs[0], rhs[1]); rl.y = pk2(rhs[2], rhs[3]);
                const f32x4_t U = __builtin_amdgcn_mfma_f32_16x16x32_bf16(frag2(tq, zz), frag2(rl, zz), z4, 0, 0, 0);
                u32x2 ul; ul.x = pk2(U[0], U[1]); ul.y = pk2(U[2], U[3]); const bf16x8_t uv = frag2(ul, vq);
                f32x4_t y = __builtin_amdgcn_mfma_f32_16x16x32_bf16(rf0, Sf[0], z4, 0, 0, 0); y = __builtin_amdgcn_mfma_f32_16x16x32_bf16(rf1, Sf[1], y, 0, 0, 0);
                y = __builtin_amdgcn_mfma_f32_16x16x32_bf16(frag2(rbq, rkq), uv, y, 0, 0, 0);
#pragma unroll
                for (int r = 0; r < 4; ++r) Yb[(ch * 16 + 4 * q + r) * 64 + vcol] = y[r];
#pragma unroll
                for (int kt = 0; kt < 4; ++kt) { const f32x4 dl = *(const f32x4*)((const float*)(sl + O_DL) + 16 * kt + 4 * q);
                    const u32x2 bq = *(const u32x2*)((const bf16*)(sl + O_BHT) + (16 * kt + c16) * 16 + 4 * q), kq = *(const u32x2*)((const bf16*)(sl + O_KHT) + (16 * kt + c16) * 16 + 4 * q);
                    const f32x4_t cin = {Sd[kt][0] * dl.x, Sd[kt][1] * dl.y, Sd[kt][2] * dl.z, Sd[kt][3] * dl.w};
                    Sd[kt] = __builtin_amdgcn_mfma_f32_16x16x32_bf16(frag2(bq, kq), uv, cin, 0, 0, 0); }
#pragma unroll
                for (int s2 = 0; s2 < 2; ++s2) { u32x2 lo, hi; lo.x = pk2(Sd[2 * s2][0], Sd[2 * s2][1]); lo.y = pk2(Sd[2 * s2][2], Sd[2 * s2][3]); hi.x = pk2(Sd[2 * s2 + 1][0], Sd[2 * s2 + 1][1]); hi.y = pk2(Sd[2 * s2 + 1][2], Sd[2 * s2 + 1][3]); Sf[s2] = frag2(lo, hi); }
            } }
        LDS_SYNC();
        { const f32x4 y0 = *(const f32x4*)(Yb + pt * 64 + k8), y1 = *(const f32x4*)(Yb + pt * 64 + k8 + 4);
          const float mean = red8((y0.x + y0.y + y0.z + y0.w) + (y1.x + y1.y + y1.z + y1.w)) * (1.f / 64); const f32x4 d0 = y0 - mean, d1 = y1 - mean;
          const float rstd = 1.0f / sqrtf(red8((d0.x * d0.x + d0.y * d0.y + d0.z * d0.z + d0.w * d0.w) + (d1.x * d1.x + d1.y * d1.y + d1.z * d1.z + d1.w * d1.w)) * (1.f / 64) + GN_EPS);
          f32x4 g0, g1; pg8::unpack8(gkeep, g0, g1);
          const f32x4 o0 = (d0 * rstd * *(const f32x4*)(ct_ + 384 + k8) + *(const f32x4*)(ct_ + 448 + k8) + bo * v0) * g0, o1 = (d1 * rstd * *(const f32x4*)(ct_ + 384 + k8 + 4) + *(const f32x4*)(ct_ + 448 + k8 + 4) + bo * v1) * g1;
          *(u32x4*)(YC + (size_t)(c0 + pt) * 512) = pg8::pack8(o0, o1); }
    }
#undef RWKV_FETCH
}

__device__ __forceinline__ void s5_unit(KArgs C, int layer, int unit, unsigned char* lds) {
    const int tid = fresh_tid(), lane = tid & 63, wave = tid >> 6, bl = unit >> 5, g = unit & 31, c16 = lane & 15, q = lane >> 4, sg = wave & 3, th = wave >> 2, p = 16 * sg + c16;
    constexpr int SP = 136;
    float* us = (float*)lds; float* ends = us + 1024; bf16* St = (bf16*)(ends + 16 * 128);
    const bf16* U = WSP(const bf16, WS_U) + (size_t)bl * SEQ * 512 + g * 16;
    bf16* YD0 = WSP(bf16, WS_YD0) + (size_t)bl * SEQ * 512 + g * 16;
    const size_t wo = (layer & 1) ? WDELTA : 0;
    bf16x8_t bre, bim;
    { const float* bb = WSP(const float, WS_BBAR + wo) + ((size_t)g * 64 + p) * 32; u32x4 wr_, wi_;
      if (q < 2) { const float* b8 = bb + 16 * q; wr_.x = pk2(b8[0], b8[2]); wr_.y = pk2(b8[4], b8[6]); wr_.z = pk2(b8[8], b8[10]); wr_.w = pk2(b8[12], b8[14]);
                   wi_.x = pk2(b8[1], b8[3]); wi_.y = pk2(b8[5], b8[7]); wi_.z = pk2(b8[9], b8[11]); wi_.w = pk2(b8[13], b8[15]); }
      else { wr_ = (u32x4){0u, 0u, 0u, 0u}; wi_ = wr_; }
      bre = __builtin_bit_cast(bf16x8_t, wr_); bim = __builtin_bit_cast(bf16x8_t, wi_); }
    float apr[4], api[4];
    { const float ar = WSP(const float, WS_ABAR + wo)[(g * 64 + p) * 2], ai = WSP(const float, WS_ABAR + wo)[(g * 64 + p) * 2 + 1]; apr[0] = ar; api[0] = ai;
#pragma unroll
      for (int i = 1; i < 4; ++i) { apr[i] = apr[i - 1] * ar - api[i - 1] * ai; api[i] = apr[i - 1] * ai + api[i - 1] * ar; } }
    bf16x8_t cf[4];
    { const float* cre = C->in[I_S5CRE] + ((size_t)layer * 32 + g) * 1024 + c16 * 64; const float* cim = C->in[I_S5CIM] + ((size_t)layer * 32 + g) * 1024 + c16 * 64;
#pragma unroll
      for (int ks = 0; ks < 4; ++ks) { const int c0_ = 32 * ks + 8 * q; const float* src = c0_ < 64 ? cre + c0_ : cim + (c0_ - 64); const float sgn = c0_ < 64 ? 1.f : -1.f;
          u32x4 w; w.x = pk2(sgn * src[0], sgn * src[1]); w.y = pk2(sgn * src[2], sgn * src[3]); w.z = pk2(sgn * src[4], sgn * src[5]); w.w = pk2(sgn * src[6], sgn * src[7]); cf[ks] = __builtin_bit_cast(bf16x8_t, w); } }
    const float dj = C->in[I_S5D][layer * 512 + g * 16 + c16];
    float cr = 0.f, ci = 0.f;
    u32x2 fu; fu.x = 0u; fu.y = 0u;
#define S5_FETCH(c0_) do { if (tid < 256) fu = *(const u32x2*)(U + (size_t)((c0_) + (tid >> 2)) * 512 + (tid & 3) * 4); } while (0)
    S5_FETCH(0);
    for (int c0 = 0; c0 < SEQ; c0 += 64) {
        LDS_SYNC();
        if (tid < 256) *(f32x4*)(us + (tid >> 2) * 16 + (tid & 3) * 4) = (f32x4){lo_bf(fu.x), hi_bf(fu.x), lo_bf(fu.y), hi_bf(fu.y)};
        if (c0 + 64 < SEQ) S5_FETCH(c0 + 64);
        LDS_SYNC();
        float lr[2][4], li[2][4];
#pragma unroll
        for (int tt = 0; tt < 2; ++tt) { bf16x8_t af;
            if (q < 2) { const float* ur = us + (32 * th + 16 * tt + c16) * 16 + 8 * q; const f32x4 u0 = *(const f32x4*)ur, u1 = *(const f32x4*)(ur + 4);
                u32x4 w; w.x = pk2(u0.x, u0.y); w.y = pk2(u0.z, u0.w); w.z = pk2(u1.x, u1.y); w.w = pk2(u1.z, u1.w); af = __builtin_bit_cast(bf16x8_t, w); }
            else { const u32x4 z = {0u, 0u, 0u, 0u}; af = __builtin_bit_cast(bf16x8_t, z); }
            const f32x4_t z4 = {0.f, 0.f, 0.f, 0.f};
            const f32x4_t dre = __builtin_amdgcn_mfma_f32_16x16x32_bf16(af, bre, z4, 0, 0, 0), dim = __builtin_amdgcn_mfma_f32_16x16x32_bf16(af, bim, z4, 0, 0, 0);
            lr[tt][0] = dre[0]; li[tt][0] = dim[0];
#pragma unroll
            for (int r = 1; r < 4; ++r) { lr[tt][r] = apr[0] * lr[tt][r - 1] - api[0] * li[tt][r - 1] + dre[r]; li[tt][r] = apr[0] * li[tt][r - 1] + api[0] * lr[tt][r - 1] + dim[r]; }
            const int rho = (2 * th + tt) * 4 + q; ends[(rho * 64 + p) * 2] = lr[tt][3]; ends[(rho * 64 + p) * 2 + 1] = li[tt][3]; }
        LDS_SYNC();
        { float xr = cr, xi = ci; const int rho0 = (2 * th) * 4 + q;
          for (int rr = 0; rr < 16; ++rr) {
              if (rr == rho0 || rr == rho0 + 4) { const int tt = (rr == rho0) ? 0 : 1;
#pragma unroll
                  for (int r = 0; r < 4; ++r) { const float sr = lr[tt][r] + apr[r] * xr - api[r] * xi, si = li[tt][r] + apr[r] * xi + api[r] * xr; const int t = 32 * th + 16 * tt + 4 * q + r;
                      St[t * SP + p] = f2bf(sr); St[t * SP + 64 + p] = f2bf(si); } }
              const float er = ends[(rr * 64 + p) * 2], ei = ends[(rr * 64 + p) * 2 + 1]; const float nr = apr[3] * xr - api[3] * xi + er, ni = apr[3] * xi + api[3] * xr + ei; xr = nr; xi = ni; }
          cr = xr; ci = xi; }
        LDS_SYNC();
        if (wave < 4) { f32x4_t y = {0.f, 0.f, 0.f, 0.f};
#pragma unroll
            for (int ks = 0; ks < 4; ++ks) y = __builtin_amdgcn_mfma_f32_16x16x32_bf16(*(const bf16x8_t*)(St + (16 * wave + c16) * SP + 32 * ks + 8 * q), cf[ks], y, 0, 0, 0);
#pragma unroll
            for (int r = 0; r < 4; ++r) { const int t = 16 * wave + 4 * q + r; YD0[(size_t)(c0 + t) * 512 + c16] = f2bf(gelu_tanh(y[r] + dj * us[t * 16 + c16])); } }
    }
#undef S5_FETCH
}

__device__ __forceinline__ unsigned ord_key(float f) { const unsigned u = __float_as_uint(f); return (u & 0x80000000u) ? ~u : (u | 0x80000000u); }
__device__ __forceinline__ void dsa_vt_item(KArgs C, int item, int lane, bf16* scr) {
    const int tb = item % NK64, bh = item / NK64, h = bh & 7, bl = bh >> 3;
    const bf16* V = WSP(const bf16, WS_V) + ((size_t)bl * SEQ + tb * 64) * 512 + h * 64;
    WAVE_SYNC();
#pragma unroll
    for (int i = 0; i < 8; ++i) { const int tk = (lane >> 3) + 8 * i, c8 = (lane & 7) * 8; const u32x4 w = *(const u32x4*)(V + (size_t)tk * 512 + c8);
        unsigned* d = (unsigned*)(scr + tk * 66 + c8); d[0] = w.x; d[1] = w.y; d[2] = w.z; d[3] = w.w; }
    WAVE_SYNC();
    bf16* Vt = WSP(bf16, WS_VT) + ((size_t)bh * 64) * SEQ + tb * 64 + lane;
#pragma unroll 8
    for (int d = 0; d < 64; ++d) Vt[(size_t)d * SEQ] = scr[lane * 66 + d];
}
constexpr int IDX_CAP = 128, IDX_NBIN = 1024;
__device__ __forceinline__ void dsa_index_unit(KArgs C, int unit, int lane, int wave, unsigned char* lds) {
    const int oct = unit & 7, pairid = (unit >> 3) % (NK64 / 2), kx = (unit >> 3) / (NK64 / 2), bl = kx >> 1, c = (kx & 1) ? NK64 - 1 - pairid : pairid;
    const int t0 = c * 64 + oct * 8, nkeys = (c + 1) * 64, nk64 = c + 1; const size_t row0 = (size_t)bl * SEQ + t0;
    unsigned* mrow = WSP(unsigned, WS_MASK) + (row0 + wave) * MW;
    if (nkeys <= TOPK) { for (int w = lane; w < MW; w += 64) mrow[w] = (w * 32 < nkeys) ? 0xffffffffu : 0u; return; }
    float* scf = (float*)lds;
    unsigned* hist = (unsigned*)(lds + LDS_X) + wave * (IDX_NBIN / 2); unsigned* candv = (unsigned*)(lds + LDS_X + 8 * IDX_NBIN * 2) + wave * IDX_CAP; unsigned* candi = candv + 8 * IDX_CAP; unsigned* mword = (unsigned*)(lds + LDS_X + 8 * IDX_NBIN * 2 + 16 * IDX_CAP * 4) + wave * MW;
    const bf16* SMb = WSP(const bf16, WS_SM) + (size_t)bl * SEQ * 256;
    const int l31 = lane & 31, half = lane >> 5;
    const bf16* qa = SMb + (size_t)(t0 + (l31 >> 2)) * 256 + 8 + (l31 & 3) * 32 + 8 * half;
    const bf16x8_t a0 = *(const bf16x8_t*)qa, a1 = *(const bf16x8_t*)(qa + 16);
    u32x2 wraw[4];
#pragma unroll
    for (int g = 0; g < 4; ++g) wraw[g] = *(const u32x2*)(SMb + (size_t)(t0 + 2 * g + half) * 256 + 168);
    LDS_SYNC();
    {
      float wv[4][4];
#pragma unroll
      for (int g = 0; g < 4; ++g) { const u32x2 w = wraw[g]; wv[g][0] = lo_bf(w.x) * 0.5f; wv[g][1] = hi_bf(w.x) * 0.5f; wv[g][2] = lo_bf(w.y) * 0.5f; wv[g][3] = hi_bf(w.y) * 0.5f; }
      for (int kt0 = wave; kt0 < nk64 * 2; kt0 += 8 * NWAVES) {
          bf16x8_t b0[8], b1[8];
#pragma unroll
          for (int u4 = 0; u4 < 8; ++u4) { const int kt = kt0 + 8 * u4; const bf16* kb = WSP(const bf16, WS_KI) + ((size_t)bl * SEQ + (size_t)((kt < nk64 * 2 ? kt : wave) * 32 + l31)) * 32 + 8 * half;
              b0[u4] = *(const bf16x8_t*)kb; b1[u4] = *(const bf16x8_t*)(kb + 16); }
#pragma unroll
          for (int u4 = 0; u4 < 8; ++u4) { const int kt = kt0 + 8 * u4; if (kt < nk64 * 2) {
              f32x16 d;
#pragma unroll
              for (int r = 0; r < 16; ++r) d[r] = 0.f;
              d = __builtin_amdgcn_mfma_f32_32x32x16_bf16(a0, b0[u4], d, 0, 0, 0); d = __builtin_amdgcn_mfma_f32_32x32x16_bf16(a1, b1[u4], d, 0, 0, 0);
#pragma unroll
              for (int g = 0; g < 4; ++g) { float sc = 0.f;
#pragma unroll
                  for (int j = 0; j < 4; ++j) sc += wv[g][j] * fmaxf(d[4 * g + j] * 0.17677669529f, 0.f);
                  scf[(2 * g + half) * SEQ + kt * 32 + l31] = sc; } } }
      } }
    { const int tail0 = nkeys, tail1 = ((nk64 + 7) >> 3) * 512;
      for (int e = tail0 + (int)(threadIdx.x); e < tail1; e += NTHREADS) {
#pragma unroll
          for (int qq = 0; qq < 8; ++qq) scf[qq * SEQ + e] = -3.0e38f; } }
    LDS_SYNC();
    const float* sc = scf + wave * SEQ; constexpr float NEG = -3.0e38f; const int nb8 = (nk64 + 7) >> 3;
    float v[NK64];
#pragma unroll
    for (int ib = 0; ib < NK64 / 8; ++ib) if (ib < nb8) {
#pragma unroll
        for (int j = 0; j < 8; ++j) v[ib * 8 + j] = sc[(ib * 8 + j) * 64 + lane];
        SCHED_FENCE(); }
    float mn = INFINITY, mx = -INFINITY;
#pragma unroll
    for (int ib = 0; ib < NK64 / 8; ++ib) if (ib < nb8) {
#pragma unroll
        for (int j = 0; j < 8; ++j) { const float x = v[ib * 8 + j]; mx = fmaxf(mx, x); mn = fminf(mn, x == NEG ? INFINITY : x); } }
    mn = -wave_max(-mn); mx = wave_max(mx);
    const float scale = (mx > mn) ? ((float)(IDX_NBIN - 2) - 0.01f) / (mx - mn) : 0.f;
#pragma unroll
    for (int i = 0; i < IDX_NBIN / 128; ++i) hist[lane * (IDX_NBIN / 128) + i] = 0u;
    for (int w = lane; w < MW; w += 64) mword[w] = 0u;
    WAVE_SYNC();
#define IDX_BIN(x) ({ const float x_ = (x); int b_ = (int)(fmaxf(x_ - mn, 0.f) * scale + 1.0f); b_ = b_ > IDX_NBIN - 2 ? IDX_NBIN - 2 : b_; b_ + (__float_as_int(x_) >> 31) + (__float_as_int(x_) > 0 ? 1 : 0); })
#pragma unroll
    for (int ib = 0; ib < NK64 / 8; ++ib) if (ib < nb8) {
#pragma unroll
        for (int j = 0; j < 8; ++j) { const int b = IDX_BIN(v[ib * 8 + j]); atomicAdd(&hist[b >> 1], (b & 1) ? 0x10000u : 1u); }
        SCHED_FENCE(); }
    WAVE_SYNC();
    int bstar, cgt;
    {
      unsigned hw[8]; int tot = 0;
#pragma unroll
      for (int i = 0; i < 8; ++i) { hw[i] = hist[lane * 8 + i]; tot += (int)(hw[i] & 0xffffu) + (int)(hw[i] >> 16); }
      int suf = tot;
#pragma unroll
      for (int o = 1; o < 64; o <<= 1) { const int t = __shfl_down(suf, o); if (lane + o < 64) suf += t; }
      const unsigned long long ge = __ballot(suf >= TOPK); const int L = 63 - __builtin_clzll(ge);
      int cum = __shfl(suf, L) - __shfl(tot, L); bstar = 16 * L; cgt = cum; bool found = false;
#pragma unroll
      for (int i = 7; i >= 0; --i) { const unsigned w = (unsigned)__shfl((int)hw[i], L); const int chi = (int)(w >> 16), clo = (int)(w & 0xffffu);
          if (!found && cum + chi >= TOPK) { bstar = 16 * L + 2 * i + 1; cgt = cum; found = true; } cum += found ? 0 : chi;
          if (!found && cum + clo >= TOPK) { bstar = 16 * L + 2 * i; cgt = cum; found = true; } cum += found ? 0 : clo; } }
    const int need = TOPK - cgt; int ncand = 0;
    const bool tiebin = bstar == IDX_BIN(0.0f);
    unsigned mylo = 0u, myhi = 0u;
#pragma unroll
    for (int ib = 0; ib < NK64 / 8; ++ib) if (ib < nb8) {
#pragma unroll
        for (int j = 0; j < 8; ++j) { const int i = ib * 8 + j; const int b = IDX_BIN(v[i]);
            unsigned long long bs = __ballot(b > bstar); const unsigned long long bc = __ballot(b == bstar);
            if (bc != 0ull) {
                const int pos = ncand + (int)__builtin_amdgcn_mbcnt_hi((unsigned)(bc >> 32), __builtin_amdgcn_mbcnt_lo((unsigned)bc, 0u));
                if (tiebin) bs |= __ballot(b == bstar && pos < need);
                else if (b == bstar && pos < IDX_CAP) { candv[pos] = ord_key(v[i]); candi[pos] = (unsigned)(i * 64 + lane); }
                ncand += __popcll(bc); }
            if (lane == i) { mylo = (unsigned)bs; myhi = (unsigned)(bs >> 32); } }
        SCHED_FENCE(); }
    if (lane < nb8 * 8) { mword[2 * lane] = mylo; mword[2 * lane + 1] = myhi; }
#undef IDX_BIN
    WAVE_SYNC();
    if (tiebin) { }
    else if (ncand <= IDX_CAP) {
        for (int m = lane; m < ncand; m += 64) { const unsigned vm = candv[m]; int rank = 0;
#pragma unroll 4
            for (int j = 0; j < ncand; ++j) { const unsigned vj = candv[j]; rank += (vj > vm || (vj == vm && j < m)) ? 1 : 0; }
            if (rank < need) { const unsigned idx = candi[m]; atomicOr(&mword[idx >> 5], 1u << (idx & 31)); } }
    } else {
        unsigned T = 0u;
        for (int bit = 31; bit >= 0; --bit) { const unsigned cand = T | (1u << bit); int cn = 0;
#pragma unroll
            for (int ib = 0; ib < NK64 / 8; ++ib) if (ib < nb8) {
#pragma unroll
                for (int j = 0; j < 8; ++j) cn += (ord_key(v[ib * 8 + j]) >= cand) ? 1 : 0; }
            if (wave_sum_i(cn) >= TOPK) T = cand; }
        int cg = 0;
#pragma unroll
        for (int ib = 0; ib < NK64 / 8; ++ib) if (ib < nb8) {
#pragma unroll
            for (int j = 0; j < 8; ++j) cg += (ord_key(v[ib * 8 + j]) > T) ? 1 : 0; }
        const int need2 = TOPK - wave_sum_i(cg); int taken = 0;
#pragma unroll
        for (int ib = 0; ib < NK64 / 8; ++ib) if (ib < nb8) {
#pragma unroll
            for (int j = 0; j < 8; ++j) { const int i = ib * 8 + j; const unsigned kv = ord_key(v[i]); const bool eq = kv == T; const unsigned long long be = __ballot(eq);
                const int pre = __popcll(be & ((1ull << lane) - 1ull)); const bool sel = (kv > T) || (eq && (taken + pre) < need2); taken += __popcll(be);
                const unsigned long long bs = __ballot(sel); if (lane == 0) { mword[2 * i] = (unsigned)bs; mword[2 * i + 1] = (unsigned)(bs >> 32); } } }
    }
    WAVE_SYNC();
#ifdef HOST_EMU
    if (lane == 0) { static int rows = 0, bad = 0, ties = 0, falls = 0; std::vector<int> id(nkeys); for (int i = 0; i < nkeys; ++i) id[i] = i;
        std::stable_sort(id.begin(), id.end(), [&](int a, int b) { return sc[a] > sc[b]; }); std::vector<unsigned> ref(MW, 0u); for (int i = 0; i < TOPK; ++i) ref[id[i] >> 5] |= 1u << (id[i] & 31);
        bool ok = true; for (int w = 0; w < MW; ++w) ok = ok && ref[w] == mword[w]; ++rows; bad += ok ? 0 : 1; ties += tiebin ? 1 : 0; falls += (!tiebin && ncand > IDX_CAP) ? 1 : 0;
        if ((rows & 63) == 0 || !ok) printf("[idx-check] rows %d bad %d tiebin %d fallback %d\n", rows, bad, ties, falls); }
#endif
    for (int w = lane; w < MW; w += 64) mrow[w] = mword[w];
}

constexpr int AT_KP = 72, AT_VP = 72, AT_BUF = 64 * AT_KP + 64 * AT_VP;
__device__ __forceinline__ void dsa_attn_half(KArgs C, int bl, int h, int cb, int tid, bf16* tiles, const float* btab) {
    const int lane = tid & 63, wave = tid >> 6, l31 = lane & 31, hh = lane >> 5, c = 4 * cb + (wave >> 1), qb = wave & 1, q0 = c * 64 + qb * 32, qpos = q0 + l31, q0s = __builtin_amdgcn_readfirstlane(q0);
    const size_t qrow = (size_t)bl * SEQ + qpos;
    const bf16* Qp = WSP(const bf16, WS_Q) + qrow * 512 + h * 64 + 8 * hh;
    const unsigned* Mp = WSP(const unsigned, WS_MASK) + qrow * MW;
    const bf16* gk = WSP(const bf16, WS_K) + ((size_t)bl * SEQ + (tid >> 3)) * 512 + h * 64 + (tid & 7) * 8;
    const bf16* gv = WSP(const bf16, WS_VT) + ((size_t)(bl * 8 + h) * 64 + (tid >> 3)) * SEQ + (tid & 7) * 8;
    const int lk = (tid >> 3) * AT_KP + (tid & 7) * 8, lv = 64 * AT_KP + (tid >> 3) * AT_VP + (tid & 7) * 8;
    constexpr float SC = 0.125f * 1.44269504089f;
    bf16x8_t qf[4];
#pragma unroll
    for (int s = 0; s < 4; ++s) qf[s] = *(const bf16x8_t*)(Qp + 16 * s);
    f32x16 O0, O1;
#pragma unroll
    for (int r = 0; r < 16; ++r) { O0[r] = 0.f; O1[r] = 0.f; }
    float m = -1e30f, lsum = 0.f;
    const int ntw = c + 1, nt = 4 * cb + 4;
    u32x4 prek = *(const u32x4*)gk, prev = *(const u32x4*)gv; u32x2 mwn = *(const u32x2*)Mp;
    LDS_SYNC();
    const float bfar = btab[0];
    *(u32x4*)(tiles + lk) = prek; *(u32x4*)(tiles + lv) = prev;
    if (nt > 1) { prek = *(const u32x4*)(gk + (size_t)64 * 512); prev = *(const u32x4*)(gv + 64); }
    for (int kt = 0; kt < nt; ++kt) {
        LDS_SYNC();
        const bf16* tb = tiles + (kt & 1) * AT_BUF; const u32x2 mw2 = mwn;
        if (kt + 1 < ntw) mwn = *(const u32x2*)(Mp + 2 * (kt + 1));
        if (kt < ntw) {
            f32x16 S[2];
#pragma unroll
            for (int t2 = 0; t2 < 2; ++t2) {
#pragma unroll
                for (int r = 0; r < 16; ++r) S[t2][r] = 0.f;
#pragma unroll
                for (int s = 0; s < 4; ++s) S[t2] = __builtin_amdgcn_mfma_f32_32x32x16_bf16(*(const bf16x8_t*)(tb + (t2 * 32 + l31) * AT_KP + 16 * s + 8 * hh), qf[s], S[t2], 0, 0, 0); }
#define AT_P2(P_, X0_, X1_, MW_, R_, ROW_) do { f32x2 pp_; pp_.x = __uint_as_float(__float_as_uint(__builtin_amdgcn_exp2f(X0_)) & bit_fill<ROW_>(MW_)); \
                pp_.y = __uint_as_float(__float_as_uint(__builtin_amdgcn_exp2f(X1_)) & bit_fill<ROW_ + 1>(MW_)); P_[R_] = pp_.x; P_[R_ + 1] = pp_.y; ps2 += pp_; } while (0)
#define AT_RESCALE(TM_) do { float tm_ = (TM_); tm_ = fmaxf(tm_, __shfl_xor(tm_, 32)); \
                if (__ballot(tm_ > m) != 0ull) { const float mn = fmaxf(m, tm_), alpha = __builtin_amdgcn_exp2f(m - mn); m = mn; lsum *= alpha; \
                    _Pragma("unroll") for (int r = 0; r < 16; ++r) { O0[r] *= alpha; O1[r] *= alpha; } } } while (0)
            f32x16 P[2]; f32x2 ps2 = (f32x2){0.f, 0.f}; float tm;
            const unsigned mwc0 = mw2.x >> (4 * hh), mwc1 = mw2.y >> (4 * hh);
            const bool far = (kt * 64 + 63 - q0s) <= -166;
            if (far) { float rm = fmaxf(S[0][0], S[1][0]);
#pragma unroll
                for (int r = 1; r < 16; ++r) rm = fmaxf(fmaxf(rm, S[0][r]), S[1][r]);
                tm = rm * SC + bfar;
            } else { tm = -1e30f;
#pragma unroll
                for (int t2 = 0; t2 < 2; ++t2) { const int rb = kt * 64 + t2 * 32 + 4 * hh - qpos + 256;
#pragma unroll
                    for (int r = 0; r < 16; ++r) { const int row = (r & 3) + 8 * (r >> 2); int ti = rb + row; ti = ti < 0 ? 0 : ti; tm = fmaxf(tm, S[t2][r] * SC + btab[ti]); } } }
            AT_RESCALE(tm);
            if (far) { const float ad = bfar - m;
#define AT_FAR(R_, ROW_) do { const f32x2 x0_ = (f32x2){S[0][R_], S[0][R_ + 1]} * SC + ad, x1_ = (f32x2){S[1][R_], S[1][R_ + 1]} * SC + ad; \
                    AT_P2(P[0], x0_.x, x0_.y, mwc0, R_, ROW_); AT_P2(P[1], x1_.x, x1_.y, mwc1, R_, ROW_); } while (0)
                AT_FAR(0, 0); AT_FAR(2, 2); AT_FAR(4, 8); AT_FAR(6, 10); AT_FAR(8, 16); AT_FAR(10, 18); AT_FAR(12, 24); AT_FAR(14, 26);
#undef AT_FAR
            } else {
#define AT_BIAS(T2_, R_, ROW_) (S[T2_][R_] * SC + (btab[imax0(kt * 64 + (T2_) * 32 + 4 * hh - qpos + 256 + (ROW_))] - m))
#define AT_NEAR(R_, ROW_) do { AT_P2(P[0], AT_BIAS(0, R_, ROW_), AT_BIAS(0, R_ + 1, ROW_ + 1), mwc0, R_, ROW_); AT_P2(P[1], AT_BIAS(1, R_, ROW_), AT_BIAS(1, R_ + 1, ROW_ + 1), mwc1, R_, ROW_); } while (0)
                AT_NEAR(0, 0); AT_NEAR(2, 2); AT_NEAR(4, 8); AT_NEAR(6, 10); AT_NEAR(8, 16); AT_NEAR(10, 18); AT_NEAR(12, 24); AT_NEAR(14, 26);
#undef AT_BIAS
#undef AT_NEAR
            }
#undef AT_P2
#undef AT_RESCALE
            const float ps = ps2.x + ps2.y;
            lsum += ps;
#pragma unroll
            for (int t2 = 0; t2 < 2; ++t2) { const bf16* vb = tb + 64 * AT_KP + l31 * AT_VP + t2 * 32 + 4 * hh;
#pragma unroll
                for (int s = 0; s < 2; ++s) { u32x4 w; w.x = pk2(P[t2][8 * s + 0], P[t2][8 * s + 1]); w.y = pk2(P[t2][8 * s + 2], P[t2][8 * s + 3]); w.z = pk2(P[t2][8 * s + 4], P[t2][8 * s + 5]); w.w = pk2(P[t2][8 * s + 6], P[t2][8 * s + 7]);
                    const bf16x8_t pf = __builtin_bit_cast(bf16x8_t, w);
                    O0 = __builtin_amdgcn_mfma_f32_32x32x16_bf16(frag2(*(const u32x2*)(vb + 16 * s), *(const u32x2*)(vb + 16 * s + 8)), pf, O0, 0, 0, 0);
                    O1 = __builtin_amdgcn_mfma_f32_32x32x16_bf16(frag2(*(const u32x2*)(vb + 32 * AT_VP + 16 * s), *(const u32x2*)(vb + 32 * AT_VP + 16 * s + 8)), pf, O1, 0, 0, 0); } }
        }
        if (kt + 1 < nt) { bf16* nb = tiles + ((kt + 1) & 1) * AT_BUF; *(u32x4*)(nb + lk) = prek; *(u32x4*)(nb + lv) = prev;
            if (kt + 2 < nt) { prek = *(const u32x4*)(gk + (size_t)(kt + 2) * 64 * 512); prev = *(const u32x4*)(gv + (size_t)(kt + 2) * 64); } }
    }
    lsum += __shfl_xor(lsum, 32);
    const float inv = 1.0f / lsum;
    bf16* Y = WSP(bf16, WS_Y) + (size_t)MG * 512 + qrow * 512 + h * 64 + 4 * hh;
#pragma unroll
    for (int g = 0; g < 4; ++g) { u32x2 w; w.x = pk2(O0[4 * g] * inv, O0[4 * g + 1] * inv); w.y = pk2(O0[4 * g + 2] * inv, O0[4 * g + 3] * inv); *(u32x2*)(Y + 8 * g) = w;
        u32x2 w2; w2.x = pk2(O1[4 * g] * inv, O1[4 * g + 1] * inv); w2.y = pk2(O1[4 * g + 2] * inv, O1[4 * g + 3] * inv); *(u32x2*)(Y + 32 + 8 * g) = w2; }
}
__device__ __forceinline__ void dsa_attn_unit3(KArgs C, int unit, int tid, unsigned char* lds) {
    constexpr int NPAIR = NK64 / 8;
    const int pr = unit % NPAIR, h = (unit / NPAIR) & 7, bl = unit / (NPAIR * 8);
    float* btab = (float*)lds; bf16* tiles = (bf16*)(lds + 2048);
    __syncthreads();
    { const int* tab = WSP(const int, WS_TAB); const float* relb = C->in[I_RELB];
      if (tid < 320) btab[tid] = relb[tab[tid - 256 + SEQ - 1] * 8 + h] * 1.44269504089f; }
    dsa_attn_half(C, bl, h, pr, tid, tiles, btab);
    dsa_attn_half(C, bl, h, NK64 / 4 - 1 - pr, tid, tiles, btab);
}
#ifndef GP_ALIGN
#define GP_ALIGN true
#endif
#ifndef GP_SP2
#define GP_SP2 true
#endif
constexpr int SEGS_PER_GROUP = 11, NSEG = DEPTH * (1 + NGRP * SEGS_PER_GROUP) + 1;

#ifdef HOST_EMU
#define GRID_BARRIER() emu_grid_sync()
#define LDS_PTR(p) ((unsigned char*)(p))
#else
#define GRID_BARRIER() do { XcdBarrier b_; b_.bar = (unsigned*)(Ck->ws + WS_CTL); b_.x = xb_xcc_id(); b_.st = (volatile LAS unsigned*)(lds + LDS_CTL_OFF); xcd_barrier(b_); } while (0)
#define LDS_PTR(p) ((PG8_LAS unsigned char*)(p))
#endif

__global__ void __launch_bounds__(NTHREADS, 2) fwd_kernel(Args a) {
#ifdef HOST_EMU
    unsigned char* lds = emu_lds;
#else
    extern __shared__ __attribute__((aligned(16))) unsigned char lds[];
#endif
#ifdef HOST_EMU
    KArgs Ck = &a;
#else
    KArgs Ck = (KArgs)__builtin_amdgcn_kernarg_segment_ptr();
    (void)a;
#endif
#ifndef HOST_EMU
    if (threadIdx.x < 4) ((LAS unsigned*)(lds + LDS_CTL_OFF))[threadIdx.x] = 0u;
    __syncthreads();
    if (Ck->seg_hi - Ck->seg_lo > 1) (void)xcd_barrier_post((unsigned*)(Ck->ws + WS_CTL), (volatile LAS unsigned*)(lds + LDS_CTL_OFF));
#endif
#define SEGID 0
#define RUN (SEGID >= Ck->seg_lo && SEGID < Ck->seg_hi)
#define SEAM do { if (SEGID >= Ck->seg_lo && SEGID + 1 < Ck->seg_hi) { GRID_BARRIER(); } } while (0)
#define WO ((layer & 1) ? WDELTA : (size_t)0)
#define PHASE_VARS KArgs C = KLAUNDER(Ck); const int G = gridDim.x, bx = blockIdx.x, ngw = G * NWAVES; (void)ngw; const int tid = fresh_tid(), lane = tid & 63, wave = __builtin_amdgcn_readfirstlane(tid >> 6), gw = bx * NWAVES + wave; (void)lane; (void)gw; (void)C
    for (int layer = 0; layer < DEPTH; ++layer) {
#undef SEGID
#define SEGID (layer * (1 + NGRP * SEGS_PER_GROUP))
        if (RUN) { PHASE_VARS; phase_weights(C, layer, lds, gw, ngw, lane, wave); }
        SEAM;
        for (int grp = 0; grp < NGRP; ++grp) {
#define XIN ((layer == 0 ? C->in[I_X] : (const float*)C->out) + (size_t)grp * MG * D)
#define XOUT (C->out + (size_t)grp * MG * D)
#undef SEGID
#define SEGID (layer * (1 + NGRP * SEGS_PER_GROUP) + 1 + grp * SEGS_PER_GROUP + 0)
            if (RUN) { PHASE_VARS; for (int m = gw; m < MG; m += 2 * ngw) { if (m + ngw < MG) rms_rowN_bf16<2>(XIN + (size_t)m * D, C->in[I_NMIX] + layer * D, WSP(bf16, WS_H) + (size_t)m * D, (size_t)ngw * D, lane); else rms_row_bf16(XIN + (size_t)m * D, C->in[I_NMIX] + layer * D, WSP(bf16, WS_H) + (size_t)m * D, lane); } }
            SEAM;
#undef SEGID
#define SEGID (layer * (1 + NGRP * SEGS_PER_GROUP) + 1 + grp * SEGS_PER_GROUP + 1)
            if (RUN) { PHASE_VARS; pg8::Gemm g{WSP(const bf16, WS_H), WSP(const bf16, WS_WIN + WO), MG, NMIXC, D}; pg8::StaticOrder S; S.init(MG, NMIXC, G, bx);
                pg8::EpiProj E{C->ws};
                pg8::gemm_phase<pg8::EpiProj, pg8::StaticOrder, false, GP_ALIGN, GP_SP2>(LDS_PTR(lds), g, S, E, nullptr); }
            SEAM;
#undef SEGID
#define SEGID (layer * (1 + NGRP * SEGS_PER_GROUP) + 1 + grp * SEGS_PER_GROUP + 2)
            if (RUN) { PHASE_VARS;
                for (int m = gw; m < MG; m += 2 * ngw) { if (m + ngw < MG) { rwkv_prep_row2(C, layer, m, ngw, lane); ssd_conv_row2(C, layer, m, ngw, lane); } else { rwkv_prep_row(C, layer, m, lane); ssd_conv_row(C, layer, m, lane); } }
                for (int it = gw; it < NB * 8 * NK64; it += ngw) dsa_vt_item(C, it, lane, (bf16*)(lds + wave * 16384));
                __syncthreads();
                for (int u = bx; u < NB * NK64 * 8; u += G) dsa_index_unit(C, u, lane, wave, lds);
            }
            SEAM;
#undef SEGID
#define SEGID (layer * (1 + NGRP * SEGS_PER_GROUP) + 1 + grp * SEGS_PER_GROUP + 3)
            if (RUN) { PHASE_VARS; pg8::Gemm g{WSP(const bf16, WS_RA), WSP(const bf16, WS_WLORA + WO), MG, 1536, 256}; pg8::StaticOrder S; S.init(MG, 1536, G, bx);
                pg8::EpiLora E{WSP(float, WS_WLOG), WSP(bf16, WS_ASIG), WSP(bf16, WS_GG), C->in[I_W0] + layer * 512, C->in[I_A0] + layer * 512};
                pg8::gemm_phase<pg8::EpiLora, pg8::StaticOrder, false, GP_ALIGN, GP_SP2>(LDS_PTR(lds), g, S, E, nullptr); }
            SEAM;
#undef SEGID
#define SEGID (layer * (1 + NGRP * SEGS_PER_GROUP) + 1 + grp * SEGS_PER_GROUP + 4)
            if (RUN) { PHASE_VARS;
                constexpr int U_R = NB * 8, U_S = U_R + NB * 8;
                for (int u = bx; u < U_R; u += G) rwkv_unit(C, layer, u, lds);
                for (int u = (bx + G - U_R % G) % G; u < NB * 8; u += G) ssd_unit(C, layer, u, lds);
                { const int first = U_S % G, span = G - first;
                  if (bx >= first) for (int u = bx - first; u < NB * 32; u += span) s5_unit(C, layer, u, lds); }
                for (;;) {
                    const int t2 = fresh_tid();
                    volatile unsigned* qs2 = (volatile unsigned*)(lds + LDS_CTL_OFF + 32);
                    __syncthreads();
                    if (t2 == 0) *qs2 = atomicAdd((unsigned*)(Ck->ws + WS_QCTR) + ((layer * NGRP + grp) * 2) * 64, 1u);
                    __syncthreads();
                    const int u = (int)*qs2;
                    if (u >= NB * NK64) break;
                    dsa_attn_unit3(KLAUNDER(Ck), u, t2, lds);
                }
            }
            SEAM;
#undef SEGID
#define SEGID (layer * (1 + NGRP * SEGS_PER_GROUP) + 1 + grp * SEGS_PER_GROUP + 5)
            if (RUN) { PHASE_VARS;
                { pg8::Gemm g{WSP(const bf16, WS_H), WSP(const bf16, WS_WIN + WO) + (size_t)NMIXC * D, MG, 4096, D}; pg8::StaticOrder S; S.init(MG, 4096, G, bx);
                  pg8::EpiGate E{WSP(bf16, WS_G)}; pg8::gemm_phase<pg8::EpiGate, pg8::StaticOrder, false, GP_ALIGN, GP_SP2>(LDS_PTR(lds), g, S, E, nullptr); }
                { pg8::Gemm g{WSP(const bf16, WS_YD0), WSP(const bf16, WS_GLU + WO), MG, 512, 512}; pg8::StaticOrder S; S.init(MG, 512, G, bx);
                  pg8::EpiGlu E{WSP(const bf16, WS_YD0), WSP(bf16, WS_Y) + (size_t)3 * MG * 512, C->in[I_GLUB] + layer * 512};
                  pg8::gemm_phase<pg8::EpiGlu, pg8::StaticOrder, false, GP_ALIGN, GP_SP2>(LDS_PTR(lds), g, S, E, nullptr); }
                for (int it = gw; it < MG * 2; it += 4 * ngw) ssd_norm_item4(C, layer, it, ngw, MG * 2, lane);
            }
            SEAM;
#undef SEGID
#define SEGID (layer * (1 + NGRP * SEGS_PER_GROUP) + 1 + grp * SEGS_PER_GROUP + 6)
            if (RUN) { PHASE_VARS; pg8::Gemm g{WSP(const bf16, WS_Y), WSP(const bf16, WS_WB + WO), 4 * MG, 4096, 512}; pg8::MergeOrder S{G, bx};
                pg8::EpiMerge E{WSP(const bf16, WS_G), WSP(bf16, WS_MRG)};
                pg8::gemm_phase<pg8::EpiMerge, pg8::MergeOrder, false, GP_ALIGN, GP_SP2>(LDS_PTR(lds), g, S, E, nullptr); }
            SEAM;
#undef SEGID
#define SEGID (layer * (1 + NGRP * SEGS_PER_GROUP) + 1 + grp * SEGS_PER_GROUP + 7)
            if (RUN) { PHASE_VARS; pg8::Gemm g{WSP(const bf16, WS_MRG), WSP(const bf16, WS_WOUT + WO), MG, D, D}; pg8::StaticOrder S; S.init(MG, D, G, bx);
                pg8::EpiResid E{XIN, XOUT}; pg8::gemm_phase<pg8::EpiResid, pg8::StaticOrder, false, GP_ALIGN, GP_SP2>(LDS_PTR(lds), g, S, E, nullptr); }
            SEAM;
#undef SEGID
#define SEGID (layer * (1 + NGRP * SEGS_PER_GROUP) + 1 + grp * SEGS_PER_GROUP + 8)
            if (RUN) { PHASE_VARS; for (int m = gw; m < MG; m += 2 * ngw) { if (m + ngw < MG) rms_rowN_bf16<2>(XOUT + (size_t)m * D, C->in[I_NFFN] + layer * D, WSP(bf16, WS_H) + (size_t)m * D, (size_t)ngw * D, lane); else rms_row_bf16(XOUT + (size_t)m * D, C->in[I_NFFN] + layer * D, WSP(bf16, WS_H) + (size_t)m * D, lane); } }
            SEAM;
#undef SEGID
#define SEGID (layer * (1 + NGRP * SEGS_PER_GROUP) + 1 + grp * SEGS_PER_GROUP + 9)
            if (RUN) { PHASE_VARS; pg8::Gemm g{WSP(const bf16, WS_H), WSP(const bf16, WS_W13 + WO), MG, 5632, D}; pg8::StaticOrder S; S.init(MG, 5632, G, bx);
                pg8::EpiSwiglu E{WSP(bf16, WS_HID)};
                pg8::gemm_phase<pg8::EpiSwiglu, pg8::StaticOrder, false, GP_ALIGN, GP_SP2>(LDS_PTR(lds), g, S, E, nullptr); }
            SEAM;
#undef SEGID
#define SEGID (layer * (1 + NGRP * SEGS_PER_GROUP) + 1 + grp * SEGS_PER_GROUP + 10)
            if (RUN) { PHASE_VARS; pg8::Gemm g{WSP(const bf16, WS_HID), WSP(const bf16, WS_W2 + WO), MG, D, FFN}; pg8::StaticOrder S; S.init(MG, D, G, bx);
                pg8::EpiResid E{XOUT, XOUT}; pg8::gemm_phase<pg8::EpiResid, pg8::StaticOrder, false, GP_ALIGN, GP_SP2>(LDS_PTR(lds), g, S, E, nullptr); }
            SEAM;
        }
    }
#undef SEGID
#define SEGID (NSEG - 1)
    { const int layer = 0; (void)layer;
    if (RUN) { PHASE_VARS; for (int m = gw; m < M; m += 2 * ngw) { if (m + ngw < M) rms_row2_f32(C->out + (size_t)m * D, (size_t)ngw * D, C->in[I_NFIN], lane); else rms_row_f32(C->out + (size_t)m * D, C->in[I_NFIN], lane); } } }
#undef RUN
#undef SEAM
}

extern "C" void kernel_launch(void* const* d_in, const int* in_sizes, int n_in, void* d_out, int out_size, void* d_ws, size_t ws_size, hipStream_t stream) {
    static int grid = 0;
    if (grid == 0) {
        if (n_in != N_IN || out_size != M * D || ws_size < WS_END) { fprintf(stderr, "kernel_launch: unexpected shapes (n_in %d, out %d, ws %zu < %zu)\n", n_in, out_size, ws_size, (size_t)WS_END); grid = -1; return; }
        int dev = 0, cus = 0;
        if (hipGetDevice(&dev) != hipSuccess || hipDeviceGetAttribute(&cus, hipDeviceAttributeMultiprocessorCount, dev) != hipSuccess || cus < 1) { grid = -1; return; }
        if (hipFuncSetAttribute((const void*)fwd_kernel, hipFuncAttributeMaxDynamicSharedMemorySize, LDS_BYTES) != hipSuccess) { fprintf(stderr, "kernel_launch: hipFuncSetAttribute failed\n"); grid = -1; return; }
        (void)hipGetLastError();
        grid = cus;
    }
    if (grid < 0) return;
    (void)hipMemsetAsync((char*)d_ws + WS_CTL, 0, CTL_BYTES, stream);
    Args a{};
    for (int i = 0; i < N_IN; ++i) a.in[i] = (const float*)d_in[i];
    a.out = (float*)d_out; a.ws = (unsigned char*)d_ws;
#if CFG_LAUNCHES == 1
    a.seg_lo = 0; a.seg_hi = NSEG;
    hipLaunchKernelGGL(fwd_kernel, dim3(grid), dim3(NTHREADS), LDS_BYTES, stream, a);
#else
    for (int s = 0; s < NSEG; ++s) { a.seg_lo = s; a.seg_hi = s + 1; hipLaunchKernelGGL(fwd_kernel, dim3(grid), dim3(NTHREADS), LDS_BYTES, stream, a); }
#endif
}
```

```cpp
#ifdef HOST_EMU
#error "HOST_EMU is a host-only debug build"
#else
#include <hip/hip_runtime.h>
#endif
#include <cstdio>
#include <cstdint>
#include <cmath>

#ifndef CFG_BATCH
#define CFG_BATCH 16
#endif
#ifndef CFG_SEQ
#define CFG_SEQ 4096
#endif
#ifndef CFG_DEPTH
#define CFG_DEPTH 4
#endif
#ifndef CFG_NB
#define CFG_NB 8
#endif
#ifndef CFG_LAUNCHES
#define CFG_LAUNCHES 1
#endif

typedef unsigned short bf16;
typedef float f32x4 __attribute__((ext_vector_type(4)));
typedef float f32x2 __attribute__((ext_vector_type(2)));
typedef unsigned u32x4 __attribute__((ext_vector_type(4)));
typedef unsigned u32x2 __attribute__((ext_vector_type(2)));

constexpr int BATCH = CFG_BATCH, SEQ = CFG_SEQ, DEPTH = CFG_DEPTH, NB = CFG_NB;
constexpr int D = 1024, M = BATCH * SEQ, MG = NB * SEQ, NGRP = BATCH / NB;
constexpr int IN_COLS = 9388, NPROJ = 9472, NMIXC = 5376, FFN = 2816;
constexpr int TOPK = (SEQ / 4) < 256 ? (SEQ / 4) : 256;
constexpr int NK64 = SEQ / 64, MW = SEQ / 32;
constexpr float RMS_EPS = 1e-6f, GN_EPS = 64e-5f;
static_assert(BATCH % NB == 0 && MG % 256 == 0 && SEQ % 64 == 0, "shape");

enum { I_X = 0, I_RELB, I_NMIX, I_WIN, I_CONVW, I_CONVB, I_DTB, I_ALOG, I_SSDD, I_SSDNG, I_MU, I_W0, I_W2, I_A0, I_A2, I_G2, I_KK, I_KA, I_RK, I_LNG, I_LNB,
       I_S5ARE, I_S5AIM, I_S5BRE, I_S5BIM, I_S5CRE, I_S5CIM, I_S5D, I_S5LDT, I_GLUW, I_GLUB, I_WBR, I_WOUT, I_NFFN, I_W1, I_W3, I_W2F, I_NFIN, N_IN };

constexpr size_t MiB = 1u << 20;
constexpr size_t al256(size_t x) { return (x + 255) & ~(size_t)255; }
constexpr size_t WS_CTL = 0, CTL_BYTES = 64 * 1024;
constexpr size_t WS_TAB = WS_CTL + CTL_BYTES;
constexpr size_t WS_ABAR = al256(WS_TAB + (SEQ + 64) * 4);
constexpr size_t WS_BBAR = WS_ABAR + 32 * 64 * 2 * 4;
constexpr size_t WS_WIN = al256(WS_BBAR + 32 * 64 * 16 * 2 * 4);
constexpr size_t WS_WB = WS_WIN + (size_t)NPROJ * 1024 * 2;
constexpr size_t WS_WOUT = WS_WB + (size_t)4 * 1024 * 512 * 2;
constexpr size_t WS_W13 = WS_WOUT + (size_t)1024 * 1024 * 2;
constexpr size_t WS_W2 = WS_W13 + (size_t)5632 * 1024 * 2;
constexpr size_t WS_GLU = WS_W2 + (size_t)1024 * 2816 * 2;
constexpr size_t WS_WLORA = WS_GLU + (size_t)512 * 512 * 2;
constexpr size_t WS_H = al256(WS_WLORA + (size_t)1536 * 256 * 2);
constexpr size_t WS_Z = WS_H + (size_t)MG * 1024 * 2;
constexpr size_t WS_XBC = WS_Z + (size_t)MG * 512 * 2;
constexpr size_t WS_Q = WS_XBC + (size_t)MG * 768 * 2;
constexpr size_t WS_K = WS_Q + (size_t)MG * 512 * 2;
constexpr size_t WS_V = WS_K + (size_t)MG * 512 * 2;
constexpr size_t WS_RW = WS_V + (size_t)MG * 512 * 2;
constexpr size_t WS_U = WS_RW + (size_t)MG * 1792 * 2;
constexpr size_t WS_SM = WS_U + (size_t)MG * 512 * 2;
constexpr size_t WS_G = WS_Q;
constexpr size_t WS_Y = WS_SM + (size_t)MG * 256 * 2;
constexpr size_t WS_YD0 = WS_Y + (size_t)4 * MG * 512 * 2;
constexpr size_t WS_MRG = WS_YD0 + (size_t)MG * 512 * 2;
constexpr size_t WS_MASK = WS_MRG + (size_t)MG * 1024 * 2;
constexpr size_t WS_RA = WS_MASK + (size_t)MG * MW * 4;
constexpr size_t WS_WLOG = WS_RA + (size_t)MG * 256 * 2;
constexpr size_t WS_ASIG = WS_WLOG + (size_t)MG * 512 * 4;
constexpr size_t WS_GG = WS_ASIG + (size_t)MG * 512 * 2;
constexpr size_t WS_XBA = WS_GG + (size_t)MG * 512 * 2;
constexpr size_t WS_VT = WS_XBA + (size_t)MG * 768 * 2;
constexpr size_t WS_KI = WS_VT + (size_t)MG * 512 * 2;
constexpr size_t WS_QCTR = 16384;
constexpr size_t WS_HID = WS_G;
constexpr size_t WS_WALT = al256(WS_KI + (size_t)MG * 32 * 2);
constexpr size_t WDELTA = WS_WALT - WS_ABAR;
constexpr size_t WS_END = WS_WALT + (WS_H - WS_ABAR);
static_assert(WS_SM + (size_t)MG * 256 * 2 - WS_Q == (size_t)MG * 4096 * 2, "G overlays exactly Q..SM");
static_assert((size_t)MG * 2816 * 2 <= (size_t)MG * 4096 * 2, "HID fits in G");

constexpr int LDS_SCRATCH = 131072;
constexpr int LDS_CTL_OFF = LDS_SCRATCH;
constexpr int LDS_X = LDS_SCRATCH + 64;
constexpr int LDS_BYTES = 161792;
constexpr int NTHREADS = 512, NWAVES = 8;

__device__ __forceinline__ float bf2f(bf16 v) { return __uint_as_float(((unsigned)v) << 16); }
#ifdef HOST_EMU
__device__ __forceinline__ bf16 f2bf(float f) { unsigned u = __float_as_uint(f); u += 0x7fffu + ((u >> 16) & 1u); return (bf16)(u >> 16); }
#else
__device__ __forceinline__ bf16 f2bf(float f) { return __builtin_bit_cast(bf16, (__bf16)f); }
#endif
#ifdef HOST_EMU
__device__ __forceinline__ unsigned pk2(float lo, float hi) { return (unsigned)f2bf(lo) | ((unsigned)f2bf(hi) << 16); }
#else
typedef __bf16 bf16x2_hw __attribute__((ext_vector_type(2)));
__device__ __forceinline__ unsigned pk2(float lo, float hi) { const f32x2 v = {lo, hi}; return __builtin_bit_cast(unsigned, __builtin_convertvector(v, bf16x2_hw)); }
#endif
__device__ __forceinline__ float lo_bf(unsigned w) { return __uint_as_float(w << 16); }
__device__ __forceinline__ float hi_bf(unsigned w) { return __uint_as_float(w & 0xffff0000u); }
#ifndef HOST_EMU
__device__ __forceinline__ float sigm(float x) { return __builtin_amdgcn_rcpf(1.0f + __expf(-x)); }
#else
__device__ __forceinline__ float sigm(float x) { return 1.0f / (1.0f + __expf(-x)); }
#endif
#ifndef HOST_EMU
template <int BIT> __device__ __forceinline__ unsigned bit_fill(unsigned w) { unsigned r; asm("v_bfe_i32 %0, %1, %2, 1" : "=v"(r) : "v"(w), "n"(BIT)); return r; }
#else
template <int BIT> __device__ __forceinline__ unsigned bit_fill(unsigned w) { return ((w >> BIT) & 1u) ? 0xffffffffu : 0u; }
#endif
__device__ __forceinline__ int imax0(int v) { return v < 0 ? 0 : v; }
__device__ __forceinline__ float tanh_fast(float x) { return 2.0f * sigm(2.0f * x) - 1.0f; }
__device__ __forceinline__ float softplusf(float x) { return x > 20.f ? x : log1pf(__expf(x)); }
__device__ __forceinline__ float gelu_tanh(float x) { const float u = 0.7978845608f * (x + 0.044715f * x * x * x); return x * sigm(2.0f * u); }
__device__ __forceinline__ float wave_sum(float v) {
#pragma unroll
    for (int o = 1; o < 64; o <<= 1) v += __shfl_xor(v, o);
    return v;
}
__device__ __forceinline__ float wave_max(float v) {
#pragma unroll
    for (int o = 1; o < 64; o <<= 1) v = fmaxf(v, __shfl_xor(v, o));
    return v;
}
__device__ __forceinline__ int wave_sum_i(int v) {
#pragma unroll
    for (int o = 1; o < 64; o <<= 1) v += __shfl_xor(v, o);
    return v;
}
#ifdef HOST_EMU
#define WAVE_SYNC() (void)emu_wave_exchange(0)
#define SCHED_FENCE() do {} while (0)
#define LDS_SYNC() __syncthreads()
#else
#define WAVE_SYNC() __builtin_amdgcn_wave_barrier()
#define SCHED_FENCE() __builtin_amdgcn_sched_barrier(0)
#define LDS_SYNC() do { asm volatile("s_waitcnt lgkmcnt(0)" ::: "memory"); __builtin_amdgcn_s_barrier(); asm volatile("" ::: "memory"); } while (0)
#endif
#ifndef HOST_EMU
namespace pg8 {
__device__ __forceinline__ int pg8_fresh_tid() { int t = (int)threadIdx.x; asm volatile("" : "+v"(t)); return t; }
#define PG8_LAS __attribute__((address_space(3)))
typedef unsigned short bf16_t;
typedef short bf16x8 __attribute__((ext_vector_type(8)));
typedef float f32x4 __attribute__((ext_vector_type(4)));
typedef unsigned u32x4 __attribute__((ext_vector_type(4)));
constexpr int BM = 256, BK = 64, HALF = 128, HTB = HALF * BK * 2  , STAGE_BYTES = 8 * HTB, NXCD = 8, WGM = 8;

__host__ __device__ __forceinline__ int lds_byte(int r, int c) { const int st = (r >> 4) * 2 + (c >> 5), rr = r & 15, cc = c & 31, ob = rr * 64 + cc * 2; return st * 1024 + (ob ^ (((ob >> 9) & 1) << 5)); }
__host__ __device__ __forceinline__ void stage_rc(int b, int& R, int& C) { const int st = b / 1024, sb = b % 1024, swz = sb ^ (((sb >> 9) & 1) << 5); R = (st >> 1) * 16 + swz / 64; C = (st & 1) * 32 + (swz % 64) / 2; }
__host__ __device__ __forceinline__ int perm32(int rho) { const int n = rho >> 4, i = rho & 15; return 8 * (i >> 2) + 4 * n + (i & 3); }

struct Unit { int pm, pn; };
struct Gemm { const bf16_t* A; const bf16_t* Bt; int M, N, K; };

struct StaticOrder {
    int nM, nN, nwg, G, c;
    __host__ __device__ void init(int M, int N, int G_, int c_) { nM = M / BM; nN = N / BM; nwg = nM * nN; G = G_; c = c_; }
    __host__ __device__ bool next(int i, Unit& u) const {
        const long L = (long)i * G + c; if (L >= nwg) return false;
        int wgid = (int)L; { const int q = nwg / NXCD, r = nwg % NXCD, xcd = wgid % NXCD, off = wgid / NXCD; wgid = (xcd < r ? xcd * (q + 1) : r * (q + 1) + (xcd - r) * q) + off; }
        const int nig = WGM * nN, gid = wgid / nig, fm = gid * WGM, gsz = (nM - fm) < WGM ? (nM - fm) : WGM;
        u.pm = fm + ((wgid % nig) % gsz); u.pn = (wgid % nig) / gsz; return true;
    }
    __device__ __forceinline__ void a_ready(const Unit&) const {}
    __device__ __forceinline__ void done(const Unit&) const {}
};

__device__ __forceinline__ unsigned cvt_pk_bf16(float lo, float hi) { return pk2(lo, hi); }

template <class E, class = void> struct epi_keep { static constexpr bool value = false; };
template <class E> struct epi_keep<E, decltype((void)E::KEEP_ACC)> { static constexpr bool value = true; };
template <class Epi, class Sched, bool STAMP = false, bool ALIGN_EPI = false, bool SP2 = false>
__device__ __forceinline__ void gemm_phase(PG8_LAS unsigned char* lds, const Gemm g, const Sched& S, const Epi& E, unsigned long long* stamps) {
    const int tid = pg8_fresh_tid(), wid = __builtin_amdgcn_readfirstlane(tid >> 6), lane = tid & 63, wr = wid >> 2, wc = wid & 3, fr = lane & 15, fq = lane >> 4;
    int K_ = g.K; asm volatile("" : "+s"(K_));
    const int K = K_, nt = K / BK;
    int ts_lo = 0, ts_hi = 0, nts = 0; const unsigned long long rt_entry = STAMP ? (unsigned long long)wall_clock64() : 0ull;
#define PG8_STAMP() do { if (STAMP && wid == 0 && nts < 64) { const unsigned long long _c = (unsigned long long)clock64(); \
        ts_lo = (lane == nts) ? (int)(unsigned)_c : ts_lo; ts_hi = (lane == nts) ? (int)(unsigned)(_c >> 32) : ts_hi; ++nts; } } while (0)
    PG8_STAMP();
    unsigned voffA[2], voffB[2];
#pragma unroll
    for (int i = 0; i < 2; ++i) { int R, C; stage_rc(tid * 16 + i * 8192, R, C); const int Rb = Epi::PERM ? ((R & ~31) + perm32(R & 31)) : R;
        voffA[i] = (unsigned)(R * K + C) * 2u; voffB[i] = (unsigned)(Rb * K + C) * 2u; }
    const size_t kstep = (size_t)(BK * 2);
    const size_t hstep = (size_t)HALF * K * 2;
    const size_t tstep = 2 * hstep;
    const unsigned ldsw = (unsigned)wid * 1024u;
    const int aoff = lds_byte(wr * 64 + fr, fq * 8), boff = lds_byte(wc * 32 + fr, fq * 8);
#define PG8_SA(b, h) (((b) * 2 + (h)) * HTB)
#define PG8_SB(b, h) ((4 + (b) * 2 + (h)) * HTB)
#define PG8_STAGE(bufoff, gbase, voff) do { _Pragma("unroll") for (int _i = 0; _i < 2; ++_i) \
        __builtin_amdgcn_global_load_lds((const unsigned*)((const char*)(gbase) + (voff)[_i]), (PG8_LAS unsigned*)(lds + (bufoff) + ldsw + _i * 8192), 16, 0, 0); } while (0)
#define PG8_LDA(dst, b, h) do { _Pragma("unroll") for (int m = 0; m < 4; ++m) _Pragma("unroll") for (int k = 0; k < 2; ++k) dst[m][k] = *(const PG8_LAS bf16x8*)(lds + PG8_SA(b, h) + aoff + m * 2048 + k * 1024); } while (0)
#define PG8_LDB(dst, b, h) do { _Pragma("unroll") for (int n = 0; n < 2; ++n) _Pragma("unroll") for (int k = 0; k < 2; ++k) dst[n][k] = *(const PG8_LAS bf16x8*)(lds + PG8_SB(b, h) + boff + n * 2048 + k * 1024); } while (0)
#define PG8_MMA(ai, bj, At, Bt) do { __builtin_amdgcn_s_setprio(1); _Pragma("unroll") for (int m = 0; m < 4; ++m) _Pragma("unroll") for (int n = 0; n < 2; ++n) _Pragma("unroll") for (int k = 0; k < 2; ++k) \
        acc[ai][bj][m][n] = __builtin_amdgcn_mfma_f32_16x16x32_bf16(Bt[n][k], At[m][k], acc[ai][bj][m][n], 0, 0, 0); __builtin_amdgcn_s_setprio(0); } while (0)
#define PG8_WAIT_V(n) asm volatile("s_waitcnt vmcnt(" #n ")" ::: "memory")
#define PG8_WAIT_L(n) asm volatile("s_waitcnt lgkmcnt(" #n ")" ::: "memory")
#define PG8_BAR __builtin_amdgcn_s_barrier()
#define PG8_SCHED __builtin_amdgcn_sched_barrier(0)
    Unit cur, nxt; int ui = 0;
    if (!S.next(0, cur)) return;
    f32x4 acc[2][2][4][2];
#pragma unroll
    for (int a = 0; a < 2; ++a)
#pragma unroll
        for (int b = 0; b < 2; ++b)
#pragma unroll
            for (int m = 0; m < 4; ++m)
#pragma unroll
                for (int n = 0; n < 2; ++n) acc[a][b][m][n] = (f32x4){0.f, 0.f, 0.f, 0.f};
    bf16x8 At[4][2], B0[2][2], B1[2][2];
    const char* cA = (const char*)g.A + (size_t)cur.pm * tstep; const char* cB = (const char*)g.Bt + (size_t)cur.pn * tstep;
    S.a_ready(cur);
    if constexpr (SP2) {
        PG8_STAGE(PG8_SB(0, 0), cB, voffB); PG8_STAGE(PG8_SB(0, 1), cB + hstep, voffB); PG8_STAGE(PG8_SA(0, 0), cA, voffA); PG8_STAGE(PG8_SA(0, 1), cA + hstep, voffA);
        if (wr == 1) PG8_BAR;
        PG8_WAIT_V(2); PG8_BAR;
        PG8_STAGE(PG8_SB(1, 0), cB + kstep, voffB); PG8_STAGE(PG8_SA(1, 0), cA + kstep, voffA); PG8_STAGE(PG8_SB(1, 1), cB + hstep + kstep, voffB);
        PG8_WAIT_V(6); PG8_BAR;
    } else {
    PG8_STAGE(PG8_SB(0, 0), cB, voffB); PG8_STAGE(PG8_SA(0, 0), cA, voffA); PG8_STAGE(PG8_SB(0, 1), cB + hstep, voffB); PG8_STAGE(PG8_SA(0, 1), cA + hstep, voffA);
    if (wr == 1) PG8_BAR;
    PG8_WAIT_V(4); PG8_BAR;
    PG8_STAGE(PG8_SB(1, 0), cB + kstep, voffB); PG8_STAGE(PG8_SA(1, 0), cA + kstep, voffA); PG8_STAGE(PG8_SB(1, 1), cB + hstep + kstep, voffB);
    PG8_WAIT_V(6); PG8_BAR;
    }
    PG8_STAMP();
    for (;;) {
        const bool has_next = S.next(ui + 1, nxt);
        const char* nA = has_next ? (const char*)g.A + (size_t)nxt.pm * tstep : cA; const char* nB = has_next ? (const char*)g.Bt + (size_t)nxt.pn * tstep : cB;
        for (int t = 0; t < nt; t += 2) {
            const bool last = (t == nt - 2);
            const char* a1 = cA + (size_t)(t + 1) * kstep;
            const char* a2 = last ? nA : cA + (size_t)(t + 2) * kstep; const char* b2 = last ? nB : cB + (size_t)(t + 2) * kstep;
            const char* a3 = a2 + kstep; const char* b3 = b2 + kstep;
            if (last && has_next) S.a_ready(nxt);
            if constexpr (SP2) {
            PG8_LDB(B0, 0, 0); PG8_LDB(B1, 0, 1); PG8_SCHED; PG8_LDA(At, 0, 0); PG8_STAGE(PG8_SA(1, 1), a1 + hstep, voffA);
            PG8_WAIT_V(8); PG8_WAIT_L(0); PG8_BAR; PG8_MMA(0, 0, At, B0); PG8_MMA(0, 1, At, B1); PG8_BAR; PG8_SCHED;
            PG8_LDA(At, 0, 1); PG8_STAGE(PG8_SB(0, 0), b2, voffB); PG8_STAGE(PG8_SB(0, 1), b2 + hstep, voffB); PG8_STAGE(PG8_SA(0, 0), a2, voffA);
            PG8_WAIT_V(8); PG8_WAIT_L(0); PG8_BAR; PG8_MMA(1, 0, At, B0); PG8_MMA(1, 1, At, B1); PG8_BAR; PG8_SCHED;
            PG8_LDB(B0, 1, 0); PG8_LDB(B1, 1, 1); PG8_SCHED; PG8_LDA(At, 1, 0); PG8_STAGE(PG8_SA(0, 1), a2 + hstep, voffA);
            PG8_WAIT_V(8); PG8_WAIT_L(0); PG8_BAR; PG8_MMA(0, 0, At, B0); PG8_MMA(0, 1, At, B1); PG8_BAR; PG8_SCHED;
            PG8_LDA(At, 1, 1); PG8_STAGE(PG8_SB(1, 0), b3, voffB); PG8_STAGE(PG8_SB(1, 1), b3 + hstep, voffB); PG8_STAGE(PG8_SA(1, 0), a3, voffA);
            PG8_WAIT_V(8); PG8_WAIT_L(0); PG8_BAR; PG8_MMA(1, 0, At, B0); PG8_MMA(1, 1, At, B1); PG8_BAR; PG8_SCHED;
            } else {
            PG8_LDB(B0, 0, 0); PG8_SCHED; PG8_LDA(At, 0, 0); PG8_STAGE(PG8_SA(1, 1), a1 + hstep, voffA);
            PG8_WAIT_L(8); PG8_BAR; PG8_WAIT_L(0); PG8_MMA(0, 0, At, B0); PG8_BAR; PG8_SCHED;
            PG8_LDB(B1, 0, 1); PG8_STAGE(PG8_SB(0, 0), b2, voffB);
            PG8_BAR; PG8_WAIT_L(0); PG8_MMA(0, 1, At, B1); PG8_BAR;
            PG8_LDA(At, 0, 1); PG8_STAGE(PG8_SA(0, 0), a2, voffA);
            PG8_BAR; PG8_WAIT_L(0); PG8_MMA(1, 0, At, B0); PG8_BAR; PG8_SCHED;
            PG8_STAGE(PG8_SB(0, 1), b2 + hstep, voffB);
            PG8_WAIT_V(6); PG8_BAR; PG8_MMA(1, 1, At, B1); PG8_BAR;
            PG8_LDB(B0, 1, 0); PG8_SCHED; PG8_LDA(At, 1, 0); PG8_STAGE(PG8_SA(0, 1), a2 + hstep, voffA);
            PG8_WAIT_L(8); PG8_BAR; PG8_WAIT_L(0); PG8_MMA(0, 0, At, B0); PG8_BAR; PG8_SCHED;
            PG8_LDB(B1, 1, 1); PG8_STAGE(PG8_SB(1, 0), b3, voffB);
            PG8_BAR; PG8_WAIT_L(0); PG8_MMA(0, 1, At, B1); PG8_BAR;
            PG8_LDA(At, 1, 1); PG8_STAGE(PG8_SA(1, 0), a3, voffA);
            PG8_BAR; PG8_WAIT_L(0); PG8_MMA(1, 0, At, B0); PG8_BAR; PG8_SCHED;
            PG8_STAGE(PG8_SB(1, 1), b3 + hstep, voffB);
            PG8_WAIT_V(6); PG8_BAR; PG8_MMA(1, 1, At, B1); PG8_BAR;
            }
        }
        PG8_STAMP();
        if constexpr (ALIGN_EPI) { if (wr == 0) PG8_BAR; }
        if constexpr (!Epi::AFTER_DRAIN) { E(acc, cur, wr, wc, fr, fq); S.done(cur); }
        PG8_STAMP();
        if (!has_next) break;
        bool zero_acc = true; if constexpr (epi_keep<Epi>::value) zero_acc = !E.keep(cur);
        if (zero_acc) { const bf16x8 z8 = {0, 0, 0, 0, 0, 0, 0, 0};
#pragma unroll
        for (int a = 0; a < 2; ++a)
#pragma unroll
            for (int b = 0; b < 2; ++b)
#pragma unroll
                for (int m = 0; m < 4; ++m)
#pragma unroll
                    for (int n = 0; n < 2; ++n) acc[a][b][m][n] = __builtin_amdgcn_mfma_f32_16x16x32_bf16(z8, z8, (f32x4){0.f, 0.f, 0.f, 0.f}, 0, 0, 0); }
        cur = nxt; cA = nA; cB = nB; ++ui;
        if constexpr (ALIGN_EPI) { if (wr == 1) PG8_BAR; }
    }
    PG8_WAIT_V(0);
    if constexpr (!ALIGN_EPI) { if (wr == 0) PG8_BAR; }
    PG8_BAR;
    if constexpr (Epi::AFTER_DRAIN) { E.fused(acc, cur, wr, wc, fr, fq, lds, wid, lane); S.done(cur); }
    PG8_STAMP();
    if (STAMP && wid == 0) { stamps[lane] = lane < nts ? (((unsigned long long)(unsigned)ts_hi << 32) | (unsigned)ts_lo) : 0ull;
        if (lane == 62) stamps[62] = rt_entry; if (lane == 63) stamps[63] = (unsigned long long)wall_clock64(); }
#undef PG8_STAMP
#undef PG8_SA
#undef PG8_SB
#undef PG8_STAGE
#undef PG8_LDA
#undef PG8_LDB
#undef PG8_MMA
#undef PG8_WAIT_V
#undef PG8_WAIT_L
#undef PG8_BAR
#undef PG8_SCHED
}
}

#define XB_TMO      128
#define XB_XCNT(j)  (256  + 64 * (j))
#define XB_XSUB(j)  (1280 + 64 * (j))
#define XB_XGEN(j)  (2304 + 64 * (j))
#define XB_TOP      3328
#define XB_TOPGEN   3392
#define XCD_BAR_WORDS 3456
#define XB_SPIN_CAP (1u << 18)
#define LAS __attribute__((address_space(3)))

__device__ __forceinline__ unsigned xb_ld(unsigned* p)              { return __hip_atomic_load(p, __ATOMIC_RELAXED, __HIP_MEMORY_SCOPE_AGENT); }
__device__ __forceinline__ unsigned xb_add(unsigned* p, unsigned v) { return __hip_atomic_fetch_add(p, v, __ATOMIC_RELAXED, __HIP_MEMORY_SCOPE_AGENT); }
__device__ __forceinline__ unsigned xb_xcc_id() { return (unsigned)__builtin_amdgcn_s_getreg((3 << 11) | 20) & 0xFu; }
#define XB_SPIN(cond, bar) do { unsigned _sp = 0; while (cond) { __builtin_amdgcn_s_sleep(1); \
    if ((++_sp & 255u) == 0u) { if (xb_ld(&(bar)[XB_TMO])) break; if (_sp > XB_SPIN_CAP) { atomicAdd(&(bar)[XB_TMO], 1u); break; } } } } while (0)

struct XcdBarrier {
    unsigned* bar; unsigned x;
    volatile LAS unsigned* st;
};

__device__ __forceinline__ XcdBarrier xcd_barrier_post(unsigned* bar, volatile LAS unsigned* st) {
    XcdBarrier b; b.bar = bar; b.x = xb_xcc_id(); b.st = st;
    if (threadIdx.x == 0) (void)xb_add(&bar[XB_XCNT(b.x)], 1u);
    return b;
}
__device__ __forceinline__ void xcd_barrier_complete(unsigned* bar, unsigned x, unsigned& nloc, unsigned& nx) {
    const unsigned G = gridDim.x * gridDim.y * gridDim.z;
    unsigned sum, cnt, mine, sp = 0u;
    for (;;) {
        sum = 0u; cnt = 0u; mine = 0u;
#pragma unroll
        for (unsigned j = 0; j < 16; ++j) { const unsigned c = xb_ld(&bar[XB_XCNT(j)]); sum += c; cnt += (c > 0u) ? 1u : 0u; mine = (j == x) ? c : mine; }
        if (sum == G) break;
        __builtin_amdgcn_s_sleep(1);
        if ((++sp & 255u) == 0u) { if (xb_ld(&bar[XB_TMO])) break; if (sp > XB_SPIN_CAP) { atomicAdd(&bar[XB_TMO], 1u); break; } }
    }
    nloc = mine > 0u ? mine : 1u; nx = cnt > 0u ? cnt : 1u;
}

__device__ __forceinline__ void xcd_barrier(const XcdBarrier& b) {
    asm volatile("s_waitcnt vmcnt(0)" ::: "memory");
    __syncthreads();
    if (threadIdx.x == 0) {
        unsigned* bar = b.bar;
        __builtin_amdgcn_s_waitcnt(0);
        unsigned nloc = b.st[0], nx = b.st[1];
        if (nloc == 0u) { xcd_barrier_complete(bar, b.x, nloc, nx); b.st[0] = nloc; b.st[1] = nx; }
        const unsigned old = xb_add(&bar[XB_XSUB(b.x)], 1u);
        const unsigned gen = old / nloc;
        if (old + 1u == (gen + 1u) * nloc) {
            __builtin_amdgcn_fence(__ATOMIC_RELEASE, "agent");
            asm volatile("s_waitcnt vmcnt(0)" ::: "memory");
            const unsigned og = xb_add(&bar[XB_TOP], 1u);
            const unsigned tg = og / nx;
            if (og + 1u == (tg + 1u) * nx) xb_add(&bar[XB_TOPGEN], 1u);
            else XB_SPIN(xb_ld(&bar[XB_TOPGEN]) == tg, bar);
            __builtin_amdgcn_fence(__ATOMIC_ACQUIRE, "agent");
            xb_add(&bar[XB_XGEN(b.x)], 1u);
            asm volatile("s_waitcnt vmcnt(0)" ::: "memory");
        } else {
            XB_SPIN(xb_ld(&bar[XB_XGEN(b.x)]) == gen, bar);
            __builtin_amdgcn_fence(__ATOMIC_ACQUIRE, "agent");
            asm volatile("s_waitcnt vmcnt(0)" ::: "memory");
        }
    }
    __syncthreads();
}

#else
namespace pg8 {
typedef unsigned short bf16_t;
typedef float f32x4 __attribute__((ext_vector_type(4)));
typedef unsigned u32x4 __attribute__((ext_vector_type(4)));
constexpr int BM = 256, BK = 64, HALF = 128, NXCD = 8, WGM = 8;
struct Unit { int pm, pn; };
struct Gemm { const bf16_t* A; const bf16_t* Bt; int M, N, K; };
template <class E, class = void> struct epi_keep { static constexpr bool value = false; };
template <class E> struct epi_keep<E, decltype((void)E::KEEP_ACC)> { static constexpr bool value = true; };
struct StaticOrder {
    int nM, nN, nwg, G, c;
    void init(int M, int N, int G_, int c_) { nM = M / BM; nN = N / BM; nwg = nM * nN; G = G_; c = c_; }
    bool next(int i, Unit& u) const {
        const long L = (long)i * G + c; if (L >= nwg) return false;
        int wgid = (int)L; { const int q = nwg / NXCD, r = nwg % NXCD, xcd = wgid % NXCD, off = wgid / NXCD; wgid = (xcd < r ? xcd * (q + 1) : r * (q + 1) + (xcd - r) * q) + off; }
        const int nig = WGM * nN, gid = wgid / nig, fm = gid * WGM, gsz = (nM - fm) < WGM ? (nM - fm) : WGM;
        u.pm = fm + ((wgid % nig) % gsz); u.pn = (wgid % nig) / gsz; return true;
    }
    void a_ready(const Unit&) const {}
    void done(const Unit&) const {}
};
static inline unsigned cvt_pk_bf16(float lo, float hi) { return pk2(lo, hi); }
static float* emu_tile_buf(int b) { static std::vector<std::vector<float>> t; if ((int)t.size() <= b) t.resize(b + 1); if (t[b].empty()) t[b].resize(256 * 256); return t[b].data(); }
template <class Epi, class Sched, bool STAMP = false, bool ALIGN_EPI = false, bool SP2 = false, bool ZPEEL = false>
void gemm_phase(unsigned char* lds, const Gemm g, const Sched& S, const Epi& E, unsigned long long* stamps) {
    const int tid = threadIdx.x, wid = tid >> 6, lane = tid & 63, wr = wid >> 2, wc = wid & 3, fr = lane & 15, fq = lane >> 4;
    float* tile = emu_tile_buf(blockIdx.x);
    Unit u; f32x4 acc[2][2][4][2]; bool keep_next = false;
    for (int ui = 0; S.next(ui, u); ++ui) {
        __syncthreads();
        if (tid == 0) {
            std::vector<float> a((size_t)256 * g.K), b((size_t)256 * g.K);
            for (int r = 0; r < 256; ++r) for (int k = 0; k < g.K; ++k) { a[(size_t)r * g.K + k] = bf2f(g.A[((size_t)u.pm * 256 + r) * g.K + k]); b[(size_t)r * g.K + k] = bf2f(g.Bt[((size_t)u.pn * 256 + r) * g.K + k]); }
            for (int r = 0; r < 256; ++r) for (int c = 0; c < 256; ++c) { const float* ar = &a[(size_t)r * g.K]; const float* br = &b[(size_t)c * g.K]; float s = 0.f; for (int k = 0; k < g.K; ++k) s += ar[k] * br[k]; tile[r * 256 + c] = s; }
        }
        __syncthreads();
        if (!keep_next) for (int ai = 0; ai < 2; ++ai) for (int bj = 0; bj < 2; ++bj) for (int m = 0; m < 4; ++m) for (int n = 0; n < 2; ++n) acc[ai][bj][m][n] = (f32x4){0.f, 0.f, 0.f, 0.f};
        for (int ai = 0; ai < 2; ++ai) for (int bj = 0; bj < 2; ++bj) for (int m = 0; m < 4; ++m) for (int n = 0; n < 2; ++n) for (int j = 0; j < 4; ++j) {
            const int r = 128 * ai + 64 * wr + 16 * m + fr;
            const int c = Epi::PERM ? (128 * bj + 32 * wc + 8 * fq + 4 * n + j) : (128 * bj + 32 * wc + 16 * n + 4 * fq + j);
            acc[ai][bj][m][n][j] += tile[r * 256 + c];
        }
        E(acc, u, wr, wc, fr, fq); S.done(u);
        if constexpr (epi_keep<Epi>::value) keep_next = E.keep(u); else keep_next = false;
        __syncthreads();
    }
}
}
#endif
namespace pg8 {
#ifdef HOST_EMU
#define EPI_FENCE() do {} while (0)
#else
#define EPI_FENCE() asm volatile("" ::: "memory")
#endif
__device__ __forceinline__ u32x4 pack8(const f32x4 v0, const f32x4 v1) { u32x4 w; w.x = cvt_pk_bf16(v0[0], v0[1]); w.y = cvt_pk_bf16(v0[2], v0[3]); w.z = cvt_pk_bf16(v1[0], v1[1]); w.w = cvt_pk_bf16(v1[2], v1[3]); return w; }
__device__ __forceinline__ void unpack8(const u32x4 w, f32x4& v0, f32x4& v1) { v0 = (f32x4){lo_bf(w.x), hi_bf(w.x), lo_bf(w.y), hi_bf(w.y)}; v1 = (f32x4){lo_bf(w.z), hi_bf(w.z), lo_bf(w.w), hi_bf(w.w)}; }
__device__ __forceinline__ f32x4 sig4(const f32x4 v) { return (f32x4){sigm(v[0]), sigm(v[1]), sigm(v[2]), sigm(v[3])}; }
#ifndef HOST_EMU
__device__ __forceinline__ float gate_sig(float x) { return __builtin_amdgcn_rcpf(fminf(1.0f + __expf(-x), 1.0e6f)); }
#else
__device__ __forceinline__ float gate_sig(float x) { return fmaxf(sigm(x), 1.0e-6f); }
#endif
__device__ __forceinline__ f32x4 gsig4(const f32x4 v) { return (f32x4){gate_sig(v[0]), gate_sig(v[1]), gate_sig(v[2]), gate_sig(v[3])}; }

struct EpiProj {
    static constexpr bool PERM = true, AFTER_DRAIN = false;
    unsigned char* ws;
    __device__ __forceinline__ void operator()(const f32x4 (&acc)[2][2][4][2], const Unit& u, int wr, int wc, int fr, int fq) const {
        const int pn = u.pn; size_t off; int ld, c0;
        if (pn < 2) { off = WS_Z; ld = 512; c0 = pn * 256; }
        else if (pn < 5) { off = WS_XBC; ld = 768; c0 = (pn - 2) * 256; }
        else if (pn < 7) { off = WS_Q; ld = 512; c0 = (pn - 5) * 256; }
        else if (pn < 9) { off = WS_K; ld = 512; c0 = (pn - 7) * 256; }
        else if (pn < 11) { off = WS_V; ld = 512; c0 = (pn - 9) * 256; }
        else if (pn < 18) { off = WS_RW; ld = 1792; c0 = (pn - 11) * 256; }
        else if (pn < 20) { off = WS_U; ld = 512; c0 = (pn - 18) * 256; }
        else { off = WS_SM; ld = 256; c0 = 0; }
        bf16_t* dst = (bf16_t*)(ws + off);
        const int row0 = u.pm * BM + wr * 64 + fr, col0 = c0 + wc * 32 + 8 * fq;
        const int kic = HALF + wc * 32 + 8 * fq - 136;
        const bool ki = (pn == 20) && kic >= 0 && kic < 32;
#pragma unroll
        for (int ai = 0; ai < 2; ++ai)
#pragma unroll
            for (int m = 0; m < 4; ++m) { const size_t row = (size_t)(row0 + ai * HALF + m * 16); bf16_t* rowp = dst + row * ld + col0;
#pragma unroll
                for (int bj = 0; bj < 2; ++bj) { const u32x4 w = pack8(acc[ai][bj][m][0], acc[ai][bj][m][1]); *(u32x4*)(rowp + bj * HALF) = w;
                    if (bj == 1 && ki) *(u32x4*)((bf16_t*)(ws + WS_KI) + row * 32 + kic) = w; } }
    }
};
struct EpiGate {
    static constexpr bool PERM = true, AFTER_DRAIN = false;
    bf16_t* G;
    __device__ __forceinline__ void operator()(const f32x4 (&acc)[2][2][4][2], const Unit& u, int wr, int wc, int fr, int fq) const {
        const int row0 = u.pm * BM + wr * 64 + fr, col0 = u.pn * BM + wc * 32 + 8 * fq;
#pragma unroll
        for (int ai = 0; ai < 2; ++ai)
#pragma unroll
            for (int m = 0; m < 4; ++m) { bf16_t* rowp = G + (size_t)(row0 + ai * HALF + m * 16) * 4096 + col0;
#pragma unroll
                for (int bj = 0; bj < 2; ++bj) *(u32x4*)(rowp + bj * HALF) = pack8(gsig4(acc[ai][bj][m][0]), gsig4(acc[ai][bj][m][1])); }
    }
};
struct EpiMerge {
    static constexpr bool PERM = true, AFTER_DRAIN = false, KEEP_ACC = true;
    const bf16_t* G; bf16_t* MRG;
    __device__ __forceinline__ bool keep(const Unit& u) const { return (u.pn >> 2) < 3; }
    __device__ __forceinline__ void operator()(f32x4 (&acc)[2][2][4][2], const Unit& u, int wr, int wc, int fr, int fq) const {
        const int n = u.pn >> 2, pn = u.pn & 3, pm = u.pm - n * (MG / 256);
        const int row0 = pm * BM + wr * 64 + fr, col0 = pn * BM + wc * 32 + 8 * fq;
#pragma unroll
        for (int ai = 0; ai < 2; ++ai)
#pragma unroll
            for (int mp = 0; mp < 2; ++mp) { u32x4 ga[2][2], gb[2][2];
#pragma unroll
                for (int mm = 0; mm < 2; ++mm)
#pragma unroll
                    for (int bj = 0; bj < 2; ++bj) { const bf16_t* gp = G + (size_t)(row0 + ai * HALF + (2 * mp + mm) * 16) * 4096 + n * 1024 + col0 + bj * HALF; ga[mm][bj] = *(const u32x4*)gp; if (n < 3) gb[mm][bj] = *(const u32x4*)(gp + 1024); }
#pragma unroll
                for (int mm = 0; mm < 2; ++mm)
#pragma unroll
                    for (int bj = 0; bj < 2; ++bj) { const int m = 2 * mp + mm; f32x4 a0, a1; unpack8(ga[mm][bj], a0, a1);
                        if (n < 3) { f32x4 b0, b1; unpack8(gb[mm][bj], b0, b1);
#pragma unroll
                            for (int j = 0; j < 4; ++j) { acc[ai][bj][m][0][j] *= a0[j] * __builtin_amdgcn_rcpf(b0[j]); acc[ai][bj][m][1][j] *= a1[j] * __builtin_amdgcn_rcpf(b1[j]); } }
                        else
                            *(u32x4*)(MRG + (size_t)(row0 + ai * HALF + m * 16) * 1024 + col0 + bj * HALF) = pack8(acc[ai][bj][m][0] * a0, acc[ai][bj][m][1] * a1); }
                EPI_FENCE(); }
    }
};
struct MergeOrder {
    int G, c;
    __device__ __forceinline__ bool next(int i, Unit& u) const {
        const int tile = (i >> 2) * G + c, n = i & 3; if (tile >= (MG / 256) * 4) return false;
        u.pm = n * (MG / 256) + (tile >> 2); u.pn = n * 4 + (tile & 3); return true;
    }
    __device__ __forceinline__ void a_ready(const Unit&) const {}
    __device__ __forceinline__ void done(const Unit&) const {}
};
struct EpiResid {
    static constexpr bool PERM = false, AFTER_DRAIN = false;
    const float* base; float* out;
    __device__ __forceinline__ void operator()(const f32x4 (&acc)[2][2][4][2], const Unit& u, int wr, int wc, int fr, int fq) const {
        const int row0 = u.pm * BM + wr * 64 + fr, col0 = u.pn * BM + wc * 32 + 4 * fq;
#pragma unroll
        for (int ai = 0; ai < 2; ++ai) {
            f32x4 bv[4][2][2];
#pragma unroll
            for (int m = 0; m < 4; ++m)
#pragma unroll
                for (int bj = 0; bj < 2; ++bj)
#pragma unroll
                    for (int n = 0; n < 2; ++n) bv[m][bj][n] = *(const f32x4*)(base + (size_t)(row0 + ai * HALF + m * 16) * 1024 + col0 + bj * HALF + n * 16);
#pragma unroll
            for (int m = 0; m < 4; ++m)
#pragma unroll
                for (int bj = 0; bj < 2; ++bj)
#pragma unroll
                    for (int n = 0; n < 2; ++n) *(f32x4*)(out + (size_t)(row0 + ai * HALF + m * 16) * 1024 + col0 + bj * HALF + n * 16) = bv[m][bj][n] + acc[ai][bj][m][n];
            EPI_FENCE(); }
    }
};
struct EpiSwiglu {
    static constexpr bool PERM = true, AFTER_DRAIN = false;
    bf16_t* HID;
    __device__ __forceinline__ void operator()(const f32x4 (&acc)[2][2][4][2], const Unit& u, int wr, int wc, int fr, int fq) const {
        const int row0 = u.pm * BM + wr * 64 + fr, col0 = u.pn * HALF + wc * 32 + 8 * fq;
#pragma unroll
        for (int ai = 0; ai < 2; ++ai)
#pragma unroll
            for (int m = 0; m < 4; ++m) { f32x4 v[2];
#pragma unroll
                for (int n = 0; n < 2; ++n) { const f32x4 a = acc[ai][0][m][n], b = acc[ai][1][m][n]; v[n] = a * sig4(a) * b; }
                *(u32x4*)(HID + (size_t)(row0 + ai * HALF + m * 16) * FFN + col0) = pack8(v[0], v[1]); }
    }
};
struct EpiGlu {
    static constexpr bool PERM = true, AFTER_DRAIN = false;
    const bf16_t* Y0; bf16_t* OUT; const float* bias;
    __device__ __forceinline__ void operator()(const f32x4 (&acc)[2][2][4][2], const Unit& u, int wr, int wc, int fr, int fq) const {
        const int row0 = u.pm * BM + wr * 64 + fr, col0 = u.pn * BM + wc * 32 + 8 * fq;
#pragma unroll
        for (int ai = 0; ai < 2; ++ai)
#pragma unroll
            for (int m = 0; m < 4; ++m) { const size_t row = (size_t)(row0 + ai * HALF + m * 16);
#pragma unroll
                for (int bj = 0; bj < 2; ++bj) { const int col = col0 + bj * HALF;
                    f32x4 y0, y1; unpack8(*(const u32x4*)(Y0 + row * 512 + col), y0, y1);
                    const f32x4 b0 = *(const f32x4*)(bias + col), b1 = *(const f32x4*)(bias + col + 4);
                    *(u32x4*)(OUT + row * 512 + col) = pack8(y0 * sig4(acc[ai][bj][m][0] + b0), y1 * sig4(acc[ai][bj][m][1] + b1)); }
                EPI_FENCE(); }
    }
};
__device__ __forceinline__ float logdecay(float x) { return -0.6065306597f * sigm(x); }
struct EpiLora {
    static constexpr bool PERM = true, AFTER_DRAIN = false;
    float* WLOG; bf16_t* ASIG; bf16_t* GG; const float* w0; const float* a0;
    __device__ __forceinline__ void operator()(const f32x4 (&acc)[2][2][4][2], const Unit& u, int wr, int wc, int fr, int fq) const {
        const int kind = u.pn >> 1, row0 = u.pm * BM + wr * 64 + fr, col0 = (u.pn & 1) * BM + wc * 32 + 8 * fq;
        if (kind == 0) {
            f32x4 b[2][2];
#pragma unroll
            for (int bj = 0; bj < 2; ++bj) { b[bj][0] = *(const f32x4*)(w0 + col0 + bj * HALF); b[bj][1] = *(const f32x4*)(w0 + col0 + bj * HALF + 4); }
#pragma unroll
            for (int ai = 0; ai < 2; ++ai)
#pragma unroll
                for (int m = 0; m < 4; ++m)
#pragma unroll
                    for (int bj = 0; bj < 2; ++bj)
#pragma unroll
                        for (int n = 0; n < 2; ++n) { const f32x4 x = acc[ai][bj][m][n] + b[bj][n];
                            *(f32x4*)(WLOG + (size_t)(row0 + ai * HALF + m * 16) * 512 + col0 + bj * HALF + 4 * n) = (f32x4){logdecay(x[0]), logdecay(x[1]), logdecay(x[2]), logdecay(x[3])}; }
        } else if (kind == 1) {
            f32x4 b[2][2];
#pragma unroll
            for (int bj = 0; bj < 2; ++bj) { b[bj][0] = *(const f32x4*)(a0 + col0 + bj * HALF); b[bj][1] = *(const f32x4*)(a0 + col0 + bj * HALF + 4); }
#pragma unroll
            for (int ai = 0; ai < 2; ++ai)
#pragma unroll
                for (int m = 0; m < 4; ++m)
#pragma unroll
                    for (int bj = 0; bj < 2; ++bj)
                        *(u32x4*)(ASIG + (size_t)(row0 + ai * HALF + m * 16) * 512 + col0 + bj * HALF) = pack8(sig4(acc[ai][bj][m][0] + b[bj][0]), sig4(acc[ai][bj][m][1] + b[bj][1]));
        } else {
#pragma unroll
            for (int ai = 0; ai < 2; ++ai)
#pragma unroll
                for (int m = 0; m < 4; ++m)
#pragma unroll
                    for (int bj = 0; bj < 2; ++bj)
                        *(u32x4*)(GG + (size_t)(row0 + ai * HALF + m * 16) * 512 + col0 + bj * HALF) = pack8(acc[ai][bj][m][0], acc[ai][bj][m][1]);
        }
    }
};
}
typedef short bf16x8_t __attribute__((ext_vector_type(8)));
typedef float f32x16 __attribute__((ext_vector_type(16)));
typedef float f32x4_t __attribute__((ext_vector_type(4)));
__device__ __forceinline__ bf16x8_t frag2(const u32x2 lo, const u32x2 hi) { u32x4 w; w.x = lo.x; w.y = lo.y; w.z = hi.x; w.w = hi.y; return __builtin_bit_cast(bf16x8_t, w); }
struct Args { const float* in[N_IN]; float* out; unsigned char* ws; int seg_lo, seg_hi; };
#ifdef HOST_EMU
typedef const Args* KArgs;
#define KLAUNDER(p) (p)
__device__ __forceinline__ int fresh_tid() { return (int)threadIdx.x; }
#else
typedef const __attribute__((address_space(4))) Args* KArgs;
__device__ __forceinline__ KArgs klaunder(KArgs p) { asm volatile("" : "+s"(p)); return p; }
#define KLAUNDER(p) klaunder(p)
__device__ __forceinline__ int fresh_tid() { int t = (int)threadIdx.x; asm volatile("" : "+v"(t)); return t; }
#endif
#define WSP(T, off) ((T*)(C->ws + (off)))

template <class Src>
__device__ __forceinline__ void transpose_item(const Src& S, int K, bf16* WT, float* scr, int item, int lane) {
    const int nblk = S.ndst / 32, kb = item / nblk, nb = item % nblk, k0 = 64 * kb, n0 = 32 * nb;
    const float* cp = S.col(n0 + (lane & 31)); const int ld = S.ld; const float* cq = cp ? cp : S.col(0);
    float ld32[32];
#pragma unroll
    for (int i = 0; i < 32; ++i) ld32[i] = cq[(size_t)(k0 + 2 * i + (lane >> 5)) * ld];
#pragma unroll
    for (int i = 0; i < 32; ++i) { const int kk = 2 * i + (lane >> 5); scr[kk * 33 + (lane & 31)] = cp ? ld32[i] : 0.f; }
    WAVE_SYNC();
    const int c = lane & 7;
#pragma unroll
    for (int j = 0; j < 4; ++j) { const int n = (lane >> 3) + 8 * j; const float* s = scr + (8 * c) * 33 + n;
        u32x4 o; o.x = pk2(s[0 * 33], s[1 * 33]); o.y = pk2(s[2 * 33], s[3 * 33]); o.z = pk2(s[4 * 33], s[5 * 33]); o.w = pk2(s[6 * 33], s[7 * 33]);
        *(u32x4*)(WT + (size_t)(n0 + n) * K + k0 + 8 * c) = o; }
    WAVE_SYNC();
}
struct SrcWin { const float* w; int ndst, ld;
    __device__ __forceinline__ const float* col(int n) const {
        int s;
        if (n < 1280) s = n;
        else if (n < 2816) s = n + 8;
        else if (n < 4608) s = n - 2816 + 2988;
        else if (n < 5120) s = n - 4608 + 4780;
        else if (n < 5128) s = n - 5120 + 1280;
        else if (n < 5256) s = n - 5128 + 2824;
        else if (n < 5288) s = n - 5256 + 2952;
        else if (n < 5292) s = n - 5288 + 2984;
        else if (n < 5376) return nullptr;
        else s = n - 5376 + 5292;
        return w + s; } };
struct SrcPlain { const float* w; int ndst, ld; __device__ __forceinline__ const float* col(int n) const { return w + n; } };
struct SrcW13 { const float* w1; const float* w3; int ndst, ld;
    __device__ __forceinline__ const float* col(int n) const { const int pn = n >> 8, r = n & 255; return w1 + (r < 128 ? (ptrdiff_t)0 : (w3 - w1)) + pn * 128 + (r & 127); } };

__device__ __forceinline__ void phase_weights(KArgs C, int layer, unsigned char* lds, int gw, int ngw, int lane, int wave) {
    float* scr = (float*)(lds + wave * 16384); const size_t wo = (layer & 1) ? WDELTA : 0;
    constexpr int N_IN_ = 16 * (NPROJ / 32), N_BR = 8 * 32, N_OUT = 16 * 32, N_13 = 16 * (5632 / 32), N_2 = 44 * 32, N_GLU = 8 * 16;
    { constexpr int E0 = N_IN_, E1 = E0 + 4 * N_BR, E2 = E1 + N_OUT, E3 = E2 + N_13, E4 = E3 + N_2, E5 = E4 + N_GLU;
      for (int it = gw; it < E5; it += ngw) {
          if (it < E0) { const SrcWin s_in{C->in[I_WIN] + (size_t)layer * 1024 * IN_COLS, NPROJ, IN_COLS}; transpose_item(s_in, 1024, WSP(bf16, WS_WIN + wo), scr, it, lane); }
          else if (it < E1) { const int i2 = it - E0, n = i2 / N_BR; const SrcPlain s_b{C->in[I_WBR] + ((size_t)layer * 4 + n) * 512 * 1024, 1024, 1024};
              transpose_item(s_b, 512, WSP(bf16, WS_WB + wo) + (size_t)n * 1024 * 512, scr, i2 % N_BR, lane); }
          else if (it < E2) { const SrcPlain s_out{C->in[I_WOUT] + (size_t)layer * 1024 * 1024, 1024, 1024}; transpose_item(s_out, 1024, WSP(bf16, WS_WOUT + wo), scr, it - E1, lane); }
          else if (it < E3) { const SrcW13 s_13{C->in[I_W1] + (size_t)layer * 1024 * FFN, C->in[I_W3] + (size_t)layer * 1024 * FFN, 5632, FFN}; transpose_item(s_13, 1024, WSP(bf16, WS_W13 + wo), scr, it - E2, lane); }
          else if (it < E4) { const SrcPlain s_2{C->in[I_W2F] + (size_t)layer * FFN * 1024, 1024, 1024}; transpose_item(s_2, FFN, WSP(bf16, WS_W2 + wo), scr, it - E3, lane); }
          else { const SrcPlain s_glu{C->in[I_GLUW] + (size_t)layer * 512 * 512, 512, 512}; transpose_item(s_glu, 512, WSP(bf16, WS_GLU + wo), scr, it - E4, lane); } } }
    { const float* w2 = C->in[I_W2] + (size_t)layer * 64 * 512; const float* a2 = C->in[I_A2] + (size_t)layer * 64 * 512; const float* g2 = C->in[I_G2] + (size_t)layer * 128 * 512;
      bf16* WL = WSP(bf16, WS_WLORA + wo);
      for (int e = gw * 64 + lane; e < 1536 * 256; e += ngw * 64) { const int n = e >> 8, kc = e & 255; float v = 0.f;
          if (n < 512) { if (kc < 64) v = w2[kc * 512 + n]; } else if (n < 1024) { if (kc >= 64 && kc < 128) v = a2[(kc - 64) * 512 + (n - 512)]; } else { if (kc >= 128) v = g2[(kc - 128) * 512 + (n - 1024)]; }
          WL[e] = f2bf(v); } }
    const int gt = gw * 64 + lane, ngt = ngw * 64;
    for (int ej = ngt - 1 - gt; ej < 32 * 64 * 16; ej += ngt) {
        const int e = ej >> 4, j = ej & 15, g = e >> 6;
        const float ar = C->in[I_S5ARE][layer * 2048 + e], ai = C->in[I_S5AIM][layer * 2048 + e], dt = expf(C->in[I_S5LDT][layer * 32 + g]);
        const float br = C->in[I_S5BRE][((size_t)layer * 2048 + e) * 16 + j], bi = C->in[I_S5BIM][((size_t)layer * 2048 + e) * 16 + j];
        const float mag = expf(ar * dt), abr = mag * cosf(ai * dt), abi = mag * sinf(ai * dt);
        const float den = ar * ar + ai * ai, nr = abr - 1.0f, ni = abi;
        const float qr = (nr * ar + ni * ai) / den, qi = (ni * ar - nr * ai) / den;
        if (j == 0) { float* ab = WSP(float, WS_ABAR + wo) + e * 2; ab[0] = abr; ab[1] = abi; }
        float* bb = WSP(float, WS_BBAR + wo) + (size_t)e * 32;
        bb[2 * j] = qr * br - qi * bi; bb[2 * j + 1] = qr * bi + qi * br;
    }
    if (layer == 0) for (int e = gt; e < SEQ + 63; e += ngt) {
        const int rel = e - (SEQ - 1); const int n = rel < 0 ? -rel : rel; int b = rel > 0 ? 16 : 0;
        if (n < 8) b += n; else { int lg = 8 + (int)(logf((float)n / 8.0f) / 3.4657359028f * 8.0f); if (lg > 15) lg = 15; b += lg; }
        WSP(int, WS_TAB)[e] = b;
    }
}

__device__ __forceinline__ void rms_row_bf16(const float* xrow, const float* g, bf16* orow, int lane) {
    const f32x4* xr = (const f32x4*)xrow + lane; const f32x4* gr = (const f32x4*)g + lane;
    f32x4 v[4]; float s = 0.f;
#pragma unroll
    for (int j = 0; j < 4; ++j) { v[j] = xr[64 * j]; s += (v[j].x * v[j].x + v[j].y * v[j].y) + (v[j].z * v[j].z + v[j].w * v[j].w); }
    const float rstd = 1.0f / sqrtf(wave_sum(s) * (1.f / D) + RMS_EPS);
    u32x2* o8 = (u32x2*)orow + lane;
#pragma unroll
    for (int j = 0; j < 4; ++j) { const f32x4 gg = gr[64 * j]; u32x2 w; w.x = pk2(v[j].x * rstd * gg.x, v[j].y * rstd * gg.y); w.y = pk2(v[j].z * rstd * gg.z, v[j].w * rstd * gg.w); o8[64 * j] = w; }
}
template <int NR>
__device__ __forceinline__ void rms_rowN_bf16(const float* xrow, const float* g, bf16* orow, size_t step, int lane) {
    const f32x4* gr = (const f32x4*)g + lane; f32x4 v[NR][4]; float ss[NR];
#pragma unroll
    for (int q = 0; q < NR; ++q)
#pragma unroll
        for (int j = 0; j < 4; ++j) v[q][j] = ((const f32x4*)(xrow + q * step) + lane)[64 * j];
#pragma unroll
    for (int q = 0; q < NR; ++q) { float s = 0.f;
#pragma unroll
        for (int j = 0; j < 4; ++j) s += (v[q][j].x * v[q][j].x + v[q][j].y * v[q][j].y) + (v[q][j].z * v[q][j].z + v[q][j].w * v[q][j].w);
        ss[q] = s; }
#pragma unroll
    for (int o = 1; o < 64; o <<= 1)
#pragma unroll
        for (int q = 0; q < NR; ++q) ss[q] += __shfl_xor(ss[q], o);
#pragma unroll
    for (int q = 0; q < NR; ++q) { const float r = 1.0f / sqrtf(ss[q] * (1.f / D) + RMS_EPS); u32x2* o8 = (u32x2*)(orow + q * step) + lane;
#pragma unroll
        for (int j = 0; j < 4; ++j) { const f32x4 gg = gr[64 * j]; u32x2 w; w.x = pk2(v[q][j].x * r * gg.x, v[q][j].y * r * gg.y); w.y = pk2(v[q][j].z * r * gg.z, v[q][j].w * r * gg.w); o8[64 * j] = w; } }
}
__device__ __forceinline__ void rms_row_f32(float* xrow, const float* g, int lane) {
    f32x4* xr = (f32x4*)xrow + lane; const f32x4* gr = (const f32x4*)g + lane;
    f32x4 v[4]; float s = 0.f;
#pragma unroll
    for (int j = 0; j < 4; ++j) { v[j] = xr[64 * j]; s += (v[j].x * v[j].x + v[j].y * v[j].y) + (v[j].z * v[j].z + v[j].w * v[j].w); }
    const float rstd = 1.0f / sqrtf(wave_sum(s) * (1.f / D) + RMS_EPS);
#pragma unroll
    for (int j = 0; j < 4; ++j) xr[64 * j] = v[j] * rstd * gr[64 * j];
}

#ifdef HOST_EMU
__device__ __forceinline__ float red8(float v) { v += __shfl_xor(v, 1); v += __shfl_xor(v, 2); v += __shfl_xor(v, 4); return v; }
__device__ __forceinline__ float red16(float v) { v = red8(v); v += __shfl_xor(v, 8); return v; }
#else
template <int CTRL> __device__ __forceinline__ float dpp_f(float v) { return __builtin_bit_cast(float, __builtin_amdgcn_update_dpp(0, __builtin_bit_cast(int, v), CTRL, 0xf, 0xf, true)); }
__device__ __forceinline__ float red8(float v) { v += dpp_f<0xB1>(v); v += dpp_f<0x4E>(v); v += dpp_f<0x141>(v); return v; }
__device__ __forceinline__ float red16(float v) { v = red8(v); v += dpp_f<0x140>(v); return v; }
#endif
__device__ __forceinline__ f32x4 sig4g(const f32x4 v) { return (f32x4){sigm(v[0]), sigm(v[1]), sigm(v[2]), sigm(v[3])}; }
__device__ __forceinline__ void rms_row2_f32(float* xrow, size_t step, const float* g, int lane) {
    f32x4* xa = (f32x4*)xrow + lane; f32x4* xb = (f32x4*)(xrow + step) + lane; const f32x4* gr = (const f32x4*)g + lane;
    f32x4 va[4], vb[4]; float sa = 0.f, sb = 0.f;
#pragma unroll
    for (int j = 0; j < 4; ++j) { va[j] = xa[64 * j]; vb[j] = xb[64 * j]; }
#pragma unroll
    for (int j = 0; j < 4; ++j) { sa += (va[j].x * va[j].x + va[j].y * va[j].y) + (va[j].z * va[j].z + va[j].w * va[j].w); sb += (vb[j].x * vb[j].x + vb[j].y * vb[j].y) + (vb[j].z * vb[j].z + vb[j].w * vb[j].w); }
#pragma unroll
    for (int o = 1; o < 64; o <<= 1) { sa += __shfl_xor(sa, o); sb += __shfl_xor(sb, o); }
    const float ra = 1.0f / sqrtf(sa * (1.f / D) + RMS_EPS), rb = 1.0f / sqrtf(sb * (1.f / D) + RMS_EPS);
#pragma unroll
    for (int j = 0; j < 4; ++j) { const f32x4 gg = gr[64 * j]; xa[64 * j] = va[j] * ra * gg; xb[64 * j] = vb[j] * rb * gg; }
}
__device__ __forceinline__ void ssd_conv_row(KArgs C, int layer, int m, int lane) {
    const int t = m % SEQ; const float* cw = C->in[I_CONVW] + layer * 4 * 768; const float* cb = C->in[I_CONVB] + layer * 768;
#pragma unroll
    for (int i = 0; i < 3; ++i) { const int ch = i * 256 + lane * 4; const bf16* p = WSP(const bf16, WS_XBC) + (size_t)m * 768 + ch;
        f32x4 a = *(const f32x4*)(cb + ch);
#pragma unroll
        for (int q = 0; q < 4; ++q) if (t - 3 + q >= 0) { const u32x2 w = *(const u32x2*)(p - (3 - q) * 768); const f32x4 cq = *(const f32x4*)(cw + q * 768 + ch);
            a += cq * (f32x4){lo_bf(w.x), hi_bf(w.x), lo_bf(w.y), hi_bf(w.y)}; }
        a = a * sig4g(a);
        u32x2 o; o.x = pk2(a.x, a.y); o.y = pk2(a.z, a.w); *(u32x2*)(WSP(bf16, WS_XBA) + (size_t)m * 768 + ch) = o; }
}
__device__ __forceinline__ void ssd_conv_row2(KArgs C, int layer, int m, int step, int lane) {
    const float* cw = C->in[I_CONVW] + layer * 4 * 768; const float* cb = C->in[I_CONVB] + layer * 768;
    u32x2 w[2][3][4]; f32x4 cq[3][4], bb[3];
#pragma unroll
    for (int i = 0; i < 3; ++i) { const int ch = i * 256 + lane * 4; bb[i] = *(const f32x4*)(cb + ch);
#pragma unroll
        for (int q = 0; q < 4; ++q) { cq[i][q] = *(const f32x4*)(cw + q * 768 + ch);
#pragma unroll
            for (int r = 0; r < 2; ++r) { const int mm = m + r * step, t = mm % SEQ; const bf16* p = WSP(const bf16, WS_XBC) + (size_t)mm * 768 + ch;
                if (t - 3 + q >= 0) w[r][i][q] = *(const u32x2*)(p - (3 - q) * 768); else { w[r][i][q].x = 0u; w[r][i][q].y = 0u; } } } }
#pragma unroll
    for (int r = 0; r < 2; ++r)
#pragma unroll
        for (int i = 0; i < 3; ++i) { const int ch = i * 256 + lane * 4; f32x4 a = bb[i];
#pragma unroll
            for (int q = 0; q < 4; ++q) a += cq[i][q] * (f32x4){lo_bf(w[r][i][q].x), hi_bf(w[r][i][q].x), lo_bf(w[r][i][q].y), hi_bf(w[r][i][q].y)};
            a = a * sig4g(a);
            u32x2 o; o.x = pk2(a.x, a.y); o.y = pk2(a.z, a.w); *(u32x2*)(WSP(bf16, WS_XBA) + (size_t)(m + r * step) * 768 + ch) = o; }
}
__device__ __forceinline__ void ssd_unit(KArgs C, int layer, int unit, unsigned char* lds) {
    const int tid = fresh_tid(), lane = tid & 63, wave = tid >> 6, bl = unit >> 3, h = unit & 7, gi = h >> 2, pp = tid >> 3, c8 = (tid & 7) * 8, c16 = lane & 15, q = lane >> 4;
    bf16* Cb = (bf16*)lds; bf16* Bb = Cb + 4096; bf16* XT = Bb + 4096; bf16* BwT = XT + 4096; bf16* Pm = BwT + 4096; float* Yo = (float*)(Pm + 4096); float* dts = Yo + 8192; float* acs = dts + 128;
    const bf16* XA = WSP(const bf16, WS_XBA) + (size_t)bl * SEQ * 768 + (size_t)pp * 768 + c8;
    const bf16* SMp = WSP(const bf16, WS_SM) + (size_t)bl * SEQ * 256;
    const bf16* Zp = WSP(const bf16, WS_Z) + (size_t)bl * SEQ * 512 + (size_t)pp * 512 + h * 64 + c8;
    bf16* YA = WSP(bf16, WS_Y) + (size_t)bl * SEQ * 512 + (size_t)pp * 512 + h * 64 + c8;
    const float dtb = C->in[I_DTB][layer * 8 + h], A = -__expf(C->in[I_ALOG][layer * 8 + h]), Dh = C->in[I_SSDD][layer * 8 + h];
    f32x4_t Sd[2]; bf16x8_t Sf; Sd[0] = (f32x4_t){0.f, 0.f, 0.f, 0.f}; Sd[1] = Sd[0]; { u32x2 z; z.x = 0u; z.y = 0u; Sf = frag2(z, z); }
    const int pt = wave & 3, nh = wave >> 2;
    u32x4 fx, fb, fc, fz;
#define SSD_FETCH(c0_) do { const bf16* q_ = XA + (size_t)(c0_) * 768; fx = *(const u32x4*)(q_ + h * 64); fb = *(const u32x4*)(q_ + 512 + gi * 64); fc = *(const u32x4*)(q_ + 640 + gi * 64); fz = *(const u32x4*)(Zp + (size_t)(c0_) * 512); } while (0)
#define SSD_DT(c0_, par) do { if (wave == 0) { const float dt_ = softplusf(bf2f(SMp[(size_t)((c0_) + lane) * 256 + h]) + dtb); float a_ = A * dt_; \
        _Pragma("unroll") for (int o_ = 1; o_ < 64; o_ <<= 1) { const float t_ = __shfl_up(a_, o_); if (lane >= o_) a_ += t_; } dts[(par) * 64 + lane] = dt_; acs[(par) * 64 + lane] = a_; } } while (0)
    LDS_SYNC();
    SSD_FETCH(0); SSD_DT(0, 0);
    for (int c0 = 0, par = 0; c0 < SEQ; c0 += 64, par ^= 1) {
        LDS_SYNC();
        const u32x4 xk = fx, zk = fz;
        {
          const float dt = dts[par * 64 + pp], ea = __expf(acs[par * 64 + 63] - acs[par * 64 + pp]);
          *(u32x4*)(Cb + pp * 64 + c8) = fc; *(u32x4*)(Bb + pp * 64 + c8) = fb;
          f32x4 x0, x1, b0, b1; pg8::unpack8(fx, x0, x1); pg8::unpack8(fb, b0, b1); x0 = x0 * dt; x1 = x1 * dt; b0 = b0 * ea; b1 = b1 * ea;
#pragma unroll
          for (int i = 0; i < 4; ++i) { XT[(c8 + i) * 64 + pp] = f2bf(x0[i]); XT[(c8 + 4 + i) * 64 + pp] = f2bf(x1[i]); BwT[(c8 + i) * 64 + pp] = f2bf(b0[i]); BwT[(c8 + 4 + i) * 64 + pp] = f2bf(b1[i]); } }
        if (c0 + 64 < SEQ) { SSD_FETCH(c0 + 64); SSD_DT(c0 + 64, par ^ 1); }
        LDS_SYNC();
        {
          const f32x4_t z4 = {0.f, 0.f, 0.f, 0.f};
#pragma unroll
          for (int i = 0; i < 2; ++i) { const int id = wave + 8 * i, lt = id >> 2, st = id & 3; f32x4_t g = z4;
              if (st <= lt) {
#pragma unroll
                  for (int ks = 0; ks < 2; ++ks) g = __builtin_amdgcn_mfma_f32_16x16x32_bf16(*(const bf16x8_t*)(Cb + (16 * lt + c16) * 64 + 32 * ks + 8 * q), *(const bf16x8_t*)(Bb + (16 * st + c16) * 64 + 32 * ks + 8 * q), g, 0, 0, 0);
                  const float as_ = acs[par * 64 + 16 * st + c16];
#pragma unroll
                  for (int r = 0; r < 4; ++r) { const int l = 16 * lt + 4 * q + r; g[r] = (16 * st + c16 <= l) ? g[r] * __expf(acs[par * 64 + l] - as_) : 0.f; } }
#pragma unroll
              for (int r = 0; r < 4; ++r) Pm[(16 * lt + 4 * q + r) * 64 + 16 * st + c16] = f2bf(g[r]); }
#pragma unroll
          for (int lt = 0; lt < 4; ++lt) { const bf16* cr = Cb + (16 * lt + c16) * 64 + 32 * nh + 4 * q;
              const f32x4_t yo = __builtin_amdgcn_mfma_f32_16x16x32_bf16(frag2(*(const u32x2*)cr, *(const u32x2*)(cr + 16)), Sf, z4, 0, 0, 0);
#pragma unroll
              for (int r = 0; r < 4; ++r) Yo[nh * 4096 + (16 * lt + 4 * q + r) * 64 + 16 * pt + c16] = yo[r]; }
          const float eL = __expf(acs[par * 64 + 63]);
          const bf16x8_t xb0 = *(const bf16x8_t*)(XT + (16 * pt + c16) * 64 + 8 * q), xb1 = *(const bf16x8_t*)(XT + (16 * pt + c16) * 64 + 32 + 8 * q);
#pragma unroll
          for (int i = 0; i < 2; ++i) { const bf16* br = BwT + (16 * (2 * nh + i) + c16) * 64 + 8 * q; f32x4_t cin = Sd[i] * eL;
              cin = __builtin_amdgcn_mfma_f32_16x16x32_bf16(*(const bf16x8_t*)br, xb0, cin, 0, 0, 0); Sd[i] = __builtin_amdgcn_mfma_f32_16x16x32_bf16(*(const bf16x8_t*)(br + 32), xb1, cin, 0, 0, 0); }
          u32x2 lo, hi; lo.x = pk2(Sd[0][0], Sd[0][1]); lo.y = pk2(Sd[0][2], Sd[0][3]); hi.x = pk2(Sd[1][0], Sd[1][1]); hi.y = pk2(Sd[1][2], Sd[1][3]); Sf = frag2(lo, hi); }
        LDS_SYNC();
        {
          const f32x4_t z4 = {0.f, 0.f, 0.f, 0.f};
#pragma unroll
          for (int i = 0; i < 2; ++i) { const int id = wave + 8 * i, lt = id >> 2, p2 = id & 3;
              f32x4_t y = __builtin_amdgcn_mfma_f32_16x16x32_bf16(*(const bf16x8_t*)(Pm + (16 * lt + c16) * 64 + 8 * q), *(const bf16x8_t*)(XT + (16 * p2 + c16) * 64 + 8 * q), z4, 0, 0, 0);
              if (lt >= 2) y = __builtin_amdgcn_mfma_f32_16x16x32_bf16(*(const bf16x8_t*)(Pm + (16 * lt + c16) * 64 + 32 + 8 * q), *(const bf16x8_t*)(XT + (16 * p2 + c16) * 64 + 32 + 8 * q), y, 0, 0, 0);
#pragma unroll
              for (int r = 0; r < 4; ++r) { const int l = 16 * lt + 4 * q + r, o = l * 64 + 16 * p2 + c16; Yo[o] = y[r] + __expf(acs[par * 64 + l]) * (Yo[o] + Yo[4096 + o]); } } }
        LDS_SYNC();
        {
          f32x4 x0, x1, z0, z1; pg8::unpack8(xk, x0, x1); pg8::unpack8(zk, z0, z1);
          const f32x4 y0 = (*(const f32x4*)(Yo + pp * 64 + c8) + Dh * x0) * z0 * sig4g(z0), y1 = (*(const f32x4*)(Yo + pp * 64 + c8 + 4) + Dh * x1) * z1 * sig4g(z1);
          *(u32x4*)(YA + (size_t)c0 * 512) = pg8::pack8(y0, y1); }
    }
#undef SSD_FETCH
#undef SSD_DT
}
__device__ __forceinline__ void ssd_norm_item4(KArgs C, int layer, int item0, int stride, int nitems, int lane) {
    u32x2 w[4]; bf16* p[4];
#pragma unroll
    for (int q = 0; q < 4; ++q) { const int item = item0 + q * stride; p[q] = WSP(bf16, WS_Y) + (size_t)((item < nitems ? item : item0) >> 1) * 512 + ((item < nitems ? item : item0) & 1) * 256 + lane * 4; w[q] = *(const u32x2*)p[q]; }
#pragma unroll
    for (int q = 0; q < 4; ++q) { const int item = item0 + q * stride; if (item < nitems) {
        float v[4] = {lo_bf(w[q].x), hi_bf(w[q].x), lo_bf(w[q].y), hi_bf(w[q].y)};
        const float rstd = 1.0f / sqrtf(wave_sum(v[0] * v[0] + v[1] * v[1] + v[2] * v[2] + v[3] * v[3]) * (1.f / 256) + RMS_EPS);
        const float* g = C->in[I_SSDNG] + layer * 512 + (item & 1) * 256 + lane * 4;
        u32x2 o; o.x = pk2(v[0] * rstd * g[0], v[1] * rstd * g[1]); o.y = pk2(v[2] * rstd * g[2], v[3] * rstd * g[3]); *(u32x2*)p[q] = o; } }
}
__device__ __forceinline__ void rwkv_prep_row(KArgs C, int layer, int m, int lane) {
    const int t = m % SEQ, col = 1536 + lane * 4;
    const bf16* cur = WSP(const bf16, WS_RW) + (size_t)m * 1792 + col;
    const u32x2 wc = *(const u32x2*)cur; u32x2 wp; wp.x = 0u; wp.y = 0u; if (t > 0) wp = *(const u32x2*)(cur - 1792);
    const f32x4 mu = *(const f32x4*)(C->in[I_MU] + layer * 1792 + col);
    float v[4] = {lo_bf(wc.x), hi_bf(wc.x), lo_bf(wc.y), hi_bf(wc.y)}; const float p[4] = {lo_bf(wp.x), hi_bf(wp.x), lo_bf(wp.y), hi_bf(wp.y)};
#pragma unroll
    for (int i = 0; i < 4; ++i) { v[i] = v[i] + (p[i] - v[i]) * mu[i]; v[i] = lane < 16 ? tanh_fast(v[i]) : (lane < 32 ? v[i] : sigm(v[i])); }
    u32x2 o; o.x = pk2(v[0], v[1]); o.y = pk2(v[2], v[3]); *(u32x2*)(WSP(bf16, WS_RA) + (size_t)m * 256 + lane * 4) = o;
}
__device__ __forceinline__ void ssd_conv_rows8(KArgs C, int layer, int m0, int lane) {
    const float* cw = C->in[I_CONVW] + layer * 4 * 768; const float* cb = C->in[I_CONVB] + layer * 768; const bool head = (m0 % SEQ) == 0;
    u32x2 w[3][11];
#pragma unroll
    for (int i = 0; i < 3; ++i) { const bf16* p = WSP(const bf16, WS_XBC) + (size_t)m0 * 768 + i * 256 + lane * 4;
#pragma unroll
        for (int r = 0; r < 11; ++r) { if (r >= 3 || !head) w[i][r] = *(const u32x2*)(p + (r - 3) * 768); else { w[i][r].x = 0u; w[i][r].y = 0u; } } }
#pragma unroll
    for (int i = 0; i < 3; ++i) { const int ch = i * 256 + lane * 4; const f32x4 bb = *(const f32x4*)(cb + ch); f32x4 cq[4], x[11];
#pragma unroll
        for (int q = 0; q < 4; ++q) cq[q] = *(const f32x4*)(cw + q * 768 + ch);
#pragma unroll
        for (int r = 0; r < 11; ++r) x[r] = (f32x4){lo_bf(w[i][r].x), hi_bf(w[i][r].x), lo_bf(w[i][r].y), hi_bf(w[i][r].y)};
#pragma unroll
        for (int r = 0; r < 8; ++r) { f32x4 a = bb;
#pragma unroll
            for (int q = 0; q < 4; ++q) a += cq[q] * x[r + q];
            a = a * sig4g(a);
            u32x2 o; o.x = pk2(a.x, a.y); o.y = pk2(a.z, a.w); *(u32x2*)(WSP(bf16, WS_XBA) + (size_t)(m0 + r) * 768 + ch) = o; } }
}
__device__ __forceinline__ void rwkv_prep_row2(KArgs C, int layer, int m, int step, int lane) {
    const int col = 1536 + lane * 4; const f32x4 mu = *(const f32x4*)(C->in[I_MU] + layer * 1792 + col);
    u32x2 wc[2], wp[2];
#pragma unroll
    for (int r = 0; r < 2; ++r) { const int mm = m + r * step; const bf16* cur = WSP(const bf16, WS_RW) + (size_t)mm * 1792 + col; wc[r] = *(const u32x2*)cur;
        if (mm % SEQ > 0) wp[r] = *(const u32x2*)(cur - 1792); else { wp[r].x = 0u; wp[r].y = 0u; } }
#pragma unroll
    for (int r = 0; r < 2; ++r) { float v[4] = {lo_bf(wc[r].x), hi_bf(wc[r].x), lo_bf(wc[r].y), hi_bf(wc[r].y)}; const float p[4] = {lo_bf(wp[r].x), hi_bf(wp[r].x), lo_bf(wp[r].y), hi_bf(wp[r].y)};
#pragma unroll
        for (int i = 0; i < 4; ++i) { v[i] = v[i] + (p[i] - v[i]) * mu[i]; v[i] = lane < 16 ? tanh_fast(v[i]) : (lane < 32 ? v[i] : sigm(v[i])); }
        u32x2 o; o.x = pk2(v[0], v[1]); o.y = pk2(v[2], v[3]); *(u32x2*)(WSP(bf16, WS_RA) + (size_t)(m + r * step) * 256 + lane * 4) = o; }
}
__device__ __forceinline__ void rwkv_unit(KArgs C, int layer, int unit, unsigned char* lds) {
    constexpr int SLOT = 16704, O_RT = 2048, O_BTL = 4096, O_KTL = 6144, O_BHT = 8192, O_KHT = 10240, O_VT = 12288, O_TM = 14336, O_AAK = 14848, O_RB = 15360, O_RK = 15872, O_DL = 16384, O_BON = 16640;
    const int tid = fresh_tid(), lane = tid & 63, wave = tid >> 6, bl = unit >> 3, h = unit & 7, pt = tid >> 3, k8 = (tid & 7) * 8, cc = pt >> 4, tl = pt & 15, hc = h * 64 + k8;
    float* WL = (float*)(lds + 4 * SLOT); float* Nf = WL + 4096; float* Yb = Nf + 1024; float* ct_ = Yb + 4096;
    const bf16* RW = WSP(const bf16, WS_RW) + (size_t)bl * SEQ * 1792 + hc;
    const float* WLG = WSP(const float, WS_WLOG) + (size_t)bl * SEQ * 512 + hc;
    const bf16* AS = WSP(const bf16, WS_ASIG) + (size_t)bl * SEQ * 512 + hc;
    const bf16* GG = WSP(const bf16, WS_GG) + (size_t)bl * SEQ * 512 + hc;
    bf16* YC = WSP(bf16, WS_Y) + (size_t)2 * MG * 512 + (size_t)bl * SEQ * 512 + hc;
    LDS_SYNC();
    { const int row = tid >> 6, j = tid & 63; const float* src = row == 0 ? C->in[I_MU] + layer * 1792 : row == 1 ? C->in[I_MU] + layer * 1792 + 512 : row == 2 ? C->in[I_MU] + layer * 1792 + 1024
          : row == 3 ? C->in[I_KK] + layer * 512 : row == 4 ? C->in[I_KA] + layer * 512 : row == 5 ? C->in[I_RK] + layer * 512 : row == 6 ? C->in[I_LNG] + layer * 512 : C->in[I_LNB] + layer * 512;
      ct_[tid] = src[h * 64 + j]; }
    f32x4_t Sd[4]; bf16x8_t Sf[2];
#pragma unroll
    for (int i = 0; i < 4; ++i) Sd[i] = (f32x4_t){0.f, 0.f, 0.f, 0.f};
    { u32x2 z; z.x = 0u; z.y = 0u; Sf[0] = frag2(z, z); Sf[1] = Sf[0]; }
    u32x4 rc, rp, kc, kp, vc, vp, ac, gc; f32x4 wl0, wl1;
#define RWKV_FETCH(c0_) do { const int tt_ = (c0_) + pt; const bf16* q_ = RW + (size_t)tt_ * 1792; \
        rc = *(const u32x4*)q_; kc = *(const u32x4*)(q_ + 512); vc = *(const u32x4*)(q_ + 1024); \
        if (tt_ > 0) { rp = *(const u32x4*)(q_ - 1792); kp = *(const u32x4*)(q_ - 1792 + 512); vp = *(const u32x4*)(q_ - 1792 + 1024); } else { rp = (u32x4){0u, 0u, 0u, 0u}; kp = rp; vp = rp; } \
        wl0 = *(const f32x4*)(WLG + (size_t)tt_ * 512); wl1 = *(const f32x4*)(WLG + (size_t)tt_ * 512 + 4); ac = *(const u32x4*)(AS + (size_t)tt_ * 512); gc = *(const u32x4*)(GG + (size_t)tt_ * 512); } while (0)
    RWKV_FETCH(0);
    LDS_SYNC();
    for (int c0 = 0; c0 < SEQ; c0 += 64) {
        unsigned char* slot = lds + cc * SLOT;
        f32x4 r0, r1, kq0, kq1, v0, v1, kk0, kk1, b0, b1; const u32x4 gkeep = gc; const f32x4 wk0 = wl0, wk1 = wl1; float bo;
        { f32x4 c0_, c1_, p0_, p1_, a0, a1;
          pg8::unpack8(rc, c0_, c1_); pg8::unpack8(rp, p0_, p1_); r0 = c0_ + (p0_ - c0_) * *(const f32x4*)(ct_ + k8); r1 = c1_ + (p1_ - c1_) * *(const f32x4*)(ct_ + k8 + 4);
          pg8::unpack8(kc, c0_, c1_); pg8::unpack8(kp, p0_, p1_); const f32x4 k00 = c0_ + (p0_ - c0_) * *(const f32x4*)(ct_ + 64 + k8), k01 = c1_ + (p1_ - c1_) * *(const f32x4*)(ct_ + 64 + k8 + 4);
          pg8::unpack8(vc, c0_, c1_); pg8::unpack8(vp, p0_, p1_); v0 = c0_ + (p0_ - c0_) * *(const f32x4*)(ct_ + 128 + k8); v1 = c1_ + (p1_ - c1_) * *(const f32x4*)(ct_ + 128 + k8 + 4);
          pg8::unpack8(ac, a0, a1);
          kk0 = k00 * *(const f32x4*)(ct_ + 192 + k8); kk1 = k01 * *(const f32x4*)(ct_ + 192 + k8 + 4);
          const float inv = 1.0f / fmaxf(sqrtf(red8((kk0.x * kk0.x + kk0.y * kk0.y + kk0.z * kk0.z + kk0.w * kk0.w) + (kk1.x * kk1.x + kk1.y * kk1.y + kk1.z * kk1.z + kk1.w * kk1.w))), 1e-12f);
          kk0 = kk0 * inv; kk1 = kk1 * inv; b0 = kk0 * a0; b1 = kk1 * a1;
          kq0 = k00 * (1.0f + (a0 - 1.0f) * *(const f32x4*)(ct_ + 256 + k8)); kq1 = k01 * (1.0f + (a1 - 1.0f) * *(const f32x4*)(ct_ + 256 + k8 + 4));
          const f32x4 q0 = r0 * kq0 * *(const f32x4*)(ct_ + 320 + k8), q1 = r1 * kq1 * *(const f32x4*)(ct_ + 320 + k8 + 4);
          bo = red8((q0.x + q0.y + q0.z + q0.w) + (q1.x + q1.y + q1.z + q1.w));
          *(f32x4*)(WL + pt * 64 + k8) = wk0; *(f32x4*)(WL + pt * 64 + k8 + 4) = wk1; }
        if (c0 + 64 < SEQ) RWKV_FETCH(c0 + 64);
        LDS_SYNC();
        if (tid < 256) { const int c_ = tid >> 6, k_ = tid & 63; float w16[16], run = 0.f;
#pragma unroll
            for (int t = 0; t < 16; ++t) w16[t] = WL[(c_ * 16 + t) * 64 + k_];
#pragma unroll
            for (int t = 0; t < 16; ++t) { run += w16[t]; WL[(c_ * 16 + t) * 64 + k_] = run; }
            ((float*)(lds + c_ * SLOT + O_DL))[k_] = __expf(run); }
        LDS_SYNC();
        { const f32x4 cs0 = *(const f32x4*)(WL + pt * 64 + k8), cs1 = *(const f32x4*)(WL + pt * 64 + k8 + 4), d0 = *(const f32x4*)((const float*)(slot + O_DL) + k8), d1 = *(const f32x4*)((const float*)(slot + O_DL) + k8 + 4);
          f32x4 e0, e1, f0, f1, w0, w1;
#pragma unroll
          for (int i = 0; i < 4; ++i) { e0[i] = __expf(cs0[i]); e1[i] = __expf(cs1[i]); f0[i] = __builtin_amdgcn_rcpf(e0[i]); f1[i] = __builtin_amdgcn_rcpf(e1[i]); w0[i] = __expf(-wk0[i]); w1[i] = __expf(-wk1[i]); }
          const f32x4 bt0 = b0 * f0, bt1 = b1 * f1, kt0 = kq0 * f0, kt1 = kq1 * f1;
          *(u32x4*)((bf16*)slot + tl * 64 + k8) = pg8::pack8(-(kk0 * e0 * w0), -(kk1 * e1 * w1));
          *(u32x4*)((bf16*)(slot + O_RT) + tl * 64 + k8) = pg8::pack8(r0 * e0, r1 * e1);
          *(u32x4*)((bf16*)(slot + O_BTL) + tl * 64 + k8) = pg8::pack8(bt0, bt1);
          *(u32x4*)((bf16*)(slot + O_KTL) + tl * 64 + k8) = pg8::pack8(kt0, kt1);
          const f32x4 bh0 = bt0 * d0, bh1 = bt1 * d1, kh0 = kt0 * d0, kh1 = kt1 * d1;
          bf16* bht = (bf16*)(slot + O_BHT) + k8 * 16 + tl; bf16* kht = (bf16*)(slot + O_KHT) + k8 * 16 + tl; bf16* vt = (bf16*)(slot + O_VT) + k8 * 16 + tl;
#pragma unroll
          for (int i = 0; i < 4; ++i) { bht[i * 16] = f2bf(bh0[i]); bht[(i + 4) * 16] = f2bf(bh1[i]); kht[i * 16] = f2bf(kh0[i]); kht[(i + 4) * 16] = f2bf(kh1[i]); vt[i * 16] = f2bf(v0[i]); vt[(i + 4) * 16] = f2bf(v1[i]); } }
        LDS_SYNC();
        { unsigned char* sl = lds + (wave & 3) * SLOT; const int c16 = lane & 15, q = lane >> 4;
          const bf16x8_t a0 = *(const bf16x8_t*)((const bf16*)sl + c16 * 64 + 8 * q), a1 = *(const bf16x8_t*)((const bf16*)sl + c16 * 64 + 32 + 8 * q);
          const bf16x8_t bb0 = *(const bf16x8_t*)((const bf16*)(sl + O_BTL) + c16 * 64 + 8 * q), bb1 = *(const bf16x8_t*)((const bf16*)(sl + O_BTL) + c16 * 64 + 32 + 8 * q);
          const f32x4_t z4 = {0.f, 0.f, 0.f, 0.f};
          if (wave < 4) {
              f32x4_t n = __builtin_amdgcn_mfma_f32_16x16x32_bf16(a0, bb0, z4, 0, 0, 0); n = __builtin_amdgcn_mfma_f32_16x16x32_bf16(a1, bb1, n, 0, 0, 0);
              float* nf = Nf + (wave & 3) * 256;
#pragma unroll
              for (int r = 0; r < 4; ++r) nf[c16 * 16 + 4 * q + r] = (c16 < 4 * q + r) ? n[r] : 0.f;
              WAVE_SYNC();
              float tc[16];
#pragma unroll
              for (int t = 0; t < 16; ++t) tc[t] = (t == c16) ? 1.f : 0.f;
#pragma unroll
              for (int s2 = 0; s2 < 15; ++s2) { const f32x4 n0 = *(const f32x4*)(nf + s2 * 16), n1 = *(const f32x4*)(nf + s2 * 16 + 4), n2 = *(const f32x4*)(nf + s2 * 16 + 8), n3 = *(const f32x4*)(nf + s2 * 16 + 12);
                  const float ts = tc[s2]; const float nn[16] = {n0.x, n0.y, n0.z, n0.w, n1.x, n1.y, n1.z, n1.w, n2.x, n2.y, n2.z, n2.w, n3.x, n3.y, n3.z, n3.w};
#pragma unroll
                  for (int t = 0; t < 16; ++t) if (t > s2) tc[t] += nn[t] * ts; }
              if (q == 0) { bf16* tm = (bf16*)(sl + O_TM) + c16;
#pragma unroll
                  for (int t = 0; t < 16; ++t) tm[t * 16] = f2bf(tc[t]); }
          } else {
              const bf16x8_t r0f = *(const bf16x8_t*)((const bf16*)(sl + O_RT) + c16 * 64 + 8 * q), r1f = *(const bf16x8_t*)((const bf16*)(sl + O_RT) + c16 * 64 + 32 + 8 * q);
              const bf16x8_t kb0 = *(const bf16x8_t*)((const bf16*)(sl + O_KTL) + c16 * 64 + 8 * q), kb1 = *(const bf16x8_t*)((const bf16*)(sl + O_KTL) + c16 * 64 + 32 + 8 * q);
              f32x4_t ak = __builtin_amdgcn_mfma_f32_16x16x32_bf16(a0, kb0, z4, 0, 0, 0); ak = __builtin_amdgcn_mfma_f32_16x16x32_bf16(a1, kb1, ak, 0, 0, 0);
              f32x4_t rb = __builtin_amdgcn_mfma_f32_16x16x32_bf16(r0f, bb0, z4, 0, 0, 0); rb = __builtin_amdgcn_mfma_f32_16x16x32_bf16(r1f, bb1, rb, 0, 0, 0);
              f32x4_t rk = __builtin_amdgcn_mfma_f32_16x16x32_bf16(r0f, kb0, z4, 0, 0, 0); rk = __builtin_amdgcn_mfma_f32_16x16x32_bf16(r1f, kb1, rk, 0, 0, 0);
#pragma unroll
              for (int r = 0; r < 4; ++r) { const int t = 4 * q + r;
                  ((bf16*)(sl + O_AAK))[t * 16 + c16] = f2bf(c16 < t ? ak[r] : 0.f); ((bf16*)(sl + O_RB))[t * 16 + c16] = f2bf(c16 <= t ? rb[r] : 0.f); ((bf16*)(sl + O_RK))[t * 16 + c16] = f2bf(c16 <= t ? rk[r] : 0.f); }
          } }
        LDS_SYNC();
        if (wave < 4) { const int c16 = lane & 15, q = lane >> 4, vcol = 16 * wave + c16; u32x2 zz; zz.x = 0u; zz.y = 0u; const f32x4_t z4 = {0.f, 0.f, 0.f, 0.f};
#pragma unroll
            for (int ch = 0; ch < 4; ++ch) { const unsigned char* sl = lds + ch * SLOT;
                const bf16* at = (const bf16*)sl + c16 * 64 + 4 * q; const bf16* rt = (const bf16*)(sl + O_RT) + c16 * 64 + 4 * q;
                const bf16x8_t af0 = frag2(*(const u32x2*)at, *(const u32x2*)(at + 16)), af1 = frag2(*(const u32x2*)(at + 32), *(const u32x2*)(at + 48));
                const bf16x8_t rf0 = frag2(*(const u32x2*)rt, *(const u32x2*)(rt + 16)), rf1 = frag2(*(const u32x2*)(rt + 32), *(const u32x2*)(rt + 48));
                const u32x2 vq = *(const u32x2*)((const bf16*)(sl + O_VT) + vcol * 16 + 4 * q);
                const u32x2 aq = *(const u32x2*)((const bf16*)(sl + O_AAK) + c16 * 16 + 4 * q), tq = *(const u32x2*)((const bf16*)(sl + O_TM) + c16 * 16 + 4 * q);
                const u32x2 rbq = *(const u32x2*)((const bf16*)(sl + O_RB) + c16 * 16 + 4 * q), rkq = *(const u32x2*)((const bf16*)(sl + O_RK) + c16 * 16 + 4 * q);
                f32x4_t rhs = __builtin_amdgcn_mfma_f32_16x16x32_bf16(frag2(zz, aq), frag2(zz, vq), z4, 0, 0, 0); rhs = __builtin_amdgcn_mfma_f32_16x16x32_bf16(af0, Sf[0], rhs, 0, 0, 0);
                { const f32x4_t r2 = __builtin_amdgcn_mfma_f32_16x16x32_bf16(af1, Sf[1], z4, 0, 0, 0); rhs = rhs + r2; }
                u32x2 rl; rl.x = pk2(rhs[0], rhs[1]); rl.y = pk2(rhs[2], rhs[3]);
                const f32x4_t U = __builtin_amdgcn_mfma_f32_16x16x32_bf16(frag2(tq, zz), frag2(rl, zz), z4, 0, 0, 0);
                u32x2 ul; ul.x = pk2(U[0], U[1]); ul.y = pk2(U[2], U[3]); const bf16x8_t uv = frag2(ul, vq);
                f32x4_t y = __builtin_amdgcn_mfma_f32_16x16x32_bf16(rf0, Sf[0], z4, 0, 0, 0); y = __builtin_amdgcn_mfma_f32_16x16x32_bf16(rf1, Sf[1], y, 0, 0, 0);
                y = __builtin_amdgcn_mfma_f32_16x16x32_bf16(frag2(rbq, rkq), uv, y, 0, 0, 0);
#pragma unroll
                for (int r = 0; r < 4; ++r) Yb[(ch * 16 + 4 * q + r) * 64 + vcol] = y[r];
#pragma unroll
                for (int kt = 0; kt < 4; ++kt) { const f32x4 dl = *(const f32x4*)((const float*)(sl + O_DL) + 16 * kt + 4 * q);
                    const u32x2 bq = *(const u32x2*)((const bf16*)(sl + O_BHT) + (16 * kt + c16) * 16 + 4 * q), kq = *(const u32x2*)((const bf16*)(sl + O_KHT) + (16 * kt + c16) * 16 + 4 * q);
                    const f32x4_t cin = {Sd[kt][0] * dl.x, Sd[kt][1] * dl.y, Sd[kt][2] * dl.z, Sd[kt][3] * dl.w};
                    Sd[kt] = __builtin_amdgcn_mfma_f32_16x16x32_bf16(frag2(bq, kq), uv, cin, 0, 0, 0); }
#pragma unroll
                for (int s2 = 0; s2 < 2; ++s2) { u32x2 lo, hi; lo.x = pk2(Sd[2 * s2][0], Sd[2 * s2][1]); lo.y = pk2(Sd[2 * s2][2], Sd[2 * s2][3]); hi.x = pk2(Sd[2 * s2 + 1][0], Sd[2 * s2 + 1][1]); hi.y = pk2(Sd[2 * s2 + 1][2], Sd[2 * s2 + 1][3]); Sf[s2] = frag2(lo, hi); }
            } }
        LDS_SYNC();
        { const f32x4 y0 = *(const f32x4*)(Yb + pt * 64 + k8), y1 = *(const f32x4*)(Yb + pt * 64 + k8 + 4);
          const float mean = red8((y0.x + y0.y + y0.z + y0.w) + (y1.x + y1.y + y1.z + y1.w)) * (1.f / 64); const f32x4 d0 = y0 - mean, d1 = y1 - mean;
          const float rstd = 1.0f / sqrtf(red8((d0.x * d0.x + d0.y * d0.y + d0.z * d0.z + d0.w * d0.w) + (d1.x * d1.x + d1.y * d1.y + d1.z * d1.z + d1.w * d1.w)) * (1.f / 64) + GN_EPS);
          f32x4 g0, g1; pg8::unpack8(gkeep, g0, g1);
          const f32x4 o0 = (d0 * rstd * *(const f32x4*)(ct_ + 384 + k8) + *(const f32x4*)(ct_ + 448 + k8) + bo * v0) * g0, o1 = (d1 * rstd * *(const f32x4*)(ct_ + 384 + k8 + 4) + *(const f32x4*)(ct_ + 448 + k8 + 4) + bo * v1) * g1;
          *(u32x4*)(YC + (size_t)(c0 + pt) * 512) = pg8::pack8(o0, o1); }
    }
#undef RWKV_FETCH
}

__device__ __forceinline__ void s5_unit(KArgs C, int layer, int unit, unsigned char* lds) {
    const int tid = fresh_tid(), lane = tid & 63, wave = tid >> 6, bl = unit >> 5, g = unit & 31, c16 = lane & 15, q = lane >> 4, sg = wave & 3, th = wave >> 2, p = 16 * sg + c16;
    constexpr int SP = 136;
    float* us = (float*)lds; float* ends = us + 1024; bf16* St = (bf16*)(ends + 16 * 128);
    const bf16* U = WSP(const bf16, WS_U) + (size_t)bl * SEQ * 512 + g * 16;
    bf16* YD0 = WSP(bf16, WS_YD0) + (size_t)bl * SEQ * 512 + g * 16;
    const size_t wo = (layer & 1) ? WDELTA : 0;
    bf16x8_t bre, bim;
    { const float* bb = WSP(const float, WS_BBAR + wo) + ((size_t)g * 64 + p) * 32; u32x4 wr_, wi_;
      if (q < 2) { const float* b8 = bb + 16 * q; wr_.x = pk2(b8[0], b8[2]); wr_.y = pk2(b8[4], b8[6]); wr_.z = pk2(b8[8], b8[10]); wr_.w = pk2(b8[12], b8[14]);
                   wi_.x = pk2(b8[1], b8[3]); wi_.y = pk2(b8[5], b8[7]); wi_.z = pk2(b8[9], b8[11]); wi_.w = pk2(b8[13], b8[15]); }
      else { wr_ = (u32x4){0u, 0u, 0u, 0u}; wi_ = wr_; }
      bre = __builtin_bit_cast(bf16x8_t, wr_); bim = __builtin_bit_cast(bf16x8_t, wi_); }
    float apr[4], api[4];
    { const float ar = WSP(const float, WS_ABAR + wo)[(g * 64 + p) * 2], ai = WSP(const float, WS_ABAR + wo)[(g * 64 + p) * 2 + 1]; apr[0] = ar; api[0] = ai;
#pragma unroll
      for (int i = 1; i < 4; ++i) { apr[i] = apr[i - 1] * ar - api[i - 1] * ai; api[i] = apr[i - 1] * ai + api[i - 1] * ar; } }
    bf16x8_t cf[4];
    { const float* cre = C->in[I_S5CRE] + ((size_t)layer * 32 + g) * 1024 + c16 * 64; const float* cim = C->in[I_S5CIM] + ((size_t)layer * 32 + g) * 1024 + c16 * 64;
#pragma unroll
      for (int ks = 0; ks < 4; ++ks) { const int c0_ = 32 * ks + 8 * q; const float* src = c0_ < 64 ? cre + c0_ : cim + (c0_ - 64); const float sgn = c0_ < 64 ? 1.f : -1.f;
          u32x4 w; w.x = pk2(sgn * src[0], sgn * src[1]); w.y = pk2(sgn * src[2], sgn * src[3]); w.z = pk2(sgn * src[4], sgn * src[5]); w.w = pk2(sgn * src[6], sgn * src[7]); cf[ks] = __builtin_bit_cast(bf16x8_t, w); } }
    const float dj = C->in[I_S5D][layer * 512 + g * 16 + c16];
    float cr = 0.f, ci = 0.f;
    u32x2 fu; fu.x = 0u; fu.y = 0u;
#define S5_FETCH(c0_) do { if (tid < 256) fu = *(const u32x2*)(U + (size_t)((c0_) + (tid >> 2)) * 512 + (tid & 3) * 4); } while (0)
    S5_FETCH(0);
    for (int c0 = 0; c0 < SEQ; c0 += 64) {
        LDS_SYNC();
        if (tid < 256) *(f32x4*)(us + (tid >> 2) * 16 + (tid & 3) * 4) = (f32x4){lo_bf(fu.x), hi_bf(fu.x), lo_bf(fu.y), hi_bf(fu.y)};
        if (c0 + 64 < SEQ) S5_FETCH(c0 + 64);
        LDS_SYNC();
        float lr[2][4], li[2][4];
#pragma unroll
        for (int tt = 0; tt < 2; ++tt) { bf16x8_t af;
            if (q < 2) { const float* ur = us + (32 * th + 16 * tt + c16) * 16 + 8 * q; const f32x4 u0 = *(const f32x4*)ur, u1 = *(const f32x4*)(ur + 4);
                u32x4 w; w.x = pk2(u0.x, u0.y); w.y = pk2(u0.z, u0.w); w.z = pk2(u1.x, u1.y); w.w = pk2(u1.z, u1.w); af = __builtin_bit_cast(bf16x8_t, w); }
            else { const u32x4 z = {0u, 0u, 0u, 0u}; af = __builtin_bit_cast(bf16x8_t, z); }
            const f32x4_t z4 = {0.f, 0.f, 0.f, 0.f};
            const f32x4_t dre = __builtin_amdgcn_mfma_f32_16x16x32_bf16(af, bre, z4, 0, 0, 0), dim = __builtin_amdgcn_mfma_f32_16x16x32_bf16(af, bim, z4, 0, 0, 0);
            lr[tt][0] = dre[0]; li[tt][0] = dim[0];
#pragma unroll
            for (int r = 1; r < 4; ++r) { lr[tt][r] = apr[0] * lr[tt][r - 1] - api[0] * li[tt][r - 1] + dre[r]; li[tt][r] = apr[0] * li[tt][r - 1] + api[0] * lr[tt][r - 1] + dim[r]; }
            const int rho = (2 * th + tt) * 4 + q; ends[(rho * 64 + p) * 2] = lr[tt][3]; ends[(rho * 64 + p) * 2 + 1] = li[tt][3]; }
        LDS_SYNC();
        { float xr = cr, xi = ci; const int rho0 = (2 * th) * 4 + q;
          for (int rr = 0; rr < 16; ++rr) {
              if (rr == rho0 || rr == rho0 + 4) { const int tt = (rr == rho0) ? 0 : 1;
#pragma unroll
                  for (int r = 0; r < 4; ++r) { const float sr = lr[tt][r] + apr[r] * xr - api[r] * xi, si = li[tt][r] + apr[r] * xi + api[r] * xr; const int t = 32 * th + 16 * tt + 4 * q + r;
                      St[t * SP + p] = f2bf(sr); St[t * SP + 64 + p] = f2bf(si); } }
              const float er = ends[(rr * 64 + p) * 2], ei = ends[(rr * 64 + p) * 2 + 1]; const float nr = apr[3] * xr - api[3] * xi + er, ni = apr[3] * xi + api[3] * xr + ei; xr = nr; xi = ni; }
          cr = xr; ci = xi; }
        LDS_SYNC();
        if (wave < 4) { f32x4_t y = {0.f, 0.f, 0.f, 0.f};
#pragma unroll
            for (int ks = 0; ks < 4; ++ks) y = __builtin_amdgcn_mfma_f32_16x16x32_bf16(*(const bf16x8_t*)(St + (16 * wave + c16) * SP + 32 * ks + 8 * q), cf[ks], y, 0, 0, 0);
#pragma unroll
            for (int r = 0; r < 4; ++r) { const int t = 16 * wave + 4 * q + r; YD0[(size_t)(c0 + t) * 512 + c16] = f2bf(gelu_tanh(y[r] + dj * us[t * 16 + c16])); } }
    }
#undef S5_FETCH
}

__device__ __forceinline__ unsigned ord_key(float f) { const unsigned u = __float_as_uint(f); return (u & 0x80000000u) ? ~u : (u | 0x80000000u); }
__device__ __forceinline__ void dsa_vt_item(KArgs C, int item, int lane, bf16* scr) {
    const int tb = item % NK64, bh = item / NK64, h = bh & 7, bl = bh >> 3;
    const bf16* V = WSP(const bf16, WS_V) + ((size_t)bl * SEQ + tb * 64) * 512 + h * 64;
    WAVE_SYNC();
#pragma unroll
    for (int i = 0; i < 8; ++i) { const int tk = (lane >> 3) + 8 * i, c8 = (lane & 7) * 8; const u32x4 w = *(const u32x4*)(V + (size_t)tk * 512 + c8);
        unsigned* d = (unsigned*)(scr + tk * 66 + c8); d[0] = w.x; d[1] = w.y; d[2] = w.z; d[3] = w.w; }
    WAVE_SYNC();
    bf16* Vt = WSP(bf16, WS_VT) + ((size_t)bh * 64) * SEQ + tb * 64 + lane;
#pragma unroll 8
    for (int d = 0; d < 64; ++d) Vt[(size_t)d * SEQ] = scr[lane * 66 + d];
}
constexpr int IDX_CAP = 128, IDX_NBIN = 1024;
__device__ __forceinline__ void dsa_index_unit(KArgs C, int unit, int lane, int wave, unsigned char* lds) {
    const int oct = unit & 7, pairid = (unit >> 3) % (NK64 / 2), kx = (unit >> 3) / (NK64 / 2), bl = kx >> 1, c = (kx & 1) ? NK64 - 1 - pairid : pairid;
    const int t0 = c * 64 + oct * 8, nkeys = (c + 1) * 64, nk64 = c + 1; const size_t row0 = (size_t)bl * SEQ + t0;
    unsigned* mrow = WSP(unsigned, WS_MASK) + (row0 + wave) * MW;
    if (nkeys <= TOPK) { for (int w = lane; w < MW; w += 64) mrow[w] = (w * 32 < nkeys) ? 0xffffffffu : 0u; return; }
    float* scf = (float*)lds;
    unsigned* hist = (unsigned*)(lds + LDS_X) + wave * (IDX_NBIN / 2); unsigned* candv = (unsigned*)(lds + LDS_X + 8 * IDX_NBIN * 2) + wave * IDX_CAP; unsigned* candi = candv + 8 * IDX_CAP; unsigned* mword = (unsigned*)(lds + LDS_X + 8 * IDX_NBIN * 2 + 16 * IDX_CAP * 4) + wave * MW;
    const bf16* SMb = WSP(const bf16, WS_SM) + (size_t)bl * SEQ * 256;
    const int l31 = lane & 31, half = lane >> 5;
    const bf16* qa = SMb + (size_t)(t0 + (l31 >> 2)) * 256 + 8 + (l31 & 3) * 32 + 8 * half;
    const bf16x8_t a0 = *(const bf16x8_t*)qa, a1 = *(const bf16x8_t*)(qa + 16);
    u32x2 wraw[4];
#pragma unroll
    for (int g = 0; g < 4; ++g) wraw[g] = *(const u32x2*)(SMb + (size_t)(t0 + 2 * g + half) * 256 + 168);
    LDS_SYNC();
    {
      float wv[4][4];
#pragma unroll
      for (int g = 0; g < 4; ++g) { const u32x2 w = wraw[g]; wv[g][0] = lo_bf(w.x) * 0.5f; wv[g][1] = hi_bf(w.x) * 0.5f; wv[g][2] = lo_bf(w.y) * 0.5f; wv[g][3] = hi_bf(w.y) * 0.5f; }
      for (int kt0 = wave; kt0 < nk64 * 2; kt0 += 8 * NWAVES) {
          bf16x8_t b0[8], b1[8];
#pragma unroll
          for (int u4 = 0; u4 < 8; ++u4) { const int kt = kt0 + 8 * u4; const bf16* kb = WSP(const bf16, WS_KI) + ((size_t)bl * SEQ + (size_t)((kt < nk64 * 2 ? kt : wave) * 32 + l31)) * 32 + 8 * half;
              b0[u4] = *(const bf16x8_t*)kb; b1[u4] = *(const bf16x8_t*)(kb + 16); }
#pragma unroll
          for (int u4 = 0; u4 < 8; ++u4) { const int kt = kt0 + 8 * u4; if (kt < nk64 * 2) {
              f32x16 d;
#pragma unroll
              for (int r = 0; r < 16; ++r) d[r] = 0.f;
              d = __builtin_amdgcn_mfma_f32_32x32x16_bf16(a0, b0[u4], d, 0, 0, 0); d = __builtin_amdgcn_mfma_f32_32x32x16_bf16(a1, b1[u4], d, 0, 0, 0);
#pragma unroll
              for (int g = 0; g < 4; ++g) { float sc = 0.f;
#pragma unroll
                  for (int j = 0; j < 4; ++j) sc += wv[g][j] * fmaxf(d[4 * g + j] * 0.17677669529f, 0.f);
                  scf[(2 * g + half) * SEQ + kt * 32 + l31] = sc; } } }
      } }
    { const int tail0 = nkeys, tail1 = ((nk64 + 7) >> 3) * 512;
      for (int e = tail0 + (int)(threadIdx.x); e < tail1; e += NTHREADS) {
#pragma unroll
          for (int qq = 0; qq < 8; ++qq) scf[qq * SEQ + e] = -3.0e38f; } }
    LDS_SYNC();
    const float* sc = scf + wave * SEQ; constexpr float NEG = -3.0e38f; const int nb8 = (nk64 + 7) >> 3;
    float v[NK64];
#pragma unroll
    for (int ib = 0; ib < NK64 / 8; ++ib) if (ib < nb8) {
#pragma unroll
        for (int j = 0; j < 8; ++j) v[ib * 8 + j] = sc[(ib * 8 + j) * 64 + lane];
        SCHED_FENCE(); }
    float mn = INFINITY, mx = -INFINITY;
#pragma unroll
    for (int ib = 0; ib < NK64 / 8; ++ib) if (ib < nb8) {
#pragma unroll
        for (int j = 0; j < 8; ++j) { const float x = v[ib * 8 + j]; mx = fmaxf(mx, x); mn = fminf(mn, x == NEG ? INFINITY : x); } }
    mn = -wave_max(-mn); mx = wave_max(mx);
    const float scale = (mx > mn) ? ((float)(IDX_NBIN - 2) - 0.01f) / (mx - mn) : 0.f;
#pragma unroll
    for (int i = 0; i < IDX_NBIN / 128; ++i) hist[lane * (IDX_NBIN / 128) + i] = 0u;
    for (int w = lane; w < MW; w += 64) mword[w] = 0u;
    WAVE_SYNC();
#define IDX_BIN(x) ({ const float x_ = (x); int b_ = (int)(fmaxf(x_ - mn, 0.f) * scale + 1.0f); b_ = b_ > IDX_NBIN - 2 ? IDX_NBIN - 2 : b_; b_ + (__float_as_int(x_) >> 31) + (__float_as_int(x_) > 0 ? 1 : 0); })
#pragma unroll
    for (int ib = 0; ib < NK64 / 8; ++ib) if (ib < nb8) {
#pragma unroll
        for (int j = 0; j < 8; ++j) { const int b = IDX_BIN(v[ib * 8 + j]); atomicAdd(&hist[b >> 1], (b & 1) ? 0x10000u : 1u); v[ib * 8 + j] = __int_as_float(b); }
        SCHED_FENCE(); }
    WAVE_SYNC();
    int bstar, cgt;
    {
      unsigned hw[8]; int tot = 0;
#pragma unroll
      for (int i = 0; i < 8; ++i) { hw[i] = hist[lane * 8 + i]; tot += (int)(hw[i] & 0xffffu) + (int)(hw[i] >> 16); }
      int suf = tot;
#pragma unroll
      for (int o = 1; o < 64; o <<= 1) { const int t = __shfl_down(suf, o); if (lane + o < 64) suf += t; }
      const unsigned long long ge = __ballot(suf >= TOPK); const int L = 63 - __builtin_clzll(ge);
      int cum = __shfl(suf, L) - __shfl(tot, L); bstar = 16 * L; cgt = cum; bool found = false;
#pragma unroll
      for (int i = 7; i >= 0; --i) { const unsigned w = (unsigned)__shfl((int)hw[i], L); const int chi = (int)(w >> 16), clo = (int)(w & 0xffffu);
          if (!found && cum + chi >= TOPK) { bstar = 16 * L + 2 * i + 1; cgt = cum; found = true; } cum += found ? 0 : chi;
          if (!found && cum + clo >= TOPK) { bstar = 16 * L + 2 * i; cgt = cum; found = true; } cum += found ? 0 : clo; } }
    const int need = TOPK - cgt; int ncand = 0;
    const bool tiebin = bstar == IDX_BIN(0.0f);
    unsigned mylo = 0u, myhi = 0u;
#pragma unroll
    for (int ib = 0; ib < NK64 / 8; ++ib) if (ib < nb8) {
#pragma unroll
        for (int j = 0; j < 8; ++j) { const int i = ib * 8 + j; const int b = __float_as_int(v[i]);
            unsigned long long bs = __ballot(b > bstar); const unsigned long long bc = __ballot(b == bstar);
            if (bc != 0ull) {
                const int pos = ncand + (int)__builtin_amdgcn_mbcnt_hi((unsigned)(bc >> 32), __builtin_amdgcn_mbcnt_lo((unsigned)bc, 0u));
                if (tiebin) bs |= __ballot(b == bstar && pos < need);
                else if (b == bstar && pos < IDX_CAP) { candv[pos] = ord_key(sc[i * 64 + lane]); candi[pos] = (unsigned)(i * 64 + lane); }
                ncand += __popcll(bc); }
            if (lane == i) { mylo = (unsigned)bs; myhi = (unsigned)(bs >> 32); } }
        SCHED_FENCE(); }
    if (lane < nb8 * 8) { mword[2 * lane] = mylo; mword[2 * lane + 1] = myhi; }
#undef IDX_BIN
    WAVE_SYNC();
    if (tiebin) { }
    else if (ncand <= IDX_CAP) {
        for (int m = lane; m < ncand; m += 64) { const unsigned vm = candv[m]; int rank = 0;
#pragma unroll 4
            for (int j = 0; j < ncand; ++j) { const unsigned vj = candv[j]; rank += (vj > vm || (vj == vm && j < m)) ? 1 : 0; }
            if (rank < need) { const unsigned idx = candi[m]; atomicOr(&mword[idx >> 5], 1u << (idx & 31)); } }
    } else {
#pragma unroll
        for (int ib = 0; ib < NK64 / 8; ++ib) if (ib < nb8) {
#pragma unroll
            for (int j = 0; j < 8; ++j) v[ib * 8 + j] = sc[(ib * 8 + j) * 64 + lane]; }
        unsigned T = 0u;
        for (int bit = 31; bit >= 0; --bit) { const unsigned cand = T | (1u << bit); int cn = 0;
#pragma unroll
            for (int ib = 0; ib < NK64 / 8; ++ib) if (ib < nb8) {
#pragma unroll
                for (int j = 0; j < 8; ++j) cn += (ord_key(v[ib * 8 + j]) >= cand) ? 1 : 0; }
            if (wave_sum_i(cn) >= TOPK) T = cand; }
        int cg = 0;
#pragma unroll
        for (int ib = 0; ib < NK64 / 8; ++ib) if (ib < nb8) {
#pragma unroll
            for (int j = 0; j < 8; ++j) cg += (ord_key(v[ib * 8 + j]) > T) ? 1 : 0; }
        const int need2 = TOPK - wave_sum_i(cg); int taken = 0;
#pragma unroll
        for (int ib = 0; ib < NK64 / 8; ++ib) if (ib < nb8) {
#pragma unroll
            for (int j = 0; j < 8; ++j) { const int i = ib * 8 + j; const unsigned kv = ord_key(v[i]); const bool eq = kv == T; const unsigned long long be = __ballot(eq);
                const int pre = __popcll(be & ((1ull << lane) - 1ull)); const bool sel = (kv > T) || (eq && (taken + pre) < need2); taken += __popcll(be);
                const unsigned long long bs = __ballot(sel); if (lane == 0) { mword[2 * i] = (unsigned)bs; mword[2 * i + 1] = (unsigned)(bs >> 32); } } }
    }
    WAVE_SYNC();
#ifdef HOST_EMU
    if (lane == 0) { static int rows = 0, bad = 0, ties = 0, falls = 0; std::vector<int> id(nkeys); for (int i = 0; i < nkeys; ++i) id[i] = i;
        std::stable_sort(id.begin(), id.end(), [&](int a, int b) { return sc[a] > sc[b]; }); std::vector<unsigned> ref(MW, 0u); for (int i = 0; i < TOPK; ++i) ref[id[i] >> 5] |= 1u << (id[i] & 31);
        bool ok = true; for (int w = 0; w < MW; ++w) ok = ok && ref[w] == mword[w]; ++rows; bad += ok ? 0 : 1; ties += tiebin ? 1 : 0; falls += (!tiebin && ncand > IDX_CAP) ? 1 : 0;
        if ((rows & 63) == 0 || !ok) printf("[idx-check] rows %d bad %d tiebin %d fallback %d\n", rows, bad, ties, falls); }
#endif
    for (int w = lane; w < MW; w += 64) mrow[w] = mword[w];
}

constexpr int AT_KP = 72, AT_VP = 72, AT_BUF = 64 * AT_KP + 64 * AT_VP;
__device__ __forceinline__ void dsa_attn_half(KArgs C, int bl, int h, int cb, int tid, bf16* tiles, const float* btab) {
    const int lane = tid & 63, wave = tid >> 6, l31 = lane & 31, hh = lane >> 5, c = 4 * cb + (wave >> 1), qb = wave & 1, q0 = c * 64 + qb * 32, qpos = q0 + l31, q0s = __builtin_amdgcn_readfirstlane(q0);
    const size_t qrow = (size_t)bl * SEQ + qpos;
    const bf16* Qp = WSP(const bf16, WS_Q) + qrow * 512 + h * 64 + 8 * hh;
    const unsigned* Mp = WSP(const unsigned, WS_MASK) + qrow * MW;
    const bf16* gk = WSP(const bf16, WS_K) + ((size_t)bl * SEQ + (tid >> 3)) * 512 + h * 64 + (tid & 7) * 8;
    const bf16* gv = WSP(const bf16, WS_VT) + ((size_t)(bl * 8 + h) * 64 + (tid >> 3)) * SEQ + (tid & 7) * 8;
    const int lk = (tid >> 3) * AT_KP + (tid & 7) * 8, lv = 64 * AT_KP + (tid >> 3) * AT_VP + (tid & 7) * 8;
    constexpr float SC = 0.125f * 1.44269504089f;
    bf16x8_t qf[4];
#pragma unroll
    for (int s = 0; s < 4; ++s) qf[s] = *(const bf16x8_t*)(Qp + 16 * s);
    f32x16 O0, O1;
#pragma unroll
    for (int r = 0; r < 16; ++r) { O0[r] = 0.f; O1[r] = 0.f; }
    float m = -1e30f, lsum = 0.f;
    const int ntw = c + 1, nt = 4 * cb + 4;
    u32x4 prek = *(const u32x4*)gk, prev = *(const u32x4*)gv; u32x2 mwn = *(const u32x2*)Mp;
    LDS_SYNC();
    const float bfar = btab[0];
    *(u32x4*)(tiles + lk) = prek; *(u32x4*)(tiles + lv) = prev;
    if (nt > 1) { prek = *(const u32x4*)(gk + (size_t)64 * 512); prev = *(const u32x4*)(gv + 64); }
    for (int kt = 0; kt < nt; ++kt) {
        LDS_SYNC();
        const bf16* tb = tiles + (kt & 1) * AT_BUF; const u32x2 mw2 = mwn;
        if (kt + 1 < ntw) mwn = *(const u32x2*)(Mp + 2 * (kt + 1));
        if (kt < ntw) {
            f32x16 S[2];
#pragma unroll
            for (int t2 = 0; t2 < 2; ++t2) {
#pragma unroll
                for (int r = 0; r < 16; ++r) S[t2][r] = 0.f;
#pragma unroll
                for (int s = 0; s < 4; ++s) S[t2] = __builtin_amdgcn_mfma_f32_32x32x16_bf16(*(const bf16x8_t*)(tb + (t2 * 32 + l31) * AT_KP + 16 * s + 8 * hh), qf[s], S[t2], 0, 0, 0); }
#define AT_P2(P_, X0_, X1_, MW_, R_, ROW_) do { f32x2 pp_; pp_.x = __uint_as_float(__float_as_uint(__builtin_amdgcn_exp2f(X0_)) & bit_fill<ROW_>(MW_)); \
                pp_.y = __uint_as_float(__float_as_uint(__builtin_amdgcn_exp2f(X1_)) & bit_fill<ROW_ + 1>(MW_)); P_[R_] = pp_.x; P_[R_ + 1] = pp_.y; ps2 += pp_; } while (0)
#define AT_RESCALE(TM_) do { float tm_ = (TM_); tm_ = fmaxf(tm_, __shfl_xor(tm_, 32)); \
                if (__ballot(tm_ > m) != 0ull) { const float mn = fmaxf(m, tm_), alpha = __builtin_amdgcn_exp2f(m - mn); m = mn; lsum *= alpha; \
                    _Pragma("unroll") for (int r = 0; r < 16; ++r) { O0[r] *= alpha; O1[r] *= alpha; } } } while (0)
            f32x16 P[2]; f32x2 ps2 = (f32x2){0.f, 0.f}; float tm;
            const unsigned mwc0 = mw2.x >> (4 * hh), mwc1 = mw2.y >> (4 * hh);
            const bool far = (kt * 64 + 63 - q0s) <= -166;
            if (far) { float rm = fmaxf(S[0][0], S[1][0]);
#pragma unroll
                for (int r = 1; r < 16; ++r) rm = fmaxf(fmaxf(rm, S[0][r]), S[1][r]);
                tm = rm * SC + bfar;
            } else { tm = -1e30f;
#pragma unroll
                for (int t2 = 0; t2 < 2; ++t2) { const int rb = kt * 64 + t2 * 32 + 4 * hh - qpos + 256;
#pragma unroll
                    for (int r = 0; r < 16; ++r) { const int row = (r & 3) + 8 * (r >> 2); int ti = rb + row; ti = ti < 0 ? 0 : ti; tm = fmaxf(tm, S[t2][r] * SC + btab[ti]); } } }
            AT_RESCALE(tm);
            if (far) { const float ad = bfar - m;
#define AT_FAR(R_, ROW_) do { const f32x2 x0_ = (f32x2){S[0][R_], S[0][R_ + 1]} * SC + ad, x1_ = (f32x2){S[1][R_], S[1][R_ + 1]} * SC + ad; \
                    AT_P2(P[0], x0_.x, x0_.y, mwc0, R_, ROW_); AT_P2(P[1], x1_.x, x1_.y, mwc1, R_, ROW_); } while (0)
                AT_FAR(0, 0); AT_FAR(2, 2); AT_FAR(4, 8); AT_FAR(6, 10); AT_FAR(8, 16); AT_FAR(10, 18); AT_FAR(12, 24); AT_FAR(14, 26);
#undef AT_FAR
            } else {
#define AT_BIAS(T2_, R_, ROW_) (S[T2_][R_] * SC + (btab[imax0(kt * 64 + (T2_) * 32 + 4 * hh - qpos + 256 + (ROW_))] - m))
#define AT_NEAR(R_, ROW_) do { AT_P2(P[0], AT_BIAS(0, R_, ROW_), AT_BIAS(0, R_ + 1, ROW_ + 1), mwc0, R_, ROW_); AT_P2(P[1], AT_BIAS(1, R_, ROW_), AT_BIAS(1, R_ + 1, ROW_ + 1), mwc1, R_, ROW_); } while (0)
                AT_NEAR(0, 0); AT_NEAR(2, 2); AT_NEAR(4, 8); AT_NEAR(6, 10); AT_NEAR(8, 16); AT_NEAR(10, 18); AT_NEAR(12, 24); AT_NEAR(14, 26);
#undef AT_BIAS
#undef AT_NEAR
            }
#undef AT_P2
#undef AT_RESCALE
            const float ps = ps2.x + ps2.y;
            lsum += ps;
#pragma unroll
            for (int t2 = 0; t2 < 2; ++t2) { const bf16* vb = tb + 64 * AT_KP + l31 * AT_VP + t2 * 32 + 4 * hh;
#pragma unroll
                for (int s = 0; s < 2; ++s) { u32x4 w; w.x = pk2(P[t2][8 * s + 0], P[t2][8 * s + 1]); w.y = pk2(P[t2][8 * s + 2], P[t2][8 * s + 3]); w.z = pk2(P[t2][8 * s + 4], P[t2][8 * s + 5]); w.w = pk2(P[t2][8 * s + 6], P[t2][8 * s + 7]);
                    const bf16x8_t pf = __builtin_bit_cast(bf16x8_t, w);
                    O0 = __builtin_amdgcn_mfma_f32_32x32x16_bf16(frag2(*(const u32x2*)(vb + 16 * s), *(const u32x2*)(vb + 16 * s + 8)), pf, O0, 0, 0, 0);
                    O1 = __builtin_amdgcn_mfma_f32_32x32x16_bf16(frag2(*(const u32x2*)(vb + 32 * AT_VP + 16 * s), *(const u32x2*)(vb + 32 * AT_VP + 16 * s + 8)), pf, O1, 0, 0, 0); } }
        }
        if (kt + 1 < nt) { bf16* nb = tiles + ((kt + 1) & 1) * AT_BUF; *(u32x4*)(nb + lk) = prek; *(u32x4*)(nb + lv) = prev;
            if (kt + 2 < nt) { prek = *(const u32x4*)(gk + (size_t)(kt + 2) * 64 * 512); prev = *(const u32x4*)(gv + (size_t)(kt + 2) * 64); } }
    }
    lsum += __shfl_xor(lsum, 32);
    const float inv = 1.0f / lsum;
    bf16* Y = WSP(bf16, WS_Y) + (size_t)MG * 512 + qrow * 512 + h * 64 + 4 * hh;
#pragma unroll
    for (int g = 0; g < 4; ++g) { u32x2 w; w.x = pk2(O0[4 * g] * inv, O0[4 * g + 1] * inv); w.y = pk2(O0[4 * g + 2] * inv, O0[4 * g + 3] * inv); *(u32x2*)(Y + 8 * g) = w;
        u32x2 w2; w2.x = pk2(O1[4 * g] * inv, O1[4 * g + 1] * inv); w2.y = pk2(O1[4 * g + 2] * inv, O1[4 * g + 3] * inv); *(u32x2*)(Y + 32 + 8 * g) = w2; }
}
__device__ __forceinline__ void dsa_attn_unit3(KArgs C, int unit, int tid, unsigned char* lds) {
    constexpr int NPAIR = NK64 / 8;
    const int pr = unit % NPAIR, h = (unit / NPAIR) & 7, bl = unit / (NPAIR * 8);
    float* btab = (float*)lds; bf16* tiles = (bf16*)(lds + 2048);
    __syncthreads();
    { const int* tab = WSP(const int, WS_TAB); const float* relb = C->in[I_RELB];
      if (tid < 320) btab[tid] = relb[tab[tid - 256 + SEQ - 1] * 8 + h] * 1.44269504089f; }
    dsa_attn_half(C, bl, h, pr, tid, tiles, btab);
    dsa_attn_half(C, bl, h, NK64 / 4 - 1 - pr, tid, tiles, btab);
}
#ifndef GP_ALIGN
#define GP_ALIGN true
#endif
#ifndef GP_SP2
#define GP_SP2 true
#endif
constexpr int SEGS_PER_GROUP = 11, NSEG = DEPTH * (1 + NGRP * SEGS_PER_GROUP) + 1;

#ifdef HOST_EMU
#define GRID_BARRIER() emu_grid_sync()
#define LDS_PTR(p) ((unsigned char*)(p))
#else
#define GRID_BARRIER() do { XcdBarrier b_; b_.bar = (unsigned*)(Ck->ws + WS_CTL); b_.x = xb_xcc_id(); b_.st = (volatile LAS unsigned*)(lds + LDS_CTL_OFF); xcd_barrier(b_); } while (0)
#define LDS_PTR(p) ((PG8_LAS unsigned char*)(p))
#endif

__global__ void __launch_bounds__(NTHREADS, 2) fwd_kernel(Args a) {
#ifdef HOST_EMU
    unsigned char* lds = emu_lds;
#else
    extern __shared__ __attribute__((aligned(16))) unsigned char lds[];
#endif
#ifdef HOST_EMU
    KArgs Ck = &a;
#else
    KArgs Ck = (KArgs)__builtin_amdgcn_kernarg_segment_ptr();
    (void)a;
#endif
#ifndef HOST_EMU
    if (threadIdx.x < 4) ((LAS unsigned*)(lds + LDS_CTL_OFF))[threadIdx.x] = 0u;
    __syncthreads();
    if (Ck->seg_hi - Ck->seg_lo > 1) (void)xcd_barrier_post((unsigned*)(Ck->ws + WS_CTL), (volatile LAS unsigned*)(lds + LDS_CTL_OFF));
#endif
#define SEGID 0
#define RUN (SEGID >= Ck->seg_lo && SEGID < Ck->seg_hi)
#define SEAM do { if (SEGID >= Ck->seg_lo && SEGID + 1 < Ck->seg_hi) { GRID_BARRIER(); } } while (0)
#define WO ((layer & 1) ? WDELTA : (size_t)0)
#define PHASE_VARS KArgs C = KLAUNDER(Ck); const int G = gridDim.x, bx = blockIdx.x, ngw = G * NWAVES; (void)ngw; const int tid = fresh_tid(), lane = tid & 63, wave = __builtin_amdgcn_readfirstlane(tid >> 6), gw = bx * NWAVES + wave; (void)lane; (void)gw; (void)C
    for (int layer = 0; layer < DEPTH; ++layer) {
#undef SEGID
#define SEGID (layer * (1 + NGRP * SEGS_PER_GROUP))
        if (RUN) { PHASE_VARS; phase_weights(C, layer, lds, gw, ngw, lane, wave); }
        SEAM;
        for (int grp = 0; grp < NGRP; ++grp) {
#define XIN ((layer == 0 ? C->in[I_X] : (const float*)C->out) + (size_t)grp * MG * D)
#define XOUT (C->out + (size_t)grp * MG * D)
#undef SEGID
#define SEGID (layer * (1 + NGRP * SEGS_PER_GROUP) + 1 + grp * SEGS_PER_GROUP + 0)
            if (RUN) { PHASE_VARS; for (int m = gw; m < MG; m += 2 * ngw) { if (m + ngw < MG) rms_rowN_bf16<2>(XIN + (size_t)m * D, C->in[I_NMIX] + layer * D, WSP(bf16, WS_H) + (size_t)m * D, (size_t)ngw * D, lane); else rms_row_bf16(XIN + (size_t)m * D, C->in[I_NMIX] + layer * D, WSP(bf16, WS_H) + (size_t)m * D, lane); } }
            SEAM;
#undef SEGID
#define SEGID (layer * (1 + NGRP * SEGS_PER_GROUP) + 1 + grp * SEGS_PER_GROUP + 1)
            if (RUN) { PHASE_VARS; pg8::Gemm g{WSP(const bf16, WS_H), WSP(const bf16, WS_WIN + WO), MG, NMIXC, D}; pg8::StaticOrder S; S.init(MG, NMIXC, G, bx);
                pg8::EpiProj E{C->ws};
                pg8::gemm_phase<pg8::EpiProj, pg8::StaticOrder, false, GP_ALIGN, GP_SP2>(LDS_PTR(lds), g, S, E, nullptr); }
            SEAM;
#undef SEGID
#define SEGID (layer * (1 + NGRP * SEGS_PER_GROUP) + 1 + grp * SEGS_PER_GROUP + 2)
            if (RUN) { PHASE_VARS;
                for (int m = gw; m < MG; m += 2 * ngw) { if (m + ngw < MG) rwkv_prep_row2(C, layer, m, ngw, lane); else rwkv_prep_row(C, layer, m, lane); }
                for (int m8 = gw; m8 < MG / 8; m8 += ngw) ssd_conv_rows8(C, layer, m8 * 8, lane);
                for (int it = gw; it < NB * 8 * NK64; it += ngw) dsa_vt_item(C, it, lane, (bf16*)(lds + wave * 16384));
                __syncthreads();
                for (int u = bx; u < NB * NK64 * 8; u += G) dsa_index_unit(C, u, lane, wave, lds);
            }
            SEAM;
#undef SEGID
#define SEGID (layer * (1 + NGRP * SEGS_PER_GROUP) + 1 + grp * SEGS_PER_GROUP + 3)
            if (RUN) { PHASE_VARS; pg8::Gemm g{WSP(const bf16, WS_RA), WSP(const bf16, WS_WLORA + WO), MG, 1536, 256}; pg8::StaticOrder S; S.init(MG, 1536, G, bx);
                pg8::EpiLora E{WSP(float, WS_WLOG), WSP(bf16, WS_ASIG), WSP(bf16, WS_GG), C->in[I_W0] + layer * 512, C->in[I_A0] + layer * 512};
                pg8::gemm_phase<pg8::EpiLora, pg8::StaticOrder, false, GP_ALIGN, GP_SP2>(LDS_PTR(lds), g, S, E, nullptr); }
            SEAM;
#undef SEGID
#define SEGID (layer * (1 + NGRP * SEGS_PER_GROUP) + 1 + grp * SEGS_PER_GROUP + 4)
            if (RUN) { PHASE_VARS;
                constexpr int U_R = NB * 8, U_S = U_R + NB * 8;
                for (int u = bx; u < U_R; u += G) rwkv_unit(C, layer, u, lds);
                for (int u = (bx + G - U_R % G) % G; u < NB * 8; u += G) ssd_unit(C, layer, u, lds);
                { const int first = U_S % G, span = G - first;
                  if (bx >= first) for (int u = bx - first; u < NB * 32; u += span) s5_unit(C, layer, u, lds); }
                for (;;) {
                    const int t2 = fresh_tid();
                    volatile unsigned* qs2 = (volatile unsigned*)(lds + LDS_CTL_OFF + 32);
                    __syncthreads();
                    if (t2 == 0) *qs2 = atomicAdd((unsigned*)(Ck->ws + WS_QCTR) + ((layer * NGRP + grp) * 2) * 64, 1u);
                    __syncthreads();
                    const int u = (int)*qs2;
                    if (u >= NB * NK64) break;
                    dsa_attn_unit3(KLAUNDER(Ck), u, t2, lds);
                }
            }
            SEAM;
#undef SEGID
#define SEGID (layer * (1 + NGRP * SEGS_PER_GROUP) + 1 + grp * SEGS_PER_GROUP + 5)
            if (RUN) { PHASE_VARS;
                { pg8::Gemm g{WSP(const bf16, WS_H), WSP(const bf16, WS_WIN + WO) + (size_t)NMIXC * D, MG, 4096, D}; pg8::StaticOrder S; S.init(MG, 4096, G, bx);
                  pg8::EpiGate E{WSP(bf16, WS_G)}; pg8::gemm_phase<pg8::EpiGate, pg8::StaticOrder, false, GP_ALIGN, GP_SP2>(LDS_PTR(lds), g, S, E, nullptr); }
                { pg8::Gemm g{WSP(const bf16, WS_YD0), WSP(const bf16, WS_GLU + WO), MG, 512, 512}; pg8::StaticOrder S; S.init(MG, 512, G, bx);
                  pg8::EpiGlu E{WSP(const bf16, WS_YD0), WSP(bf16, WS_Y) + (size_t)3 * MG * 512, C->in[I_GLUB] + layer * 512};
                  pg8::gemm_phase<pg8::EpiGlu, pg8::StaticOrder, false, GP_ALIGN, GP_SP2>(LDS_PTR(lds), g, S, E, nullptr); }
                for (int it = gw; it < MG * 2; it += 4 * ngw) ssd_norm_item4(C, layer, it, ngw, MG * 2, lane);
            }
            SEAM;
#undef SEGID
#define SEGID (layer * (1 + NGRP * SEGS_PER_GROUP) + 1 + grp * SEGS_PER_GROUP + 6)
            if (RUN) { PHASE_VARS; pg8::Gemm g{WSP(const bf16, WS_Y), WSP(const bf16, WS_WB + WO), 4 * MG, 4096, 512}; pg8::MergeOrder S{G, bx};
                pg8::EpiMerge E{WSP(const bf16, WS_G), WSP(bf16, WS_MRG)};
                pg8::gemm_phase<pg8::EpiMerge, pg8::MergeOrder, false, GP_ALIGN, GP_SP2>(LDS_PTR(lds), g, S, E, nullptr); }
            SEAM;
#undef SEGID
#define SEGID (layer * (1 + NGRP * SEGS_PER_GROUP) + 1 + grp * SEGS_PER_GROUP + 7)
            if (RUN) { PHASE_VARS; pg8::Gemm g{WSP(const bf16, WS_MRG), WSP(const bf16, WS_WOUT + WO), MG, D, D}; pg8::StaticOrder S; S.init(MG, D, G, bx);
                pg8::EpiResid E{XIN, XOUT}; pg8::gemm_phase<pg8::EpiResid, pg8::StaticOrder, false, GP_ALIGN, GP_SP2>(LDS_PTR(lds), g, S, E, nullptr); }
            SEAM;
#undef SEGID
#define SEGID (layer * (1 + NGRP * SEGS_PER_GROUP) + 1 + grp * SEGS_PER_GROUP + 8)
            if (RUN) { PHASE_VARS; for (int m = gw; m < MG; m += 2 * ngw) { if (m + ngw < MG) rms_rowN_bf16<2>(XOUT + (size_t)m * D, C->in[I_NFFN] + layer * D, WSP(bf16, WS_H) + (size_t)m * D, (size_t)ngw * D, lane); else rms_row_bf16(XOUT + (size_t)m * D, C->in[I_NFFN] + layer * D, WSP(bf16, WS_H) + (size_t)m * D, lane); } }
            SEAM;
#undef SEGID
#define SEGID (layer * (1 + NGRP * SEGS_PER_GROUP) + 1 + grp * SEGS_PER_GROUP + 9)
            if (RUN) { PHASE_VARS; pg8::Gemm g{WSP(const bf16, WS_H), WSP(const bf16, WS_W13 + WO), MG, 5632, D}; pg8::StaticOrder S; S.init(MG, 5632, G, bx);
                pg8::EpiSwiglu E{WSP(bf16, WS_HID)};
                pg8::gemm_phase<pg8::EpiSwiglu, pg8::StaticOrder, false, GP_ALIGN, GP_SP2>(LDS_PTR(lds), g, S, E, nullptr); }
            SEAM;
#undef SEGID
#define SEGID (layer * (1 + NGRP * SEGS_PER_GROUP) + 1 + grp * SEGS_PER_GROUP + 10)
            if (RUN) { PHASE_VARS; pg8::Gemm g{WSP(const bf16, WS_HID), WSP(const bf16, WS_W2 + WO), MG, D, FFN}; pg8::StaticOrder S; S.init(MG, D, G, bx);
                pg8::EpiResid E{XOUT, XOUT}; pg8::gemm_phase<pg8::EpiResid, pg8::StaticOrder, false, GP_ALIGN, GP_SP2>(LDS_PTR(lds), g, S, E, nullptr); }
            SEAM;
        }
    }
#undef SEGID
#define SEGID (NSEG - 1)
    { const int layer = 0; (void)layer;
    if (RUN) { PHASE_VARS; for (int m = gw; m < M; m += 2 * ngw) { if (m + ngw < M) rms_row2_f32(C->out + (size_t)m * D, (size_t)ngw * D, C->in[I_NFIN], lane); else rms_row_f32(C->out + (size_t)m * D, C->in[I_NFIN], lane); } } }
#undef RUN
#undef SEAM
}

extern "C" void kernel_launch(void* const* d_in, const int* in_sizes, int n_in, void* d_out, int out_size, void* d_ws, size_t ws_size, hipStream_t stream) {
    static int grid = 0;
    if (grid == 0) {
        if (n_in != N_IN || out_size != M * D || ws_size < WS_END) { fprintf(stderr, "kernel_launch: unexpected shapes (n_in %d, out %d, ws %zu < %zu)\n", n_in, out_size, ws_size, (size_t)WS_END); grid = -1; return; }
        int dev = 0, cus = 0;
        if (hipGetDevice(&dev) != hipSuccess || hipDeviceGetAttribute(&cus, hipDeviceAttributeMultiprocessorCount, dev) != hipSuccess || cus < 1) { grid = -1; return; }
        if (hipFuncSetAttribute((const void*)fwd_kernel, hipFuncAttributeMaxDynamicSharedMemorySize, LDS_BYTES) != hipSuccess) { fprintf(stderr, "kernel_launch: hipFuncSetAttribute failed\n"); grid = -1; return; }
        (void)hipGetLastError();
        grid = cus;
    }
    if (grid < 0) return;
    (void)hipMemsetAsync((char*)d_ws + WS_CTL, 0, CTL_BYTES, stream);
    Args a{};
    for (int i = 0; i < N_IN; ++i) a.in[i] = (const float*)d_in[i];
    a.out = (float*)d_out; a.ws = (unsigned char*)d_ws;
#if CFG_LAUNCHES == 1
    a.seg_lo = 0; a.seg_hi = NSEG;
    hipLaunchKernelGGL(fwd_kernel, dim3(grid), dim3(NTHREADS), LDS_BYTES, stream, a);
#else
    for (int s = 0; s < NSEG; ++s) { a.seg_lo = s; a.seg_hi = s + 1; hipLaunchKernelGGL(fwd_kernel, dim3(grid), dim3(NTHREADS), LDS_BYTES, stream, a); }
#endif
}
```

```cpp
#ifdef HOST_EMU
#error "HOST_EMU is a host-only debug build"
#else
#include <hip/hip_runtime.h>
#endif
#include <cstdio>
#include <cstdint>
#include <cmath>

#ifndef CFG_BATCH
#define CFG_BATCH 16
#endif
#ifndef CFG_SEQ
#define CFG_SEQ 4096
#endif
#ifndef CFG_DEPTH
#define CFG_DEPTH 4
#endif
#ifndef CFG_NB
#define CFG_NB 8
#endif
#ifndef CFG_LAUNCHES
#define CFG_LAUNCHES 1
#endif

typedef unsigned short bf16;
typedef float f32x4 __attribute__((ext_vector_type(4)));
typedef float f32x2 __attribute__((ext_vector_type(2)));
typedef unsigned u32x4 __attribute__((ext_vector_type(4)));
typedef unsigned u32x2 __attribute__((ext_vector_type(2)));

constexpr int BATCH = CFG_BATCH, SEQ = CFG_SEQ, DEPTH = CFG_DEPTH, NB = CFG_NB;
constexpr int D = 1024, M = BATCH * SEQ, MG = NB * SEQ, NGRP = BATCH / NB;
constexpr int IN_COLS = 9388, NPROJ = 9472, NMIXC = 5376, FFN = 2816;
constexpr int TOPK = (SEQ / 4) < 256 ? (SEQ / 4) : 256;
constexpr int NK64 = SEQ / 64, MW = SEQ / 32;
constexpr float RMS_EPS = 1e-6f, GN_EPS = 64e-5f;
static_assert(BATCH % NB == 0 && MG % 256 == 0 && SEQ % 64 == 0, "shape");

enum { I_X = 0, I_RELB, I_NMIX, I_WIN, I_CONVW, I_CONVB, I_DTB, I_ALOG, I_SSDD, I_SSDNG, I_MU, I_W0, I_W2, I_A0, I_A2, I_G2, I_KK, I_KA, I_RK, I_LNG, I_LNB,
       I_S5ARE, I_S5AIM, I_S5BRE, I_S5BIM, I_S5CRE, I_S5CIM, I_S5D, I_S5LDT, I_GLUW, I_GLUB, I_WBR, I_WOUT, I_NFFN, I_W1, I_W3, I_W2F, I_NFIN, N_IN };

constexpr size_t MiB = 1u << 20;
constexpr size_t al256(size_t x) { return (x + 255) & ~(size_t)255; }
constexpr size_t WS_CTL = 0, CTL_BYTES = 64 * 1024;
constexpr size_t WS_TAB = WS_CTL + CTL_BYTES;
constexpr size_t WS_ABAR = al256(WS_TAB + (SEQ + 64) * 4);
constexpr size_t WS_BBAR = WS_ABAR + 32 * 64 * 2 * 4;
constexpr size_t WS_WIN = al256(WS_BBAR + 32 * 64 * 16 * 2 * 4);
constexpr size_t WS_WB = WS_WIN + (size_t)NPROJ * 1024 * 2;
constexpr size_t WS_WOUT = WS_WB + (size_t)4 * 1024 * 512 * 2;
constexpr size_t WS_W13 = WS_WOUT + (size_t)1024 * 1024 * 2;
constexpr size_t WS_W2 = WS_W13 + (size_t)5632 * 1024 * 2;
constexpr size_t WS_GLU = WS_W2 + (size_t)1024 * 2816 * 2;
constexpr size_t WS_WLORA = WS_GLU + (size_t)512 * 512 * 2;
constexpr size_t WS_H = al256(WS_WLORA + (size_t)1536 * 256 * 2);
constexpr size_t WS_Z = WS_H + (size_t)MG * 1024 * 2;
constexpr size_t WS_XBC = WS_Z + (size_t)MG * 512 * 2;
constexpr size_t WS_Q = WS_XBC + (size_t)MG * 768 * 2;
constexpr size_t WS_K = WS_Q + (size_t)MG * 512 * 2;
constexpr size_t WS_V = WS_K + (size_t)MG * 512 * 2;
constexpr size_t WS_RW = WS_V + (size_t)MG * 512 * 2;
constexpr size_t WS_U = WS_RW + (size_t)MG * 1792 * 2;
constexpr size_t WS_SM = WS_U + (size_t)MG * 512 * 2;
constexpr size_t WS_G = WS_Q;
constexpr size_t WS_Y = WS_SM + (size_t)MG * 256 * 2;
constexpr size_t WS_YD0 = WS_Y + (size_t)4 * MG * 512 * 2;
constexpr size_t WS_MRG = WS_YD0 + (size_t)MG * 512 * 2;
constexpr size_t WS_MASK = WS_MRG + (size_t)MG * 1024 * 2;
constexpr size_t WS_RA = WS_MASK + (size_t)MG * MW * 4;
constexpr size_t WS_WLOG = WS_RA + (size_t)MG * 256 * 2;
constexpr size_t WS_ASIG = WS_WLOG + (size_t)MG * 512 * 4;
constexpr size_t WS_GG = WS_ASIG + (size_t)MG * 512 * 2;
constexpr size_t WS_XBA = WS_GG + (size_t)MG * 512 * 2;
constexpr size_t WS_VT = WS_XBA + (size_t)MG * 768 * 2;
constexpr size_t WS_KI = WS_VT + (size_t)MG * 512 * 2;
constexpr size_t WS_QCTR = 16384;
constexpr size_t WS_HID = WS_G;
constexpr size_t WS_WALT = al256(WS_KI + (size_t)MG * 32 * 2);
constexpr size_t WDELTA = WS_WALT - WS_ABAR;
constexpr size_t WS_END = WS_WALT + (WS_H - WS_ABAR);
static_assert(WS_SM + (size_t)MG * 256 * 2 - WS_Q == (size_t)MG * 4096 * 2, "G overlays exactly Q..SM");
static_assert((size_t)MG * 2816 * 2 <= (size_t)MG * 4096 * 2, "HID fits in G");

constexpr int LDS_SCRATCH = 131072;
constexpr int LDS_CTL_OFF = LDS_SCRATCH;
constexpr int LDS_X = LDS_SCRATCH + 64;
constexpr int LDS_BYTES = 161792;
constexpr int NTHREADS = 512, NWAVES = 8;

__device__ __forceinline__ float bf2f(bf16 v) { return __uint_as_float(((unsigned)v) << 16); }
#ifdef HOST_EMU
__device__ __forceinline__ bf16 f2bf(float f) { unsigned u = __float_as_uint(f); u += 0x7fffu + ((u >> 16) & 1u); return (bf16)(u >> 16); }
#else
__device__ __forceinline__ bf16 f2bf(float f) { return __builtin_bit_cast(bf16, (__bf16)f); }
#endif
#ifdef HOST_EMU
__device__ __forceinline__ unsigned pk2(float lo, float hi) { return (unsigned)f2bf(lo) | ((unsigned)f2bf(hi) << 16); }
#else
typedef __bf16 bf16x2_hw __attribute__((ext_vector_type(2)));
__device__ __forceinline__ unsigned pk2(float lo, float hi) { const f32x2 v = {lo, hi}; return __builtin_bit_cast(unsigned, __builtin_convertvector(v, bf16x2_hw)); }
#endif
__device__ __forceinline__ float lo_bf(unsigned w) { return __uint_as_float(w << 16); }
__device__ __forceinline__ float hi_bf(unsigned w) { return __uint_as_float(w & 0xffff0000u); }
#ifndef HOST_EMU
__device__ __forceinline__ float sigm(float x) { return __builtin_amdgcn_rcpf(1.0f + __expf(-x)); }
#else
__device__ __forceinline__ float sigm(float x) { return 1.0f / (1.0f + __expf(-x)); }
#endif
#ifndef HOST_EMU
template <int BIT> __device__ __forceinline__ unsigned bit_fill(unsigned w) { unsigned r; asm("v_bfe_i32 %0, %1, %2, 1" : "=v"(r) : "v"(w), "n"(BIT)); return r; }
#else
template <int BIT> __device__ __forceinline__ unsigned bit_fill(unsigned w) { return ((w >> BIT) & 1u) ? 0xffffffffu : 0u; }
#endif
__device__ __forceinline__ int imax0(int v) { return v < 0 ? 0 : v; }
__device__ __forceinline__ float tanh_fast(float x) { return 2.0f * sigm(2.0f * x) - 1.0f; }
__device__ __forceinline__ float softplusf(float x) { return x > 20.f ? x : log1pf(__expf(x)); }
__device__ __forceinline__ float gelu_tanh(float x) { const float u = 0.7978845608f * (x + 0.044715f * x * x * x); return x * sigm(2.0f * u); }
__device__ __forceinline__ float wave_sum(float v) {
#pragma unroll
    for (int o = 1; o < 64; o <<= 1) v += __shfl_xor(v, o);
    return v;
}
__device__ __forceinline__ float wave_max(float v) {
#pragma unroll
    for (int o = 1; o < 64; o <<= 1) v = fmaxf(v, __shfl_xor(v, o));
    return v;
}
__device__ __forceinline__ int wave_sum_i(int v) {
#pragma unroll
    for (int o = 1; o < 64; o <<= 1) v += __shfl_xor(v, o);
    return v;
}
#ifdef HOST_EMU
#define WAVE_SYNC() (void)emu_wave_exchange(0)
#define SCHED_FENCE() do {} while (0)
#define LDS_SYNC() __syncthreads()
#else
#define WAVE_SYNC() __builtin_amdgcn_wave_barrier()
#define SCHED_FENCE() __builtin_amdgcn_sched_barrier(0)
#define LDS_SYNC() do { asm volatile("s_waitcnt lgkmcnt(0)" ::: "memory"); __builtin_amdgcn_s_barrier(); asm volatile("" ::: "memory"); } while (0)
#endif
#ifndef HOST_EMU
namespace pg8 {
__device__ __forceinline__ int pg8_fresh_tid() { int t = (int)threadIdx.x; asm volatile("" : "+v"(t)); return t; }
#define PG8_LAS __attribute__((address_space(3)))
typedef unsigned short bf16_t;
typedef short bf16x8 __attribute__((ext_vector_type(8)));
typedef float f32x4 __attribute__((ext_vector_type(4)));
typedef unsigned u32x4 __attribute__((ext_vector_type(4)));
constexpr int BM = 256, BK = 64, HALF = 128, HTB = HALF * BK * 2  , STAGE_BYTES = 8 * HTB, NXCD = 8, WGM = 8;

__host__ __device__ __forceinline__ int lds_byte(int r, int c) { const int st = (r >> 4) * 2 + (c >> 5), rr = r & 15, cc = c & 31, ob = rr * 64 + cc * 2; return st * 1024 + (ob ^ (((ob >> 9) & 1) << 5)); }
__host__ __device__ __forceinline__ void stage_rc(int b, int& R, int& C) { const int st = b / 1024, sb = b % 1024, swz = sb ^ (((sb >> 9) & 1) << 5); R = (st >> 1) * 16 + swz / 64; C = (st & 1) * 32 + (swz % 64) / 2; }
__host__ __device__ __forceinline__ int perm32(int rho) { const int n = rho >> 4, i = rho & 15; return 8 * (i >> 2) + 4 * n + (i & 3); }

struct Unit { int pm, pn; };
struct Gemm { const bf16_t* A; const bf16_t* Bt; int M, N, K; };

struct StaticOrder {
    int nM, nN, nwg, G, c;
    __host__ __device__ void init(int M, int N, int G_, int c_) { nM = M / BM; nN = N / BM; nwg = nM * nN; G = G_; c = c_; }
    __host__ __device__ bool next(int i, Unit& u) const {
        const long L = (long)i * G + c; if (L >= nwg) return false;
        int wgid = (int)L; { const int q = nwg / NXCD, r = nwg % NXCD, xcd = wgid % NXCD, off = wgid / NXCD; wgid = (xcd < r ? xcd * (q + 1) : r * (q + 1) + (xcd - r) * q) + off; }
        const int nig = WGM * nN, gid = wgid / nig, fm = gid * WGM, gsz = (nM - fm) < WGM ? (nM - fm) : WGM;
        u.pm = fm + ((wgid % nig) % gsz); u.pn = (wgid % nig) / gsz; return true;
    }
    __device__ __forceinline__ void a_ready(const Unit&) const {}
    __device__ __forceinline__ void done(const Unit&) const {}
};

__device__ __forceinline__ unsigned cvt_pk_bf16(float lo, float hi) { return pk2(lo, hi); }

template <class E, class = void> struct epi_keep { static constexpr bool value = false; };
template <class E> struct epi_keep<E, decltype((void)E::KEEP_ACC)> { static constexpr bool value = true; };
template <class Epi, class Sched, bool STAMP = false, bool ALIGN_EPI = false, bool SP2 = false>
__device__ __forceinline__ void gemm_phase(PG8_LAS unsigned char* lds, const Gemm g, const Sched& S, const Epi& E, unsigned long long* stamps) {
    const int tid = pg8_fresh_tid(), wid = __builtin_amdgcn_readfirstlane(tid >> 6), lane = tid & 63, wr = wid >> 2, wc = wid & 3, fr = lane & 15, fq = lane >> 4;
    int K_ = g.K; asm volatile("" : "+s"(K_));
    const int K = K_, nt = K / BK;
    int ts_lo = 0, ts_hi = 0, nts = 0; const unsigned long long rt_entry = STAMP ? (unsigned long long)wall_clock64() : 0ull;
#define PG8_STAMP() do { if (STAMP && wid == 0 && nts < 64) { const unsigned long long _c = (unsigned long long)clock64(); \
        ts_lo = (lane == nts) ? (int)(unsigned)_c : ts_lo; ts_hi = (lane == nts) ? (int)(unsigned)(_c >> 32) : ts_hi; ++nts; } } while (0)
    PG8_STAMP();
    unsigned voffA[2], voffB[2];
#pragma unroll
    for (int i = 0; i < 2; ++i) { int R, C; stage_rc(tid * 16 + i * 8192, R, C); const int Rb = Epi::PERM ? ((R & ~31) + perm32(R & 31)) : R;
        voffA[i] = (unsigned)(R * K + C) * 2u; voffB[i] = (unsigned)(Rb * K + C) * 2u; }
    const size_t kstep = (size_t)(BK * 2);
    const size_t hstep = (size_t)HALF * K * 2;
    const size_t tstep = 2 * hstep;
    const unsigned ldsw = (unsigned)wid * 1024u;
    const int aoff = lds_byte(wr * 64 + fr, fq * 8), boff = lds_byte(wc * 32 + fr, fq * 8);
#define PG8_SA(b, h) (((b) * 2 + (h)) * HTB)
#define PG8_SB(b, h) ((4 + (b) * 2 + (h)) * HTB)
#define PG8_STAGE(bufoff, gbase, voff) do { _Pragma("unroll") for (int _i = 0; _i < 2; ++_i) \
        __builtin_amdgcn_global_load_lds((const unsigned*)((const char*)(gbase) + (voff)[_i]), (PG8_LAS unsigned*)(lds + (bufoff) + ldsw + _i * 8192), 16, 0, 0); } while (0)
#define PG8_LDA(dst, b, h) do { _Pragma("unroll") for (int m = 0; m < 4; ++m) _Pragma("unroll") for (int k = 0; k < 2; ++k) dst[m][k] = *(const PG8_LAS bf16x8*)(lds + PG8_SA(b, h) + aoff + m * 2048 + k * 1024); } while (0)
#define PG8_LDB(dst, b, h) do { _Pragma("unroll") for (int n = 0; n < 2; ++n) _Pragma("unroll") for (int k = 0; k < 2; ++k) dst[n][k] = *(const PG8_LAS bf16x8*)(lds + PG8_SB(b, h) + boff + n * 2048 + k * 1024); } while (0)
#define PG8_MMA(ai, bj, At, Bt) do { __builtin_amdgcn_s_setprio(1); _Pragma("unroll") for (int m = 0; m < 4; ++m) _Pragma("unroll") for (int n = 0; n < 2; ++n) _Pragma("unroll") for (int k = 0; k < 2; ++k) \
        acc[ai][bj][m][n] = __builtin_amdgcn_mfma_f32_16x16x32_bf16(Bt[n][k], At[m][k], acc[ai][bj][m][n], 0, 0, 0); __builtin_amdgcn_s_setprio(0); } while (0)
#define PG8_WAIT_V(n) asm volatile("s_waitcnt vmcnt(" #n ")" ::: "memory")
#define PG8_WAIT_L(n) asm volatile("s_waitcnt lgkmcnt(" #n ")" ::: "memory")
#define PG8_BAR __builtin_amdgcn_s_barrier()
#define PG8_SCHED __builtin_amdgcn_sched_barrier(0)
    Unit cur, nxt; int ui = 0;
    if (!S.next(0, cur)) return;
    f32x4 acc[2][2][4][2];
#pragma unroll
    for (int a = 0; a < 2; ++a)
#pragma unroll
        for (int b = 0; b < 2; ++b)
#pragma unroll
            for (int m = 0; m < 4; ++m)
#pragma unroll
                for (int n = 0; n < 2; ++n) acc[a][b][m][n] = (f32x4){0.f, 0.f, 0.f, 0.f};
    bf16x8 At[4][2], B0[2][2], B1[2][2];
    const char* cA = (const char*)g.A + (size_t)cur.pm * tstep; const char* cB = (const char*)g.Bt + (size_t)cur.pn * tstep;
    S.a_ready(cur);
    if constexpr (SP2) {
        PG8_STAGE(PG8_SB(0, 0), cB, voffB); PG8_STAGE(PG8_SB(0, 1), cB + hstep, voffB); PG8_STAGE(PG8_SA(0, 0), cA, voffA); PG8_STAGE(PG8_SA(0, 1), cA + hstep, voffA);
        if (wr == 1) PG8_BAR;
        PG8_WAIT_V(2); PG8_BAR;
        PG8_STAGE(PG8_SB(1, 0), cB + kstep, voffB); PG8_STAGE(PG8_SA(1, 0), cA + kstep, voffA); PG8_STAGE(PG8_SB(1, 1), cB + hstep + kstep, voffB);
        PG8_WAIT_V(6); PG8_BAR;
    } else {
    PG8_STAGE(PG8_SB(0, 0), cB, voffB); PG8_STAGE(PG8_SA(0, 0), cA, voffA); PG8_STAGE(PG8_SB(0, 1), cB + hstep, voffB); PG8_STAGE(PG8_SA(0, 1), cA + hstep, voffA);
    if (wr == 1) PG8_BAR;
    PG8_WAIT_V(4); PG8_BAR;
    PG8_STAGE(PG8_SB(1, 0), cB + kstep, voffB); PG8_STAGE(PG8_SA(1, 0), cA + kstep, voffA); PG8_STAGE(PG8_SB(1, 1), cB + hstep + kstep, voffB);
    PG8_WAIT_V(6); PG8_BAR;
    }
    PG8_STAMP();
    for (;;) {
        const bool has_next = S.next(ui + 1, nxt);
        const char* nA = has_next ? (const char*)g.A + (size_t)nxt.pm * tstep : cA; const char* nB = has_next ? (const char*)g.Bt + (size_t)nxt.pn * tstep : cB;
        for (int t = 0; t < nt; t += 2) {
            const bool last = (t == nt - 2);
            const char* a1 = cA + (size_t)(t + 1) * kstep;
            const char* a2 = last ? nA : cA + (size_t)(t + 2) * kstep; const char* b2 = last ? nB : cB + (size_t)(t + 2) * kstep;
            const char* a3 = a2 + kstep; const char* b3 = b2 + kstep;
            if (last && has_next) S.a_ready(nxt);
            if constexpr (SP2) {
            PG8_LDB(B0, 0, 0); PG8_LDB(B1, 0, 1); PG8_SCHED; PG8_LDA(At, 0, 0); PG8_STAGE(PG8_SA(1, 1), a1 + hstep, voffA);
            PG8_WAIT_V(8); PG8_WAIT_L(0); PG8_BAR; PG8_MMA(0, 0, At, B0); PG8_MMA(0, 1, At, B1); PG8_BAR; PG8_SCHED;
            PG8_LDA(At, 0, 1); PG8_STAGE(PG8_SB(0, 0), b2, voffB); PG8_STAGE(PG8_SB(0, 1), b2 + hstep, voffB); PG8_STAGE(PG8_SA(0, 0), a2, voffA);
            PG8_WAIT_V(8); PG8_WAIT_L(0); PG8_BAR; PG8_MMA(1, 0, At, B0); PG8_MMA(1, 1, At, B1); PG8_BAR; PG8_SCHED;
            PG8_LDB(B0, 1, 0); PG8_LDB(B1, 1, 1); PG8_SCHED; PG8_LDA(At, 1, 0); PG8_STAGE(PG8_SA(0, 1), a2 + hstep, voffA);
            PG8_WAIT_V(8); PG8_WAIT_L(0); PG8_BAR; PG8_MMA(0, 0, At, B0); PG8_MMA(0, 1, At, B1); PG8_BAR; PG8_SCHED;
            PG8_LDA(At, 1, 1); PG8_STAGE(PG8_SB(1, 0), b3, voffB); PG8_STAGE(PG8_SB(1, 1), b3 + hstep, voffB); PG8_STAGE(PG8_SA(1, 0), a3, voffA);
            PG8_WAIT_V(8); PG8_WAIT_L(0); PG8_BAR; PG8_MMA(1, 0, At, B0); PG8_MMA(1, 1, At, B1); PG8_BAR; PG8_SCHED;
            } else {
            PG8_LDB(B0, 0, 0); PG8_SCHED; PG8_LDA(At, 0, 0); PG8_STAGE(PG8_SA(1, 1), a1 + hstep, voffA);
            PG8_WAIT_L(8); PG8_BAR; PG8_WAIT_L(0); PG8_MMA(0, 0, At, B0); PG8_BAR; PG8_SCHED;
            PG8_LDB(B1, 0, 1); PG8_STAGE(PG8_SB(0, 0), b2, voffB);
            PG8_BAR; PG8_WAIT_L(0); PG8_MMA(0, 1, At, B1); PG8_BAR;
            PG8_LDA(At, 0, 1); PG8_STAGE(PG8_SA(0, 0), a2, voffA);
            PG8_BAR; PG8_WAIT_L(0); PG8_MMA(1, 0, At, B0); PG8_BAR; PG8_SCHED;
            PG8_STAGE(PG8_SB(0, 1), b2 + hstep, voffB);
            PG8_WAIT_V(6); PG8_BAR; PG8_MMA(1, 1, At, B1); PG8_BAR;
            PG8_LDB(B0, 1, 0); PG8_SCHED; PG8_LDA(At, 1, 0); PG8_STAGE(PG8_SA(0, 1), a2 + hstep, voffA);
            PG8_WAIT_L(8); PG8_BAR; PG8_WAIT_L(0); PG8_MMA(0, 0, At, B0); PG8_BAR; PG8_SCHED;
            PG8_LDB(B1, 1, 1); PG8_STAGE(PG8_SB(1, 0), b3, voffB);
            PG8_BAR; PG8_WAIT_L(0); PG8_MMA(0, 1, At, B1); PG8_BAR;
            PG8_LDA(At, 1, 1); PG8_STAGE(PG8_SA(1, 0), a3, voffA);
            PG8_BAR; PG8_WAIT_L(0); PG8_MMA(1, 0, At, B0); PG8_BAR; PG8_SCHED;
            PG8_STAGE(PG8_SB(1, 1), b3 + hstep, voffB);
            PG8_WAIT_V(6); PG8_BAR; PG8_MMA(1, 1, At, B1); PG8_BAR;
            }
        }
        PG8_STAMP();
        if constexpr (ALIGN_EPI) { if (wr == 0) PG8_BAR; }
        if constexpr (!Epi::AFTER_DRAIN) { E(acc, cur, wr, wc, fr, fq); S.done(cur); }
        PG8_STAMP();
        if (!has_next) break;
        bool zero_acc = true; if constexpr (epi_keep<Epi>::value) zero_acc = !E.keep(cur);
        if (zero_acc) { const bf16x8 z8 = {0, 0, 0, 0, 0, 0, 0, 0};
#pragma unroll
        for (int a = 0; a < 2; ++a)
#pragma unroll
            for (int b = 0; b < 2; ++b)
#pragma unroll
                for (int m = 0; m < 4; ++m)
#pragma unroll
                    for (int n = 0; n < 2; ++n) acc[a][b][m][n] = __builtin_amdgcn_mfma_f32_16x16x32_bf16(z8, z8, (f32x4){0.f, 0.f, 0.f, 0.f}, 0, 0, 0); }
        cur = nxt; cA = nA; cB = nB; ++ui;
        if constexpr (ALIGN_EPI) { if (wr == 1) PG8_BAR; }
    }
    PG8_WAIT_V(0);
    if constexpr (!ALIGN_EPI) { if (wr == 0) PG8_BAR; }
    PG8_BAR;
    if constexpr (Epi::AFTER_DRAIN) { E.fused(acc, cur, wr, wc, fr, fq, lds, wid, lane); S.done(cur); }
    PG8_STAMP();
    if (STAMP && wid == 0) { stamps[lane] = lane < nts ? (((unsigned long long)(unsigned)ts_hi << 32) | (unsigned)ts_lo) : 0ull;
        if (lane == 62) stamps[62] = rt_entry; if (lane == 63) stamps[63] = (unsigned long long)wall_clock64(); }
#undef PG8_STAMP
#undef PG8_SA
#undef PG8_SB
#undef PG8_STAGE
#undef PG8_LDA
#undef PG8_LDB
#undef PG8_MMA
#undef PG8_WAIT_V
#undef PG8_WAIT_L
#undef PG8_BAR
#undef PG8_SCHED
}
}

#define XB_TMO      128
#define XB_XCNT(j)  (256  + 64 * (j))
#define XB_XSUB(j)  (1280 + 64 * (j))
#define XB_XGEN(j)  (2304 + 64 * (j))
#define XB_TOP      3328
#define XB_TOPGEN   3392
#define XCD_BAR_WORDS 3456
#define XB_SPIN_CAP (1u << 18)
#define LAS __attribute__((address_space(3)))

__device__ __forceinline__ unsigned xb_ld(unsigned* p)              { return __hip_atomic_load(p, __ATOMIC_RELAXED, __HIP_MEMORY_SCOPE_AGENT); }
__device__ __forceinline__ unsigned xb_add(unsigned* p, unsigned v) { return __hip_atomic_fetch_add(p, v, __ATOMIC_RELAXED, __HIP_MEMORY_SCOPE_AGENT); }
__device__ __forceinline__ unsigned xb_xcc_id() { return (unsigned)__builtin_amdgcn_s_getreg((3 << 11) | 20) & 0xFu; }
#define XB_SPIN(cond, bar) do { unsigned _sp = 0; while (cond) { __builtin_amdgcn_s_sleep(1); \
    if ((++_sp & 255u) == 0u) { if (xb_ld(&(bar)[XB_TMO])) break; if (_sp > XB_SPIN_CAP) { atomicAdd(&(bar)[XB_TMO], 1u); break; } } } } while (0)

struct XcdBarrier {
    unsigned* bar; unsigned x;
    volatile LAS unsigned* st;
};

__device__ __forceinline__ XcdBarrier xcd_barrier_post(unsigned* bar, volatile LAS unsigned* st) {
    XcdBarrier b; b.bar = bar; b.x = xb_xcc_id(); b.st = st;
    if (threadIdx.x == 0) (void)xb_add(&bar[XB_XCNT(b.x)], 1u);
    return b;
}
__device__ __forceinline__ void xcd_barrier_complete(unsigned* bar, unsigned x, unsigned& nloc, unsigned& nx) {
    const unsigned G = gridDim.x * gridDim.y * gridDim.z;
    unsigned sum, cnt, mine, sp = 0u;
    for (;;) {
        sum = 0u; cnt = 0u; mine = 0u;
#pragma unroll
        for (unsigned j = 0; j < 16; ++j) { const unsigned c = xb_ld(&bar[XB_XCNT(j)]); sum += c; cnt += (c > 0u) ? 1u : 0u; mine = (j == x) ? c : mine; }
        if (sum == G) break;
        __builtin_amdgcn_s_sleep(1);
        if ((++sp & 255u) == 0u) { if (xb_ld(&bar[XB_TMO])) break; if (sp > XB_SPIN_CAP) { atomicAdd(&bar[XB_TMO], 1u); break; } }
    }
    nloc = mine > 0u ? mine : 1u; nx = cnt > 0u ? cnt : 1u;
}

__device__ __forceinline__ void xcd_barrier(const XcdBarrier& b) {
    asm volatile("s_waitcnt vmcnt(0)" ::: "memory");
    __syncthreads();
    if (threadIdx.x == 0) {
        unsigned* bar = b.bar;
        __builtin_amdgcn_s_waitcnt(0);
        unsigned nloc = b.st[0], nx = b.st[1];
        if (nloc == 0u) { xcd_barrier_complete(bar, b.x, nloc, nx); b.st[0] = nloc; b.st[1] = nx; }
        const unsigned old = xb_add(&bar[XB_XSUB(b.x)], 1u);
        const unsigned gen = old / nloc;
        if (old + 1u == (gen + 1u) * nloc) {
            __builtin_amdgcn_fence(__ATOMIC_RELEASE, "agent");
            asm volatile("s_waitcnt vmcnt(0)" ::: "memory");
            const unsigned og = xb_add(&bar[XB_TOP], 1u);
            const unsigned tg = og / nx;
            if (og + 1u == (tg + 1u) * nx) xb_add(&bar[XB_TOPGEN], 1u);
            else XB_SPIN(xb_ld(&bar[XB_TOPGEN]) == tg, bar);
            __builtin_amdgcn_fence(__ATOMIC_ACQUIRE, "agent");
            xb_add(&bar[XB_XGEN(b.x)], 1u);
            asm volatile("s_waitcnt vmcnt(0)" ::: "memory");
        } else {
            XB_SPIN(xb_ld(&bar[XB_XGEN(b.x)]) == gen, bar);
            __builtin_amdgcn_fence(__ATOMIC_ACQUIRE, "agent");
            asm volatile("s_waitcnt vmcnt(0)" ::: "memory");
        }
    }
    __syncthreads();
}

#else
namespace pg8 {
typedef unsigned short bf16_t;
typedef float f32x4 __attribute__((ext_vector_type(4)));
typedef unsigned u32x4 __attribute__((ext_vector_type(4)));
constexpr int BM = 256, BK = 64, HALF = 128, NXCD = 8, WGM = 8;
struct Unit { int pm, pn; };
struct Gemm { const bf16_t* A; const bf16_t* Bt; int M, N, K; };
template <class E, class = void> struct epi_keep { static constexpr bool value = false; };
template <class E> struct epi_keep<E, decltype((void)E::KEEP_ACC)> { static constexpr bool value = true; };
struct StaticOrder {
    int nM, nN, nwg, G, c;
    void init(int M, int N, int G_, int c_) { nM = M / BM; nN = N / BM; nwg = nM * nN; G = G_; c = c_; }
    bool next(int i, Unit& u) const {
        const long L = (long)i * G + c; if (L >= nwg) return false;
        int wgid = (int)L; { const int q = nwg / NXCD, r = nwg % NXCD, xcd = wgid % NXCD, off = wgid / NXCD; wgid = (xcd < r ? xcd * (q + 1) : r * (q + 1) + (xcd - r) * q) + off; }
        const int nig = WGM * nN, gid = wgid / nig, fm = gid * WGM, gsz = (nM - fm) < WGM ? (nM - fm) : WGM;
        u.pm = fm + ((wgid % nig) % gsz); u.pn = (wgid % nig) / gsz; return true;
    }
    void a_ready(const Unit&) const {}
    void done(const Unit&) const {}
};
static inline unsigned cvt_pk_bf16(float lo, float hi) { return pk2(lo, hi); }
static float* emu_tile_buf(int b) { static std::vector<std::vector<float>> t; if ((int)t.size() <= b) t.resize(b + 1); if (t[b].empty()) t[b].resize(256 * 256); return t[b].data(); }
template <class Epi, class Sched, bool STAMP = false, bool ALIGN_EPI = false, bool SP2 = false, bool ZPEEL = false>
void gemm_phase(unsigned char* lds, const Gemm g, const Sched& S, const Epi& E, unsigned long long* stamps) {
    const int tid = threadIdx.x, wid = tid >> 6, lane = tid & 63, wr = wid >> 2, wc = wid & 3, fr = lane & 15, fq = lane >> 4;
    float* tile = emu_tile_buf(blockIdx.x);
    Unit u; f32x4 acc[2][2][4][2]; bool keep_next = false;
    for (int ui = 0; S.next(ui, u); ++ui) {
        __syncthreads();
        if (tid == 0) {
            std::vector<float> a((size_t)256 * g.K), b((size_t)256 * g.K);
            for (int r = 0; r < 256; ++r) for (int k = 0; k < g.K; ++k) { a[(size_t)r * g.K + k] = bf2f(g.A[((size_t)u.pm * 256 + r) * g.K + k]); b[(size_t)r * g.K + k] = bf2f(g.Bt[((size_t)u.pn * 256 + r) * g.K + k]); }
            for (int r = 0; r < 256; ++r) for (int c = 0; c < 256; ++c) { const float* ar = &a[(size_t)r * g.K]; const float* br = &b[(size_t)c * g.K]; float s = 0.f; for (int k = 0; k < g.K; ++k) s += ar[k] * br[k]; tile[r * 256 + c] = s; }
        }
        __syncthreads();
        if (!keep_next) for (int ai = 0; ai < 2; ++ai) for (int bj = 0; bj < 2; ++bj) for (int m = 0; m < 4; ++m) for (int n = 0; n < 2; ++n) acc[ai][bj][m][n] = (f32x4){0.f, 0.f, 0.f, 0.f};
        for (int ai = 0; ai < 2; ++ai) for (int bj = 0; bj < 2; ++bj) for (int m = 0; m < 4; ++m) for (int n = 0; n < 2; ++n) for (int j = 0; j < 4; ++j) {
            const int r = 128 * ai + 64 * wr + 16 * m + fr;
            const int c = Epi::PERM ? (128 * bj + 32 * wc + 8 * fq + 4 * n + j) : (128 * bj + 32 * wc + 16 * n + 4 * fq + j);
            acc[ai][bj][m][n][j] += tile[r * 256 + c];
        }
        E(acc, u, wr, wc, fr, fq); S.done(u);
        if constexpr (epi_keep<Epi>::value) keep_next = E.keep(u); else keep_next = false;
        __syncthreads();
    }
}
}
#endif
namespace pg8 {
#ifdef HOST_EMU
#define EPI_FENCE() do {} while (0)
#else
#define EPI_FENCE() asm volatile("" ::: "memory")
#endif
__device__ __forceinline__ u32x4 pack8(const f32x4 v0, const f32x4 v1) { u32x4 w; w.x = cvt_pk_bf16(v0[0], v0[1]); w.y = cvt_pk_bf16(v0[2], v0[3]); w.z = cvt_pk_bf16(v1[0], v1[1]); w.w = cvt_pk_bf16(v1[2], v1[3]); return w; }
__device__ __forceinline__ void unpack8(const u32x4 w, f32x4& v0, f32x4& v1) { v0 = (f32x4){lo_bf(w.x), hi_bf(w.x), lo_bf(w.y), hi_bf(w.y)}; v1 = (f32x4){lo_bf(w.z), hi_bf(w.z), lo_bf(w.w), hi_bf(w.w)}; }
__device__ __forceinline__ f32x4 sig4(const f32x4 v) { return (f32x4){sigm(v[0]), sigm(v[1]), sigm(v[2]), sigm(v[3])}; }
#ifndef HOST_EMU
__device__ __forceinline__ float gate_sig(float x) { return __builtin_amdgcn_rcpf(fminf(1.0f + __expf(-x), 1.0e6f)); }
#else
__device__ __forceinline__ float gate_sig(float x) { return fmaxf(sigm(x), 1.0e-6f); }
#endif
__device__ __forceinline__ f32x4 gsig4(const f32x4 v) { return (f32x4){gate_sig(v[0]), gate_sig(v[1]), gate_sig(v[2]), gate_sig(v[3])}; }

struct EpiProj {
    static constexpr bool PERM = true, AFTER_DRAIN = false;
    unsigned char* ws;
    __device__ __forceinline__ void operator()(const f32x4 (&acc)[2][2][4][2], const Unit& u, int wr, int wc, int fr, int fq) const {
        const int pn = u.pn; size_t off; int ld, c0;
        if (pn < 2) { off = WS_Z; ld = 512; c0 = pn * 256; }
        else if (pn < 5) { off = WS_XBC; ld = 768; c0 = (pn - 2) * 256; }
        else if (pn < 7) { off = WS_Q; ld = 512; c0 = (pn - 5) * 256; }
        else if (pn < 9) { off = WS_K; ld = 512; c0 = (pn - 7) * 256; }
        else if (pn < 11) { off = WS_V; ld = 512; c0 = (pn - 9) * 256; }
        else if (pn < 18) { off = WS_RW; ld = 1792; c0 = (pn - 11) * 256; }
        else if (pn < 20) { off = WS_U; ld = 512; c0 = (pn - 18) * 256; }
        else { off = WS_SM; ld = 256; c0 = 0; }
        bf16_t* dst = (bf16_t*)(ws + off);
        const int row0 = u.pm * BM + wr * 64 + fr, col0 = c0 + wc * 32 + 8 * fq;
        const int kic = HALF + wc * 32 + 8 * fq - 136;
        const bool ki = (pn == 20) && kic >= 0 && kic < 32;
#pragma unroll
        for (int ai = 0; ai < 2; ++ai)
#pragma unroll
            for (int m = 0; m < 4; ++m) { const size_t row = (size_t)(row0 + ai * HALF + m * 16); bf16_t* rowp = dst + row * ld + col0;
#pragma unroll
                for (int bj = 0; bj < 2; ++bj) { const u32x4 w = pack8(acc[ai][bj][m][0], acc[ai][bj][m][1]); *(u32x4*)(rowp + bj * HALF) = w;
                    if (bj == 1 && ki) *(u32x4*)((bf16_t*)(ws + WS_KI) + row * 32 + kic) = w; } }
    }
};
struct EpiGate {
    static constexpr bool PERM = true, AFTER_DRAIN = false;
    bf16_t* G;
    __device__ __forceinline__ void operator()(const f32x4 (&acc)[2][2][4][2], const Unit& u, int wr, int wc, int fr, int fq) const {
        const int row0 = u.pm * BM + wr * 64 + fr, col0 = u.pn * BM + wc * 32 + 8 * fq;
#pragma unroll
        for (int ai = 0; ai < 2; ++ai)
#pragma unroll
            for (int m = 0; m < 4; ++m) { bf16_t* rowp = G + (size_t)(row0 + ai * HALF + m * 16) * 4096 + col0;
#pragma unroll
                for (int bj = 0; bj < 2; ++bj) *(u32x4*)(rowp + bj * HALF) = pack8(gsig4(acc[ai][bj][m][0]), gsig4(acc[ai][bj][m][1])); }
    }
};
struct EpiMerge {
    static constexpr bool PERM = true, AFTER_DRAIN = false, KEEP_ACC = true;
    const bf16_t* G; bf16_t* MRG;
    __device__ __forceinline__ bool keep(const Unit& u) const { return (u.pn >> 2) < 3; }
    __device__ __forceinline__ void operator()(f32x4 (&acc)[2][2][4][2], const Unit& u, int wr, int wc, int fr, int fq) const {
        const int n = u.pn >> 2, pn = u.pn & 3, pm = u.pm - n * (MG / 256);
        const int row0 = pm * BM + wr * 64 + fr, col0 = pn * BM + wc * 32 + 8 * fq;
#pragma unroll
        for (int ai = 0; ai < 2; ++ai)
#pragma unroll
            for (int mp = 0; mp < 2; ++mp) { u32x4 ga[2][2], gb[2][2];
#pragma unroll
                for (int mm = 0; mm < 2; ++mm)
#pragma unroll
                    for (int bj = 0; bj < 2; ++bj) { const bf16_t* gp = G + (size_t)(row0 + ai * HALF + (2 * mp + mm) * 16) * 4096 + n * 1024 + col0 + bj * HALF; ga[mm][bj] = *(const u32x4*)gp; if (n < 3) gb[mm][bj] = *(const u32x4*)(gp + 1024); }
#pragma unroll
                for (int mm = 0; mm < 2; ++mm)
#pragma unroll
                    for (int bj = 0; bj < 2; ++bj) { const int m = 2 * mp + mm; f32x4 a0, a1; unpack8(ga[mm][bj], a0, a1);
                        if (n < 3) { f32x4 b0, b1; unpack8(gb[mm][bj], b0, b1);
#pragma unroll
                            for (int j = 0; j < 4; ++j) { acc[ai][bj][m][0][j] *= a0[j] * __builtin_amdgcn_rcpf(b0[j]); acc[ai][bj][m][1][j] *= a1[j] * __builtin_amdgcn_rcpf(b1[j]); } }
                        else
                            *(u32x4*)(MRG + (size_t)(row0 + ai * HALF + m * 16) * 1024 + col0 + bj * HALF) = pack8(acc[ai][bj][m][0] * a0, acc[ai][bj][m][1] * a1); }
                EPI_FENCE(); }
    }
};
struct MergeOrder {
    int G, c;
    __device__ __forceinline__ bool next(int i, Unit& u) const {
        const int tile = (i >> 2) * G + c, n = i & 3; if (tile >= (MG / 256) * 4) return false;
        u.pm = n * (MG / 256) + (tile >> 2); u.pn = n * 4 + (tile & 3); return true;
    }
    __device__ __forceinline__ void a_ready(const Unit&) const {}
    __device__ __forceinline__ void done(const Unit&) const {}
};
struct EpiResid {
    static constexpr bool PERM = false, AFTER_DRAIN = false;
    const float* base; float* out;
    __device__ __forceinline__ void operator()(const f32x4 (&acc)[2][2][4][2], const Unit& u, int wr, int wc, int fr, int fq) const {
        const int row0 = u.pm * BM + wr * 64 + fr, col0 = u.pn * BM + wc * 32 + 4 * fq;
#pragma unroll
        for (int ai = 0; ai < 2; ++ai) {
            f32x4 bv[4][2][2];
#pragma unroll
            for (int m = 0; m < 4; ++m)
#pragma unroll
                for (int bj = 0; bj < 2; ++bj)
#pragma unroll
                    for (int n = 0; n < 2; ++n) bv[m][bj][n] = *(const f32x4*)(base + (size_t)(row0 + ai * HALF + m * 16) * 1024 + col0 + bj * HALF + n * 16);
#pragma unroll
            for (int m = 0; m < 4; ++m)
#pragma unroll
                for (int bj = 0; bj < 2; ++bj)
#pragma unroll
                    for (int n = 0; n < 2; ++n) *(f32x4*)(out + (size_t)(row0 + ai * HALF + m * 16) * 1024 + col0 + bj * HALF + n * 16) = bv[m][bj][n] + acc[ai][bj][m][n];
            EPI_FENCE(); }
    }
};
struct EpiSwiglu {
    static constexpr bool PERM = true, AFTER_DRAIN = false;
    bf16_t* HID;
    __device__ __forceinline__ void operator()(const f32x4 (&acc)[2][2][4][2], const Unit& u, int wr, int wc, int fr, int fq) const {
        const int row0 = u.pm * BM + wr * 64 + fr, col0 = u.pn * HALF + wc * 32 + 8 * fq;
#pragma unroll
        for (int ai = 0; ai < 2; ++ai)
#pragma unroll
            for (int m = 0; m < 4; ++m) { f32x4 v[2];
#pragma unroll
                for (int n = 0; n < 2; ++n) { const f32x4 a = acc[ai][0][m][n], b = acc[ai][1][m][n]; v[n] = a * sig4(a) * b; }
                *(u32x4*)(HID + (size_t)(row0 + ai * HALF + m * 16) * FFN + col0) = pack8(v[0], v[1]); }
    }
};
struct EpiGlu {
    static constexpr bool PERM = true, AFTER_DRAIN = false;
    const bf16_t* Y0; bf16_t* OUT; const float* bias;
    __device__ __forceinline__ void operator()(const f32x4 (&acc)[2][2][4][2], const Unit& u, int wr, int wc, int fr, int fq) const {
        const int row0 = u.pm * BM + wr * 64 + fr, col0 = u.pn * BM + wc * 32 + 8 * fq;
#pragma unroll
        for (int ai = 0; ai < 2; ++ai)
#pragma unroll
            for (int m = 0; m < 4; ++m) { const size_t row = (size_t)(row0 + ai * HALF + m * 16);
#pragma unroll
                for (int bj = 0; bj < 2; ++bj) { const int col = col0 + bj * HALF;
                    f32x4 y0, y1; unpack8(*(const u32x4*)(Y0 + row * 512 + col), y0, y1);
                    const f32x4 b0 = *(const f32x4*)(bias + col), b1 = *(const f32x4*)(bias + col + 4);
                    *(u32x4*)(OUT + row * 512 + col) = pack8(y0 * sig4(acc[ai][bj][m][0] + b0), y1 * sig4(acc[ai][bj][m][1] + b1)); }
                EPI_FENCE(); }
    }
};
__device__ __forceinline__ float logdecay(float x) { return -0.6065306597f * sigm(x); }
struct EpiLora {
    static constexpr bool PERM = true, AFTER_DRAIN = false;
    float* WLOG; bf16_t* ASIG; bf16_t* GG; const float* w0; const float* a0;
    __device__ __forceinline__ void operator()(const f32x4 (&acc)[2][2][4][2], const Unit& u, int wr, int wc, int fr, int fq) const {
        const int kind = u.pn >> 1, row0 = u.pm * BM + wr * 64 + fr, col0 = (u.pn & 1) * BM + wc * 32 + 8 * fq;
        if (kind == 0) {
            f32x4 b[2][2];
#pragma unroll
            for (int bj = 0; bj < 2; ++bj) { b[bj][0] = *(const f32x4*)(w0 + col0 + bj * HALF); b[bj][1] = *(const f32x4*)(w0 + col0 + bj * HALF + 4); }
#pragma unroll
            for (int ai = 0; ai < 2; ++ai)
#pragma unroll
                for (int m = 0; m < 4; ++m)
#pragma unroll
                    for (int bj = 0; bj < 2; ++bj)
#pragma unroll
                        for (int n = 0; n < 2; ++n) { const f32x4 x = acc[ai][bj][m][n] + b[bj][n];
                            *(f32x4*)(WLOG + (size_t)(row0 + ai * HALF + m * 16) * 512 + col0 + bj * HALF + 4 * n) = (f32x4){logdecay(x[0]), logdecay(x[1]), logdecay(x[2]), logdecay(x[3])}; }
        } else if (kind == 1) {
            f32x4 b[2][2];
#pragma unroll
            for (int bj = 0; bj < 2; ++bj) { b[bj][0] = *(const f32x4*)(a0 + col0 + bj * HALF); b[bj][1] = *(const f32x4*)(a0 + col0 + bj * HALF + 4); }
#pragma unroll
            for (int ai = 0; ai < 2; ++ai)
#pragma unroll
                for (int m = 0; m < 4; ++m)
#pragma unroll
                    for (int bj = 0; bj < 2; ++bj)
                        *(u32x4*)(ASIG + (size_t)(row0 + ai * HALF + m * 16) * 512 + col0 + bj * HALF) = pack8(sig4(acc[ai][bj][m][0] + b[bj][0]), sig4(acc[ai][bj][m][1] + b[bj][1]));
        } else {
#pragma unroll
            for (int ai = 0; ai < 2; ++ai)
#pragma unroll
                for (int m = 0; m < 4; ++m)
#pragma unroll
                    for (int bj = 0; bj < 2; ++bj)
                        *(u32x4*)(GG + (size_t)(row0 + ai * HALF + m * 16) * 512 + col0 + bj * HALF) = pack8(acc[ai][bj][m][0], acc[ai][bj][m][1]);
        }
    }
};
}
typedef short bf16x8_t __attribute__((ext_vector_type(8)));
typedef float f32x16 __attribute__((ext_vector_type(16)));
typedef float f32x4_t __attribute__((ext_vector_type(4)));
__device__ __forceinline__ bf16x8_t frag2(const u32x2 lo, const u32x2 hi) { u32x4 w; w.x = lo.x; w.y = lo.y; w.z = hi.x; w.w = hi.y; return __builtin_bit_cast(bf16x8_t, w); }
struct Args { const float* in[N_IN]; float* out; unsigned char* ws; int seg_lo, seg_hi; };
#ifdef HOST_EMU
typedef const Args* KArgs;
#define KLAUNDER(p) (p)
__device__ __forceinline__ int fresh_tid() { return (int)threadIdx.x; }
#else
typedef const __attribute__((address_space(4))) Args* KArgs;
__device__ __forceinline__ KArgs klaunder(KArgs p) { asm volatile("" : "+s"(p)); return p; }
#define KLAUNDER(p) klaunder(p)
__device__ __forceinline__ int fresh_tid() { int t = (int)threadIdx.x; asm volatile("" : "+v"(t)); return t; }
#endif
#define WSP(T, off) ((T*)(C->ws + (off)))

template <class Src>
__device__ __forceinline__ void transpose_item(const Src& S, int K, bf16* WT, float* scr, int item, int lane) {
    const int nblk = S.ndst / 32, kb = item / nblk, nb = item % nblk, k0 = 64 * kb, n0 = 32 * nb;
    const float* cp = S.col(n0 + (lane & 31)); const int ld = S.ld; const float* cq = cp ? cp : S.col(0);
    float ld32[32];
#pragma unroll
    for (int i = 0; i < 32; ++i) ld32[i] = cq[(size_t)(k0 + 2 * i + (lane >> 5)) * ld];
#pragma unroll
    for (int i = 0; i < 32; ++i) { const int kk = 2 * i + (lane >> 5); scr[kk * 33 + (lane & 31)] = cp ? ld32[i] : 0.f; }
    WAVE_SYNC();
    const int c = lane & 7;
#pragma unroll
    for (int j = 0; j < 4; ++j) { const int n = (lane >> 3) + 8 * j; const float* s = scr + (8 * c) * 33 + n;
        u32x4 o; o.x = pk2(s[0 * 33], s[1 * 33]); o.y = pk2(s[2 * 33], s[3 * 33]); o.z = pk2(s[4 * 33], s[5 * 33]); o.w = pk2(s[6 * 33], s[7 * 33]);
        *(u32x4*)(WT + (size_t)(n0 + n) * K + k0 + 8 * c) = o; }
    WAVE_SYNC();
}
struct SrcWin { const float* w; int ndst, ld;
    __device__ __forceinline__ const float* col(int n) const {
        int s;
        if (n < 1280) s = n;
        else if (n < 2816) s = n + 8;
        else if (n < 4608) s = n - 2816 + 2988;
        else if (n < 5120) s = n - 4608 + 4780;
        else if (n < 5128) s = n - 5120 + 1280;
        else if (n < 5256) s = n - 5128 + 2824;
        else if (n < 5288) s = n - 5256 + 2952;
        else if (n < 5292) s = n - 5288 + 2984;
        else if (n < 5376) return nullptr;
        else s = n - 5376 + 5292;
        return w + s; } };
struct SrcPlain { const float* w; int ndst, ld; __device__ __forceinline__ const float* col(int n) const { return w + n; } };
struct SrcW13 { const float* w1; const float* w3; int ndst, ld;
    __device__ __forceinline__ const float* col(int n) const { const int pn = n >> 8, r = n & 255; return w1 + (r < 128 ? (ptrdiff_t)0 : (w3 - w1)) + pn * 128 + (r & 127); } };

__device__ __forceinline__ void phase_weights(KArgs C, int layer, unsigned char* lds, int gw, int ngw, int lane, int wave) {
    float* scr = (float*)(lds + wave * 16384); const size_t wo = (layer & 1) ? WDELTA : 0;
    constexpr int N_IN_ = 16 * (NPROJ / 32), N_BR = 8 * 32, N_OUT = 16 * 32, N_13 = 16 * (5632 / 32), N_2 = 44 * 32, N_GLU = 8 * 16;
    { constexpr int E0 = N_IN_, E1 = E0 + 4 * N_BR, E2 = E1 + N_OUT, E3 = E2 + N_13, E4 = E3 + N_2, E5 = E4 + N_GLU;
      for (int it = gw; it < E5; it += ngw) {
          if (it < E0) { const SrcWin s_in{C->in[I_WIN] + (size_t)layer * 1024 * IN_COLS, NPROJ, IN_COLS}; transpose_item(s_in, 1024, WSP(bf16, WS_WIN + wo), scr, it, lane); }
          else if (it < E1) { const int i2 = it - E0, n = i2 / N_BR; const SrcPlain s_b{C->in[I_WBR] + ((size_t)layer * 4 + n) * 512 * 1024, 1024, 1024};
              transpose_item(s_b, 512, WSP(bf16, WS_WB + wo) + (size_t)n * 1024 * 512, scr, i2 % N_BR, lane); }
          else if (it < E2) { const SrcPlain s_out{C->in[I_WOUT] + (size_t)layer * 1024 * 1024, 1024, 1024}; transpose_item(s_out, 1024, WSP(bf16, WS_WOUT + wo), scr, it - E1, lane); }
          else if (it < E3) { const SrcW13 s_13{C->in[I_W1] + (size_t)layer * 1024 * FFN, C->in[I_W3] + (size_t)layer * 1024 * FFN, 5632, FFN}; transpose_item(s_13, 1024, WSP(bf16, WS_W13 + wo), scr, it - E2, lane); }
          else if (it < E4) { const SrcPlain s_2{C->in[I_W2F] + (size_t)layer * FFN * 1024, 1024, 1024}; transpose_item(s_2, FFN, WSP(bf16, WS_W2 + wo), scr, it - E3, lane); }
          else { const SrcPlain s_glu{C->in[I_GLUW] + (size_t)layer * 512 * 512, 512, 512}; transpose_item(s_glu, 512, WSP(bf16, WS_GLU + wo), scr, it - E4, lane); } } }
    { const float* w2 = C->in[I_W2] + (size_t)layer * 64 * 512; const float* a2 = C->in[I_A2] + (size_t)layer * 64 * 512; const float* g2 = C->in[I_G2] + (size_t)layer * 128 * 512;
      bf16* WL = WSP(bf16, WS_WLORA + wo);
      for (int e = gw * 64 + lane; e < 1536 * 256; e += ngw * 64) { const int n = e >> 8, kc = e & 255; float v = 0.f;
          if (n < 512) { if (kc < 64) v = w2[kc * 512 + n]; } else if (n < 1024) { if (kc >= 64 && kc < 128) v = a2[(kc - 64) * 512 + (n - 512)]; } else { if (kc >= 128) v = g2[(kc - 128) * 512 + (n - 1024)]; }
          WL[e] = f2bf(v); } }
    const int gt = gw * 64 + lane, ngt = ngw * 64;
    for (int ej = ngt - 1 - gt; ej < 32 * 64 * 16; ej += ngt) {
        const int e = ej >> 4, j = ej & 15, g = e >> 6;
        const float ar = C->in[I_S5ARE][layer * 2048 + e], ai = C->in[I_S5AIM][layer * 2048 + e], dt = expf(C->in[I_S5LDT][layer * 32 + g]);
        const float br = C->in[I_S5BRE][((size_t)layer * 2048 + e) * 16 + j], bi = C->in[I_S5BIM][((size_t)layer * 2048 + e) * 16 + j];
        const float mag = expf(ar * dt), abr = mag * cosf(ai * dt), abi = mag * sinf(ai * dt);
        const float den = ar * ar + ai * ai, nr = abr - 1.0f, ni = abi;
        const float qr = (nr * ar + ni * ai) / den, qi = (ni * ar - nr * ai) / den;
        if (j == 0) { float* ab = WSP(float, WS_ABAR + wo) + e * 2; ab[0] = abr; ab[1] = abi; }
        float* bb = WSP(float, WS_BBAR + wo) + (size_t)e * 32;
        bb[2 * j] = qr * br - qi * bi; bb[2 * j + 1] = qr * bi + qi * br;
    }
    if (layer == 0) for (int e = gt; e < SEQ + 63; e += ngt) {
        const int rel = e - (SEQ - 1); const int n = rel < 0 ? -rel : rel; int b = rel > 0 ? 16 : 0;
        if (n < 8) b += n; else { int lg = 8 + (int)(logf((float)n / 8.0f) / 3.4657359028f * 8.0f); if (lg > 15) lg = 15; b += lg; }
        WSP(int, WS_TAB)[e] = b;
    }
}

__device__ __forceinline__ void rms_row_bf16(const float* xrow, const float* g, bf16* orow, int lane) {
    const f32x4* xr = (const f32x4*)xrow + lane; const f32x4* gr = (const f32x4*)g + lane;
    f32x4 v[4]; float s = 0.f;
#pragma unroll
    for (int j = 0; j < 4; ++j) { v[j] = xr[64 * j]; s += (v[j].x * v[j].x + v[j].y * v[j].y) + (v[j].z * v[j].z + v[j].w * v[j].w); }
    const float rstd = 1.0f / sqrtf(wave_sum(s) * (1.f / D) + RMS_EPS);
    u32x2* o8 = (u32x2*)orow + lane;
#pragma unroll
    for (int j = 0; j < 4; ++j) { const f32x4 gg = gr[64 * j]; u32x2 w; w.x = pk2(v[j].x * rstd * gg.x, v[j].y * rstd * gg.y); w.y = pk2(v[j].z * rstd * gg.z, v[j].w * rstd * gg.w); o8[64 * j] = w; }
}
template <int NR>
__device__ __forceinline__ void rms_rows_bf16(const float* x, const float* g, bf16* o, int gw, int ngw, int nrows, int lane) {
    const f32x4* gr = (const f32x4*)g + lane; f32x4 gg[4], v[NR][4], nx[NR][4];
#pragma unroll
    for (int j = 0; j < 4; ++j) gg[j] = gr[64 * j];
#pragma unroll
    for (int q = 0; q < NR; ++q)
#pragma unroll
        for (int j = 0; j < 4; ++j) nx[q][j] = (gw + q * ngw < nrows) ? ((const f32x4*)(x + (size_t)(gw + q * ngw) * D) + lane)[64 * j] : (f32x4){0.f, 0.f, 0.f, 0.f};
    for (int m = gw; m < nrows; m += NR * ngw) {
#pragma unroll
        for (int q = 0; q < NR; ++q)
#pragma unroll
            for (int j = 0; j < 4; ++j) v[q][j] = nx[q][j];
        if (m + NR * ngw < nrows) {
#pragma unroll
            for (int q = 0; q < NR; ++q)
#pragma unroll
                for (int j = 0; j < 4; ++j) nx[q][j] = (m + (NR + q) * ngw < nrows) ? ((const f32x4*)(x + (size_t)(m + (NR + q) * ngw) * D) + lane)[64 * j] : (f32x4){0.f, 0.f, 0.f, 0.f}; }
        float ss[NR];
#pragma unroll
        for (int q = 0; q < NR; ++q) { float s = 0.f;
#pragma unroll
            for (int j = 0; j < 4; ++j) s += (v[q][j].x * v[q][j].x + v[q][j].y * v[q][j].y) + (v[q][j].z * v[q][j].z + v[q][j].w * v[q][j].w);
            ss[q] = s; }
#pragma unroll
        for (int of = 1; of < 64; of <<= 1)
#pragma unroll
            for (int q = 0; q < NR; ++q) ss[q] += __shfl_xor(ss[q], of);
#pragma unroll
        for (int q = 0; q < NR; ++q) if (m + q * ngw < nrows) { const float r = 1.0f / sqrtf(ss[q] * (1.f / D) + RMS_EPS); u32x2* o8 = (u32x2*)(o + (size_t)(m + q * ngw) * D) + lane;
#pragma unroll
            for (int j = 0; j < 4; ++j) { u32x2 w; w.x = pk2(v[q][j].x * r * gg[j].x, v[q][j].y * r * gg[j].y); w.y = pk2(v[q][j].z * r * gg[j].z, v[q][j].w * r * gg[j].w); o8[64 * j] = w; } } }
}
template <int NR>
__device__ __forceinline__ void rms_rowN_bf16(const float* xrow, const float* g, bf16* orow, size_t step, int lane) {
    const f32x4* gr = (const f32x4*)g + lane; f32x4 v[NR][4]; float ss[NR];
#pragma unroll
    for (int q = 0; q < NR; ++q)
#pragma unroll
        for (int j = 0; j < 4; ++j) v[q][j] = ((const f32x4*)(xrow + q * step) + lane)[64 * j];
#pragma unroll
    for (int q = 0; q < NR; ++q) { float s = 0.f;
#pragma unroll
        for (int j = 0; j < 4; ++j) s += (v[q][j].x * v[q][j].x + v[q][j].y * v[q][j].y) + (v[q][j].z * v[q][j].z + v[q][j].w * v[q][j].w);
        ss[q] = s; }
#pragma unroll
    for (int o = 1; o < 64; o <<= 1)
#pragma unroll
        for (int q = 0; q < NR; ++q) ss[q] += __shfl_xor(ss[q], o);
#pragma unroll
    for (int q = 0; q < NR; ++q) { const float r = 1.0f / sqrtf(ss[q] * (1.f / D) + RMS_EPS); u32x2* o8 = (u32x2*)(orow + q * step) + lane;
#pragma unroll
        for (int j = 0; j < 4; ++j) { const f32x4 gg = gr[64 * j]; u32x2 w; w.x = pk2(v[q][j].x * r * gg.x, v[q][j].y * r * gg.y); w.y = pk2(v[q][j].z * r * gg.z, v[q][j].w * r * gg.w); o8[64 * j] = w; } }
}
__device__ __forceinline__ void rms_row_f32(float* xrow, const float* g, int lane) {
    f32x4* xr = (f32x4*)xrow + lane; const f32x4* gr = (const f32x4*)g + lane;
    f32x4 v[4]; float s = 0.f;
#pragma unroll
    for (int j = 0; j < 4; ++j) { v[j] = xr[64 * j]; s += (v[j].x * v[j].x + v[j].y * v[j].y) + (v[j].z * v[j].z + v[j].w * v[j].w); }
    const float rstd = 1.0f / sqrtf(wave_sum(s) * (1.f / D) + RMS_EPS);
#pragma unroll
    for (int j = 0; j < 4; ++j) xr[64 * j] = v[j] * rstd * gr[64 * j];
}

#ifdef HOST_EMU
__device__ __forceinline__ float red8(float v) { v += __shfl_xor(v, 1); v += __shfl_xor(v, 2); v += __shfl_xor(v, 4); return v; }
__device__ __forceinline__ float red16(float v) { v = red8(v); v += __shfl_xor(v, 8); return v; }
#else
template <int CTRL> __device__ __forceinline__ float dpp_f(float v) { return __builtin_bit_cast(float, __builtin_amdgcn_update_dpp(0, __builtin_bit_cast(int, v), CTRL, 0xf, 0xf, true)); }
__device__ __forceinline__ float red8(float v) { v += dpp_f<0xB1>(v); v += dpp_f<0x4E>(v); v += dpp_f<0x141>(v); return v; }
__device__ __forceinline__ float red16(float v) { v = red8(v); v += dpp_f<0x140>(v); return v; }
#endif
__device__ __forceinline__ f32x4 sig4g(const f32x4 v) { return (f32x4){sigm(v[0]), sigm(v[1]), sigm(v[2]), sigm(v[3])}; }
__device__ __forceinline__ void rms_row2_f32(float* xrow, size_t step, const float* g, int lane) {
    f32x4* xa = (f32x4*)xrow + lane; f32x4* xb = (f32x4*)(xrow + step) + lane; const f32x4* gr = (const f32x4*)g + lane;
    f32x4 va[4], vb[4]; float sa = 0.f, sb = 0.f;
#pragma unroll
    for (int j = 0; j < 4; ++j) { va[j] = xa[64 * j]; vb[j] = xb[64 * j]; }
#pragma unroll
    for (int j = 0; j < 4; ++j) { sa += (va[j].x * va[j].x + va[j].y * va[j].y) + (va[j].z * va[j].z + va[j].w * va[j].w); sb += (vb[j].x * vb[j].x + vb[j].y * vb[j].y) + (vb[j].z * vb[j].z + vb[j].w * vb[j].w); }
#pragma unroll
    for (int o = 1; o < 64; o <<= 1) { sa += __shfl_xor(sa, o); sb += __shfl_xor(sb, o); }
    const float ra = 1.0f / sqrtf(sa * (1.f / D) + RMS_EPS), rb = 1.0f / sqrtf(sb * (1.f / D) + RMS_EPS);
#pragma unroll
    for (int j = 0; j < 4; ++j) { const f32x4 gg = gr[64 * j]; xa[64 * j] = va[j] * ra * gg; xb[64 * j] = vb[j] * rb * gg; }
}
__device__ __forceinline__ void ssd_conv_row(KArgs C, int layer, int m, int lane) {
    const int t = m % SEQ; const float* cw = C->in[I_CONVW] + layer * 4 * 768; const float* cb = C->in[I_CONVB] + layer * 768;
#pragma unroll
    for (int i = 0; i < 3; ++i) { const int ch = i * 256 + lane * 4; const bf16* p = WSP(const bf16, WS_XBC) + (size_t)m * 768 + ch;
        f32x4 a = *(const f32x4*)(cb + ch);
#pragma unroll
        for (int q = 0; q < 4; ++q) if (t - 3 + q >= 0) { const u32x2 w = *(const u32x2*)(p - (3 - q) * 768); const f32x4 cq = *(const f32x4*)(cw + q * 768 + ch);
            a += cq * (f32x4){lo_bf(w.x), hi_bf(w.x), lo_bf(w.y), hi_bf(w.y)}; }
        a = a * sig4g(a);
        u32x2 o; o.x = pk2(a.x, a.y); o.y = pk2(a.z, a.w); *(u32x2*)(WSP(bf16, WS_XBA) + (size_t)m * 768 + ch) = o; }
}
__device__ __forceinline__ void ssd_conv_row2(KArgs C, int layer, int m, int step, int lane) {
    const float* cw = C->in[I_CONVW] + layer * 4 * 768; const float* cb = C->in[I_CONVB] + layer * 768;
    u32x2 w[2][3][4]; f32x4 cq[3][4], bb[3];
#pragma unroll
    for (int i = 0; i < 3; ++i) { const int ch = i * 256 + lane * 4; bb[i] = *(const f32x4*)(cb + ch);
#pragma unroll
        for (int q = 0; q < 4; ++q) { cq[i][q] = *(const f32x4*)(cw + q * 768 + ch);
#pragma unroll
            for (int r = 0; r < 2; ++r) { const int mm = m + r * step, t = mm % SEQ; const bf16* p = WSP(const bf16, WS_XBC) + (size_t)mm * 768 + ch;
                if (t - 3 + q >= 0) w[r][i][q] = *(const u32x2*)(p - (3 - q) * 768); else { w[r][i][q].x = 0u; w[r][i][q].y = 0u; } } } }
#pragma unroll
    for (int r = 0; r < 2; ++r)
#pragma unroll
        for (int i = 0; i < 3; ++i) { const int ch = i * 256 + lane * 4; f32x4 a = bb[i];
#pragma unroll
            for (int q = 0; q < 4; ++q) a += cq[i][q] * (f32x4){lo_bf(w[r][i][q].x), hi_bf(w[r][i][q].x), lo_bf(w[r][i][q].y), hi_bf(w[r][i][q].y)};
            a = a * sig4g(a);
            u32x2 o; o.x = pk2(a.x, a.y); o.y = pk2(a.z, a.w); *(u32x2*)(WSP(bf16, WS_XBA) + (size_t)(m + r * step) * 768 + ch) = o; }
}
__device__ __forceinline__ void ssd_unit(KArgs C, int layer, int unit, unsigned char* lds) {
    const int tid = fresh_tid(), lane = tid & 63, wave = tid >> 6, bl = unit >> 3, h = unit & 7, gi = h >> 2, pp = tid >> 3, c8 = (tid & 7) * 8, c16 = lane & 15, q = lane >> 4;
    bf16* Cb = (bf16*)lds; bf16* Bb = Cb + 4096; bf16* XT = Bb + 4096; bf16* BwT = XT + 4096; bf16* Pm = BwT + 4096; float* Yo = (float*)(Pm + 4096); float* dts = Yo + 8192; float* acs = dts + 128;
    const bf16* XA = WSP(const bf16, WS_XBA) + (size_t)bl * SEQ * 768 + (size_t)pp * 768 + c8;
    const bf16* SMp = WSP(const bf16, WS_SM) + (size_t)bl * SEQ * 256;
    const bf16* Zp = WSP(const bf16, WS_Z) + (size_t)bl * SEQ * 512 + (size_t)pp * 512 + h * 64 + c8;
    bf16* YA = WSP(bf16, WS_Y) + (size_t)bl * SEQ * 512 + (size_t)pp * 512 + h * 64 + c8;
    const float dtb = C->in[I_DTB][layer * 8 + h], A = -__expf(C->in[I_ALOG][layer * 8 + h]), Dh = C->in[I_SSDD][layer * 8 + h];
    f32x4_t Sd[2]; bf16x8_t Sf; Sd[0] = (f32x4_t){0.f, 0.f, 0.f, 0.f}; Sd[1] = Sd[0]; { u32x2 z; z.x = 0u; z.y = 0u; Sf = frag2(z, z); }
    const int pt = wave & 3, nh = wave >> 2;
    u32x4 fx, fb, fc, fz;
#define SSD_FETCH(c0_) do { const bf16* q_ = XA + (size_t)(c0_) * 768; fx = *(const u32x4*)(q_ + h * 64); fb = *(const u32x4*)(q_ + 512 + gi * 64); fc = *(const u32x4*)(q_ + 640 + gi * 64); fz = *(const u32x4*)(Zp + (size_t)(c0_) * 512); } while (0)
#define SSD_DT(c0_, par) do { if (wave == 0) { const float dt_ = softplusf(bf2f(SMp[(size_t)((c0_) + lane) * 256 + h]) + dtb); float a_ = A * dt_; \
        _Pragma("unroll") for (int o_ = 1; o_ < 64; o_ <<= 1) { const float t_ = __shfl_up(a_, o_); if (lane >= o_) a_ += t_; } dts[(par) * 64 + lane] = dt_; acs[(par) * 64 + lane] = a_; } } while (0)
    LDS_SYNC();
    SSD_FETCH(0); SSD_DT(0, 0);
    for (int c0 = 0, par = 0; c0 < SEQ; c0 += 64, par ^= 1) {
        LDS_SYNC();
        const u32x4 xk = fx, zk = fz;
        {
          const float dt = dts[par * 64 + pp], ea = __expf(acs[par * 64 + 63] - acs[par * 64 + pp]);
          *(u32x4*)(Cb + pp * 64 + c8) = fc; *(u32x4*)(Bb + pp * 64 + c8) = fb;
          f32x4 x0, x1, b0, b1; pg8::unpack8(fx, x0, x1); pg8::unpack8(fb, b0, b1); x0 = x0 * dt; x1 = x1 * dt; b0 = b0 * ea; b1 = b1 * ea;
#pragma unroll
          for (int i = 0; i < 4; ++i) { XT[(c8 + i) * 64 + pp] = f2bf(x0[i]); XT[(c8 + 4 + i) * 64 + pp] = f2bf(x1[i]); BwT[(c8 + i) * 64 + pp] = f2bf(b0[i]); BwT[(c8 + 4 + i) * 64 + pp] = f2bf(b1[i]); } }
        if (c0 + 64 < SEQ) { SSD_FETCH(c0 + 64); SSD_DT(c0 + 64, par ^ 1); }
        LDS_SYNC();
        {
          const f32x4_t z4 = {0.f, 0.f, 0.f, 0.f};
#pragma unroll
          for (int i = 0; i < 2; ++i) { const int id = wave + 8 * i, lt = id >> 2, st = id & 3; f32x4_t g = z4;
              if (st <= lt) {
#pragma unroll
                  for (int ks = 0; ks < 2; ++ks) g = __builtin_amdgcn_mfma_f32_16x16x32_bf16(*(const bf16x8_t*)(Cb + (16 * lt + c16) * 64 + 32 * ks + 8 * q), *(const bf16x8_t*)(Bb + (16 * st + c16) * 64 + 32 * ks + 8 * q), g, 0, 0, 0);
                  const float as_ = acs[par * 64 + 16 * st + c16];
#pragma unroll
                  for (int r = 0; r < 4; ++r) { const int l = 16 * lt + 4 * q + r; g[r] = (16 * st + c16 <= l) ? g[r] * __expf(acs[par * 64 + l] - as_) : 0.f; } }
#pragma unroll
              for (int r = 0; r < 4; ++r) Pm[(16 * lt + 4 * q + r) * 64 + 16 * st + c16] = f2bf(g[r]); }
#pragma unroll
          for (int lt = 0; lt < 4; ++lt) { const bf16* cr = Cb + (16 * lt + c16) * 64 + 32 * nh + 4 * q;
              const f32x4_t yo = __builtin_amdgcn_mfma_f32_16x16x32_bf16(frag2(*(const u32x2*)cr, *(const u32x2*)(cr + 16)), Sf, z4, 0, 0, 0);
#pragma unroll
              for (int r = 0; r < 4; ++r) Yo[nh * 4096 + (16 * lt + 4 * q + r) * 64 + 16 * pt + c16] = yo[r]; }
          const float eL = __expf(acs[par * 64 + 63]);
          const bf16x8_t xb0 = *(const bf16x8_t*)(XT + (16 * pt + c16) * 64 + 8 * q), xb1 = *(const bf16x8_t*)(XT + (16 * pt + c16) * 64 + 32 + 8 * q);
#pragma unroll
          for (int i = 0; i < 2; ++i) { const bf16* br = BwT + (16 * (2 * nh + i) + c16) * 64 + 8 * q; f32x4_t cin = Sd[i] * eL;
              cin = __builtin_amdgcn_mfma_f32_16x16x32_bf16(*(const bf16x8_t*)br, xb0, cin, 0, 0, 0); Sd[i] = __builtin_amdgcn_mfma_f32_16x16x32_bf16(*(const bf16x8_t*)(br + 32), xb1, cin, 0, 0, 0); }
          u32x2 lo, hi; lo.x = pk2(Sd[0][0], Sd[0][1]); lo.y = pk2(Sd[0][2], Sd[0][3]); hi.x = pk2(Sd[1][0], Sd[1][1]); hi.y = pk2(Sd[1][2], Sd[1][3]); Sf = frag2(lo, hi); }
        LDS_SYNC();
        {
          const f32x4_t z4 = {0.f, 0.f, 0.f, 0.f};
#pragma unroll
          for (int i = 0; i < 2; ++i) { const int id = wave + 8 * i, lt = id >> 2, p2 = id & 3;
              f32x4_t y = __builtin_amdgcn_mfma_f32_16x16x32_bf16(*(const bf16x8_t*)(Pm + (16 * lt + c16) * 64 + 8 * q), *(const bf16x8_t*)(XT + (16 * p2 + c16) * 64 + 8 * q), z4, 0, 0, 0);
              if (lt >= 2) y = __builtin_amdgcn_mfma_f32_16x16x32_bf16(*(const bf16x8_t*)(Pm + (16 * lt + c16) * 64 + 32 + 8 * q), *(const bf16x8_t*)(XT + (16 * p2 + c16) * 64 + 32 + 8 * q), y, 0, 0, 0);
#pragma unroll
              for (int r = 0; r < 4; ++r) { const int l = 16 * lt + 4 * q + r, o = l * 64 + 16 * p2 + c16; Yo[o] = y[r] + __expf(acs[par * 64 + l]) * (Yo[o] + Yo[4096 + o]); } } }
        LDS_SYNC();
        {
          f32x4 x0, x1, z0, z1; pg8::unpack8(xk, x0, x1); pg8::unpack8(zk, z0, z1);
          const f32x4 y0 = (*(const f32x4*)(Yo + pp * 64 + c8) + Dh * x0) * z0 * sig4g(z0), y1 = (*(const f32x4*)(Yo + pp * 64 + c8 + 4) + Dh * x1) * z1 * sig4g(z1);
          *(u32x4*)(YA + (size_t)c0 * 512) = pg8::pack8(y0, y1); }
    }
#undef SSD_FETCH
#undef SSD_DT
}
__device__ __forceinline__ void ssd_norm_item4(KArgs C, int layer, int item0, int stride, int nitems, int lane) {
    u32x2 w[4]; bf16* p[4];
#pragma unroll
    for (int q = 0; q < 4; ++q) { const int item = item0 + q * stride; p[q] = WSP(bf16, WS_Y) + (size_t)((item < nitems ? item : item0) >> 1) * 512 + ((item < nitems ? item : item0) & 1) * 256 + lane * 4; w[q] = *(const u32x2*)p[q]; }
#pragma unroll
    for (int q = 0; q < 4; ++q) { const int item = item0 + q * stride; if (item < nitems) {
        float v[4] = {lo_bf(w[q].x), hi_bf(w[q].x), lo_bf(w[q].y), hi_bf(w[q].y)};
        const float rstd = 1.0f / sqrtf(wave_sum(v[0] * v[0] + v[1] * v[1] + v[2] * v[2] + v[3] * v[3]) * (1.f / 256) + RMS_EPS);
        const float* g = C->in[I_SSDNG] + layer * 512 + (item & 1) * 256 + lane * 4;
        u32x2 o; o.x = pk2(v[0] * rstd * g[0], v[1] * rstd * g[1]); o.y = pk2(v[2] * rstd * g[2], v[3] * rstd * g[3]); *(u32x2*)p[q] = o; } }
}
__device__ __forceinline__ void rwkv_prep_row(KArgs C, int layer, int m, int lane) {
    const int t = m % SEQ, col = 1536 + lane * 4;
    const bf16* cur = WSP(const bf16, WS_RW) + (size_t)m * 1792 + col;
    const u32x2 wc = *(const u32x2*)cur; u32x2 wp; wp.x = 0u; wp.y = 0u; if (t > 0) wp = *(const u32x2*)(cur - 1792);
    const f32x4 mu = *(const f32x4*)(C->in[I_MU] + layer * 1792 + col);
    float v[4] = {lo_bf(wc.x), hi_bf(wc.x), lo_bf(wc.y), hi_bf(wc.y)}; const float p[4] = {lo_bf(wp.x), hi_bf(wp.x), lo_bf(wp.y), hi_bf(wp.y)};
#pragma unroll
    for (int i = 0; i < 4; ++i) { v[i] = v[i] + (p[i] - v[i]) * mu[i]; v[i] = lane < 16 ? tanh_fast(v[i]) : (lane < 32 ? v[i] : sigm(v[i])); }
    u32x2 o; o.x = pk2(v[0], v[1]); o.y = pk2(v[2], v[3]); *(u32x2*)(WSP(bf16, WS_RA) + (size_t)m * 256 + lane * 4) = o;
}
__device__ __forceinline__ void ssd_conv_rows8(KArgs C, int layer, int m0, int lane) {
    const float* cw = C->in[I_CONVW] + layer * 4 * 768; const float* cb = C->in[I_CONVB] + layer * 768; const bool head = (m0 % SEQ) == 0;
    u32x2 w[3][11];
#pragma unroll
    for (int i = 0; i < 3; ++i) { const bf16* p = WSP(const bf16, WS_XBC) + (size_t)m0 * 768 + i * 256 + lane * 4;
#pragma unroll
        for (int r = 0; r < 11; ++r) { if (r >= 3 || !head) w[i][r] = *(const u32x2*)(p + (r - 3) * 768); else { w[i][r].x = 0u; w[i][r].y = 0u; } } }
#pragma unroll
    for (int i = 0; i < 3; ++i) { const int ch = i * 256 + lane * 4; const f32x4 bb = *(const f32x4*)(cb + ch); f32x4 cq[4], x[11];
#pragma unroll
        for (int q = 0; q < 4; ++q) cq[q] = *(const f32x4*)(cw + q * 768 + ch);
#pragma unroll
        for (int r = 0; r < 11; ++r) x[r] = (f32x4){lo_bf(w[i][r].x), hi_bf(w[i][r].x), lo_bf(w[i][r].y), hi_bf(w[i][r].y)};
#pragma unroll
        for (int r = 0; r < 8; ++r) { f32x4 a = bb;
#pragma unroll
            for (int q = 0; q < 4; ++q) a += cq[q] * x[r + q];
            a = a * sig4g(a);
            u32x2 o; o.x = pk2(a.x, a.y); o.y = pk2(a.z, a.w); *(u32x2*)(WSP(bf16, WS_XBA) + (size_t)(m0 + r) * 768 + ch) = o; } }
}
__device__ __forceinline__ void rwkv_prep_rows8(KArgs C, int layer, int m0, int lane) {
    const int col = 1536 + lane * 4; const f32x4 mu = *(const f32x4*)(C->in[I_MU] + layer * 1792 + col); const bool head = (m0 % SEQ) == 0;
    const bf16* cur = WSP(const bf16, WS_RW) + (size_t)m0 * 1792 + col; u32x2 w[9];
#pragma unroll
    for (int r = 0; r < 9; ++r) { if (r >= 1 || !head) w[r] = *(const u32x2*)(cur + (r - 1) * 1792); else { w[r].x = 0u; w[r].y = 0u; } }
#pragma unroll
    for (int r = 0; r < 8; ++r) { float v[4] = {lo_bf(w[r + 1].x), hi_bf(w[r + 1].x), lo_bf(w[r + 1].y), hi_bf(w[r + 1].y)}; const float p[4] = {lo_bf(w[r].x), hi_bf(w[r].x), lo_bf(w[r].y), hi_bf(w[r].y)};
#pragma unroll
        for (int i = 0; i < 4; ++i) { v[i] = v[i] + (p[i] - v[i]) * mu[i]; v[i] = lane < 16 ? tanh_fast(v[i]) : (lane < 32 ? v[i] : sigm(v[i])); }
        u32x2 o; o.x = pk2(v[0], v[1]); o.y = pk2(v[2], v[3]); *(u32x2*)(WSP(bf16, WS_RA) + (size_t)(m0 + r) * 256 + lane * 4) = o; }
}
__device__ __forceinline__ void rwkv_prep_row2(KArgs C, int layer, int m, int step, int lane) {
    const int col = 1536 + lane * 4; const f32x4 mu = *(const f32x4*)(C->in[I_MU] + layer * 1792 + col);
    u32x2 wc[2], wp[2];
#pragma unroll
    for (int r = 0; r < 2; ++r) { const int mm = m + r * step; const bf16* cur = WSP(const bf16, WS_RW) + (size_t)mm * 1792 + col; wc[r] = *(const u32x2*)cur;
        if (mm % SEQ > 0) wp[r] = *(const u32x2*)(cur - 1792); else { wp[r].x = 0u; wp[r].y = 0u; } }
#pragma unroll
    for (int r = 0; r < 2; ++r) { float v[4] = {lo_bf(wc[r].x), hi_bf(wc[r].x), lo_bf(wc[r].y), hi_bf(wc[r].y)}; const float p[4] = {lo_bf(wp[r].x), hi_bf(wp[r].x), lo_bf(wp[r].y), hi_bf(wp[r].y)};
#pragma unroll
        for (int i = 0; i < 4; ++i) { v[i] = v[i] + (p[i] - v[i]) * mu[i]; v[i] = lane < 16 ? tanh_fast(v[i]) : (lane < 32 ? v[i] : sigm(v[i])); }
        u32x2 o; o.x = pk2(v[0], v[1]); o.y = pk2(v[2], v[3]); *(u32x2*)(WSP(bf16, WS_RA) + (size_t)(m + r * step) * 256 + lane * 4) = o; }
}
__device__ __forceinline__ void rwkv_unit(KArgs C, int layer, int unit, unsigned char* lds) {
    constexpr int SLOT = 16704, O_RT = 2048, O_BTL = 4096, O_KTL = 6144, O_BHT = 8192, O_KHT = 10240, O_VT = 12288, O_TM = 14336, O_AAK = 14848, O_RB = 15360, O_RK = 15872, O_DL = 16384, O_BON = 16640;
    const int tid = fresh_tid(), lane = tid & 63, wave = tid >> 6, bl = unit >> 3, h = unit & 7, pt = tid >> 3, k8 = (tid & 7) * 8, cc = pt >> 4, tl = pt & 15, hc = h * 64 + k8;
    float* WL = (float*)(lds + 4 * SLOT); float* Nf = WL + 4096; float* Yb = Nf + 1024; float* ct_ = Yb + 4096;
    const bf16* RW = WSP(const bf16, WS_RW) + (size_t)bl * SEQ * 1792 + hc;
    const float* WLG = WSP(const float, WS_WLOG) + (size_t)bl * SEQ * 512 + hc;
    const bf16* AS = WSP(const bf16, WS_ASIG) + (size_t)bl * SEQ * 512 + hc;
    const bf16* GG = WSP(const bf16, WS_GG) + (size_t)bl * SEQ * 512 + hc;
    bf16* YC = WSP(bf16, WS_Y) + (size_t)2 * MG * 512 + (size_t)bl * SEQ * 512 + hc;
    LDS_SYNC();
    { const int row = tid >> 6, j = tid & 63; const float* src = row == 0 ? C->in[I_MU] + layer * 1792 : row == 1 ? C->in[I_MU] + layer * 1792 + 512 : row == 2 ? C->in[I_MU] + layer * 1792 + 1024
          : row == 3 ? C->in[I_KK] + layer * 512 : row == 4 ? C->in[I_KA] + layer * 512 : row == 5 ? C->in[I_RK] + layer * 512 : row == 6 ? C->in[I_LNG] + layer * 512 : C->in[I_LNB] + layer * 512;
      ct_[tid] = src[h * 64 + j]; }
    f32x4_t Sd[4]; bf16x8_t Sf[2];
#pragma unroll
    for (int i = 0; i < 4; ++i) Sd[i] = (f32x4_t){0.f, 0.f, 0.f, 0.f};
    { u32x2 z; z.x = 0u; z.y = 0u; Sf[0] = frag2(z, z); Sf[1] = Sf[0]; }
    u32x4 rc, rp, kc, kp, vc, vp, ac, gc; f32x4 wl0, wl1;
#define RWKV_FETCH(c0_) do { const int tt_ = (c0_) + pt; const bf16* q_ = RW + (size_t)tt_ * 1792; \
        rc = *(const u32x4*)q_; kc = *(const u32x4*)(q_ + 512); vc = *(const u32x4*)(q_ + 1024); \
        if (tt_ > 0) { rp = *(const u32x4*)(q_ - 1792); kp = *(const u32x4*)(q_ - 1792 + 512); vp = *(const u32x4*)(q_ - 1792 + 1024); } else { rp = (u32x4){0u, 0u, 0u, 0u}; kp = rp; vp = rp; } \
        wl0 = *(const f32x4*)(WLG + (size_t)tt_ * 512); wl1 = *(const f32x4*)(WLG + (size_t)tt_ * 512 + 4); ac = *(const u32x4*)(AS + (size_t)tt_ * 512); gc = *(const u32x4*)(GG + (size_t)tt_ * 512); } while (0)
    RWKV_FETCH(0);
    LDS_SYNC();
    for (int c0 = 0; c0 < SEQ; c0 += 64) {
        unsigned char* slot = lds + cc * SLOT;
        f32x4 r0, r1, kq0, kq1, v0, v1, kk0, kk1, b0, b1; const u32x4 gkeep = gc; const f32x4 wk0 = wl0, wk1 = wl1; float bo;
        { f32x4 c0_, c1_, p0_, p1_, a0, a1;
          pg8::unpack8(rc, c0_, c1_); pg8::unpack8(rp, p0_, p1_); r0 = c0_ + (p0_ - c0_) * *(const f32x4*)(ct_ + k8); r1 = c1_ + (p1_ - c1_) * *(const f32x4*)(ct_ + k8 + 4);
          pg8::unpack8(kc, c0_, c1_); pg8::unpack8(kp, p0_, p1_); const f32x4 k00 = c0_ + (p0_ - c0_) * *(const f32x4*)(ct_ + 64 + k8), k01 = c1_ + (p1_ - c1_) * *(const f32x4*)(ct_ + 64 + k8 + 4);
          pg8::unpack8(vc, c0_, c1_); pg8::unpack8(vp, p0_, p1_); v0 = c0_ + (p0_ - c0_) * *(const f32x4*)(ct_ + 128 + k8); v1 = c1_ + (p1_ - c1_) * *(const f32x4*)(ct_ + 128 + k8 + 4);
          pg8::unpack8(ac, a0, a1);
          kk0 = k00 * *(const f32x4*)(ct_ + 192 + k8); kk1 = k01 * *(const f32x4*)(ct_ + 192 + k8 + 4);
          const float inv = 1.0f / fmaxf(sqrtf(red8((kk0.x * kk0.x + kk0.y * kk0.y + kk0.z * kk0.z + kk0.w * kk0.w) + (kk1.x * kk1.x + kk1.y * kk1.y + kk1.z * kk1.z + kk1.w * kk1.w))), 1e-12f);
          kk0 = kk0 * inv; kk1 = kk1 * inv; b0 = kk0 * a0; b1 = kk1 * a1;
          kq0 = k00 * (1.0f + (a0 - 1.0f) * *(const f32x4*)(ct_ + 256 + k8)); kq1 = k01 * (1.0f + (a1 - 1.0f) * *(const f32x4*)(ct_ + 256 + k8 + 4));
          const f32x4 q0 = r0 * kq0 * *(const f32x4*)(ct_ + 320 + k8), q1 = r1 * kq1 * *(const f32x4*)(ct_ + 320 + k8 + 4);
          bo = red8((q0.x + q0.y + q0.z + q0.w) + (q1.x + q1.y + q1.z + q1.w));
          *(f32x4*)(WL + pt * 64 + k8) = wk0; *(f32x4*)(WL + pt * 64 + k8 + 4) = wk1; }
        if (c0 + 64 < SEQ) RWKV_FETCH(c0 + 64);
        LDS_SYNC();
        if (tid < 256) { const int c_ = tid >> 6, k_ = tid & 63; float w16[16], run = 0.f;
#pragma unroll
            for (int t = 0; t < 16; ++t) w16[t] = WL[(c_ * 16 + t) * 64 + k_];
#pragma unroll
            for (int t = 0; t < 16; ++t) { run += w16[t]; WL[(c_ * 16 + t) * 64 + k_] = run; }
            ((float*)(lds + c_ * SLOT + O_DL))[k_] = __expf(run); }
        LDS_SYNC();
        { const f32x4 cs0 = *(const f32x4*)(WL + pt * 64 + k8), cs1 = *(const f32x4*)(WL + pt * 64 + k8 + 4), d0 = *(const f32x4*)((const float*)(slot + O_DL) + k8), d1 = *(const f32x4*)((const float*)(slot + O_DL) + k8 + 4);
          f32x4 e0, e1, f0, f1, w0, w1;
#pragma unroll
          for (int i = 0; i < 4; ++i) { e0[i] = __expf(cs0[i]); e1[i] = __expf(cs1[i]); f0[i] = __builtin_amdgcn_rcpf(e0[i]); f1[i] = __builtin_amdgcn_rcpf(e1[i]); w0[i] = __expf(-wk0[i]); w1[i] = __expf(-wk1[i]); }
          const f32x4 bt0 = b0 * f0, bt1 = b1 * f1, kt0 = kq0 * f0, kt1 = kq1 * f1;
          *(u32x4*)((bf16*)slot + tl * 64 + k8) = pg8::pack8(-(kk0 * e0 * w0), -(kk1 * e1 * w1));
          *(u32x4*)((bf16*)(slot + O_RT) + tl * 64 + k8) = pg8::pack8(r0 * e0, r1 * e1);
          *(u32x4*)((bf16*)(slot + O_BTL) + tl * 64 + k8) = pg8::pack8(bt0, bt1);
          *(u32x4*)((bf16*)(slot + O_KTL) + tl * 64 + k8) = pg8::pack8(kt0, kt1);
          const f32x4 bh0 = bt0 * d0, bh1 = bt1 * d1, kh0 = kt0 * d0, kh1 = kt1 * d1;
          bf16* bht = (bf16*)(slot + O_BHT) + k8 * 16 + tl; bf16* kht = (bf16*)(slot + O_KHT) + k8 * 16 + tl; bf16* vt = (bf16*)(slot + O_VT) + k8 * 16 + tl;
#pragma unroll
          for (int i = 0; i < 4; ++i) { bht[i * 16] = f2bf(bh0[i]); bht[(i + 4) * 16] = f2bf(bh1[i]); kht[i * 16] = f2bf(kh0[i]); kht[(i + 4) * 16] = f2bf(kh1[i]); vt[i * 16] = f2bf(v0[i]); vt[(i + 4) * 16] = f2bf(v1[i]); } }
        LDS_SYNC();
        { unsigned char* sl = lds + (wave & 3) * SLOT; const int c16 = lane & 15, q = lane >> 4;
          const bf16x8_t a0 = *(const bf16x8_t*)((const bf16*)sl + c16 * 64 + 8 * q), a1 = *(const bf16x8_t*)((const bf16*)sl + c16 * 64 + 32 + 8 * q);
          const bf16x8_t bb0 = *(const bf16x8_t*)((const bf16*)(sl + O_BTL) + c16 * 64 + 8 * q), bb1 = *(const bf16x8_t*)((const bf16*)(sl + O_BTL) + c16 * 64 + 32 + 8 * q);
          const f32x4_t z4 = {0.f, 0.f, 0.f, 0.f};
          if (wave < 4) {
              f32x4_t n = __builtin_amdgcn_mfma_f32_16x16x32_bf16(a0, bb0, z4, 0, 0, 0); n = __builtin_amdgcn_mfma_f32_16x16x32_bf16(a1, bb1, n, 0, 0, 0);
              float* nf = Nf + (wave & 3) * 256;
#pragma unroll
              for (int r = 0; r < 4; ++r) nf[c16 * 16 + 4 * q + r] = (c16 < 4 * q + r) ? n[r] : 0.f;
              WAVE_SYNC();
              float tc[16];
#pragma unroll
              for (int t = 0; t < 16; ++t) tc[t] = (t == c16) ? 1.f : 0.f;
#pragma unroll
              for (int s2 = 0; s2 < 15; ++s2) { const f32x4 n0 = *(const f32x4*)(nf + s2 * 16), n1 = *(const f32x4*)(nf + s2 * 16 + 4), n2 = *(const f32x4*)(nf + s2 * 16 + 8), n3 = *(const f32x4*)(nf + s2 * 16 + 12);
                  const float ts = tc[s2]; const float nn[16] = {n0.x, n0.y, n0.z, n0.w, n1.x, n1.y, n1.z, n1.w, n2.x, n2.y, n2.z, n2.w, n3.x, n3.y, n3.z, n3.w};
#pragma unroll
                  for (int t = 0; t < 16; ++t) if (t > s2) tc[t] += nn[t] * ts; }
              if (q == 0) { bf16* tm = (bf16*)(sl + O_TM) + c16;
#pragma unroll
                  for (int t = 0; t < 16; ++t) tm[t * 16] = f2bf(tc[t]); }
          } else {
              const bf16x8_t r0f = *(const bf16x8_t*)((const bf16*)(sl + O_RT) + c16 * 64 + 8 * q), r1f = *(const bf16x8_t*)((const bf16*)(sl + O_RT) + c16 * 64 + 32 + 8 * q);
              const bf16x8_t kb0 = *(const bf16x8_t*)((const bf16*)(sl + O_KTL) + c16 * 64 + 8 * q), kb1 = *(const bf16x8_t*)((const bf16*)(sl + O_KTL) + c16 * 64 + 32 + 8 * q);
              f32x4_t ak = __builtin_amdgcn_mfma_f32_16x16x32_bf16(a0, kb0, z4, 0, 0, 0); ak = __builtin_amdgcn_mfma_f32_16x16x32_bf16(a1, kb1, ak, 0, 0, 0);
              f32x4_t rb = __builtin_amdgcn_mfma_f32_16x16x32_bf16(r0f, bb0, z4, 0, 0, 0); rb = __builtin_amdgcn_mfma_f32_16x16x32_bf16(r1f, bb1, rb, 0, 0, 0);
              f32x4_t rk = __builtin_amdgcn_mfma_f32_16x16x32_bf16(r0f, kb0, z4, 0, 0, 0); rk = __builtin_amdgcn_mfma_f32_16x16x32_bf16(r1f, kb1, rk, 0, 0, 0);
#pragma unroll
              for (int r = 0; r < 4; ++r) { const int t = 4 * q + r;
                  ((bf16*)(sl + O_AAK))[t * 16 + c16] = f2bf(c16 < t ? ak[r] : 0.f); ((bf16*)(sl + O_RB))[t * 16 + c16] = f2bf(c16 <= t ? rb[r] : 0.f); ((bf16*)(sl + O_RK))[t * 16 + c16] = f2bf(c16 <= t ? rk[r] : 0.f); }
          } }
        LDS_SYNC();
        if (wave < 4) { const int c16 = lane & 15, q = lane >> 4, vcol = 16 * wave + c16; u32x2 zz; zz.x = 0u; zz.y = 0u; const f32x4_t z4 = {0.f, 0.f, 0.f, 0.f};
#pragma unroll
            for (int ch = 0; ch < 4; ++ch) { const unsigned char* sl = lds + ch * SLOT;
                const bf16* at = (const bf16*)sl + c16 * 64 + 4 * q; const bf16* rt = (const bf16*)(sl + O_RT) + c16 * 64 + 4 * q;
                const bf16x8_t af0 = frag2(*(const u32x2*)at, *(const u32x2*)(at + 16)), af1 = frag2(*(const u32x2*)(at + 32), *(const u32x2*)(at + 48));
                const bf16x8_t rf0 = frag2(*(const u32x2*)rt, *(const u32x2*)(rt + 16)), rf1 = frag2(*(const u32x2*)(rt + 32), *(const u32x2*)(rt + 48));
                const u32x2 vq = *(const u32x2*)((const bf16*)(sl + O_VT) + vcol * 16 + 4 * q);
                const u32x2 aq = *(const u32x2*)((const bf16*)(sl + O_AAK) + c16 * 16 + 4 * q), tq = *(const u32x2*)((const bf16*)(sl + O_TM) + c16 * 16 + 4 * q);
                const u32x2 rbq = *(const u32x2*)((const bf16*)(sl + O_RB) + c16 * 16 + 4 * q), rkq = *(const u32x2*)((const bf16*)(sl + O_RK) + c16 * 16 + 4 * q);
                f32x4_t rhs = __builtin_amdgcn_mfma_f32_16x16x32_bf16(frag2(zz, aq), frag2(zz, vq), z4, 0, 0, 0); rhs = __builtin_amdgcn_mfma_f32_16x16x32_bf16(af0, Sf[0], rhs, 0, 0, 0);
                { const f32x4_t r2 = __builtin_amdgcn_mfma_f32_16x16x32_bf16(af1, Sf[1], z4, 0, 0, 0); rhs = rhs + r2; }
                u32x2 rl; rl.x = pk2(rhs[0], rhs[1]); rl.y = pk2(rhs[2], rhs[3]);
                const f32x4_t U = __builtin_amdgcn_mfma_f32_16x16x32_bf16(frag2(tq, zz), frag2(rl, zz), z4, 0, 0, 0);
                u32x2 ul; ul.x = pk2(U[0], U[1]); ul.y = pk2(U[2], U[3]); const bf16x8_t uv = frag2(ul, vq);
                f32x4_t y = __builtin_amdgcn_mfma_f32_16x16x32_bf16(rf0, Sf[0], z4, 0, 0, 0); y = __builtin_amdgcn_mfma_f32_16x16x32_bf16(rf1, Sf[1], y, 0, 0, 0);
                y = __builtin_amdgcn_mfma_f32_16x16x32_bf16(frag2(rbq, rkq), uv, y, 0, 0, 0);
#pragma unroll
                for (int r = 0; r < 4; ++r) Yb[(ch * 16 + 4 * q + r) * 64 + vcol] = y[r];
#pragma unroll
                for (int kt = 0; kt < 4; ++kt) { const f32x4 dl = *(const f32x4*)((const float*)(sl + O_DL) + 16 * kt + 4 * q);
                    const u32x2 bq = *(const u32x2*)((const bf16*)(sl + O_BHT) + (16 * kt + c16) * 16 + 4 * q), kq = *(const u32x2*)((const bf16*)(sl + O_KHT) + (16 * kt + c16) * 16 + 4 * q);
                    const f32x4_t cin = {Sd[kt][0] * dl.x, Sd[kt][1] * dl.y, Sd[kt][2] * dl.z, Sd[kt][3] * dl.w};
                    Sd[kt] = __builtin_amdgcn_mfma_f32_16x16x32_bf16(frag2(bq, kq), uv, cin, 0, 0, 0); }
#pragma unroll
                for (int s2 = 0; s2 < 2; ++s2) { u32x2 lo, hi; lo.x = pk2(Sd[2 * s2][0], Sd[2 * s2][1]); lo.y = pk2(Sd[2 * s2][2], Sd[2 * s2][3]); hi.x = pk2(Sd[2 * s2 + 1][0], Sd[2 * s2 + 1][1]); hi.y = pk2(Sd[2 * s2 + 1][2], Sd[2 * s2 + 1][3]); Sf[s2] = frag2(lo, hi); }
            } }
        LDS_SYNC();
        { const f32x4 y0 = *(const f32x4*)(Yb + pt * 64 + k8), y1 = *(const f32x4*)(Yb + pt * 64 + k8 + 4);
          const float mean = red8((y0.x + y0.y + y0.z + y0.w) + (y1.x + y1.y + y1.z + y1.w)) * (1.f / 64); const f32x4 d0 = y0 - mean, d1 = y1 - mean;
          const float rstd = 1.0f / sqrtf(red8((d0.x * d0.x + d0.y * d0.y + d0.z * d0.z + d0.w * d0.w) + (d1.x * d1.x + d1.y * d1.y + d1.z * d1.z + d1.w * d1.w)) * (1.f / 64) + GN_EPS);
          f32x4 g0, g1; pg8::unpack8(gkeep, g0, g1);
          const f32x4 o0 = (d0 * rstd * *(const f32x4*)(ct_ + 384 + k8) + *(const f32x4*)(ct_ + 448 + k8) + bo * v0) * g0, o1 = (d1 * rstd * *(const f32x4*)(ct_ + 384 + k8 + 4) + *(const f32x4*)(ct_ + 448 + k8 + 4) + bo * v1) * g1;
          *(u32x4*)(YC + (size_t)(c0 + pt) * 512) = pg8::pack8(o0, o1); }
    }
#undef RWKV_FETCH
}

__device__ __forceinline__ void s5_unit(KArgs C, int layer, int unit, unsigned char* lds) {
    const int tid = fresh_tid(), lane = tid & 63, wave = tid >> 6, bl = unit >> 5, g = unit & 31, c16 = lane & 15, q = lane >> 4, sg = wave & 3, th = wave >> 2, p = 16 * sg + c16;
    constexpr int SP = 136;
    float* us = (float*)lds; float* ends = us + 1024; bf16* St = (bf16*)(ends + 16 * 128);
    const bf16* U = WSP(const bf16, WS_U) + (size_t)bl * SEQ * 512 + g * 16;
    bf16* YD0 = WSP(bf16, WS_YD0) + (size_t)bl * SEQ * 512 + g * 16;
    const size_t wo = (layer & 1) ? WDELTA : 0;
    bf16x8_t bre, bim;
    { const float* bb = WSP(const float, WS_BBAR + wo) + ((size_t)g * 64 + p) * 32; u32x4 wr_, wi_;
      if (q < 2) { const float* b8 = bb + 16 * q; wr_.x = pk2(b8[0], b8[2]); wr_.y = pk2(b8[4], b8[6]); wr_.z = pk2(b8[8], b8[10]); wr_.w = pk2(b8[12], b8[14]);
                   wi_.x = pk2(b8[1], b8[3]); wi_.y = pk2(b8[5], b8[7]); wi_.z = pk2(b8[9], b8[11]); wi_.w = pk2(b8[13], b8[15]); }
      else { wr_ = (u32x4){0u, 0u, 0u, 0u}; wi_ = wr_; }
      bre = __builtin_bit_cast(bf16x8_t, wr_); bim = __builtin_bit_cast(bf16x8_t, wi_); }
    float apr[4], api[4];
    { const float ar = WSP(const float, WS_ABAR + wo)[(g * 64 + p) * 2], ai = WSP(const float, WS_ABAR + wo)[(g * 64 + p) * 2 + 1]; apr[0] = ar; api[0] = ai;
#pragma unroll
      for (int i = 1; i < 4; ++i) { apr[i] = apr[i - 1] * ar - api[i - 1] * ai; api[i] = apr[i - 1] * ai + api[i - 1] * ar; } }
    bf16x8_t cf[4];
    { const float* cre = C->in[I_S5CRE] + ((size_t)layer * 32 + g) * 1024 + c16 * 64; const float* cim = C->in[I_S5CIM] + ((size_t)layer * 32 + g) * 1024 + c16 * 64;
#pragma unroll
      for (int ks = 0; ks < 4; ++ks) { const int c0_ = 32 * ks + 8 * q; const float* src = c0_ < 64 ? cre + c0_ : cim + (c0_ - 64); const float sgn = c0_ < 64 ? 1.f : -1.f;
          u32x4 w; w.x = pk2(sgn * src[0], sgn * src[1]); w.y = pk2(sgn * src[2], sgn * src[3]); w.z = pk2(sgn * src[4], sgn * src[5]); w.w = pk2(sgn * src[6], sgn * src[7]); cf[ks] = __builtin_bit_cast(bf16x8_t, w); } }
    const float dj = C->in[I_S5D][layer * 512 + g * 16 + c16];
    float cr = 0.f, ci = 0.f;
    u32x2 fu; fu.x = 0u; fu.y = 0u;
#define S5_FETCH(c0_) do { if (tid < 256) fu = *(const u32x2*)(U + (size_t)((c0_) + (tid >> 2)) * 512 + (tid & 3) * 4); } while (0)
    S5_FETCH(0);
    for (int c0 = 0; c0 < SEQ; c0 += 64) {
        LDS_SYNC();
        if (tid < 256) *(f32x4*)(us + (tid >> 2) * 16 + (tid & 3) * 4) = (f32x4){lo_bf(fu.x), hi_bf(fu.x), lo_bf(fu.y), hi_bf(fu.y)};
        if (c0 + 64 < SEQ) S5_FETCH(c0 + 64);
        LDS_SYNC();
        float lr[2][4], li[2][4];
#pragma unroll
        for (int tt = 0; tt < 2; ++tt) { bf16x8_t af;
            if (q < 2) { const float* ur = us + (32 * th + 16 * tt + c16) * 16 + 8 * q; const f32x4 u0 = *(const f32x4*)ur, u1 = *(const f32x4*)(ur + 4);
                u32x4 w; w.x = pk2(u0.x, u0.y); w.y = pk2(u0.z, u0.w); w.z = pk2(u1.x, u1.y); w.w = pk2(u1.z, u1.w); af = __builtin_bit_cast(bf16x8_t, w); }
            else { const u32x4 z = {0u, 0u, 0u, 0u}; af = __builtin_bit_cast(bf16x8_t, z); }
            const f32x4_t z4 = {0.f, 0.f, 0.f, 0.f};
            const f32x4_t dre = __builtin_amdgcn_mfma_f32_16x16x32_bf16(af, bre, z4, 0, 0, 0), dim = __builtin_amdgcn_mfma_f32_16x16x32_bf16(af, bim, z4, 0, 0, 0);
            lr[tt][0] = dre[0]; li[tt][0] = dim[0];
#pragma unroll
            for (int r = 1; r < 4; ++r) { lr[tt][r] = apr[0] * lr[tt][r - 1] - api[0] * li[tt][r - 1] + dre[r]; li[tt][r] = apr[0] * li[tt][r - 1] + api[0] * lr[tt][r - 1] + dim[r]; }
            const int rho = (2 * th + tt) * 4 + q; ends[(rho * 64 + p) * 2] = lr[tt][3]; ends[(rho * 64 + p) * 2 + 1] = li[tt][3]; }
        LDS_SYNC();
        { float xr = cr, xi = ci; const int rho0 = (2 * th) * 4 + q;
          for (int rr = 0; rr < 16; ++rr) {
              if (rr == rho0 || rr == rho0 + 4) { const int tt = (rr == rho0) ? 0 : 1;
#pragma unroll
                  for (int r = 0; r < 4; ++r) { const float sr = lr[tt][r] + apr[r] * xr - api[r] * xi, si = li[tt][r] + apr[r] * xi + api[r] * xr; const int t = 32 * th + 16 * tt + 4 * q + r;
                      St[t * SP + p] = f2bf(sr); St[t * SP + 64 + p] = f2bf(si); } }
              const float er = ends[(rr * 64 + p) * 2], ei = ends[(rr * 64 + p) * 2 + 1]; const float nr = apr[3] * xr - api[3] * xi + er, ni = apr[3] * xi + api[3] * xr + ei; xr = nr; xi = ni; }
          cr = xr; ci = xi; }
        LDS_SYNC();
        if (wave < 4) { f32x4_t y = {0.f, 0.f, 0.f, 0.f};
#pragma unroll
            for (int ks = 0; ks < 4; ++ks) y = __builtin_amdgcn_mfma_f32_16x16x32_bf16(*(const bf16x8_t*)(St + (16 * wave + c16) * SP + 32 * ks + 8 * q), cf[ks], y, 0, 0, 0);
#pragma unroll
            for (int r = 0; r < 4; ++r) { const int t = 16 * wave + 4 * q + r; YD0[(size_t)(c0 + t) * 512 + c16] = f2bf(gelu_tanh(y[r] + dj * us[t * 16 + c16])); } }
    }
#undef S5_FETCH
}

__device__ __forceinline__ unsigned ord_key(float f) { const unsigned u = __float_as_uint(f); return (u & 0x80000000u) ? ~u : (u | 0x80000000u); }
__device__ __forceinline__ void dsa_vt_item(KArgs C, int item, int lane, bf16* scr) {
    const int tb = item % NK64, bh = item / NK64, h = bh & 7, bl = bh >> 3;
    const bf16* V = WSP(const bf16, WS_V) + ((size_t)bl * SEQ + tb * 64) * 512 + h * 64;
    WAVE_SYNC();
#pragma unroll
    for (int i = 0; i < 8; ++i) { const int tk = (lane >> 3) + 8 * i, c8 = (lane & 7) * 8; const u32x4 w = *(const u32x4*)(V + (size_t)tk * 512 + c8);
        unsigned* d = (unsigned*)(scr + tk * 66 + c8); d[0] = w.x; d[1] = w.y; d[2] = w.z; d[3] = w.w; }
    WAVE_SYNC();
    bf16* Vt = WSP(bf16, WS_VT) + ((size_t)bh * 64) * SEQ + tb * 64 + lane;
#pragma unroll 8
    for (int d = 0; d < 64; ++d) Vt[(size_t)d * SEQ] = scr[lane * 66 + d];
}
constexpr int IDX_CAP = 128, IDX_NBIN = 1024;
__device__ __forceinline__ void dsa_index_unit(KArgs C, int unit, int lane, int wave, unsigned char* lds) {
    const int oct = unit & 7, pairid = (unit >> 3) % (NK64 / 2), kx = (unit >> 3) / (NK64 / 2), bl = kx >> 1, c = (kx & 1) ? NK64 - 1 - pairid : pairid;
    const int t0 = c * 64 + oct * 8, nkeys = (c + 1) * 64, nk64 = c + 1; const size_t row0 = (size_t)bl * SEQ + t0;
    unsigned* mrow = WSP(unsigned, WS_MASK) + (row0 + wave) * MW;
    if (nkeys <= TOPK) { for (int w = lane; w < MW; w += 64) mrow[w] = (w * 32 < nkeys) ? 0xffffffffu : 0u; return; }
    float* scf = (float*)lds;
    unsigned* hist = (unsigned*)(lds + LDS_X) + wave * (IDX_NBIN / 2); unsigned* candv = (unsigned*)(lds + LDS_X + 8 * IDX_NBIN * 2) + wave * IDX_CAP; unsigned* candi = candv + 8 * IDX_CAP; unsigned* mword = (unsigned*)(lds + LDS_X + 8 * IDX_NBIN * 2 + 16 * IDX_CAP * 4) + wave * MW;
    const bf16* SMb = WSP(const bf16, WS_SM) + (size_t)bl * SEQ * 256;
    const int l31 = lane & 31, half = lane >> 5;
    const bf16* qa = SMb + (size_t)(t0 + (l31 >> 2)) * 256 + 8 + (l31 & 3) * 32 + 8 * half;
    const bf16x8_t a0 = *(const bf16x8_t*)qa, a1 = *(const bf16x8_t*)(qa + 16);
    u32x2 wraw[4];
#pragma unroll
    for (int g = 0; g < 4; ++g) wraw[g] = *(const u32x2*)(SMb + (size_t)(t0 + 2 * g + half) * 256 + 168);
    LDS_SYNC();
    {
      float wv[4][4];
#pragma unroll
      for (int g = 0; g < 4; ++g) { const u32x2 w = wraw[g]; wv[g][0] = lo_bf(w.x) * 0.5f; wv[g][1] = hi_bf(w.x) * 0.5f; wv[g][2] = lo_bf(w.y) * 0.5f; wv[g][3] = hi_bf(w.y) * 0.5f; }
      for (int kt0 = wave; kt0 < nk64 * 2; kt0 += 8 * NWAVES) {
          bf16x8_t b0[8], b1[8];
#pragma unroll
          for (int u4 = 0; u4 < 8; ++u4) { const int kt = kt0 + 8 * u4; const bf16* kb = WSP(const bf16, WS_KI) + ((size_t)bl * SEQ + (size_t)((kt < nk64 * 2 ? kt : wave) * 32 + l31)) * 32 + 8 * half;
              b0[u4] = *(const bf16x8_t*)kb; b1[u4] = *(const bf16x8_t*)(kb + 16); }
#pragma unroll
          for (int u4 = 0; u4 < 8; ++u4) { const int kt = kt0 + 8 * u4; if (kt < nk64 * 2) {
              f32x16 d;
#pragma unroll
              for (int r = 0; r < 16; ++r) d[r] = 0.f;
              d = __builtin_amdgcn_mfma_f32_32x32x16_bf16(a0, b0[u4], d, 0, 0, 0); d = __builtin_amdgcn_mfma_f32_32x32x16_bf16(a1, b1[u4], d, 0, 0, 0);
#pragma unroll
              for (int g = 0; g < 4; ++g) { float sc = 0.f;
#pragma unroll
                  for (int j = 0; j < 4; ++j) sc += wv[g][j] * fmaxf(d[4 * g + j] * 0.17677669529f, 0.f);
                  scf[(2 * g + half) * SEQ + kt * 32 + l31] = sc; } } }
      } }
    { const int tail0 = nkeys, tail1 = ((nk64 + 7) >> 3) * 512;
      for (int e = tail0 + (int)(threadIdx.x); e < tail1; e += NTHREADS) {
#pragma unroll
          for (int qq = 0; qq < 8; ++qq) scf[qq * SEQ + e] = -3.0e38f; } }
    LDS_SYNC();
    const float* sc = scf + wave * SEQ; constexpr float NEG = -3.0e38f; const int nb8 = (nk64 + 7) >> 3;
    float v[NK64];
#pragma unroll
    for (int ib = 0; ib < NK64 / 8; ++ib) if (ib < nb8) {
#pragma unroll
        for (int j = 0; j < 8; ++j) v[ib * 8 + j] = sc[(ib * 8 + j) * 64 + lane];
        SCHED_FENCE(); }
    float mn = INFINITY, mx = -INFINITY;
#pragma unroll
    for (int ib = 0; ib < NK64 / 8; ++ib) if (ib < nb8) {
#pragma unroll
        for (int j = 0; j < 8; ++j) { const float x = v[ib * 8 + j]; mx = fmaxf(mx, x); mn = fminf(mn, x == NEG ? INFINITY : x); } }
    mn = -wave_max(-mn); mx = wave_max(mx);
    const float scale = (mx > mn) ? ((float)(IDX_NBIN - 2) - 0.01f) / (mx - mn) : 0.f;
#pragma unroll
    for (int i = 0; i < IDX_NBIN / 128; ++i) hist[lane * (IDX_NBIN / 128) + i] = 0u;
    for (int w = lane; w < MW; w += 64) mword[w] = 0u;
    WAVE_SYNC();
#define IDX_BIN(x) ({ const float x_ = (x); int b_ = (int)(fmaxf(x_ - mn, 0.f) * scale + 1.0f); b_ = b_ > IDX_NBIN - 2 ? IDX_NBIN - 2 : b_; b_ + (__float_as_int(x_) >> 31) + (__float_as_int(x_) > 0 ? 1 : 0); })
#pragma unroll
    for (int ib = 0; ib < NK64 / 8; ++ib) if (ib < nb8) {
#pragma unroll
        for (int j = 0; j < 8; ++j) { const int b = IDX_BIN(v[ib * 8 + j]); atomicAdd(&hist[b >> 1], (b & 1) ? 0x10000u : 1u); v[ib * 8 + j] = __int_as_float(b); }
        SCHED_FENCE(); }
    WAVE_SYNC();
    int bstar, cgt;
    {
      unsigned hw[8]; int tot = 0;
#pragma unroll
      for (int i = 0; i < 8; ++i) { hw[i] = hist[lane * 8 + i]; tot += (int)(hw[i] & 0xffffu) + (int)(hw[i] >> 16); }
      int suf = tot;
#pragma unroll
      for (int o = 1; o < 64; o <<= 1) { const int t = __shfl_down(suf, o); if (lane + o < 64) suf += t; }
      const unsigned long long ge = __ballot(suf >= TOPK); const int L = 63 - __builtin_clzll(ge);
      int cum = __shfl(suf, L) - __shfl(tot, L); bstar = 16 * L; cgt = cum; bool found = false;
#pragma unroll
      for (int i = 7; i >= 0; --i) { const unsigned w = (unsigned)__shfl((int)hw[i], L); const int chi = (int)(w >> 16), clo = (int)(w & 0xffffu);
          if (!found && cum + chi >= TOPK) { bstar = 16 * L + 2 * i + 1; cgt = cum; found = true; } cum += found ? 0 : chi;
          if (!found && cum + clo >= TOPK) { bstar = 16 * L + 2 * i; cgt = cum; found = true; } cum += found ? 0 : clo; } }
    const int need = TOPK - cgt; int ncand = 0;
    const bool tiebin = bstar == IDX_BIN(0.0f);
    unsigned mylo = 0u, myhi = 0u;
#pragma unroll
    for (int ib = 0; ib < NK64 / 8; ++ib) if (ib < nb8) {
#pragma unroll
        for (int j = 0; j < 8; ++j) { const int i = ib * 8 + j; const int b = __float_as_int(v[i]);
            unsigned long long bs = __ballot(b > bstar); const unsigned long long bc = __ballot(b == bstar);
            if (bc != 0ull) {
                const int pos = ncand + (int)__builtin_amdgcn_mbcnt_hi((unsigned)(bc >> 32), __builtin_amdgcn_mbcnt_lo((unsigned)bc, 0u));
                if (tiebin) bs |= __ballot(b == bstar && pos < need);
                else if (b == bstar && pos < IDX_CAP) { candv[pos] = ord_key(sc[i * 64 + lane]); candi[pos] = (unsigned)(i * 64 + lane); }
                ncand += __popcll(bc); }
            if (lane == i) { mylo = (unsigned)bs; myhi = (unsigned)(bs >> 32); } }
        SCHED_FENCE(); }
    if (lane < nb8 * 8) { mword[2 * lane] = mylo; mword[2 * lane + 1] = myhi; }
#undef IDX_BIN
    WAVE_SYNC();
    if (tiebin) { }
    else if (ncand <= IDX_CAP) {
        for (int m = lane; m < ncand; m += 64) { const unsigned vm = candv[m]; int rank = 0;
#pragma unroll 4
            for (int j = 0; j < ncand; ++j) { const unsigned vj = candv[j]; rank += (vj > vm || (vj == vm && j < m)) ? 1 : 0; }
            if (rank < need) { const unsigned idx = candi[m]; atomicOr(&mword[idx >> 5], 1u << (idx & 31)); } }
    } else {
#pragma unroll
        for (int ib = 0; ib < NK64 / 8; ++ib) if (ib < nb8) {
#pragma unroll
            for (int j = 0; j < 8; ++j) v[ib * 8 + j] = sc[(ib * 8 + j) * 64 + lane]; }
        unsigned T = 0u;
        for (int bit = 31; bit >= 0; --bit) { const unsigned cand = T | (1u << bit); int cn = 0;
#pragma unroll
            for (int ib = 0; ib < NK64 / 8; ++ib) if (ib < nb8) {
#pragma unroll
                for (int j = 0; j < 8; ++j) cn += (ord_key(v[ib * 8 + j]) >= cand) ? 1 : 0; }
            if (wave_sum_i(cn) >= TOPK) T = cand; }
        int cg = 0;
#pragma unroll
        for (int ib = 0; ib < NK64 / 8; ++ib) if (ib < nb8) {
#pragma unroll
            for (int j = 0; j < 8; ++j) cg += (ord_key(v[ib * 8 + j]) > T) ? 1 : 0; }
        const int need2 = TOPK - wave_sum_i(cg); int taken = 0;
#pragma unroll
        for (int ib = 0; ib < NK64 / 8; ++ib) if (ib < nb8) {
#pragma unroll
            for (int j = 0; j < 8; ++j) { const int i = ib * 8 + j; const unsigned kv = ord_key(v[i]); const bool eq = kv == T; const unsigned long long be = __ballot(eq);
                const int pre = __popcll(be & ((1ull << lane) - 1ull)); const bool sel = (kv > T) || (eq && (taken + pre) < need2); taken += __popcll(be);
                const unsigned long long bs = __ballot(sel); if (lane == 0) { mword[2 * i] = (unsigned)bs; mword[2 * i + 1] = (unsigned)(bs >> 32); } } }
    }
    WAVE_SYNC();
#ifdef HOST_EMU
    if (lane == 0) { static int rows = 0, bad = 0, ties = 0, falls = 0; std::vector<int> id(nkeys); for (int i = 0; i < nkeys; ++i) id[i] = i;
        std::stable_sort(id.begin(), id.end(), [&](int a, int b) { return sc[a] > sc[b]; }); std::vector<unsigned> ref(MW, 0u); for (int i = 0; i < TOPK; ++i) ref[id[i] >> 5] |= 1u << (id[i] & 31);
        bool ok = true; for (int w = 0; w < MW; ++w) ok = ok && ref[w] == mword[w]; ++rows; bad += ok ? 0 : 1; ties += tiebin ? 1 : 0; falls += (!tiebin && ncand > IDX_CAP) ? 1 : 0;
        if ((rows & 63) == 0 || !ok) printf("[idx-check] rows %d bad %d tiebin %d fallback %d\n", rows, bad, ties, falls); }
#endif
    for (int w = lane; w < MW; w += 64) mrow[w] = mword[w];
}

constexpr int AT_KP = 72, AT_VP = 72, AT_BUF = 64 * AT_KP + 64 * AT_VP;
__device__ __forceinline__ void dsa_attn_half(KArgs C, int bl, int h, int cb, int tid, bf16* tiles, const float* btab) {
    const int lane = tid & 63, wave = tid >> 6, l31 = lane & 31, hh = lane >> 5, c = 4 * cb + (wave >> 1), qb = wave & 1, q0 = c * 64 + qb * 32, qpos = q0 + l31, q0s = __builtin_amdgcn_readfirstlane(q0);
    const size_t qrow = (size_t)bl * SEQ + qpos;
    const bf16* Qp = WSP(const bf16, WS_Q) + qrow * 512 + h * 64 + 8 * hh;
    const unsigned* Mp = WSP(const unsigned, WS_MASK) + qrow * MW;
    const bf16* gk = WSP(const bf16, WS_K) + ((size_t)bl * SEQ + (tid >> 3)) * 512 + h * 64 + (tid & 7) * 8;
    const bf16* gv = WSP(const bf16, WS_VT) + ((size_t)(bl * 8 + h) * 64 + (tid >> 3)) * SEQ + (tid & 7) * 8;
    const int lk = (tid >> 3) * AT_KP + (tid & 7) * 8, lv = 64 * AT_KP + (tid >> 3) * AT_VP + (tid & 7) * 8;
    constexpr float SC = 0.125f * 1.44269504089f;
    bf16x8_t qf[4];
#pragma unroll
    for (int s = 0; s < 4; ++s) qf[s] = *(const bf16x8_t*)(Qp + 16 * s);
    f32x16 O0, O1;
#pragma unroll
    for (int r = 0; r < 16; ++r) { O0[r] = 0.f; O1[r] = 0.f; }
    float m = -1e30f, lsum = 0.f;
    const int ntw = c + 1, nt = 4 * cb + 4;
    u32x4 prek = *(const u32x4*)gk, prev = *(const u32x4*)gv; u32x2 mwn = *(const u32x2*)Mp;
    LDS_SYNC();
    const float bfar = btab[0];
    *(u32x4*)(tiles + lk) = prek; *(u32x4*)(tiles + lv) = prev;
    if (nt > 1) { prek = *(const u32x4*)(gk + (size_t)64 * 512); prev = *(const u32x4*)(gv + 64); }
    for (int kt = 0; kt < nt; ++kt) {
        LDS_SYNC();
        const bf16* tb = tiles + (kt & 1) * AT_BUF; const u32x2 mw2 = mwn;
        if (kt + 1 < ntw) mwn = *(const u32x2*)(Mp + 2 * (kt + 1));
        if (kt < ntw) {
            f32x16 S[2];
#pragma unroll
            for (int t2 = 0; t2 < 2; ++t2) {
#pragma unroll
                for (int r = 0; r < 16; ++r) S[t2][r] = 0.f;
#pragma unroll
                for (int s = 0; s < 4; ++s) S[t2] = __builtin_amdgcn_mfma_f32_32x32x16_bf16(*(const bf16x8_t*)(tb + (t2 * 32 + l31) * AT_KP + 16 * s + 8 * hh), qf[s], S[t2], 0, 0, 0); }
#define AT_P2(P_, X0_, X1_, MW_, R_, ROW_) do { f32x2 pp_; pp_.x = __uint_as_float(__float_as_uint(__builtin_amdgcn_exp2f(X0_)) & bit_fill<ROW_>(MW_)); \
                pp_.y = __uint_as_float(__float_as_uint(__builtin_amdgcn_exp2f(X1_)) & bit_fill<ROW_ + 1>(MW_)); P_[R_] = pp_.x; P_[R_ + 1] = pp_.y; ps2 += pp_; } while (0)
#define AT_RESCALE(TM_) do { float tm_ = (TM_); tm_ = fmaxf(tm_, __shfl_xor(tm_, 32)); \
                if (__ballot(tm_ > m) != 0ull) { const float mn = fmaxf(m, tm_), alpha = __builtin_amdgcn_exp2f(m - mn); m = mn; lsum *= alpha; \
                    _Pragma("unroll") for (int r = 0; r < 16; ++r) { O0[r] *= alpha; O1[r] *= alpha; } } } while (0)
            f32x16 P[2]; f32x2 ps2 = (f32x2){0.f, 0.f}; float tm;
            const unsigned mwc0 = mw2.x >> (4 * hh), mwc1 = mw2.y >> (4 * hh);
            const bool far = (kt * 64 + 63 - q0s) <= -166;
            if (far) { float rm = fmaxf(S[0][0], S[1][0]);
#pragma unroll
                for (int r = 1; r < 16; ++r) rm = fmaxf(fmaxf(rm, S[0][r]), S[1][r]);
                tm = rm * SC + bfar;
            } else { tm = -1e30f;
#pragma unroll
                for (int t2 = 0; t2 < 2; ++t2) { const int rb = kt * 64 + t2 * 32 + 4 * hh - qpos + 256;
#pragma unroll
                    for (int r = 0; r < 16; ++r) { const int row = (r & 3) + 8 * (r >> 2); int ti = rb + row; ti = ti < 0 ? 0 : ti; tm = fmaxf(tm, S[t2][r] * SC + btab[ti]); } } }
            AT_RESCALE(tm);
            if (far) { const float ad = bfar - m;
#define AT_FAR(R_, ROW_) do { const f32x2 x0_ = (f32x2){S[0][R_], S[0][R_ + 1]} * SC + ad, x1_ = (f32x2){S[1][R_], S[1][R_ + 1]} * SC + ad; \
                    AT_P2(P[0], x0_.x, x0_.y, mwc0, R_, ROW_); AT_P2(P[1], x1_.x, x1_.y, mwc1, R_, ROW_); } while (0)
                AT_FAR(0, 0); AT_FAR(2, 2); AT_FAR(4, 8); AT_FAR(6, 10); AT_FAR(8, 16); AT_FAR(10, 18); AT_FAR(12, 24); AT_FAR(14, 26);
#undef AT_FAR
            } else {
#define AT_BIAS(T2_, R_, ROW_) (S[T2_][R_] * SC + (btab[imax0(kt * 64 + (T2_) * 32 + 4 * hh - qpos + 256 + (ROW_))] - m))
#define AT_NEAR(R_, ROW_) do { AT_P2(P[0], AT_BIAS(0, R_, ROW_), AT_BIAS(0, R_ + 1, ROW_ + 1), mwc0, R_, ROW_); AT_P2(P[1], AT_BIAS(1, R_, ROW_), AT_BIAS(1, R_ + 1, ROW_ + 1), mwc1, R_, ROW_); } while (0)
                AT_NEAR(0, 0); AT_NEAR(2, 2); AT_NEAR(4, 8); AT_NEAR(6, 10); AT_NEAR(8, 16); AT_NEAR(10, 18); AT_NEAR(12, 24); AT_NEAR(14, 26);
#undef AT_BIAS
#undef AT_NEAR
            }
#undef AT_P2
#undef AT_RESCALE
            const float ps = ps2.x + ps2.y;
            lsum += ps;
#pragma unroll
            for (int t2 = 0; t2 < 2; ++t2) { const bf16* vb = tb + 64 * AT_KP + l31 * AT_VP + t2 * 32 + 4 * hh;
#pragma unroll
                for (int s = 0; s < 2; ++s) { u32x4 w; w.x = pk2(P[t2][8 * s + 0], P[t2][8 * s + 1]); w.y = pk2(P[t2][8 * s + 2], P[t2][8 * s + 3]); w.z = pk2(P[t2][8 * s + 4], P[t2][8 * s + 5]); w.w = pk2(P[t2][8 * s + 6], P[t2][8 * s + 7]);
                    const bf16x8_t pf = __builtin_bit_cast(bf16x8_t, w);
                    O0 = __builtin_amdgcn_mfma_f32_32x32x16_bf16(frag2(*(const u32x2*)(vb + 16 * s), *(const u32x2*)(vb + 16 * s + 8)), pf, O0, 0, 0, 0);
                    O1 = __builtin_amdgcn_mfma_f32_32x32x16_bf16(frag2(*(const u32x2*)(vb + 32 * AT_VP + 16 * s), *(const u32x2*)(vb + 32 * AT_VP + 16 * s + 8)), pf, O1, 0, 0, 0); } }
        }
        if (kt + 1 < nt) { bf16* nb = tiles + ((kt + 1) & 1) * AT_BUF; *(u32x4*)(nb + lk) = prek; *(u32x4*)(nb + lv) = prev;
            if (kt + 2 < nt) { prek = *(const u32x4*)(gk + (size_t)(kt + 2) * 64 * 512); prev = *(const u32x4*)(gv + (size_t)(kt + 2) * 64); } }
    }
    lsum += __shfl_xor(lsum, 32);
    const float inv = 1.0f / lsum;
    bf16* Y = WSP(bf16, WS_Y) + (size_t)MG * 512 + qrow * 512 + h * 64 + 4 * hh;
#pragma unroll
    for (int g = 0; g < 4; ++g) { u32x2 w; w.x = pk2(O0[4 * g] * inv, O0[4 * g + 1] * inv); w.y = pk2(O0[4 * g + 2] * inv, O0[4 * g + 3] * inv); *(u32x2*)(Y + 8 * g) = w;
        u32x2 w2; w2.x = pk2(O1[4 * g] * inv, O1[4 * g + 1] * inv); w2.y = pk2(O1[4 * g + 2] * inv, O1[4 * g + 3] * inv); *(u32x2*)(Y + 32 + 8 * g) = w2; }
}
__device__ __forceinline__ void dsa_attn_unit3(KArgs C, int unit, int tid, unsigned char* lds) {
    constexpr int NPAIR = NK64 / 8;
    const int pr = unit % NPAIR, h = (unit / NPAIR) & 7, bl = unit / (NPAIR * 8);
    float* btab = (float*)lds; bf16* tiles = (bf16*)(lds + 2048);
    __syncthreads();
    { const int* tab = WSP(const int, WS_TAB); const float* relb = C->in[I_RELB];
      if (tid < 320) btab[tid] = relb[tab[tid - 256 + SEQ - 1] * 8 + h] * 1.44269504089f; }
    dsa_attn_half(C, bl, h, pr, tid, tiles, btab);
    dsa_attn_half(C, bl, h, NK64 / 4 - 1 - pr, tid, tiles, btab);
}
#ifndef GP_ALIGN
#define GP_ALIGN true
#endif
#ifndef GP_SP2
#define GP_SP2 true
#endif
constexpr int SEGS_PER_GROUP = 11, NSEG = DEPTH * (1 + NGRP * SEGS_PER_GROUP) + 1;

#ifdef HOST_EMU
#define GRID_BARRIER() emu_grid_sync()
#define LDS_PTR(p) ((unsigned char*)(p))
#else
#define GRID_BARRIER() do { XcdBarrier b_; b_.bar = (unsigned*)(Ck->ws + WS_CTL); b_.x = xb_xcc_id(); b_.st = (volatile LAS unsigned*)(lds + LDS_CTL_OFF); xcd_barrier(b_); } while (0)
#define LDS_PTR(p) ((PG8_LAS unsigned char*)(p))
#endif

__global__ void __launch_bounds__(NTHREADS, 2) fwd_kernel(Args a) {
#ifdef HOST_EMU
    unsigned char* lds = emu_lds;
#else
    extern __shared__ __attribute__((aligned(16))) unsigned char lds[];
#endif
#ifdef HOST_EMU
    KArgs Ck = &a;
#else
    KArgs Ck = (KArgs)__builtin_amdgcn_kernarg_segment_ptr();
    (void)a;
#endif
#ifndef HOST_EMU
    if (threadIdx.x < 4) ((LAS unsigned*)(lds + LDS_CTL_OFF))[threadIdx.x] = 0u;
    __syncthreads();
    if (Ck->seg_hi - Ck->seg_lo > 1) (void)xcd_barrier_post((unsigned*)(Ck->ws + WS_CTL), (volatile LAS unsigned*)(lds + LDS_CTL_OFF));
#endif
#define SEGID 0
#define RUN (SEGID >= Ck->seg_lo && SEGID < Ck->seg_hi)
#define SEAM do { if (SEGID >= Ck->seg_lo && SEGID + 1 < Ck->seg_hi) { GRID_BARRIER(); } } while (0)
#define WO ((layer & 1) ? WDELTA : (size_t)0)
#define PHASE_VARS KArgs C = KLAUNDER(Ck); const int G = gridDim.x, bx = blockIdx.x, ngw = G * NWAVES; (void)ngw; const int tid = fresh_tid(), lane = tid & 63, wave = __builtin_amdgcn_readfirstlane(tid >> 6), gw = bx * NWAVES + wave; (void)lane; (void)gw; (void)C
    for (int layer = 0; layer < DEPTH; ++layer) {
#undef SEGID
#define SEGID (layer * (1 + NGRP * SEGS_PER_GROUP))
        if (RUN) { PHASE_VARS; phase_weights(C, layer, lds, gw, ngw, lane, wave); }
        SEAM;
        for (int grp = 0; grp < NGRP; ++grp) {
#define XIN ((layer == 0 ? C->in[I_X] : (const float*)C->out) + (size_t)grp * MG * D)
#define XOUT (C->out + (size_t)grp * MG * D)
#undef SEGID
#define SEGID (layer * (1 + NGRP * SEGS_PER_GROUP) + 1 + grp * SEGS_PER_GROUP + 0)
            if (RUN) { PHASE_VARS; rms_rows_bf16<4>(XIN, C->in[I_NMIX] + layer * D, WSP(bf16, WS_H), gw, ngw, MG, lane); }
            SEAM;
#undef SEGID
#define SEGID (layer * (1 + NGRP * SEGS_PER_GROUP) + 1 + grp * SEGS_PER_GROUP + 1)
            if (RUN) { PHASE_VARS; pg8::Gemm g{WSP(const bf16, WS_H), WSP(const bf16, WS_WIN + WO), MG, NMIXC, D}; pg8::StaticOrder S; S.init(MG, NMIXC, G, bx);
                pg8::EpiProj E{C->ws};
                pg8::gemm_phase<pg8::EpiProj, pg8::StaticOrder, false, GP_ALIGN, GP_SP2>(LDS_PTR(lds), g, S, E, nullptr); }
            SEAM;
#undef SEGID
#define SEGID (layer * (1 + NGRP * SEGS_PER_GROUP) + 1 + grp * SEGS_PER_GROUP + 2)
            if (RUN) { PHASE_VARS;
                for (int m8 = gw; m8 < MG / 8; m8 += ngw) { rwkv_prep_rows8(C, layer, m8 * 8, lane); ssd_conv_rows8(C, layer, m8 * 8, lane); }
                for (int it = gw; it < NB * 8 * NK64; it += ngw) dsa_vt_item(C, it, lane, (bf16*)(lds + wave * 16384));
                __syncthreads();
                for (int u = bx; u < NB * NK64 * 8; u += G) dsa_index_unit(C, u, lane, wave, lds);
            }
            SEAM;
#undef SEGID
#define SEGID (layer * (1 + NGRP * SEGS_PER_GROUP) + 1 + grp * SEGS_PER_GROUP + 3)
            if (RUN) { PHASE_VARS; pg8::Gemm g{WSP(const bf16, WS_RA), WSP(const bf16, WS_WLORA + WO), MG, 1536, 256}; pg8::StaticOrder S; S.init(MG, 1536, G, bx);
                pg8::EpiLora E{WSP(float, WS_WLOG), WSP(bf16, WS_ASIG), WSP(bf16, WS_GG), C->in[I_W0] + layer * 512, C->in[I_A0] + layer * 512};
                pg8::gemm_phase<pg8::EpiLora, pg8::StaticOrder, false, GP_ALIGN, GP_SP2>(LDS_PTR(lds), g, S, E, nullptr); }
            SEAM;
#undef SEGID
#define SEGID (layer * (1 + NGRP * SEGS_PER_GROUP) + 1 + grp * SEGS_PER_GROUP + 4)
            if (RUN) { PHASE_VARS;
                constexpr int U_R = NB * 8, U_S = U_R + NB * 8;
                for (int u = bx; u < U_R; u += G) rwkv_unit(C, layer, u, lds);
                for (int u = (bx + G - U_R % G) % G; u < NB * 8; u += G) ssd_unit(C, layer, u, lds);
                { const int first = U_S % G, span = G - first;
                  if (bx >= first) for (int u = bx - first; u < NB * 32; u += span) s5_unit(C, layer, u, lds); }
                for (;;) {
                    const int t2 = fresh_tid();
                    volatile unsigned* qs2 = (volatile unsigned*)(lds + LDS_CTL_OFF + 32);
                    __syncthreads();
                    if (t2 == 0) *qs2 = atomicAdd((unsigned*)(Ck->ws + WS_QCTR) + ((layer * NGRP + grp) * 2) * 64, 1u);
                    __syncthreads();
                    const int u = (int)*qs2;
                    if (u >= NB * NK64) break;
                    dsa_attn_unit3(KLAUNDER(Ck), u, t2, lds);
                }
            }
            SEAM;
#undef SEGID
#define SEGID (layer * (1 + NGRP * SEGS_PER_GROUP) + 1 + grp * SEGS_PER_GROUP + 5)
            if (RUN) { PHASE_VARS;
                { pg8::Gemm g{WSP(const bf16, WS_H), WSP(const bf16, WS_WIN + WO) + (size_t)NMIXC * D, MG, 4096, D}; pg8::StaticOrder S; S.init(MG, 4096, G, bx);
                  pg8::EpiGate E{WSP(bf16, WS_G)}; pg8::gemm_phase<pg8::EpiGate, pg8::StaticOrder, false, GP_ALIGN, GP_SP2>(LDS_PTR(lds), g, S, E, nullptr); }
                { pg8::Gemm g{WSP(const bf16, WS_YD0), WSP(const bf16, WS_GLU + WO), MG, 512, 512}; pg8::StaticOrder S; S.init(MG, 512, G, bx);
                  pg8::EpiGlu E{WSP(const bf16, WS_YD0), WSP(bf16, WS_Y) + (size_t)3 * MG * 512, C->in[I_GLUB] + layer * 512};
                  pg8::gemm_phase<pg8::EpiGlu, pg8::StaticOrder, false, GP_ALIGN, GP_SP2>(LDS_PTR(lds), g, S, E, nullptr); }
                for (int it = gw; it < MG * 2; it += 4 * ngw) ssd_norm_item4(C, layer, it, ngw, MG * 2, lane);
            }
            SEAM;
#undef SEGID
#define SEGID (layer * (1 + NGRP * SEGS_PER_GROUP) + 1 + grp * SEGS_PER_GROUP + 6)
            if (RUN) { PHASE_VARS; pg8::Gemm g{WSP(const bf16, WS_Y), WSP(const bf16, WS_WB + WO), 4 * MG, 4096, 512}; pg8::MergeOrder S{G, bx};
                pg8::EpiMerge E{WSP(const bf16, WS_G), WSP(bf16, WS_MRG)};
                pg8::gemm_phase<pg8::EpiMerge, pg8::MergeOrder, false, GP_ALIGN, GP_SP2>(LDS_PTR(lds), g, S, E, nullptr); }
            SEAM;
#undef SEGID
#define SEGID (layer * (1 + NGRP * SEGS_PER_GROUP) + 1 + grp * SEGS_PER_GROUP + 7)
            if (RUN) { PHASE_VARS; pg8::Gemm g{WSP(const bf16, WS_MRG), WSP(const bf16, WS_WOUT + WO), MG, D, D}; pg8::StaticOrder S; S.init(MG, D, G, bx);
                pg8::EpiResid E{XIN, XOUT}; pg8::gemm_phase<pg8::EpiResid, pg8::StaticOrder, false, GP_ALIGN, GP_SP2>(LDS_PTR(lds), g, S, E, nullptr); }
            SEAM;
#undef SEGID
#define SEGID (layer * (1 + NGRP * SEGS_PER_GROUP) + 1 + grp * SEGS_PER_GROUP + 8)
            if (RUN) { PHASE_VARS; rms_rows_bf16<4>(XOUT, C->in[I_NFFN] + layer * D, WSP(bf16, WS_H), gw, ngw, MG, lane); }
            SEAM;
#undef SEGID
#define SEGID (layer * (1 + NGRP * SEGS_PER_GROUP) + 1 + grp * SEGS_PER_GROUP + 9)
            if (RUN) { PHASE_VARS; pg8::Gemm g{WSP(const bf16, WS_H), WSP(const bf16, WS_W13 + WO), MG, 5632, D}; pg8::StaticOrder S; S.init(MG, 5632, G, bx);
                pg8::EpiSwiglu E{WSP(bf16, WS_HID)};
                pg8::gemm_phase<pg8::EpiSwiglu, pg8::StaticOrder, false, GP_ALIGN, GP_SP2>(LDS_PTR(lds), g, S, E, nullptr); }
            SEAM;
#undef SEGID
#define SEGID (layer * (1 + NGRP * SEGS_PER_GROUP) + 1 + grp * SEGS_PER_GROUP + 10)
            if (RUN) { PHASE_VARS; pg8::Gemm g{WSP(const bf16, WS_HID), WSP(const bf16, WS_W2 + WO), MG, D, FFN}; pg8::StaticOrder S; S.init(MG, D, G, bx);
                pg8::EpiResid E{XOUT, XOUT}; pg8::gemm_phase<pg8::EpiResid, pg8::StaticOrder, false, GP_ALIGN, GP_SP2>(LDS_PTR(lds), g, S, E, nullptr); }
            SEAM;
        }
    }
#undef SEGID
#define SEGID (NSEG - 1)
    { const int layer = 0; (void)layer;
    if (RUN) { PHASE_VARS; for (int m = gw; m < M; m += 2 * ngw) { if (m + ngw < M) rms_row2_f32(C->out + (size_t)m * D, (size_t)ngw * D, C->in[I_NFIN], lane); else rms_row_f32(C->out + (size_t)m * D, C->in[I_NFIN], lane); } } }
#undef RUN
#undef SEAM
}

extern "C" void kernel_launch(void* const* d_in, const int* in_sizes, int n_in, void* d_out, int out_size, void* d_ws, size_t ws_size, hipStream_t stream) {
    static int grid = 0;
    if (grid == 0) {
        if (n_in != N_IN || out_size != M * D || ws_size < WS_END) { fprintf(stderr, "kernel_launch: unexpected shapes (n_in %d, out %d, ws %zu < %zu)\n", n_in, out_size, ws_size, (size_t)WS_END); grid = -1; return; }
        int dev = 0, cus = 0;
        if (hipGetDevice(&dev) != hipSuccess || hipDeviceGetAttribute(&cus, hipDeviceAttributeMultiprocessorCount, dev) != hipSuccess || cus < 1) { grid = -1; return; }
        if (hipFuncSetAttribute((const void*)fwd_kernel, hipFuncAttributeMaxDynamicSharedMemorySize, LDS_BYTES) != hipSuccess) { fprintf(stderr, "kernel_launch: hipFuncSetAttribute failed\n"); grid = -1; return; }
        (void)hipGetLastError();
        grid = cus;
    }
    if (grid < 0) return;
    (void)hipMemsetAsync((char*)d_ws + WS_CTL, 0, CTL_BYTES, stream);
    Args a{};
    for (int i = 0; i < N_IN; ++i) a.in[i] = (const float*)d_in[i];
    a.out = (float*)d_out; a.ws = (unsigned char*)d_ws;
#if CFG_LAUNCHES == 1
    a.seg_lo = 0; a.seg_hi = NSEG;
    hipLaunchKernelGGL(fwd_kernel, dim3(grid), dim3(NTHREADS), LDS_BYTES, stream, a);
#else
    for (int s = 0; s < NSEG; ++s) { a.seg_lo = s; a.seg_hi = s + 1; hipLaunchKernelGGL(fwd_kernel, dim3(grid), dim3(NTHREADS), LDS_BYTES, stream, a); }
#endif
}
```

```cpp
#ifdef HOST_EMU
#error "HOST_EMU is a host-only debug build"
#else
#include <hip/hip_runtime.h>
#endif
#include <cstdio>
#include <cstdint>
#include <cmath>

#ifndef CFG_BATCH
#define CFG_BATCH 16
#endif
#ifndef CFG_SEQ
#define CFG_SEQ 4096
#endif
#ifndef CFG_DEPTH
#define CFG_DEPTH 4
#endif
#ifndef CFG_NB
#define CFG_NB 8
#endif
#ifndef CFG_LAUNCHES
#define CFG_LAUNCHES 1
#endif

typedef unsigned short bf16;
typedef float f32x4 __attribute__((ext_vector_type(4)));
typedef float f32x2 __attribute__((ext_vector_type(2)));
typedef unsigned u32x4 __attribute__((ext_vector_type(4)));
typedef unsigned u32x2 __attribute__((ext_vector_type(2)));

constexpr int BATCH = CFG_BATCH, SEQ = CFG_SEQ, DEPTH = CFG_DEPTH, NB = CFG_NB;
constexpr int D = 1024, M = BATCH * SEQ, MG = NB * SEQ, NGRP = BATCH / NB;
constexpr int IN_COLS = 9388, NPROJ = 9472, NMIXC = 5376, FFN = 2816;
constexpr int TOPK = (SEQ / 4) < 256 ? (SEQ / 4) : 256;
constexpr int NK64 = SEQ / 64, MW = SEQ / 32;
constexpr float RMS_EPS = 1e-6f, GN_EPS = 64e-5f;
static_assert(BATCH % NB == 0 && MG % 256 == 0 && SEQ % 64 == 0, "shape");

enum { I_X = 0, I_RELB, I_NMIX, I_WIN, I_CONVW, I_CONVB, I_DTB, I_ALOG, I_SSDD, I_SSDNG, I_MU, I_W0, I_W2, I_A0, I_A2, I_G2, I_KK, I_KA, I_RK, I_LNG, I_LNB,
       I_S5ARE, I_S5AIM, I_S5BRE, I_S5BIM, I_S5CRE, I_S5CIM, I_S5D, I_S5LDT, I_GLUW, I_GLUB, I_WBR, I_WOUT, I_NFFN, I_W1, I_W3, I_W2F, I_NFIN, N_IN };

constexpr size_t MiB = 1u << 20;
constexpr size_t al256(size_t x) { return (x + 255) & ~(size_t)255; }
constexpr size_t WS_CTL = 0, CTL_BYTES = 64 * 1024;
constexpr size_t WS_TAB = WS_CTL + CTL_BYTES;
constexpr size_t WS_ABAR = al256(WS_TAB + (SEQ + 64) * 4);
constexpr size_t WS_BBAR = WS_ABAR + 32 * 64 * 2 * 4;
constexpr size_t WS_WIN = al256(WS_BBAR + 32 * 64 * 16 * 2 * 4);
constexpr size_t WS_WB = WS_WIN + (size_t)NPROJ * 1024 * 2;
constexpr size_t WS_WOUT = WS_WB + (size_t)4 * 1024 * 512 * 2;
constexpr size_t WS_W13 = WS_WOUT + (size_t)1024 * 1024 * 2;
constexpr size_t WS_W2 = WS_W13 + (size_t)5632 * 1024 * 2;
constexpr size_t WS_GLU = WS_W2 + (size_t)1024 * 2816 * 2;
constexpr size_t WS_WLORA = WS_GLU + (size_t)512 * 512 * 2;
constexpr size_t WS_H = al256(WS_WLORA + (size_t)1536 * 256 * 2);
constexpr size_t WS_Z = WS_H + (size_t)MG * 1024 * 2;
constexpr size_t WS_XBC = WS_Z + (size_t)MG * 512 * 2;
constexpr size_t WS_Q = WS_XBC + (size_t)MG * 768 * 2;
constexpr size_t WS_K = WS_Q + (size_t)MG * 512 * 2;
constexpr size_t WS_V = WS_K + (size_t)MG * 512 * 2;
constexpr size_t WS_RW = WS_V + (size_t)MG * 512 * 2;
constexpr size_t WS_U = WS_RW + (size_t)MG * 1792 * 2;
constexpr size_t WS_SM = WS_U + (size_t)MG * 512 * 2;
constexpr size_t WS_G = WS_Q;
constexpr size_t WS_Y = WS_SM + (size_t)MG * 256 * 2;
constexpr size_t WS_YD0 = WS_Y + (size_t)4 * MG * 512 * 2;
constexpr size_t WS_MRG = WS_YD0 + (size_t)MG * 512 * 2;
constexpr size_t WS_MASK = WS_MRG + (size_t)MG * 1024 * 2;
constexpr size_t WS_RA = WS_MASK + (size_t)MG * MW * 4;
constexpr size_t WS_WLOG = WS_RA + (size_t)MG * 256 * 2;
constexpr size_t WS_ASIG = WS_WLOG + (size_t)MG * 512 * 4;
constexpr size_t WS_GG = WS_ASIG + (size_t)MG * 512 * 2;
constexpr size_t WS_XBA = WS_GG + (size_t)MG * 512 * 2;
constexpr size_t WS_VT = WS_XBA + (size_t)MG * 768 * 2;
constexpr size_t WS_KI = WS_VT + (size_t)MG * 512 * 2;
constexpr size_t WS_QCTR = 16384;
constexpr size_t WS_HID = WS_G;
constexpr size_t WS_WALT = al256(WS_KI + (size_t)MG * 32 * 2);
constexpr size_t WDELTA = WS_WALT - WS_ABAR;
constexpr size_t WS_END = WS_WALT + (WS_H - WS_ABAR);
static_assert(WS_SM + (size_t)MG * 256 * 2 - WS_Q == (size_t)MG * 4096 * 2, "G overlays exactly Q..SM");
static_assert((size_t)MG * 2816 * 2 <= (size_t)MG * 4096 * 2, "HID fits in G");

constexpr int LDS_SCRATCH = 131072;
constexpr int LDS_CTL_OFF = LDS_SCRATCH;
constexpr int LDS_X = LDS_SCRATCH + 64;
constexpr int LDS_BYTES = 161792;
constexpr int NTHREADS = 512, NWAVES = 8;

__device__ __forceinline__ float bf2f(bf16 v) { return __uint_as_float(((unsigned)v) << 16); }
#ifdef HOST_EMU
__device__ __forceinline__ bf16 f2bf(float f) { unsigned u = __float_as_uint(f); u += 0x7fffu + ((u >> 16) & 1u); return (bf16)(u >> 16); }
#else
__device__ __forceinline__ bf16 f2bf(float f) { return __builtin_bit_cast(bf16, (__bf16)f); }
#endif
#ifdef HOST_EMU
__device__ __forceinline__ unsigned pk2(float lo, float hi) { return (unsigned)f2bf(lo) | ((unsigned)f2bf(hi) << 16); }
#else
typedef __bf16 bf16x2_hw __attribute__((ext_vector_type(2)));
__device__ __forceinline__ unsigned pk2(float lo, float hi) { const f32x2 v = {lo, hi}; return __builtin_bit_cast(unsigned, __builtin_convertvector(v, bf16x2_hw)); }
#endif
__device__ __forceinline__ float lo_bf(unsigned w) { return __uint_as_float(w << 16); }
__device__ __forceinline__ float hi_bf(unsigned w) { return __uint_as_float(w & 0xffff0000u); }
#ifndef HOST_EMU
__device__ __forceinline__ float sigm(float x) { return __builtin_amdgcn_rcpf(1.0f + __expf(-x)); }
#else
__device__ __forceinline__ float sigm(float x) { return 1.0f / (1.0f + __expf(-x)); }
#endif
#ifndef HOST_EMU
template <int BIT> __device__ __forceinline__ unsigned bit_fill(unsigned w) { unsigned r; asm("v_bfe_i32 %0, %1, %2, 1" : "=v"(r) : "v"(w), "n"(BIT)); return r; }
#else
template <int BIT> __device__ __forceinline__ unsigned bit_fill(unsigned w) { return ((w >> BIT) & 1u) ? 0xffffffffu : 0u; }
#endif
__device__ __forceinline__ int imax0(int v) { return v < 0 ? 0 : v; }
__device__ __forceinline__ float tanh_fast(float x) { return 2.0f * sigm(2.0f * x) - 1.0f; }
__device__ __forceinline__ float softplusf(float x) { return x > 20.f ? x : log1pf(__expf(x)); }
__device__ __forceinline__ float gelu_tanh(float x) { const float u = 0.7978845608f * (x + 0.044715f * x * x * x); return x * sigm(2.0f * u); }
__device__ __forceinline__ float wave_sum(float v) {
#pragma unroll
    for (int o = 1; o < 64; o <<= 1) v += __shfl_xor(v, o);
    return v;
}
__device__ __forceinline__ float wave_max(float v) {
#pragma unroll
    for (int o = 1; o < 64; o <<= 1) v = fmaxf(v, __shfl_xor(v, o));
    return v;
}
__device__ __forceinline__ int wave_sum_i(int v) {
#pragma unroll
    for (int o = 1; o < 64; o <<= 1) v += __shfl_xor(v, o);
    return v;
}
#ifdef HOST_EMU
#define WAVE_SYNC() (void)emu_wave_exchange(0)
#define SCHED_FENCE() do {} while (0)
#define LDS_SYNC() __syncthreads()
#else
#define WAVE_SYNC() __builtin_amdgcn_wave_barrier()
#define SCHED_FENCE() __builtin_amdgcn_sched_barrier(0)
#define LDS_SYNC() do { asm volatile("s_waitcnt lgkmcnt(0)" ::: "memory"); __builtin_amdgcn_s_barrier(); asm volatile("" ::: "memory"); } while (0)
#endif
#ifndef HOST_EMU
namespace pg8 {
__device__ __forceinline__ int pg8_fresh_tid() { int t = (int)threadIdx.x; asm volatile("" : "+v"(t)); return t; }
#define PG8_LAS __attribute__((address_space(3)))
typedef unsigned short bf16_t;
typedef short bf16x8 __attribute__((ext_vector_type(8)));
typedef float f32x4 __attribute__((ext_vector_type(4)));
typedef unsigned u32x4 __attribute__((ext_vector_type(4)));
constexpr int BM = 256, BK = 64, HALF = 128, HTB = HALF * BK * 2  , STAGE_BYTES = 8 * HTB, NXCD = 8, WGM = 8;

__host__ __device__ __forceinline__ int lds_byte(int r, int c) { const int st = (r >> 4) * 2 + (c >> 5), rr = r & 15, cc = c & 31, ob = rr * 64 + cc * 2; return st * 1024 + (ob ^ (((ob >> 9) & 1) << 5)); }
__host__ __device__ __forceinline__ void stage_rc(int b, int& R, int& C) { const int st = b / 1024, sb = b % 1024, swz = sb ^ (((sb >> 9) & 1) << 5); R = (st >> 1) * 16 + swz / 64; C = (st & 1) * 32 + (swz % 64) / 2; }
__host__ __device__ __forceinline__ int perm32(int rho) { const int n = rho >> 4, i = rho & 15; return 8 * (i >> 2) + 4 * n + (i & 3); }

struct Unit { int pm, pn; };
struct Gemm { const bf16_t* A; const bf16_t* Bt; int M, N, K; };

struct StaticOrder {
    int nM, nN, nwg, G, c;
    __host__ __device__ void init(int M, int N, int G_, int c_) { nM = M / BM; nN = N / BM; nwg = nM * nN; G = G_; c = c_; }
    __host__ __device__ bool next(int i, Unit& u) const {
        const long L = (long)i * G + c; if (L >= nwg) return false;
        int wgid = (int)L; { const int q = nwg / NXCD, r = nwg % NXCD, xcd = wgid % NXCD, off = wgid / NXCD; wgid = (xcd < r ? xcd * (q + 1) : r * (q + 1) + (xcd - r) * q) + off; }
        const int nig = WGM * nN, gid = wgid / nig, fm = gid * WGM, gsz = (nM - fm) < WGM ? (nM - fm) : WGM;
        u.pm = fm + ((wgid % nig) % gsz); u.pn = (wgid % nig) / gsz; return true;
    }
    __device__ __forceinline__ void a_ready(const Unit&) const {}
    __device__ __forceinline__ void done(const Unit&) const {}
};

__device__ __forceinline__ unsigned cvt_pk_bf16(float lo, float hi) { return pk2(lo, hi); }

template <class E, class = void> struct epi_keep { static constexpr bool value = false; };
template <class E> struct epi_keep<E, decltype((void)E::KEEP_ACC)> { static constexpr bool value = true; };
template <class Epi, class Sched, bool STAMP = false, bool ALIGN_EPI = false, bool SP2 = false>
__device__ __forceinline__ void gemm_phase(PG8_LAS unsigned char* lds, const Gemm g, const Sched& S, const Epi& E, unsigned long long* stamps) {
    const int tid = pg8_fresh_tid(), wid = __builtin_amdgcn_readfirstlane(tid >> 6), lane = tid & 63, wr = wid >> 2, wc = wid & 3, fr = lane & 15, fq = lane >> 4;
    int K_ = g.K; asm volatile("" : "+s"(K_));
    const int K = K_, nt = K / BK;
    int ts_lo = 0, ts_hi = 0, nts = 0; const unsigned long long rt_entry = STAMP ? (unsigned long long)wall_clock64() : 0ull;
#define PG8_STAMP() do { if (STAMP && wid == 0 && nts < 64) { const unsigned long long _c = (unsigned long long)clock64(); \
        ts_lo = (lane == nts) ? (int)(unsigned)_c : ts_lo; ts_hi = (lane == nts) ? (int)(unsigned)(_c >> 32) : ts_hi; ++nts; } } while (0)
    PG8_STAMP();
    unsigned voffA[2], voffB[2];
#pragma unroll
    for (int i = 0; i < 2; ++i) { int R, C; stage_rc(tid * 16 + i * 8192, R, C); const int Rb = Epi::PERM ? ((R & ~31) + perm32(R & 31)) : R;
        voffA[i] = (unsigned)(R * K + C) * 2u; voffB[i] = (unsigned)(Rb * K + C) * 2u; }
    const size_t kstep = (size_t)(BK * 2);
    const size_t hstep = (size_t)HALF * K * 2;
    const size_t tstep = 2 * hstep;
    const unsigned ldsw = (unsigned)wid * 1024u;
    const int aoff = lds_byte(wr * 64 + fr, fq * 8), boff = lds_byte(wc * 32 + fr, fq * 8);
#define PG8_SA(b, h) (((b) * 2 + (h)) * HTB)
#define PG8_SB(b, h) ((4 + (b) * 2 + (h)) * HTB)
#define PG8_STAGE(bufoff, gbase, voff) do { _Pragma("unroll") for (int _i = 0; _i < 2; ++_i) \
        __builtin_amdgcn_global_load_lds((const unsigned*)((const char*)(gbase) + (voff)[_i]), (PG8_LAS unsigned*)(lds + (bufoff) + ldsw + _i * 8192), 16, 0, 0); } while (0)
#define PG8_LDA(dst, b, h) do { _Pragma("unroll") for (int m = 0; m < 4; ++m) _Pragma("unroll") for (int k = 0; k < 2; ++k) dst[m][k] = *(const PG8_LAS bf16x8*)(lds + PG8_SA(b, h) + aoff + m * 2048 + k * 1024); } while (0)
#define PG8_LDB(dst, b, h) do { _Pragma("unroll") for (int n = 0; n < 2; ++n) _Pragma("unroll") for (int k = 0; k < 2; ++k) dst[n][k] = *(const PG8_LAS bf16x8*)(lds + PG8_SB(b, h) + boff + n * 2048 + k * 1024); } while (0)
#define PG8_MMA(ai, bj, At, Bt) do { __builtin_amdgcn_s_setprio(1); _Pragma("unroll") for (int m = 0; m < 4; ++m) _Pragma("unroll") for (int n = 0; n < 2; ++n) _Pragma("unroll") for (int k = 0; k < 2; ++k) \
        acc[ai][bj][m][n] = __builtin_amdgcn_mfma_f32_16x16x32_bf16(Bt[n][k], At[m][k], acc[ai][bj][m][n], 0, 0, 0); __builtin_amdgcn_s_setprio(0); } while (0)
#define PG8_WAIT_V(n) asm volatile("s_waitcnt vmcnt(" #n ")" ::: "memory")
#define PG8_WAIT_L(n) asm volatile("s_waitcnt lgkmcnt(" #n ")" ::: "memory")
#define PG8_BAR __builtin_amdgcn_s_barrier()
#define PG8_SCHED __builtin_amdgcn_sched_barrier(0)
    Unit cur, nxt; int ui = 0;
    if (!S.next(0, cur)) return;
    f32x4 acc[2][2][4][2];
#pragma unroll
    for (int a = 0; a < 2; ++a)
#pragma unroll
        for (int b = 0; b < 2; ++b)
#pragma unroll
            for (int m = 0; m < 4; ++m)
#pragma unroll
                for (int n = 0; n < 2; ++n) acc[a][b][m][n] = (f32x4){0.f, 0.f, 0.f, 0.f};
    bf16x8 At[4][2], B0[2][2], B1[2][2];
    const char* cA = (const char*)g.A + (size_t)cur.pm * tstep; const char* cB = (const char*)g.Bt + (size_t)cur.pn * tstep;
    S.a_ready(cur);
    if constexpr (SP2) {
        PG8_STAGE(PG8_SB(0, 0), cB, voffB); PG8_STAGE(PG8_SB(0, 1), cB + hstep, voffB); PG8_STAGE(PG8_SA(0, 0), cA, voffA); PG8_STAGE(PG8_SA(0, 1), cA + hstep, voffA);
        if (wr == 1) PG8_BAR;
        PG8_WAIT_V(2); PG8_BAR;
        PG8_STAGE(PG8_SB(1, 0), cB + kstep, voffB); PG8_STAGE(PG8_SA(1, 0), cA + kstep, voffA); PG8_STAGE(PG8_SB(1, 1), cB + hstep + kstep, voffB);
        PG8_WAIT_V(6); PG8_BAR;
    } else {
    PG8_STAGE(PG8_SB(0, 0), cB, voffB); PG8_STAGE(PG8_SA(0, 0), cA, voffA); PG8_STAGE(PG8_SB(0, 1), cB + hstep, voffB); PG8_STAGE(PG8_SA(0, 1), cA + hstep, voffA);
    if (wr == 1) PG8_BAR;
    PG8_WAIT_V(4); PG8_BAR;
    PG8_STAGE(PG8_SB(1, 0), cB + kstep, voffB); PG8_STAGE(PG8_SA(1, 0), cA + kstep, voffA); PG8_STAGE(PG8_SB(1, 1), cB + hstep + kstep, voffB);
    PG8_WAIT_V(6); PG8_BAR;
    }
    PG8_STAMP();
    for (;;) {
        const bool has_next = S.next(ui + 1, nxt);
        const char* nA = has_next ? (const char*)g.A + (size_t)nxt.pm * tstep : cA; const char* nB = has_next ? (const char*)g.Bt + (size_t)nxt.pn * tstep : cB;
        for (int t = 0; t < nt; t += 2) {
            const bool last = (t == nt - 2);
            const char* a1 = cA + (size_t)(t + 1) * kstep;
            const char* a2 = last ? nA : cA + (size_t)(t + 2) * kstep; const char* b2 = last ? nB : cB + (size_t)(t + 2) * kstep;
            const char* a3 = a2 + kstep; const char* b3 = b2 + kstep;
            if (last && has_next) S.a_ready(nxt);
            if constexpr (SP2) {
            PG8_LDB(B0, 0, 0); PG8_LDB(B1, 0, 1); PG8_SCHED; PG8_LDA(At, 0, 0); PG8_STAGE(PG8_SA(1, 1), a1 + hstep, voffA);
            PG8_WAIT_V(8); PG8_WAIT_L(0); PG8_BAR; PG8_MMA(0, 0, At, B0); PG8_MMA(0, 1, At, B1); PG8_BAR; PG8_SCHED;
            PG8_LDA(At, 0, 1); PG8_STAGE(PG8_SB(0, 0), b2, voffB); PG8_STAGE(PG8_SB(0, 1), b2 + hstep, voffB); PG8_STAGE(PG8_SA(0, 0), a2, voffA);
            PG8_WAIT_V(8); PG8_WAIT_L(0); PG8_BAR; PG8_MMA(1, 0, At, B0); PG8_MMA(1, 1, At, B1); PG8_BAR; PG8_SCHED;
            PG8_LDB(B0, 1, 0); PG8_LDB(B1, 1, 1); PG8_SCHED; PG8_LDA(At, 1, 0); PG8_STAGE(PG8_SA(0, 1), a2 + hstep, voffA);
            PG8_WAIT_V(8); PG8_WAIT_L(0); PG8_BAR; PG8_MMA(0, 0, At, B0); PG8_MMA(0, 1, At, B1); PG8_BAR; PG8_SCHED;
            PG8_LDA(At, 1, 1); PG8_STAGE(PG8_SB(1, 0), b3, voffB); PG8_STAGE(PG8_SB(1, 1), b3 + hstep, voffB); PG8_STAGE(PG8_SA(1, 0), a3, voffA);
            PG8_WAIT_V(8); PG8_WAIT_L(0); PG8_BAR; PG8_MMA(1, 0, At, B0); PG8_MMA(1, 1, At, B1); PG8_BAR; PG8_SCHED;
            } else {
            PG8_LDB(B0, 0, 0); PG8_SCHED; PG8_LDA(At, 0, 0); PG8_STAGE(PG8_SA(1, 1), a1 + hstep, voffA);
            PG8_WAIT_L(8); PG8_BAR; PG8_WAIT_L(0); PG8_MMA(0, 0, At, B0); PG8_BAR; PG8_SCHED;
            PG8_LDB(B1, 0, 1); PG8_STAGE(PG8_SB(0, 0), b2, voffB);
            PG8_BAR; PG8_WAIT_L(0); PG8_MMA(0, 1, At, B1); PG8_BAR;
            PG8_LDA(At, 0, 1); PG8_STAGE(PG8_SA(0, 0), a2, voffA);
            PG8_BAR; PG8_WAIT_L(0); PG8_MMA(1, 0, At, B0); PG8_BAR; PG8_SCHED;
            PG8_STAGE(PG8_SB(0, 1), b2 + hstep, voffB);
            PG8_WAIT_V(6); PG8_BAR; PG8_MMA(1, 1, At, B1); PG8_BAR;
            PG8_LDB(B0, 1, 0); PG8_SCHED; PG8_LDA(At, 1, 0); PG8_STAGE(PG8_SA(0, 1), a2 + hstep, voffA);
            PG8_WAIT_L(8); PG8_BAR; PG8_WAIT_L(0); PG8_MMA(0, 0, At, B0); PG8_BAR; PG8_SCHED;
            PG8_LDB(B1, 1, 1); PG8_STAGE(PG8_SB(1, 0), b3, voffB);
            PG8_BAR; PG8_WAIT_L(0); PG8_MMA(0, 1, At, B1); PG8_BAR;
            PG8_LDA(At, 1, 1); PG8_STAGE(PG8_SA(1, 0), a3, voffA);
            PG8_BAR; PG8_WAIT_L(0); PG8_MMA(1, 0, At, B0); PG8_BAR; PG8_SCHED;
            PG8_STAGE(PG8_SB(1, 1), b3 + hstep, voffB);
            PG8_WAIT_V(6); PG8_BAR; PG8_MMA(1, 1, At, B1); PG8_BAR;
            }
        }
        PG8_STAMP();
        if constexpr (ALIGN_EPI) { if (wr == 0) PG8_BAR; }
        if constexpr (!Epi::AFTER_DRAIN) { E(acc, cur, wr, wc, fr, fq); S.done(cur); }
        PG8_STAMP();
        if (!has_next) break;
        bool zero_acc = true; if constexpr (epi_keep<Epi>::value) zero_acc = !E.keep(cur);
        if (zero_acc) { const bf16x8 z8 = {0, 0, 0, 0, 0, 0, 0, 0};
#pragma unroll
        for (int a = 0; a < 2; ++a)
#pragma unroll
            for (int b = 0; b < 2; ++b)
#pragma unroll
                for (int m = 0; m < 4; ++m)
#pragma unroll
                    for (int n = 0; n < 2; ++n) acc[a][b][m][n] = __builtin_amdgcn_mfma_f32_16x16x32_bf16(z8, z8, (f32x4){0.f, 0.f, 0.f, 0.f}, 0, 0, 0); }
        cur = nxt; cA = nA; cB = nB; ++ui;
        if constexpr (ALIGN_EPI) { if (wr == 1) PG8_BAR; }
    }
    PG8_WAIT_V(0);
    if constexpr (!ALIGN_EPI) { if (wr == 0) PG8_BAR; }
    PG8_BAR;
    if constexpr (Epi::AFTER_DRAIN) { E.fused(acc, cur, wr, wc, fr, fq, lds, wid, lane); S.done(cur); }
    PG8_STAMP();
    if (STAMP && wid == 0) { stamps[lane] = lane < nts ? (((unsigned long long)(unsigned)ts_hi << 32) | (unsigned)ts_lo) : 0ull;
        if (lane == 62) stamps[62] = rt_entry; if (lane == 63) stamps[63] = (unsigned long long)wall_clock64(); }
#undef PG8_STAMP
#undef PG8_SA
#undef PG8_SB
#undef PG8_STAGE
#undef PG8_LDA
#undef PG8_LDB
#undef PG8_MMA
#undef PG8_WAIT_V
#undef PG8_WAIT_L
#undef PG8_BAR
#undef PG8_SCHED
}
}

#define XB_TMO      128
#define XB_XCNT(j)  (256  + 64 * (j))
#define XB_XSUB(j)  (1280 + 64 * (j))
#define XB_XGEN(j)  (2304 + 64 * (j))
#define XB_TOP      3328
#define XB_TOPGEN   3392
#define XCD_BAR_WORDS 3456
#define XB_SPIN_CAP (1u << 18)
#define LAS __attribute__((address_space(3)))

__device__ __forceinline__ unsigned xb_ld(unsigned* p)              { return __hip_atomic_load(p, __ATOMIC_RELAXED, __HIP_MEMORY_SCOPE_AGENT); }
__device__ __forceinline__ unsigned xb_add(unsigned* p, unsigned v) { return __hip_atomic_fetch_add(p, v, __ATOMIC_RELAXED, __HIP_MEMORY_SCOPE_AGENT); }
__device__ __forceinline__ unsigned xb_xcc_id() { return (unsigned)__builtin_amdgcn_s_getreg((3 << 11) | 20) & 0xFu; }
#define XB_SPIN(cond, bar) do { unsigned _sp = 0; while (cond) { __builtin_amdgcn_s_sleep(1); \
    if ((++_sp & 255u) == 0u) { if (xb_ld(&(bar)[XB_TMO])) break; if (_sp > XB_SPIN_CAP) { atomicAdd(&(bar)[XB_TMO], 1u); break; } } } } while (0)

struct XcdBarrier {
    unsigned* bar; unsigned x;
    volatile LAS unsigned* st;
};

__device__ __forceinline__ XcdBarrier xcd_barrier_post(unsigned* bar, volatile LAS unsigned* st) {
    XcdBarrier b; b.bar = bar; b.x = xb_xcc_id(); b.st = st;
    if (threadIdx.x == 0) (void)xb_add(&bar[XB_XCNT(b.x)], 1u);
    return b;
}
__device__ __forceinline__ void xcd_barrier_complete(unsigned* bar, unsigned x, unsigned& nloc, unsigned& nx) {
    const unsigned G = gridDim.x * gridDim.y * gridDim.z;
    unsigned sum, cnt, mine, sp = 0u;
    for (;;) {
        sum = 0u; cnt = 0u; mine = 0u;
#pragma unroll
        for (unsigned j = 0; j < 16; ++j) { const unsigned c = xb_ld(&bar[XB_XCNT(j)]); sum += c; cnt += (c > 0u) ? 1u : 0u; mine = (j == x) ? c : mine; }
        if (sum == G) break;
        __builtin_amdgcn_s_sleep(1);
        if ((++sp & 255u) == 0u) { if (xb_ld(&bar[XB_TMO])) break; if (sp > XB_SPIN_CAP) { atomicAdd(&bar[XB_TMO], 1u); break; } }
    }
    nloc = mine > 0u ? mine : 1u; nx = cnt > 0u ? cnt : 1u;
}

__device__ __forceinline__ void xcd_barrier(const XcdBarrier& b) {
    asm volatile("s_waitcnt vmcnt(0)" ::: "memory");
    __syncthreads();
    if (threadIdx.x == 0) {
        unsigned* bar = b.bar;
        __builtin_amdgcn_s_waitcnt(0);
        unsigned nloc = b.st[0], nx = b.st[1];
        if (nloc == 0u) { xcd_barrier_complete(bar, b.x, nloc, nx); b.st[0] = nloc; b.st[1] = nx; }
        const unsigned old = xb_add(&bar[XB_XSUB(b.x)], 1u);
        const unsigned gen = old / nloc;
        if (old + 1u == (gen + 1u) * nloc) {
            __builtin_amdgcn_fence(__ATOMIC_RELEASE, "agent");
            asm volatile("s_waitcnt vmcnt(0)" ::: "memory");
            const unsigned og = xb_add(&bar[XB_TOP], 1u);
            const unsigned tg = og / nx;
            if (og + 1u == (tg + 1u) * nx) xb_add(&bar[XB_TOPGEN], 1u);
            else XB_SPIN(xb_ld(&bar[XB_TOPGEN]) == tg, bar);
            __builtin_amdgcn_fence(__ATOMIC_ACQUIRE, "agent");
            xb_add(&bar[XB_XGEN(b.x)], 1u);
            asm volatile("s_waitcnt vmcnt(0)" ::: "memory");
        } else {
            XB_SPIN(xb_ld(&bar[XB_XGEN(b.x)]) == gen, bar);
            __builtin_amdgcn_fence(__ATOMIC_ACQUIRE, "agent");
            asm volatile("s_waitcnt vmcnt(0)" ::: "memory");
        }
    }
    __syncthreads();
}

#else
namespace pg8 {
typedef unsigned short bf16_t;
typedef float f32x4 __attribute__((ext_vector_type(4)));
typedef unsigned u32x4 __attribute__((ext_vector_type(4)));
constexpr int BM = 256, BK = 64, HALF = 128, NXCD = 8, WGM = 8;
struct Unit { int pm, pn; };
struct Gemm { const bf16_t* A; const bf16_t* Bt; int M, N, K; };
template <class E, class = void> struct epi_keep { static constexpr bool value = false; };
template <class E> struct epi_keep<E, decltype((void)E::KEEP_ACC)> { static constexpr bool value = true; };
struct StaticOrder {
    int nM, nN, nwg, G, c;
    void init(int M, int N, int G_, int c_) { nM = M / BM; nN = N / BM; nwg = nM * nN; G = G_; c = c_; }
    bool next(int i, Unit& u) const {
        const long L = (long)i * G + c; if (L >= nwg) return false;
        int wgid = (int)L; { const int q = nwg / NXCD, r = nwg % NXCD, xcd = wgid % NXCD, off = wgid / NXCD; wgid = (xcd < r ? xcd * (q + 1) : r * (q + 1) + (xcd - r) * q) + off; }
        const int nig = WGM * nN, gid = wgid / nig, fm = gid * WGM, gsz = (nM - fm) < WGM ? (nM - fm) : WGM;
        u.pm = fm + ((wgid % nig) % gsz); u.pn = (wgid % nig) / gsz; return true;
    }
    void a_ready(const Unit&) const {}
    void done(const Unit&) const {}
};
static inline unsigned cvt_pk_bf16(float lo, float hi) { return pk2(lo, hi); }
static float* emu_tile_buf(int b) { static std::vector<std::vector<float>> t; if ((int)t.size() <= b) t.resize(b + 1); if (t[b].empty()) t[b].resize(256 * 256); return t[b].data(); }
template <class Epi, class Sched, bool STAMP = false, bool ALIGN_EPI = false, bool SP2 = false, bool ZPEEL = false>
void gemm_phase(unsigned char* lds, const Gemm g, const Sched& S, const Epi& E, unsigned long long* stamps) {
    const int tid = threadIdx.x, wid = tid >> 6, lane = tid & 63, wr = wid >> 2, wc = wid & 3, fr = lane & 15, fq = lane >> 4;
    float* tile = emu_tile_buf(blockIdx.x);
    Unit u; f32x4 acc[2][2][4][2]; bool keep_next = false;
    for (int ui = 0; S.next(ui, u); ++ui) {
        __syncthreads();
        if (tid == 0) {
            std::vector<float> a((size_t)256 * g.K), b((size_t)256 * g.K);
            for (int r = 0; r < 256; ++r) for (int k = 0; k < g.K; ++k) { a[(size_t)r * g.K + k] = bf2f(g.A[((size_t)u.pm * 256 + r) * g.K + k]); b[(size_t)r * g.K + k] = bf2f(g.Bt[((size_t)u.pn * 256 + r) * g.K + k]); }
            for (int r = 0; r < 256; ++r) for (int c = 0; c < 256; ++c) { const float* ar = &a[(size_t)r * g.K]; const float* br = &b[(size_t)c * g.K]; float s = 0.f; for (int k = 0; k < g.K; ++k) s += ar[k] * br[k]; tile[r * 256 + c] = s; }
        }
        __syncthreads();
        if (!keep_next) for (int ai = 0; ai < 2; ++ai) for (int bj = 0; bj < 2; ++bj) for (int m = 0; m < 4; ++m) for (int n = 0; n < 2; ++n) acc[ai][bj][m][n] = (f32x4){0.f, 0.f, 0.f, 0.f};
        for (int ai = 0; ai < 2; ++ai) for (int bj = 0; bj < 2; ++bj) for (int m = 0; m < 4; ++m) for (int n = 0; n < 2; ++n) for (int j = 0; j < 4; ++j) {
            const int r = 128 * ai + 64 * wr + 16 * m + fr;
            const int c = Epi::PERM ? (128 * bj + 32 * wc + 8 * fq + 4 * n + j) : (128 * bj + 32 * wc + 16 * n + 4 * fq + j);
            acc[ai][bj][m][n][j] += tile[r * 256 + c];
        }
        E(acc, u, wr, wc, fr, fq); S.done(u);
        if constexpr (epi_keep<Epi>::value) keep_next = E.keep(u); else keep_next = false;
        __syncthreads();
    }
}
}
#endif
namespace pg8 {
#ifdef HOST_EMU
#define EPI_FENCE() do {} while (0)
#else
#define EPI_FENCE() asm volatile("" ::: "memory")
#endif
__device__ __forceinline__ u32x4 pack8(const f32x4 v0, const f32x4 v1) { u32x4 w; w.x = cvt_pk_bf16(v0[0], v0[1]); w.y = cvt_pk_bf16(v0[2], v0[3]); w.z = cvt_pk_bf16(v1[0], v1[1]); w.w = cvt_pk_bf16(v1[2], v1[3]); return w; }
__device__ __forceinline__ void unpack8(const u32x4 w, f32x4& v0, f32x4& v1) { v0 = (f32x4){lo_bf(w.x), hi_bf(w.x), lo_bf(w.y), hi_bf(w.y)}; v1 = (f32x4){lo_bf(w.z), hi_bf(w.z), lo_bf(w.w), hi_bf(w.w)}; }
__device__ __forceinline__ f32x4 sig4(const f32x4 v) { return (f32x4){sigm(v[0]), sigm(v[1]), sigm(v[2]), sigm(v[3])}; }
#ifndef HOST_EMU
__device__ __forceinline__ float gate_sig(float x) { return __builtin_amdgcn_rcpf(fminf(1.0f + __expf(-x), 1.0e6f)); }
#else
__device__ __forceinline__ float gate_sig(float x) { return fmaxf(sigm(x), 1.0e-6f); }
#endif
__device__ __forceinline__ f32x4 gsig4(const f32x4 v) { return (f32x4){gate_sig(v[0]), gate_sig(v[1]), gate_sig(v[2]), gate_sig(v[3])}; }

struct EpiProj {
    static constexpr bool PERM = true, AFTER_DRAIN = false;
    unsigned char* ws;
    __device__ __forceinline__ void operator()(const f32x4 (&acc)[2][2][4][2], const Unit& u, int wr, int wc, int fr, int fq) const {
        const int pn = u.pn; size_t off; int ld, c0;
        if (pn < 2) { off = WS_Z; ld = 512; c0 = pn * 256; }
        else if (pn < 5) { off = WS_XBC; ld = 768; c0 = (pn - 2) * 256; }
        else if (pn < 7) { off = WS_Q; ld = 512; c0 = (pn - 5) * 256; }
        else if (pn < 9) { off = WS_K; ld = 512; c0 = (pn - 7) * 256; }
        else if (pn < 11) { off = WS_V; ld = 512; c0 = (pn - 9) * 256; }
        else if (pn < 18) { off = WS_RW; ld = 1792; c0 = (pn - 11) * 256; }
        else if (pn < 20) { off = WS_U; ld = 512; c0 = (pn - 18) * 256; }
        else { off = WS_SM; ld = 256; c0 = 0; }
        bf16_t* dst = (bf16_t*)(ws + off);
        const int row0 = u.pm * BM + wr * 64 + fr, col0 = c0 + wc * 32 + 8 * fq;
        const int kic = HALF + wc * 32 + 8 * fq - 136;
        const bool ki = (pn == 20) && kic >= 0 && kic < 32;
#pragma unroll
        for (int ai = 0; ai < 2; ++ai)
#pragma unroll
            for (int m = 0; m < 4; ++m) { const size_t row = (size_t)(row0 + ai * HALF + m * 16); bf16_t* rowp = dst + row * ld + col0;
#pragma unroll
                for (int bj = 0; bj < 2; ++bj) { const u32x4 w = pack8(acc[ai][bj][m][0], acc[ai][bj][m][1]); *(u32x4*)(rowp + bj * HALF) = w;
                    if (bj == 1 && ki) *(u32x4*)((bf16_t*)(ws + WS_KI) + row * 32 + kic) = w; } }
    }
};
struct EpiGate {
    static constexpr bool PERM = true, AFTER_DRAIN = false;
    bf16_t* G;
    __device__ __forceinline__ void operator()(const f32x4 (&acc)[2][2][4][2], const Unit& u, int wr, int wc, int fr, int fq) const {
        const int row0 = u.pm * BM + wr * 64 + fr, col0 = u.pn * BM + wc * 32 + 8 * fq;
#pragma unroll
        for (int ai = 0; ai < 2; ++ai)
#pragma unroll
            for (int m = 0; m < 4; ++m) { bf16_t* rowp = G + (size_t)(row0 + ai * HALF + m * 16) * 4096 + col0;
#pragma unroll
                for (int bj = 0; bj < 2; ++bj) *(u32x4*)(rowp + bj * HALF) = pack8(gsig4(acc[ai][bj][m][0]), gsig4(acc[ai][bj][m][1])); }
    }
};
struct EpiMerge {
    static constexpr bool PERM = true, AFTER_DRAIN = false, KEEP_ACC = true;
    const bf16_t* G; bf16_t* MRG;
    __device__ __forceinline__ bool keep(const Unit& u) const { return (u.pn >> 2) < 3; }
    __device__ __forceinline__ void operator()(f32x4 (&acc)[2][2][4][2], const Unit& u, int wr, int wc, int fr, int fq) const {
        const int n = u.pn >> 2, pn = u.pn & 3, pm = u.pm - n * (MG / 256);
        const int row0 = pm * BM + wr * 64 + fr, col0 = pn * BM + wc * 32 + 8 * fq;
#pragma unroll
        for (int ai = 0; ai < 2; ++ai)
#pragma unroll
            for (int mp = 0; mp < 2; ++mp) { u32x4 ga[2][2], gb[2][2];
#pragma unroll
                for (int mm = 0; mm < 2; ++mm)
#pragma unroll
                    for (int bj = 0; bj < 2; ++bj) { const bf16_t* gp = G + (size_t)(row0 + ai * HALF + (2 * mp + mm) * 16) * 4096 + n * 1024 + col0 + bj * HALF; ga[mm][bj] = *(const u32x4*)gp; if (n < 3) gb[mm][bj] = *(const u32x4*)(gp + 1024); }
#pragma unroll
                for (int mm = 0; mm < 2; ++mm)
#pragma unroll
                    for (int bj = 0; bj < 2; ++bj) { const int m = 2 * mp + mm; f32x4 a0, a1; unpack8(ga[mm][bj], a0, a1);
                        if (n < 3) { f32x4 b0, b1; unpack8(gb[mm][bj], b0, b1);
#pragma unroll
                            for (int j = 0; j < 4; ++j) { acc[ai][bj][m][0][j] *= a0[j] * __builtin_amdgcn_rcpf(b0[j]); acc[ai][bj][m][1][j] *= a1[j] * __builtin_amdgcn_rcpf(b1[j]); } }
                        else
                            *(u32x4*)(MRG + (size_t)(row0 + ai * HALF + m * 16) * 1024 + col0 + bj * HALF) = pack8(acc[ai][bj][m][0] * a0, acc[ai][bj][m][1] * a1); }
                EPI_FENCE(); }
    }
};
struct MergeOrder {
    int G, c;
    __device__ __forceinline__ bool next(int i, Unit& u) const {
        const int tile = (i >> 2) * G + c, n = i & 3; if (tile >= (MG / 256) * 4) return false;
        u.pm = n * (MG / 256) + (tile >> 2); u.pn = n * 4 + (tile & 3); return true;
    }
    __device__ __forceinline__ void a_ready(const Unit&) const {}
    __device__ __forceinline__ void done(const Unit&) const {}
};
struct EpiResid {
    static constexpr bool PERM = false, AFTER_DRAIN = false;
    const float* base; float* out;
    __device__ __forceinline__ void operator()(const f32x4 (&acc)[2][2][4][2], const Unit& u, int wr, int wc, int fr, int fq) const {
        const int row0 = u.pm * BM + wr * 64 + fr, col0 = u.pn * BM + wc * 32 + 4 * fq;
#pragma unroll
        for (int ai = 0; ai < 2; ++ai) {
            f32x4 bv[4][2][2];
#pragma unroll
            for (int m = 0; m < 4; ++m)
#pragma unroll
                for (int bj = 0; bj < 2; ++bj)
#pragma unroll
                    for (int n = 0; n < 2; ++n) bv[m][bj][n] = *(const f32x4*)(base + (size_t)(row0 + ai * HALF + m * 16) * 1024 + col0 + bj * HALF + n * 16);
#pragma unroll
            for (int m = 0; m < 4; ++m)
#pragma unroll
                for (int bj = 0; bj < 2; ++bj)
#pragma unroll
                    for (int n = 0; n < 2; ++n) *(f32x4*)(out + (size_t)(row0 + ai * HALF + m * 16) * 1024 + col0 + bj * HALF + n * 16) = bv[m][bj][n] + acc[ai][bj][m][n];
            EPI_FENCE(); }
    }
};
struct EpiSwiglu {
    static constexpr bool PERM = true, AFTER_DRAIN = false;
    bf16_t* HID;
    __device__ __forceinline__ void operator()(const f32x4 (&acc)[2][2][4][2], const Unit& u, int wr, int wc, int fr, int fq) const {
        const int row0 = u.pm * BM + wr * 64 + fr, col0 = u.pn * HALF + wc * 32 + 8 * fq;
#pragma unroll
        for (int ai = 0; ai < 2; ++ai)
#pragma unroll
            for (int m = 0; m < 4; ++m) { f32x4 v[2];
#pragma unroll
                for (int n = 0; n < 2; ++n) { const f32x4 a = acc[ai][0][m][n], b = acc[ai][1][m][n]; v[n] = a * sig4(a) * b; }
                *(u32x4*)(HID + (size_t)(row0 + ai * HALF + m * 16) * FFN + col0) = pack8(v[0], v[1]); }
    }
};
struct EpiGlu {
    static constexpr bool PERM = true, AFTER_DRAIN = false;
    const bf16_t* Y0; bf16_t* OUT; const float* bias;
    __device__ __forceinline__ void operator()(const f32x4 (&acc)[2][2][4][2], const Unit& u, int wr, int wc, int fr, int fq) const {
        const int row0 = u.pm * BM + wr * 64 + fr, col0 = u.pn * BM + wc * 32 + 8 * fq;
#pragma unroll
        for (int ai = 0; ai < 2; ++ai)
#pragma unroll
            for (int m = 0; m < 4; ++m) { const size_t row = (size_t)(row0 + ai * HALF + m * 16);
#pragma unroll
                for (int bj = 0; bj < 2; ++bj) { const int col = col0 + bj * HALF;
                    f32x4 y0, y1; unpack8(*(const u32x4*)(Y0 + row * 512 + col), y0, y1);
                    const f32x4 b0 = *(const f32x4*)(bias + col), b1 = *(const f32x4*)(bias + col + 4);
                    *(u32x4*)(OUT + row * 512 + col) = pack8(y0 * sig4(acc[ai][bj][m][0] + b0), y1 * sig4(acc[ai][bj][m][1] + b1)); }
                EPI_FENCE(); }
    }
};
__device__ __forceinline__ float logdecay(float x) { return -0.6065306597f * sigm(x); }
struct EpiLora {
    static constexpr bool PERM = true, AFTER_DRAIN = false;
    float* WLOG; bf16_t* ASIG; bf16_t* GG; const float* w0; const float* a0;
    __device__ __forceinline__ void operator()(const f32x4 (&acc)[2][2][4][2], const Unit& u, int wr, int wc, int fr, int fq) const {
        const int kind = u.pn >> 1, row0 = u.pm * BM + wr * 64 + fr, col0 = (u.pn & 1) * BM + wc * 32 + 8 * fq;
        if (kind == 0) {
            f32x4 b[2][2];
#pragma unroll
            for (int bj = 0; bj < 2; ++bj) { b[bj][0] = *(const f32x4*)(w0 + col0 + bj * HALF); b[bj][1] = *(const f32x4*)(w0 + col0 + bj * HALF + 4); }
#pragma unroll
            for (int ai = 0; ai < 2; ++ai)
#pragma unroll
                for (int m = 0; m < 4; ++m)
#pragma unroll
                    for (int bj = 0; bj < 2; ++bj)
#pragma unroll
                        for (int n = 0; n < 2; ++n) { const f32x4 x = acc[ai][bj][m][n] + b[bj][n];
                            *(f32x4*)(WLOG + (size_t)(row0 + ai * HALF + m * 16) * 512 + col0 + bj * HALF + 4 * n) = (f32x4){logdecay(x[0]), logdecay(x[1]), logdecay(x[2]), logdecay(x[3])}; }
        } else if (kind == 1) {
            f32x4 b[2][2];
#pragma unroll
            for (int bj = 0; bj < 2; ++bj) { b[bj][0] = *(const f32x4*)(a0 + col0 + bj * HALF); b[bj][1] = *(const f32x4*)(a0 + col0 + bj * HALF + 4); }
#pragma unroll
            for (int ai = 0; ai < 2; ++ai)
#pragma unroll
                for (int m = 0; m < 4; ++m)
#pragma unroll
                    for (int bj = 0; bj < 2; ++bj)
                        *(u32x4*)(ASIG + (size_t)(row0 + ai * HALF + m * 16) * 512 + col0 + bj * HALF) = pack8(sig4(acc[ai][bj][m][0] + b[bj][0]), sig4(acc[ai][bj][m][1] + b[bj][1]));
        } else {
#pragma unroll
            for (int ai = 0; ai < 2; ++ai)
#pragma unroll
                for (int m = 0; m < 4; ++m)
#pragma unroll
                    for (int bj = 0; bj < 2; ++bj)
                        *(u32x4*)(GG + (size_t)(row0 + ai * HALF + m * 16) * 512 + col0 + bj * HALF) = pack8(acc[ai][bj][m][0], acc[ai][bj][m][1]);
        }
    }
};
}
typedef short bf16x8_t __attribute__((ext_vector_type(8)));
typedef float f32x16 __attribute__((ext_vector_type(16)));
typedef float f32x4_t __attribute__((ext_vector_type(4)));
__device__ __forceinline__ bf16x8_t frag2(const u32x2 lo, const u32x2 hi) { u32x4 w; w.x = lo.x; w.y = lo.y; w.z = hi.x; w.w = hi.y; return __builtin_bit_cast(bf16x8_t, w); }
struct Args { const float* in[N_IN]; float* out; unsigned char* ws; int seg_lo, seg_hi; };
#ifdef HOST_EMU
typedef const Args* KArgs;
#define KLAUNDER(p) (p)
__device__ __forceinline__ int fresh_tid() { return (int)threadIdx.x; }
#else
typedef const __attribute__((address_space(4))) Args* KArgs;
__device__ __forceinline__ KArgs klaunder(KArgs p) { asm volatile("" : "+s"(p)); return p; }
#define KLAUNDER(p) klaunder(p)
__device__ __forceinline__ int fresh_tid() { int t = (int)threadIdx.x; asm volatile("" : "+v"(t)); return t; }
#endif
#define WSP(T, off) ((T*)(C->ws + (off)))

template <class Src>
__device__ __forceinline__ void transpose_item(const Src& S, int K, bf16* WT, float* scr, int item, int lane) {
    const int nblk = S.ndst / 32, kb = item / nblk, nb = item % nblk, k0 = 64 * kb, n0 = 32 * nb;
    const float* cp = S.col(n0 + (lane & 31)); const int ld = S.ld; const float* cq = cp ? cp : S.col(0);
    float ld32[32];
#pragma unroll
    for (int i = 0; i < 32; ++i) ld32[i] = cq[(size_t)(k0 + 2 * i + (lane >> 5)) * ld];
#pragma unroll
    for (int i = 0; i < 32; ++i) { const int kk = 2 * i + (lane >> 5); scr[kk * 33 + (lane & 31)] = cp ? ld32[i] : 0.f; }
    WAVE_SYNC();
    const int c = lane & 7;
#pragma unroll
    for (int j = 0; j < 4; ++j) { const int n = (lane >> 3) + 8 * j; const float* s = scr + (8 * c) * 33 + n;
        u32x4 o; o.x = pk2(s[0 * 33], s[1 * 33]); o.y = pk2(s[2 * 33], s[3 * 33]); o.z = pk2(s[4 * 33], s[5 * 33]); o.w = pk2(s[6 * 33], s[7 * 33]);
        *(u32x4*)(WT + (size_t)(n0 + n) * K + k0 + 8 * c) = o; }
    WAVE_SYNC();
}
struct SrcWin { const float* w; int ndst, ld;
    __device__ __forceinline__ const float* col(int n) const {
        int s;
        if (n < 1280) s = n;
        else if (n < 2816) s = n + 8;
        else if (n < 4608) s = n - 2816 + 2988;
        else if (n < 5120) s = n - 4608 + 4780;
        else if (n < 5128) s = n - 5120 + 1280;
        else if (n < 5256) s = n - 5128 + 2824;
        else if (n < 5288) s = n - 5256 + 2952;
        else if (n < 5292) s = n - 5288 + 2984;
        else if (n < 5376) return nullptr;
        else s = n - 5376 + 5292;
        return w + s; } };
struct SrcPlain { const float* w; int ndst, ld; __device__ __forceinline__ const float* col(int n) const { return w + n; } };
struct SrcW13 { const float* w1; const float* w3; int ndst, ld;
    __device__ __forceinline__ const float* col(int n) const { const int pn = n >> 8, r = n & 255; return w1 + (r < 128 ? (ptrdiff_t)0 : (w3 - w1)) + pn * 128 + (r & 127); } };

__device__ __forceinline__ void phase_weights(KArgs C, int layer, unsigned char* lds, int gw, int ngw, int lane, int wave) {
    float* scr = (float*)(lds + wave * 16384); const size_t wo = (layer & 1) ? WDELTA : 0;
    constexpr int N_IN_ = 16 * (NPROJ / 32), N_BR = 8 * 32, N_OUT = 16 * 32, N_13 = 16 * (5632 / 32), N_2 = 44 * 32, N_GLU = 8 * 16;
    { constexpr int E0 = N_IN_, E1 = E0 + 4 * N_BR, E2 = E1 + N_OUT, E3 = E2 + N_13, E4 = E3 + N_2, E5 = E4 + N_GLU;
      for (int it = gw; it < E5; it += ngw) {
          if (it < E0) { const SrcWin s_in{C->in[I_WIN] + (size_t)layer * 1024 * IN_COLS, NPROJ, IN_COLS}; transpose_item(s_in, 1024, WSP(bf16, WS_WIN + wo), scr, it, lane); }
          else if (it < E1) { const int i2 = it - E0, n = i2 / N_BR; const SrcPlain s_b{C->in[I_WBR] + ((size_t)layer * 4 + n) * 512 * 1024, 1024, 1024};
              transpose_item(s_b, 512, WSP(bf16, WS_WB + wo) + (size_t)n * 1024 * 512, scr, i2 % N_BR, lane); }
          else if (it < E2) { const SrcPlain s_out{C->in[I_WOUT] + (size_t)layer * 1024 * 1024, 1024, 1024}; transpose_item(s_out, 1024, WSP(bf16, WS_WOUT + wo), scr, it - E1, lane); }
          else if (it < E3) { const SrcW13 s_13{C->in[I_W1] + (size_t)layer * 1024 * FFN, C->in[I_W3] + (size_t)layer * 1024 * FFN, 5632, FFN}; transpose_item(s_13, 1024, WSP(bf16, WS_W13 + wo), scr, it - E2, lane); }
          else if (it < E4) { const SrcPlain s_2{C->in[I_W2F] + (size_t)layer * FFN * 1024, 1024, 1024}; transpose_item(s_2, FFN, WSP(bf16, WS_W2 + wo), scr, it - E3, lane); }
          else { const SrcPlain s_glu{C->in[I_GLUW] + (size_t)layer * 512 * 512, 512, 512}; transpose_item(s_glu, 512, WSP(bf16, WS_GLU + wo), scr, it - E4, lane); } } }
    { const float* w2 = C->in[I_W2] + (size_t)layer * 64 * 512; const float* a2 = C->in[I_A2] + (size_t)layer * 64 * 512; const float* g2 = C->in[I_G2] + (size_t)layer * 128 * 512;
      bf16* WL = WSP(bf16, WS_WLORA + wo);
      for (int e = gw * 64 + lane; e < 1536 * 256; e += ngw * 64) { const int n = e >> 8, kc = e & 255; float v = 0.f;
          if (n < 512) { if (kc < 64) v = w2[kc * 512 + n]; } else if (n < 1024) { if (kc >= 64 && kc < 128) v = a2[(kc - 64) * 512 + (n - 512)]; } else { if (kc >= 128) v = g2[(kc - 128) * 512 + (n - 1024)]; }
          WL[e] = f2bf(v); } }
    const int gt = gw * 64 + lane, ngt = ngw * 64;
    for (int ej = ngt - 1 - gt; ej < 32 * 64 * 16; ej += ngt) {
        const int e = ej >> 4, j = ej & 15, g = e >> 6;
        const float ar = C->in[I_S5ARE][layer * 2048 + e], ai = C->in[I_S5AIM][layer * 2048 + e], dt = expf(C->in[I_S5LDT][layer * 32 + g]);
        const float br = C->in[I_S5BRE][((size_t)layer * 2048 + e) * 16 + j], bi = C->in[I_S5BIM][((size_t)layer * 2048 + e) * 16 + j];
        const float mag = expf(ar * dt), abr = mag * cosf(ai * dt), abi = mag * sinf(ai * dt);
        const float den = ar * ar + ai * ai, nr = abr - 1.0f, ni = abi;
        const float qr = (nr * ar + ni * ai) / den, qi = (ni * ar - nr * ai) / den;
        if (j == 0) { float* ab = WSP(float, WS_ABAR + wo) + e * 2; ab[0] = abr; ab[1] = abi; }
        float* bb = WSP(float, WS_BBAR + wo) + (size_t)e * 32;
        bb[2 * j] = qr * br - qi * bi; bb[2 * j + 1] = qr * bi + qi * br;
    }
    if (layer == 0) for (int e = gt; e < SEQ + 63; e += ngt) {
        const int rel = e - (SEQ - 1); const int n = rel < 0 ? -rel : rel; int b = rel > 0 ? 16 : 0;
        if (n < 8) b += n; else { int lg = 8 + (int)(logf((float)n / 8.0f) / 3.4657359028f * 8.0f); if (lg > 15) lg = 15; b += lg; }
        WSP(int, WS_TAB)[e] = b;
    }
}

__device__ __forceinline__ void rms_row_bf16(const float* xrow, const float* g, bf16* orow, int lane) {
    const f32x4* xr = (const f32x4*)xrow + lane; const f32x4* gr = (const f32x4*)g + lane;
    f32x4 v[4]; float s = 0.f;
#pragma unroll
    for (int j = 0; j < 4; ++j) { v[j] = xr[64 * j]; s += (v[j].x * v[j].x + v[j].y * v[j].y) + (v[j].z * v[j].z + v[j].w * v[j].w); }
    const float rstd = 1.0f / sqrtf(wave_sum(s) * (1.f / D) + RMS_EPS);
    u32x2* o8 = (u32x2*)orow + lane;
#pragma unroll
    for (int j = 0; j < 4; ++j) { const f32x4 gg = gr[64 * j]; u32x2 w; w.x = pk2(v[j].x * rstd * gg.x, v[j].y * rstd * gg.y); w.y = pk2(v[j].z * rstd * gg.z, v[j].w * rstd * gg.w); o8[64 * j] = w; }
}
template <int NR>
__device__ __forceinline__ void rms_rows_bf16(const float* x, const float* g, bf16* o, int gw, int ngw, int nrows, int lane) {
    const f32x4* gr = (const f32x4*)g + lane; f32x4 gg[4], v[NR][4], nx[NR][4];
#pragma unroll
    for (int j = 0; j < 4; ++j) gg[j] = gr[64 * j];
#pragma unroll
    for (int q = 0; q < NR; ++q)
#pragma unroll
        for (int j = 0; j < 4; ++j) nx[q][j] = (gw + q * ngw < nrows) ? ((const f32x4*)(x + (size_t)(gw + q * ngw) * D) + lane)[64 * j] : (f32x4){0.f, 0.f, 0.f, 0.f};
    for (int m = gw; m < nrows; m += NR * ngw) {
#pragma unroll
        for (int q = 0; q < NR; ++q)
#pragma unroll
            for (int j = 0; j < 4; ++j) v[q][j] = nx[q][j];
        if (m + NR * ngw < nrows) {
#pragma unroll
            for (int q = 0; q < NR; ++q)
#pragma unroll
                for (int j = 0; j < 4; ++j) nx[q][j] = (m + (NR + q) * ngw < nrows) ? ((const f32x4*)(x + (size_t)(m + (NR + q) * ngw) * D) + lane)[64 * j] : (f32x4){0.f, 0.f, 0.f, 0.f}; }
        float ss[NR];
#pragma unroll
        for (int q = 0; q < NR; ++q) { float s = 0.f;
#pragma unroll
            for (int j = 0; j < 4; ++j) s += (v[q][j].x * v[q][j].x + v[q][j].y * v[q][j].y) + (v[q][j].z * v[q][j].z + v[q][j].w * v[q][j].w);
            ss[q] = s; }
#pragma unroll
        for (int of = 1; of < 64; of <<= 1)
#pragma unroll
            for (int q = 0; q < NR; ++q) ss[q] += __shfl_xor(ss[q], of);
#pragma unroll
        for (int q = 0; q < NR; ++q) if (m + q * ngw < nrows) { const float r = 1.0f / sqrtf(ss[q] * (1.f / D) + RMS_EPS); u32x2* o8 = (u32x2*)(o + (size_t)(m + q * ngw) * D) + lane;
#pragma unroll
            for (int j = 0; j < 4; ++j) { u32x2 w; w.x = pk2(v[q][j].x * r * gg[j].x, v[q][j].y * r * gg[j].y); w.y = pk2(v[q][j].z * r * gg[j].z, v[q][j].w * r * gg[j].w); o8[64 * j] = w; } } }
}
template <int NR>
__device__ __forceinline__ void rms_rowN_bf16(const float* xrow, const float* g, bf16* orow, size_t step, int lane) {
    const f32x4* gr = (const f32x4*)g + lane; f32x4 v[NR][4]; float ss[NR];
#pragma unroll
    for (int q = 0; q < NR; ++q)
#pragma unroll
        for (int j = 0; j < 4; ++j) v[q][j] = ((const f32x4*)(xrow + q * step) + lane)[64 * j];
#pragma unroll
    for (int q = 0; q < NR; ++q) { float s = 0.f;
#pragma unroll
        for (int j = 0; j < 4; ++j) s += (v[q][j].x * v[q][j].x + v[q][j].y * v[q][j].y) + (v[q][j].z * v[q][j].z + v[q][j].w * v[q][j].w);
        ss[q] = s; }
#pragma unroll
    for (int o = 1; o < 64; o <<= 1)
#pragma unroll
        for (int q = 0; q < NR; ++q) ss[q] += __shfl_xor(ss[q], o);
#pragma unroll
    for (int q = 0; q < NR; ++q) { const float r = 1.0f / sqrtf(ss[q] * (1.f / D) + RMS_EPS); u32x2* o8 = (u32x2*)(orow + q * step) + lane;
#pragma unroll
        for (int j = 0; j < 4; ++j) { const f32x4 gg = gr[64 * j]; u32x2 w; w.x = pk2(v[q][j].x * r * gg.x, v[q][j].y * r * gg.y); w.y = pk2(v[q][j].z * r * gg.z, v[q][j].w * r * gg.w); o8[64 * j] = w; } }
}
__device__ __forceinline__ void rms_row_f32(float* xrow, const float* g, int lane) {
    f32x4* xr = (f32x4*)xrow + lane; const f32x4* gr = (const f32x4*)g + lane;
    f32x4 v[4]; float s = 0.f;
#pragma unroll
    for (int j = 0; j < 4; ++j) { v[j] = xr[64 * j]; s += (v[j].x * v[j].x + v[j].y * v[j].y) + (v[j].z * v[j].z + v[j].w * v[j].w); }
    const float rstd = 1.0f / sqrtf(wave_sum(s) * (1.f / D) + RMS_EPS);
#pragma unroll
    for (int j = 0; j < 4; ++j) xr[64 * j] = v[j] * rstd * gr[64 * j];
}

#ifdef HOST_EMU
__device__ __forceinline__ float red8(float v) { v += __shfl_xor(v, 1); v += __shfl_xor(v, 2); v += __shfl_xor(v, 4); return v; }
__device__ __forceinline__ float red16(float v) { v = red8(v); v += __shfl_xor(v, 8); return v; }
#else
template <int CTRL> __device__ __forceinline__ float dpp_f(float v) { return __builtin_bit_cast(float, __builtin_amdgcn_update_dpp(0, __builtin_bit_cast(int, v), CTRL, 0xf, 0xf, true)); }
__device__ __forceinline__ float red8(float v) { v += dpp_f<0xB1>(v); v += dpp_f<0x4E>(v); v += dpp_f<0x141>(v); return v; }
__device__ __forceinline__ float red16(float v) { v = red8(v); v += dpp_f<0x140>(v); return v; }
#endif
__device__ __forceinline__ f32x4 sig4g(const f32x4 v) { return (f32x4){sigm(v[0]), sigm(v[1]), sigm(v[2]), sigm(v[3])}; }
__device__ __forceinline__ void rms_row2_f32(float* xrow, size_t step, const float* g, int lane) {
    f32x4* xa = (f32x4*)xrow + lane; f32x4* xb = (f32x4*)(xrow + step) + lane; const f32x4* gr = (const f32x4*)g + lane;
    f32x4 va[4], vb[4]; float sa = 0.f, sb = 0.f;
#pragma unroll
    for (int j = 0; j < 4; ++j) { va[j] = xa[64 * j]; vb[j] = xb[64 * j]; }
#pragma unroll
    for (int j = 0; j < 4; ++j) { sa += (va[j].x * va[j].x + va[j].y * va[j].y) + (va[j].z * va[j].z + va[j].w * va[j].w); sb += (vb[j].x * vb[j].x + vb[j].y * vb[j].y) + (vb[j].z * vb[j].z + vb[j].w * vb[j].w); }
#pragma unroll
    for (int o = 1; o < 64; o <<= 1) { sa += __shfl_xor(sa, o); sb += __shfl_xor(sb, o); }
    const float ra = 1.0f / sqrtf(sa * (1.f / D) + RMS_EPS), rb = 1.0f / sqrtf(sb * (1.f / D) + RMS_EPS);
#pragma unroll
    for (int j = 0; j < 4; ++j) { const f32x4 gg = gr[64 * j]; xa[64 * j] = va[j] * ra * gg; xb[64 * j] = vb[j] * rb * gg; }
}
__device__ __forceinline__ void ssd_conv_row(KArgs C, int layer, int m, int lane) {
    const int t = m % SEQ; const float* cw = C->in[I_CONVW] + layer * 4 * 768; const float* cb = C->in[I_CONVB] + layer * 768;
#pragma unroll
    for (int i = 0; i < 3; ++i) { const int ch = i * 256 + lane * 4; const bf16* p = WSP(const bf16, WS_XBC) + (size_t)m * 768 + ch;
        f32x4 a = *(const f32x4*)(cb + ch);
#pragma unroll
        for (int q = 0; q < 4; ++q) if (t - 3 + q >= 0) { const u32x2 w = *(const u32x2*)(p - (3 - q) * 768); const f32x4 cq = *(const f32x4*)(cw + q * 768 + ch);
            a += cq * (f32x4){lo_bf(w.x), hi_bf(w.x), lo_bf(w.y), hi_bf(w.y)}; }
        a = a * sig4g(a);
        u32x2 o; o.x = pk2(a.x, a.y); o.y = pk2(a.z, a.w); *(u32x2*)(WSP(bf16, WS_XBA) + (size_t)m * 768 + ch) = o; }
}
__device__ __forceinline__ void ssd_conv_row2(KArgs C, int layer, int m, int step, int lane) {
    const float* cw = C->in[I_CONVW] + layer * 4 * 768; const float* cb = C->in[I_CONVB] + layer * 768;
    u32x2 w[2][3][4]; f32x4 cq[3][4], bb[3];
#pragma unroll
    for (int i = 0; i < 3; ++i) { const int ch = i * 256 + lane * 4; bb[i] = *(const f32x4*)(cb + ch);
#pragma unroll
        for (int q = 0; q < 4; ++q) { cq[i][q] = *(const f32x4*)(cw + q * 768 + ch);
#pragma unroll
            for (int r = 0; r < 2; ++r) { const int mm = m + r * step, t = mm % SEQ; const bf16* p = WSP(const bf16, WS_XBC) + (size_t)mm * 768 + ch;
                if (t - 3 + q >= 0) w[r][i][q] = *(const u32x2*)(p - (3 - q) * 768); else { w[r][i][q].x = 0u; w[r][i][q].y = 0u; } } } }
#pragma unroll
    for (int r = 0; r < 2; ++r)
#pragma unroll
        for (int i = 0; i < 3; ++i) { const int ch = i * 256 + lane * 4; f32x4 a = bb[i];
#pragma unroll
            for (int q = 0; q < 4; ++q) a += cq[i][q] * (f32x4){lo_bf(w[r][i][q].x), hi_bf(w[r][i][q].x), lo_bf(w[r][i][q].y), hi_bf(w[r][i][q].y)};
            a = a * sig4g(a);
            u32x2 o; o.x = pk2(a.x, a.y); o.y = pk2(a.z, a.w); *(u32x2*)(WSP(bf16, WS_XBA) + (size_t)(m + r * step) * 768 + ch) = o; }
}
__device__ __forceinline__ void ssd_unit(KArgs C, int layer, int unit, unsigned char* lds) {
    const int tid = fresh_tid(), lane = tid & 63, wave = tid >> 6, bl = unit >> 3, h = unit & 7, gi = h >> 2, pp = tid >> 3, c8 = (tid & 7) * 8, c16 = lane & 15, q = lane >> 4;
    bf16* Cb = (bf16*)lds; bf16* Bb = Cb + 4096; bf16* XT = Bb + 4096; bf16* BwT = XT + 4096; bf16* Pm = BwT + 4096; float* Yo = (float*)(Pm + 4096); float* dts = Yo + 8192; float* acs = dts + 128;
    const bf16* XA = WSP(const bf16, WS_XBA) + (size_t)bl * SEQ * 768 + (size_t)pp * 768 + c8;
    const bf16* SMp = WSP(const bf16, WS_SM) + (size_t)bl * SEQ * 256;
    const bf16* Zp = WSP(const bf16, WS_Z) + (size_t)bl * SEQ * 512 + (size_t)pp * 512 + h * 64 + c8;
    bf16* YA = WSP(bf16, WS_Y) + (size_t)bl * SEQ * 512 + (size_t)pp * 512 + h * 64 + c8;
    const float dtb = C->in[I_DTB][layer * 8 + h], A = -__expf(C->in[I_ALOG][layer * 8 + h]), Dh = C->in[I_SSDD][layer * 8 + h];
    f32x4_t Sd[2]; bf16x8_t Sf; Sd[0] = (f32x4_t){0.f, 0.f, 0.f, 0.f}; Sd[1] = Sd[0]; { u32x2 z; z.x = 0u; z.y = 0u; Sf = frag2(z, z); }
    const int pt = wave & 3, nh = wave >> 2;
    u32x4 fx, fb, fc, fz;
#define SSD_FETCH(c0_) do { const bf16* q_ = XA + (size_t)(c0_) * 768; fx = *(const u32x4*)(q_ + h * 64); fb = *(const u32x4*)(q_ + 512 + gi * 64); fc = *(const u32x4*)(q_ + 640 + gi * 64); fz = *(const u32x4*)(Zp + (size_t)(c0_) * 512); } while (0)
#define SSD_DT(c0_, par) do { if (wave == 0) { const float dt_ = softplusf(bf2f(SMp[(size_t)((c0_) + lane) * 256 + h]) + dtb); float a_ = A * dt_; \
        _Pragma("unroll") for (int o_ = 1; o_ < 64; o_ <<= 1) { const float t_ = __shfl_up(a_, o_); if (lane >= o_) a_ += t_; } dts[(par) * 64 + lane] = dt_; acs[(par) * 64 + lane] = a_; } } while (0)
    LDS_SYNC();
    SSD_FETCH(0); SSD_DT(0, 0);
    for (int c0 = 0, par = 0; c0 < SEQ; c0 += 64, par ^= 1) {
        LDS_SYNC();
        const u32x4 xk = fx, zk = fz;
        {
          const float dt = dts[par * 64 + pp], ea = __expf(acs[par * 64 + 63] - acs[par * 64 + pp]);
          *(u32x4*)(Cb + pp * 64 + c8) = fc; *(u32x4*)(Bb + pp * 64 + c8) = fb;
          f32x4 x0, x1, b0, b1; pg8::unpack8(fx, x0, x1); pg8::unpack8(fb, b0, b1); x0 = x0 * dt; x1 = x1 * dt; b0 = b0 * ea; b1 = b1 * ea;
#pragma unroll
          for (int i = 0; i < 4; ++i) { XT[(c8 + i) * 64 + pp] = f2bf(x0[i]); XT[(c8 + 4 + i) * 64 + pp] = f2bf(x1[i]); BwT[(c8 + i) * 64 + pp] = f2bf(b0[i]); BwT[(c8 + 4 + i) * 64 + pp] = f2bf(b1[i]); } }
        if (c0 + 64 < SEQ) { SSD_FETCH(c0 + 64); SSD_DT(c0 + 64, par ^ 1); }
        LDS_SYNC();
        {
          const f32x4_t z4 = {0.f, 0.f, 0.f, 0.f};
#pragma unroll
          for (int i = 0; i < 2; ++i) { const int id = wave + 8 * i, lt = id >> 2, st = id & 3; f32x4_t g = z4;
              if (st <= lt) {
#pragma unroll
                  for (int ks = 0; ks < 2; ++ks) g = __builtin_amdgcn_mfma_f32_16x16x32_bf16(*(const bf16x8_t*)(Cb + (16 * lt + c16) * 64 + 32 * ks + 8 * q), *(const bf16x8_t*)(Bb + (16 * st + c16) * 64 + 32 * ks + 8 * q), g, 0, 0, 0);
                  const float as_ = acs[par * 64 + 16 * st + c16];
#pragma unroll
                  for (int r = 0; r < 4; ++r) { const int l = 16 * lt + 4 * q + r; g[r] = (16 * st + c16 <= l) ? g[r] * __expf(acs[par * 64 + l] - as_) : 0.f; } }
#pragma unroll
              for (int r = 0; r < 4; ++r) Pm[(16 * lt + 4 * q + r) * 64 + 16 * st + c16] = f2bf(g[r]); }
#pragma unroll
          for (int lt = 0; lt < 4; ++lt) { const bf16* cr = Cb + (16 * lt + c16) * 64 + 32 * nh + 4 * q;
              const f32x4_t yo = __builtin_amdgcn_mfma_f32_16x16x32_bf16(frag2(*(const u32x2*)cr, *(const u32x2*)(cr + 16)), Sf, z4, 0, 0, 0);
#pragma unroll
              for (int r = 0; r < 4; ++r) Yo[nh * 4096 + (16 * lt + 4 * q + r) * 64 + 16 * pt + c16] = yo[r]; }
          const float eL = __expf(acs[par * 64 + 63]);
          const bf16x8_t xb0 = *(const bf16x8_t*)(XT + (16 * pt + c16) * 64 + 8 * q), xb1 = *(const bf16x8_t*)(XT + (16 * pt + c16) * 64 + 32 + 8 * q);
#pragma unroll
          for (int i = 0; i < 2; ++i) { const bf16* br = BwT + (16 * (2 * nh + i) + c16) * 64 + 8 * q; f32x4_t cin = Sd[i] * eL;
              cin = __builtin_amdgcn_mfma_f32_16x16x32_bf16(*(const bf16x8_t*)br, xb0, cin, 0, 0, 0); Sd[i] = __builtin_amdgcn_mfma_f32_16x16x32_bf16(*(const bf16x8_t*)(br + 32), xb1, cin, 0, 0, 0); }
          u32x2 lo, hi; lo.x = pk2(Sd[0][0], Sd[0][1]); lo.y = pk2(Sd[0][2], Sd[0][3]); hi.x = pk2(Sd[1][0], Sd[1][1]); hi.y = pk2(Sd[1][2], Sd[1][3]); Sf = frag2(lo, hi); }
        LDS_SYNC();
        {
          const f32x4_t z4 = {0.f, 0.f, 0.f, 0.f};
#pragma unroll
          for (int i = 0; i < 2; ++i) { const int id = wave + 8 * i, lt = id >> 2, p2 = id & 3;
              f32x4_t y = __builtin_amdgcn_mfma_f32_16x16x32_bf16(*(const bf16x8_t*)(Pm + (16 * lt + c16) * 64 + 8 * q), *(const bf16x8_t*)(XT + (16 * p2 + c16) * 64 + 8 * q), z4, 0, 0, 0);
              if (lt >= 2) y = __builtin_amdgcn_mfma_f32_16x16x32_bf16(*(const bf16x8_t*)(Pm + (16 * lt + c16) * 64 + 32 + 8 * q), *(const bf16x8_t*)(XT + (16 * p2 + c16) * 64 + 32 + 8 * q), y, 0, 0, 0);
#pragma unroll
              for (int r = 0; r < 4; ++r) { const int l = 16 * lt + 4 * q + r, o = l * 64 + 16 * p2 + c16; Yo[o] = y[r] + __expf(acs[par * 64 + l]) * (Yo[o] + Yo[4096 + o]); } } }
        LDS_SYNC();
        {
          f32x4 x0, x1, z0, z1; pg8::unpack8(xk, x0, x1); pg8::unpack8(zk, z0, z1);
          const f32x4 y0 = (*(const f32x4*)(Yo + pp * 64 + c8) + Dh * x0) * z0 * sig4g(z0), y1 = (*(const f32x4*)(Yo + pp * 64 + c8 + 4) + Dh * x1) * z1 * sig4g(z1);
          *(u32x4*)(YA + (size_t)c0 * 512) = pg8::pack8(y0, y1); }
    }
#undef SSD_FETCH
#undef SSD_DT
}
__device__ __forceinline__ void ssd_norm_item4(KArgs C, int layer, int item0, int stride, int nitems, int lane) {
    u32x2 w[4]; bf16* p[4];
#pragma unroll
    for (int q = 0; q < 4; ++q) { const int item = item0 + q * stride; p[q] = WSP(bf16, WS_Y) + (size_t)((item < nitems ? item : item0) >> 1) * 512 + ((item < nitems ? item : item0) & 1) * 256 + lane * 4; w[q] = *(const u32x2*)p[q]; }
#pragma unroll
    for (int q = 0; q < 4; ++q) { const int item = item0 + q * stride; if (item < nitems) {
        float v[4] = {lo_bf(w[q].x), hi_bf(w[q].x), lo_bf(w[q].y), hi_bf(w[q].y)};
        const float rstd = 1.0f / sqrtf(wave_sum(v[0] * v[0] + v[1] * v[1] + v[2] * v[2] + v[3] * v[3]) * (1.f / 256) + RMS_EPS);
        const float* g = C->in[I_SSDNG] + layer * 512 + (item & 1) * 256 + lane * 4;
        u32x2 o; o.x = pk2(v[0] * rstd * g[0], v[1] * rstd * g[1]); o.y = pk2(v[2] * rstd * g[2], v[3] * rstd * g[3]); *(u32x2*)p[q] = o; } }
}
__device__ __forceinline__ void rwkv_prep_row(KArgs C, int layer, int m, int lane) {
    const int t = m % SEQ, col = 1536 + lane * 4;
    const bf16* cur = WSP(const bf16, WS_RW) + (size_t)m * 1792 + col;
    const u32x2 wc = *(const u32x2*)cur; u32x2 wp; wp.x = 0u; wp.y = 0u; if (t > 0) wp = *(const u32x2*)(cur - 1792);
    const f32x4 mu = *(const f32x4*)(C->in[I_MU] + layer * 1792 + col);
    float v[4] = {lo_bf(wc.x), hi_bf(wc.x), lo_bf(wc.y), hi_bf(wc.y)}; const float p[4] = {lo_bf(wp.x), hi_bf(wp.x), lo_bf(wp.y), hi_bf(wp.y)};
#pragma unroll
    for (int i = 0; i < 4; ++i) { v[i] = v[i] + (p[i] - v[i]) * mu[i]; v[i] = lane < 16 ? tanh_fast(v[i]) : (lane < 32 ? v[i] : sigm(v[i])); }
    u32x2 o; o.x = pk2(v[0], v[1]); o.y = pk2(v[2], v[3]); *(u32x2*)(WSP(bf16, WS_RA) + (size_t)m * 256 + lane * 4) = o;
}
__device__ __forceinline__ void ssd_conv_rows8(KArgs C, int layer, int m0, int lane) {
    const float* cw = C->in[I_CONVW] + layer * 4 * 768; const float* cb = C->in[I_CONVB] + layer * 768; const bool head = (m0 % SEQ) == 0;
    u32x2 w[3][11];
#pragma unroll
    for (int i = 0; i < 3; ++i) { const bf16* p = WSP(const bf16, WS_XBC) + (size_t)m0 * 768 + i * 256 + lane * 4;
#pragma unroll
        for (int r = 0; r < 11; ++r) { if (r >= 3 || !head) w[i][r] = *(const u32x2*)(p + (r - 3) * 768); else { w[i][r].x = 0u; w[i][r].y = 0u; } } }
#pragma unroll
    for (int i = 0; i < 3; ++i) { const int ch = i * 256 + lane * 4; const f32x4 bb = *(const f32x4*)(cb + ch); f32x4 cq[4], x[11];
#pragma unroll
        for (int q = 0; q < 4; ++q) cq[q] = *(const f32x4*)(cw + q * 768 + ch);
#pragma unroll
        for (int r = 0; r < 11; ++r) x[r] = (f32x4){lo_bf(w[i][r].x), hi_bf(w[i][r].x), lo_bf(w[i][r].y), hi_bf(w[i][r].y)};
#pragma unroll
        for (int r = 0; r < 8; ++r) { f32x4 a = bb;
#pragma unroll
            for (int q = 0; q < 4; ++q) a += cq[q] * x[r + q];
            a = a * sig4g(a);
            u32x2 o; o.x = pk2(a.x, a.y); o.y = pk2(a.z, a.w); *(u32x2*)(WSP(bf16, WS_XBA) + (size_t)(m0 + r) * 768 + ch) = o; } }
}
__device__ __forceinline__ void rwkv_prep_rows8(KArgs C, int layer, int m0, int lane) {
    const int col = 1536 + lane * 4; const f32x4 mu = *(const f32x4*)(C->in[I_MU] + layer * 1792 + col); const bool head = (m0 % SEQ) == 0;
    const bf16* cur = WSP(const bf16, WS_RW) + (size_t)m0 * 1792 + col; u32x2 w[9];
#pragma unroll
    for (int r = 0; r < 9; ++r) { if (r >= 1 || !head) w[r] = *(const u32x2*)(cur + (r - 1) * 1792); else { w[r].x = 0u; w[r].y = 0u; } }
#pragma unroll
    for (int r = 0; r < 8; ++r) { float v[4] = {lo_bf(w[r + 1].x), hi_bf(w[r + 1].x), lo_bf(w[r + 1].y), hi_bf(w[r + 1].y)}; const float p[4] = {lo_bf(w[r].x), hi_bf(w[r].x), lo_bf(w[r].y), hi_bf(w[r].y)};
#pragma unroll
        for (int i = 0; i < 4; ++i) { v[i] = v[i] + (p[i] - v[i]) * mu[i]; v[i] = lane < 16 ? tanh_fast(v[i]) : (lane < 32 ? v[i] : sigm(v[i])); }
        u32x2 o; o.x = pk2(v[0], v[1]); o.y = pk2(v[2], v[3]); *(u32x2*)(WSP(bf16, WS_RA) + (size_t)(m0 + r) * 256 + lane * 4) = o; }
}
__device__ __forceinline__ void rwkv_prep_row2(KArgs C, int layer, int m, int step, int lane) {
    const int col = 1536 + lane * 4; const f32x4 mu = *(const f32x4*)(C->in[I_MU] + layer * 1792 + col);
    u32x2 wc[2], wp[2];
#pragma unroll
    for (int r = 0; r < 2; ++r) { const int mm = m + r * step; const bf16* cur = WSP(const bf16, WS_RW) + (size_t)mm * 1792 + col; wc[r] = *(const u32x2*)cur;
        if (mm % SEQ > 0) wp[r] = *(const u32x2*)(cur - 1792); else { wp[r].x = 0u; wp[r].y = 0u; } }
#pragma unroll
    for (int r = 0; r < 2; ++r) { float v[4] = {lo_bf(wc[r].x), hi_bf(wc[r].x), lo_bf(wc[r].y), hi_bf(wc[r].y)}; const float p[4] = {lo_bf(wp[r].x), hi_bf(wp[r].x), lo_bf(wp[r].y), hi_bf(wp[r].y)};
#pragma unroll
        for (int i = 0; i < 4; ++i) { v[i] = v[i] + (p[i] - v[i]) * mu[i]; v[i] = lane < 16 ? tanh_fast(v[i]) : (lane < 32 ? v[i] : sigm(v[i])); }
        u32x2 o; o.x = pk2(v[0], v[1]); o.y = pk2(v[2], v[3]); *(u32x2*)(WSP(bf16, WS_RA) + (size_t)(m + r * step) * 256 + lane * 4) = o; }
}
__device__ __forceinline__ void rwkv_unit(KArgs C, int layer, int unit, unsigned char* lds) {
    constexpr int SLOT = 16704, O_RT = 2048, O_BTL = 4096, O_KTL = 6144, O_BHT = 8192, O_KHT = 10240, O_VT = 12288, O_TM = 14336, O_AAK = 14848, O_RB = 15360, O_RK = 15872, O_DL = 16384, O_BON = 16640;
    const int tid = fresh_tid(), lane = tid & 63, wave = tid >> 6, bl = unit >> 3, h = unit & 7, pt = tid >> 3, k8 = (tid & 7) * 8, cc = pt >> 4, tl = pt & 15, hc = h * 64 + k8;
    float* WL = (float*)(lds + 4 * SLOT); float* Nf = WL + 4096; float* Yb = Nf + 1024; float* ct_ = Yb + 4096;
    const bf16* RW = WSP(const bf16, WS_RW) + (size_t)bl * SEQ * 1792 + hc;
    const float* WLG = WSP(const float, WS_WLOG) + (size_t)bl * SEQ * 512 + hc;
    const bf16* AS = WSP(const bf16, WS_ASIG) + (size_t)bl * SEQ * 512 + hc;
    const bf16* GG = WSP(const bf16, WS_GG) + (size_t)bl * SEQ * 512 + hc;
    bf16* YC = WSP(bf16, WS_Y) + (size_t)2 * MG * 512 + (size_t)bl * SEQ * 512 + hc;
    LDS_SYNC();
    { const int row = tid >> 6, j = tid & 63; const float* src = row == 0 ? C->in[I_MU] + layer * 1792 : row == 1 ? C->in[I_MU] + layer * 1792 + 512 : row == 2 ? C->in[I_MU] + layer * 1792 + 1024
          : row == 3 ? C->in[I_KK] + layer * 512 : row == 4 ? C->in[I_KA] + layer * 512 : row == 5 ? C->in[I_RK] + layer * 512 : row == 6 ? C->in[I_LNG] + layer * 512 : C->in[I_LNB] + layer * 512;
      ct_[tid] = src[h * 64 + j]; }
    f32x4_t Sd[4]; bf16x8_t Sf[2];
#pragma unroll
    for (int i = 0; i < 4; ++i) Sd[i] = (f32x4_t){0.f, 0.f, 0.f, 0.f};
    { u32x2 z; z.x = 0u; z.y = 0u; Sf[0] = frag2(z, z); Sf[1] = Sf[0]; }
    u32x4 rc, rp, kc, kp, vc, vp, ac, gc; f32x4 wl0, wl1;
#define RWKV_FETCH(c0_) do { const int tt_ = (c0_) + pt; const bf16* q_ = RW + (size_t)tt_ * 1792; \
        rc = *(const u32x4*)q_; kc = *(const u32x4*)(q_ + 512); vc = *(const u32x4*)(q_ + 1024); \
        if (tt_ > 0) { rp = *(const u32x4*)(q_ - 1792); kp = *(const u32x4*)(q_ - 1792 + 512); vp = *(const u32x4*)(q_ - 1792 + 1024); } else { rp = (u32x4){0u, 0u, 0u, 0u}; kp = rp; vp = rp; } \
        wl0 = *(const f32x4*)(WLG + (size_t)tt_ * 512); wl1 = *(const f32x4*)(WLG + (size_t)tt_ * 512 + 4); ac = *(const u32x4*)(AS + (size_t)tt_ * 512); gc = *(const u32x4*)(GG + (size_t)tt_ * 512); } while (0)
    RWKV_FETCH(0);
    LDS_SYNC();
    for (int c0 = 0; c0 < SEQ; c0 += 64) {
        unsigned char* slot = lds + cc * SLOT;
        f32x4 r0, r1, kq0, kq1, v0, v1, kk0, kk1, b0, b1; const u32x4 gkeep = gc; const f32x4 wk0 = wl0, wk1 = wl1; float bo;
        { f32x4 c0_, c1_, p0_, p1_, a0, a1;
          pg8::unpack8(rc, c0_, c1_); pg8::unpack8(rp, p0_, p1_); r0 = c0_ + (p0_ - c0_) * *(const f32x4*)(ct_ + k8); r1 = c1_ + (p1_ - c1_) * *(const f32x4*)(ct_ + k8 + 4);
          pg8::unpack8(kc, c0_, c1_); pg8::unpack8(kp, p0_, p1_); const f32x4 k00 = c0_ + (p0_ - c0_) * *(const f32x4*)(ct_ + 64 + k8), k01 = c1_ + (p1_ - c1_) * *(const f32x4*)(ct_ + 64 + k8 + 4);
          pg8::unpack8(vc, c0_, c1_); pg8::unpack8(vp, p0_, p1_); v0 = c0_ + (p0_ - c0_) * *(const f32x4*)(ct_ + 128 + k8); v1 = c1_ + (p1_ - c1_) * *(const f32x4*)(ct_ + 128 + k8 + 4);
          pg8::unpack8(ac, a0, a1);
          kk0 = k00 * *(const f32x4*)(ct_ + 192 + k8); kk1 = k01 * *(const f32x4*)(ct_ + 192 + k8 + 4);
          const float inv = 1.0f / fmaxf(sqrtf(red8((kk0.x * kk0.x + kk0.y * kk0.y + kk0.z * kk0.z + kk0.w * kk0.w) + (kk1.x * kk1.x + kk1.y * kk1.y + kk1.z * kk1.z + kk1.w * kk1.w))), 1e-12f);
          kk0 = kk0 * inv; kk1 = kk1 * inv; b0 = kk0 * a0; b1 = kk1 * a1;
          kq0 = k00 * (1.0f + (a0 - 1.0f) * *(const f32x4*)(ct_ + 256 + k8)); kq1 = k01 * (1.0f + (a1 - 1.0f) * *(const f32x4*)(ct_ + 256 + k8 + 4));
          const f32x4 q0 = r0 * kq0 * *(const f32x4*)(ct_ + 320 + k8), q1 = r1 * kq1 * *(const f32x4*)(ct_ + 320 + k8 + 4);
          bo = red8((q0.x + q0.y + q0.z + q0.w) + (q1.x + q1.y + q1.z + q1.w));
          *(f32x4*)(WL + pt * 64 + k8) = wk0; *(f32x4*)(WL + pt * 64 + k8 + 4) = wk1; }
        if (c0 + 64 < SEQ) RWKV_FETCH(c0 + 64);
        LDS_SYNC();
        if (tid < 256) { const int c_ = tid >> 6, k_ = tid & 63; float w16[16], run = 0.f;
#pragma unroll
            for (int t = 0; t < 16; ++t) w16[t] = WL[(c_ * 16 + t) * 64 + k_];
#pragma unroll
            for (int t = 0; t < 16; ++t) { run += w16[t]; WL[(c_ * 16 + t) * 64 + k_] = run; }
            ((float*)(lds + c_ * SLOT + O_DL))[k_] = __expf(run); }
        LDS_SYNC();
        { const f32x4 cs0 = *(const f32x4*)(WL + pt * 64 + k8), cs1 = *(const f32x4*)(WL + pt * 64 + k8 + 4), d0 = *(const f32x4*)((const float*)(slot + O_DL) + k8), d1 = *(const f32x4*)((const float*)(slot + O_DL) + k8 + 4);
          f32x4 e0, e1, f0, f1, w0, w1;
#pragma unroll
          for (int i = 0; i < 4; ++i) { e0[i] = __expf(cs0[i]); e1[i] = __expf(cs1[i]); f0[i] = __builtin_amdgcn_rcpf(e0[i]); f1[i] = __builtin_amdgcn_rcpf(e1[i]); w0[i] = __expf(-wk0[i]); w1[i] = __expf(-wk1[i]); }
          const f32x4 bt0 = b0 * f0, bt1 = b1 * f1, kt0 = kq0 * f0, kt1 = kq1 * f1;
          *(u32x4*)((bf16*)slot + tl * 64 + k8) = pg8::pack8(-(kk0 * e0 * w0), -(kk1 * e1 * w1));
          *(u32x4*)((bf16*)(slot + O_RT) + tl * 64 + k8) = pg8::pack8(r0 * e0, r1 * e1);
          *(u32x4*)((bf16*)(slot + O_BTL) + tl * 64 + k8) = pg8::pack8(bt0, bt1);
          *(u32x4*)((bf16*)(slot + O_KTL) + tl * 64 + k8) = pg8::pack8(kt0, kt1);
          const f32x4 bh0 = bt0 * d0, bh1 = bt1 * d1, kh0 = kt0 * d0, kh1 = kt1 * d1;
          bf16* bht = (bf16*)(slot + O_BHT) + k8 * 16 + tl; bf16* kht = (bf16*)(slot + O_KHT) + k8 * 16 + tl; bf16* vt = (bf16*)(slot + O_VT) + k8 * 16 + tl;
#pragma unroll
          for (int i = 0; i < 4; ++i) { bht[i * 16] = f2bf(bh0[i]); bht[(i + 4) * 16] = f2bf(bh1[i]); kht[i * 16] = f2bf(kh0[i]); kht[(i + 4) * 16] = f2bf(kh1[i]); vt[i * 16] = f2bf(v0[i]); vt[(i + 4) * 16] = f2bf(v1[i]); } }
        LDS_SYNC();
        { unsigned char* sl = lds + (wave & 3) * SLOT; const int c16 = lane & 15, q = lane >> 4;
          const bf16x8_t a0 = *(const bf16x8_t*)((const bf16*)sl + c16 * 64 + 8 * q), a1 = *(const bf16x8_t*)((const bf16*)sl + c16 * 64 + 32 + 8 * q);
          const bf16x8_t bb0 = *(const bf16x8_t*)((const bf16*)(sl + O_BTL) + c16 * 64 + 8 * q), bb1 = *(const bf16x8_t*)((const bf16*)(sl + O_BTL) + c16 * 64 + 32 + 8 * q);
          const f32x4_t z4 = {0.f, 0.f, 0.f, 0.f};
          if (wave < 4) {
              f32x4_t n = __builtin_amdgcn_mfma_f32_16x16x32_bf16(a0, bb0, z4, 0, 0, 0); n = __builtin_amdgcn_mfma_f32_16x16x32_bf16(a1, bb1, n, 0, 0, 0);
              float* nf = Nf + (wave & 3) * 256;
#pragma unroll
              for (int r = 0; r < 4; ++r) nf[c16 * 16 + 4 * q + r] = (c16 < 4 * q + r) ? n[r] : 0.f;
              WAVE_SYNC();
              float tc[16];
#pragma unroll
              for (int t = 0; t < 16; ++t) tc[t] = (t == c16) ? 1.f : 0.f;
#pragma unroll
              for (int s2 = 0; s2 < 15; ++s2) { const f32x4 n0 = *(const f32x4*)(nf + s2 * 16), n1 = *(const f32x4*)(nf + s2 * 16 + 4), n2 = *(const f32x4*)(nf + s2 * 16 + 8), n3 = *(const f32x4*)(nf + s2 * 16 + 12);
                  const float ts = tc[s2]; const float nn[16] = {n0.x, n0.y, n0.z, n0.w, n1.x, n1.y, n1.z, n1.w, n2.x, n2.y, n2.z, n2.w, n3.x, n3.y, n3.z, n3.w};
#pragma unroll
                  for (int t = 0; t < 16; ++t) if (t > s2) tc[t] += nn[t] * ts; }
              if (q == 0) { bf16* tm = (bf16*)(sl + O_TM) + c16;
#pragma unroll
                  for (int t = 0; t < 16; ++t) tm[t * 16] = f2bf(tc[t]); }
          } else {
              const bf16x8_t r0f = *(const bf16x8_t*)((const bf16*)(sl + O_RT) + c16 * 64 + 8 * q), r1f = *(const bf16x8_t*)((const bf16*)(sl + O_RT) + c16 * 64 + 32 + 8 * q);
              const bf16x8_t kb0 = *(const bf16x8_t*)((const bf16*)(sl + O_KTL) + c16 * 64 + 8 * q), kb1 = *(const bf16x8_t*)((const bf16*)(sl + O_KTL) + c16 * 64 + 32 + 8 * q);
              f32x4_t ak = __builtin_amdgcn_mfma_f32_16x16x32_bf16(a0, kb0, z4, 0, 0, 0); ak = __builtin_amdgcn_mfma_f32_16x16x32_bf16(a1, kb1, ak, 0, 0, 0);
              f32x4_t rb = __builtin_amdgcn_mfma_f32_16x16x32_bf16(r0f, bb0, z4, 0, 0, 0); rb = __builtin_amdgcn_mfma_f32_16x16x32_bf16(r1f, bb1, rb, 0, 0, 0);
              f32x4_t rk = __builtin_amdgcn_mfma_f32_16x16x32_bf16(r0f, kb0, z4, 0, 0, 0); rk = __builtin_amdgcn_mfma_f32_16x16x32_bf16(r1f, kb1, rk, 0, 0, 0);
#pragma unroll
              for (int r = 0; r < 4; ++r) { const int t = 4 * q + r;
                  ((bf16*)(sl + O_AAK))[t * 16 + c16] = f2bf(c16 < t ? ak[r] : 0.f); ((bf16*)(sl + O_RB))[t * 16 + c16] = f2bf(c16 <= t ? rb[r] : 0.f); ((bf16*)(sl + O_RK))[t * 16 + c16] = f2bf(c16 <= t ? rk[r] : 0.f); }
          } }
        LDS_SYNC();
        if (wave < 4) { const int c16 = lane & 15, q = lane >> 4, vcol = 16 * wave + c16; u32x2 zz; zz.x = 0u; zz.y = 0u; const f32x4_t z4 = {0.f, 0.f, 0.f, 0.f};
#pragma unroll
            for (int ch = 0; ch < 4; ++ch) { const unsigned char* sl = lds + ch * SLOT;
                const bf16* at = (const bf16*)sl + c16 * 64 + 4 * q; const bf16* rt = (const bf16*)(sl + O_RT) + c16 * 64 + 4 * q;
                const bf16x8_t af0 = frag2(*(const u32x2*)at, *(const u32x2*)(at + 16)), af1 = frag2(*(const u32x2*)(at + 32), *(const u32x2*)(at + 48));
                const bf16x8_t rf0 = frag2(*(const u32x2*)rt, *(const u32x2*)(rt + 16)), rf1 = frag2(*(const u32x2*)(rt + 32), *(const u32x2*)(rt + 48));
                const u32x2 vq = *(const u32x2*)((const bf16*)(sl + O_VT) + vcol * 16 + 4 * q);
                const u32x2 aq = *(const u32x2*)((const bf16*)(sl + O_AAK) + c16 * 16 + 4 * q), tq = *(const u32x2*)((const bf16*)(sl + O_TM) + c16 * 16 + 4 * q);
                const u32x2 rbq = *(const u32x2*)((const bf16*)(sl + O_RB) + c16 * 16 + 4 * q), rkq = *(const u32x2*)((const bf16*)(sl + O_RK) + c16 * 16 + 4 * q);
                f32x4_t rhs = __builtin_amdgcn_mfma_f32_16x16x32_bf16(frag2(zz, aq), frag2(zz, vq), z4, 0, 0, 0); rhs = __builtin_amdgcn_mfma_f32_16x16x32_bf16(af0, Sf[0], rhs, 0, 0, 0);
                { const f32x4_t r2 = __builtin_amdgcn_mfma_f32_16x16x32_bf16(af1, Sf[1], z4, 0, 0, 0); rhs = rhs + r2; }
                u32x2 rl; rl.x = pk2(rhs[0], rhs[1]); rl.y = pk2(rhs[2], rhs[3]);
                const f32x4_t U = __builtin_amdgcn_mfma_f32_16x16x32_bf16(frag2(tq, zz), frag2(rl, zz), z4, 0, 0, 0);
                u32x2 ul; ul.x = pk2(U[0], U[1]); ul.y = pk2(U[2], U[3]); const bf16x8_t uv = frag2(ul, vq);
                f32x4_t y = __builtin_amdgcn_mfma_f32_16x16x32_bf16(rf0, Sf[0], z4, 0, 0, 0); y = __builtin_amdgcn_mfma_f32_16x16x32_bf16(rf1, Sf[1], y, 0, 0, 0);
                y = __builtin_amdgcn_mfma_f32_16x16x32_bf16(frag2(rbq, rkq), uv, y, 0, 0, 0);
#pragma unroll
                for (int r = 0; r < 4; ++r) Yb[(ch * 16 + 4 * q + r) * 64 + vcol] = y[r];
#pragma unroll
                for (int kt = 0; kt < 4; ++kt) { const f32x4 dl = *(const f32x4*)((const float*)(sl + O_DL) + 16 * kt + 4 * q);
                    const u32x2 bq = *(const u32x2*)((const bf16*)(sl + O_BHT) + (16 * kt + c16) * 16 + 4 * q), kq = *(const u32x2*)((const bf16*)(sl + O_KHT) + (16 * kt + c16) * 16 + 4 * q);
                    const f32x4_t cin = {Sd[kt][0] * dl.x, Sd[kt][1] * dl.y, Sd[kt][2] * dl.z, Sd[kt][3] * dl.w};
                    Sd[kt] = __builtin_amdgcn_mfma_f32_16x16x32_bf16(frag2(bq, kq), uv, cin, 0, 0, 0); }
#pragma unroll
                for (int s2 = 0; s2 < 2; ++s2) { u32x2 lo, hi; lo.x = pk2(Sd[2 * s2][0], Sd[2 * s2][1]); lo.y = pk2(Sd[2 * s2][2], Sd[2 * s2][3]); hi.x = pk2(Sd[2 * s2 + 1][0], Sd[2 * s2 + 1][1]); hi.y = pk2(Sd[2 * s2 + 1][2], Sd[2 * s2 + 1][3]); Sf[s2] = frag2(lo, hi); }
            } }
        LDS_SYNC();
        { const f32x4 y0 = *(const f32x4*)(Yb + pt * 64 + k8), y1 = *(const f32x4*)(Yb + pt * 64 + k8 + 4);
          const float mean = red8((y0.x + y0.y + y0.z + y0.w) + (y1.x + y1.y + y1.z + y1.w)) * (1.f / 64); const f32x4 d0 = y0 - mean, d1 = y1 - mean;
          const float rstd = 1.0f / sqrtf(red8((d0.x * d0.x + d0.y * d0.y + d0.z * d0.z + d0.w * d0.w) + (d1.x * d1.x + d1.y * d1.y + d1.z * d1.z + d1.w * d1.w)) * (1.f / 64) + GN_EPS);
          f32x4 g0, g1; pg8::unpack8(gkeep, g0, g1);
          const f32x4 o0 = (d0 * rstd * *(const f32x4*)(ct_ + 384 + k8) + *(const f32x4*)(ct_ + 448 + k8) + bo * v0) * g0, o1 = (d1 * rstd * *(const f32x4*)(ct_ + 384 + k8 + 4) + *(const f32x4*)(ct_ + 448 + k8 + 4) + bo * v1) * g1;
          *(u32x4*)(YC + (size_t)(c0 + pt) * 512) = pg8::pack8(o0, o1); }
    }
#undef RWKV_FETCH
}

__device__ __forceinline__ void s5_unit(KArgs C, int layer, int unit, unsigned char* lds) {
    const int tid = fresh_tid(), lane = tid & 63, wave = tid >> 6, bl = unit >> 5, g = unit & 31, c16 = lane & 15, q = lane >> 4, sg = wave & 3, th = wave >> 2, p = 16 * sg + c16;
    constexpr int SP = 136;
    float* us = (float*)lds; float* ends = us + 2048; bf16* St = (bf16*)(ends + 32 * 128);
    const bf16* U = WSP(const bf16, WS_U) + (size_t)bl * SEQ * 512 + g * 16;
    bf16* YD0 = WSP(bf16, WS_YD0) + (size_t)bl * SEQ * 512 + g * 16;
    const size_t wo = (layer & 1) ? WDELTA : 0;
    bf16x8_t bre, bim;
    { const float* bb = WSP(const float, WS_BBAR + wo) + ((size_t)g * 64 + p) * 32; u32x4 wr_, wi_;
      if (q < 2) { const float* b8 = bb + 16 * q; wr_.x = pk2(b8[0], b8[2]); wr_.y = pk2(b8[4], b8[6]); wr_.z = pk2(b8[8], b8[10]); wr_.w = pk2(b8[12], b8[14]);
                   wi_.x = pk2(b8[1], b8[3]); wi_.y = pk2(b8[5], b8[7]); wi_.z = pk2(b8[9], b8[11]); wi_.w = pk2(b8[13], b8[15]); }
      else { wr_ = (u32x4){0u, 0u, 0u, 0u}; wi_ = wr_; }
      bre = __builtin_bit_cast(bf16x8_t, wr_); bim = __builtin_bit_cast(bf16x8_t, wi_); }
    float apr[4], api[4];
    { const float ar = WSP(const float, WS_ABAR + wo)[(g * 64 + p) * 2], ai = WSP(const float, WS_ABAR + wo)[(g * 64 + p) * 2 + 1]; apr[0] = ar; api[0] = ai;
#pragma unroll
      for (int i = 1; i < 4; ++i) { apr[i] = apr[i - 1] * ar - api[i - 1] * ai; api[i] = apr[i - 1] * ai + api[i - 1] * ar; } }
    bf16x8_t cf[4];
    { const float* cre = C->in[I_S5CRE] + ((size_t)layer * 32 + g) * 1024 + c16 * 64; const float* cim = C->in[I_S5CIM] + ((size_t)layer * 32 + g) * 1024 + c16 * 64;
#pragma unroll
      for (int ks = 0; ks < 4; ++ks) { const int c0_ = 32 * ks + 8 * q; const float* src = c0_ < 64 ? cre + c0_ : cim + (c0_ - 64); const float sgn = c0_ < 64 ? 1.f : -1.f;
          u32x4 w; w.x = pk2(sgn * src[0], sgn * src[1]); w.y = pk2(sgn * src[2], sgn * src[3]); w.z = pk2(sgn * src[4], sgn * src[5]); w.w = pk2(sgn * src[6], sgn * src[7]); cf[ks] = __builtin_bit_cast(bf16x8_t, w); } }
    const float dj = C->in[I_S5D][layer * 512 + g * 16 + c16];
    float cr = 0.f, ci = 0.f;
    u32x2 fu; fu.x = 0u; fu.y = 0u;
#define S5_FETCH(c0_) do { fu = *(const u32x2*)(U + (size_t)((c0_) + (tid >> 2)) * 512 + (tid & 3) * 4); } while (0)
    S5_FETCH(0);
    for (int c0 = 0; c0 < SEQ; c0 += 128) {
        LDS_SYNC();
        *(f32x4*)(us + (tid >> 2) * 16 + (tid & 3) * 4) = (f32x4){lo_bf(fu.x), hi_bf(fu.x), lo_bf(fu.y), hi_bf(fu.y)};
        if (c0 + 128 < SEQ) S5_FETCH(c0 + 128);
        LDS_SYNC();
        float lr[4][4], li[4][4];
#pragma unroll
        for (int tt = 0; tt < 4; ++tt) { bf16x8_t af;
            if (q < 2) { const float* ur = us + (64 * th + 16 * tt + c16) * 16 + 8 * q; const f32x4 u0 = *(const f32x4*)ur, u1 = *(const f32x4*)(ur + 4);
                u32x4 w; w.x = pk2(u0.x, u0.y); w.y = pk2(u0.z, u0.w); w.z = pk2(u1.x, u1.y); w.w = pk2(u1.z, u1.w); af = __builtin_bit_cast(bf16x8_t, w); }
            else { const u32x4 z = {0u, 0u, 0u, 0u}; af = __builtin_bit_cast(bf16x8_t, z); }
            const f32x4_t z4 = {0.f, 0.f, 0.f, 0.f};
            const f32x4_t dre = __builtin_amdgcn_mfma_f32_16x16x32_bf16(af, bre, z4, 0, 0, 0), dim = __builtin_amdgcn_mfma_f32_16x16x32_bf16(af, bim, z4, 0, 0, 0);
            lr[tt][0] = dre[0]; li[tt][0] = dim[0];
#pragma unroll
            for (int r = 1; r < 4; ++r) { lr[tt][r] = apr[0] * lr[tt][r - 1] - api[0] * li[tt][r - 1] + dre[r]; li[tt][r] = apr[0] * li[tt][r - 1] + api[0] * lr[tt][r - 1] + dim[r]; }
            const int rho = (4 * th + tt) * 4 + q; ends[(rho * 64 + p) * 2] = lr[tt][3]; ends[(rho * 64 + p) * 2 + 1] = li[tt][3]; }
        LDS_SYNC();
        { float xr = cr, xi = ci;
#pragma unroll
          for (int rr = 0; rr < 32; ++rr) { const int tt = (rr >> 2) & 3;
              if ((rr >> 4) == th && (rr & 3) == q) {
#pragma unroll
                  for (int r = 0; r < 4; ++r) { const float sr = lr[tt][r] + apr[r] * xr - api[r] * xi, si = li[tt][r] + apr[r] * xi + api[r] * xr; const int t = 64 * th + 16 * tt + 4 * q + r;
                      St[t * SP + p] = f2bf(sr); St[t * SP + 64 + p] = f2bf(si); } }
              const float er = ends[(rr * 64 + p) * 2], ei = ends[(rr * 64 + p) * 2 + 1]; const float nr = apr[3] * xr - api[3] * xi + er, ni = apr[3] * xi + api[3] * xr + ei; xr = nr; xi = ni; }
          cr = xr; ci = xi; }
        LDS_SYNC();
        { f32x4_t y = {0.f, 0.f, 0.f, 0.f};
#pragma unroll
            for (int ks = 0; ks < 4; ++ks) y = __builtin_amdgcn_mfma_f32_16x16x32_bf16(*(const bf16x8_t*)(St + (16 * wave + c16) * SP + 32 * ks + 8 * q), cf[ks], y, 0, 0, 0);
#pragma unroll
            for (int r = 0; r < 4; ++r) { const int t = 16 * wave + 4 * q + r; YD0[(size_t)(c0 + t) * 512 + c16] = f2bf(gelu_tanh(y[r] + dj * us[t * 16 + c16])); } }
    }
#undef S5_FETCH
}

__device__ __forceinline__ unsigned ord_key(float f) { const unsigned u = __float_as_uint(f); return (u & 0x80000000u) ? ~u : (u | 0x80000000u); }
__device__ __forceinline__ void dsa_vt_item(KArgs C, int item, int lane, bf16* scr) {
    const int tb = item % NK64, bh = item / NK64, h = bh & 7, bl = bh >> 3;
    const bf16* V = WSP(const bf16, WS_V) + ((size_t)bl * SEQ + tb * 64) * 512 + h * 64;
    WAVE_SYNC();
#pragma unroll
    for (int i = 0; i < 8; ++i) { const int tk = (lane >> 3) + 8 * i, c8 = (lane & 7) * 8; const u32x4 w = *(const u32x4*)(V + (size_t)tk * 512 + c8);
        unsigned* d = (unsigned*)(scr + tk * 66 + c8); d[0] = w.x; d[1] = w.y; d[2] = w.z; d[3] = w.w; }
    WAVE_SYNC();
    bf16* Vt = WSP(bf16, WS_VT) + ((size_t)bh * 64) * SEQ + tb * 64 + lane;
#pragma unroll 8
    for (int d = 0; d < 64; ++d) Vt[(size_t)d * SEQ] = scr[lane * 66 + d];
}
constexpr int IDX_CAP = 128, IDX_NBIN = 1024;
__device__ __forceinline__ void dsa_index_unit(KArgs C, int unit, int lane, int wave, unsigned char* lds) {
    const int oct = unit & 7, pairid = (unit >> 3) % (NK64 / 2), kx = (unit >> 3) / (NK64 / 2), bl = kx >> 1, c = (kx & 1) ? NK64 - 1 - pairid : pairid;
    const int t0 = c * 64 + oct * 8, nkeys = (c + 1) * 64, nk64 = c + 1; const size_t row0 = (size_t)bl * SEQ + t0;
    unsigned* mrow = WSP(unsigned, WS_MASK) + (row0 + wave) * MW;
    if (nkeys <= TOPK) { for (int w = lane; w < MW; w += 64) mrow[w] = (w * 32 < nkeys) ? 0xffffffffu : 0u; return; }
    float* scf = (float*)lds;
    unsigned* hist = (unsigned*)(lds + LDS_X) + wave * (IDX_NBIN / 2); unsigned* candv = (unsigned*)(lds + LDS_X + 8 * IDX_NBIN * 2) + wave * IDX_CAP; unsigned* candi = candv + 8 * IDX_CAP; unsigned* mword = (unsigned*)(lds + LDS_X + 8 * IDX_NBIN * 2 + 16 * IDX_CAP * 4) + wave * MW;
    const bf16* SMb = WSP(const bf16, WS_SM) + (size_t)bl * SEQ * 256;
    const int l31 = lane & 31, half = lane >> 5;
    const bf16* qa = SMb + (size_t)(t0 + (l31 >> 2)) * 256 + 8 + (l31 & 3) * 32 + 8 * half;
    const bf16x8_t a0 = *(const bf16x8_t*)qa, a1 = *(const bf16x8_t*)(qa + 16);
    u32x2 wraw[4];
#pragma unroll
    for (int g = 0; g < 4; ++g) wraw[g] = *(const u32x2*)(SMb + (size_t)(t0 + 2 * g + half) * 256 + 168);
    LDS_SYNC();
    {
      float wv[4][4];
#pragma unroll
      for (int g = 0; g < 4; ++g) { const u32x2 w = wraw[g]; wv[g][0] = lo_bf(w.x) * 0.5f; wv[g][1] = hi_bf(w.x) * 0.5f; wv[g][2] = lo_bf(w.y) * 0.5f; wv[g][3] = hi_bf(w.y) * 0.5f; }
      for (int kt0 = wave; kt0 < nk64 * 2; kt0 += 8 * NWAVES) {
          bf16x8_t b0[8], b1[8];
#pragma unroll
          for (int u4 = 0; u4 < 8; ++u4) { const int kt = kt0 + 8 * u4; const bf16* kb = WSP(const bf16, WS_KI) + ((size_t)bl * SEQ + (size_t)((kt < nk64 * 2 ? kt : wave) * 32 + l31)) * 32 + 8 * half;
              b0[u4] = *(const bf16x8_t*)kb; b1[u4] = *(const bf16x8_t*)(kb + 16); }
#pragma unroll
          for (int u4 = 0; u4 < 8; ++u4) { const int kt = kt0 + 8 * u4; if (kt < nk64 * 2) {
              f32x16 d;
#pragma unroll
              for (int r = 0; r < 16; ++r) d[r] = 0.f;
              d = __builtin_amdgcn_mfma_f32_32x32x16_bf16(a0, b0[u4], d, 0, 0, 0); d = __builtin_amdgcn_mfma_f32_32x32x16_bf16(a1, b1[u4], d, 0, 0, 0);
#pragma unroll
              for (int g = 0; g < 4; ++g) { float sc = 0.f;
#pragma unroll
                  for (int j = 0; j < 4; ++j) sc += wv[g][j] * fmaxf(d[4 * g + j] * 0.17677669529f, 0.f);
                  scf[(2 * g + half) * SEQ + kt * 32 + l31] = sc; } } }
      } }
    { const int tail0 = nkeys, tail1 = ((nk64 + 7) >> 3) * 512;
      for (int e = tail0 + (int)(threadIdx.x); e < tail1; e += NTHREADS) {
#pragma unroll
          for (int qq = 0; qq < 8; ++qq) scf[qq * SEQ + e] = -3.0e38f; } }
    LDS_SYNC();
    const float* sc = scf + wave * SEQ; constexpr float NEG = -3.0e38f; const int nb8 = (nk64 + 7) >> 3;
    float v[NK64];
#pragma unroll
    for (int ib = 0; ib < NK64 / 8; ++ib) if (ib < nb8) {
#pragma unroll
        for (int j = 0; j < 8; ++j) v[ib * 8 + j] = sc[(ib * 8 + j) * 64 + lane];
        SCHED_FENCE(); }
    float mn = INFINITY, mx = -INFINITY;
#pragma unroll
    for (int ib = 0; ib < NK64 / 8; ++ib) if (ib < nb8) {
#pragma unroll
        for (int j = 0; j < 8; ++j) { const float x = v[ib * 8 + j]; mx = fmaxf(mx, x); mn = fminf(mn, x == NEG ? INFINITY : x); } }
    mn = -wave_max(-mn); mx = wave_max(mx);
    const float scale = (mx > mn) ? ((float)(IDX_NBIN - 2) - 0.01f) / (mx - mn) : 0.f;
#pragma unroll
    for (int i = 0; i < IDX_NBIN / 128; ++i) hist[lane * (IDX_NBIN / 128) + i] = 0u;
    for (int w = lane; w < MW; w += 64) mword[w] = 0u;
    WAVE_SYNC();
#define IDX_BIN(x) ({ const float x_ = (x); int b_ = (int)(fmaxf(x_ - mn, 0.f) * scale + 1.0f); b_ = b_ > IDX_NBIN - 2 ? IDX_NBIN - 2 : b_; b_ + (__float_as_int(x_) >> 31) + (__float_as_int(x_) > 0 ? 1 : 0); })
#pragma unroll
    for (int ib = 0; ib < NK64 / 8; ++ib) if (ib < nb8) {
#pragma unroll
        for (int j = 0; j < 8; ++j) { const int b = IDX_BIN(v[ib * 8 + j]); atomicAdd(&hist[b >> 1], (b & 1) ? 0x10000u : 1u); v[ib * 8 + j] = __int_as_float(b); }
        SCHED_FENCE(); }
    WAVE_SYNC();
    int bstar, cgt;
    {
      unsigned hw[8]; int tot = 0;
#pragma unroll
      for (int i = 0; i < 8; ++i) { hw[i] = hist[lane * 8 + i]; tot += (int)(hw[i] & 0xffffu) + (int)(hw[i] >> 16); }
      int suf = tot;
#pragma unroll
      for (int o = 1; o < 64; o <<= 1) { const int t = __shfl_down(suf, o); if (lane + o < 64) suf += t; }
      const unsigned long long ge = __ballot(suf >= TOPK); const int L = 63 - __builtin_clzll(ge);
      int cum = __shfl(suf, L) - __shfl(tot, L); bstar = 16 * L; cgt = cum; bool found = false;
#pragma unroll
      for (int i = 7; i >= 0; --i) { const unsigned w = (unsigned)__shfl((int)hw[i], L); const int chi = (int)(w >> 16), clo = (int)(w & 0xffffu);
          if (!found && cum + chi >= TOPK) { bstar = 16 * L + 2 * i + 1; cgt = cum; found = true; } cum += found ? 0 : chi;
          if (!found && cum + clo >= TOPK) { bstar = 16 * L + 2 * i; cgt = cum; found = true; } cum += found ? 0 : clo; } }
    const int need = TOPK - cgt; int ncand = 0;
    const bool tiebin = bstar == IDX_BIN(0.0f);
    unsigned mylo = 0u, myhi = 0u;
#pragma unroll
    for (int ib = 0; ib < NK64 / 8; ++ib) if (ib < nb8) {
#pragma unroll
        for (int j = 0; j < 8; ++j) { const int i = ib * 8 + j; const int b = __float_as_int(v[i]);
            unsigned long long bs = __ballot(b > bstar); const unsigned long long bc = __ballot(b == bstar);
            if (bc != 0ull) {
                const int pos = ncand + (int)__builtin_amdgcn_mbcnt_hi((unsigned)(bc >> 32), __builtin_amdgcn_mbcnt_lo((unsigned)bc, 0u));
                if (tiebin) bs |= __ballot(b == bstar && pos < need);
                else if (b == bstar && pos < IDX_CAP) { candv[pos] = ord_key(sc[i * 64 + lane]); candi[pos] = (unsigned)(i * 64 + lane); }
                ncand += __popcll(bc); }
            if (lane == i) { mylo = (unsigned)bs; myhi = (unsigned)(bs >> 32); } }
        SCHED_FENCE(); }
    if (lane < nb8 * 8) { mword[2 * lane] = mylo; mword[2 * lane + 1] = myhi; }
#undef IDX_BIN
    WAVE_SYNC();
    if (tiebin) { }
    else if (ncand <= IDX_CAP) {
        for (int m = lane; m < ncand; m += 64) { const unsigned vm = candv[m]; int rank = 0;
#pragma unroll 4
            for (int j = 0; j < ncand; ++j) { const unsigned vj = candv[j]; rank += (vj > vm || (vj == vm && j < m)) ? 1 : 0; }
            if (rank < need) { const unsigned idx = candi[m]; atomicOr(&mword[idx >> 5], 1u << (idx & 31)); } }
    } else {
#pragma unroll
        for (int ib = 0; ib < NK64 / 8; ++ib) if (ib < nb8) {
#pragma unroll
            for (int j = 0; j < 8; ++j) v[ib * 8 + j] = sc[(ib * 8 + j) * 64 + lane]; }
        unsigned T = 0u;
        for (int bit = 31; bit >= 0; --bit) { const unsigned cand = T | (1u << bit); int cn = 0;
#pragma unroll
            for (int ib = 0; ib < NK64 / 8; ++ib) if (ib < nb8) {
#pragma unroll
                for (int j = 0; j < 8; ++j) cn += (ord_key(v[ib * 8 + j]) >= cand) ? 1 : 0; }
            if (wave_sum_i(cn) >= TOPK) T = cand; }
        int cg = 0;
#pragma unroll
        for (int ib = 0; ib < NK64 / 8; ++ib) if (ib < nb8) {
#pragma unroll
            for (int j = 0; j < 8; ++j) cg += (ord_key(v[ib * 8 + j]) > T) ? 1 : 0; }
        const int need2 = TOPK - wave_sum_i(cg); int taken = 0;
#pragma unroll
        for (int ib = 0; ib < NK64 / 8; ++ib) if (ib < nb8) {
#pragma unroll
            for (int j = 0; j < 8; ++j) { const int i = ib * 8 + j; const unsigned kv = ord_key(v[i]); const bool eq = kv == T; const unsigned long long be = __ballot(eq);
                const int pre = __popcll(be & ((1ull << lane) - 1ull)); const bool sel = (kv > T) || (eq && (taken + pre) < need2); taken += __popcll(be);
                const unsigned long long bs = __ballot(sel); if (lane == 0) { mword[2 * i] = (unsigned)bs; mword[2 * i + 1] = (unsigned)(bs >> 32); } } }
    }
    WAVE_SYNC();
#ifdef HOST_EMU
    if (lane == 0) { static int rows = 0, bad = 0, ties = 0, falls = 0; std::vector<int> id(nkeys); for (int i = 0; i < nkeys; ++i) id[i] = i;
        std::stable_sort(id.begin(), id.end(), [&](int a, int b) { return sc[a] > sc[b]; }); std::vector<unsigned> ref(MW, 0u); for (int i = 0; i < TOPK; ++i) ref[id[i] >> 5] |= 1u << (id[i] & 31);
        bool ok = true; for (int w = 0; w < MW; ++w) ok = ok && ref[w] == mword[w]; ++rows; bad += ok ? 0 : 1; ties += tiebin ? 1 : 0; falls += (!tiebin && ncand > IDX_CAP) ? 1 : 0;
        if ((rows & 63) == 0 || !ok) printf("[idx-check] rows %d bad %d tiebin %d fallback %d\n", rows, bad, ties, falls); }
#endif
    for (int w = lane; w < MW; w += 64) mrow[w] = mword[w];
}

constexpr int AT_KP = 72, AT_VP = 72, AT_BUF = 64 * AT_KP + 64 * AT_VP;
__device__ __forceinline__ void dsa_attn_half(KArgs C, int bl, int h, int cb, int tid, bf16* tiles, const float* btab) {
    const int lane = tid & 63, wave = tid >> 6, l31 = lane & 31, hh = lane >> 5, c = 4 * cb + (wave >> 1), qb = wave & 1, q0 = c * 64 + qb * 32, qpos = q0 + l31, q0s = __builtin_amdgcn_readfirstlane(q0);
    const size_t qrow = (size_t)bl * SEQ + qpos;
    const bf16* Qp = WSP(const bf16, WS_Q) + qrow * 512 + h * 64 + 8 * hh;
    const unsigned* Mp = WSP(const unsigned, WS_MASK) + qrow * MW;
    const bf16* gk = WSP(const bf16, WS_K) + ((size_t)bl * SEQ + (tid >> 3)) * 512 + h * 64 + (tid & 7) * 8;
    const bf16* gv = WSP(const bf16, WS_VT) + ((size_t)(bl * 8 + h) * 64 + (tid >> 3)) * SEQ + (tid & 7) * 8;
    const int lk = (tid >> 3) * AT_KP + (tid & 7) * 8, lv = 64 * AT_KP + (tid >> 3) * AT_VP + (tid & 7) * 8;
    constexpr float SC = 0.125f * 1.44269504089f;
    bf16x8_t qf[4];
#pragma unroll
    for (int s = 0; s < 4; ++s) qf[s] = *(const bf16x8_t*)(Qp + 16 * s);
    f32x16 O0, O1;
#pragma unroll
    for (int r = 0; r < 16; ++r) { O0[r] = 0.f; O1[r] = 0.f; }
    float m = -1e30f, lsum = 0.f;
    const int ntw = c + 1, nt = 4 * cb + 4;
    u32x4 prek = *(const u32x4*)gk, prev = *(const u32x4*)gv; u32x2 mwn = *(const u32x2*)Mp;
    LDS_SYNC();
    const float bfar = btab[0];
    *(u32x4*)(tiles + lk) = prek; *(u32x4*)(tiles + lv) = prev;
    if (nt > 1) { prek = *(const u32x4*)(gk + (size_t)64 * 512); prev = *(const u32x4*)(gv + 64); }
    for (int kt = 0; kt < nt; ++kt) {
        LDS_SYNC();
        const bf16* tb = tiles + (kt & 1) * AT_BUF; const u32x2 mw2 = mwn;
        if (kt + 1 < ntw) mwn = *(const u32x2*)(Mp + 2 * (kt + 1));
        if (kt < ntw) {
            f32x16 S[2];
#pragma unroll
            for (int t2 = 0; t2 < 2; ++t2) {
#pragma unroll
                for (int r = 0; r < 16; ++r) S[t2][r] = 0.f;
#pragma unroll
                for (int s = 0; s < 4; ++s) S[t2] = __builtin_amdgcn_mfma_f32_32x32x16_bf16(*(const bf16x8_t*)(tb + (t2 * 32 + l31) * AT_KP + 16 * s + 8 * hh), qf[s], S[t2], 0, 0, 0); }
#define AT_P2(P_, X0_, X1_, MW_, R_, ROW_) do { f32x2 pp_; pp_.x = __uint_as_float(__float_as_uint(__builtin_amdgcn_exp2f(X0_)) & bit_fill<ROW_>(MW_)); \
                pp_.y = __uint_as_float(__float_as_uint(__builtin_amdgcn_exp2f(X1_)) & bit_fill<ROW_ + 1>(MW_)); P_[R_] = pp_.x; P_[R_ + 1] = pp_.y; ps2 += pp_; } while (0)
#define AT_RESCALE(TM_) do { float tm_ = (TM_); tm_ = fmaxf(tm_, __shfl_xor(tm_, 32)); \
                if (__ballot(tm_ > m) != 0ull) { const float mn = fmaxf(m, tm_), alpha = __builtin_amdgcn_exp2f(m - mn); m = mn; lsum *= alpha; \
                    _Pragma("unroll") for (int r = 0; r < 16; ++r) { O0[r] *= alpha; O1[r] *= alpha; } } } while (0)
            f32x16 P[2]; f32x2 ps2 = (f32x2){0.f, 0.f}; float tm;
            const unsigned mwc0 = mw2.x >> (4 * hh), mwc1 = mw2.y >> (4 * hh);
            const bool far = (kt * 64 + 63 - q0s) <= -166;
            if (far) { float rm = fmaxf(S[0][0], S[1][0]);
#pragma unroll
                for (int r = 1; r < 16; ++r) rm = fmaxf(fmaxf(rm, S[0][r]), S[1][r]);
                tm = rm * SC + bfar;
            } else { tm = -1e30f;
#pragma unroll
                for (int t2 = 0; t2 < 2; ++t2) { const int rb = kt * 64 + t2 * 32 + 4 * hh - qpos + 256;
#pragma unroll
                    for (int r = 0; r < 16; ++r) { const int row = (r & 3) + 8 * (r >> 2); int ti = rb + row; ti = ti < 0 ? 0 : ti; tm = fmaxf(tm, S[t2][r] * SC + btab[ti]); } } }
            AT_RESCALE(tm);
            if (far) { const float ad = bfar - m;
#define AT_FAR(R_, ROW_) do { const f32x2 x0_ = (f32x2){S[0][R_], S[0][R_ + 1]} * SC + ad, x1_ = (f32x2){S[1][R_], S[1][R_ + 1]} * SC + ad; \
                    AT_P2(P[0], x0_.x, x0_.y, mwc0, R_, ROW_); AT_P2(P[1], x1_.x, x1_.y, mwc1, R_, ROW_); } while (0)
                AT_FAR(0, 0); AT_FAR(2, 2); AT_FAR(4, 8); AT_FAR(6, 10); AT_FAR(8, 16); AT_FAR(10, 18); AT_FAR(12, 24); AT_FAR(14, 26);
#undef AT_FAR
            } else {
#define AT_BIAS(T2_, R_, ROW_) (S[T2_][R_] * SC + (btab[imax0(kt * 64 + (T2_) * 32 + 4 * hh - qpos + 256 + (ROW_))] - m))
#define AT_NEAR(R_, ROW_) do { AT_P2(P[0], AT_BIAS(0, R_, ROW_), AT_BIAS(0, R_ + 1, ROW_ + 1), mwc0, R_, ROW_); AT_P2(P[1], AT_BIAS(1, R_, ROW_), AT_BIAS(1, R_ + 1, ROW_ + 1), mwc1, R_, ROW_); } while (0)
                AT_NEAR(0, 0); AT_NEAR(2, 2); AT_NEAR(4, 8); AT_NEAR(6, 10); AT_NEAR(8, 16); AT_NEAR(10, 18); AT_NEAR(12, 24); AT_NEAR(14, 26);
#undef AT_BIAS
#undef AT_NEAR
            }
#undef AT_P2
#undef AT_RESCALE
            const float ps = ps2.x + ps2.y;
            lsum += ps;
#pragma unroll
            for (int t2 = 0; t2 < 2; ++t2) { const bf16* vb = tb + 64 * AT_KP + l31 * AT_VP + t2 * 32 + 4 * hh;
#pragma unroll
                for (int s = 0; s < 2; ++s) { u32x4 w; w.x = pk2(P[t2][8 * s + 0], P[t2][8 * s + 1]); w.y = pk2(P[t2][8 * s + 2], P[t2][8 * s + 3]); w.z = pk2(P[t2][8 * s + 4], P[t2][8 * s + 5]); w.w = pk2(P[t2][8 * s + 6], P[t2][8 * s + 7]);
                    const bf16x8_t pf = __builtin_bit_cast(bf16x8_t, w);
                    O0 = __builtin_amdgcn_mfma_f32_32x32x16_bf16(frag2(*(const u32x2*)(vb + 16 * s), *(const u32x2*)(vb + 16 * s + 8)), pf, O0, 0, 0, 0);
                    O1 = __builtin_amdgcn_mfma_f32_32x32x16_bf16(frag2(*(const u32x2*)(vb + 32 * AT_VP + 16 * s), *(const u32x2*)(vb + 32 * AT_VP + 16 * s + 8)), pf, O1, 0, 0, 0); } }
        }
        if (kt + 1 < nt) { bf16* nb = tiles + ((kt + 1) & 1) * AT_BUF; *(u32x4*)(nb + lk) = prek; *(u32x4*)(nb + lv) = prev;
            if (kt + 2 < nt) { prek = *(const u32x4*)(gk + (size_t)(kt + 2) * 64 * 512); prev = *(const u32x4*)(gv + (size_t)(kt + 2) * 64); } }
    }
    lsum += __shfl_xor(lsum, 32);
    const float inv = 1.0f / lsum;
    bf16* Y = WSP(bf16, WS_Y) + (size_t)MG * 512 + qrow * 512 + h * 64 + 4 * hh;
#pragma unroll
    for (int g = 0; g < 4; ++g) { u32x2 w; w.x = pk2(O0[4 * g] * inv, O0[4 * g + 1] * inv); w.y = pk2(O0[4 * g + 2] * inv, O0[4 * g + 3] * inv); *(u32x2*)(Y + 8 * g) = w;
        u32x2 w2; w2.x = pk2(O1[4 * g] * inv, O1[4 * g + 1] * inv); w2.y = pk2(O1[4 * g + 2] * inv, O1[4 * g + 3] * inv); *(u32x2*)(Y + 32 + 8 * g) = w2; }
}
__device__ __forceinline__ void dsa_attn_unit3(KArgs C, int unit, int tid, unsigned char* lds) {
    constexpr int NPAIR = NK64 / 8;
    const int pr = unit % NPAIR, h = (unit / NPAIR) & 7, bl = unit / (NPAIR * 8);
    float* btab = (float*)lds; bf16* tiles = (bf16*)(lds + 2048);
    __syncthreads();
    { const int* tab = WSP(const int, WS_TAB); const float* relb = C->in[I_RELB];
      if (tid < 320) btab[tid] = relb[tab[tid - 256 + SEQ - 1] * 8 + h] * 1.44269504089f; }
    dsa_attn_half(C, bl, h, pr, tid, tiles, btab);
    dsa_attn_half(C, bl, h, NK64 / 4 - 1 - pr, tid, tiles, btab);
}
#ifndef GP_ALIGN
#define GP_ALIGN true
#endif
#ifndef GP_SP2
#define GP_SP2 true
#endif
constexpr int SEGS_PER_GROUP = 11, NSEG = DEPTH * (1 + NGRP * SEGS_PER_GROUP) + 1;

#ifdef HOST_EMU
#define GRID_BARRIER() emu_grid_sync()
#define LDS_PTR(p) ((unsigned char*)(p))
#else
#define GRID_BARRIER() do { XcdBarrier b_; b_.bar = (unsigned*)(Ck->ws + WS_CTL); b_.x = xb_xcc_id(); b_.st = (volatile LAS unsigned*)(lds + LDS_CTL_OFF); xcd_barrier(b_); } while (0)
#define LDS_PTR(p) ((PG8_LAS unsigned char*)(p))
#endif

__global__ void __launch_bounds__(NTHREADS, 2) fwd_kernel(Args a) {
#ifdef HOST_EMU
    unsigned char* lds = emu_lds;
#else
    extern __shared__ __attribute__((aligned(16))) unsigned char lds[];
#endif
#ifdef HOST_EMU
    KArgs Ck = &a;
#else
    KArgs Ck = (KArgs)__builtin_amdgcn_kernarg_segment_ptr();
    (void)a;
#endif
#ifndef HOST_EMU
    if (threadIdx.x < 4) ((LAS unsigned*)(lds + LDS_CTL_OFF))[threadIdx.x] = 0u;
    __syncthreads();
    if (Ck->seg_hi - Ck->seg_lo > 1) (void)xcd_barrier_post((unsigned*)(Ck->ws + WS_CTL), (volatile LAS unsigned*)(lds + LDS_CTL_OFF));
#endif
#define SEGID 0
#define RUN (SEGID >= Ck->seg_lo && SEGID < Ck->seg_hi)
#define SEAM do { if (SEGID >= Ck->seg_lo && SEGID + 1 < Ck->seg_hi) { GRID_BARRIER(); } } while (0)
#define WO ((layer & 1) ? WDELTA : (size_t)0)
#define PHASE_VARS KArgs C = KLAUNDER(Ck); const int G = gridDim.x, bx = blockIdx.x, ngw = G * NWAVES; (void)ngw; const int tid = fresh_tid(), lane = tid & 63, wave = __builtin_amdgcn_readfirstlane(tid >> 6), gw = bx * NWAVES + wave; (void)lane; (void)gw; (void)C
    for (int layer = 0; layer < DEPTH; ++layer) {
#undef SEGID
#define SEGID (layer * (1 + NGRP * SEGS_PER_GROUP))
        if (RUN) { PHASE_VARS; phase_weights(C, layer, lds, gw, ngw, lane, wave); }
        SEAM;
        for (int grp = 0; grp < NGRP; ++grp) {
#define XIN ((layer == 0 ? C->in[I_X] : (const float*)C->out) + (size_t)grp * MG * D)
#define XOUT (C->out + (size_t)grp * MG * D)
#undef SEGID
#define SEGID (layer * (1 + NGRP * SEGS_PER_GROUP) + 1 + grp * SEGS_PER_GROUP + 0)
            if (RUN) { PHASE_VARS; rms_rows_bf16<4>(XIN, C->in[I_NMIX] + layer * D, WSP(bf16, WS_H), gw, ngw, MG, lane); }
            SEAM;
#undef SEGID
#define SEGID (layer * (1 + NGRP * SEGS_PER_GROUP) + 1 + grp * SEGS_PER_GROUP + 1)
            if (RUN) { PHASE_VARS; pg8::Gemm g{WSP(const bf16, WS_H), WSP(const bf16, WS_WIN + WO), MG, NMIXC, D}; pg8::StaticOrder S; S.init(MG, NMIXC, G, bx);
                pg8::EpiProj E{C->ws};
                pg8::gemm_phase<pg8::EpiProj, pg8::StaticOrder, false, GP_ALIGN, GP_SP2>(LDS_PTR(lds), g, S, E, nullptr); }
            SEAM;
#undef SEGID
#define SEGID (layer * (1 + NGRP * SEGS_PER_GROUP) + 1 + grp * SEGS_PER_GROUP + 2)
            if (RUN) { PHASE_VARS;
                for (int m8 = gw; m8 < MG / 8; m8 += ngw) { rwkv_prep_rows8(C, layer, m8 * 8, lane); ssd_conv_rows8(C, layer, m8 * 8, lane); }
                for (int it = gw; it < NB * 8 * NK64; it += ngw) dsa_vt_item(C, it, lane, (bf16*)(lds + wave * 16384));
                __syncthreads();
                for (int u = bx; u < NB * NK64 * 8; u += G) dsa_index_unit(C, u, lane, wave, lds);
            }
            SEAM;
#undef SEGID
#define SEGID (layer * (1 + NGRP * SEGS_PER_GROUP) + 1 + grp * SEGS_PER_GROUP + 3)
            if (RUN) { PHASE_VARS; pg8::Gemm g{WSP(const bf16, WS_RA), WSP(const bf16, WS_WLORA + WO), MG, 1536, 256}; pg8::StaticOrder S; S.init(MG, 1536, G, bx);
                pg8::EpiLora E{WSP(float, WS_WLOG), WSP(bf16, WS_ASIG), WSP(bf16, WS_GG), C->in[I_W0] + layer * 512, C->in[I_A0] + layer * 512};
                pg8::gemm_phase<pg8::EpiLora, pg8::StaticOrder, false, GP_ALIGN, GP_SP2>(LDS_PTR(lds), g, S, E, nullptr); }
            SEAM;
#undef SEGID
#define SEGID (layer * (1 + NGRP * SEGS_PER_GROUP) + 1 + grp * SEGS_PER_GROUP + 4)
            if (RUN) { PHASE_VARS;
                constexpr int U_R = NB * 8, U_S = U_R + NB * 8;
                for (int u = bx; u < U_R; u += G) rwkv_unit(C, layer, u, lds);
                for (int u = (bx + G - U_R % G) % G; u < NB * 8; u += G) ssd_unit(C, layer, u, lds);
                { const int first = U_S % G, span = G - first;
                  if (bx >= first) for (int u = bx - first; u < NB * 32; u += span) s5_unit(C, layer, u, lds); }
                for (;;) {
                    const int t2 = fresh_tid();
                    volatile unsigned* qs2 = (volatile unsigned*)(lds + LDS_CTL_OFF + 32);
                    __syncthreads();
                    if (t2 == 0) *qs2 = atomicAdd((unsigned*)(Ck->ws + WS_QCTR) + ((layer * NGRP + grp) * 2) * 64, 1u);
                    __syncthreads();
                    const int u = (int)*qs2;
                    if (u >= NB * NK64) break;
                    dsa_attn_unit3(KLAUNDER(Ck), u, t2, lds);
                }
            }
            SEAM;
#undef SEGID
#define SEGID (layer * (1 + NGRP * SEGS_PER_GROUP) + 1 + grp * SEGS_PER_GROUP + 5)
            if (RUN) { PHASE_VARS;
                { pg8::Gemm g{WSP(const bf16, WS_H), WSP(const bf16, WS_WIN + WO) + (size_t)NMIXC * D, MG, 4096, D}; pg8::StaticOrder S; S.init(MG, 4096, G, bx);
                  pg8::EpiGate E{WSP(bf16, WS_G)}; pg8::gemm_phase<pg8::EpiGate, pg8::StaticOrder, false, GP_ALIGN, GP_SP2>(LDS_PTR(lds), g, S, E, nullptr); }
                { pg8::Gemm g{WSP(const bf16, WS_YD0), WSP(const bf16, WS_GLU + WO), MG, 512, 512}; pg8::StaticOrder S; S.init(MG, 512, G, bx);
                  pg8::EpiGlu E{WSP(const bf16, WS_YD0), WSP(bf16, WS_Y) + (size_t)3 * MG * 512, C->in[I_GLUB] + layer * 512};
                  pg8::gemm_phase<pg8::EpiGlu, pg8::StaticOrder, false, GP_ALIGN, GP_SP2>(LDS_PTR(lds), g, S, E, nullptr); }
                for (int it = gw; it < MG * 2; it += 4 * ngw) ssd_norm_item4(C, layer, it, ngw, MG * 2, lane);
            }
            SEAM;
#undef SEGID
#define SEGID (layer * (1 + NGRP * SEGS_PER_GROUP) + 1 + grp * SEGS_PER_GROUP + 6)
            if (RUN) { PHASE_VARS; pg8::Gemm g{WSP(const bf16, WS_Y), WSP(const bf16, WS_WB + WO), 4 * MG, 4096, 512}; pg8::MergeOrder S{G, bx};
                pg8::EpiMerge E{WSP(const bf16, WS_G), WSP(bf16, WS_MRG)};
                pg8::gemm_phase<pg8::EpiMerge, pg8::MergeOrder, false, GP_ALIGN, GP_SP2>(LDS_PTR(lds), g, S, E, nullptr); }
            SEAM;
#undef SEGID
#define SEGID (layer * (1 + NGRP * SEGS_PER_GROUP) + 1 + grp * SEGS_PER_GROUP + 7)
            if (RUN) { PHASE_VARS; pg8::Gemm g{WSP(const bf16, WS_MRG), WSP(const bf16, WS_WOUT + WO), MG, D, D}; pg8::StaticOrder S; S.init(MG, D, G, bx);
                pg8::EpiResid E{XIN, XOUT}; pg8::gemm_phase<pg8::EpiResid, pg8::StaticOrder, false, GP_ALIGN, GP_SP2>(LDS_PTR(lds), g, S, E, nullptr); }
            SEAM;
#undef SEGID
#define SEGID (layer * (1 + NGRP * SEGS_PER_GROUP) + 1 + grp * SEGS_PER_GROUP + 8)
            if (RUN) { PHASE_VARS; rms_rows_bf16<4>(XOUT, C->in[I_NFFN] + layer * D, WSP(bf16, WS_H), gw, ngw, MG, lane); }
            SEAM;
#undef SEGID
#define SEGID (layer * (1 + NGRP * SEGS_PER_GROUP) + 1 + grp * SEGS_PER_GROUP + 9)
            if (RUN) { PHASE_VARS; pg8::Gemm g{WSP(const bf16, WS_H), WSP(const bf16, WS_W13 + WO), MG, 5632, D}; pg8::StaticOrder S; S.init(MG, 5632, G, bx);
                pg8::EpiSwiglu E{WSP(bf16, WS_HID)};
                pg8::gemm_phase<pg8::EpiSwiglu, pg8::StaticOrder, false, GP_ALIGN, GP_SP2>(LDS_PTR(lds), g, S, E, nullptr); }
            SEAM;
#undef SEGID
#define SEGID (layer * (1 + NGRP * SEGS_PER_GROUP) + 1 + grp * SEGS_PER_GROUP + 10)
            if (RUN) { PHASE_VARS; pg8::Gemm g{WSP(const bf16, WS_HID), WSP(const bf16, WS_W2 + WO), MG, D, FFN}; pg8::StaticOrder S; S.init(MG, D, G, bx);
                pg8::EpiResid E{XOUT, XOUT}; pg8::gemm_phase<pg8::EpiResid, pg8::StaticOrder, false, GP_ALIGN, GP_SP2>(LDS_PTR(lds), g, S, E, nullptr); }
            SEAM;
        }
    }
#undef SEGID
#define SEGID (NSEG - 1)
    { const int layer = 0; (void)layer;
    if (RUN) { PHASE_VARS; for (int m = gw; m < M; m += 2 * ngw) { if (m + ngw < M) rms_row2_f32(C->out + (size_t)m * D, (size_t)ngw * D, C->in[I_NFIN], lane); else rms_row_f32(C->out + (size_t)m * D, C->in[I_NFIN], lane); } } }
#undef RUN
#undef SEAM
}

extern "C" void kernel_launch(void* const* d_in, const int* in_sizes, int n_in, void* d_out, int out_size, void* d_ws, size_t ws_size, hipStream_t stream) {
    static int grid = 0;
    if (grid == 0) {
        if (n_in != N_IN || out_size != M * D || ws_size < WS_END) { fprintf(stderr, "kernel_launch: unexpected shapes (n_in %d, out %d, ws %zu < %zu)\n", n_in, out_size, ws_size, (size_t)WS_END); grid = -1; return; }
        int dev = 0, cus = 0;
        if (hipGetDevice(&dev) != hipSuccess || hipDeviceGetAttribute(&cus, hipDeviceAttributeMultiprocessorCount, dev) != hipSuccess || cus < 1) { grid = -1; return; }
        if (hipFuncSetAttribute((const void*)fwd_kernel, hipFuncAttributeMaxDynamicSharedMemorySize, LDS_BYTES) != hipSuccess) { fprintf(stderr, "kernel_launch: hipFuncSetAttribute failed\n"); grid = -1; return; }
        (void)hipGetLastError();
        grid = cus;
    }
    if (grid < 0) return;
    (void)hipMemsetAsync((char*)d_ws + WS_CTL, 0, CTL_BYTES, stream);
    Args a{};
    for (int i = 0; i < N_IN; ++i) a.in[i] = (const float*)d_in[i];
    a.out = (float*)d_out; a.ws = (unsigned char*)d_ws;
#if CFG_LAUNCHES == 1
    a.seg_lo = 0; a.seg_hi = NSEG;
    hipLaunchKernelGGL(fwd_kernel, dim3(grid), dim3(NTHREADS), LDS_BYTES, stream, a);
#else
    for (int s = 0; s < NSEG; ++s) { a.seg_lo = s; a.seg_hi = s + 1; hipLaunchKernelGGL(fwd_kernel, dim3(grid), dim3(NTHREADS), LDS_BYTES, stream, a); }
#endif
}
```

```cpp
#ifdef HOST_EMU
#error "HOST_EMU is a host-only debug build"
#else
#include <hip/hip_runtime.h>
#endif
#include <cstdio>
#include <cstdint>
#include <cmath>

#ifndef CFG_BATCH
#define CFG_BATCH 16
#endif
#ifndef CFG_SEQ
#define CFG_SEQ 4096
#endif
#ifndef CFG_DEPTH
#define CFG_DEPTH 4
#endif
#ifndef CFG_NB
#define CFG_NB 8
#endif
#ifndef CFG_LAUNCHES
#define CFG_LAUNCHES 1
#endif

typedef unsigned short bf16;
typedef float f32x4 __attribute__((ext_vector_type(4)));
typedef float f32x2 __attribute__((ext_vector_type(2)));
typedef unsigned u32x4 __attribute__((ext_vector_type(4)));
typedef unsigned u32x2 __attribute__((ext_vector_type(2)));

constexpr int BATCH = CFG_BATCH, SEQ = CFG_SEQ, DEPTH = CFG_DEPTH, NB = CFG_NB;
constexpr int D = 1024, M = BATCH * SEQ, MG = NB * SEQ, NGRP = BATCH / NB;
constexpr int IN_COLS = 9388, NPROJ = 9472, NMIXC = 5376, FFN = 2816;
constexpr int TOPK = (SEQ / 4) < 256 ? (SEQ / 4) : 256;
constexpr int NK64 = SEQ / 64, MW = SEQ / 32;
constexpr float RMS_EPS = 1e-6f, GN_EPS = 64e-5f;
static_assert(BATCH % NB == 0 && MG % 256 == 0 && SEQ % 64 == 0, "shape");

enum { I_X = 0, I_RELB, I_NMIX, I_WIN, I_CONVW, I_CONVB, I_DTB, I_ALOG, I_SSDD, I_SSDNG, I_MU, I_W0, I_W2, I_A0, I_A2, I_G2, I_KK, I_KA, I_RK, I_LNG, I_LNB,
       I_S5ARE, I_S5AIM, I_S5BRE, I_S5BIM, I_S5CRE, I_S5CIM, I_S5D, I_S5LDT, I_GLUW, I_GLUB, I_WBR, I_WOUT, I_NFFN, I_W1, I_W3, I_W2F, I_NFIN, N_IN };

constexpr size_t MiB = 1u << 20;
constexpr size_t al256(size_t x) { return (x + 255) & ~(size_t)255; }
constexpr size_t WS_CTL = 0, CTL_BYTES = 64 * 1024;
constexpr size_t WS_TAB = WS_CTL + CTL_BYTES;
constexpr size_t WS_ABAR = al256(WS_TAB + (SEQ + 64) * 4);
constexpr size_t WS_BBAR = WS_ABAR + 32 * 64 * 2 * 4;
constexpr size_t WS_WIN = al256(WS_BBAR + 32 * 64 * 16 * 2 * 4);
constexpr size_t WS_WB = WS_WIN + (size_t)NPROJ * 1024 * 2;
constexpr size_t WS_WOUT = WS_WB + (size_t)4 * 1024 * 512 * 2;
constexpr size_t WS_W13 = WS_WOUT + (size_t)1024 * 1024 * 2;
constexpr size_t WS_W2 = WS_W13 + (size_t)5632 * 1024 * 2;
constexpr size_t WS_GLU = WS_W2 + (size_t)1024 * 2816 * 2;
constexpr size_t WS_WLORA = WS_GLU + (size_t)512 * 512 * 2;
constexpr size_t WS_H = al256(WS_WLORA + (size_t)1536 * 256 * 2);
constexpr size_t WS_Z = WS_H + (size_t)MG * 1024 * 2;
constexpr size_t WS_XBC = WS_Z + (size_t)MG * 512 * 2;
constexpr size_t WS_Q = WS_XBC + (size_t)MG * 768 * 2;
constexpr size_t WS_K = WS_Q + (size_t)MG * 512 * 2;
constexpr size_t WS_V = WS_K + (size_t)MG * 512 * 2;
constexpr size_t WS_RW = WS_V + (size_t)MG * 512 * 2;
constexpr size_t WS_U = WS_RW + (size_t)MG * 1792 * 2;
constexpr size_t WS_SM = WS_U + (size_t)MG * 512 * 2;
constexpr size_t WS_G = WS_Q;
constexpr size_t WS_Y = WS_SM + (size_t)MG * 256 * 2;
constexpr size_t WS_YD0 = WS_Y + (size_t)4 * MG * 512 * 2;
constexpr size_t WS_MRG = WS_YD0 + (size_t)MG * 512 * 2;
constexpr size_t WS_MASK = WS_MRG + (size_t)MG * 1024 * 2;
constexpr size_t WS_RA = WS_MASK + (size_t)MG * MW * 4;
constexpr size_t WS_WLOG = WS_RA + (size_t)MG * 256 * 2;
constexpr size_t WS_ASIG = WS_WLOG + (size_t)MG * 512 * 4;
constexpr size_t WS_GG = WS_ASIG + (size_t)MG * 512 * 2;
constexpr size_t WS_XBA = WS_GG + (size_t)MG * 512 * 2;
constexpr size_t WS_VT = WS_XBA + (size_t)MG * 768 * 2;
constexpr size_t WS_KI = WS_VT + (size_t)MG * 512 * 2;
constexpr size_t WS_QCTR = 16384;
constexpr size_t WS_HID = WS_G;
constexpr size_t WS_WALT = al256(WS_KI + (size_t)MG * 32 * 2);
constexpr size_t WDELTA = WS_WALT - WS_ABAR;
constexpr size_t WS_END = WS_WALT + (WS_H - WS_ABAR);
static_assert(WS_SM + (size_t)MG * 256 * 2 - WS_Q == (size_t)MG * 4096 * 2, "G overlays exactly Q..SM");
static_assert((size_t)MG * 2816 * 2 <= (size_t)MG * 4096 * 2, "HID fits in G");

constexpr int LDS_SCRATCH = 131072;
constexpr int LDS_CTL_OFF = LDS_SCRATCH;
constexpr int LDS_X = LDS_SCRATCH + 64;
constexpr int LDS_BYTES = 161792;
constexpr int NTHREADS = 512, NWAVES = 8;

__device__ __forceinline__ float bf2f(bf16 v) { return __uint_as_float(((unsigned)v) << 16); }
#ifdef HOST_EMU
__device__ __forceinline__ bf16 f2bf(float f) { unsigned u = __float_as_uint(f); u += 0x7fffu + ((u >> 16) & 1u); return (bf16)(u >> 16); }
#else
__device__ __forceinline__ bf16 f2bf(float f) { return __builtin_bit_cast(bf16, (__bf16)f); }
#endif
#ifdef HOST_EMU
__device__ __forceinline__ unsigned pk2(float lo, float hi) { return (unsigned)f2bf(lo) | ((unsigned)f2bf(hi) << 16); }
#else
typedef __bf16 bf16x2_hw __attribute__((ext_vector_type(2)));
__device__ __forceinline__ unsigned pk2(float lo, float hi) { const f32x2 v = {lo, hi}; return __builtin_bit_cast(unsigned, __builtin_convertvector(v, bf16x2_hw)); }
#endif
__device__ __forceinline__ float lo_bf(unsigned w) { return __uint_as_float(w << 16); }
__device__ __forceinline__ float hi_bf(unsigned w) { return __uint_as_float(w & 0xffff0000u); }
#ifndef HOST_EMU
__device__ __forceinline__ float sigm(float x) { return __builtin_amdgcn_rcpf(1.0f + __expf(-x)); }
#else
__device__ __forceinline__ float sigm(float x) { return 1.0f / (1.0f + __expf(-x)); }
#endif
#ifndef HOST_EMU
template <int BIT> __device__ __forceinline__ unsigned bit_fill(unsigned w) { unsigned r; asm("v_bfe_i32 %0, %1, %2, 1" : "=v"(r) : "v"(w), "n"(BIT)); return r; }
#else
template <int BIT> __device__ __forceinline__ unsigned bit_fill(unsigned w) { return ((w >> BIT) & 1u) ? 0xffffffffu : 0u; }
#endif
__device__ __forceinline__ int imax0(int v) { return v < 0 ? 0 : v; }
__device__ __forceinline__ float tanh_fast(float x) { return 2.0f * sigm(2.0f * x) - 1.0f; }
__device__ __forceinline__ float softplusf(float x) { return x > 20.f ? x : log1pf(__expf(x)); }
__device__ __forceinline__ float gelu_tanh(float x) { const float u = 0.7978845608f * (x + 0.044715f * x * x * x); return x * sigm(2.0f * u); }
__device__ __forceinline__ float wave_sum(float v) {
#pragma unroll
    for (int o = 1; o < 64; o <<= 1) v += __shfl_xor(v, o);
    return v;
}
__device__ __forceinline__ float wave_max(float v) {
#pragma unroll
    for (int o = 1; o < 64; o <<= 1) v = fmaxf(v, __shfl_xor(v, o));
    return v;
}
__device__ __forceinline__ int wave_sum_i(int v) {
#pragma unroll
    for (int o = 1; o < 64; o <<= 1) v += __shfl_xor(v, o);
    return v;
}
#ifdef HOST_EMU
#define WAVE_SYNC() (void)emu_wave_exchange(0)
#define SCHED_FENCE() do {} while (0)
#define LDS_SYNC() __syncthreads()
#else
#define WAVE_SYNC() __builtin_amdgcn_wave_barrier()
#define SCHED_FENCE() __builtin_amdgcn_sched_barrier(0)
#define LDS_SYNC() do { asm volatile("s_waitcnt lgkmcnt(0)" ::: "memory"); __builtin_amdgcn_s_barrier(); asm volatile("" ::: "memory"); } while (0)
#endif
#ifndef HOST_EMU
namespace pg8 {
__device__ __forceinline__ int pg8_fresh_tid() { int t = (int)threadIdx.x; asm volatile("" : "+v"(t)); return t; }
#define PG8_LAS __attribute__((address_space(3)))
typedef unsigned short bf16_t;
typedef short bf16x8 __attribute__((ext_vector_type(8)));
typedef float f32x4 __attribute__((ext_vector_type(4)));
typedef unsigned u32x4 __attribute__((ext_vector_type(4)));
constexpr int BM = 256, BK = 64, HALF = 128, HTB = HALF * BK * 2  , STAGE_BYTES = 8 * HTB, NXCD = 8, WGM = 8;

__host__ __device__ __forceinline__ int lds_byte(int r, int c) { const int st = (r >> 4) * 2 + (c >> 5), rr = r & 15, cc = c & 31, ob = rr * 64 + cc * 2; return st * 1024 + (ob ^ (((ob >> 9) & 1) << 5)); }
__host__ __device__ __forceinline__ void stage_rc(int b, int& R, int& C) { const int st = b / 1024, sb = b % 1024, swz = sb ^ (((sb >> 9) & 1) << 5); R = (st >> 1) * 16 + swz / 64; C = (st & 1) * 32 + (swz % 64) / 2; }
__host__ __device__ __forceinline__ int perm32(int rho) { const int n = rho >> 4, i = rho & 15; return 8 * (i >> 2) + 4 * n + (i & 3); }

struct Unit { int pm, pn; };
struct Gemm { const bf16_t* A; const bf16_t* Bt; int M, N, K; };

struct StaticOrder {
    int nM, nN, nwg, G, c;
    __host__ __device__ void init(int M, int N, int G_, int c_) { nM = M / BM; nN = N / BM; nwg = nM * nN; G = G_; c = c_; }
    __host__ __device__ bool next(int i, Unit& u) const {
        const long L = (long)i * G + c; if (L >= nwg) return false;
        int wgid = (int)L; { const int q = nwg / NXCD, r = nwg % NXCD, xcd = wgid % NXCD, off = wgid / NXCD; wgid = (xcd < r ? xcd * (q + 1) : r * (q + 1) + (xcd - r) * q) + off; }
        const int nig = WGM * nN, gid = wgid / nig, fm = gid * WGM, gsz = (nM - fm) < WGM ? (nM - fm) : WGM;
        u.pm = fm + ((wgid % nig) % gsz); u.pn = (wgid % nig) / gsz; return true;
    }
    __device__ __forceinline__ void a_ready(const Unit&) const {}
    __device__ __forceinline__ void done(const Unit&) const {}
};

__device__ __forceinline__ unsigned cvt_pk_bf16(float lo, float hi) { return pk2(lo, hi); }

template <class E, class = void> struct epi_keep { static constexpr bool value = false; };
template <class E> struct epi_keep<E, decltype((void)E::KEEP_ACC)> { static constexpr bool value = true; };
template <class Epi, class Sched, bool STAMP = false, bool ALIGN_EPI = false, bool SP2 = false>
__device__ __forceinline__ void gemm_phase(PG8_LAS unsigned char* lds, const Gemm g, const Sched& S, const Epi& E, unsigned long long* stamps) {
    const int tid = pg8_fresh_tid(), wid = __builtin_amdgcn_readfirstlane(tid >> 6), lane = tid & 63, wr = wid >> 2, wc = wid & 3, fr = lane & 15, fq = lane >> 4;
    int K_ = g.K; asm volatile("" : "+s"(K_));
    const int K = K_, nt = K / BK;
    int ts_lo = 0, ts_hi = 0, nts = 0; const unsigned long long rt_entry = STAMP ? (unsigned long long)wall_clock64() : 0ull;
#define PG8_STAMP() do { if (STAMP && wid == 0 && nts < 64) { const unsigned long long _c = (unsigned long long)clock64(); \
        ts_lo = (lane == nts) ? (int)(unsigned)_c : ts_lo; ts_hi = (lane == nts) ? (int)(unsigned)(_c >> 32) : ts_hi; ++nts; } } while (0)
    PG8_STAMP();
    unsigned voffA[2], voffB[2];
#pragma unroll
    for (int i = 0; i < 2; ++i) { int R, C; stage_rc(tid * 16 + i * 8192, R, C); const int Rb = Epi::PERM ? ((R & ~31) + perm32(R & 31)) : R;
        voffA[i] = (unsigned)(R * K + C) * 2u; voffB[i] = (unsigned)(Rb * K + C) * 2u; }
    const size_t kstep = (size_t)(BK * 2);
    const size_t hstep = (size_t)HALF * K * 2;
    const size_t tstep = 2 * hstep;
    const unsigned ldsw = (unsigned)wid * 1024u;
    const int aoff = lds_byte(wr * 64 + fr, fq * 8), boff = lds_byte(wc * 32 + fr, fq * 8);
#define PG8_SA(b, h) (((b) * 2 + (h)) * HTB)
#define PG8_SB(b, h) ((4 + (b) * 2 + (h)) * HTB)
#define PG8_STAGE(bufoff, gbase, voff) do { _Pragma("unroll") for (int _i = 0; _i < 2; ++_i) \
        __builtin_amdgcn_global_load_lds((const unsigned*)((const char*)(gbase) + (voff)[_i]), (PG8_LAS unsigned*)(lds + (bufoff) + ldsw + _i * 8192), 16, 0, 0); } while (0)
#define PG8_LDA(dst, b, h) do { _Pragma("unroll") for (int m = 0; m < 4; ++m) _Pragma("unroll") for (int k = 0; k < 2; ++k) dst[m][k] = *(const PG8_LAS bf16x8*)(lds + PG8_SA(b, h) + aoff + m * 2048 + k * 1024); } while (0)
#define PG8_LDB(dst, b, h) do { _Pragma("unroll") for (int n = 0; n < 2; ++n) _Pragma("unroll") for (int k = 0; k < 2; ++k) dst[n][k] = *(const PG8_LAS bf16x8*)(lds + PG8_SB(b, h) + boff + n * 2048 + k * 1024); } while (0)
#define PG8_MMA(ai, bj, At, Bt) do { __builtin_amdgcn_s_setprio(1); _Pragma("unroll") for (int m = 0; m < 4; ++m) _Pragma("unroll") for (int n = 0; n < 2; ++n) _Pragma("unroll") for (int k = 0; k < 2; ++k) \
        acc[ai][bj][m][n] = __builtin_amdgcn_mfma_f32_16x16x32_bf16(Bt[n][k], At[m][k], acc[ai][bj][m][n], 0, 0, 0); __builtin_amdgcn_s_setprio(0); } while (0)
#define PG8_WAIT_V(n) asm volatile("s_waitcnt vmcnt(" #n ")" ::: "memory")
#define PG8_WAIT_L(n) asm volatile("s_waitcnt lgkmcnt(" #n ")" ::: "memory")
#define PG8_BAR __builtin_amdgcn_s_barrier()
#define PG8_SCHED __builtin_amdgcn_sched_barrier(0)
    Unit cur, nxt; int ui = 0;
    if (!S.next(0, cur)) return;
    f32x4 acc[2][2][4][2];
#pragma unroll
    for (int a = 0; a < 2; ++a)
#pragma unroll
        for (int b = 0; b < 2; ++b)
#pragma unroll
            for (int m = 0; m < 4; ++m)
#pragma unroll
                for (int n = 0; n < 2; ++n) acc[a][b][m][n] = (f32x4){0.f, 0.f, 0.f, 0.f};
    bf16x8 At[4][2], B0[2][2], B1[2][2];
    const char* cA = (const char*)g.A + (size_t)cur.pm * tstep; const char* cB = (const char*)g.Bt + (size_t)cur.pn * tstep;
    S.a_ready(cur);
    if constexpr (SP2) {
        PG8_STAGE(PG8_SB(0, 0), cB, voffB); PG8_STAGE(PG8_SB(0, 1), cB + hstep, voffB); PG8_STAGE(PG8_SA(0, 0), cA, voffA); PG8_STAGE(PG8_SA(0, 1), cA + hstep, voffA);
        if (wr == 1) PG8_BAR;
        PG8_WAIT_V(2); PG8_BAR;
        PG8_STAGE(PG8_SB(1, 0), cB + kstep, voffB); PG8_STAGE(PG8_SA(1, 0), cA + kstep, voffA); PG8_STAGE(PG8_SB(1, 1), cB + hstep + kstep, voffB);
        PG8_WAIT_V(6); PG8_BAR;
    } else {
    PG8_STAGE(PG8_SB(0, 0), cB, voffB); PG8_STAGE(PG8_SA(0, 0), cA, voffA); PG8_STAGE(PG8_SB(0, 1), cB + hstep, voffB); PG8_STAGE(PG8_SA(0, 1), cA + hstep, voffA);
    if (wr == 1) PG8_BAR;
    PG8_WAIT_V(4); PG8_BAR;
    PG8_STAGE(PG8_SB(1, 0), cB + kstep, voffB); PG8_STAGE(PG8_SA(1, 0), cA + kstep, voffA); PG8_STAGE(PG8_SB(1, 1), cB + hstep + kstep, voffB);
    PG8_WAIT_V(6); PG8_BAR;
    }
    PG8_STAMP();
    for (;;) {
        const bool has_next = S.next(ui + 1, nxt);
        const char* nA = has_next ? (const char*)g.A + (size_t)nxt.pm * tstep : cA; const char* nB = has_next ? (const char*)g.Bt + (size_t)nxt.pn * tstep : cB;
        for (int t = 0; t < nt; t += 2) {
            const bool last = (t == nt - 2);
            const char* a1 = cA + (size_t)(t + 1) * kstep;
            const char* a2 = last ? nA : cA + (size_t)(t + 2) * kstep; const char* b2 = last ? nB : cB + (size_t)(t + 2) * kstep;
            const char* a3 = a2 + kstep; const char* b3 = b2 + kstep;
            if (last && has_next) S.a_ready(nxt);
            if constexpr (SP2) {
            PG8_LDB(B0, 0, 0); PG8_LDB(B1, 0, 1); PG8_SCHED; PG8_LDA(At, 0, 0); PG8_STAGE(PG8_SA(1, 1), a1 + hstep, voffA);
            PG8_WAIT_V(8); PG8_WAIT_L(0); PG8_BAR; PG8_MMA(0, 0, At, B0); PG8_MMA(0, 1, At, B1); PG8_BAR; PG8_SCHED;
            PG8_LDA(At, 0, 1); PG8_STAGE(PG8_SB(0, 0), b2, voffB); PG8_STAGE(PG8_SB(0, 1), b2 + hstep, voffB); PG8_STAGE(PG8_SA(0, 0), a2, voffA);
            PG8_WAIT_V(8); PG8_WAIT_L(0); PG8_BAR; PG8_MMA(1, 0, At, B0); PG8_MMA(1, 1, At, B1); PG8_BAR; PG8_SCHED;
            PG8_LDB(B0, 1, 0); PG8_LDB(B1, 1, 1); PG8_SCHED; PG8_LDA(At, 1, 0); PG8_STAGE(PG8_SA(0, 1), a2 + hstep, voffA);
            PG8_WAIT_V(8); PG8_WAIT_L(0); PG8_BAR; PG8_MMA(0, 0, At, B0); PG8_MMA(0, 1, At, B1); PG8_BAR; PG8_SCHED;
            PG8_LDA(At, 1, 1); PG8_STAGE(PG8_SB(1, 0), b3, voffB); PG8_STAGE(PG8_SB(1, 1), b3 + hstep, voffB); PG8_STAGE(PG8_SA(1, 0), a3, voffA);
            PG8_WAIT_V(8); PG8_WAIT_L(0); PG8_BAR; PG8_MMA(1, 0, At, B0); PG8_MMA(1, 1, At, B1); PG8_BAR; PG8_SCHED;
            } else {
            PG8_LDB(B0, 0, 0); PG8_SCHED; PG8_LDA(At, 0, 0); PG8_STAGE(PG8_SA(1, 1), a1 + hstep, voffA);
            PG8_WAIT_L(8); PG8_BAR; PG8_WAIT_L(0); PG8_MMA(0, 0, At, B0); PG8_BAR; PG8_SCHED;
            PG8_LDB(B1, 0, 1); PG8_STAGE(PG8_SB(0, 0), b2, voffB);
            PG8_BAR; PG8_WAIT_L(0); PG8_MMA(0, 1, At, B1); PG8_BAR;
            PG8_LDA(At, 0, 1); PG8_STAGE(PG8_SA(0, 0), a2, voffA);
            PG8_BAR; PG8_WAIT_L(0); PG8_MMA(1, 0, At, B0); PG8_BAR; PG8_SCHED;
            PG8_STAGE(PG8_SB(0, 1), b2 + hstep, voffB);
            PG8_WAIT_V(6); PG8_BAR; PG8_MMA(1, 1, At, B1); PG8_BAR;
            PG8_LDB(B0, 1, 0); PG8_SCHED; PG8_LDA(At, 1, 0); PG8_STAGE(PG8_SA(0, 1), a2 + hstep, voffA);
            PG8_WAIT_L(8); PG8_BAR; PG8_WAIT_L(0); PG8_MMA(0, 0, At, B0); PG8_BAR; PG8_SCHED;
            PG8_LDB(B1, 1, 1); PG8_STAGE(PG8_SB(1, 0), b3, voffB);
            PG8_BAR; PG8_WAIT_L(0); PG8_MMA(0, 1, At, B1); PG8_BAR;
            PG8_LDA(At, 1, 1); PG8_STAGE(PG8_SA(1, 0), a3, voffA);
            PG8_BAR; PG8_WAIT_L(0); PG8_MMA(1, 0, At, B0); PG8_BAR; PG8_SCHED;
            PG8_STAGE(PG8_SB(1, 1), b3 + hstep, voffB);
            PG8_WAIT_V(6); PG8_BAR; PG8_MMA(1, 1, At, B1); PG8_BAR;
            }
        }
        PG8_STAMP();
        if constexpr (ALIGN_EPI) { if (wr == 0) PG8_BAR; }
        if constexpr (!Epi::AFTER_DRAIN) { E(acc, cur, wr, wc, fr, fq); S.done(cur); }
        PG8_STAMP();
        if (!has_next) break;
        bool zero_acc = true; if constexpr (epi_keep<Epi>::value) zero_acc = !E.keep(cur);
        if (zero_acc) { const bf16x8 z8 = {0, 0, 0, 0, 0, 0, 0, 0};
#pragma unroll
        for (int a = 0; a < 2; ++a)
#pragma unroll
            for (int b = 0; b < 2; ++b)
#pragma unroll
                for (int m = 0; m < 4; ++m)
#pragma unroll
                    for (int n = 0; n < 2; ++n) acc[a][b][m][n] = __builtin_amdgcn_mfma_f32_16x16x32_bf16(z8, z8, (f32x4){0.f, 0.f, 0.f, 0.f}, 0, 0, 0); }
        cur = nxt; cA = nA; cB = nB; ++ui;
        if constexpr (ALIGN_EPI) { if (wr == 1) PG8_BAR; }
    }
    PG8_WAIT_V(0);
    if constexpr (!ALIGN_EPI) { if (wr == 0) PG8_BAR; }
    PG8_BAR;
    if constexpr (Epi::AFTER_DRAIN) { E.fused(acc, cur, wr, wc, fr, fq, lds, wid, lane); S.done(cur); }
    PG8_STAMP();
    if (STAMP && wid == 0) { stamps[lane] = lane < nts ? (((unsigned long long)(unsigned)ts_hi << 32) | (unsigned)ts_lo) : 0ull;
        if (lane == 62) stamps[62] = rt_entry; if (lane == 63) stamps[63] = (unsigned long long)wall_clock64(); }
#undef PG8_STAMP
#undef PG8_SA
#undef PG8_SB
#undef PG8_STAGE
#undef PG8_LDA
#undef PG8_LDB
#undef PG8_MMA
#undef PG8_WAIT_V
#undef PG8_WAIT_L
#undef PG8_BAR
#undef PG8_SCHED
}
}

#define XB_TMO      128
#define XB_XCNT(j)  (256  + 64 * (j))
#define XB_XSUB(j)  (1280 + 64 * (j))
#define XB_XGEN(j)  (2304 + 64 * (j))
#define XB_TOP      3328
#define XB_TOPGEN   3392
#define XCD_BAR_WORDS 3456
#define XB_SPIN_CAP (1u << 18)
#define LAS __attribute__((address_space(3)))

__device__ __forceinline__ unsigned xb_ld(unsigned* p)              { return __hip_atomic_load(p, __ATOMIC_RELAXED, __HIP_MEMORY_SCOPE_AGENT); }
__device__ __forceinline__ unsigned xb_add(unsigned* p, unsigned v) { return __hip_atomic_fetch_add(p, v, __ATOMIC_RELAXED, __HIP_MEMORY_SCOPE_AGENT); }
__device__ __forceinline__ unsigned xb_xcc_id() { return (unsigned)__builtin_amdgcn_s_getreg((3 << 11) | 20) & 0xFu; }
#define XB_SPIN(cond, bar) do { unsigned _sp = 0; while (cond) { __builtin_amdgcn_s_sleep(1); \
    if ((++_sp & 255u) == 0u) { if (xb_ld(&(bar)[XB_TMO])) break; if (_sp > XB_SPIN_CAP) { atomicAdd(&(bar)[XB_TMO], 1u); break; } } } } while (0)

struct XcdBarrier {
    unsigned* bar; unsigned x;
    volatile LAS unsigned* st;
};

__device__ __forceinline__ XcdBarrier xcd_barrier_post(unsigned* bar, volatile LAS unsigned* st) {
    XcdBarrier b; b.bar = bar; b.x = xb_xcc_id(); b.st = st;
    if (threadIdx.x == 0) (void)xb_add(&bar[XB_XCNT(b.x)], 1u);
    return b;
}
__device__ __forceinline__ void xcd_barrier_complete(unsigned* bar, unsigned x, unsigned& nloc, unsigned& nx) {
    const unsigned G = gridDim.x * gridDim.y * gridDim.z;
    unsigned sum, cnt, mine, sp = 0u;
    for (;;) {
        sum = 0u; cnt = 0u; mine = 0u;
#pragma unroll
        for (unsigned j = 0; j < 16; ++j) { const unsigned c = xb_ld(&bar[XB_XCNT(j)]); sum += c; cnt += (c > 0u) ? 1u : 0u; mine = (j == x) ? c : mine; }
        if (sum == G) break;
        __builtin_amdgcn_s_sleep(1);
        if ((++sp & 255u) == 0u) { if (xb_ld(&bar[XB_TMO])) break; if (sp > XB_SPIN_CAP) { atomicAdd(&bar[XB_TMO], 1u); break; } }
    }
    nloc = mine > 0u ? mine : 1u; nx = cnt > 0u ? cnt : 1u;
}

__device__ __forceinline__ void xcd_barrier(const XcdBarrier& b) {
    asm volatile("s_waitcnt vmcnt(0)" ::: "memory");
    __syncthreads();
    if (threadIdx.x == 0) {
        unsigned* bar = b.bar;
        __builtin_amdgcn_s_waitcnt(0);
        unsigned nloc = b.st[0], nx = b.st[1];
        if (nloc == 0u) { xcd_barrier_complete(bar, b.x, nloc, nx); b.st[0] = nloc; b.st[1] = nx; }
        const unsigned old = xb_add(&bar[XB_XSUB(b.x)], 1u);
        const unsigned gen = old / nloc;
        if (old + 1u == (gen + 1u) * nloc) {
            __builtin_amdgcn_fence(__ATOMIC_RELEASE, "agent");
            asm volatile("s_waitcnt vmcnt(0)" ::: "memory");
            const unsigned og = xb_add(&bar[XB_TOP], 1u);
            const unsigned tg = og / nx;
            if (og + 1u == (tg + 1u) * nx) xb_add(&bar[XB_TOPGEN], 1u);
            else XB_SPIN(xb_ld(&bar[XB_TOPGEN]) == tg, bar);
            __builtin_amdgcn_fence(__ATOMIC_ACQUIRE, "agent");
            xb_add(&bar[XB_XGEN(b.x)], 1u);
            asm volatile("s_waitcnt vmcnt(0)" ::: "memory");
        } else {
            XB_SPIN(xb_ld(&bar[XB_XGEN(b.x)]) == gen, bar);
            __builtin_amdgcn_fence(__ATOMIC_ACQUIRE, "agent");
            asm volatile("s_waitcnt vmcnt(0)" ::: "memory");
        }
    }
    __syncthreads();
}

#else
namespace pg8 {
typedef unsigned short bf16_t;
typedef float f32x4 __attribute__((ext_vector_type(4)));
typedef unsigned u32x4 __attribute__((ext_vector_type(4)));
constexpr int BM = 256, BK = 64, HALF = 128, NXCD = 8, WGM = 8;
struct Unit { int pm, pn; };
struct Gemm { const bf16_t* A; const bf16_t* Bt; int M, N, K; };
template <class E, class = void> struct epi_keep { static constexpr bool value = false; };
template <class E> struct epi_keep<E, decltype((void)E::KEEP_ACC)> { static constexpr bool value = true; };
struct StaticOrder {
    int nM, nN, nwg, G, c;
    void init(int M, int N, int G_, int c_) { nM = M / BM; nN = N / BM; nwg = nM * nN; G = G_; c = c_; }
    bool next(int i, Unit& u) const {
        const long L = (long)i * G + c; if (L >= nwg) return false;
        int wgid = (int)L; { const int q = nwg / NXCD, r = nwg % NXCD, xcd = wgid % NXCD, off = wgid / NXCD; wgid = (xcd < r ? xcd * (q + 1) : r * (q + 1) + (xcd - r) * q) + off; }
        const int nig = WGM * nN, gid = wgid / nig, fm = gid * WGM, gsz = (nM - fm) < WGM ? (nM - fm) : WGM;
        u.pm = fm + ((wgid % nig) % gsz); u.pn = (wgid % nig) / gsz; return true;
    }
    void a_ready(const Unit&) const {}
    void done(const Unit&) const {}
};
static inline unsigned cvt_pk_bf16(float lo, float hi) { return pk2(lo, hi); }
static float* emu_tile_buf(int b) { static std::vector<std::vector<float>> t; if ((int)t.size() <= b) t.resize(b + 1); if (t[b].empty()) t[b].resize(256 * 256); return t[b].data(); }
template <class Epi, class Sched, bool STAMP = false, bool ALIGN_EPI = false, bool SP2 = false, bool ZPEEL = false>
void gemm_phase(unsigned char* lds, const Gemm g, const Sched& S, const Epi& E, unsigned long long* stamps) {
    const int tid = threadIdx.x, wid = tid >> 6, lane = tid & 63, wr = wid >> 2, wc = wid & 3, fr = lane & 15, fq = lane >> 4;
    float* tile = emu_tile_buf(blockIdx.x);
    Unit u; f32x4 acc[2][2][4][2]; bool keep_next = false;
    for (int ui = 0; S.next(ui, u); ++ui) {
        __syncthreads();
        if (tid == 0) {
            std::vector<float> a((size_t)256 * g.K), b((size_t)256 * g.K);
            for (int r = 0; r < 256; ++r) for (int k = 0; k < g.K; ++k) { a[(size_t)r * g.K + k] = bf2f(g.A[((size_t)u.pm * 256 + r) * g.K + k]); b[(size_t)r * g.K + k] = bf2f(g.Bt[((size_t)u.pn * 256 + r) * g.K + k]); }
            for (int r = 0; r < 256; ++r) for (int c = 0; c < 256; ++c) { const float* ar = &a[(size_t)r * g.K]; const float* br = &b[(size_t)c * g.K]; float s = 0.f; for (int k = 0; k < g.K; ++k) s += ar[k] * br[k]; tile[r * 256 + c] = s; }
        }
        __syncthreads();
        if (!keep_next) for (int ai = 0; ai < 2; ++ai) for (int bj = 0; bj < 2; ++bj) for (int m = 0; m < 4; ++m) for (int n = 0; n < 2; ++n) acc[ai][bj][m][n] = (f32x4){0.f, 0.f, 0.f, 0.f};
        for (int ai = 0; ai < 2; ++ai) for (int bj = 0; bj < 2; ++bj) for (int m = 0; m < 4; ++m) for (int n = 0; n < 2; ++n) for (int j = 0; j < 4; ++j) {
            const int r = 128 * ai + 64 * wr + 16 * m + fr;
            const int c = Epi::PERM ? (128 * bj + 32 * wc + 8 * fq + 4 * n + j) : (128 * bj + 32 * wc + 16 * n + 4 * fq + j);
            acc[ai][bj][m][n][j] += tile[r * 256 + c];
        }
        E(acc, u, wr, wc, fr, fq); S.done(u);
        if constexpr (epi_keep<Epi>::value) keep_next = E.keep(u); else keep_next = false;
        __syncthreads();
    }
}
}
#endif
namespace pg8 {
#ifdef HOST_EMU
#define EPI_FENCE() do {} while (0)
#else
#define EPI_FENCE() asm volatile("" ::: "memory")
#endif
__device__ __forceinline__ u32x4 pack8(const f32x4 v0, const f32x4 v1) { u32x4 w; w.x = cvt_pk_bf16(v0[0], v0[1]); w.y = cvt_pk_bf16(v0[2], v0[3]); w.z = cvt_pk_bf16(v1[0], v1[1]); w.w = cvt_pk_bf16(v1[2], v1[3]); return w; }
__device__ __forceinline__ void unpack8(const u32x4 w, f32x4& v0, f32x4& v1) { v0 = (f32x4){lo_bf(w.x), hi_bf(w.x), lo_bf(w.y), hi_bf(w.y)}; v1 = (f32x4){lo_bf(w.z), hi_bf(w.z), lo_bf(w.w), hi_bf(w.w)}; }
__device__ __forceinline__ f32x4 sig4(const f32x4 v) { return (f32x4){sigm(v[0]), sigm(v[1]), sigm(v[2]), sigm(v[3])}; }
#ifndef HOST_EMU
__device__ __forceinline__ float gate_sig(float x) { return __builtin_amdgcn_rcpf(fminf(1.0f + __expf(-x), 1.0e6f)); }
#else
__device__ __forceinline__ float gate_sig(float x) { return fmaxf(sigm(x), 1.0e-6f); }
#endif
__device__ __forceinline__ f32x4 gsig4(const f32x4 v) { return (f32x4){gate_sig(v[0]), gate_sig(v[1]), gate_sig(v[2]), gate_sig(v[3])}; }

struct EpiProj {
    static constexpr bool PERM = true, AFTER_DRAIN = false;
    unsigned char* ws;
    __device__ __forceinline__ void operator()(const f32x4 (&acc)[2][2][4][2], const Unit& u, int wr, int wc, int fr, int fq) const {
        const int pn = u.pn; size_t off; int ld, c0;
        if (pn < 2) { off = WS_Z; ld = 512; c0 = pn * 256; }
        else if (pn < 5) { off = WS_XBC; ld = 768; c0 = (pn - 2) * 256; }
        else if (pn < 7) { off = WS_Q; ld = 512; c0 = (pn - 5) * 256; }
        else if (pn < 9) { off = WS_K; ld = 512; c0 = (pn - 7) * 256; }
        else if (pn < 11) { off = WS_V; ld = 512; c0 = (pn - 9) * 256; }
        else if (pn < 18) { off = WS_RW; ld = 1792; c0 = (pn - 11) * 256; }
        else if (pn < 20) { off = WS_U; ld = 512; c0 = (pn - 18) * 256; }
        else { off = WS_SM; ld = 256; c0 = 0; }
        bf16_t* dst = (bf16_t*)(ws + off);
        const int row0 = u.pm * BM + wr * 64 + fr, col0 = c0 + wc * 32 + 8 * fq;
        const int kic = HALF + wc * 32 + 8 * fq - 136;
        const bool ki = (pn == 20) && kic >= 0 && kic < 32;
#pragma unroll
        for (int ai = 0; ai < 2; ++ai)
#pragma unroll
            for (int m = 0; m < 4; ++m) { const size_t row = (size_t)(row0 + ai * HALF + m * 16); bf16_t* rowp = dst + row * ld + col0;
#pragma unroll
                for (int bj = 0; bj < 2; ++bj) { const u32x4 w = pack8(acc[ai][bj][m][0], acc[ai][bj][m][1]); *(u32x4*)(rowp + bj * HALF) = w;
                    if (bj == 1 && ki) *(u32x4*)((bf16_t*)(ws + WS_KI) + row * 32 + kic) = w; } }
    }
};
struct EpiGate {
    static constexpr bool PERM = true, AFTER_DRAIN = false;
    bf16_t* G;
    __device__ __forceinline__ void operator()(const f32x4 (&acc)[2][2][4][2], const Unit& u, int wr, int wc, int fr, int fq) const {
        const int row0 = u.pm * BM + wr * 64 + fr, col0 = u.pn * BM + wc * 32 + 8 * fq;
#pragma unroll
        for (int ai = 0; ai < 2; ++ai)
#pragma unroll
            for (int m = 0; m < 4; ++m) { bf16_t* rowp = G + (size_t)(row0 + ai * HALF + m * 16) * 4096 + col0;
#pragma unroll
                for (int bj = 0; bj < 2; ++bj) *(u32x4*)(rowp + bj * HALF) = pack8(gsig4(acc[ai][bj][m][0]), gsig4(acc[ai][bj][m][1])); }
    }
};
struct EpiMerge {
    static constexpr bool PERM = true, AFTER_DRAIN = false, KEEP_ACC = true;
    const bf16_t* G; bf16_t* MRG;
    __device__ __forceinline__ bool keep(const Unit& u) const { return (u.pn >> 2) < 3; }
    __device__ __forceinline__ void operator()(f32x4 (&acc)[2][2][4][2], const Unit& u, int wr, int wc, int fr, int fq) const {
        const int n = u.pn >> 2, pn = u.pn & 3, pm = u.pm - n * (MG / 256);
        const int row0 = pm * BM + wr * 64 + fr, col0 = pn * BM + wc * 32 + 8 * fq;
#pragma unroll
        for (int ai = 0; ai < 2; ++ai)
#pragma unroll
            for (int mp = 0; mp < 2; ++mp) { u32x4 ga[2][2], gb[2][2];
#pragma unroll
                for (int mm = 0; mm < 2; ++mm)
#pragma unroll
                    for (int bj = 0; bj < 2; ++bj) { const bf16_t* gp = G + (size_t)(row0 + ai * HALF + (2 * mp + mm) * 16) * 4096 + n * 1024 + col0 + bj * HALF; ga[mm][bj] = *(const u32x4*)gp; if (n < 3) gb[mm][bj] = *(const u32x4*)(gp + 1024); }
#pragma unroll
                for (int mm = 0; mm < 2; ++mm)
#pragma unroll
                    for (int bj = 0; bj < 2; ++bj) { const int m = 2 * mp + mm; f32x4 a0, a1; unpack8(ga[mm][bj], a0, a1);
                        if (n < 3) { f32x4 b0, b1; unpack8(gb[mm][bj], b0, b1);
#pragma unroll
                            for (int j = 0; j < 4; ++j) { acc[ai][bj][m][0][j] *= a0[j] * __builtin_amdgcn_rcpf(b0[j]); acc[ai][bj][m][1][j] *= a1[j] * __builtin_amdgcn_rcpf(b1[j]); } }
                        else
                            *(u32x4*)(MRG + (size_t)(row0 + ai * HALF + m * 16) * 1024 + col0 + bj * HALF) = pack8(acc[ai][bj][m][0] * a0, acc[ai][bj][m][1] * a1); }
                EPI_FENCE(); }
    }
};
struct MergeOrder {
    int G, c;
    __device__ __forceinline__ bool next(int i, Unit& u) const {
        const int tile = (i >> 2) * G + c, n = i & 3; if (tile >= (MG / 256) * 4) return false;
        u.pm = n * (MG / 256) + (tile >> 2); u.pn = n * 4 + (tile & 3); return true;
    }
    __device__ __forceinline__ void a_ready(const Unit&) const {}
    __device__ __forceinline__ void done(const Unit&) const {}
};
struct EpiResid {
    static constexpr bool PERM = false, AFTER_DRAIN = false;
    const float* base; float* out;
    __device__ __forceinline__ void operator()(const f32x4 (&acc)[2][2][4][2], const Unit& u, int wr, int wc, int fr, int fq) const {
        const int row0 = u.pm * BM + wr * 64 + fr, col0 = u.pn * BM + wc * 32 + 4 * fq;
#pragma unroll
        for (int ai = 0; ai < 2; ++ai) {
            f32x4 bv[4][2][2];
#pragma unroll
            for (int m = 0; m < 4; ++m)
#pragma unroll
                for (int bj = 0; bj < 2; ++bj)
#pragma unroll
                    for (int n = 0; n < 2; ++n) bv[m][bj][n] = *(const f32x4*)(base + (size_t)(row0 + ai * HALF + m * 16) * 1024 + col0 + bj * HALF + n * 16);
#pragma unroll
            for (int m = 0; m < 4; ++m)
#pragma unroll
                for (int bj = 0; bj < 2; ++bj)
#pragma unroll
                    for (int n = 0; n < 2; ++n) *(f32x4*)(out + (size_t)(row0 + ai * HALF + m * 16) * 1024 + col0 + bj * HALF + n * 16) = bv[m][bj][n] + acc[ai][bj][m][n];
            EPI_FENCE(); }
    }
};
struct EpiSwiglu {
    static constexpr bool PERM = true, AFTER_DRAIN = false;
    bf16_t* HID;
    __device__ __forceinline__ void operator()(const f32x4 (&acc)[2][2][4][2], const Unit& u, int wr, int wc, int fr, int fq) const {
        const int row0 = u.pm * BM + wr * 64 + fr, col0 = u.pn * HALF + wc * 32 + 8 * fq;
#pragma unroll
        for (int ai = 0; ai < 2; ++ai)
#pragma unroll
            for (int m = 0; m < 4; ++m) { f32x4 v[2];
#pragma unroll
                for (int n = 0; n < 2; ++n) { const f32x4 a = acc[ai][0][m][n], b = acc[ai][1][m][n]; v[n] = a * sig4(a) * b; }
                *(u32x4*)(HID + (size_t)(row0 + ai * HALF + m * 16) * FFN + col0) = pack8(v[0], v[1]); }
    }
};
struct EpiGlu {
    static constexpr bool PERM = true, AFTER_DRAIN = false;
    const bf16_t* Y0; bf16_t* OUT; const float* bias;
    __device__ __forceinline__ void operator()(const f32x4 (&acc)[2][2][4][2], const Unit& u, int wr, int wc, int fr, int fq) const {
        const int row0 = u.pm * BM + wr * 64 + fr, col0 = u.pn * BM + wc * 32 + 8 * fq;
#pragma unroll
        for (int ai = 0; ai < 2; ++ai)
#pragma unroll
            for (int m = 0; m < 4; ++m) { const size_t row = (size_t)(row0 + ai * HALF + m * 16);
#pragma unroll
                for (int bj = 0; bj < 2; ++bj) { const int col = col0 + bj * HALF;
                    f32x4 y0, y1; unpack8(*(const u32x4*)(Y0 + row * 512 + col), y0, y1);
                    const f32x4 b0 = *(const f32x4*)(bias + col), b1 = *(const f32x4*)(bias + col + 4);
                    *(u32x4*)(OUT + row * 512 + col) = pack8(y0 * sig4(acc[ai][bj][m][0] + b0), y1 * sig4(acc[ai][bj][m][1] + b1)); }
                EPI_FENCE(); }
    }
};
__device__ __forceinline__ float logdecay(float x) { return -0.6065306597f * sigm(x); }
struct EpiLora {
    static constexpr bool PERM = true, AFTER_DRAIN = false;
    float* WLOG; bf16_t* ASIG; bf16_t* GG; const float* w0; const float* a0;
    __device__ __forceinline__ void operator()(const f32x4 (&acc)[2][2][4][2], const Unit& u, int wr, int wc, int fr, int fq) const {
        const int kind = u.pn >> 1, row0 = u.pm * BM + wr * 64 + fr, col0 = (u.pn & 1) * BM + wc * 32 + 8 * fq;
        if (kind == 0) {
            f32x4 b[2][2];
#pragma unroll
            for (int bj = 0; bj < 2; ++bj) { b[bj][0] = *(const f32x4*)(w0 + col0 + bj * HALF); b[bj][1] = *(const f32x4*)(w0 + col0 + bj * HALF + 4); }
#pragma unroll
            for (int ai = 0; ai < 2; ++ai)
#pragma unroll
                for (int m = 0; m < 4; ++m)
#pragma unroll
                    for (int bj = 0; bj < 2; ++bj)
#pragma unroll
                        for (int n = 0; n < 2; ++n) { const f32x4 x = acc[ai][bj][m][n] + b[bj][n];
                            *(f32x4*)(WLOG + (size_t)(row0 + ai * HALF + m * 16) * 512 + col0 + bj * HALF + 4 * n) = (f32x4){logdecay(x[0]), logdecay(x[1]), logdecay(x[2]), logdecay(x[3])}; }
        } else if (kind == 1) {
            f32x4 b[2][2];
#pragma unroll
            for (int bj = 0; bj < 2; ++bj) { b[bj][0] = *(const f32x4*)(a0 + col0 + bj * HALF); b[bj][1] = *(const f32x4*)(a0 + col0 + bj * HALF + 4); }
#pragma unroll
            for (int ai = 0; ai < 2; ++ai)
#pragma unroll
                for (int m = 0; m < 4; ++m)
#pragma unroll
                    for (int bj = 0; bj < 2; ++bj)
                        *(u32x4*)(ASIG + (size_t)(row0 + ai * HALF + m * 16) * 512 + col0 + bj * HALF) = pack8(sig4(acc[ai][bj][m][0] + b[bj][0]), sig4(acc[ai][bj][m][1] + b[bj][1]));
        } else {
#pragma unroll
            for (int ai = 0; ai < 2; ++ai)
#pragma unroll
                for (int m = 0; m < 4; ++m)
#pragma unroll
                    for (int bj = 0; bj < 2; ++bj)
                        *(u32x4*)(GG + (size_t)(row0 + ai * HALF + m * 16) * 512 + col0 + bj * HALF) = pack8(acc[ai][bj][m][0], acc[ai][bj][m][1]);
        }
    }
};
}
typedef short bf16x8_t __attribute__((ext_vector_type(8)));
typedef float f32x16 __attribute__((ext_vector_type(16)));
typedef float f32x4_t __attribute__((ext_vector_type(4)));
__device__ __forceinline__ bf16x8_t frag2(const u32x2 lo, const u32x2 hi) { u32x4 w; w.x = lo.x; w.y = lo.y; w.z = hi.x; w.w = hi.y; return __builtin_bit_cast(bf16x8_t, w); }
struct Args { const float* in[N_IN]; float* out; unsigned char* ws; int seg_lo, seg_hi; };
#ifdef HOST_EMU
typedef const Args* KArgs;
#define KLAUNDER(p) (p)
__device__ __forceinline__ int fresh_tid() { return (int)threadIdx.x; }
#else
typedef const __attribute__((address_space(4))) Args* KArgs;
__device__ __forceinline__ KArgs klaunder(KArgs p) { asm volatile("" : "+s"(p)); return p; }
#define KLAUNDER(p) klaunder(p)
__device__ __forceinline__ int fresh_tid() { int t = (int)threadIdx.x; asm volatile("" : "+v"(t)); return t; }
#endif
#define WSP(T, off) ((T*)(C->ws + (off)))

template <class Src>
__device__ __forceinline__ void transpose_item(const Src& S, int K, bf16* WT, float* scr, int item, int lane) {
    const int nblk = S.ndst / 32, kb = item / nblk, nb = item % nblk, k0 = 64 * kb, n0 = 32 * nb;
    const float* cp = S.col(n0 + (lane & 31)); const int ld = S.ld; const float* cq = cp ? cp : S.col(0);
    float ld32[32];
#pragma unroll
    for (int i = 0; i < 32; ++i) ld32[i] = cq[(size_t)(k0 + 2 * i + (lane >> 5)) * ld];
#pragma unroll
    for (int i = 0; i < 32; ++i) { const int kk = 2 * i + (lane >> 5); scr[kk * 33 + (lane & 31)] = cp ? ld32[i] : 0.f; }
    WAVE_SYNC();
    const int c = lane & 7;
#pragma unroll
    for (int j = 0; j < 4; ++j) { const int n = (lane >> 3) + 8 * j; const float* s = scr + (8 * c) * 33 + n;
        u32x4 o; o.x = pk2(s[0 * 33], s[1 * 33]); o.y = pk2(s[2 * 33], s[3 * 33]); o.z = pk2(s[4 * 33], s[5 * 33]); o.w = pk2(s[6 * 33], s[7 * 33]);
        *(u32x4*)(WT + (size_t)(n0 + n) * K + k0 + 8 * c) = o; }
    WAVE_SYNC();
}
struct SrcWin { const float* w; int ndst, ld;
    __device__ __forceinline__ const float* col(int n) const {
        int s;
        if (n < 1280) s = n;
        else if (n < 2816) s = n + 8;
        else if (n < 4608) s = n - 2816 + 2988;
        else if (n < 5120) s = n - 4608 + 4780;
        else if (n < 5128) s = n - 5120 + 1280;
        else if (n < 5256) s = n - 5128 + 2824;
        else if (n < 5288) s = n - 5256 + 2952;
        else if (n < 5292) s = n - 5288 + 2984;
        else if (n < 5376) return nullptr;
        else s = n - 5376 + 5292;
        return w + s; } };
struct SrcPlain { const float* w; int ndst, ld; __device__ __forceinline__ const float* col(int n) const { return w + n; } };
struct SrcW13 { const float* w1; const float* w3; int ndst, ld;
    __device__ __forceinline__ const float* col(int n) const { const int pn = n >> 8, r = n & 255; return w1 + (r < 128 ? (ptrdiff_t)0 : (w3 - w1)) + pn * 128 + (r & 127); } };

__device__ __forceinline__ void phase_weights(KArgs C, int layer, unsigned char* lds, int gw, int ngw, int lane, int wave) {
    float* scr = (float*)(lds + wave * 16384); const size_t wo = (layer & 1) ? WDELTA : 0;
    constexpr int N_IN_ = 16 * (NPROJ / 32), N_BR = 8 * 32, N_OUT = 16 * 32, N_13 = 16 * (5632 / 32), N_2 = 44 * 32, N_GLU = 8 * 16;
    { constexpr int E0 = N_IN_, E1 = E0 + 4 * N_BR, E2 = E1 + N_OUT, E3 = E2 + N_13, E4 = E3 + N_2, E5 = E4 + N_GLU;
      for (int it = gw; it < E5; it += ngw) {
          if (it < E0) { const SrcWin s_in{C->in[I_WIN] + (size_t)layer * 1024 * IN_COLS, NPROJ, IN_COLS}; transpose_item(s_in, 1024, WSP(bf16, WS_WIN + wo), scr, it, lane); }
          else if (it < E1) { const int i2 = it - E0, n = i2 / N_BR; const SrcPlain s_b{C->in[I_WBR] + ((size_t)layer * 4 + n) * 512 * 1024, 1024, 1024};
              transpose_item(s_b, 512, WSP(bf16, WS_WB + wo) + (size_t)n * 1024 * 512, scr, i2 % N_BR, lane); }
          else if (it < E2) { const SrcPlain s_out{C->in[I_WOUT] + (size_t)layer * 1024 * 1024, 1024, 1024}; transpose_item(s_out, 1024, WSP(bf16, WS_WOUT + wo), scr, it - E1, lane); }
          else if (it < E3) { const SrcW13 s_13{C->in[I_W1] + (size_t)layer * 1024 * FFN, C->in[I_W3] + (size_t)layer * 1024 * FFN, 5632, FFN}; transpose_item(s_13, 1024, WSP(bf16, WS_W13 + wo), scr, it - E2, lane); }
          else if (it < E4) { const SrcPlain s_2{C->in[I_W2F] + (size_t)layer * FFN * 1024, 1024, 1024}; transpose_item(s_2, FFN, WSP(bf16, WS_W2 + wo), scr, it - E3, lane); }
          else { const SrcPlain s_glu{C->in[I_GLUW] + (size_t)layer * 512 * 512, 512, 512}; transpose_item(s_glu, 512, WSP(bf16, WS_GLU + wo), scr, it - E4, lane); } } }
    { const float* w2 = C->in[I_W2] + (size_t)layer * 64 * 512; const float* a2 = C->in[I_A2] + (size_t)layer * 64 * 512; const float* g2 = C->in[I_G2] + (size_t)layer * 128 * 512;
      bf16* WL = WSP(bf16, WS_WLORA + wo);
      for (int e = gw * 64 + lane; e < 1536 * 256; e += ngw * 64) { const int n = e >> 8, kc = e & 255; float v = 0.f;
          if (n < 512) { if (kc < 64) v = w2[kc * 512 + n]; } else if (n < 1024) { if (kc >= 64 && kc < 128) v = a2[(kc - 64) * 512 + (n - 512)]; } else { if (kc >= 128) v = g2[(kc - 128) * 512 + (n - 1024)]; }
          WL[e] = f2bf(v); } }
    const int gt = gw * 64 + lane, ngt = ngw * 64;
    for (int ej = ngt - 1 - gt; ej < 32 * 64 * 16; ej += ngt) {
        const int e = ej >> 4, j = ej & 15, g = e >> 6;
        const float ar = C->in[I_S5ARE][layer * 2048 + e], ai = C->in[I_S5AIM][layer * 2048 + e], dt = expf(C->in[I_S5LDT][layer * 32 + g]);
        const float br = C->in[I_S5BRE][((size_t)layer * 2048 + e) * 16 + j], bi = C->in[I_S5BIM][((size_t)layer * 2048 + e) * 16 + j];
        const float mag = expf(ar * dt), abr = mag * cosf(ai * dt), abi = mag * sinf(ai * dt);
        const float den = ar * ar + ai * ai, nr = abr - 1.0f, ni = abi;
        const float qr = (nr * ar + ni * ai) / den, qi = (ni * ar - nr * ai) / den;
        if (j == 0) { float* ab = WSP(float, WS_ABAR + wo) + e * 2; ab[0] = abr; ab[1] = abi; }
        float* bb = WSP(float, WS_BBAR + wo) + (size_t)e * 32;
        bb[2 * j] = qr * br - qi * bi; bb[2 * j + 1] = qr * bi + qi * br;
    }
    if (layer == 0) for (int e = gt; e < SEQ + 63; e += ngt) {
        const int rel = e - (SEQ - 1); const int n = rel < 0 ? -rel : rel; int b = rel > 0 ? 16 : 0;
        if (n < 8) b += n; else { int lg = 8 + (int)(logf((float)n / 8.0f) / 3.4657359028f * 8.0f); if (lg > 15) lg = 15; b += lg; }
        WSP(int, WS_TAB)[e] = b;
    }
}

__device__ __forceinline__ void rms_row_bf16(const float* xrow, const float* g, bf16* orow, int lane) {
    const f32x4* xr = (const f32x4*)xrow + lane; const f32x4* gr = (const f32x4*)g + lane;
    f32x4 v[4]; float s = 0.f;
#pragma unroll
    for (int j = 0; j < 4; ++j) { v[j] = xr[64 * j]; s += (v[j].x * v[j].x + v[j].y * v[j].y) + (v[j].z * v[j].z + v[j].w * v[j].w); }
    const float rstd = 1.0f / sqrtf(wave_sum(s) * (1.f / D) + RMS_EPS);
    u32x2* o8 = (u32x2*)orow + lane;
#pragma unroll
    for (int j = 0; j < 4; ++j) { const f32x4 gg = gr[64 * j]; u32x2 w; w.x = pk2(v[j].x * rstd * gg.x, v[j].y * rstd * gg.y); w.y = pk2(v[j].z * rstd * gg.z, v[j].w * rstd * gg.w); o8[64 * j] = w; }
}
template <int NR>
__device__ __forceinline__ void rms_rows_bf16(const float* x, const float* g, bf16* o, int gw, int ngw, int nrows, int lane) {
    const f32x4* gr = (const f32x4*)g + lane; f32x4 gg[4], v[NR][4], nx[NR][4];
#pragma unroll
    for (int j = 0; j < 4; ++j) gg[j] = gr[64 * j];
#pragma unroll
    for (int q = 0; q < NR; ++q)
#pragma unroll
        for (int j = 0; j < 4; ++j) nx[q][j] = (gw + q * ngw < nrows) ? ((const f32x4*)(x + (size_t)(gw + q * ngw) * D) + lane)[64 * j] : (f32x4){0.f, 0.f, 0.f, 0.f};
    for (int m = gw; m < nrows; m += NR * ngw) {
#pragma unroll
        for (int q = 0; q < NR; ++q)
#pragma unroll
            for (int j = 0; j < 4; ++j) v[q][j] = nx[q][j];
        if (m + NR * ngw < nrows) {
#pragma unroll
            for (int q = 0; q < NR; ++q)
#pragma unroll
                for (int j = 0; j < 4; ++j) nx[q][j] = (m + (NR + q) * ngw < nrows) ? ((const f32x4*)(x + (size_t)(m + (NR + q) * ngw) * D) + lane)[64 * j] : (f32x4){0.f, 0.f, 0.f, 0.f}; }
        float ss[NR];
#pragma unroll
        for (int q = 0; q < NR; ++q) { float s = 0.f;
#pragma unroll
            for (int j = 0; j < 4; ++j) s += (v[q][j].x * v[q][j].x + v[q][j].y * v[q][j].y) + (v[q][j].z * v[q][j].z + v[q][j].w * v[q][j].w);
            ss[q] = s; }
#pragma unroll
        for (int of = 1; of < 64; of <<= 1)
#pragma unroll
            for (int q = 0; q < NR; ++q) ss[q] += __shfl_xor(ss[q], of);
#pragma unroll
        for (int q = 0; q < NR; ++q) if (m + q * ngw < nrows) { const float r = 1.0f / sqrtf(ss[q] * (1.f / D) + RMS_EPS); u32x2* o8 = (u32x2*)(o + (size_t)(m + q * ngw) * D) + lane;
#pragma unroll
            for (int j = 0; j < 4; ++j) { u32x2 w; w.x = pk2(v[q][j].x * r * gg[j].x, v[q][j].y * r * gg[j].y); w.y = pk2(v[q][j].z * r * gg[j].z, v[q][j].w * r * gg[j].w); o8[64 * j] = w; } } }
}
template <int NR>
__device__ __forceinline__ void rms_rowN_bf16(const float* xrow, const float* g, bf16* orow, size_t step, int lane) {
    const f32x4* gr = (const f32x4*)g + lane; f32x4 v[NR][4]; float ss[NR];
#pragma unroll
    for (int q = 0; q < NR; ++q)
#pragma unroll
        for (int j = 0; j < 4; ++j) v[q][j] = ((const f32x4*)(xrow + q * step) + lane)[64 * j];
#pragma unroll
    for (int q = 0; q < NR; ++q) { float s = 0.f;
#pragma unroll
        for (int j = 0; j < 4; ++j) s += (v[q][j].x * v[q][j].x + v[q][j].y * v[q][j].y) + (v[q][j].z * v[q][j].z + v[q][j].w * v[q][j].w);
        ss[q] = s; }
#pragma unroll
    for (int o = 1; o < 64; o <<= 1)
#pragma unroll
        for (int q = 0; q < NR; ++q) ss[q] += __shfl_xor(ss[q], o);
#pragma unroll
    for (int q = 0; q < NR; ++q) { const float r = 1.0f / sqrtf(ss[q] * (1.f / D) + RMS_EPS); u32x2* o8 = (u32x2*)(orow + q * step) + lane;
#pragma unroll
        for (int j = 0; j < 4; ++j) { const f32x4 gg = gr[64 * j]; u32x2 w; w.x = pk2(v[q][j].x * r * gg.x, v[q][j].y * r * gg.y); w.y = pk2(v[q][j].z * r * gg.z, v[q][j].w * r * gg.w); o8[64 * j] = w; } }
}
__device__ __forceinline__ void rms_row_f32(float* xrow, const float* g, int lane) {
    f32x4* xr = (f32x4*)xrow + lane; const f32x4* gr = (const f32x4*)g + lane;
    f32x4 v[4]; float s = 0.f;
#pragma unroll
    for (int j = 0; j < 4; ++j) { v[j] = xr[64 * j]; s += (v[j].x * v[j].x + v[j].y * v[j].y) + (v[j].z * v[j].z + v[j].w * v[j].w); }
    const float rstd = 1.0f / sqrtf(wave_sum(s) * (1.f / D) + RMS_EPS);
#pragma unroll
    for (int j = 0; j < 4; ++j) xr[64 * j] = v[j] * rstd * gr[64 * j];
}

#ifdef HOST_EMU
__device__ __forceinline__ float red8(float v) { v += __shfl_xor(v, 1); v += __shfl_xor(v, 2); v += __shfl_xor(v, 4); return v; }
__device__ __forceinline__ float red16(float v) { v = red8(v); v += __shfl_xor(v, 8); return v; }
#else
template <int CTRL> __device__ __forceinline__ float dpp_f(float v) { return __builtin_bit_cast(float, __builtin_amdgcn_update_dpp(0, __builtin_bit_cast(int, v), CTRL, 0xf, 0xf, true)); }
__device__ __forceinline__ float red8(float v) { v += dpp_f<0xB1>(v); v += dpp_f<0x4E>(v); v += dpp_f<0x141>(v); return v; }
__device__ __forceinline__ float red16(float v) { v = red8(v); v += dpp_f<0x140>(v); return v; }
#endif
__device__ __forceinline__ f32x4 sig4g(const f32x4 v) { return (f32x4){sigm(v[0]), sigm(v[1]), sigm(v[2]), sigm(v[3])}; }
__device__ __forceinline__ void rms_row2_f32(float* xrow, size_t step, const float* g, int lane) {
    f32x4* xa = (f32x4*)xrow + lane; f32x4* xb = (f32x4*)(xrow + step) + lane; const f32x4* gr = (const f32x4*)g + lane;
    f32x4 va[4], vb[4]; float sa = 0.f, sb = 0.f;
#pragma unroll
    for (int j = 0; j < 4; ++j) { va[j] = xa[64 * j]; vb[j] = xb[64 * j]; }
#pragma unroll
    for (int j = 0; j < 4; ++j) { sa += (va[j].x * va[j].x + va[j].y * va[j].y) + (va[j].z * va[j].z + va[j].w * va[j].w); sb += (vb[j].x * vb[j].x + vb[j].y * vb[j].y) + (vb[j].z * vb[j].z + vb[j].w * vb[j].w); }
#pragma unroll
    for (int o = 1; o < 64; o <<= 1) { sa += __shfl_xor(sa, o); sb += __shfl_xor(sb, o); }
    const float ra = 1.0f / sqrtf(sa * (1.f / D) + RMS_EPS), rb = 1.0f / sqrtf(sb * (1.f / D) + RMS_EPS);
#pragma unroll
    for (int j = 0; j < 4; ++j) { const f32x4 gg = gr[64 * j]; xa[64 * j] = va[j] * ra * gg; xb[64 * j] = vb[j] * rb * gg; }
}
__device__ __forceinline__ void ssd_conv_row(KArgs C, int layer, int m, int lane) {
    const int t = m % SEQ; const float* cw = C->in[I_CONVW] + layer * 4 * 768; const float* cb = C->in[I_CONVB] + layer * 768;
#pragma unroll
    for (int i = 0; i < 3; ++i) { const int ch = i * 256 + lane * 4; const bf16* p = WSP(const bf16, WS_XBC) + (size_t)m * 768 + ch;
        f32x4 a = *(const f32x4*)(cb + ch);
#pragma unroll
        for (int q = 0; q < 4; ++q) if (t - 3 + q >= 0) { const u32x2 w = *(const u32x2*)(p - (3 - q) * 768); const f32x4 cq = *(const f32x4*)(cw + q * 768 + ch);
            a += cq * (f32x4){lo_bf(w.x), hi_bf(w.x), lo_bf(w.y), hi_bf(w.y)}; }
        a = a * sig4g(a);
        u32x2 o; o.x = pk2(a.x, a.y); o.y = pk2(a.z, a.w); *(u32x2*)(WSP(bf16, WS_XBA) + (size_t)m * 768 + ch) = o; }
}
__device__ __forceinline__ void ssd_conv_row2(KArgs C, int layer, int m, int step, int lane) {
    const float* cw = C->in[I_CONVW] + layer * 4 * 768; const float* cb = C->in[I_CONVB] + layer * 768;
    u32x2 w[2][3][4]; f32x4 cq[3][4], bb[3];
#pragma unroll
    for (int i = 0; i < 3; ++i) { const int ch = i * 256 + lane * 4; bb[i] = *(const f32x4*)(cb + ch);
#pragma unroll
        for (int q = 0; q < 4; ++q) { cq[i][q] = *(const f32x4*)(cw + q * 768 + ch);
#pragma unroll
            for (int r = 0; r < 2; ++r) { const int mm = m + r * step, t = mm % SEQ; const bf16* p = WSP(const bf16, WS_XBC) + (size_t)mm * 768 + ch;
                if (t - 3 + q >= 0) w[r][i][q] = *(const u32x2*)(p - (3 - q) * 768); else { w[r][i][q].x = 0u; w[r][i][q].y = 0u; } } } }
#pragma unroll
    for (int r = 0; r < 2; ++r)
#pragma unroll
        for (int i = 0; i < 3; ++i) { const int ch = i * 256 + lane * 4; f32x4 a = bb[i];
#pragma unroll
            for (int q = 0; q < 4; ++q) a += cq[i][q] * (f32x4){lo_bf(w[r][i][q].x), hi_bf(w[r][i][q].x), lo_bf(w[r][i][q].y), hi_bf(w[r][i][q].y)};
            a = a * sig4g(a);
            u32x2 o; o.x = pk2(a.x, a.y); o.y = pk2(a.z, a.w); *(u32x2*)(WSP(bf16, WS_XBA) + (size_t)(m + r * step) * 768 + ch) = o; }
}
__device__ __forceinline__ void ssd_unit(KArgs C, int layer, int unit, unsigned char* lds) {
    const int tid = fresh_tid(), lane = tid & 63, wave = tid >> 6, bl = unit >> 3, h = unit & 7, gi = h >> 2, pp = tid >> 3, c8 = (tid & 7) * 8, c16 = lane & 15, q = lane >> 4;
    bf16* Cb = (bf16*)lds; bf16* Bb = Cb + 4096; bf16* XT = Bb + 4096; bf16* BwT = XT + 4096; bf16* Pm = BwT + 4096; float* Yo = (float*)(Pm + 4096); float* dts = Yo + 8192; float* acs = dts + 128;
    const bf16* XA = WSP(const bf16, WS_XBA) + (size_t)bl * SEQ * 768 + (size_t)pp * 768 + c8;
    const bf16* SMp = WSP(const bf16, WS_SM) + (size_t)bl * SEQ * 256;
    const bf16* Zp = WSP(const bf16, WS_Z) + (size_t)bl * SEQ * 512 + (size_t)pp * 512 + h * 64 + c8;
    bf16* YA = WSP(bf16, WS_Y) + (size_t)bl * SEQ * 512 + (size_t)pp * 512 + h * 64 + c8;
    const float dtb = C->in[I_DTB][layer * 8 + h], A = -__expf(C->in[I_ALOG][layer * 8 + h]), Dh = C->in[I_SSDD][layer * 8 + h];
    f32x4_t Sd[2]; bf16x8_t Sf; Sd[0] = (f32x4_t){0.f, 0.f, 0.f, 0.f}; Sd[1] = Sd[0]; { u32x2 z; z.x = 0u; z.y = 0u; Sf = frag2(z, z); }
    const int pt = wave & 3, nh = wave >> 2;
    u32x4 fx, fb, fc, fz;
#define SSD_FETCH(c0_) do { const bf16* q_ = XA + (size_t)(c0_) * 768; fx = *(const u32x4*)(q_ + h * 64); fb = *(const u32x4*)(q_ + 512 + gi * 64); fc = *(const u32x4*)(q_ + 640 + gi * 64); fz = *(const u32x4*)(Zp + (size_t)(c0_) * 512); } while (0)
#define SSD_DT(c0_, par) do { if (wave == 0) { const float dt_ = softplusf(bf2f(SMp[(size_t)((c0_) + lane) * 256 + h]) + dtb); float a_ = A * dt_; \
        _Pragma("unroll") for (int o_ = 1; o_ < 64; o_ <<= 1) { const float t_ = __shfl_up(a_, o_); if (lane >= o_) a_ += t_; } dts[(par) * 64 + lane] = dt_; acs[(par) * 64 + lane] = a_; } } while (0)
    LDS_SYNC();
    SSD_FETCH(0); SSD_DT(0, 0);
    for (int c0 = 0, par = 0; c0 < SEQ; c0 += 64, par ^= 1) {
        LDS_SYNC();
        const u32x4 xk = fx, zk = fz;
        {
          const float dt = dts[par * 64 + pp], ea = __expf(acs[par * 64 + 63] - acs[par * 64 + pp]);
          *(u32x4*)(Cb + pp * 64 + c8) = fc; *(u32x4*)(Bb + pp * 64 + c8) = fb;
          f32x4 x0, x1, b0, b1; pg8::unpack8(fx, x0, x1); pg8::unpack8(fb, b0, b1); x0 = x0 * dt; x1 = x1 * dt; b0 = b0 * ea; b1 = b1 * ea;
#pragma unroll
          for (int i = 0; i < 4; ++i) { XT[(c8 + i) * 64 + pp] = f2bf(x0[i]); XT[(c8 + 4 + i) * 64 + pp] = f2bf(x1[i]); BwT[(c8 + i) * 64 + pp] = f2bf(b0[i]); BwT[(c8 + 4 + i) * 64 + pp] = f2bf(b1[i]); } }
        if (c0 + 64 < SEQ) { SSD_FETCH(c0 + 64); SSD_DT(c0 + 64, par ^ 1); }
        LDS_SYNC();
        {
          const f32x4_t z4 = {0.f, 0.f, 0.f, 0.f};
#pragma unroll
          for (int i = 0; i < 2; ++i) { const int id = wave + 8 * i, lt = id >> 2, st = id & 3; f32x4_t g = z4;
              if (st <= lt) {
#pragma unroll
                  for (int ks = 0; ks < 2; ++ks) g = __builtin_amdgcn_mfma_f32_16x16x32_bf16(*(const bf16x8_t*)(Cb + (16 * lt + c16) * 64 + 32 * ks + 8 * q), *(const bf16x8_t*)(Bb + (16 * st + c16) * 64 + 32 * ks + 8 * q), g, 0, 0, 0);
                  const float as_ = acs[par * 64 + 16 * st + c16];
#pragma unroll
                  for (int r = 0; r < 4; ++r) { const int l = 16 * lt + 4 * q + r; g[r] = (16 * st + c16 <= l) ? g[r] * __expf(acs[par * 64 + l] - as_) : 0.f; } }
#pragma unroll
              for (int r = 0; r < 4; ++r) Pm[(16 * lt + 4 * q + r) * 64 + 16 * st + c16] = f2bf(g[r]); }
#pragma unroll
          for (int lt = 0; lt < 4; ++lt) { const bf16* cr = Cb + (16 * lt + c16) * 64 + 32 * nh + 4 * q;
              const f32x4_t yo = __builtin_amdgcn_mfma_f32_16x16x32_bf16(frag2(*(const u32x2*)cr, *(const u32x2*)(cr + 16)), Sf, z4, 0, 0, 0);
#pragma unroll
              for (int r = 0; r < 4; ++r) Yo[nh * 4096 + (16 * lt + 4 * q + r) * 64 + 16 * pt + c16] = yo[r]; }
          const float eL = __expf(acs[par * 64 + 63]);
          const bf16x8_t xb0 = *(const bf16x8_t*)(XT + (16 * pt + c16) * 64 + 8 * q), xb1 = *(const bf16x8_t*)(XT + (16 * pt + c16) * 64 + 32 + 8 * q);
#pragma unroll
          for (int i = 0; i < 2; ++i) { const bf16* br = BwT + (16 * (2 * nh + i) + c16) * 64 + 8 * q; f32x4_t cin = Sd[i] * eL;
              cin = __builtin_amdgcn_mfma_f32_16x16x32_bf16(*(const bf16x8_t*)br, xb0, cin, 0, 0, 0); Sd[i] = __builtin_amdgcn_mfma_f32_16x16x32_bf16(*(const bf16x8_t*)(br + 32), xb1, cin, 0, 0, 0); }
          u32x2 lo, hi; lo.x = pk2(Sd[0][0], Sd[0][1]); lo.y = pk2(Sd[0][2], Sd[0][3]); hi.x = pk2(Sd[1][0], Sd[1][1]); hi.y = pk2(Sd[1][2], Sd[1][3]); Sf = frag2(lo, hi); }
        LDS_SYNC();
        {
          const f32x4_t z4 = {0.f, 0.f, 0.f, 0.f};
#pragma unroll
          for (int i = 0; i < 2; ++i) { const int id = wave + 8 * i, lt = id >> 2, p2 = id & 3;
              f32x4_t y = __builtin_amdgcn_mfma_f32_16x16x32_bf16(*(const bf16x8_t*)(Pm + (16 * lt + c16) * 64 + 8 * q), *(const bf16x8_t*)(XT + (16 * p2 + c16) * 64 + 8 * q), z4, 0, 0, 0);
              if (lt >= 2) y = __builtin_amdgcn_mfma_f32_16x16x32_bf16(*(const bf16x8_t*)(Pm + (16 * lt + c16) * 64 + 32 + 8 * q), *(const bf16x8_t*)(XT + (16 * p2 + c16) * 64 + 32 + 8 * q), y, 0, 0, 0);
#pragma unroll
              for (int r = 0; r < 4; ++r) { const int l = 16 * lt + 4 * q + r, o = l * 64 + 16 * p2 + c16; Yo[o] = y[r] + __expf(acs[par * 64 + l]) * (Yo[o] + Yo[4096 + o]); } } }
        LDS_SYNC();
        {
          f32x4 x0, x1, z0, z1; pg8::unpack8(xk, x0, x1); pg8::unpack8(zk, z0, z1);
          const f32x4 y0 = (*(const f32x4*)(Yo + pp * 64 + c8) + Dh * x0) * z0 * sig4g(z0), y1 = (*(const f32x4*)(Yo + pp * 64 + c8 + 4) + Dh * x1) * z1 * sig4g(z1);
          *(u32x4*)(YA + (size_t)c0 * 512) = pg8::pack8(y0, y1); }
    }
#undef SSD_FETCH
#undef SSD_DT
}
__device__ __forceinline__ void ssd_norm_item4(KArgs C, int layer, int item0, int stride, int nitems, int lane) {
    u32x2 w[4]; bf16* p[4];
#pragma unroll
    for (int q = 0; q < 4; ++q) { const int item = item0 + q * stride; p[q] = WSP(bf16, WS_Y) + (size_t)((item < nitems ? item : item0) >> 1) * 512 + ((item < nitems ? item : item0) & 1) * 256 + lane * 4; w[q] = *(const u32x2*)p[q]; }
#pragma unroll
    for (int q = 0; q < 4; ++q) { const int item = item0 + q * stride; if (item < nitems) {
        float v[4] = {lo_bf(w[q].x), hi_bf(w[q].x), lo_bf(w[q].y), hi_bf(w[q].y)};
        const float rstd = 1.0f / sqrtf(wave_sum(v[0] * v[0] + v[1] * v[1] + v[2] * v[2] + v[3] * v[3]) * (1.f / 256) + RMS_EPS);
        const float* g = C->in[I_SSDNG] + layer * 512 + (item & 1) * 256 + lane * 4;
        u32x2 o; o.x = pk2(v[0] * rstd * g[0], v[1] * rstd * g[1]); o.y = pk2(v[2] * rstd * g[2], v[3] * rstd * g[3]); *(u32x2*)p[q] = o; } }
}
__device__ __forceinline__ void rwkv_prep_row(KArgs C, int layer, int m, int lane) {
    const int t = m % SEQ, col = 1536 + lane * 4;
    const bf16* cur = WSP(const bf16, WS_RW) + (size_t)m * 1792 + col;
    const u32x2 wc = *(const u32x2*)cur; u32x2 wp; wp.x = 0u; wp.y = 0u; if (t > 0) wp = *(const u32x2*)(cur - 1792);
    const f32x4 mu = *(const f32x4*)(C->in[I_MU] + layer * 1792 + col);
    float v[4] = {lo_bf(wc.x), hi_bf(wc.x), lo_bf(wc.y), hi_bf(wc.y)}; const float p[4] = {lo_bf(wp.x), hi_bf(wp.x), lo_bf(wp.y), hi_bf(wp.y)};
#pragma unroll
    for (int i = 0; i < 4; ++i) { v[i] = v[i] + (p[i] - v[i]) * mu[i]; v[i] = lane < 16 ? tanh_fast(v[i]) : (lane < 32 ? v[i] : sigm(v[i])); }
    u32x2 o; o.x = pk2(v[0], v[1]); o.y = pk2(v[2], v[3]); *(u32x2*)(WSP(bf16, WS_RA) + (size_t)m * 256 + lane * 4) = o;
}
__device__ __forceinline__ void ssd_conv_rows8(KArgs C, int layer, int m0, int lane) {
    const float* cw = C->in[I_CONVW] + layer * 4 * 768; const float* cb = C->in[I_CONVB] + layer * 768; const bool head = (m0 % SEQ) == 0;
    u32x2 w[3][11];
#pragma unroll
    for (int i = 0; i < 3; ++i) { const bf16* p = WSP(const bf16, WS_XBC) + (size_t)m0 * 768 + i * 256 + lane * 4;
#pragma unroll
        for (int r = 0; r < 11; ++r) { if (r >= 3 || !head) w[i][r] = *(const u32x2*)(p + (r - 3) * 768); else { w[i][r].x = 0u; w[i][r].y = 0u; } } }
#pragma unroll
    for (int i = 0; i < 3; ++i) { const int ch = i * 256 + lane * 4; const f32x4 bb = *(const f32x4*)(cb + ch); f32x4 cq[4], x[11];
#pragma unroll
        for (int q = 0; q < 4; ++q) cq[q] = *(const f32x4*)(cw + q * 768 + ch);
#pragma unroll
        for (int r = 0; r < 11; ++r) x[r] = (f32x4){lo_bf(w[i][r].x), hi_bf(w[i][r].x), lo_bf(w[i][r].y), hi_bf(w[i][r].y)};
#pragma unroll
        for (int r = 0; r < 8; ++r) { f32x4 a = bb;
#pragma unroll
            for (int q = 0; q < 4; ++q) a += cq[q] * x[r + q];
            a = a * sig4g(a);
            u32x2 o; o.x = pk2(a.x, a.y); o.y = pk2(a.z, a.w); *(u32x2*)(WSP(bf16, WS_XBA) + (size_t)(m0 + r) * 768 + ch) = o; } }
}
__device__ __forceinline__ void rwkv_prep_rows8(KArgs C, int layer, int m0, int lane) {
    const int col = 1536 + lane * 4; const f32x4 mu = *(const f32x4*)(C->in[I_MU] + layer * 1792 + col); const bool head = (m0 % SEQ) == 0;
    const bf16* cur = WSP(const bf16, WS_RW) + (size_t)m0 * 1792 + col; u32x2 w[9];
#pragma unroll
    for (int r = 0; r < 9; ++r) { if (r >= 1 || !head) w[r] = *(const u32x2*)(cur + (r - 1) * 1792); else { w[r].x = 0u; w[r].y = 0u; } }
#pragma unroll
    for (int r = 0; r < 8; ++r) { float v[4] = {lo_bf(w[r + 1].x), hi_bf(w[r + 1].x), lo_bf(w[r + 1].y), hi_bf(w[r + 1].y)}; const float p[4] = {lo_bf(w[r].x), hi_bf(w[r].x), lo_bf(w[r].y), hi_bf(w[r].y)};
#pragma unroll
        for (int i = 0; i < 4; ++i) { v[i] = v[i] + (p[i] - v[i]) * mu[i]; v[i] = lane < 16 ? tanh_fast(v[i]) : (lane < 32 ? v[i] : sigm(v[i])); }
        u32x2 o; o.x = pk2(v[0], v[1]); o.y = pk2(v[2], v[3]); *(u32x2*)(WSP(bf16, WS_RA) + (size_t)(m0 + r) * 256 + lane * 4) = o; }
}
__device__ __forceinline__ void rwkv_prep_row2(KArgs C, int layer, int m, int step, int lane) {
    const int col = 1536 + lane * 4; const f32x4 mu = *(const f32x4*)(C->in[I_MU] + layer * 1792 + col);
    u32x2 wc[2], wp[2];
#pragma unroll
    for (int r = 0; r < 2; ++r) { const int mm = m + r * step; const bf16* cur = WSP(const bf16, WS_RW) + (size_t)mm * 1792 + col; wc[r] = *(const u32x2*)cur;
        if (mm % SEQ > 0) wp[r] = *(const u32x2*)(cur - 1792); else { wp[r].x = 0u; wp[r].y = 0u; } }
#pragma unroll
    for (int r = 0; r < 2; ++r) { float v[4] = {lo_bf(wc[r].x), hi_bf(wc[r].x), lo_bf(wc[r].y), hi_bf(wc[r].y)}; const float p[4] = {lo_bf(wp[r].x), hi_bf(wp[r].x), lo_bf(wp[r].y), hi_bf(wp[r].y)};
#pragma unroll
        for (int i = 0; i < 4; ++i) { v[i] = v[i] + (p[i] - v[i]) * mu[i]; v[i] = lane < 16 ? tanh_fast(v[i]) : (lane < 32 ? v[i] : sigm(v[i])); }
        u32x2 o; o.x = pk2(v[0], v[1]); o.y = pk2(v[2], v[3]); *(u32x2*)(WSP(bf16, WS_RA) + (size_t)(m + r * step) * 256 + lane * 4) = o; }
}
__device__ __forceinline__ void rwkv_unit(KArgs C, int layer, int unit, unsigned char* lds) {
    constexpr int SLOT = 16704, O_RT = 2048, O_BTL = 4096, O_KTL = 6144, O_BHT = 8192, O_KHT = 10240, O_VT = 12288, O_TM = 14336, O_AAK = 14848, O_RB = 15360, O_RK = 15872, O_DL = 16384, O_BON = 16640;
    const int tid = fresh_tid(), lane = tid & 63, wave = tid >> 6, bl = unit >> 3, h = unit & 7, pt = tid >> 3, k8 = (tid & 7) * 8, cc = pt >> 4, tl = pt & 15, hc = h * 64 + k8;
    float* WL = (float*)(lds + 4 * SLOT); float* Nf = WL + 4096; float* Yb = Nf + 1024; float* ct_ = Yb + 4096;
    const bf16* RW = WSP(const bf16, WS_RW) + (size_t)bl * SEQ * 1792 + hc;
    const float* WLG = WSP(const float, WS_WLOG) + (size_t)bl * SEQ * 512 + hc;
    const bf16* AS = WSP(const bf16, WS_ASIG) + (size_t)bl * SEQ * 512 + hc;
    const bf16* GG = WSP(const bf16, WS_GG) + (size_t)bl * SEQ * 512 + hc;
    bf16* YC = WSP(bf16, WS_Y) + (size_t)2 * MG * 512 + (size_t)bl * SEQ * 512 + hc;
    LDS_SYNC();
    { const int row = tid >> 6, j = tid & 63; const float* src = row == 0 ? C->in[I_MU] + layer * 1792 : row == 1 ? C->in[I_MU] + layer * 1792 + 512 : row == 2 ? C->in[I_MU] + layer * 1792 + 1024
          : row == 3 ? C->in[I_KK] + layer * 512 : row == 4 ? C->in[I_KA] + layer * 512 : row == 5 ? C->in[I_RK] + layer * 512 : row == 6 ? C->in[I_LNG] + layer * 512 : C->in[I_LNB] + layer * 512;
      ct_[tid] = src[h * 64 + j]; }
    f32x4_t Sd[4]; bf16x8_t Sf[2];
#pragma unroll
    for (int i = 0; i < 4; ++i) Sd[i] = (f32x4_t){0.f, 0.f, 0.f, 0.f};
    { u32x2 z; z.x = 0u; z.y = 0u; Sf[0] = frag2(z, z); Sf[1] = Sf[0]; }
    u32x4 rc, rp, kc, kp, vc, vp, ac, gc; f32x4 wl0, wl1;
#define RWKV_FETCH(c0_) do { const int tt_ = (c0_) + pt; const bf16* q_ = RW + (size_t)tt_ * 1792; \
        rc = *(const u32x4*)q_; kc = *(const u32x4*)(q_ + 512); vc = *(const u32x4*)(q_ + 1024); \
        if (tt_ > 0) { rp = *(const u32x4*)(q_ - 1792); kp = *(const u32x4*)(q_ - 1792 + 512); vp = *(const u32x4*)(q_ - 1792 + 1024); } else { rp = (u32x4){0u, 0u, 0u, 0u}; kp = rp; vp = rp; } \
        wl0 = *(const f32x4*)(WLG + (size_t)tt_ * 512); wl1 = *(const f32x4*)(WLG + (size_t)tt_ * 512 + 4); ac = *(const u32x4*)(AS + (size_t)tt_ * 512); gc = *(const u32x4*)(GG + (size_t)tt_ * 512); } while (0)
    RWKV_FETCH(0);
    LDS_SYNC();
    for (int c0 = 0; c0 < SEQ; c0 += 64) {
        unsigned char* slot = lds + cc * SLOT;
        f32x4 r0, r1, kq0, kq1, v0, v1, kk0, kk1, b0, b1; const u32x4 gkeep = gc; const f32x4 wk0 = wl0, wk1 = wl1; float bo;
        { f32x4 c0_, c1_, p0_, p1_, a0, a1;
          pg8::unpack8(rc, c0_, c1_); pg8::unpack8(rp, p0_, p1_); r0 = c0_ + (p0_ - c0_) * *(const f32x4*)(ct_ + k8); r1 = c1_ + (p1_ - c1_) * *(const f32x4*)(ct_ + k8 + 4);
          pg8::unpack8(kc, c0_, c1_); pg8::unpack8(kp, p0_, p1_); const f32x4 k00 = c0_ + (p0_ - c0_) * *(const f32x4*)(ct_ + 64 + k8), k01 = c1_ + (p1_ - c1_) * *(const f32x4*)(ct_ + 64 + k8 + 4);
          pg8::unpack8(vc, c0_, c1_); pg8::unpack8(vp, p0_, p1_); v0 = c0_ + (p0_ - c0_) * *(const f32x4*)(ct_ + 128 + k8); v1 = c1_ + (p1_ - c1_) * *(const f32x4*)(ct_ + 128 + k8 + 4);
          pg8::unpack8(ac, a0, a1);
          kk0 = k00 * *(const f32x4*)(ct_ + 192 + k8); kk1 = k01 * *(const f32x4*)(ct_ + 192 + k8 + 4);
          const float inv = 1.0f / fmaxf(sqrtf(red8((kk0.x * kk0.x + kk0.y * kk0.y + kk0.z * kk0.z + kk0.w * kk0.w) + (kk1.x * kk1.x + kk1.y * kk1.y + kk1.z * kk1.z + kk1.w * kk1.w))), 1e-12f);
          kk0 = kk0 * inv; kk1 = kk1 * inv; b0 = kk0 * a0; b1 = kk1 * a1;
          kq0 = k00 * (1.0f + (a0 - 1.0f) * *(const f32x4*)(ct_ + 256 + k8)); kq1 = k01 * (1.0f + (a1 - 1.0f) * *(const f32x4*)(ct_ + 256 + k8 + 4));
          const f32x4 q0 = r0 * kq0 * *(const f32x4*)(ct_ + 320 + k8), q1 = r1 * kq1 * *(const f32x4*)(ct_ + 320 + k8 + 4);
          bo = red8((q0.x + q0.y + q0.z + q0.w) + (q1.x + q1.y + q1.z + q1.w));
          *(f32x4*)(WL + pt * 64 + k8) = wk0; *(f32x4*)(WL + pt * 64 + k8 + 4) = wk1; }
        if (c0 + 64 < SEQ) RWKV_FETCH(c0 + 64);
        LDS_SYNC();
        if (tid < 256) { const int c_ = tid >> 6, k_ = tid & 63; float w16[16], run = 0.f;
#pragma unroll
            for (int t = 0; t < 16; ++t) w16[t] = WL[(c_ * 16 + t) * 64 + k_];
#pragma unroll
            for (int t = 0; t < 16; ++t) { run += w16[t]; WL[(c_ * 16 + t) * 64 + k_] = run; }
            ((float*)(lds + c_ * SLOT + O_DL))[k_] = __expf(run); }
        LDS_SYNC();
        { const f32x4 cs0 = *(const f32x4*)(WL + pt * 64 + k8), cs1 = *(const f32x4*)(WL + pt * 64 + k8 + 4), d0 = *(const f32x4*)((const float*)(slot + O_DL) + k8), d1 = *(const f32x4*)((const float*)(slot + O_DL) + k8 + 4);
          f32x4 e0, e1, f0, f1, w0, w1;
#pragma unroll
          for (int i = 0; i < 4; ++i) { e0[i] = __expf(cs0[i]); e1[i] = __expf(cs1[i]); f0[i] = __builtin_amdgcn_rcpf(e0[i]); f1[i] = __builtin_amdgcn_rcpf(e1[i]); w0[i] = __expf(-wk0[i]); w1[i] = __expf(-wk1[i]); }
          const f32x4 bt0 = b0 * f0, bt1 = b1 * f1, kt0 = kq0 * f0, kt1 = kq1 * f1;
          *(u32x4*)((bf16*)slot + tl * 64 + k8) = pg8::pack8(-(kk0 * e0 * w0), -(kk1 * e1 * w1));
          *(u32x4*)((bf16*)(slot + O_RT) + tl * 64 + k8) = pg8::pack8(r0 * e0, r1 * e1);
          *(u32x4*)((bf16*)(slot + O_BTL) + tl * 64 + k8) = pg8::pack8(bt0, bt1);
          *(u32x4*)((bf16*)(slot + O_KTL) + tl * 64 + k8) = pg8::pack8(kt0, kt1);
          const f32x4 bh0 = bt0 * d0, bh1 = bt1 * d1, kh0 = kt0 * d0, kh1 = kt1 * d1;
          bf16* bht = (bf16*)(slot + O_BHT) + k8 * 16 + tl; bf16* kht = (bf16*)(slot + O_KHT) + k8 * 16 + tl; bf16* vt = (bf16*)(slot + O_VT) + k8 * 16 + tl;
#pragma unroll
          for (int i = 0; i < 4; ++i) { bht[i * 16] = f2bf(bh0[i]); bht[(i + 4) * 16] = f2bf(bh1[i]); kht[i * 16] = f2bf(kh0[i]); kht[(i + 4) * 16] = f2bf(kh1[i]); vt[i * 16] = f2bf(v0[i]); vt[(i + 4) * 16] = f2bf(v1[i]); } }
        LDS_SYNC();
        { unsigned char* sl = lds + (wave & 3) * SLOT; const int c16 = lane & 15, q = lane >> 4;
          const bf16x8_t a0 = *(const bf16x8_t*)((const bf16*)sl + c16 * 64 + 8 * q), a1 = *(const bf16x8_t*)((const bf16*)sl + c16 * 64 + 32 + 8 * q);
          const bf16x8_t bb0 = *(const bf16x8_t*)((const bf16*)(sl + O_BTL) + c16 * 64 + 8 * q), bb1 = *(const bf16x8_t*)((const bf16*)(sl + O_BTL) + c16 * 64 + 32 + 8 * q);
          const f32x4_t z4 = {0.f, 0.f, 0.f, 0.f};
          if (wave < 4) {
              f32x4_t n = __builtin_amdgcn_mfma_f32_16x16x32_bf16(a0, bb0, z4, 0, 0, 0); n = __builtin_amdgcn_mfma_f32_16x16x32_bf16(a1, bb1, n, 0, 0, 0);
              float* nf = Nf + (wave & 3) * 256;
#pragma unroll
              for (int r = 0; r < 4; ++r) nf[c16 * 16 + 4 * q + r] = (c16 < 4 * q + r) ? n[r] : 0.f;
              WAVE_SYNC();
              float tc[16];
#pragma unroll
              for (int t = 0; t < 16; ++t) tc[t] = (t == c16) ? 1.f : 0.f;
#pragma unroll
              for (int s2 = 0; s2 < 15; ++s2) { const f32x4 n0 = *(const f32x4*)(nf + s2 * 16), n1 = *(const f32x4*)(nf + s2 * 16 + 4), n2 = *(const f32x4*)(nf + s2 * 16 + 8), n3 = *(const f32x4*)(nf + s2 * 16 + 12);
                  const float ts = tc[s2]; const float nn[16] = {n0.x, n0.y, n0.z, n0.w, n1.x, n1.y, n1.z, n1.w, n2.x, n2.y, n2.z, n2.w, n3.x, n3.y, n3.z, n3.w};
#pragma unroll
                  for (int t = 0; t < 16; ++t) if (t > s2) tc[t] += nn[t] * ts; }
              if (q == 0) { bf16* tm = (bf16*)(sl + O_TM) + c16;
#pragma unroll
                  for (int t = 0; t < 16; ++t) tm[t * 16] = f2bf(tc[t]); }
          } else {
              const bf16x8_t r0f = *(const bf16x8_t*)((const bf16*)(sl + O_RT) + c16 * 64 + 8 * q), r1f = *(const bf16x8_t*)((const bf16*)(sl + O_RT) + c16 * 64 + 32 + 8 * q);
              const bf16x8_t kb0 = *(const bf16x8_t*)((const bf16*)(sl + O_KTL) + c16 * 64 + 8 * q), kb1 = *(const bf16x8_t*)((const bf16*)(sl + O_KTL) + c16 * 64 + 32 + 8 * q);
              f32x4_t ak = __builtin_amdgcn_mfma_f32_16x16x32_bf16(a0, kb0, z4, 0, 0, 0); ak = __builtin_amdgcn_mfma_f32_16x16x32_bf16(a1, kb1, ak, 0, 0, 0);
              f32x4_t rb = __builtin_amdgcn_mfma_f32_16x16x32_bf16(r0f, bb0, z4, 0, 0, 0); rb = __builtin_amdgcn_mfma_f32_16x16x32_bf16(r1f, bb1, rb, 0, 0, 0);
              f32x4_t rk = __builtin_amdgcn_mfma_f32_16x16x32_bf16(r0f, kb0, z4, 0, 0, 0); rk = __builtin_amdgcn_mfma_f32_16x16x32_bf16(r1f, kb1, rk, 0, 0, 0);
#pragma unroll
              for (int r = 0; r < 4; ++r) { const int t = 4 * q + r;
                  ((bf16*)(sl + O_AAK))[t * 16 + c16] = f2bf(c16 < t ? ak[r] : 0.f); ((bf16*)(sl + O_RB))[t * 16 + c16] = f2bf(c16 <= t ? rb[r] : 0.f); ((bf16*)(sl + O_RK))[t * 16 + c16] = f2bf(c16 <= t ? rk[r] : 0.f); }
          } }
        LDS_SYNC();
        if (wave < 4) { const int c16 = lane & 15, q = lane >> 4, vcol = 16 * wave + c16; u32x2 zz; zz.x = 0u; zz.y = 0u; const f32x4_t z4 = {0.f, 0.f, 0.f, 0.f};
#pragma unroll
            for (int ch = 0; ch < 4; ++ch) { const unsigned char* sl = lds + ch * SLOT;
                const bf16* at = (const bf16*)sl + c16 * 64 + 4 * q; const bf16* rt = (const bf16*)(sl + O_RT) + c16 * 64 + 4 * q;
                const bf16x8_t af0 = frag2(*(const u32x2*)at, *(const u32x2*)(at + 16)), af1 = frag2(*(const u32x2*)(at + 32), *(const u32x2*)(at + 48));
                const bf16x8_t rf0 = frag2(*(const u32x2*)rt, *(const u32x2*)(rt + 16)), rf1 = frag2(*(const u32x2*)(rt + 32), *(const u32x2*)(rt + 48));
                const u32x2 vq = *(const u32x2*)((const bf16*)(sl + O_VT) + vcol * 16 + 4 * q);
                const u32x2 aq = *(const u32x2*)((const bf16*)(sl + O_AAK) + c16 * 16 + 4 * q), tq = *(const u32x2*)((const bf16*)(sl + O_TM) + c16 * 16 + 4 * q);
                const u32x2 rbq = *(const u32x2*)((const bf16*)(sl + O_RB) + c16 * 16 + 4 * q), rkq = *(const u32x2*)((const bf16*)(sl + O_RK) + c16 * 16 + 4 * q);
                f32x4_t rhs = __builtin_amdgcn_mfma_f32_16x16x32_bf16(frag2(zz, aq), frag2(zz, vq), z4, 0, 0, 0); rhs = __builtin_amdgcn_mfma_f32_16x16x32_bf16(af0, Sf[0], rhs, 0, 0, 0);
                { const f32x4_t r2 = __builtin_amdgcn_mfma_f32_16x16x32_bf16(af1, Sf[1], z4, 0, 0, 0); rhs = rhs + r2; }
                u32x2 rl; rl.x = pk2(rhs[0], rhs[1]); rl.y = pk2(rhs[2], rhs[3]);
                const f32x4_t U = __builtin_amdgcn_mfma_f32_16x16x32_bf16(frag2(tq, zz), frag2(rl, zz), z4, 0, 0, 0);
                u32x2 ul; ul.x = pk2(U[0], U[1]); ul.y = pk2(U[2], U[3]); const bf16x8_t uv = frag2(ul, vq);
                f32x4_t y = __builtin_amdgcn_mfma_f32_16x16x32_bf16(rf0, Sf[0], z4, 0, 0, 0); y = __builtin_amdgcn_mfma_f32_16x16x32_bf16(rf1, Sf[1], y, 0, 0, 0);
                y = __builtin_amdgcn_mfma_f32_16x16x32_bf16(frag2(rbq, rkq), uv, y, 0, 0, 0);
#pragma unroll
                for (int r = 0; r < 4; ++r) Yb[(ch * 16 + 4 * q + r) * 64 + vcol] = y[r];
#pragma unroll
                for (int kt = 0; kt < 4; ++kt) { const f32x4 dl = *(const f32x4*)((const float*)(sl + O_DL) + 16 * kt + 4 * q);
                    const u32x2 bq = *(const u32x2*)((const bf16*)(sl + O_BHT) + (16 * kt + c16) * 16 + 4 * q), kq = *(const u32x2*)((const bf16*)(sl + O_KHT) + (16 * kt + c16) * 16 + 4 * q);
                    const f32x4_t cin = {Sd[kt][0] * dl.x, Sd[kt][1] * dl.y, Sd[kt][2] * dl.z, Sd[kt][3] * dl.w};
                    Sd[kt] = __builtin_amdgcn_mfma_f32_16x16x32_bf16(frag2(bq, kq), uv, cin, 0, 0, 0); }
#pragma unroll
                for (int s2 = 0; s2 < 2; ++s2) { u32x2 lo, hi; lo.x = pk2(Sd[2 * s2][0], Sd[2 * s2][1]); lo.y = pk2(Sd[2 * s2][2], Sd[2 * s2][3]); hi.x = pk2(Sd[2 * s2 + 1][0], Sd[2 * s2 + 1][1]); hi.y = pk2(Sd[2 * s2 + 1][2], Sd[2 * s2 + 1][3]); Sf[s2] = frag2(lo, hi); }
            } }
        LDS_SYNC();
        { const f32x4 y0 = *(const f32x4*)(Yb + pt * 64 + k8), y1 = *(const f32x4*)(Yb + pt * 64 + k8 + 4);
          const float mean = red8((y0.x + y0.y + y0.z + y0.w) + (y1.x + y1.y + y1.z + y1.w)) * (1.f / 64); const f32x4 d0 = y0 - mean, d1 = y1 - mean;
          const float rstd = 1.0f / sqrtf(red8((d0.x * d0.x + d0.y * d0.y + d0.z * d0.z + d0.w * d0.w) + (d1.x * d1.x + d1.y * d1.y + d1.z * d1.z + d1.w * d1.w)) * (1.f / 64) + GN_EPS);
          f32x4 g0, g1; pg8::unpack8(gkeep, g0, g1);
          const f32x4 o0 = (d0 * rstd * *(const f32x4*)(ct_ + 384 + k8) + *(const f32x4*)(ct_ + 448 + k8) + bo * v0) * g0, o1 = (d1 * rstd * *(const f32x4*)(ct_ + 384 + k8 + 4) + *(const f32x4*)(ct_ + 448 + k8 + 4) + bo * v1) * g1;
          *(u32x4*)(YC + (size_t)(c0 + pt) * 512) = pg8::pack8(o0, o1); }
    }
#undef RWKV_FETCH
}

__device__ __forceinline__ void s5_unit(KArgs C, int layer, int unit, unsigned char* lds) {
    const int tid = fresh_tid(), lane = tid & 63, wave = tid >> 6, bl = unit >> 5, g = unit & 31, c16 = lane & 15, q = lane >> 4, sg = wave & 3, th = wave >> 2, p = 16 * sg + c16;
    constexpr int SP = 136;
    float* us0 = (float*)lds; float* ends = us0 + 4096; bf16* St = (bf16*)(ends + 32 * 128);
    const bf16* U = WSP(const bf16, WS_U) + (size_t)bl * SEQ * 512 + g * 16;
    bf16* YD0 = WSP(bf16, WS_YD0) + (size_t)bl * SEQ * 512 + g * 16;
    const size_t wo = (layer & 1) ? WDELTA : 0;
    bf16x8_t bre, bim;
    { const float* bb = WSP(const float, WS_BBAR + wo) + ((size_t)g * 64 + p) * 32; u32x4 wr_, wi_;
      if (q < 2) { const float* b8 = bb + 16 * q; wr_.x = pk2(b8[0], b8[2]); wr_.y = pk2(b8[4], b8[6]); wr_.z = pk2(b8[8], b8[10]); wr_.w = pk2(b8[12], b8[14]);
                   wi_.x = pk2(b8[1], b8[3]); wi_.y = pk2(b8[5], b8[7]); wi_.z = pk2(b8[9], b8[11]); wi_.w = pk2(b8[13], b8[15]); }
      else { wr_ = (u32x4){0u, 0u, 0u, 0u}; wi_ = wr_; }
      bre = __builtin_bit_cast(bf16x8_t, wr_); bim = __builtin_bit_cast(bf16x8_t, wi_); }
    float apr[4], api[4];
    { const float ar = WSP(const float, WS_ABAR + wo)[(g * 64 + p) * 2], ai = WSP(const float, WS_ABAR + wo)[(g * 64 + p) * 2 + 1]; apr[0] = ar; api[0] = ai;
#pragma unroll
      for (int i = 1; i < 4; ++i) { apr[i] = apr[i - 1] * ar - api[i - 1] * ai; api[i] = apr[i - 1] * ai + api[i - 1] * ar; } }
    bf16x8_t cf[4];
    { const float* cre = C->in[I_S5CRE] + ((size_t)layer * 32 + g) * 1024 + c16 * 64; const float* cim = C->in[I_S5CIM] + ((size_t)layer * 32 + g) * 1024 + c16 * 64;
#pragma unroll
      for (int ks = 0; ks < 4; ++ks) { const int c0_ = 32 * ks + 8 * q; const float* src = c0_ < 64 ? cre + c0_ : cim + (c0_ - 64); const float sgn = c0_ < 64 ? 1.f : -1.f;
          u32x4 w; w.x = pk2(sgn * src[0], sgn * src[1]); w.y = pk2(sgn * src[2], sgn * src[3]); w.z = pk2(sgn * src[4], sgn * src[5]); w.w = pk2(sgn * src[6], sgn * src[7]); cf[ks] = __builtin_bit_cast(bf16x8_t, w); } }
    const float dj = C->in[I_S5D][layer * 512 + g * 16 + c16];
    float cr = 0.f, ci = 0.f;
    u32x2 fu; fu.x = 0u; fu.y = 0u;
#define S5_FETCH(c0_) do { fu = *(const u32x2*)(U + (size_t)((c0_) + (tid >> 2)) * 512 + (tid & 3) * 4); } while (0)
    S5_FETCH(0);
    LDS_SYNC();
    *(f32x4*)(us0 + (tid >> 2) * 16 + (tid & 3) * 4) = (f32x4){lo_bf(fu.x), hi_bf(fu.x), lo_bf(fu.y), hi_bf(fu.y)};
    if (128 < SEQ) S5_FETCH(128);
    for (int c0 = 0; c0 < SEQ; c0 += 128) { float* us = us0 + ((c0 >> 7) & 1) * 2048;
        LDS_SYNC();
        float lr[4][4], li[4][4];
#pragma unroll
        for (int tt = 0; tt < 4; ++tt) { bf16x8_t af;
            if (q < 2) { const float* ur = us + (64 * th + 16 * tt + c16) * 16 + 8 * q; const f32x4 u0 = *(const f32x4*)ur, u1 = *(const f32x4*)(ur + 4);
                u32x4 w; w.x = pk2(u0.x, u0.y); w.y = pk2(u0.z, u0.w); w.z = pk2(u1.x, u1.y); w.w = pk2(u1.z, u1.w); af = __builtin_bit_cast(bf16x8_t, w); }
            else { const u32x4 z = {0u, 0u, 0u, 0u}; af = __builtin_bit_cast(bf16x8_t, z); }
            const f32x4_t z4 = {0.f, 0.f, 0.f, 0.f};
            const f32x4_t dre = __builtin_amdgcn_mfma_f32_16x16x32_bf16(af, bre, z4, 0, 0, 0), dim = __builtin_amdgcn_mfma_f32_16x16x32_bf16(af, bim, z4, 0, 0, 0);
            lr[tt][0] = dre[0]; li[tt][0] = dim[0];
#pragma unroll
            for (int r = 1; r < 4; ++r) { lr[tt][r] = apr[0] * lr[tt][r - 1] - api[0] * li[tt][r - 1] + dre[r]; li[tt][r] = apr[0] * li[tt][r - 1] + api[0] * lr[tt][r - 1] + dim[r]; }
            const int rho = (4 * th + tt) * 4 + q; ends[(rho * 64 + p) * 2] = lr[tt][3]; ends[(rho * 64 + p) * 2 + 1] = li[tt][3]; }
        LDS_SYNC();
        { float xr = cr, xi = ci, xinr[4] = {0.f, 0.f, 0.f, 0.f}, xini[4] = {0.f, 0.f, 0.f, 0.f};
#pragma unroll
          for (int rr = 0; rr < 32; ++rr) { const int tt = (rr >> 2) & 3;
              if ((rr >> 4) == th) { const bool mine = (rr & 3) == q; xinr[tt] = mine ? xr : xinr[tt]; xini[tt] = mine ? xi : xini[tt]; }
              const float er = ends[(rr * 64 + p) * 2], ei = ends[(rr * 64 + p) * 2 + 1]; const float nr = apr[3] * xr - api[3] * xi + er, ni = apr[3] * xi + api[3] * xr + ei; xr = nr; xi = ni; }
          cr = xr; ci = xi;
#pragma unroll
          for (int tt = 0; tt < 4; ++tt)
#pragma unroll
              for (int r = 0; r < 4; ++r) { const float sr = lr[tt][r] + apr[r] * xinr[tt] - api[r] * xini[tt], si = li[tt][r] + apr[r] * xini[tt] + api[r] * xinr[tt]; const int t = 64 * th + 16 * tt + 4 * q + r;
                  St[t * SP + p] = f2bf(sr); St[t * SP + 64 + p] = f2bf(si); } }
        LDS_SYNC();
        { f32x4_t y = {0.f, 0.f, 0.f, 0.f};
#pragma unroll
            for (int ks = 0; ks < 4; ++ks) y = __builtin_amdgcn_mfma_f32_16x16x32_bf16(*(const bf16x8_t*)(St + (16 * wave + c16) * SP + 32 * ks + 8 * q), cf[ks], y, 0, 0, 0);
#pragma unroll
            for (int r = 0; r < 4; ++r) { const int t = 16 * wave + 4 * q + r; YD0[(size_t)(c0 + t) * 512 + c16] = f2bf(gelu_tanh(y[r] + dj * us[t * 16 + c16])); } }
        if (c0 + 128 < SEQ) { float* un = us0 + (((c0 >> 7) + 1) & 1) * 2048;
            *(f32x4*)(un + (tid >> 2) * 16 + (tid & 3) * 4) = (f32x4){lo_bf(fu.x), hi_bf(fu.x), lo_bf(fu.y), hi_bf(fu.y)};
            if (c0 + 256 < SEQ) S5_FETCH(c0 + 256); }
    }
#undef S5_FETCH
}

__device__ __forceinline__ unsigned ord_key(float f) { const unsigned u = __float_as_uint(f); return (u & 0x80000000u) ? ~u : (u | 0x80000000u); }
__device__ __forceinline__ void dsa_vt_item(KArgs C, int item, int lane, bf16* scr) {
    const int tb = item % NK64, bh = item / NK64, h = bh & 7, bl = bh >> 3;
    const bf16* V = WSP(const bf16, WS_V) + ((size_t)bl * SEQ + tb * 64) * 512 + h * 64;
    WAVE_SYNC();
#pragma unroll
    for (int i = 0; i < 8; ++i) { const int tk = (lane >> 3) + 8 * i, c8 = (lane & 7) * 8; const u32x4 w = *(const u32x4*)(V + (size_t)tk * 512 + c8);
        unsigned* d = (unsigned*)(scr + tk * 66 + c8); d[0] = w.x; d[1] = w.y; d[2] = w.z; d[3] = w.w; }
    WAVE_SYNC();
    bf16* Vt = WSP(bf16, WS_VT) + ((size_t)bh * 64) * SEQ + tb * 64 + lane;
#pragma unroll 8
    for (int d = 0; d < 64; ++d) Vt[(size_t)d * SEQ] = scr[lane * 66 + d];
}
constexpr int IDX_CAP = 128, IDX_NBIN = 1024;
__device__ __forceinline__ void dsa_index_unit(KArgs C, int unit, int lane, int wave, unsigned char* lds) {
    const int oct = unit & 7, pairid = (unit >> 3) % (NK64 / 2), kx = (unit >> 3) / (NK64 / 2), bl = kx >> 1, c = (kx & 1) ? NK64 - 1 - pairid : pairid;
    const int t0 = c * 64 + oct * 8, nkeys = (c + 1) * 64, nk64 = c + 1; const size_t row0 = (size_t)bl * SEQ + t0;
    unsigned* mrow = WSP(unsigned, WS_MASK) + (row0 + wave) * MW;
    if (nkeys <= TOPK) { for (int w = lane; w < MW; w += 64) mrow[w] = (w * 32 < nkeys) ? 0xffffffffu : 0u; return; }
    float* scf = (float*)lds;
    unsigned* hist = (unsigned*)(lds + LDS_X) + wave * (IDX_NBIN / 2); unsigned* candv = (unsigned*)(lds + LDS_X + 8 * IDX_NBIN * 2) + wave * IDX_CAP; unsigned* candi = candv + 8 * IDX_CAP; unsigned* mword = (unsigned*)(lds + LDS_X + 8 * IDX_NBIN * 2 + 16 * IDX_CAP * 4) + wave * MW;
    const bf16* SMb = WSP(const bf16, WS_SM) + (size_t)bl * SEQ * 256;
    const int l31 = lane & 31, half = lane >> 5;
    const bf16* qa = SMb + (size_t)(t0 + (l31 >> 2)) * 256 + 8 + (l31 & 3) * 32 + 8 * half;
    const bf16x8_t a0 = *(const bf16x8_t*)qa, a1 = *(const bf16x8_t*)(qa + 16);
    u32x2 wraw[4];
#pragma unroll
    for (int g = 0; g < 4; ++g) wraw[g] = *(const u32x2*)(SMb + (size_t)(t0 + 2 * g + half) * 256 + 168);
    LDS_SYNC();
    {
      float wv[4][4];
#pragma unroll
      for (int g = 0; g < 4; ++g) { const u32x2 w = wraw[g]; wv[g][0] = lo_bf(w.x) * 0.5f; wv[g][1] = hi_bf(w.x) * 0.5f; wv[g][2] = lo_bf(w.y) * 0.5f; wv[g][3] = hi_bf(w.y) * 0.5f; }
      for (int kt0 = wave; kt0 < nk64 * 2; kt0 += 8 * NWAVES) {
          bf16x8_t b0[8], b1[8];
#pragma unroll
          for (int u4 = 0; u4 < 8; ++u4) { const int kt = kt0 + 8 * u4; const bf16* kb = WSP(const bf16, WS_KI) + ((size_t)bl * SEQ + (size_t)((kt < nk64 * 2 ? kt : wave) * 32 + l31)) * 32 + 8 * half;
              b0[u4] = *(const bf16x8_t*)kb; b1[u4] = *(const bf16x8_t*)(kb + 16); }
#pragma unroll
          for (int u4 = 0; u4 < 8; ++u4) { const int kt = kt0 + 8 * u4; if (kt < nk64 * 2) {
              f32x16 d;
#pragma unroll
              for (int r = 0; r < 16; ++r) d[r] = 0.f;
              d = __builtin_amdgcn_mfma_f32_32x32x16_bf16(a0, b0[u4], d, 0, 0, 0); d = __builtin_amdgcn_mfma_f32_32x32x16_bf16(a1, b1[u4], d, 0, 0, 0);
#pragma unroll
              for (int g = 0; g < 4; ++g) { float sc = 0.f;
#pragma unroll
                  for (int j = 0; j < 4; ++j) sc += wv[g][j] * fmaxf(d[4 * g + j] * 0.17677669529f, 0.f);
                  scf[(2 * g + half) * SEQ + kt * 32 + l31] = sc; } } }
      } }
    { const int tail0 = nkeys, tail1 = ((nk64 + 7) >> 3) * 512;
      for (int e = tail0 + (int)(threadIdx.x); e < tail1; e += NTHREADS) {
#pragma unroll
          for (int qq = 0; qq < 8; ++qq) scf[qq * SEQ + e] = -3.0e38f; } }
    LDS_SYNC();
    const float* sc = scf + wave * SEQ; constexpr float NEG = -3.0e38f; const int nb8 = (nk64 + 7) >> 3;
    float v[NK64];
#pragma unroll
    for (int ib = 0; ib < NK64 / 8; ++ib) if (ib < nb8) {
#pragma unroll
        for (int j = 0; j < 8; ++j) v[ib * 8 + j] = sc[(ib * 8 + j) * 64 + lane];
        SCHED_FENCE(); }
    float mn = INFINITY, mx = -INFINITY;
#pragma unroll
    for (int ib = 0; ib < NK64 / 8; ++ib) if (ib < nb8) {
#pragma unroll
        for (int j = 0; j < 8; ++j) { const float x = v[ib * 8 + j]; mx = fmaxf(mx, x); mn = fminf(mn, x == NEG ? INFINITY : x); } }
    mn = -wave_max(-mn); mx = wave_max(mx);
    const float scale = (mx > mn) ? ((float)(IDX_NBIN - 2) - 0.01f) / (mx - mn) : 0.f;
#pragma unroll
    for (int i = 0; i < IDX_NBIN / 128; ++i) hist[lane * (IDX_NBIN / 128) + i] = 0u;
    for (int w = lane; w < MW; w += 64) mword[w] = 0u;
    WAVE_SYNC();
#define IDX_BIN(x) ({ const float x_ = (x); int b_ = (int)(fmaxf(x_ - mn, 0.f) * scale + 1.0f); b_ = b_ > IDX_NBIN - 2 ? IDX_NBIN - 2 : b_; b_ + (__float_as_int(x_) >> 31) + (__float_as_int(x_) > 0 ? 1 : 0); })
#pragma unroll
    for (int ib = 0; ib < NK64 / 8; ++ib) if (ib < nb8) {
#pragma unroll
        for (int j = 0; j < 8; ++j) { const int b = IDX_BIN(v[ib * 8 + j]); atomicAdd(&hist[b >> 1], (b & 1) ? 0x10000u : 1u); v[ib * 8 + j] = __int_as_float(b); }
        SCHED_FENCE(); }
    WAVE_SYNC();
    int bstar, cgt;
    {
      unsigned hw[8]; int tot = 0;
#pragma unroll
      for (int i = 0; i < 8; ++i) { hw[i] = hist[lane * 8 + i]; tot += (int)(hw[i] & 0xffffu) + (int)(hw[i] >> 16); }
      int suf = tot;
#pragma unroll
      for (int o = 1; o < 64; o <<= 1) { const int t = __shfl_down(suf, o); if (lane + o < 64) suf += t; }
      const unsigned long long ge = __ballot(suf >= TOPK); const int L = 63 - __builtin_clzll(ge);
      int cum = __shfl(suf, L) - __shfl(tot, L); bstar = 16 * L; cgt = cum; bool found = false;
#pragma unroll
      for (int i = 7; i >= 0; --i) { const unsigned w = (unsigned)__shfl((int)hw[i], L); const int chi = (int)(w >> 16), clo = (int)(w & 0xffffu);
          if (!found && cum + chi >= TOPK) { bstar = 16 * L + 2 * i + 1; cgt = cum; found = true; } cum += found ? 0 : chi;
          if (!found && cum + clo >= TOPK) { bstar = 16 * L + 2 * i; cgt = cum; found = true; } cum += found ? 0 : clo; } }
    const int need = TOPK - cgt; int ncand = 0;
    const bool tiebin = bstar == IDX_BIN(0.0f);
    unsigned mylo = 0u, myhi = 0u;
#pragma unroll
    for (int ib = 0; ib < NK64 / 8; ++ib) if (ib < nb8) {
#pragma unroll
        for (int j = 0; j < 8; ++j) { const int i = ib * 8 + j; const int b = __float_as_int(v[i]);
            unsigned long long bs = __ballot(b > bstar); const unsigned long long bc = __ballot(b == bstar);
            if (bc != 0ull) {
                const int pos = ncand + (int)__builtin_amdgcn_mbcnt_hi((unsigned)(bc >> 32), __builtin_amdgcn_mbcnt_lo((unsigned)bc, 0u));
                if (tiebin) bs |= __ballot(b == bstar && pos < need);
                else if (b == bstar && pos < IDX_CAP) { candv[pos] = ord_key(sc[i * 64 + lane]); candi[pos] = (unsigned)(i * 64 + lane); }
                ncand += __popcll(bc); }
            if (lane == i) { mylo = (unsigned)bs; myhi = (unsigned)(bs >> 32); } }
        SCHED_FENCE(); }
    if (lane < nb8 * 8) { mword[2 * lane] = mylo; mword[2 * lane + 1] = myhi; }
#undef IDX_BIN
    WAVE_SYNC();
    if (tiebin) { }
    else if (ncand <= IDX_CAP) {
        for (int m = lane; m < ncand; m += 64) { const unsigned vm = candv[m]; int rank = 0;
#pragma unroll 4
            for (int j = 0; j < ncand; ++j) { const unsigned vj = candv[j]; rank += (vj > vm || (vj == vm && j < m)) ? 1 : 0; }
            if (rank < need) { const unsigned idx = candi[m]; atomicOr(&mword[idx >> 5], 1u << (idx & 31)); } }
    } else {
#pragma unroll
        for (int ib = 0; ib < NK64 / 8; ++ib) if (ib < nb8) {
#pragma unroll
            for (int j = 0; j < 8; ++j) v[ib * 8 + j] = sc[(ib * 8 + j) * 64 + lane]; }
        unsigned T = 0u;
        for (int bit = 31; bit >= 0; --bit) { const unsigned cand = T | (1u << bit); int cn = 0;
#pragma unroll
            for (int ib = 0; ib < NK64 / 8; ++ib) if (ib < nb8) {
#pragma unroll
                for (int j = 0; j < 8; ++j) cn += (ord_key(v[ib * 8 + j]) >= cand) ? 1 : 0; }
            if (wave_sum_i(cn) >= TOPK) T = cand; }
        int cg = 0;
#pragma unroll
        for (int ib = 0; ib < NK64 / 8; ++ib) if (ib < nb8) {
#pragma unroll
            for (int j = 0; j < 8; ++j) cg += (ord_key(v[ib * 8 + j]) > T) ? 1 : 0; }
        const int need2 = TOPK - wave_sum_i(cg); int taken = 0;
#pragma unroll
        for (int ib = 0; ib < NK64 / 8; ++ib) if (ib < nb8) {
#pragma unroll
            for (int j = 0; j < 8; ++j) { const int i = ib * 8 + j; const unsigned kv = ord_key(v[i]); const bool eq = kv == T; const unsigned long long be = __ballot(eq);
                const int pre = __popcll(be & ((1ull << lane) - 1ull)); const bool sel = (kv > T) || (eq && (taken + pre) < need2); taken += __popcll(be);
                const unsigned long long bs = __ballot(sel); if (lane == 0) { mword[2 * i] = (unsigned)bs; mword[2 * i + 1] = (unsigned)(bs >> 32); } } }
    }
    WAVE_SYNC();
#ifdef HOST_EMU
    if (lane == 0) { static int rows = 0, bad = 0, ties = 0, falls = 0; std::vector<int> id(nkeys); for (int i = 0; i < nkeys; ++i) id[i] = i;
        std::stable_sort(id.begin(), id.end(), [&](int a, int b) { return sc[a] > sc[b]; }); std::vector<unsigned> ref(MW, 0u); for (int i = 0; i < TOPK; ++i) ref[id[i] >> 5] |= 1u << (id[i] & 31);
        bool ok = true; for (int w = 0; w < MW; ++w) ok = ok && ref[w] == mword[w]; ++rows; bad += ok ? 0 : 1; ties += tiebin ? 1 : 0; falls += (!tiebin && ncand > IDX_CAP) ? 1 : 0;
        if ((rows & 63) == 0 || !ok) printf("[idx-check] rows %d bad %d tiebin %d fallback %d\n", rows, bad, ties, falls); }
#endif
    for (int w = lane; w < MW; w += 64) mrow[w] = mword[w];
}

constexpr int AT_KP = 72, AT_VP = 72, AT_BUF = 64 * AT_KP + 64 * AT_VP;
__device__ __forceinline__ void dsa_attn_half(KArgs C, int bl, int h, int cb, int tid, bf16* tiles, const float* btab) {
    const int lane = tid & 63, wave = tid >> 6, l31 = lane & 31, hh = lane >> 5, c = 4 * cb + (wave >> 1), qb = wave & 1, q0 = c * 64 + qb * 32, qpos = q0 + l31, q0s = __builtin_amdgcn_readfirstlane(q0);
    const size_t qrow = (size_t)bl * SEQ + qpos;
    const bf16* Qp = WSP(const bf16, WS_Q) + qrow * 512 + h * 64 + 8 * hh;
    const unsigned* Mp = WSP(const unsigned, WS_MASK) + qrow * MW;
    const bf16* gk = WSP(const bf16, WS_K) + ((size_t)bl * SEQ + (tid >> 3)) * 512 + h * 64 + (tid & 7) * 8;
    const bf16* gv = WSP(const bf16, WS_VT) + ((size_t)(bl * 8 + h) * 64 + (tid >> 3)) * SEQ + (tid & 7) * 8;
    const int lk = (tid >> 3) * AT_KP + (tid & 7) * 8, lv = 64 * AT_KP + (tid >> 3) * AT_VP + (tid & 7) * 8;
    constexpr float SC = 0.125f * 1.44269504089f;
    bf16x8_t qf[4];
#pragma unroll
    for (int s = 0; s < 4; ++s) qf[s] = *(const bf16x8_t*)(Qp + 16 * s);
    f32x16 O0, O1;
#pragma unroll
    for (int r = 0; r < 16; ++r) { O0[r] = 0.f; O1[r] = 0.f; }
    float m = -1e30f, lsum = 0.f;
    const int ntw = c + 1, nt = 4 * cb + 4;
    u32x4 prek = *(const u32x4*)gk, prev = *(const u32x4*)gv; u32x2 mwn = *(const u32x2*)Mp;
    LDS_SYNC();
    const float bfar = btab[0];
    *(u32x4*)(tiles + lk) = prek; *(u32x4*)(tiles + lv) = prev;
    if (nt > 1) { prek = *(const u32x4*)(gk + (size_t)64 * 512); prev = *(const u32x4*)(gv + 64); }
    for (int kt = 0; kt < nt; ++kt) {
        LDS_SYNC();
        const bf16* tb = tiles + (kt & 1) * AT_BUF; const u32x2 mw2 = mwn;
        if (kt + 1 < ntw) mwn = *(const u32x2*)(Mp + 2 * (kt + 1));
        if (kt < ntw) {
            f32x16 S[2];
#pragma unroll
            for (int t2 = 0; t2 < 2; ++t2) {
#pragma unroll
                for (int r = 0; r < 16; ++r) S[t2][r] = 0.f;
#pragma unroll
                for (int s = 0; s < 4; ++s) S[t2] = __builtin_amdgcn_mfma_f32_32x32x16_bf16(*(const bf16x8_t*)(tb + (t2 * 32 + l31) * AT_KP + 16 * s + 8 * hh), qf[s], S[t2], 0, 0, 0); }
#define AT_P2(P_, X0_, X1_, MW_, R_, ROW_) do { f32x2 pp_; pp_.x = __uint_as_float(__float_as_uint(__builtin_amdgcn_exp2f(X0_)) & bit_fill<ROW_>(MW_)); \
                pp_.y = __uint_as_float(__float_as_uint(__builtin_amdgcn_exp2f(X1_)) & bit_fill<ROW_ + 1>(MW_)); P_[R_] = pp_.x; P_[R_ + 1] = pp_.y; ps2 += pp_; } while (0)
#define AT_RESCALE(TM_) do { float tm_ = (TM_); tm_ = fmaxf(tm_, __shfl_xor(tm_, 32)); \
                if (__ballot(tm_ > m) != 0ull) { const float mn = fmaxf(m, tm_), alpha = __builtin_amdgcn_exp2f(m - mn); m = mn; lsum *= alpha; \
                    _Pragma("unroll") for (int r = 0; r < 16; ++r) { O0[r] *= alpha; O1[r] *= alpha; } } } while (0)
            f32x16 P[2]; f32x2 ps2 = (f32x2){0.f, 0.f}; float tm;
            const unsigned mwc0 = mw2.x >> (4 * hh), mwc1 = mw2.y >> (4 * hh);
            const bool far = (kt * 64 + 63 - q0s) <= -166;
            if (far) { float rm = fmaxf(S[0][0], S[1][0]);
#pragma unroll
                for (int r = 1; r < 16; ++r) rm = fmaxf(fmaxf(rm, S[0][r]), S[1][r]);
                tm = rm * SC + bfar;
            } else { tm = -1e30f;
#pragma unroll
                for (int t2 = 0; t2 < 2; ++t2) { const int rb = kt * 64 + t2 * 32 + 4 * hh - qpos + 256;
#pragma unroll
                    for (int r = 0; r < 16; ++r) { const int row = (r & 3) + 8 * (r >> 2); int ti = rb + row; ti = ti < 0 ? 0 : ti; tm = fmaxf(tm, S[t2][r] * SC + btab[ti]); } } }
            AT_RESCALE(tm);
            if (far) { const float ad = bfar - m;
#define AT_FAR(R_, ROW_) do { const f32x2 x0_ = (f32x2){S[0][R_], S[0][R_ + 1]} * SC + ad, x1_ = (f32x2){S[1][R_], S[1][R_ + 1]} * SC + ad; \
                    AT_P2(P[0], x0_.x, x0_.y, mwc0, R_, ROW_); AT_P2(P[1], x1_.x, x1_.y, mwc1, R_, ROW_); } while (0)
                AT_FAR(0, 0); AT_FAR(2, 2); AT_FAR(4, 8); AT_FAR(6, 10); AT_FAR(8, 16); AT_FAR(10, 18); AT_FAR(12, 24); AT_FAR(14, 26);
#undef AT_FAR
            } else {
#define AT_BIAS(T2_, R_, ROW_) (S[T2_][R_] * SC + (btab[imax0(kt * 64 + (T2_) * 32 + 4 * hh - qpos + 256 + (ROW_))] - m))
#define AT_NEAR(R_, ROW_) do { AT_P2(P[0], AT_BIAS(0, R_, ROW_), AT_BIAS(0, R_ + 1, ROW_ + 1), mwc0, R_, ROW_); AT_P2(P[1], AT_BIAS(1, R_, ROW_), AT_BIAS(1, R_ + 1, ROW_ + 1), mwc1, R_, ROW_); } while (0)
                AT_NEAR(0, 0); AT_NEAR(2, 2); AT_NEAR(4, 8); AT_NEAR(6, 10); AT_NEAR(8, 16); AT_NEAR(10, 18); AT_NEAR(12, 24); AT_NEAR(14, 26);
#undef AT_BIAS
#undef AT_NEAR
            }
#undef AT_P2
#undef AT_RESCALE
            const float ps = ps2.x + ps2.y;
            lsum += ps;
#pragma unroll
            for (int t2 = 0; t2 < 2; ++t2) { const bf16* vb = tb + 64 * AT_KP + l31 * AT_VP + t2 * 32 + 4 * hh;
#pragma unroll
                for (int s = 0; s < 2; ++s) { u32x4 w; w.x = pk2(P[t2][8 * s + 0], P[t2][8 * s + 1]); w.y = pk2(P[t2][8 * s + 2], P[t2][8 * s + 3]); w.z = pk2(P[t2][8 * s + 4], P[t2][8 * s + 5]); w.w = pk2(P[t2][8 * s + 6], P[t2][8 * s + 7]);
                    const bf16x8_t pf = __builtin_bit_cast(bf16x8_t, w);
                    O0 = __builtin_amdgcn_mfma_f32_32x32x16_bf16(frag2(*(const u32x2*)(vb + 16 * s), *(const u32x2*)(vb + 16 * s + 8)), pf, O0, 0, 0, 0);
                    O1 = __builtin_amdgcn_mfma_f32_32x32x16_bf16(frag2(*(const u32x2*)(vb + 32 * AT_VP + 16 * s), *(const u32x2*)(vb + 32 * AT_VP + 16 * s + 8)), pf, O1, 0, 0, 0); } }
        }
        if (kt + 1 < nt) { bf16* nb = tiles + ((kt + 1) & 1) * AT_BUF; *(u32x4*)(nb + lk) = prek; *(u32x4*)(nb + lv) = prev;
            if (kt + 2 < nt) { prek = *(const u32x4*)(gk + (size_t)(kt + 2) * 64 * 512); prev = *(const u32x4*)(gv + (size_t)(kt + 2) * 64); } }
    }
    lsum += __shfl_xor(lsum, 32);
    const float inv = 1.0f / lsum;
    bf16* Y = WSP(bf16, WS_Y) + (size_t)MG * 512 + qrow * 512 + h * 64 + 4 * hh;
#pragma unroll
    for (int g = 0; g < 4; ++g) { u32x2 w; w.x = pk2(O0[4 * g] * inv, O0[4 * g + 1] * inv); w.y = pk2(O0[4 * g + 2] * inv, O0[4 * g + 3] * inv); *(u32x2*)(Y + 8 * g) = w;
        u32x2 w2; w2.x = pk2(O1[4 * g] * inv, O1[4 * g + 1] * inv); w2.y = pk2(O1[4 * g + 2] * inv, O1[4 * g + 3] * inv); *(u32x2*)(Y + 32 + 8 * g) = w2; }
}
__device__ __forceinline__ void dsa_attn_unit3(KArgs C, int unit, int tid, unsigned char* lds) {
    constexpr int NPAIR = NK64 / 8;
    const int pr = unit % NPAIR, h = (unit / NPAIR) & 7, bl = unit / (NPAIR * 8);
    float* btab = (float*)lds; bf16* tiles = (bf16*)(lds + 2048);
    __syncthreads();
    { const int* tab = WSP(const int, WS_TAB); const float* relb = C->in[I_RELB];
      if (tid < 320) btab[tid] = relb[tab[tid - 256 + SEQ - 1] * 8 + h] * 1.44269504089f; }
    dsa_attn_half(C, bl, h, pr, tid, tiles, btab);
    dsa_attn_half(C, bl, h, NK64 / 4 - 1 - pr, tid, tiles, btab);
}
#ifndef GP_ALIGN
#define GP_ALIGN true
#endif
#ifndef GP_SP2
#define GP_SP2 true
#endif
constexpr int SEGS_PER_GROUP = 11, NSEG = DEPTH * (1 + NGRP * SEGS_PER_GROUP) + 1;

#ifdef HOST_EMU
#define GRID_BARRIER() emu_grid_sync()
#define LDS_PTR(p) ((unsigned char*)(p))
#else
#define GRID_BARRIER() do { XcdBarrier b_; b_.bar = (unsigned*)(Ck->ws + WS_CTL); b_.x = xb_xcc_id(); b_.st = (volatile LAS unsigned*)(lds + LDS_CTL_OFF); xcd_barrier(b_); } while (0)
#define LDS_PTR(p) ((PG8_LAS unsigned char*)(p))
#endif

__global__ void __launch_bounds__(NTHREADS, 2) fwd_kernel(Args a) {
#ifdef HOST_EMU
    unsigned char* lds = emu_lds;
#else
    extern __shared__ __attribute__((aligned(16))) unsigned char lds[];
#endif
#ifdef HOST_EMU
    KArgs Ck = &a;
#else
    KArgs Ck = (KArgs)__builtin_amdgcn_kernarg_segment_ptr();
    (void)a;
#endif
#ifndef HOST_EMU
    if (threadIdx.x < 4) ((LAS unsigned*)(lds + LDS_CTL_OFF))[threadIdx.x] = 0u;
    __syncthreads();
    if (Ck->seg_hi - Ck->seg_lo > 1) (void)xcd_barrier_post((unsigned*)(Ck->ws + WS_CTL), (volatile LAS unsigned*)(lds + LDS_CTL_OFF));
#endif
#define SEGID 0
#define RUN (SEGID >= Ck->seg_lo && SEGID < Ck->seg_hi)
#define SEAM do { if (SEGID >= Ck->seg_lo && SEGID + 1 < Ck->seg_hi) { GRID_BARRIER(); } } while (0)
#define WO ((layer & 1) ? WDELTA : (size_t)0)
#define PHASE_VARS KArgs C = KLAUNDER(Ck); const int G = gridDim.x, bx = blockIdx.x, ngw = G * NWAVES; (void)ngw; const int tid = fresh_tid(), lane = tid & 63, wave = __builtin_amdgcn_readfirstlane(tid >> 6), gw = bx * NWAVES + wave; (void)lane; (void)gw; (void)C
    for (int layer = 0; layer < DEPTH; ++layer) {
#undef SEGID
#define SEGID (layer * (1 + NGRP * SEGS_PER_GROUP))
        if (RUN) { PHASE_VARS; phase_weights(C, layer, lds, gw, ngw, lane, wave); }
        SEAM;
        for (int grp = 0; grp < NGRP; ++grp) {
#define XIN ((layer == 0 ? C->in[I_X] : (const float*)C->out) + (size_t)grp * MG * D)
#define XOUT (C->out + (size_t)grp * MG * D)
#undef SEGID
#define SEGID (layer * (1 + NGRP * SEGS_PER_GROUP) + 1 + grp * SEGS_PER_GROUP + 0)
            if (RUN) { PHASE_VARS; rms_rows_bf16<4>(XIN, C->in[I_NMIX] + layer * D, WSP(bf16, WS_H), gw, ngw, MG, lane); }
            SEAM;
#undef SEGID
#define SEGID (layer * (1 + NGRP * SEGS_PER_GROUP) + 1 + grp * SEGS_PER_GROUP + 1)
            if (RUN) { PHASE_VARS; pg8::Gemm g{WSP(const bf16, WS_H), WSP(const bf16, WS_WIN + WO), MG, NMIXC, D}; pg8::StaticOrder S; S.init(MG, NMIXC, G, bx);
                pg8::EpiProj E{C->ws};
                pg8::gemm_phase<pg8::EpiProj, pg8::StaticOrder, false, GP_ALIGN, GP_SP2>(LDS_PTR(lds), g, S, E, nullptr); }
            SEAM;
#undef SEGID
#define SEGID (layer * (1 + NGRP * SEGS_PER_GROUP) + 1 + grp * SEGS_PER_GROUP + 2)
            if (RUN) { PHASE_VARS;
                for (int m8 = gw; m8 < MG / 8; m8 += ngw) { rwkv_prep_rows8(C, layer, m8 * 8, lane); ssd_conv_rows8(C, layer, m8 * 8, lane); }
                for (int it = gw; it < NB * 8 * NK64; it += ngw) dsa_vt_item(C, it, lane, (bf16*)(lds + wave * 16384));
                __syncthreads();
                for (int u = bx; u < NB * NK64 * 8; u += G) dsa_index_unit(C, u, lane, wave, lds);
            }
            SEAM;
#undef SEGID
#define SEGID (layer * (1 + NGRP * SEGS_PER_GROUP) + 1 + grp * SEGS_PER_GROUP + 3)
            if (RUN) { PHASE_VARS; pg8::Gemm g{WSP(const bf16, WS_RA), WSP(const bf16, WS_WLORA + WO), MG, 1536, 256}; pg8::StaticOrder S; S.init(MG, 1536, G, bx);
                pg8::EpiLora E{WSP(float, WS_WLOG), WSP(bf16, WS_ASIG), WSP(bf16, WS_GG), C->in[I_W0] + layer * 512, C->in[I_A0] + layer * 512};
                pg8::gemm_phase<pg8::EpiLora, pg8::StaticOrder, false, GP_ALIGN, GP_SP2>(LDS_PTR(lds), g, S, E, nullptr); }
            SEAM;
#undef SEGID
#define SEGID (layer * (1 + NGRP * SEGS_PER_GROUP) + 1 + grp * SEGS_PER_GROUP + 4)
            if (RUN) { PHASE_VARS;
                constexpr int U_R = NB * 8, U_S = U_R + NB * 8;
                for (int u = bx; u < U_R; u += G) rwkv_unit(C, layer, u, lds);
                for (int u = (bx + G - U_R % G) % G; u < NB * 8; u += G) ssd_unit(C, layer, u, lds);
                { const int first = U_S % G, span = G - first;
                  if (bx >= first) for (int u = bx - first; u < NB * 32; u += span) s5_unit(C, layer, u, lds); }
                for (;;) {
                    const int t2 = fresh_tid();
                    volatile unsigned* qs2 = (volatile unsigned*)(lds + LDS_CTL_OFF + 32);
                    __syncthreads();
                    if (t2 == 0) *qs2 = atomicAdd((unsigned*)(Ck->ws + WS_QCTR) + ((layer * NGRP + grp) * 2) * 64, 1u);
                    __syncthreads();
                    const int u = (int)*qs2;
                    if (u >= NB * NK64) break;
                    dsa_attn_unit3(KLAUNDER(Ck), u, t2, lds);
                }
            }
            SEAM;
#undef SEGID
#define SEGID (layer * (1 + NGRP * SEGS_PER_GROUP) + 1 + grp * SEGS_PER_GROUP + 5)
            if (RUN) { PHASE_VARS;
                { pg8::Gemm g{WSP(const bf16, WS_H), WSP(const bf16, WS_WIN + WO) + (size_t)NMIXC * D, MG, 4096, D}; pg8::StaticOrder S; S.init(MG, 4096, G, bx);
                  pg8::EpiGate E{WSP(bf16, WS_G)}; pg8::gemm_phase<pg8::EpiGate, pg8::StaticOrder, false, GP_ALIGN, GP_SP2>(LDS_PTR(lds), g, S, E, nullptr); }
                { pg8::Gemm g{WSP(const bf16, WS_YD0), WSP(const bf16, WS_GLU + WO), MG, 512, 512}; pg8::StaticOrder S; S.init(MG, 512, G, bx);
                  pg8::EpiGlu E{WSP(const bf16, WS_YD0), WSP(bf16, WS_Y) + (size_t)3 * MG * 512, C->in[I_GLUB] + layer * 512};
                  pg8::gemm_phase<pg8::EpiGlu, pg8::StaticOrder, false, GP_ALIGN, GP_SP2>(LDS_PTR(lds), g, S, E, nullptr); }
                for (int it = gw; it < MG * 2; it += 4 * ngw) ssd_norm_item4(C, layer, it, ngw, MG * 2, lane);
            }
            SEAM;
#undef SEGID
#define SEGID (layer * (1 + NGRP * SEGS_PER_GROUP) + 1 + grp * SEGS_PER_GROUP + 6)
            if (RUN) { PHASE_VARS; pg8::Gemm g{WSP(const bf16, WS_Y), WSP(const bf16, WS_WB + WO), 4 * MG, 4096, 512}; pg8::MergeOrder S{G, bx};
                pg8::EpiMerge E{WSP(const bf16, WS_G), WSP(bf16, WS_MRG)};
                pg8::gemm_phase<pg8::EpiMerge, pg8::MergeOrder, false, GP_ALIGN, GP_SP2>(LDS_PTR(lds), g, S, E, nullptr); }
            SEAM;
#undef SEGID
#define SEGID (layer * (1 + NGRP * SEGS_PER_GROUP) + 1 + grp * SEGS_PER_GROUP + 7)
            if (RUN) { PHASE_VARS; pg8::Gemm g{WSP(const bf16, WS_MRG), WSP(const bf16, WS_WOUT + WO), MG, D, D}; pg8::StaticOrder S; S.init(MG, D, G, bx);
                pg8::EpiResid E{XIN, XOUT}; pg8::gemm_phase<pg8::EpiResid, pg8::StaticOrder, false, GP_ALIGN, GP_SP2>(LDS_PTR(lds), g, S, E, nullptr); }
            SEAM;
#undef SEGID
#define SEGID (layer * (1 + NGRP * SEGS_PER_GROUP) + 1 + grp * SEGS_PER_GROUP + 8)
            if (RUN) { PHASE_VARS; rms_rows_bf16<4>(XOUT, C->in[I_NFFN] + layer * D, WSP(bf16, WS_H), gw, ngw, MG, lane); }
            SEAM;
#undef SEGID
#define SEGID (layer * (1 + NGRP * SEGS_PER_GROUP) + 1 + grp * SEGS_PER_GROUP + 9)
            if (RUN) { PHASE_VARS; pg8::Gemm g{WSP(const bf16, WS_H), WSP(const bf16, WS_W13 + WO), MG, 5632, D}; pg8::StaticOrder S; S.init(MG, 5632, G, bx);
                pg8::EpiSwiglu E{WSP(bf16, WS_HID)};
                pg8::gemm_phase<pg8::EpiSwiglu, pg8::StaticOrder, false, GP_ALIGN, GP_SP2>(LDS_PTR(lds), g, S, E, nullptr); }
            SEAM;
#undef SEGID
#define SEGID (layer * (1 + NGRP * SEGS_PER_GROUP) + 1 + grp * SEGS_PER_GROUP + 10)
            if (RUN) { PHASE_VARS; pg8::Gemm g{WSP(const bf16, WS_HID), WSP(const bf16, WS_W2 + WO), MG, D, FFN}; pg8::StaticOrder S; S.init(MG, D, G, bx);
                pg8::EpiResid E{XOUT, XOUT}; pg8::gemm_phase<pg8::EpiResid, pg8::StaticOrder, false, GP_ALIGN, GP_SP2>(LDS_PTR(lds), g, S, E, nullptr); }
            SEAM;
        }
    }
#undef SEGID
#define SEGID (NSEG - 1)
    { const int layer = 0; (void)layer;
    if (RUN) { PHASE_VARS; for (int m = gw; m < M; m += 2 * ngw) { if (m + ngw < M) rms_row2_f32(C->out + (size_t)m * D, (size_t)ngw * D, C->in[I_NFIN], lane); else rms_row_f32(C->out + (size_t)m * D, C->in[I_NFIN], lane); } } }
#undef RUN
#undef SEAM
}

extern "C" void kernel_launch(void* const* d_in, const int* in_sizes, int n_in, void* d_out, int out_size, void* d_ws, size_t ws_size, hipStream_t stream) {
    static int grid = 0;
    if (grid == 0) {
        if (n_in != N_IN || out_size != M * D || ws_size < WS_END) { fprintf(stderr, "kernel_launch: unexpected shapes (n_in %d, out %d, ws %zu < %zu)\n", n_in, out_size, ws_size, (size_t)WS_END); grid = -1; return; }
        int dev = 0, cus = 0;
        if (hipGetDevice(&dev) != hipSuccess || hipDeviceGetAttribute(&cus, hipDeviceAttributeMultiprocessorCount, dev) != hipSuccess || cus < 1) { grid = -1; return; }
        if (hipFuncSetAttribute((const void*)fwd_kernel, hipFuncAttributeMaxDynamicSharedMemorySize, LDS_BYTES) != hipSuccess) { fprintf(stderr, "kernel_launch: hipFuncSetAttribute failed\n"); grid = -1; return; }
        (void)hipGetLastError();
        grid = cus;
    }
    if (grid < 0) return;
    (void)hipMemsetAsync((char*)d_ws + WS_CTL, 0, CTL_BYTES, stream);
    Args a{};
    for (int i = 0; i < N_IN; ++i) a.in[i] = (const float*)d_in[i];
    a.out = (float*)d_out; a.ws = (unsigned char*)d_ws;
#if CFG_LAUNCHES == 1
    a.seg_lo = 0; a.seg_hi = NSEG;
    hipLaunchKernelGGL(fwd_kernel, dim3(grid), dim3(NTHREADS), LDS_BYTES, stream, a);
#else
    for (int s = 0; s < NSEG; ++s) { a.seg_lo = s; a.seg_hi = s + 1; hipLaunchKernelGGL(fwd_kernel, dim3(grid), dim3(NTHREADS), LDS_BYTES, stream, a); }
#endif
}
```
